# Optimizing an MI355X kernel written in HIP

```python
import math
import jax, jax.numpy as jnp
from jax import lax
import numpy as np

D_MODEL = 2048
BATCH = 4
SEQ = 8192
DEPTH = 1

MIX_WIDTH = D_MODEL
RWKV_HEAD_DIM = 64
RWKV_WIDTH = MIX_WIDTH // 2
RWKV_HEADS = RWKV_WIDTH // RWKV_HEAD_DIM
RWKV_DECAY_LORA = 64
RWKV_ICLR_LORA = 64
RWKV_GATE_LORA = 160
RWKV_GN_EPS = 64e-5
SSM_HEAD_DIM = 64
SSM_WIDTH = MIX_WIDTH - RWKV_WIDTH
SSM_HEADS = SSM_WIDTH // SSM_HEAD_DIM
SSM_GROUPS = 2
SSM_HEADS_PER_GROUP = SSM_HEADS // SSM_GROUPS
SSM_STATE = 128
SSM_CONV = 4
SSM_CHUNK = 128
SSM_CONV_CH = SSM_WIDTH + 2 * SSM_GROUPS * SSM_STATE
SSM_NORM_EPS = 1e-5
RWKV_PROJ = 3 * RWKV_WIDTH + RWKV_DECAY_LORA + RWKV_ICLR_LORA + RWKV_GATE_LORA
SSM_PROJ = SSM_WIDTH + SSM_CONV_CH + SSM_HEADS
IN_PROJ = RWKV_PROJ + SSM_PROJ
PEER_HEADS = 8
PEER_N_KEYS = 128
PEER_EXPERTS = PEER_N_KEYS * PEER_N_KEYS
PEER_KEY_DIM = 256
PEER_HALF = PEER_KEY_DIM // 2
PEER_TOPK = 16
PEER_BLOCK = 128
RMS_EPS = 1e-6

kernel_name = "hymba_rwkv7_mamba2_peer_adaln"


def rms_norm(x, w, eps=RMS_EPS):
    xf = x.astype(jnp.float32)
    return xf * lax.rsqrt(jnp.mean(xf * xf, axis=-1, keepdims=True) + eps) * w.astype(jnp.float32)


def modulate(x, shift, scale):
    return x * (1.0 + scale[:, None, :]) + shift[:, None, :]


def token_shift(p):
    return jnp.pad(p, ((0, 0), (1, 0), (0, 0)))[:, :-1]


def rwkv7_recurrence(r, w, k, v, kk, a):
    bsz, _, h, n = r.shape

    def step(S, inp):
        r_t, w_t, k_t, v_t, kk_t, a_t = inp
        sa = jnp.einsum('bhvk,bhk->bhv', S, kk_t)
        S = (S * w_t[:, :, None, :]
             - sa[..., None] * (kk_t * a_t)[:, :, None, :]
             + v_t[..., None] * k_t[:, :, None, :])
        return S, jnp.einsum('bhvk,bhk->bhv', S, r_t)

    S0 = jnp.zeros((bsz, h, n, n), jnp.float32)
    xs = (jnp.moveaxis(r, 1, 0), jnp.moveaxis(w, 1, 0), jnp.moveaxis(k, 1, 0),
          jnp.moveaxis(v, 1, 0), jnp.moveaxis(kk, 1, 0), jnp.moveaxis(a, 1, 0))
    _, o = lax.scan(step, S0, xs)
    return jnp.moveaxis(o, 0, 1)


def rwkv7_mix(p, mu, w0, w_up, a0, a_up, g_up, k_k, k_a, r_k, ln_w, ln_b):
    bsz, t, _ = p.shape
    p = p + (token_shift(p) - p) * mu
    s0 = RWKV_WIDTH
    r, k, v, wd, ad, gd = jnp.split(
        p, [s0, 2 * s0, 3 * s0, 3 * s0 + RWKV_DECAY_LORA,
            3 * s0 + RWKV_DECAY_LORA + RWKV_ICLR_LORA], axis=-1)
    w_log = -jax.nn.softplus(-(w0 + jnp.tanh(wd) @ w_up)) - 0.5
    decay = jnp.exp(-jnp.exp(w_log))
    a = jax.nn.sigmoid(a0 + ad @ a_up)
    g = jax.nn.sigmoid(gd) @ g_up
    heads = lambda z: z.reshape(bsz, t, RWKV_HEADS, RWKV_HEAD_DIM)
    kk = heads(k * k_k)
    kk = kk / jnp.maximum(jnp.sqrt(jnp.sum(kk * kk, axis=-1, keepdims=True)), 1e-12)
    k = k * (1.0 + (a - 1.0) * k_a)
    r, k, v, decay, a = heads(r), heads(k), heads(v), heads(decay), heads(a)
    o = rwkv7_recurrence(r, decay, k, v, kk, a)
    mean = jnp.mean(o, axis=-1, keepdims=True)
    var = jnp.mean(jnp.square(o - mean), axis=-1, keepdims=True)
    o = ((o - mean) * lax.rsqrt(var + RWKV_GN_EPS)).reshape(bsz, t, RWKV_WIDTH) * ln_w + ln_b
    bonus = jnp.sum(r * k * r_k, axis=-1, keepdims=True) * v
    return (o + bonus.reshape(bsz, t, RWKV_WIDTH)) * g


def segsum_exp(a):
    n = a.shape[-1]
    cs = jnp.cumsum(a, axis=-1)
    diff = cs[..., :, None] - cs[..., None, :]
    mask = jnp.tril(jnp.ones((n, n), dtype=bool))
    return jnp.exp(jnp.where(mask, diff, -jnp.inf))


def ssd_chunked(x, a, b, c):
    bsz, t, g, r, p = x.shape
    n = b.shape[-1]
    nc, L = t // SSM_CHUNK, SSM_CHUNK
    x = x.reshape(bsz, nc, L, g, r, p)
    b = b.reshape(bsz, nc, L, g, n)
    c = c.reshape(bsz, nc, L, g, n)
    a = a.reshape(bsz, nc, L, g, r).transpose(0, 3, 4, 1, 2)
    a_cs = jnp.cumsum(a, axis=-1)
    cb = jnp.einsum('bclgn,bcsgn->bgcls', c, b)
    y_diag = jnp.einsum('bgrcls,bcsgrp->bclgrp', cb[:, :, None] * segsum_exp(a), x)
    decay_to_end = jnp.exp(a_cs[..., -1:] - a_cs)
    states = jnp.einsum('bclgn,bgrcl,bclgrp->bcgrpn', b, decay_to_end, x)
    states = jnp.pad(states, ((0, 0), (1, 0), (0, 0), (0, 0), (0, 0), (0, 0)))
    decay_chunk = segsum_exp(jnp.pad(a_cs[..., -1], ((0, 0), (0, 0), (0, 0), (1, 0))))
    states = jnp.einsum('bgrzc,bcgrpn->bzgrpn', decay_chunk, states)[:, :-1]
    y_off = jnp.einsum('bclgn,bcgrpn,bgrcl->bclgrp', c, states, jnp.exp(a_cs))
    return (y_diag + y_off).reshape(bsz, t, g, r, p)


def mamba2_mix(p, conv_w, conv_b, dt_bias, a_log, d_skip, norm_w):
    bsz, t, _ = p.shape
    z, xbc, dt = jnp.split(p, [SSM_WIDTH, SSM_WIDTH + SSM_CONV_CH], axis=-1)
    xbc = lax.conv_general_dilated(
        xbc, conv_w[:, None, :].astype(xbc.dtype), window_strides=(1,),
        padding=[(SSM_CONV - 1, 0)], dimension_numbers=('NWC', 'WIO', 'NWC'),
        feature_group_count=SSM_CONV_CH) + conv_b
    xbc = jax.nn.silu(xbc)
    xs, bm, cm = jnp.split(xbc, [SSM_WIDTH, SSM_WIDTH + SSM_GROUPS * SSM_STATE], axis=-1)
    dt = jax.nn.softplus(dt + dt_bias)
    A = -jnp.exp(a_log.astype(jnp.float32))
    G, R = SSM_GROUPS, SSM_HEADS_PER_GROUP
    xs = xs.reshape(bsz, t, G, R, SSM_HEAD_DIM)
    dt_g = dt.reshape(bsz, t, G, R)
    y = ssd_chunked(xs * dt_g[..., None], dt_g * A.reshape(G, R),
                    bm.reshape(bsz, t, G, SSM_STATE), cm.reshape(bsz, t, G, SSM_STATE))
    y = y + xs * d_skip.reshape(G, R)[..., None]
    y = y.reshape(bsz, t, SSM_WIDTH) * jax.nn.silu(z)
    y = y.reshape(bsz, t, G, SSM_WIDTH // G)
    y = y * lax.rsqrt(jnp.mean(y * y, axis=-1, keepdims=True) + SSM_NORM_EPS)
    return y.reshape(bsz, t, SSM_WIDTH) * norm_w


def peer_ffn(n, w_query, sub_keys, u_emb, v_emb):
    bsz, t, d = n.shape
    blocks = n.reshape(bsz * t // PEER_BLOCK, PEER_BLOCK, d)

    def one_block(xb):
        q = (xb @ w_query).reshape(PEER_BLOCK, PEER_HEADS, 2, PEER_HALF)
        s = jnp.einsum('lhpd,hpnd->lhpn', q, sub_keys).astype(jnp.float32)
        s_half, i_half = lax.top_k(s, PEER_TOPK)
        cand_s = (s_half[:, :, 0, :, None] + s_half[:, :, 1, None, :]).reshape(
            PEER_BLOCK, PEER_HEADS, PEER_TOPK * PEER_TOPK)
        cand_i = (i_half[:, :, 0, :, None] * PEER_N_KEYS + i_half[:, :, 1, None, :]).reshape(
            PEER_BLOCK, PEER_HEADS, PEER_TOPK * PEER_TOPK)
        top_s, pos = lax.top_k(cand_s, PEER_TOPK)
        eidx = jnp.take_along_axis(cand_i, pos, axis=-1)
        gates = jax.nn.softmax(top_s, axis=-1)
        u = u_emb[eidx]
        act = jax.nn.gelu(jnp.einsum('ld,lhkd->lhk', xb, u), approximate=False)
        return jnp.einsum('lhk,lhkd->ld', gates * act, v_emb[eidx])

    return lax.map(one_block, blocks).reshape(bsz, t, d)


def setup_inputs(seed: int = 0) -> dict:
    key = jax.random.key(seed)
    ks = jax.random.split(key, 32)
    nrm = lambda i, shape, s: jax.random.normal(ks[i], shape, jnp.float32) * s
    L = DEPTH
    dt0 = jnp.exp(jax.random.uniform(ks[17], (L, SSM_HEADS), jnp.float32,
                                     minval=math.log(1e-3), maxval=math.log(1e-1)))
    return {
        "x": nrm(0, (BATCH, SEQ, D_MODEL), 1.0),
        "c": nrm(1, (BATCH, D_MODEL), 1.0),
        "ada_w": nrm(2, (L, D_MODEL, 6 * D_MODEL), 0.5 * D_MODEL ** -0.5),
        "ada_b": nrm(3, (L, 6 * D_MODEL), 0.02),
        "norm1_w": 1.0 + nrm(4, (L, D_MODEL), 0.02),
        "w_in": nrm(5, (L, D_MODEL, IN_PROJ), D_MODEL ** -0.5),
        "rwkv_mu": jax.random.uniform(ks[6], (L, RWKV_PROJ), jnp.float32),
        "rwkv_w0": jax.random.uniform(ks[7], (L, RWKV_WIDTH), jnp.float32, minval=-6.5, maxval=-1.5),
        "rwkv_w_up": nrm(8, (L, RWKV_DECAY_LORA, RWKV_WIDTH), 0.5 * RWKV_DECAY_LORA ** -0.5),
        "rwkv_a0": nrm(9, (L, RWKV_WIDTH), 0.1),
        "rwkv_a_up": nrm(10, (L, RWKV_ICLR_LORA, RWKV_WIDTH), 0.5 * RWKV_ICLR_LORA ** -0.5),
        "rwkv_g_up": nrm(11, (L, RWKV_GATE_LORA, RWKV_WIDTH), RWKV_GATE_LORA ** -0.5),
        "rwkv_k_k": 0.85 + nrm(12, (L, RWKV_WIDTH), 0.02),
        "rwkv_k_a": 1.0 + nrm(13, (L, RWKV_WIDTH), 0.02),
        "rwkv_r_k": nrm(14, (L, RWKV_HEADS, RWKV_HEAD_DIM), 0.1),
        "rwkv_ln_w": 1.0 + nrm(15, (L, RWKV_WIDTH), 0.02),
        "rwkv_ln_b": nrm(16, (L, RWKV_WIDTH), 0.02),
        "mamba_conv_w": nrm(18, (L, SSM_CONV, SSM_CONV_CH), SSM_CONV ** -0.5),
        "mamba_conv_b": nrm(19, (L, SSM_CONV_CH), 0.02),
        "mamba_dt_bias": dt0 + jnp.log(-jnp.expm1(-dt0)),
        "mamba_a_log": jnp.log(jax.random.uniform(ks[20], (L, SSM_HEADS), jnp.float32, minval=1.0, maxval=16.0)),
        "mamba_d": 1.0 + nrm(21, (L, SSM_HEADS), 0.02),
        "mamba_norm_w": 1.0 + nrm(22, (L, SSM_WIDTH), 0.02),
        "w_out": nrm(23, (L, MIX_WIDTH, D_MODEL), MIX_WIDTH ** -0.5),
        "norm2_w": 1.0 + nrm(24, (L, D_MODEL), 0.02),
        "peer_w_query": nrm(25, (L, D_MODEL, PEER_HEADS * PEER_KEY_DIM), D_MODEL ** -0.5),
        "peer_sub_keys": nrm(26, (L, PEER_HEADS, 2, PEER_N_KEYS, PEER_HALF), PEER_HALF ** -0.5),
        "peer_u": nrm(27, (L, PEER_EXPERTS, D_MODEL), D_MODEL ** -0.5),
        "peer_v": nrm(28, (L, PEER_EXPERTS, D_MODEL), 1.0),
        "final_norm_w": 1.0 + nrm(29, (D_MODEL,), 0.02),
    }


def reference(x, c, ada_w, ada_b, norm1_w, w_in, rwkv_mu, rwkv_w0, rwkv_w_up, rwkv_a0,
              rwkv_a_up, rwkv_g_up, rwkv_k_k, rwkv_k_a, rwkv_r_k, rwkv_ln_w, rwkv_ln_b,
              mamba_conv_w, mamba_conv_b, mamba_dt_bias, mamba_a_log, mamba_d, mamba_norm_w,
              w_out, norm2_w, peer_w_query, peer_sub_keys, peer_u, peer_v, final_norm_w):
    out_dtype = x.dtype
    h = x.astype(jnp.float32)
    cond = jax.nn.silu(c.astype(jnp.float32))
    for i in range(DEPTH):
        mod = cond @ ada_w[i] + ada_b[i]
        shift1, scale1, gate1, shift2, scale2, gate2 = jnp.split(mod, 6, axis=-1)
        n = modulate(rms_norm(h, norm1_w[i]), shift1, scale1)
        proj = n @ w_in[i]
        o_rwkv = rwkv7_mix(proj[..., :RWKV_PROJ], rwkv_mu[i], rwkv_w0[i], rwkv_w_up[i],
                           rwkv_a0[i], rwkv_a_up[i], rwkv_g_up[i], rwkv_k_k[i], rwkv_k_a[i],
                           rwkv_r_k[i], rwkv_ln_w[i], rwkv_ln_b[i])
        o_ssm = mamba2_mix(proj[..., RWKV_PROJ:], mamba_conv_w[i], mamba_conv_b[i],
                           mamba_dt_bias[i], mamba_a_log[i], mamba_d[i], mamba_norm_w[i])
        mix = jnp.concatenate([o_rwkv, o_ssm], axis=-1) @ w_out[i]
        h = h + gate1[:, None, :] * mix
        n = modulate(rms_norm(h, norm2_w[i]), shift2, scale2)
        h = h + gate2[:, None, :] * peer_ffn(n, peer_w_query[i], peer_sub_keys[i], peer_u[i], peer_v[i])
    return rms_norm(h, final_norm_w).astype(out_dtype)
```

```cpp
#include <hip/hip_runtime.h>
#include <hip/hip_cooperative_groups.h>
#include <cstdio>
#include <cstdint>
namespace cg = cooperative_groups;
namespace pg8 {
#define PG8_LAS __attribute__((address_space(3)))
typedef unsigned short bf16_t;
typedef short bf16x8 __attribute__((ext_vector_type(8)));
typedef float f32x4 __attribute__((ext_vector_type(4)));
typedef unsigned u32x4 __attribute__((ext_vector_type(4)));
constexpr int BM = 256, BK = 64, HALF = 128, HTB = HALF * BK * 2  , STAGE_BYTES = 8 * HTB, NXCD = 8, WGM = 8;

__host__ __device__ __forceinline__ int lds_byte(int r, int c) { const int st = (r >> 4) * 2 + (c >> 5), rr = r & 15, cc = c & 31, ob = rr * 64 + cc * 2; return st * 1024 + (ob ^ (((ob >> 9) & 1) << 5)); }
__host__ __device__ __forceinline__ void stage_rc(int b, int& R, int& C) { const int st = b / 1024, sb = b % 1024, swz = sb ^ (((sb >> 9) & 1) << 5); R = (st >> 1) * 16 + swz / 64; C = (st & 1) * 32 + (swz % 64) / 2; }
__host__ __device__ __forceinline__ int perm32(int rho) { const int n = rho >> 4, i = rho & 15; return 8 * (i >> 2) + 4 * n + (i & 3); }

struct Unit { int pm, pn; };
struct Gemm { const bf16_t* A; const bf16_t* Bt; int M, N, K; };

struct StaticOrder {
    int nM, nN, nwg, G, c;
    __host__ __device__ void init(int M, int N, int G_, int c_) { nM = M / BM; nN = N / BM; nwg = nM * nN; G = G_; c = c_; }
    __host__ __device__ bool next(int i, Unit& u) const {
        const long L = (long)i * G + c; if (L >= nwg) return false;
        int wgid = (int)L; { const int q = nwg / NXCD, r = nwg % NXCD, xcd = wgid % NXCD, off = wgid / NXCD; wgid = (xcd < r ? xcd * (q + 1) : r * (q + 1) + (xcd - r) * q) + off; }
        const int nig = WGM * nN, gid = wgid / nig, fm = gid * WGM, gsz = (nM - fm) < WGM ? (nM - fm) : WGM;
        u.pm = fm + ((wgid % nig) % gsz); u.pn = (wgid % nig) / gsz; return true;
    }
    __device__ __forceinline__ void a_ready(const Unit&) const {}
    __device__ __forceinline__ void done(const Unit&) const {}
};
__device__ __forceinline__ unsigned cvt_pk_bf16(float lo, float hi) { unsigned r; asm volatile("v_cvt_pk_bf16_f32 %0, %1, %2" : "=v"(r) : "v"(lo), "v"(hi)); return r; }
struct EpiStoreBf16 {
    static constexpr bool PERM = true, AFTER_DRAIN = false;
    bf16_t* O; int ldc;
    __device__ __forceinline__ void operator()(const f32x4 (&acc)[2][2][4][2], const Unit& u, int wr, int wc, int fr, int fq) const {
        const int row0 = u.pm * BM + wr * 64 + fr; const int col0 = u.pn * BM + wc * 32 + 8 * fq;
#pragma unroll
        for (int ai = 0; ai < 2; ++ai)
#pragma unroll
            for (int m = 0; m < 4; ++m) { bf16_t* rowp = O + (size_t)(row0 + ai * HALF + m * 16) * ldc + col0;
#pragma unroll
                for (int bj = 0; bj < 2; ++bj) { const f32x4 v0 = acc[ai][bj][m][0], v1 = acc[ai][bj][m][1];
                    u32x4 w; w.x = cvt_pk_bf16(v0[0], v0[1]); w.y = cvt_pk_bf16(v0[2], v0[3]); w.z = cvt_pk_bf16(v1[0], v1[1]); w.w = cvt_pk_bf16(v1[2], v1[3]);
                    *(u32x4*)(rowp + bj * HALF) = w; } }
    }
};
struct EpiResid {
    static constexpr bool PERM = true, AFTER_DRAIN = false;
    const float* X; const float* gate; float* O; int ldc; int rows_per_batch; int gstride;
    __device__ __forceinline__ void operator()(const f32x4 (&acc)[2][2][4][2], const Unit& u, int wr, int wc, int fr, int fq) const {
        const int row0 = u.pm * BM + wr * 64 + fr; const int col0 = u.pn * BM + wc * 32 + 8 * fq;
        const float* g = gate + (size_t)((u.pm * BM) / rows_per_batch) * gstride + col0;
        f32x4 gv[2][2];
#pragma unroll
        for (int bj = 0; bj < 2; ++bj)
#pragma unroll
            for (int n = 0; n < 2; ++n) gv[bj][n] = *(const f32x4*)(g + bj * HALF + 4 * n);
#pragma unroll
        for (int ai = 0; ai < 2; ++ai)
#pragma unroll
            for (int m = 0; m < 4; ++m) { const size_t off = (size_t)(row0 + ai * HALF + m * 16) * ldc + col0;
#pragma unroll
                for (int bj = 0; bj < 2; ++bj)
#pragma unroll
                    for (int n = 0; n < 2; ++n) { const f32x4 xv = *(const f32x4*)(X + off + bj * HALF + 4 * n);
                        *(f32x4*)(O + off + bj * HALF + 4 * n) = xv + gv[bj][n] * acc[ai][bj][m][n]; } }
    }
};
template <class Epi, class Sched, bool ALIGN_EPI = false, bool SP2 = false>
__device__ __forceinline__ void gemm_phase(PG8_LAS unsigned char* lds, const Gemm g, const Sched& S, const Epi& E) {
    const int tid = threadIdx.x, wid = __builtin_amdgcn_readfirstlane(tid >> 6), lane = tid & 63, wr = wid >> 2, wc = wid & 3, fr = lane & 15, fq = lane >> 4;
    const int K = g.K, nt = K / BK;
    unsigned voffA[2], voffB[2];
#pragma unroll
    for (int i = 0; i < 2; ++i) { int R, C; stage_rc(tid * 16 + i * 8192, R, C); const int Rb = Epi::PERM ? ((R & ~31) + perm32(R & 31)) : R;
        voffA[i] = (unsigned)(R * K + C) * 2u; voffB[i] = (unsigned)(Rb * K + C) * 2u; }
    const size_t kstep = (size_t)(BK * 2);
    const size_t hstep = (size_t)HALF * K * 2;
    const size_t tstep = 2 * hstep;
    const unsigned ldsw = (unsigned)wid * 1024u;
    const int aoff = lds_byte(wr * 64 + fr, fq * 8), boff = lds_byte(wc * 32 + fr, fq * 8);
#define PG8_SA(b, h) (((b) * 2 + (h)) * HTB)
#define PG8_SB(b, h) ((4 + (b) * 2 + (h)) * HTB)
#define PG8_STAGE(bufoff, gbase, voff) do { _Pragma("unroll") for (int _i = 0; _i < 2; ++_i) \
        __builtin_amdgcn_global_load_lds((const unsigned*)((const char*)(gbase) + (voff)[_i]), (PG8_LAS unsigned*)(lds + (bufoff) + ldsw + _i * 8192), 16, 0, 0); } while (0)
#define PG8_LDA(dst, b, h) do { _Pragma("unroll") for (int m = 0; m < 4; ++m) _Pragma("unroll") for (int k = 0; k < 2; ++k) dst[m][k] = *(const PG8_LAS bf16x8*)(lds + PG8_SA(b, h) + aoff + m * 2048 + k * 1024); } while (0)
#define PG8_LDB(dst, b, h) do { _Pragma("unroll") for (int n = 0; n < 2; ++n) _Pragma("unroll") for (int k = 0; k < 2; ++k) dst[n][k] = *(const PG8_LAS bf16x8*)(lds + PG8_SB(b, h) + boff + n * 2048 + k * 1024); } while (0)
#define PG8_MMA(ai, bj, At, Bt) do { __builtin_amdgcn_s_setprio(1); _Pragma("unroll") for (int m = 0; m < 4; ++m) _Pragma("unroll") for (int n = 0; n < 2; ++n) _Pragma("unroll") for (int k = 0; k < 2; ++k) \
        acc[ai][bj][m][n] = __builtin_amdgcn_mfma_f32_16x16x32_bf16(Bt[n][k], At[m][k], acc[ai][bj][m][n], 0, 0, 0); __builtin_amdgcn_s_setprio(0); } while (0)
#define PG8_WAIT_V(n) asm volatile("s_waitcnt vmcnt(" #n ")" ::: "memory")
#define PG8_WAIT_L(n) asm volatile("s_waitcnt lgkmcnt(" #n ")" ::: "memory")
#define PG8_BAR __builtin_amdgcn_s_barrier()
#define PG8_SCHED __builtin_amdgcn_sched_barrier(0)
    Unit cur, nxt; int ui = 0;
    if (!S.next(0, cur)) return;
    f32x4 acc[2][2][4][2];
#pragma unroll
    for (int a = 0; a < 2; ++a)
#pragma unroll
        for (int b = 0; b < 2; ++b)
#pragma unroll
            for (int m = 0; m < 4; ++m)
#pragma unroll
                for (int n = 0; n < 2; ++n) acc[a][b][m][n] = (f32x4){0.f, 0.f, 0.f, 0.f};
    bf16x8 At[4][2], B0[2][2], B1[2][2];
    const char* cA = (const char*)g.A + (size_t)cur.pm * tstep; const char* cB = (const char*)g.Bt + (size_t)cur.pn * tstep;
    S.a_ready(cur);
    if constexpr (SP2) {
        PG8_STAGE(PG8_SB(0, 0), cB, voffB); PG8_STAGE(PG8_SB(0, 1), cB + hstep, voffB); PG8_STAGE(PG8_SA(0, 0), cA, voffA); PG8_STAGE(PG8_SA(0, 1), cA + hstep, voffA);
        if (wr == 1) PG8_BAR;
        PG8_WAIT_V(2); PG8_BAR;
        PG8_STAGE(PG8_SB(1, 0), cB + kstep, voffB); PG8_STAGE(PG8_SA(1, 0), cA + kstep, voffA); PG8_STAGE(PG8_SB(1, 1), cB + hstep + kstep, voffB);
        PG8_WAIT_V(6); PG8_BAR;
    } else {
        PG8_STAGE(PG8_SB(0, 0), cB, voffB); PG8_STAGE(PG8_SA(0, 0), cA, voffA); PG8_STAGE(PG8_SB(0, 1), cB + hstep, voffB); PG8_STAGE(PG8_SA(0, 1), cA + hstep, voffA);
        if (wr == 1) PG8_BAR;
        PG8_WAIT_V(4); PG8_BAR;
        PG8_STAGE(PG8_SB(1, 0), cB + kstep, voffB); PG8_STAGE(PG8_SA(1, 0), cA + kstep, voffA); PG8_STAGE(PG8_SB(1, 1), cB + hstep + kstep, voffB);
        PG8_WAIT_V(6); PG8_BAR;
    }
    for (;;) {
        const bool has_next = S.next(ui + 1, nxt);
        const char* nA = has_next ? (const char*)g.A + (size_t)nxt.pm * tstep : cA; const char* nB = has_next ? (const char*)g.Bt + (size_t)nxt.pn * tstep : cB;
        for (int t = 0; t < nt; t += 2) {
            const bool last = (t == nt - 2);
            const char* a1 = cA + (size_t)(t + 1) * kstep;
            const char* a2 = last ? nA : cA + (size_t)(t + 2) * kstep; const char* b2 = last ? nB : cB + (size_t)(t + 2) * kstep;
            const char* a3 = a2 + kstep; const char* b3 = b2 + kstep;
            if (last && has_next) S.a_ready(nxt);
            if constexpr (SP2) {
            PG8_LDB(B0, 0, 0); PG8_LDB(B1, 0, 1); PG8_SCHED; PG8_LDA(At, 0, 0); PG8_STAGE(PG8_SA(1, 1), a1 + hstep, voffA);
            PG8_WAIT_V(8); PG8_WAIT_L(0); PG8_BAR; PG8_MMA(0, 0, At, B0); PG8_MMA(0, 1, At, B1); PG8_BAR; PG8_SCHED;
            PG8_LDA(At, 0, 1); PG8_STAGE(PG8_SB(0, 0), b2, voffB); PG8_STAGE(PG8_SB(0, 1), b2 + hstep, voffB); PG8_STAGE(PG8_SA(0, 0), a2, voffA);
            PG8_WAIT_V(8); PG8_WAIT_L(0); PG8_BAR; PG8_MMA(1, 0, At, B0); PG8_MMA(1, 1, At, B1); PG8_BAR; PG8_SCHED;
            PG8_LDB(B0, 1, 0); PG8_LDB(B1, 1, 1); PG8_SCHED; PG8_LDA(At, 1, 0); PG8_STAGE(PG8_SA(0, 1), a2 + hstep, voffA);
            PG8_WAIT_V(8); PG8_WAIT_L(0); PG8_BAR; PG8_MMA(0, 0, At, B0); PG8_MMA(0, 1, At, B1); PG8_BAR; PG8_SCHED;
            PG8_LDA(At, 1, 1); PG8_STAGE(PG8_SB(1, 0), b3, voffB); PG8_STAGE(PG8_SB(1, 1), b3 + hstep, voffB); PG8_STAGE(PG8_SA(1, 0), a3, voffA);
            PG8_WAIT_V(8); PG8_WAIT_L(0); PG8_BAR; PG8_MMA(1, 0, At, B0); PG8_MMA(1, 1, At, B1); PG8_BAR; PG8_SCHED;
            } else {
            PG8_LDB(B0, 0, 0); PG8_SCHED; PG8_LDA(At, 0, 0); PG8_STAGE(PG8_SA(1, 1), a1 + hstep, voffA);
            PG8_WAIT_L(8); PG8_BAR; PG8_WAIT_L(0); PG8_MMA(0, 0, At, B0); PG8_BAR; PG8_SCHED;
            PG8_LDB(B1, 0, 1); PG8_STAGE(PG8_SB(0, 0), b2, voffB);
            PG8_BAR; PG8_WAIT_L(0); PG8_MMA(0, 1, At, B1); PG8_BAR;
            PG8_LDA(At, 0, 1); PG8_STAGE(PG8_SA(0, 0), a2, voffA);
            PG8_BAR; PG8_WAIT_L(0); PG8_MMA(1, 0, At, B0); PG8_BAR; PG8_SCHED;
            PG8_STAGE(PG8_SB(0, 1), b2 + hstep, voffB);
            PG8_WAIT_V(6); PG8_BAR; PG8_MMA(1, 1, At, B1); PG8_BAR;
            PG8_LDB(B0, 1, 0); PG8_SCHED; PG8_LDA(At, 1, 0); PG8_STAGE(PG8_SA(0, 1), a2 + hstep, voffA);
            PG8_WAIT_L(8); PG8_BAR; PG8_WAIT_L(0); PG8_MMA(0, 0, At, B0); PG8_BAR; PG8_SCHED;
            PG8_LDB(B1, 1, 1); PG8_STAGE(PG8_SB(1, 0), b3, voffB);
            PG8_BAR; PG8_WAIT_L(0); PG8_MMA(0, 1, At, B1); PG8_BAR;
            PG8_LDA(At, 1, 1); PG8_STAGE(PG8_SA(1, 0), a3, voffA);
            PG8_BAR; PG8_WAIT_L(0); PG8_MMA(1, 0, At, B0); PG8_BAR; PG8_SCHED;
            PG8_STAGE(PG8_SB(1, 1), b3 + hstep, voffB);
            PG8_WAIT_V(6); PG8_BAR; PG8_MMA(1, 1, At, B1); PG8_BAR;
            }
        }
        if constexpr (ALIGN_EPI) { if (wr == 0) PG8_BAR; }
        if constexpr (!Epi::AFTER_DRAIN) { E(acc, cur, wr, wc, fr, fq); S.done(cur); }
        if (!has_next) break;
#pragma unroll
        for (int a = 0; a < 2; ++a)
#pragma unroll
            for (int b = 0; b < 2; ++b)
#pragma unroll
                for (int m = 0; m < 4; ++m)
#pragma unroll
                    for (int n = 0; n < 2; ++n) acc[a][b][m][n] = (f32x4){0.f, 0.f, 0.f, 0.f};
        cur = nxt; cA = nA; cB = nB; ++ui;
        if constexpr (ALIGN_EPI) { if (wr == 1) PG8_BAR; }
    }
    PG8_WAIT_V(0);
    if constexpr (!ALIGN_EPI) { if (wr == 0) PG8_BAR; }
    PG8_BAR;
    if constexpr (Epi::AFTER_DRAIN) { E.fused(acc, cur, wr, wc, fr, fq, lds, wid, lane); S.done(cur); }
#undef PG8_SA
#undef PG8_SB
#undef PG8_STAGE
#undef PG8_LDA
#undef PG8_LDB
#undef PG8_MMA
#undef PG8_WAIT_V
#undef PG8_WAIT_L
#undef PG8_BAR
#undef PG8_SCHED
}
}
#define GAS __attribute__((address_space(1)))
#define LAS __attribute__((address_space(3)))
typedef unsigned short bf16;
typedef unsigned v4u __attribute__((ext_vector_type(4)));
typedef unsigned v2u __attribute__((ext_vector_type(2)));
typedef float f32x4 __attribute__((ext_vector_type(4)));
typedef float f32x2 __attribute__((ext_vector_type(2)));
typedef short bf16x8 __attribute__((ext_vector_type(8)));
typedef __bf16 bf16x2_t __attribute__((ext_vector_type(2)));

constexpr int NWAVES = 8, NTHR = 512;
constexpr int DM = 2048, NB = 4, SEQ = 8192, M = NB * SEQ;
constexpr int RW = 1024, RHEADS = 16, HD = 64;
constexpr int L_W = 64, L_A = 64, L_G = 160;
constexpr int INP = 5936, INPP = 6144;
constexpr int C_R = 0, C_K = 1024, C_V = 2048, C_WD = 3072, C_AD = 3136, C_GD = 3200, C_Z = 3360, C_XBC = 4384, C_DT = 5920;
constexpr int MODW = 6 * DM;
constexpr int NEXP = 16384;
constexpr float RMS_EPS = 1e-6f;

enum { I_X = 0, I_C, I_ADAW, I_ADAB, I_N1W, I_WIN, I_MU, I_W0, I_WUP, I_A0, I_AUP, I_GUP, I_KK, I_KA, I_RK, I_LNW, I_LNB,
       I_CONVW, I_CONVB, I_DTB, I_ALOG, I_DSK, I_MNW, I_WOUT, I_N2W, I_WQ, I_KEYS, I_PU, I_PV, I_FNW, N_IN };

constexpr size_t MiB = 1u << 20;
constexpr size_t WS_CTL = 0, CTL_ZERO_BYTES = 1 * MiB;
constexpr size_t WS_MOD = 1 * MiB;
constexpr size_t WS_WIN = 2 * MiB, WS_WOUT = 26 * MiB, WS_WQ = 34 * MiB, WS_KEYS = 42 * MiB;
constexpr size_t WS_WUPT = 43 * MiB, WS_AUPT = 43 * MiB + 256 * 1024, WS_GUPT = 43 * MiB + 512 * 1024;
constexpr size_t WS_PU = 44 * MiB, WS_PV = 108 * MiB;
constexpr size_t WS_XN = 172 * MiB;
constexpr size_t WS_LW = WS_XN, WS_AA = WS_XN + 64 * MiB;
constexpr size_t WS_PROJ = 300 * MiB;
constexpr size_t WS_Q = WS_PROJ;
constexpr size_t WS_GG = 684 * MiB;
constexpr size_t WS_OY = 748 * MiB;
constexpr size_t WS_END = 876 * MiB;

constexpr int RING_BYTES = 131072, LDS_BYTES = 147456;

#define LDS_WAIT() asm volatile("s_waitcnt lgkmcnt(0)" ::: "memory")
#define VM_WAIT() asm volatile("s_waitcnt vmcnt(0)" ::: "memory")
__device__ __forceinline__ unsigned pk2(float lo, float hi) { f32x2 v = {lo, hi}; bf16x2_t b = __builtin_convertvector(v, bf16x2_t); return __builtin_bit_cast(unsigned, b); }
__device__ __forceinline__ float bflo(unsigned u) { return __uint_as_float(u << 16); }
__device__ __forceinline__ float bfhi(unsigned u) { return __uint_as_float(u & 0xffff0000u); }
__device__ __forceinline__ float bf1(bf16 h) { return __uint_as_float((unsigned)h << 16); }
__device__ __forceinline__ float wave_sum(float v) {
#pragma unroll
    for (int o = 1; o < 64; o <<= 1) v += __shfl_xor(v, o);
    return v;
}
__device__ __forceinline__ float silu_f(float v) { return v / (1.f + __expf(-v)); }
__device__ __forceinline__ float sigmoid_f(float v) { return 1.f / (1.f + __expf(-v)); }

struct Ctx {
    LAS unsigned char* lds;
    int tid, lane, wave, G, gw, NGW;
    const float* const* in;
    float* out; unsigned char* ws;
};

__device__ __forceinline__ void transpose_item(const float* W, int K, int N, bf16* WT, int ldt, int nrows_out, LAS float* scr, int kb, int nb, int lane) {
    const int k0 = 64 * kb, n0 = 32 * nb;
#pragma unroll 8
    for (int i = 0; i < 32; ++i) { const int kk = 2 * i + (lane >> 5), k = k0 + kk, n = n0 + (lane & 31);
        scr[kk * 33 + (lane & 31)] = (k < K && n < N) ? W[(size_t)k * N + n] : 0.f; }
    LDS_WAIT(); asm volatile("" ::: "memory");
    const int c = lane & 7;
#pragma unroll
    for (int j = 0; j < 4; ++j) { const int n = (lane >> 3) + 8 * j; const LAS float* s = scr + (8 * c) * 33 + n;
        v4u o; o.x = pk2(s[0 * 33], s[1 * 33]); o.y = pk2(s[2 * 33], s[3 * 33]); o.z = pk2(s[4 * 33], s[5 * 33]); o.w = pk2(s[6 * 33], s[7 * 33]);
        if (n0 + n < nrows_out && k0 + 8 * c + 8 <= ldt) *(v4u*)(WT + (size_t)(n0 + n) * ldt + k0 + 8 * c) = o; }
    LDS_WAIT(); asm volatile("" ::: "memory");
}
__device__ __forceinline__ void transpose_all(const float* W, int K, int N, bf16* WT, int ldt, int nrows_out, LAS float* scr, int gw, int NGW, int lane) {
    const int nkb = (K + 63) / 64, nnb = nrows_out / 32, nit = nkb * nnb;
    for (int it = gw; it < nit; it += NGW) transpose_item(W, K, N, WT, ldt, nrows_out, scr, it / nnb, it % nnb, lane);
}
__device__ __forceinline__ void convert_all(const float* src, bf16* dst, size_t n8, int gw, int NGW, int lane) {
    const f32x4* s4 = (const f32x4*)src; v4u* d4 = (v4u*)dst;
    for (size_t i = (size_t)gw * 64 + lane; i < n8; i += (size_t)NGW * 64) {
        const f32x4 a = __builtin_nontemporal_load(s4 + 2 * i), b = __builtin_nontemporal_load(s4 + 2 * i + 1);
        v4u o; o.x = pk2(a.x, a.y); o.y = pk2(a.z, a.w); o.z = pk2(b.x, b.y); o.w = pk2(b.z, b.w);
        d4[i] = o; }
}
__device__ __forceinline__ void p0_prologue(const Ctx& F) {
    if (blockIdx.x < MODW / 64) {
        LAS float* sc = (LAS float*)F.lds;
        LAS float* red = sc + NB * DM;
        const float* c = F.in[I_C];
        for (int i = F.tid; i < NB * DM; i += NTHR) sc[i] = silu_f(c[i]);
        __syncthreads();
        const int j = blockIdx.x * 64 + F.lane;
        const float* wp = F.in[I_ADAW] + (size_t)(F.wave * 256) * MODW + j;
        float a0 = 0.f, a1 = 0.f, a2 = 0.f, a3 = 0.f;
#pragma unroll 16
        for (int kk = 0; kk < 256; ++kk) { const float w = wp[(size_t)kk * MODW]; const int k = F.wave * 256 + kk;
            a0 += sc[k] * w; a1 += sc[DM + k] * w; a2 += sc[2 * DM + k] * w; a3 += sc[3 * DM + k] * w; }
        red[(F.wave * 4 + 0) * 64 + F.lane] = a0; red[(F.wave * 4 + 1) * 64 + F.lane] = a1; red[(F.wave * 4 + 2) * 64 + F.lane] = a2; red[(F.wave * 4 + 3) * 64 + F.lane] = a3;
        __syncthreads();
        if (F.tid < 256) { const int b = F.tid >> 6, l = F.tid & 63; float s = F.in[I_ADAB][blockIdx.x * 64 + l];
#pragma unroll
            for (int w = 0; w < 8; ++w) s += red[(w * 4 + b) * 64 + l];
            ((float*)(F.ws + WS_MOD))[b * MODW + blockIdx.x * 64 + l] = s; }
        __syncthreads();
    }
    LAS float* scr = (LAS float*)(F.lds + F.wave * 16384);
    transpose_all(F.in[I_WIN], DM, INP, (bf16*)(F.ws + WS_WIN), DM, INPP, scr, F.gw, F.NGW, F.lane);
    transpose_all(F.in[I_WOUT], DM, DM, (bf16*)(F.ws + WS_WOUT), DM, DM, scr, F.gw, F.NGW, F.lane);
    transpose_all(F.in[I_WQ], DM, DM, (bf16*)(F.ws + WS_WQ), DM, DM, scr, F.gw, F.NGW, F.lane);
    transpose_all(F.in[I_WUP], L_W, RW, (bf16*)(F.ws + WS_WUPT), L_W, RW, scr, F.gw, F.NGW, F.lane);
    transpose_all(F.in[I_AUP], L_A, RW, (bf16*)(F.ws + WS_AUPT), L_A, RW, scr, F.gw, F.NGW, F.lane);
    transpose_all(F.in[I_GUP], L_G, RW, (bf16*)(F.ws + WS_GUPT), L_G, RW, scr, F.gw, F.NGW, F.lane);
    convert_all(F.in[I_KEYS], (bf16*)(F.ws + WS_KEYS), (size_t)16 * 128 * 128 / 8, F.gw, F.NGW, F.lane);
    convert_all(F.in[I_PU], (bf16*)(F.ws + WS_PU), (size_t)NEXP * DM / 8, F.gw, F.NGW, F.lane);
    convert_all(F.in[I_PV], (bf16*)(F.ws + WS_PV), (size_t)NEXP * DM / 8, F.gw, F.NGW, F.lane);
}

__device__ __forceinline__ void norm_mod_rows(const Ctx& F, const float* X, const float* nw, int shift_off, int scale_off, bf16* XN) {
    const float* mod = (const float*)(F.ws + WS_MOD);
    for (int m = F.gw; m < M; m += F.NGW) {
        const int b = m / SEQ;
        const f32x4* xr = (const f32x4*)(X + (size_t)m * DM) + F.lane;
        f32x4 v[8]; float s = 0.f;
#pragma unroll
        for (int j = 0; j < 8; ++j) { v[j] = xr[64 * j]; s += (v[j].x * v[j].x + v[j].y * v[j].y) + (v[j].z * v[j].z + v[j].w * v[j].w); }
        const float rstd = rsqrtf(wave_sum(s) * (1.f / DM) + RMS_EPS);
        const f32x4* wp = (const f32x4*)nw + F.lane;
        const f32x4* shp = (const f32x4*)(mod + (size_t)b * MODW + shift_off) + F.lane;
        const f32x4* scp = (const f32x4*)(mod + (size_t)b * MODW + scale_off) + F.lane;
        v2u* o = (v2u*)(XN + (size_t)m * DM) + F.lane;
#pragma unroll
        for (int j = 0; j < 8; ++j) { const f32x4 w = wp[64 * j], a = scp[64 * j], c = shp[64 * j];
            const f32x4 r = (v[j] * rstd) * w * (a + 1.f) + c;
            v2u p; p.x = pk2(r.x, r.y); p.y = pk2(r.z, r.w); o[64 * j] = p; }
    }
}
__device__ __forceinline__ void final_norm_rows(const Ctx& F, const float* H, const float* nw, float* O) {
    for (int m = F.gw; m < M; m += F.NGW) {
        const f32x4* xr = (const f32x4*)(H + (size_t)m * DM) + F.lane;
        f32x4 v[8]; float s = 0.f;
#pragma unroll
        for (int j = 0; j < 8; ++j) { v[j] = xr[64 * j]; s += (v[j].x * v[j].x + v[j].y * v[j].y) + (v[j].z * v[j].z + v[j].w * v[j].w); }
        const float rstd = rsqrtf(wave_sum(s) * (1.f / DM) + RMS_EPS);
        const f32x4* wp = (const f32x4*)nw + F.lane;
        f32x4* o = (f32x4*)(O + (size_t)m * DM) + F.lane;
#pragma unroll
        for (int j = 0; j < 8; ++j) o[64 * j] = (v[j] * rstd) * wp[64 * j];
    }
}

template <int CTRL> __device__ __forceinline__ float dpp_f(float x) { return __builtin_bit_cast(float, __builtin_amdgcn_mov_dpp(__builtin_bit_cast(int, x), CTRL, 0xf, 0xf, true)); }
__device__ __forceinline__ float rowsum16(float x) { x += dpp_f<0xB1>(x); x += dpp_f<0x4E>(x); x += dpp_f<0x124>(x); x += dpp_f<0x128>(x); return x; }
__device__ __forceinline__ float quadsum(float x) { x += dpp_f<0xB1>(x); x += dpp_f<0x4E>(x); return x; }
__device__ __forceinline__ void unpack8(const v4u p, float (&e)[8]) { e[0] = bflo(p.x); e[1] = bfhi(p.x); e[2] = bflo(p.y); e[3] = bfhi(p.y); e[4] = bflo(p.z); e[5] = bfhi(p.z); e[6] = bflo(p.w); e[7] = bfhi(p.w); }
__device__ __forceinline__ v4u pack8(const float (&e)[8]) { v4u o; o.x = pk2(e[0], e[1]); o.y = pk2(e[2], e[3]); o.z = pk2(e[4], e[5]); o.w = pk2(e[6], e[7]); return o; }

__device__ __forceinline__ void p3_lora(const Ctx& F) {
    const bf16* PROJ = (const bf16*)(F.ws + WS_PROJ);
    const bf16* WUPT = (const bf16*)(F.ws + WS_WUPT); const bf16* AUPT = (const bf16*)(F.ws + WS_AUPT); const bf16* GUPT = (const bf16*)(F.ws + WS_GUPT);
    bf16* LW = (bf16*)(F.ws + WS_LW); bf16* AA = (bf16*)(F.ws + WS_AA); bf16* GG = (bf16*)(F.ws + WS_GG);
    const float* mu = F.in[I_MU]; const float* w0 = F.in[I_W0]; const float* a0 = F.in[I_A0];
    const int r16 = F.lane & 15, q = F.lane >> 4;
    for (int mt = F.gw; mt < M / 16; mt += F.NGW) {
        const int m = mt * 16 + r16; const bool first = (m % SEQ) == 0;
        const bf16* row = PROJ + (size_t)m * INPP;
        bf16x8 af[9];
#pragma unroll
        for (int s = 0; s < 9; ++s) {
            const int col = ((s < 2) ? (C_WD + 32 * s) : (s < 4) ? (C_AD + 32 * (s - 2)) : (C_GD + 32 * (s - 4))) + 8 * q;
            const v4u pc = *(const v4u*)(row + col);
            v4u pp = {0u, 0u, 0u, 0u}; if (!first) pp = *(const v4u*)(row - INPP + col);
            const f32x4 m0 = *(const f32x4*)(mu + col), m1 = *(const f32x4*)(mu + col + 4);
            float c[8], p[8], e[8]; unpack8(pc, c); unpack8(pp, p);
            const float mm[8] = {m0.x, m0.y, m0.z, m0.w, m1.x, m1.y, m1.z, m1.w};
#pragma unroll
            for (int j = 0; j < 8; ++j) { float v = c[j] + (p[j] - c[j]) * mm[j];
                if (s < 2) { const float t = __expf(2.f * v); v = 1.f - 2.f / (t + 1.f); }
                else if (s >= 4) v = sigmoid_f(v);
                e[j] = v; }
            af[s] = __builtin_bit_cast(bf16x8, pack8(e));
        }
        for (int nt = 0; nt < RW / 16; ++nt) {
            const int n0 = nt * 16;
            f32x4 acc0 = {0.f, 0.f, 0.f, 0.f}, acc1 = acc0, acc2 = acc0;
            const bf16* wu = WUPT + (size_t)(n0 + r16) * L_W + 8 * q;
            const bf16* au = AUPT + (size_t)(n0 + r16) * L_A + 8 * q;
            const bf16* gu = GUPT + (size_t)(n0 + r16) * L_G + 8 * q;
#pragma unroll
            for (int s = 0; s < 2; ++s) acc0 = __builtin_amdgcn_mfma_f32_16x16x32_bf16(*(const bf16x8*)(wu + 32 * s), af[s], acc0, 0, 0, 0);
#pragma unroll
            for (int s = 0; s < 2; ++s) acc1 = __builtin_amdgcn_mfma_f32_16x16x32_bf16(*(const bf16x8*)(au + 32 * s), af[2 + s], acc1, 0, 0, 0);
#pragma unroll
            for (int s = 0; s < 5; ++s) acc2 = __builtin_amdgcn_mfma_f32_16x16x32_bf16(*(const bf16x8*)(gu + 32 * s), af[4 + s], acc2, 0, 0, 0);
            const int n = n0 + 4 * q;
            const f32x4 w0v = *(const f32x4*)(w0 + n), a0v = *(const f32x4*)(a0 + n);
            v2u o0, o1, o2;
            o0.x = pk2(-0.60653066f * sigmoid_f(acc0[0] + w0v.x), -0.60653066f * sigmoid_f(acc0[1] + w0v.y));
            o0.y = pk2(-0.60653066f * sigmoid_f(acc0[2] + w0v.z), -0.60653066f * sigmoid_f(acc0[3] + w0v.w));
            o1.x = pk2(sigmoid_f(acc1[0] + a0v.x), sigmoid_f(acc1[1] + a0v.y)); o1.y = pk2(sigmoid_f(acc1[2] + a0v.z), sigmoid_f(acc1[3] + a0v.w));
            o2.x = pk2(acc2[0], acc2[1]); o2.y = pk2(acc2[2], acc2[3]);
            *(v2u*)(LW + (size_t)m * RW + n) = o0; *(v2u*)(AA + (size_t)m * RW + n) = o1; *(v2u*)(GG + (size_t)m * RW + n) = o2;
        }
    }
}

constexpr int TC = 32, NCHUNK = SEQ / TC;
constexpr int RB_R = 0, RB_W = TC * 64, RB_K = 2 * TC * 64, RB_KK = 3 * TC * 64, RB_KA = 4 * TC * 64, RB_V = 5 * TC * 64, RB_SIZE = 5 * TC * 64 + TC * 32;
constexpr int MB_B = 0, MB_C = TC * 128, MB_X = 2 * TC * 128, MB_DT = MB_X + TC * 32, MB_DA = MB_DT + TC, MB_SIZE = MB_DA + TC;
static_assert(2 * RB_SIZE * 4 <= RING_BYTES && 2 * MB_SIZE * 4 <= RING_BYTES, "scan buffers fit the LDS ring");

struct RwkvRaw { bf16 r[5], k[5], v[5], lw[4], a[4]; };
__device__ __forceinline__ void rwkv_load(RwkvRaw& raw, const bf16* PROJ, const bf16* LW, const bf16* AA, int b, int h, int t0w, int c) {
    const bf16* base = PROJ + (size_t)(b * SEQ + t0w) * INPP + h * 64 + c;
#pragma unroll
    for (int i = 0; i < 5; ++i) {
        if (i == 0 && t0w == 0) { raw.r[0] = 0; raw.k[0] = 0; raw.v[0] = 0; }
        else { const bf16* row = base + (long)(i - 1) * INPP; raw.r[i] = row[C_R]; raw.k[i] = row[C_K]; raw.v[i] = row[C_V]; }
    }
#pragma unroll
    for (int i = 0; i < 4; ++i) { const size_t o = (size_t)(b * SEQ + t0w + i) * RW + h * 64 + c; raw.lw[i] = LW[o]; raw.a[i] = AA[o]; }
}
__device__ __forceinline__ void rwkv_stage(const RwkvRaw& raw, LAS float* buf, int tl0, int c, int hf, float mu_r, float mu_k, float mu_v, float kkw, float kaw) {
#pragma unroll
    for (int i = 0; i < 4; ++i) {
        const int t = tl0 + i;
        const float rc = bf1(raw.r[i + 1]), rp = bf1(raw.r[i]), kc = bf1(raw.k[i + 1]), kp = bf1(raw.k[i]), vc = bf1(raw.v[i + 1]), vp = bf1(raw.v[i]);
        const float rr = rc + (rp - rc) * mu_r, kx = kc + (kp - kc) * mu_k, vv = vc + (vp - vc) * mu_v;
        const float a = bf1(raw.a[i]), dec = __expf(bf1(raw.lw[i]));
        const float kkraw = kx * kkw; const float ss = wave_sum(kkraw * kkraw);
        const float kkn = kkraw / fmaxf(sqrtf(ss), 1e-12f);
        buf[RB_R + t * 64 + c] = rr; buf[RB_W + t * 64 + c] = dec; buf[RB_K + t * 64 + c] = kx * (1.f + (a - 1.f) * kaw);
        buf[RB_KK + t * 64 + c] = kkn; buf[RB_KA + t * 64 + c] = kkn * a;
        if ((c >> 5) == hf) buf[RB_V + t * 32 + (c & 31)] = vv;
    }
}
__device__ __forceinline__ void rwkv_task(const Ctx& F, int task) {
    const int b = task >> 5, h = (task >> 1) & 15, hf = task & 1;
    const bf16* PROJ = (const bf16*)(F.ws + WS_PROJ); const bf16* LW = (const bf16*)(F.ws + WS_LW); const bf16* AA = (const bf16*)(F.ws + WS_AA);
    bf16* OY = (bf16*)(F.ws + WS_OY);
    LAS float* lbuf = (LAS float*)F.lds;
    const int c = F.lane, w = F.wave, r = F.lane >> 4, cg = F.lane & 15;
    const int ch = h * 64 + c;
    const float mu_r = F.in[I_MU][C_R + ch], mu_k = F.in[I_MU][C_K + ch], mu_v = F.in[I_MU][C_V + ch], kkw = F.in[I_KK][ch], kaw = F.in[I_KA][ch];
    RwkvRaw raw;
    rwkv_load(raw, PROJ, LW, AA, b, h, 4 * w, c);
    rwkv_stage(raw, lbuf, 4 * w, c, hf, mu_r, mu_k, mu_v, kkw, kaw);
    __syncthreads();
    float S[4] = {0.f, 0.f, 0.f, 0.f};
    bf16* orow = OY + (size_t)(b * SEQ) * DM + h * 64 + 32 * hf + 4 * w + r;
    for (int ck = 0; ck < NCHUNK; ++ck) {
        const LAS float* buf = lbuf + (ck & 1) * RB_SIZE;
        const bool more = (ck + 1 < NCHUNK);
        if (more) rwkv_load(raw, PROJ, LW, AA, b, h, (ck + 1) * TC + 4 * w, c);
#pragma unroll 4
        for (int tt = 0; tt < TC; ++tt) {
            const f32x4 kk4 = *(const LAS f32x4*)(buf + RB_KK + tt * 64 + 4 * cg), w4 = *(const LAS f32x4*)(buf + RB_W + tt * 64 + 4 * cg);
            const f32x4 ka4 = *(const LAS f32x4*)(buf + RB_KA + tt * 64 + 4 * cg), k4 = *(const LAS f32x4*)(buf + RB_K + tt * 64 + 4 * cg);
            const f32x4 r4 = *(const LAS f32x4*)(buf + RB_R + tt * 64 + 4 * cg);
            const float vr = buf[RB_V + tt * 32 + 4 * w + r];
            float sa = (S[0] * kk4.x + S[1] * kk4.y) + (S[2] * kk4.z + S[3] * kk4.w);
            sa = rowsum16(sa);
            S[0] = S[0] * w4.x + (vr * k4.x - sa * ka4.x); S[1] = S[1] * w4.y + (vr * k4.y - sa * ka4.y);
            S[2] = S[2] * w4.z + (vr * k4.z - sa * ka4.z); S[3] = S[3] * w4.w + (vr * k4.w - sa * ka4.w);
            float o = (S[0] * r4.x + S[1] * r4.y) + (S[2] * r4.z + S[3] * r4.w);
            o = rowsum16(o);
            if (cg == 0) orow[(size_t)(ck * TC + tt) * DM] = (bf16)(pk2(o, 0.f) & 0xffffu);
        }
        if (more) rwkv_stage(raw, lbuf + ((ck + 1) & 1) * RB_SIZE, 4 * w, c, hf, mu_r, mu_k, mu_v, kkw, kaw);
        __syncthreads();
    }
}

struct MambaRaw { bf16 x[3][11]; bf16 dt; };
__device__ __forceinline__ int mamba_col(int cb, int head, int hf, int lane) {
    const int g = head >> 3;
    return (cb == 0) ? (head * 64 + 32 * hf + (lane & 31)) : (cb < 3) ? (1024 + g * 128 + (cb - 1) * 64 + lane) : (1280 + g * 128 + (cb - 3) * 64 + lane);
}
__device__ __forceinline__ void mamba_load(MambaRaw& raw, const bf16* PROJ, int b, int head, int hf, int t0, int w, int lane) {
#pragma unroll
    for (int k = 0; k < 3; ++k) { const int id = w + 8 * k;
        if (id < 20) { const int cb = id >> 2, ts = id & 3; const int chn = mamba_col(cb, head, hf, lane);
            const bf16* base = PROJ + (size_t)(b * SEQ) * INPP + C_XBC + chn;
#pragma unroll
            for (int j = 0; j < 11; ++j) { const int t = t0 + 8 * ts - 3 + j; raw.x[k][j] = (t >= 0) ? base[(size_t)t * INPP] : (bf16)0; } } }
    if (w == 7) raw.dt = PROJ[(size_t)(b * SEQ + t0 + (lane & 31)) * INPP + C_DT + head];
}
__device__ __forceinline__ void mamba_stage(const MambaRaw& raw, LAS float* buf, const float* convw, const float* convb, int head, int hf, int w, int lane, float dtb, float Aneg) {
#pragma unroll
    for (int k = 0; k < 3; ++k) { const int id = w + 8 * k;
        if (id < 20) { const int cb = id >> 2, ts = id & 3; const int chn = mamba_col(cb, head, hf, lane);
            const float w0 = convw[chn], w1 = convw[1536 + chn], w2 = convw[2 * 1536 + chn], w3 = convw[3 * 1536 + chn], bb = convb[chn];
#pragma unroll
            for (int i = 0; i < 8; ++i) { const float v = bb + w0 * bf1(raw.x[k][i]) + w1 * bf1(raw.x[k][i + 1]) + w2 * bf1(raw.x[k][i + 2]) + w3 * bf1(raw.x[k][i + 3]);
                const float sv = silu_f(v); const int t = 8 * ts + i;
                if (cb == 0) { if (lane < 32) buf[MB_X + t * 32 + lane] = sv; }
                else if (cb < 3) buf[MB_B + t * 128 + (cb - 1) * 64 + lane] = sv;
                else buf[MB_C + t * 128 + (cb - 3) * 64 + lane] = sv; } } }
    if (w == 7 && lane < 32) { const float xr = bf1(raw.dt) + dtb; const float dt = (xr > 20.f) ? xr : log1pf(__expf(xr));
        buf[MB_DT + lane] = dt; buf[MB_DA + lane] = __expf(dt * Aneg); }
}
__device__ __forceinline__ void mamba_task(const Ctx& F, int task) {
    const int b = task >> 5, head = (task >> 1) & 15, hf = task & 1;
    const bf16* PROJ = (const bf16*)(F.ws + WS_PROJ); bf16* OY = (bf16*)(F.ws + WS_OY);
    LAS float* lbuf = (LAS float*)F.lds;
    const int w = F.wave, r = F.lane >> 4, ng = F.lane & 15;
    const float dtb = F.in[I_DTB][head], Aneg = -__expf(F.in[I_ALOG][head]), Dsk = F.in[I_DSK][head];
    const float* convw = F.in[I_CONVW]; const float* convb = F.in[I_CONVB];
    MambaRaw raw;
    mamba_load(raw, PROJ, b, head, hf, 0, w, F.lane);
    mamba_stage(raw, lbuf, convw, convb, head, hf, w, F.lane, dtb, Aneg);
    __syncthreads();
    float hs[8] = {0.f, 0.f, 0.f, 0.f, 0.f, 0.f, 0.f, 0.f};
    bf16* orow = OY + (size_t)(b * SEQ) * DM + RW + head * 64 + 32 * hf + 4 * w + r;
    for (int ck = 0; ck < NCHUNK; ++ck) {
        const LAS float* buf = lbuf + (ck & 1) * MB_SIZE;
        const bool more = (ck + 1 < NCHUNK);
        if (more) mamba_load(raw, PROJ, b, head, hf, (ck + 1) * TC, w, F.lane);
#pragma unroll 4
        for (int tt = 0; tt < TC; ++tt) {
            const f32x4 b0 = *(const LAS f32x4*)(buf + MB_B + tt * 128 + 8 * ng), b1 = *(const LAS f32x4*)(buf + MB_B + tt * 128 + 8 * ng + 4);
            const f32x4 c0 = *(const LAS f32x4*)(buf + MB_C + tt * 128 + 8 * ng), c1 = *(const LAS f32x4*)(buf + MB_C + tt * 128 + 8 * ng + 4);
            const float x = buf[MB_X + tt * 32 + 4 * w + r], dt = buf[MB_DT + tt], dA = buf[MB_DA + tt];
            const float xdt = x * dt;
            hs[0] = hs[0] * dA + xdt * b0.x; hs[1] = hs[1] * dA + xdt * b0.y; hs[2] = hs[2] * dA + xdt * b0.z; hs[3] = hs[3] * dA + xdt * b0.w;
            hs[4] = hs[4] * dA + xdt * b1.x; hs[5] = hs[5] * dA + xdt * b1.y; hs[6] = hs[6] * dA + xdt * b1.z; hs[7] = hs[7] * dA + xdt * b1.w;
            float y = ((hs[0] * c0.x + hs[1] * c0.y) + (hs[2] * c0.z + hs[3] * c0.w)) + ((hs[4] * c1.x + hs[5] * c1.y) + (hs[6] * c1.z + hs[7] * c1.w));
            y = rowsum16(y) + Dsk * x;
            if (ng == 0) orow[(size_t)(ck * TC + tt) * DM] = (bf16)(pk2(y, 0.f) & 0xffffu);
        }
        if (more) mamba_stage(raw, lbuf + ((ck + 1) & 1) * MB_SIZE, convw, convb, head, hf, w, F.lane, dtb, Aneg);
        __syncthreads();
    }
}
__device__ __forceinline__ void p4_scans(const Ctx& F) {
    for (int task = blockIdx.x; task < 256; task += F.G) {
        if (task < 128) rwkv_task(F, task); else mamba_task(F, task - 128);
        __syncthreads();
    }
}

__device__ __forceinline__ void p5_post(const Ctx& F) {
    const bf16* PROJ = (const bf16*)(F.ws + WS_PROJ); const bf16* AA = (const bf16*)(F.ws + WS_AA); const bf16* GG = (const bf16*)(F.ws + WS_GG);
    bf16* OY = (bf16*)(F.ws + WS_OY);
    const float* mu = F.in[I_MU];
    const int c0 = 16 * F.lane;
    for (int m = F.gw; m < M; m += F.NGW) {
        const bool first = (m % SEQ) == 0;
        const bf16* prow = PROJ + (size_t)m * INPP;
        bf16* oyrow = OY + (size_t)m * DM;
        float res_r[16], res_m[16];
        {
            float o[16];
            { float t0[8], t1[8]; unpack8(*(const v4u*)(oyrow + c0), t0); unpack8(*(const v4u*)(oyrow + c0 + 8), t1);
#pragma unroll
              for (int j = 0; j < 8; ++j) { o[j] = t0[j]; o[8 + j] = t1[j]; } }
            float s = 0.f;
#pragma unroll
            for (int j = 0; j < 16; ++j) s += o[j];
            const float mean = quadsum(s) * (1.f / 64.f);
            float q = 0.f;
#pragma unroll
            for (int j = 0; j < 16; ++j) { o[j] -= mean; q += o[j] * o[j]; }
            const float rstd = rsqrtf(quadsum(q) * (1.f / 64.f) + 64e-5f);
            float bs = 0.f; float vv[16];
#pragma unroll
            for (int hh = 0; hh < 2; ++hh) {
                const int cc = c0 + 8 * hh;
                float rc[8], rp[8], kc[8], kp[8], vc[8], vp[8], av[8];
                unpack8(*(const v4u*)(prow + C_R + cc), rc); unpack8(*(const v4u*)(prow + C_K + cc), kc); unpack8(*(const v4u*)(prow + C_V + cc), vc);
                if (!first) { unpack8(*(const v4u*)(prow - INPP + C_R + cc), rp); unpack8(*(const v4u*)(prow - INPP + C_K + cc), kp); unpack8(*(const v4u*)(prow - INPP + C_V + cc), vp); }
                else {
#pragma unroll
                    for (int j = 0; j < 8; ++j) { rp[j] = 0.f; kp[j] = 0.f; vp[j] = 0.f; } }
                unpack8(*(const v4u*)(AA + (size_t)m * RW + cc), av);
#pragma unroll
                for (int j = 0; j < 8; ++j) { const int ch = cc + j;
                    const float rr = rc[j] + (rp[j] - rc[j]) * mu[C_R + ch], kx = kc[j] + (kp[j] - kc[j]) * mu[C_K + ch];
                    vv[8 * hh + j] = vc[j] + (vp[j] - vc[j]) * mu[C_V + ch];
                    const float k2 = kx * (1.f + (av[j] - 1.f) * F.in[I_KA][ch]);
                    bs += rr * k2 * F.in[I_RK][ch]; }
            }
            bs = quadsum(bs);
            float gv[16]; { float t0[8], t1[8]; unpack8(*(const v4u*)(GG + (size_t)m * RW + c0), t0); unpack8(*(const v4u*)(GG + (size_t)m * RW + c0 + 8), t1);
#pragma unroll
              for (int j = 0; j < 8; ++j) { gv[j] = t0[j]; gv[8 + j] = t1[j]; } }
#pragma unroll
            for (int j = 0; j < 16; ++j) { const int ch = c0 + j; res_r[j] = (o[j] * rstd * F.in[I_LNW][ch] + F.in[I_LNB][ch] + bs * vv[j]) * gv[j]; }
        }
        {
            float y[16], z[16];
            { float t0[8], t1[8]; unpack8(*(const v4u*)(oyrow + RW + c0), t0); unpack8(*(const v4u*)(oyrow + RW + c0 + 8), t1);
#pragma unroll
              for (int j = 0; j < 8; ++j) { y[j] = t0[j]; y[8 + j] = t1[j]; } }
            { float t0[8], t1[8]; unpack8(*(const v4u*)(prow + C_Z + c0), t0); unpack8(*(const v4u*)(prow + C_Z + c0 + 8), t1);
#pragma unroll
              for (int j = 0; j < 8; ++j) { z[j] = t0[j]; z[8 + j] = t1[j]; } }
            float q = 0.f;
#pragma unroll
            for (int j = 0; j < 16; ++j) { y[j] *= silu_f(z[j]); q += y[j] * y[j]; }
#pragma unroll
            for (int o = 1; o < 32; o <<= 1) q += __shfl_xor(q, o);
            const float rstd = rsqrtf(q * (1.f / 512.f) + 1e-5f);
#pragma unroll
            for (int j = 0; j < 16; ++j) res_m[j] = y[j] * rstd * F.in[I_MNW][c0 + j];
        }
        { float t0[8], t1[8];
#pragma unroll
          for (int j = 0; j < 8; ++j) { t0[j] = res_r[j]; t1[j] = res_r[8 + j]; }
          *(v4u*)(oyrow + c0) = pack8(t0); *(v4u*)(oyrow + c0 + 8) = pack8(t1);
#pragma unroll
          for (int j = 0; j < 8; ++j) { t0[j] = res_m[j]; t1[j] = res_m[8 + j]; }
          *(v4u*)(oyrow + RW + c0) = pack8(t0); *(v4u*)(oyrow + RW + c0 + 8) = pack8(t1); }
    }
}
__device__ __forceinline__ float rowmax16(float x) { x = fmaxf(x, dpp_f<0xB1>(x)); x = fmaxf(x, dpp_f<0x4E>(x)); x = fmaxf(x, dpp_f<0x124>(x)); x = fmaxf(x, dpp_f<0x128>(x)); return x; }
__device__ __forceinline__ int cand_code(int s) {
    if (s < 16) return s << 4;
    if (s < 24) return 1 | ((s - 16) << 4);
    if (s < 29) return 2 | ((s - 24) << 4);
    if (s < 33) return 3 | ((s - 29) << 4);
    if (s < 36) return 4 | ((s - 33) << 4);
    if (s < 42) { const int k = s - 36; return (5 + (k >> 1)) | ((k & 1) << 4); }
    if (s < 50) return 8 + (s - 42);
    return -1;
}
template <int NV>
__device__ __forceinline__ void select16x4(float (&v)[4][NV], int r16, float (&kept)[4]) {
    const float NINF = -__builtin_inff();
#pragma unroll
    for (int j = 0; j < 4; ++j) kept[j] = NINF;
#pragma unroll 1
    for (int rd = 0; rd < 16; ++rd) {
#pragma unroll
        for (int j = 0; j < 4; ++j) {
            float m = v[j][0];
#pragma unroll
            for (int i = 1; i < NV; ++i) m = fmaxf(m, v[j][i]);
            m = rowmax16(m);
            kept[j] = (r16 == rd) ? m : kept[j];
#pragma unroll
            for (int i = 0; i < NV; ++i) v[j][i] = (v[j][i] == m) ? NINF : v[j][i];
        }
    }
}
__device__ __forceinline__ float dot2bf(unsigned a, unsigned b, float acc) { return __builtin_amdgcn_fdot2_f32_bf16(__builtin_bit_cast(bf16x2_t, a), __builtin_bit_cast(bf16x2_t, b), acc, false); }

constexpr int PT = 16;
constexpr int RT_E = 0, RT_G = PT * 128 * 4, RT_CO = 2 * PT * 128 * 4;

__device__ __forceinline__ void p9_peer(const Ctx& F) {
    const bf16* Q = (const bf16*)(F.ws + WS_Q); const bf16* KEYS = (const bf16*)(F.ws + WS_KEYS);
    const bf16* PU = (const bf16*)(F.ws + WS_PU); const bf16* PV = (const bf16*)(F.ws + WS_PV); const bf16* XN = (const bf16*)(F.ws + WS_XN);
    const float* mod = (const float*)(F.ws + WS_MOD); const float* fw = F.in[I_FNW];
    LAS int* rtE = (LAS int*)(F.lds + RT_E); LAS float* rtG = (LAS float*)(F.lds + RT_G); LAS float* rtC = (LAS float*)(F.lds + RT_CO);
    const int lane = F.lane, w = F.wave, r16 = lane & 15, q = lane >> 4, gbase = lane & 48;
    int ci[4], cj[4]; bool cvalid[4];
#pragma unroll
    for (int u = 0; u < 4; ++u) { const int cd = cand_code(r16 + 16 * u); cvalid[u] = cd >= 0; ci[u] = cd & 15; cj[u] = (cd >> 4) & 15; }
    const float NINF = -__builtin_inff();

    for (int tile = blockIdx.x; tile < M / PT; tile += F.G) {
        const int m0 = tile * PT;
        float top[2][4];
#pragma unroll
        for (int p = 0; p < 2; ++p) {
            const int hp = 2 * w + p;
            const bf16* qrow = Q + (size_t)(m0 + r16) * DM + hp * 128 + 8 * q;
            bf16x8 af[4];
#pragma unroll
            for (int s = 0; s < 4; ++s) af[s] = *(const bf16x8*)(qrow + 32 * s);
            float v[4][8];
#pragma unroll
            for (int nt = 0; nt < 8; ++nt) {
                const bf16* krow = KEYS + (size_t)(hp * 128 + nt * 16 + r16) * 128 + 8 * q;
                f32x4 acc = {0.f, 0.f, 0.f, 0.f};
#pragma unroll
                for (int s = 0; s < 4; ++s) acc = __builtin_amdgcn_mfma_f32_16x16x32_bf16(af[s], *(const bf16x8*)(krow + 32 * s), acc, 0, 0, 0);
                const unsigned tag = 127u - (unsigned)(nt * 16 + r16);
#pragma unroll
                for (int j = 0; j < 4; ++j) v[j][nt] = __uint_as_float((__float_as_uint(acc[j]) & ~127u) | tag);
            }
            select16x4<8>(v, r16, top[p]);
        }
        float cv[4][4];
#pragma unroll
        for (int u = 0; u < 4; ++u)
#pragma unroll
            for (int j = 0; j < 4; ++j) {
                const float a = __shfl(top[0][j], gbase + ci[u]), b = __shfl(top[1][j], gbase + cj[u]);
                const float cs = __uint_as_float(__float_as_uint(a) & ~127u) + __uint_as_float(__float_as_uint(b) & ~127u);
                const float pk = __uint_as_float((__float_as_uint(cs) & ~63u) | (63u - (unsigned)(r16 + 16 * u)));
                cv[j][u] = cvalid[u] ? pk : NINF;
            }
        float best[4];
        select16x4<4>(cv, r16, best);
#pragma unroll
        for (int j = 0; j < 4; ++j) {
            const unsigned bb = __float_as_uint(best[j]);
            const int cd = cand_code(63 - (int)(bb & 63u));
            const int k0 = 127 - (int)(__float_as_uint(__shfl(top[0][j], gbase + (cd & 15))) & 127u);
            const int k1 = 127 - (int)(__float_as_uint(__shfl(top[1][j], gbase + ((cd >> 4) & 15))) & 127u);
            const float s = __uint_as_float(bb & ~63u);
            const float mx = rowmax16(s), e = __expf(s - mx), sum = rowsum16(e);
            const int tl = 4 * q + j;
            rtE[tl * 128 + w * 16 + r16] = k0 * 128 + k1; rtG[tl * 128 + w * 16 + r16] = e / sum;
        }
        __syncthreads();
#pragma unroll 1
        for (int tk = 0; tk < 2; ++tk) {
            const int tl = 2 * w + tk, m = m0 + tl, b = m / SEQ;
            v4u xv[4];
#pragma unroll
            for (int i = 0; i < 4; ++i) xv[i] = *(const v4u*)(XN + (size_t)m * DM + 512 * i + 8 * lane);
#pragma unroll 1
            for (int e0 = 0; e0 < 128; e0 += 4) {
                v4u uu[4][4];
#pragma unroll
                for (int k = 0; k < 4; ++k) { const int id = __builtin_amdgcn_readfirstlane(rtE[tl * 128 + e0 + k]); const bf16* ur = PU + (size_t)id * DM + 8 * lane;
#pragma unroll
                    for (int i = 0; i < 4; ++i) uu[k][i] = *(const v4u*)(ur + 512 * i); }
#pragma unroll
                for (int k = 0; k < 4; ++k) { float d0 = 0.f, d1 = 0.f;
#pragma unroll
                    for (int i = 0; i < 4; ++i) { d0 = dot2bf(uu[k][i].x, xv[i].x, d0); d1 = dot2bf(uu[k][i].y, xv[i].y, d1); d0 = dot2bf(uu[k][i].z, xv[i].z, d0); d1 = dot2bf(uu[k][i].w, xv[i].w, d1); }
                    float d = rowsum16(d0 + d1); d += __shfl_xor(d, 16); d += __shfl_xor(d, 32);
                    if (lane == 0) rtC[tl * 128 + e0 + k] = d; }
            }
#pragma unroll
            for (int k = 0; k < 2; ++k) { const int e = lane + 64 * k; const float d = rtC[tl * 128 + e];
                rtC[tl * 128 + e] = rtG[tl * 128 + e] * (0.5f * d * (1.f + erff(d * 0.70710678f))); }
            float acc[32];
#pragma unroll
            for (int i = 0; i < 32; ++i) acc[i] = 0.f;
#pragma unroll 1
            for (int e0 = 0; e0 < 128; e0 += 4) {
                v4u vv[4][4]; float cf[4];
#pragma unroll
                for (int k = 0; k < 4; ++k) { const int id = __builtin_amdgcn_readfirstlane(rtE[tl * 128 + e0 + k]); const bf16* vr = PV + (size_t)id * DM + 8 * lane;
                    cf[k] = rtC[tl * 128 + e0 + k];
#pragma unroll
                    for (int i = 0; i < 4; ++i) vv[k][i] = *(const v4u*)(vr + 512 * i); }
#pragma unroll
                for (int k = 0; k < 4; ++k)
#pragma unroll
                    for (int i = 0; i < 4; ++i) {
                        acc[8 * i + 0] += cf[k] * bflo(vv[k][i].x); acc[8 * i + 1] += cf[k] * bfhi(vv[k][i].x); acc[8 * i + 2] += cf[k] * bflo(vv[k][i].y); acc[8 * i + 3] += cf[k] * bfhi(vv[k][i].y);
                        acc[8 * i + 4] += cf[k] * bflo(vv[k][i].z); acc[8 * i + 5] += cf[k] * bfhi(vv[k][i].z); acc[8 * i + 6] += cf[k] * bflo(vv[k][i].w); acc[8 * i + 7] += cf[k] * bfhi(vv[k][i].w); }
            }
            float* orow = F.out + (size_t)m * DM; const float* g2 = mod + (size_t)b * MODW + 5 * DM;
            float ss = 0.f;
#pragma unroll
            for (int i = 0; i < 4; ++i)
#pragma unroll
                for (int hh = 0; hh < 2; ++hh) { const int col = 512 * i + 8 * lane + 4 * hh;
                    const f32x4 h1 = *(const f32x4*)(orow + col), g = *(const f32x4*)(g2 + col);
                    acc[8 * i + 4 * hh + 0] = h1.x + g.x * acc[8 * i + 4 * hh + 0]; acc[8 * i + 4 * hh + 1] = h1.y + g.y * acc[8 * i + 4 * hh + 1];
                    acc[8 * i + 4 * hh + 2] = h1.z + g.z * acc[8 * i + 4 * hh + 2]; acc[8 * i + 4 * hh + 3] = h1.w + g.w * acc[8 * i + 4 * hh + 3];
                    ss += (acc[8 * i + 4 * hh + 0] * acc[8 * i + 4 * hh + 0] + acc[8 * i + 4 * hh + 1] * acc[8 * i + 4 * hh + 1]) + (acc[8 * i + 4 * hh + 2] * acc[8 * i + 4 * hh + 2] + acc[8 * i + 4 * hh + 3] * acc[8 * i + 4 * hh + 3]); }
            const float rstd = rsqrtf(wave_sum(ss) * (1.f / DM) + RMS_EPS);
#pragma unroll
            for (int i = 0; i < 4; ++i)
#pragma unroll
                for (int hh = 0; hh < 2; ++hh) { const int col = 512 * i + 8 * lane + 4 * hh; const f32x4 wv = *(const f32x4*)(fw + col);
                    f32x4 o; o.x = acc[8 * i + 4 * hh + 0] * rstd * wv.x; o.y = acc[8 * i + 4 * hh + 1] * rstd * wv.y; o.z = acc[8 * i + 4 * hh + 2] * rstd * wv.z; o.w = acc[8 * i + 4 * hh + 3] * rstd * wv.w;
                    *(f32x4*)(orow + col) = o; }
        }
        __syncthreads();
    }
}
struct Args { const float* in[N_IN]; float* out; unsigned char* ws; int ph_lo, ph_hi; };
constexpr int N_PHASES = 10;

__global__ void __launch_bounds__(NTHR, 2) fwd_kernel(Args args) {
    extern __shared__ __attribute__((aligned(16))) unsigned char lds_raw[];
    cg::grid_group grid = cg::this_grid();
    Ctx F;
    F.lds = (LAS unsigned char*)lds_raw;
    F.tid = threadIdx.x; F.lane = F.tid & 63; F.wave = __builtin_amdgcn_readfirstlane(F.tid >> 6);
    F.G = gridDim.x; F.gw = blockIdx.x * NWAVES + F.wave; F.NGW = F.G * NWAVES;
    F.in = args.in; F.out = args.out; F.ws = args.ws;
    const int lo = args.ph_lo, hi = args.ph_hi;
#define IN(k) (lo <= (k) && (k) < hi)
#define SEAM(k) do { if (IN(k) && IN((k) + 1)) grid.sync(); } while (0)

    if (IN(0)) { p0_prologue(F); }
    SEAM(0);
    if (IN(1)) { norm_mod_rows(F, F.in[I_X], F.in[I_N1W], 0, DM, (bf16*)(F.ws + WS_XN)); }
    SEAM(1);
    if (IN(2)) {
        pg8::Gemm g{(const pg8::bf16_t*)(F.ws + WS_XN), (const pg8::bf16_t*)(F.ws + WS_WIN), M, INPP, DM};
        pg8::StaticOrder S; S.init(M, INPP, F.G, (int)blockIdx.x);
        pg8::EpiStoreBf16 E{(pg8::bf16_t*)(F.ws + WS_PROJ), INPP};
        pg8::gemm_phase<pg8::EpiStoreBf16, pg8::StaticOrder, true, true>(F.lds, g, S, E);
    }
    SEAM(2);
    if (IN(3)) { p3_lora(F); }
    SEAM(3);
    if (IN(4)) { p4_scans(F); }
    SEAM(4);
    if (IN(5)) { p5_post(F); }
    SEAM(5);
    if (IN(6)) {
        pg8::Gemm g{(const pg8::bf16_t*)(F.ws + WS_OY), (const pg8::bf16_t*)(F.ws + WS_WOUT), M, DM, DM};
        pg8::StaticOrder S; S.init(M, DM, F.G, (int)blockIdx.x);
        pg8::EpiResid E{F.in[I_X], (const float*)(F.ws + WS_MOD) + 2 * DM, F.out, DM, SEQ, MODW};
        pg8::gemm_phase<pg8::EpiResid, pg8::StaticOrder, true, true>(F.lds, g, S, E);
    }
    SEAM(6);
    if (IN(7)) { norm_mod_rows(F, F.out, F.in[I_N2W], 3 * DM, 4 * DM, (bf16*)(F.ws + WS_XN)); }
    SEAM(7);
    if (IN(8)) {
        pg8::Gemm g{(const pg8::bf16_t*)(F.ws + WS_XN), (const pg8::bf16_t*)(F.ws + WS_WQ), M, DM, DM};
        pg8::StaticOrder S; S.init(M, DM, F.G, (int)blockIdx.x);
        pg8::EpiStoreBf16 E{(pg8::bf16_t*)(F.ws + WS_Q), DM};
        pg8::gemm_phase<pg8::EpiStoreBf16, pg8::StaticOrder, true, true>(F.lds, g, S, E);
    }
    SEAM(8);
    if (IN(9)) { p9_peer(F); }
#undef IN
#undef SEAM
}

extern "C" void kernel_launch(void* const* d_in, const int* in_sizes, int n_in, void* d_out, int out_size, void* d_ws, size_t ws_size, hipStream_t stream) {
    static int grid = 0;
    if (grid == 0) {
        if (n_in != N_IN || in_sizes[0] != M * DM || out_size != M * DM || ws_size < WS_END) {
            fprintf(stderr, "kernel_launch: unexpected shapes: n_in %d in0 %d out %d ws %zu (need %zu)\n", n_in, n_in > 0 ? in_sizes[0] : -1, out_size, ws_size, (size_t)WS_END); grid = -1; return; }
        int dev = 0, cus = 0, per_cu = 0;
        if (hipGetDevice(&dev) != hipSuccess || hipDeviceGetAttribute(&cus, hipDeviceAttributeMultiprocessorCount, dev) != hipSuccess) { grid = -1; return; }
        if (hipFuncSetAttribute((const void*)fwd_kernel, hipFuncAttributeMaxDynamicSharedMemorySize, LDS_BYTES) != hipSuccess) { fprintf(stderr, "kernel_launch: hipFuncSetAttribute failed\n"); grid = -1; return; }
        if (hipOccupancyMaxActiveBlocksPerMultiprocessor(&per_cu, (const void*)fwd_kernel, NTHR, LDS_BYTES) != hipSuccess || per_cu < 1) { fprintf(stderr, "kernel_launch: occupancy query says %d blocks per CU\n", per_cu); per_cu = 1; }
        (void)hipGetLastError();
        grid = cus;
        fprintf(stderr, "kernel_launch: cus %d per_cu %d grid %d ws %zu\n", cus, per_cu, grid, ws_size);
    }
    if (grid < 0) return;
    (void)hipMemsetAsync((char*)d_ws + WS_CTL, 0, CTL_ZERO_BYTES, stream);
    Args a{};
    for (int i = 0; i < N_IN; ++i) a.in[i] = (const float*)d_in[i];
    a.out = (float*)d_out; a.ws = (unsigned char*)d_ws; a.ph_lo = 0; a.ph_hi = N_PHASES;
    void* kargs[] = {&a};
    hipError_t e = hipLaunchCooperativeKernel((const void*)fwd_kernel, dim3(grid), dim3(NTHR), kargs, LDS_BYTES, stream);
    if (e != hipSuccess) fprintf(stderr, "kernel_launch: cooperative launch failed: %s (grid %d)\n", hipGetErrorString(e), grid);
}
```

```cpp
#include <hip/hip_runtime.h>
#include <hip/hip_cooperative_groups.h>
#include <cstdio>
#include <cstdint>
namespace cg = cooperative_groups;
namespace pg8 {
#define PG8_LAS __attribute__((address_space(3)))
typedef unsigned short bf16_t;
typedef short bf16x8 __attribute__((ext_vector_type(8)));
typedef float f32x4 __attribute__((ext_vector_type(4)));
typedef unsigned u32x4 __attribute__((ext_vector_type(4)));
constexpr int BM = 256, BK = 64, HALF = 128, HTB = HALF * BK * 2  , STAGE_BYTES = 8 * HTB, NXCD = 8, WGM = 8;

__host__ __device__ __forceinline__ int lds_byte(int r, int c) { const int st = (r >> 4) * 2 + (c >> 5), rr = r & 15, cc = c & 31, ob = rr * 64 + cc * 2; return st * 1024 + (ob ^ (((ob >> 9) & 1) << 5)); }
__host__ __device__ __forceinline__ void stage_rc(int b, int& R, int& C) { const int st = b / 1024, sb = b % 1024, swz = sb ^ (((sb >> 9) & 1) << 5); R = (st >> 1) * 16 + swz / 64; C = (st & 1) * 32 + (swz % 64) / 2; }
__host__ __device__ __forceinline__ int perm32(int rho) { const int n = rho >> 4, i = rho & 15; return 8 * (i >> 2) + 4 * n + (i & 3); }

struct Unit { int pm, pn; };
struct Gemm { const bf16_t* A; const bf16_t* Bt; int M, N, K; };

struct StaticOrder {
    int nM, nN, nwg, G, c;
    __host__ __device__ void init(int M, int N, int G_, int c_) { nM = M / BM; nN = N / BM; nwg = nM * nN; G = G_; c = c_; }
    __host__ __device__ bool next(int i, Unit& u) const {
        const long L = (long)i * G + c; if (L >= nwg) return false;
        int wgid = (int)L; { const int q = nwg / NXCD, r = nwg % NXCD, xcd = wgid % NXCD, off = wgid / NXCD; wgid = (xcd < r ? xcd * (q + 1) : r * (q + 1) + (xcd - r) * q) + off; }
        const int nig = WGM * nN, gid = wgid / nig, fm = gid * WGM, gsz = (nM - fm) < WGM ? (nM - fm) : WGM;
        u.pm = fm + ((wgid % nig) % gsz); u.pn = (wgid % nig) / gsz; return true;
    }
    __device__ __forceinline__ void a_ready(const Unit&) const {}
    __device__ __forceinline__ void done(const Unit&) const {}
};
__device__ __forceinline__ unsigned cvt_pk_bf16(float lo, float hi) { unsigned r; asm volatile("v_cvt_pk_bf16_f32 %0, %1, %2" : "=v"(r) : "v"(lo), "v"(hi)); return r; }
struct EpiStoreBf16 {
    static constexpr bool PERM = true, AFTER_DRAIN = false;
    bf16_t* O; int ldc;
    __device__ __forceinline__ void operator()(const f32x4 (&acc)[2][2][4][2], const Unit& u, int wr, int wc, int fr, int fq) const {
        const int row0 = u.pm * BM + wr * 64 + fr; const int col0 = u.pn * BM + wc * 32 + 8 * fq;
#pragma unroll
        for (int ai = 0; ai < 2; ++ai)
#pragma unroll
            for (int m = 0; m < 4; ++m) { bf16_t* rowp = O + (size_t)(row0 + ai * HALF + m * 16) * ldc + col0;
#pragma unroll
                for (int bj = 0; bj < 2; ++bj) { const f32x4 v0 = acc[ai][bj][m][0], v1 = acc[ai][bj][m][1];
                    u32x4 w; w.x = cvt_pk_bf16(v0[0], v0[1]); w.y = cvt_pk_bf16(v0[2], v0[3]); w.z = cvt_pk_bf16(v1[0], v1[1]); w.w = cvt_pk_bf16(v1[2], v1[3]);
                    *(u32x4*)(rowp + bj * HALF) = w; } }
    }
};
struct EpiResid {
    static constexpr bool PERM = true, AFTER_DRAIN = false;
    const float* X; const float* gate; float* O; int ldc; int rows_per_batch; int gstride;
    __device__ __forceinline__ void operator()(const f32x4 (&acc)[2][2][4][2], const Unit& u, int wr, int wc, int fr, int fq) const {
        const int row0 = u.pm * BM + wr * 64 + fr; const int col0 = u.pn * BM + wc * 32 + 8 * fq;
        const float* g = gate + (size_t)((u.pm * BM) / rows_per_batch) * gstride + col0;
        f32x4 gv[2][2];
#pragma unroll
        for (int bj = 0; bj < 2; ++bj)
#pragma unroll
            for (int n = 0; n < 2; ++n) gv[bj][n] = *(const f32x4*)(g + bj * HALF + 4 * n);
#pragma unroll
        for (int ai = 0; ai < 2; ++ai)
#pragma unroll
            for (int m = 0; m < 4; ++m) { const size_t off = (size_t)(row0 + ai * HALF + m * 16) * ldc + col0;
#pragma unroll
                for (int bj = 0; bj < 2; ++bj)
#pragma unroll
                    for (int n = 0; n < 2; ++n) { const f32x4 xv = *(const f32x4*)(X + off + bj * HALF + 4 * n);
                        *(f32x4*)(O + off + bj * HALF + 4 * n) = xv + gv[bj][n] * acc[ai][bj][m][n]; } }
    }
};
template <class Epi, class Sched, bool ALIGN_EPI = false, bool SP2 = false>
__device__ __forceinline__ void gemm_phase(PG8_LAS unsigned char* lds, const Gemm g, const Sched& S, const Epi& E) {
    const int tid = threadIdx.x, wid = __builtin_amdgcn_readfirstlane(tid >> 6), lane = tid & 63, wr = wid >> 2, wc = wid & 3, fr = lane & 15, fq = lane >> 4;
    const int K = g.K, nt = K / BK;
    unsigned voffA[2], voffB[2];
#pragma unroll
    for (int i = 0; i < 2; ++i) { int R, C; stage_rc(tid * 16 + i * 8192, R, C); const int Rb = Epi::PERM ? ((R & ~31) + perm32(R & 31)) : R;
        voffA[i] = (unsigned)(R * K + C) * 2u; voffB[i] = (unsigned)(Rb * K + C) * 2u; }
    const size_t kstep = (size_t)(BK * 2);
    const size_t hstep = (size_t)HALF * K * 2;
    const size_t tstep = 2 * hstep;
    const unsigned ldsw = (unsigned)wid * 1024u;
    const int aoff = lds_byte(wr * 64 + fr, fq * 8), boff = lds_byte(wc * 32 + fr, fq * 8);
#define PG8_SA(b, h) (((b) * 2 + (h)) * HTB)
#define PG8_SB(b, h) ((4 + (b) * 2 + (h)) * HTB)
#define PG8_STAGE(bufoff, gbase, voff) do { _Pragma("unroll") for (int _i = 0; _i < 2; ++_i) \
        __builtin_amdgcn_global_load_lds((const unsigned*)((const char*)(gbase) + (voff)[_i]), (PG8_LAS unsigned*)(lds + (bufoff) + ldsw + _i * 8192), 16, 0, 0); } while (0)
#define PG8_LDA(dst, b, h) do { _Pragma("unroll") for (int m = 0; m < 4; ++m) _Pragma("unroll") for (int k = 0; k < 2; ++k) dst[m][k] = *(const PG8_LAS bf16x8*)(lds + PG8_SA(b, h) + aoff + m * 2048 + k * 1024); } while (0)
#define PG8_LDB(dst, b, h) do { _Pragma("unroll") for (int n = 0; n < 2; ++n) _Pragma("unroll") for (int k = 0; k < 2; ++k) dst[n][k] = *(const PG8_LAS bf16x8*)(lds + PG8_SB(b, h) + boff + n * 2048 + k * 1024); } while (0)
#define PG8_MMA(ai, bj, At, Bt) do { __builtin_amdgcn_s_setprio(1); _Pragma("unroll") for (int m = 0; m < 4; ++m) _Pragma("unroll") for (int n = 0; n < 2; ++n) _Pragma("unroll") for (int k = 0; k < 2; ++k) \
        acc[ai][bj][m][n] = __builtin_amdgcn_mfma_f32_16x16x32_bf16(Bt[n][k], At[m][k], acc[ai][bj][m][n], 0, 0, 0); __builtin_amdgcn_s_setprio(0); } while (0)
#define PG8_WAIT_V(n) asm volatile("s_waitcnt vmcnt(" #n ")" ::: "memory")
#define PG8_WAIT_L(n) asm volatile("s_waitcnt lgkmcnt(" #n ")" ::: "memory")
#define PG8_BAR __builtin_amdgcn_s_barrier()
#define PG8_SCHED __builtin_amdgcn_sched_barrier(0)
    Unit cur, nxt; int ui = 0;
    if (!S.next(0, cur)) return;
    f32x4 acc[2][2][4][2];
#pragma unroll
    for (int a = 0; a < 2; ++a)
#pragma unroll
        for (int b = 0; b < 2; ++b)
#pragma unroll
            for (int m = 0; m < 4; ++m)
#pragma unroll
                for (int n = 0; n < 2; ++n) acc[a][b][m][n] = (f32x4){0.f, 0.f, 0.f, 0.f};
    bf16x8 At[4][2], B0[2][2], B1[2][2];
    const char* cA = (const char*)g.A + (size_t)cur.pm * tstep; const char* cB = (const char*)g.Bt + (size_t)cur.pn * tstep;
    S.a_ready(cur);
    if constexpr (SP2) {
        PG8_STAGE(PG8_SB(0, 0), cB, voffB); PG8_STAGE(PG8_SB(0, 1), cB + hstep, voffB); PG8_STAGE(PG8_SA(0, 0), cA, voffA); PG8_STAGE(PG8_SA(0, 1), cA + hstep, voffA);
        if (wr == 1) PG8_BAR;
        PG8_WAIT_V(2); PG8_BAR;
        PG8_STAGE(PG8_SB(1, 0), cB + kstep, voffB); PG8_STAGE(PG8_SA(1, 0), cA + kstep, voffA); PG8_STAGE(PG8_SB(1, 1), cB + hstep + kstep, voffB);
        PG8_WAIT_V(6); PG8_BAR;
    } else {
        PG8_STAGE(PG8_SB(0, 0), cB, voffB); PG8_STAGE(PG8_SA(0, 0), cA, voffA); PG8_STAGE(PG8_SB(0, 1), cB + hstep, voffB); PG8_STAGE(PG8_SA(0, 1), cA + hstep, voffA);
        if (wr == 1) PG8_BAR;
        PG8_WAIT_V(4); PG8_BAR;
        PG8_STAGE(PG8_SB(1, 0), cB + kstep, voffB); PG8_STAGE(PG8_SA(1, 0), cA + kstep, voffA); PG8_STAGE(PG8_SB(1, 1), cB + hstep + kstep, voffB);
        PG8_WAIT_V(6); PG8_BAR;
    }
    for (;;) {
        const bool has_next = S.next(ui + 1, nxt);
        const char* nA = has_next ? (const char*)g.A + (size_t)nxt.pm * tstep : cA; const char* nB = has_next ? (const char*)g.Bt + (size_t)nxt.pn * tstep : cB;
        for (int t = 0; t < nt; t += 2) {
            const bool last = (t == nt - 2);
            const char* a1 = cA + (size_t)(t + 1) * kstep;
            const char* a2 = last ? nA : cA + (size_t)(t + 2) * kstep; const char* b2 = last ? nB : cB + (size_t)(t + 2) * kstep;
            const char* a3 = a2 + kstep; const char* b3 = b2 + kstep;
            if (last && has_next) S.a_ready(nxt);
            if constexpr (SP2) {
            PG8_LDB(B0, 0, 0); PG8_LDB(B1, 0, 1); PG8_SCHED; PG8_LDA(At, 0, 0); PG8_STAGE(PG8_SA(1, 1), a1 + hstep, voffA);
            PG8_WAIT_V(8); PG8_WAIT_L(0); PG8_BAR; PG8_MMA(0, 0, At, B0); PG8_MMA(0, 1, At, B1); PG8_BAR; PG8_SCHED;
            PG8_LDA(At, 0, 1); PG8_STAGE(PG8_SB(0, 0), b2, voffB); PG8_STAGE(PG8_SB(0, 1), b2 + hstep, voffB); PG8_STAGE(PG8_SA(0, 0), a2, voffA);
            PG8_WAIT_V(8); PG8_WAIT_L(0); PG8_BAR; PG8_MMA(1, 0, At, B0); PG8_MMA(1, 1, At, B1); PG8_BAR; PG8_SCHED;
            PG8_LDB(B0, 1, 0); PG8_LDB(B1, 1, 1); PG8_SCHED; PG8_LDA(At, 1, 0); PG8_STAGE(PG8_SA(0, 1), a2 + hstep, voffA);
            PG8_WAIT_V(8); PG8_WAIT_L(0); PG8_BAR; PG8_MMA(0, 0, At, B0); PG8_MMA(0, 1, At, B1); PG8_BAR; PG8_SCHED;
            PG8_LDA(At, 1, 1); PG8_STAGE(PG8_SB(1, 0), b3, voffB); PG8_STAGE(PG8_SB(1, 1), b3 + hstep, voffB); PG8_STAGE(PG8_SA(1, 0), a3, voffA);
            PG8_WAIT_V(8); PG8_WAIT_L(0); PG8_BAR; PG8_MMA(1, 0, At, B0); PG8_MMA(1, 1, At, B1); PG8_BAR; PG8_SCHED;
            } else {
            PG8_LDB(B0, 0, 0); PG8_SCHED; PG8_LDA(At, 0, 0); PG8_STAGE(PG8_SA(1, 1), a1 + hstep, voffA);
            PG8_WAIT_L(8); PG8_BAR; PG8_WAIT_L(0); PG8_MMA(0, 0, At, B0); PG8_BAR; PG8_SCHED;
            PG8_LDB(B1, 0, 1); PG8_STAGE(PG8_SB(0, 0), b2, voffB);
            PG8_BAR; PG8_WAIT_L(0); PG8_MMA(0, 1, At, B1); PG8_BAR;
            PG8_LDA(At, 0, 1); PG8_STAGE(PG8_SA(0, 0), a2, voffA);
            PG8_BAR; PG8_WAIT_L(0); PG8_MMA(1, 0, At, B0); PG8_BAR; PG8_SCHED;
            PG8_STAGE(PG8_SB(0, 1), b2 + hstep, voffB);
            PG8_WAIT_V(6); PG8_BAR; PG8_MMA(1, 1, At, B1); PG8_BAR;
            PG8_LDB(B0, 1, 0); PG8_SCHED; PG8_LDA(At, 1, 0); PG8_STAGE(PG8_SA(0, 1), a2 + hstep, voffA);
            PG8_WAIT_L(8); PG8_BAR; PG8_WAIT_L(0); PG8_MMA(0, 0, At, B0); PG8_BAR; PG8_SCHED;
            PG8_LDB(B1, 1, 1); PG8_STAGE(PG8_SB(1, 0), b3, voffB);
            PG8_BAR; PG8_WAIT_L(0); PG8_MMA(0, 1, At, B1); PG8_BAR;
            PG8_LDA(At, 1, 1); PG8_STAGE(PG8_SA(1, 0), a3, voffA);
            PG8_BAR; PG8_WAIT_L(0); PG8_MMA(1, 0, At, B0); PG8_BAR; PG8_SCHED;
            PG8_STAGE(PG8_SB(1, 1), b3 + hstep, voffB);
            PG8_WAIT_V(6); PG8_BAR; PG8_MMA(1, 1, At, B1); PG8_BAR;
            }
        }
        if constexpr (ALIGN_EPI) { if (wr == 0) PG8_BAR; }
        if constexpr (!Epi::AFTER_DRAIN) { E(acc, cur, wr, wc, fr, fq); S.done(cur); }
        if (!has_next) break;
#pragma unroll
        for (int a = 0; a < 2; ++a)
#pragma unroll
            for (int b = 0; b < 2; ++b)
#pragma unroll
                for (int m = 0; m < 4; ++m)
#pragma unroll
                    for (int n = 0; n < 2; ++n) acc[a][b][m][n] = (f32x4){0.f, 0.f, 0.f, 0.f};
        cur = nxt; cA = nA; cB = nB; ++ui;
        if constexpr (ALIGN_EPI) { if (wr == 1) PG8_BAR; }
    }
    PG8_WAIT_V(0);
    if constexpr (!ALIGN_EPI) { if (wr == 0) PG8_BAR; }
    PG8_BAR;
    if constexpr (Epi::AFTER_DRAIN) { E.fused(acc, cur, wr, wc, fr, fq, lds, wid, lane); S.done(cur); }
#undef PG8_SA
#undef PG8_SB
#undef PG8_STAGE
#undef PG8_LDA
#undef PG8_LDB
#undef PG8_MMA
#undef PG8_WAIT_V
#undef PG8_WAIT_L
#undef PG8_BAR
#undef PG8_SCHED
}
}
#define GAS __attribute__((address_space(1)))
#define LAS __attribute__((address_space(3)))
typedef unsigned short bf16;
typedef unsigned v4u __attribute__((ext_vector_type(4)));
typedef unsigned v2u __attribute__((ext_vector_type(2)));
typedef float f32x4 __attribute__((ext_vector_type(4)));
typedef float f32x2 __attribute__((ext_vector_type(2)));
typedef short bf16x8 __attribute__((ext_vector_type(8)));
typedef __bf16 bf16x2_t __attribute__((ext_vector_type(2)));

constexpr int NWAVES = 8, NTHR = 512;
constexpr int DM = 2048, NB = 4, SEQ = 8192, M = NB * SEQ;
constexpr int RW = 1024, RHEADS = 16, HD = 64;
constexpr int L_W = 64, L_A = 64, L_G = 160;
constexpr int INP = 5936, INPP = 6144;
constexpr int C_R = 0, C_K = 1024, C_V = 2048, C_WD = 3072, C_AD = 3136, C_GD = 3200, C_Z = 3360, C_XBC = 4384, C_DT = 5920;
constexpr int MODW = 6 * DM;
constexpr int NEXP = 16384;
constexpr float RMS_EPS = 1e-6f;

enum { I_X = 0, I_C, I_ADAW, I_ADAB, I_N1W, I_WIN, I_MU, I_W0, I_WUP, I_A0, I_AUP, I_GUP, I_KK, I_KA, I_RK, I_LNW, I_LNB,
       I_CONVW, I_CONVB, I_DTB, I_ALOG, I_DSK, I_MNW, I_WOUT, I_N2W, I_WQ, I_KEYS, I_PU, I_PV, I_FNW, N_IN };

constexpr size_t MiB = 1u << 20;
constexpr size_t WS_CTL = 0, CTL_ZERO_BYTES = 1 * MiB;
constexpr size_t WS_MOD = 1 * MiB;
constexpr size_t WS_WIN = 2 * MiB, WS_WOUT = 26 * MiB, WS_WQ = 34 * MiB, WS_KEYS = 42 * MiB;
constexpr size_t WS_WUPT = 43 * MiB, WS_AUPT = 43 * MiB + 256 * 1024, WS_GUPT = 43 * MiB + 512 * 1024;
constexpr size_t WS_PU8 = 44 * MiB, WS_PV8 = 76 * MiB;
constexpr size_t WS_USC = 108 * MiB, WS_VSC = 108 * MiB + 65536;
constexpr size_t WS_XN = 172 * MiB;
constexpr size_t WS_LW = WS_XN, WS_AA = WS_XN + 64 * MiB;
constexpr size_t WS_PROJ = 300 * MiB;
constexpr size_t WS_Q = WS_PROJ;
constexpr size_t WS_GG = 684 * MiB;
constexpr size_t WS_PD = WS_PROJ + 128 * MiB;
constexpr size_t WS_RTE = 684 * MiB, WS_RTG = 700 * MiB, WS_COEF = 716 * MiB;
constexpr size_t WS_OY = 748 * MiB;
constexpr size_t WS_END = 876 * MiB;

constexpr int RING_BYTES = 131072, LDS_BYTES = 147456;

#define LDS_WAIT() asm volatile("s_waitcnt lgkmcnt(0)" ::: "memory")
#define VM_WAIT() asm volatile("s_waitcnt vmcnt(0)" ::: "memory")
__device__ __forceinline__ unsigned pk2(float lo, float hi) { f32x2 v = {lo, hi}; bf16x2_t b = __builtin_convertvector(v, bf16x2_t); return __builtin_bit_cast(unsigned, b); }
__device__ __forceinline__ float bflo(unsigned u) { return __uint_as_float(u << 16); }
__device__ __forceinline__ float bfhi(unsigned u) { return __uint_as_float(u & 0xffff0000u); }
__device__ __forceinline__ float bf1(bf16 h) { return __uint_as_float((unsigned)h << 16); }
__device__ __forceinline__ float wave_sum(float v) {
#pragma unroll
    for (int o = 1; o < 64; o <<= 1) v += __shfl_xor(v, o);
    return v;
}
__device__ __forceinline__ float rcp_f(float v) { return __builtin_amdgcn_rcpf(v); }
__device__ __forceinline__ float silu_f(float v) { return v * rcp_f(1.f + __expf(-v)); }
__device__ __forceinline__ float sigmoid_f(float v) { return rcp_f(1.f + __expf(-v)); }

struct Ctx {
    LAS unsigned char* lds;
    int tid, lane, wave, G, gw, NGW;
    const float* const* in;
    float* out; unsigned char* ws;
};

__device__ __forceinline__ void transpose_item(const float* W, int K, int N, bf16* WT, int ldt, int nrows_out, LAS float* scr, int kb, int nb, int lane) {
    const int k0 = 64 * kb, n0 = 32 * nb;
#pragma unroll 8
    for (int i = 0; i < 32; ++i) { const int kk = 2 * i + (lane >> 5), k = k0 + kk, n = n0 + (lane & 31);
        scr[kk * 33 + (lane & 31)] = (k < K && n < N) ? W[(size_t)k * N + n] : 0.f; }
    LDS_WAIT(); asm volatile("" ::: "memory");
    const int c = lane & 7;
#pragma unroll
    for (int j = 0; j < 4; ++j) { const int n = (lane >> 3) + 8 * j; const LAS float* s = scr + (8 * c) * 33 + n;
        v4u o; o.x = pk2(s[0 * 33], s[1 * 33]); o.y = pk2(s[2 * 33], s[3 * 33]); o.z = pk2(s[4 * 33], s[5 * 33]); o.w = pk2(s[6 * 33], s[7 * 33]);
        if (n0 + n < nrows_out && k0 + 8 * c + 8 <= ldt) *(v4u*)(WT + (size_t)(n0 + n) * ldt + k0 + 8 * c) = o; }
    LDS_WAIT(); asm volatile("" ::: "memory");
}
__device__ __forceinline__ void transpose_all(const float* W, int K, int N, bf16* WT, int ldt, int nrows_out, LAS float* scr, int gw, int NGW, int lane) {
    const int nkb = (K + 63) / 64, nnb = nrows_out / 32, nit = nkb * nnb;
    for (int it = gw; it < nit; it += NGW) transpose_item(W, K, N, WT, ldt, nrows_out, scr, it / nnb, it % nnb, lane);
}
__device__ __forceinline__ void convert_all(const float* src, bf16* dst, size_t n8, int gw, int NGW, int lane) {
    const f32x4* s4 = (const f32x4*)src; v4u* d4 = (v4u*)dst;
    for (size_t i = (size_t)gw * 64 + lane; i < n8; i += (size_t)NGW * 64) {
        const f32x4 a = __builtin_nontemporal_load(s4 + 2 * i), b = __builtin_nontemporal_load(s4 + 2 * i + 1);
        v4u o; o.x = pk2(a.x, a.y); o.y = pk2(a.z, a.w); o.z = pk2(b.x, b.y); o.w = pk2(b.z, b.w);
        d4[i] = o; }
}
__device__ __forceinline__ void quantize_rows_fp8(const float* src, unsigned char* dst8, float* scales, int gw, int NGW, int lane) {
    for (int e = gw; e < NEXP; e += NGW) {
        const f32x4* s4 = (const f32x4*)(src + (size_t)e * DM) + lane;
        f32x4 v[8]; float am = 0.f;
#pragma unroll
        for (int i = 0; i < 8; ++i) { v[i] = __builtin_nontemporal_load(s4 + 64 * i);
            am = fmaxf(fmaxf(am, fmaxf(fabsf(v[i].x), fabsf(v[i].y))), fmaxf(fabsf(v[i].z), fabsf(v[i].w))); }
#pragma unroll
        for (int o = 1; o < 64; o <<= 1) am = fmaxf(am, __shfl_xor(am, o));
        am = fmaxf(am, 1e-30f);
        const float inv = 440.f / am;
#pragma unroll
        for (int i = 0; i < 8; ++i) { int w = __builtin_amdgcn_cvt_pk_fp8_f32(v[i].x * inv, v[i].y * inv, 0, false); w = __builtin_amdgcn_cvt_pk_fp8_f32(v[i].z * inv, v[i].w * inv, w, true);
            const int seg = 2 * i + (lane >> 5);
            *(int*)(dst8 + (size_t)seg * ((size_t)NEXP * 128) + (size_t)e * 128 + 4 * (lane & 31)) = w; }
        if (lane == 0) scales[e] = am * (1.f / 440.f);
    }
}
__device__ __forceinline__ void p0_prologue(const Ctx& F) {
    if (blockIdx.x < MODW / 64) {
        LAS float* sc = (LAS float*)F.lds;
        LAS float* red = sc + NB * DM;
        const float* c = F.in[I_C];
        for (int i = F.tid; i < NB * DM; i += NTHR) sc[i] = silu_f(c[i]);
        __syncthreads();
        const int j = blockIdx.x * 64 + F.lane;
        const float* wp = F.in[I_ADAW] + (size_t)(F.wave * 256) * MODW + j;
        float a0 = 0.f, a1 = 0.f, a2 = 0.f, a3 = 0.f;
#pragma unroll 16
        for (int kk = 0; kk < 256; ++kk) { const float w = wp[(size_t)kk * MODW]; const int k = F.wave * 256 + kk;
            a0 += sc[k] * w; a1 += sc[DM + k] * w; a2 += sc[2 * DM + k] * w; a3 += sc[3 * DM + k] * w; }
        red[(F.wave * 4 + 0) * 64 + F.lane] = a0; red[(F.wave * 4 + 1) * 64 + F.lane] = a1; red[(F.wave * 4 + 2) * 64 + F.lane] = a2; red[(F.wave * 4 + 3) * 64 + F.lane] = a3;
        __syncthreads();
        if (F.tid < 256) { const int b = F.tid >> 6, l = F.tid & 63; float s = F.in[I_ADAB][blockIdx.x * 64 + l];
#pragma unroll
            for (int w = 0; w < 8; ++w) s += red[(w * 4 + b) * 64 + l];
            ((float*)(F.ws + WS_MOD))[b * MODW + blockIdx.x * 64 + l] = s; }
        __syncthreads();
    }
    LAS float* scr = (LAS float*)(F.lds + F.wave * 16384);
    transpose_all(F.in[I_WIN], DM, INP, (bf16*)(F.ws + WS_WIN), DM, INPP, scr, F.gw, F.NGW, F.lane);
    transpose_all(F.in[I_WOUT], DM, DM, (bf16*)(F.ws + WS_WOUT), DM, DM, scr, F.gw, F.NGW, F.lane);
    transpose_all(F.in[I_WQ], DM, DM, (bf16*)(F.ws + WS_WQ), DM, DM, scr, F.gw, F.NGW, F.lane);
    transpose_all(F.in[I_WUP], L_W, RW, (bf16*)(F.ws + WS_WUPT), L_W, RW, scr, F.gw, F.NGW, F.lane);
    transpose_all(F.in[I_AUP], L_A, RW, (bf16*)(F.ws + WS_AUPT), L_A, RW, scr, F.gw, F.NGW, F.lane);
    transpose_all(F.in[I_GUP], L_G, RW, (bf16*)(F.ws + WS_GUPT), L_G, RW, scr, F.gw, F.NGW, F.lane);
    convert_all(F.in[I_KEYS], (bf16*)(F.ws + WS_KEYS), (size_t)16 * 128 * 128 / 8, F.gw, F.NGW, F.lane);
    quantize_rows_fp8(F.in[I_PU], F.ws + WS_PU8, (float*)(F.ws + WS_USC), F.gw, F.NGW, F.lane);
    quantize_rows_fp8(F.in[I_PV], F.ws + WS_PV8, (float*)(F.ws + WS_VSC), F.gw, F.NGW, F.lane);
}

__device__ __forceinline__ void norm_mod_rows(const Ctx& F, const float* X, const float* nw, int shift_off, int scale_off, bf16* XN) {
    const float* mod = (const float*)(F.ws + WS_MOD);
    for (int m = F.gw; m < M; m += F.NGW) {
        const int b = m / SEQ;
        const f32x4* xr = (const f32x4*)(X + (size_t)m * DM) + F.lane;
        f32x4 v[8]; float s = 0.f;
#pragma unroll
        for (int j = 0; j < 8; ++j) { v[j] = xr[64 * j]; s += (v[j].x * v[j].x + v[j].y * v[j].y) + (v[j].z * v[j].z + v[j].w * v[j].w); }
        const float rstd = rsqrtf(wave_sum(s) * (1.f / DM) + RMS_EPS);
        const f32x4* wp = (const f32x4*)nw + F.lane;
        const f32x4* shp = (const f32x4*)(mod + (size_t)b * MODW + shift_off) + F.lane;
        const f32x4* scp = (const f32x4*)(mod + (size_t)b * MODW + scale_off) + F.lane;
        v2u* o = (v2u*)(XN + (size_t)m * DM) + F.lane;
#pragma unroll
        for (int j = 0; j < 8; ++j) { const f32x4 w = wp[64 * j], a = scp[64 * j], c = shp[64 * j];
            const f32x4 r = (v[j] * rstd) * w * (a + 1.f) + c;
            v2u p; p.x = pk2(r.x, r.y); p.y = pk2(r.z, r.w); o[64 * j] = p; }
    }
}
__device__ __forceinline__ void final_norm_rows(const Ctx& F, const float* H, const float* nw, float* O) {
    for (int m = F.gw; m < M; m += F.NGW) {
        const f32x4* xr = (const f32x4*)(H + (size_t)m * DM) + F.lane;
        f32x4 v[8]; float s = 0.f;
#pragma unroll
        for (int j = 0; j < 8; ++j) { v[j] = xr[64 * j]; s += (v[j].x * v[j].x + v[j].y * v[j].y) + (v[j].z * v[j].z + v[j].w * v[j].w); }
        const float rstd = rsqrtf(wave_sum(s) * (1.f / DM) + RMS_EPS);
        const f32x4* wp = (const f32x4*)nw + F.lane;
        f32x4* o = (f32x4*)(O + (size_t)m * DM) + F.lane;
#pragma unroll
        for (int j = 0; j < 8; ++j) o[64 * j] = (v[j] * rstd) * wp[64 * j];
    }
}

#define LO2(v) __builtin_shufflevector((v), (v), 0, 1)
#define HI2(v) __builtin_shufflevector((v), (v), 2, 3)
template <int CTRL> __device__ __forceinline__ float dpp_f(float x) { return __builtin_bit_cast(float, __builtin_amdgcn_mov_dpp(__builtin_bit_cast(int, x), CTRL, 0xf, 0xf, true)); }
__device__ __forceinline__ float rowsum16(float x) { x += dpp_f<0xB1>(x); x += dpp_f<0x4E>(x); x += dpp_f<0x124>(x); x += dpp_f<0x128>(x); return x; }
__device__ __forceinline__ float quadsum(float x) { x += dpp_f<0xB1>(x); x += dpp_f<0x4E>(x); return x; }

__device__ __forceinline__ float treduce16(const float (&p)[16], bool b0, bool b1, bool b2, bool b3) {
    float a[8], bq[4], c2[2];
#pragma unroll
    for (int j = 0; j < 8; ++j) { const float mine = b3 ? p[j + 8] : p[j], send = b3 ? p[j] : p[j + 8]; a[j] = mine + dpp_f<0x128>(send); }
#pragma unroll
    for (int j = 0; j < 4; ++j) { const float mine = b2 ? a[j + 4] : a[j], send = b2 ? a[j] : a[j + 4]; const float up = dpp_f<0x104>(send), dn = dpp_f<0x114>(send); bq[j] = mine + (b2 ? dn : up); }
#pragma unroll
    for (int j = 0; j < 2; ++j) { const float mine = b1 ? bq[j + 2] : bq[j], send = b1 ? bq[j] : bq[j + 2]; c2[j] = mine + dpp_f<0x4E>(send); }
    const float mine = b0 ? c2[1] : c2[0], send = b0 ? c2[0] : c2[1];
    return mine + dpp_f<0xB1>(send);
}
__device__ __forceinline__ float wave_sum_dpp(float v) { v = rowsum16(v); v += __shfl_xor(v, 16); v += __shfl_xor(v, 32); return v; }
__device__ __forceinline__ void unpack8(const v4u p, float (&e)[8]) { e[0] = bflo(p.x); e[1] = bfhi(p.x); e[2] = bflo(p.y); e[3] = bfhi(p.y); e[4] = bflo(p.z); e[5] = bfhi(p.z); e[6] = bflo(p.w); e[7] = bfhi(p.w); }
__device__ __forceinline__ v4u pack8(const float (&e)[8]) { v4u o; o.x = pk2(e[0], e[1]); o.y = pk2(e[2], e[3]); o.z = pk2(e[4], e[5]); o.w = pk2(e[6], e[7]); return o; }

__device__ __forceinline__ void p3_lora(const Ctx& F) {
    const bf16* PROJ = (const bf16*)(F.ws + WS_PROJ);
    const bf16* WUPT = (const bf16*)(F.ws + WS_WUPT); const bf16* AUPT = (const bf16*)(F.ws + WS_AUPT); const bf16* GUPT = (const bf16*)(F.ws + WS_GUPT);
    bf16* LW = (bf16*)(F.ws + WS_LW); bf16* AA = (bf16*)(F.ws + WS_AA); bf16* GG = (bf16*)(F.ws + WS_GG);
    const float* mu = F.in[I_MU]; const float* w0 = F.in[I_W0]; const float* a0 = F.in[I_A0];
    const int r16 = F.lane & 15, q = F.lane >> 4;
    for (int mt = F.gw; mt < M / 16; mt += F.NGW) {
        const int m = mt * 16 + r16; const bool first = (m % SEQ) == 0;
        const bf16* row = PROJ + (size_t)m * INPP;
        bf16x8 af[9];
#pragma unroll
        for (int s = 0; s < 9; ++s) {
            const int col = ((s < 2) ? (C_WD + 32 * s) : (s < 4) ? (C_AD + 32 * (s - 2)) : (C_GD + 32 * (s - 4))) + 8 * q;
            const v4u pc = *(const v4u*)(row + col);
            v4u pp = {0u, 0u, 0u, 0u}; if (!first) pp = *(const v4u*)(row - INPP + col);
            const f32x4 m0 = *(const f32x4*)(mu + col), m1 = *(const f32x4*)(mu + col + 4);
            float c[8], p[8], e[8]; unpack8(pc, c); unpack8(pp, p);
            const float mm[8] = {m0.x, m0.y, m0.z, m0.w, m1.x, m1.y, m1.z, m1.w};
#pragma unroll
            for (int j = 0; j < 8; ++j) { float v = c[j] + (p[j] - c[j]) * mm[j];
                if (s < 2) { const float t = __expf(2.f * v); v = 1.f - 2.f * rcp_f(t + 1.f); }
                else if (s >= 4) v = sigmoid_f(v);
                e[j] = v; }
            af[s] = __builtin_bit_cast(bf16x8, pack8(e));
        }
        for (int nt = 0; nt < RW / 16; ++nt) {
            const int n0 = nt * 16;
            f32x4 acc0 = {0.f, 0.f, 0.f, 0.f}, acc1 = acc0, acc2 = acc0;
            const bf16* wu = WUPT + (size_t)(n0 + r16) * L_W + 8 * q;
            const bf16* au = AUPT + (size_t)(n0 + r16) * L_A + 8 * q;
            const bf16* gu = GUPT + (size_t)(n0 + r16) * L_G + 8 * q;
#pragma unroll
            for (int s = 0; s < 2; ++s) acc0 = __builtin_amdgcn_mfma_f32_16x16x32_bf16(*(const bf16x8*)(wu + 32 * s), af[s], acc0, 0, 0, 0);
#pragma unroll
            for (int s = 0; s < 2; ++s) acc1 = __builtin_amdgcn_mfma_f32_16x16x32_bf16(*(const bf16x8*)(au + 32 * s), af[2 + s], acc1, 0, 0, 0);
#pragma unroll
            for (int s = 0; s < 5; ++s) acc2 = __builtin_amdgcn_mfma_f32_16x16x32_bf16(*(const bf16x8*)(gu + 32 * s), af[4 + s], acc2, 0, 0, 0);
            const int n = n0 + 4 * q;
            const f32x4 w0v = *(const f32x4*)(w0 + n), a0v = *(const f32x4*)(a0 + n);
            v2u o0, o1, o2;
            o0.x = pk2(-0.60653066f * sigmoid_f(acc0[0] + w0v.x), -0.60653066f * sigmoid_f(acc0[1] + w0v.y));
            o0.y = pk2(-0.60653066f * sigmoid_f(acc0[2] + w0v.z), -0.60653066f * sigmoid_f(acc0[3] + w0v.w));
            o1.x = pk2(sigmoid_f(acc1[0] + a0v.x), sigmoid_f(acc1[1] + a0v.y)); o1.y = pk2(sigmoid_f(acc1[2] + a0v.z), sigmoid_f(acc1[3] + a0v.w));
            o2.x = pk2(acc2[0], acc2[1]); o2.y = pk2(acc2[2], acc2[3]);
            *(v2u*)(LW + (size_t)m * RW + n) = o0; *(v2u*)(AA + (size_t)m * RW + n) = o1; *(v2u*)(GG + (size_t)m * RW + n) = o2;
        }
    }
}

constexpr int TC = 32, NCHUNK = SEQ / TC;
constexpr int RB_R = 0, RB_W = TC * 64, RB_K = 2 * TC * 64, RB_KK = 3 * TC * 64, RB_KA = 4 * TC * 64, RB_V = 5 * TC * 64, RB_SIZE = 5 * TC * 64 + TC * 32;
constexpr int MB_B = 0, MB_C = TC * 128, MB_X = 2 * TC * 128, MB_DT = MB_X + TC * 32, MB_DA = MB_DT + TC, MB_SIZE = MB_DA + TC;
static_assert(2 * RB_SIZE * 4 <= RING_BYTES && 2 * MB_SIZE * 4 <= RING_BYTES, "scan buffers fit the LDS ring");

struct RwkvRaw { bf16 r[5], k[5], v[5], lw[4], a[4]; };
__device__ __forceinline__ void rwkv_load(RwkvRaw& raw, const bf16* PROJ, const bf16* LW, const bf16* AA, int b, int h, int t0w, int c) {
    const bf16* base = PROJ + (size_t)(b * SEQ + t0w) * INPP + h * 64 + c;
#pragma unroll
    for (int i = 0; i < 5; ++i) {
        if (i == 0 && t0w == 0) { raw.r[0] = 0; raw.k[0] = 0; raw.v[0] = 0; }
        else { const bf16* row = base + (long)(i - 1) * INPP; raw.r[i] = row[C_R]; raw.k[i] = row[C_K]; raw.v[i] = row[C_V]; }
    }
#pragma unroll
    for (int i = 0; i < 4; ++i) { const size_t o = (size_t)(b * SEQ + t0w + i) * RW + h * 64 + c; raw.lw[i] = LW[o]; raw.a[i] = AA[o]; }
}
__device__ __forceinline__ void rwkv_stage(const RwkvRaw& raw, LAS float* buf, int tl0, int c, int hf, float mu_r, float mu_k, float mu_v, float kkw, float kaw) {
#pragma unroll
    for (int i = 0; i < 4; ++i) {
        const int t = tl0 + i;
        const float rc = bf1(raw.r[i + 1]), rp = bf1(raw.r[i]), kc = bf1(raw.k[i + 1]), kp = bf1(raw.k[i]), vc = bf1(raw.v[i + 1]), vp = bf1(raw.v[i]);
        const float rr = rc + (rp - rc) * mu_r, kx = kc + (kp - kc) * mu_k, vv = vc + (vp - vc) * mu_v;
        const float a = bf1(raw.a[i]), dec = __expf(bf1(raw.lw[i]));
        const float kkraw = kx * kkw; const float ss = wave_sum_dpp(kkraw * kkraw);
        const float kkn = kkraw * rcp_f(fmaxf(sqrtf(ss), 1e-12f));
        buf[RB_R + t * 64 + c] = rr; buf[RB_W + t * 64 + c] = dec; buf[RB_K + t * 64 + c] = kx * (1.f + (a - 1.f) * kaw);
        buf[RB_KK + t * 64 + c] = kkn; buf[RB_KA + t * 64 + c] = kkn * a;
        if ((c >> 5) == hf) buf[RB_V + t * 32 + (c & 31)] = vv;
    }
}
__device__ __forceinline__ void rwkv_task(const Ctx& F, int task) {
    const int b = task >> 5, h = (task >> 1) & 15, hf = task & 1;
    const bf16* PROJ = (const bf16*)(F.ws + WS_PROJ); const bf16* LW = (const bf16*)(F.ws + WS_LW); const bf16* AA = (const bf16*)(F.ws + WS_AA);
    bf16* OY = (bf16*)(F.ws + WS_OY);
    LAS float* lbuf = (LAS float*)F.lds;
    const int c = F.lane, w = F.wave, r = F.lane >> 4, cg = F.lane & 15;
    const int ch = h * 64 + c;
    const float mu_r = F.in[I_MU][C_R + ch], mu_k = F.in[I_MU][C_K + ch], mu_v = F.in[I_MU][C_V + ch], kkw = F.in[I_KK][ch], kaw = F.in[I_KA][ch];
    RwkvRaw raw;
    rwkv_load(raw, PROJ, LW, AA, b, h, 4 * w, c);
    rwkv_stage(raw, lbuf, 4 * w, c, hf, mu_r, mu_k, mu_v, kkw, kaw);
    __syncthreads();
    f32x2 S01 = {0.f, 0.f}, S23 = {0.f, 0.f};
    const bool cb0 = cg & 1, cb1 = cg & 2, cb2 = cg & 4, cb3 = cg & 8;
    bf16* orow = OY + (size_t)(b * SEQ) * DM + h * 64 + 32 * hf + 4 * w + r;
    for (int ck = 0; ck < NCHUNK; ++ck) {
        const LAS float* buf = lbuf + (ck & 1) * RB_SIZE;
        const bool more = (ck + 1 < NCHUNK);
        if (more) rwkv_load(raw, PROJ, LW, AA, b, h, (ck + 1) * TC + 4 * w, c);
#pragma unroll 1
        for (int hb = 0; hb < TC / 16; ++hb) {
            float op[16];
            const LAS float* bp = buf + hb * 16 * 64 + 4 * cg; const LAS float* vp = buf + RB_V + hb * 16 * 32 + 4 * w + r;
            f32x4 kk4 = *(const LAS f32x4*)(bp + RB_KK), w4 = *(const LAS f32x4*)(bp + RB_W), ka4 = *(const LAS f32x4*)(bp + RB_KA), k4 = *(const LAS f32x4*)(bp + RB_K), r4 = *(const LAS f32x4*)(bp + RB_R);
            float vr = vp[0];
#pragma unroll
            for (int j = 0; j < 16; ++j) {
                f32x4 nkk = kk4, nw = w4, nka = ka4, nk = k4, nr = r4; float nv = vr;
                if (j < 15) { nkk = *(const LAS f32x4*)(bp + RB_KK + (j + 1) * 64); nw = *(const LAS f32x4*)(bp + RB_W + (j + 1) * 64); nka = *(const LAS f32x4*)(bp + RB_KA + (j + 1) * 64);
                              nk = *(const LAS f32x4*)(bp + RB_K + (j + 1) * 64); nr = *(const LAS f32x4*)(bp + RB_R + (j + 1) * 64); nv = vp[(j + 1) * 32]; }
                const f32x2 tq = S01 * LO2(kk4) + S23 * HI2(kk4);
                const float sa = rowsum16(tq.x + tq.y);
                const f32x2 sav = {sa, sa}, vrv = {vr, vr};
                S01 = S01 * LO2(w4) + (vrv * LO2(k4) - sav * LO2(ka4));
                S23 = S23 * HI2(w4) + (vrv * HI2(k4) - sav * HI2(ka4));
                const f32x2 uq = S01 * LO2(r4) + S23 * HI2(r4);
                op[j] = uq.x + uq.y;
                asm volatile("" : "+v"(S01), "+v"(S23) :: "memory");
                kk4 = nkk; w4 = nw; ka4 = nka; k4 = nk; r4 = nr; vr = nv;
            }
            const float ored = treduce16(op, cb0, cb1, cb2, cb3);
            orow[(size_t)(ck * TC + hb * 16 + cg) * DM] = (bf16)(pk2(ored, 0.f) & 0xffffu);
        }
        if (more) rwkv_stage(raw, lbuf + ((ck + 1) & 1) * RB_SIZE, 4 * w, c, hf, mu_r, mu_k, mu_v, kkw, kaw);
        __syncthreads();
    }
}

struct MambaRaw { bf16 x[3][11]; bf16 dt; };
__device__ __forceinline__ int mamba_col(int cb, int head, int hf, int lane) {
    const int g = head >> 3;
    return (cb == 0) ? (head * 64 + 32 * hf + (lane & 31)) : (cb < 3) ? (1024 + g * 128 + (cb - 1) * 64 + lane) : (1280 + g * 128 + (cb - 3) * 64 + lane);
}
__device__ __forceinline__ void mamba_load(MambaRaw& raw, const bf16* PROJ, int b, int head, int hf, int t0, int w, int lane) {
#pragma unroll
    for (int k = 0; k < 3; ++k) { const int id = w + 8 * k;
        if (id < 20) { const int cb = id >> 2, ts = id & 3; const int chn = mamba_col(cb, head, hf, lane);
            const bf16* base = PROJ + (size_t)(b * SEQ) * INPP + C_XBC + chn;
#pragma unroll
            for (int j = 0; j < 11; ++j) { const int t = t0 + 8 * ts - 3 + j; raw.x[k][j] = (t >= 0) ? base[(size_t)t * INPP] : (bf16)0; } } }
    if (w == 7) raw.dt = PROJ[(size_t)(b * SEQ + t0 + (lane & 31)) * INPP + C_DT + head];
}
__device__ __forceinline__ void mamba_stage(const MambaRaw& raw, LAS float* buf, const float* convw, const float* convb, int head, int hf, int w, int lane, float dtb, float Aneg) {
#pragma unroll
    for (int k = 0; k < 3; ++k) { const int id = w + 8 * k;
        if (id < 20) { const int cb = id >> 2, ts = id & 3; const int chn = mamba_col(cb, head, hf, lane);
            const float w0 = convw[chn], w1 = convw[1536 + chn], w2 = convw[2 * 1536 + chn], w3 = convw[3 * 1536 + chn], bb = convb[chn];
            const int dbase = (cb == 0) ? MB_X : (cb < 3) ? (MB_B + (cb - 1) * 64) : (MB_C + (cb - 3) * 64); const int dstride = (cb == 0) ? 32 : 128;
            const int nn = ((cb - 1) & 1) * 64 + lane;
            const int pos = (cb == 0) ? lane : (((nn >> 2) & 1) * 64 + (nn >> 3) * 4 + (nn & 3));
            const int dbase2 = (cb == 0) ? MB_X : (cb < 3) ? MB_B : MB_C;
            LAS float* dst = buf + dbase2 + 8 * ts * dstride + pos;
            const bool act = (cb != 0) || (lane < 32);
#pragma unroll
            for (int i = 0; i < 8; ++i) { const float v = bb + w0 * bf1(raw.x[k][i]) + w1 * bf1(raw.x[k][i + 1]) + w2 * bf1(raw.x[k][i + 2]) + w3 * bf1(raw.x[k][i + 3]);
                if (act) dst[i * dstride] = silu_f(v); } } }
    if (w == 7 && lane < 32) { const float xr = bf1(raw.dt) + dtb; const float dt = (xr > 20.f) ? xr : log1pf(__expf(xr));
        buf[MB_DT + lane] = dt; buf[MB_DA + lane] = __expf(dt * Aneg); }
}
__device__ __forceinline__ void mamba_task(const Ctx& F, int task) {
    const int b = task >> 5, head = (task >> 1) & 15, hf = task & 1;
    const bf16* PROJ = (const bf16*)(F.ws + WS_PROJ); bf16* OY = (bf16*)(F.ws + WS_OY);
    LAS float* lbuf = (LAS float*)F.lds;
    const int w = F.wave, r = F.lane >> 4, ng = F.lane & 15;
    const float dtb = F.in[I_DTB][head], Aneg = -__expf(F.in[I_ALOG][head]), Dsk = F.in[I_DSK][head];
    const float* convw = F.in[I_CONVW]; const float* convb = F.in[I_CONVB];
    MambaRaw raw;
    mamba_load(raw, PROJ, b, head, hf, 0, w, F.lane);
    mamba_stage(raw, lbuf, convw, convb, head, hf, w, F.lane, dtb, Aneg);
    __syncthreads();
    f32x2 h01 = {0.f, 0.f}, h23 = {0.f, 0.f}, h45 = {0.f, 0.f}, h67 = {0.f, 0.f};
    const bool cb0 = ng & 1, cb1 = ng & 2, cb2 = ng & 4, cb3 = ng & 8;
    bf16* orow = OY + (size_t)(b * SEQ) * DM + RW + head * 64 + 32 * hf + 4 * w + r;
    for (int ck = 0; ck < NCHUNK; ++ck) {
        const LAS float* buf = lbuf + (ck & 1) * MB_SIZE;
        const bool more = (ck + 1 < NCHUNK);
        if (more) mamba_load(raw, PROJ, b, head, hf, (ck + 1) * TC, w, F.lane);
#pragma unroll 1
        for (int hb = 0; hb < TC / 16; ++hb) {
            float yp[16];
            const LAS float* bp = buf + hb * 16 * 128 + 4 * ng; const LAS float* xp = buf + MB_X + hb * 16 * 32 + 4 * w + r; const LAS float* dp = buf + MB_DT + hb * 16;
            f32x4 b0 = *(const LAS f32x4*)(bp + MB_B), b1 = *(const LAS f32x4*)(bp + MB_B + 64), c0 = *(const LAS f32x4*)(bp + MB_C), c1 = *(const LAS f32x4*)(bp + MB_C + 64);
            float x = xp[0], dt = dp[0], dA = dp[TC];
#pragma unroll
            for (int j = 0; j < 16; ++j) {
                f32x4 nb0 = b0, nb1 = b1, nc0 = c0, nc1 = c1; float nx = x, ndt = dt, ndA = dA;
                if (j < 15) { nb0 = *(const LAS f32x4*)(bp + MB_B + (j + 1) * 128); nb1 = *(const LAS f32x4*)(bp + MB_B + (j + 1) * 128 + 64);
                              nc0 = *(const LAS f32x4*)(bp + MB_C + (j + 1) * 128); nc1 = *(const LAS f32x4*)(bp + MB_C + (j + 1) * 128 + 64);
                              nx = xp[(j + 1) * 32]; ndt = dp[j + 1]; ndA = dp[TC + j + 1]; }
                const float xdt = x * dt;
                const f32x2 dAv = {dA, dA}, xv = {xdt, xdt};
                h01 = h01 * dAv + xv * LO2(b0); h23 = h23 * dAv + xv * HI2(b0); h45 = h45 * dAv + xv * LO2(b1); h67 = h67 * dAv + xv * HI2(b1);
                const f32x2 tq = (h01 * LO2(c0) + h23 * HI2(c0)) + (h45 * LO2(c1) + h67 * HI2(c1));
                yp[j] = tq.x + tq.y;
                asm volatile("" : "+v"(h01), "+v"(h23), "+v"(h45), "+v"(h67) :: "memory");
                b0 = nb0; b1 = nb1; c0 = nc0; c1 = nc1; x = nx; dt = ndt; dA = ndA;
            }
            const float yred = treduce16(yp, cb0, cb1, cb2, cb3) + Dsk * buf[MB_X + (hb * 16 + ng) * 32 + 4 * w + r];
            orow[(size_t)(ck * TC + hb * 16 + ng) * DM] = (bf16)(pk2(yred, 0.f) & 0xffffu);
        }
        if (more) mamba_stage(raw, lbuf + ((ck + 1) & 1) * MB_SIZE, convw, convb, head, hf, w, F.lane, dtb, Aneg);
        __syncthreads();
    }
}
__device__ __forceinline__ void p4_scans(const Ctx& F) {
    for (int task = blockIdx.x; task < 256; task += F.G) {
        if (task < 128) rwkv_task(F, task); else mamba_task(F, task - 128);
        __syncthreads();
    }
}

__device__ __forceinline__ void p5_post(const Ctx& F) {
    const bf16* PROJ = (const bf16*)(F.ws + WS_PROJ); const bf16* AA = (const bf16*)(F.ws + WS_AA); const bf16* GG = (const bf16*)(F.ws + WS_GG);
    bf16* OY = (bf16*)(F.ws + WS_OY);
    const float* mu = F.in[I_MU];
    const int c0 = 16 * F.lane;
    for (int m = F.gw; m < M; m += F.NGW) {
        const bool first = (m % SEQ) == 0;
        const bf16* prow = PROJ + (size_t)m * INPP;
        bf16* oyrow = OY + (size_t)m * DM;
        float res_r[16], res_m[16];
        {
            float o[16];
            { float t0[8], t1[8]; unpack8(*(const v4u*)(oyrow + c0), t0); unpack8(*(const v4u*)(oyrow + c0 + 8), t1);
#pragma unroll
              for (int j = 0; j < 8; ++j) { o[j] = t0[j]; o[8 + j] = t1[j]; } }
            float s = 0.f;
#pragma unroll
            for (int j = 0; j < 16; ++j) s += o[j];
            const float mean = quadsum(s) * (1.f / 64.f);
            float q = 0.f;
#pragma unroll
            for (int j = 0; j < 16; ++j) { o[j] -= mean; q += o[j] * o[j]; }
            const float rstd = rsqrtf(quadsum(q) * (1.f / 64.f) + 64e-5f);
            float bs = 0.f; float vv[16];
#pragma unroll
            for (int hh = 0; hh < 2; ++hh) {
                const int cc = c0 + 8 * hh;
                float rc[8], rp[8], kc[8], kp[8], vc[8], vp[8], av[8];
                unpack8(*(const v4u*)(prow + C_R + cc), rc); unpack8(*(const v4u*)(prow + C_K + cc), kc); unpack8(*(const v4u*)(prow + C_V + cc), vc);
                if (!first) { unpack8(*(const v4u*)(prow - INPP + C_R + cc), rp); unpack8(*(const v4u*)(prow - INPP + C_K + cc), kp); unpack8(*(const v4u*)(prow - INPP + C_V + cc), vp); }
                else {
#pragma unroll
                    for (int j = 0; j < 8; ++j) { rp[j] = 0.f; kp[j] = 0.f; vp[j] = 0.f; } }
                unpack8(*(const v4u*)(AA + (size_t)m * RW + cc), av);
#pragma unroll
                for (int j = 0; j < 8; ++j) { const int ch = cc + j;
                    const float rr = rc[j] + (rp[j] - rc[j]) * mu[C_R + ch], kx = kc[j] + (kp[j] - kc[j]) * mu[C_K + ch];
                    vv[8 * hh + j] = vc[j] + (vp[j] - vc[j]) * mu[C_V + ch];
                    const float k2 = kx * (1.f + (av[j] - 1.f) * F.in[I_KA][ch]);
                    bs += rr * k2 * F.in[I_RK][ch]; }
            }
            bs = quadsum(bs);
            float gv[16]; { float t0[8], t1[8]; unpack8(*(const v4u*)(GG + (size_t)m * RW + c0), t0); unpack8(*(const v4u*)(GG + (size_t)m * RW + c0 + 8), t1);
#pragma unroll
              for (int j = 0; j < 8; ++j) { gv[j] = t0[j]; gv[8 + j] = t1[j]; } }
#pragma unroll
            for (int j = 0; j < 16; ++j) { const int ch = c0 + j; res_r[j] = (o[j] * rstd * F.in[I_LNW][ch] + F.in[I_LNB][ch] + bs * vv[j]) * gv[j]; }
        }
        {
            float y[16], z[16];
            { float t0[8], t1[8]; unpack8(*(const v4u*)(oyrow + RW + c0), t0); unpack8(*(const v4u*)(oyrow + RW + c0 + 8), t1);
#pragma unroll
              for (int j = 0; j < 8; ++j) { y[j] = t0[j]; y[8 + j] = t1[j]; } }
            { float t0[8], t1[8]; unpack8(*(const v4u*)(prow + C_Z + c0), t0); unpack8(*(const v4u*)(prow + C_Z + c0 + 8), t1);
#pragma unroll
              for (int j = 0; j < 8; ++j) { z[j] = t0[j]; z[8 + j] = t1[j]; } }
            float q = 0.f;
#pragma unroll
            for (int j = 0; j < 16; ++j) { y[j] *= silu_f(z[j]); q += y[j] * y[j]; }
#pragma unroll
            for (int o = 1; o < 32; o <<= 1) q += __shfl_xor(q, o);
            const float rstd = rsqrtf(q * (1.f / 512.f) + 1e-5f);
#pragma unroll
            for (int j = 0; j < 16; ++j) res_m[j] = y[j] * rstd * F.in[I_MNW][c0 + j];
        }
        { float t0[8], t1[8];
#pragma unroll
          for (int j = 0; j < 8; ++j) { t0[j] = res_r[j]; t1[j] = res_r[8 + j]; }
          *(v4u*)(oyrow + c0) = pack8(t0); *(v4u*)(oyrow + c0 + 8) = pack8(t1);
#pragma unroll
          for (int j = 0; j < 8; ++j) { t0[j] = res_m[j]; t1[j] = res_m[8 + j]; }
          *(v4u*)(oyrow + RW + c0) = pack8(t0); *(v4u*)(oyrow + RW + c0 + 8) = pack8(t1); }
    }
}
__device__ __forceinline__ float rowmax16(float x) { x = fmaxf(x, dpp_f<0xB1>(x)); x = fmaxf(x, dpp_f<0x4E>(x)); x = fmaxf(x, dpp_f<0x124>(x)); x = fmaxf(x, dpp_f<0x128>(x)); return x; }
__device__ __forceinline__ int cand_code(int s) {
    if (s < 16) return s << 4;
    if (s < 24) return 1 | ((s - 16) << 4);
    if (s < 29) return 2 | ((s - 24) << 4);
    if (s < 33) return 3 | ((s - 29) << 4);
    if (s < 36) return 4 | ((s - 33) << 4);
    if (s < 42) { const int k = s - 36; return (5 + (k >> 1)) | ((k & 1) << 4); }
    if (s < 50) return 8 + (s - 42);
    return -1;
}
template <int NV>
__device__ __forceinline__ void select16x4(float (&v)[4][NV], int r16, float (&kept)[4]) {
    const float NINF = -__builtin_inff();
#pragma unroll
    for (int j = 0; j < 4; ++j) kept[j] = NINF;
#pragma unroll 1
    for (int rd = 0; rd < 16; ++rd) {
#pragma unroll
        for (int j = 0; j < 4; ++j) {
            float m = v[j][0];
#pragma unroll
            for (int i = 1; i < NV; ++i) m = fmaxf(m, v[j][i]);
            m = rowmax16(m);
            kept[j] = (r16 == rd) ? m : kept[j];
#pragma unroll
            for (int i = 0; i < NV; ++i) v[j][i] = (v[j][i] == m) ? NINF : v[j][i];
        }
    }
}
__device__ __forceinline__ float dot2bf(unsigned a, unsigned b, float acc) { return __builtin_amdgcn_fdot2_f32_bf16(__builtin_bit_cast(bf16x2_t, a), __builtin_bit_cast(bf16x2_t, b), acc, false); }

constexpr int PT = 16;
constexpr size_t RANGE_BYTES = (size_t)NEXP * 128;

__device__ __forceinline__ void p9_route(const Ctx& F) {
    const bf16* Q = (const bf16*)(F.ws + WS_Q); const bf16* KEYS = (const bf16*)(F.ws + WS_KEYS);
    int* rtE = (int*)(F.ws + WS_RTE); float* rtG = (float*)(F.ws + WS_RTG);
    const int lane = F.lane, w = F.wave, r16 = lane & 15, q = lane >> 4, gbase = lane & 48;
    int ci[4], cj[4]; bool cvalid[4];
#pragma unroll
    for (int u = 0; u < 4; ++u) { const int cd = cand_code(r16 + 16 * u); cvalid[u] = cd >= 0; ci[u] = cd & 15; cj[u] = (cd >> 4) & 15; }
    const float NINF = -__builtin_inff();
    for (int tile = blockIdx.x; tile < M / PT; tile += F.G) {
        const int m0 = tile * PT;
        float top[2][4];
#pragma unroll
        for (int p = 0; p < 2; ++p) {
            const int hp = 2 * w + p;
            const bf16* qrow = Q + (size_t)(m0 + r16) * DM + hp * 128 + 8 * q;
            bf16x8 af[4];
#pragma unroll
            for (int s = 0; s < 4; ++s) af[s] = *(const bf16x8*)(qrow + 32 * s);
            float v[4][8];
#pragma unroll
            for (int nt = 0; nt < 8; ++nt) {
                const bf16* krow = KEYS + (size_t)(hp * 128 + nt * 16 + r16) * 128 + 8 * q;
                f32x4 acc = {0.f, 0.f, 0.f, 0.f};
#pragma unroll
                for (int s = 0; s < 4; ++s) acc = __builtin_amdgcn_mfma_f32_16x16x32_bf16(af[s], *(const bf16x8*)(krow + 32 * s), acc, 0, 0, 0);
                const unsigned tag = 127u - (unsigned)(nt * 16 + r16);
#pragma unroll
                for (int j = 0; j < 4; ++j) v[j][nt] = __uint_as_float((__float_as_uint(acc[j]) & ~127u) | tag);
            }
            select16x4<8>(v, r16, top[p]);
        }
        float cv[4][4];
#pragma unroll
        for (int u = 0; u < 4; ++u)
#pragma unroll
            for (int j = 0; j < 4; ++j) {
                const float a = __shfl(top[0][j], gbase + ci[u]), b = __shfl(top[1][j], gbase + cj[u]);
                const float cs = __uint_as_float(__float_as_uint(a) & ~127u) + __uint_as_float(__float_as_uint(b) & ~127u);
                const float pk = __uint_as_float((__float_as_uint(cs) & ~63u) | (63u - (unsigned)(r16 + 16 * u)));
                cv[j][u] = cvalid[u] ? pk : NINF;
            }
        float best[4];
        select16x4<4>(cv, r16, best);
#pragma unroll
        for (int j = 0; j < 4; ++j) {
            const unsigned bb = __float_as_uint(best[j]);
            const int cd = cand_code(63 - (int)(bb & 63u));
            const int k0 = 127 - (int)(__float_as_uint(__shfl(top[0][j], gbase + (cd & 15))) & 127u);
            const int k1 = 127 - (int)(__float_as_uint(__shfl(top[1][j], gbase + ((cd >> 4) & 15))) & 127u);
            const float s = __uint_as_float(bb & ~63u);
            const float mx = rowmax16(s), e = __expf(s - mx), sum = rowsum16(e);
            const size_t o = (size_t)(m0 + 4 * q + j) * 128 + w * 16 + r16;
            rtE[o] = k0 * 128 + k1; rtG[o] = e * rcp_f(sum);
        }
    }
}

__device__ __forceinline__ f32x2 cvt2_fp8(unsigned wd, bool hi) { return hi ? __builtin_amdgcn_cvt_pk_f32_fp8((int)wd, true) : __builtin_amdgcn_cvt_pk_f32_fp8((int)wd, false); }
__device__ __forceinline__ void treduce8x16(const float (&p)[16], bool b0, bool b1, bool b2, float& r0, float& r1) {
    float a[8], bq[4];
#pragma unroll
    for (int i = 0; i < 8; ++i) { const float mine = b2 ? p[i + 8] : p[i], send = b2 ? p[i] : p[i + 8]; const float up = dpp_f<0x104>(send), dn = dpp_f<0x114>(send); a[i] = mine + (b2 ? dn : up); }
#pragma unroll
    for (int i = 0; i < 4; ++i) { const float mine = b1 ? a[i + 4] : a[i], send = b1 ? a[i] : a[i + 4]; bq[i] = mine + dpp_f<0x4E>(send); }
    { const float mine = b0 ? bq[2] : bq[0], send = b0 ? bq[0] : bq[2]; r0 = mine + dpp_f<0xB1>(send); }
    { const float mine = b0 ? bq[3] : bq[1], send = b0 ? bq[1] : bq[3]; r1 = mine + dpp_f<0xB1>(send); }
}
struct XGroup { int xg, gwi, stride; };
__device__ __forceinline__ XGroup xgroup(const Ctx& F) { XGroup g; g.xg = blockIdx.x & 7; const int nbg = (F.G - g.xg + 7) >> 3; g.gwi = (blockIdx.x >> 3) * NWAVES + F.wave; g.stride = nbg * NWAVES; return g; }

__device__ __forceinline__ void p10_peer_u(const Ctx& F) {
    const unsigned char* PU8 = F.ws + WS_PU8; const bf16* XN = (const bf16*)(F.ws + WS_XN);
    const int* rtE = (const int*)(F.ws + WS_RTE); float* PD = (float*)(F.ws + WS_PD);
    const XGroup g = xgroup(F);
    const int lane = F.lane, j = lane >> 3, sub = lane & 7;
    const bool b0 = sub & 1, b1 = sub & 2, b2 = sub & 4;
    for (int rr = 0; rr < 2; ++rr) {
        const int r = g.xg + 8 * rr;
        const unsigned char* tab = PU8 + (size_t)r * RANGE_BYTES + 16 * sub;
        int m = g.gwi;
        v4u ev[4], xs[2];
        if (m < M) {
#pragma unroll
            for (int i = 0; i < 4; ++i) ev[i] = *(const v4u*)(rtE + (size_t)m * 128 + 16 * j + 4 * i);
            xs[0] = *(const v4u*)(XN + (size_t)m * DM + 128 * r + 16 * sub); xs[1] = *(const v4u*)(XN + (size_t)m * DM + 128 * r + 16 * sub + 8);
        }
        for (; m < M; m += g.stride) {
            v4u gt[16];
#pragma unroll
            for (int k = 0; k < 16; ++k) gt[k] = *(const v4u*)(tab + (size_t)ev[k >> 2][k & 3] * 128);
            float x[16]; { float t0[8], t1[8]; unpack8(xs[0], t0); unpack8(xs[1], t1);
#pragma unroll
              for (int i = 0; i < 8; ++i) { x[i] = t0[i]; x[8 + i] = t1[i]; } }
            const int mn = m + g.stride;
            if (mn < M) {
#pragma unroll
                for (int i = 0; i < 4; ++i) ev[i] = *(const v4u*)(rtE + (size_t)mn * 128 + 16 * j + 4 * i);
                xs[0] = *(const v4u*)(XN + (size_t)mn * DM + 128 * r + 16 * sub); xs[1] = *(const v4u*)(XN + (size_t)mn * DM + 128 * r + 16 * sub + 8);
            }
            float p[16];
#pragma unroll
            for (int k = 0; k < 16; ++k) {
                f32x2 a0 = {0.f, 0.f}, a1 = {0.f, 0.f};
#pragma unroll
                for (int d = 0; d < 4; ++d) { const unsigned wd = gt[k][d];
                    a0 += cvt2_fp8(wd, false) * (f32x2){x[4 * d], x[4 * d + 1]}; a1 += cvt2_fp8(wd, true) * (f32x2){x[4 * d + 2], x[4 * d + 3]}; }
                p[k] = (a0.x + a0.y) + (a1.x + a1.y);
            }
            float r0, r1; treduce8x16(p, b0, b1, b2, r0, r1);
            *(f32x2*)(PD + ((size_t)r * M + m) * 128 + 2 * lane) = (f32x2){r0, r1};
        }
    }
}

__device__ __forceinline__ void p11_peer_coef(const Ctx& F) {
    const int* rtE = (const int*)(F.ws + WS_RTE); const float* rtG = (const float*)(F.ws + WS_RTG); const float* PD = (const float*)(F.ws + WS_PD);
    const float* usc = (const float*)(F.ws + WS_USC); const float* vsc = (const float*)(F.ws + WS_VSC); float* COEF = (float*)(F.ws + WS_COEF);
    for (int m = F.gw; m < M; m += F.NGW) {
        const size_t o = (size_t)m * 128 + 2 * F.lane;
        f32x2 d = {0.f, 0.f};
#pragma unroll
        for (int r = 0; r < 16; ++r) d += *(const f32x2*)(PD + (size_t)r * M * 128 + o);
        const int e0 = rtE[o], e1 = rtE[o + 1];
        const f32x2 gt = *(const f32x2*)(rtG + o);
        const float d0 = d.x * usc[e0], d1 = d.y * usc[e1];
        f32x2 c; c.x = gt.x * (0.5f * d0 * (1.f + erff(d0 * 0.70710678f))) * vsc[e0]; c.y = gt.y * (0.5f * d1 * (1.f + erff(d1 * 0.70710678f))) * vsc[e1];
        *(f32x2*)(COEF + o) = c;
    }
}

__device__ __forceinline__ void p12_peer_v(const Ctx& F) {
    const unsigned char* PV8 = F.ws + WS_PV8; const int* rtE = (const int*)(F.ws + WS_RTE); const float* COEF = (const float*)(F.ws + WS_COEF);
    const float* mod = (const float*)(F.ws + WS_MOD);
    const XGroup g = xgroup(F);
    const int lane = F.lane, j = lane >> 3, sub = lane & 7;
    const bool jb0 = j & 1;
    for (int rr = 0; rr < 2; ++rr) {
        const int r = g.xg + 8 * rr;
        const unsigned char* tab = PV8 + (size_t)r * RANGE_BYTES + 16 * sub;
        int m = g.gwi;
        v4u ev[4]; f32x4 cf[4];
        if (m < M) {
#pragma unroll
            for (int i = 0; i < 4; ++i) { ev[i] = *(const v4u*)(rtE + (size_t)m * 128 + 16 * j + 4 * i); cf[i] = *(const f32x4*)(COEF + (size_t)m * 128 + 16 * j + 4 * i); }
        }
        for (; m < M; m += g.stride) {
            v4u gt[16];
#pragma unroll
            for (int k = 0; k < 16; ++k) gt[k] = *(const v4u*)(tab + (size_t)ev[k >> 2][k & 3] * 128);
            f32x4 cc[4];
#pragma unroll
            for (int i = 0; i < 4; ++i) cc[i] = cf[i];
            const int mn = m + g.stride;
            if (mn < M) {
#pragma unroll
                for (int i = 0; i < 4; ++i) { ev[i] = *(const v4u*)(rtE + (size_t)mn * 128 + 16 * j + 4 * i); cf[i] = *(const f32x4*)(COEF + (size_t)mn * 128 + 16 * j + 4 * i); }
            }
            f32x2 acc[8];
#pragma unroll
            for (int i = 0; i < 8; ++i) acc[i] = (f32x2){0.f, 0.f};
#pragma unroll
            for (int k = 0; k < 16; ++k) { const float c = cc[k >> 2][k & 3]; const f32x2 cv2 = {c, c};
#pragma unroll
                for (int d = 0; d < 4; ++d) { const unsigned wd = gt[k][d]; acc[2 * d] += cv2 * cvt2_fp8(wd, false); acc[2 * d + 1] += cv2 * cvt2_fp8(wd, true); } }
            float a[16];
#pragma unroll
            for (int i = 0; i < 8; ++i) { a[2 * i] = acc[i].x; a[2 * i + 1] = acc[i].y; }
            float s8[8], s4[4];
#pragma unroll
            for (int c = 0; c < 8; ++c) { auto rr2 = __builtin_amdgcn_permlane32_swap(__float_as_uint(a[c]), __float_as_uint(a[c + 8]), false, false); s8[c] = __uint_as_float(rr2[0]) + __uint_as_float(rr2[1]); }
#pragma unroll
            for (int c = 0; c < 4; ++c) { auto rr2 = __builtin_amdgcn_permlane16_swap(__float_as_uint(s8[c]), __float_as_uint(s8[c + 4]), false, false); s4[c] = __uint_as_float(rr2[0]) + __uint_as_float(rr2[1]); }
            f32x2 res;
            { const float mine = jb0 ? s4[2] : s4[0], send = jb0 ? s4[0] : s4[2]; res.x = mine + dpp_f<0x128>(send); }
            { const float mine = jb0 ? s4[3] : s4[1], send = jb0 ? s4[1] : s4[3]; res.y = mine + dpp_f<0x128>(send); }
            const int col = 128 * r + 16 * sub + 2 * j;
            float* orow = F.out + (size_t)m * DM + col;
            const f32x2 h1 = *(const f32x2*)orow, g2 = *(const f32x2*)(mod + (size_t)(m / SEQ) * MODW + 5 * DM + col);
            *(f32x2*)orow = h1 + g2 * res;
        }
    }
}
struct Args { const float* in[N_IN]; float* out; unsigned char* ws; int ph_lo, ph_hi; };
constexpr int N_PHASES = 14;

__global__ void __launch_bounds__(NTHR, 2) fwd_kernel(Args args) {
    extern __shared__ __attribute__((aligned(16))) unsigned char lds_raw[];
    cg::grid_group grid = cg::this_grid();
    Ctx F;
    F.lds = (LAS unsigned char*)lds_raw;
    F.tid = threadIdx.x; F.lane = F.tid & 63; F.wave = __builtin_amdgcn_readfirstlane(F.tid >> 6);
    F.G = gridDim.x; F.gw = blockIdx.x * NWAVES + F.wave; F.NGW = F.G * NWAVES;
    F.in = args.in; F.out = args.out; F.ws = args.ws;
    const int lo = args.ph_lo, hi = args.ph_hi;
#define IN(k) (lo <= (k) && (k) < hi)
#define REP_MASK 0
#ifndef REP_MASK
#define REP_MASK 0
#endif
#define REPS(k) for (int rep_ = 0; rep_ < 1 + ((REP_MASK >> (k)) & 1); ++rep_)
#define SEAM(k) do { if (IN(k) && IN((k) + 1)) grid.sync(); } while (0)

    if (IN(0)) REPS(0) { p0_prologue(F); }
    SEAM(0);
    if (IN(1)) REPS(1) { norm_mod_rows(F, F.in[I_X], F.in[I_N1W], 0, DM, (bf16*)(F.ws + WS_XN)); }
    SEAM(1);
    if (IN(2)) REPS(2) {
        pg8::Gemm g{(const pg8::bf16_t*)(F.ws + WS_XN), (const pg8::bf16_t*)(F.ws + WS_WIN), M, INPP, DM};
        pg8::StaticOrder S; S.init(M, INPP, F.G, (int)blockIdx.x);
        pg8::EpiStoreBf16 E{(pg8::bf16_t*)(F.ws + WS_PROJ), INPP};
        pg8::gemm_phase<pg8::EpiStoreBf16, pg8::StaticOrder, true, true>(F.lds, g, S, E);
    }
    SEAM(2);
    if (IN(3)) REPS(3) { p3_lora(F); }
    SEAM(3);
    if (IN(4)) REPS(4) { p4_scans(F); }
    SEAM(4);
    if (IN(5)) { p5_post(F); }
    SEAM(5);
    if (IN(6)) REPS(6) {
        pg8::Gemm g{(const pg8::bf16_t*)(F.ws + WS_OY), (const pg8::bf16_t*)(F.ws + WS_WOUT), M, DM, DM};
        pg8::StaticOrder S; S.init(M, DM, F.G, (int)blockIdx.x);
        pg8::EpiResid E{F.in[I_X], (const float*)(F.ws + WS_MOD) + 2 * DM, F.out, DM, SEQ, MODW};
        pg8::gemm_phase<pg8::EpiResid, pg8::StaticOrder, true, true>(F.lds, g, S, E);
    }
    SEAM(6);
    if (IN(7)) REPS(7) { norm_mod_rows(F, F.out, F.in[I_N2W], 3 * DM, 4 * DM, (bf16*)(F.ws + WS_XN)); }
    SEAM(7);
    if (IN(8)) REPS(8) {
        pg8::Gemm g{(const pg8::bf16_t*)(F.ws + WS_XN), (const pg8::bf16_t*)(F.ws + WS_WQ), M, DM, DM};
        pg8::StaticOrder S; S.init(M, DM, F.G, (int)blockIdx.x);
        pg8::EpiStoreBf16 E{(pg8::bf16_t*)(F.ws + WS_Q), DM};
        pg8::gemm_phase<pg8::EpiStoreBf16, pg8::StaticOrder, true, true>(F.lds, g, S, E);
    }
    SEAM(8);
    if (IN(9)) { p9_route(F); }
    SEAM(9);
    if (IN(10)) { p10_peer_u(F); }
    SEAM(10);
    if (IN(11)) { p11_peer_coef(F); }
    SEAM(11);
    if (IN(12)) { p12_peer_v(F); }
    SEAM(12);
    if (IN(13)) { final_norm_rows(F, F.out, F.in[I_FNW], F.out); }
#undef IN
#undef SEAM
}

extern "C" void kernel_launch(void* const* d_in, const int* in_sizes, int n_in, void* d_out, int out_size, void* d_ws, size_t ws_size, hipStream_t stream) {
    static int grid = 0;
    if (grid == 0) {
        if (n_in != N_IN || in_sizes[0] != M * DM || out_size != M * DM || ws_size < WS_END) {
            fprintf(stderr, "kernel_launch: unexpected shapes: n_in %d in0 %d out %d ws %zu (need %zu)\n", n_in, n_in > 0 ? in_sizes[0] : -1, out_size, ws_size, (size_t)WS_END); grid = -1; return; }
        int dev = 0, cus = 0, per_cu = 0;
        if (hipGetDevice(&dev) != hipSuccess || hipDeviceGetAttribute(&cus, hipDeviceAttributeMultiprocessorCount, dev) != hipSuccess) { grid = -1; return; }
        if (hipFuncSetAttribute((const void*)fwd_kernel, hipFuncAttributeMaxDynamicSharedMemorySize, LDS_BYTES) != hipSuccess) { fprintf(stderr, "kernel_launch: hipFuncSetAttribute failed\n"); grid = -1; return; }
        if (hipOccupancyMaxActiveBlocksPerMultiprocessor(&per_cu, (const void*)fwd_kernel, NTHR, LDS_BYTES) != hipSuccess || per_cu < 1) { fprintf(stderr, "kernel_launch: occupancy query says %d blocks per CU\n", per_cu); per_cu = 1; }
        (void)hipGetLastError();
        grid = cus;
        fprintf(stderr, "kernel_launch: cus %d per_cu %d grid %d ws %zu\n", cus, per_cu, grid, ws_size);
    }
    if (grid < 0) return;
    (void)hipMemsetAsync((char*)d_ws + WS_CTL, 0, CTL_ZERO_BYTES, stream);
    Args a{};
    for (int i = 0; i < N_IN; ++i) a.in[i] = (const float*)d_in[i];
    a.out = (float*)d_out; a.ws = (unsigned char*)d_ws; a.ph_lo = 0; a.ph_hi = N_PHASES;
    void* kargs[] = {&a};
    hipError_t e = hipLaunchCooperativeKernel((const void*)fwd_kernel, dim3(grid), dim3(NTHR), kargs, LDS_BYTES, stream);
    if (e != hipSuccess) fprintf(stderr, "kernel_launch: cooperative launch failed: %s (grid %d)\n", hipGetErrorString(e), grid);
}
```

```cpp
#include <hip/hip_runtime.h>
#include <hip/hip_cooperative_groups.h>
#include <cstdio>
#include <cstdint>
namespace cg = cooperative_groups;
namespace pg8 {
#define PG8_LAS __attribute__((address_space(3)))
typedef unsigned short bf16_t;
typedef short bf16x8 __attribute__((ext_vector_type(8)));
typedef float f32x4 __attribute__((ext_vector_type(4)));
typedef unsigned u32x4 __attribute__((ext_vector_type(4)));
constexpr int BM = 256, BK = 64, HALF = 128, HTB = HALF * BK * 2  , STAGE_BYTES = 8 * HTB, NXCD = 8, WGM = 8;

__host__ __device__ __forceinline__ int lds_byte(int r, int c) { const int st = (r >> 4) * 2 + (c >> 5), rr = r & 15, cc = c & 31, ob = rr * 64 + cc * 2; return st * 1024 + (ob ^ (((ob >> 9) & 1) << 5)); }
__host__ __device__ __forceinline__ void stage_rc(int b, int& R, int& C) { const int st = b / 1024, sb = b % 1024, swz = sb ^ (((sb >> 9) & 1) << 5); R = (st >> 1) * 16 + swz / 64; C = (st & 1) * 32 + (swz % 64) / 2; }
__host__ __device__ __forceinline__ int perm32(int rho) { const int n = rho >> 4, i = rho & 15; return 8 * (i >> 2) + 4 * n + (i & 3); }

struct Unit { int pm, pn; };
struct Gemm { const bf16_t* A; const bf16_t* Bt; int M, N, K; };

struct StaticOrder {
    int nM, nN, nwg, G, c;
    __host__ __device__ void init(int M, int N, int G_, int c_) { nM = M / BM; nN = N / BM; nwg = nM * nN; G = G_; c = c_; }
    __host__ __device__ bool next(int i, Unit& u) const {
        const long L = (long)i * G + c; if (L >= nwg) return false;
        int wgid = (int)L; { const int q = nwg / NXCD, r = nwg % NXCD, xcd = wgid % NXCD, off = wgid / NXCD; wgid = (xcd < r ? xcd * (q + 1) : r * (q + 1) + (xcd - r) * q) + off; }
        const int nig = WGM * nN, gid = wgid / nig, fm = gid * WGM, gsz = (nM - fm) < WGM ? (nM - fm) : WGM;
        u.pm = fm + ((wgid % nig) % gsz); u.pn = (wgid % nig) / gsz; return true;
    }
    __device__ __forceinline__ void a_ready(const Unit&) const {}
    __device__ __forceinline__ void done(const Unit&) const {}
};
__device__ __forceinline__ unsigned cvt_pk_bf16(float lo, float hi) { unsigned r; asm volatile("v_cvt_pk_bf16_f32 %0, %1, %2" : "=v"(r) : "v"(lo), "v"(hi)); return r; }
struct EpiStoreBf16 {
    static constexpr bool PERM = true, AFTER_DRAIN = false;
    bf16_t* O; int ldc;
    __device__ __forceinline__ void operator()(const f32x4 (&acc)[2][2][4][2], const Unit& u, int wr, int wc, int fr, int fq) const {
        const int row0 = u.pm * BM + wr * 64 + fr; const int col0 = u.pn * BM + wc * 32 + 8 * fq;
#pragma unroll
        for (int ai = 0; ai < 2; ++ai)
#pragma unroll
            for (int m = 0; m < 4; ++m) { bf16_t* rowp = O + (size_t)(row0 + ai * HALF + m * 16) * ldc + col0;
#pragma unroll
                for (int bj = 0; bj < 2; ++bj) { const f32x4 v0 = acc[ai][bj][m][0], v1 = acc[ai][bj][m][1];
                    u32x4 w; w.x = cvt_pk_bf16(v0[0], v0[1]); w.y = cvt_pk_bf16(v0[2], v0[3]); w.z = cvt_pk_bf16(v1[0], v1[1]); w.w = cvt_pk_bf16(v1[2], v1[3]);
                    *(u32x4*)(rowp + bj * HALF) = w; } }
    }
};
struct EpiResid {
    static constexpr bool PERM = true, AFTER_DRAIN = false;
    const float* X; const float* gate; float* O; int ldc; int rows_per_batch; int gstride;
    __device__ __forceinline__ void operator()(const f32x4 (&acc)[2][2][4][2], const Unit& u, int wr, int wc, int fr, int fq) const {
        const int row0 = u.pm * BM + wr * 64 + fr; const int col0 = u.pn * BM + wc * 32 + 8 * fq;
        const float* g = gate + (size_t)((u.pm * BM) / rows_per_batch) * gstride + col0;
        f32x4 gv[2][2];
#pragma unroll
        for (int bj = 0; bj < 2; ++bj)
#pragma unroll
            for (int n = 0; n < 2; ++n) gv[bj][n] = *(const f32x4*)(g + bj * HALF + 4 * n);
#pragma unroll
        for (int ai = 0; ai < 2; ++ai)
#pragma unroll
            for (int m = 0; m < 4; ++m) { const size_t off = (size_t)(row0 + ai * HALF + m * 16) * ldc + col0;
#pragma unroll
                for (int bj = 0; bj < 2; ++bj)
#pragma unroll
                    for (int n = 0; n < 2; ++n) { const f32x4 xv = *(const f32x4*)(X + off + bj * HALF + 4 * n);
                        *(f32x4*)(O + off + bj * HALF + 4 * n) = xv + gv[bj][n] * acc[ai][bj][m][n]; } }
    }
};
template <class Epi, class Sched, bool ALIGN_EPI = false, bool SP2 = false>
__device__ __forceinline__ void gemm_phase(PG8_LAS unsigned char* lds, const Gemm g, const Sched& S, const Epi& E) {
    const int tid = threadIdx.x, wid = __builtin_amdgcn_readfirstlane(tid >> 6), lane = tid & 63, wr = wid >> 2, wc = wid & 3, fr = lane & 15, fq = lane >> 4;
    const int K = g.K, nt = K / BK;
    unsigned voffA[2], voffB[2];
#pragma unroll
    for (int i = 0; i < 2; ++i) { int R, C; stage_rc(tid * 16 + i * 8192, R, C); const int Rb = Epi::PERM ? ((R & ~31) + perm32(R & 31)) : R;
        voffA[i] = (unsigned)(R * K + C) * 2u; voffB[i] = (unsigned)(Rb * K + C) * 2u; }
    const size_t kstep = (size_t)(BK * 2);
    const size_t hstep = (size_t)HALF * K * 2;
    const size_t tstep = 2 * hstep;
    const unsigned ldsw = (unsigned)wid * 1024u;
    const int aoff = lds_byte(wr * 64 + fr, fq * 8), boff = lds_byte(wc * 32 + fr, fq * 8);
#define PG8_SA(b, h) (((b) * 2 + (h)) * HTB)
#define PG8_SB(b, h) ((4 + (b) * 2 + (h)) * HTB)
#define PG8_STAGE(bufoff, gbase, voff) do { _Pragma("unroll") for (int _i = 0; _i < 2; ++_i) \
        __builtin_amdgcn_global_load_lds((const unsigned*)((const char*)(gbase) + (voff)[_i]), (PG8_LAS unsigned*)(lds + (bufoff) + ldsw + _i * 8192), 16, 0, 0); } while (0)
#define PG8_LDA(dst, b, h) do { _Pragma("unroll") for (int m = 0; m < 4; ++m) _Pragma("unroll") for (int k = 0; k < 2; ++k) dst[m][k] = *(const PG8_LAS bf16x8*)(lds + PG8_SA(b, h) + aoff + m * 2048 + k * 1024); } while (0)
#define PG8_LDB(dst, b, h) do { _Pragma("unroll") for (int n = 0; n < 2; ++n) _Pragma("unroll") for (int k = 0; k < 2; ++k) dst[n][k] = *(const PG8_LAS bf16x8*)(lds + PG8_SB(b, h) + boff + n * 2048 + k * 1024); } while (0)
#define PG8_MMA(ai, bj, At, Bt) do { __builtin_amdgcn_s_setprio(1); _Pragma("unroll") for (int m = 0; m < 4; ++m) _Pragma("unroll") for (int n = 0; n < 2; ++n) _Pragma("unroll") for (int k = 0; k < 2; ++k) \
        acc[ai][bj][m][n] = __builtin_amdgcn_mfma_f32_16x16x32_bf16(Bt[n][k], At[m][k], acc[ai][bj][m][n], 0, 0, 0); __builtin_amdgcn_s_setprio(0); } while (0)
#define PG8_WAIT_V(n) asm volatile("s_waitcnt vmcnt(" #n ")" ::: "memory")
#define PG8_WAIT_L(n) asm volatile("s_waitcnt lgkmcnt(" #n ")" ::: "memory")
#define PG8_BAR __builtin_amdgcn_s_barrier()
#define PG8_SCHED __builtin_amdgcn_sched_barrier(0)
    Unit cur, nxt; int ui = 0;
    if (!S.next(0, cur)) return;
    f32x4 acc[2][2][4][2];
#pragma unroll
    for (int a = 0; a < 2; ++a)
#pragma unroll
        for (int b = 0; b < 2; ++b)
#pragma unroll
            for (int m = 0; m < 4; ++m)
#pragma unroll
                for (int n = 0; n < 2; ++n) acc[a][b][m][n] = (f32x4){0.f, 0.f, 0.f, 0.f};
    bf16x8 At[4][2], B0[2][2], B1[2][2];
    const char* cA = (const char*)g.A + (size_t)cur.pm * tstep; const char* cB = (const char*)g.Bt + (size_t)cur.pn * tstep;
    S.a_ready(cur);
    if constexpr (SP2) {
        PG8_STAGE(PG8_SB(0, 0), cB, voffB); PG8_STAGE(PG8_SB(0, 1), cB + hstep, voffB); PG8_STAGE(PG8_SA(0, 0), cA, voffA); PG8_STAGE(PG8_SA(0, 1), cA + hstep, voffA);
        if (wr == 1) PG8_BAR;
        PG8_WAIT_V(2); PG8_BAR;
        PG8_STAGE(PG8_SB(1, 0), cB + kstep, voffB); PG8_STAGE(PG8_SA(1, 0), cA + kstep, voffA); PG8_STAGE(PG8_SB(1, 1), cB + hstep + kstep, voffB);
        PG8_WAIT_V(6); PG8_BAR;
    } else {
        PG8_STAGE(PG8_SB(0, 0), cB, voffB); PG8_STAGE(PG8_SA(0, 0), cA, voffA); PG8_STAGE(PG8_SB(0, 1), cB + hstep, voffB); PG8_STAGE(PG8_SA(0, 1), cA + hstep, voffA);
        if (wr == 1) PG8_BAR;
        PG8_WAIT_V(4); PG8_BAR;
        PG8_STAGE(PG8_SB(1, 0), cB + kstep, voffB); PG8_STAGE(PG8_SA(1, 0), cA + kstep, voffA); PG8_STAGE(PG8_SB(1, 1), cB + hstep + kstep, voffB);
        PG8_WAIT_V(6); PG8_BAR;
    }
    for (;;) {
        const bool has_next = S.next(ui + 1, nxt);
        const char* nA = has_next ? (const char*)g.A + (size_t)nxt.pm * tstep : cA; const char* nB = has_next ? (const char*)g.Bt + (size_t)nxt.pn * tstep : cB;
        for (int t = 0; t < nt; t += 2) {
            const bool last = (t == nt - 2);
            const char* a1 = cA + (size_t)(t + 1) * kstep;
            const char* a2 = last ? nA : cA + (size_t)(t + 2) * kstep; const char* b2 = last ? nB : cB + (size_t)(t + 2) * kstep;
            const char* a3 = a2 + kstep; const char* b3 = b2 + kstep;
            if (last && has_next) S.a_ready(nxt);
            if constexpr (SP2) {
            PG8_LDB(B0, 0, 0); PG8_LDB(B1, 0, 1); PG8_SCHED; PG8_LDA(At, 0, 0); PG8_STAGE(PG8_SA(1, 1), a1 + hstep, voffA);
            PG8_WAIT_V(8); PG8_WAIT_L(0); PG8_BAR; PG8_MMA(0, 0, At, B0); PG8_MMA(0, 1, At, B1); PG8_BAR; PG8_SCHED;
            PG8_LDA(At, 0, 1); PG8_STAGE(PG8_SB(0, 0), b2, voffB); PG8_STAGE(PG8_SB(0, 1), b2 + hstep, voffB); PG8_STAGE(PG8_SA(0, 0), a2, voffA);
            PG8_WAIT_V(8); PG8_WAIT_L(0); PG8_BAR; PG8_MMA(1, 0, At, B0); PG8_MMA(1, 1, At, B1); PG8_BAR; PG8_SCHED;
            PG8_LDB(B0, 1, 0); PG8_LDB(B1, 1, 1); PG8_SCHED; PG8_LDA(At, 1, 0); PG8_STAGE(PG8_SA(0, 1), a2 + hstep, voffA);
            PG8_WAIT_V(8); PG8_WAIT_L(0); PG8_BAR; PG8_MMA(0, 0, At, B0); PG8_MMA(0, 1, At, B1); PG8_BAR; PG8_SCHED;
            PG8_LDA(At, 1, 1); PG8_STAGE(PG8_SB(1, 0), b3, voffB); PG8_STAGE(PG8_SB(1, 1), b3 + hstep, voffB); PG8_STAGE(PG8_SA(1, 0), a3, voffA);
            PG8_WAIT_V(8); PG8_WAIT_L(0); PG8_BAR; PG8_MMA(1, 0, At, B0); PG8_MMA(1, 1, At, B1); PG8_BAR; PG8_SCHED;
            } else {
            PG8_LDB(B0, 0, 0); PG8_SCHED; PG8_LDA(At, 0, 0); PG8_STAGE(PG8_SA(1, 1), a1 + hstep, voffA);
            PG8_WAIT_L(8); PG8_BAR; PG8_WAIT_L(0); PG8_MMA(0, 0, At, B0); PG8_BAR; PG8_SCHED;
            PG8_LDB(B1, 0, 1); PG8_STAGE(PG8_SB(0, 0), b2, voffB);
            PG8_BAR; PG8_WAIT_L(0); PG8_MMA(0, 1, At, B1); PG8_BAR;
            PG8_LDA(At, 0, 1); PG8_STAGE(PG8_SA(0, 0), a2, voffA);
            PG8_BAR; PG8_WAIT_L(0); PG8_MMA(1, 0, At, B0); PG8_BAR; PG8_SCHED;
            PG8_STAGE(PG8_SB(0, 1), b2 + hstep, voffB);
            PG8_WAIT_V(6); PG8_BAR; PG8_MMA(1, 1, At, B1); PG8_BAR;
            PG8_LDB(B0, 1, 0); PG8_SCHED; PG8_LDA(At, 1, 0); PG8_STAGE(PG8_SA(0, 1), a2 + hstep, voffA);
            PG8_WAIT_L(8); PG8_BAR; PG8_WAIT_L(0); PG8_MMA(0, 0, At, B0); PG8_BAR; PG8_SCHED;
            PG8_LDB(B1, 1, 1); PG8_STAGE(PG8_SB(1, 0), b3, voffB);
            PG8_BAR; PG8_WAIT_L(0); PG8_MMA(0, 1, At, B1); PG8_BAR;
            PG8_LDA(At, 1, 1); PG8_STAGE(PG8_SA(1, 0), a3, voffA);
            PG8_BAR; PG8_WAIT_L(0); PG8_MMA(1, 0, At, B0); PG8_BAR; PG8_SCHED;
            PG8_STAGE(PG8_SB(1, 1), b3 + hstep, voffB);
            PG8_WAIT_V(6); PG8_BAR; PG8_MMA(1, 1, At, B1); PG8_BAR;
            }
        }
        if constexpr (ALIGN_EPI) { if (wr == 0) PG8_BAR; }
        if constexpr (!Epi::AFTER_DRAIN) { E(acc, cur, wr, wc, fr, fq); S.done(cur); }
        if (!has_next) break;
#pragma unroll
        for (int a = 0; a < 2; ++a)
#pragma unroll
            for (int b = 0; b < 2; ++b)
#pragma unroll
                for (int m = 0; m < 4; ++m)
#pragma unroll
                    for (int n = 0; n < 2; ++n) acc[a][b][m][n] = (f32x4){0.f, 0.f, 0.f, 0.f};
        cur = nxt; cA = nA; cB = nB; ++ui;
        if constexpr (ALIGN_EPI) { if (wr == 1) PG8_BAR; }
    }
    PG8_WAIT_V(0);
    if constexpr (!ALIGN_EPI) { if (wr == 0) PG8_BAR; }
    PG8_BAR;
    if constexpr (Epi::AFTER_DRAIN) { E.fused(acc, cur, wr, wc, fr, fq, lds, wid, lane); S.done(cur); }
#undef PG8_SA
#undef PG8_SB
#undef PG8_STAGE
#undef PG8_LDA
#undef PG8_LDB
#undef PG8_MMA
#undef PG8_WAIT_V
#undef PG8_WAIT_L
#undef PG8_BAR
#undef PG8_SCHED
}
}
#define GAS __attribute__((address_space(1)))
#define LAS __attribute__((address_space(3)))
typedef unsigned short bf16;
typedef unsigned v4u __attribute__((ext_vector_type(4)));
typedef unsigned v2u __attribute__((ext_vector_type(2)));
typedef float f32x4 __attribute__((ext_vector_type(4)));
typedef float f32x2 __attribute__((ext_vector_type(2)));
typedef short bf16x8 __attribute__((ext_vector_type(8)));
typedef __bf16 bf16x2_t __attribute__((ext_vector_type(2)));

constexpr int NWAVES = 8, NTHR = 512;
constexpr int DM = 2048, NB = 4, SEQ = 8192, M = NB * SEQ;
constexpr int RW = 1024, RHEADS = 16, HD = 64;
constexpr int L_W = 64, L_A = 64, L_G = 160;
constexpr int INP = 5936, INPP = 6144;
constexpr int C_R = 0, C_K = 1024, C_V = 2048, C_WD = 3072, C_AD = 3136, C_GD = 3200, C_Z = 3360, C_XBC = 4384, C_DT = 5920;
constexpr int MODW = 6 * DM;
constexpr int NEXP = 16384;
constexpr float RMS_EPS = 1e-6f;

enum { I_X = 0, I_C, I_ADAW, I_ADAB, I_N1W, I_WIN, I_MU, I_W0, I_WUP, I_A0, I_AUP, I_GUP, I_KK, I_KA, I_RK, I_LNW, I_LNB,
       I_CONVW, I_CONVB, I_DTB, I_ALOG, I_DSK, I_MNW, I_WOUT, I_N2W, I_WQ, I_KEYS, I_PU, I_PV, I_FNW, N_IN };

constexpr size_t MiB = 1u << 20;
constexpr size_t WS_CTL = 0, CTL_ZERO_BYTES = 1 * MiB;
constexpr size_t WS_MOD = 1 * MiB;
constexpr size_t WS_WIN = 2 * MiB, WS_WOUT = 26 * MiB, WS_WQ = 34 * MiB, WS_KEYS = 42 * MiB;
constexpr size_t WS_WUPT = 43 * MiB, WS_AUPT = 43 * MiB + 256 * 1024, WS_GUPT = 43 * MiB + 512 * 1024;
constexpr size_t WS_PU8 = 44 * MiB, WS_PV8 = 76 * MiB;
constexpr size_t WS_USC = 108 * MiB, WS_VSC = 108 * MiB + 65536;
constexpr size_t WS_XN = 172 * MiB;
constexpr size_t WS_LW = WS_XN, WS_AA = WS_XN + 64 * MiB;
constexpr size_t WS_PROJ = 300 * MiB;
constexpr size_t WS_Q = WS_PROJ;
constexpr size_t WS_GG = 684 * MiB;
constexpr size_t WS_PD = WS_PROJ + 128 * MiB;
constexpr size_t WS_RTE = 684 * MiB, WS_RTG = 700 * MiB, WS_COEF = 716 * MiB;
constexpr size_t WS_OY = 748 * MiB;
constexpr size_t WS_END = 876 * MiB;

constexpr int RING_BYTES = 131072, LDS_BYTES = 147456;

#define LDS_WAIT() asm volatile("s_waitcnt lgkmcnt(0)" ::: "memory")
#define VM_WAIT() asm volatile("s_waitcnt vmcnt(0)" ::: "memory")
__device__ __forceinline__ unsigned pk2(float lo, float hi) { f32x2 v = {lo, hi}; bf16x2_t b = __builtin_convertvector(v, bf16x2_t); return __builtin_bit_cast(unsigned, b); }
__device__ __forceinline__ float bflo(unsigned u) { return __uint_as_float(u << 16); }
__device__ __forceinline__ float bfhi(unsigned u) { return __uint_as_float(u & 0xffff0000u); }
__device__ __forceinline__ float bf1(bf16 h) { return __uint_as_float((unsigned)h << 16); }
__device__ __forceinline__ float wave_sum(float v) {
#pragma unroll
    for (int o = 1; o < 64; o <<= 1) v += __shfl_xor(v, o);
    return v;
}
__device__ __forceinline__ float rcp_f(float v) { return __builtin_amdgcn_rcpf(v); }
__device__ __forceinline__ float silu_f(float v) { return v * rcp_f(1.f + __expf(-v)); }
__device__ __forceinline__ float sigmoid_f(float v) { return rcp_f(1.f + __expf(-v)); }

struct Ctx {
    LAS unsigned char* lds;
    int tid, lane, wave, G, gw, NGW;
    const float* const* in;
    float* out; unsigned char* ws;
};

__device__ __forceinline__ void transpose_item(const float* W, int K, int N, bf16* WT, int ldt, int nrows_out, LAS float* scr, int kb, int nb, int lane) {
    const int k0 = 64 * kb, n0 = 32 * nb;
#pragma unroll 8
    for (int i = 0; i < 32; ++i) { const int kk = 2 * i + (lane >> 5), k = k0 + kk, n = n0 + (lane & 31);
        scr[kk * 33 + (lane & 31)] = (k < K && n < N) ? W[(size_t)k * N + n] : 0.f; }
    LDS_WAIT(); asm volatile("" ::: "memory");
    const int c = lane & 7;
#pragma unroll
    for (int j = 0; j < 4; ++j) { const int n = (lane >> 3) + 8 * j; const LAS float* s = scr + (8 * c) * 33 + n;
        v4u o; o.x = pk2(s[0 * 33], s[1 * 33]); o.y = pk2(s[2 * 33], s[3 * 33]); o.z = pk2(s[4 * 33], s[5 * 33]); o.w = pk2(s[6 * 33], s[7 * 33]);
        if (n0 + n < nrows_out && k0 + 8 * c + 8 <= ldt) *(v4u*)(WT + (size_t)(n0 + n) * ldt + k0 + 8 * c) = o; }
    LDS_WAIT(); asm volatile("" ::: "memory");
}
__device__ __forceinline__ void transpose_all(const float* W, int K, int N, bf16* WT, int ldt, int nrows_out, LAS float* scr, int gw, int NGW, int lane) {
    const int nkb = (K + 63) / 64, nnb = nrows_out / 32, nit = nkb * nnb;
    for (int it = gw; it < nit; it += NGW) transpose_item(W, K, N, WT, ldt, nrows_out, scr, it / nnb, it % nnb, lane);
}
__device__ __forceinline__ void convert_all(const float* src, bf16* dst, size_t n8, int gw, int NGW, int lane) {
    const f32x4* s4 = (const f32x4*)src; v4u* d4 = (v4u*)dst;
    for (size_t i = (size_t)gw * 64 + lane; i < n8; i += (size_t)NGW * 64) {
        const f32x4 a = __builtin_nontemporal_load(s4 + 2 * i), b = __builtin_nontemporal_load(s4 + 2 * i + 1);
        v4u o; o.x = pk2(a.x, a.y); o.y = pk2(a.z, a.w); o.z = pk2(b.x, b.y); o.w = pk2(b.z, b.w);
        d4[i] = o; }
}
__device__ __forceinline__ void quantize_rows_fp8(const float* src, unsigned char* dst8, float* scales, int gw, int NGW, int lane) {
    for (int e = gw; e < NEXP; e += NGW) {
        const f32x4* s4 = (const f32x4*)(src + (size_t)e * DM) + lane;
        f32x4 v[8]; float am = 0.f;
#pragma unroll
        for (int i = 0; i < 8; ++i) { v[i] = __builtin_nontemporal_load(s4 + 64 * i);
            am = fmaxf(fmaxf(am, fmaxf(fabsf(v[i].x), fabsf(v[i].y))), fmaxf(fabsf(v[i].z), fabsf(v[i].w))); }
#pragma unroll
        for (int o = 1; o < 64; o <<= 1) am = fmaxf(am, __shfl_xor(am, o));
        am = fmaxf(am, 1e-30f);
        const float inv = 440.f / am;
#pragma unroll
        for (int i = 0; i < 8; ++i) { int w = __builtin_amdgcn_cvt_pk_fp8_f32(v[i].x * inv, v[i].y * inv, 0, false); w = __builtin_amdgcn_cvt_pk_fp8_f32(v[i].z * inv, v[i].w * inv, w, true);
            const int seg = 2 * i + (lane >> 5);
            *(int*)(dst8 + (size_t)seg * ((size_t)NEXP * 128) + (size_t)e * 128 + 4 * (lane & 31)) = w; }
        if (lane == 0) scales[e] = am * (1.f / 440.f);
    }
}
__device__ __forceinline__ void p0_prologue(const Ctx& F) {
    __syncthreads();
    if (blockIdx.x < MODW / 64) {
        LAS float* sc = (LAS float*)F.lds;
        LAS float* red = sc + NB * DM;
        const float* c = F.in[I_C];
        for (int i = F.tid; i < NB * DM; i += NTHR) sc[i] = silu_f(c[i]);
        __syncthreads();
        const int j = blockIdx.x * 64 + F.lane;
        const float* wp = F.in[I_ADAW] + (size_t)(F.wave * 256) * MODW + j;
        float a0 = 0.f, a1 = 0.f, a2 = 0.f, a3 = 0.f;
#pragma unroll 16
        for (int kk = 0; kk < 256; ++kk) { const float w = wp[(size_t)kk * MODW]; const int k = F.wave * 256 + kk;
            a0 += sc[k] * w; a1 += sc[DM + k] * w; a2 += sc[2 * DM + k] * w; a3 += sc[3 * DM + k] * w; }
        red[(F.wave * 4 + 0) * 64 + F.lane] = a0; red[(F.wave * 4 + 1) * 64 + F.lane] = a1; red[(F.wave * 4 + 2) * 64 + F.lane] = a2; red[(F.wave * 4 + 3) * 64 + F.lane] = a3;
        __syncthreads();
        if (F.tid < 256) { const int b = F.tid >> 6, l = F.tid & 63; float s = F.in[I_ADAB][blockIdx.x * 64 + l];
#pragma unroll
            for (int w = 0; w < 8; ++w) s += red[(w * 4 + b) * 64 + l];
            ((float*)(F.ws + WS_MOD))[b * MODW + blockIdx.x * 64 + l] = s; }
        __syncthreads();
    }
    LAS float* scr = (LAS float*)(F.lds + F.wave * 16384);
    transpose_all(F.in[I_WIN], DM, INP, (bf16*)(F.ws + WS_WIN), DM, INPP, scr, F.gw, F.NGW, F.lane);
    transpose_all(F.in[I_WOUT], DM, DM, (bf16*)(F.ws + WS_WOUT), DM, DM, scr, F.gw, F.NGW, F.lane);
    transpose_all(F.in[I_WQ], DM, DM, (bf16*)(F.ws + WS_WQ), DM, DM, scr, F.gw, F.NGW, F.lane);
    transpose_all(F.in[I_WUP], L_W, RW, (bf16*)(F.ws + WS_WUPT), L_W, RW, scr, F.gw, F.NGW, F.lane);
    transpose_all(F.in[I_AUP], L_A, RW, (bf16*)(F.ws + WS_AUPT), L_A, RW, scr, F.gw, F.NGW, F.lane);
    transpose_all(F.in[I_GUP], L_G, RW, (bf16*)(F.ws + WS_GUPT), L_G, RW, scr, F.gw, F.NGW, F.lane);
    convert_all(F.in[I_KEYS], (bf16*)(F.ws + WS_KEYS), (size_t)16 * 128 * 128 / 8, F.gw, F.NGW, F.lane);
    quantize_rows_fp8(F.in[I_PU], F.ws + WS_PU8, (float*)(F.ws + WS_USC), F.gw, F.NGW, F.lane);
    quantize_rows_fp8(F.in[I_PV], F.ws + WS_PV8, (float*)(F.ws + WS_VSC), F.gw, F.NGW, F.lane);
}

__device__ __forceinline__ void norm_mod_rows(const Ctx& F, const float* X, const float* nw, int shift_off, int scale_off, bf16* XN) {
    const float* mod = (const float*)(F.ws + WS_MOD);
    for (int m = F.gw; m < M; m += F.NGW) {
        const int b = m / SEQ;
        const f32x4* xr = (const f32x4*)(X + (size_t)m * DM) + F.lane;
        f32x4 v[8]; float s = 0.f;
#pragma unroll
        for (int j = 0; j < 8; ++j) { v[j] = xr[64 * j]; s += (v[j].x * v[j].x + v[j].y * v[j].y) + (v[j].z * v[j].z + v[j].w * v[j].w); }
        const float rstd = rsqrtf(wave_sum(s) * (1.f / DM) + RMS_EPS);
        const f32x4* wp = (const f32x4*)nw + F.lane;
        const f32x4* shp = (const f32x4*)(mod + (size_t)b * MODW + shift_off) + F.lane;
        const f32x4* scp = (const f32x4*)(mod + (size_t)b * MODW + scale_off) + F.lane;
        v2u* o = (v2u*)(XN + (size_t)m * DM) + F.lane;
#pragma unroll
        for (int j = 0; j < 8; ++j) { const f32x4 w = wp[64 * j], a = scp[64 * j], c = shp[64 * j];
            const f32x4 r = (v[j] * rstd) * w * (a + 1.f) + c;
            v2u p; p.x = pk2(r.x, r.y); p.y = pk2(r.z, r.w); o[64 * j] = p; }
    }
}
__device__ __forceinline__ void final_norm_rows(const Ctx& F, const float* H, const float* nw, float* O) {
    for (int m = F.gw; m < M; m += F.NGW) {
        const f32x4* xr = (const f32x4*)(H + (size_t)m * DM) + F.lane;
        f32x4 v[8]; float s = 0.f;
#pragma unroll
        for (int j = 0; j < 8; ++j) { v[j] = xr[64 * j]; s += (v[j].x * v[j].x + v[j].y * v[j].y) + (v[j].z * v[j].z + v[j].w * v[j].w); }
        const float rstd = rsqrtf(wave_sum(s) * (1.f / DM) + RMS_EPS);
        const f32x4* wp = (const f32x4*)nw + F.lane;
        f32x4* o = (f32x4*)(O + (size_t)m * DM) + F.lane;
#pragma unroll
        for (int j = 0; j < 8; ++j) o[64 * j] = (v[j] * rstd) * wp[64 * j];
    }
}

#define LO2(v) __builtin_shufflevector((v), (v), 0, 1)
#define HI2(v) __builtin_shufflevector((v), (v), 2, 3)
template <int CTRL> __device__ __forceinline__ float dpp_f(float x) { return __builtin_bit_cast(float, __builtin_amdgcn_mov_dpp(__builtin_bit_cast(int, x), CTRL, 0xf, 0xf, true)); }
__device__ __forceinline__ float rowsum16(float x) { x += dpp_f<0xB1>(x); x += dpp_f<0x4E>(x); x += dpp_f<0x124>(x); x += dpp_f<0x128>(x); return x; }
__device__ __forceinline__ float quadsum(float x) { x += dpp_f<0xB1>(x); x += dpp_f<0x4E>(x); return x; }

__device__ __forceinline__ float treduce16(const float (&p)[16], bool b0, bool b1, bool b2, bool b3) {
    float a[8], bq[4], c2[2];
#pragma unroll
    for (int j = 0; j < 8; ++j) { const float mine = b3 ? p[j + 8] : p[j], send = b3 ? p[j] : p[j + 8]; a[j] = mine + dpp_f<0x128>(send); }
#pragma unroll
    for (int j = 0; j < 4; ++j) { const float mine = b2 ? a[j + 4] : a[j], send = b2 ? a[j] : a[j + 4]; const float up = dpp_f<0x104>(send), dn = dpp_f<0x114>(send); bq[j] = mine + (b2 ? dn : up); }
#pragma unroll
    for (int j = 0; j < 2; ++j) { const float mine = b1 ? bq[j + 2] : bq[j], send = b1 ? bq[j] : bq[j + 2]; c2[j] = mine + dpp_f<0x4E>(send); }
    const float mine = b0 ? c2[1] : c2[0], send = b0 ? c2[0] : c2[1];
    return mine + dpp_f<0xB1>(send);
}
__device__ __forceinline__ float wave_sum_dpp(float v) { v = rowsum16(v); v += __shfl_xor(v, 16); v += __shfl_xor(v, 32); return v; }
__device__ __forceinline__ void unpack8(const v4u p, float (&e)[8]) { e[0] = bflo(p.x); e[1] = bfhi(p.x); e[2] = bflo(p.y); e[3] = bfhi(p.y); e[4] = bflo(p.z); e[5] = bfhi(p.z); e[6] = bflo(p.w); e[7] = bfhi(p.w); }
__device__ __forceinline__ v4u pack8(const float (&e)[8]) { v4u o; o.x = pk2(e[0], e[1]); o.y = pk2(e[2], e[3]); o.z = pk2(e[4], e[5]); o.w = pk2(e[6], e[7]); return o; }

__device__ __forceinline__ void p3_lora(const Ctx& F) {
    const bf16* PROJ = (const bf16*)(F.ws + WS_PROJ);
    const bf16* WUPT = (const bf16*)(F.ws + WS_WUPT); const bf16* AUPT = (const bf16*)(F.ws + WS_AUPT); const bf16* GUPT = (const bf16*)(F.ws + WS_GUPT);
    bf16* LW = (bf16*)(F.ws + WS_LW); bf16* AA = (bf16*)(F.ws + WS_AA); bf16* GG = (bf16*)(F.ws + WS_GG);
    const float* mu = F.in[I_MU]; const float* w0 = F.in[I_W0]; const float* a0 = F.in[I_A0];
    const int r16 = F.lane & 15, q = F.lane >> 4;
    for (int mt = F.gw; mt < M / 16; mt += F.NGW) {
        const int m = mt * 16 + r16; const bool first = (m % SEQ) == 0;
        const bf16* row = PROJ + (size_t)m * INPP;
        bf16x8 af[9];
#pragma unroll
        for (int s = 0; s < 9; ++s) {
            const int col = ((s < 2) ? (C_WD + 32 * s) : (s < 4) ? (C_AD + 32 * (s - 2)) : (C_GD + 32 * (s - 4))) + 8 * q;
            const v4u pc = *(const v4u*)(row + col);
            v4u pp = {0u, 0u, 0u, 0u}; if (!first) pp = *(const v4u*)(row - INPP + col);
            const f32x4 m0 = *(const f32x4*)(mu + col), m1 = *(const f32x4*)(mu + col + 4);
            float c[8], p[8], e[8]; unpack8(pc, c); unpack8(pp, p);
            const float mm[8] = {m0.x, m0.y, m0.z, m0.w, m1.x, m1.y, m1.z, m1.w};
#pragma unroll
            for (int j = 0; j < 8; ++j) { float v = c[j] + (p[j] - c[j]) * mm[j];
                if (s < 2) { const float t = __expf(2.f * v); v = 1.f - 2.f * rcp_f(t + 1.f); }
                else if (s >= 4) v = sigmoid_f(v);
                e[j] = v; }
            af[s] = __builtin_bit_cast(bf16x8, pack8(e));
        }
        for (int nt = 0; nt < RW / 16; ++nt) {
            const int n0 = nt * 16;
            f32x4 acc0 = {0.f, 0.f, 0.f, 0.f}, acc1 = acc0, acc2 = acc0;
            const bf16* wu = WUPT + (size_t)(n0 + r16) * L_W + 8 * q;
            const bf16* au = AUPT + (size_t)(n0 + r16) * L_A + 8 * q;
            const bf16* gu = GUPT + (size_t)(n0 + r16) * L_G + 8 * q;
#pragma unroll
            for (int s = 0; s < 2; ++s) acc0 = __builtin_amdgcn_mfma_f32_16x16x32_bf16(*(const bf16x8*)(wu + 32 * s), af[s], acc0, 0, 0, 0);
#pragma unroll
            for (int s = 0; s < 2; ++s) acc1 = __builtin_amdgcn_mfma_f32_16x16x32_bf16(*(const bf16x8*)(au + 32 * s), af[2 + s], acc1, 0, 0, 0);
#pragma unroll
            for (int s = 0; s < 5; ++s) acc2 = __builtin_amdgcn_mfma_f32_16x16x32_bf16(*(const bf16x8*)(gu + 32 * s), af[4 + s], acc2, 0, 0, 0);
            const int n = n0 + 4 * q;
            const f32x4 w0v = *(const f32x4*)(w0 + n), a0v = *(const f32x4*)(a0 + n);
            v2u o0, o1, o2;
            o0.x = pk2(-0.60653066f * sigmoid_f(acc0[0] + w0v.x), -0.60653066f * sigmoid_f(acc0[1] + w0v.y));
            o0.y = pk2(-0.60653066f * sigmoid_f(acc0[2] + w0v.z), -0.60653066f * sigmoid_f(acc0[3] + w0v.w));
            o1.x = pk2(sigmoid_f(acc1[0] + a0v.x), sigmoid_f(acc1[1] + a0v.y)); o1.y = pk2(sigmoid_f(acc1[2] + a0v.z), sigmoid_f(acc1[3] + a0v.w));
            o2.x = pk2(acc2[0], acc2[1]); o2.y = pk2(acc2[2], acc2[3]);
            *(v2u*)(LW + (size_t)m * RW + n) = o0; *(v2u*)(AA + (size_t)m * RW + n) = o1; *(v2u*)(GG + (size_t)m * RW + n) = o2;
        }
    }
}

constexpr int TC = 32, NCHUNK = SEQ / TC;
constexpr int RB_R = 0, RB_W = TC * 64, RB_K = 2 * TC * 64, RB_KK = 3 * TC * 64, RB_KA = 4 * TC * 64, RB_V = 5 * TC * 64, RB_SIZE = 5 * TC * 64 + TC * 16;
constexpr int MB_B = 0, MB_C = TC * 128, MB_X = 2 * TC * 128, MB_DT = MB_X + TC * 32, MB_DA = MB_DT + TC, MB_SIZE = MB_DA + TC;
static_assert(2 * RB_SIZE * 4 <= RING_BYTES, "scan buffers fit the LDS ring");

struct RwkvRaw { bf16 r[9], k[9], v[9], lw[8], a[8]; };
__device__ __forceinline__ void rwkv_load(RwkvRaw& raw, const bf16* PROJ, const bf16* LW, const bf16* AA, int b, int h, int t0w, int c) {
    const bf16* base = PROJ + (size_t)(b * SEQ + t0w) * INPP + h * 64 + c;
#pragma unroll
    for (int i = 0; i < 9; ++i) {
        if (i == 0 && t0w == 0) { raw.r[0] = 0; raw.k[0] = 0; raw.v[0] = 0; }
        else { const bf16* row = base + (long)(i - 1) * INPP; raw.r[i] = row[C_R]; raw.k[i] = row[C_K]; raw.v[i] = row[C_V]; }
    }
#pragma unroll
    for (int i = 0; i < 8; ++i) { const size_t o = (size_t)(b * SEQ + t0w + i) * RW + h * 64 + c; raw.lw[i] = LW[o]; raw.a[i] = AA[o]; }
}
__device__ __forceinline__ void rwkv_stage(const RwkvRaw& raw, LAS float* buf, int tl0, int c, int qt, float mu_r, float mu_k, float mu_v, float kkw, float kaw) {
#pragma unroll
    for (int i = 0; i < 8; ++i) {
        const int t = tl0 + i;
        const float rc = bf1(raw.r[i + 1]), rp = bf1(raw.r[i]), kc = bf1(raw.k[i + 1]), kp = bf1(raw.k[i]), vc = bf1(raw.v[i + 1]), vp = bf1(raw.v[i]);
        const float rr = rc + (rp - rc) * mu_r, kx = kc + (kp - kc) * mu_k, vv = vc + (vp - vc) * mu_v;
        const float a = bf1(raw.a[i]), dec = __expf(bf1(raw.lw[i]));
        const float kkraw = kx * kkw; const float ss = wave_sum_dpp(kkraw * kkraw);
        const float kkn = kkraw * rcp_f(fmaxf(sqrtf(ss), 1e-12f));
        buf[RB_R + t * 64 + c] = rr; buf[RB_W + t * 64 + c] = dec; buf[RB_K + t * 64 + c] = kx * (1.f + (a - 1.f) * kaw);
        buf[RB_KK + t * 64 + c] = kkn; buf[RB_KA + t * 64 + c] = kkn * a;
        if ((c >> 4) == qt) buf[RB_V + t * 16 + (c & 15)] = vv;
    }
}
__device__ __forceinline__ void rwkv_task(const Ctx& F, int task) {
    const int b = task >> 6, h = (task >> 2) & 15, qt = task & 3;
    const bf16* PROJ = (const bf16*)(F.ws + WS_PROJ); const bf16* LW = (const bf16*)(F.ws + WS_LW); const bf16* AA = (const bf16*)(F.ws + WS_AA);
    bf16* OY = (bf16*)(F.ws + WS_OY);
    LAS float* lbuf = (LAS float*)F.lds;
    const int c = F.lane, w = F.wave, r = F.lane >> 4, cg = F.lane & 15;
    const bool stager = w >= 4; const int sw = w & 3;
    const int ch = h * 64 + c;
    const float mu_r = F.in[I_MU][C_R + ch], mu_k = F.in[I_MU][C_K + ch], mu_v = F.in[I_MU][C_V + ch], kkw = F.in[I_KK][ch], kaw = F.in[I_KA][ch];
    RwkvRaw raw;
    if (stager) { rwkv_load(raw, PROJ, LW, AA, b, h, 8 * sw, c); rwkv_stage(raw, lbuf, 8 * sw, c, qt, mu_r, mu_k, mu_v, kkw, kaw); rwkv_load(raw, PROJ, LW, AA, b, h, TC + 8 * sw, c); }
    __syncthreads();
    f32x2 S01 = {0.f, 0.f}, S23 = {0.f, 0.f};
    const bool cb0 = cg & 1, cb1 = cg & 2, cb2 = cg & 4, cb3 = cg & 8;
    bf16* orow = OY + (size_t)(b * SEQ) * DM + h * 64 + 16 * qt + 4 * sw + r;
    for (int ck = 0; ck < NCHUNK; ++ck) {
        const LAS float* buf = lbuf + (ck & 1) * RB_SIZE;
        if (stager) {
            if (ck + 1 < NCHUNK) { rwkv_stage(raw, lbuf + ((ck + 1) & 1) * RB_SIZE, 8 * sw, c, qt, mu_r, mu_k, mu_v, kkw, kaw);
                if (ck + 2 < NCHUNK) rwkv_load(raw, PROJ, LW, AA, b, h, (ck + 2) * TC + 8 * sw, c); }
        } else {
            const LAS float* bp = buf + 4 * cg; const LAS float* vp = buf + RB_V + 4 * sw + r;
            f32x4 qkk[3], qw[3], qka[3], qk[3], qr[3]; float qv[3];
#pragma unroll
            for (int i = 0; i < 3; ++i) { qkk[i] = *(const LAS f32x4*)(bp + RB_KK + i * 64); qw[i] = *(const LAS f32x4*)(bp + RB_W + i * 64); qka[i] = *(const LAS f32x4*)(bp + RB_KA + i * 64);
                qk[i] = *(const LAS f32x4*)(bp + RB_K + i * 64); qr[i] = *(const LAS f32x4*)(bp + RB_R + i * 64); qv[i] = vp[i * 16]; }
            float op[16];
#pragma unroll
            for (int j = 0; j < TC; ++j) {
                const int u = j % 3;
                const f32x4 kk4 = qkk[u], w4 = qw[u], ka4 = qka[u], k4 = qk[u], r4 = qr[u]; const float vr = qv[u];
                const f32x2 tq = S01 * LO2(kk4) + S23 * HI2(kk4);
                const float sa = rowsum16(tq.x + tq.y);
                const f32x2 sav = {sa, sa}, vrv = {vr, vr};
                S01 = S01 * LO2(w4) + (vrv * LO2(k4) - sav * LO2(ka4));
                S23 = S23 * HI2(w4) + (vrv * HI2(k4) - sav * HI2(ka4));
                const f32x2 uq = S01 * LO2(r4) + S23 * HI2(r4);
                op[j & 15] = uq.x + uq.y;
                asm volatile("" : "+v"(S01), "+v"(S23) :: "memory");
                if (j + 3 < TC) { qkk[u] = *(const LAS f32x4*)(bp + RB_KK + (j + 3) * 64); qw[u] = *(const LAS f32x4*)(bp + RB_W + (j + 3) * 64); qka[u] = *(const LAS f32x4*)(bp + RB_KA + (j + 3) * 64);
                                  qk[u] = *(const LAS f32x4*)(bp + RB_K + (j + 3) * 64); qr[u] = *(const LAS f32x4*)(bp + RB_R + (j + 3) * 64); qv[u] = vp[(j + 3) * 16]; }
                if ((j & 15) == 15) {
                    const float ored = treduce16(op, cb0, cb1, cb2, cb3);
                    orow[(size_t)(ck * TC + (j - 15) + cg) * DM] = (bf16)(pk2(ored, 0.f) & 0xffffu);
                }
            }
        }
        __syncthreads();
    }
}

__device__ __forceinline__ void p4_scans(const Ctx& F) {
    for (int task = blockIdx.x; task < NB * RHEADS * 4; task += F.G) { rwkv_task(F, task); __syncthreads(); }
}

__device__ __forceinline__ void p5_post(const Ctx& F) {
    const bf16* PROJ = (const bf16*)(F.ws + WS_PROJ); const bf16* AA = (const bf16*)(F.ws + WS_AA); const bf16* GG = (const bf16*)(F.ws + WS_GG);
    bf16* OY = (bf16*)(F.ws + WS_OY);
    const float* mu = F.in[I_MU];
    const int c0 = 16 * F.lane;
    for (int m = F.gw; m < M; m += F.NGW) {
        const bool first = (m % SEQ) == 0;
        const bf16* prow = PROJ + (size_t)m * INPP;
        bf16* oyrow = OY + (size_t)m * DM;
        float res_r[16], res_m[16];
        {
            float o[16];
            { float t0[8], t1[8]; unpack8(*(const v4u*)(oyrow + c0), t0); unpack8(*(const v4u*)(oyrow + c0 + 8), t1);
#pragma unroll
              for (int j = 0; j < 8; ++j) { o[j] = t0[j]; o[8 + j] = t1[j]; } }
            float s = 0.f;
#pragma unroll
            for (int j = 0; j < 16; ++j) s += o[j];
            const float mean = quadsum(s) * (1.f / 64.f);
            float q = 0.f;
#pragma unroll
            for (int j = 0; j < 16; ++j) { o[j] -= mean; q += o[j] * o[j]; }
            const float rstd = rsqrtf(quadsum(q) * (1.f / 64.f) + 64e-5f);
            float bs = 0.f; float vv[16];
#pragma unroll
            for (int hh = 0; hh < 2; ++hh) {
                const int cc = c0 + 8 * hh;
                float rc[8], rp[8], kc[8], kp[8], vc[8], vp[8], av[8];
                unpack8(*(const v4u*)(prow + C_R + cc), rc); unpack8(*(const v4u*)(prow + C_K + cc), kc); unpack8(*(const v4u*)(prow + C_V + cc), vc);
                if (!first) { unpack8(*(const v4u*)(prow - INPP + C_R + cc), rp); unpack8(*(const v4u*)(prow - INPP + C_K + cc), kp); unpack8(*(const v4u*)(prow - INPP + C_V + cc), vp); }
                else {
#pragma unroll
                    for (int j = 0; j < 8; ++j) { rp[j] = 0.f; kp[j] = 0.f; vp[j] = 0.f; } }
                unpack8(*(const v4u*)(AA + (size_t)m * RW + cc), av);
#pragma unroll
                for (int j = 0; j < 8; ++j) { const int ch = cc + j;
                    const float rr = rc[j] + (rp[j] - rc[j]) * mu[C_R + ch], kx = kc[j] + (kp[j] - kc[j]) * mu[C_K + ch];
                    vv[8 * hh + j] = vc[j] + (vp[j] - vc[j]) * mu[C_V + ch];
                    const float k2 = kx * (1.f + (av[j] - 1.f) * F.in[I_KA][ch]);
                    bs += rr * k2 * F.in[I_RK][ch]; }
            }
            bs = quadsum(bs);
            float gv[16]; { float t0[8], t1[8]; unpack8(*(const v4u*)(GG + (size_t)m * RW + c0), t0); unpack8(*(const v4u*)(GG + (size_t)m * RW + c0 + 8), t1);
#pragma unroll
              for (int j = 0; j < 8; ++j) { gv[j] = t0[j]; gv[8 + j] = t1[j]; } }
#pragma unroll
            for (int j = 0; j < 16; ++j) { const int ch = c0 + j; res_r[j] = (o[j] * rstd * F.in[I_LNW][ch] + F.in[I_LNB][ch] + bs * vv[j]) * gv[j]; }
        }
        {
            float y[16], z[16];
            { float t0[8], t1[8]; unpack8(*(const v4u*)(oyrow + RW + c0), t0); unpack8(*(const v4u*)(oyrow + RW + c0 + 8), t1);
#pragma unroll
              for (int j = 0; j < 8; ++j) { y[j] = t0[j]; y[8 + j] = t1[j]; } }
            { float t0[8], t1[8]; unpack8(*(const v4u*)(prow + C_Z + c0), t0); unpack8(*(const v4u*)(prow + C_Z + c0 + 8), t1);
#pragma unroll
              for (int j = 0; j < 8; ++j) { z[j] = t0[j]; z[8 + j] = t1[j]; } }
            float q = 0.f;
#pragma unroll
            for (int j = 0; j < 16; ++j) { y[j] *= silu_f(z[j]); q += y[j] * y[j]; }
#pragma unroll
            for (int o = 1; o < 32; o <<= 1) q += __shfl_xor(q, o);
            const float rstd = rsqrtf(q * (1.f / 512.f) + 1e-5f);
#pragma unroll
            for (int j = 0; j < 16; ++j) res_m[j] = y[j] * rstd * F.in[I_MNW][c0 + j];
        }
        { float t0[8], t1[8];
#pragma unroll
          for (int j = 0; j < 8; ++j) { t0[j] = res_r[j]; t1[j] = res_r[8 + j]; }
          *(v4u*)(oyrow + c0) = pack8(t0); *(v4u*)(oyrow + c0 + 8) = pack8(t1);
#pragma unroll
          for (int j = 0; j < 8; ++j) { t0[j] = res_m[j]; t1[j] = res_m[8 + j]; }
          *(v4u*)(oyrow + RW + c0) = pack8(t0); *(v4u*)(oyrow + RW + c0 + 8) = pack8(t1); }
    }
}
constexpr int MC_L = 128, MC_NC = SEQ / MC_L, LSTR = 136;
constexpr int MT_BYTES = 128 * LSTR * 2;
constexpr size_t WS_ST = 876 * MiB, WS_SIN = 940 * MiB, WS_ATOT = 1004 * MiB, WS_END2 = 1005 * MiB;

__device__ __forceinline__ float mamba_dt_scan(const Ctx& F, const bf16* PROJ, int b, int c, int g, LAS float* DT, LAS float* ACS) {
    const int head = g * 8 + F.wave, lane = F.lane;
    const float dtb = F.in[I_DTB][head], Aneg = -__expf(F.in[I_ALOG][head]);
    const bf16* p = PROJ + (size_t)(b * SEQ + c * MC_L + 2 * lane) * INPP + C_DT + head;
    const float x0 = bf1(p[0]) + dtb, x1 = bf1(p[INPP]) + dtb;
    const float d0 = (x0 > 20.f) ? x0 : log1pf(__expf(x0)), d1 = (x1 > 20.f) ? x1 : log1pf(__expf(x1));
    const float s0 = d0 * Aneg, s1 = s0 + d1 * Aneg;
    float incl = s1;
#pragma unroll
    for (int o = 1; o < 64; o <<= 1) { const float t = __shfl_up(incl, o); if (lane >= o) incl += t; }
    const float excl = incl - s1;
    DT[F.wave * 128 + 2 * lane] = d0; DT[F.wave * 128 + 2 * lane + 1] = d1;
    ACS[F.wave * 128 + 2 * lane] = excl + s0; ACS[F.wave * 128 + 2 * lane + 1] = excl + s1;
    return __shfl(incl, 63);
}
template <bool SC>
__device__ __forceinline__ void mstage_T(const bf16* PROJ, int b, int c, int chn, LAS bf16* dst, const LAS float* scale, const float* convw, const float* convb, int tid) {
    const int f = tid & 127, t0 = 32 * (tid >> 7);
    const bf16* base = PROJ + (size_t)(b * SEQ + c * MC_L + t0) * INPP + C_XBC + chn;
    const float w0 = convw[chn], w1 = convw[1536 + chn], w2 = convw[2 * 1536 + chn], w3 = convw[3 * 1536 + chn], bb = convb[chn];
    float r0 = 0.f, r1 = 0.f, r2 = 0.f;
    if (c * MC_L + t0 > 0) { r0 = bf1(base[-3 * INPP]); r1 = bf1(base[-2 * INPP]); r2 = bf1(base[-1 * INPP]); }
#pragma unroll
    for (int i8 = 0; i8 < 4; ++i8) {
        float e[8];
#pragma unroll
        for (int i = 0; i < 8; ++i) { const int t = 8 * i8 + i; const float r3 = bf1(base[(size_t)t * INPP]);
            float v = silu_f(bb + w0 * r0 + w1 * r1 + w2 * r2 + w3 * r3);
            if (SC) v *= scale[t0 + t];
            e[i] = v; r0 = r1; r1 = r2; r2 = r3; }
        *(LAS v4u*)(dst + f * LSTR + t0 + 8 * i8) = pack8(e);
    }
}
__device__ __forceinline__ void mstage_N(const bf16* PROJ, int b, int c, int g, LAS bf16* Bn, LAS bf16* Cn, const float* convw, const float* convb, int tid) {
    const int f8 = tid & 31, t0 = 8 * (tid >> 5);
    const int chn = (f8 < 16) ? (1024 + g * 128 + 8 * f8) : (1280 + g * 128 + 8 * (f8 - 16));
    LAS bf16* dst = ((f8 < 16) ? Bn : Cn) + 8 * (f8 & 15);
    const bf16* base = PROJ + (size_t)(b * SEQ + c * MC_L + t0) * INPP + C_XBC + chn;
    float w[4][8], bb[8];
#pragma unroll
    for (int i = 0; i < 4; ++i) { const f32x4 a = *(const f32x4*)(convw + i * 1536 + chn), d = *(const f32x4*)(convw + i * 1536 + chn + 4);
        w[i][0] = a.x; w[i][1] = a.y; w[i][2] = a.z; w[i][3] = a.w; w[i][4] = d.x; w[i][5] = d.y; w[i][6] = d.z; w[i][7] = d.w; }
    { const f32x4 a = *(const f32x4*)(convb + chn), d = *(const f32x4*)(convb + chn + 4); bb[0] = a.x; bb[1] = a.y; bb[2] = a.z; bb[3] = a.w; bb[4] = d.x; bb[5] = d.y; bb[6] = d.z; bb[7] = d.w; }
    float r0[8], r1[8], r2[8];
    if (c * MC_L + t0 > 0) { unpack8(*(const v4u*)(base - 3 * INPP), r0); unpack8(*(const v4u*)(base - 2 * INPP), r1); unpack8(*(const v4u*)(base - 1 * INPP), r2); }
    else {
#pragma unroll
        for (int k = 0; k < 8; ++k) { r0[k] = 0.f; r1[k] = 0.f; r2[k] = 0.f; } }
#pragma unroll
    for (int t = 0; t < 8; ++t) {
        float r3[8], e[8]; unpack8(*(const v4u*)(base + (size_t)t * INPP), r3);
#pragma unroll
        for (int k = 0; k < 8; ++k) { e[k] = silu_f(bb[k] + w[0][k] * r0[k] + w[1][k] * r1[k] + w[2][k] * r2[k] + w[3][k] * r3[k]); r0[k] = r1[k]; r1[k] = r2[k]; r2[k] = r3[k]; }
        *(LAS v4u*)(dst + (t0 + t) * LSTR) = pack8(e);
    }
}

__device__ __forceinline__ void m1_chunk_states(const Ctx& F) {
    const bf16* PROJ = (const bf16*)(F.ws + WS_PROJ); bf16* ST = (bf16*)(F.ws + WS_ST); float* ATOT = (float*)(F.ws + WS_ATOT);
    LAS bf16* BT = (LAS bf16*)F.lds; LAS bf16* XT = (LAS bf16*)(F.lds + MT_BYTES);
    LAS float* DT = (LAS float*)(F.lds + 3 * MT_BYTES); LAS float* ACS = DT + 8 * 128; LAS float* SCL = ACS + 8 * 128;
    const float* convw = F.in[I_CONVW]; const float* convb = F.in[I_CONVB];
    const int tid = F.tid, w = F.wave, lane = F.lane, r16 = lane & 15, q = lane >> 4;
    for (int it = blockIdx.x; it < NB * MC_NC * 2; it += F.G) {
        const int g = it & 1, c = (it >> 1) & (MC_NC - 1), b = it >> 7;
        __syncthreads();
        const float atot = mamba_dt_scan(F, PROJ, b, c, g, DT, ACS);
        if (lane == 0) ATOT[(b * MC_NC + c) * 16 + g * 8 + w] = atot;
        LDS_WAIT();
        SCL[w * 128 + 2 * lane] = DT[w * 128 + 2 * lane] * __expf(atot - ACS[w * 128 + 2 * lane]);
        SCL[w * 128 + 2 * lane + 1] = DT[w * 128 + 2 * lane + 1] * __expf(atot - ACS[w * 128 + 2 * lane + 1]);
        mstage_T<false>(PROJ, b, c, 1024 + g * 128 + (tid & 127), BT, nullptr, convw, convb, tid);
#pragma unroll 1
        for (int hb = 0; hb < 2; ++hb) {
            __syncthreads();
#pragma unroll
            for (int im = 0; im < 2; ++im) { const int hl = 4 * hb + 2 * im + ((tid & 127) >> 6);
                mstage_T<true>(PROJ, b, c, (g * 8 + hl) * 64 + (tid & 63), XT + im * 128 * LSTR, SCL + hl * 128, convw, convb, tid); }
            __syncthreads();
            const int hh = w >> 1, ph = w & 1;
            f32x4 acc[2][8];
#pragma unroll
            for (int a = 0; a < 2; ++a)
#pragma unroll
                for (int n = 0; n < 8; ++n) acc[a][n] = (f32x4){0.f, 0.f, 0.f, 0.f};
#pragma unroll
            for (int ks = 0; ks < 4; ++ks) {
                bf16x8 xa[2];
#pragma unroll
                for (int a = 0; a < 2; ++a) xa[a] = *(const LAS bf16x8*)(XT + (hh * 64 + 32 * ph + 16 * a + r16) * LSTR + 32 * ks + 8 * q);
#pragma unroll
                for (int n = 0; n < 8; ++n) { const bf16x8 bfr = *(const LAS bf16x8*)(BT + (16 * n + r16) * LSTR + 32 * ks + 8 * q);
#pragma unroll
                    for (int a = 0; a < 2; ++a) acc[a][n] = __builtin_amdgcn_mfma_f32_16x16x32_bf16(bfr, xa[a], acc[a][n], 0, 0, 0); }
            }
            bf16* st = ST + ((size_t)((b * MC_NC + c) * 16 + g * 8 + 4 * hb + hh)) * (64 * 128);
#pragma unroll
            for (int a = 0; a < 2; ++a)
#pragma unroll
                for (int n = 0; n < 8; ++n) { v2u o; o.x = pk2(acc[a][n][0], acc[a][n][1]); o.y = pk2(acc[a][n][2], acc[a][n][3]);
                    *(v2u*)(st + (32 * ph + 16 * a + r16) * 128 + 16 * n + 4 * q) = o; }
        }
    }
}

__device__ __forceinline__ void m2_prefix(const Ctx& F) {
    const bf16* ST = (const bf16*)(F.ws + WS_ST); bf16* SIN = (bf16*)(F.ws + WS_SIN); const float* ATOT = (const float*)(F.ws + WS_ATOT);
    const int nthr = F.G * NTHR;
    for (int gi = blockIdx.x * NTHR + F.tid; gi < NB * 16 * 2048; gi += nthr) {
        const int e4 = gi & 2047, bh = gi >> 11, b = bh >> 4, h = bh & 15;
        float r0 = 0.f, r1 = 0.f, r2 = 0.f, r3 = 0.f;
#pragma unroll 4
        for (int c = 0; c < MC_NC; ++c) {
            const size_t o = ((size_t)((b * MC_NC + c) * 16 + h)) * 8192 + 4 * e4;
            v2u so; so.x = pk2(r0, r1); so.y = pk2(r2, r3);
            *(v2u*)(SIN + o) = so;
            const v2u sv = *(const v2u*)(ST + o); const float d = __expf(ATOT[(b * MC_NC + c) * 16 + h]);
            r0 = r0 * d + bflo(sv.x); r1 = r1 * d + bfhi(sv.x); r2 = r2 * d + bflo(sv.y); r3 = r3 * d + bfhi(sv.y);
        }
    }
}

__device__ __forceinline__ void m3_outputs(const Ctx& F) {
    const bf16* PROJ = (const bf16*)(F.ws + WS_PROJ); const bf16* SIN = (const bf16*)(F.ws + WS_SIN); bf16* OY = (bf16*)(F.ws + WS_OY);
    LAS bf16* Cn = (LAS bf16*)F.lds; LAS bf16* RB = (LAS bf16*)(F.lds + MT_BYTES);
    LAS bf16* Mw = (LAS bf16*)(F.lds + 2 * MT_BYTES) + F.wave * 16 * LSTR;
    LAS float* DT = (LAS float*)(F.lds + 3 * MT_BYTES); LAS float* ACS = DT + 8 * 128;
    const float* convw = F.in[I_CONVW]; const float* convb = F.in[I_CONVB];
    const int tid = F.tid, w = F.wave, lane = F.lane, r16 = lane & 15, q = lane >> 4;
    for (int it = blockIdx.x; it < NB * MC_NC * 2; it += F.G) {
        const int g = it & 1, c = (it >> 1) & (MC_NC - 1), b = it >> 7;
        __syncthreads();
        (void)mamba_dt_scan(F, PROJ, b, c, g, DT, ACS);
        mstage_N(PROJ, b, c, g, RB, Cn, convw, convb, tid);
        __syncthreads();
        bf16x8 cf[4];
#pragma unroll
        for (int ks = 0; ks < 4; ++ks) cf[ks] = *(const LAS bf16x8*)(Cn + (16 * w + r16) * LSTR + 32 * ks + 8 * q);
        f32x4 Gt[8];
#pragma unroll
        for (int nt = 0; nt < 8; ++nt) { Gt[nt] = (f32x4){0.f, 0.f, 0.f, 0.f};
#pragma unroll
            for (int ks = 0; ks < 4; ++ks) Gt[nt] = __builtin_amdgcn_mfma_f32_16x16x32_bf16(*(const LAS bf16x8*)(RB + (16 * nt + r16) * LSTR + 32 * ks + 8 * q), cf[ks], Gt[nt], 0, 0, 0); }
        const int l = 16 * w + r16;
        const size_t mrow = (size_t)(b * SEQ + c * MC_L + l);
#pragma unroll 1
        for (int hb = 0; hb < 4; ++hb) {
            __syncthreads();
            { const int hl = 2 * hb + ((tid & 127) >> 6); mstage_T<false>(PROJ, b, c, (g * 8 + hl) * 64 + (tid & 63), RB, nullptr, convw, convb, tid); }
            __syncthreads();
#pragma unroll 1
            for (int h2 = 0; h2 < 2; ++h2) {
                const int hl = 2 * hb + h2, head = g * 8 + hl;
                const float acs_l = ACS[hl * 128 + l];
#pragma unroll
                for (int nt = 0; nt < 8; ++nt) { const f32x4 as = *(const LAS f32x4*)(ACS + hl * 128 + 16 * nt + 4 * q), ds = *(const LAS f32x4*)(DT + hl * 128 + 16 * nt + 4 * q);
                    float mv[4];
#pragma unroll
                    for (int j = 0; j < 4; ++j) { const int s = 16 * nt + 4 * q + j; mv[j] = (s <= l) ? Gt[nt][j] * __expf(acs_l - as[j]) * ds[j] : 0.f; }
                    v2u o; o.x = pk2(mv[0], mv[1]); o.y = pk2(mv[2], mv[3]);
                    *(LAS v2u*)(Mw + r16 * LSTR + 16 * nt + 4 * q) = o; }
                LDS_WAIT(); asm volatile("" ::: "memory");
                bf16x8 mf[4];
#pragma unroll
                for (int ks = 0; ks < 4; ++ks) mf[ks] = *(const LAS bf16x8*)(Mw + r16 * LSTR + 32 * ks + 8 * q);
                const bf16* sin = SIN + ((size_t)((b * MC_NC + c) * 16 + head)) * 8192;
                const float el = __expf(acs_l), Dh = F.in[I_DSK][head];
#pragma unroll
                for (int pt = 0; pt < 4; ++pt) {
                    f32x4 yd = {0.f, 0.f, 0.f, 0.f}, yo = {0.f, 0.f, 0.f, 0.f};
#pragma unroll
                    for (int ks = 0; ks < 4; ++ks) {
                        yd = __builtin_amdgcn_mfma_f32_16x16x32_bf16(*(const LAS bf16x8*)(RB + (h2 * 64 + 16 * pt + r16) * LSTR + 32 * ks + 8 * q), mf[ks], yd, 0, 0, 0);
                        yo = __builtin_amdgcn_mfma_f32_16x16x32_bf16(*(const bf16x8*)(sin + (16 * pt + r16) * 128 + 32 * ks + 8 * q), cf[ks], yo, 0, 0, 0); }
                    float yv[4];
#pragma unroll
                    for (int j = 0; j < 4; ++j) yv[j] = yd[j] + el * yo[j] + Dh * bf1(RB[(h2 * 64 + 16 * pt + 4 * q + j) * LSTR + l]);
                    v2u o; o.x = pk2(yv[0], yv[1]); o.y = pk2(yv[2], yv[3]);
                    *(v2u*)(OY + mrow * DM + RW + head * 64 + 16 * pt + 4 * q) = o;
                }
                asm volatile("" ::: "memory");
            }
        }
    }
}
__device__ __forceinline__ float rowmax16(float x) { x = fmaxf(x, dpp_f<0xB1>(x)); x = fmaxf(x, dpp_f<0x4E>(x)); x = fmaxf(x, dpp_f<0x124>(x)); x = fmaxf(x, dpp_f<0x128>(x)); return x; }
__device__ __forceinline__ int cand_code(int s) {
    if (s < 16) return s << 4;
    if (s < 24) return 1 | ((s - 16) << 4);
    if (s < 29) return 2 | ((s - 24) << 4);
    if (s < 33) return 3 | ((s - 29) << 4);
    if (s < 36) return 4 | ((s - 33) << 4);
    if (s < 42) { const int k = s - 36; return (5 + (k >> 1)) | ((k & 1) << 4); }
    if (s < 50) return 8 + (s - 42);
    return -1;
}
template <int NV>
__device__ __forceinline__ void select16x4(float (&v)[4][NV], int r16, float (&kept)[4]) {
    const float NINF = -__builtin_inff();
#pragma unroll
    for (int j = 0; j < 4; ++j) kept[j] = NINF;
#pragma unroll 1
    for (int rd = 0; rd < 16; ++rd) {
#pragma unroll
        for (int j = 0; j < 4; ++j) {
            float m = v[j][0];
#pragma unroll
            for (int i = 1; i < NV; ++i) m = fmaxf(m, v[j][i]);
            m = rowmax16(m);
            kept[j] = (r16 == rd) ? m : kept[j];
#pragma unroll
            for (int i = 0; i < NV; ++i) v[j][i] = (v[j][i] == m) ? NINF : v[j][i];
        }
    }
}
__device__ __forceinline__ float dot2bf(unsigned a, unsigned b, float acc) { return __builtin_amdgcn_fdot2_f32_bf16(__builtin_bit_cast(bf16x2_t, a), __builtin_bit_cast(bf16x2_t, b), acc, false); }

constexpr int PT = 16;
constexpr size_t RANGE_BYTES = (size_t)NEXP * 128;

__device__ __forceinline__ void p9_route(const Ctx& F) {
    const bf16* Q = (const bf16*)(F.ws + WS_Q); const bf16* KEYS = (const bf16*)(F.ws + WS_KEYS);
    int* rtE = (int*)(F.ws + WS_RTE); float* rtG = (float*)(F.ws + WS_RTG);
    const int lane = F.lane, w = F.wave, r16 = lane & 15, q = lane >> 4, gbase = lane & 48;
    int ci[4], cj[4]; bool cvalid[4];
#pragma unroll
    for (int u = 0; u < 4; ++u) { const int cd = cand_code(r16 + 16 * u); cvalid[u] = cd >= 0; ci[u] = cd & 15; cj[u] = (cd >> 4) & 15; }
    const float NINF = -__builtin_inff();
    for (int tile = blockIdx.x; tile < M / PT; tile += F.G) {
        const int m0 = tile * PT;
        float top[2][4];
#pragma unroll
        for (int p = 0; p < 2; ++p) {
            const int hp = 2 * w + p;
            const bf16* qrow = Q + (size_t)(m0 + r16) * DM + hp * 128 + 8 * q;
            bf16x8 af[4];
#pragma unroll
            for (int s = 0; s < 4; ++s) af[s] = *(const bf16x8*)(qrow + 32 * s);
            float v[4][8];
#pragma unroll
            for (int nt = 0; nt < 8; ++nt) {
                const bf16* krow = KEYS + (size_t)(hp * 128 + nt * 16 + r16) * 128 + 8 * q;
                f32x4 acc = {0.f, 0.f, 0.f, 0.f};
#pragma unroll
                for (int s = 0; s < 4; ++s) acc = __builtin_amdgcn_mfma_f32_16x16x32_bf16(af[s], *(const bf16x8*)(krow + 32 * s), acc, 0, 0, 0);
                const unsigned tag = 127u - (unsigned)(nt * 16 + r16);
#pragma unroll
                for (int j = 0; j < 4; ++j) v[j][nt] = __uint_as_float((__float_as_uint(acc[j]) & ~127u) | tag);
            }
            select16x4<8>(v, r16, top[p]);
        }
        float cv[4][4];
#pragma unroll
        for (int u = 0; u < 4; ++u)
#pragma unroll
            for (int j = 0; j < 4; ++j) {
                const float a = __shfl(top[0][j], gbase + ci[u]), b = __shfl(top[1][j], gbase + cj[u]);
                const float cs = __uint_as_float(__float_as_uint(a) & ~127u) + __uint_as_float(__float_as_uint(b) & ~127u);
                const float pk = __uint_as_float((__float_as_uint(cs) & ~63u) | (63u - (unsigned)(r16 + 16 * u)));
                cv[j][u] = cvalid[u] ? pk : NINF;
            }
        float best[4];
        select16x4<4>(cv, r16, best);
#pragma unroll
        for (int j = 0; j < 4; ++j) {
            const unsigned bb = __float_as_uint(best[j]);
            const int cd = cand_code(63 - (int)(bb & 63u));
            const int k0 = 127 - (int)(__float_as_uint(__shfl(top[0][j], gbase + (cd & 15))) & 127u);
            const int k1 = 127 - (int)(__float_as_uint(__shfl(top[1][j], gbase + ((cd >> 4) & 15))) & 127u);
            const float s = __uint_as_float(bb & ~63u);
            const float mx = rowmax16(s), e = __expf(s - mx), sum = rowsum16(e);
            const size_t o = (size_t)(m0 + 4 * q + j) * 128 + w * 16 + r16;
            rtE[o] = k0 * 128 + k1; rtG[o] = e * rcp_f(sum);
        }
    }
}

__device__ __forceinline__ f32x2 cvt2_fp8(unsigned wd, bool hi) { return hi ? __builtin_amdgcn_cvt_pk_f32_fp8((int)wd, true) : __builtin_amdgcn_cvt_pk_f32_fp8((int)wd, false); }
__device__ __forceinline__ void treduce8x16(const float (&p)[16], bool b0, bool b1, bool b2, float& r0, float& r1) {
    float a[8], bq[4];
#pragma unroll
    for (int i = 0; i < 8; ++i) { const float mine = b2 ? p[i + 8] : p[i], send = b2 ? p[i] : p[i + 8]; const float up = dpp_f<0x104>(send), dn = dpp_f<0x114>(send); a[i] = mine + (b2 ? dn : up); }
#pragma unroll
    for (int i = 0; i < 4; ++i) { const float mine = b1 ? a[i + 4] : a[i], send = b1 ? a[i] : a[i + 4]; bq[i] = mine + dpp_f<0x4E>(send); }
    { const float mine = b0 ? bq[2] : bq[0], send = b0 ? bq[0] : bq[2]; r0 = mine + dpp_f<0xB1>(send); }
    { const float mine = b0 ? bq[3] : bq[1], send = b0 ? bq[1] : bq[3]; r1 = mine + dpp_f<0xB1>(send); }
}
struct XGroup { int xg, gwi, stride; };
__device__ __forceinline__ XGroup xgroup(const Ctx& F) { XGroup g; g.xg = blockIdx.x & 7; const int nbg = (F.G - g.xg + 7) >> 3; g.gwi = (blockIdx.x >> 3) * NWAVES + F.wave; g.stride = nbg * NWAVES; return g; }

__device__ __forceinline__ void p10_peer_u(const Ctx& F) {
    const unsigned char* PU8 = F.ws + WS_PU8; const bf16* XN = (const bf16*)(F.ws + WS_XN);
    const int* rtE = (const int*)(F.ws + WS_RTE); float* PD = (float*)(F.ws + WS_PD);
    const XGroup g = xgroup(F);
    const int lane = F.lane, j = lane >> 3, sub = lane & 7;
    const bool b0 = sub & 1, b1 = sub & 2, b2 = sub & 4;
    for (int rr = 0; rr < 2; ++rr) {
        const int r = g.xg + 8 * rr;
        const unsigned char* tab = PU8 + (size_t)r * RANGE_BYTES + 16 * sub;
        int m = g.gwi;
        v4u ev[4], xs[2];
        if (m < M) {
#pragma unroll
            for (int i = 0; i < 4; ++i) ev[i] = *(const v4u*)(rtE + (size_t)m * 128 + 16 * j + 4 * i);
            xs[0] = *(const v4u*)(XN + (size_t)m * DM + 128 * r + 16 * sub); xs[1] = *(const v4u*)(XN + (size_t)m * DM + 128 * r + 16 * sub + 8);
        }
        for (; m < M; m += g.stride) {
            v4u gt[16];
#pragma unroll
            for (int k = 0; k < 16; ++k) gt[k] = *(const v4u*)(tab + (size_t)ev[k >> 2][k & 3] * 128);
            float x[16]; { float t0[8], t1[8]; unpack8(xs[0], t0); unpack8(xs[1], t1);
#pragma unroll
              for (int i = 0; i < 8; ++i) { x[i] = t0[i]; x[8 + i] = t1[i]; } }
            const int mn = m + g.stride;
            if (mn < M) {
#pragma unroll
                for (int i = 0; i < 4; ++i) ev[i] = *(const v4u*)(rtE + (size_t)mn * 128 + 16 * j + 4 * i);
                xs[0] = *(const v4u*)(XN + (size_t)mn * DM + 128 * r + 16 * sub); xs[1] = *(const v4u*)(XN + (size_t)mn * DM + 128 * r + 16 * sub + 8);
            }
            float p[16];
#pragma unroll
            for (int k = 0; k < 16; ++k) {
                f32x2 a0 = {0.f, 0.f}, a1 = {0.f, 0.f};
#pragma unroll
                for (int d = 0; d < 4; ++d) { const unsigned wd = gt[k][d];
                    a0 += cvt2_fp8(wd, false) * (f32x2){x[4 * d], x[4 * d + 1]}; a1 += cvt2_fp8(wd, true) * (f32x2){x[4 * d + 2], x[4 * d + 3]}; }
                p[k] = (a0.x + a0.y) + (a1.x + a1.y);
            }
            float r0, r1; treduce8x16(p, b0, b1, b2, r0, r1);
            *(f32x2*)(PD + ((size_t)r * M + m) * 128 + 2 * lane) = (f32x2){r0, r1};
        }
    }
}

__device__ __forceinline__ void p11_peer_coef(const Ctx& F) {
    const int* rtE = (const int*)(F.ws + WS_RTE); const float* rtG = (const float*)(F.ws + WS_RTG); const float* PD = (const float*)(F.ws + WS_PD);
    const float* usc = (const float*)(F.ws + WS_USC); const float* vsc = (const float*)(F.ws + WS_VSC); float* COEF = (float*)(F.ws + WS_COEF);
    for (int m = F.gw; m < M; m += F.NGW) {
        const size_t o = (size_t)m * 128 + 2 * F.lane;
        f32x2 d = {0.f, 0.f};
#pragma unroll
        for (int r = 0; r < 16; ++r) d += *(const f32x2*)(PD + (size_t)r * M * 128 + o);
        const int e0 = rtE[o], e1 = rtE[o + 1];
        const f32x2 gt = *(const f32x2*)(rtG + o);
        const float d0 = d.x * usc[e0], d1 = d.y * usc[e1];
        f32x2 c; c.x = gt.x * (0.5f * d0 * (1.f + erff(d0 * 0.70710678f))) * vsc[e0]; c.y = gt.y * (0.5f * d1 * (1.f + erff(d1 * 0.70710678f))) * vsc[e1];
        *(f32x2*)(COEF + o) = c;
    }
}

__device__ __forceinline__ void p12_peer_v(const Ctx& F) {
    const unsigned char* PV8 = F.ws + WS_PV8; const int* rtE = (const int*)(F.ws + WS_RTE); const float* COEF = (const float*)(F.ws + WS_COEF);
    const float* mod = (const float*)(F.ws + WS_MOD);
    const XGroup g = xgroup(F);
    const int lane = F.lane, j = lane >> 3, sub = lane & 7;
    const bool jb0 = j & 1;
    for (int rr = 0; rr < 2; ++rr) {
        const int r = g.xg + 8 * rr;
        const unsigned char* tab = PV8 + (size_t)r * RANGE_BYTES + 16 * sub;
        int m = g.gwi;
        v4u ev[4]; f32x4 cf[4];
        if (m < M) {
#pragma unroll
            for (int i = 0; i < 4; ++i) { ev[i] = *(const v4u*)(rtE + (size_t)m * 128 + 16 * j + 4 * i); cf[i] = *(const f32x4*)(COEF + (size_t)m * 128 + 16 * j + 4 * i); }
        }
        for (; m < M; m += g.stride) {
            v4u gt[16];
#pragma unroll
            for (int k = 0; k < 16; ++k) gt[k] = *(const v4u*)(tab + (size_t)ev[k >> 2][k & 3] * 128);
            f32x4 cc[4];
#pragma unroll
            for (int i = 0; i < 4; ++i) cc[i] = cf[i];
            const int mn = m + g.stride;
            if (mn < M) {
#pragma unroll
                for (int i = 0; i < 4; ++i) { ev[i] = *(const v4u*)(rtE + (size_t)mn * 128 + 16 * j + 4 * i); cf[i] = *(const f32x4*)(COEF + (size_t)mn * 128 + 16 * j + 4 * i); }
            }
            f32x2 acc[8];
#pragma unroll
            for (int i = 0; i < 8; ++i) acc[i] = (f32x2){0.f, 0.f};
#pragma unroll
            for (int k = 0; k < 16; ++k) { const float c = cc[k >> 2][k & 3]; const f32x2 cv2 = {c, c};
#pragma unroll
                for (int d = 0; d < 4; ++d) { const unsigned wd = gt[k][d]; acc[2 * d] += cv2 * cvt2_fp8(wd, false); acc[2 * d + 1] += cv2 * cvt2_fp8(wd, true); } }
            float a[16];
#pragma unroll
            for (int i = 0; i < 8; ++i) { a[2 * i] = acc[i].x; a[2 * i + 1] = acc[i].y; }
            float s8[8], s4[4];
#pragma unroll
            for (int c = 0; c < 8; ++c) { auto rr2 = __builtin_amdgcn_permlane32_swap(__float_as_uint(a[c]), __float_as_uint(a[c + 8]), false, false); s8[c] = __uint_as_float(rr2[0]) + __uint_as_float(rr2[1]); }
#pragma unroll
            for (int c = 0; c < 4; ++c) { auto rr2 = __builtin_amdgcn_permlane16_swap(__float_as_uint(s8[c]), __float_as_uint(s8[c + 4]), false, false); s4[c] = __uint_as_float(rr2[0]) + __uint_as_float(rr2[1]); }
            f32x2 res;
            { const float mine = jb0 ? s4[2] : s4[0], send = jb0 ? s4[0] : s4[2]; res.x = mine + dpp_f<0x128>(send); }
            { const float mine = jb0 ? s4[3] : s4[1], send = jb0 ? s4[1] : s4[3]; res.y = mine + dpp_f<0x128>(send); }
            const int col = 128 * r + 16 * sub + 2 * j;
            float* orow = F.out + (size_t)m * DM + col;
            const f32x2 h1 = *(const f32x2*)orow, g2 = *(const f32x2*)(mod + (size_t)(m / SEQ) * MODW + 5 * DM + col);
            *(f32x2*)orow = h1 + g2 * res;
        }
    }
}
#define XB_TMO      128
#define XB_XCNT(j)  (256  + 64 * (j))
#define XB_XSUB(j)  (1280 + 64 * (j))
#define XB_XGEN(j)  (2304 + 64 * (j))
#define XB_TOP      3328
#define XB_TOPGEN   3392
#define XCD_BAR_WORDS 3456
#define XB_SPIN_CAP (1u << 18)

__device__ __forceinline__ unsigned xb_ld(unsigned* p)              { return __hip_atomic_load(p, __ATOMIC_RELAXED, __HIP_MEMORY_SCOPE_AGENT); }
__device__ __forceinline__ unsigned xb_add(unsigned* p, unsigned v) { return __hip_atomic_fetch_add(p, v, __ATOMIC_RELAXED, __HIP_MEMORY_SCOPE_AGENT); }
__device__ __forceinline__ unsigned xb_xcc_id() { return (unsigned)__builtin_amdgcn_s_getreg((3 << 11) | 20) & 0xFu; }
#define XB_SPIN(cond, bar) do { unsigned _sp = 0; while (cond) { __builtin_amdgcn_s_sleep(1); \
    if ((++_sp & 255u) == 0u) { if (xb_ld(&(bar)[XB_TMO])) break; if (_sp > XB_SPIN_CAP) { atomicAdd(&(bar)[XB_TMO], 1u); break; } } } } while (0)

struct XcdBarrier {
    unsigned* bar; unsigned x;
    volatile LAS unsigned* st;
};

__device__ __forceinline__ XcdBarrier xcd_barrier_post(unsigned* bar, volatile LAS unsigned* st) {
    XcdBarrier b; b.bar = bar; b.x = xb_xcc_id(); b.st = st;
    if (threadIdx.x == 0) (void)xb_add(&bar[XB_XCNT(b.x)], 1u);
    return b;
}
__device__ __forceinline__ void xcd_barrier_complete(unsigned* bar, unsigned x, unsigned& nloc, unsigned& nx) {
    const unsigned G = gridDim.x * gridDim.y * gridDim.z;
    unsigned sum, cnt, mine, sp = 0u;
    for (;;) {
        sum = 0u; cnt = 0u; mine = 0u;
#pragma unroll
        for (unsigned j = 0; j < 16; ++j) { const unsigned c = xb_ld(&bar[XB_XCNT(j)]); sum += c; cnt += (c > 0u) ? 1u : 0u; mine = (j == x) ? c : mine; }
        if (sum == G) break;
        __builtin_amdgcn_s_sleep(1);
        if ((++sp & 255u) == 0u) { if (xb_ld(&bar[XB_TMO])) break; if (sp > XB_SPIN_CAP) { atomicAdd(&bar[XB_TMO], 1u); break; } }
    }
    nloc = mine > 0u ? mine : 1u; nx = cnt > 0u ? cnt : 1u;
}

__device__ __forceinline__ void xcd_barrier(const XcdBarrier& b) {
    asm volatile("s_waitcnt vmcnt(0)" ::: "memory");
    __syncthreads();
    if (threadIdx.x == 0) {
        unsigned* bar = b.bar;
        __builtin_amdgcn_s_waitcnt(0);
        unsigned nloc = b.st[0], nx = b.st[1];
        if (nloc == 0u) { xcd_barrier_complete(bar, b.x, nloc, nx); b.st[0] = nloc; b.st[1] = nx; }
        const unsigned old = xb_add(&bar[XB_XSUB(b.x)], 1u);
        const unsigned gen = old / nloc;
        if (old + 1u == (gen + 1u) * nloc) {
            __builtin_amdgcn_fence(__ATOMIC_RELEASE, "agent");
            asm volatile("s_waitcnt vmcnt(0)" ::: "memory");
            const unsigned og = xb_add(&bar[XB_TOP], 1u);
            const unsigned tg = og / nx;
            if (og + 1u == (tg + 1u) * nx) xb_add(&bar[XB_TOPGEN], 1u);
            else XB_SPIN(xb_ld(&bar[XB_TOPGEN]) == tg, bar);
            __builtin_amdgcn_fence(__ATOMIC_ACQUIRE, "agent");
            xb_add(&bar[XB_XGEN(b.x)], 1u);
            asm volatile("s_waitcnt vmcnt(0)" ::: "memory");
        } else {
            XB_SPIN(xb_ld(&bar[XB_XGEN(b.x)]) == gen, bar);
            __builtin_amdgcn_fence(__ATOMIC_ACQUIRE, "agent");
            asm volatile("s_waitcnt vmcnt(0)" ::: "memory");
        }
    }
    __syncthreads();
}

struct Args { const float* in[N_IN]; float* out; unsigned char* ws; int ph_lo, ph_hi; };
constexpr int N_PHASES = 15;

__global__ void __launch_bounds__(NTHR, 2) fwd_kernel(Args args) {
    extern __shared__ __attribute__((aligned(16))) unsigned char lds_raw[];
    cg::grid_group grid = cg::this_grid();
    Ctx F;
    F.lds = (LAS unsigned char*)lds_raw;
    F.tid = threadIdx.x; F.lane = F.tid & 63; F.wave = __builtin_amdgcn_readfirstlane(F.tid >> 6);
    F.G = gridDim.x; F.gw = blockIdx.x * NWAVES + F.wave; F.NGW = F.G * NWAVES;
    F.in = args.in; F.out = args.out; F.ws = args.ws;
    const int lo = args.ph_lo, hi = args.ph_hi;
    volatile LAS unsigned* bst = (volatile LAS unsigned*)(F.lds + RING_BYTES + 64);
    if (F.tid < 2) bst[F.tid] = 0u;
    __syncthreads();
    const XcdBarrier bar = xcd_barrier_post((unsigned*)(F.ws + WS_CTL) + 4096, bst);
#define IN(k) (lo <= (k) && (k) < hi)
#define REP_MASK 0
#ifndef REP_MASK
#define REP_MASK 0
#endif
#define REPS(k) for (int rep_ = 0; rep_ < 1 + ((REP_MASK >> (k)) & 1); ++rep_)
#define SEAM(k) do { if (IN(k) && IN((k) + 1)) { if ((k) == 0) grid.sync(); else xcd_barrier(bar); } } while (0)

    if (IN(0)) REPS(0) { p0_prologue(F); }
    SEAM(0);
    if (IN(1)) REPS(1) { norm_mod_rows(F, F.in[I_X], F.in[I_N1W], 0, DM, (bf16*)(F.ws + WS_XN)); }
    SEAM(1);
    if (IN(2)) REPS(2) {
        pg8::Gemm g{(const pg8::bf16_t*)(F.ws + WS_XN), (const pg8::bf16_t*)(F.ws + WS_WIN), M, INPP, DM};
        pg8::StaticOrder S; S.init(M, INPP, F.G, (int)blockIdx.x);
        pg8::EpiStoreBf16 E{(pg8::bf16_t*)(F.ws + WS_PROJ), INPP};
        pg8::gemm_phase<pg8::EpiStoreBf16, pg8::StaticOrder, true, true>(F.lds, g, S, E);
    }
    SEAM(2);
    if (IN(3)) REPS(3) { p3_lora(F); m1_chunk_states(F); }
    SEAM(3);
    if (IN(4)) REPS(4) { m2_prefix(F); p4_scans(F); }
    SEAM(4);
    if (IN(5)) REPS(5) { m3_outputs(F); }
    SEAM(5);
    if (IN(6)) { p5_post(F); }
    SEAM(6);
    if (IN(7)) REPS(7) {
        pg8::Gemm g{(const pg8::bf16_t*)(F.ws + WS_OY), (const pg8::bf16_t*)(F.ws + WS_WOUT), M, DM, DM};
        pg8::StaticOrder S; S.init(M, DM, F.G, (int)blockIdx.x);
        pg8::EpiResid E{F.in[I_X], (const float*)(F.ws + WS_MOD) + 2 * DM, F.out, DM, SEQ, MODW};
        pg8::gemm_phase<pg8::EpiResid, pg8::StaticOrder, true, true>(F.lds, g, S, E);
    }
    SEAM(7);
    if (IN(8)) REPS(8) { norm_mod_rows(F, F.out, F.in[I_N2W], 3 * DM, 4 * DM, (bf16*)(F.ws + WS_XN)); }
    SEAM(8);
    if (IN(9)) REPS(9) {
        pg8::Gemm g{(const pg8::bf16_t*)(F.ws + WS_XN), (const pg8::bf16_t*)(F.ws + WS_WQ), M, DM, DM};
        pg8::StaticOrder S; S.init(M, DM, F.G, (int)blockIdx.x);
        pg8::EpiStoreBf16 E{(pg8::bf16_t*)(F.ws + WS_Q), DM};
        pg8::gemm_phase<pg8::EpiStoreBf16, pg8::StaticOrder, true, true>(F.lds, g, S, E);
    }
    SEAM(9);
    if (IN(10)) REPS(10) { p9_route(F); }
    SEAM(10);
    if (IN(11)) REPS(11) { p10_peer_u(F); }
    SEAM(11);
    if (IN(12)) REPS(12) { p11_peer_coef(F); }
    SEAM(12);
    if (IN(13)) { p12_peer_v(F); }
    SEAM(13);
    if (IN(14)) { final_norm_rows(F, F.out, F.in[I_FNW], F.out); }
#undef IN
#undef SEAM
}

extern "C" void kernel_launch(void* const* d_in, const int* in_sizes, int n_in, void* d_out, int out_size, void* d_ws, size_t ws_size, hipStream_t stream) {
    static int grid = 0;
    if (grid == 0) {
        if (n_in != N_IN || in_sizes[0] != M * DM || out_size != M * DM || ws_size < WS_END2) {
            fprintf(stderr, "kernel_launch: unexpected shapes: n_in %d in0 %d out %d ws %zu (need %zu)\n", n_in, n_in > 0 ? in_sizes[0] : -1, out_size, ws_size, (size_t)WS_END2); grid = -1; return; }
        int dev = 0, cus = 0, per_cu = 0;
        if (hipGetDevice(&dev) != hipSuccess || hipDeviceGetAttribute(&cus, hipDeviceAttributeMultiprocessorCount, dev) != hipSuccess) { grid = -1; return; }
        if (hipFuncSetAttribute((const void*)fwd_kernel, hipFuncAttributeMaxDynamicSharedMemorySize, LDS_BYTES) != hipSuccess) { fprintf(stderr, "kernel_launch: hipFuncSetAttribute failed\n"); grid = -1; return; }
        if (hipOccupancyMaxActiveBlocksPerMultiprocessor(&per_cu, (const void*)fwd_kernel, NTHR, LDS_BYTES) != hipSuccess || per_cu < 1) { fprintf(stderr, "kernel_launch: occupancy query says %d blocks per CU\n", per_cu); per_cu = 1; }
        (void)hipGetLastError();
        grid = cus;
        fprintf(stderr, "kernel_launch: cus %d per_cu %d grid %d ws %zu\n", cus, per_cu, grid, ws_size);
    }
    if (grid < 0) return;
    (void)hipMemsetAsync((char*)d_ws + WS_CTL, 0, CTL_ZERO_BYTES, stream);
    Args a{};
    for (int i = 0; i < N_IN; ++i) a.in[i] = (const float*)d_in[i];
    a.out = (float*)d_out; a.ws = (unsigned char*)d_ws; a.ph_lo = 0; a.ph_hi = N_PHASES;
    void* kargs[] = {&a};
    hipError_t e = hipLaunchCooperativeKernel((const void*)fwd_kernel, dim3(grid), dim3(NTHR), kargs, LDS_BYTES, stream);
    if (e != hipSuccess) fprintf(stderr, "kernel_launch: cooperative launch failed: %s (grid %d)\n", hipGetErrorString(e), grid);
}
```

```cpp
#include <hip/hip_runtime.h>
#include <hip/hip_cooperative_groups.h>
#include <cstdio>
#include <cstdint>
namespace cg = cooperative_groups;
namespace pg8 {
#define PG8_LAS __attribute__((address_space(3)))
typedef unsigned short bf16_t;
typedef short bf16x8 __attribute__((ext_vector_type(8)));
typedef float f32x4 __attribute__((ext_vector_type(4)));
typedef unsigned u32x4 __attribute__((ext_vector_type(4)));
constexpr int BM = 256, BK = 64, HALF = 128, HTB = HALF * BK * 2  , STAGE_BYTES = 8 * HTB, NXCD = 8, WGM = 8;

__host__ __device__ __forceinline__ int lds_byte(int r, int c) { const int st = (r >> 4) * 2 + (c >> 5), rr = r & 15, cc = c & 31, ob = rr * 64 + cc * 2; return st * 1024 + (ob ^ (((ob >> 9) & 1) << 5)); }
__host__ __device__ __forceinline__ void stage_rc(int b, int& R, int& C) { const int st = b / 1024, sb = b % 1024, swz = sb ^ (((sb >> 9) & 1) << 5); R = (st >> 1) * 16 + swz / 64; C = (st & 1) * 32 + (swz % 64) / 2; }
__host__ __device__ __forceinline__ int perm32(int rho) { const int n = rho >> 4, i = rho & 15; return 8 * (i >> 2) + 4 * n + (i & 3); }

struct Unit { int pm, pn; };
struct Gemm { const bf16_t* A; const bf16_t* Bt; int M, N, K; };

struct StaticOrder {
    int nM, nN, nwg, G, c;
    __host__ __device__ void init(int M, int N, int G_, int c_) { nM = M / BM; nN = N / BM; nwg = nM * nN; G = G_; c = c_; }
    __host__ __device__ bool next(int i, Unit& u) const {
        const long L = (long)i * G + c; if (L >= nwg) return false;
        int wgid = (int)L; { const int q = nwg / NXCD, r = nwg % NXCD, xcd = wgid % NXCD, off = wgid / NXCD; wgid = (xcd < r ? xcd * (q + 1) : r * (q + 1) + (xcd - r) * q) + off; }
        const int nig = WGM * nN, gid = wgid / nig, fm = gid * WGM, gsz = (nM - fm) < WGM ? (nM - fm) : WGM;
        u.pm = fm + ((wgid % nig) % gsz); u.pn = (wgid % nig) / gsz; return true;
    }
    __device__ __forceinline__ void a_ready(const Unit&) const {}
    __device__ __forceinline__ void done(const Unit&) const {}
};
__device__ __forceinline__ unsigned cvt_pk_bf16(float lo, float hi) { unsigned r; asm volatile("v_cvt_pk_bf16_f32 %0, %1, %2" : "=v"(r) : "v"(lo), "v"(hi)); return r; }
struct EpiStoreBf16 {
    static constexpr bool PERM = true, AFTER_DRAIN = false;
    bf16_t* O; int ldc;
    __device__ __forceinline__ void operator()(const f32x4 (&acc)[2][2][4][2], const Unit& u, int wr, int wc, int fr, int fq) const {
        const int row0 = u.pm * BM + wr * 64 + fr; const int col0 = u.pn * BM + wc * 32 + 8 * fq;
#pragma unroll
        for (int ai = 0; ai < 2; ++ai)
#pragma unroll
            for (int m = 0; m < 4; ++m) { bf16_t* rowp = O + (size_t)(row0 + ai * HALF + m * 16) * ldc + col0;
#pragma unroll
                for (int bj = 0; bj < 2; ++bj) { const f32x4 v0 = acc[ai][bj][m][0], v1 = acc[ai][bj][m][1];
                    u32x4 w; w.x = cvt_pk_bf16(v0[0], v0[1]); w.y = cvt_pk_bf16(v0[2], v0[3]); w.z = cvt_pk_bf16(v1[0], v1[1]); w.w = cvt_pk_bf16(v1[2], v1[3]);
                    *(u32x4*)(rowp + bj * HALF) = w; } }
    }
};
struct EpiResid {
    static constexpr bool PERM = true, AFTER_DRAIN = false;
    const float* X; const float* gate; bf16_t* O; int ldc; int rows_per_batch; int gstride;
    __device__ __forceinline__ void operator()(const f32x4 (&acc)[2][2][4][2], const Unit& u, int wr, int wc, int fr, int fq) const {
        const int row0 = u.pm * BM + wr * 64 + fr; const int col0 = u.pn * BM + wc * 32 + 8 * fq;
        const float* g = gate + (size_t)((u.pm * BM) / rows_per_batch) * gstride + col0;
        f32x4 gv[2][2];
#pragma unroll
        for (int bj = 0; bj < 2; ++bj)
#pragma unroll
            for (int n = 0; n < 2; ++n) gv[bj][n] = *(const f32x4*)(g + bj * HALF + 4 * n);
#pragma unroll
        for (int ai = 0; ai < 2; ++ai)
#pragma unroll
            for (int m = 0; m < 4; ++m) { const size_t off = (size_t)(row0 + ai * HALF + m * 16) * ldc + col0;
#pragma unroll
                for (int bj = 0; bj < 2; ++bj) { const f32x4 x0 = *(const f32x4*)(X + off + bj * HALF), x1 = *(const f32x4*)(X + off + bj * HALF + 4);
                    const f32x4 v0 = x0 + gv[bj][0] * acc[ai][bj][m][0], v1 = x1 + gv[bj][1] * acc[ai][bj][m][1];
                    u32x4 w; w.x = cvt_pk_bf16(v0[0], v0[1]); w.y = cvt_pk_bf16(v0[2], v0[3]); w.z = cvt_pk_bf16(v1[0], v1[1]); w.w = cvt_pk_bf16(v1[2], v1[3]);
                    *(u32x4*)(O + off + bj * HALF) = w; } }
    }
};
template <class Epi, class Sched, bool ALIGN_EPI = false, bool SP2 = false>
__device__ __forceinline__ void gemm_phase(PG8_LAS unsigned char* lds, const Gemm g, const Sched& S, const Epi& E) {
    const int tid = threadIdx.x, wid = __builtin_amdgcn_readfirstlane(tid >> 6), lane = tid & 63, wr = wid >> 2, wc = wid & 3, fr = lane & 15, fq = lane >> 4;
    const int K = g.K, nt = K / BK;
    unsigned voffA[2], voffB[2];
#pragma unroll
    for (int i = 0; i < 2; ++i) { int R, C; stage_rc(tid * 16 + i * 8192, R, C); const int Rb = Epi::PERM ? ((R & ~31) + perm32(R & 31)) : R;
        voffA[i] = (unsigned)(R * K + C) * 2u; voffB[i] = (unsigned)(Rb * K + C) * 2u; }
    const size_t kstep = (size_t)(BK * 2);
    const size_t hstep = (size_t)HALF * K * 2;
    const size_t tstep = 2 * hstep;
    const unsigned ldsw = (unsigned)wid * 1024u;
    const int aoff = lds_byte(wr * 64 + fr, fq * 8), boff = lds_byte(wc * 32 + fr, fq * 8);
#define PG8_SA(b, h) (((b) * 2 + (h)) * HTB)
#define PG8_SB(b, h) ((4 + (b) * 2 + (h)) * HTB)
#define PG8_STAGE(bufoff, gbase, voff) do { _Pragma("unroll") for (int _i = 0; _i < 2; ++_i) \
        __builtin_amdgcn_global_load_lds((const unsigned*)((const char*)(gbase) + (voff)[_i]), (PG8_LAS unsigned*)(lds + (bufoff) + ldsw + _i * 8192), 16, 0, 0); } while (0)
#define PG8_LDA(dst, b, h) do { _Pragma("unroll") for (int m = 0; m < 4; ++m) _Pragma("unroll") for (int k = 0; k < 2; ++k) dst[m][k] = *(const PG8_LAS bf16x8*)(lds + PG8_SA(b, h) + aoff + m * 2048 + k * 1024); } while (0)
#define PG8_LDB(dst, b, h) do { _Pragma("unroll") for (int n = 0; n < 2; ++n) _Pragma("unroll") for (int k = 0; k < 2; ++k) dst[n][k] = *(const PG8_LAS bf16x8*)(lds + PG8_SB(b, h) + boff + n * 2048 + k * 1024); } while (0)
#define PG8_MMA(ai, bj, At, Bt) do { __builtin_amdgcn_s_setprio(1); _Pragma("unroll") for (int m = 0; m < 4; ++m) _Pragma("unroll") for (int n = 0; n < 2; ++n) _Pragma("unroll") for (int k = 0; k < 2; ++k) \
        acc[ai][bj][m][n] = __builtin_amdgcn_mfma_f32_16x16x32_bf16(Bt[n][k], At[m][k], acc[ai][bj][m][n], 0, 0, 0); __builtin_amdgcn_s_setprio(0); } while (0)
#define PG8_WAIT_V(n) asm volatile("s_waitcnt vmcnt(" #n ")" ::: "memory")
#define PG8_WAIT_L(n) asm volatile("s_waitcnt lgkmcnt(" #n ")" ::: "memory")
#define PG8_BAR __builtin_amdgcn_s_barrier()
#define PG8_SCHED __builtin_amdgcn_sched_barrier(0)
    Unit cur, nxt; int ui = 0;
    if (!S.next(0, cur)) return;
    f32x4 acc[2][2][4][2];
#pragma unroll
    for (int a = 0; a < 2; ++a)
#pragma unroll
        for (int b = 0; b < 2; ++b)
#pragma unroll
            for (int m = 0; m < 4; ++m)
#pragma unroll
                for (int n = 0; n < 2; ++n) acc[a][b][m][n] = (f32x4){0.f, 0.f, 0.f, 0.f};
    bf16x8 At[4][2], B0[2][2], B1[2][2];
    const char* cA = (const char*)g.A + (size_t)cur.pm * tstep; const char* cB = (const char*)g.Bt + (size_t)cur.pn * tstep;
    S.a_ready(cur);
    if constexpr (SP2) {
        PG8_STAGE(PG8_SB(0, 0), cB, voffB); PG8_STAGE(PG8_SB(0, 1), cB + hstep, voffB); PG8_STAGE(PG8_SA(0, 0), cA, voffA); PG8_STAGE(PG8_SA(0, 1), cA + hstep, voffA);
        if (wr == 1) PG8_BAR;
        PG8_WAIT_V(2); PG8_BAR;
        PG8_STAGE(PG8_SB(1, 0), cB + kstep, voffB); PG8_STAGE(PG8_SA(1, 0), cA + kstep, voffA); PG8_STAGE(PG8_SB(1, 1), cB + hstep + kstep, voffB);
        PG8_WAIT_V(6); PG8_BAR;
    } else {
        PG8_STAGE(PG8_SB(0, 0), cB, voffB); PG8_STAGE(PG8_SA(0, 0), cA, voffA); PG8_STAGE(PG8_SB(0, 1), cB + hstep, voffB); PG8_STAGE(PG8_SA(0, 1), cA + hstep, voffA);
        if (wr == 1) PG8_BAR;
        PG8_WAIT_V(4); PG8_BAR;
        PG8_STAGE(PG8_SB(1, 0), cB + kstep, voffB); PG8_STAGE(PG8_SA(1, 0), cA + kstep, voffA); PG8_STAGE(PG8_SB(1, 1), cB + hstep + kstep, voffB);
        PG8_WAIT_V(6); PG8_BAR;
    }
    for (;;) {
        const bool has_next = S.next(ui + 1, nxt);
        const char* nA = has_next ? (const char*)g.A + (size_t)nxt.pm * tstep : cA; const char* nB = has_next ? (const char*)g.Bt + (size_t)nxt.pn * tstep : cB;
        for (int t = 0; t < nt; t += 2) {
            const bool last = (t == nt - 2);
            const char* a1 = cA + (size_t)(t + 1) * kstep;
            const char* a2 = last ? nA : cA + (size_t)(t + 2) * kstep; const char* b2 = last ? nB : cB + (size_t)(t + 2) * kstep;
            const char* a3 = a2 + kstep; const char* b3 = b2 + kstep;
            if (last && has_next) S.a_ready(nxt);
            if constexpr (SP2) {
            PG8_LDB(B0, 0, 0); PG8_LDB(B1, 0, 1); PG8_SCHED; PG8_LDA(At, 0, 0); PG8_STAGE(PG8_SA(1, 1), a1 + hstep, voffA);
            PG8_WAIT_V(8); PG8_WAIT_L(0); PG8_BAR; PG8_MMA(0, 0, At, B0); PG8_MMA(0, 1, At, B1); PG8_BAR; PG8_SCHED;
            PG8_LDA(At, 0, 1); PG8_STAGE(PG8_SB(0, 0), b2, voffB); PG8_STAGE(PG8_SB(0, 1), b2 + hstep, voffB); PG8_STAGE(PG8_SA(0, 0), a2, voffA);
            PG8_WAIT_V(8); PG8_WAIT_L(0); PG8_BAR; PG8_MMA(1, 0, At, B0); PG8_MMA(1, 1, At, B1); PG8_BAR; PG8_SCHED;
            PG8_LDB(B0, 1, 0); PG8_LDB(B1, 1, 1); PG8_SCHED; PG8_LDA(At, 1, 0); PG8_STAGE(PG8_SA(0, 1), a2 + hstep, voffA);
            PG8_WAIT_V(8); PG8_WAIT_L(0); PG8_BAR; PG8_MMA(0, 0, At, B0); PG8_MMA(0, 1, At, B1); PG8_BAR; PG8_SCHED;
            PG8_LDA(At, 1, 1); PG8_STAGE(PG8_SB(1, 0), b3, voffB); PG8_STAGE(PG8_SB(1, 1), b3 + hstep, voffB); PG8_STAGE(PG8_SA(1, 0), a3, voffA);
            PG8_WAIT_V(8); PG8_WAIT_L(0); PG8_BAR; PG8_MMA(1, 0, At, B0); PG8_MMA(1, 1, At, B1); PG8_BAR; PG8_SCHED;
            } else {
            PG8_LDB(B0, 0, 0); PG8_SCHED; PG8_LDA(At, 0, 0); PG8_STAGE(PG8_SA(1, 1), a1 + hstep, voffA);
            PG8_WAIT_L(8); PG8_BAR; PG8_WAIT_L(0); PG8_MMA(0, 0, At, B0); PG8_BAR; PG8_SCHED;
            PG8_LDB(B1, 0, 1); PG8_STAGE(PG8_SB(0, 0), b2, voffB);
            PG8_BAR; PG8_WAIT_L(0); PG8_MMA(0, 1, At, B1); PG8_BAR;
            PG8_LDA(At, 0, 1); PG8_STAGE(PG8_SA(0, 0), a2, voffA);
            PG8_BAR; PG8_WAIT_L(0); PG8_MMA(1, 0, At, B0); PG8_BAR; PG8_SCHED;
            PG8_STAGE(PG8_SB(0, 1), b2 + hstep, voffB);
            PG8_WAIT_V(6); PG8_BAR; PG8_MMA(1, 1, At, B1); PG8_BAR;
            PG8_LDB(B0, 1, 0); PG8_SCHED; PG8_LDA(At, 1, 0); PG8_STAGE(PG8_SA(0, 1), a2 + hstep, voffA);
            PG8_WAIT_L(8); PG8_BAR; PG8_WAIT_L(0); PG8_MMA(0, 0, At, B0); PG8_BAR; PG8_SCHED;
            PG8_LDB(B1, 1, 1); PG8_STAGE(PG8_SB(1, 0), b3, voffB);
            PG8_BAR; PG8_WAIT_L(0); PG8_MMA(0, 1, At, B1); PG8_BAR;
            PG8_LDA(At, 1, 1); PG8_STAGE(PG8_SA(1, 0), a3, voffA);
            PG8_BAR; PG8_WAIT_L(0); PG8_MMA(1, 0, At, B0); PG8_BAR; PG8_SCHED;
            PG8_STAGE(PG8_SB(1, 1), b3 + hstep, voffB);
            PG8_WAIT_V(6); PG8_BAR; PG8_MMA(1, 1, At, B1); PG8_BAR;
            }
        }
        if constexpr (ALIGN_EPI) { if (wr == 0) PG8_BAR; }
        if constexpr (!Epi::AFTER_DRAIN) { E(acc, cur, wr, wc, fr, fq); S.done(cur); }
        if (!has_next) break;
#pragma unroll
        for (int a = 0; a < 2; ++a)
#pragma unroll
            for (int b = 0; b < 2; ++b)
#pragma unroll
                for (int m = 0; m < 4; ++m)
#pragma unroll
                    for (int n = 0; n < 2; ++n) acc[a][b][m][n] = (f32x4){0.f, 0.f, 0.f, 0.f};
        cur = nxt; cA = nA; cB = nB; ++ui;
        if constexpr (ALIGN_EPI) { if (wr == 1) PG8_BAR; }
    }
    PG8_WAIT_V(0);
    if constexpr (!ALIGN_EPI) { if (wr == 0) PG8_BAR; }
    PG8_BAR;
    if constexpr (Epi::AFTER_DRAIN) { E.fused(acc, cur, wr, wc, fr, fq, lds, wid, lane); S.done(cur); }
#undef PG8_SA
#undef PG8_SB
#undef PG8_STAGE
#undef PG8_LDA
#undef PG8_LDB
#undef PG8_MMA
#undef PG8_WAIT_V
#undef PG8_WAIT_L
#undef PG8_BAR
#undef PG8_SCHED
}
}
#define GAS __attribute__((address_space(1)))
#define LAS __attribute__((address_space(3)))
typedef unsigned short bf16;
typedef unsigned v4u __attribute__((ext_vector_type(4)));
typedef unsigned v2u __attribute__((ext_vector_type(2)));
typedef float f32x4 __attribute__((ext_vector_type(4)));
typedef float f32x2 __attribute__((ext_vector_type(2)));
typedef short bf16x8 __attribute__((ext_vector_type(8)));
typedef __bf16 bf16x2_t __attribute__((ext_vector_type(2)));

constexpr int NWAVES = 8, NTHR = 512;
constexpr int DM = 2048, NB = 4, SEQ = 8192, M = NB * SEQ;
constexpr int RW = 1024, RHEADS = 16, HD = 64;
constexpr int L_W = 64, L_A = 64, L_G = 160;
constexpr int INP = 5936, INPP = 6144;
constexpr int C_R = 0, C_K = 1024, C_V = 2048, C_WD = 3072, C_AD = 3136, C_GD = 3200, C_Z = 3360, C_XBC = 4384, C_DT = 5920;
constexpr int MODW = 6 * DM;
constexpr int NEXP = 16384;
constexpr float RMS_EPS = 1e-6f;

enum { I_X = 0, I_C, I_ADAW, I_ADAB, I_N1W, I_WIN, I_MU, I_W0, I_WUP, I_A0, I_AUP, I_GUP, I_KK, I_KA, I_RK, I_LNW, I_LNB,
       I_CONVW, I_CONVB, I_DTB, I_ALOG, I_DSK, I_MNW, I_WOUT, I_N2W, I_WQ, I_KEYS, I_PU, I_PV, I_FNW, N_IN };

constexpr size_t MiB = 1u << 20;
constexpr size_t WS_CTL = 0, CTL_ZERO_BYTES = 1 * MiB;
constexpr size_t WS_MOD = 1 * MiB;
constexpr size_t WS_WIN = 2 * MiB, WS_WOUT = 26 * MiB, WS_WQ = 34 * MiB, WS_KEYS = 42 * MiB;
constexpr size_t WS_WUPT = 43 * MiB, WS_AUPT = 43 * MiB + 256 * 1024, WS_GUPT = 43 * MiB + 512 * 1024;
constexpr size_t WS_PU8 = 44 * MiB, WS_PV8 = 76 * MiB;
constexpr size_t WS_USC = 108 * MiB, WS_VSC = 108 * MiB + 65536;
constexpr size_t WS_XN = 172 * MiB;
constexpr size_t WS_LW = WS_XN, WS_AA = WS_XN + 64 * MiB;
constexpr size_t WS_PROJ = 300 * MiB;
constexpr size_t WS_Q = WS_PROJ;
constexpr size_t WS_GG = 684 * MiB;
constexpr size_t WS_PD = WS_PROJ + 128 * MiB;
constexpr size_t WS_RTE = 684 * MiB, WS_RTG = 700 * MiB, WS_COEF = 716 * MiB;
constexpr size_t WS_OY = 748 * MiB;
constexpr size_t WS_END = 876 * MiB;
constexpr size_t WS_HB = 876 * MiB;

constexpr int RING_BYTES = 131072, LDS_BYTES = 147456;

#define LDS_WAIT() asm volatile("s_waitcnt lgkmcnt(0)" ::: "memory")
#define VM_WAIT() asm volatile("s_waitcnt vmcnt(0)" ::: "memory")
__device__ __forceinline__ unsigned pk2(float lo, float hi) { f32x2 v = {lo, hi}; bf16x2_t b = __builtin_convertvector(v, bf16x2_t); return __builtin_bit_cast(unsigned, b); }
__device__ __forceinline__ float bflo(unsigned u) { return __uint_as_float(u << 16); }
__device__ __forceinline__ float bfhi(unsigned u) { return __uint_as_float(u & 0xffff0000u); }
__device__ __forceinline__ float bf1(bf16 h) { return __uint_as_float((unsigned)h << 16); }
__device__ __forceinline__ float wave_sum(float v) {
#pragma unroll
    for (int o = 1; o < 64; o <<= 1) v += __shfl_xor(v, o);
    return v;
}
__device__ __forceinline__ float rcp_f(float v) { return __builtin_amdgcn_rcpf(v); }
__device__ __forceinline__ float silu_f(float v) { return v * rcp_f(1.f + __expf(-v)); }
__device__ __forceinline__ float sigmoid_f(float v) { return rcp_f(1.f + __expf(-v)); }

struct Ctx {
    LAS unsigned char* lds;
    int tid, lane, wave, G, gw, NGW;
    const float* const* in;
    float* out; unsigned char* ws;
};

__device__ __forceinline__ void transpose_item(const float* W, int K, int N, bf16* WT, int ldt, int nrows_out, LAS float* scr, int kb, int nb, int lane) {
    const int k0 = 64 * kb, n0 = 32 * nb;
#pragma unroll 8
    for (int i = 0; i < 32; ++i) { const int kk = 2 * i + (lane >> 5), k = k0 + kk, n = n0 + (lane & 31);
        scr[kk * 33 + (lane & 31)] = (k < K && n < N) ? W[(size_t)k * N + n] : 0.f; }
    LDS_WAIT(); asm volatile("" ::: "memory");
    const int c = lane & 7;
#pragma unroll
    for (int j = 0; j < 4; ++j) { const int n = (lane >> 3) + 8 * j; const LAS float* s = scr + (8 * c) * 33 + n;
        v4u o; o.x = pk2(s[0 * 33], s[1 * 33]); o.y = pk2(s[2 * 33], s[3 * 33]); o.z = pk2(s[4 * 33], s[5 * 33]); o.w = pk2(s[6 * 33], s[7 * 33]);
        if (n0 + n < nrows_out && k0 + 8 * c + 8 <= ldt) *(v4u*)(WT + (size_t)(n0 + n) * ldt + k0 + 8 * c) = o; }
    LDS_WAIT(); asm volatile("" ::: "memory");
}
__device__ __forceinline__ void transpose_all(const float* W, int K, int N, bf16* WT, int ldt, int nrows_out, LAS float* scr, int gw, int NGW, int lane) {
    const int nkb = (K + 63) / 64, nnb = nrows_out / 32, nit = nkb * nnb;
    for (int it = gw; it < nit; it += NGW) transpose_item(W, K, N, WT, ldt, nrows_out, scr, it / nnb, it % nnb, lane);
}
__device__ __forceinline__ void convert_all(const float* src, bf16* dst, size_t n8, int gw, int NGW, int lane) {
    const f32x4* s4 = (const f32x4*)src; v4u* d4 = (v4u*)dst;
    for (size_t i = (size_t)gw * 64 + lane; i < n8; i += (size_t)NGW * 64) {
        const f32x4 a = __builtin_nontemporal_load(s4 + 2 * i), b = __builtin_nontemporal_load(s4 + 2 * i + 1);
        v4u o; o.x = pk2(a.x, a.y); o.y = pk2(a.z, a.w); o.z = pk2(b.x, b.y); o.w = pk2(b.z, b.w);
        d4[i] = o; }
}
__device__ __forceinline__ void quantize_rows_fp8(const float* src, unsigned char* dst8, float* scales, int gw, int NGW, int lane) {
    for (int e = gw; e < NEXP; e += NGW) {
        const f32x4* s4 = (const f32x4*)(src + (size_t)e * DM) + lane;
        f32x4 v[8]; float am = 0.f;
#pragma unroll
        for (int i = 0; i < 8; ++i) { v[i] = __builtin_nontemporal_load(s4 + 64 * i);
            am = fmaxf(fmaxf(am, fmaxf(fabsf(v[i].x), fabsf(v[i].y))), fmaxf(fabsf(v[i].z), fabsf(v[i].w))); }
#pragma unroll
        for (int o = 1; o < 64; o <<= 1) am = fmaxf(am, __shfl_xor(am, o));
        am = fmaxf(am, 1e-30f);
        const float inv = 440.f / am;
#pragma unroll
        for (int i = 0; i < 8; ++i) { int w = __builtin_amdgcn_cvt_pk_fp8_f32(v[i].x * inv, v[i].y * inv, 0, false); w = __builtin_amdgcn_cvt_pk_fp8_f32(v[i].z * inv, v[i].w * inv, w, true);
            const int seg = 2 * i + (lane >> 5);
            *(int*)(dst8 + (size_t)seg * ((size_t)NEXP * 128) + (size_t)e * 128 + 4 * (lane & 31)) = w; }
        if (lane == 0) scales[e] = am * (1.f / 440.f);
    }
}
__device__ __forceinline__ void p0_prologue(const Ctx& F) {
    __syncthreads();
    if (blockIdx.x < MODW / 64) {
        LAS float* sc = (LAS float*)F.lds;
        LAS float* red = sc + NB * DM;
        const float* c = F.in[I_C];
        for (int i = F.tid; i < NB * DM; i += NTHR) sc[i] = silu_f(c[i]);
        __syncthreads();
        const int j = blockIdx.x * 64 + F.lane;
        const float* wp = F.in[I_ADAW] + (size_t)(F.wave * 256) * MODW + j;
        float a0 = 0.f, a1 = 0.f, a2 = 0.f, a3 = 0.f;
#pragma unroll 16
        for (int kk = 0; kk < 256; ++kk) { const float w = wp[(size_t)kk * MODW]; const int k = F.wave * 256 + kk;
            a0 += sc[k] * w; a1 += sc[DM + k] * w; a2 += sc[2 * DM + k] * w; a3 += sc[3 * DM + k] * w; }
        red[(F.wave * 4 + 0) * 64 + F.lane] = a0; red[(F.wave * 4 + 1) * 64 + F.lane] = a1; red[(F.wave * 4 + 2) * 64 + F.lane] = a2; red[(F.wave * 4 + 3) * 64 + F.lane] = a3;
        __syncthreads();
        if (F.tid < 256) { const int b = F.tid >> 6, l = F.tid & 63; float s = F.in[I_ADAB][blockIdx.x * 64 + l];
#pragma unroll
            for (int w = 0; w < 8; ++w) s += red[(w * 4 + b) * 64 + l];
            ((float*)(F.ws + WS_MOD))[b * MODW + blockIdx.x * 64 + l] = s; }
        __syncthreads();
    }
    LAS float* scr = (LAS float*)(F.lds + F.wave * 16384);
    transpose_all(F.in[I_WIN], DM, INP, (bf16*)(F.ws + WS_WIN), DM, INPP, scr, F.gw, F.NGW, F.lane);
    transpose_all(F.in[I_WOUT], DM, DM, (bf16*)(F.ws + WS_WOUT), DM, DM, scr, F.gw, F.NGW, F.lane);
    transpose_all(F.in[I_WQ], DM, DM, (bf16*)(F.ws + WS_WQ), DM, DM, scr, F.gw, F.NGW, F.lane);
    transpose_all(F.in[I_WUP], L_W, RW, (bf16*)(F.ws + WS_WUPT), L_W, RW, scr, F.gw, F.NGW, F.lane);
    transpose_all(F.in[I_AUP], L_A, RW, (bf16*)(F.ws + WS_AUPT), L_A, RW, scr, F.gw, F.NGW, F.lane);
    transpose_all(F.in[I_GUP], L_G, RW, (bf16*)(F.ws + WS_GUPT), L_G, RW, scr, F.gw, F.NGW, F.lane);
    convert_all(F.in[I_KEYS], (bf16*)(F.ws + WS_KEYS), (size_t)16 * 128 * 128 / 8, F.gw, F.NGW, F.lane);
    quantize_rows_fp8(F.in[I_PU], F.ws + WS_PU8, (float*)(F.ws + WS_USC), F.gw, F.NGW, F.lane);
    quantize_rows_fp8(F.in[I_PV], F.ws + WS_PV8, (float*)(F.ws + WS_VSC), F.gw, F.NGW, F.lane);
}

__device__ __forceinline__ void norm_mod_rows(const Ctx& F, const float* X, const float* nw, int shift_off, int scale_off, bf16* XN) {
    const float* mod = (const float*)(F.ws + WS_MOD);
    for (int m = F.gw; m < M; m += F.NGW) {
        const int b = m / SEQ;
        const f32x4* xr = (const f32x4*)(X + (size_t)m * DM) + F.lane;
        f32x4 v[8]; float s = 0.f;
#pragma unroll
        for (int j = 0; j < 8; ++j) { v[j] = xr[64 * j]; s += (v[j].x * v[j].x + v[j].y * v[j].y) + (v[j].z * v[j].z + v[j].w * v[j].w); }
        const float rstd = rsqrtf(wave_sum(s) * (1.f / DM) + RMS_EPS);
        const f32x4* wp = (const f32x4*)nw + F.lane;
        const f32x4* shp = (const f32x4*)(mod + (size_t)b * MODW + shift_off) + F.lane;
        const f32x4* scp = (const f32x4*)(mod + (size_t)b * MODW + scale_off) + F.lane;
        v2u* o = (v2u*)(XN + (size_t)m * DM) + F.lane;
#pragma unroll
        for (int j = 0; j < 8; ++j) { const f32x4 w = wp[64 * j], a = scp[64 * j], c = shp[64 * j];
            const f32x4 r = (v[j] * rstd) * w * (a + 1.f) + c;
            v2u p; p.x = pk2(r.x, r.y); p.y = pk2(r.z, r.w); o[64 * j] = p; }
    }
}
__device__ __forceinline__ void final_norm_rows(const Ctx& F, const float* H, const float* nw, float* O) {
    for (int m = F.gw; m < M; m += F.NGW) {
        const f32x4* xr = (const f32x4*)(H + (size_t)m * DM) + F.lane;
        f32x4 v[8]; float s = 0.f;
#pragma unroll
        for (int j = 0; j < 8; ++j) { v[j] = xr[64 * j]; s += (v[j].x * v[j].x + v[j].y * v[j].y) + (v[j].z * v[j].z + v[j].w * v[j].w); }
        const float rstd = rsqrtf(wave_sum(s) * (1.f / DM) + RMS_EPS);
        const f32x4* wp = (const f32x4*)nw + F.lane;
        f32x4* o = (f32x4*)(O + (size_t)m * DM) + F.lane;
#pragma unroll
        for (int j = 0; j < 8; ++j) o[64 * j] = (v[j] * rstd) * wp[64 * j];
    }
}


__device__ __forceinline__ void load_row_bf16(const bf16* row, int lane, f32x4 (&v)[8]) {
    const v2u* p = (const v2u*)row + lane;
#pragma unroll
    for (int j = 0; j < 8; ++j) { const v2u u = p[64 * j]; v[j] = (f32x4){bflo(u.x), bfhi(u.x), bflo(u.y), bfhi(u.y)}; }
}
__device__ __forceinline__ void norm_mod_rows_bf16(const Ctx& F, const bf16* X, const float* nw, int shift_off, int scale_off, bf16* XN) {
    const float* mod = (const float*)(F.ws + WS_MOD);
    for (int m = F.gw; m < M; m += F.NGW) {
        const int b = m / SEQ;
        f32x4 v[8]; load_row_bf16(X + (size_t)m * DM, F.lane, v); float s = 0.f;
#pragma unroll
        for (int j = 0; j < 8; ++j) s += (v[j].x * v[j].x + v[j].y * v[j].y) + (v[j].z * v[j].z + v[j].w * v[j].w);
        const float rstd = rsqrtf(wave_sum(s) * (1.f / DM) + RMS_EPS);
        const f32x4* wp = (const f32x4*)nw + F.lane;
        const f32x4* shp = (const f32x4*)(mod + (size_t)b * MODW + shift_off) + F.lane;
        const f32x4* scp = (const f32x4*)(mod + (size_t)b * MODW + scale_off) + F.lane;
        v2u* o = (v2u*)(XN + (size_t)m * DM) + F.lane;
#pragma unroll
        for (int j = 0; j < 8; ++j) { const f32x4 w = wp[64 * j], a = scp[64 * j], c = shp[64 * j];
            const f32x4 r = (v[j] * rstd) * w * (a + 1.f) + c;
            v2u p; p.x = pk2(r.x, r.y); p.y = pk2(r.z, r.w); o[64 * j] = p; }
    }
}
__device__ __forceinline__ void final_norm_rows_bf16(const Ctx& F, const bf16* H, const float* nw, float* O) {
    for (int m = F.gw; m < M; m += F.NGW) {
        f32x4 v[8]; load_row_bf16(H + (size_t)m * DM, F.lane, v); float s = 0.f;
#pragma unroll
        for (int j = 0; j < 8; ++j) s += (v[j].x * v[j].x + v[j].y * v[j].y) + (v[j].z * v[j].z + v[j].w * v[j].w);
        const float rstd = rsqrtf(wave_sum(s) * (1.f / DM) + RMS_EPS);
        const f32x4* wp = (const f32x4*)nw + F.lane;
        f32x4* o = (f32x4*)(O + (size_t)m * DM) + F.lane;
#pragma unroll
        for (int j = 0; j < 8; ++j) o[64 * j] = (v[j] * rstd) * wp[64 * j];
    }
}
#define LO2(v) __builtin_shufflevector((v), (v), 0, 1)
#define HI2(v) __builtin_shufflevector((v), (v), 2, 3)
template <int CTRL> __device__ __forceinline__ float dpp_f(float x) { return __builtin_bit_cast(float, __builtin_amdgcn_mov_dpp(__builtin_bit_cast(int, x), CTRL, 0xf, 0xf, true)); }
__device__ __forceinline__ float rowsum16(float x) { x += dpp_f<0xB1>(x); x += dpp_f<0x4E>(x); x += dpp_f<0x124>(x); x += dpp_f<0x128>(x); return x; }
__device__ __forceinline__ float quadsum(float x) { x += dpp_f<0xB1>(x); x += dpp_f<0x4E>(x); return x; }

__device__ __forceinline__ float treduce16(const float (&p)[16], bool b0, bool b1, bool b2, bool b3) {
    float a[8], bq[4], c2[2];
#pragma unroll
    for (int j = 0; j < 8; ++j) { const float mine = b3 ? p[j + 8] : p[j], send = b3 ? p[j] : p[j + 8]; a[j] = mine + dpp_f<0x128>(send); }
#pragma unroll
    for (int j = 0; j < 4; ++j) { const float mine = b2 ? a[j + 4] : a[j], send = b2 ? a[j] : a[j + 4]; const float up = dpp_f<0x104>(send), dn = dpp_f<0x114>(send); bq[j] = mine + (b2 ? dn : up); }
#pragma unroll
    for (int j = 0; j < 2; ++j) { const float mine = b1 ? bq[j + 2] : bq[j], send = b1 ? bq[j] : bq[j + 2]; c2[j] = mine + dpp_f<0x4E>(send); }
    const float mine = b0 ? c2[1] : c2[0], send = b0 ? c2[0] : c2[1];
    return mine + dpp_f<0xB1>(send);
}
__device__ __forceinline__ float wave_sum_dpp(float v) { v = rowsum16(v); v += __shfl_xor(v, 16); v += __shfl_xor(v, 32); return v; }
__device__ __forceinline__ void unpack8(const v4u p, float (&e)[8]) { e[0] = bflo(p.x); e[1] = bfhi(p.x); e[2] = bflo(p.y); e[3] = bfhi(p.y); e[4] = bflo(p.z); e[5] = bfhi(p.z); e[6] = bflo(p.w); e[7] = bfhi(p.w); }
__device__ __forceinline__ v4u pack8(const float (&e)[8]) { v4u o; o.x = pk2(e[0], e[1]); o.y = pk2(e[2], e[3]); o.z = pk2(e[4], e[5]); o.w = pk2(e[6], e[7]); return o; }

__device__ __forceinline__ void p3_lora(const Ctx& F) {
    const bf16* PROJ = (const bf16*)(F.ws + WS_PROJ);
    const bf16* WUPT = (const bf16*)(F.ws + WS_WUPT); const bf16* AUPT = (const bf16*)(F.ws + WS_AUPT); const bf16* GUPT = (const bf16*)(F.ws + WS_GUPT);
    bf16* LW = (bf16*)(F.ws + WS_LW); bf16* AA = (bf16*)(F.ws + WS_AA); bf16* GG = (bf16*)(F.ws + WS_GG);
    const float* mu = F.in[I_MU]; const float* w0 = F.in[I_W0]; const float* a0 = F.in[I_A0];
    const int r16 = F.lane & 15, q = F.lane >> 4;
    for (int mt = F.gw; mt < M / 16; mt += F.NGW) {
        const int m = mt * 16 + r16; const bool first = (m % SEQ) == 0;
        const bf16* row = PROJ + (size_t)m * INPP;
        bf16x8 af[9];
#pragma unroll
        for (int s = 0; s < 9; ++s) {
            const int col = ((s < 2) ? (C_WD + 32 * s) : (s < 4) ? (C_AD + 32 * (s - 2)) : (C_GD + 32 * (s - 4))) + 8 * q;
            const v4u pc = *(const v4u*)(row + col);
            v4u pp = {0u, 0u, 0u, 0u}; if (!first) pp = *(const v4u*)(row - INPP + col);
            const f32x4 m0 = *(const f32x4*)(mu + col), m1 = *(const f32x4*)(mu + col + 4);
            float c[8], p[8], e[8]; unpack8(pc, c); unpack8(pp, p);
            const float mm[8] = {m0.x, m0.y, m0.z, m0.w, m1.x, m1.y, m1.z, m1.w};
#pragma unroll
            for (int j = 0; j < 8; ++j) { float v = c[j] + (p[j] - c[j]) * mm[j];
                if (s < 2) { const float t = __expf(2.f * v); v = 1.f - 2.f * rcp_f(t + 1.f); }
                else if (s >= 4) v = sigmoid_f(v);
                e[j] = v; }
            af[s] = __builtin_bit_cast(bf16x8, pack8(e));
        }
        bf16x8 wf[9];
        { const bf16* wu = WUPT + (size_t)r16 * L_W + 8 * q; const bf16* au = AUPT + (size_t)r16 * L_A + 8 * q; const bf16* gu = GUPT + (size_t)r16 * L_G + 8 * q;
#pragma unroll
          for (int s2 = 0; s2 < 2; ++s2) { wf[s2] = *(const bf16x8*)(wu + 32 * s2); wf[2 + s2] = *(const bf16x8*)(au + 32 * s2); }
#pragma unroll
          for (int s2 = 0; s2 < 5; ++s2) wf[4 + s2] = *(const bf16x8*)(gu + 32 * s2); }
        for (int nt = 0; nt < RW / 16; ++nt) {
            const int n0 = nt * 16;
            bf16x8 wn[9];
            { const int n1 = (nt + 1 < RW / 16) ? n0 + 16 : n0;
              const bf16* wu = WUPT + (size_t)(n1 + r16) * L_W + 8 * q; const bf16* au = AUPT + (size_t)(n1 + r16) * L_A + 8 * q; const bf16* gu = GUPT + (size_t)(n1 + r16) * L_G + 8 * q;
#pragma unroll
              for (int s2 = 0; s2 < 2; ++s2) { wn[s2] = *(const bf16x8*)(wu + 32 * s2); wn[2 + s2] = *(const bf16x8*)(au + 32 * s2); }
#pragma unroll
              for (int s2 = 0; s2 < 5; ++s2) wn[4 + s2] = *(const bf16x8*)(gu + 32 * s2); }
            f32x4 acc0 = {0.f, 0.f, 0.f, 0.f}, acc1 = acc0, acc2 = acc0;
#pragma unroll
            for (int s2 = 0; s2 < 2; ++s2) acc0 = __builtin_amdgcn_mfma_f32_16x16x32_bf16(wf[s2], af[s2], acc0, 0, 0, 0);
#pragma unroll
            for (int s2 = 0; s2 < 2; ++s2) acc1 = __builtin_amdgcn_mfma_f32_16x16x32_bf16(wf[2 + s2], af[2 + s2], acc1, 0, 0, 0);
#pragma unroll
            for (int s2 = 0; s2 < 5; ++s2) acc2 = __builtin_amdgcn_mfma_f32_16x16x32_bf16(wf[4 + s2], af[4 + s2], acc2, 0, 0, 0);
#pragma unroll
            for (int s2 = 0; s2 < 9; ++s2) wf[s2] = wn[s2];
            const int n = n0 + 4 * q;
            const f32x4 w0v = *(const f32x4*)(w0 + n), a0v = *(const f32x4*)(a0 + n);
            v2u o0, o1, o2;
            o0.x = pk2(-0.60653066f * sigmoid_f(acc0[0] + w0v.x), -0.60653066f * sigmoid_f(acc0[1] + w0v.y));
            o0.y = pk2(-0.60653066f * sigmoid_f(acc0[2] + w0v.z), -0.60653066f * sigmoid_f(acc0[3] + w0v.w));
            o1.x = pk2(sigmoid_f(acc1[0] + a0v.x), sigmoid_f(acc1[1] + a0v.y)); o1.y = pk2(sigmoid_f(acc1[2] + a0v.z), sigmoid_f(acc1[3] + a0v.w));
            o2.x = pk2(acc2[0], acc2[1]); o2.y = pk2(acc2[2], acc2[3]);
            *(v2u*)(LW + (size_t)m * RW + n) = o0; *(v2u*)(AA + (size_t)m * RW + n) = o1; *(v2u*)(GG + (size_t)m * RW + n) = o2;
        }
    }
}

constexpr int TC = 32, NCHUNK = SEQ / TC;
constexpr int RB_R = 0, RB_W = TC * 64, RB_K = 2 * TC * 64, RB_KK = 3 * TC * 64, RB_KA = 4 * TC * 64, RB_V = 5 * TC * 64, RB_SIZE = 5 * TC * 64 + TC * 16;
constexpr int MB_B = 0, MB_C = TC * 128, MB_X = 2 * TC * 128, MB_DT = MB_X + TC * 32, MB_DA = MB_DT + TC, MB_SIZE = MB_DA + TC;
static_assert(2 * RB_SIZE * 4 <= RING_BYTES, "scan buffers fit the LDS ring");

struct RwkvRaw { bf16 r[9], k[9], v[9], lw[8], a[8]; };
__device__ __forceinline__ void rwkv_load(RwkvRaw& raw, const bf16* PROJ, const bf16* LW, const bf16* AA, int b, int h, int t0w, int c) {
    const bf16* base = PROJ + (size_t)(b * SEQ + t0w) * INPP + h * 64 + c;
#pragma unroll
    for (int i = 0; i < 9; ++i) {
        if (i == 0 && t0w == 0) { raw.r[0] = 0; raw.k[0] = 0; raw.v[0] = 0; }
        else { const bf16* row = base + (long)(i - 1) * INPP; raw.r[i] = row[C_R]; raw.k[i] = row[C_K]; raw.v[i] = row[C_V]; }
    }
#pragma unroll
    for (int i = 0; i < 8; ++i) { const size_t o = (size_t)(b * SEQ + t0w + i) * RW + h * 64 + c; raw.lw[i] = LW[o]; raw.a[i] = AA[o]; }
}
__device__ __forceinline__ void rwkv_stage(const RwkvRaw& raw, LAS float* buf, int tl0, int c, int qt, float mu_r, float mu_k, float mu_v, float kkw, float kaw) {
#pragma unroll
    for (int i = 0; i < 8; ++i) {
        const int t = tl0 + i;
        const float rc = bf1(raw.r[i + 1]), rp = bf1(raw.r[i]), kc = bf1(raw.k[i + 1]), kp = bf1(raw.k[i]), vc = bf1(raw.v[i + 1]), vp = bf1(raw.v[i]);
        const float rr = rc + (rp - rc) * mu_r, kx = kc + (kp - kc) * mu_k, vv = vc + (vp - vc) * mu_v;
        const float a = bf1(raw.a[i]), dec = __expf(bf1(raw.lw[i]));
        const float kkraw = kx * kkw; const float ss = wave_sum_dpp(kkraw * kkraw);
        const float kkn = kkraw * rcp_f(fmaxf(sqrtf(ss), 1e-12f));
        buf[RB_R + t * 64 + c] = rr; buf[RB_W + t * 64 + c] = dec; buf[RB_K + t * 64 + c] = kx * (1.f + (a - 1.f) * kaw);
        buf[RB_KK + t * 64 + c] = kkn; buf[RB_KA + t * 64 + c] = kkn * a;
        if ((c >> 4) == qt) buf[RB_V + t * 16 + (c & 15)] = vv;
    }
}
__device__ __forceinline__ void rwkv_task(const Ctx& F, int task) {
    const int b = task >> 6, h = (task >> 2) & 15, qt = task & 3;
    const bf16* PROJ = (const bf16*)(F.ws + WS_PROJ); const bf16* LW = (const bf16*)(F.ws + WS_LW); const bf16* AA = (const bf16*)(F.ws + WS_AA);
    bf16* OY = (bf16*)(F.ws + WS_OY);
    LAS float* lbuf = (LAS float*)F.lds;
    const int c = F.lane, w = F.wave, r = F.lane >> 4, cg = F.lane & 15;
    const bool stager = w >= 4; const int sw = w & 3;
    const int ch = h * 64 + c;
    const float mu_r = F.in[I_MU][C_R + ch], mu_k = F.in[I_MU][C_K + ch], mu_v = F.in[I_MU][C_V + ch], kkw = F.in[I_KK][ch], kaw = F.in[I_KA][ch];
    RwkvRaw raw;
    if (stager) { rwkv_load(raw, PROJ, LW, AA, b, h, 8 * sw, c); rwkv_stage(raw, lbuf, 8 * sw, c, qt, mu_r, mu_k, mu_v, kkw, kaw); rwkv_load(raw, PROJ, LW, AA, b, h, TC + 8 * sw, c); }
    __syncthreads();
    f32x2 S01 = {0.f, 0.f}, S23 = {0.f, 0.f};
    const bool cb0 = cg & 1, cb1 = cg & 2, cb2 = cg & 4, cb3 = cg & 8;
    bf16* orow = OY + (size_t)(b * SEQ) * DM + h * 64 + 16 * qt + 4 * sw + r;
    for (int ck = 0; ck < NCHUNK; ++ck) {
        const LAS float* buf = lbuf + (ck & 1) * RB_SIZE;
        if (stager) {
            if (ck + 1 < NCHUNK) { rwkv_stage(raw, lbuf + ((ck + 1) & 1) * RB_SIZE, 8 * sw, c, qt, mu_r, mu_k, mu_v, kkw, kaw);
                if (ck + 2 < NCHUNK) rwkv_load(raw, PROJ, LW, AA, b, h, (ck + 2) * TC + 8 * sw, c); }
        } else {
            const LAS float* bp = buf + 4 * cg; const LAS float* vp = buf + RB_V + 4 * sw + r;
            f32x4 qkk[3], qw[3], qka[3], qk[3], qr[3]; float qv[3];
#pragma unroll
            for (int i = 0; i < 3; ++i) { qkk[i] = *(const LAS f32x4*)(bp + RB_KK + i * 64); qw[i] = *(const LAS f32x4*)(bp + RB_W + i * 64); qka[i] = *(const LAS f32x4*)(bp + RB_KA + i * 64);
                qk[i] = *(const LAS f32x4*)(bp + RB_K + i * 64); qr[i] = *(const LAS f32x4*)(bp + RB_R + i * 64); qv[i] = vp[i * 16]; }
            float op[16];
#pragma unroll
            for (int j = 0; j < TC; ++j) {
                const int u = j % 3;
                const f32x4 kk4 = qkk[u], w4 = qw[u], ka4 = qka[u], k4 = qk[u], r4 = qr[u]; const float vr = qv[u];
                const f32x2 tq = S01 * LO2(kk4) + S23 * HI2(kk4);
                const float sa = rowsum16(tq.x + tq.y);
                const f32x2 sav = {sa, sa}, vrv = {vr, vr};
                S01 = S01 * LO2(w4) + (vrv * LO2(k4) - sav * LO2(ka4));
                S23 = S23 * HI2(w4) + (vrv * HI2(k4) - sav * HI2(ka4));
                const f32x2 uq = S01 * LO2(r4) + S23 * HI2(r4);
                op[j & 15] = uq.x + uq.y;
                asm volatile("" : "+v"(S01), "+v"(S23) :: "memory");
                if (j + 3 < TC) { qkk[u] = *(const LAS f32x4*)(bp + RB_KK + (j + 3) * 64); qw[u] = *(const LAS f32x4*)(bp + RB_W + (j + 3) * 64); qka[u] = *(const LAS f32x4*)(bp + RB_KA + (j + 3) * 64);
                                  qk[u] = *(const LAS f32x4*)(bp + RB_K + (j + 3) * 64); qr[u] = *(const LAS f32x4*)(bp + RB_R + (j + 3) * 64); qv[u] = vp[(j + 3) * 16]; }
                if ((j & 15) == 15) {
                    const float ored = treduce16(op, cb0, cb1, cb2, cb3);
                    orow[(size_t)(ck * TC + (j - 15) + cg) * DM] = (bf16)(pk2(ored, 0.f) & 0xffffu);
                }
            }
        }
        __syncthreads();
    }
}

__device__ __forceinline__ void p4_scans(const Ctx& F) {
    for (int task = blockIdx.x; task < NB * RHEADS * 4; task += F.G) { rwkv_task(F, task); __syncthreads(); }
}

__device__ __forceinline__ void p5_post(const Ctx& F) {
    const bf16* PROJ = (const bf16*)(F.ws + WS_PROJ); const bf16* AA = (const bf16*)(F.ws + WS_AA); const bf16* GG = (const bf16*)(F.ws + WS_GG);
    bf16* OY = (bf16*)(F.ws + WS_OY);
    const float* mu = F.in[I_MU];
    const int c0 = 16 * F.lane;
    for (int m = F.gw; m < M; m += F.NGW) {
        const bool first = (m % SEQ) == 0;
        const bf16* prow = PROJ + (size_t)m * INPP;
        bf16* oyrow = OY + (size_t)m * DM;
        float res_r[16], res_m[16];
        {
            float o[16];
            { float t0[8], t1[8]; unpack8(*(const v4u*)(oyrow + c0), t0); unpack8(*(const v4u*)(oyrow + c0 + 8), t1);
#pragma unroll
              for (int j = 0; j < 8; ++j) { o[j] = t0[j]; o[8 + j] = t1[j]; } }
            float s = 0.f;
#pragma unroll
            for (int j = 0; j < 16; ++j) s += o[j];
            const float mean = quadsum(s) * (1.f / 64.f);
            float q = 0.f;
#pragma unroll
            for (int j = 0; j < 16; ++j) { o[j] -= mean; q += o[j] * o[j]; }
            const float rstd = rsqrtf(quadsum(q) * (1.f / 64.f) + 64e-5f);
            float bs = 0.f; float vv[16];
#pragma unroll
            for (int hh = 0; hh < 2; ++hh) {
                const int cc = c0 + 8 * hh;
                float rc[8], rp[8], kc[8], kp[8], vc[8], vp[8], av[8];
                unpack8(*(const v4u*)(prow + C_R + cc), rc); unpack8(*(const v4u*)(prow + C_K + cc), kc); unpack8(*(const v4u*)(prow + C_V + cc), vc);
                if (!first) { unpack8(*(const v4u*)(prow - INPP + C_R + cc), rp); unpack8(*(const v4u*)(prow - INPP + C_K + cc), kp); unpack8(*(const v4u*)(prow - INPP + C_V + cc), vp); }
                else {
#pragma unroll
                    for (int j = 0; j < 8; ++j) { rp[j] = 0.f; kp[j] = 0.f; vp[j] = 0.f; } }
                unpack8(*(const v4u*)(AA + (size_t)m * RW + cc), av);
#pragma unroll
                for (int j = 0; j < 8; ++j) { const int ch = cc + j;
                    const float rr = rc[j] + (rp[j] - rc[j]) * mu[C_R + ch], kx = kc[j] + (kp[j] - kc[j]) * mu[C_K + ch];
                    vv[8 * hh + j] = vc[j] + (vp[j] - vc[j]) * mu[C_V + ch];
                    const float k2 = kx * (1.f + (av[j] - 1.f) * F.in[I_KA][ch]);
                    bs += rr * k2 * F.in[I_RK][ch]; }
            }
            bs = quadsum(bs);
            float gv[16]; { float t0[8], t1[8]; unpack8(*(const v4u*)(GG + (size_t)m * RW + c0), t0); unpack8(*(const v4u*)(GG + (size_t)m * RW + c0 + 8), t1);
#pragma unroll
              for (int j = 0; j < 8; ++j) { gv[j] = t0[j]; gv[8 + j] = t1[j]; } }
#pragma unroll
            for (int j = 0; j < 16; ++j) { const int ch = c0 + j; res_r[j] = (o[j] * rstd * F.in[I_LNW][ch] + F.in[I_LNB][ch] + bs * vv[j]) * gv[j]; }
        }
        {
            float y[16], z[16];
            { float t0[8], t1[8]; unpack8(*(const v4u*)(oyrow + RW + c0), t0); unpack8(*(const v4u*)(oyrow + RW + c0 + 8), t1);
#pragma unroll
              for (int j = 0; j < 8; ++j) { y[j] = t0[j]; y[8 + j] = t1[j]; } }
            { float t0[8], t1[8]; unpack8(*(const v4u*)(prow + C_Z + c0), t0); unpack8(*(const v4u*)(prow + C_Z + c0 + 8), t1);
#pragma unroll
              for (int j = 0; j < 8; ++j) { z[j] = t0[j]; z[8 + j] = t1[j]; } }
            float q = 0.f;
#pragma unroll
            for (int j = 0; j < 16; ++j) { y[j] *= silu_f(z[j]); q += y[j] * y[j]; }
#pragma unroll
            for (int o = 1; o < 32; o <<= 1) q += __shfl_xor(q, o);
            const float rstd = rsqrtf(q * (1.f / 512.f) + 1e-5f);
#pragma unroll
            for (int j = 0; j < 16; ++j) res_m[j] = y[j] * rstd * F.in[I_MNW][c0 + j];
        }
        { float t0[8], t1[8];
#pragma unroll
          for (int j = 0; j < 8; ++j) { t0[j] = res_r[j]; t1[j] = res_r[8 + j]; }
          *(v4u*)(oyrow + c0) = pack8(t0); *(v4u*)(oyrow + c0 + 8) = pack8(t1);
#pragma unroll
          for (int j = 0; j < 8; ++j) { t0[j] = res_m[j]; t1[j] = res_m[8 + j]; }
          *(v4u*)(oyrow + RW + c0) = pack8(t0); *(v4u*)(oyrow + RW + c0 + 8) = pack8(t1); }
    }
}
constexpr int MC_L = 128, MC_NC = SEQ / MC_L, LSTR = 136;
constexpr int MT_BYTES = 128 * LSTR * 2;
constexpr size_t WS_ST = 876 * MiB, WS_SIN = 940 * MiB, WS_ATOT = 1004 * MiB, WS_END2 = 1005 * MiB;

__device__ __forceinline__ float mamba_dt_scan(const Ctx& F, const bf16* PROJ, int b, int c, int g, LAS float* DT, LAS float* ACS) {
    const int head = g * 8 + F.wave, lane = F.lane;
    const float dtb = F.in[I_DTB][head], Aneg = -__expf(F.in[I_ALOG][head]);
    const bf16* p = PROJ + (size_t)(b * SEQ + c * MC_L + 2 * lane) * INPP + C_DT + head;
    const float x0 = bf1(p[0]) + dtb, x1 = bf1(p[INPP]) + dtb;
    const float d0 = (x0 > 20.f) ? x0 : log1pf(__expf(x0)), d1 = (x1 > 20.f) ? x1 : log1pf(__expf(x1));
    const float s0 = d0 * Aneg, s1 = s0 + d1 * Aneg;
    float incl = s1;
#pragma unroll
    for (int o = 1; o < 64; o <<= 1) { const float t = __shfl_up(incl, o); if (lane >= o) incl += t; }
    const float excl = incl - s1;
    DT[F.wave * 128 + 2 * lane] = d0; DT[F.wave * 128 + 2 * lane + 1] = d1;
    ACS[F.wave * 128 + 2 * lane] = excl + s0; ACS[F.wave * 128 + 2 * lane + 1] = excl + s1;
    return __shfl(incl, 63);
}
template <bool SC>
__device__ __forceinline__ void mstage_T(const bf16* PROJ, int b, int c, int chn, LAS bf16* dst, const LAS float* scale, const float* convw, const float* convb, int tid) {
    const int f = tid & 127, t0 = 32 * (tid >> 7);
    const bf16* base = PROJ + (size_t)(b * SEQ + c * MC_L + t0) * INPP + C_XBC + chn;
    const float w0 = convw[chn], w1 = convw[1536 + chn], w2 = convw[2 * 1536 + chn], w3 = convw[3 * 1536 + chn], bb = convb[chn];
    float r0 = 0.f, r1 = 0.f, r2 = 0.f;
    if (c * MC_L + t0 > 0) { r0 = bf1(base[-3 * INPP]); r1 = bf1(base[-2 * INPP]); r2 = bf1(base[-1 * INPP]); }
#pragma unroll
    for (int i8 = 0; i8 < 4; ++i8) {
        float e[8];
#pragma unroll
        for (int i = 0; i < 8; ++i) { const int t = 8 * i8 + i; const float r3 = bf1(base[(size_t)t * INPP]);
            float v = silu_f(bb + w0 * r0 + w1 * r1 + w2 * r2 + w3 * r3);
            if (SC) v *= scale[t0 + t];
            e[i] = v; r0 = r1; r1 = r2; r2 = r3; }
        *(LAS v4u*)(dst + f * LSTR + t0 + 8 * i8) = pack8(e);
    }
}
__device__ __forceinline__ void mstage_N(const bf16* PROJ, int b, int c, int g, LAS bf16* Bn, LAS bf16* Cn, const float* convw, const float* convb, int tid) {
    const int f8 = tid & 31, t0 = 8 * (tid >> 5);
    const int chn = (f8 < 16) ? (1024 + g * 128 + 8 * f8) : (1280 + g * 128 + 8 * (f8 - 16));
    LAS bf16* dst = ((f8 < 16) ? Bn : Cn) + 8 * (f8 & 15);
    const bf16* base = PROJ + (size_t)(b * SEQ + c * MC_L + t0) * INPP + C_XBC + chn;
    float w[4][8], bb[8];
#pragma unroll
    for (int i = 0; i < 4; ++i) { const f32x4 a = *(const f32x4*)(convw + i * 1536 + chn), d = *(const f32x4*)(convw + i * 1536 + chn + 4);
        w[i][0] = a.x; w[i][1] = a.y; w[i][2] = a.z; w[i][3] = a.w; w[i][4] = d.x; w[i][5] = d.y; w[i][6] = d.z; w[i][7] = d.w; }
    { const f32x4 a = *(const f32x4*)(convb + chn), d = *(const f32x4*)(convb + chn + 4); bb[0] = a.x; bb[1] = a.y; bb[2] = a.z; bb[3] = a.w; bb[4] = d.x; bb[5] = d.y; bb[6] = d.z; bb[7] = d.w; }
    float r0[8], r1[8], r2[8];
    if (c * MC_L + t0 > 0) { unpack8(*(const v4u*)(base - 3 * INPP), r0); unpack8(*(const v4u*)(base - 2 * INPP), r1); unpack8(*(const v4u*)(base - 1 * INPP), r2); }
    else {
#pragma unroll
        for (int k = 0; k < 8; ++k) { r0[k] = 0.f; r1[k] = 0.f; r2[k] = 0.f; } }
#pragma unroll
    for (int t = 0; t < 8; ++t) {
        float r3[8], e[8]; unpack8(*(const v4u*)(base + (size_t)t * INPP), r3);
#pragma unroll
        for (int k = 0; k < 8; ++k) { e[k] = silu_f(bb[k] + w[0][k] * r0[k] + w[1][k] * r1[k] + w[2][k] * r2[k] + w[3][k] * r3[k]); r0[k] = r1[k]; r1[k] = r2[k]; r2[k] = r3[k]; }
        *(LAS v4u*)(dst + (t0 + t) * LSTR) = pack8(e);
    }
}

__device__ __forceinline__ void m1_chunk_states(const Ctx& F) {
    const bf16* PROJ = (const bf16*)(F.ws + WS_PROJ); bf16* ST = (bf16*)(F.ws + WS_ST); float* ATOT = (float*)(F.ws + WS_ATOT);
    LAS bf16* BT = (LAS bf16*)F.lds; LAS bf16* XT = (LAS bf16*)(F.lds + MT_BYTES);
    LAS float* DT = (LAS float*)(F.lds + 3 * MT_BYTES); LAS float* ACS = DT + 8 * 128; LAS float* SCL = ACS + 8 * 128;
    const float* convw = F.in[I_CONVW]; const float* convb = F.in[I_CONVB];
    const int tid = F.tid, w = F.wave, lane = F.lane, r16 = lane & 15, q = lane >> 4;
    for (int it = blockIdx.x; it < NB * MC_NC * 2; it += F.G) {
        const int g = it & 1, c = (it >> 1) & (MC_NC - 1), b = it >> 7;
        __syncthreads();
        const float atot = mamba_dt_scan(F, PROJ, b, c, g, DT, ACS);
        if (lane == 0) ATOT[(b * MC_NC + c) * 16 + g * 8 + w] = atot;
        LDS_WAIT();
        SCL[w * 128 + 2 * lane] = DT[w * 128 + 2 * lane] * __expf(atot - ACS[w * 128 + 2 * lane]);
        SCL[w * 128 + 2 * lane + 1] = DT[w * 128 + 2 * lane + 1] * __expf(atot - ACS[w * 128 + 2 * lane + 1]);
        mstage_T<false>(PROJ, b, c, 1024 + g * 128 + (tid & 127), BT, nullptr, convw, convb, tid);
#pragma unroll 1
        for (int hb = 0; hb < 2; ++hb) {
            __syncthreads();
#pragma unroll
            for (int im = 0; im < 2; ++im) { const int hl = 4 * hb + 2 * im + ((tid & 127) >> 6);
                mstage_T<true>(PROJ, b, c, (g * 8 + hl) * 64 + (tid & 63), XT + im * 128 * LSTR, SCL + hl * 128, convw, convb, tid); }
            __syncthreads();
            const int hh = w >> 1, ph = w & 1;
            f32x4 acc[2][8];
#pragma unroll
            for (int a = 0; a < 2; ++a)
#pragma unroll
                for (int n = 0; n < 8; ++n) acc[a][n] = (f32x4){0.f, 0.f, 0.f, 0.f};
#pragma unroll
            for (int ks = 0; ks < 4; ++ks) {
                bf16x8 xa[2];
#pragma unroll
                for (int a = 0; a < 2; ++a) xa[a] = *(const LAS bf16x8*)(XT + (hh * 64 + 32 * ph + 16 * a + r16) * LSTR + 32 * ks + 8 * q);
#pragma unroll
                for (int n = 0; n < 8; ++n) { const bf16x8 bfr = *(const LAS bf16x8*)(BT + (16 * n + r16) * LSTR + 32 * ks + 8 * q);
#pragma unroll
                    for (int a = 0; a < 2; ++a) acc[a][n] = __builtin_amdgcn_mfma_f32_16x16x32_bf16(bfr, xa[a], acc[a][n], 0, 0, 0); }
            }
            bf16* st = ST + ((size_t)((b * MC_NC + c) * 16 + g * 8 + 4 * hb + hh)) * (64 * 128);
#pragma unroll
            for (int a = 0; a < 2; ++a)
#pragma unroll
                for (int n = 0; n < 8; ++n) { v2u o; o.x = pk2(acc[a][n][0], acc[a][n][1]); o.y = pk2(acc[a][n][2], acc[a][n][3]);
                    *(v2u*)(st + (32 * ph + 16 * a + r16) * 128 + 16 * n + 4 * q) = o; }
        }
    }
}

__device__ __forceinline__ void m2_prefix(const Ctx& F) {
    const bf16* ST = (const bf16*)(F.ws + WS_ST); bf16* SIN = (bf16*)(F.ws + WS_SIN); const float* ATOT = (const float*)(F.ws + WS_ATOT);
    const int nthr = F.G * NTHR;
    for (int gi = blockIdx.x * NTHR + F.tid; gi < NB * 16 * 2048; gi += nthr) {
        const int e4 = gi & 2047, bh = gi >> 11, b = bh >> 4, h = bh & 15;
        float r0 = 0.f, r1 = 0.f, r2 = 0.f, r3 = 0.f;
#pragma unroll 4
        for (int c = 0; c < MC_NC; ++c) {
            const size_t o = ((size_t)((b * MC_NC + c) * 16 + h)) * 8192 + 4 * e4;
            v2u so; so.x = pk2(r0, r1); so.y = pk2(r2, r3);
            *(v2u*)(SIN + o) = so;
            const v2u sv = *(const v2u*)(ST + o); const float d = __expf(ATOT[(b * MC_NC + c) * 16 + h]);
            r0 = r0 * d + bflo(sv.x); r1 = r1 * d + bfhi(sv.x); r2 = r2 * d + bflo(sv.y); r3 = r3 * d + bfhi(sv.y);
        }
    }
}

__device__ __forceinline__ void m3_outputs(const Ctx& F) {
    const bf16* PROJ = (const bf16*)(F.ws + WS_PROJ); const bf16* SIN = (const bf16*)(F.ws + WS_SIN); bf16* OY = (bf16*)(F.ws + WS_OY);
    LAS bf16* Cn = (LAS bf16*)F.lds; LAS bf16* RB = (LAS bf16*)(F.lds + MT_BYTES);
    LAS bf16* Mw = (LAS bf16*)(F.lds + 2 * MT_BYTES) + F.wave * 16 * LSTR;
    LAS float* DT = (LAS float*)(F.lds + 3 * MT_BYTES); LAS float* ACS = DT + 8 * 128;
    const float* convw = F.in[I_CONVW]; const float* convb = F.in[I_CONVB];
    const int tid = F.tid, w = F.wave, lane = F.lane, r16 = lane & 15, q = lane >> 4;
    for (int it = blockIdx.x; it < NB * MC_NC * 2; it += F.G) {
        const int g = it & 1, c = (it >> 1) & (MC_NC - 1), b = it >> 7;
        __syncthreads();
        (void)mamba_dt_scan(F, PROJ, b, c, g, DT, ACS);
        mstage_N(PROJ, b, c, g, RB, Cn, convw, convb, tid);
        __syncthreads();
        bf16x8 cf[4];
#pragma unroll
        for (int ks = 0; ks < 4; ++ks) cf[ks] = *(const LAS bf16x8*)(Cn + (16 * w + r16) * LSTR + 32 * ks + 8 * q);
        f32x4 Gt[8];
#pragma unroll
        for (int nt = 0; nt < 8; ++nt) { Gt[nt] = (f32x4){0.f, 0.f, 0.f, 0.f};
#pragma unroll
            for (int ks = 0; ks < 4; ++ks) Gt[nt] = __builtin_amdgcn_mfma_f32_16x16x32_bf16(*(const LAS bf16x8*)(RB + (16 * nt + r16) * LSTR + 32 * ks + 8 * q), cf[ks], Gt[nt], 0, 0, 0); }
        const int l = 16 * w + r16;
        const size_t mrow = (size_t)(b * SEQ + c * MC_L + l);
#pragma unroll 1
        for (int hb = 0; hb < 4; ++hb) {
            __syncthreads();
            { const int hl = 2 * hb + ((tid & 127) >> 6); mstage_T<false>(PROJ, b, c, (g * 8 + hl) * 64 + (tid & 63), RB, nullptr, convw, convb, tid); }
            __syncthreads();
#pragma unroll 1
            for (int h2 = 0; h2 < 2; ++h2) {
                const int hl = 2 * hb + h2, head = g * 8 + hl;
                const float acs_l = ACS[hl * 128 + l];
                const bf16* sin = SIN + ((size_t)((b * MC_NC + c) * 16 + head)) * 8192;
                bf16x8 sf[4][4];
#pragma unroll
                for (int pt = 0; pt < 4; ++pt)
#pragma unroll
                    for (int ks = 0; ks < 4; ++ks) sf[pt][ks] = *(const bf16x8*)(sin + (16 * pt + r16) * 128 + 32 * ks + 8 * q);
#pragma unroll
                for (int nt = 0; nt < 8; ++nt) { const f32x4 as = *(const LAS f32x4*)(ACS + hl * 128 + 16 * nt + 4 * q), ds = *(const LAS f32x4*)(DT + hl * 128 + 16 * nt + 4 * q);
                    float mv[4];
#pragma unroll
                    for (int j = 0; j < 4; ++j) { const int s = 16 * nt + 4 * q + j; mv[j] = (s <= l) ? Gt[nt][j] * __expf(acs_l - as[j]) * ds[j] : 0.f; }
                    v2u o; o.x = pk2(mv[0], mv[1]); o.y = pk2(mv[2], mv[3]);
                    *(LAS v2u*)(Mw + r16 * LSTR + 16 * nt + 4 * q) = o; }
                LDS_WAIT(); asm volatile("" ::: "memory");
                bf16x8 mf[4];
#pragma unroll
                for (int ks = 0; ks < 4; ++ks) mf[ks] = *(const LAS bf16x8*)(Mw + r16 * LSTR + 32 * ks + 8 * q);
                const float el = __expf(acs_l), Dh = F.in[I_DSK][head];
#pragma unroll
                for (int pt = 0; pt < 4; ++pt) {
                    f32x4 yd = {0.f, 0.f, 0.f, 0.f}, yo = {0.f, 0.f, 0.f, 0.f};
#pragma unroll
                    for (int ks = 0; ks < 4; ++ks) {
                        yd = __builtin_amdgcn_mfma_f32_16x16x32_bf16(*(const LAS bf16x8*)(RB + (h2 * 64 + 16 * pt + r16) * LSTR + 32 * ks + 8 * q), mf[ks], yd, 0, 0, 0);
                        yo = __builtin_amdgcn_mfma_f32_16x16x32_bf16(sf[pt][ks], cf[ks], yo, 0, 0, 0); }
                    float yv[4];
#pragma unroll
                    for (int j = 0; j < 4; ++j) yv[j] = yd[j] + el * yo[j] + Dh * bf1(RB[(h2 * 64 + 16 * pt + 4 * q + j) * LSTR + l]);
                    v2u o; o.x = pk2(yv[0], yv[1]); o.y = pk2(yv[2], yv[3]);
                    *(v2u*)(OY + mrow * DM + RW + head * 64 + 16 * pt + 4 * q) = o;
                }
                asm volatile("" ::: "memory");
            }
        }
    }
}
__device__ __forceinline__ float rowmax16(float x) { x = fmaxf(x, dpp_f<0xB1>(x)); x = fmaxf(x, dpp_f<0x4E>(x)); x = fmaxf(x, dpp_f<0x124>(x)); x = fmaxf(x, dpp_f<0x128>(x)); return x; }
__device__ __forceinline__ int cand_code(int s) {
    if (s < 16) return s << 4;
    if (s < 24) return 1 | ((s - 16) << 4);
    if (s < 29) return 2 | ((s - 24) << 4);
    if (s < 33) return 3 | ((s - 29) << 4);
    if (s < 36) return 4 | ((s - 33) << 4);
    if (s < 42) { const int k = s - 36; return (5 + (k >> 1)) | ((k & 1) << 4); }
    if (s < 50) return 8 + (s - 42);
    return -1;
}
__device__ __forceinline__ int f2ord(float f) { const int b = __float_as_int(f); return b ^ ((b >> 31) & 0x7fffffff); }
__device__ __forceinline__ float ord2f(int k) { return __int_as_float(k ^ ((k >> 31) & 0x7fffffff)); }
template <int CTRL> __device__ __forceinline__ int dpp_i(int x) { return __builtin_amdgcn_mov_dpp(x, CTRL, 0xf, 0xf, true); }
__device__ __forceinline__ int imax(int a, int b) { return a > b ? a : b; }
__device__ __forceinline__ int imin(int a, int b) { return a < b ? a : b; }
__device__ __forceinline__ int rowmax16_i(int x) { x = imax(x, dpp_i<0xB1>(x)); x = imax(x, dpp_i<0x4E>(x)); x = imax(x, dpp_i<0x124>(x)); x = imax(x, dpp_i<0x128>(x)); return x; }
#define CSWAP_(a, b) do { const int hi_ = imax(a, b), lo_ = imin(a, b); a = hi_; b = lo_; } while (0)
template <int NV> __device__ __forceinline__ void sort_desc(int (&v)[NV]);
template <> __device__ __forceinline__ void sort_desc<8>(int (&v)[8]) {
    CSWAP_(v[0], v[1]); CSWAP_(v[2], v[3]); CSWAP_(v[4], v[5]); CSWAP_(v[6], v[7]);
    CSWAP_(v[0], v[2]); CSWAP_(v[1], v[3]); CSWAP_(v[4], v[6]); CSWAP_(v[5], v[7]);
    CSWAP_(v[1], v[2]); CSWAP_(v[5], v[6]);
    CSWAP_(v[0], v[4]); CSWAP_(v[1], v[5]); CSWAP_(v[2], v[6]); CSWAP_(v[3], v[7]);
    CSWAP_(v[2], v[4]); CSWAP_(v[3], v[5]);
    CSWAP_(v[1], v[2]); CSWAP_(v[3], v[4]); CSWAP_(v[5], v[6]);
}
template <> __device__ __forceinline__ void sort_desc<4>(int (&v)[4]) {
    CSWAP_(v[0], v[1]); CSWAP_(v[2], v[3]); CSWAP_(v[0], v[2]); CSWAP_(v[1], v[3]); CSWAP_(v[1], v[2]);
}
template <int NV>
__device__ __forceinline__ void select16x4(int (&v)[4][NV], int r16, float (&kept_f)[4]) {
    const int IMIN = (int)0x80000000;
    int kept[4];
#pragma unroll
    for (int j = 0; j < 4; ++j) { kept[j] = IMIN; sort_desc<NV>(v[j]); }
#pragma unroll 1
    for (int rd = 0; rd < 16; ++rd) {
#pragma unroll
        for (int j = 0; j < 4; ++j) {
            const int m = rowmax16_i(v[j][0]);
            kept[j] = (r16 == rd) ? m : kept[j];
            const bool own = (v[j][0] == m);
#pragma unroll
            for (int i = 0; i < NV - 1; ++i) v[j][i] = own ? v[j][i + 1] : v[j][i];
            v[j][NV - 1] = own ? IMIN : v[j][NV - 1];
        }
    }
#pragma unroll
    for (int j = 0; j < 4; ++j) kept_f[j] = ord2f(kept[j]);
}
__device__ __forceinline__ float dot2bf(unsigned a, unsigned b, float acc) { return __builtin_amdgcn_fdot2_f32_bf16(__builtin_bit_cast(bf16x2_t, a), __builtin_bit_cast(bf16x2_t, b), acc, false); }

constexpr int PT = 16;
constexpr size_t RANGE_BYTES = (size_t)NEXP * 128;

__device__ __forceinline__ void p9_route(const Ctx& F) {
    constexpr int KSTR = 136;
    const bf16* Q = (const bf16*)(F.ws + WS_Q); const bf16* KEYS = (const bf16*)(F.ws + WS_KEYS);
    int* rtE = (int*)(F.ws + WS_RTE); float* rtG = (float*)(F.ws + WS_RTG);
    LAS bf16* KL = (LAS bf16*)F.lds;
    const int lane = F.lane, w = F.wave, r16 = lane & 15, q = lane >> 4, gbase = lane & 48;
    const int h = blockIdx.x & 7, nbh = (F.G - h + 7) >> 3;
    __syncthreads();
    for (int i = F.tid; i < 2 * 128 * 16; i += NTHR) { const int row = i >> 4, ch = i & 15;
        *(LAS v4u*)(KL + row * KSTR + 8 * ch) = *(const v4u*)(KEYS + (size_t)(2 * h * 128 + row) * 128 + 8 * ch); }
    __syncthreads();
    int ci[4], cj[4]; bool cvalid[4];
#pragma unroll
    for (int u = 0; u < 4; ++u) { const int cd = cand_code(r16 + 16 * u); cvalid[u] = cd >= 0; ci[u] = cd & 15; cj[u] = (cd >> 4) & 15; }
    const float NINF = -__builtin_inff();
    const int tstride = nbh * NWAVES;
    int tile = (blockIdx.x >> 3) * NWAVES + w;
    bf16x8 afn[2][4];
    if (tile < M / PT) {
#pragma unroll
        for (int p = 0; p < 2; ++p)
#pragma unroll
            for (int s = 0; s < 4; ++s) afn[p][s] = *(const bf16x8*)(Q + (size_t)(tile * PT + r16) * DM + (2 * h + p) * 128 + 8 * q + 32 * s);
    }
    for (; tile < M / PT; tile += tstride) {
        const int m0 = tile * PT;
        bf16x8 af[2][4];
#pragma unroll
        for (int p = 0; p < 2; ++p)
#pragma unroll
            for (int s = 0; s < 4; ++s) af[p][s] = afn[p][s];
        if (tile + tstride < M / PT) {
#pragma unroll
            for (int p = 0; p < 2; ++p)
#pragma unroll
                for (int s = 0; s < 4; ++s) afn[p][s] = *(const bf16x8*)(Q + (size_t)((tile + tstride) * PT + r16) * DM + (2 * h + p) * 128 + 8 * q + 32 * s);
        }
        float top[2][4];
#pragma unroll
        for (int p = 0; p < 2; ++p) {
            int v[4][8];
#pragma unroll
            for (int nt = 0; nt < 8; ++nt) {
                const LAS bf16* krow = KL + (p * 128 + nt * 16 + r16) * KSTR + 8 * q;
                f32x4 acc = {0.f, 0.f, 0.f, 0.f};
#pragma unroll
                for (int s = 0; s < 4; ++s) acc = __builtin_amdgcn_mfma_f32_16x16x32_bf16(af[p][s], *(const LAS bf16x8*)(krow + 32 * s), acc, 0, 0, 0);
                const unsigned tag = 127u - (unsigned)(nt * 16 + r16);
#pragma unroll
                for (int j = 0; j < 4; ++j) v[j][nt] = f2ord(__uint_as_float((__float_as_uint(acc[j]) & ~127u) | tag));
                if (nt & 1) asm volatile("" ::: "memory");
            }
            select16x4<8>(v, r16, top[p]);
        }
        int cv[4][4];
#pragma unroll
        for (int u = 0; u < 4; ++u)
#pragma unroll
            for (int j = 0; j < 4; ++j) {
                const float a = __shfl(top[0][j], gbase + ci[u]), b = __shfl(top[1][j], gbase + cj[u]);
                const float cs = __uint_as_float(__float_as_uint(a) & ~127u) + __uint_as_float(__float_as_uint(b) & ~127u);
                const float pk = __uint_as_float((__float_as_uint(cs) & ~63u) | (63u - (unsigned)(r16 + 16 * u)));
                cv[j][u] = cvalid[u] ? f2ord(pk) : (int)0x80000000;
            }
        float best[4];
        select16x4<4>(cv, r16, best);
#pragma unroll
        for (int j = 0; j < 4; ++j) {
            const unsigned bb = __float_as_uint(best[j]);
            const int cd = cand_code(63 - (int)(bb & 63u));
            const int k0 = 127 - (int)(__float_as_uint(__shfl(top[0][j], gbase + (cd & 15))) & 127u);
            const int k1 = 127 - (int)(__float_as_uint(__shfl(top[1][j], gbase + ((cd >> 4) & 15))) & 127u);
            const float s = __uint_as_float(bb & ~63u);
            const float mx = rowmax16(s), e = __expf(s - mx), sum = rowsum16(e);
            const size_t o = (size_t)(m0 + 4 * q + j) * 128 + h * 16 + r16;
            rtE[o] = k0 * 128 + k1; rtG[o] = e * rcp_f(sum);
        }
    }
}

__device__ __forceinline__ f32x2 cvt2_fp8(unsigned wd, bool hi) { return hi ? __builtin_amdgcn_cvt_pk_f32_fp8((int)wd, true) : __builtin_amdgcn_cvt_pk_f32_fp8((int)wd, false); }
__device__ __forceinline__ void treduce8x16(const float (&p)[16], bool b0, bool b1, bool b2, float& r0, float& r1) {
    float a[8], bq[4];
#pragma unroll
    for (int i = 0; i < 8; ++i) { const float mine = b2 ? p[i + 8] : p[i], send = b2 ? p[i] : p[i + 8]; const float up = dpp_f<0x104>(send), dn = dpp_f<0x114>(send); a[i] = mine + (b2 ? dn : up); }
#pragma unroll
    for (int i = 0; i < 4; ++i) { const float mine = b1 ? a[i + 4] : a[i], send = b1 ? a[i] : a[i + 4]; bq[i] = mine + dpp_f<0x4E>(send); }
    { const float mine = b0 ? bq[2] : bq[0], send = b0 ? bq[0] : bq[2]; r0 = mine + dpp_f<0xB1>(send); }
    { const float mine = b0 ? bq[3] : bq[1], send = b0 ? bq[1] : bq[3]; r1 = mine + dpp_f<0xB1>(send); }
}
struct XGroup { int xg, gwi, stride; };
__device__ __forceinline__ XGroup xgroup(const Ctx& F) { XGroup g; g.xg = blockIdx.x & 7; const int nbg = (F.G - g.xg + 7) >> 3; g.gwi = (blockIdx.x >> 3) * NWAVES + F.wave; g.stride = nbg * NWAVES; return g; }

__device__ __forceinline__ void p10_peer_u(const Ctx& F) {
    const unsigned char* PU8 = F.ws + WS_PU8; const bf16* XN = (const bf16*)(F.ws + WS_XN);
    const int* rtE = (const int*)(F.ws + WS_RTE); unsigned* PD = (unsigned*)(F.ws + WS_PD);
    const XGroup g = xgroup(F);
    const int lane = F.lane, j = lane >> 3, sub = lane & 7;
    const bool b0 = sub & 1, b1 = sub & 2, b2 = sub & 4;
    for (int rr = 0; rr < 2; ++rr) {
        const int r = g.xg + 8 * rr;
        const unsigned char* tab = PU8 + (size_t)r * RANGE_BYTES + 16 * sub;
        int m = g.gwi;
        v4u ev[4], xs[2];
        if (m < M) {
#pragma unroll
            for (int i = 0; i < 4; ++i) ev[i] = *(const v4u*)(rtE + (size_t)m * 128 + 16 * j + 4 * i);
            xs[0] = *(const v4u*)(XN + (size_t)m * DM + 128 * r + 16 * sub); xs[1] = *(const v4u*)(XN + (size_t)m * DM + 128 * r + 16 * sub + 8);
        }
        for (; m < M; m += g.stride) {
            v4u gt[16];
#pragma unroll
            for (int k = 0; k < 16; ++k) gt[k] = *(const v4u*)(tab + (size_t)ev[k >> 2][k & 3] * 128);
            float x[16]; { float t0[8], t1[8]; unpack8(xs[0], t0); unpack8(xs[1], t1);
#pragma unroll
              for (int i = 0; i < 8; ++i) { x[i] = t0[i]; x[8 + i] = t1[i]; } }
            const int mn = m + g.stride;
            if (mn < M) {
#pragma unroll
                for (int i = 0; i < 4; ++i) ev[i] = *(const v4u*)(rtE + (size_t)mn * 128 + 16 * j + 4 * i);
                xs[0] = *(const v4u*)(XN + (size_t)mn * DM + 128 * r + 16 * sub); xs[1] = *(const v4u*)(XN + (size_t)mn * DM + 128 * r + 16 * sub + 8);
            }
            float p[16];
#pragma unroll
            for (int k = 0; k < 16; ++k) {
                f32x2 a0 = {0.f, 0.f}, a1 = {0.f, 0.f};
#pragma unroll
                for (int d = 0; d < 4; ++d) { const unsigned wd = gt[k][d];
                    a0 += cvt2_fp8(wd, false) * (f32x2){x[4 * d], x[4 * d + 1]}; a1 += cvt2_fp8(wd, true) * (f32x2){x[4 * d + 2], x[4 * d + 3]}; }
                p[k] = (a0.x + a0.y) + (a1.x + a1.y);
            }
            float r0, r1; treduce8x16(p, b0, b1, b2, r0, r1);
            PD[((size_t)r * M + m) * 64 + lane] = pk2(r0, r1);
        }
    }
}

__device__ __forceinline__ void p11_peer_coef(const Ctx& F) {
    const int* rtE = (const int*)(F.ws + WS_RTE); const float* rtG = (const float*)(F.ws + WS_RTG); const unsigned* PD = (const unsigned*)(F.ws + WS_PD);
    const float* usc = (const float*)(F.ws + WS_USC); const float* vsc = (const float*)(F.ws + WS_VSC); float* COEF = (float*)(F.ws + WS_COEF);
    for (int m = F.gw; m < M; m += F.NGW) {
        const size_t o = (size_t)m * 128 + 2 * F.lane;
        f32x2 d = {0.f, 0.f};
#pragma unroll
        for (int r = 0; r < 16; ++r) { const unsigned pw = PD[((size_t)r * M + m) * 64 + F.lane]; d += (f32x2){bflo(pw), bfhi(pw)}; }
        const int e0 = rtE[o], e1 = rtE[o + 1];
        const f32x2 gt = *(const f32x2*)(rtG + o);
        const float d0 = d.x * usc[e0], d1 = d.y * usc[e1];
        f32x2 c; c.x = gt.x * (0.5f * d0 * (1.f + erff(d0 * 0.70710678f))) * vsc[e0]; c.y = gt.y * (0.5f * d1 * (1.f + erff(d1 * 0.70710678f))) * vsc[e1];
        *(f32x2*)(COEF + o) = c;
    }
}

__device__ __forceinline__ void p12_peer_v(const Ctx& F) {
    const unsigned char* PV8 = F.ws + WS_PV8; const int* rtE = (const int*)(F.ws + WS_RTE); const float* COEF = (const float*)(F.ws + WS_COEF);
    const float* mod = (const float*)(F.ws + WS_MOD);
    const XGroup g = xgroup(F);
    const int lane = F.lane, j = lane >> 3, sub = lane & 7;
    const bool jb0 = j & 1;
    for (int rr = 0; rr < 2; ++rr) {
        const int r = g.xg + 8 * rr;
        const unsigned char* tab = PV8 + (size_t)r * RANGE_BYTES + 16 * sub;
        int m = g.gwi;
        v4u ev[4]; f32x4 cf[4];
        if (m < M) {
#pragma unroll
            for (int i = 0; i < 4; ++i) { ev[i] = *(const v4u*)(rtE + (size_t)m * 128 + 16 * j + 4 * i); cf[i] = *(const f32x4*)(COEF + (size_t)m * 128 + 16 * j + 4 * i); }
        }
        for (; m < M; m += g.stride) {
            v4u gt[16];
#pragma unroll
            for (int k = 0; k < 16; ++k) gt[k] = *(const v4u*)(tab + (size_t)ev[k >> 2][k & 3] * 128);
            f32x4 cc[4];
#pragma unroll
            for (int i = 0; i < 4; ++i) cc[i] = cf[i];
            const int mn = m + g.stride;
            if (mn < M) {
#pragma unroll
                for (int i = 0; i < 4; ++i) { ev[i] = *(const v4u*)(rtE + (size_t)mn * 128 + 16 * j + 4 * i); cf[i] = *(const f32x4*)(COEF + (size_t)mn * 128 + 16 * j + 4 * i); }
            }
            f32x2 acc[8];
#pragma unroll
            for (int i = 0; i < 8; ++i) acc[i] = (f32x2){0.f, 0.f};
#pragma unroll
            for (int k = 0; k < 16; ++k) { const float c = cc[k >> 2][k & 3]; const f32x2 cv2 = {c, c};
#pragma unroll
                for (int d = 0; d < 4; ++d) { const unsigned wd = gt[k][d]; acc[2 * d] += cv2 * cvt2_fp8(wd, false); acc[2 * d + 1] += cv2 * cvt2_fp8(wd, true); } }
            float a[16];
#pragma unroll
            for (int i = 0; i < 8; ++i) { a[2 * i] = acc[i].x; a[2 * i + 1] = acc[i].y; }
            float s8[8], s4[4];
#pragma unroll
            for (int c = 0; c < 8; ++c) { auto rr2 = __builtin_amdgcn_permlane32_swap(__float_as_uint(a[c]), __float_as_uint(a[c + 8]), false, false); s8[c] = __uint_as_float(rr2[0]) + __uint_as_float(rr2[1]); }
#pragma unroll
            for (int c = 0; c < 4; ++c) { auto rr2 = __builtin_amdgcn_permlane16_swap(__float_as_uint(s8[c]), __float_as_uint(s8[c + 4]), false, false); s4[c] = __uint_as_float(rr2[0]) + __uint_as_float(rr2[1]); }
            f32x2 res;
            { const float mine = jb0 ? s4[2] : s4[0], send = jb0 ? s4[0] : s4[2]; res.x = mine + dpp_f<0x128>(send); }
            { const float mine = jb0 ? s4[3] : s4[1], send = jb0 ? s4[1] : s4[3]; res.y = mine + dpp_f<0x128>(send); }
            const int col = 128 * r + 16 * sub + 2 * j;
            unsigned* orow = (unsigned*)((bf16*)(F.ws + WS_HB) + (size_t)m * DM + col);
            const unsigned hw = *orow; const f32x2 h1 = {bflo(hw), bfhi(hw)}, g2 = *(const f32x2*)(mod + (size_t)(m / SEQ) * MODW + 5 * DM + col);
            const f32x2 h2 = h1 + g2 * res;
            *orow = pk2(h2.x, h2.y);
        }
    }
}
#define XB_TMO      128
#define XB_XCNT(j)  (256  + 64 * (j))
#define XB_XSUB(j)  (1280 + 64 * (j))
#define XB_XGEN(j)  (2304 + 64 * (j))
#define XB_TOP      3328
#define XB_TOPGEN   3392
#define XCD_BAR_WORDS 3456
#define XB_SPIN_CAP (1u << 18)

__device__ __forceinline__ unsigned xb_ld(unsigned* p)              { return __hip_atomic_load(p, __ATOMIC_RELAXED, __HIP_MEMORY_SCOPE_AGENT); }
__device__ __forceinline__ unsigned xb_add(unsigned* p, unsigned v) { return __hip_atomic_fetch_add(p, v, __ATOMIC_RELAXED, __HIP_MEMORY_SCOPE_AGENT); }
__device__ __forceinline__ unsigned xb_xcc_id() { return (unsigned)__builtin_amdgcn_s_getreg((3 << 11) | 20) & 0xFu; }
#define XB_SPIN(cond, bar) do { unsigned _sp = 0; while (cond) { __builtin_amdgcn_s_sleep(1); \
    if ((++_sp & 255u) == 0u) { if (xb_ld(&(bar)[XB_TMO])) break; if (_sp > XB_SPIN_CAP) { atomicAdd(&(bar)[XB_TMO], 1u); break; } } } } while (0)

struct XcdBarrier {
    unsigned* bar; unsigned x;
    volatile LAS unsigned* st;
};

__device__ __forceinline__ XcdBarrier xcd_barrier_post(unsigned* bar, volatile LAS unsigned* st) {
    XcdBarrier b; b.bar = bar; b.x = xb_xcc_id(); b.st = st;
    if (threadIdx.x == 0) (void)xb_add(&bar[XB_XCNT(b.x)], 1u);
    return b;
}
__device__ __forceinline__ void xcd_barrier_complete(unsigned* bar, unsigned x, unsigned& nloc, unsigned& nx) {
    const unsigned G = gridDim.x * gridDim.y * gridDim.z;
    unsigned sum, cnt, mine, sp = 0u;
    for (;;) {
        sum = 0u; cnt = 0u; mine = 0u;
#pragma unroll
        for (unsigned j = 0; j < 16; ++j) { const unsigned c = xb_ld(&bar[XB_XCNT(j)]); sum += c; cnt += (c > 0u) ? 1u : 0u; mine = (j == x) ? c : mine; }
        if (sum == G) break;
        __builtin_amdgcn_s_sleep(1);
        if ((++sp & 255u) == 0u) { if (xb_ld(&bar[XB_TMO])) break; if (sp > XB_SPIN_CAP) { atomicAdd(&bar[XB_TMO], 1u); break; } }
    }
    nloc = mine > 0u ? mine : 1u; nx = cnt > 0u ? cnt : 1u;
}

__device__ __forceinline__ void xcd_barrier(const XcdBarrier& b) {
    asm volatile("s_waitcnt vmcnt(0)" ::: "memory");
    __syncthreads();
    if (threadIdx.x == 0) {
        unsigned* bar = b.bar;
        __builtin_amdgcn_s_waitcnt(0);
        unsigned nloc = b.st[0], nx = b.st[1];
        if (nloc == 0u) { xcd_barrier_complete(bar, b.x, nloc, nx); b.st[0] = nloc; b.st[1] = nx; }
        const unsigned old = xb_add(&bar[XB_XSUB(b.x)], 1u);
        const unsigned gen = old / nloc;
        if (old + 1u == (gen + 1u) * nloc) {
            __builtin_amdgcn_fence(__ATOMIC_RELEASE, "agent");
            asm volatile("s_waitcnt vmcnt(0)" ::: "memory");
            const unsigned og = xb_add(&bar[XB_TOP], 1u);
            const unsigned tg = og / nx;
            if (og + 1u == (tg + 1u) * nx) xb_add(&bar[XB_TOPGEN], 1u);
            else XB_SPIN(xb_ld(&bar[XB_TOPGEN]) == tg, bar);
            __builtin_amdgcn_fence(__ATOMIC_ACQUIRE, "agent");
            xb_add(&bar[XB_XGEN(b.x)], 1u);
            asm volatile("s_waitcnt vmcnt(0)" ::: "memory");
        } else {
            XB_SPIN(xb_ld(&bar[XB_XGEN(b.x)]) == gen, bar);
            __builtin_amdgcn_fence(__ATOMIC_ACQUIRE, "agent");
            asm volatile("s_waitcnt vmcnt(0)" ::: "memory");
        }
    }
    __syncthreads();
}

struct Args { const float* in[N_IN]; float* out; unsigned char* ws; int ph_lo, ph_hi; };
constexpr int N_PHASES = 15;

__global__ void __launch_bounds__(NTHR, 2) fwd_kernel(Args args) {
    extern __shared__ __attribute__((aligned(16))) unsigned char lds_raw[];
    cg::grid_group grid = cg::this_grid();
    Ctx F;
    F.lds = (LAS unsigned char*)lds_raw;
    F.tid = threadIdx.x; F.lane = F.tid & 63; F.wave = __builtin_amdgcn_readfirstlane(F.tid >> 6);
    F.G = gridDim.x; F.gw = blockIdx.x * NWAVES + F.wave; F.NGW = F.G * NWAVES;
    F.in = args.in; F.out = args.out; F.ws = args.ws;
    const int lo = args.ph_lo, hi = args.ph_hi;
    volatile LAS unsigned* bst = (volatile LAS unsigned*)(F.lds + RING_BYTES + 64);
    if (F.tid < 2) bst[F.tid] = 0u;
    __syncthreads();
    const XcdBarrier bar = xcd_barrier_post((unsigned*)(F.ws + WS_CTL) + 4096, bst);
#define IN(k) (lo <= (k) && (k) < hi)
#define REP_MASK 0
#ifndef REP_MASK
#define REP_MASK 0
#endif
#define REPS(k) for (int rep_ = 0; rep_ < 1 + ((REP_MASK >> (k)) & 1); ++rep_)
#define SEAM(k) do { if (IN(k) && IN((k) + 1)) { if ((k) == 0) grid.sync(); else xcd_barrier(bar); } } while (0)

    if (IN(0)) REPS(0) { p0_prologue(F); }
    SEAM(0);
    if (IN(1)) REPS(1) { norm_mod_rows(F, F.in[I_X], F.in[I_N1W], 0, DM, (bf16*)(F.ws + WS_XN)); }
    SEAM(1);
    if (IN(2)) REPS(2) {
        pg8::Gemm g{(const pg8::bf16_t*)(F.ws + WS_XN), (const pg8::bf16_t*)(F.ws + WS_WIN), M, INPP, DM};
        pg8::StaticOrder S; S.init(M, INPP, F.G, (int)blockIdx.x);
        pg8::EpiStoreBf16 E{(pg8::bf16_t*)(F.ws + WS_PROJ), INPP};
        pg8::gemm_phase<pg8::EpiStoreBf16, pg8::StaticOrder, true, true>(F.lds, g, S, E);
    }
    SEAM(2);
#ifndef P3REP
#define P3REP 0
#endif
    if (IN(3)) REPS(3) { p3_lora(F); if (P3REP == 1) p3_lora(F); m1_chunk_states(F); if (P3REP == 2) m1_chunk_states(F); }
    SEAM(3);
    if (IN(4)) REPS(4) { m2_prefix(F); p4_scans(F); }
    SEAM(4);
    if (IN(5)) REPS(5) { m3_outputs(F); }
    SEAM(5);
    if (IN(6)) { p5_post(F); }
    SEAM(6);
    if (IN(7)) REPS(7) {
        pg8::Gemm g{(const pg8::bf16_t*)(F.ws + WS_OY), (const pg8::bf16_t*)(F.ws + WS_WOUT), M, DM, DM};
        pg8::StaticOrder S; S.init(M, DM, F.G, (int)blockIdx.x);
        pg8::EpiResid E{F.in[I_X], (const float*)(F.ws + WS_MOD) + 2 * DM, (pg8::bf16_t*)(F.ws + WS_HB), DM, SEQ, MODW};
        pg8::gemm_phase<pg8::EpiResid, pg8::StaticOrder, true, true>(F.lds, g, S, E);
    }
    SEAM(7);
    if (IN(8)) REPS(8) { norm_mod_rows_bf16(F, (const bf16*)(F.ws + WS_HB), F.in[I_N2W], 3 * DM, 4 * DM, (bf16*)(F.ws + WS_XN)); }
    SEAM(8);
    if (IN(9)) REPS(9) {
        pg8::Gemm g{(const pg8::bf16_t*)(F.ws + WS_XN), (const pg8::bf16_t*)(F.ws + WS_WQ), M, DM, DM};
        pg8::StaticOrder S; S.init(M, DM, F.G, (int)blockIdx.x);
        pg8::EpiStoreBf16 E{(pg8::bf16_t*)(F.ws + WS_Q), DM};
        pg8::gemm_phase<pg8::EpiStoreBf16, pg8::StaticOrder, true, true>(F.lds, g, S, E);
    }
    SEAM(9);
    if (IN(10)) REPS(10) { p9_route(F); }
    SEAM(10);
    if (IN(11)) REPS(11) { p10_peer_u(F); }
    SEAM(11);
    if (IN(12)) REPS(12) { p11_peer_coef(F); }
    SEAM(12);
    if (IN(13)) { p12_peer_v(F); }
    SEAM(13);
    if (IN(14)) { final_norm_rows_bf16(F, (const bf16*)(F.ws + WS_HB), F.in[I_FNW], F.out); }
#undef IN
#undef SEAM
}

extern "C" void kernel_launch(void* const* d_in, const int* in_sizes, int n_in, void* d_out, int out_size, void* d_ws, size_t ws_size, hipStream_t stream) {
    static int grid = 0;
    if (grid == 0) {
        if (n_in != N_IN || in_sizes[0] != M * DM || out_size != M * DM || ws_size < WS_END2) {
            fprintf(stderr, "kernel_launch: unexpected shapes: n_in %d in0 %d out %d ws %zu (need %zu)\n", n_in, n_in > 0 ? in_sizes[0] : -1, out_size, ws_size, (size_t)WS_END2); grid = -1; return; }
        int dev = 0, cus = 0, per_cu = 0;
        if (hipGetDevice(&dev) != hipSuccess || hipDeviceGetAttribute(&cus, hipDeviceAttributeMultiprocessorCount, dev) != hipSuccess) { grid = -1; return; }
        if (hipFuncSetAttribute((const void*)fwd_kernel, hipFuncAttributeMaxDynamicSharedMemorySize, LDS_BYTES) != hipSuccess) { fprintf(stderr, "kernel_launch: hipFuncSetAttribute failed\n"); grid = -1; return; }
        if (hipOccupancyMaxActiveBlocksPerMultiprocessor(&per_cu, (const void*)fwd_kernel, NTHR, LDS_BYTES) != hipSuccess || per_cu < 1) { fprintf(stderr, "kernel_launch: occupancy query says %d blocks per CU\n", per_cu); per_cu = 1; }
        (void)hipGetLastError();
        grid = cus;
        fprintf(stderr, "kernel_launch: cus %d per_cu %d grid %d ws %zu\n", cus, per_cu, grid, ws_size);
    }
    if (grid < 0) return;
    (void)hipMemsetAsync((char*)d_ws + WS_CTL, 0, CTL_ZERO_BYTES, stream);
    Args a{};
    for (int i = 0; i < N_IN; ++i) a.in[i] = (const float*)d_in[i];
    a.out = (float*)d_out; a.ws = (unsigned char*)d_ws; a.ph_lo = 0; a.ph_hi = N_PHASES;
    void* kargs[] = {&a};
    hipError_t e = hipLaunchCooperativeKernel((const void*)fwd_kernel, dim3(grid), dim3(NTHR), kargs, LDS_BYTES, stream);
    if (e != hipSuccess) fprintf(stderr, "kernel_launch: cooperative launch failed: %s (grid %d)\n", hipGetErrorString(e), grid);
}
```

```cpp
#include <hip/hip_runtime.h>
#include <hip/hip_cooperative_groups.h>
#include <cstdio>
#include <cstdint>
namespace cg = cooperative_groups;
namespace pg8 {
#define PG8_LAS __attribute__((address_space(3)))
typedef unsigned short bf16_t;
typedef short bf16x8 __attribute__((ext_vector_type(8)));
typedef float f32x4 __attribute__((ext_vector_type(4)));
typedef unsigned u32x4 __attribute__((ext_vector_type(4)));
constexpr int BM = 256, BK = 64, HALF = 128, HTB = HALF * BK * 2  , STAGE_BYTES = 8 * HTB, NXCD = 8, WGM = 8;

__host__ __device__ __forceinline__ int lds_byte(int r, int c) { const int st = (r >> 4) * 2 + (c >> 5), rr = r & 15, cc = c & 31, ob = rr * 64 + cc * 2; return st * 1024 + (ob ^ (((ob >> 9) & 1) << 5)); }
__host__ __device__ __forceinline__ void stage_rc(int b, int& R, int& C) { const int st = b / 1024, sb = b % 1024, swz = sb ^ (((sb >> 9) & 1) << 5); R = (st >> 1) * 16 + swz / 64; C = (st & 1) * 32 + (swz % 64) / 2; }
__host__ __device__ __forceinline__ int perm32(int rho) { const int n = rho >> 4, i = rho & 15; return 8 * (i >> 2) + 4 * n + (i & 3); }

struct Unit { int pm, pn; };
struct Gemm { const bf16_t* A; const bf16_t* Bt; int M, N, K; };

struct StaticOrder {
    int nM, nN, nwg, G, c;
    __host__ __device__ void init(int M, int N, int G_, int c_) { nM = M / BM; nN = N / BM; nwg = nM * nN; G = G_; c = c_; }
    __host__ __device__ bool next(int i, Unit& u) const {
        const long L = (long)i * G + c; if (L >= nwg) return false;
        int wgid = (int)L; { const int q = nwg / NXCD, r = nwg % NXCD, xcd = wgid % NXCD, off = wgid / NXCD; wgid = (xcd < r ? xcd * (q + 1) : r * (q + 1) + (xcd - r) * q) + off; }
        const int nig = WGM * nN, gid = wgid / nig, fm = gid * WGM, gsz = (nM - fm) < WGM ? (nM - fm) : WGM;
        u.pm = fm + ((wgid % nig) % gsz); u.pn = (wgid % nig) / gsz; return true;
    }
    __device__ __forceinline__ void a_ready(const Unit&) const {}
    __device__ __forceinline__ void done(const Unit&) const {}
};
__device__ __forceinline__ unsigned cvt_pk_bf16(float lo, float hi) { unsigned r; asm volatile("v_cvt_pk_bf16_f32 %0, %1, %2" : "=v"(r) : "v"(lo), "v"(hi)); return r; }
struct EpiStoreBf16 {
    static constexpr bool PERM = true, AFTER_DRAIN = false;
    bf16_t* O; int ldc;
    __device__ __forceinline__ void operator()(const f32x4 (&acc)[2][2][4][2], const Unit& u, int wr, int wc, int fr, int fq) const {
        const int row0 = u.pm * BM + wr * 64 + fr; const int col0 = u.pn * BM + wc * 32 + 8 * fq;
#pragma unroll
        for (int ai = 0; ai < 2; ++ai)
#pragma unroll
            for (int m = 0; m < 4; ++m) { bf16_t* rowp = O + (size_t)(row0 + ai * HALF + m * 16) * ldc + col0;
#pragma unroll
                for (int bj = 0; bj < 2; ++bj) { const f32x4 v0 = acc[ai][bj][m][0], v1 = acc[ai][bj][m][1];
                    u32x4 w; w.x = cvt_pk_bf16(v0[0], v0[1]); w.y = cvt_pk_bf16(v0[2], v0[3]); w.z = cvt_pk_bf16(v1[0], v1[1]); w.w = cvt_pk_bf16(v1[2], v1[3]);
                    *(u32x4*)(rowp + bj * HALF) = w; } }
    }
};
struct EpiResid {
    static constexpr bool PERM = true, AFTER_DRAIN = false;
    const float* X; const float* gate; bf16_t* O; int ldc; int rows_per_batch; int gstride;
    __device__ __forceinline__ void operator()(const f32x4 (&acc)[2][2][4][2], const Unit& u, int wr, int wc, int fr, int fq) const {
        const int row0 = u.pm * BM + wr * 64 + fr; const int col0 = u.pn * BM + wc * 32 + 8 * fq;
        const float* g = gate + (size_t)((u.pm * BM) / rows_per_batch) * gstride + col0;
        f32x4 gv[2][2];
#pragma unroll
        for (int bj = 0; bj < 2; ++bj)
#pragma unroll
            for (int n = 0; n < 2; ++n) gv[bj][n] = *(const f32x4*)(g + bj * HALF + 4 * n);
#pragma unroll
        for (int ai = 0; ai < 2; ++ai)
#pragma unroll
            for (int m = 0; m < 4; ++m) { const size_t off = (size_t)(row0 + ai * HALF + m * 16) * ldc + col0;
#pragma unroll
                for (int bj = 0; bj < 2; ++bj) { const f32x4 x0 = *(const f32x4*)(X + off + bj * HALF), x1 = *(const f32x4*)(X + off + bj * HALF + 4);
                    const f32x4 v0 = x0 + gv[bj][0] * acc[ai][bj][m][0], v1 = x1 + gv[bj][1] * acc[ai][bj][m][1];
                    u32x4 w; w.x = cvt_pk_bf16(v0[0], v0[1]); w.y = cvt_pk_bf16(v0[2], v0[3]); w.z = cvt_pk_bf16(v1[0], v1[1]); w.w = cvt_pk_bf16(v1[2], v1[3]);
                    *(u32x4*)(O + off + bj * HALF) = w; } }
    }
};
template <class Epi, class Sched, bool ALIGN_EPI = false, bool SP2 = false>
__device__ __forceinline__ void gemm_phase(PG8_LAS unsigned char* lds, const Gemm g, const Sched& S, const Epi& E) {
    const int tid = threadIdx.x, wid = __builtin_amdgcn_readfirstlane(tid >> 6), lane = tid & 63, wr = wid >> 2, wc = wid & 3, fr = lane & 15, fq = lane >> 4;
    const int K = g.K, nt = K / BK;
    unsigned voffA[2], voffB[2];
#pragma unroll
    for (int i = 0; i < 2; ++i) { int R, C; stage_rc(tid * 16 + i * 8192, R, C); const int Rb = Epi::PERM ? ((R & ~31) + perm32(R & 31)) : R;
        voffA[i] = (unsigned)(R * K + C) * 2u; voffB[i] = (unsigned)(Rb * K + C) * 2u; }
    const size_t kstep = (size_t)(BK * 2);
    const size_t hstep = (size_t)HALF * K * 2;
    const size_t tstep = 2 * hstep;
    const unsigned ldsw = (unsigned)wid * 1024u;
    const int aoff = lds_byte(wr * 64 + fr, fq * 8), boff = lds_byte(wc * 32 + fr, fq * 8);
#define PG8_SA(b, h) (((b) * 2 + (h)) * HTB)
#define PG8_SB(b, h) ((4 + (b) * 2 + (h)) * HTB)
#define PG8_STAGE(bufoff, gbase, voff) do { _Pragma("unroll") for (int _i = 0; _i < 2; ++_i) \
        __builtin_amdgcn_global_load_lds((const unsigned*)((const char*)(gbase) + (voff)[_i]), (PG8_LAS unsigned*)(lds + (bufoff) + ldsw + _i * 8192), 16, 0, 0); } while (0)
#define PG8_LDA(dst, b, h) do { _Pragma("unroll") for (int m = 0; m < 4; ++m) _Pragma("unroll") for (int k = 0; k < 2; ++k) dst[m][k] = *(const PG8_LAS bf16x8*)(lds + PG8_SA(b, h) + aoff + m * 2048 + k * 1024); } while (0)
#define PG8_LDB(dst, b, h) do { _Pragma("unroll") for (int n = 0; n < 2; ++n) _Pragma("unroll") for (int k = 0; k < 2; ++k) dst[n][k] = *(const PG8_LAS bf16x8*)(lds + PG8_SB(b, h) + boff + n * 2048 + k * 1024); } while (0)
#define PG8_MMA(ai, bj, At, Bt) do { __builtin_amdgcn_s_setprio(1); _Pragma("unroll") for (int m = 0; m < 4; ++m) _Pragma("unroll") for (int n = 0; n < 2; ++n) _Pragma("unroll") for (int k = 0; k < 2; ++k) \
        acc[ai][bj][m][n] = __builtin_amdgcn_mfma_f32_16x16x32_bf16(Bt[n][k], At[m][k], acc[ai][bj][m][n], 0, 0, 0); __builtin_amdgcn_s_setprio(0); } while (0)
#define PG8_WAIT_V(n) asm volatile("s_waitcnt vmcnt(" #n ")" ::: "memory")
#define PG8_WAIT_L(n) asm volatile("s_waitcnt lgkmcnt(" #n ")" ::: "memory")
#define PG8_BAR __builtin_amdgcn_s_barrier()
#define PG8_SCHED __builtin_amdgcn_sched_barrier(0)
    Unit cur, nxt; int ui = 0;
    if (!S.next(0, cur)) return;
    f32x4 acc[2][2][4][2];
#pragma unroll
    for (int a = 0; a < 2; ++a)
#pragma unroll
        for (int b = 0; b < 2; ++b)
#pragma unroll
            for (int m = 0; m < 4; ++m)
#pragma unroll
                for (int n = 0; n < 2; ++n) acc[a][b][m][n] = (f32x4){0.f, 0.f, 0.f, 0.f};
    bf16x8 At[4][2], B0[2][2], B1[2][2];
    const char* cA = (const char*)g.A + (size_t)cur.pm * tstep; const char* cB = (const char*)g.Bt + (size_t)cur.pn * tstep;
    S.a_ready(cur);
    if constexpr (SP2) {
        PG8_STAGE(PG8_SB(0, 0), cB, voffB); PG8_STAGE(PG8_SB(0, 1), cB + hstep, voffB); PG8_STAGE(PG8_SA(0, 0), cA, voffA); PG8_STAGE(PG8_SA(0, 1), cA + hstep, voffA);
        if (wr == 1) PG8_BAR;
        PG8_WAIT_V(2); PG8_BAR;
        PG8_STAGE(PG8_SB(1, 0), cB + kstep, voffB); PG8_STAGE(PG8_SA(1, 0), cA + kstep, voffA); PG8_STAGE(PG8_SB(1, 1), cB + hstep + kstep, voffB);
        PG8_WAIT_V(6); PG8_BAR;
    } else {
        PG8_STAGE(PG8_SB(0, 0), cB, voffB); PG8_STAGE(PG8_SA(0, 0), cA, voffA); PG8_STAGE(PG8_SB(0, 1), cB + hstep, voffB); PG8_STAGE(PG8_SA(0, 1), cA + hstep, voffA);
        if (wr == 1) PG8_BAR;
        PG8_WAIT_V(4); PG8_BAR;
        PG8_STAGE(PG8_SB(1, 0), cB + kstep, voffB); PG8_STAGE(PG8_SA(1, 0), cA + kstep, voffA); PG8_STAGE(PG8_SB(1, 1), cB + hstep + kstep, voffB);
        PG8_WAIT_V(6); PG8_BAR;
    }
    for (;;) {
        const bool has_next = S.next(ui + 1, nxt);
        const char* nA = has_next ? (const char*)g.A + (size_t)nxt.pm * tstep : cA; const char* nB = has_next ? (const char*)g.Bt + (size_t)nxt.pn * tstep : cB;
        for (int t = 0; t < nt; t += 2) {
            const bool last = (t == nt - 2);
            const char* a1 = cA + (size_t)(t + 1) * kstep;
            const char* a2 = last ? nA : cA + (size_t)(t + 2) * kstep; const char* b2 = last ? nB : cB + (size_t)(t + 2) * kstep;
            const char* a3 = a2 + kstep; const char* b3 = b2 + kstep;
            if (last && has_next) S.a_ready(nxt);
            if constexpr (SP2) {
            PG8_LDB(B0, 0, 0); PG8_LDB(B1, 0, 1); PG8_SCHED; PG8_LDA(At, 0, 0); PG8_STAGE(PG8_SA(1, 1), a1 + hstep, voffA);
            PG8_WAIT_V(8); PG8_WAIT_L(0); PG8_BAR; PG8_MMA(0, 0, At, B0); PG8_MMA(0, 1, At, B1); PG8_BAR; PG8_SCHED;
            PG8_LDA(At, 0, 1); PG8_STAGE(PG8_SB(0, 0), b2, voffB); PG8_STAGE(PG8_SB(0, 1), b2 + hstep, voffB); PG8_STAGE(PG8_SA(0, 0), a2, voffA);
            PG8_WAIT_V(8); PG8_WAIT_L(0); PG8_BAR; PG8_MMA(1, 0, At, B0); PG8_MMA(1, 1, At, B1); PG8_BAR; PG8_SCHED;
            PG8_LDB(B0, 1, 0); PG8_LDB(B1, 1, 1); PG8_SCHED; PG8_LDA(At, 1, 0); PG8_STAGE(PG8_SA(0, 1), a2 + hstep, voffA);
            PG8_WAIT_V(8); PG8_WAIT_L(0); PG8_BAR; PG8_MMA(0, 0, At, B0); PG8_MMA(0, 1, At, B1); PG8_BAR; PG8_SCHED;
            PG8_LDA(At, 1, 1); PG8_STAGE(PG8_SB(1, 0), b3, voffB); PG8_STAGE(PG8_SB(1, 1), b3 + hstep, voffB); PG8_STAGE(PG8_SA(1, 0), a3, voffA);
            PG8_WAIT_V(8); PG8_WAIT_L(0); PG8_BAR; PG8_MMA(1, 0, At, B0); PG8_MMA(1, 1, At, B1); PG8_BAR; PG8_SCHED;
            } else {
            PG8_LDB(B0, 0, 0); PG8_SCHED; PG8_LDA(At, 0, 0); PG8_STAGE(PG8_SA(1, 1), a1 + hstep, voffA);
            PG8_WAIT_L(8); PG8_BAR; PG8_WAIT_L(0); PG8_MMA(0, 0, At, B0); PG8_BAR; PG8_SCHED;
            PG8_LDB(B1, 0, 1); PG8_STAGE(PG8_SB(0, 0), b2, voffB);
            PG8_BAR; PG8_WAIT_L(0); PG8_MMA(0, 1, At, B1); PG8_BAR;
            PG8_LDA(At, 0, 1); PG8_STAGE(PG8_SA(0, 0), a2, voffA);
            PG8_BAR; PG8_WAIT_L(0); PG8_MMA(1, 0, At, B0); PG8_BAR; PG8_SCHED;
            PG8_STAGE(PG8_SB(0, 1), b2 + hstep, voffB);
            PG8_WAIT_V(6); PG8_BAR; PG8_MMA(1, 1, At, B1); PG8_BAR;
            PG8_LDB(B0, 1, 0); PG8_SCHED; PG8_LDA(At, 1, 0); PG8_STAGE(PG8_SA(0, 1), a2 + hstep, voffA);
            PG8_WAIT_L(8); PG8_BAR; PG8_WAIT_L(0); PG8_MMA(0, 0, At, B0); PG8_BAR; PG8_SCHED;
            PG8_LDB(B1, 1, 1); PG8_STAGE(PG8_SB(1, 0), b3, voffB);
            PG8_BAR; PG8_WAIT_L(0); PG8_MMA(0, 1, At, B1); PG8_BAR;
            PG8_LDA(At, 1, 1); PG8_STAGE(PG8_SA(1, 0), a3, voffA);
            PG8_BAR; PG8_WAIT_L(0); PG8_MMA(1, 0, At, B0); PG8_BAR; PG8_SCHED;
            PG8_STAGE(PG8_SB(1, 1), b3 + hstep, voffB);
            PG8_WAIT_V(6); PG8_BAR; PG8_MMA(1, 1, At, B1); PG8_BAR;
            }
        }
        if constexpr (ALIGN_EPI) { if (wr == 0) PG8_BAR; }
        if constexpr (!Epi::AFTER_DRAIN) { E(acc, cur, wr, wc, fr, fq); S.done(cur); }
        if (!has_next) break;
#pragma unroll
        for (int a = 0; a < 2; ++a)
#pragma unroll
            for (int b = 0; b < 2; ++b)
#pragma unroll
                for (int m = 0; m < 4; ++m)
#pragma unroll
                    for (int n = 0; n < 2; ++n) acc[a][b][m][n] = (f32x4){0.f, 0.f, 0.f, 0.f};
        cur = nxt; cA = nA; cB = nB; ++ui;
        if constexpr (ALIGN_EPI) { if (wr == 1) PG8_BAR; }
    }
    PG8_WAIT_V(0);
    if constexpr (!ALIGN_EPI) { if (wr == 0) PG8_BAR; }
    PG8_BAR;
    if constexpr (Epi::AFTER_DRAIN) { E.fused(acc, cur, wr, wc, fr, fq, lds, wid, lane); S.done(cur); }
#undef PG8_SA
#undef PG8_SB
#undef PG8_STAGE
#undef PG8_LDA
#undef PG8_LDB
#undef PG8_MMA
#undef PG8_WAIT_V
#undef PG8_WAIT_L
#undef PG8_BAR
#undef PG8_SCHED
}
}
#define GAS __attribute__((address_space(1)))
#define LAS __attribute__((address_space(3)))
typedef unsigned short bf16;
typedef unsigned v4u __attribute__((ext_vector_type(4)));
typedef unsigned v2u __attribute__((ext_vector_type(2)));
typedef float f32x4 __attribute__((ext_vector_type(4)));
typedef float f32x2 __attribute__((ext_vector_type(2)));
typedef short bf16x8 __attribute__((ext_vector_type(8)));
typedef __bf16 bf16x2_t __attribute__((ext_vector_type(2)));

constexpr int NWAVES = 8, NTHR = 512;
constexpr int DM = 2048, NB = 4, SEQ = 8192, M = NB * SEQ;
constexpr int RW = 1024, RHEADS = 16, HD = 64;
constexpr int L_W = 64, L_A = 64, L_G = 160;
constexpr int INP = 5936, INPP = 6144;
constexpr int C_R = 0, C_K = 1024, C_V = 2048, C_WD = 3072, C_AD = 3136, C_GD = 3200, C_Z = 3360, C_XBC = 4384, C_DT = 5920;
constexpr int MODW = 6 * DM;
constexpr int NEXP = 16384;
constexpr float RMS_EPS = 1e-6f;

enum { I_X = 0, I_C, I_ADAW, I_ADAB, I_N1W, I_WIN, I_MU, I_W0, I_WUP, I_A0, I_AUP, I_GUP, I_KK, I_KA, I_RK, I_LNW, I_LNB,
       I_CONVW, I_CONVB, I_DTB, I_ALOG, I_DSK, I_MNW, I_WOUT, I_N2W, I_WQ, I_KEYS, I_PU, I_PV, I_FNW, N_IN };

constexpr size_t MiB = 1u << 20;
constexpr size_t WS_CTL = 0, CTL_ZERO_BYTES = 1 * MiB;
constexpr size_t WS_MOD = 1 * MiB;
constexpr size_t WS_WIN = 2 * MiB, WS_WOUT = 26 * MiB, WS_WQ = 34 * MiB, WS_KEYS = 42 * MiB;
constexpr size_t WS_WUPT = 43 * MiB, WS_AUPT = 43 * MiB + 256 * 1024, WS_GUPT = 43 * MiB + 512 * 1024;
constexpr size_t WS_PU8 = 44 * MiB, WS_PV8 = 76 * MiB;
constexpr size_t WS_USC = 108 * MiB, WS_VSC = 108 * MiB + 65536;
constexpr size_t WS_XN = 172 * MiB;
constexpr size_t WS_LW = WS_XN, WS_AA = WS_XN + 64 * MiB;
constexpr size_t WS_PROJ = 300 * MiB;
constexpr size_t WS_Q = WS_PROJ;
constexpr size_t WS_GG = 684 * MiB;
constexpr size_t WS_PD = WS_PROJ + 128 * MiB;
constexpr size_t WS_RTE = 684 * MiB, WS_RTG = 700 * MiB, WS_COEF = 716 * MiB;
constexpr size_t WS_OY = 748 * MiB;
constexpr size_t WS_END = 876 * MiB;
constexpr size_t WS_HB = 876 * MiB;

constexpr int RING_BYTES = 131072, LDS_BYTES = 147456;

#define LDS_WAIT() asm volatile("s_waitcnt lgkmcnt(0)" ::: "memory")
#define VM_WAIT() asm volatile("s_waitcnt vmcnt(0)" ::: "memory")
__device__ __forceinline__ unsigned pk2(float lo, float hi) { f32x2 v = {lo, hi}; bf16x2_t b = __builtin_convertvector(v, bf16x2_t); return __builtin_bit_cast(unsigned, b); }
__device__ __forceinline__ float bflo(unsigned u) { return __uint_as_float(u << 16); }
__device__ __forceinline__ float bfhi(unsigned u) { return __uint_as_float(u & 0xffff0000u); }
__device__ __forceinline__ float bf1(bf16 h) { return __uint_as_float((unsigned)h << 16); }
__device__ __forceinline__ float wave_sum(float v) {
#pragma unroll
    for (int o = 1; o < 64; o <<= 1) v += __shfl_xor(v, o);
    return v;
}
__device__ __forceinline__ float rcp_f(float v) { return __builtin_amdgcn_rcpf(v); }
__device__ __forceinline__ float silu_f(float v) { return v * rcp_f(1.f + __expf(-v)); }
__device__ __forceinline__ float sigmoid_f(float v) { return rcp_f(1.f + __expf(-v)); }

struct Ctx {
    LAS unsigned char* lds;
    int tid, lane, wave, G, gw, NGW;
    const float* const* in;
    float* out; unsigned char* ws;
};

__device__ __forceinline__ void transpose_item(const float* W, int K, int N, bf16* WT, int ldt, int nrows_out, LAS float* scr, int kb, int nb, int lane) {
    const int k0 = 64 * kb, n0 = 32 * nb;
#pragma unroll 8
    for (int i = 0; i < 32; ++i) { const int kk = 2 * i + (lane >> 5), k = k0 + kk, n = n0 + (lane & 31);
        scr[kk * 33 + (lane & 31)] = (k < K && n < N) ? W[(size_t)k * N + n] : 0.f; }
    LDS_WAIT(); asm volatile("" ::: "memory");
    const int c = lane & 7;
#pragma unroll
    for (int j = 0; j < 4; ++j) { const int n = (lane >> 3) + 8 * j; const LAS float* s = scr + (8 * c) * 33 + n;
        v4u o; o.x = pk2(s[0 * 33], s[1 * 33]); o.y = pk2(s[2 * 33], s[3 * 33]); o.z = pk2(s[4 * 33], s[5 * 33]); o.w = pk2(s[6 * 33], s[7 * 33]);
        if (n0 + n < nrows_out && k0 + 8 * c + 8 <= ldt) *(v4u*)(WT + (size_t)(n0 + n) * ldt + k0 + 8 * c) = o; }
    LDS_WAIT(); asm volatile("" ::: "memory");
}
__device__ __forceinline__ void transpose_all(const float* W, int K, int N, bf16* WT, int ldt, int nrows_out, LAS float* scr, int gw, int NGW, int lane) {
    const int nkb = (K + 63) / 64, nnb = nrows_out / 32, nit = nkb * nnb;
    for (int it = gw; it < nit; it += NGW) transpose_item(W, K, N, WT, ldt, nrows_out, scr, it / nnb, it % nnb, lane);
}
__device__ __forceinline__ void convert_all(const float* src, bf16* dst, size_t n8, int gw, int NGW, int lane) {
    const f32x4* s4 = (const f32x4*)src; v4u* d4 = (v4u*)dst;
    for (size_t i = (size_t)gw * 64 + lane; i < n8; i += (size_t)NGW * 64) {
        const f32x4 a = __builtin_nontemporal_load(s4 + 2 * i), b = __builtin_nontemporal_load(s4 + 2 * i + 1);
        v4u o; o.x = pk2(a.x, a.y); o.y = pk2(a.z, a.w); o.z = pk2(b.x, b.y); o.w = pk2(b.z, b.w);
        d4[i] = o; }
}
__device__ __forceinline__ void quantize_rows_fp8(const float* src, unsigned char* dst8, float* scales, int gw, int NGW, int lane) {
    for (int e = gw; e < NEXP; e += NGW) {
        const f32x4* s4 = (const f32x4*)(src + (size_t)e * DM) + lane;
        f32x4 v[8]; float am = 0.f;
#pragma unroll
        for (int i = 0; i < 8; ++i) { v[i] = __builtin_nontemporal_load(s4 + 64 * i);
            am = fmaxf(fmaxf(am, fmaxf(fabsf(v[i].x), fabsf(v[i].y))), fmaxf(fabsf(v[i].z), fabsf(v[i].w))); }
#pragma unroll
        for (int o = 1; o < 64; o <<= 1) am = fmaxf(am, __shfl_xor(am, o));
        am = fmaxf(am, 1e-30f);
        const float inv = 440.f / am;
#pragma unroll
        for (int i = 0; i < 8; ++i) { int w = __builtin_amdgcn_cvt_pk_fp8_f32(v[i].x * inv, v[i].y * inv, 0, false); w = __builtin_amdgcn_cvt_pk_fp8_f32(v[i].z * inv, v[i].w * inv, w, true);
            const int seg = 2 * i + (lane >> 5);
            *(int*)(dst8 + (size_t)seg * ((size_t)NEXP * 128) + (size_t)e * 128 + 4 * (lane & 31)) = w; }
        if (lane == 0) scales[e] = am * (1.f / 440.f);
    }
}
__device__ __forceinline__ void p0_prologue(const Ctx& F) {
    __syncthreads();
    if (blockIdx.x < MODW / 64) {
        LAS float* sc = (LAS float*)F.lds;
        LAS float* red = sc + NB * DM;
        const float* c = F.in[I_C];
        for (int i = F.tid; i < NB * DM; i += NTHR) sc[i] = silu_f(c[i]);
        __syncthreads();
        const int j = blockIdx.x * 64 + F.lane;
        const float* wp = F.in[I_ADAW] + (size_t)(F.wave * 256) * MODW + j;
        float a0 = 0.f, a1 = 0.f, a2 = 0.f, a3 = 0.f;
#pragma unroll 16
        for (int kk = 0; kk < 256; ++kk) { const float w = wp[(size_t)kk * MODW]; const int k = F.wave * 256 + kk;
            a0 += sc[k] * w; a1 += sc[DM + k] * w; a2 += sc[2 * DM + k] * w; a3 += sc[3 * DM + k] * w; }
        red[(F.wave * 4 + 0) * 64 + F.lane] = a0; red[(F.wave * 4 + 1) * 64 + F.lane] = a1; red[(F.wave * 4 + 2) * 64 + F.lane] = a2; red[(F.wave * 4 + 3) * 64 + F.lane] = a3;
        __syncthreads();
        if (F.tid < 256) { const int b = F.tid >> 6, l = F.tid & 63; float s = F.in[I_ADAB][blockIdx.x * 64 + l];
#pragma unroll
            for (int w = 0; w < 8; ++w) s += red[(w * 4 + b) * 64 + l];
            ((float*)(F.ws + WS_MOD))[b * MODW + blockIdx.x * 64 + l] = s; }
        __syncthreads();
    }
    LAS float* scr = (LAS float*)(F.lds + F.wave * 16384);
    transpose_all(F.in[I_WIN], DM, INP, (bf16*)(F.ws + WS_WIN), DM, INPP, scr, F.gw, F.NGW, F.lane);
    transpose_all(F.in[I_WOUT], DM, DM, (bf16*)(F.ws + WS_WOUT), DM, DM, scr, F.gw, F.NGW, F.lane);
    transpose_all(F.in[I_WQ], DM, DM, (bf16*)(F.ws + WS_WQ), DM, DM, scr, F.gw, F.NGW, F.lane);
    transpose_all(F.in[I_WUP], L_W, RW, (bf16*)(F.ws + WS_WUPT), L_W, RW, scr, F.gw, F.NGW, F.lane);
    transpose_all(F.in[I_AUP], L_A, RW, (bf16*)(F.ws + WS_AUPT), L_A, RW, scr, F.gw, F.NGW, F.lane);
    transpose_all(F.in[I_GUP], L_G, RW, (bf16*)(F.ws + WS_GUPT), L_G, RW, scr, F.gw, F.NGW, F.lane);
    convert_all(F.in[I_KEYS], (bf16*)(F.ws + WS_KEYS), (size_t)16 * 128 * 128 / 8, F.gw, F.NGW, F.lane);
    quantize_rows_fp8(F.in[I_PU], F.ws + WS_PU8, (float*)(F.ws + WS_USC), F.gw, F.NGW, F.lane);
    quantize_rows_fp8(F.in[I_PV], F.ws + WS_PV8, (float*)(F.ws + WS_VSC), F.gw, F.NGW, F.lane);
}

__device__ __forceinline__ void norm_mod_rows(const Ctx& F, const float* X, const float* nw, int shift_off, int scale_off, bf16* XN) {
    const float* mod = (const float*)(F.ws + WS_MOD);
    for (int m = F.gw; m < M; m += F.NGW) {
        const int b = m / SEQ;
        const f32x4* xr = (const f32x4*)(X + (size_t)m * DM) + F.lane;
        f32x4 v[8]; float s = 0.f;
#pragma unroll
        for (int j = 0; j < 8; ++j) { v[j] = xr[64 * j]; s += (v[j].x * v[j].x + v[j].y * v[j].y) + (v[j].z * v[j].z + v[j].w * v[j].w); }
        const float rstd = rsqrtf(wave_sum(s) * (1.f / DM) + RMS_EPS);
        const f32x4* wp = (const f32x4*)nw + F.lane;
        const f32x4* shp = (const f32x4*)(mod + (size_t)b * MODW + shift_off) + F.lane;
        const f32x4* scp = (const f32x4*)(mod + (size_t)b * MODW + scale_off) + F.lane;
        v2u* o = (v2u*)(XN + (size_t)m * DM) + F.lane;
#pragma unroll
        for (int j = 0; j < 8; ++j) { const f32x4 w = wp[64 * j], a = scp[64 * j], c = shp[64 * j];
            const f32x4 r = (v[j] * rstd) * w * (a + 1.f) + c;
            v2u p; p.x = pk2(r.x, r.y); p.y = pk2(r.z, r.w); o[64 * j] = p; }
    }
}
__device__ __forceinline__ void final_norm_rows(const Ctx& F, const float* H, const float* nw, float* O) {
    for (int m = F.gw; m < M; m += F.NGW) {
        const f32x4* xr = (const f32x4*)(H + (size_t)m * DM) + F.lane;
        f32x4 v[8]; float s = 0.f;
#pragma unroll
        for (int j = 0; j < 8; ++j) { v[j] = xr[64 * j]; s += (v[j].x * v[j].x + v[j].y * v[j].y) + (v[j].z * v[j].z + v[j].w * v[j].w); }
        const float rstd = rsqrtf(wave_sum(s) * (1.f / DM) + RMS_EPS);
        const f32x4* wp = (const f32x4*)nw + F.lane;
        f32x4* o = (f32x4*)(O + (size_t)m * DM) + F.lane;
#pragma unroll
        for (int j = 0; j < 8; ++j) o[64 * j] = (v[j] * rstd) * wp[64 * j];
    }
}


__device__ __forceinline__ void load_row_bf16(const bf16* row, int lane, f32x4 (&v)[8]) {
    const v2u* p = (const v2u*)row + lane;
#pragma unroll
    for (int j = 0; j < 8; ++j) { const v2u u = p[64 * j]; v[j] = (f32x4){bflo(u.x), bfhi(u.x), bflo(u.y), bfhi(u.y)}; }
}
__device__ __forceinline__ void norm_mod_rows_bf16(const Ctx& F, const bf16* X, const float* nw, int shift_off, int scale_off, bf16* XN) {
    const float* mod = (const float*)(F.ws + WS_MOD);
    for (int m = F.gw; m < M; m += F.NGW) {
        const int b = m / SEQ;
        f32x4 v[8]; load_row_bf16(X + (size_t)m * DM, F.lane, v); float s = 0.f;
#pragma unroll
        for (int j = 0; j < 8; ++j) s += (v[j].x * v[j].x + v[j].y * v[j].y) + (v[j].z * v[j].z + v[j].w * v[j].w);
        const float rstd = rsqrtf(wave_sum(s) * (1.f / DM) + RMS_EPS);
        const f32x4* wp = (const f32x4*)nw + F.lane;
        const f32x4* shp = (const f32x4*)(mod + (size_t)b * MODW + shift_off) + F.lane;
        const f32x4* scp = (const f32x4*)(mod + (size_t)b * MODW + scale_off) + F.lane;
        v2u* o = (v2u*)(XN + (size_t)m * DM) + F.lane;
#pragma unroll
        for (int j = 0; j < 8; ++j) { const f32x4 w = wp[64 * j], a = scp[64 * j], c = shp[64 * j];
            const f32x4 r = (v[j] * rstd) * w * (a + 1.f) + c;
            v2u p; p.x = pk2(r.x, r.y); p.y = pk2(r.z, r.w); o[64 * j] = p; }
    }
}
__device__ __forceinline__ void final_norm_rows_bf16(const Ctx& F, const bf16* H, const float* nw, float* O, float oscale) {
    for (int m = F.gw; m < M; m += F.NGW) {
        f32x4 v[8]; load_row_bf16(H + (size_t)m * DM, F.lane, v); float s = 0.f;
#pragma unroll
        for (int j = 0; j < 8; ++j) s += (v[j].x * v[j].x + v[j].y * v[j].y) + (v[j].z * v[j].z + v[j].w * v[j].w);
        const float rstd = rsqrtf(wave_sum(s) * (1.f / DM) + RMS_EPS) * oscale;
        const f32x4* wp = (const f32x4*)nw + F.lane;
        f32x4* o = (f32x4*)(O + (size_t)m * DM) + F.lane;
#pragma unroll
        for (int j = 0; j < 8; ++j) o[64 * j] = (v[j] * rstd) * wp[64 * j];
    }
}
#define LO2(v) __builtin_shufflevector((v), (v), 0, 1)
#define HI2(v) __builtin_shufflevector((v), (v), 2, 3)
template <int CTRL> __device__ __forceinline__ float dpp_f(float x) { return __builtin_bit_cast(float, __builtin_amdgcn_mov_dpp(__builtin_bit_cast(int, x), CTRL, 0xf, 0xf, true)); }
__device__ __forceinline__ float rowsum16(float x) { x += dpp_f<0xB1>(x); x += dpp_f<0x4E>(x); x += dpp_f<0x124>(x); x += dpp_f<0x128>(x); return x; }
__device__ __forceinline__ float quadsum(float x) { x += dpp_f<0xB1>(x); x += dpp_f<0x4E>(x); return x; }

__device__ __forceinline__ float treduce16(const float (&p)[16], bool b0, bool b1, bool b2, bool b3) {
    float a[8], bq[4], c2[2];
#pragma unroll
    for (int j = 0; j < 8; ++j) { const float mine = b3 ? p[j + 8] : p[j], send = b3 ? p[j] : p[j + 8]; a[j] = mine + dpp_f<0x128>(send); }
#pragma unroll
    for (int j = 0; j < 4; ++j) { const float mine = b2 ? a[j + 4] : a[j], send = b2 ? a[j] : a[j + 4]; const float up = dpp_f<0x104>(send), dn = dpp_f<0x114>(send); bq[j] = mine + (b2 ? dn : up); }
#pragma unroll
    for (int j = 0; j < 2; ++j) { const float mine = b1 ? bq[j + 2] : bq[j], send = b1 ? bq[j] : bq[j + 2]; c2[j] = mine + dpp_f<0x4E>(send); }
    const float mine = b0 ? c2[1] : c2[0], send = b0 ? c2[0] : c2[1];
    return mine + dpp_f<0xB1>(send);
}
__device__ __forceinline__ float wave_sum_dpp(float v) { v = rowsum16(v); v += __shfl_xor(v, 16); v += __shfl_xor(v, 32); return v; }
__device__ __forceinline__ void unpack8(const v4u p, float (&e)[8]) { e[0] = bflo(p.x); e[1] = bfhi(p.x); e[2] = bflo(p.y); e[3] = bfhi(p.y); e[4] = bflo(p.z); e[5] = bfhi(p.z); e[6] = bflo(p.w); e[7] = bfhi(p.w); }
__device__ __forceinline__ v4u pack8(const float (&e)[8]) { v4u o; o.x = pk2(e[0], e[1]); o.y = pk2(e[2], e[3]); o.z = pk2(e[4], e[5]); o.w = pk2(e[6], e[7]); return o; }

__device__ __forceinline__ void p3_lora(const Ctx& F) {
    const bf16* PROJ = (const bf16*)(F.ws + WS_PROJ);
    const bf16* WUPT = (const bf16*)(F.ws + WS_WUPT); const bf16* AUPT = (const bf16*)(F.ws + WS_AUPT); const bf16* GUPT = (const bf16*)(F.ws + WS_GUPT);
    bf16* LW = (bf16*)(F.ws + WS_LW); bf16* AA = (bf16*)(F.ws + WS_AA); bf16* GG = (bf16*)(F.ws + WS_GG);
    const float* mu = F.in[I_MU]; const float* w0 = F.in[I_W0]; const float* a0 = F.in[I_A0];
    const int r16 = F.lane & 15, q = F.lane >> 4;
    constexpr int WST = 72, GST = 168;
    LAS bf16* WU = (LAS bf16*)F.lds; LAS bf16* AU = WU + 128 * WST; LAS bf16* GU = AU + 128 * WST;
    const int nr = blockIdx.x & 7, nbr = (F.G - nr + 7) >> 3;
    __syncthreads();
    for (int i = F.tid; i < 128 * 8; i += NTHR) { const int row = i >> 3, ch = i & 7;
        *(LAS v4u*)(WU + row * WST + 8 * ch) = *(const v4u*)(WUPT + (size_t)(128 * nr + row) * L_W + 8 * ch);
        *(LAS v4u*)(AU + row * WST + 8 * ch) = *(const v4u*)(AUPT + (size_t)(128 * nr + row) * L_A + 8 * ch); }
    for (int i = F.tid; i < 128 * 20; i += NTHR) { const int row = i / 20, ch = i - row * 20;
        *(LAS v4u*)(GU + row * GST + 8 * ch) = *(const v4u*)(GUPT + (size_t)(128 * nr + row) * L_G + 8 * ch); }
    __syncthreads();
    for (int mt = (blockIdx.x >> 3) * NWAVES + F.wave; mt < M / 16; mt += nbr * NWAVES) {
        const int m = mt * 16 + r16; const bool first = (m % SEQ) == 0;
        const bf16* row = PROJ + (size_t)m * INPP;
        bf16x8 af[9];
#pragma unroll
        for (int s = 0; s < 9; ++s) {
            const int col = ((s < 2) ? (C_WD + 32 * s) : (s < 4) ? (C_AD + 32 * (s - 2)) : (C_GD + 32 * (s - 4))) + 8 * q;
            const v4u pc = *(const v4u*)(row + col);
            v4u pp = {0u, 0u, 0u, 0u}; if (!first) pp = *(const v4u*)(row - INPP + col);
            const f32x4 m0 = *(const f32x4*)(mu + col), m1 = *(const f32x4*)(mu + col + 4);
            float c[8], p[8], e[8]; unpack8(pc, c); unpack8(pp, p);
            const float mm[8] = {m0.x, m0.y, m0.z, m0.w, m1.x, m1.y, m1.z, m1.w};
#pragma unroll
            for (int j = 0; j < 8; ++j) { float v = c[j] + (p[j] - c[j]) * mm[j];
                if (s < 2) { const float t = __expf(2.f * v); v = 1.f - 2.f * rcp_f(t + 1.f); }
                else if (s >= 4) v = sigmoid_f(v);
                e[j] = v; }
            af[s] = __builtin_bit_cast(bf16x8, pack8(e));
        }
#pragma unroll 2
        for (int nt = 0; nt < 8; ++nt) {
            const LAS bf16* wu = WU + (16 * nt + r16) * WST + 8 * q; const LAS bf16* au = AU + (16 * nt + r16) * WST + 8 * q; const LAS bf16* gu = GU + (16 * nt + r16) * GST + 8 * q;
            f32x4 acc0 = {0.f, 0.f, 0.f, 0.f}, acc1 = acc0, acc2 = acc0;
#pragma unroll
            for (int s2 = 0; s2 < 2; ++s2) acc0 = __builtin_amdgcn_mfma_f32_16x16x32_bf16(*(const LAS bf16x8*)(wu + 32 * s2), af[s2], acc0, 0, 0, 0);
#pragma unroll
            for (int s2 = 0; s2 < 2; ++s2) acc1 = __builtin_amdgcn_mfma_f32_16x16x32_bf16(*(const LAS bf16x8*)(au + 32 * s2), af[2 + s2], acc1, 0, 0, 0);
#pragma unroll
            for (int s2 = 0; s2 < 5; ++s2) acc2 = __builtin_amdgcn_mfma_f32_16x16x32_bf16(*(const LAS bf16x8*)(gu + 32 * s2), af[4 + s2], acc2, 0, 0, 0);
            const int n = 128 * nr + 16 * nt + 4 * q;
            const f32x4 w0v = *(const f32x4*)(w0 + n), a0v = *(const f32x4*)(a0 + n);
            v2u o0, o1, o2;
            o0.x = pk2(-0.60653066f * sigmoid_f(acc0[0] + w0v.x), -0.60653066f * sigmoid_f(acc0[1] + w0v.y));
            o0.y = pk2(-0.60653066f * sigmoid_f(acc0[2] + w0v.z), -0.60653066f * sigmoid_f(acc0[3] + w0v.w));
            o1.x = pk2(sigmoid_f(acc1[0] + a0v.x), sigmoid_f(acc1[1] + a0v.y)); o1.y = pk2(sigmoid_f(acc1[2] + a0v.z), sigmoid_f(acc1[3] + a0v.w));
            o2.x = pk2(acc2[0], acc2[1]); o2.y = pk2(acc2[2], acc2[3]);
            *(v2u*)(LW + (size_t)m * RW + n) = o0; *(v2u*)(AA + (size_t)m * RW + n) = o1; *(v2u*)(GG + (size_t)m * RW + n) = o2;
        }
    }
    __syncthreads();
}

constexpr int TC = 32, NCHUNK = SEQ / TC;
constexpr int RB_R = 0, RB_W = TC * 64, RB_K = 2 * TC * 64, RB_KK = 3 * TC * 64, RB_KA = 4 * TC * 64, RB_V = 5 * TC * 64, RB_SIZE = 5 * TC * 64 + TC * 16;
constexpr int MB_B = 0, MB_C = TC * 128, MB_X = 2 * TC * 128, MB_DT = MB_X + TC * 32, MB_DA = MB_DT + TC, MB_SIZE = MB_DA + TC;
static_assert(2 * RB_SIZE * 4 <= RING_BYTES, "scan buffers fit the LDS ring");

struct RwkvRaw { bf16 r[9], k[9], v[9], lw[8], a[8]; };
__device__ __forceinline__ void rwkv_load(RwkvRaw& raw, const bf16* PROJ, const bf16* LW, const bf16* AA, int b, int h, int t0w, int c) {
    const bf16* base = PROJ + (size_t)(b * SEQ + t0w) * INPP + h * 64 + c;
#pragma unroll
    for (int i = 0; i < 9; ++i) {
        if (i == 0 && t0w == 0) { raw.r[0] = 0; raw.k[0] = 0; raw.v[0] = 0; }
        else { const bf16* row = base + (long)(i - 1) * INPP; raw.r[i] = row[C_R]; raw.k[i] = row[C_K]; raw.v[i] = row[C_V]; }
    }
#pragma unroll
    for (int i = 0; i < 8; ++i) { const size_t o = (size_t)(b * SEQ + t0w + i) * RW + h * 64 + c; raw.lw[i] = LW[o]; raw.a[i] = AA[o]; }
}
__device__ __forceinline__ void rwkv_stage(const RwkvRaw& raw, LAS float* buf, int tl0, int c, int qt, float mu_r, float mu_k, float mu_v, float kkw, float kaw) {
#pragma unroll
    for (int i = 0; i < 8; ++i) {
        const int t = tl0 + i;
        const float rc = bf1(raw.r[i + 1]), rp = bf1(raw.r[i]), kc = bf1(raw.k[i + 1]), kp = bf1(raw.k[i]), vc = bf1(raw.v[i + 1]), vp = bf1(raw.v[i]);
        const float rr = rc + (rp - rc) * mu_r, kx = kc + (kp - kc) * mu_k, vv = vc + (vp - vc) * mu_v;
        const float a = bf1(raw.a[i]), dec = __expf(bf1(raw.lw[i]));
        const float kkraw = kx * kkw; const float ss = wave_sum_dpp(kkraw * kkraw);
        const float kkn = kkraw * rcp_f(fmaxf(sqrtf(ss), 1e-12f));
        buf[RB_R + t * 64 + c] = rr; buf[RB_W + t * 64 + c] = dec; buf[RB_K + t * 64 + c] = kx * (1.f + (a - 1.f) * kaw);
        buf[RB_KK + t * 64 + c] = kkn; buf[RB_KA + t * 64 + c] = kkn * a;
        if ((c >> 4) == qt) buf[RB_V + t * 16 + (c & 15)] = vv;
    }
}
__device__ __forceinline__ void rwkv_task(const Ctx& F, int task) {
    const int b = task >> 6, h = (task >> 2) & 15, qt = task & 3;
    const bf16* PROJ = (const bf16*)(F.ws + WS_PROJ); const bf16* LW = (const bf16*)(F.ws + WS_LW); const bf16* AA = (const bf16*)(F.ws + WS_AA);
    bf16* OY = (bf16*)(F.ws + WS_OY);
    LAS float* lbuf = (LAS float*)F.lds;
    const int c = F.lane, w = F.wave, r = F.lane >> 4, cg = F.lane & 15;
    const bool stager = w >= 4; const int sw = w & 3;
    const int ch = h * 64 + c;
    const float mu_r = F.in[I_MU][C_R + ch], mu_k = F.in[I_MU][C_K + ch], mu_v = F.in[I_MU][C_V + ch], kkw = F.in[I_KK][ch], kaw = F.in[I_KA][ch];
    RwkvRaw raw;
    if (stager) { rwkv_load(raw, PROJ, LW, AA, b, h, 8 * sw, c); rwkv_stage(raw, lbuf, 8 * sw, c, qt, mu_r, mu_k, mu_v, kkw, kaw); rwkv_load(raw, PROJ, LW, AA, b, h, TC + 8 * sw, c); }
    __syncthreads();
    f32x2 S01 = {0.f, 0.f}, S23 = {0.f, 0.f};
    const bool cb0 = cg & 1, cb1 = cg & 2, cb2 = cg & 4, cb3 = cg & 8;
    bf16* orow = OY + (size_t)(b * SEQ) * DM + h * 64 + 16 * qt + 4 * sw + r;
    for (int ck = 0; ck < NCHUNK; ++ck) {
        const LAS float* buf = lbuf + (ck & 1) * RB_SIZE;
        if (stager) {
            if (ck + 1 < NCHUNK) { rwkv_stage(raw, lbuf + ((ck + 1) & 1) * RB_SIZE, 8 * sw, c, qt, mu_r, mu_k, mu_v, kkw, kaw);
                if (ck + 2 < NCHUNK) rwkv_load(raw, PROJ, LW, AA, b, h, (ck + 2) * TC + 8 * sw, c); }
        } else {
            const LAS float* bp = buf + 4 * cg; const LAS float* vp = buf + RB_V + 4 * sw + r;
            f32x4 qkk[3], qw[3], qka[3], qk[3], qr[3]; float qv[3];
#pragma unroll
            for (int i = 0; i < 3; ++i) { qkk[i] = *(const LAS f32x4*)(bp + RB_KK + i * 64); qw[i] = *(const LAS f32x4*)(bp + RB_W + i * 64); qka[i] = *(const LAS f32x4*)(bp + RB_KA + i * 64);
                qk[i] = *(const LAS f32x4*)(bp + RB_K + i * 64); qr[i] = *(const LAS f32x4*)(bp + RB_R + i * 64); qv[i] = vp[i * 16]; }
            float op[16];
#pragma unroll
            for (int j = 0; j < TC; ++j) {
                const int u = j % 3;
                const f32x4 kk4 = qkk[u], w4 = qw[u], ka4 = qka[u], k4 = qk[u], r4 = qr[u]; const float vr = qv[u];
                const f32x2 tq = S01 * LO2(kk4) + S23 * HI2(kk4);
                const float sa = rowsum16(tq.x + tq.y);
                const f32x2 sav = {sa, sa}, vrv = {vr, vr};
                S01 = S01 * LO2(w4) + (vrv * LO2(k4) - sav * LO2(ka4));
                S23 = S23 * HI2(w4) + (vrv * HI2(k4) - sav * HI2(ka4));
                const f32x2 uq = S01 * LO2(r4) + S23 * HI2(r4);
                op[j & 15] = uq.x + uq.y;
                asm volatile("" : "+v"(S01), "+v"(S23) :: "memory");
                if (j + 3 < TC) { qkk[u] = *(const LAS f32x4*)(bp + RB_KK + (j + 3) * 64); qw[u] = *(const LAS f32x4*)(bp + RB_W + (j + 3) * 64); qka[u] = *(const LAS f32x4*)(bp + RB_KA + (j + 3) * 64);
                                  qk[u] = *(const LAS f32x4*)(bp + RB_K + (j + 3) * 64); qr[u] = *(const LAS f32x4*)(bp + RB_R + (j + 3) * 64); qv[u] = vp[(j + 3) * 16]; }
                if ((j & 15) == 15) {
                    const float ored = treduce16(op, cb0, cb1, cb2, cb3);
                    orow[(size_t)(ck * TC + (j - 15) + cg) * DM] = (bf16)(pk2(ored, 0.f) & 0xffffu);
                }
            }
        }
        __syncthreads();
    }
}

__device__ __forceinline__ void p4_scans(const Ctx& F) {
    for (int task = blockIdx.x; task < NB * RHEADS * 4; task += F.G) { rwkv_task(F, task); __syncthreads(); }
}

__device__ __forceinline__ void ld16(const float* p, float (&v)[16]) {
#pragma unroll
    for (int i = 0; i < 4; ++i) { const f32x4 t = *(const f32x4*)(p + 4 * i); v[4 * i] = t.x; v[4 * i + 1] = t.y; v[4 * i + 2] = t.z; v[4 * i + 3] = t.w; }
}
__device__ __forceinline__ void ldbf16x16(const bf16* p, float (&v)[16]) {
    float t0[8], t1[8]; unpack8(*(const v4u*)p, t0); unpack8(*(const v4u*)(p + 8), t1);
#pragma unroll
    for (int j = 0; j < 8; ++j) { v[j] = t0[j]; v[8 + j] = t1[j]; }
}
__device__ __forceinline__ void stbf16x16(bf16* p, const float (&v)[16]) {
    float t0[8], t1[8];
#pragma unroll
    for (int j = 0; j < 8; ++j) { t0[j] = v[j]; t1[j] = v[8 + j]; }
    *(v4u*)p = pack8(t0); *(v4u*)(p + 8) = pack8(t1);
}
__device__ __forceinline__ void p5_post(const Ctx& F) {
    const bf16* PROJ = (const bf16*)(F.ws + WS_PROJ); const bf16* AA = (const bf16*)(F.ws + WS_AA); const bf16* GG = (const bf16*)(F.ws + WS_GG);
    bf16* OY = (bf16*)(F.ws + WS_OY);
    const int c0 = 16 * F.lane;
    {
        float mur[16], muk[16], muv[16], ka[16], rk[16], lnw[16], lnb[16];
        ld16(F.in[I_MU] + C_R + c0, mur); ld16(F.in[I_MU] + C_K + c0, muk); ld16(F.in[I_MU] + C_V + c0, muv);
        ld16(F.in[I_KA] + c0, ka); ld16(F.in[I_RK] + c0, rk); ld16(F.in[I_LNW] + c0, lnw); ld16(F.in[I_LNB] + c0, lnb);
        for (int m = F.gw; m < M; m += F.NGW) {
            const bool first = (m % SEQ) == 0;
            const bf16* prow = PROJ + (size_t)m * INPP; bf16* oyrow = OY + (size_t)m * DM;
            float o[16], rc[16], kc[16], vc[16], rp[16], kp[16], vp[16], av[16], gv[16];
            ldbf16x16(oyrow + c0, o); ldbf16x16(prow + C_R + c0, rc); ldbf16x16(prow + C_K + c0, kc); ldbf16x16(prow + C_V + c0, vc);
            if (!first) { ldbf16x16(prow - INPP + C_R + c0, rp); ldbf16x16(prow - INPP + C_K + c0, kp); ldbf16x16(prow - INPP + C_V + c0, vp); }
            else {
#pragma unroll
                for (int j = 0; j < 16; ++j) { rp[j] = 0.f; kp[j] = 0.f; vp[j] = 0.f; } }
            ldbf16x16(AA + (size_t)m * RW + c0, av); ldbf16x16(GG + (size_t)m * RW + c0, gv);
            float s = 0.f;
#pragma unroll
            for (int j = 0; j < 16; ++j) s += o[j];
            const float mean = quadsum(s) * (1.f / 64.f);
            float qv = 0.f, bs = 0.f;
#pragma unroll
            for (int j = 0; j < 16; ++j) { o[j] -= mean; qv += o[j] * o[j];
                const float rr = rc[j] + (rp[j] - rc[j]) * mur[j], kx = kc[j] + (kp[j] - kc[j]) * muk[j];
                bs += rr * (kx * (1.f + (av[j] - 1.f) * ka[j])) * rk[j]; }
            const float rstd = rsqrtf(quadsum(qv) * (1.f / 64.f) + 64e-5f);
            bs = quadsum(bs);
            float res[16];
#pragma unroll
            for (int j = 0; j < 16; ++j) { const float vv = vc[j] + (vp[j] - vc[j]) * muv[j]; res[j] = (o[j] * rstd * lnw[j] + lnb[j] + bs * vv) * gv[j]; }
            stbf16x16(oyrow + c0, res);
        }
    }
    {
        float nw[16]; ld16(F.in[I_MNW] + c0, nw);
        for (int m = F.gw; m < M; m += F.NGW) {
            const bf16* prow = PROJ + (size_t)m * INPP; bf16* oyrow = OY + (size_t)m * DM;
            float y[16], z[16];
            ldbf16x16(oyrow + RW + c0, y); ldbf16x16(prow + C_Z + c0, z);
            float qv = 0.f;
#pragma unroll
            for (int j = 0; j < 16; ++j) { y[j] *= silu_f(z[j]); qv += y[j] * y[j]; }
            qv = rowsum16(qv);
            { auto rr = __builtin_amdgcn_permlane16_swap(__float_as_uint(qv), __float_as_uint(qv), false, false); qv = __uint_as_float(rr[0]) + __uint_as_float(rr[1]); }
            const float rstd = rsqrtf(qv * (1.f / 512.f) + 1e-5f);
#pragma unroll
            for (int j = 0; j < 16; ++j) y[j] = y[j] * rstd * nw[j];
            stbf16x16(oyrow + RW + c0, y);
        }
    }
}
constexpr int MC_L = 128, MC_NC = SEQ / MC_L, LSTR = 136;
constexpr int MT_BYTES = 128 * LSTR * 2;
constexpr size_t WS_ST = 876 * MiB, WS_SIN = 940 * MiB, WS_ATOT = 1004 * MiB, WS_END2 = 1005 * MiB;

__device__ __forceinline__ float mamba_dt_scan(const Ctx& F, const bf16* PROJ, int b, int c, int g, LAS float* DT, LAS float* ACS) {
    const int head = g * 8 + F.wave, lane = F.lane;
    const float dtb = F.in[I_DTB][head], Aneg = -__expf(F.in[I_ALOG][head]);
    const bf16* p = PROJ + (size_t)(b * SEQ + c * MC_L + 2 * lane) * INPP + C_DT + head;
    const float x0 = bf1(p[0]) + dtb, x1 = bf1(p[INPP]) + dtb;
    const float d0 = (x0 > 20.f) ? x0 : log1pf(__expf(x0)), d1 = (x1 > 20.f) ? x1 : log1pf(__expf(x1));
    const float s0 = d0 * Aneg, s1 = s0 + d1 * Aneg;
    float incl = s1;
#pragma unroll
    for (int o = 1; o < 64; o <<= 1) { const float t = __shfl_up(incl, o); if (lane >= o) incl += t; }
    const float excl = incl - s1;
    DT[F.wave * 128 + 2 * lane] = d0; DT[F.wave * 128 + 2 * lane + 1] = d1;
    ACS[F.wave * 128 + 2 * lane] = excl + s0; ACS[F.wave * 128 + 2 * lane + 1] = excl + s1;
    return __shfl(incl, 63);
}
template <bool SC>
__device__ __forceinline__ void mstage_T(const bf16* PROJ, int b, int c, int chn, LAS bf16* dst, const LAS float* scale, const float* convw, const float* convb, int tid) {
    const int f = tid & 127, t0 = 32 * (tid >> 7);
    const bf16* base = PROJ + (size_t)(b * SEQ + c * MC_L + t0) * INPP + C_XBC + chn;
    const float w0 = convw[chn], w1 = convw[1536 + chn], w2 = convw[2 * 1536 + chn], w3 = convw[3 * 1536 + chn], bb = convb[chn];
    float r0 = 0.f, r1 = 0.f, r2 = 0.f;
    if (c * MC_L + t0 > 0) { r0 = bf1(base[-3 * INPP]); r1 = bf1(base[-2 * INPP]); r2 = bf1(base[-1 * INPP]); }
#pragma unroll
    for (int i8 = 0; i8 < 4; ++i8) {
        float e[8];
#pragma unroll
        for (int i = 0; i < 8; ++i) { const int t = 8 * i8 + i; const float r3 = bf1(base[(size_t)t * INPP]);
            float v = silu_f(bb + w0 * r0 + w1 * r1 + w2 * r2 + w3 * r3);
            if (SC) v *= scale[t0 + t];
            e[i] = v; r0 = r1; r1 = r2; r2 = r3; }
        *(LAS v4u*)(dst + f * LSTR + t0 + 8 * i8) = pack8(e);
    }
}
__device__ __forceinline__ void mstage_N(const bf16* PROJ, int b, int c, int g, LAS bf16* Bn, LAS bf16* Cn, const float* convw, const float* convb, int tid) {
    const int f8 = tid & 31, t0 = 8 * (tid >> 5);
    const int chn = (f8 < 16) ? (1024 + g * 128 + 8 * f8) : (1280 + g * 128 + 8 * (f8 - 16));
    LAS bf16* dst = ((f8 < 16) ? Bn : Cn) + 8 * (f8 & 15);
    const bf16* base = PROJ + (size_t)(b * SEQ + c * MC_L + t0) * INPP + C_XBC + chn;
    float w[4][8], bb[8];
#pragma unroll
    for (int i = 0; i < 4; ++i) { const f32x4 a = *(const f32x4*)(convw + i * 1536 + chn), d = *(const f32x4*)(convw + i * 1536 + chn + 4);
        w[i][0] = a.x; w[i][1] = a.y; w[i][2] = a.z; w[i][3] = a.w; w[i][4] = d.x; w[i][5] = d.y; w[i][6] = d.z; w[i][7] = d.w; }
    { const f32x4 a = *(const f32x4*)(convb + chn), d = *(const f32x4*)(convb + chn + 4); bb[0] = a.x; bb[1] = a.y; bb[2] = a.z; bb[3] = a.w; bb[4] = d.x; bb[5] = d.y; bb[6] = d.z; bb[7] = d.w; }
    float r0[8], r1[8], r2[8];
    if (c * MC_L + t0 > 0) { unpack8(*(const v4u*)(base - 3 * INPP), r0); unpack8(*(const v4u*)(base - 2 * INPP), r1); unpack8(*(const v4u*)(base - 1 * INPP), r2); }
    else {
#pragma unroll
        for (int k = 0; k < 8; ++k) { r0[k] = 0.f; r1[k] = 0.f; r2[k] = 0.f; } }
#pragma unroll
    for (int t = 0; t < 8; ++t) {
        float r3[8], e[8]; unpack8(*(const v4u*)(base + (size_t)t * INPP), r3);
#pragma unroll
        for (int k = 0; k < 8; ++k) { e[k] = silu_f(bb[k] + w[0][k] * r0[k] + w[1][k] * r1[k] + w[2][k] * r2[k] + w[3][k] * r3[k]); r0[k] = r1[k]; r1[k] = r2[k]; r2[k] = r3[k]; }
        *(LAS v4u*)(dst + (t0 + t) * LSTR) = pack8(e);
    }
}

__device__ __forceinline__ void m1_chunk_states(const Ctx& F) {
    const bf16* PROJ = (const bf16*)(F.ws + WS_PROJ); bf16* ST = (bf16*)(F.ws + WS_ST); float* ATOT = (float*)(F.ws + WS_ATOT);
    LAS bf16* BT = (LAS bf16*)F.lds; LAS bf16* XT = (LAS bf16*)(F.lds + MT_BYTES);
    LAS float* DT = (LAS float*)(F.lds + 3 * MT_BYTES); LAS float* ACS = DT + 8 * 128; LAS float* SCL = ACS + 8 * 128;
    const float* convw = F.in[I_CONVW]; const float* convb = F.in[I_CONVB];
    const int tid = F.tid, w = F.wave, lane = F.lane, r16 = lane & 15, q = lane >> 4;
    for (int it = blockIdx.x; it < NB * MC_NC * 2; it += F.G) {
        const int g = it & 1, c = (it >> 1) & (MC_NC - 1), b = it >> 7;
        __syncthreads();
        const float atot = mamba_dt_scan(F, PROJ, b, c, g, DT, ACS);
        if (lane == 0) ATOT[(b * MC_NC + c) * 16 + g * 8 + w] = atot;
        LDS_WAIT();
        SCL[w * 128 + 2 * lane] = DT[w * 128 + 2 * lane] * __expf(atot - ACS[w * 128 + 2 * lane]);
        SCL[w * 128 + 2 * lane + 1] = DT[w * 128 + 2 * lane + 1] * __expf(atot - ACS[w * 128 + 2 * lane + 1]);
        mstage_T<false>(PROJ, b, c, 1024 + g * 128 + (tid & 127), BT, nullptr, convw, convb, tid);
#pragma unroll 1
        for (int hb = 0; hb < 2; ++hb) {
            __syncthreads();
#pragma unroll
            for (int im = 0; im < 2; ++im) { const int hl = 4 * hb + 2 * im + ((tid & 127) >> 6);
                mstage_T<true>(PROJ, b, c, (g * 8 + hl) * 64 + (tid & 63), XT + im * 128 * LSTR, SCL + hl * 128, convw, convb, tid); }
            __syncthreads();
            const int hh = w >> 1, ph = w & 1;
            f32x4 acc[2][8];
#pragma unroll
            for (int a = 0; a < 2; ++a)
#pragma unroll
                for (int n = 0; n < 8; ++n) acc[a][n] = (f32x4){0.f, 0.f, 0.f, 0.f};
#pragma unroll
            for (int ks = 0; ks < 4; ++ks) {
                bf16x8 xa[2];
#pragma unroll
                for (int a = 0; a < 2; ++a) xa[a] = *(const LAS bf16x8*)(XT + (hh * 64 + 32 * ph + 16 * a + r16) * LSTR + 32 * ks + 8 * q);
#pragma unroll
                for (int n = 0; n < 8; ++n) { const bf16x8 bfr = *(const LAS bf16x8*)(BT + (16 * n + r16) * LSTR + 32 * ks + 8 * q);
#pragma unroll
                    for (int a = 0; a < 2; ++a) acc[a][n] = __builtin_amdgcn_mfma_f32_16x16x32_bf16(bfr, xa[a], acc[a][n], 0, 0, 0); }
            }
            bf16* st = ST + ((size_t)((b * MC_NC + c) * 16 + g * 8 + 4 * hb + hh)) * (64 * 128);
#pragma unroll
            for (int a = 0; a < 2; ++a)
#pragma unroll
                for (int n = 0; n < 8; ++n) { v2u o; o.x = pk2(acc[a][n][0], acc[a][n][1]); o.y = pk2(acc[a][n][2], acc[a][n][3]);
                    *(v2u*)(st + (32 * ph + 16 * a + r16) * 128 + 16 * n + 4 * q) = o; }
        }
    }
}

__device__ __forceinline__ void m2_prefix(const Ctx& F) {
    const bf16* ST = (const bf16*)(F.ws + WS_ST); bf16* SIN = (bf16*)(F.ws + WS_SIN); const float* ATOT = (const float*)(F.ws + WS_ATOT);
    const int nthr = F.G * NTHR;
    for (int gi = blockIdx.x * NTHR + F.tid; gi < NB * 16 * 2048; gi += nthr) {
        const int e4 = gi & 2047, bh = gi >> 11, b = bh >> 4, h = bh & 15;
        float r0 = 0.f, r1 = 0.f, r2 = 0.f, r3 = 0.f;
#pragma unroll 4
        for (int c = 0; c < MC_NC; ++c) {
            const size_t o = ((size_t)((b * MC_NC + c) * 16 + h)) * 8192 + 4 * e4;
            v2u so; so.x = pk2(r0, r1); so.y = pk2(r2, r3);
            *(v2u*)(SIN + o) = so;
            const v2u sv = *(const v2u*)(ST + o); const float d = __expf(ATOT[(b * MC_NC + c) * 16 + h]);
            r0 = r0 * d + bflo(sv.x); r1 = r1 * d + bfhi(sv.x); r2 = r2 * d + bflo(sv.y); r3 = r3 * d + bfhi(sv.y);
        }
    }
}

__device__ __forceinline__ void m3_outputs(const Ctx& F) {
    const bf16* PROJ = (const bf16*)(F.ws + WS_PROJ); const bf16* SIN = (const bf16*)(F.ws + WS_SIN); bf16* OY = (bf16*)(F.ws + WS_OY);
    LAS bf16* Cn = (LAS bf16*)F.lds; LAS bf16* RB = (LAS bf16*)(F.lds + MT_BYTES);
    LAS bf16* Mw = (LAS bf16*)(F.lds + 2 * MT_BYTES) + F.wave * 16 * LSTR;
    LAS float* DT = (LAS float*)(F.lds + 3 * MT_BYTES); LAS float* ACS = DT + 8 * 128;
    const float* convw = F.in[I_CONVW]; const float* convb = F.in[I_CONVB];
    const int tid = F.tid, w = F.wave, lane = F.lane, r16 = lane & 15, q = lane >> 4;
    for (int it = blockIdx.x; it < NB * MC_NC * 2; it += F.G) {
        const int g = it & 1, c = (it >> 1) & (MC_NC - 1), b = it >> 7;
        __syncthreads();
        (void)mamba_dt_scan(F, PROJ, b, c, g, DT, ACS);
        mstage_N(PROJ, b, c, g, RB, Cn, convw, convb, tid);
        __syncthreads();
        bf16x8 cf[4];
#pragma unroll
        for (int ks = 0; ks < 4; ++ks) cf[ks] = *(const LAS bf16x8*)(Cn + (16 * w + r16) * LSTR + 32 * ks + 8 * q);
        f32x4 Gt[8];
#pragma unroll
        for (int nt = 0; nt < 8; ++nt) { Gt[nt] = (f32x4){0.f, 0.f, 0.f, 0.f};
#pragma unroll
            for (int ks = 0; ks < 4; ++ks) Gt[nt] = __builtin_amdgcn_mfma_f32_16x16x32_bf16(*(const LAS bf16x8*)(RB + (16 * nt + r16) * LSTR + 32 * ks + 8 * q), cf[ks], Gt[nt], 0, 0, 0); }
        const int l = 16 * w + r16;
        const size_t mrow = (size_t)(b * SEQ + c * MC_L + l);
#pragma unroll 1
        for (int hb = 0; hb < 4; ++hb) {
            __syncthreads();
            { const int hl = 2 * hb + ((tid & 127) >> 6); mstage_T<false>(PROJ, b, c, (g * 8 + hl) * 64 + (tid & 63), RB, nullptr, convw, convb, tid); }
            __syncthreads();
#pragma unroll 1
            for (int h2 = 0; h2 < 2; ++h2) {
                const int hl = 2 * hb + h2, head = g * 8 + hl;
                const float acs_l = ACS[hl * 128 + l];
                const bf16* sin = SIN + ((size_t)((b * MC_NC + c) * 16 + head)) * 8192;
                bf16x8 sf[4][4];
#pragma unroll
                for (int pt = 0; pt < 4; ++pt)
#pragma unroll
                    for (int ks = 0; ks < 4; ++ks) sf[pt][ks] = *(const bf16x8*)(sin + (16 * pt + r16) * 128 + 32 * ks + 8 * q);
#pragma unroll
                for (int nt = 0; nt < 8; ++nt) { const f32x4 as = *(const LAS f32x4*)(ACS + hl * 128 + 16 * nt + 4 * q), ds = *(const LAS f32x4*)(DT + hl * 128 + 16 * nt + 4 * q);
                    float mv[4];
#pragma unroll
                    for (int j = 0; j < 4; ++j) { const int s = 16 * nt + 4 * q + j; mv[j] = (s <= l) ? Gt[nt][j] * __expf(acs_l - as[j]) * ds[j] : 0.f; }
                    v2u o; o.x = pk2(mv[0], mv[1]); o.y = pk2(mv[2], mv[3]);
                    *(LAS v2u*)(Mw + r16 * LSTR + 16 * nt + 4 * q) = o; }
                LDS_WAIT(); asm volatile("" ::: "memory");
                bf16x8 mf[4];
#pragma unroll
                for (int ks = 0; ks < 4; ++ks) mf[ks] = *(const LAS bf16x8*)(Mw + r16 * LSTR + 32 * ks + 8 * q);
                const float el = __expf(acs_l), Dh = F.in[I_DSK][head];
#pragma unroll
                for (int pt = 0; pt < 4; ++pt) {
                    f32x4 yd = {0.f, 0.f, 0.f, 0.f}, yo = {0.f, 0.f, 0.f, 0.f};
#pragma unroll
                    for (int ks = 0; ks < 4; ++ks) {
                        yd = __builtin_amdgcn_mfma_f32_16x16x32_bf16(*(const LAS bf16x8*)(RB + (h2 * 64 + 16 * pt + r16) * LSTR + 32 * ks + 8 * q), mf[ks], yd, 0, 0, 0);
                        yo = __builtin_amdgcn_mfma_f32_16x16x32_bf16(sf[pt][ks], cf[ks], yo, 0, 0, 0); }
                    float yv[4];
#pragma unroll
                    for (int j = 0; j < 4; ++j) yv[j] = yd[j] + el * yo[j] + Dh * bf1(RB[(h2 * 64 + 16 * pt + 4 * q + j) * LSTR + l]);
                    v2u o; o.x = pk2(yv[0], yv[1]); o.y = pk2(yv[2], yv[3]);
                    *(v2u*)(OY + mrow * DM + RW + head * 64 + 16 * pt + 4 * q) = o;
                }
                asm volatile("" ::: "memory");
            }
        }
    }
}
constexpr int RC = 16, RNCH = SEQ / RC, RHALF = RNCH / 2, RITEMS = NB * RHEADS * RHALF;
constexpr size_t RO_WH = 0, RO_RH = 32 * MiB, RO_VT = 64 * MiB, RO_ET = 96 * MiB, RO_OL = 128 * MiB, RO_A2 = 160 * MiB, RO_GC = 224 * MiB, RO_SS = 228 * MiB;
constexpr int RL_KAP = 0, RL_ALP = 2304, RL_KT = 4608, RL_RT = 6912, RL_KAPT = 9216, RL_VT = 11264, RL_TB = 13312, RL_BL = 14336, RL_QL = 15360, RL_PL = 16384,
              RL_WT = RL_KAP, RL_BVT = RL_ALP, RL_AL32 = RL_KT, RL_ET = RL_KT,
              RL_BYTES = 18176;
constexpr int XS = 72, TS = 16, SS16 = 32;

__device__ __forceinline__ float wave_sum_pl(float x) {
    x = rowsum16(x);
    { auto rr = __builtin_amdgcn_permlane16_swap(__float_as_uint(x), __float_as_uint(x), false, false); x = __uint_as_float(rr[0]) + __uint_as_float(rr[1]); }
    { auto rr = __builtin_amdgcn_permlane32_swap(__float_as_uint(x), __float_as_uint(x), false, false); x = __uint_as_float(rr[0]) + __uint_as_float(rr[1]); }
    return x;
}
__device__ __forceinline__ v2u pack4(const f32x4 a) { v2u o; o.x = pk2(a[0], a[1]); o.y = pk2(a[2], a[3]); return o; }
__device__ __forceinline__ f32x4 unpack4(const v2u u) { return (f32x4){bflo(u.x), bfhi(u.x), bflo(u.y), bfhi(u.y)}; }
__device__ __forceinline__ bf16 f2b(float x) { return (bf16)(pk2(x, 0.f) & 0xffffu); }

__device__ __forceinline__ void ra_item(const Ctx& F, LAS unsigned char* wl, int it, int half) {
    const int bh = it / RHALF, cl = it - bh * RHALF, ci = half * RHALF + cl, b = bh >> 4, h = bh & 15;
    const bf16* PROJ = (const bf16*)(F.ws + WS_PROJ); const bf16* LW = (const bf16*)(F.ws + WS_LW); const bf16* AA = (const bf16*)(F.ws + WS_AA);
    unsigned char* RO = (unsigned char*)F.out;
    const int lane = F.lane, r16 = lane & 15, q = lane >> 4, c = lane, ch = h * 64 + c;
    const size_t m0 = (size_t)b * SEQ + (size_t)RC * ci;
    LAS bf16* KAP = (LAS bf16*)(wl + RL_KAP); LAS bf16* ALP = (LAS bf16*)(wl + RL_ALP); LAS bf16* KT = (LAS bf16*)(wl + RL_KT); LAS bf16* RT = (LAS bf16*)(wl + RL_RT);
    LAS bf16* KAPT = (LAS bf16*)(wl + RL_KAPT); LAS bf16* VTL = (LAS bf16*)(wl + RL_VT); LAS bf16* WT = (LAS bf16*)(wl + RL_WT); LAS bf16* BVT = (LAS bf16*)(wl + RL_BVT); LAS bf16* ETL = (LAS bf16*)(wl + RL_ET);
    LAS bf16* TB = (LAS bf16*)(wl + RL_TB); LAS bf16* BL = (LAS bf16*)(wl + RL_BL); LAS bf16* QL = (LAS bf16*)(wl + RL_QL); LAS bf16* PL = (LAS bf16*)(wl + RL_PL);
    const float mu_r = F.in[I_MU][C_R + ch], mu_k = F.in[I_MU][C_K + ch], mu_v = F.in[I_MU][C_V + ch], kkw = F.in[I_KK][ch], kaw = F.in[I_KA][ch];
    const bf16* prow = PROJ + m0 * INPP + ch;
    float rp = 0.f, kp = 0.f, vp = 0.f;
    if (ci > 0) { rp = bf1(prow[-INPP + C_R]); kp = bf1(prow[-INPP + C_K]); vp = bf1(prow[-INPP + C_V]); }
    float cum = 0.f, kkna[RC], kpv[RC], cumv[RC], vvv[RC];
#pragma unroll
    for (int t = 0; t < RC; ++t) {
        const bf16* row = prow + (size_t)t * INPP;
        const float rc = bf1(row[C_R]), kc = bf1(row[C_K]), vc = bf1(row[C_V]);
        const float a = bf1(AA[(m0 + t) * RW + ch]), lw = bf1(LW[(m0 + t) * RW + ch]);
        const float rr = rc + (rp - rc) * mu_r, kx = kc + (kp - kc) * mu_k, vv = vc + (vp - vc) * mu_v;
        rp = rc; kp = kc; vp = vc;
        const float kkraw = kx * kkw; const float ss = wave_sum_pl(kkraw * kkraw);
        const float kkn = kkraw * rcp_f(fmaxf(sqrtf(ss), 1e-12f));
        const float kpp = kx * (1.f + (a - 1.f) * kaw);
        const float ep = __expf(cum); cum += lw; const float en = __expf(-cum), ec = __expf(cum);
        const bf16 bkap = f2b(kkn * ep);
        KAP[t * XS + c] = bkap; ALP[t * XS + c] = f2b(kkn * a * en); KT[t * XS + c] = f2b(kpp * en); RT[t * XS + c] = f2b(rr * ec);
        KAPT[c * TS + t] = bkap; VTL[c * TS + t] = f2b(vv);
        kkna[t] = kkn * a; kpv[t] = kpp; cumv[t] = cum; vvv[t] = vv;
    }
    {
        float e8[8]; v4u* vt = (v4u*)((bf16*)(RO + RO_VT) + (size_t)it * 1024 + c * 16);
#pragma unroll
        for (int i = 0; i < 8; ++i) e8[i] = vvv[i];
        vt[0] = pack8(e8);
#pragma unroll
        for (int i = 0; i < 8; ++i) e8[i] = vvv[8 + i];
        vt[1] = pack8(e8);
        v4u* a2 = (v4u*)((bf16*)(RO + RO_A2) + (size_t)it * 2048 + c * 32);
        float dd[RC];
#pragma unroll
        for (int t = 0; t < RC; ++t) dd[t] = __expf(cum - cumv[t]);
#pragma unroll
        for (int i = 0; i < 8; ++i) e8[i] = -kkna[i] * dd[i];
        a2[0] = pack8(e8);
#pragma unroll
        for (int i = 0; i < 8; ++i) e8[i] = -kkna[8 + i] * dd[8 + i];
        a2[1] = pack8(e8);
#pragma unroll
        for (int i = 0; i < 8; ++i) e8[i] = kpv[i] * dd[i];
        a2[2] = pack8(e8);
#pragma unroll
        for (int i = 0; i < 8; ++i) e8[i] = kpv[8 + i] * dd[8 + i];
        a2[3] = pack8(e8);
        ((float*)(RO + RO_GC))[(size_t)it * 64 + c] = __expf(cum);
    }
    LDS_WAIT(); asm volatile("" ::: "memory");
    const v2u zero2 = {0u, 0u};
    {
        f32x4 alt = {0.f, 0.f, 0.f, 0.f}, blt = alt, qlt = alt, plt = alt;
#pragma unroll
        for (int ks = 0; ks < 2; ++ks) {
            const bf16x8 fa = *(const LAS bf16x8*)(ALP + r16 * XS + 32 * ks + 8 * q), fk = *(const LAS bf16x8*)(KT + r16 * XS + 32 * ks + 8 * q);
            const bf16x8 fkp = *(const LAS bf16x8*)(KAP + r16 * XS + 32 * ks + 8 * q), fr = *(const LAS bf16x8*)(RT + r16 * XS + 32 * ks + 8 * q);
            alt = __builtin_amdgcn_mfma_f32_16x16x32_bf16(fa, fkp, alt, 0, 0, 0); blt = __builtin_amdgcn_mfma_f32_16x16x32_bf16(fk, fkp, blt, 0, 0, 0);
            qlt = __builtin_amdgcn_mfma_f32_16x16x32_bf16(fa, fr, qlt, 0, 0, 0);  plt = __builtin_amdgcn_mfma_f32_16x16x32_bf16(fk, fr, plt, 0, 0, 0);
        }
#pragma unroll
        for (int j = 0; j < 4; ++j) { const int s = 4 * q + j; const bool lt = s < r16, le = s <= r16;
            alt[j] = lt ? alt[j] : 0.f; blt[j] = lt ? blt[j] : 0.f; qlt[j] = le ? qlt[j] : 0.f; plt[j] = le ? plt[j] : 0.f; }
        *(LAS v2u*)(BL + r16 * SS16 + 4 * q) = pack4(blt); *(LAS v2u*)(QL + r16 * SS16 + 4 * q) = pack4(qlt); *(LAS v2u*)(PL + r16 * SS16 + 4 * q) = pack4(plt);
        *(LAS v2u*)(BL + r16 * SS16 + 16 + 4 * q) = zero2; *(LAS v2u*)(QL + r16 * SS16 + 16 + 4 * q) = zero2; *(LAS v2u*)(PL + r16 * SS16 + 16 + 4 * q) = zero2;
        float x[RC];
#pragma unroll
        for (int t = 0; t < RC; ++t) {
            float acc = (t == r16) ? 1.f : 0.f;
#pragma unroll
            for (int s2 = 0; s2 < t; ++s2) { const float a_ts = __uint_as_float(__builtin_amdgcn_readlane(__float_as_uint(alt[s2 & 3]), 16 * (s2 >> 2) + t)); acc -= a_ts * x[s2]; }
            x[t] = acc;
        }
        if (q == 0) {
#pragma unroll
            for (int t = 0; t < RC; ++t) { TB[t * SS16 + r16] = f2b(x[t]); TB[t * SS16 + 16 + r16] = 0; }
        }
    }
    LDS_WAIT(); asm volatile("" ::: "memory");
    const bf16x8 zf = {0, 0, 0, 0, 0, 0, 0, 0};
    const bf16x8 tbf = *(const LAS bf16x8*)(TB + r16 * SS16 + 8 * q), blf = *(const LAS bf16x8*)(BL + r16 * SS16 + 8 * q);
    const bf16x8 qlf = *(const LAS bf16x8*)(QL + r16 * SS16 + 8 * q), plf = *(const LAS bf16x8*)(PL + r16 * SS16 + 8 * q);
    const f32x4 z4 = {0.f, 0.f, 0.f, 0.f};
    bf16* gWH = (bf16*)(RO + RO_WH) + (size_t)it * 1024; bf16* gRH = (bf16*)(RO + RO_RH) + (size_t)it * 1024;
    bf16* gET = (bf16*)(RO + RO_ET) + (size_t)it * 1024; bf16* gOL = (bf16*)(RO + RO_OL) + (size_t)it * 1024;
#pragma unroll
    for (int kt = 0; kt < 4; ++kt) {
        const bf16x8 kf = (q < 2) ? *(const LAS bf16x8*)(KAPT + (16 * kt + r16) * TS + 8 * q) : zf;
        const f32x4 wa = __builtin_amdgcn_mfma_f32_16x16x32_bf16(kf, tbf, z4, 0, 0, 0);
        *(v2u*)(gWH + r16 * 64 + 16 * kt + 4 * q) = pack4(wa);
        const f32x4 wb = __builtin_amdgcn_mfma_f32_16x16x32_bf16(tbf, kf, z4, 0, 0, 0);
        *(LAS v2u*)(WT + (16 * kt + r16) * TS + 4 * q) = pack4(wb);
        const bf16x8 vf = (q < 2) ? *(const LAS bf16x8*)(VTL + (16 * kt + r16) * TS + 8 * q) : zf;
        const f32x4 bv = __builtin_amdgcn_mfma_f32_16x16x32_bf16(blf, vf, z4, 0, 0, 0);
        *(LAS v2u*)(BVT + (16 * kt + r16) * TS + 4 * q) = pack4(bv);
    }
    LDS_WAIT(); asm volatile("" ::: "memory");
#pragma unroll
    for (int vt = 0; vt < 4; ++vt) {
        const bf16x8 bf_ = (q < 2) ? *(const LAS bf16x8*)(BVT + (16 * vt + r16) * TS + 8 * q) : zf;
        const f32x4 e4 = __builtin_amdgcn_mfma_f32_16x16x32_bf16(tbf, bf_, z4, 0, 0, 0);
        const v2u ep = pack4(e4);
        *(LAS v2u*)(ETL + (16 * vt + r16) * TS + 4 * q) = ep; *(v2u*)(gET + (16 * vt + r16) * 16 + 4 * q) = ep;
    }
    LDS_WAIT(); asm volatile("" ::: "memory");
#pragma unroll
    for (int kt = 0; kt < 4; ++kt) {
        const bf16x8 wf = (q < 2) ? *(const LAS bf16x8*)(WT + (16 * kt + r16) * TS + 8 * q) : zf;
        const f32x4 qw = __builtin_amdgcn_mfma_f32_16x16x32_bf16(wf, qlf, z4, 0, 0, 0);
        const f32x4 rt4 = unpack4(*(const LAS v2u*)(RT + r16 * XS + 16 * kt + 4 * q));
        *(v2u*)(gRH + r16 * 64 + 16 * kt + 4 * q) = pack4(rt4 - qw);
        const bf16x8 vf = (q < 2) ? *(const LAS bf16x8*)(VTL + (16 * kt + r16) * TS + 8 * q) : zf;
        const bf16x8 ef = (q < 2) ? *(const LAS bf16x8*)(ETL + (16 * kt + r16) * TS + 8 * q) : zf;
        const f32x4 pv = __builtin_amdgcn_mfma_f32_16x16x32_bf16(vf, plf, z4, 0, 0, 0);
        const f32x4 qe = __builtin_amdgcn_mfma_f32_16x16x32_bf16(ef, qlf, z4, 0, 0, 0);
        *(v2u*)(gOL + r16 * 64 + 16 * kt + 4 * q) = pack4(pv - qe);
    }
    LDS_WAIT(); asm volatile("" ::: "memory");
}
__device__ __forceinline__ void ra_half(const Ctx& F, int half) {
    LAS unsigned char* wl = F.lds + F.wave * RL_BYTES;
    for (int it = F.gw; it < RITEMS; it += F.NGW) ra_item(F, wl, it, half);
}

__device__ __forceinline__ void rs_half(const Ctx& F, int half) {
    if (F.wave != 0) return;
    const unsigned char* RO = (const unsigned char*)F.out; bf16* OY = (bf16*)(F.ws + WS_OY);
    float* SSg = (float*)((unsigned char*)F.out + RO_SS);
    LAS bf16* ST = (LAS bf16*)F.lds;
    LAS bf16* ZT = (LAS bf16*)(F.lds + 16 * XS * 2);
    constexpr int ZS = 24;
    const int lane = F.lane, r16 = lane & 15, q = lane >> 4;
    for (int blk = blockIdx.x; blk < NB * RHEADS * 4; blk += F.G) {
        const int xcd = blk & 7, jj = blk >> 3, qt = jj & 3, bh = (jj >> 2) * 8 + xcd, b = bh >> 4, h = bh & 15;
        f32x4 S[4];
        if (half == 0) {
#pragma unroll
            for (int kt = 0; kt < 4; ++kt) S[kt] = (f32x4){0.f, 0.f, 0.f, 0.f};
        } else {
#pragma unroll
            for (int kt = 0; kt < 4; ++kt) S[kt] = *(const f32x4*)(SSg + (size_t)blk * 1024 + (kt * 64 + lane) * 4);
        }
#pragma unroll
        for (int kt = 0; kt < 4; ++kt) *(LAS v2u*)(ST + r16 * XS + 16 * kt + 4 * q) = pack4(S[kt]);
        LDS_WAIT(); asm volatile("" ::: "memory");
        const size_t it0 = (size_t)bh * RHALF;
        const size_t mbase = (size_t)b * SEQ + (size_t)half * RHALF * RC;
#define RS_LOAD(IT, WF, RF, A2F, VF, ET4, OL4, GC4) do { const size_t it_ = (IT); \
        const bf16* wh_ = (const bf16*)(RO + RO_WH) + it_ * 1024 + r16 * 64 + 8 * q; const bf16* rh_ = (const bf16*)(RO + RO_RH) + it_ * 1024 + r16 * 64 + 8 * q; \
        WF[0] = *(const bf16x8*)wh_; WF[1] = *(const bf16x8*)(wh_ + 32); RF[0] = *(const bf16x8*)rh_; RF[1] = *(const bf16x8*)(rh_ + 32); \
        _Pragma("unroll") for (int kt_ = 0; kt_ < 4; ++kt_) { A2F[kt_] = *(const bf16x8*)((const bf16*)(RO + RO_A2) + it_ * 2048 + (16 * kt_ + r16) * 32 + 8 * q); \
            GC4[kt_] = *(const f32x4*)((const float*)(RO + RO_GC) + it_ * 64 + 16 * kt_ + 4 * q); } \
        VF = *(const bf16x8*)((const bf16*)(RO + RO_VT) + it_ * 1024 + (16 * qt + r16) * 16 + 8 * (q & 1)); \
        ET4 = *(const v2u*)((const bf16*)(RO + RO_ET) + it_ * 1024 + (16 * qt + r16) * 16 + 4 * q); \
        OL4 = *(const v2u*)((const bf16*)(RO + RO_OL) + it_ * 1024 + r16 * 64 + 16 * qt + 4 * q); } while (0)
        bf16x8 wfq[2][2], rfq[2][2], a2q[2][4], vfq[2]; v2u etq[2], olq[2]; f32x4 gcq[2][4];
#pragma unroll
        for (int u = 0; u < 2; ++u) RS_LOAD(it0 + u, wfq[u], rfq[u], a2q[u], vfq[u], etq[u], olq[u], gcq[u]);
#define RS_STEP(U, CL) do { const int cl_ = (CL); \
            const bf16x8 sb0 = *(const LAS bf16x8*)(ST + r16 * XS + 8 * q), sb1 = *(const LAS bf16x8*)(ST + r16 * XS + 32 + 8 * q); \
            f32x4 x1 = __builtin_amdgcn_mfma_f32_16x16x32_bf16(wfq[U][0], sb0, (f32x4){0.f, 0.f, 0.f, 0.f}, 0, 0, 0); \
            x1 = __builtin_amdgcn_mfma_f32_16x16x32_bf16(wfq[U][1], sb1, x1, 0, 0, 0); \
            f32x4 ot = __builtin_amdgcn_mfma_f32_16x16x32_bf16(sb0, rfq[U][0], unpack4(olq[U]), 0, 0, 0); \
            ot = __builtin_amdgcn_mfma_f32_16x16x32_bf16(sb1, rfq[U][1], ot, 0, 0, 0); \
            *(LAS v2u*)(ZT + r16 * ZS + 4 * q) = pack4(x1 + unpack4(etq[U])); \
            *(v2u*)(OY + (mbase + (size_t)cl_ * RC + r16) * DM + h * 64 + 16 * qt + 4 * q) = pack4(ot); \
            LDS_WAIT(); asm volatile("" ::: "memory"); \
            const bf16x8 zr = *(const LAS bf16x8*)(ZT + r16 * ZS + 8 * (q & 1)); \
            const bf16x8 bz = (q < 2) ? zr : vfq[U]; \
            _Pragma("unroll") for (int kt = 0; kt < 4; ++kt) { S[kt] = __builtin_amdgcn_mfma_f32_16x16x32_bf16(a2q[U][kt], bz, S[kt] * gcq[U][kt], 0, 0, 0); \
                *(LAS v2u*)(ST + r16 * XS + 16 * kt + 4 * q) = pack4(S[kt]); } \
            RS_LOAD(it0 + ((cl_ + 2 < RHALF) ? cl_ + 2 : RHALF - 1), wfq[U], rfq[U], a2q[U], vfq[U], etq[U], olq[U], gcq[U]);     \
            LDS_WAIT(); asm volatile("" ::: "memory"); } while (0)
#pragma unroll 1
        for (int cl = 0; cl < RHALF; cl += 2) { RS_STEP(0, cl); RS_STEP(1, cl + 1); }
#undef RS_STEP
#undef RS_LOAD
        if (half == 0) {
#pragma unroll
            for (int kt = 0; kt < 4; ++kt) *(f32x4*)(SSg + (size_t)blk * 1024 + (kt * 64 + lane) * 4) = S[kt];
        }
    }
}
__device__ __forceinline__ float rowmax16(float x) { x = fmaxf(x, dpp_f<0xB1>(x)); x = fmaxf(x, dpp_f<0x4E>(x)); x = fmaxf(x, dpp_f<0x124>(x)); x = fmaxf(x, dpp_f<0x128>(x)); return x; }
__device__ __forceinline__ int cand_code(int s) {
    if (s < 16) return s << 4;
    if (s < 24) return 1 | ((s - 16) << 4);
    if (s < 29) return 2 | ((s - 24) << 4);
    if (s < 33) return 3 | ((s - 29) << 4);
    if (s < 36) return 4 | ((s - 33) << 4);
    if (s < 42) { const int k = s - 36; return (5 + (k >> 1)) | ((k & 1) << 4); }
    if (s < 50) return 8 + (s - 42);
    return -1;
}
__device__ __forceinline__ int f2ord(float f) { const int b = __float_as_int(f); return b ^ ((b >> 31) & 0x7fffffff); }
__device__ __forceinline__ float ord2f(int k) { return __int_as_float(k ^ ((k >> 31) & 0x7fffffff)); }
template <int CTRL> __device__ __forceinline__ int dpp_i(int x) { return __builtin_amdgcn_mov_dpp(x, CTRL, 0xf, 0xf, true); }
__device__ __forceinline__ int imax(int a, int b) { return a > b ? a : b; }
__device__ __forceinline__ int imin(int a, int b) { return a < b ? a : b; }
__device__ __forceinline__ int rowmax16_i(int x) { x = imax(x, dpp_i<0xB1>(x)); x = imax(x, dpp_i<0x4E>(x)); x = imax(x, dpp_i<0x124>(x)); x = imax(x, dpp_i<0x128>(x)); return x; }
#define CSWAP_(a, b) do { const int hi_ = imax(a, b), lo_ = imin(a, b); a = hi_; b = lo_; } while (0)
template <int NV> __device__ __forceinline__ void sort_desc(int (&v)[NV]);
template <> __device__ __forceinline__ void sort_desc<8>(int (&v)[8]) {
    CSWAP_(v[0], v[1]); CSWAP_(v[2], v[3]); CSWAP_(v[4], v[5]); CSWAP_(v[6], v[7]);
    CSWAP_(v[0], v[2]); CSWAP_(v[1], v[3]); CSWAP_(v[4], v[6]); CSWAP_(v[5], v[7]);
    CSWAP_(v[1], v[2]); CSWAP_(v[5], v[6]);
    CSWAP_(v[0], v[4]); CSWAP_(v[1], v[5]); CSWAP_(v[2], v[6]); CSWAP_(v[3], v[7]);
    CSWAP_(v[2], v[4]); CSWAP_(v[3], v[5]);
    CSWAP_(v[1], v[2]); CSWAP_(v[3], v[4]); CSWAP_(v[5], v[6]);
}
template <> __device__ __forceinline__ void sort_desc<4>(int (&v)[4]) {
    CSWAP_(v[0], v[1]); CSWAP_(v[2], v[3]); CSWAP_(v[0], v[2]); CSWAP_(v[1], v[3]); CSWAP_(v[1], v[2]);
}
template <int NV>
__device__ __forceinline__ void select16x4(int (&v)[4][NV], int r16, float (&kept_f)[4]) {
    const int IMIN = (int)0x80000000;
    int kept[4];
#pragma unroll
    for (int j = 0; j < 4; ++j) { kept[j] = IMIN; sort_desc<NV>(v[j]); }
#pragma unroll 1
    for (int rd = 0; rd < 16; ++rd) {
#pragma unroll
        for (int j = 0; j < 4; ++j) {
            const int m = rowmax16_i(v[j][0]);
            kept[j] = (r16 == rd) ? m : kept[j];
            const bool own = (v[j][0] == m);
#pragma unroll
            for (int i = 0; i < NV - 1; ++i) v[j][i] = own ? v[j][i + 1] : v[j][i];
            v[j][NV - 1] = own ? IMIN : v[j][NV - 1];
        }
    }
#pragma unroll
    for (int j = 0; j < 4; ++j) kept_f[j] = ord2f(kept[j]);
}
__device__ __forceinline__ float dot2bf(unsigned a, unsigned b, float acc) { return __builtin_amdgcn_fdot2_f32_bf16(__builtin_bit_cast(bf16x2_t, a), __builtin_bit_cast(bf16x2_t, b), acc, false); }

constexpr int PT = 16;
constexpr size_t RANGE_BYTES = (size_t)NEXP * 128;

__device__ __forceinline__ void p9_route(const Ctx& F) {
    constexpr int KSTR = 136;
    const bf16* Q = (const bf16*)(F.ws + WS_Q); const bf16* KEYS = (const bf16*)(F.ws + WS_KEYS);
    int* rtE = (int*)(F.ws + WS_RTE); float* rtG = (float*)(F.ws + WS_RTG);
    LAS bf16* KL = (LAS bf16*)F.lds;
    const int lane = F.lane, w = F.wave, r16 = lane & 15, q = lane >> 4, gbase = lane & 48;
    const int h = blockIdx.x & 7, nbh = (F.G - h + 7) >> 3;
    __syncthreads();
    for (int i = F.tid; i < 2 * 128 * 16; i += NTHR) { const int row = i >> 4, ch = i & 15;
        *(LAS v4u*)(KL + row * KSTR + 8 * ch) = *(const v4u*)(KEYS + (size_t)(2 * h * 128 + row) * 128 + 8 * ch); }
    __syncthreads();
    int ci[4], cj[4]; bool cvalid[4];
#pragma unroll
    for (int u = 0; u < 4; ++u) { const int cd = cand_code(r16 + 16 * u); cvalid[u] = cd >= 0; ci[u] = cd & 15; cj[u] = (cd >> 4) & 15; }
    const float NINF = -__builtin_inff();
    const int tstride = nbh * NWAVES;
    int tile = (blockIdx.x >> 3) * NWAVES + w;
    bf16x8 afn[2][4];
    if (tile < M / PT) {
#pragma unroll
        for (int p = 0; p < 2; ++p)
#pragma unroll
            for (int s = 0; s < 4; ++s) afn[p][s] = *(const bf16x8*)(Q + (size_t)(tile * PT + r16) * DM + (2 * h + p) * 128 + 8 * q + 32 * s);
    }
    for (; tile < M / PT; tile += tstride) {
        const int m0 = tile * PT;
        bf16x8 af[2][4];
#pragma unroll
        for (int p = 0; p < 2; ++p)
#pragma unroll
            for (int s = 0; s < 4; ++s) af[p][s] = afn[p][s];
        { const int tn = (tile + tstride < M / PT) ? tile + tstride : tile;
#pragma unroll
            for (int p = 0; p < 2; ++p)
#pragma unroll
                for (int s = 0; s < 4; ++s) afn[p][s] = *(const bf16x8*)(Q + (size_t)(tn * PT + r16) * DM + (2 * h + p) * 128 + 8 * q + 32 * s);
        }
        float top[2][4];
#pragma unroll
        for (int p = 0; p < 2; ++p) {
            int v[4][8];
#pragma unroll
            for (int nt = 0; nt < 8; ++nt) {
                const LAS bf16* krow = KL + (p * 128 + nt * 16 + r16) * KSTR + 8 * q;
                f32x4 acc = {0.f, 0.f, 0.f, 0.f};
#pragma unroll
                for (int s = 0; s < 4; ++s) acc = __builtin_amdgcn_mfma_f32_16x16x32_bf16(af[p][s], *(const LAS bf16x8*)(krow + 32 * s), acc, 0, 0, 0);
                const unsigned tag = 127u - (unsigned)(nt * 16 + r16);
#pragma unroll
                for (int j = 0; j < 4; ++j) v[j][nt] = f2ord(__uint_as_float((__float_as_uint(acc[j]) & ~127u) | tag));
                if (nt & 1) asm volatile("" ::: "memory");
            }
            select16x4<8>(v, r16, top[p]);
        }
        int cv[4][4];
#pragma unroll
        for (int u = 0; u < 4; ++u)
#pragma unroll
            for (int j = 0; j < 4; ++j) {
                const float a = __shfl(top[0][j], gbase + ci[u]), b = __shfl(top[1][j], gbase + cj[u]);
                const float cs = __uint_as_float(__float_as_uint(a) & ~127u) + __uint_as_float(__float_as_uint(b) & ~127u);
                const float pk = __uint_as_float((__float_as_uint(cs) & ~63u) | (63u - (unsigned)(r16 + 16 * u)));
                cv[j][u] = cvalid[u] ? f2ord(pk) : (int)0x80000000;
            }
        float best[4];
        select16x4<4>(cv, r16, best);
#pragma unroll
        for (int j = 0; j < 4; ++j) {
            const unsigned bb = __float_as_uint(best[j]);
            const int cd = cand_code(63 - (int)(bb & 63u));
            const int k0 = 127 - (int)(__float_as_uint(__shfl(top[0][j], gbase + (cd & 15))) & 127u);
            const int k1 = 127 - (int)(__float_as_uint(__shfl(top[1][j], gbase + ((cd >> 4) & 15))) & 127u);
            const float s = __uint_as_float(bb & ~63u);
            const float mx = rowmax16(s), e = __expf(s - mx), sum = rowsum16(e);
            const size_t o = (size_t)(m0 + 4 * q + j) * 128 + h * 16 + r16;
            rtE[o] = k0 * 128 + k1; rtG[o] = e * rcp_f(sum);
        }
    }
}

__device__ __forceinline__ f32x2 cvt2_fp8(unsigned wd, bool hi) { return hi ? __builtin_amdgcn_cvt_pk_f32_fp8((int)wd, true) : __builtin_amdgcn_cvt_pk_f32_fp8((int)wd, false); }
__device__ __forceinline__ void treduce8x16(const float (&p)[16], bool b0, bool b1, bool b2, float& r0, float& r1) {
    float a[8], bq[4];
#pragma unroll
    for (int i = 0; i < 8; ++i) { const float mine = b2 ? p[i + 8] : p[i], send = b2 ? p[i] : p[i + 8]; const float up = dpp_f<0x104>(send), dn = dpp_f<0x114>(send); a[i] = mine + (b2 ? dn : up); }
#pragma unroll
    for (int i = 0; i < 4; ++i) { const float mine = b1 ? a[i + 4] : a[i], send = b1 ? a[i] : a[i + 4]; bq[i] = mine + dpp_f<0x4E>(send); }
    { const float mine = b0 ? bq[2] : bq[0], send = b0 ? bq[0] : bq[2]; r0 = mine + dpp_f<0xB1>(send); }
    { const float mine = b0 ? bq[3] : bq[1], send = b0 ? bq[1] : bq[3]; r1 = mine + dpp_f<0xB1>(send); }
}
struct XGroup { int xg, gwi, stride; };
__device__ __forceinline__ XGroup xgroup(const Ctx& F) { XGroup g; g.xg = blockIdx.x & 7; const int nbg = (F.G - g.xg + 7) >> 3; g.gwi = (blockIdx.x >> 3) * NWAVES + F.wave; g.stride = nbg * NWAVES; return g; }

__device__ __forceinline__ void p10_peer_u(const Ctx& F) {
    const unsigned char* PU8 = F.ws + WS_PU8; const bf16* XN = (const bf16*)(F.ws + WS_XN);
    const int* rtE = (const int*)(F.ws + WS_RTE); unsigned* PD = (unsigned*)(F.ws + WS_PD);
    const XGroup g = xgroup(F);
    const int lane = F.lane, j = lane >> 3, sub = lane & 7;
    const bool b0 = sub & 1, b1 = sub & 2, b2 = sub & 4;
    for (int rr = 0; rr < 2; ++rr) {
        const int r = g.xg + 8 * rr;
        const unsigned char* tab = PU8 + (size_t)r * RANGE_BYTES + 16 * sub;
        int m = g.gwi;
        v4u ev[4], xs[2];
        if (m < M) {
#pragma unroll
            for (int i = 0; i < 4; ++i) ev[i] = *(const v4u*)(rtE + (size_t)m * 128 + 16 * j + 4 * i);
            xs[0] = *(const v4u*)(XN + (size_t)m * DM + 128 * r + 16 * sub); xs[1] = *(const v4u*)(XN + (size_t)m * DM + 128 * r + 16 * sub + 8);
        }
        for (; m < M; m += g.stride) {
            v4u gt[16];
#pragma unroll
            for (int k = 0; k < 16; ++k) gt[k] = *(const v4u*)(tab + (size_t)ev[k >> 2][k & 3] * 128);
            float x[16]; { float t0[8], t1[8]; unpack8(xs[0], t0); unpack8(xs[1], t1);
#pragma unroll
              for (int i = 0; i < 8; ++i) { x[i] = t0[i]; x[8 + i] = t1[i]; } }
            const int mn = (m + g.stride < M) ? m + g.stride : m;
            {
#pragma unroll
                for (int i = 0; i < 4; ++i) ev[i] = *(const v4u*)(rtE + (size_t)mn * 128 + 16 * j + 4 * i);
                xs[0] = *(const v4u*)(XN + (size_t)mn * DM + 128 * r + 16 * sub); xs[1] = *(const v4u*)(XN + (size_t)mn * DM + 128 * r + 16 * sub + 8);
            }
            float p[16];
#pragma unroll
            for (int k = 0; k < 16; ++k) {
                f32x2 a0 = {0.f, 0.f}, a1 = {0.f, 0.f};
#pragma unroll
                for (int d = 0; d < 4; ++d) { const unsigned wd = gt[k][d];
                    a0 += cvt2_fp8(wd, false) * (f32x2){x[4 * d], x[4 * d + 1]}; a1 += cvt2_fp8(wd, true) * (f32x2){x[4 * d + 2], x[4 * d + 3]}; }
                p[k] = (a0.x + a0.y) + (a1.x + a1.y);
            }
            float r0, r1; treduce8x16(p, b0, b1, b2, r0, r1);
            PD[((size_t)r * M + m) * 64 + lane] = pk2(r0, r1);
        }
    }
}

__device__ __forceinline__ void p11_peer_coef(const Ctx& F) {
    const int* rtE = (const int*)(F.ws + WS_RTE); const float* rtG = (const float*)(F.ws + WS_RTG); const unsigned* PD = (const unsigned*)(F.ws + WS_PD);
    const float* usc = (const float*)(F.ws + WS_USC); const float* vsc = (const float*)(F.ws + WS_VSC); float* COEF = (float*)(F.ws + WS_COEF);
    for (int m = F.gw; m < M; m += F.NGW) {
        const size_t o = (size_t)m * 128 + 2 * F.lane;
        f32x2 d = {0.f, 0.f};
#pragma unroll
        for (int r = 0; r < 16; ++r) { const unsigned pw = PD[((size_t)r * M + m) * 64 + F.lane]; d += (f32x2){bflo(pw), bfhi(pw)}; }
        const int e0 = rtE[o], e1 = rtE[o + 1];
        const f32x2 gt = *(const f32x2*)(rtG + o);
        const float d0 = d.x * usc[e0], d1 = d.y * usc[e1];
        f32x2 c; c.x = gt.x * (0.5f * d0 * (1.f + erff(d0 * 0.70710678f))) * vsc[e0]; c.y = gt.y * (0.5f * d1 * (1.f + erff(d1 * 0.70710678f))) * vsc[e1];
        *(f32x2*)(COEF + o) = c;
    }
}

__device__ __forceinline__ void p12_peer_v(const Ctx& F) {
    const unsigned char* PV8 = F.ws + WS_PV8; const int* rtE = (const int*)(F.ws + WS_RTE); const float* COEF = (const float*)(F.ws + WS_COEF);
    const float* mod = (const float*)(F.ws + WS_MOD);
    const XGroup g = xgroup(F);
    const int lane = F.lane, j = lane >> 3, sub = lane & 7;
    const bool jb0 = j & 1;
    for (int rr = 0; rr < 2; ++rr) {
        const int r = g.xg + 8 * rr;
        const unsigned char* tab = PV8 + (size_t)r * RANGE_BYTES + 16 * sub;
        int m = g.gwi;
        v4u ev[4]; f32x4 cf[4];
        if (m < M) {
#pragma unroll
            for (int i = 0; i < 4; ++i) { ev[i] = *(const v4u*)(rtE + (size_t)m * 128 + 16 * j + 4 * i); cf[i] = *(const f32x4*)(COEF + (size_t)m * 128 + 16 * j + 4 * i); }
        }
        for (; m < M; m += g.stride) {
            v4u gt[16];
#pragma unroll
            for (int k = 0; k < 16; ++k) gt[k] = *(const v4u*)(tab + (size_t)ev[k >> 2][k & 3] * 128);
            f32x4 cc[4];
#pragma unroll
            for (int i = 0; i < 4; ++i) cc[i] = cf[i];
            const int mn = (m + g.stride < M) ? m + g.stride : m;
            {
#pragma unroll
                for (int i = 0; i < 4; ++i) { ev[i] = *(const v4u*)(rtE + (size_t)mn * 128 + 16 * j + 4 * i); cf[i] = *(const f32x4*)(COEF + (size_t)mn * 128 + 16 * j + 4 * i); }
            }
            f32x2 acc[8];
#pragma unroll
            for (int i = 0; i < 8; ++i) acc[i] = (f32x2){0.f, 0.f};
#pragma unroll
            for (int k = 0; k < 16; ++k) { const float c = cc[k >> 2][k & 3]; const f32x2 cv2 = {c, c};
#pragma unroll
                for (int d = 0; d < 4; ++d) { const unsigned wd = gt[k][d]; acc[2 * d] += cv2 * cvt2_fp8(wd, false); acc[2 * d + 1] += cv2 * cvt2_fp8(wd, true); } }
            float a[16];
#pragma unroll
            for (int i = 0; i < 8; ++i) { a[2 * i] = acc[i].x; a[2 * i + 1] = acc[i].y; }
            float s8[8], s4[4];
#pragma unroll
            for (int c = 0; c < 8; ++c) { auto rr2 = __builtin_amdgcn_permlane32_swap(__float_as_uint(a[c]), __float_as_uint(a[c + 8]), false, false); s8[c] = __uint_as_float(rr2[0]) + __uint_as_float(rr2[1]); }
#pragma unroll
            for (int c = 0; c < 4; ++c) { auto rr2 = __builtin_amdgcn_permlane16_swap(__float_as_uint(s8[c]), __float_as_uint(s8[c + 4]), false, false); s4[c] = __uint_as_float(rr2[0]) + __uint_as_float(rr2[1]); }
            f32x2 res;
            { const float mine = jb0 ? s4[2] : s4[0], send = jb0 ? s4[0] : s4[2]; res.x = mine + dpp_f<0x128>(send); }
            { const float mine = jb0 ? s4[3] : s4[1], send = jb0 ? s4[1] : s4[3]; res.y = mine + dpp_f<0x128>(send); }
            const int col = 128 * r + 16 * sub + 2 * j;
            unsigned* orow = (unsigned*)((bf16*)(F.ws + WS_HB) + (size_t)m * DM + col);
            const unsigned hw = *orow; const f32x2 h1 = {bflo(hw), bfhi(hw)}, g2 = *(const f32x2*)(mod + (size_t)(m / SEQ) * MODW + 5 * DM + col);
            const f32x2 h2 = h1 + g2 * res;
            *orow = pk2(h2.x, h2.y);
        }
    }
}
#define XB_TMO      128
#define XB_XCNT(j)  (256  + 64 * (j))
#define XB_XSUB(j)  (1280 + 64 * (j))
#define XB_XGEN(j)  (2304 + 64 * (j))
#define XB_TOP      3328
#define XB_TOPGEN   3392
#define XCD_BAR_WORDS 3456
#define XB_SPIN_CAP (1u << 18)

__device__ __forceinline__ unsigned xb_ld(unsigned* p)              { return __hip_atomic_load(p, __ATOMIC_RELAXED, __HIP_MEMORY_SCOPE_AGENT); }
__device__ __forceinline__ unsigned xb_add(unsigned* p, unsigned v) { return __hip_atomic_fetch_add(p, v, __ATOMIC_RELAXED, __HIP_MEMORY_SCOPE_AGENT); }
__device__ __forceinline__ unsigned xb_xcc_id() { return (unsigned)__builtin_amdgcn_s_getreg((3 << 11) | 20) & 0xFu; }
#define XB_SPIN(cond, bar) do { unsigned _sp = 0; while (cond) { __builtin_amdgcn_s_sleep(1); \
    if ((++_sp & 255u) == 0u) { if (xb_ld(&(bar)[XB_TMO])) break; if (_sp > XB_SPIN_CAP) { atomicAdd(&(bar)[XB_TMO], 1u); break; } } } } while (0)

struct XcdBarrier {
    unsigned* bar; unsigned x;
    volatile LAS unsigned* st;
};

__device__ __forceinline__ XcdBarrier xcd_barrier_post(unsigned* bar, volatile LAS unsigned* st) {
    XcdBarrier b; b.bar = bar; b.x = xb_xcc_id(); b.st = st;
    if (threadIdx.x == 0) (void)xb_add(&bar[XB_XCNT(b.x)], 1u);
    return b;
}
__device__ __forceinline__ void xcd_barrier_complete(unsigned* bar, unsigned x, unsigned& nloc, unsigned& nx) {
    const unsigned G = gridDim.x * gridDim.y * gridDim.z;
    unsigned sum, cnt, mine, sp = 0u;
    for (;;) {
        sum = 0u; cnt = 0u; mine = 0u;
#pragma unroll
        for (unsigned j = 0; j < 16; ++j) { const unsigned c = xb_ld(&bar[XB_XCNT(j)]); sum += c; cnt += (c > 0u) ? 1u : 0u; mine = (j == x) ? c : mine; }
        if (sum == G) break;
        __builtin_amdgcn_s_sleep(1);
        if ((++sp & 255u) == 0u) { if (xb_ld(&bar[XB_TMO])) break; if (sp > XB_SPIN_CAP) { atomicAdd(&bar[XB_TMO], 1u); break; } }
    }
    nloc = mine > 0u ? mine : 1u; nx = cnt > 0u ? cnt : 1u;
}

__device__ __forceinline__ void xcd_barrier(const XcdBarrier& b) {
    asm volatile("s_waitcnt vmcnt(0)" ::: "memory");
    __syncthreads();
    if (threadIdx.x == 0) {
        unsigned* bar = b.bar;
        __builtin_amdgcn_s_waitcnt(0);
        unsigned nloc = b.st[0], nx = b.st[1];
        if (nloc == 0u) { xcd_barrier_complete(bar, b.x, nloc, nx); b.st[0] = nloc; b.st[1] = nx; }
        const unsigned old = xb_add(&bar[XB_XSUB(b.x)], 1u);
        const unsigned gen = old / nloc;
        if (old + 1u == (gen + 1u) * nloc) {
            __builtin_amdgcn_fence(__ATOMIC_RELEASE, "agent");
            asm volatile("s_waitcnt vmcnt(0)" ::: "memory");
            const unsigned og = xb_add(&bar[XB_TOP], 1u);
            const unsigned tg = og / nx;
            if (og + 1u == (tg + 1u) * nx) xb_add(&bar[XB_TOPGEN], 1u);
            else XB_SPIN(xb_ld(&bar[XB_TOPGEN]) == tg, bar);
            __builtin_amdgcn_fence(__ATOMIC_ACQUIRE, "agent");
            xb_add(&bar[XB_XGEN(b.x)], 1u);
            asm volatile("s_waitcnt vmcnt(0)" ::: "memory");
        } else {
            XB_SPIN(xb_ld(&bar[XB_XGEN(b.x)]) == gen, bar);
            __builtin_amdgcn_fence(__ATOMIC_ACQUIRE, "agent");
            asm volatile("s_waitcnt vmcnt(0)" ::: "memory");
        }
    }
    __syncthreads();
}

struct Args { const float* in[N_IN]; float* out; unsigned char* ws; int ph_lo, ph_hi; };
constexpr int N_PHASES = 18;

__global__ void __launch_bounds__(NTHR, 2) fwd_kernel(Args args) {
    extern __shared__ __attribute__((aligned(16))) unsigned char lds_raw[];
    cg::grid_group grid = cg::this_grid();
    Ctx F;
    F.lds = (LAS unsigned char*)lds_raw;
    F.tid = threadIdx.x; F.lane = F.tid & 63; F.wave = __builtin_amdgcn_readfirstlane(F.tid >> 6);
    F.G = gridDim.x; F.gw = blockIdx.x * NWAVES + F.wave; F.NGW = F.G * NWAVES;
    F.in = args.in; F.out = args.out; F.ws = args.ws;
    const int lo = args.ph_lo, hi = args.ph_hi;
    volatile LAS unsigned* bst = (volatile LAS unsigned*)(F.lds + LDS_BYTES - 64);
    if (F.tid < 2) bst[F.tid] = 0u;
    __syncthreads();
    const XcdBarrier bar = xcd_barrier_post((unsigned*)(F.ws + WS_CTL) + 4096, bst);
#define IN(k) (lo <= (k) && (k) < hi)
#ifndef TS_A
#define TS_A -1
#define TS_B -1
#define TS_K 0.1
#endif
    unsigned long long* stamps = (unsigned long long*)(F.ws + WS_CTL + 65536);
#define STAMP(k) do { if (TS_A >= 0 && blockIdx.x == 0 && F.tid == 0) stamps[k] = __builtin_amdgcn_s_memrealtime(); } while (0)
#define REP_MASK 0
#ifndef REP_MASK
#define REP_MASK 0
#endif
#define REPS(k) for (int rep_ = 0; rep_ < 1 + ((REP_MASK >> (k)) & 1); ++rep_)
#define SEAM(k) do { if (IN(k) && IN((k) + 1)) { if ((k) == 0) grid.sync(); else xcd_barrier(bar); } } while (0)

    STAMP(0);
    if (IN(0)) REPS(0) { p0_prologue(F); }
    SEAM(0);
    STAMP(1);
    if (IN(1)) REPS(1) { norm_mod_rows(F, F.in[I_X], F.in[I_N1W], 0, DM, (bf16*)(F.ws + WS_XN)); }
    SEAM(1);
    STAMP(2);
    if (IN(2)) REPS(2) {
        pg8::Gemm g{(const pg8::bf16_t*)(F.ws + WS_XN), (const pg8::bf16_t*)(F.ws + WS_WIN), M, INPP, DM};
        pg8::StaticOrder S; S.init(M, INPP, F.G, (int)blockIdx.x);
        pg8::EpiStoreBf16 E{(pg8::bf16_t*)(F.ws + WS_PROJ), INPP};
        pg8::gemm_phase<pg8::EpiStoreBf16, pg8::StaticOrder, true, true>(F.lds, g, S, E);
    }
    SEAM(2);
#ifndef P3REP
#define P3REP 0
#endif
    STAMP(3);
    if (IN(3)) REPS(3) { p3_lora(F); if (P3REP == 1) p3_lora(F); m1_chunk_states(F); if (P3REP == 2) m1_chunk_states(F); }
    SEAM(3);
    STAMP(4);
    if (IN(4)) REPS(4) { m2_prefix(F); ra_half(F, 0); }
    SEAM(4);
    STAMP(5);
    if (IN(5)) REPS(5) { rs_half(F, 0); }
    SEAM(5);
    STAMP(6);
    if (IN(6)) REPS(6) { ra_half(F, 1); }
    SEAM(6);
    STAMP(7);
    if (IN(7)) REPS(7) { rs_half(F, 1); }
    SEAM(7);
    STAMP(8);
    if (IN(8)) REPS(8) { m3_outputs(F); }
    SEAM(8);
    STAMP(9);
    if (IN(9)) { p5_post(F); }
    SEAM(9);
    STAMP(10);
    if (IN(10)) REPS(10) {
        pg8::Gemm g{(const pg8::bf16_t*)(F.ws + WS_OY), (const pg8::bf16_t*)(F.ws + WS_WOUT), M, DM, DM};
        pg8::StaticOrder S; S.init(M, DM, F.G, (int)blockIdx.x);
        pg8::EpiResid E{F.in[I_X], (const float*)(F.ws + WS_MOD) + 2 * DM, (pg8::bf16_t*)(F.ws + WS_HB), DM, SEQ, MODW};
        pg8::gemm_phase<pg8::EpiResid, pg8::StaticOrder, true, true>(F.lds, g, S, E);
    }
    SEAM(10);
    STAMP(11);
    if (IN(11)) REPS(11) { norm_mod_rows_bf16(F, (const bf16*)(F.ws + WS_HB), F.in[I_N2W], 3 * DM, 4 * DM, (bf16*)(F.ws + WS_XN)); }
    SEAM(11);
    STAMP(12);
    if (IN(12)) REPS(12) {
        pg8::Gemm g{(const pg8::bf16_t*)(F.ws + WS_XN), (const pg8::bf16_t*)(F.ws + WS_WQ), M, DM, DM};
        pg8::StaticOrder S; S.init(M, DM, F.G, (int)blockIdx.x);
        pg8::EpiStoreBf16 E{(pg8::bf16_t*)(F.ws + WS_Q), DM};
        pg8::gemm_phase<pg8::EpiStoreBf16, pg8::StaticOrder, true, true>(F.lds, g, S, E);
    }
    SEAM(12);
    STAMP(13);
    if (IN(13)) REPS(13) { p9_route(F); }
    SEAM(13);
    STAMP(14);
    if (IN(14)) REPS(14) { p10_peer_u(F); }
    SEAM(14);
    STAMP(15);
    if (IN(15)) REPS(15) { p11_peer_coef(F); }
    SEAM(15);
    STAMP(16);
    if (IN(16)) { p12_peer_v(F); }
    SEAM(16);
    STAMP(17);
    if (IN(17)) {
        float oscale = 1.f;
        if (TS_A >= 0) { const volatile unsigned long long* st = stamps; const float frac = (float)(st[TS_B] - st[TS_A]) / (float)(st[16] - st[0]); oscale = 1.f + (float)(TS_K) * frac; }
        final_norm_rows_bf16(F, (const bf16*)(F.ws + WS_HB), F.in[I_FNW], F.out, oscale);
    }
#undef IN
#undef SEAM
}

extern "C" void kernel_launch(void* const* d_in, const int* in_sizes, int n_in, void* d_out, int out_size, void* d_ws, size_t ws_size, hipStream_t stream) {
    static int grid = 0;
    if (grid == 0) {
        if (n_in != N_IN || in_sizes[0] != M * DM || out_size != M * DM || ws_size < WS_END2) {
            fprintf(stderr, "kernel_launch: unexpected shapes: n_in %d in0 %d out %d ws %zu (need %zu)\n", n_in, n_in > 0 ? in_sizes[0] : -1, out_size, ws_size, (size_t)WS_END2); grid = -1; return; }
        int dev = 0, cus = 0, per_cu = 0;
        if (hipGetDevice(&dev) != hipSuccess || hipDeviceGetAttribute(&cus, hipDeviceAttributeMultiprocessorCount, dev) != hipSuccess) { grid = -1; return; }
        if (hipFuncSetAttribute((const void*)fwd_kernel, hipFuncAttributeMaxDynamicSharedMemorySize, LDS_BYTES) != hipSuccess) { fprintf(stderr, "kernel_launch: hipFuncSetAttribute failed\n"); grid = -1; return; }
        if (hipOccupancyMaxActiveBlocksPerMultiprocessor(&per_cu, (const void*)fwd_kernel, NTHR, LDS_BYTES) != hipSuccess || per_cu < 1) { fprintf(stderr, "kernel_launch: occupancy query says %d blocks per CU\n", per_cu); per_cu = 1; }
        (void)hipGetLastError();
        grid = cus;
        fprintf(stderr, "kernel_launch: cus %d per_cu %d grid %d ws %zu\n", cus, per_cu, grid, ws_size);
    }
    if (grid < 0) return;
    (void)hipMemsetAsync((char*)d_ws + WS_CTL, 0, CTL_ZERO_BYTES, stream);
    Args a{};
    for (int i = 0; i < N_IN; ++i) a.in[i] = (const float*)d_in[i];
    a.out = (float*)d_out; a.ws = (unsigned char*)d_ws; a.ph_lo = 0; a.ph_hi = N_PHASES;
    void* kargs[] = {&a};
#ifndef NPASS
#define NPASS 1
#endif
    hipError_t e = hipSuccess;
    for (int pass_ = 0; pass_ < NPASS; ++pass_) {
        if (pass_ > 0) (void)hipMemsetAsync((char*)d_ws + WS_CTL, 0, CTL_ZERO_BYTES, stream);
        e = hipLaunchCooperativeKernel((const void*)fwd_kernel, dim3(grid), dim3(NTHR), kargs, LDS_BYTES, stream);
    }
    if (e != hipSuccess) fprintf(stderr, "kernel_launch: cooperative launch failed: %s (grid %d)\n", hipGetErrorString(e), grid);
}
```

```cpp
#include <hip/hip_runtime.h>
#include <hip/hip_cooperative_groups.h>
#include <cstdio>
#include <cstdint>
namespace cg = cooperative_groups;
namespace pg8 {
#define PG8_LAS __attribute__((address_space(3)))
typedef unsigned short bf16_t;
typedef short bf16x8 __attribute__((ext_vector_type(8)));
typedef float f32x4 __attribute__((ext_vector_type(4)));
typedef unsigned u32x4 __attribute__((ext_vector_type(4)));
constexpr int BM = 256, BK = 64, HALF = 128, HTB = HALF * BK * 2  , STAGE_BYTES = 8 * HTB, NXCD = 8, WGM = 8;

__host__ __device__ __forceinline__ int lds_byte(int r, int c) { const int st = (r >> 4) * 2 + (c >> 5), rr = r & 15, cc = c & 31, ob = rr * 64 + cc * 2; return st * 1024 + (ob ^ (((ob >> 9) & 1) << 5)); }
__host__ __device__ __forceinline__ void stage_rc(int b, int& R, int& C) { const int st = b / 1024, sb = b % 1024, swz = sb ^ (((sb >> 9) & 1) << 5); R = (st >> 1) * 16 + swz / 64; C = (st & 1) * 32 + (swz % 64) / 2; }
__host__ __device__ __forceinline__ int perm32(int rho) { const int n = rho >> 4, i = rho & 15; return 8 * (i >> 2) + 4 * n + (i & 3); }

struct Unit { int pm, pn; };
struct Gemm { const bf16_t* A; const bf16_t* Bt; int M, N, K; };

struct StaticOrder {
    int nM, nN, nwg, G, c;
    __host__ __device__ void init(int M, int N, int G_, int c_) { nM = M / BM; nN = N / BM; nwg = nM * nN; G = G_; c = c_; }
    __host__ __device__ bool next(int i, Unit& u) const {
        const long L = (long)i * G + c; if (L >= nwg) return false;
        int wgid = (int)L; { const int q = nwg / NXCD, r = nwg % NXCD, xcd = wgid % NXCD, off = wgid / NXCD; wgid = (xcd < r ? xcd * (q + 1) : r * (q + 1) + (xcd - r) * q) + off; }
        const int nig = WGM * nN, gid = wgid / nig, fm = gid * WGM, gsz = (nM - fm) < WGM ? (nM - fm) : WGM;
        u.pm = fm + ((wgid % nig) % gsz); u.pn = (wgid % nig) / gsz; return true;
    }
    __device__ __forceinline__ void a_ready(const Unit&) const {}
    __device__ __forceinline__ void done(const Unit&) const {}
};
__device__ __forceinline__ unsigned cvt_pk_bf16(float lo, float hi) { unsigned r; asm volatile("v_cvt_pk_bf16_f32 %0, %1, %2" : "=v"(r) : "v"(lo), "v"(hi)); return r; }
struct EpiStoreBf16 {
    static constexpr bool PERM = true, AFTER_DRAIN = false;
    bf16_t* O; int ldc;
    __device__ __forceinline__ void operator()(const f32x4 (&acc)[2][2][4][2], const Unit& u, int wr, int wc, int fr, int fq) const {
        const int row0 = u.pm * BM + wr * 64 + fr; const int col0 = u.pn * BM + wc * 32 + 8 * fq;
#pragma unroll
        for (int ai = 0; ai < 2; ++ai)
#pragma unroll
            for (int m = 0; m < 4; ++m) { bf16_t* rowp = O + (size_t)(row0 + ai * HALF + m * 16) * ldc + col0;
#pragma unroll
                for (int bj = 0; bj < 2; ++bj) { const f32x4 v0 = acc[ai][bj][m][0], v1 = acc[ai][bj][m][1];
                    u32x4 w; w.x = cvt_pk_bf16(v0[0], v0[1]); w.y = cvt_pk_bf16(v0[2], v0[3]); w.z = cvt_pk_bf16(v1[0], v1[1]); w.w = cvt_pk_bf16(v1[2], v1[3]);
                    *(u32x4*)(rowp + bj * HALF) = w; } }
    }
};
struct EpiResid {
    static constexpr bool PERM = true, AFTER_DRAIN = false;
    const float* X; const float* gate; bf16_t* O; int ldc; int rows_per_batch; int gstride;
    __device__ __forceinline__ void operator()(const f32x4 (&acc)[2][2][4][2], const Unit& u, int wr, int wc, int fr, int fq) const {
        const int row0 = u.pm * BM + wr * 64 + fr; const int col0 = u.pn * BM + wc * 32 + 8 * fq;
        const float* g = gate + (size_t)((u.pm * BM) / rows_per_batch) * gstride + col0;
        f32x4 gv[2][2];
#pragma unroll
        for (int bj = 0; bj < 2; ++bj)
#pragma unroll
            for (int n = 0; n < 2; ++n) gv[bj][n] = *(const f32x4*)(g + bj * HALF + 4 * n);
#pragma unroll
        for (int ai = 0; ai < 2; ++ai)
#pragma unroll
            for (int m = 0; m < 4; ++m) { const size_t off = (size_t)(row0 + ai * HALF + m * 16) * ldc + col0;
#pragma unroll
                for (int bj = 0; bj < 2; ++bj) { const f32x4 x0 = *(const f32x4*)(X + off + bj * HALF), x1 = *(const f32x4*)(X + off + bj * HALF + 4);
                    const f32x4 v0 = x0 + gv[bj][0] * acc[ai][bj][m][0], v1 = x1 + gv[bj][1] * acc[ai][bj][m][1];
                    u32x4 w; w.x = cvt_pk_bf16(v0[0], v0[1]); w.y = cvt_pk_bf16(v0[2], v0[3]); w.z = cvt_pk_bf16(v1[0], v1[1]); w.w = cvt_pk_bf16(v1[2], v1[3]);
                    *(u32x4*)(O + off + bj * HALF) = w; } }
    }
};
template <class Epi, class Sched, bool ALIGN_EPI = false, bool SP2 = false>
__device__ __forceinline__ void gemm_phase(PG8_LAS unsigned char* lds, const Gemm g, const Sched& S, const Epi& E) {
    const int tid = threadIdx.x, wid = __builtin_amdgcn_readfirstlane(tid >> 6), lane = tid & 63, wr = wid >> 2, wc = wid & 3, fr = lane & 15, fq = lane >> 4;
    const int K = g.K, nt = K / BK;
    unsigned voffA[2], voffB[2];
#pragma unroll
    for (int i = 0; i < 2; ++i) { int R, C; stage_rc(tid * 16 + i * 8192, R, C); const int Rb = Epi::PERM ? ((R & ~31) + perm32(R & 31)) : R;
        voffA[i] = (unsigned)(R * K + C) * 2u; voffB[i] = (unsigned)(Rb * K + C) * 2u; }
    const size_t kstep = (size_t)(BK * 2);
    const size_t hstep = (size_t)HALF * K * 2;
    const size_t tstep = 2 * hstep;
    const unsigned ldsw = (unsigned)wid * 1024u;
    const int aoff = lds_byte(wr * 64 + fr, fq * 8), boff = lds_byte(wc * 32 + fr, fq * 8);
#define PG8_SA(b, h) (((b) * 2 + (h)) * HTB)
#define PG8_SB(b, h) ((4 + (b) * 2 + (h)) * HTB)
#define PG8_STAGE(bufoff, gbase, voff) do { _Pragma("unroll") for (int _i = 0; _i < 2; ++_i) \
        __builtin_amdgcn_global_load_lds((const unsigned*)((const char*)(gbase) + (voff)[_i]), (PG8_LAS unsigned*)(lds + (bufoff) + ldsw + _i * 8192), 16, 0, 0); } while (0)
#define PG8_LDA(dst, b, h) do { _Pragma("unroll") for (int m = 0; m < 4; ++m) _Pragma("unroll") for (int k = 0; k < 2; ++k) dst[m][k] = *(const PG8_LAS bf16x8*)(lds + PG8_SA(b, h) + aoff + m * 2048 + k * 1024); } while (0)
#define PG8_LDB(dst, b, h) do { _Pragma("unroll") for (int n = 0; n < 2; ++n) _Pragma("unroll") for (int k = 0; k < 2; ++k) dst[n][k] = *(const PG8_LAS bf16x8*)(lds + PG8_SB(b, h) + boff + n * 2048 + k * 1024); } while (0)
#define PG8_MMA(ai, bj, At, Bt) do { __builtin_amdgcn_s_setprio(1); _Pragma("unroll") for (int m = 0; m < 4; ++m) _Pragma("unroll") for (int n = 0; n < 2; ++n) _Pragma("unroll") for (int k = 0; k < 2; ++k) \
        acc[ai][bj][m][n] = __builtin_amdgcn_mfma_f32_16x16x32_bf16(Bt[n][k], At[m][k], acc[ai][bj][m][n], 0, 0, 0); __builtin_amdgcn_s_setprio(0); } while (0)
#define PG8_WAIT_V(n) asm volatile("s_waitcnt vmcnt(" #n ")" ::: "memory")
#define PG8_WAIT_L(n) asm volatile("s_waitcnt lgkmcnt(" #n ")" ::: "memory")
#define PG8_BAR __builtin_amdgcn_s_barrier()
#define PG8_SCHED __builtin_amdgcn_sched_barrier(0)
    Unit cur, nxt; int ui = 0;
    if (!S.next(0, cur)) return;
    f32x4 acc[2][2][4][2];
#pragma unroll
    for (int a = 0; a < 2; ++a)
#pragma unroll
        for (int b = 0; b < 2; ++b)
#pragma unroll
            for (int m = 0; m < 4; ++m)
#pragma unroll
                for (int n = 0; n < 2; ++n) acc[a][b][m][n] = (f32x4){0.f, 0.f, 0.f, 0.f};
    bf16x8 At[4][2], B0[2][2], B1[2][2];
    const char* cA = (const char*)g.A + (size_t)cur.pm * tstep; const char* cB = (const char*)g.Bt + (size_t)cur.pn * tstep;
    S.a_ready(cur);
    if constexpr (SP2) {
        PG8_STAGE(PG8_SB(0, 0), cB, voffB); PG8_STAGE(PG8_SB(0, 1), cB + hstep, voffB); PG8_STAGE(PG8_SA(0, 0), cA, voffA); PG8_STAGE(PG8_SA(0, 1), cA + hstep, voffA);
        if (wr == 1) PG8_BAR;
        PG8_WAIT_V(2); PG8_BAR;
        PG8_STAGE(PG8_SB(1, 0), cB + kstep, voffB); PG8_STAGE(PG8_SA(1, 0), cA + kstep, voffA); PG8_STAGE(PG8_SB(1, 1), cB + hstep + kstep, voffB);
        PG8_WAIT_V(6); PG8_BAR;
    } else {
        PG8_STAGE(PG8_SB(0, 0), cB, voffB); PG8_STAGE(PG8_SA(0, 0), cA, voffA); PG8_STAGE(PG8_SB(0, 1), cB + hstep, voffB); PG8_STAGE(PG8_SA(0, 1), cA + hstep, voffA);
        if (wr == 1) PG8_BAR;
        PG8_WAIT_V(4); PG8_BAR;
        PG8_STAGE(PG8_SB(1, 0), cB + kstep, voffB); PG8_STAGE(PG8_SA(1, 0), cA + kstep, voffA); PG8_STAGE(PG8_SB(1, 1), cB + hstep + kstep, voffB);
        PG8_WAIT_V(6); PG8_BAR;
    }
    for (;;) {
        const bool has_next = S.next(ui + 1, nxt);
        const char* nA = has_next ? (const char*)g.A + (size_t)nxt.pm * tstep : cA; const char* nB = has_next ? (const char*)g.Bt + (size_t)nxt.pn * tstep : cB;
        for (int t = 0; t < nt; t += 2) {
            const bool last = (t == nt - 2);
            const char* a1 = cA + (size_t)(t + 1) * kstep;
            const char* a2 = last ? nA : cA + (size_t)(t + 2) * kstep; const char* b2 = last ? nB : cB + (size_t)(t + 2) * kstep;
            const char* a3 = a2 + kstep; const char* b3 = b2 + kstep;
            if (last && has_next) S.a_ready(nxt);
            if constexpr (SP2) {
            PG8_LDB(B0, 0, 0); PG8_LDB(B1, 0, 1); PG8_SCHED; PG8_LDA(At, 0, 0); PG8_STAGE(PG8_SA(1, 1), a1 + hstep, voffA);
            PG8_WAIT_V(8); PG8_WAIT_L(0); PG8_BAR; PG8_MMA(0, 0, At, B0); PG8_MMA(0, 1, At, B1); PG8_BAR; PG8_SCHED;
            PG8_LDA(At, 0, 1); PG8_STAGE(PG8_SB(0, 0), b2, voffB); PG8_STAGE(PG8_SB(0, 1), b2 + hstep, voffB); PG8_STAGE(PG8_SA(0, 0), a2, voffA);
            PG8_WAIT_V(8); PG8_WAIT_L(0); PG8_BAR; PG8_MMA(1, 0, At, B0); PG8_MMA(1, 1, At, B1); PG8_BAR; PG8_SCHED;
            PG8_LDB(B0, 1, 0); PG8_LDB(B1, 1, 1); PG8_SCHED; PG8_LDA(At, 1, 0); PG8_STAGE(PG8_SA(0, 1), a2 + hstep, voffA);
            PG8_WAIT_V(8); PG8_WAIT_L(0); PG8_BAR; PG8_MMA(0, 0, At, B0); PG8_MMA(0, 1, At, B1); PG8_BAR; PG8_SCHED;
            PG8_LDA(At, 1, 1); PG8_STAGE(PG8_SB(1, 0), b3, voffB); PG8_STAGE(PG8_SB(1, 1), b3 + hstep, voffB); PG8_STAGE(PG8_SA(1, 0), a3, voffA);
            PG8_WAIT_V(8); PG8_WAIT_L(0); PG8_BAR; PG8_MMA(1, 0, At, B0); PG8_MMA(1, 1, At, B1); PG8_BAR; PG8_SCHED;
            } else {
            PG8_LDB(B0, 0, 0); PG8_SCHED; PG8_LDA(At, 0, 0); PG8_STAGE(PG8_SA(1, 1), a1 + hstep, voffA);
            PG8_WAIT_L(8); PG8_BAR; PG8_WAIT_L(0); PG8_MMA(0, 0, At, B0); PG8_BAR; PG8_SCHED;
            PG8_LDB(B1, 0, 1); PG8_STAGE(PG8_SB(0, 0), b2, voffB);
            PG8_BAR; PG8_WAIT_L(0); PG8_MMA(0, 1, At, B1); PG8_BAR;
            PG8_LDA(At, 0, 1); PG8_STAGE(PG8_SA(0, 0), a2, voffA);
            PG8_BAR; PG8_WAIT_L(0); PG8_MMA(1, 0, At, B0); PG8_BAR; PG8_SCHED;
            PG8_STAGE(PG8_SB(0, 1), b2 + hstep, voffB);
            PG8_WAIT_V(6); PG8_BAR; PG8_MMA(1, 1, At, B1); PG8_BAR;
            PG8_LDB(B0, 1, 0); PG8_SCHED; PG8_LDA(At, 1, 0); PG8_STAGE(PG8_SA(0, 1), a2 + hstep, voffA);
            PG8_WAIT_L(8); PG8_BAR; PG8_WAIT_L(0); PG8_MMA(0, 0, At, B0); PG8_BAR; PG8_SCHED;
            PG8_LDB(B1, 1, 1); PG8_STAGE(PG8_SB(1, 0), b3, voffB);
            PG8_BAR; PG8_WAIT_L(0); PG8_MMA(0, 1, At, B1); PG8_BAR;
            PG8_LDA(At, 1, 1); PG8_STAGE(PG8_SA(1, 0), a3, voffA);
            PG8_BAR; PG8_WAIT_L(0); PG8_MMA(1, 0, At, B0); PG8_BAR; PG8_SCHED;
            PG8_STAGE(PG8_SB(1, 1), b3 + hstep, voffB);
            PG8_WAIT_V(6); PG8_BAR; PG8_MMA(1, 1, At, B1); PG8_BAR;
            }
        }
        if constexpr (ALIGN_EPI) { if (wr == 0) PG8_BAR; }
        if constexpr (!Epi::AFTER_DRAIN) { E(acc, cur, wr, wc, fr, fq); S.done(cur); }
        if (!has_next) break;
#pragma unroll
        for (int a = 0; a < 2; ++a)
#pragma unroll
            for (int b = 0; b < 2; ++b)
#pragma unroll
                for (int m = 0; m < 4; ++m)
#pragma unroll
                    for (int n = 0; n < 2; ++n) acc[a][b][m][n] = (f32x4){0.f, 0.f, 0.f, 0.f};
        cur = nxt; cA = nA; cB = nB; ++ui;
        if constexpr (ALIGN_EPI) { if (wr == 1) PG8_BAR; }
    }
    PG8_WAIT_V(0);
    if constexpr (!ALIGN_EPI) { if (wr == 0) PG8_BAR; }
    PG8_BAR;
    if constexpr (Epi::AFTER_DRAIN) { E.fused(acc, cur, wr, wc, fr, fq, lds, wid, lane); S.done(cur); }
#undef PG8_SA
#undef PG8_SB
#undef PG8_STAGE
#undef PG8_LDA
#undef PG8_LDB
#undef PG8_MMA
#undef PG8_WAIT_V
#undef PG8_WAIT_L
#undef PG8_BAR
#undef PG8_SCHED
}
}
#define GAS __attribute__((address_space(1)))
#define LAS __attribute__((address_space(3)))
typedef unsigned short bf16;
typedef unsigned v4u __attribute__((ext_vector_type(4)));
typedef unsigned v2u __attribute__((ext_vector_type(2)));
typedef float f32x4 __attribute__((ext_vector_type(4)));
typedef float f32x2 __attribute__((ext_vector_type(2)));
typedef short bf16x8 __attribute__((ext_vector_type(8)));
typedef __bf16 bf16x2_t __attribute__((ext_vector_type(2)));

constexpr int NWAVES = 8, NTHR = 512;
constexpr int DM = 2048, NB = 4, SEQ = 8192, M = NB * SEQ;
constexpr int RW = 1024, RHEADS = 16, HD = 64;
constexpr int L_W = 64, L_A = 64, L_G = 160;
constexpr int INP = 5936, INPP = 6144;
constexpr int C_R = 0, C_K = 1024, C_V = 2048, C_WD = 3072, C_AD = 3136, C_GD = 3200, C_Z = 3360, C_XBC = 4384, C_DT = 5920;
constexpr int MODW = 6 * DM;
constexpr int NEXP = 16384;
constexpr float RMS_EPS = 1e-6f;

enum { I_X = 0, I_C, I_ADAW, I_ADAB, I_N1W, I_WIN, I_MU, I_W0, I_WUP, I_A0, I_AUP, I_GUP, I_KK, I_KA, I_RK, I_LNW, I_LNB,
       I_CONVW, I_CONVB, I_DTB, I_ALOG, I_DSK, I_MNW, I_WOUT, I_N2W, I_WQ, I_KEYS, I_PU, I_PV, I_FNW, N_IN };

constexpr size_t MiB = 1u << 20;
constexpr size_t WS_CTL = 0, CTL_ZERO_BYTES = 1 * MiB;
constexpr size_t WS_MOD = 1 * MiB;
constexpr size_t WS_WIN = 2 * MiB, WS_WOUT = 26 * MiB, WS_WQ = 34 * MiB, WS_KEYS = 42 * MiB;
constexpr size_t WS_WUPT = 43 * MiB, WS_AUPT = 43 * MiB + 256 * 1024, WS_GUPT = 43 * MiB + 512 * 1024;
constexpr size_t WS_PU8 = 44 * MiB, WS_PV8 = 76 * MiB;
constexpr size_t WS_USC = 108 * MiB, WS_VSC = 108 * MiB + 65536;
constexpr size_t WS_XN = 172 * MiB;
constexpr size_t WS_LW = WS_XN, WS_AA = WS_XN + 64 * MiB;
constexpr size_t WS_PROJ = 300 * MiB;
constexpr size_t WS_Q = WS_PROJ;
constexpr size_t WS_GG = 684 * MiB;
constexpr size_t WS_PD = WS_PROJ + 128 * MiB;
constexpr size_t WS_RTE = 684 * MiB, WS_RTG = 700 * MiB, WS_COEF = 716 * MiB;
constexpr size_t WS_OY = 748 * MiB;
constexpr size_t WS_END = 876 * MiB;
constexpr size_t WS_HB = 876 * MiB;

constexpr int RING_BYTES = 131072, LDS_BYTES = 147456;

#define LDS_WAIT() asm volatile("s_waitcnt lgkmcnt(0)" ::: "memory")
#define VM_WAIT() asm volatile("s_waitcnt vmcnt(0)" ::: "memory")
__device__ __forceinline__ unsigned pk2(float lo, float hi) { f32x2 v = {lo, hi}; bf16x2_t b = __builtin_convertvector(v, bf16x2_t); return __builtin_bit_cast(unsigned, b); }
__device__ __forceinline__ float bflo(unsigned u) { return __uint_as_float(u << 16); }
__device__ __forceinline__ float bfhi(unsigned u) { return __uint_as_float(u & 0xffff0000u); }
__device__ __forceinline__ float bf1(bf16 h) { return __uint_as_float((unsigned)h << 16); }
__device__ __forceinline__ float wave_sum(float v) {
#pragma unroll
    for (int o = 1; o < 64; o <<= 1) v += __shfl_xor(v, o);
    return v;
}
__device__ __forceinline__ float rcp_f(float v) { return __builtin_amdgcn_rcpf(v); }
template <int CTRL> __device__ __forceinline__ float dppc_f(float x) { return __builtin_bit_cast(float, __builtin_amdgcn_mov_dpp(__builtin_bit_cast(int, x), CTRL, 0xf, 0xf, true)); }
__device__ __forceinline__ float wave_sum_fast(float x) {
    x += dppc_f<0xB1>(x); x += dppc_f<0x4E>(x); x += dppc_f<0x124>(x); x += dppc_f<0x128>(x);
    { auto rr = __builtin_amdgcn_permlane16_swap(__float_as_uint(x), __float_as_uint(x), false, false); x = __uint_as_float(rr[0]) + __uint_as_float(rr[1]); }
    { auto rr = __builtin_amdgcn_permlane32_swap(__float_as_uint(x), __float_as_uint(x), false, false); x = __uint_as_float(rr[0]) + __uint_as_float(rr[1]); }
    return x;
}
__device__ __forceinline__ float silu_f(float v) { return v * rcp_f(1.f + __expf(-v)); }
__device__ __forceinline__ float sigmoid_f(float v) { return rcp_f(1.f + __expf(-v)); }

struct Ctx {
    LAS unsigned char* lds;
    int tid, lane, wave, G, gw, NGW;
    const float* const* in;
    float* out; unsigned char* ws;
};

__device__ __forceinline__ void transpose_item(const float* W, int K, int N, bf16* WT, int ldt, int nrows_out, LAS float* scr, int kb, int nb, int lane) {
    const int k0 = 64 * kb, n0 = 64 * nb;
    const int c4 = 4 * (lane & 15), rr = lane >> 4;
    const bool vec_ok = ((N & 3) == 0) && (n0 + 64 <= N);
#pragma unroll 4
    for (int i = 0; i < 16; ++i) { const int kk = 4 * i + rr, k = k0 + kk;
        f32x4 v = {0.f, 0.f, 0.f, 0.f};
        if (k < K) { const float* src = W + (size_t)k * N + n0 + c4;
            if (vec_ok) v = *(const f32x4*)src;
            else { if (n0 + c4 + 0 < N) v.x = src[0]; if (n0 + c4 + 1 < N) v.y = src[1]; if (n0 + c4 + 2 < N) v.z = src[2]; if (n0 + c4 + 3 < N) v.w = src[3]; } }
        LAS float* d = scr + kk * 65 + c4; d[0] = v.x; d[1] = v.y; d[2] = v.z; d[3] = v.w; }
    LDS_WAIT(); asm volatile("" ::: "memory");
    const int c = lane & 7;
#pragma unroll
    for (int j = 0; j < 8; ++j) { const int n = (lane >> 3) + 8 * j; const LAS float* sp = scr + (8 * c) * 65 + n;
        v4u o; o.x = pk2(sp[0 * 65], sp[1 * 65]); o.y = pk2(sp[2 * 65], sp[3 * 65]); o.z = pk2(sp[4 * 65], sp[5 * 65]); o.w = pk2(sp[6 * 65], sp[7 * 65]);
        if (n0 + n < nrows_out && k0 + 8 * c + 8 <= ldt) *(v4u*)(WT + (size_t)(n0 + n) * ldt + k0 + 8 * c) = o; }
    LDS_WAIT(); asm volatile("" ::: "memory");
}
__device__ __forceinline__ void transpose_all(const float* W, int K, int N, bf16* WT, int ldt, int nrows_out, LAS float* scr, int gw, int NGW, int lane) {
    const int nkb = (K + 63) / 64, nnb = nrows_out / 64, nit = nkb * nnb;
    for (int it = gw; it < nit; it += NGW) transpose_item(W, K, N, WT, ldt, nrows_out, scr, it / nnb, it % nnb, lane);
}
__device__ __forceinline__ void convert_all(const float* src, bf16* dst, size_t n8, int gw, int NGW, int lane) {
    const f32x4* s4 = (const f32x4*)src; v4u* d4 = (v4u*)dst;
    for (size_t i = (size_t)gw * 64 + lane; i < n8; i += (size_t)NGW * 64) {
        const f32x4 a = __builtin_nontemporal_load(s4 + 2 * i), b = __builtin_nontemporal_load(s4 + 2 * i + 1);
        v4u o; o.x = pk2(a.x, a.y); o.y = pk2(a.z, a.w); o.z = pk2(b.x, b.y); o.w = pk2(b.z, b.w);
        d4[i] = o; }
}
__device__ __forceinline__ void quantize_rows_fp8(const float* src, unsigned char* dst8, float* scales, int e0, int e1, int step, int lane) {
    if (e0 >= e1) return;
    f32x4 vn[8];
    { const f32x4* s4 = (const f32x4*)(src + (size_t)e0 * DM) + lane;
#pragma unroll
      for (int i = 0; i < 8; ++i) vn[i] = __builtin_nontemporal_load(s4 + 64 * i); }
    for (int e = e0; e < e1; e += step) {
        f32x4 v[8];
#pragma unroll
        for (int i = 0; i < 8; ++i) v[i] = vn[i];
        { const int en = (e + step < e1) ? e + step : e; const f32x4* s4 = (const f32x4*)(src + (size_t)en * DM) + lane;
#pragma unroll
          for (int i = 0; i < 8; ++i) vn[i] = __builtin_nontemporal_load(s4 + 64 * i); }
        float am = 0.f;
#pragma unroll
        for (int i = 0; i < 8; ++i) am = fmaxf(fmaxf(am, fmaxf(fabsf(v[i].x), fabsf(v[i].y))), fmaxf(fabsf(v[i].z), fabsf(v[i].w)));
#pragma unroll
        for (int o = 1; o < 64; o <<= 1) am = fmaxf(am, __shfl_xor(am, o));
        am = fmaxf(am, 1e-30f);
        const float inv = 440.f / am;
#pragma unroll
        for (int i = 0; i < 8; ++i) { int w = __builtin_amdgcn_cvt_pk_fp8_f32(v[i].x * inv, v[i].y * inv, 0, false); w = __builtin_amdgcn_cvt_pk_fp8_f32(v[i].z * inv, v[i].w * inv, w, true);
            const int seg = 2 * i + (lane >> 5);
            *(int*)(dst8 + (size_t)seg * ((size_t)NEXP * 128) + (size_t)e * 128 + 4 * (lane & 31)) = w; }
        if (lane == 0) scales[e] = am * (1.f / 440.f);
    }
}
__device__ __forceinline__ void p0_prologue(const Ctx& F) {
    __syncthreads();
    if (blockIdx.x < MODW / 64) {
        LAS float* sc = (LAS float*)F.lds;
        LAS float* red = sc + NB * DM;
        const float* c = F.in[I_C];
        for (int i = F.tid; i < NB * DM; i += NTHR) sc[i] = silu_f(c[i]);
        __syncthreads();
        const int j = blockIdx.x * 64 + F.lane;
        const float* wp = F.in[I_ADAW] + (size_t)(F.wave * 256) * MODW + j;
        float a0 = 0.f, a1 = 0.f, a2 = 0.f, a3 = 0.f;
#pragma unroll 32
        for (int kk = 0; kk < 256; ++kk) { const float w = wp[(size_t)kk * MODW]; const int k = F.wave * 256 + kk;
            a0 += sc[k] * w; a1 += sc[DM + k] * w; a2 += sc[2 * DM + k] * w; a3 += sc[3 * DM + k] * w; }
        red[(F.wave * 4 + 0) * 64 + F.lane] = a0; red[(F.wave * 4 + 1) * 64 + F.lane] = a1; red[(F.wave * 4 + 2) * 64 + F.lane] = a2; red[(F.wave * 4 + 3) * 64 + F.lane] = a3;
        __syncthreads();
        if (F.tid < 256) { const int b = F.tid >> 6, l = F.tid & 63; float s = F.in[I_ADAB][blockIdx.x * 64 + l];
#pragma unroll
            for (int w = 0; w < 8; ++w) s += red[(w * 4 + b) * 64 + l];
            ((float*)(F.ws + WS_MOD))[b * MODW + blockIdx.x * 64 + l] = s; }
        __syncthreads();
    }
    LAS float* scr = (LAS float*)(F.lds + F.wave * 16640);
    transpose_all(F.in[I_WIN], DM, INP, (bf16*)(F.ws + WS_WIN), DM, INPP, scr, F.gw, F.NGW, F.lane);
    transpose_all(F.in[I_WOUT], DM, DM, (bf16*)(F.ws + WS_WOUT), DM, DM, scr, F.gw, F.NGW, F.lane);
    transpose_all(F.in[I_WQ], DM, DM, (bf16*)(F.ws + WS_WQ), DM, DM, scr, F.gw, F.NGW, F.lane);
    transpose_all(F.in[I_WUP], L_W, RW, (bf16*)(F.ws + WS_WUPT), L_W, RW, scr, F.gw, F.NGW, F.lane);
    transpose_all(F.in[I_AUP], L_A, RW, (bf16*)(F.ws + WS_AUPT), L_A, RW, scr, F.gw, F.NGW, F.lane);
    transpose_all(F.in[I_GUP], L_G, RW, (bf16*)(F.ws + WS_GUPT), L_G, RW, scr, F.gw, F.NGW, F.lane);
    convert_all(F.in[I_KEYS], (bf16*)(F.ws + WS_KEYS), (size_t)16 * 128 * 128 / 8, F.gw, F.NGW, F.lane);
    {
        const int nlo = (F.G < 192) ? F.G : 192, nhi = F.G - nlo;
        const int wtot = 5 * nlo + 8 * nhi;
        const int wb0 = (blockIdx.x < nlo) ? 5 * blockIdx.x : 5 * nlo + 8 * (blockIdx.x - nlo), wb1 = wb0 + ((blockIdx.x < nlo) ? 5 : 8);
        const int r0 = (int)((long)(2 * NEXP) * wb0 / wtot), r1 = (int)((long)(2 * NEXP) * wb1 / wtot);
        const int a0 = r0 < NEXP ? r0 : NEXP, a1 = r1 < NEXP ? r1 : NEXP;
        quantize_rows_fp8(F.in[I_PU], F.ws + WS_PU8, (float*)(F.ws + WS_USC), a0 + F.wave, a1, NWAVES, F.lane);
        const int b0 = (r0 > NEXP ? r0 : NEXP) - NEXP, b1 = (r1 > NEXP ? r1 : NEXP) - NEXP;
        quantize_rows_fp8(F.in[I_PV], F.ws + WS_PV8, (float*)(F.ws + WS_VSC), b0 + F.wave, b1, NWAVES, F.lane);
    }
}

__device__ __forceinline__ void norm_mod_rows(const Ctx& F, const float* X, const float* nw, int shift_off, int scale_off, bf16* XN) {
    const float* mod = (const float*)(F.ws + WS_MOD);
    if (F.gw >= M) return;
    f32x4 vn[8];
    { const f32x4* xr = (const f32x4*)(X + (size_t)F.gw * DM) + F.lane;
#pragma unroll
      for (int j = 0; j < 8; ++j) vn[j] = xr[64 * j]; }
    for (int m = F.gw; m < M; m += F.NGW) {
        const int b = m / SEQ;
        f32x4 v[8]; float s = 0.f;
#pragma unroll
        for (int j = 0; j < 8; ++j) { v[j] = vn[j]; s += (v[j].x * v[j].x + v[j].y * v[j].y) + (v[j].z * v[j].z + v[j].w * v[j].w); }
        { const int mn = (m + F.NGW < M) ? m + F.NGW : m; const f32x4* xr = (const f32x4*)(X + (size_t)mn * DM) + F.lane;
#pragma unroll
          for (int j = 0; j < 8; ++j) vn[j] = xr[64 * j]; }
        const float rstd = rsqrtf(wave_sum_fast(s) * (1.f / DM) + RMS_EPS);
        const f32x4* wp = (const f32x4*)nw + F.lane;
        const f32x4* shp = (const f32x4*)(mod + (size_t)b * MODW + shift_off) + F.lane;
        const f32x4* scp = (const f32x4*)(mod + (size_t)b * MODW + scale_off) + F.lane;
        v2u* o = (v2u*)(XN + (size_t)m * DM) + F.lane;
#pragma unroll
        for (int j = 0; j < 8; ++j) { const f32x4 w = wp[64 * j], a = scp[64 * j], c = shp[64 * j];
            const f32x4 r = (v[j] * rstd) * w * (a + 1.f) + c;
            v2u p; p.x = pk2(r.x, r.y); p.y = pk2(r.z, r.w); o[64 * j] = p; }
    }
}
__device__ __forceinline__ void final_norm_rows(const Ctx& F, const float* H, const float* nw, float* O) {
    for (int m = F.gw; m < M; m += F.NGW) {
        const f32x4* xr = (const f32x4*)(H + (size_t)m * DM) + F.lane;
        f32x4 v[8]; float s = 0.f;
#pragma unroll
        for (int j = 0; j < 8; ++j) { v[j] = xr[64 * j]; s += (v[j].x * v[j].x + v[j].y * v[j].y) + (v[j].z * v[j].z + v[j].w * v[j].w); }
        const float rstd = rsqrtf(wave_sum(s) * (1.f / DM) + RMS_EPS);
        const f32x4* wp = (const f32x4*)nw + F.lane;
        f32x4* o = (f32x4*)(O + (size_t)m * DM) + F.lane;
#pragma unroll
        for (int j = 0; j < 8; ++j) o[64 * j] = (v[j] * rstd) * wp[64 * j];
    }
}


__device__ __forceinline__ void load_row_raw(const bf16* row, int lane, v2u (&u)[8]) {
    const v2u* p = (const v2u*)row + lane;
#pragma unroll
    for (int j = 0; j < 8; ++j) u[j] = p[64 * j];
}
__device__ __forceinline__ void norm_mod_rows_bf16(const Ctx& F, const bf16* X, const float* nw, int shift_off, int scale_off, bf16* XN) {
    const float* mod = (const float*)(F.ws + WS_MOD);
    if (F.gw >= M) return;
    v2u un[8]; load_row_raw(X + (size_t)F.gw * DM, F.lane, un);
    for (int m = F.gw; m < M; m += F.NGW) {
        const int b = m / SEQ;
        f32x4 v[8]; float s = 0.f;
#pragma unroll
        for (int j = 0; j < 8; ++j) { v[j] = (f32x4){bflo(un[j].x), bfhi(un[j].x), bflo(un[j].y), bfhi(un[j].y)}; s += (v[j].x * v[j].x + v[j].y * v[j].y) + (v[j].z * v[j].z + v[j].w * v[j].w); }
        { const int mn = (m + F.NGW < M) ? m + F.NGW : m; load_row_raw(X + (size_t)mn * DM, F.lane, un); }
        const float rstd = rsqrtf(wave_sum_fast(s) * (1.f / DM) + RMS_EPS);
        const f32x4* wp = (const f32x4*)nw + F.lane;
        const f32x4* shp = (const f32x4*)(mod + (size_t)b * MODW + shift_off) + F.lane;
        const f32x4* scp = (const f32x4*)(mod + (size_t)b * MODW + scale_off) + F.lane;
        v2u* o = (v2u*)(XN + (size_t)m * DM) + F.lane;
#pragma unroll
        for (int j = 0; j < 8; ++j) { const f32x4 w = wp[64 * j], a = scp[64 * j], c = shp[64 * j];
            const f32x4 r = (v[j] * rstd) * w * (a + 1.f) + c;
            v2u p; p.x = pk2(r.x, r.y); p.y = pk2(r.z, r.w); o[64 * j] = p; }
    }
}
__device__ __forceinline__ void final_norm_rows_bf16(const Ctx& F, const bf16* H, const float* nw, float* O, float oscale) {
    if (F.gw >= M) return;
    v2u un[8]; load_row_raw(H + (size_t)F.gw * DM, F.lane, un);
    f32x4 wv[8];
#pragma unroll
    for (int j = 0; j < 8; ++j) wv[j] = ((const f32x4*)nw + F.lane)[64 * j];
    for (int m = F.gw; m < M; m += F.NGW) {
        f32x4 v[8]; float s = 0.f;
#pragma unroll
        for (int j = 0; j < 8; ++j) { v[j] = (f32x4){bflo(un[j].x), bfhi(un[j].x), bflo(un[j].y), bfhi(un[j].y)}; s += (v[j].x * v[j].x + v[j].y * v[j].y) + (v[j].z * v[j].z + v[j].w * v[j].w); }
        { const int mn = (m + F.NGW < M) ? m + F.NGW : m; load_row_raw(H + (size_t)mn * DM, F.lane, un); }
        const float rstd = rsqrtf(wave_sum_fast(s) * (1.f / DM) + RMS_EPS) * oscale;
        f32x4* o = (f32x4*)(O + (size_t)m * DM) + F.lane;
#pragma unroll
        for (int j = 0; j < 8; ++j) __builtin_nontemporal_store((v[j] * rstd) * wv[j], o + 64 * j);
    }
}
#define LO2(v) __builtin_shufflevector((v), (v), 0, 1)
#define HI2(v) __builtin_shufflevector((v), (v), 2, 3)
template <int CTRL> __device__ __forceinline__ float dpp_f(float x) { return __builtin_bit_cast(float, __builtin_amdgcn_mov_dpp(__builtin_bit_cast(int, x), CTRL, 0xf, 0xf, true)); }
__device__ __forceinline__ float rowsum16(float x) { x += dpp_f<0xB1>(x); x += dpp_f<0x4E>(x); x += dpp_f<0x124>(x); x += dpp_f<0x128>(x); return x; }
__device__ __forceinline__ float quadsum(float x) { x += dpp_f<0xB1>(x); x += dpp_f<0x4E>(x); return x; }

__device__ __forceinline__ float treduce16(const float (&p)[16], bool b0, bool b1, bool b2, bool b3) {
    float a[8], bq[4], c2[2];
#pragma unroll
    for (int j = 0; j < 8; ++j) { const float mine = b3 ? p[j + 8] : p[j], send = b3 ? p[j] : p[j + 8]; a[j] = mine + dpp_f<0x128>(send); }
#pragma unroll
    for (int j = 0; j < 4; ++j) { const float mine = b2 ? a[j + 4] : a[j], send = b2 ? a[j] : a[j + 4]; const float up = dpp_f<0x104>(send), dn = dpp_f<0x114>(send); bq[j] = mine + (b2 ? dn : up); }
#pragma unroll
    for (int j = 0; j < 2; ++j) { const float mine = b1 ? bq[j + 2] : bq[j], send = b1 ? bq[j] : bq[j + 2]; c2[j] = mine + dpp_f<0x4E>(send); }
    const float mine = b0 ? c2[1] : c2[0], send = b0 ? c2[0] : c2[1];
    return mine + dpp_f<0xB1>(send);
}
__device__ __forceinline__ float wave_sum_dpp(float v) { v = rowsum16(v); v += __shfl_xor(v, 16); v += __shfl_xor(v, 32); return v; }
__device__ __forceinline__ void unpack8(const v4u p, float (&e)[8]) { e[0] = bflo(p.x); e[1] = bfhi(p.x); e[2] = bflo(p.y); e[3] = bfhi(p.y); e[4] = bflo(p.z); e[5] = bfhi(p.z); e[6] = bflo(p.w); e[7] = bfhi(p.w); }
__device__ __forceinline__ v4u pack8(const float (&e)[8]) { v4u o; o.x = pk2(e[0], e[1]); o.y = pk2(e[2], e[3]); o.z = pk2(e[4], e[5]); o.w = pk2(e[6], e[7]); return o; }

__device__ __forceinline__ void p3_lora(const Ctx& F) {
    const bf16* PROJ = (const bf16*)(F.ws + WS_PROJ);
    const bf16* WUPT = (const bf16*)(F.ws + WS_WUPT); const bf16* AUPT = (const bf16*)(F.ws + WS_AUPT); const bf16* GUPT = (const bf16*)(F.ws + WS_GUPT);
    bf16* LW = (bf16*)(F.ws + WS_LW); bf16* AA = (bf16*)(F.ws + WS_AA); bf16* GG = (bf16*)(F.ws + WS_GG);
    const float* mu = F.in[I_MU]; const float* w0 = F.in[I_W0]; const float* a0 = F.in[I_A0];
    const int r16 = F.lane & 15, q = F.lane >> 4;
    constexpr int WST = 72, GST = 168;
    LAS bf16* WU = (LAS bf16*)F.lds; LAS bf16* AU = WU + 128 * WST; LAS bf16* GU = AU + 128 * WST;
    const int nr = blockIdx.x & 7, nbr = (F.G - nr + 7) >> 3;
    __syncthreads();
    for (int i = F.tid; i < 128 * 8; i += NTHR) { const int row = i >> 3, ch = i & 7;
        *(LAS v4u*)(WU + row * WST + 8 * ch) = *(const v4u*)(WUPT + (size_t)(128 * nr + row) * L_W + 8 * ch);
        *(LAS v4u*)(AU + row * WST + 8 * ch) = *(const v4u*)(AUPT + (size_t)(128 * nr + row) * L_A + 8 * ch); }
    for (int i = F.tid; i < 128 * 20; i += NTHR) { const int row = i / 20, ch = i - row * 20;
        *(LAS v4u*)(GU + row * GST + 8 * ch) = *(const v4u*)(GUPT + (size_t)(128 * nr + row) * L_G + 8 * ch); }
    __syncthreads();
    for (int mt = (blockIdx.x >> 3) * NWAVES + F.wave; mt < M / 16; mt += nbr * NWAVES) {
        const int m = mt * 16 + r16; const bool first = (m % SEQ) == 0;
        const bf16* row = PROJ + (size_t)m * INPP;
        bf16x8 af[9];
#pragma unroll
        for (int s = 0; s < 9; ++s) {
            const int col = ((s < 2) ? (C_WD + 32 * s) : (s < 4) ? (C_AD + 32 * (s - 2)) : (C_GD + 32 * (s - 4))) + 8 * q;
            const v4u pc = *(const v4u*)(row + col);
            v4u pp = {0u, 0u, 0u, 0u}; if (!first) pp = *(const v4u*)(row - INPP + col);
            const f32x4 m0 = *(const f32x4*)(mu + col), m1 = *(const f32x4*)(mu + col + 4);
            float c[8], p[8], e[8]; unpack8(pc, c); unpack8(pp, p);
            const float mm[8] = {m0.x, m0.y, m0.z, m0.w, m1.x, m1.y, m1.z, m1.w};
#pragma unroll
            for (int j = 0; j < 8; ++j) { float v = c[j] + (p[j] - c[j]) * mm[j];
                if (s < 2) { const float t = __expf(2.f * v); v = 1.f - 2.f * rcp_f(t + 1.f); }
                else if (s >= 4) v = sigmoid_f(v);
                e[j] = v; }
            af[s] = __builtin_bit_cast(bf16x8, pack8(e));
        }
#pragma unroll 2
        for (int nt = 0; nt < 8; ++nt) {
            const LAS bf16* wu = WU + (16 * nt + r16) * WST + 8 * q; const LAS bf16* au = AU + (16 * nt + r16) * WST + 8 * q; const LAS bf16* gu = GU + (16 * nt + r16) * GST + 8 * q;
            f32x4 acc0 = {0.f, 0.f, 0.f, 0.f}, acc1 = acc0, acc2 = acc0;
#pragma unroll
            for (int s2 = 0; s2 < 2; ++s2) acc0 = __builtin_amdgcn_mfma_f32_16x16x32_bf16(*(const LAS bf16x8*)(wu + 32 * s2), af[s2], acc0, 0, 0, 0);
#pragma unroll
            for (int s2 = 0; s2 < 2; ++s2) acc1 = __builtin_amdgcn_mfma_f32_16x16x32_bf16(*(const LAS bf16x8*)(au + 32 * s2), af[2 + s2], acc1, 0, 0, 0);
#pragma unroll
            for (int s2 = 0; s2 < 5; ++s2) acc2 = __builtin_amdgcn_mfma_f32_16x16x32_bf16(*(const LAS bf16x8*)(gu + 32 * s2), af[4 + s2], acc2, 0, 0, 0);
            const int n = 128 * nr + 16 * nt + 4 * q;
            const f32x4 w0v = *(const f32x4*)(w0 + n), a0v = *(const f32x4*)(a0 + n);
            v2u o0, o1, o2;
            o0.x = pk2(-0.60653066f * sigmoid_f(acc0[0] + w0v.x), -0.60653066f * sigmoid_f(acc0[1] + w0v.y));
            o0.y = pk2(-0.60653066f * sigmoid_f(acc0[2] + w0v.z), -0.60653066f * sigmoid_f(acc0[3] + w0v.w));
            o1.x = pk2(sigmoid_f(acc1[0] + a0v.x), sigmoid_f(acc1[1] + a0v.y)); o1.y = pk2(sigmoid_f(acc1[2] + a0v.z), sigmoid_f(acc1[3] + a0v.w));
            o2.x = pk2(acc2[0], acc2[1]); o2.y = pk2(acc2[2], acc2[3]);
            *(v2u*)(LW + (size_t)m * RW + n) = o0; *(v2u*)(AA + (size_t)m * RW + n) = o1; *(v2u*)(GG + (size_t)m * RW + n) = o2;
        }
    }
    __syncthreads();
}

constexpr int TC = 32, NCHUNK = SEQ / TC;
constexpr int RB_R = 0, RB_W = TC * 64, RB_K = 2 * TC * 64, RB_KK = 3 * TC * 64, RB_KA = 4 * TC * 64, RB_V = 5 * TC * 64, RB_SIZE = 5 * TC * 64 + TC * 16;
constexpr int MB_B = 0, MB_C = TC * 128, MB_X = 2 * TC * 128, MB_DT = MB_X + TC * 32, MB_DA = MB_DT + TC, MB_SIZE = MB_DA + TC;
static_assert(2 * RB_SIZE * 4 <= RING_BYTES, "scan buffers fit the LDS ring");

struct RwkvRaw { bf16 r[9], k[9], v[9], lw[8], a[8]; };
__device__ __forceinline__ void rwkv_load(RwkvRaw& raw, const bf16* PROJ, const bf16* LW, const bf16* AA, int b, int h, int t0w, int c) {
    const bf16* base = PROJ + (size_t)(b * SEQ + t0w) * INPP + h * 64 + c;
#pragma unroll
    for (int i = 0; i < 9; ++i) {
        if (i == 0 && t0w == 0) { raw.r[0] = 0; raw.k[0] = 0; raw.v[0] = 0; }
        else { const bf16* row = base + (long)(i - 1) * INPP; raw.r[i] = row[C_R]; raw.k[i] = row[C_K]; raw.v[i] = row[C_V]; }
    }
#pragma unroll
    for (int i = 0; i < 8; ++i) { const size_t o = (size_t)(b * SEQ + t0w + i) * RW + h * 64 + c; raw.lw[i] = LW[o]; raw.a[i] = AA[o]; }
}
__device__ __forceinline__ void rwkv_stage(const RwkvRaw& raw, LAS float* buf, int tl0, int c, int qt, float mu_r, float mu_k, float mu_v, float kkw, float kaw) {
#pragma unroll
    for (int i = 0; i < 8; ++i) {
        const int t = tl0 + i;
        const float rc = bf1(raw.r[i + 1]), rp = bf1(raw.r[i]), kc = bf1(raw.k[i + 1]), kp = bf1(raw.k[i]), vc = bf1(raw.v[i + 1]), vp = bf1(raw.v[i]);
        const float rr = rc + (rp - rc) * mu_r, kx = kc + (kp - kc) * mu_k, vv = vc + (vp - vc) * mu_v;
        const float a = bf1(raw.a[i]), dec = __expf(bf1(raw.lw[i]));
        const float kkraw = kx * kkw; const float ss = wave_sum_dpp(kkraw * kkraw);
        const float kkn = kkraw * rcp_f(fmaxf(sqrtf(ss), 1e-12f));
        buf[RB_R + t * 64 + c] = rr; buf[RB_W + t * 64 + c] = dec; buf[RB_K + t * 64 + c] = kx * (1.f + (a - 1.f) * kaw);
        buf[RB_KK + t * 64 + c] = kkn; buf[RB_KA + t * 64 + c] = kkn * a;
        if ((c >> 4) == qt) buf[RB_V + t * 16 + (c & 15)] = vv;
    }
}
__device__ __forceinline__ void rwkv_task(const Ctx& F, int task) {
    const int b = task >> 6, h = (task >> 2) & 15, qt = task & 3;
    const bf16* PROJ = (const bf16*)(F.ws + WS_PROJ); const bf16* LW = (const bf16*)(F.ws + WS_LW); const bf16* AA = (const bf16*)(F.ws + WS_AA);
    bf16* OY = (bf16*)(F.ws + WS_OY);
    LAS float* lbuf = (LAS float*)F.lds;
    const int c = F.lane, w = F.wave, r = F.lane >> 4, cg = F.lane & 15;
    const bool stager = w >= 4; const int sw = w & 3;
    const int ch = h * 64 + c;
    const float mu_r = F.in[I_MU][C_R + ch], mu_k = F.in[I_MU][C_K + ch], mu_v = F.in[I_MU][C_V + ch], kkw = F.in[I_KK][ch], kaw = F.in[I_KA][ch];
    RwkvRaw raw;
    if (stager) { rwkv_load(raw, PROJ, LW, AA, b, h, 8 * sw, c); rwkv_stage(raw, lbuf, 8 * sw, c, qt, mu_r, mu_k, mu_v, kkw, kaw); rwkv_load(raw, PROJ, LW, AA, b, h, TC + 8 * sw, c); }
    __syncthreads();
    f32x2 S01 = {0.f, 0.f}, S23 = {0.f, 0.f};
    const bool cb0 = cg & 1, cb1 = cg & 2, cb2 = cg & 4, cb3 = cg & 8;
    bf16* orow = OY + (size_t)(b * SEQ) * DM + h * 64 + 16 * qt + 4 * sw + r;
    for (int ck = 0; ck < NCHUNK; ++ck) {
        const LAS float* buf = lbuf + (ck & 1) * RB_SIZE;
        if (stager) {
            if (ck + 1 < NCHUNK) { rwkv_stage(raw, lbuf + ((ck + 1) & 1) * RB_SIZE, 8 * sw, c, qt, mu_r, mu_k, mu_v, kkw, kaw);
                if (ck + 2 < NCHUNK) rwkv_load(raw, PROJ, LW, AA, b, h, (ck + 2) * TC + 8 * sw, c); }
        } else {
            const LAS float* bp = buf + 4 * cg; const LAS float* vp = buf + RB_V + 4 * sw + r;
            f32x4 qkk[3], qw[3], qka[3], qk[3], qr[3]; float qv[3];
#pragma unroll
            for (int i = 0; i < 3; ++i) { qkk[i] = *(const LAS f32x4*)(bp + RB_KK + i * 64); qw[i] = *(const LAS f32x4*)(bp + RB_W + i * 64); qka[i] = *(const LAS f32x4*)(bp + RB_KA + i * 64);
                qk[i] = *(const LAS f32x4*)(bp + RB_K + i * 64); qr[i] = *(const LAS f32x4*)(bp + RB_R + i * 64); qv[i] = vp[i * 16]; }
            float op[16];
#pragma unroll
            for (int j = 0; j < TC; ++j) {
                const int u = j % 3;
                const f32x4 kk4 = qkk[u], w4 = qw[u], ka4 = qka[u], k4 = qk[u], r4 = qr[u]; const float vr = qv[u];
                const f32x2 tq = S01 * LO2(kk4) + S23 * HI2(kk4);
                const float sa = rowsum16(tq.x + tq.y);
                const f32x2 sav = {sa, sa}, vrv = {vr, vr};
                S01 = S01 * LO2(w4) + (vrv * LO2(k4) - sav * LO2(ka4));
                S23 = S23 * HI2(w4) + (vrv * HI2(k4) - sav * HI2(ka4));
                const f32x2 uq = S01 * LO2(r4) + S23 * HI2(r4);
                op[j & 15] = uq.x + uq.y;
                asm volatile("" : "+v"(S01), "+v"(S23) :: "memory");
                if (j + 3 < TC) { qkk[u] = *(const LAS f32x4*)(bp + RB_KK + (j + 3) * 64); qw[u] = *(const LAS f32x4*)(bp + RB_W + (j + 3) * 64); qka[u] = *(const LAS f32x4*)(bp + RB_KA + (j + 3) * 64);
                                  qk[u] = *(const LAS f32x4*)(bp + RB_K + (j + 3) * 64); qr[u] = *(const LAS f32x4*)(bp + RB_R + (j + 3) * 64); qv[u] = vp[(j + 3) * 16]; }
                if ((j & 15) == 15) {
                    const float ored = treduce16(op, cb0, cb1, cb2, cb3);
                    orow[(size_t)(ck * TC + (j - 15) + cg) * DM] = (bf16)(pk2(ored, 0.f) & 0xffffu);
                }
            }
        }
        __syncthreads();
    }
}

__device__ __forceinline__ void p4_scans(const Ctx& F) {
    for (int task = blockIdx.x; task < NB * RHEADS * 4; task += F.G) { rwkv_task(F, task); __syncthreads(); }
}

__device__ __forceinline__ void ld16(const float* p, float (&v)[16]) {
#pragma unroll
    for (int i = 0; i < 4; ++i) { const f32x4 t = *(const f32x4*)(p + 4 * i); v[4 * i] = t.x; v[4 * i + 1] = t.y; v[4 * i + 2] = t.z; v[4 * i + 3] = t.w; }
}
__device__ __forceinline__ void ldbf16x16(const bf16* p, float (&v)[16]) {
    float t0[8], t1[8]; unpack8(*(const v4u*)p, t0); unpack8(*(const v4u*)(p + 8), t1);
#pragma unroll
    for (int j = 0; j < 8; ++j) { v[j] = t0[j]; v[8 + j] = t1[j]; }
}
__device__ __forceinline__ void stbf16x16(bf16* p, const float (&v)[16]) {
    float t0[8], t1[8];
#pragma unroll
    for (int j = 0; j < 8; ++j) { t0[j] = v[j]; t1[j] = v[8 + j]; }
    *(v4u*)p = pack8(t0); *(v4u*)(p + 8) = pack8(t1);
}
__device__ __forceinline__ void p5_post(const Ctx& F) {
    const bf16* PROJ = (const bf16*)(F.ws + WS_PROJ); const bf16* AA = (const bf16*)(F.ws + WS_AA); const bf16* GG = (const bf16*)(F.ws + WS_GG);
    bf16* OY = (bf16*)(F.ws + WS_OY);
    const int c0 = 16 * F.lane;
    {
        float mur[16], muk[16], muv[16], ka[16], rk[16], lnw[16], lnb[16];
        ld16(F.in[I_MU] + C_R + c0, mur); ld16(F.in[I_MU] + C_K + c0, muk); ld16(F.in[I_MU] + C_V + c0, muv);
        ld16(F.in[I_KA] + c0, ka); ld16(F.in[I_RK] + c0, rk); ld16(F.in[I_LNW] + c0, lnw); ld16(F.in[I_LNB] + c0, lnb);
        for (int m = F.gw; m < M; m += F.NGW) {
            const bool first = (m % SEQ) == 0;
            const bf16* prow = PROJ + (size_t)m * INPP; bf16* oyrow = OY + (size_t)m * DM;
            float o[16], res[16]; float bs = 0.f;
            ldbf16x16(oyrow + c0, o);
            {
                float rc[16], rp[16], kc[16], kp[16], av[16];
                ldbf16x16(prow + C_R + c0, rc); ldbf16x16(prow + C_K + c0, kc); ldbf16x16(AA + (size_t)m * RW + c0, av);
                if (!first) { ldbf16x16(prow - INPP + C_R + c0, rp); ldbf16x16(prow - INPP + C_K + c0, kp); }
                else {
#pragma unroll
                    for (int j = 0; j < 16; ++j) { rp[j] = 0.f; kp[j] = 0.f; } }
#pragma unroll
                for (int j = 0; j < 16; ++j) { const float rr = rc[j] + (rp[j] - rc[j]) * mur[j], kx = kc[j] + (kp[j] - kc[j]) * muk[j];
                    bs += rr * (kx * (1.f + (av[j] - 1.f) * ka[j])) * rk[j]; }
            }
            bs = quadsum(bs);
            float s = 0.f;
#pragma unroll
            for (int j = 0; j < 16; ++j) s += o[j];
            const float mean = quadsum(s) * (1.f / 64.f);
            float qv = 0.f;
#pragma unroll
            for (int j = 0; j < 16; ++j) { o[j] -= mean; qv += o[j] * o[j]; }
            const float rstd = rsqrtf(quadsum(qv) * (1.f / 64.f) + 64e-5f);
            {
                float vc[16], vp[16], gv[16];
                ldbf16x16(prow + C_V + c0, vc); ldbf16x16(GG + (size_t)m * RW + c0, gv);
                if (!first) ldbf16x16(prow - INPP + C_V + c0, vp);
                else {
#pragma unroll
                    for (int j = 0; j < 16; ++j) vp[j] = 0.f; }
#pragma unroll
                for (int j = 0; j < 16; ++j) { const float vv = vc[j] + (vp[j] - vc[j]) * muv[j]; res[j] = (o[j] * rstd * lnw[j] + lnb[j] + bs * vv) * gv[j]; }
            }
            stbf16x16(oyrow + c0, res);
        }
    }
    {
        float nw[16]; ld16(F.in[I_MNW] + c0, nw);
        for (int m = F.gw; m < M; m += F.NGW) {
            const bf16* prow = PROJ + (size_t)m * INPP; bf16* oyrow = OY + (size_t)m * DM;
            float y[16], z[16];
            ldbf16x16(oyrow + RW + c0, y); ldbf16x16(prow + C_Z + c0, z);
            float qv = 0.f;
#pragma unroll
            for (int j = 0; j < 16; ++j) { y[j] *= silu_f(z[j]); qv += y[j] * y[j]; }
            qv = rowsum16(qv);
            { auto rr = __builtin_amdgcn_permlane16_swap(__float_as_uint(qv), __float_as_uint(qv), false, false); qv = __uint_as_float(rr[0]) + __uint_as_float(rr[1]); }
            const float rstd = rsqrtf(qv * (1.f / 512.f) + 1e-5f);
#pragma unroll
            for (int j = 0; j < 16; ++j) y[j] = y[j] * rstd * nw[j];
            stbf16x16(oyrow + RW + c0, y);
        }
    }
}
constexpr int MC_L = 128, MC_NC = SEQ / MC_L, LSTR = 136;
constexpr int MT_BYTES = 128 * LSTR * 2;
constexpr size_t WS_ST = 876 * MiB, WS_SIN = 940 * MiB, WS_ATOT = 1004 * MiB, WS_END2 = 1005 * MiB;

__device__ __forceinline__ float mamba_dt_scan(const Ctx& F, const bf16* PROJ, int b, int c, int g, LAS float* DT, LAS float* ACS) {
    const int head = g * 8 + F.wave, lane = F.lane;
    const float dtb = F.in[I_DTB][head], Aneg = -__expf(F.in[I_ALOG][head]);
    const bf16* p = PROJ + (size_t)(b * SEQ + c * MC_L + 2 * lane) * INPP + C_DT + head;
    const float x0 = bf1(p[0]) + dtb, x1 = bf1(p[INPP]) + dtb;
    const float d0 = (x0 > 20.f) ? x0 : log1pf(__expf(x0)), d1 = (x1 > 20.f) ? x1 : log1pf(__expf(x1));
    const float s0 = d0 * Aneg, s1 = s0 + d1 * Aneg;
    float incl = s1;
#pragma unroll
    for (int o = 1; o < 64; o <<= 1) { const float t = __shfl_up(incl, o); if (lane >= o) incl += t; }
    const float excl = incl - s1;
    DT[F.wave * 128 + 2 * lane] = d0; DT[F.wave * 128 + 2 * lane + 1] = d1;
    ACS[F.wave * 128 + 2 * lane] = excl + s0; ACS[F.wave * 128 + 2 * lane + 1] = excl + s1;
    return __shfl(incl, 63);
}
template <bool SC>
__device__ __forceinline__ void mstage_T(const bf16* PROJ, int b, int c, int chn, LAS bf16* dst, const LAS float* scale, const float* convw, const float* convb, int tid) {
    const int f = tid & 127, t0 = 32 * (tid >> 7);
    const bf16* base = PROJ + (size_t)(b * SEQ + c * MC_L + t0) * INPP + C_XBC + chn;
    const float w0 = convw[chn], w1 = convw[1536 + chn], w2 = convw[2 * 1536 + chn], w3 = convw[3 * 1536 + chn], bb = convb[chn];
    float r0 = 0.f, r1 = 0.f, r2 = 0.f;
    if (c * MC_L + t0 > 0) { r0 = bf1(base[-3 * INPP]); r1 = bf1(base[-2 * INPP]); r2 = bf1(base[-1 * INPP]); }
#pragma unroll
    for (int i8 = 0; i8 < 4; ++i8) {
        float e[8];
#pragma unroll
        for (int i = 0; i < 8; ++i) { const int t = 8 * i8 + i; const float r3 = bf1(base[(size_t)t * INPP]);
            float v = silu_f(bb + w0 * r0 + w1 * r1 + w2 * r2 + w3 * r3);
            if (SC) v *= scale[t0 + t];
            e[i] = v; r0 = r1; r1 = r2; r2 = r3; }
        *(LAS v4u*)(dst + f * LSTR + t0 + 8 * i8) = pack8(e);
    }
}
__device__ __forceinline__ void mstage_N(const bf16* PROJ, int b, int c, int g, LAS bf16* Bn, LAS bf16* Cn, const float* convw, const float* convb, int tid) {
    const int f8 = tid & 31, t0 = 8 * (tid >> 5);
    const int chn = (f8 < 16) ? (1024 + g * 128 + 8 * f8) : (1280 + g * 128 + 8 * (f8 - 16));
    LAS bf16* dst = ((f8 < 16) ? Bn : Cn) + 8 * (f8 & 15);
    const bf16* base = PROJ + (size_t)(b * SEQ + c * MC_L + t0) * INPP + C_XBC + chn;
    float w[4][8], bb[8];
#pragma unroll
    for (int i = 0; i < 4; ++i) { const f32x4 a = *(const f32x4*)(convw + i * 1536 + chn), d = *(const f32x4*)(convw + i * 1536 + chn + 4);
        w[i][0] = a.x; w[i][1] = a.y; w[i][2] = a.z; w[i][3] = a.w; w[i][4] = d.x; w[i][5] = d.y; w[i][6] = d.z; w[i][7] = d.w; }
    { const f32x4 a = *(const f32x4*)(convb + chn), d = *(const f32x4*)(convb + chn + 4); bb[0] = a.x; bb[1] = a.y; bb[2] = a.z; bb[3] = a.w; bb[4] = d.x; bb[5] = d.y; bb[6] = d.z; bb[7] = d.w; }
    float r0[8], r1[8], r2[8];
    if (c * MC_L + t0 > 0) { unpack8(*(const v4u*)(base - 3 * INPP), r0); unpack8(*(const v4u*)(base - 2 * INPP), r1); unpack8(*(const v4u*)(base - 1 * INPP), r2); }
    else {
#pragma unroll
        for (int k = 0; k < 8; ++k) { r0[k] = 0.f; r1[k] = 0.f; r2[k] = 0.f; } }
#pragma unroll
    for (int t = 0; t < 8; ++t) {
        float r3[8], e[8]; unpack8(*(const v4u*)(base + (size_t)t * INPP), r3);
#pragma unroll
        for (int k = 0; k < 8; ++k) { e[k] = silu_f(bb[k] + w[0][k] * r0[k] + w[1][k] * r1[k] + w[2][k] * r2[k] + w[3][k] * r3[k]); r0[k] = r1[k]; r1[k] = r2[k]; r2[k] = r3[k]; }
        *(LAS v4u*)(dst + (t0 + t) * LSTR) = pack8(e);
    }
}

__device__ __forceinline__ void m1_chunk_states(const Ctx& F) {
    const bf16* PROJ = (const bf16*)(F.ws + WS_PROJ); bf16* ST = (bf16*)(F.ws + WS_ST); float* ATOT = (float*)(F.ws + WS_ATOT);
    LAS bf16* BT = (LAS bf16*)F.lds; LAS bf16* XT = (LAS bf16*)(F.lds + MT_BYTES);
    LAS float* DT = (LAS float*)(F.lds + 3 * MT_BYTES); LAS float* ACS = DT + 8 * 128; LAS float* SCL = ACS + 8 * 128;
    const float* convw = F.in[I_CONVW]; const float* convb = F.in[I_CONVB];
    const int tid = F.tid, w = F.wave, lane = F.lane, r16 = lane & 15, q = lane >> 4;
    for (int it = blockIdx.x; it < NB * MC_NC * 2; it += F.G) {
        const int g = it & 1, c = (it >> 1) & (MC_NC - 1), b = it >> 7;
        __syncthreads();
        const float atot = mamba_dt_scan(F, PROJ, b, c, g, DT, ACS);
        if (lane == 0) ATOT[(b * MC_NC + c) * 16 + g * 8 + w] = atot;
        LDS_WAIT();
        SCL[w * 128 + 2 * lane] = DT[w * 128 + 2 * lane] * __expf(atot - ACS[w * 128 + 2 * lane]);
        SCL[w * 128 + 2 * lane + 1] = DT[w * 128 + 2 * lane + 1] * __expf(atot - ACS[w * 128 + 2 * lane + 1]);
        mstage_T<false>(PROJ, b, c, 1024 + g * 128 + (tid & 127), BT, nullptr, convw, convb, tid);
#pragma unroll 1
        for (int hb = 0; hb < 2; ++hb) {
            __syncthreads();
#pragma unroll
            for (int im = 0; im < 2; ++im) { const int hl = 4 * hb + 2 * im + ((tid & 127) >> 6);
                mstage_T<true>(PROJ, b, c, (g * 8 + hl) * 64 + (tid & 63), XT + im * 128 * LSTR, SCL + hl * 128, convw, convb, tid); }
            __syncthreads();
            const int hh = w >> 1, ph = w & 1;
            f32x4 acc[2][8];
#pragma unroll
            for (int a = 0; a < 2; ++a)
#pragma unroll
                for (int n = 0; n < 8; ++n) acc[a][n] = (f32x4){0.f, 0.f, 0.f, 0.f};
#pragma unroll
            for (int ks = 0; ks < 4; ++ks) {
                bf16x8 xa[2];
#pragma unroll
                for (int a = 0; a < 2; ++a) xa[a] = *(const LAS bf16x8*)(XT + (hh * 64 + 32 * ph + 16 * a + r16) * LSTR + 32 * ks + 8 * q);
#pragma unroll
                for (int n = 0; n < 8; ++n) { const bf16x8 bfr = *(const LAS bf16x8*)(BT + (16 * n + r16) * LSTR + 32 * ks + 8 * q);
#pragma unroll
                    for (int a = 0; a < 2; ++a) acc[a][n] = __builtin_amdgcn_mfma_f32_16x16x32_bf16(bfr, xa[a], acc[a][n], 0, 0, 0); }
            }
            bf16* st = ST + ((size_t)((b * MC_NC + c) * 16 + g * 8 + 4 * hb + hh)) * (64 * 128);
#pragma unroll
            for (int a = 0; a < 2; ++a)
#pragma unroll
                for (int n = 0; n < 8; ++n) { v2u o; o.x = pk2(acc[a][n][0], acc[a][n][1]); o.y = pk2(acc[a][n][2], acc[a][n][3]);
                    *(v2u*)(st + (32 * ph + 16 * a + r16) * 128 + 16 * n + 4 * q) = o; }
        }
    }
}

__device__ __forceinline__ void m2_prefix(const Ctx& F) {
    const bf16* ST = (const bf16*)(F.ws + WS_ST); bf16* SIN = (bf16*)(F.ws + WS_SIN); const float* ATOT = (const float*)(F.ws + WS_ATOT);
    const int nthr = F.G * NTHR;
    for (int gi = blockIdx.x * NTHR + F.tid; gi < NB * 16 * 2048; gi += nthr) {
        const int e4 = gi & 2047, bh = gi >> 11, b = bh >> 4, h = bh & 15;
        float r0 = 0.f, r1 = 0.f, r2 = 0.f, r3 = 0.f;
#pragma unroll 4
        for (int c = 0; c < MC_NC; ++c) {
            const size_t o = ((size_t)((b * MC_NC + c) * 16 + h)) * 8192 + 4 * e4;
            v2u so; so.x = pk2(r0, r1); so.y = pk2(r2, r3);
            *(v2u*)(SIN + o) = so;
            const v2u sv = *(const v2u*)(ST + o); const float d = __expf(ATOT[(b * MC_NC + c) * 16 + h]);
            r0 = r0 * d + bflo(sv.x); r1 = r1 * d + bfhi(sv.x); r2 = r2 * d + bflo(sv.y); r3 = r3 * d + bfhi(sv.y);
        }
    }
}

__device__ __forceinline__ void m3_outputs(const Ctx& F) {
    const bf16* PROJ = (const bf16*)(F.ws + WS_PROJ); const bf16* SIN = (const bf16*)(F.ws + WS_SIN); bf16* OY = (bf16*)(F.ws + WS_OY);
    LAS bf16* Cn = (LAS bf16*)F.lds; LAS bf16* RB = (LAS bf16*)(F.lds + MT_BYTES);
    LAS bf16* Mw = (LAS bf16*)(F.lds + 2 * MT_BYTES) + F.wave * 16 * LSTR;
    LAS float* DT = (LAS float*)(F.lds + 3 * MT_BYTES); LAS float* ACS = DT + 8 * 128;
    const float* convw = F.in[I_CONVW]; const float* convb = F.in[I_CONVB];
    const int tid = F.tid, w = F.wave, lane = F.lane, r16 = lane & 15, q = lane >> 4;
    for (int it = blockIdx.x; it < NB * MC_NC * 2; it += F.G) {
        const int g = it & 1, c = (it >> 1) & (MC_NC - 1), b = it >> 7;
        __syncthreads();
        (void)mamba_dt_scan(F, PROJ, b, c, g, DT, ACS);
        mstage_N(PROJ, b, c, g, RB, Cn, convw, convb, tid);
        __syncthreads();
        bf16x8 cf[4];
#pragma unroll
        for (int ks = 0; ks < 4; ++ks) cf[ks] = *(const LAS bf16x8*)(Cn + (16 * w + r16) * LSTR + 32 * ks + 8 * q);
        f32x4 Gt[8];
#pragma unroll
        for (int nt = 0; nt < 8; ++nt) { Gt[nt] = (f32x4){0.f, 0.f, 0.f, 0.f};
#pragma unroll
            for (int ks = 0; ks < 4; ++ks) Gt[nt] = __builtin_amdgcn_mfma_f32_16x16x32_bf16(*(const LAS bf16x8*)(RB + (16 * nt + r16) * LSTR + 32 * ks + 8 * q), cf[ks], Gt[nt], 0, 0, 0); }
        const int l = 16 * w + r16;
        const size_t mrow = (size_t)(b * SEQ + c * MC_L + l);
#pragma unroll 1
        for (int hb = 0; hb < 4; ++hb) {
            __syncthreads();
            { const int hl = 2 * hb + ((tid & 127) >> 6); mstage_T<false>(PROJ, b, c, (g * 8 + hl) * 64 + (tid & 63), RB, nullptr, convw, convb, tid); }
            __syncthreads();
#pragma unroll 1
            for (int h2 = 0; h2 < 2; ++h2) {
                const int hl = 2 * hb + h2, head = g * 8 + hl;
                const float acs_l = ACS[hl * 128 + l];
                const bf16* sin = SIN + ((size_t)((b * MC_NC + c) * 16 + head)) * 8192;
                bf16x8 sf[4][4];
#pragma unroll
                for (int pt = 0; pt < 4; ++pt)
#pragma unroll
                    for (int ks = 0; ks < 4; ++ks) sf[pt][ks] = *(const bf16x8*)(sin + (16 * pt + r16) * 128 + 32 * ks + 8 * q);
#pragma unroll
                for (int nt = 0; nt < 8; ++nt) { const f32x4 as = *(const LAS f32x4*)(ACS + hl * 128 + 16 * nt + 4 * q), ds = *(const LAS f32x4*)(DT + hl * 128 + 16 * nt + 4 * q);
                    float mv[4];
#pragma unroll
                    for (int j = 0; j < 4; ++j) { const int s = 16 * nt + 4 * q + j; mv[j] = (s <= l) ? Gt[nt][j] * __expf(acs_l - as[j]) * ds[j] : 0.f; }
                    v2u o; o.x = pk2(mv[0], mv[1]); o.y = pk2(mv[2], mv[3]);
                    *(LAS v2u*)(Mw + r16 * LSTR + 16 * nt + 4 * q) = o; }
                LDS_WAIT(); asm volatile("" ::: "memory");
                bf16x8 mf[4];
#pragma unroll
                for (int ks = 0; ks < 4; ++ks) mf[ks] = *(const LAS bf16x8*)(Mw + r16 * LSTR + 32 * ks + 8 * q);
                const float el = __expf(acs_l), Dh = F.in[I_DSK][head];
#pragma unroll
                for (int pt = 0; pt < 4; ++pt) {
                    f32x4 yd = {0.f, 0.f, 0.f, 0.f}, yo = {0.f, 0.f, 0.f, 0.f};
#pragma unroll
                    for (int ks = 0; ks < 4; ++ks) {
                        yd = __builtin_amdgcn_mfma_f32_16x16x32_bf16(*(const LAS bf16x8*)(RB + (h2 * 64 + 16 * pt + r16) * LSTR + 32 * ks + 8 * q), mf[ks], yd, 0, 0, 0);
                        yo = __builtin_amdgcn_mfma_f32_16x16x32_bf16(sf[pt][ks], cf[ks], yo, 0, 0, 0); }
                    float yv[4];
#pragma unroll
                    for (int j = 0; j < 4; ++j) yv[j] = yd[j] + el * yo[j] + Dh * bf1(RB[(h2 * 64 + 16 * pt + 4 * q + j) * LSTR + l]);
                    v2u o; o.x = pk2(yv[0], yv[1]); o.y = pk2(yv[2], yv[3]);
                    *(v2u*)(OY + mrow * DM + RW + head * 64 + 16 * pt + 4 * q) = o;
                }
                asm volatile("" ::: "memory");
            }
        }
    }
}
constexpr int RC = 16, RNCH = SEQ / RC, NPART = 4, RHALF = RNCH / NPART, RITEMS = NB * RHEADS * RHALF;
constexpr size_t RO_WH = 0, RO_RH = 16 * MiB, RO_VT = 32 * MiB, RO_ET = 48 * MiB, RO_OL = 64 * MiB, RO_A2 = 80 * MiB, RO_GC = 112 * MiB, RO_BUF = 116 * MiB, RO_SS = 232 * MiB;
constexpr int RL_KAP = 0, RL_ALP = 2304, RL_KT = 4608, RL_RT = 6912, RL_KAPT = 9216, RL_VT = 11264, RL_TB = 13312, RL_BL = 14336, RL_QL = 15360, RL_PL = 16384,
              RL_WT = RL_KAP, RL_BVT = RL_ALP, RL_AL32 = RL_KT, RL_ET = RL_KT,
              RL_BYTES = 18176;
constexpr int XS = 72, TS = 16, SS16 = 32;

__device__ __forceinline__ float wave_sum_pl(float x) {
    x = rowsum16(x);
    { auto rr = __builtin_amdgcn_permlane16_swap(__float_as_uint(x), __float_as_uint(x), false, false); x = __uint_as_float(rr[0]) + __uint_as_float(rr[1]); }
    { auto rr = __builtin_amdgcn_permlane32_swap(__float_as_uint(x), __float_as_uint(x), false, false); x = __uint_as_float(rr[0]) + __uint_as_float(rr[1]); }
    return x;
}
__device__ __forceinline__ v2u pack4(const f32x4 a) { v2u o; o.x = pk2(a[0], a[1]); o.y = pk2(a[2], a[3]); return o; }
__device__ __forceinline__ f32x4 unpack4(const v2u u) { return (f32x4){bflo(u.x), bfhi(u.x), bflo(u.y), bfhi(u.y)}; }
__device__ __forceinline__ bf16 f2b(float x) { return (bf16)(pk2(x, 0.f) & 0xffffu); }

__device__ __forceinline__ void ra_item(const Ctx& F, LAS unsigned char* wl, int it, int half) {
    const int bh = it / RHALF, cl = it - bh * RHALF, ci = half * RHALF + cl, b = bh >> 4, h = bh & 15;
    const bf16* PROJ = (const bf16*)(F.ws + WS_PROJ); const bf16* LW = (const bf16*)(F.ws + WS_LW); const bf16* AA = (const bf16*)(F.ws + WS_AA);
    unsigned char* RO = (unsigned char*)F.out + (size_t)(half & 1) * RO_BUF;
    const int lane = F.lane, r16 = lane & 15, q = lane >> 4, c = lane, ch = h * 64 + c;
    const size_t m0 = (size_t)b * SEQ + (size_t)RC * ci;
    LAS bf16* KAP = (LAS bf16*)(wl + RL_KAP); LAS bf16* ALP = (LAS bf16*)(wl + RL_ALP); LAS bf16* KT = (LAS bf16*)(wl + RL_KT); LAS bf16* RT = (LAS bf16*)(wl + RL_RT);
    LAS bf16* KAPT = (LAS bf16*)(wl + RL_KAPT); LAS bf16* VTL = (LAS bf16*)(wl + RL_VT); LAS bf16* WT = (LAS bf16*)(wl + RL_WT); LAS bf16* BVT = (LAS bf16*)(wl + RL_BVT); LAS bf16* ETL = (LAS bf16*)(wl + RL_ET);
    LAS bf16* TB = (LAS bf16*)(wl + RL_TB); LAS bf16* BL = (LAS bf16*)(wl + RL_BL); LAS bf16* QL = (LAS bf16*)(wl + RL_QL); LAS bf16* PL = (LAS bf16*)(wl + RL_PL);
    const float mu_r = F.in[I_MU][C_R + ch], mu_k = F.in[I_MU][C_K + ch], mu_v = F.in[I_MU][C_V + ch], kkw = F.in[I_KK][ch], kaw = F.in[I_KA][ch];
    const bf16* prow = PROJ + m0 * INPP + ch;
    float rp = 0.f, kp = 0.f, vp = 0.f;
    if (ci > 0) { rp = bf1(prow[-INPP + C_R]); kp = bf1(prow[-INPP + C_K]); vp = bf1(prow[-INPP + C_V]); }
    float cum = 0.f, kkna[RC], kpv[RC], cumv[RC], vvv[RC];
#pragma unroll
    for (int t = 0; t < RC; ++t) {
        const bf16* row = prow + (size_t)t * INPP;
        const float rc = bf1(row[C_R]), kc = bf1(row[C_K]), vc = bf1(row[C_V]);
        const float a = bf1(AA[(m0 + t) * RW + ch]), lw = bf1(LW[(m0 + t) * RW + ch]);
        const float rr = rc + (rp - rc) * mu_r, kx = kc + (kp - kc) * mu_k, vv = vc + (vp - vc) * mu_v;
        rp = rc; kp = kc; vp = vc;
        const float kkraw = kx * kkw; const float ss = wave_sum_pl(kkraw * kkraw);
        const float kkn = kkraw * rcp_f(fmaxf(sqrtf(ss), 1e-12f));
        const float kpp = kx * (1.f + (a - 1.f) * kaw);
        const float ep = __expf(cum); cum += lw; const float en = __expf(-cum), ec = __expf(cum);
        const bf16 bkap = f2b(kkn * ep);
        KAP[t * XS + c] = bkap; ALP[t * XS + c] = f2b(kkn * a * en); KT[t * XS + c] = f2b(kpp * en); RT[t * XS + c] = f2b(rr * ec);
        KAPT[c * TS + t] = bkap; VTL[c * TS + t] = f2b(vv);
        kkna[t] = kkn * a; kpv[t] = kpp; cumv[t] = cum; vvv[t] = vv;
    }
    {
        float e8[8]; v4u* vt = (v4u*)((bf16*)(RO + RO_VT) + (size_t)it * 1024 + c * 16);
#pragma unroll
        for (int i = 0; i < 8; ++i) e8[i] = vvv[i];
        vt[0] = pack8(e8);
#pragma unroll
        for (int i = 0; i < 8; ++i) e8[i] = vvv[8 + i];
        vt[1] = pack8(e8);
        v4u* a2 = (v4u*)((bf16*)(RO + RO_A2) + (size_t)it * 2048 + c * 32);
        float dd[RC];
#pragma unroll
        for (int t = 0; t < RC; ++t) dd[t] = __expf(cum - cumv[t]);
#pragma unroll
        for (int i = 0; i < 8; ++i) e8[i] = -kkna[i] * dd[i];
        a2[0] = pack8(e8);
#pragma unroll
        for (int i = 0; i < 8; ++i) e8[i] = -kkna[8 + i] * dd[8 + i];
        a2[1] = pack8(e8);
#pragma unroll
        for (int i = 0; i < 8; ++i) e8[i] = kpv[i] * dd[i];
        a2[2] = pack8(e8);
#pragma unroll
        for (int i = 0; i < 8; ++i) e8[i] = kpv[8 + i] * dd[8 + i];
        a2[3] = pack8(e8);
        ((float*)(RO + RO_GC))[(size_t)it * 64 + c] = __expf(cum);
    }
    LDS_WAIT(); asm volatile("" ::: "memory");
    const v2u zero2 = {0u, 0u};
    {
        f32x4 alt = {0.f, 0.f, 0.f, 0.f}, blt = alt, qlt = alt, plt = alt;
#pragma unroll
        for (int ks = 0; ks < 2; ++ks) {
            const bf16x8 fa = *(const LAS bf16x8*)(ALP + r16 * XS + 32 * ks + 8 * q), fk = *(const LAS bf16x8*)(KT + r16 * XS + 32 * ks + 8 * q);
            const bf16x8 fkp = *(const LAS bf16x8*)(KAP + r16 * XS + 32 * ks + 8 * q), fr = *(const LAS bf16x8*)(RT + r16 * XS + 32 * ks + 8 * q);
            alt = __builtin_amdgcn_mfma_f32_16x16x32_bf16(fa, fkp, alt, 0, 0, 0); blt = __builtin_amdgcn_mfma_f32_16x16x32_bf16(fk, fkp, blt, 0, 0, 0);
            qlt = __builtin_amdgcn_mfma_f32_16x16x32_bf16(fa, fr, qlt, 0, 0, 0);  plt = __builtin_amdgcn_mfma_f32_16x16x32_bf16(fk, fr, plt, 0, 0, 0);
        }
#pragma unroll
        for (int j = 0; j < 4; ++j) { const int s = 4 * q + j; const bool lt = s < r16, le = s <= r16;
            alt[j] = lt ? alt[j] : 0.f; blt[j] = lt ? blt[j] : 0.f; qlt[j] = le ? qlt[j] : 0.f; plt[j] = le ? plt[j] : 0.f; }
        *(LAS v2u*)(BL + r16 * SS16 + 4 * q) = pack4(blt); *(LAS v2u*)(QL + r16 * SS16 + 4 * q) = pack4(qlt); *(LAS v2u*)(PL + r16 * SS16 + 4 * q) = pack4(plt);
        *(LAS v2u*)(BL + r16 * SS16 + 16 + 4 * q) = zero2; *(LAS v2u*)(QL + r16 * SS16 + 16 + 4 * q) = zero2; *(LAS v2u*)(PL + r16 * SS16 + 16 + 4 * q) = zero2;
        float x[RC];
#pragma unroll
        for (int t = 0; t < RC; ++t) {
            float acc = (t == r16) ? 1.f : 0.f;
#pragma unroll
            for (int s2 = 0; s2 < t; ++s2) { const float a_ts = __uint_as_float(__builtin_amdgcn_readlane(__float_as_uint(alt[s2 & 3]), 16 * (s2 >> 2) + t)); acc -= a_ts * x[s2]; }
            x[t] = acc;
        }
        if (q == 0) {
#pragma unroll
            for (int t = 0; t < RC; ++t) { TB[t * SS16 + r16] = f2b(x[t]); TB[t * SS16 + 16 + r16] = 0; }
        }
    }
    LDS_WAIT(); asm volatile("" ::: "memory");
    const bf16x8 zf = {0, 0, 0, 0, 0, 0, 0, 0};
    const bf16x8 tbf = *(const LAS bf16x8*)(TB + r16 * SS16 + 8 * q), blf = *(const LAS bf16x8*)(BL + r16 * SS16 + 8 * q);
    const bf16x8 qlf = *(const LAS bf16x8*)(QL + r16 * SS16 + 8 * q), plf = *(const LAS bf16x8*)(PL + r16 * SS16 + 8 * q);
    const f32x4 z4 = {0.f, 0.f, 0.f, 0.f};
    bf16* gWH = (bf16*)(RO + RO_WH) + (size_t)it * 1024; bf16* gRH = (bf16*)(RO + RO_RH) + (size_t)it * 1024;
    bf16* gET = (bf16*)(RO + RO_ET) + (size_t)it * 1024; bf16* gOL = (bf16*)(RO + RO_OL) + (size_t)it * 1024;
#pragma unroll
    for (int kt = 0; kt < 4; ++kt) {
        const bf16x8 kf = (q < 2) ? *(const LAS bf16x8*)(KAPT + (16 * kt + r16) * TS + 8 * q) : zf;
        const f32x4 wa = __builtin_amdgcn_mfma_f32_16x16x32_bf16(kf, tbf, z4, 0, 0, 0);
        *(v2u*)(gWH + r16 * 64 + 16 * kt + 4 * q) = pack4(wa);
        const f32x4 wb = __builtin_amdgcn_mfma_f32_16x16x32_bf16(tbf, kf, z4, 0, 0, 0);
        *(LAS v2u*)(WT + (16 * kt + r16) * TS + 4 * q) = pack4(wb);
        const bf16x8 vf = (q < 2) ? *(const LAS bf16x8*)(VTL + (16 * kt + r16) * TS + 8 * q) : zf;
        const f32x4 bv = __builtin_amdgcn_mfma_f32_16x16x32_bf16(blf, vf, z4, 0, 0, 0);
        *(LAS v2u*)(BVT + (16 * kt + r16) * TS + 4 * q) = pack4(bv);
    }
    LDS_WAIT(); asm volatile("" ::: "memory");
#pragma unroll
    for (int vt = 0; vt < 4; ++vt) {
        const bf16x8 bf_ = (q < 2) ? *(const LAS bf16x8*)(BVT + (16 * vt + r16) * TS + 8 * q) : zf;
        const f32x4 e4 = __builtin_amdgcn_mfma_f32_16x16x32_bf16(tbf, bf_, z4, 0, 0, 0);
        const v2u ep = pack4(e4);
        *(LAS v2u*)(ETL + (16 * vt + r16) * TS + 4 * q) = ep; *(v2u*)(gET + (16 * vt + r16) * 16 + 4 * q) = ep;
    }
    LDS_WAIT(); asm volatile("" ::: "memory");
#pragma unroll
    for (int kt = 0; kt < 4; ++kt) {
        const bf16x8 wf = (q < 2) ? *(const LAS bf16x8*)(WT + (16 * kt + r16) * TS + 8 * q) : zf;
        const f32x4 qw = __builtin_amdgcn_mfma_f32_16x16x32_bf16(wf, qlf, z4, 0, 0, 0);
        const f32x4 rt4 = unpack4(*(const LAS v2u*)(RT + r16 * XS + 16 * kt + 4 * q));
        *(v2u*)(gRH + r16 * 64 + 16 * kt + 4 * q) = pack4(rt4 - qw);
        const bf16x8 vf = (q < 2) ? *(const LAS bf16x8*)(VTL + (16 * kt + r16) * TS + 8 * q) : zf;
        const bf16x8 ef = (q < 2) ? *(const LAS bf16x8*)(ETL + (16 * kt + r16) * TS + 8 * q) : zf;
        const f32x4 pv = __builtin_amdgcn_mfma_f32_16x16x32_bf16(vf, plf, z4, 0, 0, 0);
        const f32x4 qe = __builtin_amdgcn_mfma_f32_16x16x32_bf16(ef, qlf, z4, 0, 0, 0);
        *(v2u*)(gOL + r16 * 64 + 16 * kt + 4 * q) = pack4(pv - qe);
    }
    LDS_WAIT(); asm volatile("" ::: "memory");
}
__device__ __forceinline__ void ra_part(const Ctx& F, int part, int wave_lo) {
    if (F.wave < wave_lo) return;
    const int nw = NWAVES - wave_lo;
    LAS unsigned char* wl = F.lds + F.wave * RL_BYTES;
    for (int it = blockIdx.x * nw + (F.wave - wave_lo); it < RITEMS; it += F.G * nw) ra_item(F, wl, it, part);
}

__device__ __forceinline__ void rs_half(const Ctx& F, int half) {
    if (F.wave != 0) return;
    const unsigned char* RO = (const unsigned char*)F.out + (size_t)(half & 1) * RO_BUF; bf16* OY = (bf16*)(F.ws + WS_OY);
    float* SSg = (float*)((unsigned char*)F.out + RO_SS);
    LAS bf16* ST = (LAS bf16*)F.lds;
    LAS bf16* ZT = (LAS bf16*)(F.lds + 16 * XS * 2);
    constexpr int ZS = 24;
    const int lane = F.lane, r16 = lane & 15, q = lane >> 4;
    for (int blk = blockIdx.x; blk < NB * RHEADS * 4; blk += F.G) {
        const int xcd = blk & 7, jj = blk >> 3, qt = jj & 3, bh = (jj >> 2) * 8 + xcd, b = bh >> 4, h = bh & 15;
        f32x4 S[4];
        if (half == 0) {
#pragma unroll
            for (int kt = 0; kt < 4; ++kt) S[kt] = (f32x4){0.f, 0.f, 0.f, 0.f};
        } else {
#pragma unroll
            for (int kt = 0; kt < 4; ++kt) S[kt] = *(const f32x4*)(SSg + (size_t)blk * 1024 + (kt * 64 + lane) * 4);
        }
#pragma unroll
        for (int kt = 0; kt < 4; ++kt) *(LAS v2u*)(ST + r16 * XS + 16 * kt + 4 * q) = pack4(S[kt]);
        LDS_WAIT(); asm volatile("" ::: "memory");
        const size_t it0 = (size_t)bh * RHALF;
        const size_t mbase = (size_t)b * SEQ + (size_t)half * RHALF * RC;
#define RS_LOAD(IT, WF, RF, A2F, VF, ET4, OL4, GC4) do { const size_t it_ = (IT); \
        const bf16* wh_ = (const bf16*)(RO + RO_WH) + it_ * 1024 + r16 * 64 + 8 * q; const bf16* rh_ = (const bf16*)(RO + RO_RH) + it_ * 1024 + r16 * 64 + 8 * q; \
        WF[0] = *(const bf16x8*)wh_; WF[1] = *(const bf16x8*)(wh_ + 32); RF[0] = *(const bf16x8*)rh_; RF[1] = *(const bf16x8*)(rh_ + 32); \
        _Pragma("unroll") for (int kt_ = 0; kt_ < 4; ++kt_) { A2F[kt_] = *(const bf16x8*)((const bf16*)(RO + RO_A2) + it_ * 2048 + (16 * kt_ + r16) * 32 + 8 * q); \
            GC4[kt_] = *(const f32x4*)((const float*)(RO + RO_GC) + it_ * 64 + 16 * kt_ + 4 * q); } \
        VF = *(const bf16x8*)((const bf16*)(RO + RO_VT) + it_ * 1024 + (16 * qt + r16) * 16 + 8 * (q & 1)); \
        ET4 = *(const v2u*)((const bf16*)(RO + RO_ET) + it_ * 1024 + (16 * qt + r16) * 16 + 4 * q); \
        OL4 = *(const v2u*)((const bf16*)(RO + RO_OL) + it_ * 1024 + r16 * 64 + 16 * qt + 4 * q); } while (0)
        bf16x8 wfq[2][2], rfq[2][2], a2q[2][4], vfq[2]; v2u etq[2], olq[2]; f32x4 gcq[2][4];
#pragma unroll
        for (int u = 0; u < 2; ++u) RS_LOAD(it0 + u, wfq[u], rfq[u], a2q[u], vfq[u], etq[u], olq[u], gcq[u]);
#define RS_STEP(U, CL) do { const int cl_ = (CL); \
            const bf16x8 sb0 = *(const LAS bf16x8*)(ST + r16 * XS + 8 * q), sb1 = *(const LAS bf16x8*)(ST + r16 * XS + 32 + 8 * q); \
            f32x4 x1 = __builtin_amdgcn_mfma_f32_16x16x32_bf16(wfq[U][0], sb0, (f32x4){0.f, 0.f, 0.f, 0.f}, 0, 0, 0); \
            x1 = __builtin_amdgcn_mfma_f32_16x16x32_bf16(wfq[U][1], sb1, x1, 0, 0, 0); \
            f32x4 ot = __builtin_amdgcn_mfma_f32_16x16x32_bf16(sb0, rfq[U][0], unpack4(olq[U]), 0, 0, 0); \
            ot = __builtin_amdgcn_mfma_f32_16x16x32_bf16(sb1, rfq[U][1], ot, 0, 0, 0); \
            *(LAS v2u*)(ZT + r16 * ZS + 4 * q) = pack4(x1 + unpack4(etq[U])); \
            *(v2u*)(OY + (mbase + (size_t)cl_ * RC + r16) * DM + h * 64 + 16 * qt + 4 * q) = pack4(ot); \
            LDS_WAIT(); asm volatile("" ::: "memory"); \
            const bf16x8 zr = *(const LAS bf16x8*)(ZT + r16 * ZS + 8 * (q & 1)); \
            const bf16x8 bz = (q < 2) ? zr : vfq[U]; \
            _Pragma("unroll") for (int kt = 0; kt < 4; ++kt) { S[kt] = __builtin_amdgcn_mfma_f32_16x16x32_bf16(a2q[U][kt], bz, S[kt] * gcq[U][kt], 0, 0, 0); \
                *(LAS v2u*)(ST + r16 * XS + 16 * kt + 4 * q) = pack4(S[kt]); } \
            RS_LOAD(it0 + ((cl_ + 2 < RHALF) ? cl_ + 2 : RHALF - 1), wfq[U], rfq[U], a2q[U], vfq[U], etq[U], olq[U], gcq[U]);     \
            LDS_WAIT(); asm volatile("" ::: "memory"); } while (0)
#pragma unroll 1
        for (int cl = 0; cl < RHALF; cl += 2) { RS_STEP(0, cl); RS_STEP(1, cl + 1); }
#undef RS_STEP
#undef RS_LOAD
        if (half + 1 < NPART) {
#pragma unroll
            for (int kt = 0; kt < 4; ++kt) *(f32x4*)(SSg + (size_t)blk * 1024 + (kt * 64 + lane) * 4) = S[kt];
        }
    }
}
__device__ __forceinline__ float rowmax16(float x) { x = fmaxf(x, dpp_f<0xB1>(x)); x = fmaxf(x, dpp_f<0x4E>(x)); x = fmaxf(x, dpp_f<0x124>(x)); x = fmaxf(x, dpp_f<0x128>(x)); return x; }
__device__ __forceinline__ int cand_code(int s) {
    if (s < 16) return s << 4;
    if (s < 24) return 1 | ((s - 16) << 4);
    if (s < 29) return 2 | ((s - 24) << 4);
    if (s < 33) return 3 | ((s - 29) << 4);
    if (s < 36) return 4 | ((s - 33) << 4);
    if (s < 42) { const int k = s - 36; return (5 + (k >> 1)) | ((k & 1) << 4); }
    if (s < 50) return 8 + (s - 42);
    return -1;
}
__device__ __forceinline__ int f2ord(float f) { const int b = __float_as_int(f); return b ^ ((b >> 31) & 0x7fffffff); }
__device__ __forceinline__ float ord2f(int k) { return __int_as_float(k ^ ((k >> 31) & 0x7fffffff)); }
template <int CTRL> __device__ __forceinline__ int dpp_i(int x) { return __builtin_amdgcn_mov_dpp(x, CTRL, 0xf, 0xf, true); }
__device__ __forceinline__ int imax(int a, int b) { return a > b ? a : b; }
__device__ __forceinline__ int imin(int a, int b) { return a < b ? a : b; }
__device__ __forceinline__ int rowmax16_i(int x) { x = imax(x, dpp_i<0xB1>(x)); x = imax(x, dpp_i<0x4E>(x)); x = imax(x, dpp_i<0x124>(x)); x = imax(x, dpp_i<0x128>(x)); return x; }
#define CSWAP_(a, b) do { const int hi_ = imax(a, b), lo_ = imin(a, b); a = hi_; b = lo_; } while (0)
template <int NV> __device__ __forceinline__ void sort_desc(int (&v)[NV]);
template <> __device__ __forceinline__ void sort_desc<8>(int (&v)[8]) {
    CSWAP_(v[0], v[1]); CSWAP_(v[2], v[3]); CSWAP_(v[4], v[5]); CSWAP_(v[6], v[7]);
    CSWAP_(v[0], v[2]); CSWAP_(v[1], v[3]); CSWAP_(v[4], v[6]); CSWAP_(v[5], v[7]);
    CSWAP_(v[1], v[2]); CSWAP_(v[5], v[6]);
    CSWAP_(v[0], v[4]); CSWAP_(v[1], v[5]); CSWAP_(v[2], v[6]); CSWAP_(v[3], v[7]);
    CSWAP_(v[2], v[4]); CSWAP_(v[3], v[5]);
    CSWAP_(v[1], v[2]); CSWAP_(v[3], v[4]); CSWAP_(v[5], v[6]);
}
template <> __device__ __forceinline__ void sort_desc<4>(int (&v)[4]) {
    CSWAP_(v[0], v[1]); CSWAP_(v[2], v[3]); CSWAP_(v[0], v[2]); CSWAP_(v[1], v[3]); CSWAP_(v[1], v[2]);
}
template <int NV>
__device__ __forceinline__ void select16x4(int (&v)[4][NV], int r16, float (&kept_f)[4]) {
    const int IMIN = (int)0x80000000;
    int kept[4];
#pragma unroll
    for (int j = 0; j < 4; ++j) { kept[j] = IMIN; sort_desc<NV>(v[j]); }
#pragma unroll 1
    for (int rd = 0; rd < 16; ++rd) {
#pragma unroll
        for (int j = 0; j < 4; ++j) {
            const int m = rowmax16_i(v[j][0]);
            kept[j] = (r16 == rd) ? m : kept[j];
            const bool own = (v[j][0] == m);
#pragma unroll
            for (int i = 0; i < NV - 1; ++i) v[j][i] = own ? v[j][i + 1] : v[j][i];
            v[j][NV - 1] = own ? IMIN : v[j][NV - 1];
        }
    }
#pragma unroll
    for (int j = 0; j < 4; ++j) kept_f[j] = ord2f(kept[j]);
}
__device__ __forceinline__ float dot2bf(unsigned a, unsigned b, float acc) { return __builtin_amdgcn_fdot2_f32_bf16(__builtin_bit_cast(bf16x2_t, a), __builtin_bit_cast(bf16x2_t, b), acc, false); }

constexpr int PT = 16;
constexpr size_t RANGE_BYTES = (size_t)NEXP * 128;

__device__ __forceinline__ void p9_route(const Ctx& F) {
    constexpr int KSTR = 136;
    const bf16* Q = (const bf16*)(F.ws + WS_Q); const bf16* KEYS = (const bf16*)(F.ws + WS_KEYS);
    int* rtE = (int*)(F.ws + WS_RTE); float* rtG = (float*)(F.ws + WS_RTG);
    LAS bf16* KL = (LAS bf16*)F.lds;
    const int lane = F.lane, w = F.wave, r16 = lane & 15, q = lane >> 4, gbase = lane & 48;
    const int h = blockIdx.x & 7, nbh = (F.G - h + 7) >> 3;
    __syncthreads();
    for (int i = F.tid; i < 2 * 128 * 16; i += NTHR) { const int row = i >> 4, ch = i & 15;
        *(LAS v4u*)(KL + row * KSTR + 8 * ch) = *(const v4u*)(KEYS + (size_t)(2 * h * 128 + row) * 128 + 8 * ch); }
    __syncthreads();
    int ci[4], cj[4]; bool cvalid[4];
#pragma unroll
    for (int u = 0; u < 4; ++u) { const int cd = cand_code(r16 + 16 * u); cvalid[u] = cd >= 0; ci[u] = cd & 15; cj[u] = (cd >> 4) & 15; }
    const float NINF = -__builtin_inff();
    const int tstride = nbh * NWAVES;
    int tile = (blockIdx.x >> 3) * NWAVES + w;
    bf16x8 afn[2][4];
    if (tile < M / PT) {
#pragma unroll
        for (int p = 0; p < 2; ++p)
#pragma unroll
            for (int s = 0; s < 4; ++s) afn[p][s] = *(const bf16x8*)(Q + (size_t)(tile * PT + r16) * DM + (2 * h + p) * 128 + 8 * q + 32 * s);
    }
    for (; tile < M / PT; tile += tstride) {
        const int m0 = tile * PT;
        bf16x8 af[2][4];
#pragma unroll
        for (int p = 0; p < 2; ++p)
#pragma unroll
            for (int s = 0; s < 4; ++s) af[p][s] = afn[p][s];
        { const int tn = (tile + tstride < M / PT) ? tile + tstride : tile;
#pragma unroll
            for (int p = 0; p < 2; ++p)
#pragma unroll
                for (int s = 0; s < 4; ++s) afn[p][s] = *(const bf16x8*)(Q + (size_t)(tn * PT + r16) * DM + (2 * h + p) * 128 + 8 * q + 32 * s);
        }
        float top[2][4];
#pragma unroll
        for (int p = 0; p < 2; ++p) {
            int v[4][8];
#pragma unroll
            for (int nt = 0; nt < 8; ++nt) {
                const LAS bf16* krow = KL + (p * 128 + nt * 16 + r16) * KSTR + 8 * q;
                f32x4 acc = {0.f, 0.f, 0.f, 0.f};
#pragma unroll
                for (int s = 0; s < 4; ++s) acc = __builtin_amdgcn_mfma_f32_16x16x32_bf16(af[p][s], *(const LAS bf16x8*)(krow + 32 * s), acc, 0, 0, 0);
                const unsigned tag = 127u - (unsigned)(nt * 16 + r16);
#pragma unroll
                for (int j = 0; j < 4; ++j) v[j][nt] = f2ord(__uint_as_float((__float_as_uint(acc[j]) & ~127u) | tag));
                if (nt & 1) asm volatile("" ::: "memory");
            }
            select16x4<8>(v, r16, top[p]);
        }
        int cv[4][4];
#pragma unroll
        for (int u = 0; u < 4; ++u)
#pragma unroll
            for (int j = 0; j < 4; ++j) {
                const float a = __shfl(top[0][j], gbase + ci[u]), b = __shfl(top[1][j], gbase + cj[u]);
                const float cs = __uint_as_float(__float_as_uint(a) & ~127u) + __uint_as_float(__float_as_uint(b) & ~127u);
                const float pk = __uint_as_float((__float_as_uint(cs) & ~63u) | (63u - (unsigned)(r16 + 16 * u)));
                cv[j][u] = cvalid[u] ? f2ord(pk) : (int)0x80000000;
            }
        float best[4];
        select16x4<4>(cv, r16, best);
#pragma unroll
        for (int j = 0; j < 4; ++j) {
            const unsigned bb = __float_as_uint(best[j]);
            const int cd = cand_code(63 - (int)(bb & 63u));
            const int k0 = 127 - (int)(__float_as_uint(__shfl(top[0][j], gbase + (cd & 15))) & 127u);
            const int k1 = 127 - (int)(__float_as_uint(__shfl(top[1][j], gbase + ((cd >> 4) & 15))) & 127u);
            const float s = __uint_as_float(bb & ~63u);
            const float mx = rowmax16(s), e = __expf(s - mx), sum = rowsum16(e);
            const size_t o = (size_t)(m0 + 4 * q + j) * 128 + h * 16 + r16;
            rtE[o] = k0 * 128 + k1; rtG[o] = e * rcp_f(sum);
        }
    }
}

__device__ __forceinline__ f32x2 cvt2_fp8(unsigned wd, bool hi) { return hi ? __builtin_amdgcn_cvt_pk_f32_fp8((int)wd, true) : __builtin_amdgcn_cvt_pk_f32_fp8((int)wd, false); }
__device__ __forceinline__ void treduce8x16(const float (&p)[16], bool b0, bool b1, bool b2, float& r0, float& r1) {
    float a[8], bq[4];
#pragma unroll
    for (int i = 0; i < 8; ++i) { const float mine = b2 ? p[i + 8] : p[i], send = b2 ? p[i] : p[i + 8]; const float up = dpp_f<0x104>(send), dn = dpp_f<0x114>(send); a[i] = mine + (b2 ? dn : up); }
#pragma unroll
    for (int i = 0; i < 4; ++i) { const float mine = b1 ? a[i + 4] : a[i], send = b1 ? a[i] : a[i + 4]; bq[i] = mine + dpp_f<0x4E>(send); }
    { const float mine = b0 ? bq[2] : bq[0], send = b0 ? bq[0] : bq[2]; r0 = mine + dpp_f<0xB1>(send); }
    { const float mine = b0 ? bq[3] : bq[1], send = b0 ? bq[1] : bq[3]; r1 = mine + dpp_f<0xB1>(send); }
}
struct XGroup { int xg, gwi, stride; };
__device__ __forceinline__ XGroup xgroup(const Ctx& F) { XGroup g; g.xg = blockIdx.x & 7; const int nbg = (F.G - g.xg + 7) >> 3; g.gwi = (blockIdx.x >> 3) * NWAVES + F.wave; g.stride = nbg * NWAVES; return g; }

__device__ __forceinline__ void p10_peer_u(const Ctx& F) {
    const unsigned char* PU8 = F.ws + WS_PU8; const bf16* XN = (const bf16*)(F.ws + WS_XN);
    const int* rtE = (const int*)(F.ws + WS_RTE); unsigned* PD = (unsigned*)(F.ws + WS_PD);
    const XGroup g = xgroup(F);
    const int lane = F.lane, j = lane >> 3, sub = lane & 7;
    const bool b0 = sub & 1, b1 = sub & 2, b2 = sub & 4;
    for (int rr = 0; rr < 2; ++rr) {
        const int r = g.xg + 8 * rr;
        const unsigned char* tab = PU8 + (size_t)r * RANGE_BYTES + 16 * sub;
        int m = g.gwi;
        v4u ev[4], xs[2];
        if (m < M) {
#pragma unroll
            for (int i = 0; i < 4; ++i) ev[i] = *(const v4u*)(rtE + (size_t)m * 128 + 16 * j + 4 * i);
            xs[0] = *(const v4u*)(XN + (size_t)m * DM + 128 * r + 16 * sub); xs[1] = *(const v4u*)(XN + (size_t)m * DM + 128 * r + 16 * sub + 8);
        }
        for (; m < M; m += g.stride) {
            v4u gt[16];
#pragma unroll
            for (int k = 0; k < 16; ++k) gt[k] = *(const v4u*)(tab + (size_t)ev[k >> 2][k & 3] * 128);
            float x[16]; { float t0[8], t1[8]; unpack8(xs[0], t0); unpack8(xs[1], t1);
#pragma unroll
              for (int i = 0; i < 8; ++i) { x[i] = t0[i]; x[8 + i] = t1[i]; } }
            const int mn = (m + g.stride < M) ? m + g.stride : m;
            {
#pragma unroll
                for (int i = 0; i < 4; ++i) ev[i] = *(const v4u*)(rtE + (size_t)mn * 128 + 16 * j + 4 * i);
                xs[0] = *(const v4u*)(XN + (size_t)mn * DM + 128 * r + 16 * sub); xs[1] = *(const v4u*)(XN + (size_t)mn * DM + 128 * r + 16 * sub + 8);
            }
            float p[16];
#pragma unroll
            for (int k = 0; k < 16; ++k) {
                f32x2 a0 = {0.f, 0.f}, a1 = {0.f, 0.f};
#pragma unroll
                for (int d = 0; d < 4; ++d) { const unsigned wd = gt[k][d];
                    a0 += cvt2_fp8(wd, false) * (f32x2){x[4 * d], x[4 * d + 1]}; a1 += cvt2_fp8(wd, true) * (f32x2){x[4 * d + 2], x[4 * d + 3]}; }
                p[k] = (a0.x + a0.y) + (a1.x + a1.y);
            }
            float r0, r1; treduce8x16(p, b0, b1, b2, r0, r1);
            PD[((size_t)r * M + m) * 64 + lane] = pk2(r0, r1);
        }
    }
}

__device__ __forceinline__ void p11_peer_coef(const Ctx& F) {
    const int* rtE = (const int*)(F.ws + WS_RTE); const float* rtG = (const float*)(F.ws + WS_RTG); const unsigned* PD = (const unsigned*)(F.ws + WS_PD);
    const float* usc = (const float*)(F.ws + WS_USC); const float* vsc = (const float*)(F.ws + WS_VSC); float* COEF = (float*)(F.ws + WS_COEF);
    for (int m = F.gw; m < M; m += F.NGW) {
        const size_t o = (size_t)m * 128 + 2 * F.lane;
        f32x2 d = {0.f, 0.f};
#pragma unroll
        for (int r = 0; r < 16; ++r) { const unsigned pw = PD[((size_t)r * M + m) * 64 + F.lane]; d += (f32x2){bflo(pw), bfhi(pw)}; }
        const int e0 = rtE[o], e1 = rtE[o + 1];
        const f32x2 gt = *(const f32x2*)(rtG + o);
        const float d0 = d.x * usc[e0], d1 = d.y * usc[e1];
        f32x2 c; c.x = gt.x * (0.5f * d0 * (1.f + erff(d0 * 0.70710678f))) * vsc[e0]; c.y = gt.y * (0.5f * d1 * (1.f + erff(d1 * 0.70710678f))) * vsc[e1];
        *(f32x2*)(COEF + o) = c;
    }
}

__device__ __forceinline__ void p12_peer_v(const Ctx& F) {
    const unsigned char* PV8 = F.ws + WS_PV8; const int* rtE = (const int*)(F.ws + WS_RTE); const float* COEF = (const float*)(F.ws + WS_COEF);
    const float* mod = (const float*)(F.ws + WS_MOD);
    const XGroup g = xgroup(F);
    const int lane = F.lane, j = lane >> 3, sub = lane & 7;
    const bool jb0 = j & 1;
    for (int rr = 0; rr < 2; ++rr) {
        const int r = g.xg + 8 * rr;
        const unsigned char* tab = PV8 + (size_t)r * RANGE_BYTES + 16 * sub;
        int m = g.gwi;
        v4u ev[4]; f32x4 cf[4];
        if (m < M) {
#pragma unroll
            for (int i = 0; i < 4; ++i) { ev[i] = *(const v4u*)(rtE + (size_t)m * 128 + 16 * j + 4 * i); cf[i] = *(const f32x4*)(COEF + (size_t)m * 128 + 16 * j + 4 * i); }
        }
        for (; m < M; m += g.stride) {
            v4u gt[16];
#pragma unroll
            for (int k = 0; k < 16; ++k) gt[k] = *(const v4u*)(tab + (size_t)ev[k >> 2][k & 3] * 128);
            f32x4 cc[4];
#pragma unroll
            for (int i = 0; i < 4; ++i) cc[i] = cf[i];
            const int mn = (m + g.stride < M) ? m + g.stride : m;
            {
#pragma unroll
                for (int i = 0; i < 4; ++i) { ev[i] = *(const v4u*)(rtE + (size_t)mn * 128 + 16 * j + 4 * i); cf[i] = *(const f32x4*)(COEF + (size_t)mn * 128 + 16 * j + 4 * i); }
            }
            f32x2 acc[8];
#pragma unroll
            for (int i = 0; i < 8; ++i) acc[i] = (f32x2){0.f, 0.f};
#pragma unroll
            for (int k = 0; k < 16; ++k) { const float c = cc[k >> 2][k & 3]; const f32x2 cv2 = {c, c};
#pragma unroll
                for (int d = 0; d < 4; ++d) { const unsigned wd = gt[k][d]; acc[2 * d] += cv2 * cvt2_fp8(wd, false); acc[2 * d + 1] += cv2 * cvt2_fp8(wd, true); } }
            float a[16];
#pragma unroll
            for (int i = 0; i < 8; ++i) { a[2 * i] = acc[i].x; a[2 * i + 1] = acc[i].y; }
            float s8[8], s4[4];
#pragma unroll
            for (int c = 0; c < 8; ++c) { auto rr2 = __builtin_amdgcn_permlane32_swap(__float_as_uint(a[c]), __float_as_uint(a[c + 8]), false, false); s8[c] = __uint_as_float(rr2[0]) + __uint_as_float(rr2[1]); }
#pragma unroll
            for (int c = 0; c < 4; ++c) { auto rr2 = __builtin_amdgcn_permlane16_swap(__float_as_uint(s8[c]), __float_as_uint(s8[c + 4]), false, false); s4[c] = __uint_as_float(rr2[0]) + __uint_as_float(rr2[1]); }
            f32x2 res;
            { const float mine = jb0 ? s4[2] : s4[0], send = jb0 ? s4[0] : s4[2]; res.x = mine + dpp_f<0x128>(send); }
            { const float mine = jb0 ? s4[3] : s4[1], send = jb0 ? s4[1] : s4[3]; res.y = mine + dpp_f<0x128>(send); }
            const int col = 128 * r + 16 * sub + 2 * j;
            unsigned* orow = (unsigned*)((bf16*)(F.ws + WS_HB) + (size_t)m * DM + col);
            const unsigned hw = *orow; const f32x2 h1 = {bflo(hw), bfhi(hw)}, g2 = *(const f32x2*)(mod + (size_t)(m / SEQ) * MODW + 5 * DM + col);
            const f32x2 h2 = h1 + g2 * res;
            *orow = pk2(h2.x, h2.y);
        }
    }
}
#define XB_TMO      128
#define XB_XCNT(j)  (256  + 64 * (j))
#define XB_XSUB(j)  (1280 + 64 * (j))
#define XB_XGEN(j)  (2304 + 64 * (j))
#define XB_TOP      3328
#define XB_TOPGEN   3392
#define XCD_BAR_WORDS 3456
#define XB_SPIN_CAP (1u << 18)

__device__ __forceinline__ unsigned xb_ld(unsigned* p)              { return __hip_atomic_load(p, __ATOMIC_RELAXED, __HIP_MEMORY_SCOPE_AGENT); }
__device__ __forceinline__ unsigned xb_add(unsigned* p, unsigned v) { return __hip_atomic_fetch_add(p, v, __ATOMIC_RELAXED, __HIP_MEMORY_SCOPE_AGENT); }
__device__ __forceinline__ unsigned xb_xcc_id() { return (unsigned)__builtin_amdgcn_s_getreg((3 << 11) | 20) & 0xFu; }
#define XB_SPIN(cond, bar) do { unsigned _sp = 0; while (cond) { __builtin_amdgcn_s_sleep(1); \
    if ((++_sp & 255u) == 0u) { if (xb_ld(&(bar)[XB_TMO])) break; if (_sp > XB_SPIN_CAP) { atomicAdd(&(bar)[XB_TMO], 1u); break; } } } } while (0)

struct XcdBarrier {
    unsigned* bar; unsigned x;
    volatile LAS unsigned* st;
};

__device__ __forceinline__ XcdBarrier xcd_barrier_post(unsigned* bar, volatile LAS unsigned* st) {
    XcdBarrier b; b.bar = bar; b.x = xb_xcc_id(); b.st = st;
    if (threadIdx.x == 0) (void)xb_add(&bar[XB_XCNT(b.x)], 1u);
    return b;
}
__device__ __forceinline__ void xcd_barrier_complete(unsigned* bar, unsigned x, unsigned& nloc, unsigned& nx) {
    const unsigned G = gridDim.x * gridDim.y * gridDim.z;
    unsigned sum, cnt, mine, sp = 0u;
    for (;;) {
        sum = 0u; cnt = 0u; mine = 0u;
#pragma unroll
        for (unsigned j = 0; j < 16; ++j) { const unsigned c = xb_ld(&bar[XB_XCNT(j)]); sum += c; cnt += (c > 0u) ? 1u : 0u; mine = (j == x) ? c : mine; }
        if (sum == G) break;
        __builtin_amdgcn_s_sleep(1);
        if ((++sp & 255u) == 0u) { if (xb_ld(&bar[XB_TMO])) break; if (sp > XB_SPIN_CAP) { atomicAdd(&bar[XB_TMO], 1u); break; } }
    }
    nloc = mine > 0u ? mine : 1u; nx = cnt > 0u ? cnt : 1u;
}

__device__ __forceinline__ void xcd_barrier(const XcdBarrier& b) {
    asm volatile("s_waitcnt vmcnt(0)" ::: "memory");
    __syncthreads();
    if (threadIdx.x == 0) {
        unsigned* bar = b.bar;
        __builtin_amdgcn_s_waitcnt(0);
        unsigned nloc = b.st[0], nx = b.st[1];
        if (nloc == 0u) { xcd_barrier_complete(bar, b.x, nloc, nx); b.st[0] = nloc; b.st[1] = nx; }
        const unsigned old = xb_add(&bar[XB_XSUB(b.x)], 1u);
        const unsigned gen = old / nloc;
        if (old + 1u == (gen + 1u) * nloc) {
            __builtin_amdgcn_fence(__ATOMIC_RELEASE, "agent");
            asm volatile("s_waitcnt vmcnt(0)" ::: "memory");
            const unsigned og = xb_add(&bar[XB_TOP], 1u);
            const unsigned tg = og / nx;
            if (og + 1u == (tg + 1u) * nx) xb_add(&bar[XB_TOPGEN], 1u);
            else XB_SPIN(xb_ld(&bar[XB_TOPGEN]) == tg, bar);
            __builtin_amdgcn_fence(__ATOMIC_ACQUIRE, "agent");
            xb_add(&bar[XB_XGEN(b.x)], 1u);
            asm volatile("s_waitcnt vmcnt(0)" ::: "memory");
        } else {
            XB_SPIN(xb_ld(&bar[XB_XGEN(b.x)]) == gen, bar);
            __builtin_amdgcn_fence(__ATOMIC_ACQUIRE, "agent");
            asm volatile("s_waitcnt vmcnt(0)" ::: "memory");
        }
    }
    __syncthreads();
}

struct Args { const float* in[N_IN]; float* out; unsigned char* ws; int ph_lo, ph_hi; };
constexpr int N_PHASES = 19;

__global__ void __launch_bounds__(NTHR, 2) fwd_kernel(Args args) {
    extern __shared__ __attribute__((aligned(16))) unsigned char lds_raw[];
    cg::grid_group grid = cg::this_grid();
    Ctx F;
    F.lds = (LAS unsigned char*)lds_raw;
    F.tid = threadIdx.x; F.lane = F.tid & 63; F.wave = __builtin_amdgcn_readfirstlane(F.tid >> 6);
    F.G = gridDim.x; F.gw = blockIdx.x * NWAVES + F.wave; F.NGW = F.G * NWAVES;
    F.in = args.in; F.out = args.out; F.ws = args.ws;
    const int lo = args.ph_lo, hi = args.ph_hi;
    volatile LAS unsigned* bst = (volatile LAS unsigned*)(F.lds + LDS_BYTES - 64);
    if (F.tid < 2) bst[F.tid] = 0u;
    __syncthreads();
    const XcdBarrier bar = xcd_barrier_post((unsigned*)(F.ws + WS_CTL) + 4096, bst);
#define IN(k) (lo <= (k) && (k) < hi)
#ifndef TS_A
#define TS_A -1
#define TS_B -1
#define TS_K 0.1
#endif
    unsigned long long* stamps = (unsigned long long*)(F.ws + WS_CTL + 65536);
#define STAMP(k) do { if (TS_A >= 0 && blockIdx.x == 0 && F.tid == 0) stamps[k] = __builtin_amdgcn_s_memrealtime(); } while (0)
#define REP_MASK 0
#ifndef REP_MASK
#define REP_MASK 0
#endif
#define REPS(k) for (int rep_ = 0; rep_ < 1 + ((REP_MASK >> (k)) & 1); ++rep_)
#define SEAM(k) do { if (IN(k) && IN((k) + 1)) { if ((k) == 0) grid.sync(); else xcd_barrier(bar); } } while (0)

    STAMP(0);
    if (IN(0)) REPS(0) { p0_prologue(F); }
    SEAM(0);
    STAMP(1);
    if (IN(1)) REPS(1) { norm_mod_rows(F, F.in[I_X], F.in[I_N1W], 0, DM, (bf16*)(F.ws + WS_XN)); }
    SEAM(1);
    STAMP(2);
    if (IN(2)) REPS(2) {
        pg8::Gemm g{(const pg8::bf16_t*)(F.ws + WS_XN), (const pg8::bf16_t*)(F.ws + WS_WIN), M, INPP, DM};
        pg8::StaticOrder S; S.init(M, INPP, F.G, (int)blockIdx.x);
        pg8::EpiStoreBf16 E{(pg8::bf16_t*)(F.ws + WS_PROJ), INPP};
        pg8::gemm_phase<pg8::EpiStoreBf16, pg8::StaticOrder, true, true>(F.lds, g, S, E);
    }
    SEAM(2);
#ifndef P3REP
#define P3REP 0
#endif
    STAMP(3);
    if (IN(3)) REPS(3) { p3_lora(F); if (P3REP == 1) p3_lora(F); m1_chunk_states(F); if (P3REP == 2) m1_chunk_states(F); }
    SEAM(3);
    STAMP(4);
    if (IN(4)) { m2_prefix(F); ra_part(F, 0, 0); }
    SEAM(4);
    STAMP(5);
    if (IN(5)) { rs_half(F, 0); ra_part(F, 1, 1); }
    SEAM(5);
    STAMP(6);
    if (IN(6)) { rs_half(F, 1); ra_part(F, 2, 1); }
    SEAM(6);
    STAMP(7);
    if (IN(7)) { rs_half(F, 2); ra_part(F, 3, 1); }
    SEAM(7);
    STAMP(8);
    if (IN(8)) { rs_half(F, 3); }
    SEAM(8);
    STAMP(9);
    if (IN(9)) REPS(9) { m3_outputs(F); }
    SEAM(9);
    STAMP(10);
    if (IN(10)) { p5_post(F); }
    SEAM(10);
    STAMP(11);
    if (IN(11)) REPS(11) {
        pg8::Gemm g{(const pg8::bf16_t*)(F.ws + WS_OY), (const pg8::bf16_t*)(F.ws + WS_WOUT), M, DM, DM};
        pg8::StaticOrder S; S.init(M, DM, F.G, (int)blockIdx.x);
        pg8::EpiResid E{F.in[I_X], (const float*)(F.ws + WS_MOD) + 2 * DM, (pg8::bf16_t*)(F.ws + WS_HB), DM, SEQ, MODW};
        pg8::gemm_phase<pg8::EpiResid, pg8::StaticOrder, true, true>(F.lds, g, S, E);
    }
    SEAM(11);
    STAMP(12);
    if (IN(12)) REPS(12) { norm_mod_rows_bf16(F, (const bf16*)(F.ws + WS_HB), F.in[I_N2W], 3 * DM, 4 * DM, (bf16*)(F.ws + WS_XN)); }
    SEAM(12);
    STAMP(13);
    if (IN(13)) REPS(13) {
        pg8::Gemm g{(const pg8::bf16_t*)(F.ws + WS_XN), (const pg8::bf16_t*)(F.ws + WS_WQ), M, DM, DM};
        pg8::StaticOrder S; S.init(M, DM, F.G, (int)blockIdx.x);
        pg8::EpiStoreBf16 E{(pg8::bf16_t*)(F.ws + WS_Q), DM};
        pg8::gemm_phase<pg8::EpiStoreBf16, pg8::StaticOrder, true, true>(F.lds, g, S, E);
    }
    SEAM(13);
    STAMP(14);
    if (IN(14)) REPS(14) { p9_route(F); }
    SEAM(14);
    STAMP(15);
    if (IN(15)) REPS(15) { p10_peer_u(F); }
    SEAM(15);
    STAMP(16);
    if (IN(16)) REPS(16) { p11_peer_coef(F); }
    SEAM(16);
    STAMP(17);
    if (IN(17)) { p12_peer_v(F); }
    SEAM(17);
    STAMP(18);
    if (IN(18)) {
        float oscale = 1.f;
        if (TS_A >= 0) { const volatile unsigned long long* st = stamps; const float frac = (float)(st[TS_B] - st[TS_A]) / (float)(st[17] - st[0]); oscale = 1.f + (float)(TS_K) * frac; }
        final_norm_rows_bf16(F, (const bf16*)(F.ws + WS_HB), F.in[I_FNW], F.out, oscale);
    }
#undef IN
#undef SEAM
}

extern "C" void kernel_launch(void* const* d_in, const int* in_sizes, int n_in, void* d_out, int out_size, void* d_ws, size_t ws_size, hipStream_t stream) {
    static int grid = 0;
    if (grid == 0) {
        if (n_in != N_IN || in_sizes[0] != M * DM || out_size != M * DM || ws_size < WS_END2) {
            fprintf(stderr, "kernel_launch: unexpected shapes: n_in %d in0 %d out %d ws %zu (need %zu)\n", n_in, n_in > 0 ? in_sizes[0] : -1, out_size, ws_size, (size_t)WS_END2); grid = -1; return; }
        int dev = 0, cus = 0, per_cu = 0;
        if (hipGetDevice(&dev) != hipSuccess || hipDeviceGetAttribute(&cus, hipDeviceAttributeMultiprocessorCount, dev) != hipSuccess) { grid = -1; return; }
        if (hipFuncSetAttribute((const void*)fwd_kernel, hipFuncAttributeMaxDynamicSharedMemorySize, LDS_BYTES) != hipSuccess) { fprintf(stderr, "kernel_launch: hipFuncSetAttribute failed\n"); grid = -1; return; }
        if (hipOccupancyMaxActiveBlocksPerMultiprocessor(&per_cu, (const void*)fwd_kernel, NTHR, LDS_BYTES) != hipSuccess || per_cu < 1) { fprintf(stderr, "kernel_launch: occupancy query says %d blocks per CU\n", per_cu); per_cu = 1; }
        (void)hipGetLastError();
        grid = cus;
        fprintf(stderr, "kernel_launch: cus %d per_cu %d grid %d ws %zu\n", cus, per_cu, grid, ws_size);
    }
    if (grid < 0) return;
    (void)hipMemsetAsync((char*)d_ws + WS_CTL, 0, CTL_ZERO_BYTES, stream);
    Args a{};
    for (int i = 0; i < N_IN; ++i) a.in[i] = (const float*)d_in[i];
    a.out = (float*)d_out; a.ws = (unsigned char*)d_ws; a.ph_lo = 0; a.ph_hi = N_PHASES;
    void* kargs[] = {&a};
#ifndef NPASS
#define NPASS 1
#endif
    hipError_t e = hipSuccess;
    for (int pass_ = 0; pass_ < NPASS; ++pass_) {
        if (pass_ > 0) (void)hipMemsetAsync((char*)d_ws + WS_CTL, 0, CTL_ZERO_BYTES, stream);
        e = hipLaunchCooperativeKernel((const void*)fwd_kernel, dim3(grid), dim3(NTHR), kargs, LDS_BYTES, stream);
    }
    if (e != hipSuccess) fprintf(stderr, "kernel_launch: cooperative launch failed: %s (grid %d)\n", hipGetErrorString(e), grid);
}
```

```cpp
#include <hip/hip_runtime.h>
#include <hip/hip_cooperative_groups.h>
#include <cstdio>
#include <cstdint>
namespace cg = cooperative_groups;
namespace pg8 {
#define PG8_LAS __attribute__((address_space(3)))
typedef unsigned short bf16_t;
typedef short bf16x8 __attribute__((ext_vector_type(8)));
typedef float f32x4 __attribute__((ext_vector_type(4)));
typedef unsigned u32x4 __attribute__((ext_vector_type(4)));
constexpr int BM = 256, BK = 64, HALF = 128, HTB = HALF * BK * 2  , STAGE_BYTES = 8 * HTB, NXCD = 8, WGM = 8;

__host__ __device__ __forceinline__ int lds_byte(int r, int c) { const int st = (r >> 4) * 2 + (c >> 5), rr = r & 15, cc = c & 31, ob = rr * 64 + cc * 2; return st * 1024 + (ob ^ (((ob >> 9) & 1) << 5)); }
__host__ __device__ __forceinline__ void stage_rc(int b, int& R, int& C) { const int st = b / 1024, sb = b % 1024, swz = sb ^ (((sb >> 9) & 1) << 5); R = (st >> 1) * 16 + swz / 64; C = (st & 1) * 32 + (swz % 64) / 2; }
__host__ __device__ __forceinline__ int perm32(int rho) { const int n = rho >> 4, i = rho & 15; return 8 * (i >> 2) + 4 * n + (i & 3); }

struct Unit { int pm, pn; };
struct Gemm { const bf16_t* A; const bf16_t* Bt; int M, N, K; };

struct StaticOrder {
    int nM, nN, nwg, G, c;
    __host__ __device__ void init(int M, int N, int G_, int c_) { nM = M / BM; nN = N / BM; nwg = nM * nN; G = G_; c = c_; }
    __host__ __device__ bool next(int i, Unit& u) const {
        const long L = (long)i * G + c; if (L >= nwg) return false;
        int wgid = (int)L; { const int q = nwg / NXCD, r = nwg % NXCD, xcd = wgid % NXCD, off = wgid / NXCD; wgid = (xcd < r ? xcd * (q + 1) : r * (q + 1) + (xcd - r) * q) + off; }
        const int nig = WGM * nN, gid = wgid / nig, fm = gid * WGM, gsz = (nM - fm) < WGM ? (nM - fm) : WGM;
        u.pm = fm + ((wgid % nig) % gsz); u.pn = (wgid % nig) / gsz; return true;
    }
    __device__ __forceinline__ void a_ready(const Unit&) const {}
    __device__ __forceinline__ void done(const Unit&) const {}
};
__device__ __forceinline__ unsigned cvt_pk_bf16(float lo, float hi) { unsigned r; asm volatile("v_cvt_pk_bf16_f32 %0, %1, %2" : "=v"(r) : "v"(lo), "v"(hi)); return r; }
struct EpiStoreBf16 {
    static constexpr bool PERM = true, AFTER_DRAIN = false;
    bf16_t* O; int ldc;
    __device__ __forceinline__ void operator()(const f32x4 (&acc)[2][2][4][2], const Unit& u, int wr, int wc, int fr, int fq) const {
        const int row0 = u.pm * BM + wr * 64 + fr; const int col0 = u.pn * BM + wc * 32 + 8 * fq;
#pragma unroll
        for (int ai = 0; ai < 2; ++ai)
#pragma unroll
            for (int m = 0; m < 4; ++m) { bf16_t* rowp = O + (size_t)(row0 + ai * HALF + m * 16) * ldc + col0;
#pragma unroll
                for (int bj = 0; bj < 2; ++bj) { const f32x4 v0 = acc[ai][bj][m][0], v1 = acc[ai][bj][m][1];
                    u32x4 w; w.x = cvt_pk_bf16(v0[0], v0[1]); w.y = cvt_pk_bf16(v0[2], v0[3]); w.z = cvt_pk_bf16(v1[0], v1[1]); w.w = cvt_pk_bf16(v1[2], v1[3]);
                    *(u32x4*)(rowp + bj * HALF) = w; } }
    }
};
struct EpiResid {
    static constexpr bool PERM = true, AFTER_DRAIN = false;
    const float* X; const float* gate; bf16_t* O; int ldc; int rows_per_batch; int gstride;
    __device__ __forceinline__ void operator()(const f32x4 (&acc)[2][2][4][2], const Unit& u, int wr, int wc, int fr, int fq) const {
        const int row0 = u.pm * BM + wr * 64 + fr; const int col0 = u.pn * BM + wc * 32 + 8 * fq;
        const float* g = gate + (size_t)((u.pm * BM) / rows_per_batch) * gstride + col0;
        f32x4 gv[2][2];
#pragma unroll
        for (int bj = 0; bj < 2; ++bj)
#pragma unroll
            for (int n = 0; n < 2; ++n) gv[bj][n] = *(const f32x4*)(g + bj * HALF + 4 * n);
#pragma unroll
        for (int ai = 0; ai < 2; ++ai)
#pragma unroll
            for (int m = 0; m < 4; ++m) { const size_t off = (size_t)(row0 + ai * HALF + m * 16) * ldc + col0;
#pragma unroll
                for (int bj = 0; bj < 2; ++bj) { const f32x4 x0 = *(const f32x4*)(X + off + bj * HALF), x1 = *(const f32x4*)(X + off + bj * HALF + 4);
                    const f32x4 v0 = x0 + gv[bj][0] * acc[ai][bj][m][0], v1 = x1 + gv[bj][1] * acc[ai][bj][m][1];
                    u32x4 w; w.x = cvt_pk_bf16(v0[0], v0[1]); w.y = cvt_pk_bf16(v0[2], v0[3]); w.z = cvt_pk_bf16(v1[0], v1[1]); w.w = cvt_pk_bf16(v1[2], v1[3]);
                    *(u32x4*)(O + off + bj * HALF) = w; } }
    }
};
template <class Epi, class Sched, bool ALIGN_EPI = false, bool SP2 = false>
__device__ __forceinline__ void gemm_phase(PG8_LAS unsigned char* lds, const Gemm g, const Sched& S, const Epi& E) {
    const int tid = threadIdx.x, wid = __builtin_amdgcn_readfirstlane(tid >> 6), lane = tid & 63, wr = wid >> 2, wc = wid & 3, fr = lane & 15, fq = lane >> 4;
    const int K = g.K, nt = K / BK;
    unsigned voffA[2], voffB[2];
#pragma unroll
    for (int i = 0; i < 2; ++i) { int R, C; stage_rc(tid * 16 + i * 8192, R, C); const int Rb = Epi::PERM ? ((R & ~31) + perm32(R & 31)) : R;
        voffA[i] = (unsigned)(R * K + C) * 2u; voffB[i] = (unsigned)(Rb * K + C) * 2u; }
    const size_t kstep = (size_t)(BK * 2);
    const size_t hstep = (size_t)HALF * K * 2;
    const size_t tstep = 2 * hstep;
    const unsigned ldsw = (unsigned)wid * 1024u;
    const int aoff = lds_byte(wr * 64 + fr, fq * 8), boff = lds_byte(wc * 32 + fr, fq * 8);
#define PG8_SA(b, h) (((b) * 2 + (h)) * HTB)
#define PG8_SB(b, h) ((4 + (b) * 2 + (h)) * HTB)
#define PG8_STAGE(bufoff, gbase, voff) do { _Pragma("unroll") for (int _i = 0; _i < 2; ++_i) \
        __builtin_amdgcn_global_load_lds((const unsigned*)((const char*)(gbase) + (voff)[_i]), (PG8_LAS unsigned*)(lds + (bufoff) + ldsw + _i * 8192), 16, 0, 0); } while (0)
#define PG8_LDA(dst, b, h) do { _Pragma("unroll") for (int m = 0; m < 4; ++m) _Pragma("unroll") for (int k = 0; k < 2; ++k) dst[m][k] = *(const PG8_LAS bf16x8*)(lds + PG8_SA(b, h) + aoff + m * 2048 + k * 1024); } while (0)
#define PG8_LDB(dst, b, h) do { _Pragma("unroll") for (int n = 0; n < 2; ++n) _Pragma("unroll") for (int k = 0; k < 2; ++k) dst[n][k] = *(const PG8_LAS bf16x8*)(lds + PG8_SB(b, h) + boff + n * 2048 + k * 1024); } while (0)
#define PG8_MMA(ai, bj, At, Bt) do { __builtin_amdgcn_s_setprio(1); _Pragma("unroll") for (int m = 0; m < 4; ++m) _Pragma("unroll") for (int n = 0; n < 2; ++n) _Pragma("unroll") for (int k = 0; k < 2; ++k) \
        acc[ai][bj][m][n] = __builtin_amdgcn_mfma_f32_16x16x32_bf16(Bt[n][k], At[m][k], acc[ai][bj][m][n], 0, 0, 0); __builtin_amdgcn_s_setprio(0); } while (0)
#define PG8_WAIT_V(n) asm volatile("s_waitcnt vmcnt(" #n ")" ::: "memory")
#define PG8_WAIT_L(n) asm volatile("s_waitcnt lgkmcnt(" #n ")" ::: "memory")
#define PG8_BAR __builtin_amdgcn_s_barrier()
#define PG8_SCHED __builtin_amdgcn_sched_barrier(0)
    Unit cur, nxt; int ui = 0;
    if (!S.next(0, cur)) return;
    f32x4 acc[2][2][4][2];
#pragma unroll
    for (int a = 0; a < 2; ++a)
#pragma unroll
        for (int b = 0; b < 2; ++b)
#pragma unroll
            for (int m = 0; m < 4; ++m)
#pragma unroll
                for (int n = 0; n < 2; ++n) acc[a][b][m][n] = (f32x4){0.f, 0.f, 0.f, 0.f};
    bf16x8 At[4][2], B0[2][2], B1[2][2];
    const char* cA = (const char*)g.A + (size_t)cur.pm * tstep; const char* cB = (const char*)g.Bt + (size_t)cur.pn * tstep;
    S.a_ready(cur);
    if constexpr (SP2) {
        PG8_STAGE(PG8_SB(0, 0), cB, voffB); PG8_STAGE(PG8_SB(0, 1), cB + hstep, voffB); PG8_STAGE(PG8_SA(0, 0), cA, voffA); PG8_STAGE(PG8_SA(0, 1), cA + hstep, voffA);
        if (wr == 1) PG8_BAR;
        PG8_WAIT_V(2); PG8_BAR;
        PG8_STAGE(PG8_SB(1, 0), cB + kstep, voffB); PG8_STAGE(PG8_SA(1, 0), cA + kstep, voffA); PG8_STAGE(PG8_SB(1, 1), cB + hstep + kstep, voffB);
        PG8_WAIT_V(6); PG8_BAR;
    } else {
        PG8_STAGE(PG8_SB(0, 0), cB, voffB); PG8_STAGE(PG8_SA(0, 0), cA, voffA); PG8_STAGE(PG8_SB(0, 1), cB + hstep, voffB); PG8_STAGE(PG8_SA(0, 1), cA + hstep, voffA);
        if (wr == 1) PG8_BAR;
        PG8_WAIT_V(4); PG8_BAR;
        PG8_STAGE(PG8_SB(1, 0), cB + kstep, voffB); PG8_STAGE(PG8_SA(1, 0), cA + kstep, voffA); PG8_STAGE(PG8_SB(1, 1), cB + hstep + kstep, voffB);
        PG8_WAIT_V(6); PG8_BAR;
    }
    for (;;) {
        const bool has_next = S.next(ui + 1, nxt);
        const char* nA = has_next ? (const char*)g.A + (size_t)nxt.pm * tstep : cA; const char* nB = has_next ? (const char*)g.Bt + (size_t)nxt.pn * tstep : cB;
        for (int t = 0; t < nt; t += 2) {
            const bool last = (t == nt - 2);
            const char* a1 = cA + (size_t)(t + 1) * kstep;
            const char* a2 = last ? nA : cA + (size_t)(t + 2) * kstep; const char* b2 = last ? nB : cB + (size_t)(t + 2) * kstep;
            const char* a3 = a2 + kstep; const char* b3 = b2 + kstep;
            if (last && has_next) S.a_ready(nxt);
            if constexpr (SP2) {
            PG8_LDB(B0, 0, 0); PG8_LDB(B1, 0, 1); PG8_SCHED; PG8_LDA(At, 0, 0); PG8_STAGE(PG8_SA(1, 1), a1 + hstep, voffA);
            PG8_WAIT_V(8); PG8_WAIT_L(0); PG8_BAR; PG8_MMA(0, 0, At, B0); PG8_MMA(0, 1, At, B1); PG8_BAR; PG8_SCHED;
            PG8_LDA(At, 0, 1); PG8_STAGE(PG8_SB(0, 0), b2, voffB); PG8_STAGE(PG8_SB(0, 1), b2 + hstep, voffB); PG8_STAGE(PG8_SA(0, 0), a2, voffA);
            PG8_WAIT_V(8); PG8_WAIT_L(0); PG8_BAR; PG8_MMA(1, 0, At, B0); PG8_MMA(1, 1, At, B1); PG8_BAR; PG8_SCHED;
            PG8_LDB(B0, 1, 0); PG8_LDB(B1, 1, 1); PG8_SCHED; PG8_LDA(At, 1, 0); PG8_STAGE(PG8_SA(0, 1), a2 + hstep, voffA);
            PG8_WAIT_V(8); PG8_WAIT_L(0); PG8_BAR; PG8_MMA(0, 0, At, B0); PG8_MMA(0, 1, At, B1); PG8_BAR; PG8_SCHED;
            PG8_LDA(At, 1, 1); PG8_STAGE(PG8_SB(1, 0), b3, voffB); PG8_STAGE(PG8_SB(1, 1), b3 + hstep, voffB); PG8_STAGE(PG8_SA(1, 0), a3, voffA);
            PG8_WAIT_V(8); PG8_WAIT_L(0); PG8_BAR; PG8_MMA(1, 0, At, B0); PG8_MMA(1, 1, At, B1); PG8_BAR; PG8_SCHED;
            } else {
            PG8_LDB(B0, 0, 0); PG8_SCHED; PG8_LDA(At, 0, 0); PG8_STAGE(PG8_SA(1, 1), a1 + hstep, voffA);
            PG8_WAIT_L(8); PG8_BAR; PG8_WAIT_L(0); PG8_MMA(0, 0, At, B0); PG8_BAR; PG8_SCHED;
            PG8_LDB(B1, 0, 1); PG8_STAGE(PG8_SB(0, 0), b2, voffB);
            PG8_BAR; PG8_WAIT_L(0); PG8_MMA(0, 1, At, B1); PG8_BAR;
            PG8_LDA(At, 0, 1); PG8_STAGE(PG8_SA(0, 0), a2, voffA);
            PG8_BAR; PG8_WAIT_L(0); PG8_MMA(1, 0, At, B0); PG8_BAR; PG8_SCHED;
            PG8_STAGE(PG8_SB(0, 1), b2 + hstep, voffB);
            PG8_WAIT_V(6); PG8_BAR; PG8_MMA(1, 1, At, B1); PG8_BAR;
            PG8_LDB(B0, 1, 0); PG8_SCHED; PG8_LDA(At, 1, 0); PG8_STAGE(PG8_SA(0, 1), a2 + hstep, voffA);
            PG8_WAIT_L(8); PG8_BAR; PG8_WAIT_L(0); PG8_MMA(0, 0, At, B0); PG8_BAR; PG8_SCHED;
            PG8_LDB(B1, 1, 1); PG8_STAGE(PG8_SB(1, 0), b3, voffB);
            PG8_BAR; PG8_WAIT_L(0); PG8_MMA(0, 1, At, B1); PG8_BAR;
            PG8_LDA(At, 1, 1); PG8_STAGE(PG8_SA(1, 0), a3, voffA);
            PG8_BAR; PG8_WAIT_L(0); PG8_MMA(1, 0, At, B0); PG8_BAR; PG8_SCHED;
            PG8_STAGE(PG8_SB(1, 1), b3 + hstep, voffB);
            PG8_WAIT_V(6); PG8_BAR; PG8_MMA(1, 1, At, B1); PG8_BAR;
            }
        }
        if constexpr (ALIGN_EPI) { if (wr == 0) PG8_BAR; }
        if constexpr (!Epi::AFTER_DRAIN) { E(acc, cur, wr, wc, fr, fq); S.done(cur); }
        if (!has_next) break;
#pragma unroll
        for (int a = 0; a < 2; ++a)
#pragma unroll
            for (int b = 0; b < 2; ++b)
#pragma unroll
                for (int m = 0; m < 4; ++m)
#pragma unroll
                    for (int n = 0; n < 2; ++n) acc[a][b][m][n] = (f32x4){0.f, 0.f, 0.f, 0.f};
        cur = nxt; cA = nA; cB = nB; ++ui;
        if constexpr (ALIGN_EPI) { if (wr == 1) PG8_BAR; }
    }
    PG8_WAIT_V(0);
    if constexpr (!ALIGN_EPI) { if (wr == 0) PG8_BAR; }
    PG8_BAR;
    if constexpr (Epi::AFTER_DRAIN) { E.fused(acc, cur, wr, wc, fr, fq, lds, wid, lane); S.done(cur); }
#undef PG8_SA
#undef PG8_SB
#undef PG8_STAGE
#undef PG8_LDA
#undef PG8_LDB
#undef PG8_MMA
#undef PG8_WAIT_V
#undef PG8_WAIT_L
#undef PG8_BAR
#undef PG8_SCHED
}
}
#define GAS __attribute__((address_space(1)))
#define LAS __attribute__((address_space(3)))
typedef unsigned short bf16;
typedef unsigned v4u __attribute__((ext_vector_type(4)));
typedef unsigned v2u __attribute__((ext_vector_type(2)));
typedef float f32x4 __attribute__((ext_vector_type(4)));
typedef float f32x2 __attribute__((ext_vector_type(2)));
typedef short bf16x8 __attribute__((ext_vector_type(8)));
typedef __bf16 bf16x2_t __attribute__((ext_vector_type(2)));

constexpr int NWAVES = 8, NTHR = 512;
constexpr int DM = 2048, NB = 4, SEQ = 8192, M = NB * SEQ;
constexpr int RW = 1024, RHEADS = 16, HD = 64;
constexpr int L_W = 64, L_A = 64, L_G = 160;
constexpr int INP = 5936, INPP = 6144;
constexpr int C_R = 0, C_K = 1024, C_V = 2048, C_WD = 3072, C_AD = 3136, C_GD = 3200, C_Z = 3360, C_XBC = 4384, C_DT = 5920;
constexpr int MODW = 6 * DM;
constexpr int NEXP = 16384;
constexpr float RMS_EPS = 1e-6f;

enum { I_X = 0, I_C, I_ADAW, I_ADAB, I_N1W, I_WIN, I_MU, I_W0, I_WUP, I_A0, I_AUP, I_GUP, I_KK, I_KA, I_RK, I_LNW, I_LNB,
       I_CONVW, I_CONVB, I_DTB, I_ALOG, I_DSK, I_MNW, I_WOUT, I_N2W, I_WQ, I_KEYS, I_PU, I_PV, I_FNW, N_IN };

constexpr size_t MiB = 1u << 20;
constexpr size_t WS_CTL = 0, CTL_ZERO_BYTES = 1 * MiB;
constexpr size_t WS_MOD = 1 * MiB;
constexpr size_t WS_WIN = 2 * MiB, WS_WOUT = 26 * MiB, WS_WQ = 34 * MiB, WS_KEYS = 42 * MiB;
constexpr size_t WS_WUPT = 43 * MiB, WS_AUPT = 43 * MiB + 256 * 1024, WS_GUPT = 43 * MiB + 512 * 1024;
constexpr size_t WS_PU8 = 44 * MiB, WS_PV8 = 76 * MiB;
constexpr size_t WS_USC = 108 * MiB, WS_VSC = 108 * MiB + 65536;
constexpr size_t WS_XN = 172 * MiB;
constexpr size_t WS_LW = WS_XN, WS_AA = WS_XN + 64 * MiB;
constexpr size_t WS_PROJ = 300 * MiB;
constexpr size_t WS_Q = WS_PROJ;
constexpr size_t WS_GG = 684 * MiB;
constexpr size_t WS_PD = WS_PROJ + 128 * MiB;
constexpr size_t WS_RTE = 684 * MiB, WS_RTG = 700 * MiB, WS_COEF = 716 * MiB;
constexpr size_t WS_OY = 748 * MiB;
constexpr size_t WS_END = 876 * MiB;
constexpr size_t WS_HB = 876 * MiB;

constexpr int RING_BYTES = 131072, LDS_BYTES = 147456;

#define LDS_WAIT() asm volatile("s_waitcnt lgkmcnt(0)" ::: "memory")
#define VM_WAIT() asm volatile("s_waitcnt vmcnt(0)" ::: "memory")
__device__ __forceinline__ unsigned pk2(float lo, float hi) { f32x2 v = {lo, hi}; bf16x2_t b = __builtin_convertvector(v, bf16x2_t); return __builtin_bit_cast(unsigned, b); }
__device__ __forceinline__ float bflo(unsigned u) { return __uint_as_float(u << 16); }
__device__ __forceinline__ float bfhi(unsigned u) { return __uint_as_float(u & 0xffff0000u); }
__device__ __forceinline__ float bf1(bf16 h) { return __uint_as_float((unsigned)h << 16); }
__device__ __forceinline__ float wave_sum(float v) {
#pragma unroll
    for (int o = 1; o < 64; o <<= 1) v += __shfl_xor(v, o);
    return v;
}
__device__ __forceinline__ float rcp_f(float v) { return __builtin_amdgcn_rcpf(v); }
template <int CTRL> __device__ __forceinline__ float dppc_f(float x) { return __builtin_bit_cast(float, __builtin_amdgcn_mov_dpp(__builtin_bit_cast(int, x), CTRL, 0xf, 0xf, true)); }
__device__ __forceinline__ float wave_sum_fast(float x) {
    x += dppc_f<0xB1>(x); x += dppc_f<0x4E>(x); x += dppc_f<0x124>(x); x += dppc_f<0x128>(x);
    { auto rr = __builtin_amdgcn_permlane16_swap(__float_as_uint(x), __float_as_uint(x), false, false); x = __uint_as_float(rr[0]) + __uint_as_float(rr[1]); }
    { auto rr = __builtin_amdgcn_permlane32_swap(__float_as_uint(x), __float_as_uint(x), false, false); x = __uint_as_float(rr[0]) + __uint_as_float(rr[1]); }
    return x;
}
__device__ __forceinline__ float silu_f(float v) { return v * rcp_f(1.f + __expf(-v)); }
__device__ __forceinline__ float sigmoid_f(float v) { return rcp_f(1.f + __expf(-v)); }

struct Ctx {
    LAS unsigned char* lds;
    int tid, lane, wave, G, gw, NGW;
    const float* const* in;
    float* out; unsigned char* ws;
};

__device__ __forceinline__ void transpose_item(const float* W, int K, int N, bf16* WT, int ldt, int nrows_out, LAS float* scr, int kb, int nb, int lane) {
    const int k0 = 64 * kb, n0 = 64 * nb;
    const int c4 = 4 * (lane & 15), rr = lane >> 4;
    const bool vec_ok = ((N & 3) == 0) && (n0 + 64 <= N);
#pragma unroll 4
    for (int i = 0; i < 16; ++i) { const int kk = 4 * i + rr, k = k0 + kk;
        f32x4 v = {0.f, 0.f, 0.f, 0.f};
        if (k < K) { const float* src = W + (size_t)k * N + n0 + c4;
            if (vec_ok) v = *(const f32x4*)src;
            else { if (n0 + c4 + 0 < N) v.x = src[0]; if (n0 + c4 + 1 < N) v.y = src[1]; if (n0 + c4 + 2 < N) v.z = src[2]; if (n0 + c4 + 3 < N) v.w = src[3]; } }
        LAS float* d = scr + kk * 65 + c4; d[0] = v.x; d[1] = v.y; d[2] = v.z; d[3] = v.w; }
    LDS_WAIT(); asm volatile("" ::: "memory");
    const int c = lane & 7;
#pragma unroll
    for (int j = 0; j < 8; ++j) { const int n = (lane >> 3) + 8 * j; const LAS float* sp = scr + (8 * c) * 65 + n;
        v4u o; o.x = pk2(sp[0 * 65], sp[1 * 65]); o.y = pk2(sp[2 * 65], sp[3 * 65]); o.z = pk2(sp[4 * 65], sp[5 * 65]); o.w = pk2(sp[6 * 65], sp[7 * 65]);
        if (n0 + n < nrows_out && k0 + 8 * c + 8 <= ldt) *(v4u*)(WT + (size_t)(n0 + n) * ldt + k0 + 8 * c) = o; }
    LDS_WAIT(); asm volatile("" ::: "memory");
}
__device__ __forceinline__ void transpose_all(const float* W, int K, int N, bf16* WT, int ldt, int nrows_out, LAS float* scr, int gw, int NGW, int lane) {
    const int nkb = (K + 63) / 64, nnb = nrows_out / 64, nit = nkb * nnb;
    for (int it = gw; it < nit; it += NGW) transpose_item(W, K, N, WT, ldt, nrows_out, scr, it / nnb, it % nnb, lane);
}
__device__ __forceinline__ void convert_all(const float* src, bf16* dst, size_t n8, int gw, int NGW, int lane) {
    const f32x4* s4 = (const f32x4*)src; v4u* d4 = (v4u*)dst;
    for (size_t i = (size_t)gw * 64 + lane; i < n8; i += (size_t)NGW * 64) {
        const f32x4 a = __builtin_nontemporal_load(s4 + 2 * i), b = __builtin_nontemporal_load(s4 + 2 * i + 1);
        v4u o; o.x = pk2(a.x, a.y); o.y = pk2(a.z, a.w); o.z = pk2(b.x, b.y); o.w = pk2(b.z, b.w);
        d4[i] = o; }
}
__device__ __forceinline__ void quantize_rows_fp8(const float* src, unsigned char* dst8, float* scales, int e0, int e1, int step, int lane) {
    if (e0 >= e1) return;
    f32x4 vn[8];
    { const f32x4* s4 = (const f32x4*)(src + (size_t)e0 * DM) + lane;
#pragma unroll
      for (int i = 0; i < 8; ++i) vn[i] = __builtin_nontemporal_load(s4 + 64 * i); }
    for (int e = e0; e < e1; e += step) {
        f32x4 v[8];
#pragma unroll
        for (int i = 0; i < 8; ++i) v[i] = vn[i];
        { const int en = (e + step < e1) ? e + step : e; const f32x4* s4 = (const f32x4*)(src + (size_t)en * DM) + lane;
#pragma unroll
          for (int i = 0; i < 8; ++i) vn[i] = __builtin_nontemporal_load(s4 + 64 * i); }
        float am = 0.f;
#pragma unroll
        for (int i = 0; i < 8; ++i) am = fmaxf(fmaxf(am, fmaxf(fabsf(v[i].x), fabsf(v[i].y))), fmaxf(fabsf(v[i].z), fabsf(v[i].w)));
#pragma unroll
        for (int o = 1; o < 64; o <<= 1) am = fmaxf(am, __shfl_xor(am, o));
        am = fmaxf(am, 1e-30f);
        const float inv = 440.f / am;
#pragma unroll
        for (int i = 0; i < 8; ++i) { int w = __builtin_amdgcn_cvt_pk_fp8_f32(v[i].x * inv, v[i].y * inv, 0, false); w = __builtin_amdgcn_cvt_pk_fp8_f32(v[i].z * inv, v[i].w * inv, w, true);
            const int seg = 2 * i + (lane >> 5);
            *(int*)(dst8 + (size_t)seg * ((size_t)NEXP * 128) + (size_t)e * 128 + 4 * (lane & 31)) = w; }
        if (lane == 0) scales[e] = am * (1.f / 440.f);
    }
}
__device__ __forceinline__ void quantize_rows_fp4(const float* src, unsigned char* dst4, float* scales, int e0, int e1, int step, int lane) {
    if (e0 >= e1) return;
    f32x4 vn[8];
    { const f32x4* s4 = (const f32x4*)(src + (size_t)e0 * DM) + lane;
#pragma unroll
      for (int i = 0; i < 8; ++i) vn[i] = __builtin_nontemporal_load(s4 + 64 * i); }
    for (int e = e0; e < e1; e += step) {
        f32x4 v[8];
#pragma unroll
        for (int i = 0; i < 8; ++i) v[i] = vn[i];
        { const int en = (e + step < e1) ? e + step : e; const f32x4* s4 = (const f32x4*)(src + (size_t)en * DM) + lane;
#pragma unroll
          for (int i = 0; i < 8; ++i) vn[i] = __builtin_nontemporal_load(s4 + 64 * i); }
        float am = 0.f;
#pragma unroll
        for (int i = 0; i < 8; ++i) am = fmaxf(am, fmaxf(fmaxf(fabsf(v[i].x), fabsf(v[i].y)), fmaxf(fabsf(v[i].z), fabsf(v[i].w))));
#pragma unroll
        for (int o = 1; o < 64; o <<= 1) am = fmaxf(am, __shfl_xor(am, o));
        am = fmaxf(am, 1e-30f);
        const float inv = 6.f / am;
#pragma unroll
        for (int i = 0; i < 8; ++i) {
            unsigned w = __builtin_amdgcn_cvt_scalef32_pk_fp4_f32(0u, v[i].x * inv, v[i].y * inv, 1.0f, 0);
            w = __builtin_amdgcn_cvt_scalef32_pk_fp4_f32(w, v[i].z * inv, v[i].w * inv, 1.0f, 1);
            *(unsigned short*)(dst4 + (size_t)i * ((size_t)NEXP * 128) + (size_t)e * 128 + 2 * lane) = (unsigned short)w;
        }
        if (lane == 0) scales[e] = am * (1.f / 6.f);
    }
}
__device__ __forceinline__ void p0_prologue(const Ctx& F) {
    __syncthreads();
    if (blockIdx.x < MODW / 64) {
        LAS float* sc = (LAS float*)F.lds;
        LAS float* red = sc + NB * DM;
        const float* c = F.in[I_C];
        for (int i = F.tid; i < NB * DM; i += NTHR) sc[i] = silu_f(c[i]);
        __syncthreads();
        const int j = blockIdx.x * 64 + F.lane;
        const float* wp = F.in[I_ADAW] + (size_t)(F.wave * 256) * MODW + j;
        float a0 = 0.f, a1 = 0.f, a2 = 0.f, a3 = 0.f;
#pragma unroll 32
        for (int kk = 0; kk < 256; ++kk) { const float w = wp[(size_t)kk * MODW]; const int k = F.wave * 256 + kk;
            a0 += sc[k] * w; a1 += sc[DM + k] * w; a2 += sc[2 * DM + k] * w; a3 += sc[3 * DM + k] * w; }
        red[(F.wave * 4 + 0) * 64 + F.lane] = a0; red[(F.wave * 4 + 1) * 64 + F.lane] = a1; red[(F.wave * 4 + 2) * 64 + F.lane] = a2; red[(F.wave * 4 + 3) * 64 + F.lane] = a3;
        __syncthreads();
        if (F.tid < 256) { const int b = F.tid >> 6, l = F.tid & 63; float s = F.in[I_ADAB][blockIdx.x * 64 + l];
#pragma unroll
            for (int w = 0; w < 8; ++w) s += red[(w * 4 + b) * 64 + l];
            ((float*)(F.ws + WS_MOD))[b * MODW + blockIdx.x * 64 + l] = s; }
        __syncthreads();
    }
    LAS float* scr = (LAS float*)(F.lds + F.wave * 16640);
    transpose_all(F.in[I_WIN], DM, INP, (bf16*)(F.ws + WS_WIN), DM, INPP, scr, F.gw, F.NGW, F.lane);
    transpose_all(F.in[I_WOUT], DM, DM, (bf16*)(F.ws + WS_WOUT), DM, DM, scr, F.gw, F.NGW, F.lane);
    transpose_all(F.in[I_WQ], DM, DM, (bf16*)(F.ws + WS_WQ), DM, DM, scr, F.gw, F.NGW, F.lane);
    transpose_all(F.in[I_WUP], L_W, RW, (bf16*)(F.ws + WS_WUPT), L_W, RW, scr, F.gw, F.NGW, F.lane);
    transpose_all(F.in[I_AUP], L_A, RW, (bf16*)(F.ws + WS_AUPT), L_A, RW, scr, F.gw, F.NGW, F.lane);
    transpose_all(F.in[I_GUP], L_G, RW, (bf16*)(F.ws + WS_GUPT), L_G, RW, scr, F.gw, F.NGW, F.lane);
    convert_all(F.in[I_KEYS], (bf16*)(F.ws + WS_KEYS), (size_t)16 * 128 * 128 / 8, F.gw, F.NGW, F.lane);
    {
        const int nlo = (F.G < 192) ? F.G : 192, nhi = F.G - nlo;
        const int wtot = 5 * nlo + 8 * nhi;
        const int wb0 = (blockIdx.x < nlo) ? 5 * blockIdx.x : 5 * nlo + 8 * (blockIdx.x - nlo), wb1 = wb0 + ((blockIdx.x < nlo) ? 5 : 8);
        const int r0 = (int)((long)(2 * NEXP) * wb0 / wtot), r1 = (int)((long)(2 * NEXP) * wb1 / wtot);
        const int a0 = r0 < NEXP ? r0 : NEXP, a1 = r1 < NEXP ? r1 : NEXP;
        quantize_rows_fp8(F.in[I_PU], F.ws + WS_PU8, (float*)(F.ws + WS_USC), a0 + F.wave, a1, NWAVES, F.lane);
        const int b0 = (r0 > NEXP ? r0 : NEXP) - NEXP, b1 = (r1 > NEXP ? r1 : NEXP) - NEXP;
        quantize_rows_fp4(F.in[I_PV], F.ws + WS_PV8, (float*)(F.ws + WS_VSC), b0 + F.wave, b1, NWAVES, F.lane);
    }
}

__device__ __forceinline__ void norm_mod_rows(const Ctx& F, const float* X, const float* nw, int shift_off, int scale_off, bf16* XN) {
    const float* mod = (const float*)(F.ws + WS_MOD);
    if (F.gw >= M) return;
    f32x4 vn[8];
    { const f32x4* xr = (const f32x4*)(X + (size_t)F.gw * DM) + F.lane;
#pragma unroll
      for (int j = 0; j < 8; ++j) vn[j] = xr[64 * j]; }
    for (int m = F.gw; m < M; m += F.NGW) {
        const int b = m / SEQ;
        f32x4 v[8]; float s = 0.f;
#pragma unroll
        for (int j = 0; j < 8; ++j) { v[j] = vn[j]; s += (v[j].x * v[j].x + v[j].y * v[j].y) + (v[j].z * v[j].z + v[j].w * v[j].w); }
        { const int mn = (m + F.NGW < M) ? m + F.NGW : m; const f32x4* xr = (const f32x4*)(X + (size_t)mn * DM) + F.lane;
#pragma unroll
          for (int j = 0; j < 8; ++j) vn[j] = xr[64 * j]; }
        const float rstd = rsqrtf(wave_sum_fast(s) * (1.f / DM) + RMS_EPS);
        const f32x4* wp = (const f32x4*)nw + F.lane;
        const f32x4* shp = (const f32x4*)(mod + (size_t)b * MODW + shift_off) + F.lane;
        const f32x4* scp = (const f32x4*)(mod + (size_t)b * MODW + scale_off) + F.lane;
        v2u* o = (v2u*)(XN + (size_t)m * DM) + F.lane;
#pragma unroll
        for (int j = 0; j < 8; ++j) { const f32x4 w = wp[64 * j], a = scp[64 * j], c = shp[64 * j];
            const f32x4 r = (v[j] * rstd) * w * (a + 1.f) + c;
            v2u p; p.x = pk2(r.x, r.y); p.y = pk2(r.z, r.w); o[64 * j] = p; }
    }
}
__device__ __forceinline__ void final_norm_rows(const Ctx& F, const float* H, const float* nw, float* O) {
    for (int m = F.gw; m < M; m += F.NGW) {
        const f32x4* xr = (const f32x4*)(H + (size_t)m * DM) + F.lane;
        f32x4 v[8]; float s = 0.f;
#pragma unroll
        for (int j = 0; j < 8; ++j) { v[j] = xr[64 * j]; s += (v[j].x * v[j].x + v[j].y * v[j].y) + (v[j].z * v[j].z + v[j].w * v[j].w); }
        const float rstd = rsqrtf(wave_sum(s) * (1.f / DM) + RMS_EPS);
        const f32x4* wp = (const f32x4*)nw + F.lane;
        f32x4* o = (f32x4*)(O + (size_t)m * DM) + F.lane;
#pragma unroll
        for (int j = 0; j < 8; ++j) o[64 * j] = (v[j] * rstd) * wp[64 * j];
    }
}


__device__ __forceinline__ void load_row_raw(const bf16* row, int lane, v2u (&u)[8]) {
    const v2u* p = (const v2u*)row + lane;
#pragma unroll
    for (int j = 0; j < 8; ++j) u[j] = p[64 * j];
}
__device__ __forceinline__ void norm_mod_rows_bf16(const Ctx& F, const bf16* X, const float* nw, int shift_off, int scale_off, bf16* XN) {
    const float* mod = (const float*)(F.ws + WS_MOD);
    if (F.gw >= M) return;
    v2u un[8]; load_row_raw(X + (size_t)F.gw * DM, F.lane, un);
    for (int m = F.gw; m < M; m += F.NGW) {
        const int b = m / SEQ;
        f32x4 v[8]; float s = 0.f;
#pragma unroll
        for (int j = 0; j < 8; ++j) { v[j] = (f32x4){bflo(un[j].x), bfhi(un[j].x), bflo(un[j].y), bfhi(un[j].y)}; s += (v[j].x * v[j].x + v[j].y * v[j].y) + (v[j].z * v[j].z + v[j].w * v[j].w); }
        { const int mn = (m + F.NGW < M) ? m + F.NGW : m; load_row_raw(X + (size_t)mn * DM, F.lane, un); }
        const float rstd = rsqrtf(wave_sum_fast(s) * (1.f / DM) + RMS_EPS);
        const f32x4* wp = (const f32x4*)nw + F.lane;
        const f32x4* shp = (const f32x4*)(mod + (size_t)b * MODW + shift_off) + F.lane;
        const f32x4* scp = (const f32x4*)(mod + (size_t)b * MODW + scale_off) + F.lane;
        v2u* o = (v2u*)(XN + (size_t)m * DM) + F.lane;
#pragma unroll
        for (int j = 0; j < 8; ++j) { const f32x4 w = wp[64 * j], a = scp[64 * j], c = shp[64 * j];
            const f32x4 r = (v[j] * rstd) * w * (a + 1.f) + c;
            v2u p; p.x = pk2(r.x, r.y); p.y = pk2(r.z, r.w); o[64 * j] = p; }
    }
}
__device__ __forceinline__ void final_norm_rows_bf16(const Ctx& F, const bf16* H, const float* nw, float* O, float oscale) {
    if (F.gw >= M) return;
    v2u un[8]; load_row_raw(H + (size_t)F.gw * DM, F.lane, un);
    f32x4 wv[8];
#pragma unroll
    for (int j = 0; j < 8; ++j) wv[j] = ((const f32x4*)nw + F.lane)[64 * j];
    for (int m = F.gw; m < M; m += F.NGW) {
        f32x4 v[8]; float s = 0.f;
#pragma unroll
        for (int j = 0; j < 8; ++j) { v[j] = (f32x4){bflo(un[j].x), bfhi(un[j].x), bflo(un[j].y), bfhi(un[j].y)}; s += (v[j].x * v[j].x + v[j].y * v[j].y) + (v[j].z * v[j].z + v[j].w * v[j].w); }
        { const int mn = (m + F.NGW < M) ? m + F.NGW : m; load_row_raw(H + (size_t)mn * DM, F.lane, un); }
        const float rstd = rsqrtf(wave_sum_fast(s) * (1.f / DM) + RMS_EPS) * oscale;
        f32x4* o = (f32x4*)(O + (size_t)m * DM) + F.lane;
#pragma unroll
        for (int j = 0; j < 8; ++j) __builtin_nontemporal_store((v[j] * rstd) * wv[j], o + 64 * j);
    }
}
#define LO2(v) __builtin_shufflevector((v), (v), 0, 1)
#define HI2(v) __builtin_shufflevector((v), (v), 2, 3)
template <int CTRL> __device__ __forceinline__ float dpp_f(float x) { return __builtin_bit_cast(float, __builtin_amdgcn_mov_dpp(__builtin_bit_cast(int, x), CTRL, 0xf, 0xf, true)); }
__device__ __forceinline__ float rowsum16(float x) { x += dpp_f<0xB1>(x); x += dpp_f<0x4E>(x); x += dpp_f<0x124>(x); x += dpp_f<0x128>(x); return x; }
__device__ __forceinline__ float quadsum(float x) { x += dpp_f<0xB1>(x); x += dpp_f<0x4E>(x); return x; }

__device__ __forceinline__ float treduce16(const float (&p)[16], bool b0, bool b1, bool b2, bool b3) {
    float a[8], bq[4], c2[2];
#pragma unroll
    for (int j = 0; j < 8; ++j) { const float mine = b3 ? p[j + 8] : p[j], send = b3 ? p[j] : p[j + 8]; a[j] = mine + dpp_f<0x128>(send); }
#pragma unroll
    for (int j = 0; j < 4; ++j) { const float mine = b2 ? a[j + 4] : a[j], send = b2 ? a[j] : a[j + 4]; const float up = dpp_f<0x104>(send), dn = dpp_f<0x114>(send); bq[j] = mine + (b2 ? dn : up); }
#pragma unroll
    for (int j = 0; j < 2; ++j) { const float mine = b1 ? bq[j + 2] : bq[j], send = b1 ? bq[j] : bq[j + 2]; c2[j] = mine + dpp_f<0x4E>(send); }
    const float mine = b0 ? c2[1] : c2[0], send = b0 ? c2[0] : c2[1];
    return mine + dpp_f<0xB1>(send);
}
__device__ __forceinline__ float wave_sum_dpp(float v) { v = rowsum16(v); v += __shfl_xor(v, 16); v += __shfl_xor(v, 32); return v; }
__device__ __forceinline__ void unpack8(const v4u p, float (&e)[8]) { e[0] = bflo(p.x); e[1] = bfhi(p.x); e[2] = bflo(p.y); e[3] = bfhi(p.y); e[4] = bflo(p.z); e[5] = bfhi(p.z); e[6] = bflo(p.w); e[7] = bfhi(p.w); }
__device__ __forceinline__ v4u pack8(const float (&e)[8]) { v4u o; o.x = pk2(e[0], e[1]); o.y = pk2(e[2], e[3]); o.z = pk2(e[4], e[5]); o.w = pk2(e[6], e[7]); return o; }

__device__ __forceinline__ void p3_lora(const Ctx& F) {
    const bf16* PROJ = (const bf16*)(F.ws + WS_PROJ);
    const bf16* WUPT = (const bf16*)(F.ws + WS_WUPT); const bf16* AUPT = (const bf16*)(F.ws + WS_AUPT); const bf16* GUPT = (const bf16*)(F.ws + WS_GUPT);
    bf16* LW = (bf16*)(F.ws + WS_LW); bf16* AA = (bf16*)(F.ws + WS_AA); bf16* GG = (bf16*)(F.ws + WS_GG);
    const float* mu = F.in[I_MU]; const float* w0 = F.in[I_W0]; const float* a0 = F.in[I_A0];
    const int r16 = F.lane & 15, q = F.lane >> 4;
    constexpr int WST = 72, GST = 168;
    LAS bf16* WU = (LAS bf16*)F.lds; LAS bf16* AU = WU + 128 * WST; LAS bf16* GU = AU + 128 * WST;
    const int nr = blockIdx.x & 7, nbr = (F.G - nr + 7) >> 3;
    __syncthreads();
    for (int i = F.tid; i < 128 * 8; i += NTHR) { const int row = i >> 3, ch = i & 7;
        *(LAS v4u*)(WU + row * WST + 8 * ch) = *(const v4u*)(WUPT + (size_t)(128 * nr + row) * L_W + 8 * ch);
        *(LAS v4u*)(AU + row * WST + 8 * ch) = *(const v4u*)(AUPT + (size_t)(128 * nr + row) * L_A + 8 * ch); }
    for (int i = F.tid; i < 128 * 20; i += NTHR) { const int row = i / 20, ch = i - row * 20;
        *(LAS v4u*)(GU + row * GST + 8 * ch) = *(const v4u*)(GUPT + (size_t)(128 * nr + row) * L_G + 8 * ch); }
    __syncthreads();
    for (int mt = (blockIdx.x >> 3) * NWAVES + F.wave; mt < M / 16; mt += nbr * NWAVES) {
        const int m = mt * 16 + r16; const bool first = (m % SEQ) == 0;
        const bf16* row = PROJ + (size_t)m * INPP;
        bf16x8 af[9];
#pragma unroll
        for (int s = 0; s < 9; ++s) {
            const int col = ((s < 2) ? (C_WD + 32 * s) : (s < 4) ? (C_AD + 32 * (s - 2)) : (C_GD + 32 * (s - 4))) + 8 * q;
            const v4u pc = *(const v4u*)(row + col);
            v4u pp = {0u, 0u, 0u, 0u}; if (!first) pp = *(const v4u*)(row - INPP + col);
            const f32x4 m0 = *(const f32x4*)(mu + col), m1 = *(const f32x4*)(mu + col + 4);
            float c[8], p[8], e[8]; unpack8(pc, c); unpack8(pp, p);
            const float mm[8] = {m0.x, m0.y, m0.z, m0.w, m1.x, m1.y, m1.z, m1.w};
#pragma unroll
            for (int j = 0; j < 8; ++j) { float v = c[j] + (p[j] - c[j]) * mm[j];
                if (s < 2) { const float t = __expf(2.f * v); v = 1.f - 2.f * rcp_f(t + 1.f); }
                else if (s >= 4) v = sigmoid_f(v);
                e[j] = v; }
            af[s] = __builtin_bit_cast(bf16x8, pack8(e));
        }
#pragma unroll 2
        for (int nt = 0; nt < 8; ++nt) {
            const LAS bf16* wu = WU + (16 * nt + r16) * WST + 8 * q; const LAS bf16* au = AU + (16 * nt + r16) * WST + 8 * q; const LAS bf16* gu = GU + (16 * nt + r16) * GST + 8 * q;
            f32x4 acc0 = {0.f, 0.f, 0.f, 0.f}, acc1 = acc0, acc2 = acc0;
#pragma unroll
            for (int s2 = 0; s2 < 2; ++s2) acc0 = __builtin_amdgcn_mfma_f32_16x16x32_bf16(*(const LAS bf16x8*)(wu + 32 * s2), af[s2], acc0, 0, 0, 0);
#pragma unroll
            for (int s2 = 0; s2 < 2; ++s2) acc1 = __builtin_amdgcn_mfma_f32_16x16x32_bf16(*(const LAS bf16x8*)(au + 32 * s2), af[2 + s2], acc1, 0, 0, 0);
#pragma unroll
            for (int s2 = 0; s2 < 5; ++s2) acc2 = __builtin_amdgcn_mfma_f32_16x16x32_bf16(*(const LAS bf16x8*)(gu + 32 * s2), af[4 + s2], acc2, 0, 0, 0);
            const int n = 128 * nr + 16 * nt + 4 * q;
            const f32x4 w0v = *(const f32x4*)(w0 + n), a0v = *(const f32x4*)(a0 + n);
            v2u o0, o1, o2;
            o0.x = pk2(-0.60653066f * sigmoid_f(acc0[0] + w0v.x), -0.60653066f * sigmoid_f(acc0[1] + w0v.y));
            o0.y = pk2(-0.60653066f * sigmoid_f(acc0[2] + w0v.z), -0.60653066f * sigmoid_f(acc0[3] + w0v.w));
            o1.x = pk2(sigmoid_f(acc1[0] + a0v.x), sigmoid_f(acc1[1] + a0v.y)); o1.y = pk2(sigmoid_f(acc1[2] + a0v.z), sigmoid_f(acc1[3] + a0v.w));
            o2.x = pk2(acc2[0], acc2[1]); o2.y = pk2(acc2[2], acc2[3]);
            *(v2u*)(LW + (size_t)m * RW + n) = o0; *(v2u*)(AA + (size_t)m * RW + n) = o1; *(v2u*)(GG + (size_t)m * RW + n) = o2;
        }
    }
    __syncthreads();
}

constexpr int TC = 32, NCHUNK = SEQ / TC;
constexpr int RB_R = 0, RB_W = TC * 64, RB_K = 2 * TC * 64, RB_KK = 3 * TC * 64, RB_KA = 4 * TC * 64, RB_V = 5 * TC * 64, RB_SIZE = 5 * TC * 64 + TC * 16;
constexpr int MB_B = 0, MB_C = TC * 128, MB_X = 2 * TC * 128, MB_DT = MB_X + TC * 32, MB_DA = MB_DT + TC, MB_SIZE = MB_DA + TC;
static_assert(2 * RB_SIZE * 4 <= RING_BYTES, "scan buffers fit the LDS ring");

struct RwkvRaw { bf16 r[9], k[9], v[9], lw[8], a[8]; };
__device__ __forceinline__ void rwkv_load(RwkvRaw& raw, const bf16* PROJ, const bf16* LW, const bf16* AA, int b, int h, int t0w, int c) {
    const bf16* base = PROJ + (size_t)(b * SEQ + t0w) * INPP + h * 64 + c;
#pragma unroll
    for (int i = 0; i < 9; ++i) {
        if (i == 0 && t0w == 0) { raw.r[0] = 0; raw.k[0] = 0; raw.v[0] = 0; }
        else { const bf16* row = base + (long)(i - 1) * INPP; raw.r[i] = row[C_R]; raw.k[i] = row[C_K]; raw.v[i] = row[C_V]; }
    }
#pragma unroll
    for (int i = 0; i < 8; ++i) { const size_t o = (size_t)(b * SEQ + t0w + i) * RW + h * 64 + c; raw.lw[i] = LW[o]; raw.a[i] = AA[o]; }
}
__device__ __forceinline__ void rwkv_stage(const RwkvRaw& raw, LAS float* buf, int tl0, int c, int qt, float mu_r, float mu_k, float mu_v, float kkw, float kaw) {
#pragma unroll
    for (int i = 0; i < 8; ++i) {
        const int t = tl0 + i;
        const float rc = bf1(raw.r[i + 1]), rp = bf1(raw.r[i]), kc = bf1(raw.k[i + 1]), kp = bf1(raw.k[i]), vc = bf1(raw.v[i + 1]), vp = bf1(raw.v[i]);
        const float rr = rc + (rp - rc) * mu_r, kx = kc + (kp - kc) * mu_k, vv = vc + (vp - vc) * mu_v;
        const float a = bf1(raw.a[i]), dec = __expf(bf1(raw.lw[i]));
        const float kkraw = kx * kkw; const float ss = wave_sum_dpp(kkraw * kkraw);
        const float kkn = kkraw * rcp_f(fmaxf(sqrtf(ss), 1e-12f));
        buf[RB_R + t * 64 + c] = rr; buf[RB_W + t * 64 + c] = dec; buf[RB_K + t * 64 + c] = kx * (1.f + (a - 1.f) * kaw);
        buf[RB_KK + t * 64 + c] = kkn; buf[RB_KA + t * 64 + c] = kkn * a;
        if ((c >> 4) == qt) buf[RB_V + t * 16 + (c & 15)] = vv;
    }
}
__device__ __forceinline__ void rwkv_task(const Ctx& F, int task) {
    const int b = task >> 6, h = (task >> 2) & 15, qt = task & 3;
    const bf16* PROJ = (const bf16*)(F.ws + WS_PROJ); const bf16* LW = (const bf16*)(F.ws + WS_LW); const bf16* AA = (const bf16*)(F.ws + WS_AA);
    bf16* OY = (bf16*)(F.ws + WS_OY);
    LAS float* lbuf = (LAS float*)F.lds;
    const int c = F.lane, w = F.wave, r = F.lane >> 4, cg = F.lane & 15;
    const bool stager = w >= 4; const int sw = w & 3;
    const int ch = h * 64 + c;
    const float mu_r = F.in[I_MU][C_R + ch], mu_k = F.in[I_MU][C_K + ch], mu_v = F.in[I_MU][C_V + ch], kkw = F.in[I_KK][ch], kaw = F.in[I_KA][ch];
    RwkvRaw raw;
    if (stager) { rwkv_load(raw, PROJ, LW, AA, b, h, 8 * sw, c); rwkv_stage(raw, lbuf, 8 * sw, c, qt, mu_r, mu_k, mu_v, kkw, kaw); rwkv_load(raw, PROJ, LW, AA, b, h, TC + 8 * sw, c); }
    __syncthreads();
    f32x2 S01 = {0.f, 0.f}, S23 = {0.f, 0.f};
    const bool cb0 = cg & 1, cb1 = cg & 2, cb2 = cg & 4, cb3 = cg & 8;
    bf16* orow = OY + (size_t)(b * SEQ) * DM + h * 64 + 16 * qt + 4 * sw + r;
    for (int ck = 0; ck < NCHUNK; ++ck) {
        const LAS float* buf = lbuf + (ck & 1) * RB_SIZE;
        if (stager) {
            if (ck + 1 < NCHUNK) { rwkv_stage(raw, lbuf + ((ck + 1) & 1) * RB_SIZE, 8 * sw, c, qt, mu_r, mu_k, mu_v, kkw, kaw);
                if (ck + 2 < NCHUNK) rwkv_load(raw, PROJ, LW, AA, b, h, (ck + 2) * TC + 8 * sw, c); }
        } else {
            const LAS float* bp = buf + 4 * cg; const LAS float* vp = buf + RB_V + 4 * sw + r;
            f32x4 qkk[3], qw[3], qka[3], qk[3], qr[3]; float qv[3];
#pragma unroll
            for (int i = 0; i < 3; ++i) { qkk[i] = *(const LAS f32x4*)(bp + RB_KK + i * 64); qw[i] = *(const LAS f32x4*)(bp + RB_W + i * 64); qka[i] = *(const LAS f32x4*)(bp + RB_KA + i * 64);
                qk[i] = *(const LAS f32x4*)(bp + RB_K + i * 64); qr[i] = *(const LAS f32x4*)(bp + RB_R + i * 64); qv[i] = vp[i * 16]; }
            float op[16];
#pragma unroll
            for (int j = 0; j < TC; ++j) {
                const int u = j % 3;
                const f32x4 kk4 = qkk[u], w4 = qw[u], ka4 = qka[u], k4 = qk[u], r4 = qr[u]; const float vr = qv[u];
                const f32x2 tq = S01 * LO2(kk4) + S23 * HI2(kk4);
                const float sa = rowsum16(tq.x + tq.y);
                const f32x2 sav = {sa, sa}, vrv = {vr, vr};
                S01 = S01 * LO2(w4) + (vrv * LO2(k4) - sav * LO2(ka4));
                S23 = S23 * HI2(w4) + (vrv * HI2(k4) - sav * HI2(ka4));
                const f32x2 uq = S01 * LO2(r4) + S23 * HI2(r4);
                op[j & 15] = uq.x + uq.y;
                asm volatile("" : "+v"(S01), "+v"(S23) :: "memory");
                if (j + 3 < TC) { qkk[u] = *(const LAS f32x4*)(bp + RB_KK + (j + 3) * 64); qw[u] = *(const LAS f32x4*)(bp + RB_W + (j + 3) * 64); qka[u] = *(const LAS f32x4*)(bp + RB_KA + (j + 3) * 64);
                                  qk[u] = *(const LAS f32x4*)(bp + RB_K + (j + 3) * 64); qr[u] = *(const LAS f32x4*)(bp + RB_R + (j + 3) * 64); qv[u] = vp[(j + 3) * 16]; }
                if ((j & 15) == 15) {
                    const float ored = treduce16(op, cb0, cb1, cb2, cb3);
                    orow[(size_t)(ck * TC + (j - 15) + cg) * DM] = (bf16)(pk2(ored, 0.f) & 0xffffu);
                }
            }
        }
        __syncthreads();
    }
}

__device__ __forceinline__ void p4_scans(const Ctx& F) {
    for (int task = blockIdx.x; task < NB * RHEADS * 4; task += F.G) { rwkv_task(F, task); __syncthreads(); }
}

__device__ __forceinline__ void ld16(const float* p, float (&v)[16]) {
#pragma unroll
    for (int i = 0; i < 4; ++i) { const f32x4 t = *(const f32x4*)(p + 4 * i); v[4 * i] = t.x; v[4 * i + 1] = t.y; v[4 * i + 2] = t.z; v[4 * i + 3] = t.w; }
}
__device__ __forceinline__ void ldbf16x16(const bf16* p, float (&v)[16]) {
    float t0[8], t1[8]; unpack8(*(const v4u*)p, t0); unpack8(*(const v4u*)(p + 8), t1);
#pragma unroll
    for (int j = 0; j < 8; ++j) { v[j] = t0[j]; v[8 + j] = t1[j]; }
}
__device__ __forceinline__ void stbf16x16(bf16* p, const float (&v)[16]) {
    float t0[8], t1[8];
#pragma unroll
    for (int j = 0; j < 8; ++j) { t0[j] = v[j]; t1[j] = v[8 + j]; }
    *(v4u*)p = pack8(t0); *(v4u*)(p + 8) = pack8(t1);
}
__device__ __forceinline__ void p5_post(const Ctx& F) {
    const bf16* PROJ = (const bf16*)(F.ws + WS_PROJ); const bf16* AA = (const bf16*)(F.ws + WS_AA); const bf16* GG = (const bf16*)(F.ws + WS_GG);
    bf16* OY = (bf16*)(F.ws + WS_OY);
    const int c0 = 16 * F.lane;
    {
        float mur[16], muk[16], muv[16], ka[16], rk[16], lnw[16], lnb[16];
        ld16(F.in[I_MU] + C_R + c0, mur); ld16(F.in[I_MU] + C_K + c0, muk); ld16(F.in[I_MU] + C_V + c0, muv);
        ld16(F.in[I_KA] + c0, ka); ld16(F.in[I_RK] + c0, rk); ld16(F.in[I_LNW] + c0, lnw); ld16(F.in[I_LNB] + c0, lnb);
        for (int m = F.gw; m < M; m += F.NGW) {
            const bool first = (m % SEQ) == 0;
            const bf16* prow = PROJ + (size_t)m * INPP; bf16* oyrow = OY + (size_t)m * DM;
            float o[16], res[16]; float bs = 0.f;
            ldbf16x16(oyrow + c0, o);
            {
                float rc[16], rp[16], kc[16], kp[16], av[16];
                ldbf16x16(prow + C_R + c0, rc); ldbf16x16(prow + C_K + c0, kc); ldbf16x16(AA + (size_t)m * RW + c0, av);
                if (!first) { ldbf16x16(prow - INPP + C_R + c0, rp); ldbf16x16(prow - INPP + C_K + c0, kp); }
                else {
#pragma unroll
                    for (int j = 0; j < 16; ++j) { rp[j] = 0.f; kp[j] = 0.f; } }
#pragma unroll
                for (int j = 0; j < 16; ++j) { const float rr = rc[j] + (rp[j] - rc[j]) * mur[j], kx = kc[j] + (kp[j] - kc[j]) * muk[j];
                    bs += rr * (kx * (1.f + (av[j] - 1.f) * ka[j])) * rk[j]; }
            }
            bs = quadsum(bs);
            float s = 0.f;
#pragma unroll
            for (int j = 0; j < 16; ++j) s += o[j];
            const float mean = quadsum(s) * (1.f / 64.f);
            float qv = 0.f;
#pragma unroll
            for (int j = 0; j < 16; ++j) { o[j] -= mean; qv += o[j] * o[j]; }
            const float rstd = rsqrtf(quadsum(qv) * (1.f / 64.f) + 64e-5f);
            {
                float vc[16], vp[16], gv[16];
                ldbf16x16(prow + C_V + c0, vc); ldbf16x16(GG + (size_t)m * RW + c0, gv);
                if (!first) ldbf16x16(prow - INPP + C_V + c0, vp);
                else {
#pragma unroll
                    for (int j = 0; j < 16; ++j) vp[j] = 0.f; }
#pragma unroll
                for (int j = 0; j < 16; ++j) { const float vv = vc[j] + (vp[j] - vc[j]) * muv[j]; res[j] = (o[j] * rstd * lnw[j] + lnb[j] + bs * vv) * gv[j]; }
            }
            stbf16x16(oyrow + c0, res);
        }
    }
    {
        float nw[16]; ld16(F.in[I_MNW] + c0, nw);
        for (int m = F.gw; m < M; m += F.NGW) {
            const bf16* prow = PROJ + (size_t)m * INPP; bf16* oyrow = OY + (size_t)m * DM;
            float y[16], z[16];
            ldbf16x16(oyrow + RW + c0, y); ldbf16x16(prow + C_Z + c0, z);
            float qv = 0.f;
#pragma unroll
            for (int j = 0; j < 16; ++j) { y[j] *= silu_f(z[j]); qv += y[j] * y[j]; }
            qv = rowsum16(qv);
            { auto rr = __builtin_amdgcn_permlane16_swap(__float_as_uint(qv), __float_as_uint(qv), false, false); qv = __uint_as_float(rr[0]) + __uint_as_float(rr[1]); }
            const float rstd = rsqrtf(qv * (1.f / 512.f) + 1e-5f);
#pragma unroll
            for (int j = 0; j < 16; ++j) y[j] = y[j] * rstd * nw[j];
            stbf16x16(oyrow + RW + c0, y);
        }
    }
}
constexpr int MC_L = 128, MC_NC = SEQ / MC_L, LSTR = 136;
constexpr int MT_BYTES = 128 * LSTR * 2;
constexpr size_t WS_ST = 876 * MiB, WS_SIN = 940 * MiB, WS_ATOT = 1004 * MiB, WS_END2 = 1005 * MiB;

__device__ __forceinline__ float mamba_dt_scan(const Ctx& F, const bf16* PROJ, int b, int c, int g, LAS float* DT, LAS float* ACS) {
    const int head = g * 8 + F.wave, lane = F.lane;
    const float dtb = F.in[I_DTB][head], Aneg = -__expf(F.in[I_ALOG][head]);
    const bf16* p = PROJ + (size_t)(b * SEQ + c * MC_L + 2 * lane) * INPP + C_DT + head;
    const float x0 = bf1(p[0]) + dtb, x1 = bf1(p[INPP]) + dtb;
    const float d0 = (x0 > 20.f) ? x0 : log1pf(__expf(x0)), d1 = (x1 > 20.f) ? x1 : log1pf(__expf(x1));
    const float s0 = d0 * Aneg, s1 = s0 + d1 * Aneg;
    float incl = s1;
#pragma unroll
    for (int o = 1; o < 64; o <<= 1) { const float t = __shfl_up(incl, o); if (lane >= o) incl += t; }
    const float excl = incl - s1;
    DT[F.wave * 128 + 2 * lane] = d0; DT[F.wave * 128 + 2 * lane + 1] = d1;
    ACS[F.wave * 128 + 2 * lane] = excl + s0; ACS[F.wave * 128 + 2 * lane + 1] = excl + s1;
    return __shfl(incl, 63);
}
struct TRaw { bf16 v[35]; };
__device__ __forceinline__ void mstage_T_load(TRaw& raw, const bf16* PROJ, int b, int c, int chn, int tid) {
    const int t0 = 32 * (tid >> 7);
    const bf16* base = PROJ + (size_t)(b * SEQ + c * MC_L + t0) * INPP + C_XBC + chn;
    if (c * MC_L + t0 > 0) { raw.v[0] = base[-3 * INPP]; raw.v[1] = base[-2 * INPP]; raw.v[2] = base[-1 * INPP]; }
    else { raw.v[0] = 0; raw.v[1] = 0; raw.v[2] = 0; }
#pragma unroll
    for (int t = 0; t < 32; ++t) raw.v[3 + t] = base[(size_t)t * INPP];
}
template <bool SC>
__device__ __forceinline__ void mstage_T_store(const TRaw& raw, int chn, LAS bf16* dst, const LAS float* scale, const float* convw, const float* convb, int tid) {
    const int f = tid & 127, t0 = 32 * (tid >> 7);
    const float w0 = convw[chn], w1 = convw[1536 + chn], w2 = convw[2 * 1536 + chn], w3 = convw[3 * 1536 + chn], bb = convb[chn];
#pragma unroll
    for (int i8 = 0; i8 < 4; ++i8) {
        float e[8];
#pragma unroll
        for (int i = 0; i < 8; ++i) { const int t = 8 * i8 + i;
            float v = silu_f(bb + w0 * bf1(raw.v[t]) + w1 * bf1(raw.v[t + 1]) + w2 * bf1(raw.v[t + 2]) + w3 * bf1(raw.v[t + 3]));
            if (SC) v *= scale[t0 + t];
            e[i] = v; }
        *(LAS v4u*)(dst + f * LSTR + t0 + 8 * i8) = pack8(e);
    }
}
__device__ __forceinline__ void mstage_N(const bf16* PROJ, int b, int c, int g, LAS bf16* Bn, LAS bf16* Cn, const float* convw, const float* convb, int tid) {
    const int f8 = tid & 31, t0 = 8 * (tid >> 5);
    const int chn = (f8 < 16) ? (1024 + g * 128 + 8 * f8) : (1280 + g * 128 + 8 * (f8 - 16));
    LAS bf16* dst = ((f8 < 16) ? Bn : Cn) + 8 * (f8 & 15);
    const bf16* base = PROJ + (size_t)(b * SEQ + c * MC_L + t0) * INPP + C_XBC + chn;
    float w[4][8], bb[8];
#pragma unroll
    for (int i = 0; i < 4; ++i) { const f32x4 a = *(const f32x4*)(convw + i * 1536 + chn), d = *(const f32x4*)(convw + i * 1536 + chn + 4);
        w[i][0] = a.x; w[i][1] = a.y; w[i][2] = a.z; w[i][3] = a.w; w[i][4] = d.x; w[i][5] = d.y; w[i][6] = d.z; w[i][7] = d.w; }
    { const f32x4 a = *(const f32x4*)(convb + chn), d = *(const f32x4*)(convb + chn + 4); bb[0] = a.x; bb[1] = a.y; bb[2] = a.z; bb[3] = a.w; bb[4] = d.x; bb[5] = d.y; bb[6] = d.z; bb[7] = d.w; }
    float r0[8], r1[8], r2[8];
    if (c * MC_L + t0 > 0) { unpack8(*(const v4u*)(base - 3 * INPP), r0); unpack8(*(const v4u*)(base - 2 * INPP), r1); unpack8(*(const v4u*)(base - 1 * INPP), r2); }
    else {
#pragma unroll
        for (int k = 0; k < 8; ++k) { r0[k] = 0.f; r1[k] = 0.f; r2[k] = 0.f; } }
#pragma unroll
    for (int t = 0; t < 8; ++t) {
        float r3[8], e[8]; unpack8(*(const v4u*)(base + (size_t)t * INPP), r3);
#pragma unroll
        for (int k = 0; k < 8; ++k) { e[k] = silu_f(bb[k] + w[0][k] * r0[k] + w[1][k] * r1[k] + w[2][k] * r2[k] + w[3][k] * r3[k]); r0[k] = r1[k]; r1[k] = r2[k]; r2[k] = r3[k]; }
        *(LAS v4u*)(dst + (t0 + t) * LSTR) = pack8(e);
    }
}

__device__ __forceinline__ void m1_chunk_states(const Ctx& F) {
    const bf16* PROJ = (const bf16*)(F.ws + WS_PROJ); bf16* ST = (bf16*)(F.ws + WS_ST); float* ATOT = (float*)(F.ws + WS_ATOT);
    LAS bf16* BT = (LAS bf16*)F.lds; LAS bf16* XT = (LAS bf16*)(F.lds + MT_BYTES);
    LAS float* DT = (LAS float*)(F.lds + 3 * MT_BYTES); LAS float* ACS = DT + 8 * 128; LAS float* SCL = ACS + 8 * 128;
    const float* convw = F.in[I_CONVW]; const float* convb = F.in[I_CONVB];
    const int tid = F.tid, w = F.wave, lane = F.lane, r16 = lane & 15, q = lane >> 4;
    for (int it = blockIdx.x; it < NB * MC_NC * 2; it += F.G) {
        const int g = it & 1, c = (it >> 1) & (MC_NC - 1), b = it >> 7;
        __syncthreads();
        const float atot = mamba_dt_scan(F, PROJ, b, c, g, DT, ACS);
        if (lane == 0) ATOT[(b * MC_NC + c) * 16 + g * 8 + w] = atot;
        const int chB = 1024 + g * 128 + (tid & 127);
        TRaw ra, rb;
        mstage_T_load(ra, PROJ, b, c, chB, tid);
        mstage_T_load(rb, PROJ, b, c, (g * 8 + ((tid & 127) >> 6)) * 64 + (tid & 63), tid);
        LDS_WAIT();
        SCL[w * 128 + 2 * lane] = DT[w * 128 + 2 * lane] * __expf(atot - ACS[w * 128 + 2 * lane]);
        SCL[w * 128 + 2 * lane + 1] = DT[w * 128 + 2 * lane + 1] * __expf(atot - ACS[w * 128 + 2 * lane + 1]);
        mstage_T_store<false>(ra, chB, BT, nullptr, convw, convb, tid);
        mstage_T_load(ra, PROJ, b, c, (g * 8 + 2 + ((tid & 127) >> 6)) * 64 + (tid & 63), tid);
        __syncthreads();
#pragma unroll
        for (int hb = 0; hb < 2; ++hb) {
            if (hb == 1) mstage_T_load(ra, PROJ, b, c, (g * 8 + 6 + ((tid & 127) >> 6)) * 64 + (tid & 63), tid);
            { const int hl = 4 * hb + ((tid & 127) >> 6); mstage_T_store<true>(rb, (g * 8 + hl) * 64 + (tid & 63), XT, SCL + hl * 128, convw, convb, tid); }
            if (hb == 0) mstage_T_load(rb, PROJ, b, c, (g * 8 + 4 + ((tid & 127) >> 6)) * 64 + (tid & 63), tid);
            { const int hl = 4 * hb + 2 + ((tid & 127) >> 6); mstage_T_store<true>(ra, (g * 8 + hl) * 64 + (tid & 63), XT + 128 * LSTR, SCL + hl * 128, convw, convb, tid); }
            __syncthreads();
            const int hh = w >> 1, ph = w & 1;
            f32x4 acc[2][8];
#pragma unroll
            for (int a = 0; a < 2; ++a)
#pragma unroll
                for (int n = 0; n < 8; ++n) acc[a][n] = (f32x4){0.f, 0.f, 0.f, 0.f};
#pragma unroll
            for (int ks = 0; ks < 4; ++ks) {
                bf16x8 xa[2];
#pragma unroll
                for (int a = 0; a < 2; ++a) xa[a] = *(const LAS bf16x8*)(XT + (hh * 64 + 32 * ph + 16 * a + r16) * LSTR + 32 * ks + 8 * q);
#pragma unroll
                for (int n = 0; n < 8; ++n) { const bf16x8 bfr = *(const LAS bf16x8*)(BT + (16 * n + r16) * LSTR + 32 * ks + 8 * q);
#pragma unroll
                    for (int a = 0; a < 2; ++a) acc[a][n] = __builtin_amdgcn_mfma_f32_16x16x32_bf16(bfr, xa[a], acc[a][n], 0, 0, 0); }
            }
            bf16* st = ST + ((size_t)((b * MC_NC + c) * 16 + g * 8 + 4 * hb + hh)) * (64 * 128);
#pragma unroll
            for (int a = 0; a < 2; ++a)
#pragma unroll
                for (int n = 0; n < 8; ++n) { v2u o; o.x = pk2(acc[a][n][0], acc[a][n][1]); o.y = pk2(acc[a][n][2], acc[a][n][3]);
                    *(v2u*)(st + (32 * ph + 16 * a + r16) * 128 + 16 * n + 4 * q) = o; }
            __syncthreads();
        }
    }
}

__device__ __forceinline__ void m2_prefix(const Ctx& F) {
    const bf16* ST = (const bf16*)(F.ws + WS_ST); bf16* SIN = (bf16*)(F.ws + WS_SIN); const float* ATOT = (const float*)(F.ws + WS_ATOT);
    const int nthr = F.G * NTHR;
    for (int gi = blockIdx.x * NTHR + F.tid; gi < NB * 16 * 2048; gi += nthr) {
        const int e4 = gi & 2047, bh = gi >> 11, b = bh >> 4, h = bh & 15;
        float r0 = 0.f, r1 = 0.f, r2 = 0.f, r3 = 0.f;
#pragma unroll 4
        for (int c = 0; c < MC_NC; ++c) {
            const size_t o = ((size_t)((b * MC_NC + c) * 16 + h)) * 8192 + 4 * e4;
            v2u so; so.x = pk2(r0, r1); so.y = pk2(r2, r3);
            *(v2u*)(SIN + o) = so;
            const v2u sv = *(const v2u*)(ST + o); const float d = __expf(ATOT[(b * MC_NC + c) * 16 + h]);
            r0 = r0 * d + bflo(sv.x); r1 = r1 * d + bfhi(sv.x); r2 = r2 * d + bflo(sv.y); r3 = r3 * d + bfhi(sv.y);
        }
    }
}

__device__ __forceinline__ void m3_outputs(const Ctx& F) {
    const bf16* PROJ = (const bf16*)(F.ws + WS_PROJ); const bf16* SIN = (const bf16*)(F.ws + WS_SIN); bf16* OY = (bf16*)(F.ws + WS_OY);
    LAS bf16* Cn = (LAS bf16*)F.lds; LAS bf16* RB = (LAS bf16*)(F.lds + MT_BYTES);
    LAS bf16* Mw = (LAS bf16*)(F.lds + 2 * MT_BYTES) + F.wave * 16 * LSTR;
    LAS float* DT = (LAS float*)(F.lds + 3 * MT_BYTES); LAS float* ACS = DT + 8 * 128;
    const float* convw = F.in[I_CONVW]; const float* convb = F.in[I_CONVB];
    const int tid = F.tid, w = F.wave, lane = F.lane, r16 = lane & 15, q = lane >> 4;
    for (int it = blockIdx.x; it < NB * MC_NC * 2; it += F.G) {
        const int g = it & 1, c = (it >> 1) & (MC_NC - 1), b = it >> 7;
        __syncthreads();
        (void)mamba_dt_scan(F, PROJ, b, c, g, DT, ACS);
        mstage_N(PROJ, b, c, g, RB, Cn, convw, convb, tid);
        __syncthreads();
        TRaw rx;
        mstage_T_load(rx, PROJ, b, c, (g * 8 + ((tid & 127) >> 6)) * 64 + (tid & 63), tid);
        bf16x8 cf[4];
#pragma unroll
        for (int ks = 0; ks < 4; ++ks) cf[ks] = *(const LAS bf16x8*)(Cn + (16 * w + r16) * LSTR + 32 * ks + 8 * q);
        f32x4 Gt[8];
#pragma unroll
        for (int nt = 0; nt < 8; ++nt) { Gt[nt] = (f32x4){0.f, 0.f, 0.f, 0.f};
#pragma unroll
            for (int ks = 0; ks < 4; ++ks) Gt[nt] = __builtin_amdgcn_mfma_f32_16x16x32_bf16(*(const LAS bf16x8*)(RB + (16 * nt + r16) * LSTR + 32 * ks + 8 * q), cf[ks], Gt[nt], 0, 0, 0); }
        const int l = 16 * w + r16;
        const size_t mrow = (size_t)(b * SEQ + c * MC_L + l);
#pragma unroll 1
        for (int hb = 0; hb < 4; ++hb) {
            __syncthreads();
            { const int hl = 2 * hb + ((tid & 127) >> 6); mstage_T_store<false>(rx, (g * 8 + hl) * 64 + (tid & 63), RB, nullptr, convw, convb, tid); }
            { const int hn = (hb < 3) ? 2 * (hb + 1) : 2 * hb; mstage_T_load(rx, PROJ, b, c, (g * 8 + hn + ((tid & 127) >> 6)) * 64 + (tid & 63), tid); }
            __syncthreads();
#pragma unroll 1
            for (int h2 = 0; h2 < 2; ++h2) {
                const int hl = 2 * hb + h2, head = g * 8 + hl;
                const float acs_l = ACS[hl * 128 + l];
                const bf16* sin = SIN + ((size_t)((b * MC_NC + c) * 16 + head)) * 8192;
                bf16x8 sf[4][4];
#pragma unroll
                for (int pt = 0; pt < 4; ++pt)
#pragma unroll
                    for (int ks = 0; ks < 4; ++ks) sf[pt][ks] = *(const bf16x8*)(sin + (16 * pt + r16) * 128 + 32 * ks + 8 * q);
#pragma unroll
                for (int nt = 0; nt < 8; ++nt) { const f32x4 as = *(const LAS f32x4*)(ACS + hl * 128 + 16 * nt + 4 * q), ds = *(const LAS f32x4*)(DT + hl * 128 + 16 * nt + 4 * q);
                    float mv[4];
#pragma unroll
                    for (int j = 0; j < 4; ++j) { const int s = 16 * nt + 4 * q + j; mv[j] = (s <= l) ? Gt[nt][j] * __expf(acs_l - as[j]) * ds[j] : 0.f; }
                    v2u o; o.x = pk2(mv[0], mv[1]); o.y = pk2(mv[2], mv[3]);
                    *(LAS v2u*)(Mw + r16 * LSTR + 16 * nt + 4 * q) = o; }
                LDS_WAIT(); asm volatile("" ::: "memory");
                bf16x8 mf[4];
#pragma unroll
                for (int ks = 0; ks < 4; ++ks) mf[ks] = *(const LAS bf16x8*)(Mw + r16 * LSTR + 32 * ks + 8 * q);
                const float el = __expf(acs_l), Dh = F.in[I_DSK][head];
#pragma unroll
                for (int pt = 0; pt < 4; ++pt) {
                    f32x4 yd = {0.f, 0.f, 0.f, 0.f}, yo = {0.f, 0.f, 0.f, 0.f};
#pragma unroll
                    for (int ks = 0; ks < 4; ++ks) {
                        yd = __builtin_amdgcn_mfma_f32_16x16x32_bf16(*(const LAS bf16x8*)(RB + (h2 * 64 + 16 * pt + r16) * LSTR + 32 * ks + 8 * q), mf[ks], yd, 0, 0, 0);
                        yo = __builtin_amdgcn_mfma_f32_16x16x32_bf16(sf[pt][ks], cf[ks], yo, 0, 0, 0); }
                    float yv[4];
#pragma unroll
                    for (int j = 0; j < 4; ++j) yv[j] = yd[j] + el * yo[j] + Dh * bf1(RB[(h2 * 64 + 16 * pt + 4 * q + j) * LSTR + l]);
                    v2u o; o.x = pk2(yv[0], yv[1]); o.y = pk2(yv[2], yv[3]);
                    *(v2u*)(OY + mrow * DM + RW + head * 64 + 16 * pt + 4 * q) = o;
                }
                asm volatile("" ::: "memory");
            }
        }
    }
}
constexpr int RC = 16, RNCH = SEQ / RC, NPART = 4, RHALF = RNCH / NPART, RITEMS = NB * RHEADS * RHALF;
constexpr size_t RO_WH = 0, RO_RH = 16 * MiB, RO_VT = 32 * MiB, RO_ET = 48 * MiB, RO_OL = 64 * MiB, RO_A2 = 80 * MiB, RO_GC = 112 * MiB, RO_BUF = 116 * MiB, RO_SS = 232 * MiB;
constexpr int RL_KAP = 0, RL_ALP = 2304, RL_KT = 4608, RL_RT = 6912, RL_KAPT = 9216, RL_VT = 11264, RL_TB = 13312, RL_BL = 14336, RL_QL = 15360, RL_PL = 16384,
              RL_WT = RL_KAP, RL_BVT = RL_ALP, RL_AL32 = RL_KT, RL_ET = RL_KT,
              RL_BYTES = 18176;
constexpr int XS = 72, TS = 16, SS16 = 32;

__device__ __forceinline__ float wave_sum_pl(float x) {
    x = rowsum16(x);
    { auto rr = __builtin_amdgcn_permlane16_swap(__float_as_uint(x), __float_as_uint(x), false, false); x = __uint_as_float(rr[0]) + __uint_as_float(rr[1]); }
    { auto rr = __builtin_amdgcn_permlane32_swap(__float_as_uint(x), __float_as_uint(x), false, false); x = __uint_as_float(rr[0]) + __uint_as_float(rr[1]); }
    return x;
}
__device__ __forceinline__ v2u pack4(const f32x4 a) { v2u o; o.x = pk2(a[0], a[1]); o.y = pk2(a[2], a[3]); return o; }
__device__ __forceinline__ f32x4 unpack4(const v2u u) { return (f32x4){bflo(u.x), bfhi(u.x), bflo(u.y), bfhi(u.y)}; }
__device__ __forceinline__ bf16 f2b(float x) { return (bf16)pk2(x, 0.f); }

__device__ __forceinline__ void ra_item(const Ctx& F, LAS unsigned char* wl, int it, int half) {
    const int bh = it / RHALF, cl = it - bh * RHALF, ci = half * RHALF + cl, b = bh >> 4, h = bh & 15;
    const bf16* PROJ = (const bf16*)(F.ws + WS_PROJ); const bf16* LW = (const bf16*)(F.ws + WS_LW); const bf16* AA = (const bf16*)(F.ws + WS_AA);
    unsigned char* RO = (unsigned char*)F.out + (size_t)(half & 1) * RO_BUF;
    const int lane = F.lane, r16 = lane & 15, q = lane >> 4, c = lane, ch = h * 64 + c;
    const size_t m0 = (size_t)b * SEQ + (size_t)RC * ci;
    LAS bf16* KAP = (LAS bf16*)(wl + RL_KAP); LAS bf16* ALP = (LAS bf16*)(wl + RL_ALP); LAS bf16* KT = (LAS bf16*)(wl + RL_KT); LAS bf16* RT = (LAS bf16*)(wl + RL_RT);
    LAS bf16* KAPT = (LAS bf16*)(wl + RL_KAPT); LAS bf16* VTL = (LAS bf16*)(wl + RL_VT); LAS bf16* WT = (LAS bf16*)(wl + RL_WT); LAS bf16* BVT = (LAS bf16*)(wl + RL_BVT); LAS bf16* ETL = (LAS bf16*)(wl + RL_ET);
    LAS bf16* TB = (LAS bf16*)(wl + RL_TB); LAS bf16* BL = (LAS bf16*)(wl + RL_BL); LAS bf16* QL = (LAS bf16*)(wl + RL_QL); LAS bf16* PL = (LAS bf16*)(wl + RL_PL);
    const float mu_r = F.in[I_MU][C_R + ch], mu_k = F.in[I_MU][C_K + ch], mu_v = F.in[I_MU][C_V + ch], kkw = F.in[I_KK][ch], kaw = F.in[I_KA][ch];
    const bf16* prow = PROJ + m0 * INPP + ch;
    float rp = 0.f, kp = 0.f, vp = 0.f;
    if (ci > 0) { rp = bf1(prow[-INPP + C_R]); kp = bf1(prow[-INPP + C_K]); vp = bf1(prow[-INPP + C_V]); }
    float ec = 1.f, kkna[RC], kpv[RC], env[RC], vvv[RC];
    float cum = 0.f;
#pragma unroll
    for (int t = 0; t < RC; ++t) {
        const bf16* row = prow + (size_t)t * INPP;
        const float rc = bf1(row[C_R]), kc = bf1(row[C_K]), vc = bf1(row[C_V]);
        const float a = bf1(AA[(m0 + t) * RW + ch]), lw = bf1(LW[(m0 + t) * RW + ch]);
        const float rr = rc + (rp - rc) * mu_r, kx = kc + (kp - kc) * mu_k, vv = vc + (vp - vc) * mu_v;
        rp = rc; kp = kc; vp = vc;
        const float kkraw = kx * kkw; const float ss = wave_sum_pl(kkraw * kkraw);
        const float kkn = kkraw * rcp_f(fmaxf(sqrtf(ss), 1e-12f));
        const float kpp = kx * (1.f + (a - 1.f) * kaw);
        const float ep = ec; cum += lw; ec = __expf(cum); const float en = rcp_f(ec);
        const unsigned p0 = pk2(kkn * ep, kkn * a * en), p1 = pk2(kpp * en, rr * ec), p2 = pk2(vv, 0.f);
        KAP[t * XS + c] = (bf16)p0; ALP[t * XS + c] = (bf16)(p0 >> 16); KT[t * XS + c] = (bf16)p1; RT[t * XS + c] = (bf16)(p1 >> 16);
        KAPT[c * TS + t] = (bf16)p0; VTL[c * TS + t] = (bf16)p2;
        kkna[t] = kkn * a; kpv[t] = kpp; env[t] = en; vvv[t] = vv;
    }
    {
        float e8[8]; v4u* vt = (v4u*)((bf16*)(RO + RO_VT) + (size_t)it * 1024 + c * 16);
#pragma unroll
        for (int i = 0; i < 8; ++i) e8[i] = vvv[i];
        vt[0] = pack8(e8);
#pragma unroll
        for (int i = 0; i < 8; ++i) e8[i] = vvv[8 + i];
        vt[1] = pack8(e8);
        v4u* a2 = (v4u*)((bf16*)(RO + RO_A2) + (size_t)it * 2048 + c * 32);
        float dd[RC];
#pragma unroll
        for (int t = 0; t < RC; ++t) dd[t] = ec * env[t];
#pragma unroll
        for (int i = 0; i < 8; ++i) e8[i] = -kkna[i] * dd[i];
        a2[0] = pack8(e8);
#pragma unroll
        for (int i = 0; i < 8; ++i) e8[i] = -kkna[8 + i] * dd[8 + i];
        a2[1] = pack8(e8);
#pragma unroll
        for (int i = 0; i < 8; ++i) e8[i] = kpv[i] * dd[i];
        a2[2] = pack8(e8);
#pragma unroll
        for (int i = 0; i < 8; ++i) e8[i] = kpv[8 + i] * dd[8 + i];
        a2[3] = pack8(e8);
        ((float*)(RO + RO_GC))[(size_t)it * 64 + c] = ec;
    }
    LDS_WAIT(); asm volatile("" ::: "memory");
    const v2u zero2 = {0u, 0u};
    {
        f32x4 alt = {0.f, 0.f, 0.f, 0.f}, blt = alt, qlt = alt, plt = alt;
#pragma unroll
        for (int ks = 0; ks < 2; ++ks) {
            const bf16x8 fa = *(const LAS bf16x8*)(ALP + r16 * XS + 32 * ks + 8 * q), fk = *(const LAS bf16x8*)(KT + r16 * XS + 32 * ks + 8 * q);
            const bf16x8 fkp = *(const LAS bf16x8*)(KAP + r16 * XS + 32 * ks + 8 * q), fr = *(const LAS bf16x8*)(RT + r16 * XS + 32 * ks + 8 * q);
            alt = __builtin_amdgcn_mfma_f32_16x16x32_bf16(fa, fkp, alt, 0, 0, 0); blt = __builtin_amdgcn_mfma_f32_16x16x32_bf16(fk, fkp, blt, 0, 0, 0);
            qlt = __builtin_amdgcn_mfma_f32_16x16x32_bf16(fa, fr, qlt, 0, 0, 0);  plt = __builtin_amdgcn_mfma_f32_16x16x32_bf16(fk, fr, plt, 0, 0, 0);
        }
#pragma unroll
        for (int j = 0; j < 4; ++j) { const int s = 4 * q + j; const bool lt = s < r16, le = s <= r16;
            alt[j] = lt ? alt[j] : 0.f; blt[j] = lt ? blt[j] : 0.f; qlt[j] = le ? qlt[j] : 0.f; plt[j] = le ? plt[j] : 0.f; }
        *(LAS v2u*)(BL + r16 * SS16 + 4 * q) = pack4(blt); *(LAS v2u*)(QL + r16 * SS16 + 4 * q) = pack4(qlt); *(LAS v2u*)(PL + r16 * SS16 + 4 * q) = pack4(plt);
        *(LAS v2u*)(BL + r16 * SS16 + 16 + 4 * q) = zero2; *(LAS v2u*)(QL + r16 * SS16 + 16 + 4 * q) = zero2; *(LAS v2u*)(PL + r16 * SS16 + 16 + 4 * q) = zero2;
        float x[RC];
#pragma unroll
        for (int t = 0; t < RC; ++t) {
            float acc = (t == r16) ? 1.f : 0.f;
#pragma unroll
            for (int s2 = 0; s2 < t; ++s2) { const float a_ts = __uint_as_float(__builtin_amdgcn_readlane(__float_as_uint(alt[s2 & 3]), 16 * (s2 >> 2) + t)); acc -= a_ts * x[s2]; }
            x[t] = acc;
        }
        if (q == 0) {
#pragma unroll
            for (int t = 0; t < RC; ++t) { TB[t * SS16 + r16] = f2b(x[t]); TB[t * SS16 + 16 + r16] = 0; }
        }
    }
    LDS_WAIT(); asm volatile("" ::: "memory");
    const bf16x8 zf = {0, 0, 0, 0, 0, 0, 0, 0};
    const bf16x8 tbf = *(const LAS bf16x8*)(TB + r16 * SS16 + 8 * q), blf = *(const LAS bf16x8*)(BL + r16 * SS16 + 8 * q);
    const bf16x8 qlf = *(const LAS bf16x8*)(QL + r16 * SS16 + 8 * q), plf = *(const LAS bf16x8*)(PL + r16 * SS16 + 8 * q);
    const f32x4 z4 = {0.f, 0.f, 0.f, 0.f};
    bf16* gWH = (bf16*)(RO + RO_WH) + (size_t)it * 1024; bf16* gRH = (bf16*)(RO + RO_RH) + (size_t)it * 1024;
    bf16* gET = (bf16*)(RO + RO_ET) + (size_t)it * 1024; bf16* gOL = (bf16*)(RO + RO_OL) + (size_t)it * 1024;
#pragma unroll
    for (int kt = 0; kt < 4; ++kt) {
        const bf16x8 kf = (q < 2) ? *(const LAS bf16x8*)(KAPT + (16 * kt + r16) * TS + 8 * q) : zf;
        const f32x4 wa = __builtin_amdgcn_mfma_f32_16x16x32_bf16(kf, tbf, z4, 0, 0, 0);
        *(v2u*)(gWH + r16 * 64 + 16 * kt + 4 * q) = pack4(wa);
        const f32x4 wb = __builtin_amdgcn_mfma_f32_16x16x32_bf16(tbf, kf, z4, 0, 0, 0);
        *(LAS v2u*)(WT + (16 * kt + r16) * TS + 4 * q) = pack4(wb);
        const bf16x8 vf = (q < 2) ? *(const LAS bf16x8*)(VTL + (16 * kt + r16) * TS + 8 * q) : zf;
        const f32x4 bv = __builtin_amdgcn_mfma_f32_16x16x32_bf16(blf, vf, z4, 0, 0, 0);
        *(LAS v2u*)(BVT + (16 * kt + r16) * TS + 4 * q) = pack4(bv);
    }
    LDS_WAIT(); asm volatile("" ::: "memory");
#pragma unroll
    for (int vt = 0; vt < 4; ++vt) {
        const bf16x8 bf_ = (q < 2) ? *(const LAS bf16x8*)(BVT + (16 * vt + r16) * TS + 8 * q) : zf;
        const f32x4 e4 = __builtin_amdgcn_mfma_f32_16x16x32_bf16(tbf, bf_, z4, 0, 0, 0);
        const v2u ep = pack4(e4);
        *(LAS v2u*)(ETL + (16 * vt + r16) * TS + 4 * q) = ep; *(v2u*)(gET + (16 * vt + r16) * 16 + 4 * q) = ep;
    }
    LDS_WAIT(); asm volatile("" ::: "memory");
#pragma unroll
    for (int kt = 0; kt < 4; ++kt) {
        const bf16x8 wf = (q < 2) ? *(const LAS bf16x8*)(WT + (16 * kt + r16) * TS + 8 * q) : zf;
        const f32x4 qw = __builtin_amdgcn_mfma_f32_16x16x32_bf16(wf, qlf, z4, 0, 0, 0);
        const f32x4 rt4 = unpack4(*(const LAS v2u*)(RT + r16 * XS + 16 * kt + 4 * q));
        *(v2u*)(gRH + r16 * 64 + 16 * kt + 4 * q) = pack4(rt4 - qw);
        const bf16x8 vf = (q < 2) ? *(const LAS bf16x8*)(VTL + (16 * kt + r16) * TS + 8 * q) : zf;
        const bf16x8 ef = (q < 2) ? *(const LAS bf16x8*)(ETL + (16 * kt + r16) * TS + 8 * q) : zf;
        const f32x4 pv = __builtin_amdgcn_mfma_f32_16x16x32_bf16(vf, plf, z4, 0, 0, 0);
        const f32x4 qe = __builtin_amdgcn_mfma_f32_16x16x32_bf16(ef, qlf, z4, 0, 0, 0);
        *(v2u*)(gOL + r16 * 64 + 16 * kt + 4 * q) = pack4(pv - qe);
    }
    LDS_WAIT(); asm volatile("" ::: "memory");
}
__device__ __forceinline__ void ra_part(const Ctx& F, int part) {
    LAS unsigned* ctr = (LAS unsigned*)(F.lds + LDS_BYTES - 48) + part;
    LAS unsigned char* wl = F.lds + F.wave * RL_BYTES;
    for (;;) {
        unsigned idx = 0;
        if (F.lane == 0) idx = __hip_atomic_fetch_add(ctr, 1u, __ATOMIC_RELAXED, __HIP_MEMORY_SCOPE_WORKGROUP);
        idx = (unsigned)__builtin_amdgcn_readfirstlane((int)idx);
        const int it = (int)blockIdx.x + F.G * (int)idx;
        if (it >= RITEMS) break;
        ra_item(F, wl, it, part);
    }
}

__device__ __forceinline__ void rs_half(const Ctx& F, int half) {
    if (F.wave != 0) return;
    const unsigned char* RO = (const unsigned char*)F.out + (size_t)(half & 1) * RO_BUF; bf16* OY = (bf16*)(F.ws + WS_OY);
    float* SSg = (float*)((unsigned char*)F.out + RO_SS);
    LAS bf16* ST = (LAS bf16*)F.lds;
    LAS bf16* ZT = (LAS bf16*)(F.lds + 16 * XS * 2);
    constexpr int ZS = 24;
    const int lane = F.lane, r16 = lane & 15, q = lane >> 4;
    for (int blk = blockIdx.x; blk < NB * RHEADS * 4; blk += F.G) {
        const int xcd = blk & 7, jj = blk >> 3, qt = jj & 3, bh = (jj >> 2) * 8 + xcd, b = bh >> 4, h = bh & 15;
        f32x4 S[4];
        if (half == 0) {
#pragma unroll
            for (int kt = 0; kt < 4; ++kt) S[kt] = (f32x4){0.f, 0.f, 0.f, 0.f};
        } else {
#pragma unroll
            for (int kt = 0; kt < 4; ++kt) S[kt] = *(const f32x4*)(SSg + (size_t)blk * 1024 + (kt * 64 + lane) * 4);
        }
#pragma unroll
        for (int kt = 0; kt < 4; ++kt) *(LAS v2u*)(ST + r16 * XS + 16 * kt + 4 * q) = pack4(S[kt]);
        LDS_WAIT(); asm volatile("" ::: "memory");
        const size_t it0 = (size_t)bh * RHALF;
        const size_t mbase = (size_t)b * SEQ + (size_t)half * RHALF * RC;
#define RS_LOAD(IT, WF, RF, A2F, VF, ET4, OL4, GC4) do { const size_t it_ = (IT); \
        const bf16* wh_ = (const bf16*)(RO + RO_WH) + it_ * 1024 + r16 * 64 + 8 * q; const bf16* rh_ = (const bf16*)(RO + RO_RH) + it_ * 1024 + r16 * 64 + 8 * q; \
        WF[0] = *(const bf16x8*)wh_; WF[1] = *(const bf16x8*)(wh_ + 32); RF[0] = *(const bf16x8*)rh_; RF[1] = *(const bf16x8*)(rh_ + 32); \
        _Pragma("unroll") for (int kt_ = 0; kt_ < 4; ++kt_) { A2F[kt_] = *(const bf16x8*)((const bf16*)(RO + RO_A2) + it_ * 2048 + (16 * kt_ + r16) * 32 + 8 * q); \
            GC4[kt_] = *(const f32x4*)((const float*)(RO + RO_GC) + it_ * 64 + 16 * kt_ + 4 * q); } \
        VF = *(const bf16x8*)((const bf16*)(RO + RO_VT) + it_ * 1024 + (16 * qt + r16) * 16 + 8 * (q & 1)); \
        ET4 = *(const v2u*)((const bf16*)(RO + RO_ET) + it_ * 1024 + (16 * qt + r16) * 16 + 4 * q); \
        OL4 = *(const v2u*)((const bf16*)(RO + RO_OL) + it_ * 1024 + r16 * 64 + 16 * qt + 4 * q); } while (0)
        bf16x8 wfq[2][2], rfq[2][2], a2q[2][4], vfq[2]; v2u etq[2], olq[2]; f32x4 gcq[2][4];
#pragma unroll
        for (int u = 0; u < 2; ++u) RS_LOAD(it0 + u, wfq[u], rfq[u], a2q[u], vfq[u], etq[u], olq[u], gcq[u]);
#define RS_STEP(U, CL) do { const int cl_ = (CL); \
            const bf16x8 sb0 = *(const LAS bf16x8*)(ST + r16 * XS + 8 * q), sb1 = *(const LAS bf16x8*)(ST + r16 * XS + 32 + 8 * q); \
            f32x4 x1 = __builtin_amdgcn_mfma_f32_16x16x32_bf16(wfq[U][0], sb0, (f32x4){0.f, 0.f, 0.f, 0.f}, 0, 0, 0); \
            x1 = __builtin_amdgcn_mfma_f32_16x16x32_bf16(wfq[U][1], sb1, x1, 0, 0, 0); \
            f32x4 ot = __builtin_amdgcn_mfma_f32_16x16x32_bf16(sb0, rfq[U][0], unpack4(olq[U]), 0, 0, 0); \
            ot = __builtin_amdgcn_mfma_f32_16x16x32_bf16(sb1, rfq[U][1], ot, 0, 0, 0); \
            *(LAS v2u*)(ZT + r16 * ZS + 4 * q) = pack4(x1 + unpack4(etq[U])); \
            *(v2u*)(OY + (mbase + (size_t)cl_ * RC + r16) * DM + h * 64 + 16 * qt + 4 * q) = pack4(ot); \
            LDS_WAIT(); asm volatile("" ::: "memory"); \
            const bf16x8 zr = *(const LAS bf16x8*)(ZT + r16 * ZS + 8 * (q & 1)); \
            const bf16x8 bz = (q < 2) ? zr : vfq[U]; \
            _Pragma("unroll") for (int kt = 0; kt < 4; ++kt) { S[kt] = __builtin_amdgcn_mfma_f32_16x16x32_bf16(a2q[U][kt], bz, S[kt] * gcq[U][kt], 0, 0, 0); \
                *(LAS v2u*)(ST + r16 * XS + 16 * kt + 4 * q) = pack4(S[kt]); } \
            RS_LOAD(it0 + ((cl_ + 2 < RHALF) ? cl_ + 2 : RHALF - 1), wfq[U], rfq[U], a2q[U], vfq[U], etq[U], olq[U], gcq[U]);     \
            LDS_WAIT(); asm volatile("" ::: "memory"); } while (0)
#pragma unroll 1
        for (int cl = 0; cl < RHALF; cl += 2) { RS_STEP(0, cl); RS_STEP(1, cl + 1); }
#undef RS_STEP
#undef RS_LOAD
        if (half + 1 < NPART) {
#pragma unroll
            for (int kt = 0; kt < 4; ++kt) *(f32x4*)(SSg + (size_t)blk * 1024 + (kt * 64 + lane) * 4) = S[kt];
        }
    }
}
__device__ __forceinline__ float rowmax16(float x) { x = fmaxf(x, dpp_f<0xB1>(x)); x = fmaxf(x, dpp_f<0x4E>(x)); x = fmaxf(x, dpp_f<0x124>(x)); x = fmaxf(x, dpp_f<0x128>(x)); return x; }
__device__ __forceinline__ int cand_code(int s) {
    if (s < 16) return s << 4;
    if (s < 24) return 1 | ((s - 16) << 4);
    if (s < 29) return 2 | ((s - 24) << 4);
    if (s < 33) return 3 | ((s - 29) << 4);
    if (s < 36) return 4 | ((s - 33) << 4);
    if (s < 42) { const int k = s - 36; return (5 + (k >> 1)) | ((k & 1) << 4); }
    if (s < 50) return 8 + (s - 42);
    return -1;
}
__device__ __forceinline__ int f2ord(float f) { const int b = __float_as_int(f); return b ^ ((b >> 31) & 0x7fffffff); }
__device__ __forceinline__ float ord2f(int k) { return __int_as_float(k ^ ((k >> 31) & 0x7fffffff)); }
template <int CTRL> __device__ __forceinline__ int dpp_i(int x) { return __builtin_amdgcn_mov_dpp(x, CTRL, 0xf, 0xf, true); }
__device__ __forceinline__ int imax(int a, int b) { return a > b ? a : b; }
__device__ __forceinline__ int imin(int a, int b) { return a < b ? a : b; }
__device__ __forceinline__ int rowmax16_i(int x) { x = imax(x, dpp_i<0xB1>(x)); x = imax(x, dpp_i<0x4E>(x)); x = imax(x, dpp_i<0x124>(x)); x = imax(x, dpp_i<0x128>(x)); return x; }
#define CSWAP_(a, b) do { const int hi_ = imax(a, b), lo_ = imin(a, b); a = hi_; b = lo_; } while (0)
template <int NV> __device__ __forceinline__ void sort_desc(int (&v)[NV]);
template <> __device__ __forceinline__ void sort_desc<8>(int (&v)[8]) {
    CSWAP_(v[0], v[1]); CSWAP_(v[2], v[3]); CSWAP_(v[4], v[5]); CSWAP_(v[6], v[7]);
    CSWAP_(v[0], v[2]); CSWAP_(v[1], v[3]); CSWAP_(v[4], v[6]); CSWAP_(v[5], v[7]);
    CSWAP_(v[1], v[2]); CSWAP_(v[5], v[6]);
    CSWAP_(v[0], v[4]); CSWAP_(v[1], v[5]); CSWAP_(v[2], v[6]); CSWAP_(v[3], v[7]);
    CSWAP_(v[2], v[4]); CSWAP_(v[3], v[5]);
    CSWAP_(v[1], v[2]); CSWAP_(v[3], v[4]); CSWAP_(v[5], v[6]);
}
template <> __device__ __forceinline__ void sort_desc<4>(int (&v)[4]) {
    CSWAP_(v[0], v[1]); CSWAP_(v[2], v[3]); CSWAP_(v[0], v[2]); CSWAP_(v[1], v[3]); CSWAP_(v[1], v[2]);
}
template <int NV>
__device__ __forceinline__ void select16x4(int (&v)[4][NV], int r16, float (&kept_f)[4]) {
    const int IMIN = (int)0x80000000;
    int kept[4];
#pragma unroll
    for (int j = 0; j < 4; ++j) { kept[j] = IMIN; sort_desc<NV>(v[j]); }
#pragma unroll 1
    for (int rd = 0; rd < 16; ++rd) {
#pragma unroll
        for (int j = 0; j < 4; ++j) {
            const int m = rowmax16_i(v[j][0]);
            kept[j] = (r16 == rd) ? m : kept[j];
            const bool own = (v[j][0] == m);
#pragma unroll
            for (int i = 0; i < NV - 1; ++i) v[j][i] = own ? v[j][i + 1] : v[j][i];
            v[j][NV - 1] = own ? IMIN : v[j][NV - 1];
        }
    }
#pragma unroll
    for (int j = 0; j < 4; ++j) kept_f[j] = ord2f(kept[j]);
}
__device__ __forceinline__ float dot2bf(unsigned a, unsigned b, float acc) { return __builtin_amdgcn_fdot2_f32_bf16(__builtin_bit_cast(bf16x2_t, a), __builtin_bit_cast(bf16x2_t, b), acc, false); }

constexpr int PT = 16;
constexpr size_t RANGE_BYTES = (size_t)NEXP * 128;

__device__ __forceinline__ void p9_route(const Ctx& F) {
    constexpr int KSTR = 136;
    const bf16* Q = (const bf16*)(F.ws + WS_Q); const bf16* KEYS = (const bf16*)(F.ws + WS_KEYS);
    int* rtE = (int*)(F.ws + WS_RTE); float* rtG = (float*)(F.ws + WS_RTG);
    LAS bf16* KL = (LAS bf16*)F.lds;
    const int lane = F.lane, w = F.wave, r16 = lane & 15, q = lane >> 4, gbase = lane & 48;
    const int h = blockIdx.x & 7, nbh = (F.G - h + 7) >> 3;
    __syncthreads();
    for (int i = F.tid; i < 2 * 128 * 16; i += NTHR) { const int row = i >> 4, ch = i & 15;
        *(LAS v4u*)(KL + row * KSTR + 8 * ch) = *(const v4u*)(KEYS + (size_t)(2 * h * 128 + row) * 128 + 8 * ch); }
    __syncthreads();
    int ci[4], cj[4]; bool cvalid[4];
#pragma unroll
    for (int u = 0; u < 4; ++u) { const int cd = cand_code(r16 + 16 * u); cvalid[u] = cd >= 0; ci[u] = cd & 15; cj[u] = (cd >> 4) & 15; }
    const float NINF = -__builtin_inff();
    const int tstride = nbh * NWAVES;
    int tile = (blockIdx.x >> 3) * NWAVES + w;
    bf16x8 afn[2][4];
    if (tile < M / PT) {
#pragma unroll
        for (int p = 0; p < 2; ++p)
#pragma unroll
            for (int s = 0; s < 4; ++s) afn[p][s] = *(const bf16x8*)(Q + (size_t)(tile * PT + r16) * DM + (2 * h + p) * 128 + 8 * q + 32 * s);
    }
    for (; tile < M / PT; tile += tstride) {
        const int m0 = tile * PT;
        bf16x8 af[2][4];
#pragma unroll
        for (int p = 0; p < 2; ++p)
#pragma unroll
            for (int s = 0; s < 4; ++s) af[p][s] = afn[p][s];
        { const int tn = (tile + tstride < M / PT) ? tile + tstride : tile;
#pragma unroll
            for (int p = 0; p < 2; ++p)
#pragma unroll
                for (int s = 0; s < 4; ++s) afn[p][s] = *(const bf16x8*)(Q + (size_t)(tn * PT + r16) * DM + (2 * h + p) * 128 + 8 * q + 32 * s);
        }
        float top[2][4];
#pragma unroll
        for (int p = 0; p < 2; ++p) {
            int v[4][8];
#pragma unroll
            for (int nt = 0; nt < 8; ++nt) {
                const LAS bf16* krow = KL + (p * 128 + nt * 16 + r16) * KSTR + 8 * q;
                f32x4 acc = {0.f, 0.f, 0.f, 0.f};
#pragma unroll
                for (int s = 0; s < 4; ++s) acc = __builtin_amdgcn_mfma_f32_16x16x32_bf16(af[p][s], *(const LAS bf16x8*)(krow + 32 * s), acc, 0, 0, 0);
                const unsigned tag = 127u - (unsigned)(nt * 16 + r16);
#pragma unroll
                for (int j = 0; j < 4; ++j) v[j][nt] = f2ord(__uint_as_float((__float_as_uint(acc[j]) & ~127u) | tag));
                if (nt & 1) asm volatile("" ::: "memory");
            }
            select16x4<8>(v, r16, top[p]);
        }
        int cv[4][4];
#pragma unroll
        for (int u = 0; u < 4; ++u)
#pragma unroll
            for (int j = 0; j < 4; ++j) {
                const float a = __shfl(top[0][j], gbase + ci[u]), b = __shfl(top[1][j], gbase + cj[u]);
                const float cs = __uint_as_float(__float_as_uint(a) & ~127u) + __uint_as_float(__float_as_uint(b) & ~127u);
                const float pk = __uint_as_float((__float_as_uint(cs) & ~63u) | (63u - (unsigned)(r16 + 16 * u)));
                cv[j][u] = cvalid[u] ? f2ord(pk) : (int)0x80000000;
            }
        float best[4];
        select16x4<4>(cv, r16, best);
#pragma unroll
        for (int j = 0; j < 4; ++j) {
            const unsigned bb = __float_as_uint(best[j]);
            const int cd = cand_code(63 - (int)(bb & 63u));
            const int k0 = 127 - (int)(__float_as_uint(__shfl(top[0][j], gbase + (cd & 15))) & 127u);
            const int k1 = 127 - (int)(__float_as_uint(__shfl(top[1][j], gbase + ((cd >> 4) & 15))) & 127u);
            const float s = __uint_as_float(bb & ~63u);
            const float mx = rowmax16(s), e = __expf(s - mx), sum = rowsum16(e);
            const size_t o = (size_t)(m0 + 4 * q + j) * 128 + h * 16 + r16;
            rtE[o] = k0 * 128 + k1; rtG[o] = e * rcp_f(sum);
        }
    }
}

__device__ __forceinline__ f32x2 cvt2_fp8(unsigned wd, bool hi) { return hi ? __builtin_amdgcn_cvt_pk_f32_fp8((int)wd, true) : __builtin_amdgcn_cvt_pk_f32_fp8((int)wd, false); }
__device__ __forceinline__ void treduce8x16(const float (&p)[16], bool b0, bool b1, bool b2, float& r0, float& r1) {
    float a[8], bq[4];
#pragma unroll
    for (int i = 0; i < 8; ++i) { const float mine = b2 ? p[i + 8] : p[i], send = b2 ? p[i] : p[i + 8]; const float up = dpp_f<0x104>(send), dn = dpp_f<0x114>(send); a[i] = mine + (b2 ? dn : up); }
#pragma unroll
    for (int i = 0; i < 4; ++i) { const float mine = b1 ? a[i + 4] : a[i], send = b1 ? a[i] : a[i + 4]; bq[i] = mine + dpp_f<0x4E>(send); }
    { const float mine = b0 ? bq[2] : bq[0], send = b0 ? bq[0] : bq[2]; r0 = mine + dpp_f<0xB1>(send); }
    { const float mine = b0 ? bq[3] : bq[1], send = b0 ? bq[1] : bq[3]; r1 = mine + dpp_f<0xB1>(send); }
}
struct XGroup { int xg, gwi, stride; };
__device__ __forceinline__ XGroup xgroup(const Ctx& F) { XGroup g; g.xg = blockIdx.x & 7; const int nbg = (F.G - g.xg + 7) >> 3; g.gwi = (blockIdx.x >> 3) * NWAVES + F.wave; g.stride = nbg * NWAVES; return g; }

__device__ __forceinline__ void p10_peer_u(const Ctx& F) {
    const unsigned char* PU8 = F.ws + WS_PU8; const bf16* XN = (const bf16*)(F.ws + WS_XN);
    const int* rtE = (const int*)(F.ws + WS_RTE); unsigned* PD = (unsigned*)(F.ws + WS_PD);
    const XGroup g = xgroup(F);
    const int lane = F.lane, j = lane >> 3, sub = lane & 7;
    const bool b0 = sub & 1, b1 = sub & 2, b2 = sub & 4;
    for (int rr = 0; rr < 2; ++rr) {
        const int r = g.xg + 8 * rr;
        const unsigned char* tab = PU8 + (size_t)r * RANGE_BYTES + 16 * sub;
        int m = g.gwi;
        v4u ev[4], xs[2];
        if (m < M) {
#pragma unroll
            for (int i = 0; i < 4; ++i) ev[i] = *(const v4u*)(rtE + (size_t)m * 128 + 16 * j + 4 * i);
            xs[0] = *(const v4u*)(XN + (size_t)m * DM + 128 * r + 16 * sub); xs[1] = *(const v4u*)(XN + (size_t)m * DM + 128 * r + 16 * sub + 8);
        }
        for (; m < M; m += g.stride) {
            v4u gt[16];
#pragma unroll
            for (int k = 0; k < 16; ++k) gt[k] = *(const v4u*)(tab + (size_t)ev[k >> 2][k & 3] * 128);
            float x[16]; { float t0[8], t1[8]; unpack8(xs[0], t0); unpack8(xs[1], t1);
#pragma unroll
              for (int i = 0; i < 8; ++i) { x[i] = t0[i]; x[8 + i] = t1[i]; } }
            const int mn = (m + g.stride < M) ? m + g.stride : m;
            {
#pragma unroll
                for (int i = 0; i < 4; ++i) ev[i] = *(const v4u*)(rtE + (size_t)mn * 128 + 16 * j + 4 * i);
                xs[0] = *(const v4u*)(XN + (size_t)mn * DM + 128 * r + 16 * sub); xs[1] = *(const v4u*)(XN + (size_t)mn * DM + 128 * r + 16 * sub + 8);
            }
            float p[16];
#pragma unroll
            for (int k = 0; k < 16; ++k) {
                f32x2 a0 = {0.f, 0.f}, a1 = {0.f, 0.f};
#pragma unroll
                for (int d = 0; d < 4; ++d) { const unsigned wd = gt[k][d];
                    a0 += cvt2_fp8(wd, false) * (f32x2){x[4 * d], x[4 * d + 1]}; a1 += cvt2_fp8(wd, true) * (f32x2){x[4 * d + 2], x[4 * d + 3]}; }
                p[k] = (a0.x + a0.y) + (a1.x + a1.y);
            }
            float r0, r1; treduce8x16(p, b0, b1, b2, r0, r1);
            PD[((size_t)r * M + m) * 64 + lane] = pk2(r0, r1);
        }
    }
}

__device__ __forceinline__ void p11_peer_coef(const Ctx& F) {
    const int* rtE = (const int*)(F.ws + WS_RTE); const float* rtG = (const float*)(F.ws + WS_RTG); const unsigned* PD = (const unsigned*)(F.ws + WS_PD);
    const float* usc = (const float*)(F.ws + WS_USC); const float* vsc = (const float*)(F.ws + WS_VSC); float* COEF = (float*)(F.ws + WS_COEF);
    for (int m = F.gw; m < M; m += F.NGW) {
        const size_t o = (size_t)m * 128 + 2 * F.lane;
        f32x2 d = {0.f, 0.f};
#pragma unroll
        for (int r = 0; r < 16; ++r) { const unsigned pw = PD[((size_t)r * M + m) * 64 + F.lane]; d += (f32x2){bflo(pw), bfhi(pw)}; }
        const int e0 = rtE[o], e1 = rtE[o + 1];
        const f32x2 gt = *(const f32x2*)(rtG + o);
        const float d0 = d.x * usc[e0], d1 = d.y * usc[e1];
        f32x2 c; c.x = gt.x * (0.5f * d0 * (1.f + erff(d0 * 0.70710678f))) * vsc[e0]; c.y = gt.y * (0.5f * d1 * (1.f + erff(d1 * 0.70710678f))) * vsc[e1];
        *(f32x2*)(COEF + o) = c;
    }
}

__device__ __forceinline__ void p12_peer_v(const Ctx& F) {
    const unsigned char* PV4 = F.ws + WS_PV8; const int* rtE = (const int*)(F.ws + WS_RTE); const float* COEF = (const float*)(F.ws + WS_COEF);
    const float* mod = (const float*)(F.ws + WS_MOD);
    const XGroup g = xgroup(F);
    const int lane = F.lane, j = lane >> 3, sub = lane & 7;
    const bool jb0 = j & 1;
    const int r = g.xg;
    const unsigned char* tab = PV4 + (size_t)r * RANGE_BYTES + 16 * sub;
    int m = g.gwi;
    if (m >= M) return;
    const int st = g.stride;
#define PV_LDE(e, mm, hf) { e[0] = *(const v4u*)(rtE + (size_t)(mm) * 128 + 16 * j + 8 * (hf)); e[1] = *(const v4u*)(rtE + (size_t)(mm) * 128 + 16 * j + 8 * (hf) + 4); }
#define PV_LDC(c, mm, hf) { c[0] = *(const f32x4*)(COEF + (size_t)(mm) * 128 + 16 * j + 8 * (hf)); c[1] = *(const f32x4*)(COEF + (size_t)(mm) * 128 + 16 * j + 8 * (hf) + 4); }
#define PV_GATHER(gx, e) { _Pragma("unroll") for (int k = 0; k < 8; ++k) gx[k] = *(const v4u*)(tab + (size_t)e[k >> 2][k & 3] * 128); }
#define PV_ACC(gx, c) { _Pragma("unroll") for (int k = 0; k < 8; ++k) { const float cq = c[k >> 2][k & 3]; const f32x2 cv2 = {cq, cq}; \
        _Pragma("unroll") for (int d = 0; d < 4; ++d) { const unsigned wd = gx[k][d]; \
            acc[4 * d + 0] += cv2 * __builtin_amdgcn_cvt_scalef32_pk_f32_fp4(wd, 1.0f, 0); acc[4 * d + 1] += cv2 * __builtin_amdgcn_cvt_scalef32_pk_f32_fp4(wd, 1.0f, 1); \
            acc[4 * d + 2] += cv2 * __builtin_amdgcn_cvt_scalef32_pk_f32_fp4(wd, 1.0f, 2); acc[4 * d + 3] += cv2 * __builtin_amdgcn_cvt_scalef32_pk_f32_fp4(wd, 1.0f, 3); } } }
    v4u eA1[2], eB0[2], gA[8], gB[8]; f32x4 cA0[2], cA1[2], cB0[2];
    { v4u eA0[2]; PV_LDE(eA0, m, 0); PV_LDC(cA0, m, 0); PV_LDE(eB0, m, 1); PV_LDC(cB0, m, 1);
      const int m1 = (m + st < M) ? m + st : m; PV_LDE(eA1, m1, 0); PV_LDC(cA1, m1, 0);
      PV_GATHER(gA, eA0); }
    for (; m < M; m += st) {
        const int m1 = (m + st < M) ? m + st : m, m2 = (m + 2 * st < M) ? m + 2 * st : m;
        const int col = 256 * r + 32 * sub + 4 * j;
        v2u* orow = (v2u*)((bf16*)(F.ws + WS_HB) + (size_t)m * DM + col);
        const v2u hw = *orow; const f32x4 g2 = *(const f32x4*)(mod + (size_t)(m / SEQ) * MODW + 5 * DM + col);
        PV_GATHER(gB, eB0);
        v4u eB1[2], eA2[2]; f32x4 cB1[2], cA2[2];
        PV_LDE(eB1, m1, 1); PV_LDC(cB1, m1, 1); PV_LDE(eA2, m2, 0); PV_LDC(cA2, m2, 0);
        asm volatile("" : "+v"(gA[0]), "+v"(gA[1]), "+v"(gA[2]), "+v"(gA[3]), "+v"(gA[4]), "+v"(gA[5]), "+v"(gA[6]), "+v"(gA[7]) :: "memory");
        f32x2 acc[16];
#pragma unroll
        for (int i = 0; i < 16; ++i) acc[i] = (f32x2){0.f, 0.f};
        PV_ACC(gA, cA0);
        asm volatile("" ::: "memory");
        PV_GATHER(gA, eA1);
        asm volatile("" : "+v"(gB[0]), "+v"(gB[1]), "+v"(gB[2]), "+v"(gB[3]), "+v"(gB[4]), "+v"(gB[5]), "+v"(gB[6]), "+v"(gB[7]) :: "memory");
        PV_ACC(gB, cB0);
        float a[32];
#pragma unroll
        for (int i = 0; i < 16; ++i) { a[2 * i] = acc[i].x; a[2 * i + 1] = acc[i].y; }
        float s16[16], s8[8];
#pragma unroll
        for (int c = 0; c < 16; ++c) { auto rr2 = __builtin_amdgcn_permlane32_swap(__float_as_uint(a[c]), __float_as_uint(a[c + 16]), false, false); s16[c] = __uint_as_float(rr2[0]) + __uint_as_float(rr2[1]); }
#pragma unroll
        for (int c = 0; c < 8; ++c) { auto rr2 = __builtin_amdgcn_permlane16_swap(__float_as_uint(s16[c]), __float_as_uint(s16[c + 8]), false, false); s8[c] = __uint_as_float(rr2[0]) + __uint_as_float(rr2[1]); }
        f32x4 res;
#pragma unroll
        for (int c = 0; c < 4; ++c) { const float mine = jb0 ? s8[c + 4] : s8[c], send = jb0 ? s8[c] : s8[c + 4]; res[c] = mine + dpp_f<0x128>(send); }
        const f32x4 h1 = {bflo(hw.x), bfhi(hw.x), bflo(hw.y), bfhi(hw.y)};
        const f32x4 h2 = h1 + g2 * res;
        v2u o; o.x = pk2(h2.x, h2.y); o.y = pk2(h2.z, h2.w);
        *orow = o;
#pragma unroll
        for (int i = 0; i < 2; ++i) { cA0[i] = cA1[i]; cA1[i] = cA2[i]; eA1[i] = eA2[i]; eB0[i] = eB1[i]; cB0[i] = cB1[i]; }
    }
#undef PV_LDE
#undef PV_LDC
#undef PV_GATHER
#undef PV_ACC
}
#define XB_TMO      128
#define XB_XCNT(j)  (256  + 64 * (j))
#define XB_XSUB(j)  (1280 + 64 * (j))
#define XB_XGEN(j)  (2304 + 64 * (j))
#define XB_TOP      3328
#define XB_TOPGEN   3392
#define XCD_BAR_WORDS 3456
#define XB_SPIN_CAP (1u << 18)

__device__ __forceinline__ unsigned xb_ld(unsigned* p)              { return __hip_atomic_load(p, __ATOMIC_RELAXED, __HIP_MEMORY_SCOPE_AGENT); }
__device__ __forceinline__ unsigned xb_add(unsigned* p, unsigned v) { return __hip_atomic_fetch_add(p, v, __ATOMIC_RELAXED, __HIP_MEMORY_SCOPE_AGENT); }
__device__ __forceinline__ unsigned xb_xcc_id() { return (unsigned)__builtin_amdgcn_s_getreg((3 << 11) | 20) & 0xFu; }
#define XB_SPIN(cond, bar) do { unsigned _sp = 0; while (cond) { __builtin_amdgcn_s_sleep(1); \
    if ((++_sp & 255u) == 0u) { if (xb_ld(&(bar)[XB_TMO])) break; if (_sp > XB_SPIN_CAP) { atomicAdd(&(bar)[XB_TMO], 1u); break; } } } } while (0)

struct XcdBarrier {
    unsigned* bar; unsigned x;
    volatile LAS unsigned* st;
};

__device__ __forceinline__ XcdBarrier xcd_barrier_post(unsigned* bar, volatile LAS unsigned* st) {
    XcdBarrier b; b.bar = bar; b.x = xb_xcc_id(); b.st = st;
    if (threadIdx.x == 0) (void)xb_add(&bar[XB_XCNT(b.x)], 1u);
    return b;
}
__device__ __forceinline__ void xcd_barrier_complete(unsigned* bar, unsigned x, unsigned& nloc, unsigned& nx) {
    const unsigned G = gridDim.x * gridDim.y * gridDim.z;
    unsigned sum, cnt, mine, sp = 0u;
    for (;;) {
        sum = 0u; cnt = 0u; mine = 0u;
#pragma unroll
        for (unsigned j = 0; j < 16; ++j) { const unsigned c = xb_ld(&bar[XB_XCNT(j)]); sum += c; cnt += (c > 0u) ? 1u : 0u; mine = (j == x) ? c : mine; }
        if (sum == G) break;
        __builtin_amdgcn_s_sleep(1);
        if ((++sp & 255u) == 0u) { if (xb_ld(&bar[XB_TMO])) break; if (sp > XB_SPIN_CAP) { atomicAdd(&bar[XB_TMO], 1u); break; } }
    }
    nloc = mine > 0u ? mine : 1u; nx = cnt > 0u ? cnt : 1u;
}

__device__ __forceinline__ void xcd_barrier(const XcdBarrier& b) {
    asm volatile("s_waitcnt vmcnt(0)" ::: "memory");
    __syncthreads();
    if (threadIdx.x == 0) {
        unsigned* bar = b.bar;
        __builtin_amdgcn_s_waitcnt(0);
        unsigned nloc = b.st[0], nx = b.st[1];
        if (nloc == 0u) { xcd_barrier_complete(bar, b.x, nloc, nx); b.st[0] = nloc; b.st[1] = nx; }
        const unsigned old = xb_add(&bar[XB_XSUB(b.x)], 1u);
        const unsigned gen = old / nloc;
        if (old + 1u == (gen + 1u) * nloc) {
            __builtin_amdgcn_fence(__ATOMIC_RELEASE, "agent");
            asm volatile("s_waitcnt vmcnt(0)" ::: "memory");
            const unsigned og = xb_add(&bar[XB_TOP], 1u);
            const unsigned tg = og / nx;
            if (og + 1u == (tg + 1u) * nx) xb_add(&bar[XB_TOPGEN], 1u);
            else XB_SPIN(xb_ld(&bar[XB_TOPGEN]) == tg, bar);
            __builtin_amdgcn_fence(__ATOMIC_ACQUIRE, "agent");
            xb_add(&bar[XB_XGEN(b.x)], 1u);
            asm volatile("s_waitcnt vmcnt(0)" ::: "memory");
        } else {
            XB_SPIN(xb_ld(&bar[XB_XGEN(b.x)]) == gen, bar);
            __builtin_amdgcn_fence(__ATOMIC_ACQUIRE, "agent");
            asm volatile("s_waitcnt vmcnt(0)" ::: "memory");
        }
    }
    __syncthreads();
}

struct Args { const float* in[N_IN]; float* out; unsigned char* ws; int ph_lo, ph_hi; };
constexpr int N_PHASES = 19;

__global__ void __launch_bounds__(NTHR, 2) fwd_kernel(Args args) {
    extern __shared__ __attribute__((aligned(16))) unsigned char lds_raw[];
    cg::grid_group grid = cg::this_grid();
    Ctx F;
    F.lds = (LAS unsigned char*)lds_raw;
    F.tid = threadIdx.x; F.lane = F.tid & 63; F.wave = __builtin_amdgcn_readfirstlane(F.tid >> 6);
    F.G = gridDim.x; F.gw = blockIdx.x * NWAVES + F.wave; F.NGW = F.G * NWAVES;
    F.in = args.in; F.out = args.out; F.ws = args.ws;
    const int lo = args.ph_lo, hi = args.ph_hi;
    volatile LAS unsigned* bst = (volatile LAS unsigned*)(F.lds + LDS_BYTES - 64);
    if (F.tid < 2) bst[F.tid] = 0u;
    if (F.tid < 4) ((volatile LAS unsigned*)(F.lds + LDS_BYTES - 48))[F.tid] = 0u;
    __syncthreads();
    const XcdBarrier bar = xcd_barrier_post((unsigned*)(F.ws + WS_CTL) + 4096, bst);
#define IN(k) (lo <= (k) && (k) < hi)
#ifndef TS_A
#define TS_A -1
#define TS_B -1
#define TS_K 0.1
#endif
    unsigned long long* stamps = (unsigned long long*)(F.ws + WS_CTL + 65536);
#define STAMP(k) do { if (TS_A >= 0 && blockIdx.x == 0 && F.tid == 0) stamps[k] = __builtin_amdgcn_s_memrealtime(); } while (0)
#define REP_MASK 0
#ifndef REP_MASK
#define REP_MASK 0
#endif
#define REPS(k) for (int rep_ = 0; rep_ < 1 + ((REP_MASK >> (k)) & 1); ++rep_)
#define SEAM(k) do { if (IN(k) && IN((k) + 1)) { if ((k) == 0) grid.sync(); else xcd_barrier(bar); } } while (0)

    STAMP(0);
    if (IN(0)) REPS(0) { p0_prologue(F); }
    SEAM(0);
    STAMP(1);
    if (IN(1)) REPS(1) { norm_mod_rows(F, F.in[I_X], F.in[I_N1W], 0, DM, (bf16*)(F.ws + WS_XN)); }
    SEAM(1);
    STAMP(2);
    if (IN(2)) REPS(2) {
        pg8::Gemm g{(const pg8::bf16_t*)(F.ws + WS_XN), (const pg8::bf16_t*)(F.ws + WS_WIN), M, INPP, DM};
        pg8::StaticOrder S; S.init(M, INPP, F.G, (int)blockIdx.x);
        pg8::EpiStoreBf16 E{(pg8::bf16_t*)(F.ws + WS_PROJ), INPP};
        pg8::gemm_phase<pg8::EpiStoreBf16, pg8::StaticOrder, true, true>(F.lds, g, S, E);
    }
    SEAM(2);
#ifndef P3REP
#define P3REP 0
#endif
    STAMP(3);
    if (IN(3)) REPS(3) { p3_lora(F); STAMP(40); m1_chunk_states(F); }
    SEAM(3);
    STAMP(4);
    if (IN(4)) { m2_prefix(F); ra_part(F, 0); }
    SEAM(4);
    STAMP(5);
    if (IN(5)) { rs_half(F, 0); ra_part(F, 1); }
    SEAM(5);
    STAMP(6);
    if (IN(6)) { rs_half(F, 1); ra_part(F, 2); }
    SEAM(6);
    STAMP(7);
    if (IN(7)) { rs_half(F, 2); ra_part(F, 3); }
    SEAM(7);
    STAMP(8);
    if (IN(8)) { rs_half(F, 3); }
    STAMP(9);
    if (IN(9)) REPS(9) { m3_outputs(F); }
    SEAM(9);
    STAMP(10);
    if (IN(10)) { p5_post(F); }
    SEAM(10);
    STAMP(11);
    if (IN(11)) REPS(11) {
        pg8::Gemm g{(const pg8::bf16_t*)(F.ws + WS_OY), (const pg8::bf16_t*)(F.ws + WS_WOUT), M, DM, DM};
        pg8::StaticOrder S; S.init(M, DM, F.G, (int)blockIdx.x);
        pg8::EpiResid E{F.in[I_X], (const float*)(F.ws + WS_MOD) + 2 * DM, (pg8::bf16_t*)(F.ws + WS_HB), DM, SEQ, MODW};
        pg8::gemm_phase<pg8::EpiResid, pg8::StaticOrder, true, true>(F.lds, g, S, E);
    }
    SEAM(11);
    STAMP(12);
    if (IN(12)) REPS(12) { norm_mod_rows_bf16(F, (const bf16*)(F.ws + WS_HB), F.in[I_N2W], 3 * DM, 4 * DM, (bf16*)(F.ws + WS_XN)); }
    SEAM(12);
    STAMP(13);
    if (IN(13)) REPS(13) {
        pg8::Gemm g{(const pg8::bf16_t*)(F.ws + WS_XN), (const pg8::bf16_t*)(F.ws + WS_WQ), M, DM, DM};
        pg8::StaticOrder S; S.init(M, DM, F.G, (int)blockIdx.x);
        pg8::EpiStoreBf16 E{(pg8::bf16_t*)(F.ws + WS_Q), DM};
        pg8::gemm_phase<pg8::EpiStoreBf16, pg8::StaticOrder, true, true>(F.lds, g, S, E);
    }
    SEAM(13);
    STAMP(14);
    if (IN(14)) REPS(14) { p9_route(F); }
    SEAM(14);
    STAMP(15);
    if (IN(15)) REPS(15) { p10_peer_u(F); }
    SEAM(15);
    STAMP(16);
    if (IN(16)) REPS(16) { p11_peer_coef(F); }
    SEAM(16);
    STAMP(17);
    if (IN(17)) { p12_peer_v(F); }
    SEAM(17);
    STAMP(18);
    if (IN(18)) {
        float oscale = 1.f;
        if (TS_A >= 0) { const volatile unsigned long long* st = stamps; const float frac = (float)(st[TS_B] - st[TS_A]) / (float)(st[17] - st[0]); oscale = 1.f + (float)(TS_K) * frac; }
        final_norm_rows_bf16(F, (const bf16*)(F.ws + WS_HB), F.in[I_FNW], F.out, oscale);
    }
#undef IN
#undef SEAM
}

extern "C" void kernel_launch(void* const* d_in, const int* in_sizes, int n_in, void* d_out, int out_size, void* d_ws, size_t ws_size, hipStream_t stream) {
    static int grid = 0;
    if (grid == 0) {
        if (n_in != N_IN || in_sizes[0] != M * DM || out_size != M * DM || ws_size < WS_END2) {
            fprintf(stderr, "kernel_launch: unexpected shapes: n_in %d in0 %d out %d ws %zu (need %zu)\n", n_in, n_in > 0 ? in_sizes[0] : -1, out_size, ws_size, (size_t)WS_END2); grid = -1; return; }
        int dev = 0, cus = 0, per_cu = 0;
        if (hipGetDevice(&dev) != hipSuccess || hipDeviceGetAttribute(&cus, hipDeviceAttributeMultiprocessorCount, dev) != hipSuccess) { grid = -1; return; }
        if (hipFuncSetAttribute((const void*)fwd_kernel, hipFuncAttributeMaxDynamicSharedMemorySize, LDS_BYTES) != hipSuccess) { fprintf(stderr, "kernel_launch: hipFuncSetAttribute failed\n"); grid = -1; return; }
        if (hipOccupancyMaxActiveBlocksPerMultiprocessor(&per_cu, (const void*)fwd_kernel, NTHR, LDS_BYTES) != hipSuccess || per_cu < 1) { fprintf(stderr, "kernel_launch: occupancy query says %d blocks per CU\n", per_cu); per_cu = 1; }
        (void)hipGetLastError();
        grid = cus;
        fprintf(stderr, "kernel_launch: cus %d per_cu %d grid %d ws %zu\n", cus, per_cu, grid, ws_size);
    }
    if (grid < 0) return;
    (void)hipMemsetAsync((char*)d_ws + WS_CTL, 0, CTL_ZERO_BYTES, stream);
    Args a{};
    for (int i = 0; i < N_IN; ++i) a.in[i] = (const float*)d_in[i];
    a.out = (float*)d_out; a.ws = (unsigned char*)d_ws; a.ph_lo = 0; a.ph_hi = N_PHASES;
    void* kargs[] = {&a};
#ifndef NPASS
#define NPASS 1
#endif
    hipError_t e = hipSuccess;
    for (int pass_ = 0; pass_ < NPASS; ++pass_) {
        if (pass_ > 0) (void)hipMemsetAsync((char*)d_ws + WS_CTL, 0, CTL_ZERO_BYTES, stream);
        e = hipLaunchCooperativeKernel((const void*)fwd_kernel, dim3(grid), dim3(NTHR), kargs, LDS_BYTES, stream);
    }
    if (e != hipSuccess) fprintf(stderr, "kernel_launch: cooperative launch failed: %s (grid %d)\n", hipGetErrorString(e), grid);
}
```

```cpp
#include <hip/hip_runtime.h>
#include <hip/hip_cooperative_groups.h>
#include <cstdio>
#include <cstdint>
namespace cg = cooperative_groups;
namespace pg8 {
#define PG8_LAS __attribute__((address_space(3)))
typedef unsigned short bf16_t;
typedef short bf16x8 __attribute__((ext_vector_type(8)));
typedef float f32x4 __attribute__((ext_vector_type(4)));
typedef unsigned u32x4 __attribute__((ext_vector_type(4)));
constexpr int BM = 256, BK = 64, HALF = 128, HTB = HALF * BK * 2  , STAGE_BYTES = 8 * HTB, NXCD = 8, WGM = 8;

__host__ __device__ __forceinline__ int lds_byte(int r, int c) { const int st = (r >> 4) * 2 + (c >> 5), rr = r & 15, cc = c & 31, ob = rr * 64 + cc * 2; return st * 1024 + (ob ^ (((ob >> 9) & 1) << 5)); }
__host__ __device__ __forceinline__ void stage_rc(int b, int& R, int& C) { const int st = b / 1024, sb = b % 1024, swz = sb ^ (((sb >> 9) & 1) << 5); R = (st >> 1) * 16 + swz / 64; C = (st & 1) * 32 + (swz % 64) / 2; }
__host__ __device__ __forceinline__ int perm32(int rho) { const int n = rho >> 4, i = rho & 15; return 8 * (i >> 2) + 4 * n + (i & 3); }

struct Unit { int pm, pn; };
struct Gemm { const bf16_t* A; const bf16_t* Bt; int M, N, K; };

struct StaticOrder {
    int nM, nN, nwg, G, c;
    __host__ __device__ void init(int M, int N, int G_, int c_) { nM = M / BM; nN = N / BM; nwg = nM * nN; G = G_; c = c_; }
    __host__ __device__ bool next(int i, Unit& u) const {
        const long L = (long)i * G + c; if (L >= nwg) return false;
        int wgid = (int)L; { const int q = nwg / NXCD, r = nwg % NXCD, xcd = wgid % NXCD, off = wgid / NXCD; wgid = (xcd < r ? xcd * (q + 1) : r * (q + 1) + (xcd - r) * q) + off; }
        const int nig = WGM * nN, gid = wgid / nig, fm = gid * WGM, gsz = (nM - fm) < WGM ? (nM - fm) : WGM;
        u.pm = fm + ((wgid % nig) % gsz); u.pn = (wgid % nig) / gsz; return true;
    }
    __device__ __forceinline__ void a_ready(const Unit&) const {}
    __device__ __forceinline__ void done(const Unit&) const {}
};
__device__ __forceinline__ unsigned cvt_pk_bf16(float lo, float hi) { unsigned r; asm volatile("v_cvt_pk_bf16_f32 %0, %1, %2" : "=v"(r) : "v"(lo), "v"(hi)); return r; }
struct EpiStoreBf16 {
    static constexpr bool PERM = true, AFTER_DRAIN = false;
    bf16_t* O; int ldc;
    __device__ __forceinline__ void operator()(const f32x4 (&acc)[2][2][4][2], const Unit& u, int wr, int wc, int fr, int fq) const {
        const int row0 = u.pm * BM + wr * 64 + fr; const int col0 = u.pn * BM + wc * 32 + 8 * fq;
#pragma unroll
        for (int ai = 0; ai < 2; ++ai)
#pragma unroll
            for (int m = 0; m < 4; ++m) { bf16_t* rowp = O + (size_t)(row0 + ai * HALF + m * 16) * ldc + col0;
#pragma unroll
                for (int bj = 0; bj < 2; ++bj) { const f32x4 v0 = acc[ai][bj][m][0], v1 = acc[ai][bj][m][1];
                    u32x4 w; w.x = cvt_pk_bf16(v0[0], v0[1]); w.y = cvt_pk_bf16(v0[2], v0[3]); w.z = cvt_pk_bf16(v1[0], v1[1]); w.w = cvt_pk_bf16(v1[2], v1[3]);
                    *(u32x4*)(rowp + bj * HALF) = w; } }
    }
};
struct EpiResid {
    static constexpr bool PERM = true, AFTER_DRAIN = false;
    const float* X; const float* gate; bf16_t* O; int ldc; int rows_per_batch; int gstride;
    __device__ __forceinline__ void operator()(const f32x4 (&acc)[2][2][4][2], const Unit& u, int wr, int wc, int fr, int fq) const {
        const int row0 = u.pm * BM + wr * 64 + fr; const int col0 = u.pn * BM + wc * 32 + 8 * fq;
        const float* g = gate + (size_t)((u.pm * BM) / rows_per_batch) * gstride + col0;
        f32x4 gv[2][2];
#pragma unroll
        for (int bj = 0; bj < 2; ++bj)
#pragma unroll
            for (int n = 0; n < 2; ++n) gv[bj][n] = *(const f32x4*)(g + bj * HALF + 4 * n);
#pragma unroll
        for (int ai = 0; ai < 2; ++ai)
#pragma unroll
            for (int m = 0; m < 4; ++m) { const size_t off = (size_t)(row0 + ai * HALF + m * 16) * ldc + col0;
#pragma unroll
                for (int bj = 0; bj < 2; ++bj) { const f32x4 x0 = *(const f32x4*)(X + off + bj * HALF), x1 = *(const f32x4*)(X + off + bj * HALF + 4);
                    const f32x4 v0 = x0 + gv[bj][0] * acc[ai][bj][m][0], v1 = x1 + gv[bj][1] * acc[ai][bj][m][1];
                    u32x4 w; w.x = cvt_pk_bf16(v0[0], v0[1]); w.y = cvt_pk_bf16(v0[2], v0[3]); w.z = cvt_pk_bf16(v1[0], v1[1]); w.w = cvt_pk_bf16(v1[2], v1[3]);
                    *(u32x4*)(O + off + bj * HALF) = w; } }
    }
};
template <class Epi, class Sched, bool ALIGN_EPI = false, bool SP2 = false>
__device__ __forceinline__ void gemm_phase(PG8_LAS unsigned char* lds, const Gemm g, const Sched& S, const Epi& E) {
    const int tid = threadIdx.x, wid = __builtin_amdgcn_readfirstlane(tid >> 6), lane = tid & 63, wr = wid >> 2, wc = wid & 3, fr = lane & 15, fq = lane >> 4;
    const int K = g.K, nt = K / BK;
    unsigned voffA[2], voffB[2];
#pragma unroll
    for (int i = 0; i < 2; ++i) { int R, C; stage_rc(tid * 16 + i * 8192, R, C); const int Rb = Epi::PERM ? ((R & ~31) + perm32(R & 31)) : R;
        voffA[i] = (unsigned)(R * K + C) * 2u; voffB[i] = (unsigned)(Rb * K + C) * 2u; }
    const size_t kstep = (size_t)(BK * 2);
    const size_t hstep = (size_t)HALF * K * 2;
    const size_t tstep = 2 * hstep;
    const unsigned ldsw = (unsigned)wid * 1024u;
    const int aoff = lds_byte(wr * 64 + fr, fq * 8), boff = lds_byte(wc * 32 + fr, fq * 8);
#define PG8_SA(b, h) (((b) * 2 + (h)) * HTB)
#define PG8_SB(b, h) ((4 + (b) * 2 + (h)) * HTB)
#define PG8_STAGE(bufoff, gbase, voff) do { _Pragma("unroll") for (int _i = 0; _i < 2; ++_i) \
        __builtin_amdgcn_global_load_lds((const unsigned*)((const char*)(gbase) + (voff)[_i]), (PG8_LAS unsigned*)(lds + (bufoff) + ldsw + _i * 8192), 16, 0, 0); } while (0)
#define PG8_LDA(dst, b, h) do { _Pragma("unroll") for (int m = 0; m < 4; ++m) _Pragma("unroll") for (int k = 0; k < 2; ++k) dst[m][k] = *(const PG8_LAS bf16x8*)(lds + PG8_SA(b, h) + aoff + m * 2048 + k * 1024); } while (0)
#define PG8_LDB(dst, b, h) do { _Pragma("unroll") for (int n = 0; n < 2; ++n) _Pragma("unroll") for (int k = 0; k < 2; ++k) dst[n][k] = *(const PG8_LAS bf16x8*)(lds + PG8_SB(b, h) + boff + n * 2048 + k * 1024); } while (0)
#define PG8_MMA(ai, bj, At, Bt) do { __builtin_amdgcn_s_setprio(1); _Pragma("unroll") for (int m = 0; m < 4; ++m) _Pragma("unroll") for (int n = 0; n < 2; ++n) _Pragma("unroll") for (int k = 0; k < 2; ++k) \
        acc[ai][bj][m][n] = __builtin_amdgcn_mfma_f32_16x16x32_bf16(Bt[n][k], At[m][k], acc[ai][bj][m][n], 0, 0, 0); __builtin_amdgcn_s_setprio(0); } while (0)
#define PG8_WAIT_V(n) asm volatile("s_waitcnt vmcnt(" #n ")" ::: "memory")
#define PG8_WAIT_L(n) asm volatile("s_waitcnt lgkmcnt(" #n ")" ::: "memory")
#define PG8_BAR __builtin_amdgcn_s_barrier()
#define PG8_SCHED __builtin_amdgcn_sched_barrier(0)
    Unit cur, nxt; int ui = 0;
    if (!S.next(0, cur)) return;
    f32x4 acc[2][2][4][2];
#pragma unroll
    for (int a = 0; a < 2; ++a)
#pragma unroll
        for (int b = 0; b < 2; ++b)
#pragma unroll
            for (int m = 0; m < 4; ++m)
#pragma unroll
                for (int n = 0; n < 2; ++n) acc[a][b][m][n] = (f32x4){0.f, 0.f, 0.f, 0.f};
    bf16x8 At[4][2], B0[2][2], B1[2][2];
    const char* cA = (const char*)g.A + (size_t)cur.pm * tstep; const char* cB = (const char*)g.Bt + (size_t)cur.pn * tstep;
    S.a_ready(cur);
    if constexpr (SP2) {
        PG8_STAGE(PG8_SB(0, 0), cB, voffB); PG8_STAGE(PG8_SB(0, 1), cB + hstep, voffB); PG8_STAGE(PG8_SA(0, 0), cA, voffA); PG8_STAGE(PG8_SA(0, 1), cA + hstep, voffA);
        if (wr == 1) PG8_BAR;
        PG8_WAIT_V(2); PG8_BAR;
        PG8_STAGE(PG8_SB(1, 0), cB + kstep, voffB); PG8_STAGE(PG8_SA(1, 0), cA + kstep, voffA); PG8_STAGE(PG8_SB(1, 1), cB + hstep + kstep, voffB);
        PG8_WAIT_V(6); PG8_BAR;
    } else {
        PG8_STAGE(PG8_SB(0, 0), cB, voffB); PG8_STAGE(PG8_SA(0, 0), cA, voffA); PG8_STAGE(PG8_SB(0, 1), cB + hstep, voffB); PG8_STAGE(PG8_SA(0, 1), cA + hstep, voffA);
        if (wr == 1) PG8_BAR;
        PG8_WAIT_V(4); PG8_BAR;
        PG8_STAGE(PG8_SB(1, 0), cB + kstep, voffB); PG8_STAGE(PG8_SA(1, 0), cA + kstep, voffA); PG8_STAGE(PG8_SB(1, 1), cB + hstep + kstep, voffB);
        PG8_WAIT_V(6); PG8_BAR;
    }
    for (;;) {
        const bool has_next = S.next(ui + 1, nxt);
        const char* nA = has_next ? (const char*)g.A + (size_t)nxt.pm * tstep : cA; const char* nB = has_next ? (const char*)g.Bt + (size_t)nxt.pn * tstep : cB;
        for (int t = 0; t < nt; t += 2) {
            const bool last = (t == nt - 2);
            const char* a1 = cA + (size_t)(t + 1) * kstep;
            const char* a2 = last ? nA : cA + (size_t)(t + 2) * kstep; const char* b2 = last ? nB : cB + (size_t)(t + 2) * kstep;
            const char* a3 = a2 + kstep; const char* b3 = b2 + kstep;
            if (last && has_next) S.a_ready(nxt);
            if constexpr (SP2) {
            PG8_LDB(B0, 0, 0); PG8_LDB(B1, 0, 1); PG8_SCHED; PG8_LDA(At, 0, 0); PG8_STAGE(PG8_SA(1, 1), a1 + hstep, voffA);
            PG8_WAIT_V(8); PG8_WAIT_L(0); PG8_BAR; PG8_MMA(0, 0, At, B0); PG8_MMA(0, 1, At, B1); PG8_BAR; PG8_SCHED;
            PG8_LDA(At, 0, 1); PG8_STAGE(PG8_SB(0, 0), b2, voffB); PG8_STAGE(PG8_SB(0, 1), b2 + hstep, voffB); PG8_STAGE(PG8_SA(0, 0), a2, voffA);
            PG8_WAIT_V(8); PG8_WAIT_L(0); PG8_BAR; PG8_MMA(1, 0, At, B0); PG8_MMA(1, 1, At, B1); PG8_BAR; PG8_SCHED;
            PG8_LDB(B0, 1, 0); PG8_LDB(B1, 1, 1); PG8_SCHED; PG8_LDA(At, 1, 0); PG8_STAGE(PG8_SA(0, 1), a2 + hstep, voffA);
            PG8_WAIT_V(8); PG8_WAIT_L(0); PG8_BAR; PG8_MMA(0, 0, At, B0); PG8_MMA(0, 1, At, B1); PG8_BAR; PG8_SCHED;
            PG8_LDA(At, 1, 1); PG8_STAGE(PG8_SB(1, 0), b3, voffB); PG8_STAGE(PG8_SB(1, 1), b3 + hstep, voffB); PG8_STAGE(PG8_SA(1, 0), a3, voffA);
            PG8_WAIT_V(8); PG8_WAIT_L(0); PG8_BAR; PG8_MMA(1, 0, At, B0); PG8_MMA(1, 1, At, B1); PG8_BAR; PG8_SCHED;
            } else {
            PG8_LDB(B0, 0, 0); PG8_SCHED; PG8_LDA(At, 0, 0); PG8_STAGE(PG8_SA(1, 1), a1 + hstep, voffA);
            PG8_WAIT_L(8); PG8_BAR; PG8_WAIT_L(0); PG8_MMA(0, 0, At, B0); PG8_BAR; PG8_SCHED;
            PG8_LDB(B1, 0, 1); PG8_STAGE(PG8_SB(0, 0), b2, voffB);
            PG8_BAR; PG8_WAIT_L(0); PG8_MMA(0, 1, At, B1); PG8_BAR;
            PG8_LDA(At, 0, 1); PG8_STAGE(PG8_SA(0, 0), a2, voffA);
            PG8_BAR; PG8_WAIT_L(0); PG8_MMA(1, 0, At, B0); PG8_BAR; PG8_SCHED;
            PG8_STAGE(PG8_SB(0, 1), b2 + hstep, voffB);
            PG8_WAIT_V(6); PG8_BAR; PG8_MMA(1, 1, At, B1); PG8_BAR;
            PG8_LDB(B0, 1, 0); PG8_SCHED; PG8_LDA(At, 1, 0); PG8_STAGE(PG8_SA(0, 1), a2 + hstep, voffA);
            PG8_WAIT_L(8); PG8_BAR; PG8_WAIT_L(0); PG8_MMA(0, 0, At, B0); PG8_BAR; PG8_SCHED;
            PG8_LDB(B1, 1, 1); PG8_STAGE(PG8_SB(1, 0), b3, voffB);
            PG8_BAR; PG8_WAIT_L(0); PG8_MMA(0, 1, At, B1); PG8_BAR;
            PG8_LDA(At, 1, 1); PG8_STAGE(PG8_SA(1, 0), a3, voffA);
            PG8_BAR; PG8_WAIT_L(0); PG8_MMA(1, 0, At, B0); PG8_BAR; PG8_SCHED;
            PG8_STAGE(PG8_SB(1, 1), b3 + hstep, voffB);
            PG8_WAIT_V(6); PG8_BAR; PG8_MMA(1, 1, At, B1); PG8_BAR;
            }
        }
        if constexpr (ALIGN_EPI) { if (wr == 0) PG8_BAR; }
        if constexpr (!Epi::AFTER_DRAIN) { E(acc, cur, wr, wc, fr, fq); S.done(cur); }
        if (!has_next) break;
#pragma unroll
        for (int a = 0; a < 2; ++a)
#pragma unroll
            for (int b = 0; b < 2; ++b)
#pragma unroll
                for (int m = 0; m < 4; ++m)
#pragma unroll
                    for (int n = 0; n < 2; ++n) acc[a][b][m][n] = (f32x4){0.f, 0.f, 0.f, 0.f};
        cur = nxt; cA = nA; cB = nB; ++ui;
        if constexpr (ALIGN_EPI) { if (wr == 1) PG8_BAR; }
    }
    PG8_WAIT_V(0);
    if constexpr (!ALIGN_EPI) { if (wr == 0) PG8_BAR; }
    PG8_BAR;
    if constexpr (Epi::AFTER_DRAIN) { E.fused(acc, cur, wr, wc, fr, fq, lds, wid, lane); S.done(cur); }
#undef PG8_SA
#undef PG8_SB
#undef PG8_STAGE
#undef PG8_LDA
#undef PG8_LDB
#undef PG8_MMA
#undef PG8_WAIT_V
#undef PG8_WAIT_L
#undef PG8_BAR
#undef PG8_SCHED
}
}
#define GAS __attribute__((address_space(1)))
#define LAS __attribute__((address_space(3)))
typedef unsigned short bf16;
typedef unsigned v4u __attribute__((ext_vector_type(4)));
typedef unsigned v2u __attribute__((ext_vector_type(2)));
typedef float f32x4 __attribute__((ext_vector_type(4)));
typedef float f32x2 __attribute__((ext_vector_type(2)));
typedef short bf16x8 __attribute__((ext_vector_type(8)));
typedef __bf16 bf16x2_t __attribute__((ext_vector_type(2)));

constexpr int NWAVES = 8, NTHR = 512;
constexpr int DM = 2048, NB = 4, SEQ = 8192, M = NB * SEQ;
constexpr int RW = 1024, RHEADS = 16, HD = 64;
constexpr int L_W = 64, L_A = 64, L_G = 160;
constexpr int INP = 5936, INPP = 6144;
constexpr int C_R = 0, C_K = 1024, C_V = 2048, C_WD = 3072, C_AD = 3136, C_GD = 3200, C_Z = 3360, C_XBC = 4384, C_DT = 5920;
constexpr int MODW = 6 * DM;
constexpr int NEXP = 16384;
constexpr float RMS_EPS = 1e-6f;

enum { I_X = 0, I_C, I_ADAW, I_ADAB, I_N1W, I_WIN, I_MU, I_W0, I_WUP, I_A0, I_AUP, I_GUP, I_KK, I_KA, I_RK, I_LNW, I_LNB,
       I_CONVW, I_CONVB, I_DTB, I_ALOG, I_DSK, I_MNW, I_WOUT, I_N2W, I_WQ, I_KEYS, I_PU, I_PV, I_FNW, N_IN };

constexpr size_t MiB = 1u << 20;
constexpr size_t WS_CTL = 0, CTL_ZERO_BYTES = 1 * MiB;
constexpr size_t WS_MOD = 1 * MiB;
constexpr size_t WS_WIN = 2 * MiB, WS_WOUT = 26 * MiB, WS_WQ = 34 * MiB, WS_KEYS = 42 * MiB;
constexpr size_t WS_WUPT = 43 * MiB, WS_AUPT = 43 * MiB + 256 * 1024, WS_GUPT = 43 * MiB + 512 * 1024;
constexpr size_t WS_PU8 = 44 * MiB, WS_PV8 = 76 * MiB;
constexpr size_t WS_USC = 108 * MiB, WS_VSC = 108 * MiB + 65536;
constexpr size_t WS_XN = 172 * MiB;
constexpr size_t WS_LW = WS_XN, WS_AA = WS_XN + 64 * MiB;
constexpr size_t WS_PROJ = 300 * MiB;
constexpr size_t WS_Q = WS_PROJ;
constexpr size_t WS_GG = 684 * MiB;
constexpr size_t WS_PD = WS_PROJ + 128 * MiB;
constexpr size_t WS_RTE = 684 * MiB, WS_RTG = 700 * MiB, WS_COEF = 716 * MiB;
constexpr size_t WS_OY = 748 * MiB;
constexpr size_t WS_END = 876 * MiB;
constexpr size_t WS_HB = 876 * MiB;

constexpr int RING_BYTES = 131072, LDS_BYTES = 147456;

#define LDS_WAIT() asm volatile("s_waitcnt lgkmcnt(0)" ::: "memory")
#define VM_WAIT() asm volatile("s_waitcnt vmcnt(0)" ::: "memory")
__device__ __forceinline__ unsigned pk2(float lo, float hi) { f32x2 v = {lo, hi}; bf16x2_t b = __builtin_convertvector(v, bf16x2_t); return __builtin_bit_cast(unsigned, b); }
__device__ __forceinline__ float bflo(unsigned u) { return __uint_as_float(u << 16); }
__device__ __forceinline__ float bfhi(unsigned u) { return __uint_as_float(u & 0xffff0000u); }
__device__ __forceinline__ float bf1(bf16 h) { return __uint_as_float((unsigned)h << 16); }
__device__ __forceinline__ float wave_sum(float v) {
#pragma unroll
    for (int o = 1; o < 64; o <<= 1) v += __shfl_xor(v, o);
    return v;
}
__device__ __forceinline__ float rcp_f(float v) { return __builtin_amdgcn_rcpf(v); }
template <int CTRL> __device__ __forceinline__ float dppc_f(float x) { return __builtin_bit_cast(float, __builtin_amdgcn_mov_dpp(__builtin_bit_cast(int, x), CTRL, 0xf, 0xf, true)); }
__device__ __forceinline__ float wave_sum_fast(float x) {
    x += dppc_f<0xB1>(x); x += dppc_f<0x4E>(x); x += dppc_f<0x124>(x); x += dppc_f<0x128>(x);
    { auto rr = __builtin_amdgcn_permlane16_swap(__float_as_uint(x), __float_as_uint(x), false, false); x = __uint_as_float(rr[0]) + __uint_as_float(rr[1]); }
    { auto rr = __builtin_amdgcn_permlane32_swap(__float_as_uint(x), __float_as_uint(x), false, false); x = __uint_as_float(rr[0]) + __uint_as_float(rr[1]); }
    return x;
}
__device__ __forceinline__ float silu_f(float v) { return v * rcp_f(1.f + __expf(-v)); }
__device__ __forceinline__ float sigmoid_f(float v) { return rcp_f(1.f + __expf(-v)); }

struct Ctx {
    LAS unsigned char* lds;
    int tid, lane, wave, G, gw, NGW;
    const float* const* in;
    float* out; unsigned char* ws;
};

__device__ __forceinline__ void transpose_item(const float* W, int K, int N, bf16* WT, int ldt, int nrows_out, LAS float* scr, int kb, int nb, int lane) {
    const int k0 = 64 * kb, n0 = 64 * nb;
    const int c4 = 4 * (lane & 15), rr = lane >> 4;
    const bool vec_ok = ((N & 3) == 0) && (n0 + 64 <= N);
#pragma unroll 4
    for (int i = 0; i < 16; ++i) { const int kk = 4 * i + rr, k = k0 + kk;
        f32x4 v = {0.f, 0.f, 0.f, 0.f};
        if (k < K) { const float* src = W + (size_t)k * N + n0 + c4;
            if (vec_ok) v = *(const f32x4*)src;
            else { if (n0 + c4 + 0 < N) v.x = src[0]; if (n0 + c4 + 1 < N) v.y = src[1]; if (n0 + c4 + 2 < N) v.z = src[2]; if (n0 + c4 + 3 < N) v.w = src[3]; } }
        LAS float* d = scr + kk * 65 + c4; d[0] = v.x; d[1] = v.y; d[2] = v.z; d[3] = v.w; }
    LDS_WAIT(); asm volatile("" ::: "memory");
    const int c = lane & 7;
#pragma unroll
    for (int j = 0; j < 8; ++j) { const int n = (lane >> 3) + 8 * j; const LAS float* sp = scr + (8 * c) * 65 + n;
        v4u o; o.x = pk2(sp[0 * 65], sp[1 * 65]); o.y = pk2(sp[2 * 65], sp[3 * 65]); o.z = pk2(sp[4 * 65], sp[5 * 65]); o.w = pk2(sp[6 * 65], sp[7 * 65]);
        if (n0 + n < nrows_out && k0 + 8 * c + 8 <= ldt) *(v4u*)(WT + (size_t)(n0 + n) * ldt + k0 + 8 * c) = o; }
    LDS_WAIT(); asm volatile("" ::: "memory");
}
__device__ __forceinline__ void transpose_all(const float* W, int K, int N, bf16* WT, int ldt, int nrows_out, LAS float* scr, int gw, int NGW, int lane) {
    const int nkb = (K + 63) / 64, nnb = nrows_out / 64, nit = nkb * nnb;
    for (int it = gw; it < nit; it += NGW) transpose_item(W, K, N, WT, ldt, nrows_out, scr, it / nnb, it % nnb, lane);
}
__device__ __forceinline__ void convert_all(const float* src, bf16* dst, size_t n8, int gw, int NGW, int lane) {
    const f32x4* s4 = (const f32x4*)src; v4u* d4 = (v4u*)dst;
    for (size_t i = (size_t)gw * 64 + lane; i < n8; i += (size_t)NGW * 64) {
        const f32x4 a = __builtin_nontemporal_load(s4 + 2 * i), b = __builtin_nontemporal_load(s4 + 2 * i + 1);
        v4u o; o.x = pk2(a.x, a.y); o.y = pk2(a.z, a.w); o.z = pk2(b.x, b.y); o.w = pk2(b.z, b.w);
        d4[i] = o; }
}
__device__ __forceinline__ void quantize_rows_fp8(const float* src, unsigned char* dst8, float* scales, int e0, int e1, int step, int lane) {
    if (e0 >= e1) return;
    f32x4 vn[8];
    { const f32x4* s4 = (const f32x4*)(src + (size_t)e0 * DM) + lane;
#pragma unroll
      for (int i = 0; i < 8; ++i) vn[i] = __builtin_nontemporal_load(s4 + 64 * i); }
    for (int e = e0; e < e1; e += step) {
        f32x4 v[8];
#pragma unroll
        for (int i = 0; i < 8; ++i) v[i] = vn[i];
        { const int en = (e + step < e1) ? e + step : e; const f32x4* s4 = (const f32x4*)(src + (size_t)en * DM) + lane;
#pragma unroll
          for (int i = 0; i < 8; ++i) vn[i] = __builtin_nontemporal_load(s4 + 64 * i); }
        float am = 0.f;
#pragma unroll
        for (int i = 0; i < 8; ++i) am = fmaxf(fmaxf(am, fmaxf(fabsf(v[i].x), fabsf(v[i].y))), fmaxf(fabsf(v[i].z), fabsf(v[i].w)));
#pragma unroll
        for (int o = 1; o < 64; o <<= 1) am = fmaxf(am, __shfl_xor(am, o));
        am = fmaxf(am, 1e-30f);
        const float inv = 440.f / am;
#pragma unroll
        for (int i = 0; i < 8; ++i) { int w = __builtin_amdgcn_cvt_pk_fp8_f32(v[i].x * inv, v[i].y * inv, 0, false); w = __builtin_amdgcn_cvt_pk_fp8_f32(v[i].z * inv, v[i].w * inv, w, true);
            const int seg = 2 * i + (lane >> 5);
            *(int*)(dst8 + (size_t)seg * ((size_t)NEXP * 128) + (size_t)e * 128 + 4 * (lane & 31)) = w; }
        if (lane == 0) scales[e] = am * (1.f / 440.f);
    }
}
__device__ __forceinline__ void quantize_rows_fp4(const float* src, unsigned char* dst4, float* scales, int e0, int e1, int step, int lane) {
    if (e0 >= e1) return;
    f32x4 vn[8];
    { const f32x4* s4 = (const f32x4*)(src + (size_t)e0 * DM) + lane;
#pragma unroll
      for (int i = 0; i < 8; ++i) vn[i] = __builtin_nontemporal_load(s4 + 64 * i); }
    for (int e = e0; e < e1; e += step) {
        f32x4 v[8];
#pragma unroll
        for (int i = 0; i < 8; ++i) v[i] = vn[i];
        { const int en = (e + step < e1) ? e + step : e; const f32x4* s4 = (const f32x4*)(src + (size_t)en * DM) + lane;
#pragma unroll
          for (int i = 0; i < 8; ++i) vn[i] = __builtin_nontemporal_load(s4 + 64 * i); }
        float am = 0.f;
#pragma unroll
        for (int i = 0; i < 8; ++i) am = fmaxf(am, fmaxf(fmaxf(fabsf(v[i].x), fabsf(v[i].y)), fmaxf(fabsf(v[i].z), fabsf(v[i].w))));
#pragma unroll
        for (int o = 1; o < 64; o <<= 1) am = fmaxf(am, __shfl_xor(am, o));
        am = fmaxf(am, 1e-30f);
        const float inv = 6.f / am;
#pragma unroll
        for (int i = 0; i < 8; ++i) {
            unsigned w = __builtin_amdgcn_cvt_scalef32_pk_fp4_f32(0u, v[i].x * inv, v[i].y * inv, 1.0f, 0);
            w = __builtin_amdgcn_cvt_scalef32_pk_fp4_f32(w, v[i].z * inv, v[i].w * inv, 1.0f, 1);
            *(unsigned short*)(dst4 + (size_t)i * ((size_t)NEXP * 128) + (size_t)e * 128 + 2 * lane) = (unsigned short)w;
        }
        if (lane == 0) scales[e] = am * (1.f / 6.f);
    }
}
__device__ __forceinline__ void p0_prologue(const Ctx& F) {
    __syncthreads();
    if (blockIdx.x < MODW / 64) {
        LAS float* sc = (LAS float*)F.lds;
        LAS float* red = sc + NB * DM;
        const float* c = F.in[I_C];
        for (int i = F.tid; i < NB * DM; i += NTHR) sc[i] = silu_f(c[i]);
        __syncthreads();
        const int j = blockIdx.x * 64 + F.lane;
        const float* wp = F.in[I_ADAW] + (size_t)(F.wave * 256) * MODW + j;
        float a0 = 0.f, a1 = 0.f, a2 = 0.f, a3 = 0.f;
#pragma unroll 32
        for (int kk = 0; kk < 256; ++kk) { const float w = wp[(size_t)kk * MODW]; const int k = F.wave * 256 + kk;
            a0 += sc[k] * w; a1 += sc[DM + k] * w; a2 += sc[2 * DM + k] * w; a3 += sc[3 * DM + k] * w; }
        red[(F.wave * 4 + 0) * 64 + F.lane] = a0; red[(F.wave * 4 + 1) * 64 + F.lane] = a1; red[(F.wave * 4 + 2) * 64 + F.lane] = a2; red[(F.wave * 4 + 3) * 64 + F.lane] = a3;
        __syncthreads();
        if (F.tid < 256) { const int b = F.tid >> 6, l = F.tid & 63; float s = F.in[I_ADAB][blockIdx.x * 64 + l];
#pragma unroll
            for (int w = 0; w < 8; ++w) s += red[(w * 4 + b) * 64 + l];
            ((float*)(F.ws + WS_MOD))[b * MODW + blockIdx.x * 64 + l] = s; }
        __syncthreads();
    }
    LAS float* scr = (LAS float*)(F.lds + F.wave * 16640);
    transpose_all(F.in[I_WIN], DM, INP, (bf16*)(F.ws + WS_WIN), DM, INPP, scr, F.gw, F.NGW, F.lane);
    transpose_all(F.in[I_WOUT], DM, DM, (bf16*)(F.ws + WS_WOUT), DM, DM, scr, F.gw, F.NGW, F.lane);
    transpose_all(F.in[I_WQ], DM, DM, (bf16*)(F.ws + WS_WQ), DM, DM, scr, F.gw, F.NGW, F.lane);
    transpose_all(F.in[I_WUP], L_W, RW, (bf16*)(F.ws + WS_WUPT), L_W, RW, scr, F.gw, F.NGW, F.lane);
    transpose_all(F.in[I_AUP], L_A, RW, (bf16*)(F.ws + WS_AUPT), L_A, RW, scr, F.gw, F.NGW, F.lane);
    transpose_all(F.in[I_GUP], L_G, RW, (bf16*)(F.ws + WS_GUPT), L_G, RW, scr, F.gw, F.NGW, F.lane);
    convert_all(F.in[I_KEYS], (bf16*)(F.ws + WS_KEYS), (size_t)16 * 128 * 128 / 8, F.gw, F.NGW, F.lane);
    {
        const int nlo = (F.G < 192) ? F.G : 192, nhi = F.G - nlo;
        const int wtot = 5 * nlo + 8 * nhi;
        const int wb0 = (blockIdx.x < nlo) ? 5 * blockIdx.x : 5 * nlo + 8 * (blockIdx.x - nlo), wb1 = wb0 + ((blockIdx.x < nlo) ? 5 : 8);
        const int r0 = (int)((long)(2 * NEXP) * wb0 / wtot), r1 = (int)((long)(2 * NEXP) * wb1 / wtot);
        const int a0 = r0 < NEXP ? r0 : NEXP, a1 = r1 < NEXP ? r1 : NEXP;
        quantize_rows_fp8(F.in[I_PU], F.ws + WS_PU8, (float*)(F.ws + WS_USC), a0 + F.wave, a1, NWAVES, F.lane);
        const int b0 = (r0 > NEXP ? r0 : NEXP) - NEXP, b1 = (r1 > NEXP ? r1 : NEXP) - NEXP;
        quantize_rows_fp4(F.in[I_PV], F.ws + WS_PV8, (float*)(F.ws + WS_VSC), b0 + F.wave, b1, NWAVES, F.lane);
    }
}

__device__ __forceinline__ void norm_mod_rows(const Ctx& F, const float* X, const float* nw, int shift_off, int scale_off, bf16* XN) {
    const float* mod = (const float*)(F.ws + WS_MOD);
    if (F.gw >= M) return;
    f32x4 vn[8];
    { const f32x4* xr = (const f32x4*)(X + (size_t)F.gw * DM) + F.lane;
#pragma unroll
      for (int j = 0; j < 8; ++j) vn[j] = xr[64 * j]; }
    for (int m = F.gw; m < M; m += F.NGW) {
        const int b = m / SEQ;
        f32x4 v[8]; float s = 0.f;
#pragma unroll
        for (int j = 0; j < 8; ++j) { v[j] = vn[j]; s += (v[j].x * v[j].x + v[j].y * v[j].y) + (v[j].z * v[j].z + v[j].w * v[j].w); }
        { const int mn = (m + F.NGW < M) ? m + F.NGW : m; const f32x4* xr = (const f32x4*)(X + (size_t)mn * DM) + F.lane;
#pragma unroll
          for (int j = 0; j < 8; ++j) vn[j] = xr[64 * j]; }
        const float rstd = rsqrtf(wave_sum_fast(s) * (1.f / DM) + RMS_EPS);
        const f32x4* wp = (const f32x4*)nw + F.lane;
        const f32x4* shp = (const f32x4*)(mod + (size_t)b * MODW + shift_off) + F.lane;
        const f32x4* scp = (const f32x4*)(mod + (size_t)b * MODW + scale_off) + F.lane;
        v2u* o = (v2u*)(XN + (size_t)m * DM) + F.lane;
#pragma unroll
        for (int j = 0; j < 8; ++j) { const f32x4 w = wp[64 * j], a = scp[64 * j], c = shp[64 * j];
            const f32x4 r = (v[j] * rstd) * w * (a + 1.f) + c;
            v2u p; p.x = pk2(r.x, r.y); p.y = pk2(r.z, r.w); o[64 * j] = p; }
    }
}
__device__ __forceinline__ void final_norm_rows(const Ctx& F, const float* H, const float* nw, float* O) {
    for (int m = F.gw; m < M; m += F.NGW) {
        const f32x4* xr = (const f32x4*)(H + (size_t)m * DM) + F.lane;
        f32x4 v[8]; float s = 0.f;
#pragma unroll
        for (int j = 0; j < 8; ++j) { v[j] = xr[64 * j]; s += (v[j].x * v[j].x + v[j].y * v[j].y) + (v[j].z * v[j].z + v[j].w * v[j].w); }
        const float rstd = rsqrtf(wave_sum(s) * (1.f / DM) + RMS_EPS);
        const f32x4* wp = (const f32x4*)nw + F.lane;
        f32x4* o = (f32x4*)(O + (size_t)m * DM) + F.lane;
#pragma unroll
        for (int j = 0; j < 8; ++j) o[64 * j] = (v[j] * rstd) * wp[64 * j];
    }
}


__device__ __forceinline__ void load_row_raw(const bf16* row, int lane, v2u (&u)[8]) {
    const v2u* p = (const v2u*)row + lane;
#pragma unroll
    for (int j = 0; j < 8; ++j) u[j] = p[64 * j];
}
__device__ __forceinline__ void norm_mod_rows_bf16(const Ctx& F, const bf16* X, const float* nw, int shift_off, int scale_off, bf16* XN) {
    const float* mod = (const float*)(F.ws + WS_MOD);
    if (F.gw >= M) return;
    v2u un[8]; load_row_raw(X + (size_t)F.gw * DM, F.lane, un);
    for (int m = F.gw; m < M; m += F.NGW) {
        const int b = m / SEQ;
        f32x4 v[8]; float s = 0.f;
#pragma unroll
        for (int j = 0; j < 8; ++j) { v[j] = (f32x4){bflo(un[j].x), bfhi(un[j].x), bflo(un[j].y), bfhi(un[j].y)}; s += (v[j].x * v[j].x + v[j].y * v[j].y) + (v[j].z * v[j].z + v[j].w * v[j].w); }
        { const int mn = (m + F.NGW < M) ? m + F.NGW : m; load_row_raw(X + (size_t)mn * DM, F.lane, un); }
        const float rstd = rsqrtf(wave_sum_fast(s) * (1.f / DM) + RMS_EPS);
        const f32x4* wp = (const f32x4*)nw + F.lane;
        const f32x4* shp = (const f32x4*)(mod + (size_t)b * MODW + shift_off) + F.lane;
        const f32x4* scp = (const f32x4*)(mod + (size_t)b * MODW + scale_off) + F.lane;
        v2u* o = (v2u*)(XN + (size_t)m * DM) + F.lane;
#pragma unroll
        for (int j = 0; j < 8; ++j) { const f32x4 w = wp[64 * j], a = scp[64 * j], c = shp[64 * j];
            const f32x4 r = (v[j] * rstd) * w * (a + 1.f) + c;
            v2u p; p.x = pk2(r.x, r.y); p.y = pk2(r.z, r.w); o[64 * j] = p; }
    }
}
__device__ __forceinline__ void final_norm_rows_bf16(const Ctx& F, const bf16* H, const float* nw, float* O, float oscale) {
    if (F.gw >= M) return;
    v2u un[8]; load_row_raw(H + (size_t)F.gw * DM, F.lane, un);
    f32x4 wv[8];
#pragma unroll
    for (int j = 0; j < 8; ++j) wv[j] = ((const f32x4*)nw + F.lane)[64 * j];
    for (int m = F.gw; m < M; m += F.NGW) {
        f32x4 v[8]; float s = 0.f;
#pragma unroll
        for (int j = 0; j < 8; ++j) { v[j] = (f32x4){bflo(un[j].x), bfhi(un[j].x), bflo(un[j].y), bfhi(un[j].y)}; s += (v[j].x * v[j].x + v[j].y * v[j].y) + (v[j].z * v[j].z + v[j].w * v[j].w); }
        { const int mn = (m + F.NGW < M) ? m + F.NGW : m; load_row_raw(H + (size_t)mn * DM, F.lane, un); }
        const float rstd = rsqrtf(wave_sum_fast(s) * (1.f / DM) + RMS_EPS) * oscale;
        f32x4* o = (f32x4*)(O + (size_t)m * DM) + F.lane;
#pragma unroll
        for (int j = 0; j < 8; ++j) __builtin_nontemporal_store((v[j] * rstd) * wv[j], o + 64 * j);
    }
}
#define LO2(v) __builtin_shufflevector((v), (v), 0, 1)
#define HI2(v) __builtin_shufflevector((v), (v), 2, 3)
template <int CTRL> __device__ __forceinline__ float dpp_f(float x) { return __builtin_bit_cast(float, __builtin_amdgcn_mov_dpp(__builtin_bit_cast(int, x), CTRL, 0xf, 0xf, true)); }
__device__ __forceinline__ float rowsum16(float x) { x += dpp_f<0xB1>(x); x += dpp_f<0x4E>(x); x += dpp_f<0x124>(x); x += dpp_f<0x128>(x); return x; }
__device__ __forceinline__ float quadsum(float x) { x += dpp_f<0xB1>(x); x += dpp_f<0x4E>(x); return x; }

__device__ __forceinline__ float treduce16(const float (&p)[16], bool b0, bool b1, bool b2, bool b3) {
    float a[8], bq[4], c2[2];
#pragma unroll
    for (int j = 0; j < 8; ++j) { const float mine = b3 ? p[j + 8] : p[j], send = b3 ? p[j] : p[j + 8]; a[j] = mine + dpp_f<0x128>(send); }
#pragma unroll
    for (int j = 0; j < 4; ++j) { const float mine = b2 ? a[j + 4] : a[j], send = b2 ? a[j] : a[j + 4]; const float up = dpp_f<0x104>(send), dn = dpp_f<0x114>(send); bq[j] = mine + (b2 ? dn : up); }
#pragma unroll
    for (int j = 0; j < 2; ++j) { const float mine = b1 ? bq[j + 2] : bq[j], send = b1 ? bq[j] : bq[j + 2]; c2[j] = mine + dpp_f<0x4E>(send); }
    const float mine = b0 ? c2[1] : c2[0], send = b0 ? c2[0] : c2[1];
    return mine + dpp_f<0xB1>(send);
}
__device__ __forceinline__ float wave_sum_dpp(float v) { v = rowsum16(v); v += __shfl_xor(v, 16); v += __shfl_xor(v, 32); return v; }
__device__ __forceinline__ void unpack8(const v4u p, float (&e)[8]) { e[0] = bflo(p.x); e[1] = bfhi(p.x); e[2] = bflo(p.y); e[3] = bfhi(p.y); e[4] = bflo(p.z); e[5] = bfhi(p.z); e[6] = bflo(p.w); e[7] = bfhi(p.w); }
__device__ __forceinline__ v4u pack8(const float (&e)[8]) { v4u o; o.x = pk2(e[0], e[1]); o.y = pk2(e[2], e[3]); o.z = pk2(e[4], e[5]); o.w = pk2(e[6], e[7]); return o; }

__device__ __forceinline__ void p3_lora(const Ctx& F) {
    const bf16* PROJ = (const bf16*)(F.ws + WS_PROJ);
    const bf16* WUPT = (const bf16*)(F.ws + WS_WUPT); const bf16* AUPT = (const bf16*)(F.ws + WS_AUPT); const bf16* GUPT = (const bf16*)(F.ws + WS_GUPT);
    bf16* LW = (bf16*)(F.ws + WS_LW); bf16* AA = (bf16*)(F.ws + WS_AA); bf16* GG = (bf16*)(F.ws + WS_GG);
    const float* mu = F.in[I_MU]; const float* w0 = F.in[I_W0]; const float* a0 = F.in[I_A0];
    const int r16 = F.lane & 15, q = F.lane >> 4;
    constexpr int WST = 72, GST = 168;
    LAS bf16* WU = (LAS bf16*)F.lds; LAS bf16* AU = WU + 128 * WST; LAS bf16* GU = AU + 128 * WST;
    const int nr = blockIdx.x & 7, nbr = (F.G - nr + 7) >> 3;
    __syncthreads();
    for (int i = F.tid; i < 128 * 8; i += NTHR) { const int row = i >> 3, ch = i & 7;
        *(LAS v4u*)(WU + row * WST + 8 * ch) = *(const v4u*)(WUPT + (size_t)(128 * nr + row) * L_W + 8 * ch);
        *(LAS v4u*)(AU + row * WST + 8 * ch) = *(const v4u*)(AUPT + (size_t)(128 * nr + row) * L_A + 8 * ch); }
    for (int i = F.tid; i < 128 * 20; i += NTHR) { const int row = i / 20, ch = i - row * 20;
        *(LAS v4u*)(GU + row * GST + 8 * ch) = *(const v4u*)(GUPT + (size_t)(128 * nr + row) * L_G + 8 * ch); }
    __syncthreads();
    for (int mt = (blockIdx.x >> 3) * NWAVES + F.wave; mt < M / 16; mt += nbr * NWAVES) {
        const int m = mt * 16 + r16; const bool first = (m % SEQ) == 0;
        const bf16* row = PROJ + (size_t)m * INPP;
        bf16x8 af[9];
#pragma unroll
        for (int s = 0; s < 9; ++s) {
            const int col = ((s < 2) ? (C_WD + 32 * s) : (s < 4) ? (C_AD + 32 * (s - 2)) : (C_GD + 32 * (s - 4))) + 8 * q;
            const v4u pc = *(const v4u*)(row + col);
            v4u pp = {0u, 0u, 0u, 0u}; if (!first) pp = *(const v4u*)(row - INPP + col);
            const f32x4 m0 = *(const f32x4*)(mu + col), m1 = *(const f32x4*)(mu + col + 4);
            float c[8], p[8], e[8]; unpack8(pc, c); unpack8(pp, p);
            const float mm[8] = {m0.x, m0.y, m0.z, m0.w, m1.x, m1.y, m1.z, m1.w};
#pragma unroll
            for (int j = 0; j < 8; ++j) { float v = c[j] + (p[j] - c[j]) * mm[j];
                if (s < 2) { const float t = __expf(2.f * v); v = 1.f - 2.f * rcp_f(t + 1.f); }
                else if (s >= 4) v = sigmoid_f(v);
                e[j] = v; }
            af[s] = __builtin_bit_cast(bf16x8, pack8(e));
        }
#pragma unroll 2
        for (int nt = 0; nt < 8; ++nt) {
            const LAS bf16* wu = WU + (16 * nt + r16) * WST + 8 * q; const LAS bf16* au = AU + (16 * nt + r16) * WST + 8 * q; const LAS bf16* gu = GU + (16 * nt + r16) * GST + 8 * q;
            f32x4 acc0 = {0.f, 0.f, 0.f, 0.f}, acc1 = acc0, acc2 = acc0;
#pragma unroll
            for (int s2 = 0; s2 < 2; ++s2) acc0 = __builtin_amdgcn_mfma_f32_16x16x32_bf16(*(const LAS bf16x8*)(wu + 32 * s2), af[s2], acc0, 0, 0, 0);
#pragma unroll
            for (int s2 = 0; s2 < 2; ++s2) acc1 = __builtin_amdgcn_mfma_f32_16x16x32_bf16(*(const LAS bf16x8*)(au + 32 * s2), af[2 + s2], acc1, 0, 0, 0);
#pragma unroll
            for (int s2 = 0; s2 < 5; ++s2) acc2 = __builtin_amdgcn_mfma_f32_16x16x32_bf16(*(const LAS bf16x8*)(gu + 32 * s2), af[4 + s2], acc2, 0, 0, 0);
            const int n = 128 * nr + 16 * nt + 4 * q;
            const f32x4 w0v = *(const f32x4*)(w0 + n), a0v = *(const f32x4*)(a0 + n);
            v2u o0, o1, o2;
            o0.x = pk2(-0.60653066f * sigmoid_f(acc0[0] + w0v.x), -0.60653066f * sigmoid_f(acc0[1] + w0v.y));
            o0.y = pk2(-0.60653066f * sigmoid_f(acc0[2] + w0v.z), -0.60653066f * sigmoid_f(acc0[3] + w0v.w));
            o1.x = pk2(sigmoid_f(acc1[0] + a0v.x), sigmoid_f(acc1[1] + a0v.y)); o1.y = pk2(sigmoid_f(acc1[2] + a0v.z), sigmoid_f(acc1[3] + a0v.w));
            o2.x = pk2(acc2[0], acc2[1]); o2.y = pk2(acc2[2], acc2[3]);
            *(v2u*)(LW + (size_t)m * RW + n) = o0; *(v2u*)(AA + (size_t)m * RW + n) = o1; *(v2u*)(GG + (size_t)m * RW + n) = o2;
        }
    }
    __syncthreads();
}

constexpr int TC = 32, NCHUNK = SEQ / TC;
constexpr int RB_R = 0, RB_W = TC * 64, RB_K = 2 * TC * 64, RB_KK = 3 * TC * 64, RB_KA = 4 * TC * 64, RB_V = 5 * TC * 64, RB_SIZE = 5 * TC * 64 + TC * 16;
constexpr int MB_B = 0, MB_C = TC * 128, MB_X = 2 * TC * 128, MB_DT = MB_X + TC * 32, MB_DA = MB_DT + TC, MB_SIZE = MB_DA + TC;
static_assert(2 * RB_SIZE * 4 <= RING_BYTES, "scan buffers fit the LDS ring");

struct RwkvRaw { bf16 r[9], k[9], v[9], lw[8], a[8]; };
__device__ __forceinline__ void rwkv_load(RwkvRaw& raw, const bf16* PROJ, const bf16* LW, const bf16* AA, int b, int h, int t0w, int c) {
    const bf16* base = PROJ + (size_t)(b * SEQ + t0w) * INPP + h * 64 + c;
#pragma unroll
    for (int i = 0; i < 9; ++i) {
        if (i == 0 && t0w == 0) { raw.r[0] = 0; raw.k[0] = 0; raw.v[0] = 0; }
        else { const bf16* row = base + (long)(i - 1) * INPP; raw.r[i] = row[C_R]; raw.k[i] = row[C_K]; raw.v[i] = row[C_V]; }
    }
#pragma unroll
    for (int i = 0; i < 8; ++i) { const size_t o = (size_t)(b * SEQ + t0w + i) * RW + h * 64 + c; raw.lw[i] = LW[o]; raw.a[i] = AA[o]; }
}
__device__ __forceinline__ void rwkv_stage(const RwkvRaw& raw, LAS float* buf, int tl0, int c, int qt, float mu_r, float mu_k, float mu_v, float kkw, float kaw) {
#pragma unroll
    for (int i = 0; i < 8; ++i) {
        const int t = tl0 + i;
        const float rc = bf1(raw.r[i + 1]), rp = bf1(raw.r[i]), kc = bf1(raw.k[i + 1]), kp = bf1(raw.k[i]), vc = bf1(raw.v[i + 1]), vp = bf1(raw.v[i]);
        const float rr = rc + (rp - rc) * mu_r, kx = kc + (kp - kc) * mu_k, vv = vc + (vp - vc) * mu_v;
        const float a = bf1(raw.a[i]), dec = __expf(bf1(raw.lw[i]));
        const float kkraw = kx * kkw; const float ss = wave_sum_dpp(kkraw * kkraw);
        const float kkn = kkraw * rcp_f(fmaxf(sqrtf(ss), 1e-12f));
        buf[RB_R + t * 64 + c] = rr; buf[RB_W + t * 64 + c] = dec; buf[RB_K + t * 64 + c] = kx * (1.f + (a - 1.f) * kaw);
        buf[RB_KK + t * 64 + c] = kkn; buf[RB_KA + t * 64 + c] = kkn * a;
        if ((c >> 4) == qt) buf[RB_V + t * 16 + (c & 15)] = vv;
    }
}
__device__ __forceinline__ void rwkv_task(const Ctx& F, int task) {
    const int b = task >> 6, h = (task >> 2) & 15, qt = task & 3;
    const bf16* PROJ = (const bf16*)(F.ws + WS_PROJ); const bf16* LW = (const bf16*)(F.ws + WS_LW); const bf16* AA = (const bf16*)(F.ws + WS_AA);
    bf16* OY = (bf16*)(F.ws + WS_OY);
    LAS float* lbuf = (LAS float*)F.lds;
    const int c = F.lane, w = F.wave, r = F.lane >> 4, cg = F.lane & 15;
    const bool stager = w >= 4; const int sw = w & 3;
    const int ch = h * 64 + c;
    const float mu_r = F.in[I_MU][C_R + ch], mu_k = F.in[I_MU][C_K + ch], mu_v = F.in[I_MU][C_V + ch], kkw = F.in[I_KK][ch], kaw = F.in[I_KA][ch];
    RwkvRaw raw;
    if (stager) { rwkv_load(raw, PROJ, LW, AA, b, h, 8 * sw, c); rwkv_stage(raw, lbuf, 8 * sw, c, qt, mu_r, mu_k, mu_v, kkw, kaw); rwkv_load(raw, PROJ, LW, AA, b, h, TC + 8 * sw, c); }
    __syncthreads();
    f32x2 S01 = {0.f, 0.f}, S23 = {0.f, 0.f};
    const bool cb0 = cg & 1, cb1 = cg & 2, cb2 = cg & 4, cb3 = cg & 8;
    bf16* orow = OY + (size_t)(b * SEQ) * DM + h * 64 + 16 * qt + 4 * sw + r;
    for (int ck = 0; ck < NCHUNK; ++ck) {
        const LAS float* buf = lbuf + (ck & 1) * RB_SIZE;
        if (stager) {
            if (ck + 1 < NCHUNK) { rwkv_stage(raw, lbuf + ((ck + 1) & 1) * RB_SIZE, 8 * sw, c, qt, mu_r, mu_k, mu_v, kkw, kaw);
                if (ck + 2 < NCHUNK) rwkv_load(raw, PROJ, LW, AA, b, h, (ck + 2) * TC + 8 * sw, c); }
        } else {
            const LAS float* bp = buf + 4 * cg; const LAS float* vp = buf + RB_V + 4 * sw + r;
            f32x4 qkk[3], qw[3], qka[3], qk[3], qr[3]; float qv[3];
#pragma unroll
            for (int i = 0; i < 3; ++i) { qkk[i] = *(const LAS f32x4*)(bp + RB_KK + i * 64); qw[i] = *(const LAS f32x4*)(bp + RB_W + i * 64); qka[i] = *(const LAS f32x4*)(bp + RB_KA + i * 64);
                qk[i] = *(const LAS f32x4*)(bp + RB_K + i * 64); qr[i] = *(const LAS f32x4*)(bp + RB_R + i * 64); qv[i] = vp[i * 16]; }
            float op[16];
#pragma unroll
            for (int j = 0; j < TC; ++j) {
                const int u = j % 3;
                const f32x4 kk4 = qkk[u], w4 = qw[u], ka4 = qka[u], k4 = qk[u], r4 = qr[u]; const float vr = qv[u];
                const f32x2 tq = S01 * LO2(kk4) + S23 * HI2(kk4);
                const float sa = rowsum16(tq.x + tq.y);
                const f32x2 sav = {sa, sa}, vrv = {vr, vr};
                S01 = S01 * LO2(w4) + (vrv * LO2(k4) - sav * LO2(ka4));
                S23 = S23 * HI2(w4) + (vrv * HI2(k4) - sav * HI2(ka4));
                const f32x2 uq = S01 * LO2(r4) + S23 * HI2(r4);
                op[j & 15] = uq.x + uq.y;
                asm volatile("" : "+v"(S01), "+v"(S23) :: "memory");
                if (j + 3 < TC) { qkk[u] = *(const LAS f32x4*)(bp + RB_KK + (j + 3) * 64); qw[u] = *(const LAS f32x4*)(bp + RB_W + (j + 3) * 64); qka[u] = *(const LAS f32x4*)(bp + RB_KA + (j + 3) * 64);
                                  qk[u] = *(const LAS f32x4*)(bp + RB_K + (j + 3) * 64); qr[u] = *(const LAS f32x4*)(bp + RB_R + (j + 3) * 64); qv[u] = vp[(j + 3) * 16]; }
                if ((j & 15) == 15) {
                    const float ored = treduce16(op, cb0, cb1, cb2, cb3);
                    orow[(size_t)(ck * TC + (j - 15) + cg) * DM] = (bf16)(pk2(ored, 0.f) & 0xffffu);
                }
            }
        }
        __syncthreads();
    }
}

__device__ __forceinline__ void p4_scans(const Ctx& F) {
    for (int task = blockIdx.x; task < NB * RHEADS * 4; task += F.G) { rwkv_task(F, task); __syncthreads(); }
}

__device__ __forceinline__ void ld16(const float* p, float (&v)[16]) {
#pragma unroll
    for (int i = 0; i < 4; ++i) { const f32x4 t = *(const f32x4*)(p + 4 * i); v[4 * i] = t.x; v[4 * i + 1] = t.y; v[4 * i + 2] = t.z; v[4 * i + 3] = t.w; }
}
__device__ __forceinline__ void ldbf16x16(const bf16* p, float (&v)[16]) {
    float t0[8], t1[8]; unpack8(*(const v4u*)p, t0); unpack8(*(const v4u*)(p + 8), t1);
#pragma unroll
    for (int j = 0; j < 8; ++j) { v[j] = t0[j]; v[8 + j] = t1[j]; }
}
__device__ __forceinline__ void stbf16x16(bf16* p, const float (&v)[16]) {
    float t0[8], t1[8];
#pragma unroll
    for (int j = 0; j < 8; ++j) { t0[j] = v[j]; t1[j] = v[8 + j]; }
    *(v4u*)p = pack8(t0); *(v4u*)(p + 8) = pack8(t1);
}
__device__ __forceinline__ void p5_post(const Ctx& F) {
    const bf16* PROJ = (const bf16*)(F.ws + WS_PROJ); const bf16* AA = (const bf16*)(F.ws + WS_AA); const bf16* GG = (const bf16*)(F.ws + WS_GG);
    bf16* OY = (bf16*)(F.ws + WS_OY);
    const int c0 = 16 * F.lane;
    {
        float mur[16], muk[16], muv[16], ka[16], rk[16], lnw[16], lnb[16];
        ld16(F.in[I_MU] + C_R + c0, mur); ld16(F.in[I_MU] + C_K + c0, muk); ld16(F.in[I_MU] + C_V + c0, muv);
        ld16(F.in[I_KA] + c0, ka); ld16(F.in[I_RK] + c0, rk); ld16(F.in[I_LNW] + c0, lnw); ld16(F.in[I_LNB] + c0, lnb);
        for (int m = F.gw; m < M; m += F.NGW) {
            const bool first = (m % SEQ) == 0;
            const bf16* prow = PROJ + (size_t)m * INPP; bf16* oyrow = OY + (size_t)m * DM;
            float o[16], res[16]; float bs = 0.f;
            ldbf16x16(oyrow + c0, o);
            {
                float rc[16], rp[16], kc[16], kp[16], av[16];
                ldbf16x16(prow + C_R + c0, rc); ldbf16x16(prow + C_K + c0, kc); ldbf16x16(AA + (size_t)m * RW + c0, av);
                if (!first) { ldbf16x16(prow - INPP + C_R + c0, rp); ldbf16x16(prow - INPP + C_K + c0, kp); }
                else {
#pragma unroll
                    for (int j = 0; j < 16; ++j) { rp[j] = 0.f; kp[j] = 0.f; } }
#pragma unroll
                for (int j = 0; j < 16; ++j) { const float rr = rc[j] + (rp[j] - rc[j]) * mur[j], kx = kc[j] + (kp[j] - kc[j]) * muk[j];
                    bs += rr * (kx * (1.f + (av[j] - 1.f) * ka[j])) * rk[j]; }
            }
            bs = quadsum(bs);
            float s = 0.f;
#pragma unroll
            for (int j = 0; j < 16; ++j) s += o[j];
            const float mean = quadsum(s) * (1.f / 64.f);
            float qv = 0.f;
#pragma unroll
            for (int j = 0; j < 16; ++j) { o[j] -= mean; qv += o[j] * o[j]; }
            const float rstd = rsqrtf(quadsum(qv) * (1.f / 64.f) + 64e-5f);
            {
                float vc[16], vp[16], gv[16];
                ldbf16x16(prow + C_V + c0, vc); ldbf16x16(GG + (size_t)m * RW + c0, gv);
                if (!first) ldbf16x16(prow - INPP + C_V + c0, vp);
                else {
#pragma unroll
                    for (int j = 0; j < 16; ++j) vp[j] = 0.f; }
#pragma unroll
                for (int j = 0; j < 16; ++j) { const float vv = vc[j] + (vp[j] - vc[j]) * muv[j]; res[j] = (o[j] * rstd * lnw[j] + lnb[j] + bs * vv) * gv[j]; }
            }
            stbf16x16(oyrow + c0, res);
        }
    }
    {
        float nw[16]; ld16(F.in[I_MNW] + c0, nw);
        for (int m = F.gw; m < M; m += F.NGW) {
            const bf16* prow = PROJ + (size_t)m * INPP; bf16* oyrow = OY + (size_t)m * DM;
            float y[16], z[16];
            ldbf16x16(oyrow + RW + c0, y); ldbf16x16(prow + C_Z + c0, z);
            float qv = 0.f;
#pragma unroll
            for (int j = 0; j < 16; ++j) { y[j] *= silu_f(z[j]); qv += y[j] * y[j]; }
            qv = rowsum16(qv);
            { auto rr = __builtin_amdgcn_permlane16_swap(__float_as_uint(qv), __float_as_uint(qv), false, false); qv = __uint_as_float(rr[0]) + __uint_as_float(rr[1]); }
            const float rstd = rsqrtf(qv * (1.f / 512.f) + 1e-5f);
#pragma unroll
            for (int j = 0; j < 16; ++j) y[j] = y[j] * rstd * nw[j];
            stbf16x16(oyrow + RW + c0, y);
        }
    }
}
constexpr int MC_L = 128, MC_NC = SEQ / MC_L, LSTR = 136;
constexpr int MT_BYTES = 128 * LSTR * 2;
constexpr size_t WS_ST = 876 * MiB, WS_SIN = 940 * MiB, WS_ATOT = 1004 * MiB, WS_END2 = 1005 * MiB;

__device__ __forceinline__ float mamba_dt_scan(const Ctx& F, const bf16* PROJ, int b, int c, int g, LAS float* DT, LAS float* ACS) {
    const int head = g * 8 + F.wave, lane = F.lane;
    const float dtb = F.in[I_DTB][head], Aneg = -__expf(F.in[I_ALOG][head]);
    const bf16* p = PROJ + (size_t)(b * SEQ + c * MC_L + 2 * lane) * INPP + C_DT + head;
    const float x0 = bf1(p[0]) + dtb, x1 = bf1(p[INPP]) + dtb;
    const float d0 = (x0 > 20.f) ? x0 : log1pf(__expf(x0)), d1 = (x1 > 20.f) ? x1 : log1pf(__expf(x1));
    const float s0 = d0 * Aneg, s1 = s0 + d1 * Aneg;
    float incl = s1;
#pragma unroll
    for (int o = 1; o < 64; o <<= 1) { const float t = __shfl_up(incl, o); if (lane >= o) incl += t; }
    const float excl = incl - s1;
    DT[F.wave * 128 + 2 * lane] = d0; DT[F.wave * 128 + 2 * lane + 1] = d1;
    ACS[F.wave * 128 + 2 * lane] = excl + s0; ACS[F.wave * 128 + 2 * lane + 1] = excl + s1;
    return __shfl(incl, 63);
}
struct TRaw { bf16 v[35]; };
__device__ __forceinline__ void mstage_T_load(TRaw& raw, const bf16* PROJ, int b, int c, int chn, int tid) {
    const int t0 = 32 * (tid >> 7);
    const bf16* base = PROJ + (size_t)(b * SEQ + c * MC_L + t0) * INPP + C_XBC + chn;
    if (c * MC_L + t0 > 0) { raw.v[0] = base[-3 * INPP]; raw.v[1] = base[-2 * INPP]; raw.v[2] = base[-1 * INPP]; }
    else { raw.v[0] = 0; raw.v[1] = 0; raw.v[2] = 0; }
#pragma unroll
    for (int t = 0; t < 32; ++t) raw.v[3 + t] = base[(size_t)t * INPP];
}
template <bool SC>
__device__ __forceinline__ void mstage_T_store(const TRaw& raw, int chn, LAS bf16* dst, const LAS float* scale, const float* convw, const float* convb, int tid) {
    const int f = tid & 127, t0 = 32 * (tid >> 7);
    const float w0 = convw[chn], w1 = convw[1536 + chn], w2 = convw[2 * 1536 + chn], w3 = convw[3 * 1536 + chn], bb = convb[chn];
#pragma unroll
    for (int i8 = 0; i8 < 4; ++i8) {
        float e[8];
#pragma unroll
        for (int i = 0; i < 8; ++i) { const int t = 8 * i8 + i;
            float v = silu_f(bb + w0 * bf1(raw.v[t]) + w1 * bf1(raw.v[t + 1]) + w2 * bf1(raw.v[t + 2]) + w3 * bf1(raw.v[t + 3]));
            if (SC) v *= scale[t0 + t];
            e[i] = v; }
        *(LAS v4u*)(dst + f * LSTR + t0 + 8 * i8) = pack8(e);
    }
}
__device__ __forceinline__ void mstage_N(const bf16* PROJ, int b, int c, int g, LAS bf16* Bn, LAS bf16* Cn, const float* convw, const float* convb, int tid) {
    const int f8 = tid & 31, t0 = 8 * (tid >> 5);
    const int chn = (f8 < 16) ? (1024 + g * 128 + 8 * f8) : (1280 + g * 128 + 8 * (f8 - 16));
    LAS bf16* dst = ((f8 < 16) ? Bn : Cn) + 8 * (f8 & 15);
    const bf16* base = PROJ + (size_t)(b * SEQ + c * MC_L + t0) * INPP + C_XBC + chn;
    float w[4][8], bb[8];
#pragma unroll
    for (int i = 0; i < 4; ++i) { const f32x4 a = *(const f32x4*)(convw + i * 1536 + chn), d = *(const f32x4*)(convw + i * 1536 + chn + 4);
        w[i][0] = a.x; w[i][1] = a.y; w[i][2] = a.z; w[i][3] = a.w; w[i][4] = d.x; w[i][5] = d.y; w[i][6] = d.z; w[i][7] = d.w; }
    { const f32x4 a = *(const f32x4*)(convb + chn), d = *(const f32x4*)(convb + chn + 4); bb[0] = a.x; bb[1] = a.y; bb[2] = a.z; bb[3] = a.w; bb[4] = d.x; bb[5] = d.y; bb[6] = d.z; bb[7] = d.w; }
    float r0[8], r1[8], r2[8];
    if (c * MC_L + t0 > 0) { unpack8(*(const v4u*)(base - 3 * INPP), r0); unpack8(*(const v4u*)(base - 2 * INPP), r1); unpack8(*(const v4u*)(base - 1 * INPP), r2); }
    else {
#pragma unroll
        for (int k = 0; k < 8; ++k) { r0[k] = 0.f; r1[k] = 0.f; r2[k] = 0.f; } }
#pragma unroll
    for (int t = 0; t < 8; ++t) {
        float r3[8], e[8]; unpack8(*(const v4u*)(base + (size_t)t * INPP), r3);
#pragma unroll
        for (int k = 0; k < 8; ++k) { e[k] = silu_f(bb[k] + w[0][k] * r0[k] + w[1][k] * r1[k] + w[2][k] * r2[k] + w[3][k] * r3[k]); r0[k] = r1[k]; r1[k] = r2[k]; r2[k] = r3[k]; }
        *(LAS v4u*)(dst + (t0 + t) * LSTR) = pack8(e);
    }
}

__device__ __forceinline__ void m1_chunk_states(const Ctx& F) {
    const bf16* PROJ = (const bf16*)(F.ws + WS_PROJ); bf16* ST = (bf16*)(F.ws + WS_ST); float* ATOT = (float*)(F.ws + WS_ATOT);
    LAS bf16* BT = (LAS bf16*)F.lds; LAS bf16* XT = (LAS bf16*)(F.lds + MT_BYTES);
    LAS float* DT = (LAS float*)(F.lds + 3 * MT_BYTES); LAS float* ACS = DT + 8 * 128; LAS float* SCL = ACS + 8 * 128;
    const float* convw = F.in[I_CONVW]; const float* convb = F.in[I_CONVB];
    const int tid = F.tid, w = F.wave, lane = F.lane, r16 = lane & 15, q = lane >> 4;
    for (int it = blockIdx.x; it < NB * MC_NC * 2; it += F.G) {
        const int g = it & 1, c = (it >> 1) & (MC_NC - 1), b = it >> 7;
        __syncthreads();
        const float atot = mamba_dt_scan(F, PROJ, b, c, g, DT, ACS);
        if (lane == 0) ATOT[(b * MC_NC + c) * 16 + g * 8 + w] = atot;
        const int chB = 1024 + g * 128 + (tid & 127);
        TRaw ra, rb;
        mstage_T_load(ra, PROJ, b, c, chB, tid);
        mstage_T_load(rb, PROJ, b, c, (g * 8 + ((tid & 127) >> 6)) * 64 + (tid & 63), tid);
        LDS_WAIT();
        SCL[w * 128 + 2 * lane] = DT[w * 128 + 2 * lane] * __expf(atot - ACS[w * 128 + 2 * lane]);
        SCL[w * 128 + 2 * lane + 1] = DT[w * 128 + 2 * lane + 1] * __expf(atot - ACS[w * 128 + 2 * lane + 1]);
        mstage_T_store<false>(ra, chB, BT, nullptr, convw, convb, tid);
        mstage_T_load(ra, PROJ, b, c, (g * 8 + 2 + ((tid & 127) >> 6)) * 64 + (tid & 63), tid);
        __syncthreads();
#pragma unroll
        for (int hb = 0; hb < 2; ++hb) {
            if (hb == 1) mstage_T_load(ra, PROJ, b, c, (g * 8 + 6 + ((tid & 127) >> 6)) * 64 + (tid & 63), tid);
            { const int hl = 4 * hb + ((tid & 127) >> 6); mstage_T_store<true>(rb, (g * 8 + hl) * 64 + (tid & 63), XT, SCL + hl * 128, convw, convb, tid); }
            if (hb == 0) mstage_T_load(rb, PROJ, b, c, (g * 8 + 4 + ((tid & 127) >> 6)) * 64 + (tid & 63), tid);
            { const int hl = 4 * hb + 2 + ((tid & 127) >> 6); mstage_T_store<true>(ra, (g * 8 + hl) * 64 + (tid & 63), XT + 128 * LSTR, SCL + hl * 128, convw, convb, tid); }
            __syncthreads();
            const int hh = w >> 1, ph = w & 1;
            f32x4 acc[2][8];
#pragma unroll
            for (int a = 0; a < 2; ++a)
#pragma unroll
                for (int n = 0; n < 8; ++n) acc[a][n] = (f32x4){0.f, 0.f, 0.f, 0.f};
#pragma unroll
            for (int ks = 0; ks < 4; ++ks) {
                bf16x8 xa[2];
#pragma unroll
                for (int a = 0; a < 2; ++a) xa[a] = *(const LAS bf16x8*)(XT + (hh * 64 + 32 * ph + 16 * a + r16) * LSTR + 32 * ks + 8 * q);
#pragma unroll
                for (int n = 0; n < 8; ++n) { const bf16x8 bfr = *(const LAS bf16x8*)(BT + (16 * n + r16) * LSTR + 32 * ks + 8 * q);
#pragma unroll
                    for (int a = 0; a < 2; ++a) acc[a][n] = __builtin_amdgcn_mfma_f32_16x16x32_bf16(bfr, xa[a], acc[a][n], 0, 0, 0); }
            }
            bf16* st = ST + ((size_t)((b * MC_NC + c) * 16 + g * 8 + 4 * hb + hh)) * (64 * 128);
#pragma unroll
            for (int a = 0; a < 2; ++a)
#pragma unroll
                for (int n = 0; n < 8; ++n) { v2u o; o.x = pk2(acc[a][n][0], acc[a][n][1]); o.y = pk2(acc[a][n][2], acc[a][n][3]);
                    *(v2u*)(st + (32 * ph + 16 * a + r16) * 128 + 16 * n + 4 * q) = o; }
            __syncthreads();
        }
    }
}

__device__ __forceinline__ void m2_prefix(const Ctx& F) {
    const bf16* ST = (const bf16*)(F.ws + WS_ST); bf16* SIN = (bf16*)(F.ws + WS_SIN); const float* ATOT = (const float*)(F.ws + WS_ATOT);
    const int nthr = F.G * NTHR;
    for (int gi = blockIdx.x * NTHR + F.tid; gi < NB * 16 * 2048; gi += nthr) {
        const int e4 = gi & 2047, bh = gi >> 11, b = bh >> 4, h = bh & 15;
        float r0 = 0.f, r1 = 0.f, r2 = 0.f, r3 = 0.f;
#pragma unroll 4
        for (int c = 0; c < MC_NC; ++c) {
            const size_t o = ((size_t)((b * MC_NC + c) * 16 + h)) * 8192 + 4 * e4;
            v2u so; so.x = pk2(r0, r1); so.y = pk2(r2, r3);
            *(v2u*)(SIN + o) = so;
            const v2u sv = *(const v2u*)(ST + o); const float d = __expf(ATOT[(b * MC_NC + c) * 16 + h]);
            r0 = r0 * d + bflo(sv.x); r1 = r1 * d + bfhi(sv.x); r2 = r2 * d + bflo(sv.y); r3 = r3 * d + bfhi(sv.y);
        }
    }
}

__device__ __forceinline__ void m3_outputs(const Ctx& F) {
    const bf16* PROJ = (const bf16*)(F.ws + WS_PROJ); const bf16* SIN = (const bf16*)(F.ws + WS_SIN); bf16* OY = (bf16*)(F.ws + WS_OY);
    LAS bf16* Cn = (LAS bf16*)F.lds; LAS bf16* RB = (LAS bf16*)(F.lds + MT_BYTES);
    LAS bf16* Mw = (LAS bf16*)(F.lds + 2 * MT_BYTES) + F.wave * 16 * LSTR;
    LAS float* DT = (LAS float*)(F.lds + 3 * MT_BYTES); LAS float* ACS = DT + 8 * 128;
    const float* convw = F.in[I_CONVW]; const float* convb = F.in[I_CONVB];
    const int tid = F.tid, w = F.wave, lane = F.lane, r16 = lane & 15, q = lane >> 4;
    for (int it = blockIdx.x; it < NB * MC_NC * 2; it += F.G) {
        const int g = it & 1, c = (it >> 1) & (MC_NC - 1), b = it >> 7;
        __syncthreads();
        (void)mamba_dt_scan(F, PROJ, b, c, g, DT, ACS);
        mstage_N(PROJ, b, c, g, RB, Cn, convw, convb, tid);
        __syncthreads();
        TRaw rx;
        mstage_T_load(rx, PROJ, b, c, (g * 8 + ((tid & 127) >> 6)) * 64 + (tid & 63), tid);
        bf16x8 cf[4];
#pragma unroll
        for (int ks = 0; ks < 4; ++ks) cf[ks] = *(const LAS bf16x8*)(Cn + (16 * w + r16) * LSTR + 32 * ks + 8 * q);
        f32x4 Gt[8];
#pragma unroll
        for (int nt = 0; nt < 8; ++nt) { Gt[nt] = (f32x4){0.f, 0.f, 0.f, 0.f};
#pragma unroll
            for (int ks = 0; ks < 4; ++ks) Gt[nt] = __builtin_amdgcn_mfma_f32_16x16x32_bf16(*(const LAS bf16x8*)(RB + (16 * nt + r16) * LSTR + 32 * ks + 8 * q), cf[ks], Gt[nt], 0, 0, 0); }
        const int l = 16 * w + r16;
        const size_t mrow = (size_t)(b * SEQ + c * MC_L + l);
#pragma unroll 1
        for (int hb = 0; hb < 4; ++hb) {
            __syncthreads();
            { const int hl = 2 * hb + ((tid & 127) >> 6); mstage_T_store<false>(rx, (g * 8 + hl) * 64 + (tid & 63), RB, nullptr, convw, convb, tid); }
            { const int hn = (hb < 3) ? 2 * (hb + 1) : 2 * hb; mstage_T_load(rx, PROJ, b, c, (g * 8 + hn + ((tid & 127) >> 6)) * 64 + (tid & 63), tid); }
            __syncthreads();
#pragma unroll 1
            for (int h2 = 0; h2 < 2; ++h2) {
                const int hl = 2 * hb + h2, head = g * 8 + hl;
                const float acs_l = ACS[hl * 128 + l];
                const bf16* sin = SIN + ((size_t)((b * MC_NC + c) * 16 + head)) * 8192;
                bf16x8 sf[4][4];
#pragma unroll
                for (int pt = 0; pt < 4; ++pt)
#pragma unroll
                    for (int ks = 0; ks < 4; ++ks) sf[pt][ks] = *(const bf16x8*)(sin + (16 * pt + r16) * 128 + 32 * ks + 8 * q);
#pragma unroll
                for (int nt = 0; nt < 8; ++nt) { const f32x4 as = *(const LAS f32x4*)(ACS + hl * 128 + 16 * nt + 4 * q), ds = *(const LAS f32x4*)(DT + hl * 128 + 16 * nt + 4 * q);
                    float mv[4];
#pragma unroll
                    for (int j = 0; j < 4; ++j) { const int s = 16 * nt + 4 * q + j; mv[j] = (s <= l) ? Gt[nt][j] * __expf(acs_l - as[j]) * ds[j] : 0.f; }
                    v2u o; o.x = pk2(mv[0], mv[1]); o.y = pk2(mv[2], mv[3]);
                    *(LAS v2u*)(Mw + r16 * LSTR + 16 * nt + 4 * q) = o; }
                LDS_WAIT(); asm volatile("" ::: "memory");
                bf16x8 mf[4];
#pragma unroll
                for (int ks = 0; ks < 4; ++ks) mf[ks] = *(const LAS bf16x8*)(Mw + r16 * LSTR + 32 * ks + 8 * q);
                const float el = __expf(acs_l), Dh = F.in[I_DSK][head];
#pragma unroll
                for (int pt = 0; pt < 4; ++pt) {
                    f32x4 yd = {0.f, 0.f, 0.f, 0.f}, yo = {0.f, 0.f, 0.f, 0.f};
#pragma unroll
                    for (int ks = 0; ks < 4; ++ks) {
                        yd = __builtin_amdgcn_mfma_f32_16x16x32_bf16(*(const LAS bf16x8*)(RB + (h2 * 64 + 16 * pt + r16) * LSTR + 32 * ks + 8 * q), mf[ks], yd, 0, 0, 0);
                        yo = __builtin_amdgcn_mfma_f32_16x16x32_bf16(sf[pt][ks], cf[ks], yo, 0, 0, 0); }
                    float yv[4];
#pragma unroll
                    for (int j = 0; j < 4; ++j) yv[j] = yd[j] + el * yo[j] + Dh * bf1(RB[(h2 * 64 + 16 * pt + 4 * q + j) * LSTR + l]);
                    v2u o; o.x = pk2(yv[0], yv[1]); o.y = pk2(yv[2], yv[3]);
                    *(v2u*)(OY + mrow * DM + RW + head * 64 + 16 * pt + 4 * q) = o;
                }
                asm volatile("" ::: "memory");
            }
        }
    }
}
constexpr int RC = 16, RNCH = SEQ / RC, NPART = 4, RHALF = RNCH / NPART, RITEMS = NB * RHEADS * RHALF;
constexpr size_t RO_WH = 0, RO_RH = 16 * MiB, RO_VT = 32 * MiB, RO_ET = 48 * MiB, RO_OL = 64 * MiB, RO_A2 = 80 * MiB, RO_GC = 112 * MiB, RO_BUF = 116 * MiB, RO_SS = 232 * MiB;
constexpr int RL_KAP = 0, RL_ALP = 2304, RL_KT = 4608, RL_RT = 6912, RL_KAPT = 9216, RL_VT = 11264, RL_TB = 13312, RL_BL = 14336, RL_QL = 15360, RL_PL = 16384,
              RL_WT = RL_KAP, RL_BVT = RL_ALP, RL_AL32 = RL_KT, RL_ET = RL_KT,
              RL_BYTES = 18176;
constexpr int XS = 72, TS = 16, SS16 = 32;

__device__ __forceinline__ float wave_sum_pl(float x) {
    x = rowsum16(x);
    { auto rr = __builtin_amdgcn_permlane16_swap(__float_as_uint(x), __float_as_uint(x), false, false); x = __uint_as_float(rr[0]) + __uint_as_float(rr[1]); }
    { auto rr = __builtin_amdgcn_permlane32_swap(__float_as_uint(x), __float_as_uint(x), false, false); x = __uint_as_float(rr[0]) + __uint_as_float(rr[1]); }
    return x;
}
__device__ __forceinline__ v2u pack4(const f32x4 a) { v2u o; o.x = pk2(a[0], a[1]); o.y = pk2(a[2], a[3]); return o; }
__device__ __forceinline__ f32x4 unpack4(const v2u u) { return (f32x4){bflo(u.x), bfhi(u.x), bflo(u.y), bfhi(u.y)}; }
__device__ __forceinline__ bf16 f2b(float x) { return (bf16)pk2(x, 0.f); }

__device__ __forceinline__ void ra_item(const Ctx& F, LAS unsigned char* wl, int it, int half) {
    const int bh = it / RHALF, cl = it - bh * RHALF, ci = half * RHALF + cl, b = bh >> 4, h = bh & 15;
    const bf16* PROJ = (const bf16*)(F.ws + WS_PROJ); const bf16* LW = (const bf16*)(F.ws + WS_LW); const bf16* AA = (const bf16*)(F.ws + WS_AA);
    unsigned char* RO = (unsigned char*)F.out + (size_t)(half & 1) * RO_BUF;
    const int lane = F.lane, r16 = lane & 15, q = lane >> 4, c = lane, ch = h * 64 + c;
    const size_t m0 = (size_t)b * SEQ + (size_t)RC * ci;
    LAS bf16* KAP = (LAS bf16*)(wl + RL_KAP); LAS bf16* ALP = (LAS bf16*)(wl + RL_ALP); LAS bf16* KT = (LAS bf16*)(wl + RL_KT); LAS bf16* RT = (LAS bf16*)(wl + RL_RT);
    LAS bf16* KAPT = (LAS bf16*)(wl + RL_KAPT); LAS bf16* VTL = (LAS bf16*)(wl + RL_VT); LAS bf16* WT = (LAS bf16*)(wl + RL_WT); LAS bf16* BVT = (LAS bf16*)(wl + RL_BVT); LAS bf16* ETL = (LAS bf16*)(wl + RL_ET);
    LAS bf16* TB = (LAS bf16*)(wl + RL_TB); LAS bf16* BL = (LAS bf16*)(wl + RL_BL); LAS bf16* QL = (LAS bf16*)(wl + RL_QL); LAS bf16* PL = (LAS bf16*)(wl + RL_PL);
    const float mu_r = F.in[I_MU][C_R + ch], mu_k = F.in[I_MU][C_K + ch], mu_v = F.in[I_MU][C_V + ch], kkw = F.in[I_KK][ch], kaw = F.in[I_KA][ch];
    const bf16* prow = PROJ + m0 * INPP + ch;
    float rp = 0.f, kp = 0.f, vp = 0.f;
    if (ci > 0) { rp = bf1(prow[-INPP + C_R]); kp = bf1(prow[-INPP + C_K]); vp = bf1(prow[-INPP + C_V]); }
    float ec = 1.f, kkna[RC], kpv[RC], env[RC], vvv[RC];
    float cum = 0.f;
    float rrv[RC], kxv[RC], av[RC], lwv[RC], sq[RC];
#pragma unroll
    for (int t = 0; t < RC; ++t) {
        const bf16* row = prow + (size_t)t * INPP;
        const float rc = bf1(row[C_R]), kc = bf1(row[C_K]), vc = bf1(row[C_V]);
        av[t] = bf1(AA[(m0 + t) * RW + ch]); lwv[t] = bf1(LW[(m0 + t) * RW + ch]);
        rrv[t] = rc + (rp - rc) * mu_r; kxv[t] = kc + (kp - kc) * mu_k; vvv[t] = vc + (vp - vc) * mu_v;
        rp = rc; kp = kc; vp = vc;
        const float kkraw = kxv[t] * kkw; sq[t] = kkraw * kkraw;
    }
    float invn;
    { float ssum = treduce16(sq, r16 & 1, r16 & 2, r16 & 4, r16 & 8);
      { auto sw = __builtin_amdgcn_permlane16_swap(__float_as_uint(ssum), __float_as_uint(ssum), false, false); ssum = __uint_as_float(sw[0]) + __uint_as_float(sw[1]); }
      { auto sw = __builtin_amdgcn_permlane32_swap(__float_as_uint(ssum), __float_as_uint(ssum), false, false); ssum = __uint_as_float(sw[0]) + __uint_as_float(sw[1]); }
      invn = rcp_f(fmaxf(sqrtf(ssum), 1e-12f)); }
#pragma unroll
    for (int t = 0; t < RC; ++t) {
        const float a = av[t], lw = lwv[t], rr = rrv[t], kx = kxv[t], vv = vvv[t];
        const float kkn = kx * kkw * __uint_as_float(__builtin_amdgcn_readlane(__float_as_uint(invn), t));
        const float kpp = kx * (1.f + (a - 1.f) * kaw);
        const float ep = ec; cum += lw; ec = __expf(cum); const float en = rcp_f(ec);
        const unsigned p0 = pk2(kkn * ep, kkn * a * en), p1 = pk2(kpp * en, rr * ec), p2 = pk2(vv, 0.f);
        KAP[t * XS + c] = (bf16)p0; ALP[t * XS + c] = (bf16)(p0 >> 16); KT[t * XS + c] = (bf16)p1; RT[t * XS + c] = (bf16)(p1 >> 16);
        KAPT[c * TS + t] = (bf16)p0; VTL[c * TS + t] = (bf16)p2;
        kkna[t] = kkn * a; kpv[t] = kpp; env[t] = en;
    }
    {
        float e8[8]; v4u* vt = (v4u*)((bf16*)(RO + RO_VT) + (size_t)it * 1024 + c * 16);
#pragma unroll
        for (int i = 0; i < 8; ++i) e8[i] = vvv[i];
        vt[0] = pack8(e8);
#pragma unroll
        for (int i = 0; i < 8; ++i) e8[i] = vvv[8 + i];
        vt[1] = pack8(e8);
        v4u* a2 = (v4u*)((bf16*)(RO + RO_A2) + (size_t)it * 2048 + c * 32);
        float dd[RC];
#pragma unroll
        for (int t = 0; t < RC; ++t) dd[t] = ec * env[t];
#pragma unroll
        for (int i = 0; i < 8; ++i) e8[i] = -kkna[i] * dd[i];
        a2[0] = pack8(e8);
#pragma unroll
        for (int i = 0; i < 8; ++i) e8[i] = -kkna[8 + i] * dd[8 + i];
        a2[1] = pack8(e8);
#pragma unroll
        for (int i = 0; i < 8; ++i) e8[i] = kpv[i] * dd[i];
        a2[2] = pack8(e8);
#pragma unroll
        for (int i = 0; i < 8; ++i) e8[i] = kpv[8 + i] * dd[8 + i];
        a2[3] = pack8(e8);
        ((float*)(RO + RO_GC))[(size_t)it * 64 + c] = ec;
    }
    LDS_WAIT(); asm volatile("" ::: "memory");
    const v2u zero2 = {0u, 0u};
    {
        f32x4 alt = {0.f, 0.f, 0.f, 0.f}, blt = alt, qlt = alt, plt = alt;
#pragma unroll
        for (int ks = 0; ks < 2; ++ks) {
            const bf16x8 fa = *(const LAS bf16x8*)(ALP + r16 * XS + 32 * ks + 8 * q), fk = *(const LAS bf16x8*)(KT + r16 * XS + 32 * ks + 8 * q);
            const bf16x8 fkp = *(const LAS bf16x8*)(KAP + r16 * XS + 32 * ks + 8 * q), fr = *(const LAS bf16x8*)(RT + r16 * XS + 32 * ks + 8 * q);
            alt = __builtin_amdgcn_mfma_f32_16x16x32_bf16(fa, fkp, alt, 0, 0, 0); blt = __builtin_amdgcn_mfma_f32_16x16x32_bf16(fk, fkp, blt, 0, 0, 0);
            qlt = __builtin_amdgcn_mfma_f32_16x16x32_bf16(fa, fr, qlt, 0, 0, 0);  plt = __builtin_amdgcn_mfma_f32_16x16x32_bf16(fk, fr, plt, 0, 0, 0);
        }
#pragma unroll
        for (int j = 0; j < 4; ++j) { const int s = 4 * q + j; const bool lt = s < r16, le = s <= r16;
            alt[j] = lt ? alt[j] : 0.f; blt[j] = lt ? blt[j] : 0.f; qlt[j] = le ? qlt[j] : 0.f; plt[j] = le ? plt[j] : 0.f; }
        *(LAS v2u*)(BL + r16 * SS16 + 4 * q) = pack4(blt); *(LAS v2u*)(QL + r16 * SS16 + 4 * q) = pack4(qlt); *(LAS v2u*)(PL + r16 * SS16 + 4 * q) = pack4(plt);
        *(LAS v2u*)(BL + r16 * SS16 + 16 + 4 * q) = zero2; *(LAS v2u*)(QL + r16 * SS16 + 16 + 4 * q) = zero2; *(LAS v2u*)(PL + r16 * SS16 + 16 + 4 * q) = zero2;
        float x[RC];
#pragma unroll
        for (int t = 0; t < RC; ++t) {
            float acc = (t == r16) ? 1.f : 0.f;
#pragma unroll
            for (int s2 = 0; s2 < t; ++s2) { const float a_ts = __uint_as_float(__builtin_amdgcn_readlane(__float_as_uint(alt[s2 & 3]), 16 * (s2 >> 2) + t)); acc -= a_ts * x[s2]; }
            x[t] = acc;
        }
        if (q == 0) {
#pragma unroll
            for (int t = 0; t < RC; ++t) { TB[t * SS16 + r16] = f2b(x[t]); TB[t * SS16 + 16 + r16] = 0; }
        }
    }
    LDS_WAIT(); asm volatile("" ::: "memory");
    const bf16x8 zf = {0, 0, 0, 0, 0, 0, 0, 0};
    const bf16x8 tbf = *(const LAS bf16x8*)(TB + r16 * SS16 + 8 * q), blf = *(const LAS bf16x8*)(BL + r16 * SS16 + 8 * q);
    const bf16x8 qlf = *(const LAS bf16x8*)(QL + r16 * SS16 + 8 * q), plf = *(const LAS bf16x8*)(PL + r16 * SS16 + 8 * q);
    const f32x4 z4 = {0.f, 0.f, 0.f, 0.f};
    bf16* gWH = (bf16*)(RO + RO_WH) + (size_t)it * 1024; bf16* gRH = (bf16*)(RO + RO_RH) + (size_t)it * 1024;
    bf16* gET = (bf16*)(RO + RO_ET) + (size_t)it * 1024; bf16* gOL = (bf16*)(RO + RO_OL) + (size_t)it * 1024;
#pragma unroll
    for (int kt = 0; kt < 4; ++kt) {
        const bf16x8 kf = (q < 2) ? *(const LAS bf16x8*)(KAPT + (16 * kt + r16) * TS + 8 * q) : zf;
        const f32x4 wa = __builtin_amdgcn_mfma_f32_16x16x32_bf16(kf, tbf, z4, 0, 0, 0);
        *(v2u*)(gWH + r16 * 64 + 16 * kt + 4 * q) = pack4(wa);
        const f32x4 wb = __builtin_amdgcn_mfma_f32_16x16x32_bf16(tbf, kf, z4, 0, 0, 0);
        *(LAS v2u*)(WT + (16 * kt + r16) * TS + 4 * q) = pack4(wb);
        const bf16x8 vf = (q < 2) ? *(const LAS bf16x8*)(VTL + (16 * kt + r16) * TS + 8 * q) : zf;
        const f32x4 bv = __builtin_amdgcn_mfma_f32_16x16x32_bf16(blf, vf, z4, 0, 0, 0);
        *(LAS v2u*)(BVT + (16 * kt + r16) * TS + 4 * q) = pack4(bv);
    }
    LDS_WAIT(); asm volatile("" ::: "memory");
#pragma unroll
    for (int vt = 0; vt < 4; ++vt) {
        const bf16x8 bf_ = (q < 2) ? *(const LAS bf16x8*)(BVT + (16 * vt + r16) * TS + 8 * q) : zf;
        const f32x4 e4 = __builtin_amdgcn_mfma_f32_16x16x32_bf16(tbf, bf_, z4, 0, 0, 0);
        const v2u ep = pack4(e4);
        *(LAS v2u*)(ETL + (16 * vt + r16) * TS + 4 * q) = ep; *(v2u*)(gET + (16 * vt + r16) * 16 + 4 * q) = ep;
    }
    LDS_WAIT(); asm volatile("" ::: "memory");
#pragma unroll
    for (int kt = 0; kt < 4; ++kt) {
        const bf16x8 wf = (q < 2) ? *(const LAS bf16x8*)(WT + (16 * kt + r16) * TS + 8 * q) : zf;
        const f32x4 qw = __builtin_amdgcn_mfma_f32_16x16x32_bf16(wf, qlf, z4, 0, 0, 0);
        const f32x4 rt4 = unpack4(*(const LAS v2u*)(RT + r16 * XS + 16 * kt + 4 * q));
        *(v2u*)(gRH + r16 * 64 + 16 * kt + 4 * q) = pack4(rt4 - qw);
        const bf16x8 vf = (q < 2) ? *(const LAS bf16x8*)(VTL + (16 * kt + r16) * TS + 8 * q) : zf;
        const bf16x8 ef = (q < 2) ? *(const LAS bf16x8*)(ETL + (16 * kt + r16) * TS + 8 * q) : zf;
        const f32x4 pv = __builtin_amdgcn_mfma_f32_16x16x32_bf16(vf, plf, z4, 0, 0, 0);
        const f32x4 qe = __builtin_amdgcn_mfma_f32_16x16x32_bf16(ef, qlf, z4, 0, 0, 0);
        *(v2u*)(gOL + r16 * 64 + 16 * kt + 4 * q) = pack4(pv - qe);
    }
    LDS_WAIT(); asm volatile("" ::: "memory");
}
__device__ __forceinline__ void ra_part(const Ctx& F, int part) {
    LAS unsigned* ctr = (LAS unsigned*)(F.lds + LDS_BYTES - 48) + part;
    LAS unsigned char* wl = F.lds + F.wave * RL_BYTES;
    for (;;) {
        unsigned idx = 0;
        if (F.lane == 0) idx = __hip_atomic_fetch_add(ctr, 1u, __ATOMIC_RELAXED, __HIP_MEMORY_SCOPE_WORKGROUP);
        idx = (unsigned)__builtin_amdgcn_readfirstlane((int)idx);
        const int it = (int)blockIdx.x + F.G * (int)idx;
        if (it >= RITEMS) break;
        ra_item(F, wl, it, part);
    }
}

__device__ __forceinline__ void rs_half(const Ctx& F, int half) {
    if (F.wave != 0) return;
    const unsigned char* RO = (const unsigned char*)F.out + (size_t)(half & 1) * RO_BUF; bf16* OY = (bf16*)(F.ws + WS_OY);
    float* SSg = (float*)((unsigned char*)F.out + RO_SS);
    LAS bf16* ST = (LAS bf16*)F.lds;
    LAS bf16* ZT = (LAS bf16*)(F.lds + 16 * XS * 2);
    constexpr int ZS = 24;
    const int lane = F.lane, r16 = lane & 15, q = lane >> 4;
    for (int blk = blockIdx.x; blk < NB * RHEADS * 4; blk += F.G) {
        const int xcd = blk & 7, jj = blk >> 3, qt = jj & 3, bh = (jj >> 2) * 8 + xcd, b = bh >> 4, h = bh & 15;
        f32x4 S[4];
        if (half == 0) {
#pragma unroll
            for (int kt = 0; kt < 4; ++kt) S[kt] = (f32x4){0.f, 0.f, 0.f, 0.f};
        } else {
#pragma unroll
            for (int kt = 0; kt < 4; ++kt) S[kt] = *(const f32x4*)(SSg + (size_t)blk * 1024 + (kt * 64 + lane) * 4);
        }
#pragma unroll
        for (int kt = 0; kt < 4; ++kt) *(LAS v2u*)(ST + r16 * XS + 16 * kt + 4 * q) = pack4(S[kt]);
        LDS_WAIT(); asm volatile("" ::: "memory");
        const size_t it0 = (size_t)bh * RHALF;
        const size_t mbase = (size_t)b * SEQ + (size_t)half * RHALF * RC;
#define RS_LOAD(IT, WF, RF, A2F, VF, ET4, OL4, GC4) do { const size_t it_ = (IT); \
        const bf16* wh_ = (const bf16*)(RO + RO_WH) + it_ * 1024 + r16 * 64 + 8 * q; const bf16* rh_ = (const bf16*)(RO + RO_RH) + it_ * 1024 + r16 * 64 + 8 * q; \
        WF[0] = *(const bf16x8*)wh_; WF[1] = *(const bf16x8*)(wh_ + 32); RF[0] = *(const bf16x8*)rh_; RF[1] = *(const bf16x8*)(rh_ + 32); \
        _Pragma("unroll") for (int kt_ = 0; kt_ < 4; ++kt_) { A2F[kt_] = *(const bf16x8*)((const bf16*)(RO + RO_A2) + it_ * 2048 + (16 * kt_ + r16) * 32 + 8 * q); \
            GC4[kt_] = *(const f32x4*)((const float*)(RO + RO_GC) + it_ * 64 + 16 * kt_ + 4 * q); } \
        VF = *(const bf16x8*)((const bf16*)(RO + RO_VT) + it_ * 1024 + (16 * qt + r16) * 16 + 8 * (q & 1)); \
        ET4 = *(const v2u*)((const bf16*)(RO + RO_ET) + it_ * 1024 + (16 * qt + r16) * 16 + 4 * q); \
        OL4 = *(const v2u*)((const bf16*)(RO + RO_OL) + it_ * 1024 + r16 * 64 + 16 * qt + 4 * q); } while (0)
        bf16x8 wfq[2][2], rfq[2][2], a2q[2][4], vfq[2]; v2u etq[2], olq[2]; f32x4 gcq[2][4];
#pragma unroll
        for (int u = 0; u < 2; ++u) RS_LOAD(it0 + u, wfq[u], rfq[u], a2q[u], vfq[u], etq[u], olq[u], gcq[u]);
#define RS_STEP(U, CL) do { const int cl_ = (CL); \
            const bf16x8 sb0 = *(const LAS bf16x8*)(ST + r16 * XS + 8 * q), sb1 = *(const LAS bf16x8*)(ST + r16 * XS + 32 + 8 * q); \
            f32x4 x1 = __builtin_amdgcn_mfma_f32_16x16x32_bf16(wfq[U][0], sb0, (f32x4){0.f, 0.f, 0.f, 0.f}, 0, 0, 0); \
            x1 = __builtin_amdgcn_mfma_f32_16x16x32_bf16(wfq[U][1], sb1, x1, 0, 0, 0); \
            f32x4 ot = __builtin_amdgcn_mfma_f32_16x16x32_bf16(sb0, rfq[U][0], unpack4(olq[U]), 0, 0, 0); \
            ot = __builtin_amdgcn_mfma_f32_16x16x32_bf16(sb1, rfq[U][1], ot, 0, 0, 0); \
            *(LAS v2u*)(ZT + r16 * ZS + 4 * q) = pack4(x1 + unpack4(etq[U])); \
            *(v2u*)(OY + (mbase + (size_t)cl_ * RC + r16) * DM + h * 64 + 16 * qt + 4 * q) = pack4(ot); \
            LDS_WAIT(); asm volatile("" ::: "memory"); \
            const bf16x8 zr = *(const LAS bf16x8*)(ZT + r16 * ZS + 8 * (q & 1)); \
            const bf16x8 bz = (q < 2) ? zr : vfq[U]; \
            _Pragma("unroll") for (int kt = 0; kt < 4; ++kt) { S[kt] = __builtin_amdgcn_mfma_f32_16x16x32_bf16(a2q[U][kt], bz, S[kt] * gcq[U][kt], 0, 0, 0); \
                *(LAS v2u*)(ST + r16 * XS + 16 * kt + 4 * q) = pack4(S[kt]); } \
            RS_LOAD(it0 + ((cl_ + 2 < RHALF) ? cl_ + 2 : RHALF - 1), wfq[U], rfq[U], a2q[U], vfq[U], etq[U], olq[U], gcq[U]);     \
            LDS_WAIT(); asm volatile("" ::: "memory"); } while (0)
#pragma unroll 1
        for (int cl = 0; cl < RHALF; cl += 2) { RS_STEP(0, cl); RS_STEP(1, cl + 1); }
#undef RS_STEP
#undef RS_LOAD
        if (half + 1 < NPART) {
#pragma unroll
            for (int kt = 0; kt < 4; ++kt) *(f32x4*)(SSg + (size_t)blk * 1024 + (kt * 64 + lane) * 4) = S[kt];
        }
    }
}
__device__ __forceinline__ float rowmax16(float x) { x = fmaxf(x, dpp_f<0xB1>(x)); x = fmaxf(x, dpp_f<0x4E>(x)); x = fmaxf(x, dpp_f<0x124>(x)); x = fmaxf(x, dpp_f<0x128>(x)); return x; }
__device__ __forceinline__ int cand_code(int s) {
    if (s < 16) return s << 4;
    if (s < 24) return 1 | ((s - 16) << 4);
    if (s < 29) return 2 | ((s - 24) << 4);
    if (s < 33) return 3 | ((s - 29) << 4);
    if (s < 36) return 4 | ((s - 33) << 4);
    if (s < 42) { const int k = s - 36; return (5 + (k >> 1)) | ((k & 1) << 4); }
    if (s < 50) return 8 + (s - 42);
    return -1;
}
__device__ __forceinline__ int f2ord(float f) { const int b = __float_as_int(f); return b ^ ((b >> 31) & 0x7fffffff); }
__device__ __forceinline__ float ord2f(int k) { return __int_as_float(k ^ ((k >> 31) & 0x7fffffff)); }
template <int CTRL> __device__ __forceinline__ int dpp_i(int x) { return __builtin_amdgcn_mov_dpp(x, CTRL, 0xf, 0xf, true); }
__device__ __forceinline__ int imax(int a, int b) { return a > b ? a : b; }
__device__ __forceinline__ int imin(int a, int b) { return a < b ? a : b; }
__device__ __forceinline__ int rowmax16_i(int x) { x = imax(x, dpp_i<0xB1>(x)); x = imax(x, dpp_i<0x4E>(x)); x = imax(x, dpp_i<0x124>(x)); x = imax(x, dpp_i<0x128>(x)); return x; }
#define CSWAP_(a, b) do { const int hi_ = imax(a, b), lo_ = imin(a, b); a = hi_; b = lo_; } while (0)
template <int NV> __device__ __forceinline__ void sort_desc(int (&v)[NV]);
template <> __device__ __forceinline__ void sort_desc<8>(int (&v)[8]) {
    CSWAP_(v[0], v[1]); CSWAP_(v[2], v[3]); CSWAP_(v[4], v[5]); CSWAP_(v[6], v[7]);
    CSWAP_(v[0], v[2]); CSWAP_(v[1], v[3]); CSWAP_(v[4], v[6]); CSWAP_(v[5], v[7]);
    CSWAP_(v[1], v[2]); CSWAP_(v[5], v[6]);
    CSWAP_(v[0], v[4]); CSWAP_(v[1], v[5]); CSWAP_(v[2], v[6]); CSWAP_(v[3], v[7]);
    CSWAP_(v[2], v[4]); CSWAP_(v[3], v[5]);
    CSWAP_(v[1], v[2]); CSWAP_(v[3], v[4]); CSWAP_(v[5], v[6]);
}
template <> __device__ __forceinline__ void sort_desc<4>(int (&v)[4]) {
    CSWAP_(v[0], v[1]); CSWAP_(v[2], v[3]); CSWAP_(v[0], v[2]); CSWAP_(v[1], v[3]); CSWAP_(v[1], v[2]);
}
template <int NV>
__device__ __forceinline__ void select16x4(int (&v)[4][NV], int r16, float (&kept_f)[4]) {
    const int IMIN = (int)0x80000000;
    int kept[4];
#pragma unroll
    for (int j = 0; j < 4; ++j) { kept[j] = IMIN; sort_desc<NV>(v[j]); }
#pragma unroll 1
    for (int rd = 0; rd < 16; ++rd) {
#pragma unroll
        for (int j = 0; j < 4; ++j) {
            const int m = rowmax16_i(v[j][0]);
            kept[j] = (r16 == rd) ? m : kept[j];
            const bool own = (v[j][0] == m);
#pragma unroll
            for (int i = 0; i < NV - 1; ++i) v[j][i] = own ? v[j][i + 1] : v[j][i];
            v[j][NV - 1] = own ? IMIN : v[j][NV - 1];
        }
    }
#pragma unroll
    for (int j = 0; j < 4; ++j) kept_f[j] = ord2f(kept[j]);
}
__device__ __forceinline__ float dot2bf(unsigned a, unsigned b, float acc) { return __builtin_amdgcn_fdot2_f32_bf16(__builtin_bit_cast(bf16x2_t, a), __builtin_bit_cast(bf16x2_t, b), acc, false); }

constexpr int PT = 16;
constexpr size_t RANGE_BYTES = (size_t)NEXP * 128;

__device__ __forceinline__ void p9_route(const Ctx& F) {
    constexpr int KSTR = 136;
    const bf16* Q = (const bf16*)(F.ws + WS_Q); const bf16* KEYS = (const bf16*)(F.ws + WS_KEYS);
    int* rtE = (int*)(F.ws + WS_RTE); float* rtG = (float*)(F.ws + WS_RTG);
    LAS bf16* KL = (LAS bf16*)F.lds;
    const int lane = F.lane, w = F.wave, r16 = lane & 15, q = lane >> 4, gbase = lane & 48;
    const int h = blockIdx.x & 7, nbh = (F.G - h + 7) >> 3;
    __syncthreads();
    for (int i = F.tid; i < 2 * 128 * 16; i += NTHR) { const int row = i >> 4, ch = i & 15;
        *(LAS v4u*)(KL + row * KSTR + 8 * ch) = *(const v4u*)(KEYS + (size_t)(2 * h * 128 + row) * 128 + 8 * ch); }
    __syncthreads();
    int ci[4], cj[4]; bool cvalid[4];
#pragma unroll
    for (int u = 0; u < 4; ++u) { const int cd = cand_code(r16 + 16 * u); cvalid[u] = cd >= 0; ci[u] = cd & 15; cj[u] = (cd >> 4) & 15; }
    const float NINF = -__builtin_inff();
    const int tstride = nbh * NWAVES;
    int tile = (blockIdx.x >> 3) * NWAVES + w;
    bf16x8 afn[2][4];
    if (tile < M / PT) {
#pragma unroll
        for (int p = 0; p < 2; ++p)
#pragma unroll
            for (int s = 0; s < 4; ++s) afn[p][s] = *(const bf16x8*)(Q + (size_t)(tile * PT + r16) * DM + (2 * h + p) * 128 + 8 * q + 32 * s);
    }
    for (; tile < M / PT; tile += tstride) {
        const int m0 = tile * PT;
        bf16x8 af[2][4];
#pragma unroll
        for (int p = 0; p < 2; ++p)
#pragma unroll
            for (int s = 0; s < 4; ++s) af[p][s] = afn[p][s];
        { const int tn = (tile + tstride < M / PT) ? tile + tstride : tile;
#pragma unroll
            for (int p = 0; p < 2; ++p)
#pragma unroll
                for (int s = 0; s < 4; ++s) afn[p][s] = *(const bf16x8*)(Q + (size_t)(tn * PT + r16) * DM + (2 * h + p) * 128 + 8 * q + 32 * s);
        }
        float top[2][4];
#pragma unroll
        for (int p = 0; p < 2; ++p) {
            int v[4][8];
#pragma unroll
            for (int nt = 0; nt < 8; ++nt) {
                const LAS bf16* krow = KL + (p * 128 + nt * 16 + r16) * KSTR + 8 * q;
                f32x4 acc = {0.f, 0.f, 0.f, 0.f};
#pragma unroll
                for (int s = 0; s < 4; ++s) acc = __builtin_amdgcn_mfma_f32_16x16x32_bf16(af[p][s], *(const LAS bf16x8*)(krow + 32 * s), acc, 0, 0, 0);
                const unsigned tag = 127u - (unsigned)(nt * 16 + r16);
#pragma unroll
                for (int j = 0; j < 4; ++j) v[j][nt] = f2ord(__uint_as_float((__float_as_uint(acc[j]) & ~127u) | tag));
                if (nt & 1) asm volatile("" ::: "memory");
            }
            select16x4<8>(v, r16, top[p]);
        }
        int cv[4][4];
#pragma unroll
        for (int u = 0; u < 4; ++u)
#pragma unroll
            for (int j = 0; j < 4; ++j) {
                const float a = __shfl(top[0][j], gbase + ci[u]), b = __shfl(top[1][j], gbase + cj[u]);
                const float cs = __uint_as_float(__float_as_uint(a) & ~127u) + __uint_as_float(__float_as_uint(b) & ~127u);
                const float pk = __uint_as_float((__float_as_uint(cs) & ~63u) | (63u - (unsigned)(r16 + 16 * u)));
                cv[j][u] = cvalid[u] ? f2ord(pk) : (int)0x80000000;
            }
        float best[4];
        select16x4<4>(cv, r16, best);
#pragma unroll
        for (int j = 0; j < 4; ++j) {
            const unsigned bb = __float_as_uint(best[j]);
            const int cd = cand_code(63 - (int)(bb & 63u));
            const int k0 = 127 - (int)(__float_as_uint(__shfl(top[0][j], gbase + (cd & 15))) & 127u);
            const int k1 = 127 - (int)(__float_as_uint(__shfl(top[1][j], gbase + ((cd >> 4) & 15))) & 127u);
            const float s = __uint_as_float(bb & ~63u);
            const float mx = rowmax16(s), e = __expf(s - mx), sum = rowsum16(e);
            const size_t o = (size_t)(m0 + 4 * q + j) * 128 + h * 16 + r16;
            rtE[o] = k0 * 128 + k1; rtG[o] = e * rcp_f(sum);
        }
    }
}

__device__ __forceinline__ f32x2 cvt2_fp8(unsigned wd, bool hi) { return hi ? __builtin_amdgcn_cvt_pk_f32_fp8((int)wd, true) : __builtin_amdgcn_cvt_pk_f32_fp8((int)wd, false); }
__device__ __forceinline__ void treduce8x16(const float (&p)[16], bool b0, bool b1, bool b2, float& r0, float& r1) {
    float a[8], bq[4];
#pragma unroll
    for (int i = 0; i < 8; ++i) { const float mine = b2 ? p[i + 8] : p[i], send = b2 ? p[i] : p[i + 8]; const float up = dpp_f<0x104>(send), dn = dpp_f<0x114>(send); a[i] = mine + (b2 ? dn : up); }
#pragma unroll
    for (int i = 0; i < 4; ++i) { const float mine = b1 ? a[i + 4] : a[i], send = b1 ? a[i] : a[i + 4]; bq[i] = mine + dpp_f<0x4E>(send); }
    { const float mine = b0 ? bq[2] : bq[0], send = b0 ? bq[0] : bq[2]; r0 = mine + dpp_f<0xB1>(send); }
    { const float mine = b0 ? bq[3] : bq[1], send = b0 ? bq[1] : bq[3]; r1 = mine + dpp_f<0xB1>(send); }
}
struct XGroup { int xg, gwi, stride; };
__device__ __forceinline__ XGroup xgroup(const Ctx& F) { XGroup g; g.xg = blockIdx.x & 7; const int nbg = (F.G - g.xg + 7) >> 3; g.gwi = (blockIdx.x >> 3) * NWAVES + F.wave; g.stride = nbg * NWAVES; return g; }

__device__ __forceinline__ void p10_peer_u(const Ctx& F) {
    const unsigned char* PU8 = F.ws + WS_PU8; const bf16* XN = (const bf16*)(F.ws + WS_XN);
    const int* rtE = (const int*)(F.ws + WS_RTE); unsigned* PD = (unsigned*)(F.ws + WS_PD);
    const XGroup g = xgroup(F);
    const int lane = F.lane, j = lane >> 3, sub = lane & 7;
    const bool b0 = sub & 1, b1 = sub & 2, b2 = sub & 4;
    for (int rr = 0; rr < 2; ++rr) {
        const int r = g.xg + 8 * rr;
        const unsigned char* tab = PU8 + (size_t)r * RANGE_BYTES;
        const unsigned so = 16u * (unsigned)sub;
        int m = g.gwi;
        v4u ev[4], xs[2];
        if (m < M) {
#pragma unroll
            for (int i = 0; i < 4; ++i) ev[i] = *(const v4u*)(rtE + (size_t)m * 128 + 16 * j + 4 * i);
            xs[0] = *(const v4u*)(XN + (size_t)m * DM + 128 * r + 16 * sub); xs[1] = *(const v4u*)(XN + (size_t)m * DM + 128 * r + 16 * sub + 8);
        }
        for (; m < M; m += g.stride) {
            v4u gt[16];
#pragma unroll
            for (int k = 0; k < 16; ++k) gt[k] = *(const v4u*)(tab + (ev[k >> 2][k & 3] * 128u + so));
            float x[16]; { float t0[8], t1[8]; unpack8(xs[0], t0); unpack8(xs[1], t1);
#pragma unroll
              for (int i = 0; i < 8; ++i) { x[i] = t0[i]; x[8 + i] = t1[i]; } }
            const int mn = (m + g.stride < M) ? m + g.stride : m;
            {
#pragma unroll
                for (int i = 0; i < 4; ++i) ev[i] = *(const v4u*)(rtE + (size_t)mn * 128 + 16 * j + 4 * i);
                xs[0] = *(const v4u*)(XN + (size_t)mn * DM + 128 * r + 16 * sub); xs[1] = *(const v4u*)(XN + (size_t)mn * DM + 128 * r + 16 * sub + 8);
            }
            float p[16];
#pragma unroll
            for (int k = 0; k < 16; ++k) {
                f32x2 a0 = {0.f, 0.f}, a1 = {0.f, 0.f};
#pragma unroll
                for (int d = 0; d < 4; ++d) { const unsigned wd = gt[k][d];
                    a0 += cvt2_fp8(wd, false) * (f32x2){x[4 * d], x[4 * d + 1]}; a1 += cvt2_fp8(wd, true) * (f32x2){x[4 * d + 2], x[4 * d + 3]}; }
                p[k] = (a0.x + a0.y) + (a1.x + a1.y);
            }
            float r0, r1; treduce8x16(p, b0, b1, b2, r0, r1);
            PD[((size_t)r * M + m) * 64 + lane] = pk2(r0, r1);
        }
    }
}

__device__ __forceinline__ void p11_peer_coef(const Ctx& F) {
    const int* rtE = (const int*)(F.ws + WS_RTE); const float* rtG = (const float*)(F.ws + WS_RTG); const unsigned* PD = (const unsigned*)(F.ws + WS_PD);
    const float* usc = (const float*)(F.ws + WS_USC); const float* vsc = (const float*)(F.ws + WS_VSC); float* COEF = (float*)(F.ws + WS_COEF);
    for (int m = F.gw; m < M; m += F.NGW) {
        const size_t o = (size_t)m * 128 + 2 * F.lane;
        f32x2 d = {0.f, 0.f};
#pragma unroll
        for (int r = 0; r < 16; ++r) { const unsigned pw = PD[((size_t)r * M + m) * 64 + F.lane]; d += (f32x2){bflo(pw), bfhi(pw)}; }
        const int e0 = rtE[o], e1 = rtE[o + 1];
        const f32x2 gt = *(const f32x2*)(rtG + o);
        const float d0 = d.x * usc[e0], d1 = d.y * usc[e1];
        f32x2 c; c.x = gt.x * (0.5f * d0 * (1.f + erff(d0 * 0.70710678f))) * vsc[e0]; c.y = gt.y * (0.5f * d1 * (1.f + erff(d1 * 0.70710678f))) * vsc[e1];
        *(f32x2*)(COEF + o) = c;
    }
}

__device__ __forceinline__ void p12_peer_v(const Ctx& F) {
    const unsigned char* PV4 = F.ws + WS_PV8; const int* rtE = (const int*)(F.ws + WS_RTE); const float* COEF = (const float*)(F.ws + WS_COEF);
    const float* mod = (const float*)(F.ws + WS_MOD);
    const XGroup g = xgroup(F);
    const int lane = F.lane, j = lane >> 3, sub = lane & 7;
    const bool jb0 = j & 1;
    const int r = g.xg;
    const unsigned char* tab = PV4 + (size_t)r * RANGE_BYTES;
    const unsigned so = 16u * (unsigned)sub;
    int m = g.gwi;
    if (m >= M) return;
    const int st = g.stride;
#define PV_LDE(e, mm, hf) { e[0] = *(const v4u*)(rtE + (size_t)(mm) * 128 + 16 * j + 8 * (hf)); e[1] = *(const v4u*)(rtE + (size_t)(mm) * 128 + 16 * j + 8 * (hf) + 4); }
#define PV_LDC(c, mm, hf) { c[0] = *(const f32x4*)(COEF + (size_t)(mm) * 128 + 16 * j + 8 * (hf)); c[1] = *(const f32x4*)(COEF + (size_t)(mm) * 128 + 16 * j + 8 * (hf) + 4); }
#define PV_GATHER(gx, e) { _Pragma("unroll") for (int k = 0; k < 8; ++k) gx[k] = *(const v4u*)(tab + (e[k >> 2][k & 3] * 128u + so)); }
#define PV_ACC(gx, c) { _Pragma("unroll") for (int k = 0; k < 8; ++k) { const float cq = c[k >> 2][k & 3]; const f32x2 cv2 = {cq, cq}; \
        _Pragma("unroll") for (int d = 0; d < 4; ++d) { const unsigned wd = gx[k][d]; \
            acc[4 * d + 0] += cv2 * __builtin_amdgcn_cvt_scalef32_pk_f32_fp4(wd, 1.0f, 0); acc[4 * d + 1] += cv2 * __builtin_amdgcn_cvt_scalef32_pk_f32_fp4(wd, 1.0f, 1); \
            acc[4 * d + 2] += cv2 * __builtin_amdgcn_cvt_scalef32_pk_f32_fp4(wd, 1.0f, 2); acc[4 * d + 3] += cv2 * __builtin_amdgcn_cvt_scalef32_pk_f32_fp4(wd, 1.0f, 3); } } }
    v4u eA1[2], eB0[2], gA[8], gB[8]; f32x4 cA0[2], cA1[2], cB0[2];
    { v4u eA0[2]; PV_LDE(eA0, m, 0); PV_LDC(cA0, m, 0); PV_LDE(eB0, m, 1); PV_LDC(cB0, m, 1);
      const int m1 = (m + st < M) ? m + st : m; PV_LDE(eA1, m1, 0); PV_LDC(cA1, m1, 0);
      PV_GATHER(gA, eA0); }
    for (; m < M; m += st) {
        const int m1 = (m + st < M) ? m + st : m, m2 = (m + 2 * st < M) ? m + 2 * st : m;
        const int col = 256 * r + 32 * sub + 4 * j;
        v2u* orow = (v2u*)((bf16*)(F.ws + WS_HB) + (size_t)m * DM + col);
        const v2u hw = *orow; const f32x4 g2 = *(const f32x4*)(mod + (size_t)(m / SEQ) * MODW + 5 * DM + col);
        PV_GATHER(gB, eB0);
        v4u eB1[2], eA2[2]; f32x4 cB1[2], cA2[2];
        PV_LDE(eB1, m1, 1); PV_LDC(cB1, m1, 1); PV_LDE(eA2, m2, 0); PV_LDC(cA2, m2, 0);
        asm volatile("" : "+v"(gA[0]), "+v"(gA[1]), "+v"(gA[2]), "+v"(gA[3]), "+v"(gA[4]), "+v"(gA[5]), "+v"(gA[6]), "+v"(gA[7]) :: "memory");
        f32x2 acc[16];
#pragma unroll
        for (int i = 0; i < 16; ++i) acc[i] = (f32x2){0.f, 0.f};
        PV_ACC(gA, cA0);
        asm volatile("" ::: "memory");
        PV_GATHER(gA, eA1);
        asm volatile("" : "+v"(gB[0]), "+v"(gB[1]), "+v"(gB[2]), "+v"(gB[3]), "+v"(gB[4]), "+v"(gB[5]), "+v"(gB[6]), "+v"(gB[7]) :: "memory");
        PV_ACC(gB, cB0);
        float a[32];
#pragma unroll
        for (int i = 0; i < 16; ++i) { a[2 * i] = acc[i].x; a[2 * i + 1] = acc[i].y; }
        float s16[16], s8[8];
#pragma unroll
        for (int c = 0; c < 16; ++c) { auto rr2 = __builtin_amdgcn_permlane32_swap(__float_as_uint(a[c]), __float_as_uint(a[c + 16]), false, false); s16[c] = __uint_as_float(rr2[0]) + __uint_as_float(rr2[1]); }
#pragma unroll
        for (int c = 0; c < 8; ++c) { auto rr2 = __builtin_amdgcn_permlane16_swap(__float_as_uint(s16[c]), __float_as_uint(s16[c + 8]), false, false); s8[c] = __uint_as_float(rr2[0]) + __uint_as_float(rr2[1]); }
        f32x4 res;
#pragma unroll
        for (int c = 0; c < 4; ++c) { const float mine = jb0 ? s8[c + 4] : s8[c], send = jb0 ? s8[c] : s8[c + 4]; res[c] = mine + dpp_f<0x128>(send); }
        const f32x4 h1 = {bflo(hw.x), bfhi(hw.x), bflo(hw.y), bfhi(hw.y)};
        const f32x4 h2 = h1 + g2 * res;
        v2u o; o.x = pk2(h2.x, h2.y); o.y = pk2(h2.z, h2.w);
        *orow = o;
#pragma unroll
        for (int i = 0; i < 2; ++i) { cA0[i] = cA1[i]; cA1[i] = cA2[i]; eA1[i] = eA2[i]; eB0[i] = eB1[i]; cB0[i] = cB1[i]; }
    }
#undef PV_LDE
#undef PV_LDC
#undef PV_GATHER
#undef PV_ACC
}
#define XB_TMO      128
#define XB_XCNT(j)  (256  + 64 * (j))
#define XB_XSUB(j)  (1280 + 64 * (j))
#define XB_XGEN(j)  (2304 + 64 * (j))
#define XB_TOP      3328
#define XB_TOPGEN   3392
#define XCD_BAR_WORDS 3456
#define XB_SPIN_CAP (1u << 18)

__device__ __forceinline__ unsigned xb_ld(unsigned* p)              { return __hip_atomic_load(p, __ATOMIC_RELAXED, __HIP_MEMORY_SCOPE_AGENT); }
__device__ __forceinline__ unsigned xb_add(unsigned* p, unsigned v) { return __hip_atomic_fetch_add(p, v, __ATOMIC_RELAXED, __HIP_MEMORY_SCOPE_AGENT); }
__device__ __forceinline__ unsigned xb_xcc_id() { return (unsigned)__builtin_amdgcn_s_getreg((3 << 11) | 20) & 0xFu; }
#define XB_SPIN(cond, bar) do { unsigned _sp = 0; while (cond) { __builtin_amdgcn_s_sleep(1); \
    if ((++_sp & 255u) == 0u) { if (xb_ld(&(bar)[XB_TMO])) break; if (_sp > XB_SPIN_CAP) { atomicAdd(&(bar)[XB_TMO], 1u); break; } } } } while (0)

struct XcdBarrier {
    unsigned* bar; unsigned x;
    volatile LAS unsigned* st;
};

__device__ __forceinline__ XcdBarrier xcd_barrier_post(unsigned* bar, volatile LAS unsigned* st) {
    XcdBarrier b; b.bar = bar; b.x = xb_xcc_id(); b.st = st;
    if (threadIdx.x == 0) (void)xb_add(&bar[XB_XCNT(b.x)], 1u);
    return b;
}
__device__ __forceinline__ void xcd_barrier_complete(unsigned* bar, unsigned x, unsigned& nloc, unsigned& nx) {
    const unsigned G = gridDim.x * gridDim.y * gridDim.z;
    unsigned sum, cnt, mine, sp = 0u;
    for (;;) {
        sum = 0u; cnt = 0u; mine = 0u;
#pragma unroll
        for (unsigned j = 0; j < 16; ++j) { const unsigned c = xb_ld(&bar[XB_XCNT(j)]); sum += c; cnt += (c > 0u) ? 1u : 0u; mine = (j == x) ? c : mine; }
        if (sum == G) break;
        __builtin_amdgcn_s_sleep(1);
        if ((++sp & 255u) == 0u) { if (xb_ld(&bar[XB_TMO])) break; if (sp > XB_SPIN_CAP) { atomicAdd(&bar[XB_TMO], 1u); break; } }
    }
    nloc = mine > 0u ? mine : 1u; nx = cnt > 0u ? cnt : 1u;
}

__device__ __forceinline__ void xcd_barrier(const XcdBarrier& b) {
    asm volatile("s_waitcnt vmcnt(0)" ::: "memory");
    __syncthreads();
    if (threadIdx.x == 0) {
        unsigned* bar = b.bar;
        __builtin_amdgcn_s_waitcnt(0);
        unsigned nloc = b.st[0], nx = b.st[1];
        if (nloc == 0u) { xcd_barrier_complete(bar, b.x, nloc, nx); b.st[0] = nloc; b.st[1] = nx; }
        const unsigned old = xb_add(&bar[XB_XSUB(b.x)], 1u);
        const unsigned gen = old / nloc;
        if (old + 1u == (gen + 1u) * nloc) {
            __builtin_amdgcn_fence(__ATOMIC_RELEASE, "agent");
            asm volatile("s_waitcnt vmcnt(0)" ::: "memory");
            const unsigned og = xb_add(&bar[XB_TOP], 1u);
            const unsigned tg = og / nx;
            if (og + 1u == (tg + 1u) * nx) xb_add(&bar[XB_TOPGEN], 1u);
            else XB_SPIN(xb_ld(&bar[XB_TOPGEN]) == tg, bar);
            __builtin_amdgcn_fence(__ATOMIC_ACQUIRE, "agent");
            xb_add(&bar[XB_XGEN(b.x)], 1u);
            asm volatile("s_waitcnt vmcnt(0)" ::: "memory");
        } else {
            XB_SPIN(xb_ld(&bar[XB_XGEN(b.x)]) == gen, bar);
            __builtin_amdgcn_fence(__ATOMIC_ACQUIRE, "agent");
            asm volatile("s_waitcnt vmcnt(0)" ::: "memory");
        }
    }
    __syncthreads();
}

struct Args { const float* in[N_IN]; float* out; unsigned char* ws; int ph_lo, ph_hi; };
constexpr int N_PHASES = 19;

__global__ void __launch_bounds__(NTHR, 2) fwd_kernel(Args args) {
    extern __shared__ __attribute__((aligned(16))) unsigned char lds_raw[];
    cg::grid_group grid = cg::this_grid();
    Ctx F;
    F.lds = (LAS unsigned char*)lds_raw;
    F.tid = threadIdx.x; F.lane = F.tid & 63; F.wave = __builtin_amdgcn_readfirstlane(F.tid >> 6);
    F.G = gridDim.x; F.gw = blockIdx.x * NWAVES + F.wave; F.NGW = F.G * NWAVES;
    F.in = args.in; F.out = args.out; F.ws = args.ws;
    const int lo = args.ph_lo, hi = args.ph_hi;
    volatile LAS unsigned* bst = (volatile LAS unsigned*)(F.lds + LDS_BYTES - 64);
    if (F.tid < 2) bst[F.tid] = 0u;
    if (F.tid < 4) ((volatile LAS unsigned*)(F.lds + LDS_BYTES - 48))[F.tid] = 0u;
    __syncthreads();
    const XcdBarrier bar = xcd_barrier_post((unsigned*)(F.ws + WS_CTL) + 4096, bst);
#define IN(k) (lo <= (k) && (k) < hi)
#ifndef TS_A
#define TS_A -1
#define TS_B -1
#define TS_K 0.1
#endif
    unsigned long long* stamps = (unsigned long long*)(F.ws + WS_CTL + 65536);
#define STAMP(k) do { if (TS_A >= 0 && blockIdx.x == 0 && F.tid == 0) stamps[k] = __builtin_amdgcn_s_memrealtime(); } while (0)
#define REP_MASK 0
#ifndef REP_MASK
#define REP_MASK 0
#endif
#define REPS(k) for (int rep_ = 0; rep_ < 1 + ((REP_MASK >> (k)) & 1); ++rep_)
#define SEAM(k) do { if (IN(k) && IN((k) + 1)) { if ((k) == 0) grid.sync(); else xcd_barrier(bar); } } while (0)

    STAMP(0);
    if (IN(0)) REPS(0) { p0_prologue(F); }
    SEAM(0);
    STAMP(1);
    if (IN(1)) REPS(1) { norm_mod_rows(F, F.in[I_X], F.in[I_N1W], 0, DM, (bf16*)(F.ws + WS_XN)); }
    SEAM(1);
    STAMP(2);
    if (IN(2)) REPS(2) {
        pg8::Gemm g{(const pg8::bf16_t*)(F.ws + WS_XN), (const pg8::bf16_t*)(F.ws + WS_WIN), M, INPP, DM};
        pg8::StaticOrder S; S.init(M, INPP, F.G, (int)blockIdx.x);
        pg8::EpiStoreBf16 E{(pg8::bf16_t*)(F.ws + WS_PROJ), INPP};
        pg8::gemm_phase<pg8::EpiStoreBf16, pg8::StaticOrder, true, true>(F.lds, g, S, E);
    }
    SEAM(2);
#ifndef P3REP
#define P3REP 0
#endif
    STAMP(3);
    if (IN(3)) REPS(3) { p3_lora(F); STAMP(40); m1_chunk_states(F); }
    SEAM(3);
    STAMP(4);
    if (IN(4)) { m2_prefix(F); ra_part(F, 0); }
    SEAM(4);
    STAMP(5);
    if (IN(5)) { rs_half(F, 0); ra_part(F, 1); }
    SEAM(5);
    STAMP(6);
    if (IN(6)) { rs_half(F, 1); ra_part(F, 2); }
    SEAM(6);
    STAMP(7);
    if (IN(7)) { rs_half(F, 2); ra_part(F, 3); }
    SEAM(7);
    STAMP(8);
    if (IN(8)) { rs_half(F, 3); }
    STAMP(9);
    if (IN(9)) REPS(9) { m3_outputs(F); }
    SEAM(9);
    STAMP(10);
    if (IN(10)) { p5_post(F); }
    SEAM(10);
    STAMP(11);
    if (IN(11)) REPS(11) {
        pg8::Gemm g{(const pg8::bf16_t*)(F.ws + WS_OY), (const pg8::bf16_t*)(F.ws + WS_WOUT), M, DM, DM};
        pg8::StaticOrder S; S.init(M, DM, F.G, (int)blockIdx.x);
        pg8::EpiResid E{F.in[I_X], (const float*)(F.ws + WS_MOD) + 2 * DM, (pg8::bf16_t*)(F.ws + WS_HB), DM, SEQ, MODW};
        pg8::gemm_phase<pg8::EpiResid, pg8::StaticOrder, true, true>(F.lds, g, S, E);
    }
    SEAM(11);
    STAMP(12);
    if (IN(12)) REPS(12) { norm_mod_rows_bf16(F, (const bf16*)(F.ws + WS_HB), F.in[I_N2W], 3 * DM, 4 * DM, (bf16*)(F.ws + WS_XN)); }
    SEAM(12);
    STAMP(13);
    if (IN(13)) REPS(13) {
        pg8::Gemm g{(const pg8::bf16_t*)(F.ws + WS_XN), (const pg8::bf16_t*)(F.ws + WS_WQ), M, DM, DM};
        pg8::StaticOrder S; S.init(M, DM, F.G, (int)blockIdx.x);
        pg8::EpiStoreBf16 E{(pg8::bf16_t*)(F.ws + WS_Q), DM};
        pg8::gemm_phase<pg8::EpiStoreBf16, pg8::StaticOrder, true, true>(F.lds, g, S, E);
    }
    SEAM(13);
    STAMP(14);
    if (IN(14)) REPS(14) { p9_route(F); }
    SEAM(14);
    STAMP(15);
    if (IN(15)) REPS(15) { p10_peer_u(F); }
    SEAM(15);
    STAMP(16);
    if (IN(16)) REPS(16) { p11_peer_coef(F); }
    SEAM(16);
    STAMP(17);
    if (IN(17)) { p12_peer_v(F); }
    SEAM(17);
    STAMP(18);
    if (IN(18)) {
        float oscale = 1.f;
        if (TS_A >= 0) { const volatile unsigned long long* st = stamps; const float frac = (float)(st[TS_B] - st[TS_A]) / (float)(st[17] - st[0]); oscale = 1.f + (float)(TS_K) * frac; }
        final_norm_rows_bf16(F, (const bf16*)(F.ws + WS_HB), F.in[I_FNW], F.out, oscale);
    }
#undef IN
#undef SEAM
}

extern "C" void kernel_launch(void* const* d_in, const int* in_sizes, int n_in, void* d_out, int out_size, void* d_ws, size_t ws_size, hipStream_t stream) {
    static int grid = 0;
    if (grid == 0) {
        if (n_in != N_IN || in_sizes[0] != M * DM || out_size != M * DM || ws_size < WS_END2) {
            fprintf(stderr, "kernel_launch: unexpected shapes: n_in %d in0 %d out %d ws %zu (need %zu)\n", n_in, n_in > 0 ? in_sizes[0] : -1, out_size, ws_size, (size_t)WS_END2); grid = -1; return; }
        int dev = 0, cus = 0, per_cu = 0;
        if (hipGetDevice(&dev) != hipSuccess || hipDeviceGetAttribute(&cus, hipDeviceAttributeMultiprocessorCount, dev) != hipSuccess) { grid = -1; return; }
        if (hipFuncSetAttribute((const void*)fwd_kernel, hipFuncAttributeMaxDynamicSharedMemorySize, LDS_BYTES) != hipSuccess) { fprintf(stderr, "kernel_launch: hipFuncSetAttribute failed\n"); grid = -1; return; }
        if (hipOccupancyMaxActiveBlocksPerMultiprocessor(&per_cu, (const void*)fwd_kernel, NTHR, LDS_BYTES) != hipSuccess || per_cu < 1) { fprintf(stderr, "kernel_launch: occupancy query says %d blocks per CU\n", per_cu); per_cu = 1; }
        (void)hipGetLastError();
        grid = cus;
        fprintf(stderr, "kernel_launch: cus %d per_cu %d grid %d ws %zu\n", cus, per_cu, grid, ws_size);
    }
    if (grid < 0) return;
    (void)hipMemsetAsync((char*)d_ws + WS_CTL, 0, CTL_ZERO_BYTES, stream);
    Args a{};
    for (int i = 0; i < N_IN; ++i) a.in[i] = (const float*)d_in[i];
    a.out = (float*)d_out; a.ws = (unsigned char*)d_ws; a.ph_lo = 0; a.ph_hi = N_PHASES;
    void* kargs[] = {&a};
#ifndef NPASS
#define NPASS 1
#endif
    hipError_t e = hipSuccess;
    for (int pass_ = 0; pass_ < NPASS; ++pass_) {
        if (pass_ > 0) (void)hipMemsetAsync((char*)d_ws + WS_CTL, 0, CTL_ZERO_BYTES, stream);
        e = hipLaunchCooperativeKernel((const void*)fwd_kernel, dim3(grid), dim3(NTHR), kargs, LDS_BYTES, stream);
    }
    if (e != hipSuccess) fprintf(stderr, "kernel_launch: cooperative launch failed: %s (grid %d)\n", hipGetErrorString(e), grid);
}
```

```cpp
#include <hip/hip_runtime.h>
#include <hip/hip_cooperative_groups.h>
#include <cstdio>
#include <cstdint>
namespace cg = cooperative_groups;
namespace pg8 {
#define PG8_LAS __attribute__((address_space(3)))
typedef unsigned short bf16_t;
typedef short bf16x8 __attribute__((ext_vector_type(8)));
typedef float f32x4 __attribute__((ext_vector_type(4)));
typedef unsigned u32x4 __attribute__((ext_vector_type(4)));
constexpr int BM = 256, BK = 64, HALF = 128, HTB = HALF * BK * 2  , STAGE_BYTES = 8 * HTB, NXCD = 8, WGM = 8;

__host__ __device__ __forceinline__ int lds_byte(int r, int c) { const int st = (r >> 4) * 2 + (c >> 5), rr = r & 15, cc = c & 31, ob = rr * 64 + cc * 2; return st * 1024 + (ob ^ (((ob >> 9) & 1) << 5)); }
__host__ __device__ __forceinline__ void stage_rc(int b, int& R, int& C) { const int st = b / 1024, sb = b % 1024, swz = sb ^ (((sb >> 9) & 1) << 5); R = (st >> 1) * 16 + swz / 64; C = (st & 1) * 32 + (swz % 64) / 2; }
__host__ __device__ __forceinline__ int perm32(int rho) { const int n = rho >> 4, i = rho & 15; return 8 * (i >> 2) + 4 * n + (i & 3); }

struct Unit { int pm, pn; };
struct Gemm { const bf16_t* A; const bf16_t* Bt; int M, N, K; };

struct StaticOrder {
    int nM, nN, nwg, G, c;
    __host__ __device__ void init(int M, int N, int G_, int c_) { nM = M / BM; nN = N / BM; nwg = nM * nN; G = G_; c = c_; }
    __host__ __device__ bool next(int i, Unit& u) const {
        const long L = (long)i * G + c; if (L >= nwg) return false;
        int wgid = (int)L; { const int q = nwg / NXCD, r = nwg % NXCD, xcd = wgid % NXCD, off = wgid / NXCD; wgid = (xcd < r ? xcd * (q + 1) : r * (q + 1) + (xcd - r) * q) + off; }
        const int nig = WGM * nN, gid = wgid / nig, fm = gid * WGM, gsz = (nM - fm) < WGM ? (nM - fm) : WGM;
        u.pm = fm + ((wgid % nig) % gsz); u.pn = (wgid % nig) / gsz; return true;
    }
    __device__ __forceinline__ void a_ready(const Unit&) const {}
    __device__ __forceinline__ void done(const Unit&) const {}
};
__device__ __forceinline__ unsigned cvt_pk_bf16(float lo, float hi) { unsigned r; asm volatile("v_cvt_pk_bf16_f32 %0, %1, %2" : "=v"(r) : "v"(lo), "v"(hi)); return r; }
struct EpiStoreBf16 {
    static constexpr bool PERM = true, AFTER_DRAIN = false;
    bf16_t* O; int ldc;
    __device__ __forceinline__ void operator()(const f32x4 (&acc)[2][2][4][2], const Unit& u, int wr, int wc, int fr, int fq) const {
        const int row0 = u.pm * BM + wr * 64 + fr; const int col0 = u.pn * BM + wc * 32 + 8 * fq;
#pragma unroll
        for (int ai = 0; ai < 2; ++ai)
#pragma unroll
            for (int m = 0; m < 4; ++m) { bf16_t* rowp = O + (size_t)(row0 + ai * HALF + m * 16) * ldc + col0;
#pragma unroll
                for (int bj = 0; bj < 2; ++bj) { const f32x4 v0 = acc[ai][bj][m][0], v1 = acc[ai][bj][m][1];
                    u32x4 w; w.x = cvt_pk_bf16(v0[0], v0[1]); w.y = cvt_pk_bf16(v0[2], v0[3]); w.z = cvt_pk_bf16(v1[0], v1[1]); w.w = cvt_pk_bf16(v1[2], v1[3]);
                    *(u32x4*)(rowp + bj * HALF) = w; } }
    }
};
struct EpiResid {
    static constexpr bool PERM = true, AFTER_DRAIN = false;
    const float* X; const float* gate; bf16_t* O; int ldc; int rows_per_batch; int gstride;
    __device__ __forceinline__ void operator()(const f32x4 (&acc)[2][2][4][2], const Unit& u, int wr, int wc, int fr, int fq) const {
        const int row0 = u.pm * BM + wr * 64 + fr; const int col0 = u.pn * BM + wc * 32 + 8 * fq;
        const float* g = gate + (size_t)((u.pm * BM) / rows_per_batch) * gstride + col0;
        f32x4 gv[2][2];
#pragma unroll
        for (int bj = 0; bj < 2; ++bj)
#pragma unroll
            for (int n = 0; n < 2; ++n) gv[bj][n] = *(const f32x4*)(g + bj * HALF + 4 * n);
#pragma unroll
        for (int ai = 0; ai < 2; ++ai)
#pragma unroll
            for (int m = 0; m < 4; ++m) { const size_t off = (size_t)(row0 + ai * HALF + m * 16) * ldc + col0;
#pragma unroll
                for (int bj = 0; bj < 2; ++bj) { const f32x4 x0 = *(const f32x4*)(X + off + bj * HALF), x1 = *(const f32x4*)(X + off + bj * HALF + 4);
                    const f32x4 v0 = x0 + gv[bj][0] * acc[ai][bj][m][0], v1 = x1 + gv[bj][1] * acc[ai][bj][m][1];
                    u32x4 w; w.x = cvt_pk_bf16(v0[0], v0[1]); w.y = cvt_pk_bf16(v0[2], v0[3]); w.z = cvt_pk_bf16(v1[0], v1[1]); w.w = cvt_pk_bf16(v1[2], v1[3]);
                    *(u32x4*)(O + off + bj * HALF) = w; } }
    }
};
template <class Epi, class Sched, bool ALIGN_EPI = false, bool SP2 = false>
__device__ __forceinline__ void gemm_phase(PG8_LAS unsigned char* lds, const Gemm g, const Sched& S, const Epi& E) {
    const int tid = threadIdx.x, wid = __builtin_amdgcn_readfirstlane(tid >> 6), lane = tid & 63, wr = wid >> 2, wc = wid & 3, fr = lane & 15, fq = lane >> 4;
    const int K = g.K, nt = K / BK;
    unsigned voffA[2], voffB[2];
#pragma unroll
    for (int i = 0; i < 2; ++i) { int R, C; stage_rc(tid * 16 + i * 8192, R, C); const int Rb = Epi::PERM ? ((R & ~31) + perm32(R & 31)) : R;
        voffA[i] = (unsigned)(R * K + C) * 2u; voffB[i] = (unsigned)(Rb * K + C) * 2u; }
    const size_t kstep = (size_t)(BK * 2);
    const size_t hstep = (size_t)HALF * K * 2;
    const size_t tstep = 2 * hstep;
    const unsigned ldsw = (unsigned)wid * 1024u;
    const int aoff = lds_byte(wr * 64 + fr, fq * 8), boff = lds_byte(wc * 32 + fr, fq * 8);
#define PG8_SA(b, h) (((b) * 2 + (h)) * HTB)
#define PG8_SB(b, h) ((4 + (b) * 2 + (h)) * HTB)
#define PG8_STAGE(bufoff, gbase, voff) do { _Pragma("unroll") for (int _i = 0; _i < 2; ++_i) \
        __builtin_amdgcn_global_load_lds((const unsigned*)((const char*)(gbase) + (voff)[_i]), (PG8_LAS unsigned*)(lds + (bufoff) + ldsw + _i * 8192), 16, 0, 0); } while (0)
#define PG8_LDA(dst, b, h) do { _Pragma("unroll") for (int m = 0; m < 4; ++m) _Pragma("unroll") for (int k = 0; k < 2; ++k) dst[m][k] = *(const PG8_LAS bf16x8*)(lds + PG8_SA(b, h) + aoff + m * 2048 + k * 1024); } while (0)
#define PG8_LDB(dst, b, h) do { _Pragma("unroll") for (int n = 0; n < 2; ++n) _Pragma("unroll") for (int k = 0; k < 2; ++k) dst[n][k] = *(const PG8_LAS bf16x8*)(lds + PG8_SB(b, h) + boff + n * 2048 + k * 1024); } while (0)
#define PG8_MMA(ai, bj, At, Bt) do { __builtin_amdgcn_s_setprio(1); _Pragma("unroll") for (int m = 0; m < 4; ++m) _Pragma("unroll") for (int n = 0; n < 2; ++n) _Pragma("unroll") for (int k = 0; k < 2; ++k) \
        acc[ai][bj][m][n] = __builtin_amdgcn_mfma_f32_16x16x32_bf16(Bt[n][k], At[m][k], acc[ai][bj][m][n], 0, 0, 0); __builtin_amdgcn_s_setprio(0); } while (0)
#define PG8_WAIT_V(n) asm volatile("s_waitcnt vmcnt(" #n ")" ::: "memory")
#define PG8_WAIT_L(n) asm volatile("s_waitcnt lgkmcnt(" #n ")" ::: "memory")
#define PG8_BAR __builtin_amdgcn_s_barrier()
#define PG8_SCHED __builtin_amdgcn_sched_barrier(0)
    Unit cur, nxt; int ui = 0;
    if (!S.next(0, cur)) return;
    f32x4 acc[2][2][4][2];
#pragma unroll
    for (int a = 0; a < 2; ++a)
#pragma unroll
        for (int b = 0; b < 2; ++b)
#pragma unroll
            for (int m = 0; m < 4; ++m)
#pragma unroll
                for (int n = 0; n < 2; ++n) acc[a][b][m][n] = (f32x4){0.f, 0.f, 0.f, 0.f};
    bf16x8 At[4][2], B0[2][2], B1[2][2];
    const char* cA = (const char*)g.A + (size_t)cur.pm * tstep; const char* cB = (const char*)g.Bt + (size_t)cur.pn * tstep;
    S.a_ready(cur);
    if constexpr (SP2) {
        PG8_STAGE(PG8_SB(0, 0), cB, voffB); PG8_STAGE(PG8_SB(0, 1), cB + hstep, voffB); PG8_STAGE(PG8_SA(0, 0), cA, voffA); PG8_STAGE(PG8_SA(0, 1), cA + hstep, voffA);
        if (wr == 1) PG8_BAR;
        PG8_WAIT_V(2); PG8_BAR;
        PG8_STAGE(PG8_SB(1, 0), cB + kstep, voffB); PG8_STAGE(PG8_SA(1, 0), cA + kstep, voffA); PG8_STAGE(PG8_SB(1, 1), cB + hstep + kstep, voffB);
        PG8_WAIT_V(6); PG8_BAR;
    } else {
        PG8_STAGE(PG8_SB(0, 0), cB, voffB); PG8_STAGE(PG8_SA(0, 0), cA, voffA); PG8_STAGE(PG8_SB(0, 1), cB + hstep, voffB); PG8_STAGE(PG8_SA(0, 1), cA + hstep, voffA);
        if (wr == 1) PG8_BAR;
        PG8_WAIT_V(4); PG8_BAR;
        PG8_STAGE(PG8_SB(1, 0), cB + kstep, voffB); PG8_STAGE(PG8_SA(1, 0), cA + kstep, voffA); PG8_STAGE(PG8_SB(1, 1), cB + hstep + kstep, voffB);
        PG8_WAIT_V(6); PG8_BAR;
    }
    for (;;) {
        const bool has_next = S.next(ui + 1, nxt);
        const char* nA = has_next ? (const char*)g.A + (size_t)nxt.pm * tstep : cA; const char* nB = has_next ? (const char*)g.Bt + (size_t)nxt.pn * tstep : cB;
        for (int t = 0; t < nt; t += 2) {
            const bool last = (t == nt - 2);
            const char* a1 = cA + (size_t)(t + 1) * kstep;
            const char* a2 = last ? nA : cA + (size_t)(t + 2) * kstep; const char* b2 = last ? nB : cB + (size_t)(t + 2) * kstep;
            const char* a3 = a2 + kstep; const char* b3 = b2 + kstep;
            if (last && has_next) S.a_ready(nxt);
            if constexpr (SP2) {
            PG8_LDB(B0, 0, 0); PG8_LDB(B1, 0, 1); PG8_SCHED; PG8_LDA(At, 0, 0); PG8_STAGE(PG8_SA(1, 1), a1 + hstep, voffA);
            PG8_WAIT_V(8); PG8_WAIT_L(0); PG8_BAR; PG8_MMA(0, 0, At, B0); PG8_MMA(0, 1, At, B1); PG8_BAR; PG8_SCHED;
            PG8_LDA(At, 0, 1); PG8_STAGE(PG8_SB(0, 0), b2, voffB); PG8_STAGE(PG8_SB(0, 1), b2 + hstep, voffB); PG8_STAGE(PG8_SA(0, 0), a2, voffA);
            PG8_WAIT_V(8); PG8_WAIT_L(0); PG8_BAR; PG8_MMA(1, 0, At, B0); PG8_MMA(1, 1, At, B1); PG8_BAR; PG8_SCHED;
            PG8_LDB(B0, 1, 0); PG8_LDB(B1, 1, 1); PG8_SCHED; PG8_LDA(At, 1, 0); PG8_STAGE(PG8_SA(0, 1), a2 + hstep, voffA);
            PG8_WAIT_V(8); PG8_WAIT_L(0); PG8_BAR; PG8_MMA(0, 0, At, B0); PG8_MMA(0, 1, At, B1); PG8_BAR; PG8_SCHED;
            PG8_LDA(At, 1, 1); PG8_STAGE(PG8_SB(1, 0), b3, voffB); PG8_STAGE(PG8_SB(1, 1), b3 + hstep, voffB); PG8_STAGE(PG8_SA(1, 0), a3, voffA);
            PG8_WAIT_V(8); PG8_WAIT_L(0); PG8_BAR; PG8_MMA(1, 0, At, B0); PG8_MMA(1, 1, At, B1); PG8_BAR; PG8_SCHED;
            } else {
            PG8_LDB(B0, 0, 0); PG8_SCHED; PG8_LDA(At, 0, 0); PG8_STAGE(PG8_SA(1, 1), a1 + hstep, voffA);
            PG8_WAIT_L(8); PG8_BAR; PG8_WAIT_L(0); PG8_MMA(0, 0, At, B0); PG8_BAR; PG8_SCHED;
            PG8_LDB(B1, 0, 1); PG8_STAGE(PG8_SB(0, 0), b2, voffB);
            PG8_BAR; PG8_WAIT_L(0); PG8_MMA(0, 1, At, B1); PG8_BAR;
            PG8_LDA(At, 0, 1); PG8_STAGE(PG8_SA(0, 0), a2, voffA);
            PG8_BAR; PG8_WAIT_L(0); PG8_MMA(1, 0, At, B0); PG8_BAR; PG8_SCHED;
            PG8_STAGE(PG8_SB(0, 1), b2 + hstep, voffB);
            PG8_WAIT_V(6); PG8_BAR; PG8_MMA(1, 1, At, B1); PG8_BAR;
            PG8_LDB(B0, 1, 0); PG8_SCHED; PG8_LDA(At, 1, 0); PG8_STAGE(PG8_SA(0, 1), a2 + hstep, voffA);
            PG8_WAIT_L(8); PG8_BAR; PG8_WAIT_L(0); PG8_MMA(0, 0, At, B0); PG8_BAR; PG8_SCHED;
            PG8_LDB(B1, 1, 1); PG8_STAGE(PG8_SB(1, 0), b3, voffB);
            PG8_BAR; PG8_WAIT_L(0); PG8_MMA(0, 1, At, B1); PG8_BAR;
            PG8_LDA(At, 1, 1); PG8_STAGE(PG8_SA(1, 0), a3, voffA);
            PG8_BAR; PG8_WAIT_L(0); PG8_MMA(1, 0, At, B0); PG8_BAR; PG8_SCHED;
            PG8_STAGE(PG8_SB(1, 1), b3 + hstep, voffB);
            PG8_WAIT_V(6); PG8_BAR; PG8_MMA(1, 1, At, B1); PG8_BAR;
            }
        }
        if constexpr (ALIGN_EPI) { if (wr == 0) PG8_BAR; }
        if constexpr (!Epi::AFTER_DRAIN) { E(acc, cur, wr, wc, fr, fq); S.done(cur); }
        if (!has_next) break;
#pragma unroll
        for (int a = 0; a < 2; ++a)
#pragma unroll
            for (int b = 0; b < 2; ++b)
#pragma unroll
                for (int m = 0; m < 4; ++m)
#pragma unroll
                    for (int n = 0; n < 2; ++n) acc[a][b][m][n] = (f32x4){0.f, 0.f, 0.f, 0.f};
        cur = nxt; cA = nA; cB = nB; ++ui;
        if constexpr (ALIGN_EPI) { if (wr == 1) PG8_BAR; }
    }
    PG8_WAIT_V(0);
    if constexpr (!ALIGN_EPI) { if (wr == 0) PG8_BAR; }
    PG8_BAR;
    if constexpr (Epi::AFTER_DRAIN) { E.fused(acc, cur, wr, wc, fr, fq, lds, wid, lane); S.done(cur); }
#undef PG8_SA
#undef PG8_SB
#undef PG8_STAGE
#undef PG8_LDA
#undef PG8_LDB
#undef PG8_MMA
#undef PG8_WAIT_V
#undef PG8_WAIT_L
#undef PG8_BAR
#undef PG8_SCHED
}
}
#define GAS __attribute__((address_space(1)))
#define LAS __attribute__((address_space(3)))
typedef unsigned short bf16;
typedef unsigned v4u __attribute__((ext_vector_type(4)));
typedef unsigned v2u __attribute__((ext_vector_type(2)));
typedef float f32x4 __attribute__((ext_vector_type(4)));
typedef float f32x2 __attribute__((ext_vector_type(2)));
typedef short bf16x8 __attribute__((ext_vector_type(8)));
typedef __bf16 bf16x2_t __attribute__((ext_vector_type(2)));

constexpr int NWAVES = 8, NTHR = 512;
constexpr int DM = 2048, NB = 4, SEQ = 8192, M = NB * SEQ;
constexpr int RW = 1024, RHEADS = 16, HD = 64;
constexpr int L_W = 64, L_A = 64, L_G = 160;
constexpr int INP = 5936, INPP = 6144;
constexpr int C_R = 0, C_K = 1024, C_V = 2048, C_WD = 3072, C_AD = 3136, C_GD = 3200, C_Z = 3360, C_XBC = 4384, C_DT = 5920;
constexpr int MODW = 6 * DM;
constexpr int NEXP = 16384;
constexpr float RMS_EPS = 1e-6f;

enum { I_X = 0, I_C, I_ADAW, I_ADAB, I_N1W, I_WIN, I_MU, I_W0, I_WUP, I_A0, I_AUP, I_GUP, I_KK, I_KA, I_RK, I_LNW, I_LNB,
       I_CONVW, I_CONVB, I_DTB, I_ALOG, I_DSK, I_MNW, I_WOUT, I_N2W, I_WQ, I_KEYS, I_PU, I_PV, I_FNW, N_IN };

constexpr size_t MiB = 1u << 20;
constexpr size_t WS_CTL = 0, CTL_ZERO_BYTES = 1 * MiB;
constexpr size_t WS_MOD = 1 * MiB;
constexpr size_t WS_WIN = 2 * MiB, WS_WOUT = 26 * MiB, WS_WQ = 34 * MiB, WS_KEYS = 42 * MiB;
constexpr size_t WS_WUPT = 43 * MiB, WS_AUPT = 43 * MiB + 256 * 1024, WS_GUPT = 43 * MiB + 512 * 1024;
constexpr size_t WS_PU8 = 44 * MiB, WS_PV8 = 76 * MiB;
constexpr size_t WS_USC = 108 * MiB, WS_VSC = 108 * MiB + 65536;
constexpr size_t WS_XN = 172 * MiB;
constexpr size_t WS_LW = WS_XN, WS_AA = WS_XN + 64 * MiB;
constexpr size_t WS_PROJ = 300 * MiB;
constexpr size_t WS_Q = WS_PROJ;
constexpr size_t WS_GG = 684 * MiB;
constexpr size_t WS_PD = WS_PROJ + 128 * MiB;
constexpr size_t WS_RTE = 684 * MiB, WS_RTG = 700 * MiB, WS_COEF = 716 * MiB;
constexpr size_t WS_OY = 748 * MiB;
constexpr size_t WS_END = 876 * MiB;
constexpr size_t WS_HB = 876 * MiB;

constexpr int RING_BYTES = 131072, LDS_BYTES = 147456;

#define LDS_WAIT() asm volatile("s_waitcnt lgkmcnt(0)" ::: "memory")
#define VM_WAIT() asm volatile("s_waitcnt vmcnt(0)" ::: "memory")
__device__ __forceinline__ unsigned pk2(float lo, float hi) { f32x2 v = {lo, hi}; bf16x2_t b = __builtin_convertvector(v, bf16x2_t); return __builtin_bit_cast(unsigned, b); }
__device__ __forceinline__ float bflo(unsigned u) { return __uint_as_float(u << 16); }
__device__ __forceinline__ float bfhi(unsigned u) { return __uint_as_float(u & 0xffff0000u); }
__device__ __forceinline__ float bf1(bf16 h) { return __uint_as_float((unsigned)h << 16); }
__device__ __forceinline__ float wave_sum(float v) {
#pragma unroll
    for (int o = 1; o < 64; o <<= 1) v += __shfl_xor(v, o);
    return v;
}
__device__ __forceinline__ float rcp_f(float v) { return __builtin_amdgcn_rcpf(v); }
template <int CTRL> __device__ __forceinline__ float dppc_f(float x) { return __builtin_bit_cast(float, __builtin_amdgcn_mov_dpp(__builtin_bit_cast(int, x), CTRL, 0xf, 0xf, true)); }
__device__ __forceinline__ float wave_sum_fast(float x) {
    x += dppc_f<0xB1>(x); x += dppc_f<0x4E>(x); x += dppc_f<0x124>(x); x += dppc_f<0x128>(x);
    { auto rr = __builtin_amdgcn_permlane16_swap(__float_as_uint(x), __float_as_uint(x), false, false); x = __uint_as_float(rr[0]) + __uint_as_float(rr[1]); }
    { auto rr = __builtin_amdgcn_permlane32_swap(__float_as_uint(x), __float_as_uint(x), false, false); x = __uint_as_float(rr[0]) + __uint_as_float(rr[1]); }
    return x;
}
__device__ __forceinline__ float silu_f(float v) { return v * rcp_f(1.f + __expf(-v)); }
__device__ __forceinline__ float sigmoid_f(float v) { return rcp_f(1.f + __expf(-v)); }

struct Ctx {
    LAS unsigned char* lds;
    int tid, lane, wave, G, gw, NGW;
    const float* const* in;
    float* out; unsigned char* ws;
};

__device__ __forceinline__ void transpose_item(const float* W, int K, int N, bf16* WT, int ldt, int nrows_out, LAS float* scr, int kb, int nb, int lane) {
    const int k0 = 64 * kb, n0 = 64 * nb;
    const int c4 = 4 * (lane & 15), rr = lane >> 4;
    const bool vec_ok = ((N & 3) == 0) && (n0 + 64 <= N);
#pragma unroll 4
    for (int i = 0; i < 16; ++i) { const int kk = 4 * i + rr, k = k0 + kk;
        f32x4 v = {0.f, 0.f, 0.f, 0.f};
        if (k < K) { const float* src = W + (size_t)k * N + n0 + c4;
            if (vec_ok) v = *(const f32x4*)src;
            else { if (n0 + c4 + 0 < N) v.x = src[0]; if (n0 + c4 + 1 < N) v.y = src[1]; if (n0 + c4 + 2 < N) v.z = src[2]; if (n0 + c4 + 3 < N) v.w = src[3]; } }
        LAS float* d = scr + kk * 65 + c4; d[0] = v.x; d[1] = v.y; d[2] = v.z; d[3] = v.w; }
    LDS_WAIT(); asm volatile("" ::: "memory");
    const int c = lane & 7;
#pragma unroll
    for (int j = 0; j < 8; ++j) { const int n = (lane >> 3) + 8 * j; const LAS float* sp = scr + (8 * c) * 65 + n;
        v4u o; o.x = pk2(sp[0 * 65], sp[1 * 65]); o.y = pk2(sp[2 * 65], sp[3 * 65]); o.z = pk2(sp[4 * 65], sp[5 * 65]); o.w = pk2(sp[6 * 65], sp[7 * 65]);
        if (n0 + n < nrows_out && k0 + 8 * c + 8 <= ldt) *(v4u*)(WT + (size_t)(n0 + n) * ldt + k0 + 8 * c) = o; }
    LDS_WAIT(); asm volatile("" ::: "memory");
}
__device__ __forceinline__ void transpose_all(const float* W, int K, int N, bf16* WT, int ldt, int nrows_out, LAS float* scr, int gw, int NGW, int lane) {
    const int nkb = (K + 63) / 64, nnb = nrows_out / 64, nit = nkb * nnb;
    for (int it = gw; it < nit; it += NGW) transpose_item(W, K, N, WT, ldt, nrows_out, scr, it / nnb, it % nnb, lane);
}
__device__ __forceinline__ void convert_all(const float* src, bf16* dst, size_t n8, int gw, int NGW, int lane) {
    const f32x4* s4 = (const f32x4*)src; v4u* d4 = (v4u*)dst;
    for (size_t i = (size_t)gw * 64 + lane; i < n8; i += (size_t)NGW * 64) {
        const f32x4 a = __builtin_nontemporal_load(s4 + 2 * i), b = __builtin_nontemporal_load(s4 + 2 * i + 1);
        v4u o; o.x = pk2(a.x, a.y); o.y = pk2(a.z, a.w); o.z = pk2(b.x, b.y); o.w = pk2(b.z, b.w);
        d4[i] = o; }
}
__device__ __forceinline__ void quantize_rows_fp8(const float* src, unsigned char* dst8, float* scales, int e0, int e1, int step, int lane) {
    if (e0 >= e1) return;
    f32x4 vn[8];
    { const f32x4* s4 = (const f32x4*)(src + (size_t)e0 * DM) + lane;
#pragma unroll
      for (int i = 0; i < 8; ++i) vn[i] = __builtin_nontemporal_load(s4 + 64 * i); }
    for (int e = e0; e < e1; e += step) {
        f32x4 v[8];
#pragma unroll
        for (int i = 0; i < 8; ++i) v[i] = vn[i];
        { const int en = (e + step < e1) ? e + step : e; const f32x4* s4 = (const f32x4*)(src + (size_t)en * DM) + lane;
#pragma unroll
          for (int i = 0; i < 8; ++i) vn[i] = __builtin_nontemporal_load(s4 + 64 * i); }
        float am = 0.f;
#pragma unroll
        for (int i = 0; i < 8; ++i) am = fmaxf(fmaxf(am, fmaxf(fabsf(v[i].x), fabsf(v[i].y))), fmaxf(fabsf(v[i].z), fabsf(v[i].w)));
#pragma unroll
        for (int o = 1; o < 64; o <<= 1) am = fmaxf(am, __shfl_xor(am, o));
        am = fmaxf(am, 1e-30f);
        const float inv = 440.f / am;
#pragma unroll
        for (int i = 0; i < 8; ++i) { int w = __builtin_amdgcn_cvt_pk_fp8_f32(v[i].x * inv, v[i].y * inv, 0, false); w = __builtin_amdgcn_cvt_pk_fp8_f32(v[i].z * inv, v[i].w * inv, w, true);
            const int seg = 2 * i + (lane >> 5);
            *(int*)(dst8 + (size_t)seg * ((size_t)NEXP * 128) + (size_t)e * 128 + 4 * (lane & 31)) = w; }
        if (lane == 0) scales[e] = am * (1.f / 440.f);
    }
}
__device__ __forceinline__ void quantize_rows_fp4(const float* src, unsigned char* dst4, float* scales, int e0, int e1, int step, int lane) {
    if (e0 >= e1) return;
    f32x4 vn[8];
    { const f32x4* s4 = (const f32x4*)(src + (size_t)e0 * DM) + lane;
#pragma unroll
      for (int i = 0; i < 8; ++i) vn[i] = __builtin_nontemporal_load(s4 + 64 * i); }
    for (int e = e0; e < e1; e += step) {
        f32x4 v[8];
#pragma unroll
        for (int i = 0; i < 8; ++i) v[i] = vn[i];
        { const int en = (e + step < e1) ? e + step : e; const f32x4* s4 = (const f32x4*)(src + (size_t)en * DM) + lane;
#pragma unroll
          for (int i = 0; i < 8; ++i) vn[i] = __builtin_nontemporal_load(s4 + 64 * i); }
        float am = 0.f;
#pragma unroll
        for (int i = 0; i < 8; ++i) am = fmaxf(am, fmaxf(fmaxf(fabsf(v[i].x), fabsf(v[i].y)), fmaxf(fabsf(v[i].z), fabsf(v[i].w))));
#pragma unroll
        for (int o = 1; o < 64; o <<= 1) am = fmaxf(am, __shfl_xor(am, o));
        am = fmaxf(am, 1e-30f);
        const float inv = 6.f / am;
#pragma unroll
        for (int i = 0; i < 8; ++i) {
            unsigned w = __builtin_amdgcn_cvt_scalef32_pk_fp4_f32(0u, v[i].x * inv, v[i].y * inv, 1.0f, 0);
            w = __builtin_amdgcn_cvt_scalef32_pk_fp4_f32(w, v[i].z * inv, v[i].w * inv, 1.0f, 1);
            *(unsigned short*)(dst4 + (size_t)i * ((size_t)NEXP * 128) + (size_t)e * 128 + 2 * lane) = (unsigned short)w;
        }
        if (lane == 0) scales[e] = am * (1.f / 6.f);
    }
}
__device__ __forceinline__ void p0_prologue(const Ctx& F) {
    __syncthreads();
    if (blockIdx.x < MODW / 64) {
        LAS float* sc = (LAS float*)F.lds;
        LAS float* red = sc + NB * DM;
        const float* c = F.in[I_C];
        for (int i = F.tid; i < NB * DM; i += NTHR) sc[i] = silu_f(c[i]);
        __syncthreads();
        const int j = blockIdx.x * 64 + F.lane;
        const float* wp = F.in[I_ADAW] + (size_t)(F.wave * 256) * MODW + j;
        float a0 = 0.f, a1 = 0.f, a2 = 0.f, a3 = 0.f;
#pragma unroll 32
        for (int kk = 0; kk < 256; ++kk) { const float w = wp[(size_t)kk * MODW]; const int k = F.wave * 256 + kk;
            a0 += sc[k] * w; a1 += sc[DM + k] * w; a2 += sc[2 * DM + k] * w; a3 += sc[3 * DM + k] * w; }
        red[(F.wave * 4 + 0) * 64 + F.lane] = a0; red[(F.wave * 4 + 1) * 64 + F.lane] = a1; red[(F.wave * 4 + 2) * 64 + F.lane] = a2; red[(F.wave * 4 + 3) * 64 + F.lane] = a3;
        __syncthreads();
        if (F.tid < 256) { const int b = F.tid >> 6, l = F.tid & 63; float s = F.in[I_ADAB][blockIdx.x * 64 + l];
#pragma unroll
            for (int w = 0; w < 8; ++w) s += red[(w * 4 + b) * 64 + l];
            ((float*)(F.ws + WS_MOD))[b * MODW + blockIdx.x * 64 + l] = s; }
        __syncthreads();
    }
    LAS float* scr = (LAS float*)(F.lds + F.wave * 16640);
    transpose_all(F.in[I_WIN], DM, INP, (bf16*)(F.ws + WS_WIN), DM, INPP, scr, F.gw, F.NGW, F.lane);
    transpose_all(F.in[I_WOUT], DM, DM, (bf16*)(F.ws + WS_WOUT), DM, DM, scr, F.gw, F.NGW, F.lane);
    transpose_all(F.in[I_WQ], DM, DM, (bf16*)(F.ws + WS_WQ), DM, DM, scr, F.gw, F.NGW, F.lane);
    transpose_all(F.in[I_WUP], L_W, RW, (bf16*)(F.ws + WS_WUPT), L_W, RW, scr, F.gw, F.NGW, F.lane);
    transpose_all(F.in[I_AUP], L_A, RW, (bf16*)(F.ws + WS_AUPT), L_A, RW, scr, F.gw, F.NGW, F.lane);
    transpose_all(F.in[I_GUP], L_G, RW, (bf16*)(F.ws + WS_GUPT), L_G, RW, scr, F.gw, F.NGW, F.lane);
    convert_all(F.in[I_KEYS], (bf16*)(F.ws + WS_KEYS), (size_t)16 * 128 * 128 / 8, F.gw, F.NGW, F.lane);
    {
        const int nlo = (F.G < 192) ? F.G : 192, nhi = F.G - nlo;
        const int wtot = 5 * nlo + 8 * nhi;
        const int wb0 = (blockIdx.x < nlo) ? 5 * blockIdx.x : 5 * nlo + 8 * (blockIdx.x - nlo), wb1 = wb0 + ((blockIdx.x < nlo) ? 5 : 8);
        const int r0 = (int)((long)(2 * NEXP) * wb0 / wtot), r1 = (int)((long)(2 * NEXP) * wb1 / wtot);
        const int a0 = r0 < NEXP ? r0 : NEXP, a1 = r1 < NEXP ? r1 : NEXP;
        quantize_rows_fp8(F.in[I_PU], F.ws + WS_PU8, (float*)(F.ws + WS_USC), a0 + F.wave, a1, NWAVES, F.lane);
        const int b0 = (r0 > NEXP ? r0 : NEXP) - NEXP, b1 = (r1 > NEXP ? r1 : NEXP) - NEXP;
        quantize_rows_fp4(F.in[I_PV], F.ws + WS_PV8, (float*)(F.ws + WS_VSC), b0 + F.wave, b1, NWAVES, F.lane);
    }
}

__device__ __forceinline__ void norm_mod_rows(const Ctx& F, const float* X, const float* nw, int shift_off, int scale_off, bf16* XN) {
    const float* mod = (const float*)(F.ws + WS_MOD);
    if (F.gw >= M) return;
    f32x4 vn[8];
    { const f32x4* xr = (const f32x4*)(X + (size_t)F.gw * DM) + F.lane;
#pragma unroll
      for (int j = 0; j < 8; ++j) vn[j] = xr[64 * j]; }
    for (int m = F.gw; m < M; m += F.NGW) {
        const int b = m / SEQ;
        f32x4 v[8]; float s = 0.f;
#pragma unroll
        for (int j = 0; j < 8; ++j) { v[j] = vn[j]; s += (v[j].x * v[j].x + v[j].y * v[j].y) + (v[j].z * v[j].z + v[j].w * v[j].w); }
        { const int mn = (m + F.NGW < M) ? m + F.NGW : m; const f32x4* xr = (const f32x4*)(X + (size_t)mn * DM) + F.lane;
#pragma unroll
          for (int j = 0; j < 8; ++j) vn[j] = xr[64 * j]; }
        const float rstd = rsqrtf(wave_sum_fast(s) * (1.f / DM) + RMS_EPS);
        const f32x4* wp = (const f32x4*)nw + F.lane;
        const f32x4* shp = (const f32x4*)(mod + (size_t)b * MODW + shift_off) + F.lane;
        const f32x4* scp = (const f32x4*)(mod + (size_t)b * MODW + scale_off) + F.lane;
        v2u* o = (v2u*)(XN + (size_t)m * DM) + F.lane;
#pragma unroll
        for (int j = 0; j < 8; ++j) { const f32x4 w = wp[64 * j], a = scp[64 * j], c = shp[64 * j];
            const f32x4 r = (v[j] * rstd) * w * (a + 1.f) + c;
            v2u p; p.x = pk2(r.x, r.y); p.y = pk2(r.z, r.w); o[64 * j] = p; }
    }
}
__device__ __forceinline__ void final_norm_rows(const Ctx& F, const float* H, const float* nw, float* O) {
    for (int m = F.gw; m < M; m += F.NGW) {
        const f32x4* xr = (const f32x4*)(H + (size_t)m * DM) + F.lane;
        f32x4 v[8]; float s = 0.f;
#pragma unroll
        for (int j = 0; j < 8; ++j) { v[j] = xr[64 * j]; s += (v[j].x * v[j].x + v[j].y * v[j].y) + (v[j].z * v[j].z + v[j].w * v[j].w); }
        const float rstd = rsqrtf(wave_sum(s) * (1.f / DM) + RMS_EPS);
        const f32x4* wp = (const f32x4*)nw + F.lane;
        f32x4* o = (f32x4*)(O + (size_t)m * DM) + F.lane;
#pragma unroll
        for (int j = 0; j < 8; ++j) o[64 * j] = (v[j] * rstd) * wp[64 * j];
    }
}


__device__ __forceinline__ void load_row_raw(const bf16* row, int lane, v2u (&u)[8]) {
    const v2u* p = (const v2u*)row + lane;
#pragma unroll
    for (int j = 0; j < 8; ++j) u[j] = p[64 * j];
}
__device__ __forceinline__ void norm_mod_rows_bf16(const Ctx& F, const bf16* X, const float* nw, int shift_off, int scale_off, bf16* XN) {
    const float* mod = (const float*)(F.ws + WS_MOD);
    if (F.gw >= M) return;
    v2u un[8]; load_row_raw(X + (size_t)F.gw * DM, F.lane, un);
    for (int m = F.gw; m < M; m += F.NGW) {
        const int b = m / SEQ;
        f32x4 v[8]; float s = 0.f;
#pragma unroll
        for (int j = 0; j < 8; ++j) { v[j] = (f32x4){bflo(un[j].x), bfhi(un[j].x), bflo(un[j].y), bfhi(un[j].y)}; s += (v[j].x * v[j].x + v[j].y * v[j].y) + (v[j].z * v[j].z + v[j].w * v[j].w); }
        { const int mn = (m + F.NGW < M) ? m + F.NGW : m; load_row_raw(X + (size_t)mn * DM, F.lane, un); }
        const float rstd = rsqrtf(wave_sum_fast(s) * (1.f / DM) + RMS_EPS);
        const f32x4* wp = (const f32x4*)nw + F.lane;
        const f32x4* shp = (const f32x4*)(mod + (size_t)b * MODW + shift_off) + F.lane;
        const f32x4* scp = (const f32x4*)(mod + (size_t)b * MODW + scale_off) + F.lane;
        v2u* o = (v2u*)(XN + (size_t)m * DM) + F.lane;
#pragma unroll
        for (int j = 0; j < 8; ++j) { const f32x4 w = wp[64 * j], a = scp[64 * j], c = shp[64 * j];
            const f32x4 r = (v[j] * rstd) * w * (a + 1.f) + c;
            v2u p; p.x = pk2(r.x, r.y); p.y = pk2(r.z, r.w); o[64 * j] = p; }
    }
}
__device__ __forceinline__ void final_norm_rows_bf16(const Ctx& F, const bf16* H, const float* nw, float* O, float oscale) {
    if (F.gw >= M) return;
    v2u un[8]; load_row_raw(H + (size_t)F.gw * DM, F.lane, un);
    f32x4 wv[8];
#pragma unroll
    for (int j = 0; j < 8; ++j) wv[j] = ((const f32x4*)nw + F.lane)[64 * j];
    for (int m = F.gw; m < M; m += F.NGW) {
        f32x4 v[8]; float s = 0.f;
#pragma unroll
        for (int j = 0; j < 8; ++j) { v[j] = (f32x4){bflo(un[j].x), bfhi(un[j].x), bflo(un[j].y), bfhi(un[j].y)}; s += (v[j].x * v[j].x + v[j].y * v[j].y) + (v[j].z * v[j].z + v[j].w * v[j].w); }
        { const int mn = (m + F.NGW < M) ? m + F.NGW : m; load_row_raw(H + (size_t)mn * DM, F.lane, un); }
        const float rstd = rsqrtf(wave_sum_fast(s) * (1.f / DM) + RMS_EPS) * oscale;
        f32x4* o = (f32x4*)(O + (size_t)m * DM) + F.lane;
#pragma unroll
        for (int j = 0; j < 8; ++j) __builtin_nontemporal_store((v[j] * rstd) * wv[j], o + 64 * j);
    }
}
#define LO2(v) __builtin_shufflevector((v), (v), 0, 1)
#define HI2(v) __builtin_shufflevector((v), (v), 2, 3)
template <int CTRL> __device__ __forceinline__ float dpp_f(float x) { return __builtin_bit_cast(float, __builtin_amdgcn_mov_dpp(__builtin_bit_cast(int, x), CTRL, 0xf, 0xf, true)); }
__device__ __forceinline__ float rowsum16(float x) { x += dpp_f<0xB1>(x); x += dpp_f<0x4E>(x); x += dpp_f<0x124>(x); x += dpp_f<0x128>(x); return x; }
__device__ __forceinline__ float quadsum(float x) { x += dpp_f<0xB1>(x); x += dpp_f<0x4E>(x); return x; }

__device__ __forceinline__ float treduce16(const float (&p)[16], bool b0, bool b1, bool b2, bool b3) {
    float a[8], bq[4], c2[2];
#pragma unroll
    for (int j = 0; j < 8; ++j) { const float mine = b3 ? p[j + 8] : p[j], send = b3 ? p[j] : p[j + 8]; a[j] = mine + dpp_f<0x128>(send); }
#pragma unroll
    for (int j = 0; j < 4; ++j) { const float mine = b2 ? a[j + 4] : a[j], send = b2 ? a[j] : a[j + 4]; const float up = dpp_f<0x104>(send), dn = dpp_f<0x114>(send); bq[j] = mine + (b2 ? dn : up); }
#pragma unroll
    for (int j = 0; j < 2; ++j) { const float mine = b1 ? bq[j + 2] : bq[j], send = b1 ? bq[j] : bq[j + 2]; c2[j] = mine + dpp_f<0x4E>(send); }
    const float mine = b0 ? c2[1] : c2[0], send = b0 ? c2[0] : c2[1];
    return mine + dpp_f<0xB1>(send);
}
__device__ __forceinline__ float wave_sum_dpp(float v) { v = rowsum16(v); v += __shfl_xor(v, 16); v += __shfl_xor(v, 32); return v; }
__device__ __forceinline__ void unpack8(const v4u p, float (&e)[8]) { e[0] = bflo(p.x); e[1] = bfhi(p.x); e[2] = bflo(p.y); e[3] = bfhi(p.y); e[4] = bflo(p.z); e[5] = bfhi(p.z); e[6] = bflo(p.w); e[7] = bfhi(p.w); }
__device__ __forceinline__ v4u pack8(const float (&e)[8]) { v4u o; o.x = pk2(e[0], e[1]); o.y = pk2(e[2], e[3]); o.z = pk2(e[4], e[5]); o.w = pk2(e[6], e[7]); return o; }

__device__ __forceinline__ void p3_lora(const Ctx& F) {
    const bf16* PROJ = (const bf16*)(F.ws + WS_PROJ);
    const bf16* WUPT = (const bf16*)(F.ws + WS_WUPT); const bf16* AUPT = (const bf16*)(F.ws + WS_AUPT); const bf16* GUPT = (const bf16*)(F.ws + WS_GUPT);
    bf16* LW = (bf16*)(F.ws + WS_LW); bf16* AA = (bf16*)(F.ws + WS_AA); bf16* GG = (bf16*)(F.ws + WS_GG);
    const float* mu = F.in[I_MU]; const float* w0 = F.in[I_W0]; const float* a0 = F.in[I_A0];
    const int r16 = F.lane & 15, q = F.lane >> 4;
    constexpr int WST = 72, GST = 168;
    LAS bf16* WU = (LAS bf16*)F.lds; LAS bf16* AU = WU + 128 * WST; LAS bf16* GU = AU + 128 * WST;
    const int nr = blockIdx.x & 7, nbr = (F.G - nr + 7) >> 3;
    __syncthreads();
    for (int i = F.tid; i < 128 * 8; i += NTHR) { const int row = i >> 3, ch = i & 7;
        *(LAS v4u*)(WU + row * WST + 8 * ch) = *(const v4u*)(WUPT + (size_t)(128 * nr + row) * L_W + 8 * ch);
        *(LAS v4u*)(AU + row * WST + 8 * ch) = *(const v4u*)(AUPT + (size_t)(128 * nr + row) * L_A + 8 * ch); }
    for (int i = F.tid; i < 128 * 20; i += NTHR) { const int row = i / 20, ch = i - row * 20;
        *(LAS v4u*)(GU + row * GST + 8 * ch) = *(const v4u*)(GUPT + (size_t)(128 * nr + row) * L_G + 8 * ch); }
    __syncthreads();
    for (int mt = (blockIdx.x >> 3) * NWAVES + F.wave; mt < M / 16; mt += nbr * NWAVES) {
        const int m = mt * 16 + r16; const bool first = (m % SEQ) == 0;
        const bf16* row = PROJ + (size_t)m * INPP;
        bf16x8 af[9];
#pragma unroll
        for (int s = 0; s < 9; ++s) {
            const int col = ((s < 2) ? (C_WD + 32 * s) : (s < 4) ? (C_AD + 32 * (s - 2)) : (C_GD + 32 * (s - 4))) + 8 * q;
            const v4u pc = *(const v4u*)(row + col);
            v4u pp = {0u, 0u, 0u, 0u}; if (!first) pp = *(const v4u*)(row - INPP + col);
            const f32x4 m0 = *(const f32x4*)(mu + col), m1 = *(const f32x4*)(mu + col + 4);
            float c[8], p[8], e[8]; unpack8(pc, c); unpack8(pp, p);
            const float mm[8] = {m0.x, m0.y, m0.z, m0.w, m1.x, m1.y, m1.z, m1.w};
#pragma unroll
            for (int j = 0; j < 8; ++j) { float v = c[j] + (p[j] - c[j]) * mm[j];
                if (s < 2) { const float t = __expf(2.f * v); v = 1.f - 2.f * rcp_f(t + 1.f); }
                else if (s >= 4) v = sigmoid_f(v);
                e[j] = v; }
            af[s] = __builtin_bit_cast(bf16x8, pack8(e));
        }
#pragma unroll 2
        for (int nt = 0; nt < 8; ++nt) {
            const LAS bf16* wu = WU + (16 * nt + r16) * WST + 8 * q; const LAS bf16* au = AU + (16 * nt + r16) * WST + 8 * q; const LAS bf16* gu = GU + (16 * nt + r16) * GST + 8 * q;
            f32x4 acc0 = {0.f, 0.f, 0.f, 0.f}, acc1 = acc0, acc2 = acc0;
#pragma unroll
            for (int s2 = 0; s2 < 2; ++s2) acc0 = __builtin_amdgcn_mfma_f32_16x16x32_bf16(*(const LAS bf16x8*)(wu + 32 * s2), af[s2], acc0, 0, 0, 0);
#pragma unroll
            for (int s2 = 0; s2 < 2; ++s2) acc1 = __builtin_amdgcn_mfma_f32_16x16x32_bf16(*(const LAS bf16x8*)(au + 32 * s2), af[2 + s2], acc1, 0, 0, 0);
#pragma unroll
            for (int s2 = 0; s2 < 5; ++s2) acc2 = __builtin_amdgcn_mfma_f32_16x16x32_bf16(*(const LAS bf16x8*)(gu + 32 * s2), af[4 + s2], acc2, 0, 0, 0);
            const int n = 128 * nr + 16 * nt + 4 * q;
            const f32x4 w0v = *(const f32x4*)(w0 + n), a0v = *(const f32x4*)(a0 + n);
            v2u o0, o1, o2;
            o0.x = pk2(-0.60653066f * sigmoid_f(acc0[0] + w0v.x), -0.60653066f * sigmoid_f(acc0[1] + w0v.y));
            o0.y = pk2(-0.60653066f * sigmoid_f(acc0[2] + w0v.z), -0.60653066f * sigmoid_f(acc0[3] + w0v.w));
            o1.x = pk2(sigmoid_f(acc1[0] + a0v.x), sigmoid_f(acc1[1] + a0v.y)); o1.y = pk2(sigmoid_f(acc1[2] + a0v.z), sigmoid_f(acc1[3] + a0v.w));
            o2.x = pk2(acc2[0], acc2[1]); o2.y = pk2(acc2[2], acc2[3]);
            *(v2u*)(LW + (size_t)m * RW + n) = o0; *(v2u*)(AA + (size_t)m * RW + n) = o1; *(v2u*)(GG + (size_t)m * RW + n) = o2;
        }
    }
    __syncthreads();
}

constexpr int TC = 32, NCHUNK = SEQ / TC;
constexpr int RB_R = 0, RB_W = TC * 64, RB_K = 2 * TC * 64, RB_KK = 3 * TC * 64, RB_KA = 4 * TC * 64, RB_V = 5 * TC * 64, RB_SIZE = 5 * TC * 64 + TC * 16;
constexpr int MB_B = 0, MB_C = TC * 128, MB_X = 2 * TC * 128, MB_DT = MB_X + TC * 32, MB_DA = MB_DT + TC, MB_SIZE = MB_DA + TC;
static_assert(2 * RB_SIZE * 4 <= RING_BYTES, "scan buffers fit the LDS ring");

struct RwkvRaw { bf16 r[9], k[9], v[9], lw[8], a[8]; };
__device__ __forceinline__ void rwkv_load(RwkvRaw& raw, const bf16* PROJ, const bf16* LW, const bf16* AA, int b, int h, int t0w, int c) {
    const bf16* base = PROJ + (size_t)(b * SEQ + t0w) * INPP + h * 64 + c;
#pragma unroll
    for (int i = 0; i < 9; ++i) {
        if (i == 0 && t0w == 0) { raw.r[0] = 0; raw.k[0] = 0; raw.v[0] = 0; }
        else { const bf16* row = base + (long)(i - 1) * INPP; raw.r[i] = row[C_R]; raw.k[i] = row[C_K]; raw.v[i] = row[C_V]; }
    }
#pragma unroll
    for (int i = 0; i < 8; ++i) { const size_t o = (size_t)(b * SEQ + t0w + i) * RW + h * 64 + c; raw.lw[i] = LW[o]; raw.a[i] = AA[o]; }
}
__device__ __forceinline__ void rwkv_stage(const RwkvRaw& raw, LAS float* buf, int tl0, int c, int qt, float mu_r, float mu_k, float mu_v, float kkw, float kaw) {
#pragma unroll
    for (int i = 0; i < 8; ++i) {
        const int t = tl0 + i;
        const float rc = bf1(raw.r[i + 1]), rp = bf1(raw.r[i]), kc = bf1(raw.k[i + 1]), kp = bf1(raw.k[i]), vc = bf1(raw.v[i + 1]), vp = bf1(raw.v[i]);
        const float rr = rc + (rp - rc) * mu_r, kx = kc + (kp - kc) * mu_k, vv = vc + (vp - vc) * mu_v;
        const float a = bf1(raw.a[i]), dec = __expf(bf1(raw.lw[i]));
        const float kkraw = kx * kkw; const float ss = wave_sum_dpp(kkraw * kkraw);
        const float kkn = kkraw * rcp_f(fmaxf(sqrtf(ss), 1e-12f));
        buf[RB_R + t * 64 + c] = rr; buf[RB_W + t * 64 + c] = dec; buf[RB_K + t * 64 + c] = kx * (1.f + (a - 1.f) * kaw);
        buf[RB_KK + t * 64 + c] = kkn; buf[RB_KA + t * 64 + c] = kkn * a;
        if ((c >> 4) == qt) buf[RB_V + t * 16 + (c & 15)] = vv;
    }
}
__device__ __forceinline__ void rwkv_task(const Ctx& F, int task) {
    const int b = task >> 6, h = (task >> 2) & 15, qt = task & 3;
    const bf16* PROJ = (const bf16*)(F.ws + WS_PROJ); const bf16* LW = (const bf16*)(F.ws + WS_LW); const bf16* AA = (const bf16*)(F.ws + WS_AA);
    bf16* OY = (bf16*)(F.ws + WS_OY);
    LAS float* lbuf = (LAS float*)F.lds;
    const int c = F.lane, w = F.wave, r = F.lane >> 4, cg = F.lane & 15;
    const bool stager = w >= 4; const int sw = w & 3;
    const int ch = h * 64 + c;
    const float mu_r = F.in[I_MU][C_R + ch], mu_k = F.in[I_MU][C_K + ch], mu_v = F.in[I_MU][C_V + ch], kkw = F.in[I_KK][ch], kaw = F.in[I_KA][ch];
    RwkvRaw raw;
    if (stager) { rwkv_load(raw, PROJ, LW, AA, b, h, 8 * sw, c); rwkv_stage(raw, lbuf, 8 * sw, c, qt, mu_r, mu_k, mu_v, kkw, kaw); rwkv_load(raw, PROJ, LW, AA, b, h, TC + 8 * sw, c); }
    __syncthreads();
    f32x2 S01 = {0.f, 0.f}, S23 = {0.f, 0.f};
    const bool cb0 = cg & 1, cb1 = cg & 2, cb2 = cg & 4, cb3 = cg & 8;
    bf16* orow = OY + (size_t)(b * SEQ) * DM + h * 64 + 16 * qt + 4 * sw + r;
    for (int ck = 0; ck < NCHUNK; ++ck) {
        const LAS float* buf = lbuf + (ck & 1) * RB_SIZE;
        if (stager) {
            if (ck + 1 < NCHUNK) { rwkv_stage(raw, lbuf + ((ck + 1) & 1) * RB_SIZE, 8 * sw, c, qt, mu_r, mu_k, mu_v, kkw, kaw);
                if (ck + 2 < NCHUNK) rwkv_load(raw, PROJ, LW, AA, b, h, (ck + 2) * TC + 8 * sw, c); }
        } else {
            const LAS float* bp = buf + 4 * cg; const LAS float* vp = buf + RB_V + 4 * sw + r;
            f32x4 qkk[3], qw[3], qka[3], qk[3], qr[3]; float qv[3];
#pragma unroll
            for (int i = 0; i < 3; ++i) { qkk[i] = *(const LAS f32x4*)(bp + RB_KK + i * 64); qw[i] = *(const LAS f32x4*)(bp + RB_W + i * 64); qka[i] = *(const LAS f32x4*)(bp + RB_KA + i * 64);
                qk[i] = *(const LAS f32x4*)(bp + RB_K + i * 64); qr[i] = *(const LAS f32x4*)(bp + RB_R + i * 64); qv[i] = vp[i * 16]; }
            float op[16];
#pragma unroll
            for (int j = 0; j < TC; ++j) {
                const int u = j % 3;
                const f32x4 kk4 = qkk[u], w4 = qw[u], ka4 = qka[u], k4 = qk[u], r4 = qr[u]; const float vr = qv[u];
                const f32x2 tq = S01 * LO2(kk4) + S23 * HI2(kk4);
                const float sa = rowsum16(tq.x + tq.y);
                const f32x2 sav = {sa, sa}, vrv = {vr, vr};
                S01 = S01 * LO2(w4) + (vrv * LO2(k4) - sav * LO2(ka4));
                S23 = S23 * HI2(w4) + (vrv * HI2(k4) - sav * HI2(ka4));
                const f32x2 uq = S01 * LO2(r4) + S23 * HI2(r4);
                op[j & 15] = uq.x + uq.y;
                asm volatile("" : "+v"(S01), "+v"(S23) :: "memory");
                if (j + 3 < TC) { qkk[u] = *(const LAS f32x4*)(bp + RB_KK + (j + 3) * 64); qw[u] = *(const LAS f32x4*)(bp + RB_W + (j + 3) * 64); qka[u] = *(const LAS f32x4*)(bp + RB_KA + (j + 3) * 64);
                                  qk[u] = *(const LAS f32x4*)(bp + RB_K + (j + 3) * 64); qr[u] = *(const LAS f32x4*)(bp + RB_R + (j + 3) * 64); qv[u] = vp[(j + 3) * 16]; }
                if ((j & 15) == 15) {
                    const float ored = treduce16(op, cb0, cb1, cb2, cb3);
                    orow[(size_t)(ck * TC + (j - 15) + cg) * DM] = (bf16)(pk2(ored, 0.f) & 0xffffu);
                }
            }
        }
        __syncthreads();
    }
}

__device__ __forceinline__ void p4_scans(const Ctx& F) {
    for (int task = blockIdx.x; task < NB * RHEADS * 4; task += F.G) { rwkv_task(F, task); __syncthreads(); }
}

__device__ __forceinline__ void ld16(const float* p, float (&v)[16]) {
#pragma unroll
    for (int i = 0; i < 4; ++i) { const f32x4 t = *(const f32x4*)(p + 4 * i); v[4 * i] = t.x; v[4 * i + 1] = t.y; v[4 * i + 2] = t.z; v[4 * i + 3] = t.w; }
}
__device__ __forceinline__ void ldbf16x16(const bf16* p, float (&v)[16]) {
    float t0[8], t1[8]; unpack8(*(const v4u*)p, t0); unpack8(*(const v4u*)(p + 8), t1);
#pragma unroll
    for (int j = 0; j < 8; ++j) { v[j] = t0[j]; v[8 + j] = t1[j]; }
}
__device__ __forceinline__ void stbf16x16(bf16* p, const float (&v)[16]) {
    float t0[8], t1[8];
#pragma unroll
    for (int j = 0; j < 8; ++j) { t0[j] = v[j]; t1[j] = v[8 + j]; }
    *(v4u*)p = pack8(t0); *(v4u*)(p + 8) = pack8(t1);
}
__device__ __forceinline__ void p5_post(const Ctx& F) {
    const bf16* PROJ = (const bf16*)(F.ws + WS_PROJ); const bf16* AA = (const bf16*)(F.ws + WS_AA); const bf16* GG = (const bf16*)(F.ws + WS_GG);
    bf16* OY = (bf16*)(F.ws + WS_OY);
    const int c0 = 16 * F.lane;
    {
        float mur[16], muk[16], muv[16], ka[16], rk[16], lnw[16], lnb[16];
        ld16(F.in[I_MU] + C_R + c0, mur); ld16(F.in[I_MU] + C_K + c0, muk); ld16(F.in[I_MU] + C_V + c0, muv);
        ld16(F.in[I_KA] + c0, ka); ld16(F.in[I_RK] + c0, rk); ld16(F.in[I_LNW] + c0, lnw); ld16(F.in[I_LNB] + c0, lnb);
        for (int m = F.gw; m < M; m += F.NGW) {
            const bool first = (m % SEQ) == 0;
            const bf16* prow = PROJ + (size_t)m * INPP; bf16* oyrow = OY + (size_t)m * DM;
            float o[16], res[16]; float bs = 0.f;
            ldbf16x16(oyrow + c0, o);
            {
                float rc[16], rp[16], kc[16], kp[16], av[16];
                ldbf16x16(prow + C_R + c0, rc); ldbf16x16(prow + C_K + c0, kc); ldbf16x16(AA + (size_t)m * RW + c0, av);
                if (!first) { ldbf16x16(prow - INPP + C_R + c0, rp); ldbf16x16(prow - INPP + C_K + c0, kp); }
                else {
#pragma unroll
                    for (int j = 0; j < 16; ++j) { rp[j] = 0.f; kp[j] = 0.f; } }
#pragma unroll
                for (int j = 0; j < 16; ++j) { const float rr = rc[j] + (rp[j] - rc[j]) * mur[j], kx = kc[j] + (kp[j] - kc[j]) * muk[j];
                    bs += rr * (kx * (1.f + (av[j] - 1.f) * ka[j])) * rk[j]; }
            }
            bs = quadsum(bs);
            float s = 0.f;
#pragma unroll
            for (int j = 0; j < 16; ++j) s += o[j];
            const float mean = quadsum(s) * (1.f / 64.f);
            float qv = 0.f;
#pragma unroll
            for (int j = 0; j < 16; ++j) { o[j] -= mean; qv += o[j] * o[j]; }
            const float rstd = rsqrtf(quadsum(qv) * (1.f / 64.f) + 64e-5f);
            {
                float vc[16], vp[16], gv[16];
                ldbf16x16(prow + C_V + c0, vc); ldbf16x16(GG + (size_t)m * RW + c0, gv);
                if (!first) ldbf16x16(prow - INPP + C_V + c0, vp);
                else {
#pragma unroll
                    for (int j = 0; j < 16; ++j) vp[j] = 0.f; }
#pragma unroll
                for (int j = 0; j < 16; ++j) { const float vv = vc[j] + (vp[j] - vc[j]) * muv[j]; res[j] = (o[j] * rstd * lnw[j] + lnb[j] + bs * vv) * gv[j]; }
            }
            stbf16x16(oyrow + c0, res);
        }
    }
    {
        float nw[16]; ld16(F.in[I_MNW] + c0, nw);
        for (int m = F.gw; m < M; m += F.NGW) {
            const bf16* prow = PROJ + (size_t)m * INPP; bf16* oyrow = OY + (size_t)m * DM;
            float y[16], z[16];
            ldbf16x16(oyrow + RW + c0, y); ldbf16x16(prow + C_Z + c0, z);
            float qv = 0.f;
#pragma unroll
            for (int j = 0; j < 16; ++j) { y[j] *= silu_f(z[j]); qv += y[j] * y[j]; }
            qv = rowsum16(qv);
            { auto rr = __builtin_amdgcn_permlane16_swap(__float_as_uint(qv), __float_as_uint(qv), false, false); qv = __uint_as_float(rr[0]) + __uint_as_float(rr[1]); }
            const float rstd = rsqrtf(qv * (1.f / 512.f) + 1e-5f);
#pragma unroll
            for (int j = 0; j < 16; ++j) y[j] = y[j] * rstd * nw[j];
            stbf16x16(oyrow + RW + c0, y);
        }
    }
}
constexpr int MC_L = 128, MC_NC = SEQ / MC_L, LSTR = 136;
constexpr int MT_BYTES = 128 * LSTR * 2;
constexpr size_t WS_ST = 876 * MiB, WS_SIN = 940 * MiB, WS_ATOT = 1004 * MiB, WS_END2 = 1005 * MiB;

__device__ __forceinline__ float mamba_dt_scan(const Ctx& F, const bf16* PROJ, int b, int c, int g, LAS float* DT, LAS float* ACS) {
    const int head = g * 8 + F.wave, lane = F.lane;
    const float dtb = F.in[I_DTB][head], Aneg = -__expf(F.in[I_ALOG][head]);
    const bf16* p = PROJ + (size_t)(b * SEQ + c * MC_L + 2 * lane) * INPP + C_DT + head;
    const float x0 = bf1(p[0]) + dtb, x1 = bf1(p[INPP]) + dtb;
    const float d0 = (x0 > 20.f) ? x0 : log1pf(__expf(x0)), d1 = (x1 > 20.f) ? x1 : log1pf(__expf(x1));
    const float s0 = d0 * Aneg, s1 = s0 + d1 * Aneg;
    float incl = s1;
#pragma unroll
    for (int o = 1; o < 64; o <<= 1) { const float t = __shfl_up(incl, o); if (lane >= o) incl += t; }
    const float excl = incl - s1;
    DT[F.wave * 128 + 2 * lane] = d0; DT[F.wave * 128 + 2 * lane + 1] = d1;
    ACS[F.wave * 128 + 2 * lane] = excl + s0; ACS[F.wave * 128 + 2 * lane + 1] = excl + s1;
    return __shfl(incl, 63);
}
struct TRaw { bf16 v[35]; };
__device__ __forceinline__ void mstage_T_load(TRaw& raw, const bf16* PROJ, int b, int c, int chn, int tid) {
    const int t0 = 32 * (tid >> 7);
    const bf16* base = PROJ + (size_t)(b * SEQ + c * MC_L + t0) * INPP + C_XBC + chn;
    if (c * MC_L + t0 > 0) { raw.v[0] = base[-3 * INPP]; raw.v[1] = base[-2 * INPP]; raw.v[2] = base[-1 * INPP]; }
    else { raw.v[0] = 0; raw.v[1] = 0; raw.v[2] = 0; }
#pragma unroll
    for (int t = 0; t < 32; ++t) raw.v[3 + t] = base[(size_t)t * INPP];
}
template <bool SC>
__device__ __forceinline__ void mstage_T_store(const TRaw& raw, int chn, LAS bf16* dst, const LAS float* scale, const float* convw, const float* convb, int tid) {
    const int f = tid & 127, t0 = 32 * (tid >> 7);
    const float w0 = convw[chn], w1 = convw[1536 + chn], w2 = convw[2 * 1536 + chn], w3 = convw[3 * 1536 + chn], bb = convb[chn];
#pragma unroll
    for (int i8 = 0; i8 < 4; ++i8) {
        float e[8];
#pragma unroll
        for (int i = 0; i < 8; ++i) { const int t = 8 * i8 + i;
            float v = silu_f(bb + w0 * bf1(raw.v[t]) + w1 * bf1(raw.v[t + 1]) + w2 * bf1(raw.v[t + 2]) + w3 * bf1(raw.v[t + 3]));
            if (SC) v *= scale[t0 + t];
            e[i] = v; }
        *(LAS v4u*)(dst + f * LSTR + t0 + 8 * i8) = pack8(e);
    }
}
__device__ __forceinline__ void mstage_N(const bf16* PROJ, int b, int c, int g, LAS bf16* Bn, LAS bf16* Cn, const float* convw, const float* convb, int tid) {
    const int f8 = tid & 31, t0 = 8 * (tid >> 5);
    const int chn = (f8 < 16) ? (1024 + g * 128 + 8 * f8) : (1280 + g * 128 + 8 * (f8 - 16));
    LAS bf16* dst = ((f8 < 16) ? Bn : Cn) + 8 * (f8 & 15);
    const bf16* base = PROJ + (size_t)(b * SEQ + c * MC_L + t0) * INPP + C_XBC + chn;
    float w[4][8], bb[8];
#pragma unroll
    for (int i = 0; i < 4; ++i) { const f32x4 a = *(const f32x4*)(convw + i * 1536 + chn), d = *(const f32x4*)(convw + i * 1536 + chn + 4);
        w[i][0] = a.x; w[i][1] = a.y; w[i][2] = a.z; w[i][3] = a.w; w[i][4] = d.x; w[i][5] = d.y; w[i][6] = d.z; w[i][7] = d.w; }
    { const f32x4 a = *(const f32x4*)(convb + chn), d = *(const f32x4*)(convb + chn + 4); bb[0] = a.x; bb[1] = a.y; bb[2] = a.z; bb[3] = a.w; bb[4] = d.x; bb[5] = d.y; bb[6] = d.z; bb[7] = d.w; }
    float r0[8], r1[8], r2[8];
    if (c * MC_L + t0 > 0) { unpack8(*(const v4u*)(base - 3 * INPP), r0); unpack8(*(const v4u*)(base - 2 * INPP), r1); unpack8(*(const v4u*)(base - 1 * INPP), r2); }
    else {
#pragma unroll
        for (int k = 0; k < 8; ++k) { r0[k] = 0.f; r1[k] = 0.f; r2[k] = 0.f; } }
#pragma unroll
    for (int t = 0; t < 8; ++t) {
        float r3[8], e[8]; unpack8(*(const v4u*)(base + (size_t)t * INPP), r3);
#pragma unroll
        for (int k = 0; k < 8; ++k) { e[k] = silu_f(bb[k] + w[0][k] * r0[k] + w[1][k] * r1[k] + w[2][k] * r2[k] + w[3][k] * r3[k]); r0[k] = r1[k]; r1[k] = r2[k]; r2[k] = r3[k]; }
        *(LAS v4u*)(dst + (t0 + t) * LSTR) = pack8(e);
    }
}

__device__ __forceinline__ void m1_chunk_states(const Ctx& F) {
    const bf16* PROJ = (const bf16*)(F.ws + WS_PROJ); bf16* ST = (bf16*)(F.ws + WS_ST); float* ATOT = (float*)(F.ws + WS_ATOT);
    LAS bf16* BT = (LAS bf16*)F.lds; LAS bf16* XT = (LAS bf16*)(F.lds + MT_BYTES);
    LAS float* DT = (LAS float*)(F.lds + 3 * MT_BYTES); LAS float* ACS = DT + 8 * 128; LAS float* SCL = ACS + 8 * 128;
    const float* convw = F.in[I_CONVW]; const float* convb = F.in[I_CONVB];
    const int tid = F.tid, w = F.wave, lane = F.lane, r16 = lane & 15, q = lane >> 4;
    for (int it = blockIdx.x; it < NB * MC_NC * 2; it += F.G) {
        const int g = it & 1, c = (it >> 1) & (MC_NC - 1), b = it >> 7;
        __syncthreads();
        const float atot = mamba_dt_scan(F, PROJ, b, c, g, DT, ACS);
        if (lane == 0) ATOT[(b * MC_NC + c) * 16 + g * 8 + w] = atot;
        const int chB = 1024 + g * 128 + (tid & 127);
        TRaw ra, rb;
        mstage_T_load(ra, PROJ, b, c, chB, tid);
        mstage_T_load(rb, PROJ, b, c, (g * 8 + ((tid & 127) >> 6)) * 64 + (tid & 63), tid);
        LDS_WAIT();
        SCL[w * 128 + 2 * lane] = DT[w * 128 + 2 * lane] * __expf(atot - ACS[w * 128 + 2 * lane]);
        SCL[w * 128 + 2 * lane + 1] = DT[w * 128 + 2 * lane + 1] * __expf(atot - ACS[w * 128 + 2 * lane + 1]);
        mstage_T_store<false>(ra, chB, BT, nullptr, convw, convb, tid);
        mstage_T_load(ra, PROJ, b, c, (g * 8 + 2 + ((tid & 127) >> 6)) * 64 + (tid & 63), tid);
        __syncthreads();
#pragma unroll
        for (int hb = 0; hb < 2; ++hb) {
            if (hb == 1) mstage_T_load(ra, PROJ, b, c, (g * 8 + 6 + ((tid & 127) >> 6)) * 64 + (tid & 63), tid);
            { const int hl = 4 * hb + ((tid & 127) >> 6); mstage_T_store<true>(rb, (g * 8 + hl) * 64 + (tid & 63), XT, SCL + hl * 128, convw, convb, tid); }
            if (hb == 0) mstage_T_load(rb, PROJ, b, c, (g * 8 + 4 + ((tid & 127) >> 6)) * 64 + (tid & 63), tid);
            { const int hl = 4 * hb + 2 + ((tid & 127) >> 6); mstage_T_store<true>(ra, (g * 8 + hl) * 64 + (tid & 63), XT + 128 * LSTR, SCL + hl * 128, convw, convb, tid); }
            __syncthreads();
            const int hh = w >> 1, ph = w & 1;
            f32x4 acc[2][8];
#pragma unroll
            for (int a = 0; a < 2; ++a)
#pragma unroll
                for (int n = 0; n < 8; ++n) acc[a][n] = (f32x4){0.f, 0.f, 0.f, 0.f};
#pragma unroll
            for (int ks = 0; ks < 4; ++ks) {
                bf16x8 xa[2];
#pragma unroll
                for (int a = 0; a < 2; ++a) xa[a] = *(const LAS bf16x8*)(XT + (hh * 64 + 32 * ph + 16 * a + r16) * LSTR + 32 * ks + 8 * q);
#pragma unroll
                for (int n = 0; n < 8; ++n) { const bf16x8 bfr = *(const LAS bf16x8*)(BT + (16 * n + r16) * LSTR + 32 * ks + 8 * q);
#pragma unroll
                    for (int a = 0; a < 2; ++a) acc[a][n] = __builtin_amdgcn_mfma_f32_16x16x32_bf16(bfr, xa[a], acc[a][n], 0, 0, 0); }
            }
            bf16* st = ST + ((size_t)((b * MC_NC + c) * 16 + g * 8 + 4 * hb + hh)) * (64 * 128);
#pragma unroll
            for (int a = 0; a < 2; ++a)
#pragma unroll
                for (int n = 0; n < 8; ++n) { v2u o; o.x = pk2(acc[a][n][0], acc[a][n][1]); o.y = pk2(acc[a][n][2], acc[a][n][3]);
                    *(v2u*)(st + (32 * ph + 16 * a + r16) * 128 + 16 * n + 4 * q) = o; }
            __syncthreads();
        }
    }
}

__device__ __forceinline__ void m2_prefix(const Ctx& F) {
    const bf16* ST = (const bf16*)(F.ws + WS_ST); bf16* SIN = (bf16*)(F.ws + WS_SIN); const float* ATOT = (const float*)(F.ws + WS_ATOT);
    const int nthr = F.G * NTHR;
    for (int gi = blockIdx.x * NTHR + F.tid; gi < NB * 16 * 2048; gi += nthr) {
        const int e4 = gi & 2047, bh = gi >> 11, b = bh >> 4, h = bh & 15;
        float r0 = 0.f, r1 = 0.f, r2 = 0.f, r3 = 0.f;
#pragma unroll 4
        for (int c = 0; c < MC_NC; ++c) {
            const size_t o = ((size_t)((b * MC_NC + c) * 16 + h)) * 8192 + 4 * e4;
            v2u so; so.x = pk2(r0, r1); so.y = pk2(r2, r3);
            *(v2u*)(SIN + o) = so;
            const v2u sv = *(const v2u*)(ST + o); const float d = __expf(ATOT[(b * MC_NC + c) * 16 + h]);
            r0 = r0 * d + bflo(sv.x); r1 = r1 * d + bfhi(sv.x); r2 = r2 * d + bflo(sv.y); r3 = r3 * d + bfhi(sv.y);
        }
    }
}

__device__ __forceinline__ void m3_outputs(const Ctx& F) {
    const bf16* PROJ = (const bf16*)(F.ws + WS_PROJ); const bf16* SIN = (const bf16*)(F.ws + WS_SIN); bf16* OY = (bf16*)(F.ws + WS_OY);
    LAS bf16* Cn = (LAS bf16*)F.lds; LAS bf16* RB = (LAS bf16*)(F.lds + MT_BYTES);
    LAS bf16* Mw = (LAS bf16*)(F.lds + 2 * MT_BYTES) + F.wave * 16 * LSTR;
    LAS float* DT = (LAS float*)(F.lds + 3 * MT_BYTES); LAS float* ACS = DT + 8 * 128;
    const float* convw = F.in[I_CONVW]; const float* convb = F.in[I_CONVB];
    const int tid = F.tid, w = F.wave, lane = F.lane, r16 = lane & 15, q = lane >> 4;
    for (int it = blockIdx.x; it < NB * MC_NC * 2; it += F.G) {
        const int g = it & 1, c = (it >> 1) & (MC_NC - 1), b = it >> 7;
        __syncthreads();
        (void)mamba_dt_scan(F, PROJ, b, c, g, DT, ACS);
        mstage_N(PROJ, b, c, g, RB, Cn, convw, convb, tid);
        __syncthreads();
        TRaw rx;
        mstage_T_load(rx, PROJ, b, c, (g * 8 + ((tid & 127) >> 6)) * 64 + (tid & 63), tid);
        bf16x8 cf[4];
#pragma unroll
        for (int ks = 0; ks < 4; ++ks) cf[ks] = *(const LAS bf16x8*)(Cn + (16 * w + r16) * LSTR + 32 * ks + 8 * q);
        f32x4 Gt[8];
#pragma unroll
        for (int nt = 0; nt < 8; ++nt) { Gt[nt] = (f32x4){0.f, 0.f, 0.f, 0.f};
#pragma unroll
            for (int ks = 0; ks < 4; ++ks) Gt[nt] = __builtin_amdgcn_mfma_f32_16x16x32_bf16(*(const LAS bf16x8*)(RB + (16 * nt + r16) * LSTR + 32 * ks + 8 * q), cf[ks], Gt[nt], 0, 0, 0); }
        const int l = 16 * w + r16;
        const size_t mrow = (size_t)(b * SEQ + c * MC_L + l);
#pragma unroll 1
        for (int hb = 0; hb < 4; ++hb) {
            __syncthreads();
            { const int hl = 2 * hb + ((tid & 127) >> 6); mstage_T_store<false>(rx, (g * 8 + hl) * 64 + (tid & 63), RB, nullptr, convw, convb, tid); }
            { const int hn = (hb < 3) ? 2 * (hb + 1) : 2 * hb; mstage_T_load(rx, PROJ, b, c, (g * 8 + hn + ((tid & 127) >> 6)) * 64 + (tid & 63), tid); }
            __syncthreads();
#pragma unroll 1
            for (int h2 = 0; h2 < 2; ++h2) {
                const int hl = 2 * hb + h2, head = g * 8 + hl;
                const float acs_l = ACS[hl * 128 + l];
                const bf16* sin = SIN + ((size_t)((b * MC_NC + c) * 16 + head)) * 8192;
                bf16x8 sf[4][4];
#pragma unroll
                for (int pt = 0; pt < 4; ++pt)
#pragma unroll
                    for (int ks = 0; ks < 4; ++ks) sf[pt][ks] = *(const bf16x8*)(sin + (16 * pt + r16) * 128 + 32 * ks + 8 * q);
#pragma unroll
                for (int nt = 0; nt < 8; ++nt) { const f32x4 as = *(const LAS f32x4*)(ACS + hl * 128 + 16 * nt + 4 * q), ds = *(const LAS f32x4*)(DT + hl * 128 + 16 * nt + 4 * q);
                    float mv[4];
#pragma unroll
                    for (int j = 0; j < 4; ++j) { const int s = 16 * nt + 4 * q + j; mv[j] = (s <= l) ? Gt[nt][j] * __expf(acs_l - as[j]) * ds[j] : 0.f; }
                    v2u o; o.x = pk2(mv[0], mv[1]); o.y = pk2(mv[2], mv[3]);
                    *(LAS v2u*)(Mw + r16 * LSTR + 16 * nt + 4 * q) = o; }
                LDS_WAIT(); asm volatile("" ::: "memory");
                bf16x8 mf[4];
#pragma unroll
                for (int ks = 0; ks < 4; ++ks) mf[ks] = *(const LAS bf16x8*)(Mw + r16 * LSTR + 32 * ks + 8 * q);
                const float el = __expf(acs_l), Dh = F.in[I_DSK][head];
#pragma unroll
                for (int pt = 0; pt < 4; ++pt) {
                    f32x4 yd = {0.f, 0.f, 0.f, 0.f}, yo = {0.f, 0.f, 0.f, 0.f};
#pragma unroll
                    for (int ks = 0; ks < 4; ++ks) {
                        yd = __builtin_amdgcn_mfma_f32_16x16x32_bf16(*(const LAS bf16x8*)(RB + (h2 * 64 + 16 * pt + r16) * LSTR + 32 * ks + 8 * q), mf[ks], yd, 0, 0, 0);
                        yo = __builtin_amdgcn_mfma_f32_16x16x32_bf16(sf[pt][ks], cf[ks], yo, 0, 0, 0); }
                    float yv[4];
#pragma unroll
                    for (int j = 0; j < 4; ++j) yv[j] = yd[j] + el * yo[j] + Dh * bf1(RB[(h2 * 64 + 16 * pt + 4 * q + j) * LSTR + l]);
                    v2u o; o.x = pk2(yv[0], yv[1]); o.y = pk2(yv[2], yv[3]);
                    *(v2u*)(OY + mrow * DM + RW + head * 64 + 16 * pt + 4 * q) = o;
                }
                asm volatile("" ::: "memory");
            }
        }
    }
}
constexpr int RC = 16, RNCH = SEQ / RC, NPART = 4, RHALF = RNCH / NPART, RITEMS = NB * RHEADS * RHALF;
constexpr size_t RO_WH = 0, RO_RH = 16 * MiB, RO_VT = 32 * MiB, RO_ET = 48 * MiB, RO_OL = 64 * MiB, RO_A2 = 80 * MiB, RO_GC = 112 * MiB, RO_BUF = 116 * MiB, RO_SS = 232 * MiB;
constexpr int RL_KAP = 0, RL_ALP = 2304, RL_KT = 4608, RL_RT = 6912, RL_KAPT = 9216, RL_VT = 11264, RL_TB = 13312, RL_BL = 14336, RL_QL = 15360, RL_PL = 16384,
              RL_WT = RL_KAP, RL_BVT = RL_ALP, RL_AL32 = RL_KT, RL_ET = RL_KT,
              RL_BYTES = 18176;
constexpr int XS = 72, TS = 16, SS16 = 32;

__device__ __forceinline__ float wave_sum_pl(float x) {
    x = rowsum16(x);
    { auto rr = __builtin_amdgcn_permlane16_swap(__float_as_uint(x), __float_as_uint(x), false, false); x = __uint_as_float(rr[0]) + __uint_as_float(rr[1]); }
    { auto rr = __builtin_amdgcn_permlane32_swap(__float_as_uint(x), __float_as_uint(x), false, false); x = __uint_as_float(rr[0]) + __uint_as_float(rr[1]); }
    return x;
}
__device__ __forceinline__ v2u pack4(const f32x4 a) { v2u o; o.x = pk2(a[0], a[1]); o.y = pk2(a[2], a[3]); return o; }
__device__ __forceinline__ f32x4 unpack4(const v2u u) { return (f32x4){bflo(u.x), bfhi(u.x), bflo(u.y), bfhi(u.y)}; }
__device__ __forceinline__ bf16 f2b(float x) { return (bf16)pk2(x, 0.f); }

__device__ __forceinline__ void ra_item(const Ctx& F, LAS unsigned char* wl, int it, int half) {
    const int bh = it / RHALF, cl = it - bh * RHALF, ci = half * RHALF + cl, b = bh >> 4, h = bh & 15;
    const bf16* PROJ = (const bf16*)(F.ws + WS_PROJ); const bf16* LW = (const bf16*)(F.ws + WS_LW); const bf16* AA = (const bf16*)(F.ws + WS_AA);
    unsigned char* RO = (unsigned char*)F.out + (size_t)(half & 1) * RO_BUF;
    const int lane = F.lane, r16 = lane & 15, q = lane >> 4, c = lane, ch = h * 64 + c;
    const size_t m0 = (size_t)b * SEQ + (size_t)RC * ci;
    LAS bf16* KAP = (LAS bf16*)(wl + RL_KAP); LAS bf16* ALP = (LAS bf16*)(wl + RL_ALP); LAS bf16* KT = (LAS bf16*)(wl + RL_KT); LAS bf16* RT = (LAS bf16*)(wl + RL_RT);
    LAS bf16* KAPT = (LAS bf16*)(wl + RL_KAPT); LAS bf16* VTL = (LAS bf16*)(wl + RL_VT); LAS bf16* WT = (LAS bf16*)(wl + RL_WT); LAS bf16* BVT = (LAS bf16*)(wl + RL_BVT); LAS bf16* ETL = (LAS bf16*)(wl + RL_ET);
    LAS bf16* TB = (LAS bf16*)(wl + RL_TB); LAS bf16* BL = (LAS bf16*)(wl + RL_BL); LAS bf16* QL = (LAS bf16*)(wl + RL_QL); LAS bf16* PL = (LAS bf16*)(wl + RL_PL);
    const float mu_r = F.in[I_MU][C_R + ch], mu_k = F.in[I_MU][C_K + ch], mu_v = F.in[I_MU][C_V + ch], kkw = F.in[I_KK][ch], kaw = F.in[I_KA][ch];
    const bf16* prow = PROJ + m0 * INPP + ch;
    float rp = 0.f, kp = 0.f, vp = 0.f;
    if (ci > 0) { rp = bf1(prow[-INPP + C_R]); kp = bf1(prow[-INPP + C_K]); vp = bf1(prow[-INPP + C_V]); }
    float ec = 1.f, kkna[RC], kpv[RC], env[RC], vvv[RC];
    float cum = 0.f;
#pragma unroll
    for (int t = 0; t < RC; ++t) {
        const bf16* row = prow + (size_t)t * INPP;
        const float rc = bf1(row[C_R]), kc = bf1(row[C_K]), vc = bf1(row[C_V]);
        const float a = bf1(AA[(m0 + t) * RW + ch]), lw = bf1(LW[(m0 + t) * RW + ch]);
        const float rr = rc + (rp - rc) * mu_r, kx = kc + (kp - kc) * mu_k, vv = vc + (vp - vc) * mu_v;
        rp = rc; kp = kc; vp = vc;
        const float kkraw = kx * kkw; const float ss = wave_sum_pl(kkraw * kkraw);
        const float kkn = kkraw * rcp_f(fmaxf(sqrtf(ss), 1e-12f));
        const float kpp = kx * (1.f + (a - 1.f) * kaw);
        const float ep = ec; cum += lw; ec = __expf(cum); const float en = rcp_f(ec);
        const unsigned p0 = pk2(kkn * ep, kkn * a * en), p1 = pk2(kpp * en, rr * ec), p2 = pk2(vv, 0.f);
        KAP[t * XS + c] = (bf16)p0; ALP[t * XS + c] = (bf16)(p0 >> 16); KT[t * XS + c] = (bf16)p1; RT[t * XS + c] = (bf16)(p1 >> 16);
        KAPT[c * TS + t] = (bf16)p0; VTL[c * TS + t] = (bf16)p2;
        kkna[t] = kkn * a; kpv[t] = kpp; env[t] = en; vvv[t] = vv;
    }
    {
        float e8[8]; v4u* vt = (v4u*)((bf16*)(RO + RO_VT) + (size_t)it * 1024 + c * 16);
#pragma unroll
        for (int i = 0; i < 8; ++i) e8[i] = vvv[i];
        vt[0] = pack8(e8);
#pragma unroll
        for (int i = 0; i < 8; ++i) e8[i] = vvv[8 + i];
        vt[1] = pack8(e8);
        v4u* a2 = (v4u*)((bf16*)(RO + RO_A2) + (size_t)it * 2048 + c * 32);
        float dd[RC];
#pragma unroll
        for (int t = 0; t < RC; ++t) dd[t] = ec * env[t];
#pragma unroll
        for (int i = 0; i < 8; ++i) e8[i] = -kkna[i] * dd[i];
        a2[0] = pack8(e8);
#pragma unroll
        for (int i = 0; i < 8; ++i) e8[i] = -kkna[8 + i] * dd[8 + i];
        a2[1] = pack8(e8);
#pragma unroll
        for (int i = 0; i < 8; ++i) e8[i] = kpv[i] * dd[i];
        a2[2] = pack8(e8);
#pragma unroll
        for (int i = 0; i < 8; ++i) e8[i] = kpv[8 + i] * dd[8 + i];
        a2[3] = pack8(e8);
        ((float*)(RO + RO_GC))[(size_t)it * 64 + c] = ec;
    }
    LDS_WAIT(); asm volatile("" ::: "memory");
    const v2u zero2 = {0u, 0u};
    {
        f32x4 alt = {0.f, 0.f, 0.f, 0.f}, blt = alt, qlt = alt, plt = alt;
#pragma unroll
        for (int ks = 0; ks < 2; ++ks) {
            const bf16x8 fa = *(const LAS bf16x8*)(ALP + r16 * XS + 32 * ks + 8 * q), fk = *(const LAS bf16x8*)(KT + r16 * XS + 32 * ks + 8 * q);
            const bf16x8 fkp = *(const LAS bf16x8*)(KAP + r16 * XS + 32 * ks + 8 * q), fr = *(const LAS bf16x8*)(RT + r16 * XS + 32 * ks + 8 * q);
            alt = __builtin_amdgcn_mfma_f32_16x16x32_bf16(fa, fkp, alt, 0, 0, 0); blt = __builtin_amdgcn_mfma_f32_16x16x32_bf16(fk, fkp, blt, 0, 0, 0);
            qlt = __builtin_amdgcn_mfma_f32_16x16x32_bf16(fa, fr, qlt, 0, 0, 0);  plt = __builtin_amdgcn_mfma_f32_16x16x32_bf16(fk, fr, plt, 0, 0, 0);
        }
#pragma unroll
        for (int j = 0; j < 4; ++j) { const int s = 4 * q + j; const bool lt = s < r16, le = s <= r16;
            alt[j] = lt ? alt[j] : 0.f; blt[j] = lt ? blt[j] : 0.f; qlt[j] = le ? qlt[j] : 0.f; plt[j] = le ? plt[j] : 0.f; }
        *(LAS v2u*)(BL + r16 * SS16 + 4 * q) = pack4(blt); *(LAS v2u*)(QL + r16 * SS16 + 4 * q) = pack4(qlt); *(LAS v2u*)(PL + r16 * SS16 + 4 * q) = pack4(plt);
        *(LAS v2u*)(BL + r16 * SS16 + 16 + 4 * q) = zero2; *(LAS v2u*)(QL + r16 * SS16 + 16 + 4 * q) = zero2; *(LAS v2u*)(PL + r16 * SS16 + 16 + 4 * q) = zero2;
        float x[RC];
#pragma unroll
        for (int t = 0; t < RC; ++t) {
            float acc = (t == r16) ? 1.f : 0.f;
#pragma unroll
            for (int s2 = 0; s2 < t; ++s2) { const float a_ts = __uint_as_float(__builtin_amdgcn_readlane(__float_as_uint(alt[s2 & 3]), 16 * (s2 >> 2) + t)); acc -= a_ts * x[s2]; }
            x[t] = acc;
        }
        if (q == 0) {
#pragma unroll
            for (int t = 0; t < RC; ++t) { TB[t * SS16 + r16] = f2b(x[t]); TB[t * SS16 + 16 + r16] = 0; }
        }
    }
    LDS_WAIT(); asm volatile("" ::: "memory");
    const bf16x8 zf = {0, 0, 0, 0, 0, 0, 0, 0};
    const bf16x8 tbf = *(const LAS bf16x8*)(TB + r16 * SS16 + 8 * q), blf = *(const LAS bf16x8*)(BL + r16 * SS16 + 8 * q);
    const bf16x8 qlf = *(const LAS bf16x8*)(QL + r16 * SS16 + 8 * q), plf = *(const LAS bf16x8*)(PL + r16 * SS16 + 8 * q);
    const f32x4 z4 = {0.f, 0.f, 0.f, 0.f};
    bf16* gWH = (bf16*)(RO + RO_WH) + (size_t)it * 1024; bf16* gRH = (bf16*)(RO + RO_RH) + (size_t)it * 1024;
    bf16* gET = (bf16*)(RO + RO_ET) + (size_t)it * 1024; bf16* gOL = (bf16*)(RO + RO_OL) + (size_t)it * 1024;
#pragma unroll
    for (int kt = 0; kt < 4; ++kt) {
        const bf16x8 kf = (q < 2) ? *(const LAS bf16x8*)(KAPT + (16 * kt + r16) * TS + 8 * q) : zf;
        const f32x4 wa = __builtin_amdgcn_mfma_f32_16x16x32_bf16(kf, tbf, z4, 0, 0, 0);
        *(v2u*)(gWH + r16 * 64 + 16 * kt + 4 * q) = pack4(wa);
        const f32x4 wb = __builtin_amdgcn_mfma_f32_16x16x32_bf16(tbf, kf, z4, 0, 0, 0);
        *(LAS v2u*)(WT + (16 * kt + r16) * TS + 4 * q) = pack4(wb);
        const bf16x8 vf = (q < 2) ? *(const LAS bf16x8*)(VTL + (16 * kt + r16) * TS + 8 * q) : zf;
        const f32x4 bv = __builtin_amdgcn_mfma_f32_16x16x32_bf16(blf, vf, z4, 0, 0, 0);
        *(LAS v2u*)(BVT + (16 * kt + r16) * TS + 4 * q) = pack4(bv);
    }
    LDS_WAIT(); asm volatile("" ::: "memory");
#pragma unroll
    for (int vt = 0; vt < 4; ++vt) {
        const bf16x8 bf_ = (q < 2) ? *(const LAS bf16x8*)(BVT + (16 * vt + r16) * TS + 8 * q) : zf;
        const f32x4 e4 = __builtin_amdgcn_mfma_f32_16x16x32_bf16(tbf, bf_, z4, 0, 0, 0);
        const v2u ep = pack4(e4);
        *(LAS v2u*)(ETL + (16 * vt + r16) * TS + 4 * q) = ep; *(v2u*)(gET + (16 * vt + r16) * 16 + 4 * q) = ep;
    }
    LDS_WAIT(); asm volatile("" ::: "memory");
#pragma unroll
    for (int kt = 0; kt < 4; ++kt) {
        const bf16x8 wf = (q < 2) ? *(const LAS bf16x8*)(WT + (16 * kt + r16) * TS + 8 * q) : zf;
        const f32x4 qw = __builtin_amdgcn_mfma_f32_16x16x32_bf16(wf, qlf, z4, 0, 0, 0);
        const f32x4 rt4 = unpack4(*(const LAS v2u*)(RT + r16 * XS + 16 * kt + 4 * q));
        *(v2u*)(gRH + r16 * 64 + 16 * kt + 4 * q) = pack4(rt4 - qw);
        const bf16x8 vf = (q < 2) ? *(const LAS bf16x8*)(VTL + (16 * kt + r16) * TS + 8 * q) : zf;
        const bf16x8 ef = (q < 2) ? *(const LAS bf16x8*)(ETL + (16 * kt + r16) * TS + 8 * q) : zf;
        const f32x4 pv = __builtin_amdgcn_mfma_f32_16x16x32_bf16(vf, plf, z4, 0, 0, 0);
        const f32x4 qe = __builtin_amdgcn_mfma_f32_16x16x32_bf16(ef, qlf, z4, 0, 0, 0);
        *(v2u*)(gOL + r16 * 64 + 16 * kt + 4 * q) = pack4(pv - qe);
    }
    LDS_WAIT(); asm volatile("" ::: "memory");
}
__device__ __forceinline__ void ra_part(const Ctx& F, int part) {
    LAS unsigned* ctr = (LAS unsigned*)(F.lds + LDS_BYTES - 48) + part;
    LAS unsigned char* wl = F.lds + F.wave * RL_BYTES;
    for (;;) {
        unsigned idx = 0;
        if (F.lane == 0) idx = __hip_atomic_fetch_add(ctr, 1u, __ATOMIC_RELAXED, __HIP_MEMORY_SCOPE_WORKGROUP);
        idx = (unsigned)__builtin_amdgcn_readfirstlane((int)idx);
        const int it = (int)blockIdx.x + F.G * (int)idx;
        if (it >= RITEMS) break;
        ra_item(F, wl, it, part);
    }
}

__device__ __forceinline__ void rs_half(const Ctx& F, int half) {
    if (F.wave != 0) return;
    const unsigned char* RO = (const unsigned char*)F.out + (size_t)(half & 1) * RO_BUF; bf16* OY = (bf16*)(F.ws + WS_OY);
    float* SSg = (float*)((unsigned char*)F.out + RO_SS);
    LAS bf16* ST = (LAS bf16*)F.lds;
    LAS bf16* ZT = (LAS bf16*)(F.lds + 16 * XS * 2);
    constexpr int ZS = 24;
    const int lane = F.lane, r16 = lane & 15, q = lane >> 4;
    for (int blk = blockIdx.x; blk < NB * RHEADS * 4; blk += F.G) {
        const int xcd = blk & 7, jj = blk >> 3, qt = jj & 3, bh = (jj >> 2) * 8 + xcd, b = bh >> 4, h = bh & 15;
        f32x4 S[4];
        if (half == 0) {
#pragma unroll
            for (int kt = 0; kt < 4; ++kt) S[kt] = (f32x4){0.f, 0.f, 0.f, 0.f};
        } else {
#pragma unroll
            for (int kt = 0; kt < 4; ++kt) S[kt] = *(const f32x4*)(SSg + (size_t)blk * 1024 + (kt * 64 + lane) * 4);
        }
#pragma unroll
        for (int kt = 0; kt < 4; ++kt) *(LAS v2u*)(ST + r16 * XS + 16 * kt + 4 * q) = pack4(S[kt]);
        LDS_WAIT(); asm volatile("" ::: "memory");
        const size_t it0 = (size_t)bh * RHALF;
        const size_t mbase = (size_t)b * SEQ + (size_t)half * RHALF * RC;
#define RS_LOAD(IT, WF, RF, A2F, VF, ET4, OL4, GC4) do { const size_t it_ = (IT); \
        const bf16* wh_ = (const bf16*)(RO + RO_WH) + it_ * 1024 + r16 * 64 + 8 * q; const bf16* rh_ = (const bf16*)(RO + RO_RH) + it_ * 1024 + r16 * 64 + 8 * q; \
        WF[0] = *(const bf16x8*)wh_; WF[1] = *(const bf16x8*)(wh_ + 32); RF[0] = *(const bf16x8*)rh_; RF[1] = *(const bf16x8*)(rh_ + 32); \
        _Pragma("unroll") for (int kt_ = 0; kt_ < 4; ++kt_) { A2F[kt_] = *(const bf16x8*)((const bf16*)(RO + RO_A2) + it_ * 2048 + (16 * kt_ + r16) * 32 + 8 * q); \
            GC4[kt_] = *(const f32x4*)((const float*)(RO + RO_GC) + it_ * 64 + 16 * kt_ + 4 * q); } \
        VF = *(const bf16x8*)((const bf16*)(RO + RO_VT) + it_ * 1024 + (16 * qt + r16) * 16 + 8 * (q & 1)); \
        ET4 = *(const v2u*)((const bf16*)(RO + RO_ET) + it_ * 1024 + (16 * qt + r16) * 16 + 4 * q); \
        OL4 = *(const v2u*)((const bf16*)(RO + RO_OL) + it_ * 1024 + r16 * 64 + 16 * qt + 4 * q); } while (0)
        bf16x8 wfq[2][2], rfq[2][2], a2q[2][4], vfq[2]; v2u etq[2], olq[2]; f32x4 gcq[2][4];
#pragma unroll
        for (int u = 0; u < 2; ++u) RS_LOAD(it0 + u, wfq[u], rfq[u], a2q[u], vfq[u], etq[u], olq[u], gcq[u]);
#define RS_STEP(U, CL) do { const int cl_ = (CL); \
            const bf16x8 sb0 = *(const LAS bf16x8*)(ST + r16 * XS + 8 * q), sb1 = *(const LAS bf16x8*)(ST + r16 * XS + 32 + 8 * q); \
            f32x4 x1 = __builtin_amdgcn_mfma_f32_16x16x32_bf16(wfq[U][0], sb0, (f32x4){0.f, 0.f, 0.f, 0.f}, 0, 0, 0); \
            x1 = __builtin_amdgcn_mfma_f32_16x16x32_bf16(wfq[U][1], sb1, x1, 0, 0, 0); \
            f32x4 ot = __builtin_amdgcn_mfma_f32_16x16x32_bf16(sb0, rfq[U][0], unpack4(olq[U]), 0, 0, 0); \
            ot = __builtin_amdgcn_mfma_f32_16x16x32_bf16(sb1, rfq[U][1], ot, 0, 0, 0); \
            *(LAS v2u*)(ZT + r16 * ZS + 4 * q) = pack4(x1 + unpack4(etq[U])); \
            *(v2u*)(OY + (mbase + (size_t)cl_ * RC + r16) * DM + h * 64 + 16 * qt + 4 * q) = pack4(ot); \
            LDS_WAIT(); asm volatile("" ::: "memory"); \
            const bf16x8 zr = *(const LAS bf16x8*)(ZT + r16 * ZS + 8 * (q & 1)); \
            const bf16x8 bz = (q < 2) ? zr : vfq[U]; \
            _Pragma("unroll") for (int kt = 0; kt < 4; ++kt) { S[kt] = __builtin_amdgcn_mfma_f32_16x16x32_bf16(a2q[U][kt], bz, S[kt] * gcq[U][kt], 0, 0, 0); \
                *(LAS v2u*)(ST + r16 * XS + 16 * kt + 4 * q) = pack4(S[kt]); } \
            RS_LOAD(it0 + ((cl_ + 2 < RHALF) ? cl_ + 2 : RHALF - 1), wfq[U], rfq[U], a2q[U], vfq[U], etq[U], olq[U], gcq[U]);     \
            LDS_WAIT(); asm volatile("" ::: "memory"); } while (0)
#pragma unroll 1
        for (int cl = 0; cl < RHALF; cl += 2) { RS_STEP(0, cl); RS_STEP(1, cl + 1); }
#undef RS_STEP
#undef RS_LOAD
        if (half + 1 < NPART) {
#pragma unroll
            for (int kt = 0; kt < 4; ++kt) *(f32x4*)(SSg + (size_t)blk * 1024 + (kt * 64 + lane) * 4) = S[kt];
        }
    }
}
__device__ __forceinline__ float rowmax16(float x) { x = fmaxf(x, dpp_f<0xB1>(x)); x = fmaxf(x, dpp_f<0x4E>(x)); x = fmaxf(x, dpp_f<0x124>(x)); x = fmaxf(x, dpp_f<0x128>(x)); return x; }
__device__ __forceinline__ int cand_code(int s) {
    if (s < 16) return s << 4;
    if (s < 24) return 1 | ((s - 16) << 4);
    if (s < 29) return 2 | ((s - 24) << 4);
    if (s < 33) return 3 | ((s - 29) << 4);
    if (s < 36) return 4 | ((s - 33) << 4);
    if (s < 42) { const int k = s - 36; return (5 + (k >> 1)) | ((k & 1) << 4); }
    if (s < 50) return 8 + (s - 42);
    return -1;
}
__device__ __forceinline__ int f2ord(float f) { const int b = __float_as_int(f); return b ^ ((b >> 31) & 0x7fffffff); }
__device__ __forceinline__ float ord2f(int k) { return __int_as_float(k ^ ((k >> 31) & 0x7fffffff)); }
template <int CTRL> __device__ __forceinline__ int dpp_i(int x) { return __builtin_amdgcn_mov_dpp(x, CTRL, 0xf, 0xf, true); }
__device__ __forceinline__ int imax(int a, int b) { return a > b ? a : b; }
__device__ __forceinline__ int imin(int a, int b) { return a < b ? a : b; }
__device__ __forceinline__ int rowmax16_i(int x) { x = imax(x, dpp_i<0xB1>(x)); x = imax(x, dpp_i<0x4E>(x)); x = imax(x, dpp_i<0x124>(x)); x = imax(x, dpp_i<0x128>(x)); return x; }
#define CSWAP_(a, b) do { const int hi_ = imax(a, b), lo_ = imin(a, b); a = hi_; b = lo_; } while (0)
template <int NV> __device__ __forceinline__ void sort_desc(int (&v)[NV]);
template <> __device__ __forceinline__ void sort_desc<8>(int (&v)[8]) {
    CSWAP_(v[0], v[1]); CSWAP_(v[2], v[3]); CSWAP_(v[4], v[5]); CSWAP_(v[6], v[7]);
    CSWAP_(v[0], v[2]); CSWAP_(v[1], v[3]); CSWAP_(v[4], v[6]); CSWAP_(v[5], v[7]);
    CSWAP_(v[1], v[2]); CSWAP_(v[5], v[6]);
    CSWAP_(v[0], v[4]); CSWAP_(v[1], v[5]); CSWAP_(v[2], v[6]); CSWAP_(v[3], v[7]);
    CSWAP_(v[2], v[4]); CSWAP_(v[3], v[5]);
    CSWAP_(v[1], v[2]); CSWAP_(v[3], v[4]); CSWAP_(v[5], v[6]);
}
template <> __device__ __forceinline__ void sort_desc<4>(int (&v)[4]) {
    CSWAP_(v[0], v[1]); CSWAP_(v[2], v[3]); CSWAP_(v[0], v[2]); CSWAP_(v[1], v[3]); CSWAP_(v[1], v[2]);
}
template <int NV>
__device__ __forceinline__ void select16x4(int (&v)[4][NV], int r16, float (&kept_f)[4]) {
    const int IMIN = (int)0x80000000;
    int kept[4];
#pragma unroll
    for (int j = 0; j < 4; ++j) { kept[j] = IMIN; sort_desc<NV>(v[j]); }
#pragma unroll 1
    for (int rd = 0; rd < 16; ++rd) {
#pragma unroll
        for (int j = 0; j < 4; ++j) {
            const int m = rowmax16_i(v[j][0]);
            kept[j] = (r16 == rd) ? m : kept[j];
            const bool own = (v[j][0] == m);
#pragma unroll
            for (int i = 0; i < NV - 1; ++i) v[j][i] = own ? v[j][i + 1] : v[j][i];
            v[j][NV - 1] = own ? IMIN : v[j][NV - 1];
        }
    }
#pragma unroll
    for (int j = 0; j < 4; ++j) kept_f[j] = ord2f(kept[j]);
}
__device__ __forceinline__ float dot2bf(unsigned a, unsigned b, float acc) { return __builtin_amdgcn_fdot2_f32_bf16(__builtin_bit_cast(bf16x2_t, a), __builtin_bit_cast(bf16x2_t, b), acc, false); }

constexpr int PT = 16;
constexpr size_t RANGE_BYTES = (size_t)NEXP * 128;

__device__ __forceinline__ void p9_route(const Ctx& F) {
    constexpr int KSTR = 136;
    const bf16* Q = (const bf16*)(F.ws + WS_Q); const bf16* KEYS = (const bf16*)(F.ws + WS_KEYS);
    int* rtE = (int*)(F.ws + WS_RTE); float* rtG = (float*)(F.ws + WS_RTG);
    LAS bf16* KL = (LAS bf16*)F.lds;
    const int lane = F.lane, w = F.wave, r16 = lane & 15, q = lane >> 4, gbase = lane & 48;
    const int h = blockIdx.x & 7, nbh = (F.G - h + 7) >> 3;
    __syncthreads();
    for (int i = F.tid; i < 2 * 128 * 16; i += NTHR) { const int row = i >> 4, ch = i & 15;
        *(LAS v4u*)(KL + row * KSTR + 8 * ch) = *(const v4u*)(KEYS + (size_t)(2 * h * 128 + row) * 128 + 8 * ch); }
    __syncthreads();
    int ci[4], cj[4]; bool cvalid[4];
#pragma unroll
    for (int u = 0; u < 4; ++u) { const int cd = cand_code(r16 + 16 * u); cvalid[u] = cd >= 0; ci[u] = cd & 15; cj[u] = (cd >> 4) & 15; }
    const float NINF = -__builtin_inff();
    const int tstride = nbh * NWAVES;
    int tile = (blockIdx.x >> 3) * NWAVES + w;
    bf16x8 afn[2][4];
    if (tile < M / PT) {
#pragma unroll
        for (int p = 0; p < 2; ++p)
#pragma unroll
            for (int s = 0; s < 4; ++s) afn[p][s] = *(const bf16x8*)(Q + (size_t)(tile * PT + r16) * DM + (2 * h + p) * 128 + 8 * q + 32 * s);
    }
    for (; tile < M / PT; tile += tstride) {
        const int m0 = tile * PT;
        bf16x8 af[2][4];
#pragma unroll
        for (int p = 0; p < 2; ++p)
#pragma unroll
            for (int s = 0; s < 4; ++s) af[p][s] = afn[p][s];
        { const int tn = (tile + tstride < M / PT) ? tile + tstride : tile;
#pragma unroll
            for (int p = 0; p < 2; ++p)
#pragma unroll
                for (int s = 0; s < 4; ++s) afn[p][s] = *(const bf16x8*)(Q + (size_t)(tn * PT + r16) * DM + (2 * h + p) * 128 + 8 * q + 32 * s);
        }
        float top[2][4];
#pragma unroll
        for (int p = 0; p < 2; ++p) {
            int v[4][8];
#pragma unroll
            for (int nt = 0; nt < 8; ++nt) {
                const LAS bf16* krow = KL + (p * 128 + nt * 16 + r16) * KSTR + 8 * q;
                f32x4 acc = {0.f, 0.f, 0.f, 0.f};
#pragma unroll
                for (int s = 0; s < 4; ++s) acc = __builtin_amdgcn_mfma_f32_16x16x32_bf16(af[p][s], *(const LAS bf16x8*)(krow + 32 * s), acc, 0, 0, 0);
                const unsigned tag = 127u - (unsigned)(nt * 16 + r16);
#pragma unroll
                for (int j = 0; j < 4; ++j) v[j][nt] = f2ord(__uint_as_float((__float_as_uint(acc[j]) & ~127u) | tag));
                if (nt & 1) asm volatile("" ::: "memory");
            }
            select16x4<8>(v, r16, top[p]);
        }
        int cv[4][4];
#pragma unroll
        for (int u = 0; u < 4; ++u)
#pragma unroll
            for (int j = 0; j < 4; ++j) {
                const float a = __shfl(top[0][j], gbase + ci[u]), b = __shfl(top[1][j], gbase + cj[u]);
                const float cs = __uint_as_float(__float_as_uint(a) & ~127u) + __uint_as_float(__float_as_uint(b) & ~127u);
                const float pk = __uint_as_float((__float_as_uint(cs) & ~63u) | (63u - (unsigned)(r16 + 16 * u)));
                cv[j][u] = cvalid[u] ? f2ord(pk) : (int)0x80000000;
            }
        float best[4];
        select16x4<4>(cv, r16, best);
#pragma unroll
        for (int j = 0; j < 4; ++j) {
            const unsigned bb = __float_as_uint(best[j]);
            const int cd = cand_code(63 - (int)(bb & 63u));
            const int k0 = 127 - (int)(__float_as_uint(__shfl(top[0][j], gbase + (cd & 15))) & 127u);
            const int k1 = 127 - (int)(__float_as_uint(__shfl(top[1][j], gbase + ((cd >> 4) & 15))) & 127u);
            const float s = __uint_as_float(bb & ~63u);
            const float mx = rowmax16(s), e = __expf(s - mx), sum = rowsum16(e);
            const size_t o = (size_t)(m0 + 4 * q + j) * 128 + h * 16 + r16;
            rtE[o] = k0 * 128 + k1; rtG[o] = e * rcp_f(sum);
        }
    }
}

__device__ __forceinline__ f32x2 cvt2_fp8(unsigned wd, bool hi) { return hi ? __builtin_amdgcn_cvt_pk_f32_fp8((int)wd, true) : __builtin_amdgcn_cvt_pk_f32_fp8((int)wd, false); }
__device__ __forceinline__ void treduce8x16(const float (&p)[16], bool b0, bool b1, bool b2, float& r0, float& r1) {
    float a[8], bq[4];
#pragma unroll
    for (int i = 0; i < 8; ++i) { const float mine = b2 ? p[i + 8] : p[i], send = b2 ? p[i] : p[i + 8]; const float up = dpp_f<0x104>(send), dn = dpp_f<0x114>(send); a[i] = mine + (b2 ? dn : up); }
#pragma unroll
    for (int i = 0; i < 4; ++i) { const float mine = b1 ? a[i + 4] : a[i], send = b1 ? a[i] : a[i + 4]; bq[i] = mine + dpp_f<0x4E>(send); }
    { const float mine = b0 ? bq[2] : bq[0], send = b0 ? bq[0] : bq[2]; r0 = mine + dpp_f<0xB1>(send); }
    { const float mine = b0 ? bq[3] : bq[1], send = b0 ? bq[1] : bq[3]; r1 = mine + dpp_f<0xB1>(send); }
}
struct XGroup { int xg, gwi, stride; };
__device__ __forceinline__ XGroup xgroup(const Ctx& F) { XGroup g; g.xg = blockIdx.x & 7; const int nbg = (F.G - g.xg + 7) >> 3; g.gwi = (blockIdx.x >> 3) * NWAVES + F.wave; g.stride = nbg * NWAVES; return g; }

__device__ __forceinline__ void p10_peer_u(const Ctx& F) {
    const unsigned char* PU8 = F.ws + WS_PU8; const bf16* XN = (const bf16*)(F.ws + WS_XN);
    const int* rtE = (const int*)(F.ws + WS_RTE); unsigned* PD = (unsigned*)(F.ws + WS_PD);
    const XGroup g = xgroup(F);
    const int lane = F.lane, j = lane >> 3, sub = lane & 7;
    const bool b0 = sub & 1, b1 = sub & 2, b2 = sub & 4;
    for (int rr = 0; rr < 2; ++rr) {
        const int r = g.xg + 8 * rr;
        const unsigned char* tab = PU8 + (size_t)r * RANGE_BYTES;
        const unsigned so = 16u * (unsigned)sub;
        int m = g.gwi;
        v4u ev[4], xs[2];
        if (m < M) {
#pragma unroll
            for (int i = 0; i < 4; ++i) ev[i] = *(const v4u*)(rtE + (size_t)m * 128 + 16 * j + 4 * i);
            xs[0] = *(const v4u*)(XN + (size_t)m * DM + 128 * r + 16 * sub); xs[1] = *(const v4u*)(XN + (size_t)m * DM + 128 * r + 16 * sub + 8);
        }
        for (; m < M; m += g.stride) {
            v4u gt[16];
#pragma unroll
            for (int k = 0; k < 16; ++k) gt[k] = *(const v4u*)(tab + (ev[k >> 2][k & 3] * 128u + so));
            float x[16]; { float t0[8], t1[8]; unpack8(xs[0], t0); unpack8(xs[1], t1);
#pragma unroll
              for (int i = 0; i < 8; ++i) { x[i] = t0[i]; x[8 + i] = t1[i]; } }
            const int mn = (m + g.stride < M) ? m + g.stride : m;
            {
#pragma unroll
                for (int i = 0; i < 4; ++i) ev[i] = *(const v4u*)(rtE + (size_t)mn * 128 + 16 * j + 4 * i);
                xs[0] = *(const v4u*)(XN + (size_t)mn * DM + 128 * r + 16 * sub); xs[1] = *(const v4u*)(XN + (size_t)mn * DM + 128 * r + 16 * sub + 8);
            }
            float p[16];
#pragma unroll
            for (int k = 0; k < 16; ++k) {
                f32x2 a0 = {0.f, 0.f}, a1 = {0.f, 0.f};
#pragma unroll
                for (int d = 0; d < 4; ++d) { const unsigned wd = gt[k][d];
                    a0 += cvt2_fp8(wd, false) * (f32x2){x[4 * d], x[4 * d + 1]}; a1 += cvt2_fp8(wd, true) * (f32x2){x[4 * d + 2], x[4 * d + 3]}; }
                p[k] = (a0.x + a0.y) + (a1.x + a1.y);
            }
            float r0, r1; treduce8x16(p, b0, b1, b2, r0, r1);
            PD[((size_t)r * M + m) * 64 + lane] = pk2(r0, r1);
        }
    }
}

__device__ __forceinline__ void p11_peer_coef(const Ctx& F) {
    const int* rtE = (const int*)(F.ws + WS_RTE); const float* rtG = (const float*)(F.ws + WS_RTG); const unsigned* PD = (const unsigned*)(F.ws + WS_PD);
    const float* usc = (const float*)(F.ws + WS_USC); const float* vsc = (const float*)(F.ws + WS_VSC); float* COEF = (float*)(F.ws + WS_COEF);
    for (int m = F.gw; m < M; m += F.NGW) {
        const size_t o = (size_t)m * 128 + 2 * F.lane;
        f32x2 d = {0.f, 0.f};
#pragma unroll
        for (int r = 0; r < 16; ++r) { const unsigned pw = PD[((size_t)r * M + m) * 64 + F.lane]; d += (f32x2){bflo(pw), bfhi(pw)}; }
        const int e0 = rtE[o], e1 = rtE[o + 1];
        const f32x2 gt = *(const f32x2*)(rtG + o);
        const float d0 = d.x * usc[e0], d1 = d.y * usc[e1];
        f32x2 c; c.x = gt.x * (0.5f * d0 * (1.f + erff(d0 * 0.70710678f))) * vsc[e0]; c.y = gt.y * (0.5f * d1 * (1.f + erff(d1 * 0.70710678f))) * vsc[e1];
        *(f32x2*)(COEF + o) = c;
    }
}

__device__ __forceinline__ void p12_peer_v(const Ctx& F) {
    const unsigned char* PV4 = F.ws + WS_PV8; const int* rtE = (const int*)(F.ws + WS_RTE); const float* COEF = (const float*)(F.ws + WS_COEF);
    const float* mod = (const float*)(F.ws + WS_MOD);
    const XGroup g = xgroup(F);
    const int lane = F.lane, j = lane >> 3, sub = lane & 7;
    const bool jb0 = j & 1;
    const int r = g.xg;
    const unsigned char* tab = PV4 + (size_t)r * RANGE_BYTES;
    const unsigned so = 16u * (unsigned)sub;
    int m = g.gwi;
    if (m >= M) return;
    const int st = g.stride;
#define PV_LDE(e, mm, hf) { e[0] = *(const v4u*)(rtE + (size_t)(mm) * 128 + 16 * j + 8 * (hf)); e[1] = *(const v4u*)(rtE + (size_t)(mm) * 128 + 16 * j + 8 * (hf) + 4); }
#define PV_LDC(c, mm, hf) { c[0] = *(const f32x4*)(COEF + (size_t)(mm) * 128 + 16 * j + 8 * (hf)); c[1] = *(const f32x4*)(COEF + (size_t)(mm) * 128 + 16 * j + 8 * (hf) + 4); }
#define PV_GATHER(gx, e) { _Pragma("unroll") for (int k = 0; k < 8; ++k) gx[k] = *(const v4u*)(tab + (e[k >> 2][k & 3] * 128u + so)); }
#define PV_ACC(gx, c) { _Pragma("unroll") for (int k = 0; k < 8; ++k) { const float cq = c[k >> 2][k & 3]; const f32x2 cv2 = {cq, cq}; \
        _Pragma("unroll") for (int d = 0; d < 4; ++d) { const unsigned wd = gx[k][d]; \
            acc[4 * d + 0] += cv2 * __builtin_amdgcn_cvt_scalef32_pk_f32_fp4(wd, 1.0f, 0); acc[4 * d + 1] += cv2 * __builtin_amdgcn_cvt_scalef32_pk_f32_fp4(wd, 1.0f, 1); \
            acc[4 * d + 2] += cv2 * __builtin_amdgcn_cvt_scalef32_pk_f32_fp4(wd, 1.0f, 2); acc[4 * d + 3] += cv2 * __builtin_amdgcn_cvt_scalef32_pk_f32_fp4(wd, 1.0f, 3); } } }
    v4u eA1[2], eB0[2], gA[8], gB[8]; f32x4 cA0[2], cA1[2], cB0[2];
    { v4u eA0[2]; PV_LDE(eA0, m, 0); PV_LDC(cA0, m, 0); PV_LDE(eB0, m, 1); PV_LDC(cB0, m, 1);
      const int m1 = (m + st < M) ? m + st : m; PV_LDE(eA1, m1, 0); PV_LDC(cA1, m1, 0);
      PV_GATHER(gA, eA0); }
    for (; m < M; m += st) {
        const int m1 = (m + st < M) ? m + st : m, m2 = (m + 2 * st < M) ? m + 2 * st : m;
        const int col = 256 * r + 32 * sub + 4 * j;
        v2u* orow = (v2u*)((bf16*)(F.ws + WS_HB) + (size_t)m * DM + col);
        const v2u hw = *orow; const f32x4 g2 = *(const f32x4*)(mod + (size_t)(m / SEQ) * MODW + 5 * DM + col);
        PV_GATHER(gB, eB0);
        v4u eB1[2], eA2[2]; f32x4 cB1[2], cA2[2];
        PV_LDE(eB1, m1, 1); PV_LDC(cB1, m1, 1); PV_LDE(eA2, m2, 0); PV_LDC(cA2, m2, 0);
        asm volatile("" : "+v"(gA[0]), "+v"(gA[1]), "+v"(gA[2]), "+v"(gA[3]), "+v"(gA[4]), "+v"(gA[5]), "+v"(gA[6]), "+v"(gA[7]) :: "memory");
        f32x2 acc[16];
#pragma unroll
        for (int i = 0; i < 16; ++i) acc[i] = (f32x2){0.f, 0.f};
        PV_ACC(gA, cA0);
        asm volatile("" ::: "memory");
        PV_GATHER(gA, eA1);
        asm volatile("" : "+v"(gB[0]), "+v"(gB[1]), "+v"(gB[2]), "+v"(gB[3]), "+v"(gB[4]), "+v"(gB[5]), "+v"(gB[6]), "+v"(gB[7]) :: "memory");
        PV_ACC(gB, cB0);
        float a[32];
#pragma unroll
        for (int i = 0; i < 16; ++i) { a[2 * i] = acc[i].x; a[2 * i + 1] = acc[i].y; }
        float s16[16], s8[8];
#pragma unroll
        for (int c = 0; c < 16; ++c) { auto rr2 = __builtin_amdgcn_permlane32_swap(__float_as_uint(a[c]), __float_as_uint(a[c + 16]), false, false); s16[c] = __uint_as_float(rr2[0]) + __uint_as_float(rr2[1]); }
#pragma unroll
        for (int c = 0; c < 8; ++c) { auto rr2 = __builtin_amdgcn_permlane16_swap(__float_as_uint(s16[c]), __float_as_uint(s16[c + 8]), false, false); s8[c] = __uint_as_float(rr2[0]) + __uint_as_float(rr2[1]); }
        f32x4 res;
#pragma unroll
        for (int c = 0; c < 4; ++c) { const float mine = jb0 ? s8[c + 4] : s8[c], send = jb0 ? s8[c] : s8[c + 4]; res[c] = mine + dpp_f<0x128>(send); }
        const f32x4 h1 = {bflo(hw.x), bfhi(hw.x), bflo(hw.y), bfhi(hw.y)};
        const f32x4 h2 = h1 + g2 * res;
        v2u o; o.x = pk2(h2.x, h2.y); o.y = pk2(h2.z, h2.w);
        *orow = o;
#pragma unroll
        for (int i = 0; i < 2; ++i) { cA0[i] = cA1[i]; cA1[i] = cA2[i]; eA1[i] = eA2[i]; eB0[i] = eB1[i]; cB0[i] = cB1[i]; }
    }
#undef PV_LDE
#undef PV_LDC
#undef PV_GATHER
#undef PV_ACC
}
#define XB_TMO      128
#define XB_XCNT(j)  (256  + 64 * (j))
#define XB_XSUB(j)  (1280 + 64 * (j))
#define XB_XGEN(j)  (2304 + 64 * (j))
#define XB_TOP      3328
#define XB_TOPGEN   3392
#define XCD_BAR_WORDS 3456
#define XB_SPIN_CAP (1u << 18)

__device__ __forceinline__ unsigned xb_ld(unsigned* p)              { return __hip_atomic_load(p, __ATOMIC_RELAXED, __HIP_MEMORY_SCOPE_AGENT); }
__device__ __forceinline__ unsigned xb_add(unsigned* p, unsigned v) { return __hip_atomic_fetch_add(p, v, __ATOMIC_RELAXED, __HIP_MEMORY_SCOPE_AGENT); }
__device__ __forceinline__ unsigned xb_xcc_id() { return (unsigned)__builtin_amdgcn_s_getreg((3 << 11) | 20) & 0xFu; }
#define XB_SPIN(cond, bar) do { unsigned _sp = 0; while (cond) { __builtin_amdgcn_s_sleep(1); \
    if ((++_sp & 255u) == 0u) { if (xb_ld(&(bar)[XB_TMO])) break; if (_sp > XB_SPIN_CAP) { atomicAdd(&(bar)[XB_TMO], 1u); break; } } } } while (0)

struct XcdBarrier {
    unsigned* bar; unsigned x;
    volatile LAS unsigned* st;
};

__device__ __forceinline__ XcdBarrier xcd_barrier_post(unsigned* bar, volatile LAS unsigned* st) {
    XcdBarrier b; b.bar = bar; b.x = xb_xcc_id(); b.st = st;
    if (threadIdx.x == 0) (void)xb_add(&bar[XB_XCNT(b.x)], 1u);
    return b;
}
__device__ __forceinline__ void xcd_barrier_complete(unsigned* bar, unsigned x, unsigned& nloc, unsigned& nx) {
    const unsigned G = gridDim.x * gridDim.y * gridDim.z;
    unsigned sum, cnt, mine, sp = 0u;
    for (;;) {
        sum = 0u; cnt = 0u; mine = 0u;
#pragma unroll
        for (unsigned j = 0; j < 16; ++j) { const unsigned c = xb_ld(&bar[XB_XCNT(j)]); sum += c; cnt += (c > 0u) ? 1u : 0u; mine = (j == x) ? c : mine; }
        if (sum == G) break;
        __builtin_amdgcn_s_sleep(1);
        if ((++sp & 255u) == 0u) { if (xb_ld(&bar[XB_TMO])) break; if (sp > XB_SPIN_CAP) { atomicAdd(&bar[XB_TMO], 1u); break; } }
    }
    nloc = mine > 0u ? mine : 1u; nx = cnt > 0u ? cnt : 1u;
}

__device__ __forceinline__ void xcd_barrier(const XcdBarrier& b) {
    asm volatile("s_waitcnt vmcnt(0)" ::: "memory");
    __syncthreads();
    if (threadIdx.x == 0) {
        unsigned* bar = b.bar;
        __builtin_amdgcn_s_waitcnt(0);
        unsigned nloc = b.st[0], nx = b.st[1];
        if (nloc == 0u) { xcd_barrier_complete(bar, b.x, nloc, nx); b.st[0] = nloc; b.st[1] = nx; }
        const unsigned old = xb_add(&bar[XB_XSUB(b.x)], 1u);
        const unsigned gen = old / nloc;
        if (old + 1u == (gen + 1u) * nloc) {
            __builtin_amdgcn_fence(__ATOMIC_RELEASE, "agent");
            asm volatile("s_waitcnt vmcnt(0)" ::: "memory");
            const unsigned og = xb_add(&bar[XB_TOP], 1u);
            const unsigned tg = og / nx;
            if (og + 1u == (tg + 1u) * nx) xb_add(&bar[XB_TOPGEN], 1u);
            else XB_SPIN(xb_ld(&bar[XB_TOPGEN]) == tg, bar);
            __builtin_amdgcn_fence(__ATOMIC_ACQUIRE, "agent");
            xb_add(&bar[XB_XGEN(b.x)], 1u);
            asm volatile("s_waitcnt vmcnt(0)" ::: "memory");
        } else {
            XB_SPIN(xb_ld(&bar[XB_XGEN(b.x)]) == gen, bar);
            __builtin_amdgcn_fence(__ATOMIC_ACQUIRE, "agent");
            asm volatile("s_waitcnt vmcnt(0)" ::: "memory");
        }
    }
    __syncthreads();
}

struct Args { const float* in[N_IN]; float* out; unsigned char* ws; int ph_lo, ph_hi; };
constexpr int N_PHASES = 19;

__global__ void __launch_bounds__(NTHR, 2) fwd_kernel(Args args) {
    extern __shared__ __attribute__((aligned(16))) unsigned char lds_raw[];
    cg::grid_group grid = cg::this_grid();
    Ctx F;
    F.lds = (LAS unsigned char*)lds_raw;
    F.tid = threadIdx.x; F.lane = F.tid & 63; F.wave = __builtin_amdgcn_readfirstlane(F.tid >> 6);
    F.G = gridDim.x; F.gw = blockIdx.x * NWAVES + F.wave; F.NGW = F.G * NWAVES;
    F.in = args.in; F.out = args.out; F.ws = args.ws;
    const int lo = args.ph_lo, hi = args.ph_hi;
    volatile LAS unsigned* bst = (volatile LAS unsigned*)(F.lds + LDS_BYTES - 64);
    if (F.tid < 2) bst[F.tid] = 0u;
    if (F.tid < 4) ((volatile LAS unsigned*)(F.lds + LDS_BYTES - 48))[F.tid] = 0u;
    __syncthreads();
    const XcdBarrier bar = xcd_barrier_post((unsigned*)(F.ws + WS_CTL) + 4096, bst);
#define IN(k) (lo <= (k) && (k) < hi)
#ifndef TS_A
#define TS_A -1
#define TS_B -1
#define TS_K 0.1
#endif
    unsigned long long* stamps = (unsigned long long*)(F.ws + WS_CTL + 65536);
#define STAMP(k) do { if (TS_A >= 0 && blockIdx.x == 0 && F.tid == 0) stamps[k] = __builtin_amdgcn_s_memrealtime(); } while (0)
#define REP_MASK 0
#ifndef REP_MASK
#define REP_MASK 0
#endif
#define REPS(k) for (int rep_ = 0; rep_ < 1 + ((REP_MASK >> (k)) & 1); ++rep_)
#define SEAM(k) do { if (IN(k) && IN((k) + 1)) { if ((k) == 0) grid.sync(); else xcd_barrier(bar); } } while (0)

    STAMP(0);
    if (IN(0)) REPS(0) { p0_prologue(F); }
    SEAM(0);
    STAMP(1);
    if (IN(1)) REPS(1) { norm_mod_rows(F, F.in[I_X], F.in[I_N1W], 0, DM, (bf16*)(F.ws + WS_XN)); }
    SEAM(1);
    STAMP(2);
    if (IN(2)) REPS(2) {
        pg8::Gemm g{(const pg8::bf16_t*)(F.ws + WS_XN), (const pg8::bf16_t*)(F.ws + WS_WIN), M, INPP, DM};
        pg8::StaticOrder S; S.init(M, INPP, F.G, (int)blockIdx.x);
        pg8::EpiStoreBf16 E{(pg8::bf16_t*)(F.ws + WS_PROJ), INPP};
        pg8::gemm_phase<pg8::EpiStoreBf16, pg8::StaticOrder, true, true>(F.lds, g, S, E);
    }
    SEAM(2);
#ifndef P3REP
#define P3REP 0
#endif
    STAMP(3);
    if (IN(3)) REPS(3) { p3_lora(F); STAMP(40); m1_chunk_states(F); }
    SEAM(3);
    STAMP(4);
    if (IN(4)) { m2_prefix(F); ra_part(F, 0); }
    SEAM(4);
    STAMP(5);
    if (IN(5)) { rs_half(F, 0); ra_part(F, 1); }
    SEAM(5);
    STAMP(6);
    if (IN(6)) { rs_half(F, 1); ra_part(F, 2); }
    SEAM(6);
    STAMP(7);
    if (IN(7)) { rs_half(F, 2); ra_part(F, 3); }
    SEAM(7);
    STAMP(8);
    if (IN(8)) { rs_half(F, 3); }
    STAMP(9);
    if (IN(9)) REPS(9) { m3_outputs(F); }
    SEAM(9);
    STAMP(10);
    if (IN(10)) { p5_post(F); }
    SEAM(10);
    STAMP(11);
    if (IN(11)) REPS(11) {
        pg8::Gemm g{(const pg8::bf16_t*)(F.ws + WS_OY), (const pg8::bf16_t*)(F.ws + WS_WOUT), M, DM, DM};
        pg8::StaticOrder S; S.init(M, DM, F.G, (int)blockIdx.x);
        pg8::EpiResid E{F.in[I_X], (const float*)(F.ws + WS_MOD) + 2 * DM, (pg8::bf16_t*)(F.ws + WS_HB), DM, SEQ, MODW};
        pg8::gemm_phase<pg8::EpiResid, pg8::StaticOrder, true, true>(F.lds, g, S, E);
    }
    SEAM(11);
    STAMP(12);
    if (IN(12)) REPS(12) { norm_mod_rows_bf16(F, (const bf16*)(F.ws + WS_HB), F.in[I_N2W], 3 * DM, 4 * DM, (bf16*)(F.ws + WS_XN)); }
    SEAM(12);
    STAMP(13);
    if (IN(13)) REPS(13) {
        pg8::Gemm g{(const pg8::bf16_t*)(F.ws + WS_XN), (const pg8::bf16_t*)(F.ws + WS_WQ), M, DM, DM};
        pg8::StaticOrder S; S.init(M, DM, F.G, (int)blockIdx.x);
        pg8::EpiStoreBf16 E{(pg8::bf16_t*)(F.ws + WS_Q), DM};
        pg8::gemm_phase<pg8::EpiStoreBf16, pg8::StaticOrder, true, true>(F.lds, g, S, E);
    }
    SEAM(13);
    STAMP(14);
    if (IN(14)) REPS(14) { p9_route(F); }
    SEAM(14);
    STAMP(15);
    if (IN(15)) REPS(15) { p10_peer_u(F); }
    SEAM(15);
    STAMP(16);
    if (IN(16)) REPS(16) { p11_peer_coef(F); }
    SEAM(16);
    STAMP(17);
    if (IN(17)) { p12_peer_v(F); }
    SEAM(17);
    STAMP(18);
    if (IN(18)) {
        float oscale = 1.f;
        if (TS_A >= 0) { const volatile unsigned long long* st = stamps; const float frac = (float)(st[TS_B] - st[TS_A]) / (float)(st[17] - st[0]); oscale = 1.f + (float)(TS_K) * frac; }
        final_norm_rows_bf16(F, (const bf16*)(F.ws + WS_HB), F.in[I_FNW], F.out, oscale);
    }
#undef IN
#undef SEAM
}

extern "C" void kernel_launch(void* const* d_in, const int* in_sizes, int n_in, void* d_out, int out_size, void* d_ws, size_t ws_size, hipStream_t stream) {
    static int grid = 0;
    if (grid == 0) {
        if (n_in != N_IN || in_sizes[0] != M * DM || out_size != M * DM || ws_size < WS_END2) {
            fprintf(stderr, "kernel_launch: unexpected shapes: n_in %d in0 %d out %d ws %zu (need %zu)\n", n_in, n_in > 0 ? in_sizes[0] : -1, out_size, ws_size, (size_t)WS_END2); grid = -1; return; }
        int dev = 0, cus = 0, per_cu = 0;
        if (hipGetDevice(&dev) != hipSuccess || hipDeviceGetAttribute(&cus, hipDeviceAttributeMultiprocessorCount, dev) != hipSuccess) { grid = -1; return; }
        if (hipFuncSetAttribute((const void*)fwd_kernel, hipFuncAttributeMaxDynamicSharedMemorySize, LDS_BYTES) != hipSuccess) { fprintf(stderr, "kernel_launch: hipFuncSetAttribute failed\n"); grid = -1; return; }
        if (hipOccupancyMaxActiveBlocksPerMultiprocessor(&per_cu, (const void*)fwd_kernel, NTHR, LDS_BYTES) != hipSuccess || per_cu < 1) { fprintf(stderr, "kernel_launch: occupancy query says %d blocks per CU\n", per_cu); per_cu = 1; }
        (void)hipGetLastError();
        grid = cus;
        fprintf(stderr, "kernel_launch: cus %d per_cu %d grid %d ws %zu\n", cus, per_cu, grid, ws_size);
    }
    if (grid < 0) return;
    (void)hipMemsetAsync((char*)d_ws + WS_CTL, 0, CTL_ZERO_BYTES, stream);
    Args a{};
    for (int i = 0; i < N_IN; ++i) a.in[i] = (const float*)d_in[i];
    a.out = (float*)d_out; a.ws = (unsigned char*)d_ws; a.ph_lo = 0; a.ph_hi = N_PHASES;
    void* kargs[] = {&a};
#ifndef NPASS
#define NPASS 1
#endif
    hipError_t e = hipSuccess;
    for (int pass_ = 0; pass_ < NPASS; ++pass_) {
        if (pass_ > 0) (void)hipMemsetAsync((char*)d_ws + WS_CTL, 0, CTL_ZERO_BYTES, stream);
        e = hipLaunchCooperativeKernel((const void*)fwd_kernel, dim3(grid), dim3(NTHR), kargs, LDS_BYTES, stream);
    }
    if (e != hipSuccess) fprintf(stderr, "kernel_launch: cooperative launch failed: %s (grid %d)\n", hipGetErrorString(e), grid);
}
```

```cpp
#include <hip/hip_runtime.h>
#include <hip/hip_cooperative_groups.h>
#include <cstdio>
#include <cstdint>
namespace cg = cooperative_groups;
namespace pg8 {
#define PG8_LAS __attribute__((address_space(3)))
typedef unsigned short bf16_t;
typedef short bf16x8 __attribute__((ext_vector_type(8)));
typedef float f32x4 __attribute__((ext_vector_type(4)));
typedef unsigned u32x4 __attribute__((ext_vector_type(4)));
constexpr int BM = 256, BK = 64, HALF = 128, HTB = HALF * BK * 2  , STAGE_BYTES = 8 * HTB, NXCD = 8, WGM = 8;

__host__ __device__ __forceinline__ int lds_byte(int r, int c) { const int st = (r >> 4) * 2 + (c >> 5), rr = r & 15, cc = c & 31, ob = rr * 64 + cc * 2; return st * 1024 + (ob ^ (((ob >> 9) & 1) << 5)); }
__host__ __device__ __forceinline__ void stage_rc(int b, int& R, int& C) { const int st = b / 1024, sb = b % 1024, swz = sb ^ (((sb >> 9) & 1) << 5); R = (st >> 1) * 16 + swz / 64; C = (st & 1) * 32 + (swz % 64) / 2; }
__host__ __device__ __forceinline__ int perm32(int rho) { const int n = rho >> 4, i = rho & 15; return 8 * (i >> 2) + 4 * n + (i & 3); }

struct Unit { int pm, pn; };
struct Gemm { const bf16_t* A; const bf16_t* Bt; int M, N, K; };

struct StaticOrder {
    int nM, nN, nwg, G, c;
    __host__ __device__ void init(int M, int N, int G_, int c_) { nM = M / BM; nN = N / BM; nwg = nM * nN; G = G_; c = c_; }
    __host__ __device__ bool next(int i, Unit& u) const {
        const long L = (long)i * G + c; if (L >= nwg) return false;
        int wgid = (int)L; { const int q = nwg / NXCD, r = nwg % NXCD, xcd = wgid % NXCD, off = wgid / NXCD; wgid = (xcd < r ? xcd * (q + 1) : r * (q + 1) + (xcd - r) * q) + off; }
        const int nig = WGM * nN, gid = wgid / nig, fm = gid * WGM, gsz = (nM - fm) < WGM ? (nM - fm) : WGM;
        u.pm = fm + ((wgid % nig) % gsz); u.pn = (wgid % nig) / gsz; return true;
    }
    __device__ __forceinline__ void a_ready(const Unit&) const {}
    __device__ __forceinline__ void done(const Unit&) const {}
};
__device__ __forceinline__ unsigned cvt_pk_bf16(float lo, float hi) { unsigned r; asm volatile("v_cvt_pk_bf16_f32 %0, %1, %2" : "=v"(r) : "v"(lo), "v"(hi)); return r; }
struct EpiStoreBf16 {
    static constexpr bool PERM = true, AFTER_DRAIN = false;
    bf16_t* O; int ldc;
    __device__ __forceinline__ void operator()(const f32x4 (&acc)[2][2][4][2], const Unit& u, int wr, int wc, int fr, int fq) const {
        const int row0 = u.pm * BM + wr * 64 + fr; const int col0 = u.pn * BM + wc * 32 + 8 * fq;
#pragma unroll
        for (int ai = 0; ai < 2; ++ai)
#pragma unroll
            for (int m = 0; m < 4; ++m) { bf16_t* rowp = O + (size_t)(row0 + ai * HALF + m * 16) * ldc + col0;
#pragma unroll
                for (int bj = 0; bj < 2; ++bj) { const f32x4 v0 = acc[ai][bj][m][0], v1 = acc[ai][bj][m][1];
                    u32x4 w; w.x = cvt_pk_bf16(v0[0], v0[1]); w.y = cvt_pk_bf16(v0[2], v0[3]); w.z = cvt_pk_bf16(v1[0], v1[1]); w.w = cvt_pk_bf16(v1[2], v1[3]);
                    *(u32x4*)(rowp + bj * HALF) = w; } }
    }
};
struct EpiResid {
    static constexpr bool PERM = true, AFTER_DRAIN = false;
    const float* X; const float* gate; bf16_t* O; int ldc; int rows_per_batch; int gstride;
    __device__ __forceinline__ void operator()(const f32x4 (&acc)[2][2][4][2], const Unit& u, int wr, int wc, int fr, int fq) const {
        const int row0 = u.pm * BM + wr * 64 + fr; const int col0 = u.pn * BM + wc * 32 + 8 * fq;
        const float* g = gate + (size_t)((u.pm * BM) / rows_per_batch) * gstride + col0;
        f32x4 gv[2][2];
#pragma unroll
        for (int bj = 0; bj < 2; ++bj)
#pragma unroll
            for (int n = 0; n < 2; ++n) gv[bj][n] = *(const f32x4*)(g + bj * HALF + 4 * n);
#pragma unroll
        for (int ai = 0; ai < 2; ++ai)
#pragma unroll
            for (int m = 0; m < 4; ++m) { const size_t off = (size_t)(row0 + ai * HALF + m * 16) * ldc + col0;
#pragma unroll
                for (int bj = 0; bj < 2; ++bj) { const f32x4 x0 = *(const f32x4*)(X + off + bj * HALF), x1 = *(const f32x4*)(X + off + bj * HALF + 4);
                    const f32x4 v0 = x0 + gv[bj][0] * acc[ai][bj][m][0], v1 = x1 + gv[bj][1] * acc[ai][bj][m][1];
                    u32x4 w; w.x = cvt_pk_bf16(v0[0], v0[1]); w.y = cvt_pk_bf16(v0[2], v0[3]); w.z = cvt_pk_bf16(v1[0], v1[1]); w.w = cvt_pk_bf16(v1[2], v1[3]);
                    *(u32x4*)(O + off + bj * HALF) = w; } }
    }
};
template <class Epi, class Sched, bool ALIGN_EPI = false, bool SP2 = false>
__device__ __forceinline__ void gemm_phase(PG8_LAS unsigned char* lds, const Gemm g, const Sched& S, const Epi& E) {
    const int tid = threadIdx.x, wid = __builtin_amdgcn_readfirstlane(tid >> 6), lane = tid & 63, wr = wid >> 2, wc = wid & 3, fr = lane & 15, fq = lane >> 4;
    const int K = g.K, nt = K / BK;
    unsigned voffA[2], voffB[2];
#pragma unroll
    for (int i = 0; i < 2; ++i) { int R, C; stage_rc(tid * 16 + i * 8192, R, C); const int Rb = Epi::PERM ? ((R & ~31) + perm32(R & 31)) : R;
        voffA[i] = (unsigned)(R * K + C) * 2u; voffB[i] = (unsigned)(Rb * K + C) * 2u; }
    const size_t kstep = (size_t)(BK * 2);
    const size_t hstep = (size_t)HALF * K * 2;
    const size_t tstep = 2 * hstep;
    const unsigned ldsw = (unsigned)wid * 1024u;
    const int aoff = lds_byte(wr * 64 + fr, fq * 8), boff = lds_byte(wc * 32 + fr, fq * 8);
#define PG8_SA(b, h) (((b) * 2 + (h)) * HTB)
#define PG8_SB(b, h) ((4 + (b) * 2 + (h)) * HTB)
#define PG8_STAGE(bufoff, gbase, voff) do { _Pragma("unroll") for (int _i = 0; _i < 2; ++_i) \
        __builtin_amdgcn_global_load_lds((const unsigned*)((const char*)(gbase) + (voff)[_i]), (PG8_LAS unsigned*)(lds + (bufoff) + ldsw + _i * 8192), 16, 0, 0); } while (0)
#define PG8_LDA(dst, b, h) do { _Pragma("unroll") for (int m = 0; m < 4; ++m) _Pragma("unroll") for (int k = 0; k < 2; ++k) dst[m][k] = *(const PG8_LAS bf16x8*)(lds + PG8_SA(b, h) + aoff + m * 2048 + k * 1024); } while (0)
#define PG8_LDB(dst, b, h) do { _Pragma("unroll") for (int n = 0; n < 2; ++n) _Pragma("unroll") for (int k = 0; k < 2; ++k) dst[n][k] = *(const PG8_LAS bf16x8*)(lds + PG8_SB(b, h) + boff + n * 2048 + k * 1024); } while (0)
#define PG8_MMA(ai, bj, At, Bt) do { __builtin_amdgcn_s_setprio(1); _Pragma("unroll") for (int m = 0; m < 4; ++m) _Pragma("unroll") for (int n = 0; n < 2; ++n) _Pragma("unroll") for (int k = 0; k < 2; ++k) \
        acc[ai][bj][m][n] = __builtin_amdgcn_mfma_f32_16x16x32_bf16(Bt[n][k], At[m][k], acc[ai][bj][m][n], 0, 0, 0); __builtin_amdgcn_s_setprio(0); } while (0)
#define PG8_WAIT_V(n) asm volatile("s_waitcnt vmcnt(" #n ")" ::: "memory")
#define PG8_WAIT_L(n) asm volatile("s_waitcnt lgkmcnt(" #n ")" ::: "memory")
#define PG8_BAR __builtin_amdgcn_s_barrier()
#define PG8_SCHED __builtin_amdgcn_sched_barrier(0)
    Unit cur, nxt; int ui = 0;
    if (!S.next(0, cur)) return;
    f32x4 acc[2][2][4][2];
#pragma unroll
    for (int a = 0; a < 2; ++a)
#pragma unroll
        for (int b = 0; b < 2; ++b)
#pragma unroll
            for (int m = 0; m < 4; ++m)
#pragma unroll
                for (int n = 0; n < 2; ++n) acc[a][b][m][n] = (f32x4){0.f, 0.f, 0.f, 0.f};
    bf16x8 At[4][2], B0[2][2], B1[2][2];
    const char* cA = (const char*)g.A + (size_t)cur.pm * tstep; const char* cB = (const char*)g.Bt + (size_t)cur.pn * tstep;
    S.a_ready(cur);
    if constexpr (SP2) {
        PG8_STAGE(PG8_SB(0, 0), cB, voffB); PG8_STAGE(PG8_SB(0, 1), cB + hstep, voffB); PG8_STAGE(PG8_SA(0, 0), cA, voffA); PG8_STAGE(PG8_SA(0, 1), cA + hstep, voffA);
        if (wr == 1) PG8_BAR;
        PG8_WAIT_V(2); PG8_BAR;
        PG8_STAGE(PG8_SB(1, 0), cB + kstep, voffB); PG8_STAGE(PG8_SA(1, 0), cA + kstep, voffA); PG8_STAGE(PG8_SB(1, 1), cB + hstep + kstep, voffB);
        PG8_WAIT_V(6); PG8_BAR;
    } else {
        PG8_STAGE(PG8_SB(0, 0), cB, voffB); PG8_STAGE(PG8_SA(0, 0), cA, voffA); PG8_STAGE(PG8_SB(0, 1), cB + hstep, voffB); PG8_STAGE(PG8_SA(0, 1), cA + hstep, voffA);
        if (wr == 1) PG8_BAR;
        PG8_WAIT_V(4); PG8_BAR;
        PG8_STAGE(PG8_SB(1, 0), cB + kstep, voffB); PG8_STAGE(PG8_SA(1, 0), cA + kstep, voffA); PG8_STAGE(PG8_SB(1, 1), cB + hstep + kstep, voffB);
        PG8_WAIT_V(6); PG8_BAR;
    }
    for (;;) {
        const bool has_next = S.next(ui + 1, nxt);
        const char* nA = has_next ? (const char*)g.A + (size_t)nxt.pm * tstep : cA; const char* nB = has_next ? (const char*)g.Bt + (size_t)nxt.pn * tstep : cB;
        for (int t = 0; t < nt; t += 2) {
            const bool last = (t == nt - 2);
            const char* a1 = cA + (size_t)(t + 1) * kstep;
            const char* a2 = last ? nA : cA + (size_t)(t + 2) * kstep; const char* b2 = last ? nB : cB + (size_t)(t + 2) * kstep;
            const char* a3 = a2 + kstep; const char* b3 = b2 + kstep;
            if (last && has_next) S.a_ready(nxt);
            if constexpr (SP2) {
            PG8_LDB(B0, 0, 0); PG8_LDB(B1, 0, 1); PG8_SCHED; PG8_LDA(At, 0, 0); PG8_STAGE(PG8_SA(1, 1), a1 + hstep, voffA);
            PG8_WAIT_V(8); PG8_WAIT_L(0); PG8_BAR; PG8_MMA(0, 0, At, B0); PG8_MMA(0, 1, At, B1); PG8_BAR; PG8_SCHED;
            PG8_LDA(At, 0, 1); PG8_STAGE(PG8_SB(0, 0), b2, voffB); PG8_STAGE(PG8_SB(0, 1), b2 + hstep, voffB); PG8_STAGE(PG8_SA(0, 0), a2, voffA);
            PG8_WAIT_V(8); PG8_WAIT_L(0); PG8_BAR; PG8_MMA(1, 0, At, B0); PG8_MMA(1, 1, At, B1); PG8_BAR; PG8_SCHED;
            PG8_LDB(B0, 1, 0); PG8_LDB(B1, 1, 1); PG8_SCHED; PG8_LDA(At, 1, 0); PG8_STAGE(PG8_SA(0, 1), a2 + hstep, voffA);
            PG8_WAIT_V(8); PG8_WAIT_L(0); PG8_BAR; PG8_MMA(0, 0, At, B0); PG8_MMA(0, 1, At, B1); PG8_BAR; PG8_SCHED;
            PG8_LDA(At, 1, 1); PG8_STAGE(PG8_SB(1, 0), b3, voffB); PG8_STAGE(PG8_SB(1, 1), b3 + hstep, voffB); PG8_STAGE(PG8_SA(1, 0), a3, voffA);
            PG8_WAIT_V(8); PG8_WAIT_L(0); PG8_BAR; PG8_MMA(1, 0, At, B0); PG8_MMA(1, 1, At, B1); PG8_BAR; PG8_SCHED;
            } else {
            PG8_LDB(B0, 0, 0); PG8_SCHED; PG8_LDA(At, 0, 0); PG8_STAGE(PG8_SA(1, 1), a1 + hstep, voffA);
            PG8_WAIT_L(8); PG8_BAR; PG8_WAIT_L(0); PG8_MMA(0, 0, At, B0); PG8_BAR; PG8_SCHED;
            PG8_LDB(B1, 0, 1); PG8_STAGE(PG8_SB(0, 0), b2, voffB);
            PG8_BAR; PG8_WAIT_L(0); PG8_MMA(0, 1, At, B1); PG8_BAR;
            PG8_LDA(At, 0, 1); PG8_STAGE(PG8_SA(0, 0), a2, voffA);
            PG8_BAR; PG8_WAIT_L(0); PG8_MMA(1, 0, At, B0); PG8_BAR; PG8_SCHED;
            PG8_STAGE(PG8_SB(0, 1), b2 + hstep, voffB);
            PG8_WAIT_V(6); PG8_BAR; PG8_MMA(1, 1, At, B1); PG8_BAR;
            PG8_LDB(B0, 1, 0); PG8_SCHED; PG8_LDA(At, 1, 0); PG8_STAGE(PG8_SA(0, 1), a2 + hstep, voffA);
            PG8_WAIT_L(8); PG8_BAR; PG8_WAIT_L(0); PG8_MMA(0, 0, At, B0); PG8_BAR; PG8_SCHED;
            PG8_LDB(B1, 1, 1); PG8_STAGE(PG8_SB(1, 0), b3, voffB);
            PG8_BAR; PG8_WAIT_L(0); PG8_MMA(0, 1, At, B1); PG8_BAR;
            PG8_LDA(At, 1, 1); PG8_STAGE(PG8_SA(1, 0), a3, voffA);
            PG8_BAR; PG8_WAIT_L(0); PG8_MMA(1, 0, At, B0); PG8_BAR; PG8_SCHED;
            PG8_STAGE(PG8_SB(1, 1), b3 + hstep, voffB);
            PG8_WAIT_V(6); PG8_BAR; PG8_MMA(1, 1, At, B1); PG8_BAR;
            }
        }
        if constexpr (ALIGN_EPI) { if (wr == 0) PG8_BAR; }
        if constexpr (!Epi::AFTER_DRAIN) { E(acc, cur, wr, wc, fr, fq); S.done(cur); }
        if (!has_next) break;
#pragma unroll
        for (int a = 0; a < 2; ++a)
#pragma unroll
            for (int b = 0; b < 2; ++b)
#pragma unroll
                for (int m = 0; m < 4; ++m)
#pragma unroll
                    for (int n = 0; n < 2; ++n) acc[a][b][m][n] = (f32x4){0.f, 0.f, 0.f, 0.f};
        cur = nxt; cA = nA; cB = nB; ++ui;
        if constexpr (ALIGN_EPI) { if (wr == 1) PG8_BAR; }
    }
    PG8_WAIT_V(0);
    if constexpr (!ALIGN_EPI) { if (wr == 0) PG8_BAR; }
    PG8_BAR;
    if constexpr (Epi::AFTER_DRAIN) { E.fused(acc, cur, wr, wc, fr, fq, lds, wid, lane); S.done(cur); }
#undef PG8_SA
#undef PG8_SB
#undef PG8_STAGE
#undef PG8_LDA
#undef PG8_LDB
#undef PG8_MMA
#undef PG8_WAIT_V
#undef PG8_WAIT_L
#undef PG8_BAR
#undef PG8_SCHED
}
}
#define GAS __attribute__((address_space(1)))
#define LAS __attribute__((address_space(3)))
typedef unsigned short bf16;
typedef unsigned v4u __attribute__((ext_vector_type(4)));
typedef unsigned v2u __attribute__((ext_vector_type(2)));
typedef float f32x4 __attribute__((ext_vector_type(4)));
typedef float f32x2 __attribute__((ext_vector_type(2)));
typedef short bf16x8 __attribute__((ext_vector_type(8)));
typedef __bf16 bf16x2_t __attribute__((ext_vector_type(2)));

constexpr int NWAVES = 8, NTHR = 512;
constexpr int DM = 2048, NB = 4, SEQ = 8192, M = NB * SEQ;
constexpr int RW = 1024, RHEADS = 16, HD = 64;
constexpr int L_W = 64, L_A = 64, L_G = 160;
constexpr int INP = 5936, INPP = 6144;
constexpr int C_R = 0, C_K = 1024, C_V = 2048, C_WD = 3072, C_AD = 3136, C_GD = 3200, C_Z = 3360, C_XBC = 4384, C_DT = 5920;
constexpr int MODW = 6 * DM;
constexpr int NEXP = 16384;
constexpr float RMS_EPS = 1e-6f;

enum { I_X = 0, I_C, I_ADAW, I_ADAB, I_N1W, I_WIN, I_MU, I_W0, I_WUP, I_A0, I_AUP, I_GUP, I_KK, I_KA, I_RK, I_LNW, I_LNB,
       I_CONVW, I_CONVB, I_DTB, I_ALOG, I_DSK, I_MNW, I_WOUT, I_N2W, I_WQ, I_KEYS, I_PU, I_PV, I_FNW, N_IN };

constexpr size_t MiB = 1u << 20;
constexpr size_t WS_CTL = 0, CTL_ZERO_BYTES = 1 * MiB;
constexpr size_t WS_MOD = 1 * MiB;
constexpr size_t WS_WIN = 2 * MiB, WS_WOUT = 26 * MiB, WS_WQ = 34 * MiB, WS_KEYS = 42 * MiB;
constexpr size_t WS_WUPT = 43 * MiB, WS_AUPT = 43 * MiB + 256 * 1024, WS_GUPT = 43 * MiB + 512 * 1024;
constexpr size_t WS_PU8 = 44 * MiB, WS_PV8 = 76 * MiB;
constexpr size_t WS_USC = 108 * MiB, WS_VSC = 108 * MiB + 65536;
constexpr size_t WS_XN = 172 * MiB;
constexpr size_t WS_LW = WS_XN, WS_AA = WS_XN + 64 * MiB;
constexpr size_t WS_PROJ = 300 * MiB;
constexpr size_t WS_Q = WS_PROJ;
constexpr size_t WS_GG = 684 * MiB;
constexpr size_t WS_PD = WS_PROJ + 128 * MiB;
constexpr size_t WS_RTE = 684 * MiB, WS_RTG = 700 * MiB, WS_COEF = 716 * MiB;
constexpr size_t WS_OY = 748 * MiB;
constexpr size_t WS_END = 876 * MiB;
constexpr size_t WS_HB = 876 * MiB;

constexpr int RING_BYTES = 131072, LDS_BYTES = 147456;

#define LDS_WAIT() asm volatile("s_waitcnt lgkmcnt(0)" ::: "memory")
#define VM_WAIT() asm volatile("s_waitcnt vmcnt(0)" ::: "memory")
__device__ __forceinline__ unsigned pk2(float lo, float hi) { f32x2 v = {lo, hi}; bf16x2_t b = __builtin_convertvector(v, bf16x2_t); return __builtin_bit_cast(unsigned, b); }
__device__ __forceinline__ float bflo(unsigned u) { return __uint_as_float(u << 16); }
__device__ __forceinline__ float bfhi(unsigned u) { return __uint_as_float(u & 0xffff0000u); }
__device__ __forceinline__ float bf1(bf16 h) { return __uint_as_float((unsigned)h << 16); }
__device__ __forceinline__ float wave_sum(float v) {
#pragma unroll
    for (int o = 1; o < 64; o <<= 1) v += __shfl_xor(v, o);
    return v;
}
__device__ __forceinline__ float rcp_f(float v) { return __builtin_amdgcn_rcpf(v); }
template <int CTRL> __device__ __forceinline__ float dppc_f(float x) { return __builtin_bit_cast(float, __builtin_amdgcn_mov_dpp(__builtin_bit_cast(int, x), CTRL, 0xf, 0xf, true)); }
__device__ __forceinline__ float wave_sum_fast(float x) {
    x += dppc_f<0xB1>(x); x += dppc_f<0x4E>(x); x += dppc_f<0x124>(x); x += dppc_f<0x128>(x);
    { auto rr = __builtin_amdgcn_permlane16_swap(__float_as_uint(x), __float_as_uint(x), false, false); x = __uint_as_float(rr[0]) + __uint_as_float(rr[1]); }
    { auto rr = __builtin_amdgcn_permlane32_swap(__float_as_uint(x), __float_as_uint(x), false, false); x = __uint_as_float(rr[0]) + __uint_as_float(rr[1]); }
    return x;
}
__device__ __forceinline__ float silu_f(float v) { return v * rcp_f(1.f + __expf(-v)); }
__device__ __forceinline__ float sigmoid_f(float v) { return rcp_f(1.f + __expf(-v)); }

struct Ctx {
    LAS unsigned char* lds;
    int tid, lane, wave, G, gw, NGW;
    const float* const* in;
    float* out; unsigned char* ws;
};

__device__ __forceinline__ void transpose_item(const float* W, int K, int N, bf16* WT, int ldt, int nrows_out, LAS float* scr, int kb, int nb, int lane) {
    const int k0 = 64 * kb, n0 = 64 * nb;
    const int c4 = 4 * (lane & 15), rr = lane >> 4;
    const bool vec_ok = ((N & 3) == 0) && (n0 + 64 <= N);
#pragma unroll 4
    for (int i = 0; i < 16; ++i) { const int kk = 4 * i + rr, k = k0 + kk;
        f32x4 v = {0.f, 0.f, 0.f, 0.f};
        if (k < K) { const float* src = W + (size_t)k * N + n0 + c4;
            if (vec_ok) v = *(const f32x4*)src;
            else { if (n0 + c4 + 0 < N) v.x = src[0]; if (n0 + c4 + 1 < N) v.y = src[1]; if (n0 + c4 + 2 < N) v.z = src[2]; if (n0 + c4 + 3 < N) v.w = src[3]; } }
        LAS float* d = scr + kk * 65 + c4; d[0] = v.x; d[1] = v.y; d[2] = v.z; d[3] = v.w; }
    LDS_WAIT(); asm volatile("" ::: "memory");
    const int c = lane & 7;
#pragma unroll
    for (int j = 0; j < 8; ++j) { const int n = (lane >> 3) + 8 * j; const LAS float* sp = scr + (8 * c) * 65 + n;
        v4u o; o.x = pk2(sp[0 * 65], sp[1 * 65]); o.y = pk2(sp[2 * 65], sp[3 * 65]); o.z = pk2(sp[4 * 65], sp[5 * 65]); o.w = pk2(sp[6 * 65], sp[7 * 65]);
        if (n0 + n < nrows_out && k0 + 8 * c + 8 <= ldt) *(v4u*)(WT + (size_t)(n0 + n) * ldt + k0 + 8 * c) = o; }
    LDS_WAIT(); asm volatile("" ::: "memory");
}
__device__ __forceinline__ void transpose_all(const float* W, int K, int N, bf16* WT, int ldt, int nrows_out, LAS float* scr, int gw, int NGW, int lane) {
    const int nkb = (K + 63) / 64, nnb = nrows_out / 64, nit = nkb * nnb;
    for (int it = gw; it < nit; it += NGW) transpose_item(W, K, N, WT, ldt, nrows_out, scr, it / nnb, it % nnb, lane);
}
__device__ __forceinline__ void convert_all(const float* src, bf16* dst, size_t n8, int gw, int NGW, int lane) {
    const f32x4* s4 = (const f32x4*)src; v4u* d4 = (v4u*)dst;
    for (size_t i = (size_t)gw * 64 + lane; i < n8; i += (size_t)NGW * 64) {
        const f32x4 a = __builtin_nontemporal_load(s4 + 2 * i), b = __builtin_nontemporal_load(s4 + 2 * i + 1);
        v4u o; o.x = pk2(a.x, a.y); o.y = pk2(a.z, a.w); o.z = pk2(b.x, b.y); o.w = pk2(b.z, b.w);
        d4[i] = o; }
}
__device__ __forceinline__ void quantize_rows_fp8(const float* src, unsigned char* dst8, float* scales, int e0, int e1, int step, int lane) {
    if (e0 >= e1) return;
    f32x4 vn[8];
    { const f32x4* s4 = (const f32x4*)(src + (size_t)e0 * DM) + lane;
#pragma unroll
      for (int i = 0; i < 8; ++i) vn[i] = __builtin_nontemporal_load(s4 + 64 * i); }
    for (int e = e0; e < e1; e += step) {
        f32x4 v[8];
#pragma unroll
        for (int i = 0; i < 8; ++i) v[i] = vn[i];
        { const int en = (e + step < e1) ? e + step : e; const f32x4* s4 = (const f32x4*)(src + (size_t)en * DM) + lane;
#pragma unroll
          for (int i = 0; i < 8; ++i) vn[i] = __builtin_nontemporal_load(s4 + 64 * i); }
        float am = 0.f;
#pragma unroll
        for (int i = 0; i < 8; ++i) am = fmaxf(fmaxf(am, fmaxf(fabsf(v[i].x), fabsf(v[i].y))), fmaxf(fabsf(v[i].z), fabsf(v[i].w)));
#pragma unroll
        for (int o = 1; o < 64; o <<= 1) am = fmaxf(am, __shfl_xor(am, o));
        am = fmaxf(am, 1e-30f);
        const float inv = 440.f / am;
#pragma unroll
        for (int i = 0; i < 8; ++i) { int w = __builtin_amdgcn_cvt_pk_fp8_f32(v[i].x * inv, v[i].y * inv, 0, false); w = __builtin_amdgcn_cvt_pk_fp8_f32(v[i].z * inv, v[i].w * inv, w, true);
            const int seg = 2 * i + (lane >> 5);
            *(int*)(dst8 + (size_t)seg * ((size_t)NEXP * 128) + (size_t)e * 128 + 4 * (lane & 31)) = w; }
        if (lane == 0) scales[e] = am * (1.f / 440.f);
    }
}
__device__ __forceinline__ void quantize_rows_fp4(const float* src, unsigned char* dst4, float* scales, int e0, int e1, int step, int lane) {
    if (e0 >= e1) return;
    f32x4 vn[8];
    { const f32x4* s4 = (const f32x4*)(src + (size_t)e0 * DM) + lane;
#pragma unroll
      for (int i = 0; i < 8; ++i) vn[i] = __builtin_nontemporal_load(s4 + 64 * i); }
    for (int e = e0; e < e1; e += step) {
        f32x4 v[8];
#pragma unroll
        for (int i = 0; i < 8; ++i) v[i] = vn[i];
        { const int en = (e + step < e1) ? e + step : e; const f32x4* s4 = (const f32x4*)(src + (size_t)en * DM) + lane;
#pragma unroll
          for (int i = 0; i < 8; ++i) vn[i] = __builtin_nontemporal_load(s4 + 64 * i); }
        float am = 0.f;
#pragma unroll
        for (int i = 0; i < 8; ++i) am = fmaxf(am, fmaxf(fmaxf(fabsf(v[i].x), fabsf(v[i].y)), fmaxf(fabsf(v[i].z), fabsf(v[i].w))));
#pragma unroll
        for (int o = 1; o < 64; o <<= 1) am = fmaxf(am, __shfl_xor(am, o));
        am = fmaxf(am, 1e-30f);
        const float inv = 6.f / am;
#pragma unroll
        for (int i = 0; i < 8; ++i) {
            unsigned w = __builtin_amdgcn_cvt_scalef32_pk_fp4_f32(0u, v[i].x * inv, v[i].y * inv, 1.0f, 0);
            w = __builtin_amdgcn_cvt_scalef32_pk_fp4_f32(w, v[i].z * inv, v[i].w * inv, 1.0f, 1);
            *(unsigned short*)(dst4 + (size_t)i * ((size_t)NEXP * 128) + (size_t)e * 128 + 2 * lane) = (unsigned short)w;
        }
        if (lane == 0) scales[e] = am * (1.f / 6.f);
    }
}
__device__ __forceinline__ void p0_prologue(const Ctx& F) {
    __syncthreads();
    if (blockIdx.x < MODW / 64) {
        LAS float* sc = (LAS float*)F.lds;
        LAS float* red = sc + NB * DM;
        const float* c = F.in[I_C];
        for (int i = F.tid; i < NB * DM; i += NTHR) sc[i] = silu_f(c[i]);
        __syncthreads();
        const int j = blockIdx.x * 64 + F.lane;
        const float* wp = F.in[I_ADAW] + (size_t)(F.wave * 256) * MODW + j;
        float a0 = 0.f, a1 = 0.f, a2 = 0.f, a3 = 0.f;
#pragma unroll 32
        for (int kk = 0; kk < 256; ++kk) { const float w = wp[(size_t)kk * MODW]; const int k = F.wave * 256 + kk;
            a0 += sc[k] * w; a1 += sc[DM + k] * w; a2 += sc[2 * DM + k] * w; a3 += sc[3 * DM + k] * w; }
        red[(F.wave * 4 + 0) * 64 + F.lane] = a0; red[(F.wave * 4 + 1) * 64 + F.lane] = a1; red[(F.wave * 4 + 2) * 64 + F.lane] = a2; red[(F.wave * 4 + 3) * 64 + F.lane] = a3;
        __syncthreads();
        if (F.tid < 256) { const int b = F.tid >> 6, l = F.tid & 63; float s = F.in[I_ADAB][blockIdx.x * 64 + l];
#pragma unroll
            for (int w = 0; w < 8; ++w) s += red[(w * 4 + b) * 64 + l];
            ((float*)(F.ws + WS_MOD))[b * MODW + blockIdx.x * 64 + l] = s; }
        __syncthreads();
    }
    LAS float* scr = (LAS float*)(F.lds + F.wave * 16640);
    transpose_all(F.in[I_WIN], DM, INP, (bf16*)(F.ws + WS_WIN), DM, INPP, scr, F.gw, F.NGW, F.lane);
    transpose_all(F.in[I_WOUT], DM, DM, (bf16*)(F.ws + WS_WOUT), DM, DM, scr, F.gw, F.NGW, F.lane);
    transpose_all(F.in[I_WQ], DM, DM, (bf16*)(F.ws + WS_WQ), DM, DM, scr, F.gw, F.NGW, F.lane);
    transpose_all(F.in[I_WUP], L_W, RW, (bf16*)(F.ws + WS_WUPT), L_W, RW, scr, F.gw, F.NGW, F.lane);
    transpose_all(F.in[I_AUP], L_A, RW, (bf16*)(F.ws + WS_AUPT), L_A, RW, scr, F.gw, F.NGW, F.lane);
    transpose_all(F.in[I_GUP], L_G, RW, (bf16*)(F.ws + WS_GUPT), L_G, RW, scr, F.gw, F.NGW, F.lane);
    convert_all(F.in[I_KEYS], (bf16*)(F.ws + WS_KEYS), (size_t)16 * 128 * 128 / 8, F.gw, F.NGW, F.lane);
    {
        const int nlo = (F.G < 192) ? F.G : 192, nhi = F.G - nlo;
        const int wtot = 5 * nlo + 8 * nhi;
        const int wb0 = (blockIdx.x < nlo) ? 5 * blockIdx.x : 5 * nlo + 8 * (blockIdx.x - nlo), wb1 = wb0 + ((blockIdx.x < nlo) ? 5 : 8);
        const int r0 = (int)((long)(2 * NEXP) * wb0 / wtot), r1 = (int)((long)(2 * NEXP) * wb1 / wtot);
        const int a0 = r0 < NEXP ? r0 : NEXP, a1 = r1 < NEXP ? r1 : NEXP;
        quantize_rows_fp8(F.in[I_PU], F.ws + WS_PU8, (float*)(F.ws + WS_USC), a0 + F.wave, a1, NWAVES, F.lane);
        const int b0 = (r0 > NEXP ? r0 : NEXP) - NEXP, b1 = (r1 > NEXP ? r1 : NEXP) - NEXP;
        quantize_rows_fp4(F.in[I_PV], F.ws + WS_PV8, (float*)(F.ws + WS_VSC), b0 + F.wave, b1, NWAVES, F.lane);
    }
}

__device__ __forceinline__ void norm_mod_rows(const Ctx& F, const float* X, const float* nw, int shift_off, int scale_off, bf16* XN) {
    const float* mod = (const float*)(F.ws + WS_MOD);
    if (F.gw >= M) return;
    f32x4 vn[8];
    { const f32x4* xr = (const f32x4*)(X + (size_t)F.gw * DM) + F.lane;
#pragma unroll
      for (int j = 0; j < 8; ++j) vn[j] = xr[64 * j]; }
    for (int m = F.gw; m < M; m += F.NGW) {
        const int b = m / SEQ;
        f32x4 v[8]; float s = 0.f;
#pragma unroll
        for (int j = 0; j < 8; ++j) { v[j] = vn[j]; s += (v[j].x * v[j].x + v[j].y * v[j].y) + (v[j].z * v[j].z + v[j].w * v[j].w); }
        { const int mn = (m + F.NGW < M) ? m + F.NGW : m; const f32x4* xr = (const f32x4*)(X + (size_t)mn * DM) + F.lane;
#pragma unroll
          for (int j = 0; j < 8; ++j) vn[j] = xr[64 * j]; }
        const float rstd = rsqrtf(wave_sum_fast(s) * (1.f / DM) + RMS_EPS);
        const f32x4* wp = (const f32x4*)nw + F.lane;
        const f32x4* shp = (const f32x4*)(mod + (size_t)b * MODW + shift_off) + F.lane;
        const f32x4* scp = (const f32x4*)(mod + (size_t)b * MODW + scale_off) + F.lane;
        v2u* o = (v2u*)(XN + (size_t)m * DM) + F.lane;
#pragma unroll
        for (int j = 0; j < 8; ++j) { const f32x4 w = wp[64 * j], a = scp[64 * j], c = shp[64 * j];
            const f32x4 r = (v[j] * rstd) * w * (a + 1.f) + c;
            v2u p; p.x = pk2(r.x, r.y); p.y = pk2(r.z, r.w); o[64 * j] = p; }
    }
}
__device__ __forceinline__ void final_norm_rows(const Ctx& F, const float* H, const float* nw, float* O) {
    for (int m = F.gw; m < M; m += F.NGW) {
        const f32x4* xr = (const f32x4*)(H + (size_t)m * DM) + F.lane;
        f32x4 v[8]; float s = 0.f;
#pragma unroll
        for (int j = 0; j < 8; ++j) { v[j] = xr[64 * j]; s += (v[j].x * v[j].x + v[j].y * v[j].y) + (v[j].z * v[j].z + v[j].w * v[j].w); }
        const float rstd = rsqrtf(wave_sum(s) * (1.f / DM) + RMS_EPS);
        const f32x4* wp = (const f32x4*)nw + F.lane;
        f32x4* o = (f32x4*)(O + (size_t)m * DM) + F.lane;
#pragma unroll
        for (int j = 0; j < 8; ++j) o[64 * j] = (v[j] * rstd) * wp[64 * j];
    }
}


__device__ __forceinline__ void load_row_raw(const bf16* row, int lane, v2u (&u)[8]) {
    const v2u* p = (const v2u*)row + lane;
#pragma unroll
    for (int j = 0; j < 8; ++j) u[j] = p[64 * j];
}
__device__ __forceinline__ void norm_mod_rows_bf16(const Ctx& F, const bf16* X, const float* nw, int shift_off, int scale_off, bf16* XN) {
    const float* mod = (const float*)(F.ws + WS_MOD);
    if (F.gw >= M) return;
    v2u un[8]; load_row_raw(X + (size_t)F.gw * DM, F.lane, un);
    for (int m = F.gw; m < M; m += F.NGW) {
        const int b = m / SEQ;
        f32x4 v[8]; float s = 0.f;
#pragma unroll
        for (int j = 0; j < 8; ++j) { v[j] = (f32x4){bflo(un[j].x), bfhi(un[j].x), bflo(un[j].y), bfhi(un[j].y)}; s += (v[j].x * v[j].x + v[j].y * v[j].y) + (v[j].z * v[j].z + v[j].w * v[j].w); }
        { const int mn = (m + F.NGW < M) ? m + F.NGW : m; load_row_raw(X + (size_t)mn * DM, F.lane, un); }
        const float rstd = rsqrtf(wave_sum_fast(s) * (1.f / DM) + RMS_EPS);
        const f32x4* wp = (const f32x4*)nw + F.lane;
        const f32x4* shp = (const f32x4*)(mod + (size_t)b * MODW + shift_off) + F.lane;
        const f32x4* scp = (const f32x4*)(mod + (size_t)b * MODW + scale_off) + F.lane;
        v2u* o = (v2u*)(XN + (size_t)m * DM) + F.lane;
#pragma unroll
        for (int j = 0; j < 8; ++j) { const f32x4 w = wp[64 * j], a = scp[64 * j], c = shp[64 * j];
            const f32x4 r = (v[j] * rstd) * w * (a + 1.f) + c;
            v2u p; p.x = pk2(r.x, r.y); p.y = pk2(r.z, r.w); o[64 * j] = p; }
    }
}
__device__ __forceinline__ void final_norm_rows_bf16(const Ctx& F, const bf16* H, const float* nw, float* O, float oscale) {
    if (F.gw >= M) return;
    v2u un[8]; load_row_raw(H + (size_t)F.gw * DM, F.lane, un);
    f32x4 wv[8];
#pragma unroll
    for (int j = 0; j < 8; ++j) wv[j] = ((const f32x4*)nw + F.lane)[64 * j];
    for (int m = F.gw; m < M; m += F.NGW) {
        f32x4 v[8]; float s = 0.f;
#pragma unroll
        for (int j = 0; j < 8; ++j) { v[j] = (f32x4){bflo(un[j].x), bfhi(un[j].x), bflo(un[j].y), bfhi(un[j].y)}; s += (v[j].x * v[j].x + v[j].y * v[j].y) + (v[j].z * v[j].z + v[j].w * v[j].w); }
        { const int mn = (m + F.NGW < M) ? m + F.NGW : m; load_row_raw(H + (size_t)mn * DM, F.lane, un); }
        const float rstd = rsqrtf(wave_sum_fast(s) * (1.f / DM) + RMS_EPS) * oscale;
        f32x4* o = (f32x4*)(O + (size_t)m * DM) + F.lane;
#pragma unroll
        for (int j = 0; j < 8; ++j) __builtin_nontemporal_store((v[j] * rstd) * wv[j], o + 64 * j);
    }
}
#define LO2(v) __builtin_shufflevector((v), (v), 0, 1)
#define HI2(v) __builtin_shufflevector((v), (v), 2, 3)
template <int CTRL> __device__ __forceinline__ float dpp_f(float x) { return __builtin_bit_cast(float, __builtin_amdgcn_mov_dpp(__builtin_bit_cast(int, x), CTRL, 0xf, 0xf, true)); }
__device__ __forceinline__ float rowsum16(float x) { x += dpp_f<0xB1>(x); x += dpp_f<0x4E>(x); x += dpp_f<0x124>(x); x += dpp_f<0x128>(x); return x; }
__device__ __forceinline__ float quadsum(float x) { x += dpp_f<0xB1>(x); x += dpp_f<0x4E>(x); return x; }

__device__ __forceinline__ float treduce16(const float (&p)[16], bool b0, bool b1, bool b2, bool b3) {
    float a[8], bq[4], c2[2];
#pragma unroll
    for (int j = 0; j < 8; ++j) { const float mine = b3 ? p[j + 8] : p[j], send = b3 ? p[j] : p[j + 8]; a[j] = mine + dpp_f<0x128>(send); }
#pragma unroll
    for (int j = 0; j < 4; ++j) { const float mine = b2 ? a[j + 4] : a[j], send = b2 ? a[j] : a[j + 4]; const float up = dpp_f<0x104>(send), dn = dpp_f<0x114>(send); bq[j] = mine + (b2 ? dn : up); }
#pragma unroll
    for (int j = 0; j < 2; ++j) { const float mine = b1 ? bq[j + 2] : bq[j], send = b1 ? bq[j] : bq[j + 2]; c2[j] = mine + dpp_f<0x4E>(send); }
    const float mine = b0 ? c2[1] : c2[0], send = b0 ? c2[0] : c2[1];
    return mine + dpp_f<0xB1>(send);
}
__device__ __forceinline__ float wave_sum_dpp(float v) { v = rowsum16(v); v += __shfl_xor(v, 16); v += __shfl_xor(v, 32); return v; }
__device__ __forceinline__ void unpack8(const v4u p, float (&e)[8]) { e[0] = bflo(p.x); e[1] = bfhi(p.x); e[2] = bflo(p.y); e[3] = bfhi(p.y); e[4] = bflo(p.z); e[5] = bfhi(p.z); e[6] = bflo(p.w); e[7] = bfhi(p.w); }
__device__ __forceinline__ v4u pack8(const float (&e)[8]) { v4u o; o.x = pk2(e[0], e[1]); o.y = pk2(e[2], e[3]); o.z = pk2(e[4], e[5]); o.w = pk2(e[6], e[7]); return o; }

__device__ __forceinline__ void p3_lora(const Ctx& F) {
    const bf16* PROJ = (const bf16*)(F.ws + WS_PROJ);
    const bf16* WUPT = (const bf16*)(F.ws + WS_WUPT); const bf16* AUPT = (const bf16*)(F.ws + WS_AUPT); const bf16* GUPT = (const bf16*)(F.ws + WS_GUPT);
    bf16* LW = (bf16*)(F.ws + WS_LW); bf16* AA = (bf16*)(F.ws + WS_AA); bf16* GG = (bf16*)(F.ws + WS_GG);
    const float* mu = F.in[I_MU]; const float* w0 = F.in[I_W0]; const float* a0 = F.in[I_A0];
    const int r16 = F.lane & 15, q = F.lane >> 4;
    constexpr int WST = 72, GST = 168;
    LAS bf16* WU = (LAS bf16*)F.lds; LAS bf16* AU = WU + 128 * WST; LAS bf16* GU = AU + 128 * WST;
    const int nr = blockIdx.x & 7, nbr = (F.G - nr + 7) >> 3;
    __syncthreads();
    for (int i = F.tid; i < 128 * 8; i += NTHR) { const int row = i >> 3, ch = i & 7;
        *(LAS v4u*)(WU + row * WST + 8 * ch) = *(const v4u*)(WUPT + (size_t)(128 * nr + row) * L_W + 8 * ch);
        *(LAS v4u*)(AU + row * WST + 8 * ch) = *(const v4u*)(AUPT + (size_t)(128 * nr + row) * L_A + 8 * ch); }
    for (int i = F.tid; i < 128 * 20; i += NTHR) { const int row = i / 20, ch = i - row * 20;
        *(LAS v4u*)(GU + row * GST + 8 * ch) = *(const v4u*)(GUPT + (size_t)(128 * nr + row) * L_G + 8 * ch); }
    __syncthreads();
#define P3_COL(s) ((((s) < 2) ? (C_WD + 32 * (s)) : ((s) < 4) ? (C_AD + 32 * ((s) - 2)) : (C_GD + 32 * ((s) - 4))) + 8 * q)
    const int mt0 = (blockIdx.x >> 3) * NWAVES + F.wave, mst = nbr * NWAVES;
    v4u rc_[9], rp_[9];
    if (mt0 < M / 16) { const bf16* row = PROJ + (size_t)(mt0 * 16 + r16) * INPP;
#pragma unroll
        for (int s = 0; s < 9; ++s) { rc_[s] = *(const v4u*)(row + P3_COL(s)); rp_[s] = *(const v4u*)(row - INPP + P3_COL(s)); } }
    for (int mt = mt0; mt < M / 16; mt += mst) {
        const int m = mt * 16 + r16; const bool first = (m % SEQ) == 0;
        bf16x8 af[9];
#pragma unroll
        for (int s = 0; s < 9; ++s) {
            const int col = P3_COL(s);
            const v4u pc = rc_[s];
            v4u pp = rp_[s]; if (first) pp = (v4u){0u, 0u, 0u, 0u};
            const f32x4 m0 = *(const f32x4*)(mu + col), m1 = *(const f32x4*)(mu + col + 4);
            float c[8], p[8], e[8]; unpack8(pc, c); unpack8(pp, p);
            const float mm[8] = {m0.x, m0.y, m0.z, m0.w, m1.x, m1.y, m1.z, m1.w};
#pragma unroll
            for (int j = 0; j < 8; ++j) { float v = c[j] + (p[j] - c[j]) * mm[j];
                if (s < 2) { const float t = __expf(2.f * v); v = 1.f - 2.f * rcp_f(t + 1.f); }
                else if (s >= 4) v = sigmoid_f(v);
                e[j] = v; }
            af[s] = __builtin_bit_cast(bf16x8, pack8(e));
        }
        { const int mtn = (mt + mst < M / 16) ? mt + mst : mt; const bf16* row = PROJ + (size_t)(mtn * 16 + r16) * INPP;
#pragma unroll
          for (int s = 0; s < 9; ++s) { rc_[s] = *(const v4u*)(row + P3_COL(s)); rp_[s] = *(const v4u*)(row - INPP + P3_COL(s)); } }
        asm volatile("" ::: "memory");
#pragma unroll 2
        for (int nt = 0; nt < 8; ++nt) {
            const LAS bf16* wu = WU + (16 * nt + r16) * WST + 8 * q; const LAS bf16* au = AU + (16 * nt + r16) * WST + 8 * q; const LAS bf16* gu = GU + (16 * nt + r16) * GST + 8 * q;
            f32x4 acc0 = {0.f, 0.f, 0.f, 0.f}, acc1 = acc0, acc2 = acc0;
#pragma unroll
            for (int s2 = 0; s2 < 2; ++s2) acc0 = __builtin_amdgcn_mfma_f32_16x16x32_bf16(*(const LAS bf16x8*)(wu + 32 * s2), af[s2], acc0, 0, 0, 0);
#pragma unroll
            for (int s2 = 0; s2 < 2; ++s2) acc1 = __builtin_amdgcn_mfma_f32_16x16x32_bf16(*(const LAS bf16x8*)(au + 32 * s2), af[2 + s2], acc1, 0, 0, 0);
#pragma unroll
            for (int s2 = 0; s2 < 5; ++s2) acc2 = __builtin_amdgcn_mfma_f32_16x16x32_bf16(*(const LAS bf16x8*)(gu + 32 * s2), af[4 + s2], acc2, 0, 0, 0);
            const int n = 128 * nr + 16 * nt + 4 * q;
            const f32x4 w0v = *(const f32x4*)(w0 + n), a0v = *(const f32x4*)(a0 + n);
            v2u o0, o1, o2;
            o0.x = pk2(-0.60653066f * sigmoid_f(acc0[0] + w0v.x), -0.60653066f * sigmoid_f(acc0[1] + w0v.y));
            o0.y = pk2(-0.60653066f * sigmoid_f(acc0[2] + w0v.z), -0.60653066f * sigmoid_f(acc0[3] + w0v.w));
            o1.x = pk2(sigmoid_f(acc1[0] + a0v.x), sigmoid_f(acc1[1] + a0v.y)); o1.y = pk2(sigmoid_f(acc1[2] + a0v.z), sigmoid_f(acc1[3] + a0v.w));
            o2.x = pk2(acc2[0], acc2[1]); o2.y = pk2(acc2[2], acc2[3]);
            *(v2u*)(LW + (size_t)m * RW + n) = o0; *(v2u*)(AA + (size_t)m * RW + n) = o1; *(v2u*)(GG + (size_t)m * RW + n) = o2;
        }
    }
#undef P3_COL
    __syncthreads();
}

constexpr int TC = 32, NCHUNK = SEQ / TC;
constexpr int RB_R = 0, RB_W = TC * 64, RB_K = 2 * TC * 64, RB_KK = 3 * TC * 64, RB_KA = 4 * TC * 64, RB_V = 5 * TC * 64, RB_SIZE = 5 * TC * 64 + TC * 16;
constexpr int MB_B = 0, MB_C = TC * 128, MB_X = 2 * TC * 128, MB_DT = MB_X + TC * 32, MB_DA = MB_DT + TC, MB_SIZE = MB_DA + TC;
static_assert(2 * RB_SIZE * 4 <= RING_BYTES, "scan buffers fit the LDS ring");

struct RwkvRaw { bf16 r[9], k[9], v[9], lw[8], a[8]; };
__device__ __forceinline__ void rwkv_load(RwkvRaw& raw, const bf16* PROJ, const bf16* LW, const bf16* AA, int b, int h, int t0w, int c) {
    const bf16* base = PROJ + (size_t)(b * SEQ + t0w) * INPP + h * 64 + c;
#pragma unroll
    for (int i = 0; i < 9; ++i) {
        if (i == 0 && t0w == 0) { raw.r[0] = 0; raw.k[0] = 0; raw.v[0] = 0; }
        else { const bf16* row = base + (long)(i - 1) * INPP; raw.r[i] = row[C_R]; raw.k[i] = row[C_K]; raw.v[i] = row[C_V]; }
    }
#pragma unroll
    for (int i = 0; i < 8; ++i) { const size_t o = (size_t)(b * SEQ + t0w + i) * RW + h * 64 + c; raw.lw[i] = LW[o]; raw.a[i] = AA[o]; }
}
__device__ __forceinline__ void rwkv_stage(const RwkvRaw& raw, LAS float* buf, int tl0, int c, int qt, float mu_r, float mu_k, float mu_v, float kkw, float kaw) {
#pragma unroll
    for (int i = 0; i < 8; ++i) {
        const int t = tl0 + i;
        const float rc = bf1(raw.r[i + 1]), rp = bf1(raw.r[i]), kc = bf1(raw.k[i + 1]), kp = bf1(raw.k[i]), vc = bf1(raw.v[i + 1]), vp = bf1(raw.v[i]);
        const float rr = rc + (rp - rc) * mu_r, kx = kc + (kp - kc) * mu_k, vv = vc + (vp - vc) * mu_v;
        const float a = bf1(raw.a[i]), dec = __expf(bf1(raw.lw[i]));
        const float kkraw = kx * kkw; const float ss = wave_sum_dpp(kkraw * kkraw);
        const float kkn = kkraw * rcp_f(fmaxf(sqrtf(ss), 1e-12f));
        buf[RB_R + t * 64 + c] = rr; buf[RB_W + t * 64 + c] = dec; buf[RB_K + t * 64 + c] = kx * (1.f + (a - 1.f) * kaw);
        buf[RB_KK + t * 64 + c] = kkn; buf[RB_KA + t * 64 + c] = kkn * a;
        if ((c >> 4) == qt) buf[RB_V + t * 16 + (c & 15)] = vv;
    }
}
__device__ __forceinline__ void rwkv_task(const Ctx& F, int task) {
    const int b = task >> 6, h = (task >> 2) & 15, qt = task & 3;
    const bf16* PROJ = (const bf16*)(F.ws + WS_PROJ); const bf16* LW = (const bf16*)(F.ws + WS_LW); const bf16* AA = (const bf16*)(F.ws + WS_AA);
    bf16* OY = (bf16*)(F.ws + WS_OY);
    LAS float* lbuf = (LAS float*)F.lds;
    const int c = F.lane, w = F.wave, r = F.lane >> 4, cg = F.lane & 15;
    const bool stager = w >= 4; const int sw = w & 3;
    const int ch = h * 64 + c;
    const float mu_r = F.in[I_MU][C_R + ch], mu_k = F.in[I_MU][C_K + ch], mu_v = F.in[I_MU][C_V + ch], kkw = F.in[I_KK][ch], kaw = F.in[I_KA][ch];
    RwkvRaw raw;
    if (stager) { rwkv_load(raw, PROJ, LW, AA, b, h, 8 * sw, c); rwkv_stage(raw, lbuf, 8 * sw, c, qt, mu_r, mu_k, mu_v, kkw, kaw); rwkv_load(raw, PROJ, LW, AA, b, h, TC + 8 * sw, c); }
    __syncthreads();
    f32x2 S01 = {0.f, 0.f}, S23 = {0.f, 0.f};
    const bool cb0 = cg & 1, cb1 = cg & 2, cb2 = cg & 4, cb3 = cg & 8;
    bf16* orow = OY + (size_t)(b * SEQ) * DM + h * 64 + 16 * qt + 4 * sw + r;
    for (int ck = 0; ck < NCHUNK; ++ck) {
        const LAS float* buf = lbuf + (ck & 1) * RB_SIZE;
        if (stager) {
            if (ck + 1 < NCHUNK) { rwkv_stage(raw, lbuf + ((ck + 1) & 1) * RB_SIZE, 8 * sw, c, qt, mu_r, mu_k, mu_v, kkw, kaw);
                if (ck + 2 < NCHUNK) rwkv_load(raw, PROJ, LW, AA, b, h, (ck + 2) * TC + 8 * sw, c); }
        } else {
            const LAS float* bp = buf + 4 * cg; const LAS float* vp = buf + RB_V + 4 * sw + r;
            f32x4 qkk[3], qw[3], qka[3], qk[3], qr[3]; float qv[3];
#pragma unroll
            for (int i = 0; i < 3; ++i) { qkk[i] = *(const LAS f32x4*)(bp + RB_KK + i * 64); qw[i] = *(const LAS f32x4*)(bp + RB_W + i * 64); qka[i] = *(const LAS f32x4*)(bp + RB_KA + i * 64);
                qk[i] = *(const LAS f32x4*)(bp + RB_K + i * 64); qr[i] = *(const LAS f32x4*)(bp + RB_R + i * 64); qv[i] = vp[i * 16]; }
            float op[16];
#pragma unroll
            for (int j = 0; j < TC; ++j) {
                const int u = j % 3;
                const f32x4 kk4 = qkk[u], w4 = qw[u], ka4 = qka[u], k4 = qk[u], r4 = qr[u]; const float vr = qv[u];
                const f32x2 tq = S01 * LO2(kk4) + S23 * HI2(kk4);
                const float sa = rowsum16(tq.x + tq.y);
                const f32x2 sav = {sa, sa}, vrv = {vr, vr};
                S01 = S01 * LO2(w4) + (vrv * LO2(k4) - sav * LO2(ka4));
                S23 = S23 * HI2(w4) + (vrv * HI2(k4) - sav * HI2(ka4));
                const f32x2 uq = S01 * LO2(r4) + S23 * HI2(r4);
                op[j & 15] = uq.x + uq.y;
                asm volatile("" : "+v"(S01), "+v"(S23) :: "memory");
                if (j + 3 < TC) { qkk[u] = *(const LAS f32x4*)(bp + RB_KK + (j + 3) * 64); qw[u] = *(const LAS f32x4*)(bp + RB_W + (j + 3) * 64); qka[u] = *(const LAS f32x4*)(bp + RB_KA + (j + 3) * 64);
                                  qk[u] = *(const LAS f32x4*)(bp + RB_K + (j + 3) * 64); qr[u] = *(const LAS f32x4*)(bp + RB_R + (j + 3) * 64); qv[u] = vp[(j + 3) * 16]; }
                if ((j & 15) == 15) {
                    const float ored = treduce16(op, cb0, cb1, cb2, cb3);
                    orow[(size_t)(ck * TC + (j - 15) + cg) * DM] = (bf16)(pk2(ored, 0.f) & 0xffffu);
                }
            }
        }
        __syncthreads();
    }
}

__device__ __forceinline__ void p4_scans(const Ctx& F) {
    for (int task = blockIdx.x; task < NB * RHEADS * 4; task += F.G) { rwkv_task(F, task); __syncthreads(); }
}

__device__ __forceinline__ void ld16(const float* p, float (&v)[16]) {
#pragma unroll
    for (int i = 0; i < 4; ++i) { const f32x4 t = *(const f32x4*)(p + 4 * i); v[4 * i] = t.x; v[4 * i + 1] = t.y; v[4 * i + 2] = t.z; v[4 * i + 3] = t.w; }
}
__device__ __forceinline__ void ldbf16x16(const bf16* p, float (&v)[16]) {
    float t0[8], t1[8]; unpack8(*(const v4u*)p, t0); unpack8(*(const v4u*)(p + 8), t1);
#pragma unroll
    for (int j = 0; j < 8; ++j) { v[j] = t0[j]; v[8 + j] = t1[j]; }
}
__device__ __forceinline__ void stbf16x16(bf16* p, const float (&v)[16]) {
    float t0[8], t1[8];
#pragma unroll
    for (int j = 0; j < 8; ++j) { t0[j] = v[j]; t1[j] = v[8 + j]; }
    *(v4u*)p = pack8(t0); *(v4u*)(p + 8) = pack8(t1);
}
__device__ __forceinline__ void p5_post(const Ctx& F) {
    const bf16* PROJ = (const bf16*)(F.ws + WS_PROJ); const bf16* AA = (const bf16*)(F.ws + WS_AA); const bf16* GG = (const bf16*)(F.ws + WS_GG);
    bf16* OY = (bf16*)(F.ws + WS_OY);
    const int c0 = 16 * F.lane;
    {
        float mur[16], muk[16], muv[16], ka[16], rk[16], lnw[16], lnb[16];
        ld16(F.in[I_MU] + C_R + c0, mur); ld16(F.in[I_MU] + C_K + c0, muk); ld16(F.in[I_MU] + C_V + c0, muv);
        ld16(F.in[I_KA] + c0, ka); ld16(F.in[I_RK] + c0, rk); ld16(F.in[I_LNW] + c0, lnw); ld16(F.in[I_LNB] + c0, lnb);
        for (int m = F.gw; m < M; m += F.NGW) {
            const bool first = (m % SEQ) == 0;
            const bf16* prow = PROJ + (size_t)m * INPP; bf16* oyrow = OY + (size_t)m * DM;
            float o[16], res[16]; float bs = 0.f;
            ldbf16x16(oyrow + c0, o);
            {
                float rc[16], rp[16], kc[16], kp[16], av[16];
                ldbf16x16(prow + C_R + c0, rc); ldbf16x16(prow + C_K + c0, kc); ldbf16x16(AA + (size_t)m * RW + c0, av);
                if (!first) { ldbf16x16(prow - INPP + C_R + c0, rp); ldbf16x16(prow - INPP + C_K + c0, kp); }
                else {
#pragma unroll
                    for (int j = 0; j < 16; ++j) { rp[j] = 0.f; kp[j] = 0.f; } }
#pragma unroll
                for (int j = 0; j < 16; ++j) { const float rr = rc[j] + (rp[j] - rc[j]) * mur[j], kx = kc[j] + (kp[j] - kc[j]) * muk[j];
                    bs += rr * (kx * (1.f + (av[j] - 1.f) * ka[j])) * rk[j]; }
            }
            bs = quadsum(bs);
            float s = 0.f;
#pragma unroll
            for (int j = 0; j < 16; ++j) s += o[j];
            const float mean = quadsum(s) * (1.f / 64.f);
            float qv = 0.f;
#pragma unroll
            for (int j = 0; j < 16; ++j) { o[j] -= mean; qv += o[j] * o[j]; }
            const float rstd = rsqrtf(quadsum(qv) * (1.f / 64.f) + 64e-5f);
            {
                float vc[16], vp[16], gv[16];
                ldbf16x16(prow + C_V + c0, vc); ldbf16x16(GG + (size_t)m * RW + c0, gv);
                if (!first) ldbf16x16(prow - INPP + C_V + c0, vp);
                else {
#pragma unroll
                    for (int j = 0; j < 16; ++j) vp[j] = 0.f; }
#pragma unroll
                for (int j = 0; j < 16; ++j) { const float vv = vc[j] + (vp[j] - vc[j]) * muv[j]; res[j] = (o[j] * rstd * lnw[j] + lnb[j] + bs * vv) * gv[j]; }
            }
            stbf16x16(oyrow + c0, res);
        }
    }
    {
        float nw[16]; ld16(F.in[I_MNW] + c0, nw);
        for (int m = F.gw; m < M; m += F.NGW) {
            const bf16* prow = PROJ + (size_t)m * INPP; bf16* oyrow = OY + (size_t)m * DM;
            float y[16], z[16];
            ldbf16x16(oyrow + RW + c0, y); ldbf16x16(prow + C_Z + c0, z);
            float qv = 0.f;
#pragma unroll
            for (int j = 0; j < 16; ++j) { y[j] *= silu_f(z[j]); qv += y[j] * y[j]; }
            qv = rowsum16(qv);
            { auto rr = __builtin_amdgcn_permlane16_swap(__float_as_uint(qv), __float_as_uint(qv), false, false); qv = __uint_as_float(rr[0]) + __uint_as_float(rr[1]); }
            const float rstd = rsqrtf(qv * (1.f / 512.f) + 1e-5f);
#pragma unroll
            for (int j = 0; j < 16; ++j) y[j] = y[j] * rstd * nw[j];
            stbf16x16(oyrow + RW + c0, y);
        }
    }
}
constexpr int MC_L = 128, MC_NC = SEQ / MC_L, LSTR = 136;
constexpr int MT_BYTES = 128 * LSTR * 2;
constexpr size_t WS_ST = 876 * MiB, WS_SIN = 940 * MiB, WS_ATOT = 1004 * MiB, WS_END2 = 1005 * MiB;

__device__ __forceinline__ float mamba_dt_scan(const Ctx& F, const bf16* PROJ, int b, int c, int g, LAS float* DT, LAS float* ACS) {
    const int head = g * 8 + F.wave, lane = F.lane;
    const float dtb = F.in[I_DTB][head], Aneg = -__expf(F.in[I_ALOG][head]);
    const bf16* p = PROJ + (size_t)(b * SEQ + c * MC_L + 2 * lane) * INPP + C_DT + head;
    const float x0 = bf1(p[0]) + dtb, x1 = bf1(p[INPP]) + dtb;
    const float d0 = (x0 > 20.f) ? x0 : log1pf(__expf(x0)), d1 = (x1 > 20.f) ? x1 : log1pf(__expf(x1));
    const float s0 = d0 * Aneg, s1 = s0 + d1 * Aneg;
    float incl = s1;
#pragma unroll
    for (int o = 1; o < 64; o <<= 1) { const float t = __shfl_up(incl, o); if (lane >= o) incl += t; }
    const float excl = incl - s1;
    DT[F.wave * 128 + 2 * lane] = d0; DT[F.wave * 128 + 2 * lane + 1] = d1;
    ACS[F.wave * 128 + 2 * lane] = excl + s0; ACS[F.wave * 128 + 2 * lane + 1] = excl + s1;
    return __shfl(incl, 63);
}
struct TRaw { bf16 v[35]; };
__device__ __forceinline__ void mstage_T_load(TRaw& raw, const bf16* PROJ, int b, int c, int chn, int tid) {
    const int t0 = 32 * (tid >> 7);
    const bf16* base = PROJ + (size_t)(b * SEQ + c * MC_L + t0) * INPP + C_XBC + chn;
    if (c * MC_L + t0 > 0) { raw.v[0] = base[-3 * INPP]; raw.v[1] = base[-2 * INPP]; raw.v[2] = base[-1 * INPP]; }
    else { raw.v[0] = 0; raw.v[1] = 0; raw.v[2] = 0; }
#pragma unroll
    for (int t = 0; t < 32; ++t) raw.v[3 + t] = base[(size_t)t * INPP];
}
template <bool SC>
__device__ __forceinline__ void mstage_T_store(const TRaw& raw, int chn, LAS bf16* dst, const LAS float* scale, const float* convw, const float* convb, int tid) {
    const int f = tid & 127, t0 = 32 * (tid >> 7);
    const float w0 = convw[chn], w1 = convw[1536 + chn], w2 = convw[2 * 1536 + chn], w3 = convw[3 * 1536 + chn], bb = convb[chn];
#pragma unroll
    for (int i8 = 0; i8 < 4; ++i8) {
        float e[8];
#pragma unroll
        for (int i = 0; i < 8; ++i) { const int t = 8 * i8 + i;
            float v = silu_f(bb + w0 * bf1(raw.v[t]) + w1 * bf1(raw.v[t + 1]) + w2 * bf1(raw.v[t + 2]) + w3 * bf1(raw.v[t + 3]));
            if (SC) v *= scale[t0 + t];
            e[i] = v; }
        *(LAS v4u*)(dst + f * LSTR + t0 + 8 * i8) = pack8(e);
    }
}
__device__ __forceinline__ void mstage_N(const bf16* PROJ, int b, int c, int g, LAS bf16* Bn, LAS bf16* Cn, const float* convw, const float* convb, int tid) {
    const int f8 = tid & 31, t0 = 8 * (tid >> 5);
    const int chn = (f8 < 16) ? (1024 + g * 128 + 8 * f8) : (1280 + g * 128 + 8 * (f8 - 16));
    LAS bf16* dst = ((f8 < 16) ? Bn : Cn) + 8 * (f8 & 15);
    const bf16* base = PROJ + (size_t)(b * SEQ + c * MC_L + t0) * INPP + C_XBC + chn;
    float w[4][8], bb[8];
#pragma unroll
    for (int i = 0; i < 4; ++i) { const f32x4 a = *(const f32x4*)(convw + i * 1536 + chn), d = *(const f32x4*)(convw + i * 1536 + chn + 4);
        w[i][0] = a.x; w[i][1] = a.y; w[i][2] = a.z; w[i][3] = a.w; w[i][4] = d.x; w[i][5] = d.y; w[i][6] = d.z; w[i][7] = d.w; }
    { const f32x4 a = *(const f32x4*)(convb + chn), d = *(const f32x4*)(convb + chn + 4); bb[0] = a.x; bb[1] = a.y; bb[2] = a.z; bb[3] = a.w; bb[4] = d.x; bb[5] = d.y; bb[6] = d.z; bb[7] = d.w; }
    float r0[8], r1[8], r2[8];
    if (c * MC_L + t0 > 0) { unpack8(*(const v4u*)(base - 3 * INPP), r0); unpack8(*(const v4u*)(base - 2 * INPP), r1); unpack8(*(const v4u*)(base - 1 * INPP), r2); }
    else {
#pragma unroll
        for (int k = 0; k < 8; ++k) { r0[k] = 0.f; r1[k] = 0.f; r2[k] = 0.f; } }
#pragma unroll
    for (int t = 0; t < 8; ++t) {
        float r3[8], e[8]; unpack8(*(const v4u*)(base + (size_t)t * INPP), r3);
#pragma unroll
        for (int k = 0; k < 8; ++k) { e[k] = silu_f(bb[k] + w[0][k] * r0[k] + w[1][k] * r1[k] + w[2][k] * r2[k] + w[3][k] * r3[k]); r0[k] = r1[k]; r1[k] = r2[k]; r2[k] = r3[k]; }
        *(LAS v4u*)(dst + (t0 + t) * LSTR) = pack8(e);
    }
}

__device__ __forceinline__ void m1_chunk_states(const Ctx& F) {
    const bf16* PROJ = (const bf16*)(F.ws + WS_PROJ); bf16* ST = (bf16*)(F.ws + WS_ST); float* ATOT = (float*)(F.ws + WS_ATOT);
    LAS bf16* BT = (LAS bf16*)F.lds; LAS bf16* XT = (LAS bf16*)(F.lds + MT_BYTES);
    LAS float* DT = (LAS float*)(F.lds + 3 * MT_BYTES); LAS float* ACS = DT + 8 * 128; LAS float* SCL = ACS + 8 * 128;
    const float* convw = F.in[I_CONVW]; const float* convb = F.in[I_CONVB];
    const int tid = F.tid, w = F.wave, lane = F.lane, r16 = lane & 15, q = lane >> 4;
    for (int it = blockIdx.x; it < NB * MC_NC * 2; it += F.G) {
        const int g = it & 1, c = (it >> 1) & (MC_NC - 1), b = it >> 7;
        __syncthreads();
        const float atot = mamba_dt_scan(F, PROJ, b, c, g, DT, ACS);
        if (lane == 0) ATOT[(b * MC_NC + c) * 16 + g * 8 + w] = atot;
        const int chB = 1024 + g * 128 + (tid & 127);
        TRaw ra, rb;
        mstage_T_load(ra, PROJ, b, c, chB, tid);
        mstage_T_load(rb, PROJ, b, c, (g * 8 + ((tid & 127) >> 6)) * 64 + (tid & 63), tid);
        LDS_WAIT();
        SCL[w * 128 + 2 * lane] = DT[w * 128 + 2 * lane] * __expf(atot - ACS[w * 128 + 2 * lane]);
        SCL[w * 128 + 2 * lane + 1] = DT[w * 128 + 2 * lane + 1] * __expf(atot - ACS[w * 128 + 2 * lane + 1]);
        mstage_T_store<false>(ra, chB, BT, nullptr, convw, convb, tid);
        mstage_T_load(ra, PROJ, b, c, (g * 8 + 2 + ((tid & 127) >> 6)) * 64 + (tid & 63), tid);
        __syncthreads();
#pragma unroll
        for (int hb = 0; hb < 2; ++hb) {
            if (hb == 1) mstage_T_load(ra, PROJ, b, c, (g * 8 + 6 + ((tid & 127) >> 6)) * 64 + (tid & 63), tid);
            { const int hl = 4 * hb + ((tid & 127) >> 6); mstage_T_store<true>(rb, (g * 8 + hl) * 64 + (tid & 63), XT, SCL + hl * 128, convw, convb, tid); }
            if (hb == 0) mstage_T_load(rb, PROJ, b, c, (g * 8 + 4 + ((tid & 127) >> 6)) * 64 + (tid & 63), tid);
            { const int hl = 4 * hb + 2 + ((tid & 127) >> 6); mstage_T_store<true>(ra, (g * 8 + hl) * 64 + (tid & 63), XT + 128 * LSTR, SCL + hl * 128, convw, convb, tid); }
            __syncthreads();
            const int hh = w >> 1, ph = w & 1;
            f32x4 acc[2][8];
#pragma unroll
            for (int a = 0; a < 2; ++a)
#pragma unroll
                for (int n = 0; n < 8; ++n) acc[a][n] = (f32x4){0.f, 0.f, 0.f, 0.f};
#pragma unroll
            for (int ks = 0; ks < 4; ++ks) {
                bf16x8 xa[2];
#pragma unroll
                for (int a = 0; a < 2; ++a) xa[a] = *(const LAS bf16x8*)(XT + (hh * 64 + 32 * ph + 16 * a + r16) * LSTR + 32 * ks + 8 * q);
#pragma unroll
                for (int n = 0; n < 8; ++n) { const bf16x8 bfr = *(const LAS bf16x8*)(BT + (16 * n + r16) * LSTR + 32 * ks + 8 * q);
#pragma unroll
                    for (int a = 0; a < 2; ++a) acc[a][n] = __builtin_amdgcn_mfma_f32_16x16x32_bf16(bfr, xa[a], acc[a][n], 0, 0, 0); }
            }
            bf16* st = ST + ((size_t)((b * MC_NC + c) * 16 + g * 8 + 4 * hb + hh)) * (64 * 128);
#pragma unroll
            for (int a = 0; a < 2; ++a)
#pragma unroll
                for (int n = 0; n < 8; ++n) { v2u o; o.x = pk2(acc[a][n][0], acc[a][n][1]); o.y = pk2(acc[a][n][2], acc[a][n][3]);
                    *(v2u*)(st + (32 * ph + 16 * a + r16) * 128 + 16 * n + 4 * q) = o; }
            __syncthreads();
        }
    }
}

__device__ __forceinline__ void m2_prefix(const Ctx& F) {
    const bf16* ST = (const bf16*)(F.ws + WS_ST); bf16* SIN = (bf16*)(F.ws + WS_SIN); const float* ATOT = (const float*)(F.ws + WS_ATOT);
    const int nthr = F.G * NTHR;
    for (int gi = blockIdx.x * NTHR + F.tid; gi < NB * 16 * 2048; gi += nthr) {
        const int e4 = gi & 2047, bh = gi >> 11, b = bh >> 4, h = bh & 15;
        float r0 = 0.f, r1 = 0.f, r2 = 0.f, r3 = 0.f;
#pragma unroll 4
        for (int c = 0; c < MC_NC; ++c) {
            const size_t o = ((size_t)((b * MC_NC + c) * 16 + h)) * 8192 + 4 * e4;
            v2u so; so.x = pk2(r0, r1); so.y = pk2(r2, r3);
            *(v2u*)(SIN + o) = so;
            const v2u sv = *(const v2u*)(ST + o); const float d = __expf(ATOT[(b * MC_NC + c) * 16 + h]);
            r0 = r0 * d + bflo(sv.x); r1 = r1 * d + bfhi(sv.x); r2 = r2 * d + bflo(sv.y); r3 = r3 * d + bfhi(sv.y);
        }
    }
}

__device__ __forceinline__ void m3_outputs(const Ctx& F) {
    const bf16* PROJ = (const bf16*)(F.ws + WS_PROJ); const bf16* SIN = (const bf16*)(F.ws + WS_SIN); bf16* OY = (bf16*)(F.ws + WS_OY);
    LAS bf16* Cn = (LAS bf16*)F.lds; LAS bf16* RB = (LAS bf16*)(F.lds + MT_BYTES);
    LAS bf16* Mw = (LAS bf16*)(F.lds + 2 * MT_BYTES) + F.wave * 16 * LSTR;
    LAS float* DT = (LAS float*)(F.lds + 3 * MT_BYTES); LAS float* ACS = DT + 8 * 128;
    const float* convw = F.in[I_CONVW]; const float* convb = F.in[I_CONVB];
    const int tid = F.tid, w = F.wave, lane = F.lane, r16 = lane & 15, q = lane >> 4;
    for (int it = blockIdx.x; it < NB * MC_NC * 2; it += F.G) {
        const int g = it & 1, c = (it >> 1) & (MC_NC - 1), b = it >> 7;
        __syncthreads();
        (void)mamba_dt_scan(F, PROJ, b, c, g, DT, ACS);
        mstage_N(PROJ, b, c, g, RB, Cn, convw, convb, tid);
        __syncthreads();
        TRaw rx;
        mstage_T_load(rx, PROJ, b, c, (g * 8 + ((tid & 127) >> 6)) * 64 + (tid & 63), tid);
        bf16x8 cf[4];
#pragma unroll
        for (int ks = 0; ks < 4; ++ks) cf[ks] = *(const LAS bf16x8*)(Cn + (16 * w + r16) * LSTR + 32 * ks + 8 * q);
        f32x4 Gt[8];
#pragma unroll
        for (int nt = 0; nt < 8; ++nt) { Gt[nt] = (f32x4){0.f, 0.f, 0.f, 0.f};
#pragma unroll
            for (int ks = 0; ks < 4; ++ks) Gt[nt] = __builtin_amdgcn_mfma_f32_16x16x32_bf16(*(const LAS bf16x8*)(RB + (16 * nt + r16) * LSTR + 32 * ks + 8 * q), cf[ks], Gt[nt], 0, 0, 0); }
        const int l = 16 * w + r16;
        const size_t mrow = (size_t)(b * SEQ + c * MC_L + l);
#pragma unroll 1
        for (int hb = 0; hb < 4; ++hb) {
            __syncthreads();
            { const int hl = 2 * hb + ((tid & 127) >> 6); mstage_T_store<false>(rx, (g * 8 + hl) * 64 + (tid & 63), RB, nullptr, convw, convb, tid); }
            { const int hn = (hb < 3) ? 2 * (hb + 1) : 2 * hb; mstage_T_load(rx, PROJ, b, c, (g * 8 + hn + ((tid & 127) >> 6)) * 64 + (tid & 63), tid); }
            __syncthreads();
#pragma unroll 1
            for (int h2 = 0; h2 < 2; ++h2) {
                const int hl = 2 * hb + h2, head = g * 8 + hl;
                const float acs_l = ACS[hl * 128 + l];
                const bf16* sin = SIN + ((size_t)((b * MC_NC + c) * 16 + head)) * 8192;
                bf16x8 sf[4][4];
#pragma unroll
                for (int pt = 0; pt < 4; ++pt)
#pragma unroll
                    for (int ks = 0; ks < 4; ++ks) sf[pt][ks] = *(const bf16x8*)(sin + (16 * pt + r16) * 128 + 32 * ks + 8 * q);
#pragma unroll
                for (int nt = 0; nt < 8; ++nt) { const f32x4 as = *(const LAS f32x4*)(ACS + hl * 128 + 16 * nt + 4 * q), ds = *(const LAS f32x4*)(DT + hl * 128 + 16 * nt + 4 * q);
                    float mv[4];
#pragma unroll
                    for (int j = 0; j < 4; ++j) { const int s = 16 * nt + 4 * q + j; mv[j] = (s <= l) ? Gt[nt][j] * __expf(acs_l - as[j]) * ds[j] : 0.f; }
                    v2u o; o.x = pk2(mv[0], mv[1]); o.y = pk2(mv[2], mv[3]);
                    *(LAS v2u*)(Mw + r16 * LSTR + 16 * nt + 4 * q) = o; }
                LDS_WAIT(); asm volatile("" ::: "memory");
                bf16x8 mf[4];
#pragma unroll
                for (int ks = 0; ks < 4; ++ks) mf[ks] = *(const LAS bf16x8*)(Mw + r16 * LSTR + 32 * ks + 8 * q);
                const float el = __expf(acs_l), Dh = F.in[I_DSK][head];
#pragma unroll
                for (int pt = 0; pt < 4; ++pt) {
                    f32x4 yd = {0.f, 0.f, 0.f, 0.f}, yo = {0.f, 0.f, 0.f, 0.f};
#pragma unroll
                    for (int ks = 0; ks < 4; ++ks) {
                        yd = __builtin_amdgcn_mfma_f32_16x16x32_bf16(*(const LAS bf16x8*)(RB + (h2 * 64 + 16 * pt + r16) * LSTR + 32 * ks + 8 * q), mf[ks], yd, 0, 0, 0);
                        yo = __builtin_amdgcn_mfma_f32_16x16x32_bf16(sf[pt][ks], cf[ks], yo, 0, 0, 0); }
                    float yv[4];
#pragma unroll
                    for (int j = 0; j < 4; ++j) yv[j] = yd[j] + el * yo[j] + Dh * bf1(RB[(h2 * 64 + 16 * pt + 4 * q + j) * LSTR + l]);
                    v2u o; o.x = pk2(yv[0], yv[1]); o.y = pk2(yv[2], yv[3]);
                    *(v2u*)(OY + mrow * DM + RW + head * 64 + 16 * pt + 4 * q) = o;
                }
                asm volatile("" ::: "memory");
            }
        }
    }
}
constexpr int RC = 16, RNCH = SEQ / RC, NPART = 4, RHALF = RNCH / NPART, RITEMS = NB * RHEADS * RHALF;
constexpr size_t RO_WH = 0, RO_RH = 16 * MiB, RO_VT = 32 * MiB, RO_ET = 48 * MiB, RO_OL = 64 * MiB, RO_A2 = 80 * MiB, RO_GC = 112 * MiB, RO_BUF = 116 * MiB, RO_SS = 232 * MiB;
constexpr int RL_KAP = 0, RL_ALP = 2304, RL_KT = 4608, RL_RT = 6912, RL_KAPT = 9216, RL_VT = 11264, RL_TB = 13312, RL_BL = 14336, RL_QL = 15360, RL_PL = 16384,
              RL_WT = RL_KAP, RL_BVT = RL_ALP, RL_AL32 = RL_KT, RL_ET = RL_KT,
              RL_BYTES = 18176;
constexpr int XS = 72, TS = 16, SS16 = 32;

__device__ __forceinline__ float wave_sum_pl(float x) {
    x = rowsum16(x);
    { auto rr = __builtin_amdgcn_permlane16_swap(__float_as_uint(x), __float_as_uint(x), false, false); x = __uint_as_float(rr[0]) + __uint_as_float(rr[1]); }
    { auto rr = __builtin_amdgcn_permlane32_swap(__float_as_uint(x), __float_as_uint(x), false, false); x = __uint_as_float(rr[0]) + __uint_as_float(rr[1]); }
    return x;
}
__device__ __forceinline__ v2u pack4(const f32x4 a) { v2u o; o.x = pk2(a[0], a[1]); o.y = pk2(a[2], a[3]); return o; }
__device__ __forceinline__ f32x4 unpack4(const v2u u) { return (f32x4){bflo(u.x), bfhi(u.x), bflo(u.y), bfhi(u.y)}; }
__device__ __forceinline__ bf16 f2b(float x) { return (bf16)pk2(x, 0.f); }

__device__ __forceinline__ void ra_item(const Ctx& F, LAS unsigned char* wl, int it, int half) {
    const int bh = it / RHALF, cl = it - bh * RHALF, ci = half * RHALF + cl, b = bh >> 4, h = bh & 15;
    const bf16* PROJ = (const bf16*)(F.ws + WS_PROJ); const bf16* LW = (const bf16*)(F.ws + WS_LW); const bf16* AA = (const bf16*)(F.ws + WS_AA);
    unsigned char* RO = (unsigned char*)F.out + (size_t)(half & 1) * RO_BUF;
    const int lane = F.lane, r16 = lane & 15, q = lane >> 4, c = lane, ch = h * 64 + c;
    const size_t m0 = (size_t)b * SEQ + (size_t)RC * ci;
    LAS bf16* KAP = (LAS bf16*)(wl + RL_KAP); LAS bf16* ALP = (LAS bf16*)(wl + RL_ALP); LAS bf16* KT = (LAS bf16*)(wl + RL_KT); LAS bf16* RT = (LAS bf16*)(wl + RL_RT);
    LAS bf16* KAPT = (LAS bf16*)(wl + RL_KAPT); LAS bf16* VTL = (LAS bf16*)(wl + RL_VT); LAS bf16* WT = (LAS bf16*)(wl + RL_WT); LAS bf16* BVT = (LAS bf16*)(wl + RL_BVT); LAS bf16* ETL = (LAS bf16*)(wl + RL_ET);
    LAS bf16* TB = (LAS bf16*)(wl + RL_TB); LAS bf16* BL = (LAS bf16*)(wl + RL_BL); LAS bf16* QL = (LAS bf16*)(wl + RL_QL); LAS bf16* PL = (LAS bf16*)(wl + RL_PL);
    const float mu_r = F.in[I_MU][C_R + ch], mu_k = F.in[I_MU][C_K + ch], mu_v = F.in[I_MU][C_V + ch], kkw = F.in[I_KK][ch], kaw = F.in[I_KA][ch];
    const bf16* prow = PROJ + m0 * INPP + ch;
    float rp = 0.f, kp = 0.f, vp = 0.f;
    if (ci > 0) { rp = bf1(prow[-INPP + C_R]); kp = bf1(prow[-INPP + C_K]); vp = bf1(prow[-INPP + C_V]); }
    float ec = 1.f, kkna[RC], kpv[RC], env[RC], vvv[RC];
    float cum = 0.f;
#pragma unroll
    for (int t = 0; t < RC; ++t) {
        const bf16* row = prow + (size_t)t * INPP;
        const float rc = bf1(row[C_R]), kc = bf1(row[C_K]), vc = bf1(row[C_V]);
        const float a = bf1(AA[(m0 + t) * RW + ch]), lw = bf1(LW[(m0 + t) * RW + ch]);
        const float rr = rc + (rp - rc) * mu_r, kx = kc + (kp - kc) * mu_k, vv = vc + (vp - vc) * mu_v;
        rp = rc; kp = kc; vp = vc;
        const float kkraw = kx * kkw; const float ss = wave_sum_pl(kkraw * kkraw);
        const float kkn = kkraw * rcp_f(fmaxf(sqrtf(ss), 1e-12f));
        const float kpp = kx * (1.f + (a - 1.f) * kaw);
        const float ep = ec; cum += lw; ec = __expf(cum); const float en = rcp_f(ec);
        const unsigned p0 = pk2(kkn * ep, kkn * a * en), p1 = pk2(kpp * en, rr * ec), p2 = pk2(vv, 0.f);
        KAP[t * XS + c] = (bf16)p0; ALP[t * XS + c] = (bf16)(p0 >> 16); KT[t * XS + c] = (bf16)p1; RT[t * XS + c] = (bf16)(p1 >> 16);
        KAPT[c * TS + t] = (bf16)p0; VTL[c * TS + t] = (bf16)p2;
        kkna[t] = kkn * a; kpv[t] = kpp; env[t] = en; vvv[t] = vv;
    }
    {
        float e8[8]; v4u* vt = (v4u*)((bf16*)(RO + RO_VT) + (size_t)it * 1024 + c * 16);
#pragma unroll
        for (int i = 0; i < 8; ++i) e8[i] = vvv[i];
        vt[0] = pack8(e8);
#pragma unroll
        for (int i = 0; i < 8; ++i) e8[i] = vvv[8 + i];
        vt[1] = pack8(e8);
        v4u* a2 = (v4u*)((bf16*)(RO + RO_A2) + (size_t)it * 2048 + c * 32);
        float dd[RC];
#pragma unroll
        for (int t = 0; t < RC; ++t) dd[t] = ec * env[t];
#pragma unroll
        for (int i = 0; i < 8; ++i) e8[i] = -kkna[i] * dd[i];
        a2[0] = pack8(e8);
#pragma unroll
        for (int i = 0; i < 8; ++i) e8[i] = -kkna[8 + i] * dd[8 + i];
        a2[1] = pack8(e8);
#pragma unroll
        for (int i = 0; i < 8; ++i) e8[i] = kpv[i] * dd[i];
        a2[2] = pack8(e8);
#pragma unroll
        for (int i = 0; i < 8; ++i) e8[i] = kpv[8 + i] * dd[8 + i];
        a2[3] = pack8(e8);
        ((float*)(RO + RO_GC))[(size_t)it * 64 + c] = ec;
    }
    LDS_WAIT(); asm volatile("" ::: "memory");
    const v2u zero2 = {0u, 0u};
    {
        f32x4 alt = {0.f, 0.f, 0.f, 0.f}, blt = alt, qlt = alt, plt = alt;
#pragma unroll
        for (int ks = 0; ks < 2; ++ks) {
            const bf16x8 fa = *(const LAS bf16x8*)(ALP + r16 * XS + 32 * ks + 8 * q), fk = *(const LAS bf16x8*)(KT + r16 * XS + 32 * ks + 8 * q);
            const bf16x8 fkp = *(const LAS bf16x8*)(KAP + r16 * XS + 32 * ks + 8 * q), fr = *(const LAS bf16x8*)(RT + r16 * XS + 32 * ks + 8 * q);
            alt = __builtin_amdgcn_mfma_f32_16x16x32_bf16(fa, fkp, alt, 0, 0, 0); blt = __builtin_amdgcn_mfma_f32_16x16x32_bf16(fk, fkp, blt, 0, 0, 0);
            qlt = __builtin_amdgcn_mfma_f32_16x16x32_bf16(fa, fr, qlt, 0, 0, 0);  plt = __builtin_amdgcn_mfma_f32_16x16x32_bf16(fk, fr, plt, 0, 0, 0);
        }
#pragma unroll
        for (int j = 0; j < 4; ++j) { const int s = 4 * q + j; const bool lt = s < r16, le = s <= r16;
            alt[j] = lt ? alt[j] : 0.f; blt[j] = lt ? blt[j] : 0.f; qlt[j] = le ? qlt[j] : 0.f; plt[j] = le ? plt[j] : 0.f; }
        *(LAS v2u*)(BL + r16 * SS16 + 4 * q) = pack4(blt); *(LAS v2u*)(QL + r16 * SS16 + 4 * q) = pack4(qlt); *(LAS v2u*)(PL + r16 * SS16 + 4 * q) = pack4(plt);
        *(LAS v2u*)(BL + r16 * SS16 + 16 + 4 * q) = zero2; *(LAS v2u*)(QL + r16 * SS16 + 16 + 4 * q) = zero2; *(LAS v2u*)(PL + r16 * SS16 + 16 + 4 * q) = zero2;
        float x[RC];
#pragma unroll
        for (int t = 0; t < RC; ++t) {
            float acc = (t == r16) ? 1.f : 0.f;
#pragma unroll
            for (int s2 = 0; s2 < t; ++s2) { const float a_ts = __uint_as_float(__builtin_amdgcn_readlane(__float_as_uint(alt[s2 & 3]), 16 * (s2 >> 2) + t)); acc -= a_ts * x[s2]; }
            x[t] = acc;
        }
        if (q == 0) {
#pragma unroll
            for (int t = 0; t < RC; ++t) { TB[t * SS16 + r16] = f2b(x[t]); TB[t * SS16 + 16 + r16] = 0; }
        }
    }
    LDS_WAIT(); asm volatile("" ::: "memory");
    const bf16x8 zf = {0, 0, 0, 0, 0, 0, 0, 0};
    const bf16x8 tbf = *(const LAS bf16x8*)(TB + r16 * SS16 + 8 * q), blf = *(const LAS bf16x8*)(BL + r16 * SS16 + 8 * q);
    const bf16x8 qlf = *(const LAS bf16x8*)(QL + r16 * SS16 + 8 * q), plf = *(const LAS bf16x8*)(PL + r16 * SS16 + 8 * q);
    const f32x4 z4 = {0.f, 0.f, 0.f, 0.f};
    bf16* gWH = (bf16*)(RO + RO_WH) + (size_t)it * 1024; bf16* gRH = (bf16*)(RO + RO_RH) + (size_t)it * 1024;
    bf16* gET = (bf16*)(RO + RO_ET) + (size_t)it * 1024; bf16* gOL = (bf16*)(RO + RO_OL) + (size_t)it * 1024;
#pragma unroll
    for (int kt = 0; kt < 4; ++kt) {
        const bf16x8 kf = (q < 2) ? *(const LAS bf16x8*)(KAPT + (16 * kt + r16) * TS + 8 * q) : zf;
        const f32x4 wa = __builtin_amdgcn_mfma_f32_16x16x32_bf16(kf, tbf, z4, 0, 0, 0);
        *(v2u*)(gWH + r16 * 64 + 16 * kt + 4 * q) = pack4(wa);
        const f32x4 wb = __builtin_amdgcn_mfma_f32_16x16x32_bf16(tbf, kf, z4, 0, 0, 0);
        *(LAS v2u*)(WT + (16 * kt + r16) * TS + 4 * q) = pack4(wb);
        const bf16x8 vf = (q < 2) ? *(const LAS bf16x8*)(VTL + (16 * kt + r16) * TS + 8 * q) : zf;
        const f32x4 bv = __builtin_amdgcn_mfma_f32_16x16x32_bf16(blf, vf, z4, 0, 0, 0);
        *(LAS v2u*)(BVT + (16 * kt + r16) * TS + 4 * q) = pack4(bv);
    }
    LDS_WAIT(); asm volatile("" ::: "memory");
#pragma unroll
    for (int vt = 0; vt < 4; ++vt) {
        const bf16x8 bf_ = (q < 2) ? *(const LAS bf16x8*)(BVT + (16 * vt + r16) * TS + 8 * q) : zf;
        const f32x4 e4 = __builtin_amdgcn_mfma_f32_16x16x32_bf16(tbf, bf_, z4, 0, 0, 0);
        const v2u ep = pack4(e4);
        *(LAS v2u*)(ETL + (16 * vt + r16) * TS + 4 * q) = ep; *(v2u*)(gET + (16 * vt + r16) * 16 + 4 * q) = ep;
    }
    LDS_WAIT(); asm volatile("" ::: "memory");
#pragma unroll
    for (int kt = 0; kt < 4; ++kt) {
        const bf16x8 wf = (q < 2) ? *(const LAS bf16x8*)(WT + (16 * kt + r16) * TS + 8 * q) : zf;
        const f32x4 qw = __builtin_amdgcn_mfma_f32_16x16x32_bf16(wf, qlf, z4, 0, 0, 0);
        const f32x4 rt4 = unpack4(*(const LAS v2u*)(RT + r16 * XS + 16 * kt + 4 * q));
        *(v2u*)(gRH + r16 * 64 + 16 * kt + 4 * q) = pack4(rt4 - qw);
        const bf16x8 vf = (q < 2) ? *(const LAS bf16x8*)(VTL + (16 * kt + r16) * TS + 8 * q) : zf;
        const bf16x8 ef = (q < 2) ? *(const LAS bf16x8*)(ETL + (16 * kt + r16) * TS + 8 * q) : zf;
        const f32x4 pv = __builtin_amdgcn_mfma_f32_16x16x32_bf16(vf, plf, z4, 0, 0, 0);
        const f32x4 qe = __builtin_amdgcn_mfma_f32_16x16x32_bf16(ef, qlf, z4, 0, 0, 0);
        *(v2u*)(gOL + r16 * 64 + 16 * kt + 4 * q) = pack4(pv - qe);
    }
    LDS_WAIT(); asm volatile("" ::: "memory");
}
__device__ __forceinline__ void ra_part(const Ctx& F, int part) {
    LAS unsigned* ctr = (LAS unsigned*)(F.lds + LDS_BYTES - 48) + part;
    LAS unsigned char* wl = F.lds + F.wave * RL_BYTES;
    for (;;) {
        unsigned idx = 0;
        if (F.lane == 0) idx = __hip_atomic_fetch_add(ctr, 1u, __ATOMIC_RELAXED, __HIP_MEMORY_SCOPE_WORKGROUP);
        idx = (unsigned)__builtin_amdgcn_readfirstlane((int)idx);
        const int it = (int)blockIdx.x + F.G * (int)idx;
        if (it >= RITEMS) break;
        ra_item(F, wl, it, part);
    }
}

__device__ __forceinline__ void rs_half(const Ctx& F, int half) {
    if (F.wave != 0) return;
    const unsigned char* RO = (const unsigned char*)F.out + (size_t)(half & 1) * RO_BUF; bf16* OY = (bf16*)(F.ws + WS_OY);
    float* SSg = (float*)((unsigned char*)F.out + RO_SS);
    LAS bf16* ST = (LAS bf16*)F.lds;
    LAS bf16* ZT = (LAS bf16*)(F.lds + 16 * XS * 2);
    constexpr int ZS = 24;
    const int lane = F.lane, r16 = lane & 15, q = lane >> 4;
    for (int blk = blockIdx.x; blk < NB * RHEADS * 4; blk += F.G) {
        const int xcd = blk & 7, jj = blk >> 3, qt = jj & 3, bh = (jj >> 2) * 8 + xcd, b = bh >> 4, h = bh & 15;
        f32x4 S[4];
        if (half == 0) {
#pragma unroll
            for (int kt = 0; kt < 4; ++kt) S[kt] = (f32x4){0.f, 0.f, 0.f, 0.f};
        } else {
#pragma unroll
            for (int kt = 0; kt < 4; ++kt) S[kt] = *(const f32x4*)(SSg + (size_t)blk * 1024 + (kt * 64 + lane) * 4);
        }
#pragma unroll
        for (int kt = 0; kt < 4; ++kt) *(LAS v2u*)(ST + r16 * XS + 16 * kt + 4 * q) = pack4(S[kt]);
        LDS_WAIT(); asm volatile("" ::: "memory");
        const size_t it0 = (size_t)bh * RHALF;
        const size_t mbase = (size_t)b * SEQ + (size_t)half * RHALF * RC;
#define RS_LOAD(IT, WF, RF, A2F, VF, ET4, OL4, GC4) do { const size_t it_ = (IT); \
        const bf16* wh_ = (const bf16*)(RO + RO_WH) + it_ * 1024 + r16 * 64 + 8 * q; const bf16* rh_ = (const bf16*)(RO + RO_RH) + it_ * 1024 + r16 * 64 + 8 * q; \
        WF[0] = *(const bf16x8*)wh_; WF[1] = *(const bf16x8*)(wh_ + 32); RF[0] = *(const bf16x8*)rh_; RF[1] = *(const bf16x8*)(rh_ + 32); \
        _Pragma("unroll") for (int kt_ = 0; kt_ < 4; ++kt_) { A2F[kt_] = *(const bf16x8*)((const bf16*)(RO + RO_A2) + it_ * 2048 + (16 * kt_ + r16) * 32 + 8 * q); \
            GC4[kt_] = *(const f32x4*)((const float*)(RO + RO_GC) + it_ * 64 + 16 * kt_ + 4 * q); } \
        VF = *(const bf16x8*)((const bf16*)(RO + RO_VT) + it_ * 1024 + (16 * qt + r16) * 16 + 8 * (q & 1)); \
        ET4 = *(const v2u*)((const bf16*)(RO + RO_ET) + it_ * 1024 + (16 * qt + r16) * 16 + 4 * q); \
        OL4 = *(const v2u*)((const bf16*)(RO + RO_OL) + it_ * 1024 + r16 * 64 + 16 * qt + 4 * q); } while (0)
        bf16x8 wfq[2][2], rfq[2][2], a2q[2][4], vfq[2]; v2u etq[2], olq[2]; f32x4 gcq[2][4];
#pragma unroll
        for (int u = 0; u < 2; ++u) RS_LOAD(it0 + u, wfq[u], rfq[u], a2q[u], vfq[u], etq[u], olq[u], gcq[u]);
#define RS_STEP(U, CL) do { const int cl_ = (CL); \
            const bf16x8 sb0 = *(const LAS bf16x8*)(ST + r16 * XS + 8 * q), sb1 = *(const LAS bf16x8*)(ST + r16 * XS + 32 + 8 * q); \
            f32x4 x1 = __builtin_amdgcn_mfma_f32_16x16x32_bf16(wfq[U][0], sb0, (f32x4){0.f, 0.f, 0.f, 0.f}, 0, 0, 0); \
            x1 = __builtin_amdgcn_mfma_f32_16x16x32_bf16(wfq[U][1], sb1, x1, 0, 0, 0); \
            f32x4 ot = __builtin_amdgcn_mfma_f32_16x16x32_bf16(sb0, rfq[U][0], unpack4(olq[U]), 0, 0, 0); \
            ot = __builtin_amdgcn_mfma_f32_16x16x32_bf16(sb1, rfq[U][1], ot, 0, 0, 0); \
            *(LAS v2u*)(ZT + r16 * ZS + 4 * q) = pack4(x1 + unpack4(etq[U])); \
            *(v2u*)(OY + (mbase + (size_t)cl_ * RC + r16) * DM + h * 64 + 16 * qt + 4 * q) = pack4(ot); \
            LDS_WAIT(); asm volatile("" ::: "memory"); \
            const bf16x8 zr = *(const LAS bf16x8*)(ZT + r16 * ZS + 8 * (q & 1)); \
            const bf16x8 bz = (q < 2) ? zr : vfq[U]; \
            _Pragma("unroll") for (int kt = 0; kt < 4; ++kt) { S[kt] = __builtin_amdgcn_mfma_f32_16x16x32_bf16(a2q[U][kt], bz, S[kt] * gcq[U][kt], 0, 0, 0); \
                *(LAS v2u*)(ST + r16 * XS + 16 * kt + 4 * q) = pack4(S[kt]); } \
            RS_LOAD(it0 + ((cl_ + 2 < RHALF) ? cl_ + 2 : RHALF - 1), wfq[U], rfq[U], a2q[U], vfq[U], etq[U], olq[U], gcq[U]);     \
            LDS_WAIT(); asm volatile("" ::: "memory"); } while (0)
#pragma unroll 1
        for (int cl = 0; cl < RHALF; cl += 2) { RS_STEP(0, cl); RS_STEP(1, cl + 1); }
#undef RS_STEP
#undef RS_LOAD
        if (half + 1 < NPART) {
#pragma unroll
            for (int kt = 0; kt < 4; ++kt) *(f32x4*)(SSg + (size_t)blk * 1024 + (kt * 64 + lane) * 4) = S[kt];
        }
    }
}
__device__ __forceinline__ float rowmax16(float x) { x = fmaxf(x, dpp_f<0xB1>(x)); x = fmaxf(x, dpp_f<0x4E>(x)); x = fmaxf(x, dpp_f<0x124>(x)); x = fmaxf(x, dpp_f<0x128>(x)); return x; }
__device__ __forceinline__ int cand_code(int s) {
    if (s < 16) return s << 4;
    if (s < 24) return 1 | ((s - 16) << 4);
    if (s < 29) return 2 | ((s - 24) << 4);
    if (s < 33) return 3 | ((s - 29) << 4);
    if (s < 36) return 4 | ((s - 33) << 4);
    if (s < 42) { const int k = s - 36; return (5 + (k >> 1)) | ((k & 1) << 4); }
    if (s < 50) return 8 + (s - 42);
    return -1;
}
__device__ __forceinline__ int f2ord(float f) { const int b = __float_as_int(f); return b ^ ((b >> 31) & 0x7fffffff); }
__device__ __forceinline__ float ord2f(int k) { return __int_as_float(k ^ ((k >> 31) & 0x7fffffff)); }
template <int CTRL> __device__ __forceinline__ int dpp_i(int x) { return __builtin_amdgcn_mov_dpp(x, CTRL, 0xf, 0xf, true); }
__device__ __forceinline__ int imax(int a, int b) { return a > b ? a : b; }
__device__ __forceinline__ int imin(int a, int b) { return a < b ? a : b; }
__device__ __forceinline__ int rowmax16_i(int x) { x = imax(x, dpp_i<0xB1>(x)); x = imax(x, dpp_i<0x4E>(x)); x = imax(x, dpp_i<0x124>(x)); x = imax(x, dpp_i<0x128>(x)); return x; }
#define CSWAP_(a, b) do { const int hi_ = imax(a, b), lo_ = imin(a, b); a = hi_; b = lo_; } while (0)
template <int NV> __device__ __forceinline__ void sort_desc(int (&v)[NV]);
template <> __device__ __forceinline__ void sort_desc<8>(int (&v)[8]) {
    CSWAP_(v[0], v[1]); CSWAP_(v[2], v[3]); CSWAP_(v[4], v[5]); CSWAP_(v[6], v[7]);
    CSWAP_(v[0], v[2]); CSWAP_(v[1], v[3]); CSWAP_(v[4], v[6]); CSWAP_(v[5], v[7]);
    CSWAP_(v[1], v[2]); CSWAP_(v[5], v[6]);
    CSWAP_(v[0], v[4]); CSWAP_(v[1], v[5]); CSWAP_(v[2], v[6]); CSWAP_(v[3], v[7]);
    CSWAP_(v[2], v[4]); CSWAP_(v[3], v[5]);
    CSWAP_(v[1], v[2]); CSWAP_(v[3], v[4]); CSWAP_(v[5], v[6]);
}
template <> __device__ __forceinline__ void sort_desc<4>(int (&v)[4]) {
    CSWAP_(v[0], v[1]); CSWAP_(v[2], v[3]); CSWAP_(v[0], v[2]); CSWAP_(v[1], v[3]); CSWAP_(v[1], v[2]);
}
template <int NV>
__device__ __forceinline__ void select16x4(int (&v)[4][NV], int r16, float (&kept_f)[4]) {
    const int IMIN = (int)0x80000000;
    int kept[4];
#pragma unroll
    for (int j = 0; j < 4; ++j) { kept[j] = IMIN; sort_desc<NV>(v[j]); }
#pragma unroll 1
    for (int rd = 0; rd < 16; ++rd) {
#pragma unroll
        for (int j = 0; j < 4; ++j) {
            const int m = rowmax16_i(v[j][0]);
            kept[j] = (r16 == rd) ? m : kept[j];
            const bool own = (v[j][0] == m);
#pragma unroll
            for (int i = 0; i < NV - 1; ++i) v[j][i] = own ? v[j][i + 1] : v[j][i];
            v[j][NV - 1] = own ? IMIN : v[j][NV - 1];
        }
    }
#pragma unroll
    for (int j = 0; j < 4; ++j) kept_f[j] = ord2f(kept[j]);
}
__device__ __forceinline__ float dot2bf(unsigned a, unsigned b, float acc) { return __builtin_amdgcn_fdot2_f32_bf16(__builtin_bit_cast(bf16x2_t, a), __builtin_bit_cast(bf16x2_t, b), acc, false); }

constexpr int PT = 16;
constexpr size_t RANGE_BYTES = (size_t)NEXP * 128;

__device__ __forceinline__ void p9_route(const Ctx& F) {
    constexpr int KSTR = 136;
    const bf16* Q = (const bf16*)(F.ws + WS_Q); const bf16* KEYS = (const bf16*)(F.ws + WS_KEYS);
    int* rtE = (int*)(F.ws + WS_RTE); float* rtG = (float*)(F.ws + WS_RTG);
    LAS bf16* KL = (LAS bf16*)F.lds;
    const int lane = F.lane, w = F.wave, r16 = lane & 15, q = lane >> 4, gbase = lane & 48;
    const int h = blockIdx.x & 7, nbh = (F.G - h + 7) >> 3;
    __syncthreads();
    for (int i = F.tid; i < 2 * 128 * 16; i += NTHR) { const int row = i >> 4, ch = i & 15;
        *(LAS v4u*)(KL + row * KSTR + 8 * ch) = *(const v4u*)(KEYS + (size_t)(2 * h * 128 + row) * 128 + 8 * ch); }
    __syncthreads();
    int ci[4], cj[4]; bool cvalid[4];
#pragma unroll
    for (int u = 0; u < 4; ++u) { const int cd = cand_code(r16 + 16 * u); cvalid[u] = cd >= 0; ci[u] = cd & 15; cj[u] = (cd >> 4) & 15; }
    const float NINF = -__builtin_inff();
    const int tstride = nbh * NWAVES;
    int tile = (blockIdx.x >> 3) * NWAVES + w;
    bf16x8 afn[2][4];
    if (tile < M / PT) {
#pragma unroll
        for (int p = 0; p < 2; ++p)
#pragma unroll
            for (int s = 0; s < 4; ++s) afn[p][s] = *(const bf16x8*)(Q + (size_t)(tile * PT + r16) * DM + (2 * h + p) * 128 + 8 * q + 32 * s);
    }
    for (; tile < M / PT; tile += tstride) {
        const int m0 = tile * PT;
        bf16x8 af[2][4];
#pragma unroll
        for (int p = 0; p < 2; ++p)
#pragma unroll
            for (int s = 0; s < 4; ++s) af[p][s] = afn[p][s];
        { const int tn = (tile + tstride < M / PT) ? tile + tstride : tile;
#pragma unroll
            for (int p = 0; p < 2; ++p)
#pragma unroll
                for (int s = 0; s < 4; ++s) afn[p][s] = *(const bf16x8*)(Q + (size_t)(tn * PT + r16) * DM + (2 * h + p) * 128 + 8 * q + 32 * s);
        }
        float top[2][4];
#pragma unroll
        for (int p = 0; p < 2; ++p) {
            int v[4][8];
#pragma unroll
            for (int nt = 0; nt < 8; ++nt) {
                const LAS bf16* krow = KL + (p * 128 + nt * 16 + r16) * KSTR + 8 * q;
                f32x4 acc = {0.f, 0.f, 0.f, 0.f};
#pragma unroll
                for (int s = 0; s < 4; ++s) acc = __builtin_amdgcn_mfma_f32_16x16x32_bf16(af[p][s], *(const LAS bf16x8*)(krow + 32 * s), acc, 0, 0, 0);
                const unsigned tag = 127u - (unsigned)(nt * 16 + r16);
#pragma unroll
                for (int j = 0; j < 4; ++j) v[j][nt] = f2ord(__uint_as_float((__float_as_uint(acc[j]) & ~127u) | tag));
                if (nt & 1) asm volatile("" ::: "memory");
            }
            select16x4<8>(v, r16, top[p]);
        }
        int cv[4][4];
#pragma unroll
        for (int u = 0; u < 4; ++u)
#pragma unroll
            for (int j = 0; j < 4; ++j) {
                const float a = __shfl(top[0][j], gbase + ci[u]), b = __shfl(top[1][j], gbase + cj[u]);
                const float cs = __uint_as_float(__float_as_uint(a) & ~127u) + __uint_as_float(__float_as_uint(b) & ~127u);
                const float pk = __uint_as_float((__float_as_uint(cs) & ~63u) | (63u - (unsigned)(r16 + 16 * u)));
                cv[j][u] = cvalid[u] ? f2ord(pk) : (int)0x80000000;
            }
        float best[4];
        select16x4<4>(cv, r16, best);
#pragma unroll
        for (int j = 0; j < 4; ++j) {
            const unsigned bb = __float_as_uint(best[j]);
            const int cd = cand_code(63 - (int)(bb & 63u));
            const int k0 = 127 - (int)(__float_as_uint(__shfl(top[0][j], gbase + (cd & 15))) & 127u);
            const int k1 = 127 - (int)(__float_as_uint(__shfl(top[1][j], gbase + ((cd >> 4) & 15))) & 127u);
            const float s = __uint_as_float(bb & ~63u);
            const float mx = rowmax16(s), e = __expf(s - mx), sum = rowsum16(e);
            const size_t o = (size_t)(m0 + 4 * q + j) * 128 + h * 16 + r16;
            rtE[o] = k0 * 128 + k1; rtG[o] = e * rcp_f(sum);
        }
    }
}

__device__ __forceinline__ f32x2 cvt2_fp8(unsigned wd, bool hi) { return hi ? __builtin_amdgcn_cvt_pk_f32_fp8((int)wd, true) : __builtin_amdgcn_cvt_pk_f32_fp8((int)wd, false); }
__device__ __forceinline__ void treduce8x16(const float (&p)[16], bool b0, bool b1, bool b2, float& r0, float& r1) {
    float a[8], bq[4];
#pragma unroll
    for (int i = 0; i < 8; ++i) { const float mine = b2 ? p[i + 8] : p[i], send = b2 ? p[i] : p[i + 8]; const float up = dpp_f<0x104>(send), dn = dpp_f<0x114>(send); a[i] = mine + (b2 ? dn : up); }
#pragma unroll
    for (int i = 0; i < 4; ++i) { const float mine = b1 ? a[i + 4] : a[i], send = b1 ? a[i] : a[i + 4]; bq[i] = mine + dpp_f<0x4E>(send); }
    { const float mine = b0 ? bq[2] : bq[0], send = b0 ? bq[0] : bq[2]; r0 = mine + dpp_f<0xB1>(send); }
    { const float mine = b0 ? bq[3] : bq[1], send = b0 ? bq[1] : bq[3]; r1 = mine + dpp_f<0xB1>(send); }
}
struct XGroup { int xg, gwi, stride; };
__device__ __forceinline__ XGroup xgroup(const Ctx& F) { XGroup g; g.xg = blockIdx.x & 7; const int nbg = (F.G - g.xg + 7) >> 3; g.gwi = (blockIdx.x >> 3) * NWAVES + F.wave; g.stride = nbg * NWAVES; return g; }

__device__ __forceinline__ void p10_peer_u(const Ctx& F) {
    const unsigned char* PU8 = F.ws + WS_PU8; const bf16* XN = (const bf16*)(F.ws + WS_XN);
    const int* rtE = (const int*)(F.ws + WS_RTE); unsigned* PD = (unsigned*)(F.ws + WS_PD);
    const XGroup g = xgroup(F);
    const int lane = F.lane, j = lane >> 3, sub = lane & 7;
    const bool b0 = sub & 1, b1 = sub & 2, b2 = sub & 4;
    for (int rr = 0; rr < 2; ++rr) {
        const int r = g.xg + 8 * rr;
        const unsigned char* tab = PU8 + (size_t)r * RANGE_BYTES;
        const unsigned so = 16u * (unsigned)sub;
        int m = g.gwi;
        v4u ev[4], xs[2];
        if (m < M) {
#pragma unroll
            for (int i = 0; i < 4; ++i) ev[i] = *(const v4u*)(rtE + (size_t)m * 128 + 16 * j + 4 * i);
            xs[0] = *(const v4u*)(XN + (size_t)m * DM + 128 * r + 16 * sub); xs[1] = *(const v4u*)(XN + (size_t)m * DM + 128 * r + 16 * sub + 8);
        }
        for (; m < M; m += g.stride) {
            v4u gt[16];
#pragma unroll
            for (int k = 0; k < 16; ++k) gt[k] = *(const v4u*)(tab + (ev[k >> 2][k & 3] * 128u + so));
            float x[16]; { float t0[8], t1[8]; unpack8(xs[0], t0); unpack8(xs[1], t1);
#pragma unroll
              for (int i = 0; i < 8; ++i) { x[i] = t0[i]; x[8 + i] = t1[i]; } }
            const int mn = (m + g.stride < M) ? m + g.stride : m;
            {
#pragma unroll
                for (int i = 0; i < 4; ++i) ev[i] = *(const v4u*)(rtE + (size_t)mn * 128 + 16 * j + 4 * i);
                xs[0] = *(const v4u*)(XN + (size_t)mn * DM + 128 * r + 16 * sub); xs[1] = *(const v4u*)(XN + (size_t)mn * DM + 128 * r + 16 * sub + 8);
            }
            float p[16];
#pragma unroll
            for (int k = 0; k < 16; ++k) {
                f32x2 a0 = {0.f, 0.f}, a1 = {0.f, 0.f};
#pragma unroll
                for (int d = 0; d < 4; ++d) { const unsigned wd = gt[k][d];
                    a0 += cvt2_fp8(wd, false) * (f32x2){x[4 * d], x[4 * d + 1]}; a1 += cvt2_fp8(wd, true) * (f32x2){x[4 * d + 2], x[4 * d + 3]}; }
                p[k] = (a0.x + a0.y) + (a1.x + a1.y);
            }
            float r0, r1; treduce8x16(p, b0, b1, b2, r0, r1);
            PD[((size_t)r * M + m) * 64 + lane] = pk2(r0, r1);
        }
    }
}

__device__ __forceinline__ void p11_peer_coef(const Ctx& F) {
    const int* rtE = (const int*)(F.ws + WS_RTE); const float* rtG = (const float*)(F.ws + WS_RTG); const unsigned* PD = (const unsigned*)(F.ws + WS_PD);
    const float* usc = (const float*)(F.ws + WS_USC); const float* vsc = (const float*)(F.ws + WS_VSC); float* COEF = (float*)(F.ws + WS_COEF);
    for (int m = F.gw; m < M; m += F.NGW) {
        const size_t o = (size_t)m * 128 + 2 * F.lane;
        f32x2 d = {0.f, 0.f};
#pragma unroll
        for (int r = 0; r < 16; ++r) { const unsigned pw = PD[((size_t)r * M + m) * 64 + F.lane]; d += (f32x2){bflo(pw), bfhi(pw)}; }
        const int e0 = rtE[o], e1 = rtE[o + 1];
        const f32x2 gt = *(const f32x2*)(rtG + o);
        const float d0 = d.x * usc[e0], d1 = d.y * usc[e1];
        f32x2 c; c.x = gt.x * (0.5f * d0 * (1.f + erff(d0 * 0.70710678f))) * vsc[e0]; c.y = gt.y * (0.5f * d1 * (1.f + erff(d1 * 0.70710678f))) * vsc[e1];
        *(f32x2*)(COEF + o) = c;
    }
}

__device__ __forceinline__ void p12_peer_v(const Ctx& F) {
    const unsigned char* PV4 = F.ws + WS_PV8; const int* rtE = (const int*)(F.ws + WS_RTE); const float* COEF = (const float*)(F.ws + WS_COEF);
    const float* mod = (const float*)(F.ws + WS_MOD);
    const XGroup g = xgroup(F);
    const int lane = F.lane, j = lane >> 3, sub = lane & 7;
    const bool jb0 = j & 1;
    const int r = g.xg;
    const unsigned char* tab = PV4 + (size_t)r * RANGE_BYTES;
    const unsigned so = 16u * (unsigned)sub;
    int m = g.gwi;
    if (m >= M) return;
    const int st = g.stride;
#define PV_LDE(e, mm, hf) { e[0] = *(const v4u*)(rtE + (size_t)(mm) * 128 + 16 * j + 8 * (hf)); e[1] = *(const v4u*)(rtE + (size_t)(mm) * 128 + 16 * j + 8 * (hf) + 4); }
#define PV_LDC(c, mm, hf) { c[0] = *(const f32x4*)(COEF + (size_t)(mm) * 128 + 16 * j + 8 * (hf)); c[1] = *(const f32x4*)(COEF + (size_t)(mm) * 128 + 16 * j + 8 * (hf) + 4); }
#define PV_GATHER(gx, e) { _Pragma("unroll") for (int k = 0; k < 8; ++k) gx[k] = *(const v4u*)(tab + (e[k >> 2][k & 3] * 128u + so)); }
#define PV_ACC(gx, c) { _Pragma("unroll") for (int k = 0; k < 8; ++k) { const float cq = c[k >> 2][k & 3]; const f32x2 cv2 = {cq, cq}; \
        _Pragma("unroll") for (int d = 0; d < 4; ++d) { const unsigned wd = gx[k][d]; \
            acc[4 * d + 0] += cv2 * __builtin_amdgcn_cvt_scalef32_pk_f32_fp4(wd, 1.0f, 0); acc[4 * d + 1] += cv2 * __builtin_amdgcn_cvt_scalef32_pk_f32_fp4(wd, 1.0f, 1); \
            acc[4 * d + 2] += cv2 * __builtin_amdgcn_cvt_scalef32_pk_f32_fp4(wd, 1.0f, 2); acc[4 * d + 3] += cv2 * __builtin_amdgcn_cvt_scalef32_pk_f32_fp4(wd, 1.0f, 3); } } }
    v4u eA1[2], eB0[2], gA[8], gB[8]; f32x4 cA0[2], cA1[2], cB0[2];
    { v4u eA0[2]; PV_LDE(eA0, m, 0); PV_LDC(cA0, m, 0); PV_LDE(eB0, m, 1); PV_LDC(cB0, m, 1);
      const int m1 = (m + st < M) ? m + st : m; PV_LDE(eA1, m1, 0); PV_LDC(cA1, m1, 0);
      PV_GATHER(gA, eA0); }
    for (; m < M; m += st) {
        const int m1 = (m + st < M) ? m + st : m, m2 = (m + 2 * st < M) ? m + 2 * st : m;
        const int col = 256 * r + 32 * sub + 4 * j;
        v2u* orow = (v2u*)((bf16*)(F.ws + WS_HB) + (size_t)m * DM + col);
        const v2u hw = *orow; const f32x4 g2 = *(const f32x4*)(mod + (size_t)(m / SEQ) * MODW + 5 * DM + col);
        PV_GATHER(gB, eB0);
        v4u eB1[2], eA2[2]; f32x4 cB1[2], cA2[2];
        PV_LDE(eB1, m1, 1); PV_LDC(cB1, m1, 1); PV_LDE(eA2, m2, 0); PV_LDC(cA2, m2, 0);
        asm volatile("" : "+v"(gA[0]), "+v"(gA[1]), "+v"(gA[2]), "+v"(gA[3]), "+v"(gA[4]), "+v"(gA[5]), "+v"(gA[6]), "+v"(gA[7]) :: "memory");
        f32x2 acc[16];
#pragma unroll
        for (int i = 0; i < 16; ++i) acc[i] = (f32x2){0.f, 0.f};
        PV_ACC(gA, cA0);
        asm volatile("" ::: "memory");
        PV_GATHER(gA, eA1);
        asm volatile("" : "+v"(gB[0]), "+v"(gB[1]), "+v"(gB[2]), "+v"(gB[3]), "+v"(gB[4]), "+v"(gB[5]), "+v"(gB[6]), "+v"(gB[7]) :: "memory");
        PV_ACC(gB, cB0);
        float a[32];
#pragma unroll
        for (int i = 0; i < 16; ++i) { a[2 * i] = acc[i].x; a[2 * i + 1] = acc[i].y; }
        float s16[16], s8[8];
#pragma unroll
        for (int c = 0; c < 16; ++c) { auto rr2 = __builtin_amdgcn_permlane32_swap(__float_as_uint(a[c]), __float_as_uint(a[c + 16]), false, false); s16[c] = __uint_as_float(rr2[0]) + __uint_as_float(rr2[1]); }
#pragma unroll
        for (int c = 0; c < 8; ++c) { auto rr2 = __builtin_amdgcn_permlane16_swap(__float_as_uint(s16[c]), __float_as_uint(s16[c + 8]), false, false); s8[c] = __uint_as_float(rr2[0]) + __uint_as_float(rr2[1]); }
        f32x4 res;
#pragma unroll
        for (int c = 0; c < 4; ++c) { const float mine = jb0 ? s8[c + 4] : s8[c], send = jb0 ? s8[c] : s8[c + 4]; res[c] = mine + dpp_f<0x128>(send); }
        const f32x4 h1 = {bflo(hw.x), bfhi(hw.x), bflo(hw.y), bfhi(hw.y)};
        const f32x4 h2 = h1 + g2 * res;
        v2u o; o.x = pk2(h2.x, h2.y); o.y = pk2(h2.z, h2.w);
        *orow = o;
#pragma unroll
        for (int i = 0; i < 2; ++i) { cA0[i] = cA1[i]; cA1[i] = cA2[i]; eA1[i] = eA2[i]; eB0[i] = eB1[i]; cB0[i] = cB1[i]; }
    }
#undef PV_LDE
#undef PV_LDC
#undef PV_GATHER
#undef PV_ACC
}
#define XB_TMO      128
#define XB_XCNT(j)  (256  + 64 * (j))
#define XB_XSUB(j)  (1280 + 64 * (j))
#define XB_XGEN(j)  (2304 + 64 * (j))
#define XB_TOP      3328
#define XB_TOPGEN   3392
#define XCD_BAR_WORDS 3456
#define XB_SPIN_CAP (1u << 18)

__device__ __forceinline__ unsigned xb_ld(unsigned* p)              { return __hip_atomic_load(p, __ATOMIC_RELAXED, __HIP_MEMORY_SCOPE_AGENT); }
__device__ __forceinline__ unsigned xb_add(unsigned* p, unsigned v) { return __hip_atomic_fetch_add(p, v, __ATOMIC_RELAXED, __HIP_MEMORY_SCOPE_AGENT); }
__device__ __forceinline__ unsigned xb_xcc_id() { return (unsigned)__builtin_amdgcn_s_getreg((3 << 11) | 20) & 0xFu; }
#define XB_SPIN(cond, bar) do { unsigned _sp = 0; while (cond) { __builtin_amdgcn_s_sleep(1); \
    if ((++_sp & 255u) == 0u) { if (xb_ld(&(bar)[XB_TMO])) break; if (_sp > XB_SPIN_CAP) { atomicAdd(&(bar)[XB_TMO], 1u); break; } } } } while (0)

struct XcdBarrier {
    unsigned* bar; unsigned x;
    volatile LAS unsigned* st;
};

__device__ __forceinline__ XcdBarrier xcd_barrier_post(unsigned* bar, volatile LAS unsigned* st) {
    XcdBarrier b; b.bar = bar; b.x = xb_xcc_id(); b.st = st;
    if (threadIdx.x == 0) (void)xb_add(&bar[XB_XCNT(b.x)], 1u);
    return b;
}
__device__ __forceinline__ void xcd_barrier_complete(unsigned* bar, unsigned x, unsigned& nloc, unsigned& nx) {
    const unsigned G = gridDim.x * gridDim.y * gridDim.z;
    unsigned sum, cnt, mine, sp = 0u;
    for (;;) {
        sum = 0u; cnt = 0u; mine = 0u;
#pragma unroll
        for (unsigned j = 0; j < 16; ++j) { const unsigned c = xb_ld(&bar[XB_XCNT(j)]); sum += c; cnt += (c > 0u) ? 1u : 0u; mine = (j == x) ? c : mine; }
        if (sum == G) break;
        __builtin_amdgcn_s_sleep(1);
        if ((++sp & 255u) == 0u) { if (xb_ld(&bar[XB_TMO])) break; if (sp > XB_SPIN_CAP) { atomicAdd(&bar[XB_TMO], 1u); break; } }
    }
    nloc = mine > 0u ? mine : 1u; nx = cnt > 0u ? cnt : 1u;
}

__device__ __forceinline__ void xcd_barrier(const XcdBarrier& b) {
    asm volatile("s_waitcnt vmcnt(0)" ::: "memory");
    __syncthreads();
    if (threadIdx.x == 0) {
        unsigned* bar = b.bar;
        __builtin_amdgcn_s_waitcnt(0);
        unsigned nloc = b.st[0], nx = b.st[1];
        if (nloc == 0u) { xcd_barrier_complete(bar, b.x, nloc, nx); b.st[0] = nloc; b.st[1] = nx; }
        const unsigned old = xb_add(&bar[XB_XSUB(b.x)], 1u);
        const unsigned gen = old / nloc;
        if (old + 1u == (gen + 1u) * nloc) {
            __builtin_amdgcn_fence(__ATOMIC_RELEASE, "agent");
            asm volatile("s_waitcnt vmcnt(0)" ::: "memory");
            const unsigned og = xb_add(&bar[XB_TOP], 1u);
            const unsigned tg = og / nx;
            if (og + 1u == (tg + 1u) * nx) xb_add(&bar[XB_TOPGEN], 1u);
            else XB_SPIN(xb_ld(&bar[XB_TOPGEN]) == tg, bar);
            __builtin_amdgcn_fence(__ATOMIC_ACQUIRE, "agent");
            xb_add(&bar[XB_XGEN(b.x)], 1u);
            asm volatile("s_waitcnt vmcnt(0)" ::: "memory");
        } else {
            XB_SPIN(xb_ld(&bar[XB_XGEN(b.x)]) == gen, bar);
            __builtin_amdgcn_fence(__ATOMIC_ACQUIRE, "agent");
            asm volatile("s_waitcnt vmcnt(0)" ::: "memory");
        }
    }
    __syncthreads();
}

struct Args { const float* in[N_IN]; float* out; unsigned char* ws; int ph_lo, ph_hi; };
constexpr int N_PHASES = 19;

__global__ void __launch_bounds__(NTHR, 2) fwd_kernel(Args args) {
    extern __shared__ __attribute__((aligned(16))) unsigned char lds_raw[];
    cg::grid_group grid = cg::this_grid();
    Ctx F;
    F.lds = (LAS unsigned char*)lds_raw;
    F.tid = threadIdx.x; F.lane = F.tid & 63; F.wave = __builtin_amdgcn_readfirstlane(F.tid >> 6);
    F.G = gridDim.x; F.gw = blockIdx.x * NWAVES + F.wave; F.NGW = F.G * NWAVES;
    F.in = args.in; F.out = args.out; F.ws = args.ws;
    const int lo = args.ph_lo, hi = args.ph_hi;
    volatile LAS unsigned* bst = (volatile LAS unsigned*)(F.lds + LDS_BYTES - 64);
    if (F.tid < 2) bst[F.tid] = 0u;
    if (F.tid < 4) ((volatile LAS unsigned*)(F.lds + LDS_BYTES - 48))[F.tid] = 0u;
    __syncthreads();
    const XcdBarrier bar = xcd_barrier_post((unsigned*)(F.ws + WS_CTL) + 4096, bst);
#define IN(k) (lo <= (k) && (k) < hi)
#ifndef TS_A
#define TS_A -1
#define TS_B -1
#define TS_K 0.1
#endif
    unsigned long long* stamps = (unsigned long long*)(F.ws + WS_CTL + 65536);
#define STAMP(k) do { if (TS_A >= 0 && blockIdx.x == 0 && F.tid == 0) stamps[k] = __builtin_amdgcn_s_memrealtime(); } while (0)
#define REP_MASK 0
#ifndef REP_MASK
#define REP_MASK 0
#endif
#define REPS(k) for (int rep_ = 0; rep_ < 1 + ((REP_MASK >> (k)) & 1); ++rep_)
#define SEAM(k) do { if (IN(k) && IN((k) + 1)) { if ((k) == 0) grid.sync(); else xcd_barrier(bar); } } while (0)

    STAMP(0);
    if (IN(0)) REPS(0) { p0_prologue(F); }
    SEAM(0);
    STAMP(1);
    if (IN(1)) REPS(1) { norm_mod_rows(F, F.in[I_X], F.in[I_N1W], 0, DM, (bf16*)(F.ws + WS_XN)); }
    SEAM(1);
    STAMP(2);
    if (IN(2)) REPS(2) {
        pg8::Gemm g{(const pg8::bf16_t*)(F.ws + WS_XN), (const pg8::bf16_t*)(F.ws + WS_WIN), M, INPP, DM};
        pg8::StaticOrder S; S.init(M, INPP, F.G, (int)blockIdx.x);
        pg8::EpiStoreBf16 E{(pg8::bf16_t*)(F.ws + WS_PROJ), INPP};
        pg8::gemm_phase<pg8::EpiStoreBf16, pg8::StaticOrder, true, true>(F.lds, g, S, E);
    }
    SEAM(2);
#ifndef P3REP
#define P3REP 0
#endif
    STAMP(3);
    if (IN(3)) REPS(3) { p3_lora(F); STAMP(40); m1_chunk_states(F); }
    SEAM(3);
    STAMP(4);
    if (IN(4)) { m2_prefix(F); ra_part(F, 0); }
    SEAM(4);
    STAMP(5);
    if (IN(5)) { rs_half(F, 0); ra_part(F, 1); }
    SEAM(5);
    STAMP(6);
    if (IN(6)) { rs_half(F, 1); ra_part(F, 2); }
    SEAM(6);
    STAMP(7);
    if (IN(7)) { rs_half(F, 2); ra_part(F, 3); }
    SEAM(7);
    STAMP(8);
    if (IN(8)) { rs_half(F, 3); }
    STAMP(9);
    if (IN(9)) REPS(9) { m3_outputs(F); }
    SEAM(9);
    STAMP(10);
    if (IN(10)) { p5_post(F); }
    SEAM(10);
    STAMP(11);
    if (IN(11)) REPS(11) {
        pg8::Gemm g{(const pg8::bf16_t*)(F.ws + WS_OY), (const pg8::bf16_t*)(F.ws + WS_WOUT), M, DM, DM};
        pg8::StaticOrder S; S.init(M, DM, F.G, (int)blockIdx.x);
        pg8::EpiResid E{F.in[I_X], (const float*)(F.ws + WS_MOD) + 2 * DM, (pg8::bf16_t*)(F.ws + WS_HB), DM, SEQ, MODW};
        pg8::gemm_phase<pg8::EpiResid, pg8::StaticOrder, true, true>(F.lds, g, S, E);
    }
    SEAM(11);
    STAMP(12);
    if (IN(12)) REPS(12) { norm_mod_rows_bf16(F, (const bf16*)(F.ws + WS_HB), F.in[I_N2W], 3 * DM, 4 * DM, (bf16*)(F.ws + WS_XN)); }
    SEAM(12);
    STAMP(13);
    if (IN(13)) REPS(13) {
        pg8::Gemm g{(const pg8::bf16_t*)(F.ws + WS_XN), (const pg8::bf16_t*)(F.ws + WS_WQ), M, DM, DM};
        pg8::StaticOrder S; S.init(M, DM, F.G, (int)blockIdx.x);
        pg8::EpiStoreBf16 E{(pg8::bf16_t*)(F.ws + WS_Q), DM};
        pg8::gemm_phase<pg8::EpiStoreBf16, pg8::StaticOrder, true, true>(F.lds, g, S, E);
    }
    SEAM(13);
    STAMP(14);
    if (IN(14)) REPS(14) { p9_route(F); }
    SEAM(14);
    STAMP(15);
    if (IN(15)) REPS(15) { p10_peer_u(F); }
    SEAM(15);
    STAMP(16);
    if (IN(16)) REPS(16) { p11_peer_coef(F); }
    SEAM(16);
    STAMP(17);
    if (IN(17)) { p12_peer_v(F); }
    SEAM(17);
    STAMP(18);
    if (IN(18)) {
        float oscale = 1.f;
        if (TS_A >= 0) { const volatile unsigned long long* st = stamps; const float frac = (float)(st[TS_B] - st[TS_A]) / (float)(st[17] - st[0]); oscale = 1.f + (float)(TS_K) * frac; }
        final_norm_rows_bf16(F, (const bf16*)(F.ws + WS_HB), F.in[I_FNW], F.out, oscale);
    }
#undef IN
#undef SEAM
}

extern "C" void kernel_launch(void* const* d_in, const int* in_sizes, int n_in, void* d_out, int out_size, void* d_ws, size_t ws_size, hipStream_t stream) {
    static int grid = 0;
    if (grid == 0) {
        if (n_in != N_IN || in_sizes[0] != M * DM || out_size != M * DM || ws_size < WS_END2) {
            fprintf(stderr, "kernel_launch: unexpected shapes: n_in %d in0 %d out %d ws %zu (need %zu)\n", n_in, n_in > 0 ? in_sizes[0] : -1, out_size, ws_size, (size_t)WS_END2); grid = -1; return; }
        int dev = 0, cus = 0, per_cu = 0;
        if (hipGetDevice(&dev) != hipSuccess || hipDeviceGetAttribute(&cus, hipDeviceAttributeMultiprocessorCount, dev) != hipSuccess) { grid = -1; return; }
        if (hipFuncSetAttribute((const void*)fwd_kernel, hipFuncAttributeMaxDynamicSharedMemorySize, LDS_BYTES) != hipSuccess) { fprintf(stderr, "kernel_launch: hipFuncSetAttribute failed\n"); grid = -1; return; }
        if (hipOccupancyMaxActiveBlocksPerMultiprocessor(&per_cu, (const void*)fwd_kernel, NTHR, LDS_BYTES) != hipSuccess || per_cu < 1) { fprintf(stderr, "kernel_launch: occupancy query says %d blocks per CU\n", per_cu); per_cu = 1; }
        (void)hipGetLastError();
        grid = cus;
        fprintf(stderr, "kernel_launch: cus %d per_cu %d grid %d ws %zu\n", cus, per_cu, grid, ws_size);
    }
    if (grid < 0) return;
    (void)hipMemsetAsync((char*)d_ws + WS_CTL, 0, CTL_ZERO_BYTES, stream);
    Args a{};
    for (int i = 0; i < N_IN; ++i) a.in[i] = (const float*)d_in[i];
    a.out = (float*)d_out; a.ws = (unsigned char*)d_ws; a.ph_lo = 0; a.ph_hi = N_PHASES;
    void* kargs[] = {&a};
#ifndef NPASS
#define NPASS 1
#endif
    hipError_t e = hipSuccess;
    for (int pass_ = 0; pass_ < NPASS; ++pass_) {
        if (pass_ > 0) (void)hipMemsetAsync((char*)d_ws + WS_CTL, 0, CTL_ZERO_BYTES, stream);
        e = hipLaunchCooperativeKernel((const void*)fwd_kernel, dim3(grid), dim3(NTHR), kargs, LDS_BYTES, stream);
    }
    if (e != hipSuccess) fprintf(stderr, "kernel_launch: cooperative launch failed: %s (grid %d)\n", hipGetErrorString(e), grid);
}
```

```cpp
#include <hip/hip_runtime.h>
#include <hip/hip_cooperative_groups.h>
#include <cstdio>
#include <cstdint>
namespace cg = cooperative_groups;
namespace pg8 {
#define PG8_LAS __attribute__((address_space(3)))
typedef unsigned short bf16_t;
typedef short bf16x8 __attribute__((ext_vector_type(8)));
typedef float f32x4 __attribute__((ext_vector_type(4)));
typedef unsigned u32x4 __attribute__((ext_vector_type(4)));
constexpr int BM = 256, BK = 64, HALF = 128, HTB = HALF * BK * 2  , STAGE_BYTES = 8 * HTB, NXCD = 8, WGM = 8;

__host__ __device__ __forceinline__ int lds_byte(int r, int c) { const int st = (r >> 4) * 2 + (c >> 5), rr = r & 15, cc = c & 31, ob = rr * 64 + cc * 2; return st * 1024 + (ob ^ (((ob >> 9) & 1) << 5)); }
__host__ __device__ __forceinline__ void stage_rc(int b, int& R, int& C) { const int st = b / 1024, sb = b % 1024, swz = sb ^ (((sb >> 9) & 1) << 5); R = (st >> 1) * 16 + swz / 64; C = (st & 1) * 32 + (swz % 64) / 2; }
__host__ __device__ __forceinline__ int perm32(int rho) { const int n = rho >> 4, i = rho & 15; return 8 * (i >> 2) + 4 * n + (i & 3); }

struct Unit { int pm, pn; };
struct Gemm { const bf16_t* A; const bf16_t* Bt; int M, N, K; };

struct StaticOrder {
    int nM, nN, nwg, G, c;
    __host__ __device__ void init(int M, int N, int G_, int c_) { nM = M / BM; nN = N / BM; nwg = nM * nN; G = G_; c = c_; }
    __host__ __device__ bool next(int i, Unit& u) const {
        const long L = (long)i * G + c; if (L >= nwg) return false;
        int wgid = (int)L; { const int q = nwg / NXCD, r = nwg % NXCD, xcd = wgid % NXCD, off = wgid / NXCD; wgid = (xcd < r ? xcd * (q + 1) : r * (q + 1) + (xcd - r) * q) + off; }
        const int nig = WGM * nN, gid = wgid / nig, fm = gid * WGM, gsz = (nM - fm) < WGM ? (nM - fm) : WGM;
        u.pm = fm + ((wgid % nig) % gsz); u.pn = (wgid % nig) / gsz; return true;
    }
    __device__ __forceinline__ void a_ready(const Unit&) const {}
    __device__ __forceinline__ void done(const Unit&) const {}
};
__device__ __forceinline__ unsigned cvt_pk_bf16(float lo, float hi) { unsigned r; asm volatile("v_cvt_pk_bf16_f32 %0, %1, %2" : "=v"(r) : "v"(lo), "v"(hi)); return r; }
struct EpiStoreBf16 {
    static constexpr bool PERM = true, AFTER_DRAIN = false;
    bf16_t* O; int ldc;
    __device__ __forceinline__ void operator()(const f32x4 (&acc)[2][2][4][2], const Unit& u, int wr, int wc, int fr, int fq) const {
        const int row0 = u.pm * BM + wr * 64 + fr; const int col0 = u.pn * BM + wc * 32 + 8 * fq;
#pragma unroll
        for (int ai = 0; ai < 2; ++ai)
#pragma unroll
            for (int m = 0; m < 4; ++m) { bf16_t* rowp = O + (size_t)(row0 + ai * HALF + m * 16) * ldc + col0;
#pragma unroll
                for (int bj = 0; bj < 2; ++bj) { const f32x4 v0 = acc[ai][bj][m][0], v1 = acc[ai][bj][m][1];
                    u32x4 w; w.x = cvt_pk_bf16(v0[0], v0[1]); w.y = cvt_pk_bf16(v0[2], v0[3]); w.z = cvt_pk_bf16(v1[0], v1[1]); w.w = cvt_pk_bf16(v1[2], v1[3]);
                    *(u32x4*)(rowp + bj * HALF) = w; } }
    }
};
struct EpiResid {
    static constexpr bool PERM = true, AFTER_DRAIN = false;
    const float* X; const float* gate; bf16_t* O; int ldc; int rows_per_batch; int gstride;
    __device__ __forceinline__ void operator()(const f32x4 (&acc)[2][2][4][2], const Unit& u, int wr, int wc, int fr, int fq) const {
        const int row0 = u.pm * BM + wr * 64 + fr; const int col0 = u.pn * BM + wc * 32 + 8 * fq;
        const float* g = gate + (size_t)((u.pm * BM) / rows_per_batch) * gstride + col0;
        f32x4 gv[2][2];
#pragma unroll
        for (int bj = 0; bj < 2; ++bj)
#pragma unroll
            for (int n = 0; n < 2; ++n) gv[bj][n] = *(const f32x4*)(g + bj * HALF + 4 * n);
#pragma unroll
        for (int ai = 0; ai < 2; ++ai)
#pragma unroll
            for (int m = 0; m < 4; ++m) { const size_t off = (size_t)(row0 + ai * HALF + m * 16) * ldc + col0;
#pragma unroll
                for (int bj = 0; bj < 2; ++bj) { const f32x4 x0 = *(const f32x4*)(X + off + bj * HALF), x1 = *(const f32x4*)(X + off + bj * HALF + 4);
                    const f32x4 v0 = x0 + gv[bj][0] * acc[ai][bj][m][0], v1 = x1 + gv[bj][1] * acc[ai][bj][m][1];
                    u32x4 w; w.x = cvt_pk_bf16(v0[0], v0[1]); w.y = cvt_pk_bf16(v0[2], v0[3]); w.z = cvt_pk_bf16(v1[0], v1[1]); w.w = cvt_pk_bf16(v1[2], v1[3]);
                    *(u32x4*)(O + off + bj * HALF) = w; } }
    }
};
template <class Epi, class Sched, bool ALIGN_EPI = false, bool SP2 = false>
__device__ __forceinline__ void gemm_phase(PG8_LAS unsigned char* lds, const Gemm g, const Sched& S, const Epi& E) {
    const int tid = threadIdx.x, wid = __builtin_amdgcn_readfirstlane(tid >> 6), lane = tid & 63, wr = wid >> 2, wc = wid & 3, fr = lane & 15, fq = lane >> 4;
    const int K = g.K, nt = K / BK;
    unsigned voffA[2], voffB[2];
#pragma unroll
    for (int i = 0; i < 2; ++i) { int R, C; stage_rc(tid * 16 + i * 8192, R, C); const int Rb = Epi::PERM ? ((R & ~31) + perm32(R & 31)) : R;
        voffA[i] = (unsigned)(R * K + C) * 2u; voffB[i] = (unsigned)(Rb * K + C) * 2u; }
    const size_t kstep = (size_t)(BK * 2);
    const size_t hstep = (size_t)HALF * K * 2;
    const size_t tstep = 2 * hstep;
    const unsigned ldsw = (unsigned)wid * 1024u;
    const int aoff = lds_byte(wr * 64 + fr, fq * 8), boff = lds_byte(wc * 32 + fr, fq * 8);
#define PG8_SA(b, h) (((b) * 2 + (h)) * HTB)
#define PG8_SB(b, h) ((4 + (b) * 2 + (h)) * HTB)
#define PG8_STAGE(bufoff, gbase, voff) do { _Pragma("unroll") for (int _i = 0; _i < 2; ++_i) \
        __builtin_amdgcn_global_load_lds((const unsigned*)((const char*)(gbase) + (voff)[_i]), (PG8_LAS unsigned*)(lds + (bufoff) + ldsw + _i * 8192), 16, 0, 0); } while (0)
#define PG8_LDA(dst, b, h) do { _Pragma("unroll") for (int m = 0; m < 4; ++m) _Pragma("unroll") for (int k = 0; k < 2; ++k) dst[m][k] = *(const PG8_LAS bf16x8*)(lds + PG8_SA(b, h) + aoff + m * 2048 + k * 1024); } while (0)
#define PG8_LDB(dst, b, h) do { _Pragma("unroll") for (int n = 0; n < 2; ++n) _Pragma("unroll") for (int k = 0; k < 2; ++k) dst[n][k] = *(const PG8_LAS bf16x8*)(lds + PG8_SB(b, h) + boff + n * 2048 + k * 1024); } while (0)
#define PG8_MMA(ai, bj, At, Bt) do { __builtin_amdgcn_s_setprio(1); _Pragma("unroll") for (int m = 0; m < 4; ++m) _Pragma("unroll") for (int n = 0; n < 2; ++n) _Pragma("unroll") for (int k = 0; k < 2; ++k) \
        acc[ai][bj][m][n] = __builtin_amdgcn_mfma_f32_16x16x32_bf16(Bt[n][k], At[m][k], acc[ai][bj][m][n], 0, 0, 0); __builtin_amdgcn_s_setprio(0); } while (0)
#define PG8_WAIT_V(n) asm volatile("s_waitcnt vmcnt(" #n ")" ::: "memory")
#define PG8_WAIT_L(n) asm volatile("s_waitcnt lgkmcnt(" #n ")" ::: "memory")
#define PG8_BAR __builtin_amdgcn_s_barrier()
#define PG8_SCHED __builtin_amdgcn_sched_barrier(0)
    Unit cur, nxt; int ui = 0;
    if (!S.next(0, cur)) return;
    f32x4 acc[2][2][4][2];
#pragma unroll
    for (int a = 0; a < 2; ++a)
#pragma unroll
        for (int b = 0; b < 2; ++b)
#pragma unroll
            for (int m = 0; m < 4; ++m)
#pragma unroll
                for (int n = 0; n < 2; ++n) acc[a][b][m][n] = (f32x4){0.f, 0.f, 0.f, 0.f};
    bf16x8 At[4][2], B0[2][2], B1[2][2];
    const char* cA = (const char*)g.A + (size_t)cur.pm * tstep; const char* cB = (const char*)g.Bt + (size_t)cur.pn * tstep;
    S.a_ready(cur);
    if constexpr (SP2) {
        PG8_STAGE(PG8_SB(0, 0), cB, voffB); PG8_STAGE(PG8_SB(0, 1), cB + hstep, voffB); PG8_STAGE(PG8_SA(0, 0), cA, voffA); PG8_STAGE(PG8_SA(0, 1), cA + hstep, voffA);
        if (wr == 1) PG8_BAR;
        PG8_WAIT_V(2); PG8_BAR;
        PG8_STAGE(PG8_SB(1, 0), cB + kstep, voffB); PG8_STAGE(PG8_SA(1, 0), cA + kstep, voffA); PG8_STAGE(PG8_SB(1, 1), cB + hstep + kstep, voffB);
        PG8_WAIT_V(6); PG8_BAR;
    } else {
        PG8_STAGE(PG8_SB(0, 0), cB, voffB); PG8_STAGE(PG8_SA(0, 0), cA, voffA); PG8_STAGE(PG8_SB(0, 1), cB + hstep, voffB); PG8_STAGE(PG8_SA(0, 1), cA + hstep, voffA);
        if (wr == 1) PG8_BAR;
        PG8_WAIT_V(4); PG8_BAR;
        PG8_STAGE(PG8_SB(1, 0), cB + kstep, voffB); PG8_STAGE(PG8_SA(1, 0), cA + kstep, voffA); PG8_STAGE(PG8_SB(1, 1), cB + hstep + kstep, voffB);
        PG8_WAIT_V(6); PG8_BAR;
    }
    for (;;) {
        const bool has_next = S.next(ui + 1, nxt);
        const char* nA = has_next ? (const char*)g.A + (size_t)nxt.pm * tstep : cA; const char* nB = has_next ? (const char*)g.Bt + (size_t)nxt.pn * tstep : cB;
        for (int t = 0; t < nt; t += 2) {
            const bool last = (t == nt - 2);
            const char* a1 = cA + (size_t)(t + 1) * kstep;
            const char* a2 = last ? nA : cA + (size_t)(t + 2) * kstep; const char* b2 = last ? nB : cB + (size_t)(t + 2) * kstep;
            const char* a3 = a2 + kstep; const char* b3 = b2 + kstep;
            if (last && has_next) S.a_ready(nxt);
            if constexpr (SP2) {
            PG8_LDB(B0, 0, 0); PG8_LDB(B1, 0, 1); PG8_SCHED; PG8_LDA(At, 0, 0); PG8_STAGE(PG8_SA(1, 1), a1 + hstep, voffA);
            PG8_WAIT_V(8); PG8_WAIT_L(0); PG8_BAR; PG8_MMA(0, 0, At, B0); PG8_MMA(0, 1, At, B1); PG8_BAR; PG8_SCHED;
            PG8_LDA(At, 0, 1); PG8_STAGE(PG8_SB(0, 0), b2, voffB); PG8_STAGE(PG8_SB(0, 1), b2 + hstep, voffB); PG8_STAGE(PG8_SA(0, 0), a2, voffA);
            PG8_WAIT_V(8); PG8_WAIT_L(0); PG8_BAR; PG8_MMA(1, 0, At, B0); PG8_MMA(1, 1, At, B1); PG8_BAR; PG8_SCHED;
            PG8_LDB(B0, 1, 0); PG8_LDB(B1, 1, 1); PG8_SCHED; PG8_LDA(At, 1, 0); PG8_STAGE(PG8_SA(0, 1), a2 + hstep, voffA);
            PG8_WAIT_V(8); PG8_WAIT_L(0); PG8_BAR; PG8_MMA(0, 0, At, B0); PG8_MMA(0, 1, At, B1); PG8_BAR; PG8_SCHED;
            PG8_LDA(At, 1, 1); PG8_STAGE(PG8_SB(1, 0), b3, voffB); PG8_STAGE(PG8_SB(1, 1), b3 + hstep, voffB); PG8_STAGE(PG8_SA(1, 0), a3, voffA);
            PG8_WAIT_V(8); PG8_WAIT_L(0); PG8_BAR; PG8_MMA(1, 0, At, B0); PG8_MMA(1, 1, At, B1); PG8_BAR; PG8_SCHED;
            } else {
            PG8_LDB(B0, 0, 0); PG8_SCHED; PG8_LDA(At, 0, 0); PG8_STAGE(PG8_SA(1, 1), a1 + hstep, voffA);
            PG8_WAIT_L(8); PG8_BAR; PG8_WAIT_L(0); PG8_MMA(0, 0, At, B0); PG8_BAR; PG8_SCHED;
            PG8_LDB(B1, 0, 1); PG8_STAGE(PG8_SB(0, 0), b2, voffB);
            PG8_BAR; PG8_WAIT_L(0); PG8_MMA(0, 1, At, B1); PG8_BAR;
            PG8_LDA(At, 0, 1); PG8_STAGE(PG8_SA(0, 0), a2, voffA);
            PG8_BAR; PG8_WAIT_L(0); PG8_MMA(1, 0, At, B0); PG8_BAR; PG8_SCHED;
            PG8_STAGE(PG8_SB(0, 1), b2 + hstep, voffB);
            PG8_WAIT_V(6); PG8_BAR; PG8_MMA(1, 1, At, B1); PG8_BAR;
            PG8_LDB(B0, 1, 0); PG8_SCHED; PG8_LDA(At, 1, 0); PG8_STAGE(PG8_SA(0, 1), a2 + hstep, voffA);
            PG8_WAIT_L(8); PG8_BAR; PG8_WAIT_L(0); PG8_MMA(0, 0, At, B0); PG8_BAR; PG8_SCHED;
            PG8_LDB(B1, 1, 1); PG8_STAGE(PG8_SB(1, 0), b3, voffB);
            PG8_BAR; PG8_WAIT_L(0); PG8_MMA(0, 1, At, B1); PG8_BAR;
            PG8_LDA(At, 1, 1); PG8_STAGE(PG8_SA(1, 0), a3, voffA);
            PG8_BAR; PG8_WAIT_L(0); PG8_MMA(1, 0, At, B0); PG8_BAR; PG8_SCHED;
            PG8_STAGE(PG8_SB(1, 1), b3 + hstep, voffB);
            PG8_WAIT_V(6); PG8_BAR; PG8_MMA(1, 1, At, B1); PG8_BAR;
            }
        }
        if constexpr (ALIGN_EPI) { if (wr == 0) PG8_BAR; }
        if constexpr (!Epi::AFTER_DRAIN) { E(acc, cur, wr, wc, fr, fq); S.done(cur); }
        if (!has_next) break;
#pragma unroll
        for (int a = 0; a < 2; ++a)
#pragma unroll
            for (int b = 0; b < 2; ++b)
#pragma unroll
                for (int m = 0; m < 4; ++m)
#pragma unroll
                    for (int n = 0; n < 2; ++n) acc[a][b][m][n] = (f32x4){0.f, 0.f, 0.f, 0.f};
        cur = nxt; cA = nA; cB = nB; ++ui;
        if constexpr (ALIGN_EPI) { if (wr == 1) PG8_BAR; }
    }
    PG8_WAIT_V(0);
    if constexpr (!ALIGN_EPI) { if (wr == 0) PG8_BAR; }
    PG8_BAR;
    if constexpr (Epi::AFTER_DRAIN) { E.fused(acc, cur, wr, wc, fr, fq, lds, wid, lane); S.done(cur); }
#undef PG8_SA
#undef PG8_SB
#undef PG8_STAGE
#undef PG8_LDA
#undef PG8_LDB
#undef PG8_MMA
#undef PG8_WAIT_V
#undef PG8_WAIT_L
#undef PG8_BAR
#undef PG8_SCHED
}
}
#define GAS __attribute__((address_space(1)))
#define LAS __attribute__((address_space(3)))
typedef unsigned short bf16;
typedef unsigned v4u __attribute__((ext_vector_type(4)));
typedef unsigned v2u __attribute__((ext_vector_type(2)));
typedef float f32x4 __attribute__((ext_vector_type(4)));
typedef float f32x2 __attribute__((ext_vector_type(2)));
typedef short bf16x8 __attribute__((ext_vector_type(8)));
typedef __bf16 bf16x2_t __attribute__((ext_vector_type(2)));

constexpr int NWAVES = 8, NTHR = 512;
constexpr int DM = 2048, NB = 4, SEQ = 8192, M = NB * SEQ;
constexpr int RW = 1024, RHEADS = 16, HD = 64;
constexpr int L_W = 64, L_A = 64, L_G = 160;
constexpr int INP = 5936, INPP = 6144;
constexpr int C_R = 0, C_K = 1024, C_V = 2048, C_WD = 3072, C_AD = 3136, C_GD = 3200, C_Z = 3360, C_XBC = 4384, C_DT = 5920;
constexpr int MODW = 6 * DM;
constexpr int NEXP = 16384;
constexpr float RMS_EPS = 1e-6f;

enum { I_X = 0, I_C, I_ADAW, I_ADAB, I_N1W, I_WIN, I_MU, I_W0, I_WUP, I_A0, I_AUP, I_GUP, I_KK, I_KA, I_RK, I_LNW, I_LNB,
       I_CONVW, I_CONVB, I_DTB, I_ALOG, I_DSK, I_MNW, I_WOUT, I_N2W, I_WQ, I_KEYS, I_PU, I_PV, I_FNW, N_IN };

constexpr size_t MiB = 1u << 20;
constexpr size_t WS_CTL = 0, CTL_ZERO_BYTES = 1 * MiB;
constexpr size_t WS_MOD = 1 * MiB;
constexpr size_t WS_WIN = 2 * MiB, WS_WOUT = 26 * MiB, WS_WQ = 34 * MiB, WS_KEYS = 42 * MiB;
constexpr size_t WS_WUPT = 43 * MiB, WS_AUPT = 43 * MiB + 256 * 1024, WS_GUPT = 43 * MiB + 512 * 1024;
constexpr size_t WS_PU8 = 44 * MiB, WS_PV8 = 76 * MiB;
constexpr size_t WS_USC = 108 * MiB, WS_VSC = 108 * MiB + 65536;
constexpr size_t WS_XN = 172 * MiB;
constexpr size_t WS_LW = WS_XN, WS_AA = WS_XN + 64 * MiB;
constexpr size_t WS_PROJ = 300 * MiB;
constexpr size_t WS_Q = WS_PROJ;
constexpr size_t WS_GG = 684 * MiB;
constexpr size_t WS_PD = WS_PROJ + 128 * MiB;
constexpr size_t WS_RTE = 684 * MiB, WS_RTG = 700 * MiB, WS_COEF = 716 * MiB;
constexpr size_t WS_OY = 748 * MiB;
constexpr size_t WS_END = 876 * MiB;
constexpr size_t WS_HB = 876 * MiB;

constexpr int RING_BYTES = 131072, LDS_BYTES = 147456;

#define LDS_WAIT() asm volatile("s_waitcnt lgkmcnt(0)" ::: "memory")
#define VM_WAIT() asm volatile("s_waitcnt vmcnt(0)" ::: "memory")
__device__ __forceinline__ unsigned pk2(float lo, float hi) { f32x2 v = {lo, hi}; bf16x2_t b = __builtin_convertvector(v, bf16x2_t); return __builtin_bit_cast(unsigned, b); }
__device__ __forceinline__ float bflo(unsigned u) { return __uint_as_float(u << 16); }
__device__ __forceinline__ float bfhi(unsigned u) { return __uint_as_float(u & 0xffff0000u); }
__device__ __forceinline__ float bf1(bf16 h) { return __uint_as_float((unsigned)h << 16); }
__device__ __forceinline__ float wave_sum(float v) {
#pragma unroll
    for (int o = 1; o < 64; o <<= 1) v += __shfl_xor(v, o);
    return v;
}
__device__ __forceinline__ float rcp_f(float v) { return __builtin_amdgcn_rcpf(v); }
template <int CTRL> __device__ __forceinline__ float dppc_f(float x) { return __builtin_bit_cast(float, __builtin_amdgcn_mov_dpp(__builtin_bit_cast(int, x), CTRL, 0xf, 0xf, true)); }
__device__ __forceinline__ float wave_sum_fast(float x) {
    x += dppc_f<0xB1>(x); x += dppc_f<0x4E>(x); x += dppc_f<0x124>(x); x += dppc_f<0x128>(x);
    { auto rr = __builtin_amdgcn_permlane16_swap(__float_as_uint(x), __float_as_uint(x), false, false); x = __uint_as_float(rr[0]) + __uint_as_float(rr[1]); }
    { auto rr = __builtin_amdgcn_permlane32_swap(__float_as_uint(x), __float_as_uint(x), false, false); x = __uint_as_float(rr[0]) + __uint_as_float(rr[1]); }
    return x;
}
__device__ __forceinline__ float silu_f(float v) { return v * rcp_f(1.f + __expf(-v)); }
__device__ __forceinline__ float sigmoid_f(float v) { return rcp_f(1.f + __expf(-v)); }

struct Ctx {
    LAS unsigned char* lds;
    int tid, lane, wave, G, gw, NGW;
    const float* const* in;
    float* out; unsigned char* ws;
};

__device__ __forceinline__ void transpose_item(const float* W, int K, int N, bf16* WT, int ldt, int nrows_out, LAS float* scr, int kb, int nb, int lane) {
    const int k0 = 64 * kb, n0 = 64 * nb;
    const int c4 = 4 * (lane & 15), rr = lane >> 4;
    const bool vec_ok = ((N & 3) == 0) && (n0 + 64 <= N);
#pragma unroll 4
    for (int i = 0; i < 16; ++i) { const int kk = 4 * i + rr, k = k0 + kk;
        f32x4 v = {0.f, 0.f, 0.f, 0.f};
        if (k < K) { const float* src = W + (size_t)k * N + n0 + c4;
            if (vec_ok) v = *(const f32x4*)src;
            else { if (n0 + c4 + 0 < N) v.x = src[0]; if (n0 + c4 + 1 < N) v.y = src[1]; if (n0 + c4 + 2 < N) v.z = src[2]; if (n0 + c4 + 3 < N) v.w = src[3]; } }
        LAS float* d = scr + kk * 65 + c4; d[0] = v.x; d[1] = v.y; d[2] = v.z; d[3] = v.w; }
    LDS_WAIT(); asm volatile("" ::: "memory");
    const int c = lane & 7;
#pragma unroll
    for (int j = 0; j < 8; ++j) { const int n = (lane >> 3) + 8 * j; const LAS float* sp = scr + (8 * c) * 65 + n;
        v4u o; o.x = pk2(sp[0 * 65], sp[1 * 65]); o.y = pk2(sp[2 * 65], sp[3 * 65]); o.z = pk2(sp[4 * 65], sp[5 * 65]); o.w = pk2(sp[6 * 65], sp[7 * 65]);
        if (n0 + n < nrows_out && k0 + 8 * c + 8 <= ldt) *(v4u*)(WT + (size_t)(n0 + n) * ldt + k0 + 8 * c) = o; }
    LDS_WAIT(); asm volatile("" ::: "memory");
}
__device__ __forceinline__ void transpose_all(const float* W, int K, int N, bf16* WT, int ldt, int nrows_out, LAS float* scr, int gw, int NGW, int lane) {
    const int nkb = (K + 63) / 64, nnb = nrows_out / 64, nit = nkb * nnb;
    for (int it = gw; it < nit; it += NGW) transpose_item(W, K, N, WT, ldt, nrows_out, scr, it / nnb, it % nnb, lane);
}
__device__ __forceinline__ void convert_all(const float* src, bf16* dst, size_t n8, int gw, int NGW, int lane) {
    const f32x4* s4 = (const f32x4*)src; v4u* d4 = (v4u*)dst;
    for (size_t i = (size_t)gw * 64 + lane; i < n8; i += (size_t)NGW * 64) {
        const f32x4 a = __builtin_nontemporal_load(s4 + 2 * i), b = __builtin_nontemporal_load(s4 + 2 * i + 1);
        v4u o; o.x = pk2(a.x, a.y); o.y = pk2(a.z, a.w); o.z = pk2(b.x, b.y); o.w = pk2(b.z, b.w);
        d4[i] = o; }
}
__device__ __forceinline__ void quantize_rows_fp8(const float* src, unsigned char* dst8, float* scales, int e0, int e1, int step, int lane) {
    if (e0 >= e1) return;
    f32x4 vn[8];
    { const f32x4* s4 = (const f32x4*)(src + (size_t)e0 * DM) + lane;
#pragma unroll
      for (int i = 0; i < 8; ++i) vn[i] = __builtin_nontemporal_load(s4 + 64 * i); }
    for (int e = e0; e < e1; e += step) {
        f32x4 v[8];
#pragma unroll
        for (int i = 0; i < 8; ++i) v[i] = vn[i];
        { const int en = (e + step < e1) ? e + step : e; const f32x4* s4 = (const f32x4*)(src + (size_t)en * DM) + lane;
#pragma unroll
          for (int i = 0; i < 8; ++i) vn[i] = __builtin_nontemporal_load(s4 + 64 * i); }
        float am = 0.f;
#pragma unroll
        for (int i = 0; i < 8; ++i) am = fmaxf(fmaxf(am, fmaxf(fabsf(v[i].x), fabsf(v[i].y))), fmaxf(fabsf(v[i].z), fabsf(v[i].w)));
#pragma unroll
        for (int o = 1; o < 64; o <<= 1) am = fmaxf(am, __shfl_xor(am, o));
        am = fmaxf(am, 1e-30f);
        const float inv = 440.f / am;
#pragma unroll
        for (int i = 0; i < 8; ++i) { int w = __builtin_amdgcn_cvt_pk_fp8_f32(v[i].x * inv, v[i].y * inv, 0, false); w = __builtin_amdgcn_cvt_pk_fp8_f32(v[i].z * inv, v[i].w * inv, w, true);
            const int seg = 2 * i + (lane >> 5);
            *(int*)(dst8 + (size_t)seg * ((size_t)NEXP * 128) + (size_t)e * 128 + 4 * (lane & 31)) = w; }
        if (lane == 0) scales[e] = am * (1.f / 440.f);
    }
}
__device__ __forceinline__ void quantize_rows_fp4(const float* src, unsigned char* dst4, float* scales, int e0, int e1, int step, int lane) {
    if (e0 >= e1) return;
    f32x4 vn[8];
    { const f32x4* s4 = (const f32x4*)(src + (size_t)e0 * DM) + lane;
#pragma unroll
      for (int i = 0; i < 8; ++i) vn[i] = __builtin_nontemporal_load(s4 + 64 * i); }
    for (int e = e0; e < e1; e += step) {
        f32x4 v[8];
#pragma unroll
        for (int i = 0; i < 8; ++i) v[i] = vn[i];
        { const int en = (e + step < e1) ? e + step : e; const f32x4* s4 = (const f32x4*)(src + (size_t)en * DM) + lane;
#pragma unroll
          for (int i = 0; i < 8; ++i) vn[i] = __builtin_nontemporal_load(s4 + 64 * i); }
        float am = 0.f;
#pragma unroll
        for (int i = 0; i < 8; ++i) am = fmaxf(am, fmaxf(fmaxf(fabsf(v[i].x), fabsf(v[i].y)), fmaxf(fabsf(v[i].z), fabsf(v[i].w))));
#pragma unroll
        for (int o = 1; o < 64; o <<= 1) am = fmaxf(am, __shfl_xor(am, o));
        am = fmaxf(am, 1e-30f);
        const float inv = 6.f / am;
#pragma unroll
        for (int i = 0; i < 8; ++i) {
            unsigned w = __builtin_amdgcn_cvt_scalef32_pk_fp4_f32(0u, v[i].x * inv, v[i].y * inv, 1.0f, 0);
            w = __builtin_amdgcn_cvt_scalef32_pk_fp4_f32(w, v[i].z * inv, v[i].w * inv, 1.0f, 1);
            *(unsigned short*)(dst4 + (size_t)i * ((size_t)NEXP * 128) + (size_t)e * 128 + 2 * lane) = (unsigned short)w;
        }
        if (lane == 0) scales[e] = am * (1.f / 6.f);
    }
}
__device__ __forceinline__ void p0_prologue(const Ctx& F) {
    __syncthreads();
    if (blockIdx.x < MODW / 64) {
        LAS float* sc = (LAS float*)F.lds;
        LAS float* red = sc + NB * DM;
        const float* c = F.in[I_C];
        for (int i = F.tid; i < NB * DM; i += NTHR) sc[i] = silu_f(c[i]);
        __syncthreads();
        const int j = blockIdx.x * 64 + F.lane;
        const float* wp = F.in[I_ADAW] + (size_t)(F.wave * 256) * MODW + j;
        float a0 = 0.f, a1 = 0.f, a2 = 0.f, a3 = 0.f;
#pragma unroll 32
        for (int kk = 0; kk < 256; ++kk) { const float w = wp[(size_t)kk * MODW]; const int k = F.wave * 256 + kk;
            a0 += sc[k] * w; a1 += sc[DM + k] * w; a2 += sc[2 * DM + k] * w; a3 += sc[3 * DM + k] * w; }
        red[(F.wave * 4 + 0) * 64 + F.lane] = a0; red[(F.wave * 4 + 1) * 64 + F.lane] = a1; red[(F.wave * 4 + 2) * 64 + F.lane] = a2; red[(F.wave * 4 + 3) * 64 + F.lane] = a3;
        __syncthreads();
        if (F.tid < 256) { const int b = F.tid >> 6, l = F.tid & 63; float s = F.in[I_ADAB][blockIdx.x * 64 + l];
#pragma unroll
            for (int w = 0; w < 8; ++w) s += red[(w * 4 + b) * 64 + l];
            ((float*)(F.ws + WS_MOD))[b * MODW + blockIdx.x * 64 + l] = s; }
        __syncthreads();
    }
    LAS float* scr = (LAS float*)(F.lds + F.wave * 16640);
    transpose_all(F.in[I_WIN], DM, INP, (bf16*)(F.ws + WS_WIN), DM, INPP, scr, F.gw, F.NGW, F.lane);
    transpose_all(F.in[I_WOUT], DM, DM, (bf16*)(F.ws + WS_WOUT), DM, DM, scr, F.gw, F.NGW, F.lane);
    transpose_all(F.in[I_WQ], DM, DM, (bf16*)(F.ws + WS_WQ), DM, DM, scr, F.gw, F.NGW, F.lane);
    transpose_all(F.in[I_WUP], L_W, RW, (bf16*)(F.ws + WS_WUPT), L_W, RW, scr, F.gw, F.NGW, F.lane);
    transpose_all(F.in[I_AUP], L_A, RW, (bf16*)(F.ws + WS_AUPT), L_A, RW, scr, F.gw, F.NGW, F.lane);
    transpose_all(F.in[I_GUP], L_G, RW, (bf16*)(F.ws + WS_GUPT), L_G, RW, scr, F.gw, F.NGW, F.lane);
    convert_all(F.in[I_KEYS], (bf16*)(F.ws + WS_KEYS), (size_t)16 * 128 * 128 / 8, F.gw, F.NGW, F.lane);
    {
        const int nlo = (F.G < 192) ? F.G : 192, nhi = F.G - nlo;
        const int wtot = 5 * nlo + 8 * nhi;
        const int wb0 = (blockIdx.x < nlo) ? 5 * blockIdx.x : 5 * nlo + 8 * (blockIdx.x - nlo), wb1 = wb0 + ((blockIdx.x < nlo) ? 5 : 8);
        const int r0 = (int)((long)(2 * NEXP) * wb0 / wtot), r1 = (int)((long)(2 * NEXP) * wb1 / wtot);
        const int a0 = r0 < NEXP ? r0 : NEXP, a1 = r1 < NEXP ? r1 : NEXP;
        quantize_rows_fp8(F.in[I_PU], F.ws + WS_PU8, (float*)(F.ws + WS_USC), a0 + F.wave, a1, NWAVES, F.lane);
        const int b0 = (r0 > NEXP ? r0 : NEXP) - NEXP, b1 = (r1 > NEXP ? r1 : NEXP) - NEXP;
        quantize_rows_fp4(F.in[I_PV], F.ws + WS_PV8, (float*)(F.ws + WS_VSC), b0 + F.wave, b1, NWAVES, F.lane);
    }
}

__device__ __forceinline__ void norm_mod_rows(const Ctx& F, const float* X, const float* nw, int shift_off, int scale_off, bf16* XN) {
    const float* mod = (const float*)(F.ws + WS_MOD);
    if (F.gw >= M) return;
    f32x4 vn[8];
    { const f32x4* xr = (const f32x4*)(X + (size_t)F.gw * DM) + F.lane;
#pragma unroll
      for (int j = 0; j < 8; ++j) vn[j] = xr[64 * j]; }
    for (int m = F.gw; m < M; m += F.NGW) {
        const int b = m / SEQ;
        f32x4 v[8]; float s = 0.f;
#pragma unroll
        for (int j = 0; j < 8; ++j) { v[j] = vn[j]; s += (v[j].x * v[j].x + v[j].y * v[j].y) + (v[j].z * v[j].z + v[j].w * v[j].w); }
        { const int mn = (m + F.NGW < M) ? m + F.NGW : m; const f32x4* xr = (const f32x4*)(X + (size_t)mn * DM) + F.lane;
#pragma unroll
          for (int j = 0; j < 8; ++j) vn[j] = xr[64 * j]; }
        const float rstd = rsqrtf(wave_sum_fast(s) * (1.f / DM) + RMS_EPS);
        const f32x4* wp = (const f32x4*)nw + F.lane;
        const f32x4* shp = (const f32x4*)(mod + (size_t)b * MODW + shift_off) + F.lane;
        const f32x4* scp = (const f32x4*)(mod + (size_t)b * MODW + scale_off) + F.lane;
        v2u* o = (v2u*)(XN + (size_t)m * DM) + F.lane;
#pragma unroll
        for (int j = 0; j < 8; ++j) { const f32x4 w = wp[64 * j], a = scp[64 * j], c = shp[64 * j];
            const f32x4 r = (v[j] * rstd) * w * (a + 1.f) + c;
            v2u p; p.x = pk2(r.x, r.y); p.y = pk2(r.z, r.w); o[64 * j] = p; }
    }
}
__device__ __forceinline__ void final_norm_rows(const Ctx& F, const float* H, const float* nw, float* O) {
    for (int m = F.gw; m < M; m += F.NGW) {
        const f32x4* xr = (const f32x4*)(H + (size_t)m * DM) + F.lane;
        f32x4 v[8]; float s = 0.f;
#pragma unroll
        for (int j = 0; j < 8; ++j) { v[j] = xr[64 * j]; s += (v[j].x * v[j].x + v[j].y * v[j].y) + (v[j].z * v[j].z + v[j].w * v[j].w); }
        const float rstd = rsqrtf(wave_sum(s) * (1.f / DM) + RMS_EPS);
        const f32x4* wp = (const f32x4*)nw + F.lane;
        f32x4* o = (f32x4*)(O + (size_t)m * DM) + F.lane;
#pragma unroll
        for (int j = 0; j < 8; ++j) o[64 * j] = (v[j] * rstd) * wp[64 * j];
    }
}


__device__ __forceinline__ void load_row_raw(const bf16* row, int lane, v2u (&u)[8]) {
    const v2u* p = (const v2u*)row + lane;
#pragma unroll
    for (int j = 0; j < 8; ++j) u[j] = p[64 * j];
}
__device__ __forceinline__ void norm_mod_rows_bf16(const Ctx& F, const bf16* X, const float* nw, int shift_off, int scale_off, bf16* XN) {
    const float* mod = (const float*)(F.ws + WS_MOD);
    if (F.gw >= M) return;
    v2u un[8]; load_row_raw(X + (size_t)F.gw * DM, F.lane, un);
    for (int m = F.gw; m < M; m += F.NGW) {
        const int b = m / SEQ;
        f32x4 v[8]; float s = 0.f;
#pragma unroll
        for (int j = 0; j < 8; ++j) { v[j] = (f32x4){bflo(un[j].x), bfhi(un[j].x), bflo(un[j].y), bfhi(un[j].y)}; s += (v[j].x * v[j].x + v[j].y * v[j].y) + (v[j].z * v[j].z + v[j].w * v[j].w); }
        { const int mn = (m + F.NGW < M) ? m + F.NGW : m; load_row_raw(X + (size_t)mn * DM, F.lane, un); }
        const float rstd = rsqrtf(wave_sum_fast(s) * (1.f / DM) + RMS_EPS);
        const f32x4* wp = (const f32x4*)nw + F.lane;
        const f32x4* shp = (const f32x4*)(mod + (size_t)b * MODW + shift_off) + F.lane;
        const f32x4* scp = (const f32x4*)(mod + (size_t)b * MODW + scale_off) + F.lane;
        v2u* o = (v2u*)(XN + (size_t)m * DM) + F.lane;
#pragma unroll
        for (int j = 0; j < 8; ++j) { const f32x4 w = wp[64 * j], a = scp[64 * j], c = shp[64 * j];
            const f32x4 r = (v[j] * rstd) * w * (a + 1.f) + c;
            v2u p; p.x = pk2(r.x, r.y); p.y = pk2(r.z, r.w); o[64 * j] = p; }
    }
}
__device__ __forceinline__ void final_norm_rows_bf16(const Ctx& F, const bf16* H, const float* nw, float* O, float oscale) {
    if (F.gw >= M) return;
    v2u un[8]; load_row_raw(H + (size_t)F.gw * DM, F.lane, un);
    f32x4 wv[8];
#pragma unroll
    for (int j = 0; j < 8; ++j) wv[j] = ((const f32x4*)nw + F.lane)[64 * j];
    for (int m = F.gw; m < M; m += F.NGW) {
        f32x4 v[8]; float s = 0.f;
#pragma unroll
        for (int j = 0; j < 8; ++j) { v[j] = (f32x4){bflo(un[j].x), bfhi(un[j].x), bflo(un[j].y), bfhi(un[j].y)}; s += (v[j].x * v[j].x + v[j].y * v[j].y) + (v[j].z * v[j].z + v[j].w * v[j].w); }
        { const int mn = (m + F.NGW < M) ? m + F.NGW : m; load_row_raw(H + (size_t)mn * DM, F.lane, un); }
        const float rstd = rsqrtf(wave_sum_fast(s) * (1.f / DM) + RMS_EPS) * oscale;
        f32x4* o = (f32x4*)(O + (size_t)m * DM) + F.lane;
#pragma unroll
        for (int j = 0; j < 8; ++j) __builtin_nontemporal_store((v[j] * rstd) * wv[j], o + 64 * j);
    }
}
#define LO2(v) __builtin_shufflevector((v), (v), 0, 1)
#define HI2(v) __builtin_shufflevector((v), (v), 2, 3)
template <int CTRL> __device__ __forceinline__ float dpp_f(float x) { return __builtin_bit_cast(float, __builtin_amdgcn_mov_dpp(__builtin_bit_cast(int, x), CTRL, 0xf, 0xf, true)); }
__device__ __forceinline__ float rowsum16(float x) { x += dpp_f<0xB1>(x); x += dpp_f<0x4E>(x); x += dpp_f<0x124>(x); x += dpp_f<0x128>(x); return x; }
__device__ __forceinline__ float quadsum(float x) { x += dpp_f<0xB1>(x); x += dpp_f<0x4E>(x); return x; }

__device__ __forceinline__ float treduce16(const float (&p)[16], bool b0, bool b1, bool b2, bool b3) {
    float a[8], bq[4], c2[2];
#pragma unroll
    for (int j = 0; j < 8; ++j) { const float mine = b3 ? p[j + 8] : p[j], send = b3 ? p[j] : p[j + 8]; a[j] = mine + dpp_f<0x128>(send); }
#pragma unroll
    for (int j = 0; j < 4; ++j) { const float mine = b2 ? a[j + 4] : a[j], send = b2 ? a[j] : a[j + 4]; const float up = dpp_f<0x104>(send), dn = dpp_f<0x114>(send); bq[j] = mine + (b2 ? dn : up); }
#pragma unroll
    for (int j = 0; j < 2; ++j) { const float mine = b1 ? bq[j + 2] : bq[j], send = b1 ? bq[j] : bq[j + 2]; c2[j] = mine + dpp_f<0x4E>(send); }
    const float mine = b0 ? c2[1] : c2[0], send = b0 ? c2[0] : c2[1];
    return mine + dpp_f<0xB1>(send);
}
__device__ __forceinline__ float wave_sum_dpp(float v) { v = rowsum16(v); v += __shfl_xor(v, 16); v += __shfl_xor(v, 32); return v; }
__device__ __forceinline__ void unpack8(const v4u p, float (&e)[8]) { e[0] = bflo(p.x); e[1] = bfhi(p.x); e[2] = bflo(p.y); e[3] = bfhi(p.y); e[4] = bflo(p.z); e[5] = bfhi(p.z); e[6] = bflo(p.w); e[7] = bfhi(p.w); }
__device__ __forceinline__ v4u pack8(const float (&e)[8]) { v4u o; o.x = pk2(e[0], e[1]); o.y = pk2(e[2], e[3]); o.z = pk2(e[4], e[5]); o.w = pk2(e[6], e[7]); return o; }

__device__ __forceinline__ void p3_lora(const Ctx& F) {
    const bf16* PROJ = (const bf16*)(F.ws + WS_PROJ);
    const bf16* WUPT = (const bf16*)(F.ws + WS_WUPT); const bf16* AUPT = (const bf16*)(F.ws + WS_AUPT); const bf16* GUPT = (const bf16*)(F.ws + WS_GUPT);
    bf16* LW = (bf16*)(F.ws + WS_LW); bf16* AA = (bf16*)(F.ws + WS_AA); bf16* GG = (bf16*)(F.ws + WS_GG);
    const float* mu = F.in[I_MU]; const float* w0 = F.in[I_W0]; const float* a0 = F.in[I_A0];
    const int r16 = F.lane & 15, q = F.lane >> 4;
    constexpr int WST = 72, GST = 168;
    LAS bf16* WU = (LAS bf16*)F.lds; LAS bf16* AU = WU + 128 * WST; LAS bf16* GU = AU + 128 * WST;
    const int nr = blockIdx.x & 7, nbr = (F.G - nr + 7) >> 3;
    __syncthreads();
    for (int i = F.tid; i < 128 * 8; i += NTHR) { const int row = i >> 3, ch = i & 7;
        *(LAS v4u*)(WU + row * WST + 8 * ch) = *(const v4u*)(WUPT + (size_t)(128 * nr + row) * L_W + 8 * ch);
        *(LAS v4u*)(AU + row * WST + 8 * ch) = *(const v4u*)(AUPT + (size_t)(128 * nr + row) * L_A + 8 * ch); }
    for (int i = F.tid; i < 128 * 20; i += NTHR) { const int row = i / 20, ch = i - row * 20;
        *(LAS v4u*)(GU + row * GST + 8 * ch) = *(const v4u*)(GUPT + (size_t)(128 * nr + row) * L_G + 8 * ch); }
    __syncthreads();
#define P3_COL(s) ((((s) < 2) ? (C_WD + 32 * (s)) : ((s) < 4) ? (C_AD + 32 * ((s) - 2)) : (C_GD + 32 * ((s) - 4))) + 8 * q)
    const int mt0 = (blockIdx.x >> 3) * NWAVES + F.wave, mst = nbr * NWAVES;
    v4u rc_[9], rp_[9];
    if (mt0 < M / 16) { const bf16* row = PROJ + (size_t)(mt0 * 16 + r16) * INPP;
#pragma unroll
        for (int s = 0; s < 9; ++s) { rc_[s] = *(const v4u*)(row + P3_COL(s)); rp_[s] = *(const v4u*)(row - INPP + P3_COL(s)); } }
    for (int mt = mt0; mt < M / 16; mt += mst) {
        const int m = mt * 16 + r16; const bool first = (m % SEQ) == 0;
        bf16x8 af[9];
#pragma unroll
        for (int s = 0; s < 9; ++s) {
            const int col = P3_COL(s);
            const v4u pc = rc_[s];
            v4u pp = rp_[s]; if (first) pp = (v4u){0u, 0u, 0u, 0u};
            const f32x4 m0 = *(const f32x4*)(mu + col), m1 = *(const f32x4*)(mu + col + 4);
            float c[8], p[8], e[8]; unpack8(pc, c); unpack8(pp, p);
            const float mm[8] = {m0.x, m0.y, m0.z, m0.w, m1.x, m1.y, m1.z, m1.w};
#pragma unroll
            for (int j = 0; j < 8; ++j) { float v = c[j] + (p[j] - c[j]) * mm[j];
                if (s < 2) { const float t = __expf(2.f * v); v = 1.f - 2.f * rcp_f(t + 1.f); }
                else if (s >= 4) v = sigmoid_f(v);
                e[j] = v; }
            af[s] = __builtin_bit_cast(bf16x8, pack8(e));
        }
        { const int mtn = (mt + mst < M / 16) ? mt + mst : mt; const bf16* row = PROJ + (size_t)(mtn * 16 + r16) * INPP;
#pragma unroll
          for (int s = 0; s < 9; ++s) { rc_[s] = *(const v4u*)(row + P3_COL(s)); rp_[s] = *(const v4u*)(row - INPP + P3_COL(s)); } }
        asm volatile("" ::: "memory");
#pragma unroll 2
        for (int nt = 0; nt < 8; ++nt) {
            const LAS bf16* wu = WU + (16 * nt + r16) * WST + 8 * q; const LAS bf16* au = AU + (16 * nt + r16) * WST + 8 * q; const LAS bf16* gu = GU + (16 * nt + r16) * GST + 8 * q;
            f32x4 acc0 = {0.f, 0.f, 0.f, 0.f}, acc1 = acc0, acc2 = acc0;
#pragma unroll
            for (int s2 = 0; s2 < 2; ++s2) acc0 = __builtin_amdgcn_mfma_f32_16x16x32_bf16(*(const LAS bf16x8*)(wu + 32 * s2), af[s2], acc0, 0, 0, 0);
#pragma unroll
            for (int s2 = 0; s2 < 2; ++s2) acc1 = __builtin_amdgcn_mfma_f32_16x16x32_bf16(*(const LAS bf16x8*)(au + 32 * s2), af[2 + s2], acc1, 0, 0, 0);
#pragma unroll
            for (int s2 = 0; s2 < 5; ++s2) acc2 = __builtin_amdgcn_mfma_f32_16x16x32_bf16(*(const LAS bf16x8*)(gu + 32 * s2), af[4 + s2], acc2, 0, 0, 0);
            const int n = 128 * nr + 16 * nt + 4 * q;
            const f32x4 w0v = *(const f32x4*)(w0 + n), a0v = *(const f32x4*)(a0 + n);
            v2u o0, o1, o2;
            o0.x = pk2(-0.60653066f * sigmoid_f(acc0[0] + w0v.x), -0.60653066f * sigmoid_f(acc0[1] + w0v.y));
            o0.y = pk2(-0.60653066f * sigmoid_f(acc0[2] + w0v.z), -0.60653066f * sigmoid_f(acc0[3] + w0v.w));
            o1.x = pk2(sigmoid_f(acc1[0] + a0v.x), sigmoid_f(acc1[1] + a0v.y)); o1.y = pk2(sigmoid_f(acc1[2] + a0v.z), sigmoid_f(acc1[3] + a0v.w));
            o2.x = pk2(acc2[0], acc2[1]); o2.y = pk2(acc2[2], acc2[3]);
            *(v2u*)(LW + (size_t)m * RW + n) = o0; *(v2u*)(AA + (size_t)m * RW + n) = o1; *(v2u*)(GG + (size_t)m * RW + n) = o2;
        }
    }
#undef P3_COL
    __syncthreads();
}

constexpr int TC = 32, NCHUNK = SEQ / TC;
constexpr int RB_R = 0, RB_W = TC * 64, RB_K = 2 * TC * 64, RB_KK = 3 * TC * 64, RB_KA = 4 * TC * 64, RB_V = 5 * TC * 64, RB_SIZE = 5 * TC * 64 + TC * 16;
constexpr int MB_B = 0, MB_C = TC * 128, MB_X = 2 * TC * 128, MB_DT = MB_X + TC * 32, MB_DA = MB_DT + TC, MB_SIZE = MB_DA + TC;
static_assert(2 * RB_SIZE * 4 <= RING_BYTES, "scan buffers fit the LDS ring");

struct RwkvRaw { bf16 r[9], k[9], v[9], lw[8], a[8]; };
__device__ __forceinline__ void rwkv_load(RwkvRaw& raw, const bf16* PROJ, const bf16* LW, const bf16* AA, int b, int h, int t0w, int c) {
    const bf16* base = PROJ + (size_t)(b * SEQ + t0w) * INPP + h * 64 + c;
#pragma unroll
    for (int i = 0; i < 9; ++i) {
        if (i == 0 && t0w == 0) { raw.r[0] = 0; raw.k[0] = 0; raw.v[0] = 0; }
        else { const bf16* row = base + (long)(i - 1) * INPP; raw.r[i] = row[C_R]; raw.k[i] = row[C_K]; raw.v[i] = row[C_V]; }
    }
#pragma unroll
    for (int i = 0; i < 8; ++i) { const size_t o = (size_t)(b * SEQ + t0w + i) * RW + h * 64 + c; raw.lw[i] = LW[o]; raw.a[i] = AA[o]; }
}
__device__ __forceinline__ void rwkv_stage(const RwkvRaw& raw, LAS float* buf, int tl0, int c, int qt, float mu_r, float mu_k, float mu_v, float kkw, float kaw) {
#pragma unroll
    for (int i = 0; i < 8; ++i) {
        const int t = tl0 + i;
        const float rc = bf1(raw.r[i + 1]), rp = bf1(raw.r[i]), kc = bf1(raw.k[i + 1]), kp = bf1(raw.k[i]), vc = bf1(raw.v[i + 1]), vp = bf1(raw.v[i]);
        const float rr = rc + (rp - rc) * mu_r, kx = kc + (kp - kc) * mu_k, vv = vc + (vp - vc) * mu_v;
        const float a = bf1(raw.a[i]), dec = __expf(bf1(raw.lw[i]));
        const float kkraw = kx * kkw; const float ss = wave_sum_dpp(kkraw * kkraw);
        const float kkn = kkraw * rcp_f(fmaxf(sqrtf(ss), 1e-12f));
        buf[RB_R + t * 64 + c] = rr; buf[RB_W + t * 64 + c] = dec; buf[RB_K + t * 64 + c] = kx * (1.f + (a - 1.f) * kaw);
        buf[RB_KK + t * 64 + c] = kkn; buf[RB_KA + t * 64 + c] = kkn * a;
        if ((c >> 4) == qt) buf[RB_V + t * 16 + (c & 15)] = vv;
    }
}
__device__ __forceinline__ void rwkv_task(const Ctx& F, int task) {
    const int b = task >> 6, h = (task >> 2) & 15, qt = task & 3;
    const bf16* PROJ = (const bf16*)(F.ws + WS_PROJ); const bf16* LW = (const bf16*)(F.ws + WS_LW); const bf16* AA = (const bf16*)(F.ws + WS_AA);
    bf16* OY = (bf16*)(F.ws + WS_OY);
    LAS float* lbuf = (LAS float*)F.lds;
    const int c = F.lane, w = F.wave, r = F.lane >> 4, cg = F.lane & 15;
    const bool stager = w >= 4; const int sw = w & 3;
    const int ch = h * 64 + c;
    const float mu_r = F.in[I_MU][C_R + ch], mu_k = F.in[I_MU][C_K + ch], mu_v = F.in[I_MU][C_V + ch], kkw = F.in[I_KK][ch], kaw = F.in[I_KA][ch];
    RwkvRaw raw;
    if (stager) { rwkv_load(raw, PROJ, LW, AA, b, h, 8 * sw, c); rwkv_stage(raw, lbuf, 8 * sw, c, qt, mu_r, mu_k, mu_v, kkw, kaw); rwkv_load(raw, PROJ, LW, AA, b, h, TC + 8 * sw, c); }
    __syncthreads();
    f32x2 S01 = {0.f, 0.f}, S23 = {0.f, 0.f};
    const bool cb0 = cg & 1, cb1 = cg & 2, cb2 = cg & 4, cb3 = cg & 8;
    bf16* orow = OY + (size_t)(b * SEQ) * DM + h * 64 + 16 * qt + 4 * sw + r;
    for (int ck = 0; ck < NCHUNK; ++ck) {
        const LAS float* buf = lbuf + (ck & 1) * RB_SIZE;
        if (stager) {
            if (ck + 1 < NCHUNK) { rwkv_stage(raw, lbuf + ((ck + 1) & 1) * RB_SIZE, 8 * sw, c, qt, mu_r, mu_k, mu_v, kkw, kaw);
                if (ck + 2 < NCHUNK) rwkv_load(raw, PROJ, LW, AA, b, h, (ck + 2) * TC + 8 * sw, c); }
        } else {
            const LAS float* bp = buf + 4 * cg; const LAS float* vp = buf + RB_V + 4 * sw + r;
            f32x4 qkk[3], qw[3], qka[3], qk[3], qr[3]; float qv[3];
#pragma unroll
            for (int i = 0; i < 3; ++i) { qkk[i] = *(const LAS f32x4*)(bp + RB_KK + i * 64); qw[i] = *(const LAS f32x4*)(bp + RB_W + i * 64); qka[i] = *(const LAS f32x4*)(bp + RB_KA + i * 64);
                qk[i] = *(const LAS f32x4*)(bp + RB_K + i * 64); qr[i] = *(const LAS f32x4*)(bp + RB_R + i * 64); qv[i] = vp[i * 16]; }
            float op[16];
#pragma unroll
            for (int j = 0; j < TC; ++j) {
                const int u = j % 3;
                const f32x4 kk4 = qkk[u], w4 = qw[u], ka4 = qka[u], k4 = qk[u], r4 = qr[u]; const float vr = qv[u];
                const f32x2 tq = S01 * LO2(kk4) + S23 * HI2(kk4);
                const float sa = rowsum16(tq.x + tq.y);
                const f32x2 sav = {sa, sa}, vrv = {vr, vr};
                S01 = S01 * LO2(w4) + (vrv * LO2(k4) - sav * LO2(ka4));
                S23 = S23 * HI2(w4) + (vrv * HI2(k4) - sav * HI2(ka4));
                const f32x2 uq = S01 * LO2(r4) + S23 * HI2(r4);
                op[j & 15] = uq.x + uq.y;
                asm volatile("" : "+v"(S01), "+v"(S23) :: "memory");
                if (j + 3 < TC) { qkk[u] = *(const LAS f32x4*)(bp + RB_KK + (j + 3) * 64); qw[u] = *(const LAS f32x4*)(bp + RB_W + (j + 3) * 64); qka[u] = *(const LAS f32x4*)(bp + RB_KA + (j + 3) * 64);
                                  qk[u] = *(const LAS f32x4*)(bp + RB_K + (j + 3) * 64); qr[u] = *(const LAS f32x4*)(bp + RB_R + (j + 3) * 64); qv[u] = vp[(j + 3) * 16]; }
                if ((j & 15) == 15) {
                    const float ored = treduce16(op, cb0, cb1, cb2, cb3);
                    orow[(size_t)(ck * TC + (j - 15) + cg) * DM] = (bf16)(pk2(ored, 0.f) & 0xffffu);
                }
            }
        }
        __syncthreads();
    }
}

__device__ __forceinline__ void p4_scans(const Ctx& F) {
    for (int task = blockIdx.x; task < NB * RHEADS * 4; task += F.G) { rwkv_task(F, task); __syncthreads(); }
}

__device__ __forceinline__ void ld16(const float* p, float (&v)[16]) {
#pragma unroll
    for (int i = 0; i < 4; ++i) { const f32x4 t = *(const f32x4*)(p + 4 * i); v[4 * i] = t.x; v[4 * i + 1] = t.y; v[4 * i + 2] = t.z; v[4 * i + 3] = t.w; }
}
__device__ __forceinline__ void ldbf16x16(const bf16* p, float (&v)[16]) {
    float t0[8], t1[8]; unpack8(*(const v4u*)p, t0); unpack8(*(const v4u*)(p + 8), t1);
#pragma unroll
    for (int j = 0; j < 8; ++j) { v[j] = t0[j]; v[8 + j] = t1[j]; }
}
__device__ __forceinline__ void stbf16x16(bf16* p, const float (&v)[16]) {
    float t0[8], t1[8];
#pragma unroll
    for (int j = 0; j < 8; ++j) { t0[j] = v[j]; t1[j] = v[8 + j]; }
    *(v4u*)p = pack8(t0); *(v4u*)(p + 8) = pack8(t1);
}
__device__ __forceinline__ void p5_post(const Ctx& F) {
    const bf16* PROJ = (const bf16*)(F.ws + WS_PROJ); const bf16* AA = (const bf16*)(F.ws + WS_AA); const bf16* GG = (const bf16*)(F.ws + WS_GG);
    bf16* OY = (bf16*)(F.ws + WS_OY);
    const int c0 = 16 * F.lane;
    {
        float mur[16], muk[16], muv[16], ka[16], rk[16], lnw[16], lnb[16];
        ld16(F.in[I_MU] + C_R + c0, mur); ld16(F.in[I_MU] + C_K + c0, muk); ld16(F.in[I_MU] + C_V + c0, muv);
        ld16(F.in[I_KA] + c0, ka); ld16(F.in[I_RK] + c0, rk); ld16(F.in[I_LNW] + c0, lnw); ld16(F.in[I_LNB] + c0, lnb);
        for (int m = F.gw; m < M; m += F.NGW) {
            const bool first = (m % SEQ) == 0;
            const bf16* prow = PROJ + (size_t)m * INPP; bf16* oyrow = OY + (size_t)m * DM;
            float o[16], res[16]; float bs = 0.f;
            ldbf16x16(oyrow + c0, o);
            {
                float rc[16], rp[16], kc[16], kp[16], av[16];
                ldbf16x16(prow + C_R + c0, rc); ldbf16x16(prow + C_K + c0, kc); ldbf16x16(AA + (size_t)m * RW + c0, av);
                if (!first) { ldbf16x16(prow - INPP + C_R + c0, rp); ldbf16x16(prow - INPP + C_K + c0, kp); }
                else {
#pragma unroll
                    for (int j = 0; j < 16; ++j) { rp[j] = 0.f; kp[j] = 0.f; } }
#pragma unroll
                for (int j = 0; j < 16; ++j) { const float rr = rc[j] + (rp[j] - rc[j]) * mur[j], kx = kc[j] + (kp[j] - kc[j]) * muk[j];
                    bs += rr * (kx * (1.f + (av[j] - 1.f) * ka[j])) * rk[j]; }
            }
            bs = quadsum(bs);
            float s = 0.f;
#pragma unroll
            for (int j = 0; j < 16; ++j) s += o[j];
            const float mean = quadsum(s) * (1.f / 64.f);
            float qv = 0.f;
#pragma unroll
            for (int j = 0; j < 16; ++j) { o[j] -= mean; qv += o[j] * o[j]; }
            const float rstd = rsqrtf(quadsum(qv) * (1.f / 64.f) + 64e-5f);
            {
                float vc[16], vp[16], gv[16];
                ldbf16x16(prow + C_V + c0, vc); ldbf16x16(GG + (size_t)m * RW + c0, gv);
                if (!first) ldbf16x16(prow - INPP + C_V + c0, vp);
                else {
#pragma unroll
                    for (int j = 0; j < 16; ++j) vp[j] = 0.f; }
#pragma unroll
                for (int j = 0; j < 16; ++j) { const float vv = vc[j] + (vp[j] - vc[j]) * muv[j]; res[j] = (o[j] * rstd * lnw[j] + lnb[j] + bs * vv) * gv[j]; }
            }
            stbf16x16(oyrow + c0, res);
        }
    }
    {
        float nw[16]; ld16(F.in[I_MNW] + c0, nw);
        for (int m = F.gw; m < M; m += F.NGW) {
            const bf16* prow = PROJ + (size_t)m * INPP; bf16* oyrow = OY + (size_t)m * DM;
            float y[16], z[16];
            ldbf16x16(oyrow + RW + c0, y); ldbf16x16(prow + C_Z + c0, z);
            float qv = 0.f;
#pragma unroll
            for (int j = 0; j < 16; ++j) { y[j] *= silu_f(z[j]); qv += y[j] * y[j]; }
            qv = rowsum16(qv);
            { auto rr = __builtin_amdgcn_permlane16_swap(__float_as_uint(qv), __float_as_uint(qv), false, false); qv = __uint_as_float(rr[0]) + __uint_as_float(rr[1]); }
            const float rstd = rsqrtf(qv * (1.f / 512.f) + 1e-5f);
#pragma unroll
            for (int j = 0; j < 16; ++j) y[j] = y[j] * rstd * nw[j];
            stbf16x16(oyrow + RW + c0, y);
        }
    }
}
constexpr int MC_L = 128, MC_NC = SEQ / MC_L, LSTR = 136;
constexpr int MT_BYTES = 128 * LSTR * 2;
constexpr size_t WS_ST = 876 * MiB, WS_SIN = 940 * MiB, WS_ATOT = 1004 * MiB, WS_END2 = 1005 * MiB;

__device__ __forceinline__ float mamba_dt_scan(const Ctx& F, const bf16* PROJ, int b, int c, int g, LAS float* DT, LAS float* ACS) {
    const int head = g * 8 + F.wave, lane = F.lane;
    const float dtb = F.in[I_DTB][head], Aneg = -__expf(F.in[I_ALOG][head]);
    const bf16* p = PROJ + (size_t)(b * SEQ + c * MC_L + 2 * lane) * INPP + C_DT + head;
    const float x0 = bf1(p[0]) + dtb, x1 = bf1(p[INPP]) + dtb;
    const float d0 = (x0 > 20.f) ? x0 : log1pf(__expf(x0)), d1 = (x1 > 20.f) ? x1 : log1pf(__expf(x1));
    const float s0 = d0 * Aneg, s1 = s0 + d1 * Aneg;
    float incl = s1;
#pragma unroll
    for (int o = 1; o < 64; o <<= 1) { const float t = __shfl_up(incl, o); if (lane >= o) incl += t; }
    const float excl = incl - s1;
    DT[F.wave * 128 + 2 * lane] = d0; DT[F.wave * 128 + 2 * lane + 1] = d1;
    ACS[F.wave * 128 + 2 * lane] = excl + s0; ACS[F.wave * 128 + 2 * lane + 1] = excl + s1;
    return __shfl(incl, 63);
}
struct TRaw { bf16 v[35]; };
__device__ __forceinline__ void mstage_T_load(TRaw& raw, const bf16* PROJ, int b, int c, int chn, int tid) {
    const int t0 = 32 * (tid >> 7);
    const bf16* base = PROJ + (size_t)(b * SEQ + c * MC_L + t0) * INPP + C_XBC + chn;
    if (c * MC_L + t0 > 0) { raw.v[0] = base[-3 * INPP]; raw.v[1] = base[-2 * INPP]; raw.v[2] = base[-1 * INPP]; }
    else { raw.v[0] = 0; raw.v[1] = 0; raw.v[2] = 0; }
#pragma unroll
    for (int t = 0; t < 32; ++t) raw.v[3 + t] = base[(size_t)t * INPP];
}
template <bool SC>
__device__ __forceinline__ void mstage_T_store(const TRaw& raw, int chn, LAS bf16* dst, const LAS float* scale, const float* convw, const float* convb, int tid) {
    const int f = tid & 127, t0 = 32 * (tid >> 7);
    const float w0 = convw[chn], w1 = convw[1536 + chn], w2 = convw[2 * 1536 + chn], w3 = convw[3 * 1536 + chn], bb = convb[chn];
#pragma unroll
    for (int i8 = 0; i8 < 4; ++i8) {
        float e[8];
#pragma unroll
        for (int i = 0; i < 8; ++i) { const int t = 8 * i8 + i;
            float v = silu_f(bb + w0 * bf1(raw.v[t]) + w1 * bf1(raw.v[t + 1]) + w2 * bf1(raw.v[t + 2]) + w3 * bf1(raw.v[t + 3]));
            if (SC) v *= scale[t0 + t];
            e[i] = v; }
        *(LAS v4u*)(dst + f * LSTR + t0 + 8 * i8) = pack8(e);
    }
}
__device__ __forceinline__ void mstage_N(const bf16* PROJ, int b, int c, int g, LAS bf16* Bn, LAS bf16* Cn, const float* convw, const float* convb, int tid) {
    const int f8 = tid & 31, t0 = 8 * (tid >> 5);
    const int chn = (f8 < 16) ? (1024 + g * 128 + 8 * f8) : (1280 + g * 128 + 8 * (f8 - 16));
    LAS bf16* dst = ((f8 < 16) ? Bn : Cn) + 8 * (f8 & 15);
    const bf16* base = PROJ + (size_t)(b * SEQ + c * MC_L + t0) * INPP + C_XBC + chn;
    float w[4][8], bb[8];
#pragma unroll
    for (int i = 0; i < 4; ++i) { const f32x4 a = *(const f32x4*)(convw + i * 1536 + chn), d = *(const f32x4*)(convw + i * 1536 + chn + 4);
        w[i][0] = a.x; w[i][1] = a.y; w[i][2] = a.z; w[i][3] = a.w; w[i][4] = d.x; w[i][5] = d.y; w[i][6] = d.z; w[i][7] = d.w; }
    { const f32x4 a = *(const f32x4*)(convb + chn), d = *(const f32x4*)(convb + chn + 4); bb[0] = a.x; bb[1] = a.y; bb[2] = a.z; bb[3] = a.w; bb[4] = d.x; bb[5] = d.y; bb[6] = d.z; bb[7] = d.w; }
    float r0[8], r1[8], r2[8];
    if (c * MC_L + t0 > 0) { unpack8(*(const v4u*)(base - 3 * INPP), r0); unpack8(*(const v4u*)(base - 2 * INPP), r1); unpack8(*(const v4u*)(base - 1 * INPP), r2); }
    else {
#pragma unroll
        for (int k = 0; k < 8; ++k) { r0[k] = 0.f; r1[k] = 0.f; r2[k] = 0.f; } }
#pragma unroll
    for (int t = 0; t < 8; ++t) {
        float r3[8], e[8]; unpack8(*(const v4u*)(base + (size_t)t * INPP), r3);
#pragma unroll
        for (int k = 0; k < 8; ++k) { e[k] = silu_f(bb[k] + w[0][k] * r0[k] + w[1][k] * r1[k] + w[2][k] * r2[k] + w[3][k] * r3[k]); r0[k] = r1[k]; r1[k] = r2[k]; r2[k] = r3[k]; }
        *(LAS v4u*)(dst + (t0 + t) * LSTR) = pack8(e);
    }
}

__device__ __forceinline__ void m1_chunk_states(const Ctx& F) {
    const bf16* PROJ = (const bf16*)(F.ws + WS_PROJ); bf16* ST = (bf16*)(F.ws + WS_ST); float* ATOT = (float*)(F.ws + WS_ATOT);
    LAS bf16* BT = (LAS bf16*)F.lds; LAS bf16* XT = (LAS bf16*)(F.lds + MT_BYTES);
    LAS float* DT = (LAS float*)(F.lds + 3 * MT_BYTES); LAS float* ACS = DT + 8 * 128; LAS float* SCL = ACS + 8 * 128;
    const float* convw = F.in[I_CONVW]; const float* convb = F.in[I_CONVB];
    const int tid = F.tid, w = F.wave, lane = F.lane, r16 = lane & 15, q = lane >> 4;
    for (int it = blockIdx.x; it < NB * MC_NC * 2; it += F.G) {
        const int g = it & 1, c = (it >> 1) & (MC_NC - 1), b = it >> 7;
        __syncthreads();
        const float atot = mamba_dt_scan(F, PROJ, b, c, g, DT, ACS);
        if (lane == 0) ATOT[(b * MC_NC + c) * 16 + g * 8 + w] = atot;
        const int chB = 1024 + g * 128 + (tid & 127);
        TRaw ra, rb;
        mstage_T_load(ra, PROJ, b, c, chB, tid);
        mstage_T_load(rb, PROJ, b, c, (g * 8 + ((tid & 127) >> 6)) * 64 + (tid & 63), tid);
        LDS_WAIT();
        SCL[w * 128 + 2 * lane] = DT[w * 128 + 2 * lane] * __expf(atot - ACS[w * 128 + 2 * lane]);
        SCL[w * 128 + 2 * lane + 1] = DT[w * 128 + 2 * lane + 1] * __expf(atot - ACS[w * 128 + 2 * lane + 1]);
        mstage_T_store<false>(ra, chB, BT, nullptr, convw, convb, tid);
        mstage_T_load(ra, PROJ, b, c, (g * 8 + 2 + ((tid & 127) >> 6)) * 64 + (tid & 63), tid);
        __syncthreads();
#pragma unroll
        for (int hb = 0; hb < 2; ++hb) {
            if (hb == 1) mstage_T_load(ra, PROJ, b, c, (g * 8 + 6 + ((tid & 127) >> 6)) * 64 + (tid & 63), tid);
            { const int hl = 4 * hb + ((tid & 127) >> 6); mstage_T_store<true>(rb, (g * 8 + hl) * 64 + (tid & 63), XT, SCL + hl * 128, convw, convb, tid); }
            if (hb == 0) mstage_T_load(rb, PROJ, b, c, (g * 8 + 4 + ((tid & 127) >> 6)) * 64 + (tid & 63), tid);
            { const int hl = 4 * hb + 2 + ((tid & 127) >> 6); mstage_T_store<true>(ra, (g * 8 + hl) * 64 + (tid & 63), XT + 128 * LSTR, SCL + hl * 128, convw, convb, tid); }
            __syncthreads();
            const int hh = w >> 1, ph = w & 1;
            f32x4 acc[2][8];
#pragma unroll
            for (int a = 0; a < 2; ++a)
#pragma unroll
                for (int n = 0; n < 8; ++n) acc[a][n] = (f32x4){0.f, 0.f, 0.f, 0.f};
#pragma unroll
            for (int ks = 0; ks < 4; ++ks) {
                bf16x8 xa[2];
#pragma unroll
                for (int a = 0; a < 2; ++a) xa[a] = *(const LAS bf16x8*)(XT + (hh * 64 + 32 * ph + 16 * a + r16) * LSTR + 32 * ks + 8 * q);
#pragma unroll
                for (int n = 0; n < 8; ++n) { const bf16x8 bfr = *(const LAS bf16x8*)(BT + (16 * n + r16) * LSTR + 32 * ks + 8 * q);
#pragma unroll
                    for (int a = 0; a < 2; ++a) acc[a][n] = __builtin_amdgcn_mfma_f32_16x16x32_bf16(bfr, xa[a], acc[a][n], 0, 0, 0); }
            }
            bf16* st = ST + ((size_t)((b * MC_NC + c) * 16 + g * 8 + 4 * hb + hh)) * (64 * 128);
#pragma unroll
            for (int a = 0; a < 2; ++a)
#pragma unroll
                for (int n = 0; n < 8; ++n) { v2u o; o.x = pk2(acc[a][n][0], acc[a][n][1]); o.y = pk2(acc[a][n][2], acc[a][n][3]);
                    *(v2u*)(st + (32 * ph + 16 * a + r16) * 128 + 16 * n + 4 * q) = o; }
            __syncthreads();
        }
    }
}

__device__ __forceinline__ void m2_prefix(const Ctx& F) {
    const bf16* ST = (const bf16*)(F.ws + WS_ST); bf16* SIN = (bf16*)(F.ws + WS_SIN); const float* ATOT = (const float*)(F.ws + WS_ATOT);
    const int nthr = F.G * NTHR;
    for (int gi = blockIdx.x * NTHR + F.tid; gi < NB * 16 * 2048; gi += nthr) {
        const int e4 = gi & 2047, bh = gi >> 11, b = bh >> 4, h = bh & 15;
        float r0 = 0.f, r1 = 0.f, r2 = 0.f, r3 = 0.f;
#pragma unroll 4
        for (int c = 0; c < MC_NC; ++c) {
            const size_t o = ((size_t)((b * MC_NC + c) * 16 + h)) * 8192 + 4 * e4;
            v2u so; so.x = pk2(r0, r1); so.y = pk2(r2, r3);
            *(v2u*)(SIN + o) = so;
            const v2u sv = *(const v2u*)(ST + o); const float d = __expf(ATOT[(b * MC_NC + c) * 16 + h]);
            r0 = r0 * d + bflo(sv.x); r1 = r1 * d + bfhi(sv.x); r2 = r2 * d + bflo(sv.y); r3 = r3 * d + bfhi(sv.y);
        }
    }
}

__device__ __forceinline__ void m3_outputs(const Ctx& F) {
    const bf16* PROJ = (const bf16*)(F.ws + WS_PROJ); const bf16* SIN = (const bf16*)(F.ws + WS_SIN); bf16* OY = (bf16*)(F.ws + WS_OY);
    LAS bf16* Cn = (LAS bf16*)F.lds; LAS bf16* RB = (LAS bf16*)(F.lds + MT_BYTES);
    LAS bf16* Mw = (LAS bf16*)(F.lds + 2 * MT_BYTES) + F.wave * 16 * LSTR;
    LAS float* DT = (LAS float*)(F.lds + 3 * MT_BYTES); LAS float* ACS = DT + 8 * 128;
    const float* convw = F.in[I_CONVW]; const float* convb = F.in[I_CONVB];
    const int tid = F.tid, w = F.wave, lane = F.lane, r16 = lane & 15, q = lane >> 4;
    for (int it = blockIdx.x; it < NB * MC_NC * 2; it += F.G) {
        const int g = it & 1, c = (it >> 1) & (MC_NC - 1), b = it >> 7;
        __syncthreads();
        (void)mamba_dt_scan(F, PROJ, b, c, g, DT, ACS);
        mstage_N(PROJ, b, c, g, RB, Cn, convw, convb, tid);
        __syncthreads();
        TRaw rx;
        mstage_T_load(rx, PROJ, b, c, (g * 8 + ((tid & 127) >> 6)) * 64 + (tid & 63), tid);
        bf16x8 cf[4];
#pragma unroll
        for (int ks = 0; ks < 4; ++ks) cf[ks] = *(const LAS bf16x8*)(Cn + (16 * w + r16) * LSTR + 32 * ks + 8 * q);
        f32x4 Gt[8];
#pragma unroll
        for (int nt = 0; nt < 8; ++nt) { Gt[nt] = (f32x4){0.f, 0.f, 0.f, 0.f};
#pragma unroll
            for (int ks = 0; ks < 4; ++ks) Gt[nt] = __builtin_amdgcn_mfma_f32_16x16x32_bf16(*(const LAS bf16x8*)(RB + (16 * nt + r16) * LSTR + 32 * ks + 8 * q), cf[ks], Gt[nt], 0, 0, 0); }
        const int l = 16 * w + r16;
        const size_t mrow = (size_t)(b * SEQ + c * MC_L + l);
#pragma unroll 1
        for (int hb = 0; hb < 4; ++hb) {
            __syncthreads();
            { const int hl = 2 * hb + ((tid & 127) >> 6); mstage_T_store<false>(rx, (g * 8 + hl) * 64 + (tid & 63), RB, nullptr, convw, convb, tid); }
            { const int hn = (hb < 3) ? 2 * (hb + 1) : 2 * hb; mstage_T_load(rx, PROJ, b, c, (g * 8 + hn + ((tid & 127) >> 6)) * 64 + (tid & 63), tid); }
            __syncthreads();
#pragma unroll 1
            for (int h2 = 0; h2 < 2; ++h2) {
                const int hl = 2 * hb + h2, head = g * 8 + hl;
                const float acs_l = ACS[hl * 128 + l];
                const bf16* sin = SIN + ((size_t)((b * MC_NC + c) * 16 + head)) * 8192;
                bf16x8 sf[4][4];
#pragma unroll
                for (int pt = 0; pt < 4; ++pt)
#pragma unroll
                    for (int ks = 0; ks < 4; ++ks) sf[pt][ks] = *(const bf16x8*)(sin + (16 * pt + r16) * 128 + 32 * ks + 8 * q);
#pragma unroll
                for (int nt = 0; nt < 8; ++nt) { const f32x4 as = *(const LAS f32x4*)(ACS + hl * 128 + 16 * nt + 4 * q), ds = *(const LAS f32x4*)(DT + hl * 128 + 16 * nt + 4 * q);
                    float mv[4];
#pragma unroll
                    for (int j = 0; j < 4; ++j) { const int s = 16 * nt + 4 * q + j; mv[j] = (s <= l) ? Gt[nt][j] * __expf(acs_l - as[j]) * ds[j] : 0.f; }
                    v2u o; o.x = pk2(mv[0], mv[1]); o.y = pk2(mv[2], mv[3]);
                    *(LAS v2u*)(Mw + r16 * LSTR + 16 * nt + 4 * q) = o; }
                LDS_WAIT(); asm volatile("" ::: "memory");
                bf16x8 mf[4];
#pragma unroll
                for (int ks = 0; ks < 4; ++ks) mf[ks] = *(const LAS bf16x8*)(Mw + r16 * LSTR + 32 * ks + 8 * q);
                const float el = __expf(acs_l), Dh = F.in[I_DSK][head];
#pragma unroll
                for (int pt = 0; pt < 4; ++pt) {
                    f32x4 yd = {0.f, 0.f, 0.f, 0.f}, yo = {0.f, 0.f, 0.f, 0.f};
#pragma unroll
                    for (int ks = 0; ks < 4; ++ks) {
                        yd = __builtin_amdgcn_mfma_f32_16x16x32_bf16(*(const LAS bf16x8*)(RB + (h2 * 64 + 16 * pt + r16) * LSTR + 32 * ks + 8 * q), mf[ks], yd, 0, 0, 0);
                        yo = __builtin_amdgcn_mfma_f32_16x16x32_bf16(sf[pt][ks], cf[ks], yo, 0, 0, 0); }
                    float yv[4];
#pragma unroll
                    for (int j = 0; j < 4; ++j) yv[j] = yd[j] + el * yo[j] + Dh * bf1(RB[(h2 * 64 + 16 * pt + 4 * q + j) * LSTR + l]);
                    v2u o; o.x = pk2(yv[0], yv[1]); o.y = pk2(yv[2], yv[3]);
                    *(v2u*)(OY + mrow * DM + RW + head * 64 + 16 * pt + 4 * q) = o;
                }
                asm volatile("" ::: "memory");
            }
        }
    }
}
constexpr int RC = 16, RNCH = SEQ / RC, NPART = 4, RHALF = RNCH / NPART, RITEMS = NB * RHEADS * RHALF;
constexpr size_t RO_WH = 0, RO_RH = 16 * MiB, RO_VT = 32 * MiB, RO_ET = 48 * MiB, RO_OL = 64 * MiB, RO_A2 = 80 * MiB, RO_GC = 112 * MiB, RO_BUF = 116 * MiB, RO_SS = 232 * MiB;
constexpr int RL_KAP = 0, RL_ALP = 2304, RL_KT = 4608, RL_RT = 6912, RL_KAPT = 9216, RL_VT = 11264, RL_TB = 13312, RL_BL = 14336, RL_QL = 15360, RL_PL = 16384,
              RL_WT = RL_KAP, RL_BVT = RL_ALP, RL_AL32 = RL_KT, RL_ET = RL_KT,
              RL_BYTES = 18176;
constexpr int XS = 72, TS = 16, SS16 = 32;

__device__ __forceinline__ float wave_sum_pl(float x) {
    x = rowsum16(x);
    { auto rr = __builtin_amdgcn_permlane16_swap(__float_as_uint(x), __float_as_uint(x), false, false); x = __uint_as_float(rr[0]) + __uint_as_float(rr[1]); }
    { auto rr = __builtin_amdgcn_permlane32_swap(__float_as_uint(x), __float_as_uint(x), false, false); x = __uint_as_float(rr[0]) + __uint_as_float(rr[1]); }
    return x;
}
__device__ __forceinline__ v2u pack4(const f32x4 a) { v2u o; o.x = pk2(a[0], a[1]); o.y = pk2(a[2], a[3]); return o; }
__device__ __forceinline__ f32x4 unpack4(const v2u u) { return (f32x4){bflo(u.x), bfhi(u.x), bflo(u.y), bfhi(u.y)}; }
__device__ __forceinline__ bf16 f2b(float x) { return (bf16)pk2(x, 0.f); }

__device__ __forceinline__ void ra_item(const Ctx& F, LAS unsigned char* wl, int it, int half) {
    const int bh = it / RHALF, cl = it - bh * RHALF, ci = half * RHALF + cl, b = bh >> 4, h = bh & 15;
    const bf16* PROJ = (const bf16*)(F.ws + WS_PROJ); const bf16* LW = (const bf16*)(F.ws + WS_LW); const bf16* AA = (const bf16*)(F.ws + WS_AA);
    unsigned char* RO = (unsigned char*)F.out + (size_t)(half & 1) * RO_BUF;
    const int lane = F.lane, r16 = lane & 15, q = lane >> 4, c = lane, ch = h * 64 + c;
    const size_t m0 = (size_t)b * SEQ + (size_t)RC * ci;
    LAS bf16* KAP = (LAS bf16*)(wl + RL_KAP); LAS bf16* ALP = (LAS bf16*)(wl + RL_ALP); LAS bf16* KT = (LAS bf16*)(wl + RL_KT); LAS bf16* RT = (LAS bf16*)(wl + RL_RT);
    LAS bf16* KAPT = (LAS bf16*)(wl + RL_KAPT); LAS bf16* VTL = (LAS bf16*)(wl + RL_VT); LAS bf16* WT = (LAS bf16*)(wl + RL_WT); LAS bf16* BVT = (LAS bf16*)(wl + RL_BVT); LAS bf16* ETL = (LAS bf16*)(wl + RL_ET);
    LAS bf16* TB = (LAS bf16*)(wl + RL_TB); LAS bf16* BL = (LAS bf16*)(wl + RL_BL); LAS bf16* QL = (LAS bf16*)(wl + RL_QL); LAS bf16* PL = (LAS bf16*)(wl + RL_PL);
    const float mu_r = F.in[I_MU][C_R + ch], mu_k = F.in[I_MU][C_K + ch], mu_v = F.in[I_MU][C_V + ch], kkw = F.in[I_KK][ch], kaw = F.in[I_KA][ch];
    const bf16* prow = PROJ + m0 * INPP + ch;
    float rp = 0.f, kp = 0.f, vp = 0.f;
    if (ci > 0) { rp = bf1(prow[-INPP + C_R]); kp = bf1(prow[-INPP + C_K]); vp = bf1(prow[-INPP + C_V]); }
    float ec = 1.f, kkna[RC], kpv[RC], env[RC], vvv[RC];
    float cum = 0.f;
#pragma unroll
    for (int t = 0; t < RC; ++t) {
        const bf16* row = prow + (size_t)t * INPP;
        const float rc = bf1(row[C_R]), kc = bf1(row[C_K]), vc = bf1(row[C_V]);
        const float a = bf1(AA[(m0 + t) * RW + ch]), lw = bf1(LW[(m0 + t) * RW + ch]);
        const float rr = rc + (rp - rc) * mu_r, kx = kc + (kp - kc) * mu_k, vv = vc + (vp - vc) * mu_v;
        rp = rc; kp = kc; vp = vc;
        const float kkraw = kx * kkw; const float ss = wave_sum_pl(kkraw * kkraw);
        const float kkn = kkraw * rcp_f(fmaxf(sqrtf(ss), 1e-12f));
        const float kpp = kx * (1.f + (a - 1.f) * kaw);
        const float ep = ec; cum += lw; ec = __expf(cum); const float en = rcp_f(ec);
        const unsigned p0 = pk2(kkn * ep, kkn * a * en), p1 = pk2(kpp * en, rr * ec), p2 = pk2(vv, 0.f);
        KAP[t * XS + c] = (bf16)p0; ALP[t * XS + c] = (bf16)(p0 >> 16); KT[t * XS + c] = (bf16)p1; RT[t * XS + c] = (bf16)(p1 >> 16);
        KAPT[c * TS + t] = (bf16)p0; VTL[c * TS + t] = (bf16)p2;
        kkna[t] = kkn * a; kpv[t] = kpp; env[t] = en; vvv[t] = vv;
    }
    {
        float e8[8]; v4u* vt = (v4u*)((bf16*)(RO + RO_VT) + (size_t)it * 1024 + c * 16);
#pragma unroll
        for (int i = 0; i < 8; ++i) e8[i] = vvv[i];
        vt[0] = pack8(e8);
#pragma unroll
        for (int i = 0; i < 8; ++i) e8[i] = vvv[8 + i];
        vt[1] = pack8(e8);
        v4u* a2 = (v4u*)((bf16*)(RO + RO_A2) + (size_t)it * 2048 + c * 32);
        float dd[RC];
#pragma unroll
        for (int t = 0; t < RC; ++t) dd[t] = ec * env[t];
#pragma unroll
        for (int i = 0; i < 8; ++i) e8[i] = -kkna[i] * dd[i];
        a2[0] = pack8(e8);
#pragma unroll
        for (int i = 0; i < 8; ++i) e8[i] = -kkna[8 + i] * dd[8 + i];
        a2[1] = pack8(e8);
#pragma unroll
        for (int i = 0; i < 8; ++i) e8[i] = kpv[i] * dd[i];
        a2[2] = pack8(e8);
#pragma unroll
        for (int i = 0; i < 8; ++i) e8[i] = kpv[8 + i] * dd[8 + i];
        a2[3] = pack8(e8);
        ((float*)(RO + RO_GC))[(size_t)it * 64 + c] = ec;
    }
    LDS_WAIT(); asm volatile("" ::: "memory");
    const v2u zero2 = {0u, 0u};
    {
        f32x4 alt = {0.f, 0.f, 0.f, 0.f}, blt = alt, qlt = alt, plt = alt;
#pragma unroll
        for (int ks = 0; ks < 2; ++ks) {
            const bf16x8 fa = *(const LAS bf16x8*)(ALP + r16 * XS + 32 * ks + 8 * q), fk = *(const LAS bf16x8*)(KT + r16 * XS + 32 * ks + 8 * q);
            const bf16x8 fkp = *(const LAS bf16x8*)(KAP + r16 * XS + 32 * ks + 8 * q), fr = *(const LAS bf16x8*)(RT + r16 * XS + 32 * ks + 8 * q);
            alt = __builtin_amdgcn_mfma_f32_16x16x32_bf16(fa, fkp, alt, 0, 0, 0); blt = __builtin_amdgcn_mfma_f32_16x16x32_bf16(fk, fkp, blt, 0, 0, 0);
            qlt = __builtin_amdgcn_mfma_f32_16x16x32_bf16(fa, fr, qlt, 0, 0, 0);  plt = __builtin_amdgcn_mfma_f32_16x16x32_bf16(fk, fr, plt, 0, 0, 0);
        }
#pragma unroll
        for (int j = 0; j < 4; ++j) { const int s = 4 * q + j; const bool lt = s < r16, le = s <= r16;
            alt[j] = lt ? alt[j] : 0.f; blt[j] = lt ? blt[j] : 0.f; qlt[j] = le ? qlt[j] : 0.f; plt[j] = le ? plt[j] : 0.f; }
        *(LAS v2u*)(BL + r16 * SS16 + 4 * q) = pack4(blt); *(LAS v2u*)(QL + r16 * SS16 + 4 * q) = pack4(qlt); *(LAS v2u*)(PL + r16 * SS16 + 4 * q) = pack4(plt);
        *(LAS v2u*)(BL + r16 * SS16 + 16 + 4 * q) = zero2; *(LAS v2u*)(QL + r16 * SS16 + 16 + 4 * q) = zero2; *(LAS v2u*)(PL + r16 * SS16 + 16 + 4 * q) = zero2;
        float x[RC];
#pragma unroll
        for (int t = 0; t < RC; ++t) {
            float acc = (t == r16) ? 1.f : 0.f;
#pragma unroll
            for (int s2 = 0; s2 < t; ++s2) { const float a_ts = __uint_as_float(__builtin_amdgcn_readlane(__float_as_uint(alt[s2 & 3]), 16 * (s2 >> 2) + t)); acc -= a_ts * x[s2]; }
            x[t] = acc;
        }
        if (q == 0) {
#pragma unroll
            for (int t = 0; t < RC; ++t) { TB[t * SS16 + r16] = f2b(x[t]); TB[t * SS16 + 16 + r16] = 0; }
        }
    }
    LDS_WAIT(); asm volatile("" ::: "memory");
    const bf16x8 zf = {0, 0, 0, 0, 0, 0, 0, 0};
    const bf16x8 tbf = *(const LAS bf16x8*)(TB + r16 * SS16 + 8 * q), blf = *(const LAS bf16x8*)(BL + r16 * SS16 + 8 * q);
    const bf16x8 qlf = *(const LAS bf16x8*)(QL + r16 * SS16 + 8 * q), plf = *(const LAS bf16x8*)(PL + r16 * SS16 + 8 * q);
    const f32x4 z4 = {0.f, 0.f, 0.f, 0.f};
    bf16* gWH = (bf16*)(RO + RO_WH) + (size_t)it * 1024; bf16* gRH = (bf16*)(RO + RO_RH) + (size_t)it * 1024;
    bf16* gET = (bf16*)(RO + RO_ET) + (size_t)it * 1024; bf16* gOL = (bf16*)(RO + RO_OL) + (size_t)it * 1024;
#pragma unroll
    for (int kt = 0; kt < 4; ++kt) {
        const bf16x8 kf = (q < 2) ? *(const LAS bf16x8*)(KAPT + (16 * kt + r16) * TS + 8 * q) : zf;
        const f32x4 wa = __builtin_amdgcn_mfma_f32_16x16x32_bf16(kf, tbf, z4, 0, 0, 0);
        *(v2u*)(gWH + r16 * 64 + 16 * kt + 4 * q) = pack4(wa);
        const f32x4 wb = __builtin_amdgcn_mfma_f32_16x16x32_bf16(tbf, kf, z4, 0, 0, 0);
        *(LAS v2u*)(WT + (16 * kt + r16) * TS + 4 * q) = pack4(wb);
        const bf16x8 vf = (q < 2) ? *(const LAS bf16x8*)(VTL + (16 * kt + r16) * TS + 8 * q) : zf;
        const f32x4 bv = __builtin_amdgcn_mfma_f32_16x16x32_bf16(blf, vf, z4, 0, 0, 0);
        *(LAS v2u*)(BVT + (16 * kt + r16) * TS + 4 * q) = pack4(bv);
    }
    LDS_WAIT(); asm volatile("" ::: "memory");
#pragma unroll
    for (int vt = 0; vt < 4; ++vt) {
        const bf16x8 bf_ = (q < 2) ? *(const LAS bf16x8*)(BVT + (16 * vt + r16) * TS + 8 * q) : zf;
        const f32x4 e4 = __builtin_amdgcn_mfma_f32_16x16x32_bf16(tbf, bf_, z4, 0, 0, 0);
        const v2u ep = pack4(e4);
        *(LAS v2u*)(ETL + (16 * vt + r16) * TS + 4 * q) = ep; *(v2u*)(gET + (16 * vt + r16) * 16 + 4 * q) = ep;
    }
    LDS_WAIT(); asm volatile("" ::: "memory");
#pragma unroll
    for (int kt = 0; kt < 4; ++kt) {
        const bf16x8 wf = (q < 2) ? *(const LAS bf16x8*)(WT + (16 * kt + r16) * TS + 8 * q) : zf;
        const f32x4 qw = __builtin_amdgcn_mfma_f32_16x16x32_bf16(wf, qlf, z4, 0, 0, 0);
        const f32x4 rt4 = unpack4(*(const LAS v2u*)(RT + r16 * XS + 16 * kt + 4 * q));
        *(v2u*)(gRH + r16 * 64 + 16 * kt + 4 * q) = pack4(rt4 - qw);
        const bf16x8 vf = (q < 2) ? *(const LAS bf16x8*)(VTL + (16 * kt + r16) * TS + 8 * q) : zf;
        const bf16x8 ef = (q < 2) ? *(const LAS bf16x8*)(ETL + (16 * kt + r16) * TS + 8 * q) : zf;
        const f32x4 pv = __builtin_amdgcn_mfma_f32_16x16x32_bf16(vf, plf, z4, 0, 0, 0);
        const f32x4 qe = __builtin_amdgcn_mfma_f32_16x16x32_bf16(ef, qlf, z4, 0, 0, 0);
        *(v2u*)(gOL + r16 * 64 + 16 * kt + 4 * q) = pack4(pv - qe);
    }
    LDS_WAIT(); asm volatile("" ::: "memory");
}
__device__ __forceinline__ void ra_part(const Ctx& F, int part) {
    LAS unsigned* ctr = (LAS unsigned*)(F.lds + LDS_BYTES - 48) + part;
    LAS unsigned char* wl = F.lds + F.wave * RL_BYTES;
    for (;;) {
        unsigned idx = 0;
        if (F.lane == 0) idx = __hip_atomic_fetch_add(ctr, 1u, __ATOMIC_RELAXED, __HIP_MEMORY_SCOPE_WORKGROUP);
        idx = (unsigned)__builtin_amdgcn_readfirstlane((int)idx);
        const int it = (int)blockIdx.x + F.G * (int)idx;
        if (it >= RITEMS) break;
        ra_item(F, wl, it, part);
    }
}

__device__ __forceinline__ void rs_half(const Ctx& F, int half) {
    if (F.wave != 0) return;
    const unsigned char* RO = (const unsigned char*)F.out + (size_t)(half & 1) * RO_BUF; bf16* OY = (bf16*)(F.ws + WS_OY);
    float* SSg = (float*)((unsigned char*)F.out + RO_SS);
    LAS bf16* ST = (LAS bf16*)F.lds;
    LAS bf16* ZT = (LAS bf16*)(F.lds + 16 * XS * 2);
    constexpr int ZS = 24;
    const int lane = F.lane, r16 = lane & 15, q = lane >> 4;
    for (int blk = blockIdx.x; blk < NB * RHEADS * 4; blk += F.G) {
        const int xcd = blk & 7, jj = blk >> 3, qt = jj & 3, bh = (jj >> 2) * 8 + xcd, b = bh >> 4, h = bh & 15;
        f32x4 S[4];
        if (half == 0) {
#pragma unroll
            for (int kt = 0; kt < 4; ++kt) S[kt] = (f32x4){0.f, 0.f, 0.f, 0.f};
        } else {
#pragma unroll
            for (int kt = 0; kt < 4; ++kt) S[kt] = *(const f32x4*)(SSg + (size_t)blk * 1024 + (kt * 64 + lane) * 4);
        }
#pragma unroll
        for (int kt = 0; kt < 4; ++kt) *(LAS v2u*)(ST + r16 * XS + 16 * kt + 4 * q) = pack4(S[kt]);
        LDS_WAIT(); asm volatile("" ::: "memory");
        const size_t it0 = (size_t)bh * RHALF;
        const size_t mbase = (size_t)b * SEQ + (size_t)half * RHALF * RC;
#define RS_LOAD(IT, WF, RF, A2F, VF, ET4, OL4, GC4) do { const size_t it_ = (IT); \
        const bf16* wh_ = (const bf16*)(RO + RO_WH) + it_ * 1024 + r16 * 64 + 8 * q; const bf16* rh_ = (const bf16*)(RO + RO_RH) + it_ * 1024 + r16 * 64 + 8 * q; \
        WF[0] = *(const bf16x8*)wh_; WF[1] = *(const bf16x8*)(wh_ + 32); RF[0] = *(const bf16x8*)rh_; RF[1] = *(const bf16x8*)(rh_ + 32); \
        _Pragma("unroll") for (int kt_ = 0; kt_ < 4; ++kt_) { A2F[kt_] = *(const bf16x8*)((const bf16*)(RO + RO_A2) + it_ * 2048 + (16 * kt_ + r16) * 32 + 8 * q); \
            GC4[kt_] = *(const f32x4*)((const float*)(RO + RO_GC) + it_ * 64 + 16 * kt_ + 4 * q); } \
        VF = *(const bf16x8*)((const bf16*)(RO + RO_VT) + it_ * 1024 + (16 * qt + r16) * 16 + 8 * (q & 1)); \
        ET4 = *(const v2u*)((const bf16*)(RO + RO_ET) + it_ * 1024 + (16 * qt + r16) * 16 + 4 * q); \
        OL4 = *(const v2u*)((const bf16*)(RO + RO_OL) + it_ * 1024 + r16 * 64 + 16 * qt + 4 * q); } while (0)
        bf16x8 wfq[2][2], rfq[2][2], a2q[2][4], vfq[2]; v2u etq[2], olq[2]; f32x4 gcq[2][4];
#pragma unroll
        for (int u = 0; u < 2; ++u) RS_LOAD(it0 + u, wfq[u], rfq[u], a2q[u], vfq[u], etq[u], olq[u], gcq[u]);
#define RS_STEP(U, CL) do { const int cl_ = (CL); \
            const bf16x8 sb0 = *(const LAS bf16x8*)(ST + r16 * XS + 8 * q), sb1 = *(const LAS bf16x8*)(ST + r16 * XS + 32 + 8 * q); \
            f32x4 x1 = __builtin_amdgcn_mfma_f32_16x16x32_bf16(wfq[U][0], sb0, (f32x4){0.f, 0.f, 0.f, 0.f}, 0, 0, 0); \
            x1 = __builtin_amdgcn_mfma_f32_16x16x32_bf16(wfq[U][1], sb1, x1, 0, 0, 0); \
            f32x4 ot = __builtin_amdgcn_mfma_f32_16x16x32_bf16(sb0, rfq[U][0], unpack4(olq[U]), 0, 0, 0); \
            ot = __builtin_amdgcn_mfma_f32_16x16x32_bf16(sb1, rfq[U][1], ot, 0, 0, 0); \
            *(LAS v2u*)(ZT + r16 * ZS + 4 * q) = pack4(x1 + unpack4(etq[U])); \
            *(v2u*)(OY + (mbase + (size_t)cl_ * RC + r16) * DM + h * 64 + 16 * qt + 4 * q) = pack4(ot); \
            LDS_WAIT(); asm volatile("" ::: "memory"); \
            const bf16x8 zr = *(const LAS bf16x8*)(ZT + r16 * ZS + 8 * (q & 1)); \
            const bf16x8 bz = (q < 2) ? zr : vfq[U]; \
            _Pragma("unroll") for (int kt = 0; kt < 4; ++kt) { S[kt] = __builtin_amdgcn_mfma_f32_16x16x32_bf16(a2q[U][kt], bz, S[kt] * gcq[U][kt], 0, 0, 0); \
                *(LAS v2u*)(ST + r16 * XS + 16 * kt + 4 * q) = pack4(S[kt]); } \
            RS_LOAD(it0 + ((cl_ + 2 < RHALF) ? cl_ + 2 : RHALF - 1), wfq[U], rfq[U], a2q[U], vfq[U], etq[U], olq[U], gcq[U]);     \
            LDS_WAIT(); asm volatile("" ::: "memory"); } while (0)
#pragma unroll 1
        for (int cl = 0; cl < RHALF; cl += 2) { RS_STEP(0, cl); RS_STEP(1, cl + 1); }
#undef RS_STEP
#undef RS_LOAD
        if (half + 1 < NPART) {
#pragma unroll
            for (int kt = 0; kt < 4; ++kt) *(f32x4*)(SSg + (size_t)blk * 1024 + (kt * 64 + lane) * 4) = S[kt];
        }
    }
}
__device__ __forceinline__ float rowmax16(float x) { x = fmaxf(x, dpp_f<0xB1>(x)); x = fmaxf(x, dpp_f<0x4E>(x)); x = fmaxf(x, dpp_f<0x124>(x)); x = fmaxf(x, dpp_f<0x128>(x)); return x; }
__device__ __forceinline__ int cand_code(int s) {
    if (s < 16) return s << 4;
    if (s < 24) return 1 | ((s - 16) << 4);
    if (s < 29) return 2 | ((s - 24) << 4);
    if (s < 33) return 3 | ((s - 29) << 4);
    if (s < 36) return 4 | ((s - 33) << 4);
    if (s < 42) { const int k = s - 36; return (5 + (k >> 1)) | ((k & 1) << 4); }
    if (s < 50) return 8 + (s - 42);
    return -1;
}
__device__ __forceinline__ int f2ord(float f) { const int b = __float_as_int(f); return b ^ ((b >> 31) & 0x7fffffff); }
__device__ __forceinline__ float ord2f(int k) { return __int_as_float(k ^ ((k >> 31) & 0x7fffffff)); }
template <int CTRL> __device__ __forceinline__ int dpp_i(int x) { return __builtin_amdgcn_mov_dpp(x, CTRL, 0xf, 0xf, true); }
__device__ __forceinline__ int imax(int a, int b) { return a > b ? a : b; }
__device__ __forceinline__ int imin(int a, int b) { return a < b ? a : b; }
__device__ __forceinline__ int rowmax16_i(int x) { x = imax(x, dpp_i<0xB1>(x)); x = imax(x, dpp_i<0x4E>(x)); x = imax(x, dpp_i<0x124>(x)); x = imax(x, dpp_i<0x128>(x)); return x; }
#define CSWAP_(a, b) do { const int hi_ = imax(a, b), lo_ = imin(a, b); a = hi_; b = lo_; } while (0)
template <int NV> __device__ __forceinline__ void sort_desc(int (&v)[NV]);
template <> __device__ __forceinline__ void sort_desc<8>(int (&v)[8]) {
    CSWAP_(v[0], v[1]); CSWAP_(v[2], v[3]); CSWAP_(v[4], v[5]); CSWAP_(v[6], v[7]);
    CSWAP_(v[0], v[2]); CSWAP_(v[1], v[3]); CSWAP_(v[4], v[6]); CSWAP_(v[5], v[7]);
    CSWAP_(v[1], v[2]); CSWAP_(v[5], v[6]);
    CSWAP_(v[0], v[4]); CSWAP_(v[1], v[5]); CSWAP_(v[2], v[6]); CSWAP_(v[3], v[7]);
    CSWAP_(v[2], v[4]); CSWAP_(v[3], v[5]);
    CSWAP_(v[1], v[2]); CSWAP_(v[3], v[4]); CSWAP_(v[5], v[6]);
}
template <> __device__ __forceinline__ void sort_desc<4>(int (&v)[4]) {
    CSWAP_(v[0], v[1]); CSWAP_(v[2], v[3]); CSWAP_(v[0], v[2]); CSWAP_(v[1], v[3]); CSWAP_(v[1], v[2]);
}
template <int NV>
__device__ __forceinline__ void select16x4(int (&v)[4][NV], int r16, float (&kept_f)[4]) {
    const int IMIN = (int)0x80000000;
    int kept[4];
#pragma unroll
    for (int j = 0; j < 4; ++j) { kept[j] = IMIN; sort_desc<NV>(v[j]); }
#pragma unroll 1
    for (int rd = 0; rd < 16; ++rd) {
#pragma unroll
        for (int j = 0; j < 4; ++j) {
            const int m = rowmax16_i(v[j][0]);
            kept[j] = (r16 == rd) ? m : kept[j];
            const bool own = (v[j][0] == m);
#pragma unroll
            for (int i = 0; i < NV - 1; ++i) v[j][i] = own ? v[j][i + 1] : v[j][i];
            v[j][NV - 1] = own ? IMIN : v[j][NV - 1];
        }
    }
#pragma unroll
    for (int j = 0; j < 4; ++j) kept_f[j] = ord2f(kept[j]);
}
__device__ __forceinline__ float dot2bf(unsigned a, unsigned b, float acc) { return __builtin_amdgcn_fdot2_f32_bf16(__builtin_bit_cast(bf16x2_t, a), __builtin_bit_cast(bf16x2_t, b), acc, false); }

constexpr int PT = 16;
constexpr size_t RANGE_BYTES = (size_t)NEXP * 128;

__device__ __forceinline__ void p9_route(const Ctx& F) {
    constexpr int KSTR = 136;
    const bf16* Q = (const bf16*)(F.ws + WS_Q); const bf16* KEYS = (const bf16*)(F.ws + WS_KEYS);
    int* rtE = (int*)(F.ws + WS_RTE); float* rtG = (float*)(F.ws + WS_RTG);
    LAS bf16* KL = (LAS bf16*)F.lds;
    const int lane = F.lane, w = F.wave, r16 = lane & 15, q = lane >> 4, gbase = lane & 48;
    const int h = blockIdx.x & 7, nbh = (F.G - h + 7) >> 3;
    __syncthreads();
    for (int i = F.tid; i < 2 * 128 * 16; i += NTHR) { const int row = i >> 4, ch = i & 15;
        *(LAS v4u*)(KL + row * KSTR + 8 * ch) = *(const v4u*)(KEYS + (size_t)(2 * h * 128 + row) * 128 + 8 * ch); }
    __syncthreads();
    int ci[4], cj[4]; bool cvalid[4];
#pragma unroll
    for (int u = 0; u < 4; ++u) { const int cd = cand_code(r16 + 16 * u); cvalid[u] = cd >= 0; ci[u] = cd & 15; cj[u] = (cd >> 4) & 15; }
    const float NINF = -__builtin_inff();
    const int tstride = nbh * NWAVES;
    int tile = (blockIdx.x >> 3) * NWAVES + w;
    bf16x8 afn[2][4];
    if (tile < M / PT) {
#pragma unroll
        for (int p = 0; p < 2; ++p)
#pragma unroll
            for (int s = 0; s < 4; ++s) afn[p][s] = *(const bf16x8*)(Q + (size_t)(tile * PT + r16) * DM + (2 * h + p) * 128 + 8 * q + 32 * s);
    }
    for (; tile < M / PT; tile += tstride) {
        const int m0 = tile * PT;
        bf16x8 af[2][4];
#pragma unroll
        for (int p = 0; p < 2; ++p)
#pragma unroll
            for (int s = 0; s < 4; ++s) af[p][s] = afn[p][s];
        { const int tn = (tile + tstride < M / PT) ? tile + tstride : tile;
#pragma unroll
            for (int p = 0; p < 2; ++p)
#pragma unroll
                for (int s = 0; s < 4; ++s) afn[p][s] = *(const bf16x8*)(Q + (size_t)(tn * PT + r16) * DM + (2 * h + p) * 128 + 8 * q + 32 * s);
        }
        float top[2][4];
#pragma unroll
        for (int p = 0; p < 2; ++p) {
            int v[4][8];
#pragma unroll
            for (int nt = 0; nt < 8; ++nt) {
                const LAS bf16* krow = KL + (p * 128 + nt * 16 + r16) * KSTR + 8 * q;
                f32x4 acc = {0.f, 0.f, 0.f, 0.f};
#pragma unroll
                for (int s = 0; s < 4; ++s) acc = __builtin_amdgcn_mfma_f32_16x16x32_bf16(af[p][s], *(const LAS bf16x8*)(krow + 32 * s), acc, 0, 0, 0);
                const unsigned tag = 127u - (unsigned)(nt * 16 + r16);
#pragma unroll
                for (int j = 0; j < 4; ++j) v[j][nt] = f2ord(__uint_as_float((__float_as_uint(acc[j]) & ~127u) | tag));
                if (nt & 1) asm volatile("" ::: "memory");
            }
            select16x4<8>(v, r16, top[p]);
        }
        int cv[4][4];
#pragma unroll
        for (int u = 0; u < 4; ++u)
#pragma unroll
            for (int j = 0; j < 4; ++j) {
                const float a = __shfl(top[0][j], gbase + ci[u]), b = __shfl(top[1][j], gbase + cj[u]);
                const float cs = __uint_as_float(__float_as_uint(a) & ~127u) + __uint_as_float(__float_as_uint(b) & ~127u);
                const float pk = __uint_as_float((__float_as_uint(cs) & ~63u) | (63u - (unsigned)(r16 + 16 * u)));
                cv[j][u] = cvalid[u] ? f2ord(pk) : (int)0x80000000;
            }
        float best[4];
        select16x4<4>(cv, r16, best);
#pragma unroll
        for (int j = 0; j < 4; ++j) {
            const unsigned bb = __float_as_uint(best[j]);
            const int cd = cand_code(63 - (int)(bb & 63u));
            const int k0 = 127 - (int)(__float_as_uint(__shfl(top[0][j], gbase + (cd & 15))) & 127u);
            const int k1 = 127 - (int)(__float_as_uint(__shfl(top[1][j], gbase + ((cd >> 4) & 15))) & 127u);
            const float s = __uint_as_float(bb & ~63u);
            const float mx = rowmax16(s), e = __expf(s - mx), sum = rowsum16(e);
            const size_t o = (size_t)(m0 + 4 * q + j) * 128 + h * 16 + r16;
            rtE[o] = k0 * 128 + k1; rtG[o] = e * rcp_f(sum);
        }
    }
}

__device__ __forceinline__ f32x2 cvt2_fp8(unsigned wd, bool hi) { return hi ? __builtin_amdgcn_cvt_pk_f32_fp8((int)wd, true) : __builtin_amdgcn_cvt_pk_f32_fp8((int)wd, false); }
__device__ __forceinline__ void treduce8x16(const float (&p)[16], bool b0, bool b1, bool b2, float& r0, float& r1) {
    float a[8], bq[4];
#pragma unroll
    for (int i = 0; i < 8; ++i) { const float mine = b2 ? p[i + 8] : p[i], send = b2 ? p[i] : p[i + 8]; const float up = dpp_f<0x104>(send), dn = dpp_f<0x114>(send); a[i] = mine + (b2 ? dn : up); }
#pragma unroll
    for (int i = 0; i < 4; ++i) { const float mine = b1 ? a[i + 4] : a[i], send = b1 ? a[i] : a[i + 4]; bq[i] = mine + dpp_f<0x4E>(send); }
    { const float mine = b0 ? bq[2] : bq[0], send = b0 ? bq[0] : bq[2]; r0 = mine + dpp_f<0xB1>(send); }
    { const float mine = b0 ? bq[3] : bq[1], send = b0 ? bq[1] : bq[3]; r1 = mine + dpp_f<0xB1>(send); }
}
struct XGroup { int xg, gwi, stride; };
__device__ __forceinline__ XGroup xgroup(const Ctx& F) { XGroup g; g.xg = blockIdx.x & 7; const int nbg = (F.G - g.xg + 7) >> 3; g.gwi = (blockIdx.x >> 3) * NWAVES + F.wave; g.stride = nbg * NWAVES; return g; }

__device__ __forceinline__ void p10_peer_u(const Ctx& F) {
    const unsigned char* PU8 = F.ws + WS_PU8; const bf16* XN = (const bf16*)(F.ws + WS_XN);
    const int* rtE = (const int*)(F.ws + WS_RTE); unsigned* PD = (unsigned*)(F.ws + WS_PD);
    const XGroup g = xgroup(F);
    const int lane = F.lane, j = lane >> 3, sub = lane & 7;
    const bool b0 = sub & 1, b1 = sub & 2, b2 = sub & 4;
    for (int rr = 0; rr < 2; ++rr) {
        const int r = g.xg + 8 * rr;
        const unsigned char* tab = PU8 + (size_t)r * RANGE_BYTES;
        const unsigned so = 16u * (unsigned)sub;
        int m = g.gwi;
        v4u ev[4], xs[2];
        if (m < M) {
#pragma unroll
            for (int i = 0; i < 4; ++i) ev[i] = *(const v4u*)(rtE + (size_t)m * 128 + 16 * j + 4 * i);
            xs[0] = *(const v4u*)(XN + (size_t)m * DM + 128 * r + 16 * sub); xs[1] = *(const v4u*)(XN + (size_t)m * DM + 128 * r + 16 * sub + 8);
        }
        for (; m < M; m += g.stride) {
            v4u gt[16];
#pragma unroll
            for (int k = 0; k < 16; ++k) gt[k] = *(const v4u*)(tab + (ev[k >> 2][k & 3] * 128u + so));
            float x[16]; { float t0[8], t1[8]; unpack8(xs[0], t0); unpack8(xs[1], t1);
#pragma unroll
              for (int i = 0; i < 8; ++i) { x[i] = t0[i]; x[8 + i] = t1[i]; } }
            const int mn = (m + g.stride < M) ? m + g.stride : m;
            {
#pragma unroll
                for (int i = 0; i < 4; ++i) ev[i] = *(const v4u*)(rtE + (size_t)mn * 128 + 16 * j + 4 * i);
                xs[0] = *(const v4u*)(XN + (size_t)mn * DM + 128 * r + 16 * sub); xs[1] = *(const v4u*)(XN + (size_t)mn * DM + 128 * r + 16 * sub + 8);
            }
            float p[16];
#pragma unroll
            for (int k = 0; k < 16; ++k) {
                f32x2 a0 = {0.f, 0.f}, a1 = {0.f, 0.f};
#pragma unroll
                for (int d = 0; d < 4; ++d) { const unsigned wd = gt[k][d];
                    a0 += cvt2_fp8(wd, false) * (f32x2){x[4 * d], x[4 * d + 1]}; a1 += cvt2_fp8(wd, true) * (f32x2){x[4 * d + 2], x[4 * d + 3]}; }
                const f32x2 s2 = a0 + a1; p[k] = s2.x + s2.y;
            }
            float r0, r1; treduce8x16(p, b0, b1, b2, r0, r1);
            PD[((size_t)r * M + m) * 64 + lane] = pk2(r0, r1);
        }
    }
}

__device__ __forceinline__ void p11_peer_coef(const Ctx& F) {
    const int* rtE = (const int*)(F.ws + WS_RTE); const float* rtG = (const float*)(F.ws + WS_RTG); const unsigned* PD = (const unsigned*)(F.ws + WS_PD);
    const float* usc = (const float*)(F.ws + WS_USC); const float* vsc = (const float*)(F.ws + WS_VSC); float* COEF = (float*)(F.ws + WS_COEF);
    for (int m = F.gw; m < M; m += F.NGW) {
        const size_t o = (size_t)m * 128 + 2 * F.lane;
        f32x2 d = {0.f, 0.f};
#pragma unroll
        for (int r = 0; r < 16; ++r) { const unsigned pw = PD[((size_t)r * M + m) * 64 + F.lane]; d += (f32x2){bflo(pw), bfhi(pw)}; }
        const int e0 = rtE[o], e1 = rtE[o + 1];
        const f32x2 gt = *(const f32x2*)(rtG + o);
        const float d0 = d.x * usc[e0], d1 = d.y * usc[e1];
        f32x2 c; c.x = gt.x * (0.5f * d0 * (1.f + erff(d0 * 0.70710678f))) * vsc[e0]; c.y = gt.y * (0.5f * d1 * (1.f + erff(d1 * 0.70710678f))) * vsc[e1];
        *(f32x2*)(COEF + o) = c;
    }
}

__device__ __forceinline__ void p12_peer_v(const Ctx& F) {
    const unsigned char* PV4 = F.ws + WS_PV8; const int* rtE = (const int*)(F.ws + WS_RTE); const float* COEF = (const float*)(F.ws + WS_COEF);
    const float* mod = (const float*)(F.ws + WS_MOD);
    const XGroup g = xgroup(F);
    const int lane = F.lane, j = lane >> 3, sub = lane & 7;
    const bool jb0 = j & 1;
    const int r = g.xg;
    const unsigned char* tab = PV4 + (size_t)r * RANGE_BYTES;
    const unsigned so = 16u * (unsigned)sub;
    int m = g.gwi;
    if (m >= M) return;
    const int st = g.stride;
#define PV_LDE(e, mm, hf) { e[0] = *(const v4u*)(rtE + (size_t)(mm) * 128 + 16 * j + 8 * (hf)); e[1] = *(const v4u*)(rtE + (size_t)(mm) * 128 + 16 * j + 8 * (hf) + 4); }
#define PV_LDC(c, mm, hf) { c[0] = *(const f32x4*)(COEF + (size_t)(mm) * 128 + 16 * j + 8 * (hf)); c[1] = *(const f32x4*)(COEF + (size_t)(mm) * 128 + 16 * j + 8 * (hf) + 4); }
#define PV_GATHER(gx, e) { _Pragma("unroll") for (int k = 0; k < 8; ++k) gx[k] = *(const v4u*)(tab + (e[k >> 2][k & 3] * 128u + so)); }
#define PV_ACC(gx, c) { _Pragma("unroll") for (int k = 0; k < 8; ++k) { const float cq = c[k >> 2][k & 3]; const f32x2 cv2 = {cq, cq}; \
        _Pragma("unroll") for (int d = 0; d < 4; ++d) { const unsigned wd = gx[k][d]; \
            acc[4 * d + 0] += cv2 * __builtin_amdgcn_cvt_scalef32_pk_f32_fp4(wd, 1.0f, 0); acc[4 * d + 1] += cv2 * __builtin_amdgcn_cvt_scalef32_pk_f32_fp4(wd, 1.0f, 1); \
            acc[4 * d + 2] += cv2 * __builtin_amdgcn_cvt_scalef32_pk_f32_fp4(wd, 1.0f, 2); acc[4 * d + 3] += cv2 * __builtin_amdgcn_cvt_scalef32_pk_f32_fp4(wd, 1.0f, 3); } } }
    v4u eA1[2], eB0[2], gA[8], gB[8]; f32x4 cA0[2], cA1[2], cB0[2];
    { v4u eA0[2]; PV_LDE(eA0, m, 0); PV_LDC(cA0, m, 0); PV_LDE(eB0, m, 1); PV_LDC(cB0, m, 1);
      const int m1 = (m + st < M) ? m + st : m; PV_LDE(eA1, m1, 0); PV_LDC(cA1, m1, 0);
      PV_GATHER(gA, eA0); }
    for (; m < M; m += st) {
        const int m1 = (m + st < M) ? m + st : m, m2 = (m + 2 * st < M) ? m + 2 * st : m;
        const int col = 256 * r + 32 * sub + 4 * j;
        v2u* orow = (v2u*)((bf16*)(F.ws + WS_HB) + (size_t)m * DM + col);
        const v2u hw = *orow; const f32x4 g2 = *(const f32x4*)(mod + (size_t)(m / SEQ) * MODW + 5 * DM + col);
        PV_GATHER(gB, eB0);
        v4u eB1[2], eA2[2]; f32x4 cB1[2], cA2[2];
        PV_LDE(eB1, m1, 1); PV_LDC(cB1, m1, 1); PV_LDE(eA2, m2, 0); PV_LDC(cA2, m2, 0);
        asm volatile("" : "+v"(gA[0]), "+v"(gA[1]), "+v"(gA[2]), "+v"(gA[3]), "+v"(gA[4]), "+v"(gA[5]), "+v"(gA[6]), "+v"(gA[7]) :: "memory");
        f32x2 acc[16];
#pragma unroll
        for (int i = 0; i < 16; ++i) acc[i] = (f32x2){0.f, 0.f};
        PV_ACC(gA, cA0);
        asm volatile("" ::: "memory");
        PV_GATHER(gA, eA1);
        asm volatile("" : "+v"(gB[0]), "+v"(gB[1]), "+v"(gB[2]), "+v"(gB[3]), "+v"(gB[4]), "+v"(gB[5]), "+v"(gB[6]), "+v"(gB[7]) :: "memory");
        PV_ACC(gB, cB0);
        float a[32];
#pragma unroll
        for (int i = 0; i < 16; ++i) { a[2 * i] = acc[i].x; a[2 * i + 1] = acc[i].y; }
        float s16[16], s8[8];
#pragma unroll
        for (int c = 0; c < 16; ++c) { auto rr2 = __builtin_amdgcn_permlane32_swap(__float_as_uint(a[c]), __float_as_uint(a[c + 16]), false, false); s16[c] = __uint_as_float(rr2[0]) + __uint_as_float(rr2[1]); }
#pragma unroll
        for (int c = 0; c < 8; ++c) { auto rr2 = __builtin_amdgcn_permlane16_swap(__float_as_uint(s16[c]), __float_as_uint(s16[c + 8]), false, false); s8[c] = __uint_as_float(rr2[0]) + __uint_as_float(rr2[1]); }
        f32x4 res;
#pragma unroll
        for (int c = 0; c < 4; ++c) { const float mine = jb0 ? s8[c + 4] : s8[c], send = jb0 ? s8[c] : s8[c + 4]; res[c] = mine + dpp_f<0x128>(send); }
        const f32x4 h1 = {bflo(hw.x), bfhi(hw.x), bflo(hw.y), bfhi(hw.y)};
        const f32x4 h2 = h1 + g2 * res;
        v2u o; o.x = pk2(h2.x, h2.y); o.y = pk2(h2.z, h2.w);
        *orow = o;
#pragma unroll
        for (int i = 0; i < 2; ++i) { cA0[i] = cA1[i]; cA1[i] = cA2[i]; eA1[i] = eA2[i]; eB0[i] = eB1[i]; cB0[i] = cB1[i]; }
    }
#undef PV_LDE
#undef PV_LDC
#undef PV_GATHER
#undef PV_ACC
}
#define XB_TMO      128
#define XB_XCNT(j)  (256  + 64 * (j))
#define XB_XSUB(j)  (1280 + 64 * (j))
#define XB_XGEN(j)  (2304 + 64 * (j))
#define XB_TOP      3328
#define XB_TOPGEN   3392
#define XCD_BAR_WORDS 3456
#define XB_SPIN_CAP (1u << 18)

__device__ __forceinline__ unsigned xb_ld(unsigned* p)              { return __hip_atomic_load(p, __ATOMIC_RELAXED, __HIP_MEMORY_SCOPE_AGENT); }
__device__ __forceinline__ unsigned xb_add(unsigned* p, unsigned v) { return __hip_atomic_fetch_add(p, v, __ATOMIC_RELAXED, __HIP_MEMORY_SCOPE_AGENT); }
__device__ __forceinline__ unsigned xb_xcc_id() { return (unsigned)__builtin_amdgcn_s_getreg((3 << 11) | 20) & 0xFu; }
#define XB_SPIN(cond, bar) do { unsigned _sp = 0; while (cond) { __builtin_amdgcn_s_sleep(1); \
    if ((++_sp & 255u) == 0u) { if (xb_ld(&(bar)[XB_TMO])) break; if (_sp > XB_SPIN_CAP) { atomicAdd(&(bar)[XB_TMO], 1u); break; } } } } while (0)

struct XcdBarrier {
    unsigned* bar; unsigned x;
    volatile LAS unsigned* st;
};

__device__ __forceinline__ XcdBarrier xcd_barrier_post(unsigned* bar, volatile LAS unsigned* st) {
    XcdBarrier b; b.bar = bar; b.x = xb_xcc_id(); b.st = st;
    if (threadIdx.x == 0) (void)xb_add(&bar[XB_XCNT(b.x)], 1u);
    return b;
}
__device__ __forceinline__ void xcd_barrier_complete(unsigned* bar, unsigned x, unsigned& nloc, unsigned& nx) {
    const unsigned G = gridDim.x * gridDim.y * gridDim.z;
    unsigned sum, cnt, mine, sp = 0u;
    for (;;) {
        sum = 0u; cnt = 0u; mine = 0u;
#pragma unroll
        for (unsigned j = 0; j < 16; ++j) { const unsigned c = xb_ld(&bar[XB_XCNT(j)]); sum += c; cnt += (c > 0u) ? 1u : 0u; mine = (j == x) ? c : mine; }
        if (sum == G) break;
        __builtin_amdgcn_s_sleep(1);
        if ((++sp & 255u) == 0u) { if (xb_ld(&bar[XB_TMO])) break; if (sp > XB_SPIN_CAP) { atomicAdd(&bar[XB_TMO], 1u); break; } }
    }
    nloc = mine > 0u ? mine : 1u; nx = cnt > 0u ? cnt : 1u;
}

__device__ __forceinline__ void xcd_barrier(const XcdBarrier& b) {
    asm volatile("s_waitcnt vmcnt(0)" ::: "memory");
    __syncthreads();
    if (threadIdx.x == 0) {
        unsigned* bar = b.bar;
        __builtin_amdgcn_s_waitcnt(0);
        unsigned nloc = b.st[0], nx = b.st[1];
        if (nloc == 0u) { xcd_barrier_complete(bar, b.x, nloc, nx); b.st[0] = nloc; b.st[1] = nx; }
        const unsigned old = xb_add(&bar[XB_XSUB(b.x)], 1u);
        const unsigned gen = old / nloc;
        if (old + 1u == (gen + 1u) * nloc) {
            __builtin_amdgcn_fence(__ATOMIC_RELEASE, "agent");
            asm volatile("s_waitcnt vmcnt(0)" ::: "memory");
            const unsigned og = xb_add(&bar[XB_TOP], 1u);
            const unsigned tg = og / nx;
            if (og + 1u == (tg + 1u) * nx) xb_add(&bar[XB_TOPGEN], 1u);
            else XB_SPIN(xb_ld(&bar[XB_TOPGEN]) == tg, bar);
            __builtin_amdgcn_fence(__ATOMIC_ACQUIRE, "agent");
            xb_add(&bar[XB_XGEN(b.x)], 1u);
            asm volatile("s_waitcnt vmcnt(0)" ::: "memory");
        } else {
            XB_SPIN(xb_ld(&bar[XB_XGEN(b.x)]) == gen, bar);
            __builtin_amdgcn_fence(__ATOMIC_ACQUIRE, "agent");
            asm volatile("s_waitcnt vmcnt(0)" ::: "memory");
        }
    }
    __syncthreads();
}

struct Args { const float* in[N_IN]; float* out; unsigned char* ws; int ph_lo, ph_hi; };
constexpr int N_PHASES = 19;

__global__ void __launch_bounds__(NTHR, 2) fwd_kernel(Args args) {
    extern __shared__ __attribute__((aligned(16))) unsigned char lds_raw[];
    cg::grid_group grid = cg::this_grid();
    Ctx F;
    F.lds = (LAS unsigned char*)lds_raw;
    F.tid = threadIdx.x; F.lane = F.tid & 63; F.wave = __builtin_amdgcn_readfirstlane(F.tid >> 6);
    F.G = gridDim.x; F.gw = blockIdx.x * NWAVES + F.wave; F.NGW = F.G * NWAVES;
    F.in = args.in; F.out = args.out; F.ws = args.ws;
    const int lo = args.ph_lo, hi = args.ph_hi;
    volatile LAS unsigned* bst = (volatile LAS unsigned*)(F.lds + LDS_BYTES - 64);
    if (F.tid < 2) bst[F.tid] = 0u;
    if (F.tid < 4) ((volatile LAS unsigned*)(F.lds + LDS_BYTES - 48))[F.tid] = 0u;
    __syncthreads();
    const XcdBarrier bar = xcd_barrier_post((unsigned*)(F.ws + WS_CTL) + 4096, bst);
#define IN(k) (lo <= (k) && (k) < hi)
#ifndef TS_A
#define TS_A -1
#define TS_B -1
#define TS_K 0.1
#endif
    unsigned long long* stamps = (unsigned long long*)(F.ws + WS_CTL + 65536);
#define STAMP(k) do { if (TS_A >= 0 && blockIdx.x == 0 && F.tid == 0) stamps[k] = __builtin_amdgcn_s_memrealtime(); } while (0)
#define REP_MASK 0
#ifndef REP_MASK
#define REP_MASK 0
#endif
#define REPS(k) for (int rep_ = 0; rep_ < 1 + ((REP_MASK >> (k)) & 1); ++rep_)
#define SEAM(k) do { if (IN(k) && IN((k) + 1)) { if ((k) == 0) grid.sync(); else xcd_barrier(bar); } } while (0)

    STAMP(0);
    if (IN(0)) REPS(0) { p0_prologue(F); }
    SEAM(0);
    STAMP(1);
    if (IN(1)) REPS(1) { norm_mod_rows(F, F.in[I_X], F.in[I_N1W], 0, DM, (bf16*)(F.ws + WS_XN)); }
    SEAM(1);
    STAMP(2);
    if (IN(2)) REPS(2) {
        pg8::Gemm g{(const pg8::bf16_t*)(F.ws + WS_XN), (const pg8::bf16_t*)(F.ws + WS_WIN), M, INPP, DM};
        pg8::StaticOrder S; S.init(M, INPP, F.G, (int)blockIdx.x);
        pg8::EpiStoreBf16 E{(pg8::bf16_t*)(F.ws + WS_PROJ), INPP};
        pg8::gemm_phase<pg8::EpiStoreBf16, pg8::StaticOrder, true, true>(F.lds, g, S, E);
    }
    SEAM(2);
#ifndef P3REP
#define P3REP 0
#endif
    STAMP(3);
    if (IN(3)) REPS(3) { p3_lora(F); STAMP(40); m1_chunk_states(F); }
    SEAM(3);
    STAMP(4);
    if (IN(4)) { m2_prefix(F); ra_part(F, 0); }
    SEAM(4);
    STAMP(5);
    if (IN(5)) { rs_half(F, 0); ra_part(F, 1); }
    SEAM(5);
    STAMP(6);
    if (IN(6)) { rs_half(F, 1); ra_part(F, 2); }
    SEAM(6);
    STAMP(7);
    if (IN(7)) { rs_half(F, 2); ra_part(F, 3); }
    SEAM(7);
    STAMP(8);
    if (IN(8)) { rs_half(F, 3); }
    STAMP(9);
    if (IN(9)) REPS(9) { m3_outputs(F); }
    SEAM(9);
    STAMP(10);
    if (IN(10)) { p5_post(F); }
    SEAM(10);
    STAMP(11);
    if (IN(11)) REPS(11) {
        pg8::Gemm g{(const pg8::bf16_t*)(F.ws + WS_OY), (const pg8::bf16_t*)(F.ws + WS_WOUT), M, DM, DM};
        pg8::StaticOrder S; S.init(M, DM, F.G, (int)blockIdx.x);
        pg8::EpiResid E{F.in[I_X], (const float*)(F.ws + WS_MOD) + 2 * DM, (pg8::bf16_t*)(F.ws + WS_HB), DM, SEQ, MODW};
        pg8::gemm_phase<pg8::EpiResid, pg8::StaticOrder, true, true>(F.lds, g, S, E);
    }
    SEAM(11);
    STAMP(12);
    if (IN(12)) REPS(12) { norm_mod_rows_bf16(F, (const bf16*)(F.ws + WS_HB), F.in[I_N2W], 3 * DM, 4 * DM, (bf16*)(F.ws + WS_XN)); }
    SEAM(12);
    STAMP(13);
    if (IN(13)) REPS(13) {
        pg8::Gemm g{(const pg8::bf16_t*)(F.ws + WS_XN), (const pg8::bf16_t*)(F.ws + WS_WQ), M, DM, DM};
        pg8::StaticOrder S; S.init(M, DM, F.G, (int)blockIdx.x);
        pg8::EpiStoreBf16 E{(pg8::bf16_t*)(F.ws + WS_Q), DM};
        pg8::gemm_phase<pg8::EpiStoreBf16, pg8::StaticOrder, true, true>(F.lds, g, S, E);
    }
    SEAM(13);
    STAMP(14);
    if (IN(14)) REPS(14) { p9_route(F); }
    SEAM(14);
    STAMP(15);
    if (IN(15)) REPS(15) { p10_peer_u(F); }
    SEAM(15);
    STAMP(16);
    if (IN(16)) REPS(16) { p11_peer_coef(F); }
    SEAM(16);
    STAMP(17);
    if (IN(17)) { p12_peer_v(F); }
    SEAM(17);
    STAMP(18);
    if (IN(18)) {
        float oscale = 1.f;
        if (TS_A >= 0) { const volatile unsigned long long* st = stamps; const float frac = (float)(st[TS_B] - st[TS_A]) / (float)(st[17] - st[0]); oscale = 1.f + (float)(TS_K) * frac; }
        final_norm_rows_bf16(F, (const bf16*)(F.ws + WS_HB), F.in[I_FNW], F.out, oscale);
    }
#undef IN
#undef SEAM
}

extern "C" void kernel_launch(void* const* d_in, const int* in_sizes, int n_in, void* d_out, int out_size, void* d_ws, size_t ws_size, hipStream_t stream) {
    static int grid = 0;
    if (grid == 0) {
        if (n_in != N_IN || in_sizes[0] != M * DM || out_size != M * DM || ws_size < WS_END2) {
            fprintf(stderr, "kernel_launch: unexpected shapes: n_in %d in0 %d out %d ws %zu (need %zu)\n", n_in, n_in > 0 ? in_sizes[0] : -1, out_size, ws_size, (size_t)WS_END2); grid = -1; return; }
        int dev = 0, cus = 0, per_cu = 0;
        if (hipGetDevice(&dev) != hipSuccess || hipDeviceGetAttribute(&cus, hipDeviceAttributeMultiprocessorCount, dev) != hipSuccess) { grid = -1; return; }
        if (hipFuncSetAttribute((const void*)fwd_kernel, hipFuncAttributeMaxDynamicSharedMemorySize, LDS_BYTES) != hipSuccess) { fprintf(stderr, "kernel_launch: hipFuncSetAttribute failed\n"); grid = -1; return; }
        if (hipOccupancyMaxActiveBlocksPerMultiprocessor(&per_cu, (const void*)fwd_kernel, NTHR, LDS_BYTES) != hipSuccess || per_cu < 1) { fprintf(stderr, "kernel_launch: occupancy query says %d blocks per CU\n", per_cu); per_cu = 1; }
        (void)hipGetLastError();
        grid = cus;
        fprintf(stderr, "kernel_launch: cus %d per_cu %d grid %d ws %zu\n", cus, per_cu, grid, ws_size);
    }
    if (grid < 0) return;
    (void)hipMemsetAsync((char*)d_ws + WS_CTL, 0, CTL_ZERO_BYTES, stream);
    Args a{};
    for (int i = 0; i < N_IN; ++i) a.in[i] = (const float*)d_in[i];
    a.out = (float*)d_out; a.ws = (unsigned char*)d_ws; a.ph_lo = 0; a.ph_hi = N_PHASES;
    void* kargs[] = {&a};
#ifndef NPASS
#define NPASS 1
#endif
    hipError_t e = hipSuccess;
    for (int pass_ = 0; pass_ < NPASS; ++pass_) {
        if (pass_ > 0) (void)hipMemsetAsync((char*)d_ws + WS_CTL, 0, CTL_ZERO_BYTES, stream);
        e = hipLaunchCooperativeKernel((const void*)fwd_kernel, dim3(grid), dim3(NTHR), kargs, LDS_BYTES, stream);
    }
    if (e != hipSuccess) fprintf(stderr, "kernel_launch: cooperative launch failed: %s (grid %d)\n", hipGetErrorString(e), grid);
}
```

```cpp
#include <hip/hip_runtime.h>
#include <hip/hip_cooperative_groups.h>
#include <cstdio>
#include <cstdint>
namespace cg = cooperative_groups;
namespace pg8 {
#define PG8_LAS __attribute__((address_space(3)))
typedef unsigned short bf16_t;
typedef short bf16x8 __attribute__((ext_vector_type(8)));
typedef float f32x4 __attribute__((ext_vector_type(4)));
typedef unsigned u32x4 __attribute__((ext_vector_type(4)));
constexpr int BM = 256, BK = 64, HALF = 128, HTB = HALF * BK * 2  , STAGE_BYTES = 8 * HTB, NXCD = 8, WGM = 8;

__host__ __device__ __forceinline__ int lds_byte(int r, int c) { const int st = (r >> 4) * 2 + (c >> 5), rr = r & 15, cc = c & 31, ob = rr * 64 + cc * 2; return st * 1024 + (ob ^ (((ob >> 9) & 1) << 5)); }
__host__ __device__ __forceinline__ void stage_rc(int b, int& R, int& C) { const int st = b / 1024, sb = b % 1024, swz = sb ^ (((sb >> 9) & 1) << 5); R = (st >> 1) * 16 + swz / 64; C = (st & 1) * 32 + (swz % 64) / 2; }
__host__ __device__ __forceinline__ int perm32(int rho) { const int n = rho >> 4, i = rho & 15; return 8 * (i >> 2) + 4 * n + (i & 3); }

struct Unit { int pm, pn; };
struct Gemm { const bf16_t* A; const bf16_t* Bt; int M, N, K; };

struct StaticOrder {
    int nM, nN, nwg, G, c;
    __host__ __device__ void init(int M, int N, int G_, int c_) { nM = M / BM; nN = N / BM; nwg = nM * nN; G = G_; c = c_; }
    __host__ __device__ bool next(int i, Unit& u) const {
        const long L = (long)i * G + c; if (L >= nwg) return false;
        int wgid = (int)L; { const int q = nwg / NXCD, r = nwg % NXCD, xcd = wgid % NXCD, off = wgid / NXCD; wgid = (xcd < r ? xcd * (q + 1) : r * (q + 1) + (xcd - r) * q) + off; }
        const int nig = WGM * nN, gid = wgid / nig, fm = gid * WGM, gsz = (nM - fm) < WGM ? (nM - fm) : WGM;
        u.pm = fm + ((wgid % nig) % gsz); u.pn = (wgid % nig) / gsz; return true;
    }
    __device__ __forceinline__ void a_ready(const Unit&) const {}
    __device__ __forceinline__ void done(const Unit&) const {}
};
__device__ __forceinline__ unsigned cvt_pk_bf16(float lo, float hi) { unsigned r; asm volatile("v_cvt_pk_bf16_f32 %0, %1, %2" : "=v"(r) : "v"(lo), "v"(hi)); return r; }
struct EpiStoreBf16 {
    static constexpr bool PERM = true, AFTER_DRAIN = false;
    bf16_t* O; int ldc;
    __device__ __forceinline__ void operator()(const f32x4 (&acc)[2][2][4][2], const Unit& u, int wr, int wc, int fr, int fq) const {
        const int row0 = u.pm * BM + wr * 64 + fr; const int col0 = u.pn * BM + wc * 32 + 8 * fq;
#pragma unroll
        for (int ai = 0; ai < 2; ++ai)
#pragma unroll
            for (int m = 0; m < 4; ++m) { bf16_t* rowp = O + (size_t)(row0 + ai * HALF + m * 16) * ldc + col0;
#pragma unroll
                for (int bj = 0; bj < 2; ++bj) { const f32x4 v0 = acc[ai][bj][m][0], v1 = acc[ai][bj][m][1];
                    u32x4 w; w.x = cvt_pk_bf16(v0[0], v0[1]); w.y = cvt_pk_bf16(v0[2], v0[3]); w.z = cvt_pk_bf16(v1[0], v1[1]); w.w = cvt_pk_bf16(v1[2], v1[3]);
                    *(u32x4*)(rowp + bj * HALF) = w; } }
    }
};
struct EpiResid {
    static constexpr bool PERM = true, AFTER_DRAIN = false;
    const float* X; const float* gate; bf16_t* O; int ldc; int rows_per_batch; int gstride;
    __device__ __forceinline__ void operator()(const f32x4 (&acc)[2][2][4][2], const Unit& u, int wr, int wc, int fr, int fq) const {
        const int row0 = u.pm * BM + wr * 64 + fr; const int col0 = u.pn * BM + wc * 32 + 8 * fq;
        const float* g = gate + (size_t)((u.pm * BM) / rows_per_batch) * gstride + col0;
        f32x4 gv[2][2];
#pragma unroll
        for (int bj = 0; bj < 2; ++bj)
#pragma unroll
            for (int n = 0; n < 2; ++n) gv[bj][n] = *(const f32x4*)(g + bj * HALF + 4 * n);
#pragma unroll
        for (int ai = 0; ai < 2; ++ai)
#pragma unroll
            for (int m = 0; m < 4; ++m) { const size_t off = (size_t)(row0 + ai * HALF + m * 16) * ldc + col0;
#pragma unroll
                for (int bj = 0; bj < 2; ++bj) { const f32x4 x0 = *(const f32x4*)(X + off + bj * HALF), x1 = *(const f32x4*)(X + off + bj * HALF + 4);
                    const f32x4 v0 = x0 + gv[bj][0] * acc[ai][bj][m][0], v1 = x1 + gv[bj][1] * acc[ai][bj][m][1];
                    u32x4 w; w.x = cvt_pk_bf16(v0[0], v0[1]); w.y = cvt_pk_bf16(v0[2], v0[3]); w.z = cvt_pk_bf16(v1[0], v1[1]); w.w = cvt_pk_bf16(v1[2], v1[3]);
                    *(u32x4*)(O + off + bj * HALF) = w; } }
    }
};
template <class Epi, class Sched, bool ALIGN_EPI = false, bool SP2 = false>
__device__ __forceinline__ void gemm_phase(PG8_LAS unsigned char* lds, const Gemm g, const Sched& S, const Epi& E) {
    const int tid = threadIdx.x, wid = __builtin_amdgcn_readfirstlane(tid >> 6), lane = tid & 63, wr = wid >> 2, wc = wid & 3, fr = lane & 15, fq = lane >> 4;
    const int K = g.K, nt = K / BK;
    unsigned voffA[2], voffB[2];
#pragma unroll
    for (int i = 0; i < 2; ++i) { int R, C; stage_rc(tid * 16 + i * 8192, R, C); const int Rb = Epi::PERM ? ((R & ~31) + perm32(R & 31)) : R;
        voffA[i] = (unsigned)(R * K + C) * 2u; voffB[i] = (unsigned)(Rb * K + C) * 2u; }
    const size_t kstep = (size_t)(BK * 2);
    const size_t hstep = (size_t)HALF * K * 2;
    const size_t tstep = 2 * hstep;
    const unsigned ldsw = (unsigned)wid * 1024u;
    const int aoff = lds_byte(wr * 64 + fr, fq * 8), boff = lds_byte(wc * 32 + fr, fq * 8);
#define PG8_SA(b, h) (((b) * 2 + (h)) * HTB)
#define PG8_SB(b, h) ((4 + (b) * 2 + (h)) * HTB)
#define PG8_STAGE(bufoff, gbase, voff) do { _Pragma("unroll") for (int _i = 0; _i < 2; ++_i) \
        __builtin_amdgcn_global_load_lds((const unsigned*)((const char*)(gbase) + (voff)[_i]), (PG8_LAS unsigned*)(lds + (bufoff) + ldsw + _i * 8192), 16, 0, 0); } while (0)
#define PG8_LDA(dst, b, h) do { _Pragma("unroll") for (int m = 0; m < 4; ++m) _Pragma("unroll") for (int k = 0; k < 2; ++k) dst[m][k] = *(const PG8_LAS bf16x8*)(lds + PG8_SA(b, h) + aoff + m * 2048 + k * 1024); } while (0)
#define PG8_LDB(dst, b, h) do { _Pragma("unroll") for (int n = 0; n < 2; ++n) _Pragma("unroll") for (int k = 0; k < 2; ++k) dst[n][k] = *(const PG8_LAS bf16x8*)(lds + PG8_SB(b, h) + boff + n * 2048 + k * 1024); } while (0)
#define PG8_MMA(ai, bj, At, Bt) do { __builtin_amdgcn_s_setprio(1); _Pragma("unroll") for (int m = 0; m < 4; ++m) _Pragma("unroll") for (int n = 0; n < 2; ++n) _Pragma("unroll") for (int k = 0; k < 2; ++k) \
        acc[ai][bj][m][n] = __builtin_amdgcn_mfma_f32_16x16x32_bf16(Bt[n][k], At[m][k], acc[ai][bj][m][n], 0, 0, 0); __builtin_amdgcn_s_setprio(0); } while (0)
#define PG8_WAIT_V(n) asm volatile("s_waitcnt vmcnt(" #n ")" ::: "memory")
#define PG8_WAIT_L(n) asm volatile("s_waitcnt lgkmcnt(" #n ")" ::: "memory")
#define PG8_BAR __builtin_amdgcn_s_barrier()
#define PG8_SCHED __builtin_amdgcn_sched_barrier(0)
    Unit cur, nxt; int ui = 0;
    if (!S.next(0, cur)) return;
    f32x4 acc[2][2][4][2];
#pragma unroll
    for (int a = 0; a < 2; ++a)
#pragma unroll
        for (int b = 0; b < 2; ++b)
#pragma unroll
            for (int m = 0; m < 4; ++m)
#pragma unroll
                for (int n = 0; n < 2; ++n) acc[a][b][m][n] = (f32x4){0.f, 0.f, 0.f, 0.f};
    bf16x8 At[4][2], B0[2][2], B1[2][2];
    const char* cA = (const char*)g.A + (size_t)cur.pm * tstep; const char* cB = (const char*)g.Bt + (size_t)cur.pn * tstep;
    S.a_ready(cur);
    if constexpr (SP2) {
        PG8_STAGE(PG8_SB(0, 0), cB, voffB); PG8_STAGE(PG8_SB(0, 1), cB + hstep, voffB); PG8_STAGE(PG8_SA(0, 0), cA, voffA); PG8_STAGE(PG8_SA(0, 1), cA + hstep, voffA);
        if (wr == 1) PG8_BAR;
        PG8_WAIT_V(2); PG8_BAR;
        PG8_STAGE(PG8_SB(1, 0), cB + kstep, voffB); PG8_STAGE(PG8_SA(1, 0), cA + kstep, voffA); PG8_STAGE(PG8_SB(1, 1), cB + hstep + kstep, voffB);
        PG8_WAIT_V(6); PG8_BAR;
    } else {
        PG8_STAGE(PG8_SB(0, 0), cB, voffB); PG8_STAGE(PG8_SA(0, 0), cA, voffA); PG8_STAGE(PG8_SB(0, 1), cB + hstep, voffB); PG8_STAGE(PG8_SA(0, 1), cA + hstep, voffA);
        if (wr == 1) PG8_BAR;
        PG8_WAIT_V(4); PG8_BAR;
        PG8_STAGE(PG8_SB(1, 0), cB + kstep, voffB); PG8_STAGE(PG8_SA(1, 0), cA + kstep, voffA); PG8_STAGE(PG8_SB(1, 1), cB + hstep + kstep, voffB);
        PG8_WAIT_V(6); PG8_BAR;
    }
    for (;;) {
        const bool has_next = S.next(ui + 1, nxt);
        const char* nA = has_next ? (const char*)g.A + (size_t)nxt.pm * tstep : cA; const char* nB = has_next ? (const char*)g.Bt + (size_t)nxt.pn * tstep : cB;
        for (int t = 0; t < nt; t += 2) {
            const bool last = (t == nt - 2);
            const char* a1 = cA + (size_t)(t + 1) * kstep;
            const char* a2 = last ? nA : cA + (size_t)(t + 2) * kstep; const char* b2 = last ? nB : cB + (size_t)(t + 2) * kstep;
            const char* a3 = a2 + kstep; const char* b3 = b2 + kstep;
            if (last && has_next) S.a_ready(nxt);
            if constexpr (SP2) {
            PG8_LDB(B0, 0, 0); PG8_LDB(B1, 0, 1); PG8_SCHED; PG8_LDA(At, 0, 0); PG8_STAGE(PG8_SA(1, 1), a1 + hstep, voffA);
            PG8_WAIT_V(8); PG8_WAIT_L(0); PG8_BAR; PG8_MMA(0, 0, At, B0); PG8_MMA(0, 1, At, B1); PG8_BAR; PG8_SCHED;
            PG8_LDA(At, 0, 1); PG8_STAGE(PG8_SB(0, 0), b2, voffB); PG8_STAGE(PG8_SB(0, 1), b2 + hstep, voffB); PG8_STAGE(PG8_SA(0, 0), a2, voffA);
            PG8_WAIT_V(8); PG8_WAIT_L(0); PG8_BAR; PG8_MMA(1, 0, At, B0); PG8_MMA(1, 1, At, B1); PG8_BAR; PG8_SCHED;
            PG8_LDB(B0, 1, 0); PG8_LDB(B1, 1, 1); PG8_SCHED; PG8_LDA(At, 1, 0); PG8_STAGE(PG8_SA(0, 1), a2 + hstep, voffA);
            PG8_WAIT_V(8); PG8_WAIT_L(0); PG8_BAR; PG8_MMA(0, 0, At, B0); PG8_MMA(0, 1, At, B1); PG8_BAR; PG8_SCHED;
            PG8_LDA(At, 1, 1); PG8_STAGE(PG8_SB(1, 0), b3, voffB); PG8_STAGE(PG8_SB(1, 1), b3 + hstep, voffB); PG8_STAGE(PG8_SA(1, 0), a3, voffA);
            PG8_WAIT_V(8); PG8_WAIT_L(0); PG8_BAR; PG8_MMA(1, 0, At, B0); PG8_MMA(1, 1, At, B1); PG8_BAR; PG8_SCHED;
            } else {
            PG8_LDB(B0, 0, 0); PG8_SCHED; PG8_LDA(At, 0, 0); PG8_STAGE(PG8_SA(1, 1), a1 + hstep, voffA);
            PG8_WAIT_L(8); PG8_BAR; PG8_WAIT_L(0); PG8_MMA(0, 0, At, B0); PG8_BAR; PG8_SCHED;
            PG8_LDB(B1, 0, 1); PG8_STAGE(PG8_SB(0, 0), b2, voffB);
            PG8_BAR; PG8_WAIT_L(0); PG8_MMA(0, 1, At, B1); PG8_BAR;
            PG8_LDA(At, 0, 1); PG8_STAGE(PG8_SA(0, 0), a2, voffA);
            PG8_BAR; PG8_WAIT_L(0); PG8_MMA(1, 0, At, B0); PG8_BAR; PG8_SCHED;
            PG8_STAGE(PG8_SB(0, 1), b2 + hstep, voffB);
            PG8_WAIT_V(6); PG8_BAR; PG8_MMA(1, 1, At, B1); PG8_BAR;
            PG8_LDB(B0, 1, 0); PG8_SCHED; PG8_LDA(At, 1, 0); PG8_STAGE(PG8_SA(0, 1), a2 + hstep, voffA);
            PG8_WAIT_L(8); PG8_BAR; PG8_WAIT_L(0); PG8_MMA(0, 0, At, B0); PG8_BAR; PG8_SCHED;
            PG8_LDB(B1, 1, 1); PG8_STAGE(PG8_SB(1, 0), b3, voffB);
            PG8_BAR; PG8_WAIT_L(0); PG8_MMA(0, 1, At, B1); PG8_BAR;
            PG8_LDA(At, 1, 1); PG8_STAGE(PG8_SA(1, 0), a3, voffA);
            PG8_BAR; PG8_WAIT_L(0); PG8_MMA(1, 0, At, B0); PG8_BAR; PG8_SCHED;
            PG8_STAGE(PG8_SB(1, 1), b3 + hstep, voffB);
            PG8_WAIT_V(6); PG8_BAR; PG8_MMA(1, 1, At, B1); PG8_BAR;
            }
        }
        if constexpr (ALIGN_EPI) { if (wr == 0) PG8_BAR; }
        if constexpr (!Epi::AFTER_DRAIN) { E(acc, cur, wr, wc, fr, fq); S.done(cur); }
        if (!has_next) break;
#pragma unroll
        for (int a = 0; a < 2; ++a)
#pragma unroll
            for (int b = 0; b < 2; ++b)
#pragma unroll
                for (int m = 0; m < 4; ++m)
#pragma unroll
                    for (int n = 0; n < 2; ++n) acc[a][b][m][n] = (f32x4){0.f, 0.f, 0.f, 0.f};
        cur = nxt; cA = nA; cB = nB; ++ui;
        if constexpr (ALIGN_EPI) { if (wr == 1) PG8_BAR; }
    }
    PG8_WAIT_V(0);
    if constexpr (!ALIGN_EPI) { if (wr == 0) PG8_BAR; }
    PG8_BAR;
    if constexpr (Epi::AFTER_DRAIN) { E.fused(acc, cur, wr, wc, fr, fq, lds, wid, lane); S.done(cur); }
#undef PG8_SA
#undef PG8_SB
#undef PG8_STAGE
#undef PG8_LDA
#undef PG8_LDB
#undef PG8_MMA
#undef PG8_WAIT_V
#undef PG8_WAIT_L
#undef PG8_BAR
#undef PG8_SCHED
}
}
#define GAS __attribute__((address_space(1)))
#define LAS __attribute__((address_space(3)))
typedef unsigned short bf16;
typedef unsigned v4u __attribute__((ext_vector_type(4)));
typedef unsigned v2u __attribute__((ext_vector_type(2)));
typedef float f32x4 __attribute__((ext_vector_type(4)));
typedef float f32x2 __attribute__((ext_vector_type(2)));
typedef short bf16x8 __attribute__((ext_vector_type(8)));
typedef __bf16 bf16x2_t __attribute__((ext_vector_type(2)));

constexpr int NWAVES = 8, NTHR = 512;
constexpr int DM = 2048, NB = 4, SEQ = 8192, M = NB * SEQ;
constexpr int RW = 1024, RHEADS = 16, HD = 64;
constexpr int L_W = 64, L_A = 64, L_G = 160;
constexpr int INP = 5936, INPP = 6144;
constexpr int C_R = 0, C_K = 1024, C_V = 2048, C_WD = 3072, C_AD = 3136, C_GD = 3200, C_Z = 3360, C_XBC = 4384, C_DT = 5920;
constexpr int MODW = 6 * DM;
constexpr int NEXP = 16384;
constexpr float RMS_EPS = 1e-6f;

enum { I_X = 0, I_C, I_ADAW, I_ADAB, I_N1W, I_WIN, I_MU, I_W0, I_WUP, I_A0, I_AUP, I_GUP, I_KK, I_KA, I_RK, I_LNW, I_LNB,
       I_CONVW, I_CONVB, I_DTB, I_ALOG, I_DSK, I_MNW, I_WOUT, I_N2W, I_WQ, I_KEYS, I_PU, I_PV, I_FNW, N_IN };

constexpr size_t MiB = 1u << 20;
constexpr size_t WS_CTL = 0, CTL_ZERO_BYTES = 1 * MiB;
constexpr size_t WS_MOD = 1 * MiB;
constexpr size_t WS_WIN = 2 * MiB, WS_WOUT = 26 * MiB, WS_WQ = 34 * MiB, WS_KEYS = 42 * MiB;
constexpr size_t WS_WUPT = 43 * MiB, WS_AUPT = 43 * MiB + 256 * 1024, WS_GUPT = 43 * MiB + 512 * 1024;
constexpr size_t WS_PU8 = 44 * MiB, WS_PV8 = 76 * MiB;
constexpr size_t WS_USC = 108 * MiB, WS_VSC = 108 * MiB + 65536;
constexpr size_t WS_XN = 172 * MiB;
constexpr size_t WS_LW = WS_XN, WS_AA = WS_XN + 64 * MiB;
constexpr size_t WS_PROJ = 300 * MiB;
constexpr size_t WS_Q = WS_PROJ;
constexpr size_t WS_GG = 684 * MiB;
constexpr size_t WS_PD = WS_PROJ + 128 * MiB;
constexpr size_t WS_RTE = 684 * MiB, WS_RTG = 700 * MiB, WS_COEF = 716 * MiB;
constexpr size_t WS_OY = 748 * MiB;
constexpr size_t WS_END = 876 * MiB;
constexpr size_t WS_HB = 876 * MiB;

constexpr int RING_BYTES = 131072, LDS_BYTES = 147456;

#define LDS_WAIT() asm volatile("s_waitcnt lgkmcnt(0)" ::: "memory")
#define VM_WAIT() asm volatile("s_waitcnt vmcnt(0)" ::: "memory")
__device__ __forceinline__ unsigned pk2(float lo, float hi) { f32x2 v = {lo, hi}; bf16x2_t b = __builtin_convertvector(v, bf16x2_t); return __builtin_bit_cast(unsigned, b); }
__device__ __forceinline__ float bflo(unsigned u) { return __uint_as_float(u << 16); }
__device__ __forceinline__ float bfhi(unsigned u) { return __uint_as_float(u & 0xffff0000u); }
__device__ __forceinline__ float bf1(bf16 h) { return __uint_as_float((unsigned)h << 16); }
__device__ __forceinline__ float wave_sum(float v) {
#pragma unroll
    for (int o = 1; o < 64; o <<= 1) v += __shfl_xor(v, o);
    return v;
}
__device__ __forceinline__ float rcp_f(float v) { return __builtin_amdgcn_rcpf(v); }
template <int CTRL> __device__ __forceinline__ float dppc_f(float x) { return __builtin_bit_cast(float, __builtin_amdgcn_mov_dpp(__builtin_bit_cast(int, x), CTRL, 0xf, 0xf, true)); }
__device__ __forceinline__ float wave_sum_fast(float x) {
    x += dppc_f<0xB1>(x); x += dppc_f<0x4E>(x); x += dppc_f<0x124>(x); x += dppc_f<0x128>(x);
    { auto rr = __builtin_amdgcn_permlane16_swap(__float_as_uint(x), __float_as_uint(x), false, false); x = __uint_as_float(rr[0]) + __uint_as_float(rr[1]); }
    { auto rr = __builtin_amdgcn_permlane32_swap(__float_as_uint(x), __float_as_uint(x), false, false); x = __uint_as_float(rr[0]) + __uint_as_float(rr[1]); }
    return x;
}
__device__ __forceinline__ float silu_f(float v) { return v * rcp_f(1.f + __expf(-v)); }
__device__ __forceinline__ float sigmoid_f(float v) { return rcp_f(1.f + __expf(-v)); }

struct Ctx {
    LAS unsigned char* lds;
    int tid, lane, wave, G, gw, NGW;
    const float* const* in;
    float* out; unsigned char* ws;
};

__device__ __forceinline__ void transpose_item(const float* W, int K, int N, bf16* WT, int ldt, int nrows_out, LAS float* scr, int kb, int nb, int lane) {
    const int k0 = 64 * kb, n0 = 64 * nb;
    const int c4 = 4 * (lane & 15), rr = lane >> 4;
    const bool vec_ok = ((N & 3) == 0) && (n0 + 64 <= N);
#pragma unroll 4
    for (int i = 0; i < 16; ++i) { const int kk = 4 * i + rr, k = k0 + kk;
        f32x4 v = {0.f, 0.f, 0.f, 0.f};
        if (k < K) { const float* src = W + (size_t)k * N + n0 + c4;
            if (vec_ok) v = *(const f32x4*)src;
            else { if (n0 + c4 + 0 < N) v.x = src[0]; if (n0 + c4 + 1 < N) v.y = src[1]; if (n0 + c4 + 2 < N) v.z = src[2]; if (n0 + c4 + 3 < N) v.w = src[3]; } }
        LAS float* d = scr + kk * 65 + c4; d[0] = v.x; d[1] = v.y; d[2] = v.z; d[3] = v.w; }
    LDS_WAIT(); asm volatile("" ::: "memory");
    const int c = lane & 7;
#pragma unroll
    for (int j = 0; j < 8; ++j) { const int n = (lane >> 3) + 8 * j; const LAS float* sp = scr + (8 * c) * 65 + n;
        v4u o; o.x = pk2(sp[0 * 65], sp[1 * 65]); o.y = pk2(sp[2 * 65], sp[3 * 65]); o.z = pk2(sp[4 * 65], sp[5 * 65]); o.w = pk2(sp[6 * 65], sp[7 * 65]);
        if (n0 + n < nrows_out && k0 + 8 * c + 8 <= ldt) *(v4u*)(WT + (size_t)(n0 + n) * ldt + k0 + 8 * c) = o; }
    LDS_WAIT(); asm volatile("" ::: "memory");
}
__device__ __forceinline__ void transpose_all(const float* W, int K, int N, bf16* WT, int ldt, int nrows_out, LAS float* scr, int gw, int NGW, int lane) {
    const int nkb = (K + 63) / 64, nnb = nrows_out / 64, nit = nkb * nnb;
    for (int it = gw; it < nit; it += NGW) transpose_item(W, K, N, WT, ldt, nrows_out, scr, it / nnb, it % nnb, lane);
}
__device__ __forceinline__ void convert_all(const float* src, bf16* dst, size_t n8, int gw, int NGW, int lane) {
    const f32x4* s4 = (const f32x4*)src; v4u* d4 = (v4u*)dst;
    for (size_t i = (size_t)gw * 64 + lane; i < n8; i += (size_t)NGW * 64) {
        const f32x4 a = __builtin_nontemporal_load(s4 + 2 * i), b = __builtin_nontemporal_load(s4 + 2 * i + 1);
        v4u o; o.x = pk2(a.x, a.y); o.y = pk2(a.z, a.w); o.z = pk2(b.x, b.y); o.w = pk2(b.z, b.w);
        d4[i] = o; }
}
__device__ __forceinline__ void quantize_rows_fp8(const float* src, unsigned char* dst8, float* scales, int e0, int e1, int step, int lane) {
    if (e0 >= e1) return;
    f32x4 vn[8];
    { const f32x4* s4 = (const f32x4*)(src + (size_t)e0 * DM) + lane;
#pragma unroll
      for (int i = 0; i < 8; ++i) vn[i] = __builtin_nontemporal_load(s4 + 64 * i); }
    for (int e = e0; e < e1; e += step) {
        f32x4 v[8];
#pragma unroll
        for (int i = 0; i < 8; ++i) v[i] = vn[i];
        { const int en = (e + step < e1) ? e + step : e; const f32x4* s4 = (const f32x4*)(src + (size_t)en * DM) + lane;
#pragma unroll
          for (int i = 0; i < 8; ++i) vn[i] = __builtin_nontemporal_load(s4 + 64 * i); }
        float am = 0.f;
#pragma unroll
        for (int i = 0; i < 8; ++i) am = fmaxf(fmaxf(am, fmaxf(fabsf(v[i].x), fabsf(v[i].y))), fmaxf(fabsf(v[i].z), fabsf(v[i].w)));
#pragma unroll
        for (int o = 1; o < 64; o <<= 1) am = fmaxf(am, __shfl_xor(am, o));
        am = fmaxf(am, 1e-30f);
        const float inv = 440.f / am;
#pragma unroll
        for (int i = 0; i < 8; ++i) { int w = __builtin_amdgcn_cvt_pk_fp8_f32(v[i].x * inv, v[i].y * inv, 0, false); w = __builtin_amdgcn_cvt_pk_fp8_f32(v[i].z * inv, v[i].w * inv, w, true);
            const int seg = 2 * i + (lane >> 5);
            *(int*)(dst8 + (size_t)seg * ((size_t)NEXP * 128) + (size_t)e * 128 + 4 * (lane & 31)) = w; }
        if (lane == 0) scales[e] = am * (1.f / 440.f);
    }
}
__device__ __forceinline__ void quantize_rows_fp4(const float* src, unsigned char* dst4, float* scales, int e0, int e1, int step, int lane) {
    if (e0 >= e1) return;
    f32x4 vn[8];
    { const f32x4* s4 = (const f32x4*)(src + (size_t)e0 * DM) + lane;
#pragma unroll
      for (int i = 0; i < 8; ++i) vn[i] = __builtin_nontemporal_load(s4 + 64 * i); }
    for (int e = e0; e < e1; e += step) {
        f32x4 v[8];
#pragma unroll
        for (int i = 0; i < 8; ++i) v[i] = vn[i];
        { const int en = (e + step < e1) ? e + step : e; const f32x4* s4 = (const f32x4*)(src + (size_t)en * DM) + lane;
#pragma unroll
          for (int i = 0; i < 8; ++i) vn[i] = __builtin_nontemporal_load(s4 + 64 * i); }
        float am = 0.f;
#pragma unroll
        for (int i = 0; i < 8; ++i) am = fmaxf(am, fmaxf(fmaxf(fabsf(v[i].x), fabsf(v[i].y)), fmaxf(fabsf(v[i].z), fabsf(v[i].w))));
#pragma unroll
        for (int o = 1; o < 64; o <<= 1) am = fmaxf(am, __shfl_xor(am, o));
        am = fmaxf(am, 1e-30f);
        const float inv = 6.f / am;
#pragma unroll
        for (int i = 0; i < 8; ++i) {
            unsigned w = __builtin_amdgcn_cvt_scalef32_pk_fp4_f32(0u, v[i].x * inv, v[i].y * inv, 1.0f, 0);
            w = __builtin_amdgcn_cvt_scalef32_pk_fp4_f32(w, v[i].z * inv, v[i].w * inv, 1.0f, 1);
            *(unsigned short*)(dst4 + (size_t)i * ((size_t)NEXP * 128) + (size_t)e * 128 + 2 * lane) = (unsigned short)w;
        }
        if (lane == 0) scales[e] = am * (1.f / 6.f);
    }
}
__device__ __forceinline__ void p0_prologue(const Ctx& F) {
    __syncthreads();
    if (blockIdx.x < MODW / 64) {
        LAS float* sc = (LAS float*)F.lds;
        LAS float* red = sc + NB * DM;
        const float* c = F.in[I_C];
        for (int i = F.tid; i < NB * DM; i += NTHR) sc[i] = silu_f(c[i]);
        __syncthreads();
        const int j = blockIdx.x * 64 + F.lane;
        const float* wp = F.in[I_ADAW] + (size_t)(F.wave * 256) * MODW + j;
        float a0 = 0.f, a1 = 0.f, a2 = 0.f, a3 = 0.f;
#pragma unroll 32
        for (int kk = 0; kk < 256; ++kk) { const float w = wp[(size_t)kk * MODW]; const int k = F.wave * 256 + kk;
            a0 += sc[k] * w; a1 += sc[DM + k] * w; a2 += sc[2 * DM + k] * w; a3 += sc[3 * DM + k] * w; }
        red[(F.wave * 4 + 0) * 64 + F.lane] = a0; red[(F.wave * 4 + 1) * 64 + F.lane] = a1; red[(F.wave * 4 + 2) * 64 + F.lane] = a2; red[(F.wave * 4 + 3) * 64 + F.lane] = a3;
        __syncthreads();
        if (F.tid < 256) { const int b = F.tid >> 6, l = F.tid & 63; float s = F.in[I_ADAB][blockIdx.x * 64 + l];
#pragma unroll
            for (int w = 0; w < 8; ++w) s += red[(w * 4 + b) * 64 + l];
            ((float*)(F.ws + WS_MOD))[b * MODW + blockIdx.x * 64 + l] = s; }
        __syncthreads();
    }
    LAS float* scr = (LAS float*)(F.lds + F.wave * 16640);
    transpose_all(F.in[I_WIN], DM, INP, (bf16*)(F.ws + WS_WIN), DM, INPP, scr, F.gw, F.NGW, F.lane);
    transpose_all(F.in[I_WOUT], DM, DM, (bf16*)(F.ws + WS_WOUT), DM, DM, scr, F.gw, F.NGW, F.lane);
    transpose_all(F.in[I_WQ], DM, DM, (bf16*)(F.ws + WS_WQ), DM, DM, scr, F.gw, F.NGW, F.lane);
    transpose_all(F.in[I_WUP], L_W, RW, (bf16*)(F.ws + WS_WUPT), L_W, RW, scr, F.gw, F.NGW, F.lane);
    transpose_all(F.in[I_AUP], L_A, RW, (bf16*)(F.ws + WS_AUPT), L_A, RW, scr, F.gw, F.NGW, F.lane);
    transpose_all(F.in[I_GUP], L_G, RW, (bf16*)(F.ws + WS_GUPT), L_G, RW, scr, F.gw, F.NGW, F.lane);
    convert_all(F.in[I_KEYS], (bf16*)(F.ws + WS_KEYS), (size_t)16 * 128 * 128 / 8, F.gw, F.NGW, F.lane);
    {
        const int nlo = (F.G < 192) ? F.G : 192, nhi = F.G - nlo;
        const int wtot = 5 * nlo + 8 * nhi;
        const int wb0 = (blockIdx.x < nlo) ? 5 * blockIdx.x : 5 * nlo + 8 * (blockIdx.x - nlo), wb1 = wb0 + ((blockIdx.x < nlo) ? 5 : 8);
        const int r0 = (int)((long)(2 * NEXP) * wb0 / wtot), r1 = (int)((long)(2 * NEXP) * wb1 / wtot);
        const int a0 = r0 < NEXP ? r0 : NEXP, a1 = r1 < NEXP ? r1 : NEXP;
        quantize_rows_fp4(F.in[I_PU], F.ws + WS_PU8, (float*)(F.ws + WS_USC), a0 + F.wave, a1, NWAVES, F.lane);
        const int b0 = (r0 > NEXP ? r0 : NEXP) - NEXP, b1 = (r1 > NEXP ? r1 : NEXP) - NEXP;
        quantize_rows_fp4(F.in[I_PV], F.ws + WS_PV8, (float*)(F.ws + WS_VSC), b0 + F.wave, b1, NWAVES, F.lane);
    }
}

__device__ __forceinline__ void norm_mod_rows(const Ctx& F, const float* X, const float* nw, int shift_off, int scale_off, bf16* XN) {
    const float* mod = (const float*)(F.ws + WS_MOD);
    if (F.gw >= M) return;
    f32x4 vn[8];
    { const f32x4* xr = (const f32x4*)(X + (size_t)F.gw * DM) + F.lane;
#pragma unroll
      for (int j = 0; j < 8; ++j) vn[j] = xr[64 * j]; }
    for (int m = F.gw; m < M; m += F.NGW) {
        const int b = m / SEQ;
        f32x4 v[8]; float s = 0.f;
#pragma unroll
        for (int j = 0; j < 8; ++j) { v[j] = vn[j]; s += (v[j].x * v[j].x + v[j].y * v[j].y) + (v[j].z * v[j].z + v[j].w * v[j].w); }
        { const int mn = (m + F.NGW < M) ? m + F.NGW : m; const f32x4* xr = (const f32x4*)(X + (size_t)mn * DM) + F.lane;
#pragma unroll
          for (int j = 0; j < 8; ++j) vn[j] = xr[64 * j]; }
        const float rstd = rsqrtf(wave_sum_fast(s) * (1.f / DM) + RMS_EPS);
        const f32x4* wp = (const f32x4*)nw + F.lane;
        const f32x4* shp = (const f32x4*)(mod + (size_t)b * MODW + shift_off) + F.lane;
        const f32x4* scp = (const f32x4*)(mod + (size_t)b * MODW + scale_off) + F.lane;
        v2u* o = (v2u*)(XN + (size_t)m * DM) + F.lane;
#pragma unroll
        for (int j = 0; j < 8; ++j) { const f32x4 w = wp[64 * j], a = scp[64 * j], c = shp[64 * j];
            const f32x4 r = (v[j] * rstd) * w * (a + 1.f) + c;
            v2u p; p.x = pk2(r.x, r.y); p.y = pk2(r.z, r.w); o[64 * j] = p; }
    }
}
__device__ __forceinline__ void final_norm_rows(const Ctx& F, const float* H, const float* nw, float* O) {
    for (int m = F.gw; m < M; m += F.NGW) {
        const f32x4* xr = (const f32x4*)(H + (size_t)m * DM) + F.lane;
        f32x4 v[8]; float s = 0.f;
#pragma unroll
        for (int j = 0; j < 8; ++j) { v[j] = xr[64 * j]; s += (v[j].x * v[j].x + v[j].y * v[j].y) + (v[j].z * v[j].z + v[j].w * v[j].w); }
        const float rstd = rsqrtf(wave_sum(s) * (1.f / DM) + RMS_EPS);
        const f32x4* wp = (const f32x4*)nw + F.lane;
        f32x4* o = (f32x4*)(O + (size_t)m * DM) + F.lane;
#pragma unroll
        for (int j = 0; j < 8; ++j) o[64 * j] = (v[j] * rstd) * wp[64 * j];
    }
}


__device__ __forceinline__ void load_row_raw(const bf16* row, int lane, v2u (&u)[8]) {
    const v2u* p = (const v2u*)row + lane;
#pragma unroll
    for (int j = 0; j < 8; ++j) u[j] = p[64 * j];
}
__device__ __forceinline__ void norm_mod_rows_bf16(const Ctx& F, const bf16* X, const float* nw, int shift_off, int scale_off, bf16* XN) {
    const float* mod = (const float*)(F.ws + WS_MOD);
    if (F.gw >= M) return;
    v2u un[8]; load_row_raw(X + (size_t)F.gw * DM, F.lane, un);
    for (int m = F.gw; m < M; m += F.NGW) {
        const int b = m / SEQ;
        f32x4 v[8]; float s = 0.f;
#pragma unroll
        for (int j = 0; j < 8; ++j) { v[j] = (f32x4){bflo(un[j].x), bfhi(un[j].x), bflo(un[j].y), bfhi(un[j].y)}; s += (v[j].x * v[j].x + v[j].y * v[j].y) + (v[j].z * v[j].z + v[j].w * v[j].w); }
        { const int mn = (m + F.NGW < M) ? m + F.NGW : m; load_row_raw(X + (size_t)mn * DM, F.lane, un); }
        const float rstd = rsqrtf(wave_sum_fast(s) * (1.f / DM) + RMS_EPS);
        const f32x4* wp = (const f32x4*)nw + F.lane;
        const f32x4* shp = (const f32x4*)(mod + (size_t)b * MODW + shift_off) + F.lane;
        const f32x4* scp = (const f32x4*)(mod + (size_t)b * MODW + scale_off) + F.lane;
        v2u* o = (v2u*)(XN + (size_t)m * DM) + F.lane;
#pragma unroll
        for (int j = 0; j < 8; ++j) { const f32x4 w = wp[64 * j], a = scp[64 * j], c = shp[64 * j];
            const f32x4 r = (v[j] * rstd) * w * (a + 1.f) + c;
            v2u p; p.x = pk2(r.x, r.y); p.y = pk2(r.z, r.w); o[64 * j] = p; }
    }
}
__device__ __forceinline__ void final_norm_rows_bf16(const Ctx& F, const bf16* H, const float* nw, float* O, float oscale) {
    if (F.gw >= M) return;
    v2u un[8]; load_row_raw(H + (size_t)F.gw * DM, F.lane, un);
    f32x4 wv[8];
#pragma unroll
    for (int j = 0; j < 8; ++j) wv[j] = ((const f32x4*)nw + F.lane)[64 * j];
    for (int m = F.gw; m < M; m += F.NGW) {
        f32x4 v[8]; float s = 0.f;
#pragma unroll
        for (int j = 0; j < 8; ++j) { v[j] = (f32x4){bflo(un[j].x), bfhi(un[j].x), bflo(un[j].y), bfhi(un[j].y)}; s += (v[j].x * v[j].x + v[j].y * v[j].y) + (v[j].z * v[j].z + v[j].w * v[j].w); }
        { const int mn = (m + F.NGW < M) ? m + F.NGW : m; load_row_raw(H + (size_t)mn * DM, F.lane, un); }
        const float rstd = rsqrtf(wave_sum_fast(s) * (1.f / DM) + RMS_EPS) * oscale;
        f32x4* o = (f32x4*)(O + (size_t)m * DM) + F.lane;
#pragma unroll
        for (int j = 0; j < 8; ++j) __builtin_nontemporal_store((v[j] * rstd) * wv[j], o + 64 * j);
    }
}
#define LO2(v) __builtin_shufflevector((v), (v), 0, 1)
#define HI2(v) __builtin_shufflevector((v), (v), 2, 3)
template <int CTRL> __device__ __forceinline__ float dpp_f(float x) { return __builtin_bit_cast(float, __builtin_amdgcn_mov_dpp(__builtin_bit_cast(int, x), CTRL, 0xf, 0xf, true)); }
__device__ __forceinline__ float rowsum16(float x) { x += dpp_f<0xB1>(x); x += dpp_f<0x4E>(x); x += dpp_f<0x124>(x); x += dpp_f<0x128>(x); return x; }
__device__ __forceinline__ float quadsum(float x) { x += dpp_f<0xB1>(x); x += dpp_f<0x4E>(x); return x; }

__device__ __forceinline__ float treduce16(const float (&p)[16], bool b0, bool b1, bool b2, bool b3) {
    float a[8], bq[4], c2[2];
#pragma unroll
    for (int j = 0; j < 8; ++j) { const float mine = b3 ? p[j + 8] : p[j], send = b3 ? p[j] : p[j + 8]; a[j] = mine + dpp_f<0x128>(send); }
#pragma unroll
    for (int j = 0; j < 4; ++j) { const float mine = b2 ? a[j + 4] : a[j], send = b2 ? a[j] : a[j + 4]; const float up = dpp_f<0x104>(send), dn = dpp_f<0x114>(send); bq[j] = mine + (b2 ? dn : up); }
#pragma unroll
    for (int j = 0; j < 2; ++j) { const float mine = b1 ? bq[j + 2] : bq[j], send = b1 ? bq[j] : bq[j + 2]; c2[j] = mine + dpp_f<0x4E>(send); }
    const float mine = b0 ? c2[1] : c2[0], send = b0 ? c2[0] : c2[1];
    return mine + dpp_f<0xB1>(send);
}
__device__ __forceinline__ float wave_sum_dpp(float v) { v = rowsum16(v); v += __shfl_xor(v, 16); v += __shfl_xor(v, 32); return v; }
__device__ __forceinline__ void unpack8(const v4u p, float (&e)[8]) { e[0] = bflo(p.x); e[1] = bfhi(p.x); e[2] = bflo(p.y); e[3] = bfhi(p.y); e[4] = bflo(p.z); e[5] = bfhi(p.z); e[6] = bflo(p.w); e[7] = bfhi(p.w); }
__device__ __forceinline__ v4u pack8(const float (&e)[8]) { v4u o; o.x = pk2(e[0], e[1]); o.y = pk2(e[2], e[3]); o.z = pk2(e[4], e[5]); o.w = pk2(e[6], e[7]); return o; }

__device__ __forceinline__ void p3_lora(const Ctx& F) {
    const bf16* PROJ = (const bf16*)(F.ws + WS_PROJ);
    const bf16* WUPT = (const bf16*)(F.ws + WS_WUPT); const bf16* AUPT = (const bf16*)(F.ws + WS_AUPT); const bf16* GUPT = (const bf16*)(F.ws + WS_GUPT);
    bf16* LW = (bf16*)(F.ws + WS_LW); bf16* AA = (bf16*)(F.ws + WS_AA); bf16* GG = (bf16*)(F.ws + WS_GG);
    const float* mu = F.in[I_MU]; const float* w0 = F.in[I_W0]; const float* a0 = F.in[I_A0];
    const int r16 = F.lane & 15, q = F.lane >> 4;
    constexpr int WST = 72, GST = 168;
    LAS bf16* WU = (LAS bf16*)F.lds; LAS bf16* AU = WU + 128 * WST; LAS bf16* GU = AU + 128 * WST;
    const int nr = blockIdx.x & 7, nbr = (F.G - nr + 7) >> 3;
    __syncthreads();
    for (int i = F.tid; i < 128 * 8; i += NTHR) { const int row = i >> 3, ch = i & 7;
        *(LAS v4u*)(WU + row * WST + 8 * ch) = *(const v4u*)(WUPT + (size_t)(128 * nr + row) * L_W + 8 * ch);
        *(LAS v4u*)(AU + row * WST + 8 * ch) = *(const v4u*)(AUPT + (size_t)(128 * nr + row) * L_A + 8 * ch); }
    for (int i = F.tid; i < 128 * 20; i += NTHR) { const int row = i / 20, ch = i - row * 20;
        *(LAS v4u*)(GU + row * GST + 8 * ch) = *(const v4u*)(GUPT + (size_t)(128 * nr + row) * L_G + 8 * ch); }
    __syncthreads();
#define P3_COL(s) ((((s) < 2) ? (C_WD + 32 * (s)) : ((s) < 4) ? (C_AD + 32 * ((s) - 2)) : (C_GD + 32 * ((s) - 4))) + 8 * q)
    const int mt0 = (blockIdx.x >> 3) * NWAVES + F.wave, mst = nbr * NWAVES;
    v4u rc_[9], rp_[9];
    if (mt0 < M / 16) { const bf16* row = PROJ + (size_t)(mt0 * 16 + r16) * INPP;
#pragma unroll
        for (int s = 0; s < 9; ++s) { rc_[s] = *(const v4u*)(row + P3_COL(s)); rp_[s] = *(const v4u*)(row - INPP + P3_COL(s)); } }
    for (int mt = mt0; mt < M / 16; mt += mst) {
        const int m = mt * 16 + r16; const bool first = (m % SEQ) == 0;
        bf16x8 af[9];
#pragma unroll
        for (int s = 0; s < 9; ++s) {
            const int col = P3_COL(s);
            const v4u pc = rc_[s];
            v4u pp = rp_[s]; if (first) pp = (v4u){0u, 0u, 0u, 0u};
            const f32x4 m0 = *(const f32x4*)(mu + col), m1 = *(const f32x4*)(mu + col + 4);
            float c[8], p[8], e[8]; unpack8(pc, c); unpack8(pp, p);
            const float mm[8] = {m0.x, m0.y, m0.z, m0.w, m1.x, m1.y, m1.z, m1.w};
#pragma unroll
            for (int j = 0; j < 8; ++j) { float v = c[j] + (p[j] - c[j]) * mm[j];
                if (s < 2) { const float t = __expf(2.f * v); v = 1.f - 2.f * rcp_f(t + 1.f); }
                else if (s >= 4) v = sigmoid_f(v);
                e[j] = v; }
            af[s] = __builtin_bit_cast(bf16x8, pack8(e));
        }
        { const int mtn = (mt + mst < M / 16) ? mt + mst : mt; const bf16* row = PROJ + (size_t)(mtn * 16 + r16) * INPP;
#pragma unroll
          for (int s = 0; s < 9; ++s) { rc_[s] = *(const v4u*)(row + P3_COL(s)); rp_[s] = *(const v4u*)(row - INPP + P3_COL(s)); } }
        asm volatile("" ::: "memory");
#pragma unroll 2
        for (int nt = 0; nt < 8; ++nt) {
            const LAS bf16* wu = WU + (16 * nt + r16) * WST + 8 * q; const LAS bf16* au = AU + (16 * nt + r16) * WST + 8 * q; const LAS bf16* gu = GU + (16 * nt + r16) * GST + 8 * q;
            f32x4 acc0 = {0.f, 0.f, 0.f, 0.f}, acc1 = acc0, acc2 = acc0;
#pragma unroll
            for (int s2 = 0; s2 < 2; ++s2) acc0 = __builtin_amdgcn_mfma_f32_16x16x32_bf16(*(const LAS bf16x8*)(wu + 32 * s2), af[s2], acc0, 0, 0, 0);
#pragma unroll
            for (int s2 = 0; s2 < 2; ++s2) acc1 = __builtin_amdgcn_mfma_f32_16x16x32_bf16(*(const LAS bf16x8*)(au + 32 * s2), af[2 + s2], acc1, 0, 0, 0);
#pragma unroll
            for (int s2 = 0; s2 < 5; ++s2) acc2 = __builtin_amdgcn_mfma_f32_16x16x32_bf16(*(const LAS bf16x8*)(gu + 32 * s2), af[4 + s2], acc2, 0, 0, 0);
            const int n = 128 * nr + 16 * nt + 4 * q;
            const f32x4 w0v = *(const f32x4*)(w0 + n), a0v = *(const f32x4*)(a0 + n);
            v2u o0, o1, o2;
            o0.x = pk2(-0.60653066f * sigmoid_f(acc0[0] + w0v.x), -0.60653066f * sigmoid_f(acc0[1] + w0v.y));
            o0.y = pk2(-0.60653066f * sigmoid_f(acc0[2] + w0v.z), -0.60653066f * sigmoid_f(acc0[3] + w0v.w));
            o1.x = pk2(sigmoid_f(acc1[0] + a0v.x), sigmoid_f(acc1[1] + a0v.y)); o1.y = pk2(sigmoid_f(acc1[2] + a0v.z), sigmoid_f(acc1[3] + a0v.w));
            o2.x = pk2(acc2[0], acc2[1]); o2.y = pk2(acc2[2], acc2[3]);
            *(v2u*)(LW + (size_t)m * RW + n) = o0; *(v2u*)(AA + (size_t)m * RW + n) = o1; *(v2u*)(GG + (size_t)m * RW + n) = o2;
        }
    }
#undef P3_COL
    __syncthreads();
}

constexpr int TC = 32, NCHUNK = SEQ / TC;
constexpr int RB_R = 0, RB_W = TC * 64, RB_K = 2 * TC * 64, RB_KK = 3 * TC * 64, RB_KA = 4 * TC * 64, RB_V = 5 * TC * 64, RB_SIZE = 5 * TC * 64 + TC * 16;
constexpr int MB_B = 0, MB_C = TC * 128, MB_X = 2 * TC * 128, MB_DT = MB_X + TC * 32, MB_DA = MB_DT + TC, MB_SIZE = MB_DA + TC;
static_assert(2 * RB_SIZE * 4 <= RING_BYTES, "scan buffers fit the LDS ring");

struct RwkvRaw { bf16 r[9], k[9], v[9], lw[8], a[8]; };
__device__ __forceinline__ void rwkv_load(RwkvRaw& raw, const bf16* PROJ, const bf16* LW, const bf16* AA, int b, int h, int t0w, int c) {
    const bf16* base = PROJ + (size_t)(b * SEQ + t0w) * INPP + h * 64 + c;
#pragma unroll
    for (int i = 0; i < 9; ++i) {
        if (i == 0 && t0w == 0) { raw.r[0] = 0; raw.k[0] = 0; raw.v[0] = 0; }
        else { const bf16* row = base + (long)(i - 1) * INPP; raw.r[i] = row[C_R]; raw.k[i] = row[C_K]; raw.v[i] = row[C_V]; }
    }
#pragma unroll
    for (int i = 0; i < 8; ++i) { const size_t o = (size_t)(b * SEQ + t0w + i) * RW + h * 64 + c; raw.lw[i] = LW[o]; raw.a[i] = AA[o]; }
}
__device__ __forceinline__ void rwkv_stage(const RwkvRaw& raw, LAS float* buf, int tl0, int c, int qt, float mu_r, float mu_k, float mu_v, float kkw, float kaw) {
#pragma unroll
    for (int i = 0; i < 8; ++i) {
        const int t = tl0 + i;
        const float rc = bf1(raw.r[i + 1]), rp = bf1(raw.r[i]), kc = bf1(raw.k[i + 1]), kp = bf1(raw.k[i]), vc = bf1(raw.v[i + 1]), vp = bf1(raw.v[i]);
        const float rr = rc + (rp - rc) * mu_r, kx = kc + (kp - kc) * mu_k, vv = vc + (vp - vc) * mu_v;
        const float a = bf1(raw.a[i]), dec = __expf(bf1(raw.lw[i]));
        const float kkraw = kx * kkw; const float ss = wave_sum_dpp(kkraw * kkraw);
        const float kkn = kkraw * rcp_f(fmaxf(sqrtf(ss), 1e-12f));
        buf[RB_R + t * 64 + c] = rr; buf[RB_W + t * 64 + c] = dec; buf[RB_K + t * 64 + c] = kx * (1.f + (a - 1.f) * kaw);
        buf[RB_KK + t * 64 + c] = kkn; buf[RB_KA + t * 64 + c] = kkn * a;
        if ((c >> 4) == qt) buf[RB_V + t * 16 + (c & 15)] = vv;
    }
}
__device__ __forceinline__ void rwkv_task(const Ctx& F, int task) {
    const int b = task >> 6, h = (task >> 2) & 15, qt = task & 3;
    const bf16* PROJ = (const bf16*)(F.ws + WS_PROJ); const bf16* LW = (const bf16*)(F.ws + WS_LW); const bf16* AA = (const bf16*)(F.ws + WS_AA);
    bf16* OY = (bf16*)(F.ws + WS_OY);
    LAS float* lbuf = (LAS float*)F.lds;
    const int c = F.lane, w = F.wave, r = F.lane >> 4, cg = F.lane & 15;
    const bool stager = w >= 4; const int sw = w & 3;
    const int ch = h * 64 + c;
    const float mu_r = F.in[I_MU][C_R + ch], mu_k = F.in[I_MU][C_K + ch], mu_v = F.in[I_MU][C_V + ch], kkw = F.in[I_KK][ch], kaw = F.in[I_KA][ch];
    RwkvRaw raw;
    if (stager) { rwkv_load(raw, PROJ, LW, AA, b, h, 8 * sw, c); rwkv_stage(raw, lbuf, 8 * sw, c, qt, mu_r, mu_k, mu_v, kkw, kaw); rwkv_load(raw, PROJ, LW, AA, b, h, TC + 8 * sw, c); }
    __syncthreads();
    f32x2 S01 = {0.f, 0.f}, S23 = {0.f, 0.f};
    const bool cb0 = cg & 1, cb1 = cg & 2, cb2 = cg & 4, cb3 = cg & 8;
    bf16* orow = OY + (size_t)(b * SEQ) * DM + h * 64 + 16 * qt + 4 * sw + r;
    for (int ck = 0; ck < NCHUNK; ++ck) {
        const LAS float* buf = lbuf + (ck & 1) * RB_SIZE;
        if (stager) {
            if (ck + 1 < NCHUNK) { rwkv_stage(raw, lbuf + ((ck + 1) & 1) * RB_SIZE, 8 * sw, c, qt, mu_r, mu_k, mu_v, kkw, kaw);
                if (ck + 2 < NCHUNK) rwkv_load(raw, PROJ, LW, AA, b, h, (ck + 2) * TC + 8 * sw, c); }
        } else {
            const LAS float* bp = buf + 4 * cg; const LAS float* vp = buf + RB_V + 4 * sw + r;
            f32x4 qkk[3], qw[3], qka[3], qk[3], qr[3]; float qv[3];
#pragma unroll
            for (int i = 0; i < 3; ++i) { qkk[i] = *(const LAS f32x4*)(bp + RB_KK + i * 64); qw[i] = *(const LAS f32x4*)(bp + RB_W + i * 64); qka[i] = *(const LAS f32x4*)(bp + RB_KA + i * 64);
                qk[i] = *(const LAS f32x4*)(bp + RB_K + i * 64); qr[i] = *(const LAS f32x4*)(bp + RB_R + i * 64); qv[i] = vp[i * 16]; }
            float op[16];
#pragma unroll
            for (int j = 0; j < TC; ++j) {
                const int u = j % 3;
                const f32x4 kk4 = qkk[u], w4 = qw[u], ka4 = qka[u], k4 = qk[u], r4 = qr[u]; const float vr = qv[u];
                const f32x2 tq = S01 * LO2(kk4) + S23 * HI2(kk4);
                const float sa = rowsum16(tq.x + tq.y);
                const f32x2 sav = {sa, sa}, vrv = {vr, vr};
                S01 = S01 * LO2(w4) + (vrv * LO2(k4) - sav * LO2(ka4));
                S23 = S23 * HI2(w4) + (vrv * HI2(k4) - sav * HI2(ka4));
                const f32x2 uq = S01 * LO2(r4) + S23 * HI2(r4);
                op[j & 15] = uq.x + uq.y;
                asm volatile("" : "+v"(S01), "+v"(S23) :: "memory");
                if (j + 3 < TC) { qkk[u] = *(const LAS f32x4*)(bp + RB_KK + (j + 3) * 64); qw[u] = *(const LAS f32x4*)(bp + RB_W + (j + 3) * 64); qka[u] = *(const LAS f32x4*)(bp + RB_KA + (j + 3) * 64);
                                  qk[u] = *(const LAS f32x4*)(bp + RB_K + (j + 3) * 64); qr[u] = *(const LAS f32x4*)(bp + RB_R + (j + 3) * 64); qv[u] = vp[(j + 3) * 16]; }
                if ((j & 15) == 15) {
                    const float ored = treduce16(op, cb0, cb1, cb2, cb3);
                    orow[(size_t)(ck * TC + (j - 15) + cg) * DM] = (bf16)(pk2(ored, 0.f) & 0xffffu);
                }
            }
        }
        __syncthreads();
    }
}

__device__ __forceinline__ void p4_scans(const Ctx& F) {
    for (int task = blockIdx.x; task < NB * RHEADS * 4; task += F.G) { rwkv_task(F, task); __syncthreads(); }
}

__device__ __forceinline__ void ld16(const float* p, float (&v)[16]) {
#pragma unroll
    for (int i = 0; i < 4; ++i) { const f32x4 t = *(const f32x4*)(p + 4 * i); v[4 * i] = t.x; v[4 * i + 1] = t.y; v[4 * i + 2] = t.z; v[4 * i + 3] = t.w; }
}
__device__ __forceinline__ void ldbf16x16(const bf16* p, float (&v)[16]) {
    float t0[8], t1[8]; unpack8(*(const v4u*)p, t0); unpack8(*(const v4u*)(p + 8), t1);
#pragma unroll
    for (int j = 0; j < 8; ++j) { v[j] = t0[j]; v[8 + j] = t1[j]; }
}
__device__ __forceinline__ void stbf16x16(bf16* p, const float (&v)[16]) {
    float t0[8], t1[8];
#pragma unroll
    for (int j = 0; j < 8; ++j) { t0[j] = v[j]; t1[j] = v[8 + j]; }
    *(v4u*)p = pack8(t0); *(v4u*)(p + 8) = pack8(t1);
}
__device__ __forceinline__ void p5_post(const Ctx& F) {
    const bf16* PROJ = (const bf16*)(F.ws + WS_PROJ); const bf16* AA = (const bf16*)(F.ws + WS_AA); const bf16* GG = (const bf16*)(F.ws + WS_GG);
    bf16* OY = (bf16*)(F.ws + WS_OY);
    const int c0 = 16 * F.lane;
    {
        float mur[16], muk[16], muv[16], ka[16], rk[16], lnw[16], lnb[16];
        ld16(F.in[I_MU] + C_R + c0, mur); ld16(F.in[I_MU] + C_K + c0, muk); ld16(F.in[I_MU] + C_V + c0, muv);
        ld16(F.in[I_KA] + c0, ka); ld16(F.in[I_RK] + c0, rk); ld16(F.in[I_LNW] + c0, lnw); ld16(F.in[I_LNB] + c0, lnb);
        for (int m = F.gw; m < M; m += F.NGW) {
            const bool first = (m % SEQ) == 0;
            const bf16* prow = PROJ + (size_t)m * INPP; bf16* oyrow = OY + (size_t)m * DM;
            float o[16], res[16]; float bs = 0.f;
            ldbf16x16(oyrow + c0, o);
            {
                float rc[16], rp[16], kc[16], kp[16], av[16];
                ldbf16x16(prow + C_R + c0, rc); ldbf16x16(prow + C_K + c0, kc); ldbf16x16(AA + (size_t)m * RW + c0, av);
                if (!first) { ldbf16x16(prow - INPP + C_R + c0, rp); ldbf16x16(prow - INPP + C_K + c0, kp); }
                else {
#pragma unroll
                    for (int j = 0; j < 16; ++j) { rp[j] = 0.f; kp[j] = 0.f; } }
#pragma unroll
                for (int j = 0; j < 16; ++j) { const float rr = rc[j] + (rp[j] - rc[j]) * mur[j], kx = kc[j] + (kp[j] - kc[j]) * muk[j];
                    bs += rr * (kx * (1.f + (av[j] - 1.f) * ka[j])) * rk[j]; }
            }
            bs = quadsum(bs);
            float s = 0.f;
#pragma unroll
            for (int j = 0; j < 16; ++j) s += o[j];
            const float mean = quadsum(s) * (1.f / 64.f);
            float qv = 0.f;
#pragma unroll
            for (int j = 0; j < 16; ++j) { o[j] -= mean; qv += o[j] * o[j]; }
            const float rstd = rsqrtf(quadsum(qv) * (1.f / 64.f) + 64e-5f);
            {
                float vc[16], vp[16], gv[16];
                ldbf16x16(prow + C_V + c0, vc); ldbf16x16(GG + (size_t)m * RW + c0, gv);
                if (!first) ldbf16x16(prow - INPP + C_V + c0, vp);
                else {
#pragma unroll
                    for (int j = 0; j < 16; ++j) vp[j] = 0.f; }
#pragma unroll
                for (int j = 0; j < 16; ++j) { const float vv = vc[j] + (vp[j] - vc[j]) * muv[j]; res[j] = (o[j] * rstd * lnw[j] + lnb[j] + bs * vv) * gv[j]; }
            }
            stbf16x16(oyrow + c0, res);
        }
    }
    {
        float nw[16]; ld16(F.in[I_MNW] + c0, nw);
        for (int m = F.gw; m < M; m += F.NGW) {
            const bf16* prow = PROJ + (size_t)m * INPP; bf16* oyrow = OY + (size_t)m * DM;
            float y[16], z[16];
            ldbf16x16(oyrow + RW + c0, y); ldbf16x16(prow + C_Z + c0, z);
            float qv = 0.f;
#pragma unroll
            for (int j = 0; j < 16; ++j) { y[j] *= silu_f(z[j]); qv += y[j] * y[j]; }
            qv = rowsum16(qv);
            { auto rr = __builtin_amdgcn_permlane16_swap(__float_as_uint(qv), __float_as_uint(qv), false, false); qv = __uint_as_float(rr[0]) + __uint_as_float(rr[1]); }
            const float rstd = rsqrtf(qv * (1.f / 512.f) + 1e-5f);
#pragma unroll
            for (int j = 0; j < 16; ++j) y[j] = y[j] * rstd * nw[j];
            stbf16x16(oyrow + RW + c0, y);
        }
    }
}
constexpr int MC_L = 128, MC_NC = SEQ / MC_L, LSTR = 136;
constexpr int MT_BYTES = 128 * LSTR * 2;
constexpr size_t WS_ST = 876 * MiB, WS_SIN = 940 * MiB, WS_ATOT = 1004 * MiB, WS_END2 = 1005 * MiB;

__device__ __forceinline__ float mamba_dt_scan(const Ctx& F, const bf16* PROJ, int b, int c, int g, LAS float* DT, LAS float* ACS) {
    const int head = g * 8 + F.wave, lane = F.lane;
    const float dtb = F.in[I_DTB][head], Aneg = -__expf(F.in[I_ALOG][head]);
    const bf16* p = PROJ + (size_t)(b * SEQ + c * MC_L + 2 * lane) * INPP + C_DT + head;
    const float x0 = bf1(p[0]) + dtb, x1 = bf1(p[INPP]) + dtb;
    const float d0 = (x0 > 20.f) ? x0 : log1pf(__expf(x0)), d1 = (x1 > 20.f) ? x1 : log1pf(__expf(x1));
    const float s0 = d0 * Aneg, s1 = s0 + d1 * Aneg;
    float incl = s1;
#pragma unroll
    for (int o = 1; o < 64; o <<= 1) { const float t = __shfl_up(incl, o); if (lane >= o) incl += t; }
    const float excl = incl - s1;
    DT[F.wave * 128 + 2 * lane] = d0; DT[F.wave * 128 + 2 * lane + 1] = d1;
    ACS[F.wave * 128 + 2 * lane] = excl + s0; ACS[F.wave * 128 + 2 * lane + 1] = excl + s1;
    return __shfl(incl, 63);
}
struct TRaw { bf16 v[35]; };
__device__ __forceinline__ void mstage_T_load(TRaw& raw, const bf16* PROJ, int b, int c, int chn, int tid) {
    const int t0 = 32 * (tid >> 7);
    const bf16* base = PROJ + (size_t)(b * SEQ + c * MC_L + t0) * INPP + C_XBC + chn;
    if (c * MC_L + t0 > 0) { raw.v[0] = base[-3 * INPP]; raw.v[1] = base[-2 * INPP]; raw.v[2] = base[-1 * INPP]; }
    else { raw.v[0] = 0; raw.v[1] = 0; raw.v[2] = 0; }
#pragma unroll
    for (int t = 0; t < 32; ++t) raw.v[3 + t] = base[(size_t)t * INPP];
}
template <bool SC>
__device__ __forceinline__ void mstage_T_store(const TRaw& raw, int chn, LAS bf16* dst, const LAS float* scale, const float* convw, const float* convb, int tid) {
    const int f = tid & 127, t0 = 32 * (tid >> 7);
    const float w0 = convw[chn], w1 = convw[1536 + chn], w2 = convw[2 * 1536 + chn], w3 = convw[3 * 1536 + chn], bb = convb[chn];
#pragma unroll
    for (int i8 = 0; i8 < 4; ++i8) {
        float e[8];
#pragma unroll
        for (int i = 0; i < 8; ++i) { const int t = 8 * i8 + i;
            float v = silu_f(bb + w0 * bf1(raw.v[t]) + w1 * bf1(raw.v[t + 1]) + w2 * bf1(raw.v[t + 2]) + w3 * bf1(raw.v[t + 3]));
            if (SC) v *= scale[t0 + t];
            e[i] = v; }
        *(LAS v4u*)(dst + f * LSTR + t0 + 8 * i8) = pack8(e);
    }
}
__device__ __forceinline__ void mstage_N(const bf16* PROJ, int b, int c, int g, LAS bf16* Bn, LAS bf16* Cn, const float* convw, const float* convb, int tid) {
    const int f8 = tid & 31, t0 = 8 * (tid >> 5);
    const int chn = (f8 < 16) ? (1024 + g * 128 + 8 * f8) : (1280 + g * 128 + 8 * (f8 - 16));
    LAS bf16* dst = ((f8 < 16) ? Bn : Cn) + 8 * (f8 & 15);
    const bf16* base = PROJ + (size_t)(b * SEQ + c * MC_L + t0) * INPP + C_XBC + chn;
    float w[4][8], bb[8];
#pragma unroll
    for (int i = 0; i < 4; ++i) { const f32x4 a = *(const f32x4*)(convw + i * 1536 + chn), d = *(const f32x4*)(convw + i * 1536 + chn + 4);
        w[i][0] = a.x; w[i][1] = a.y; w[i][2] = a.z; w[i][3] = a.w; w[i][4] = d.x; w[i][5] = d.y; w[i][6] = d.z; w[i][7] = d.w; }
    { const f32x4 a = *(const f32x4*)(convb + chn), d = *(const f32x4*)(convb + chn + 4); bb[0] = a.x; bb[1] = a.y; bb[2] = a.z; bb[3] = a.w; bb[4] = d.x; bb[5] = d.y; bb[6] = d.z; bb[7] = d.w; }
    float r0[8], r1[8], r2[8];
    if (c * MC_L + t0 > 0) { unpack8(*(const v4u*)(base - 3 * INPP), r0); unpack8(*(const v4u*)(base - 2 * INPP), r1); unpack8(*(const v4u*)(base - 1 * INPP), r2); }
    else {
#pragma unroll
        for (int k = 0; k < 8; ++k) { r0[k] = 0.f; r1[k] = 0.f; r2[k] = 0.f; } }
#pragma unroll
    for (int t = 0; t < 8; ++t) {
        float r3[8], e[8]; unpack8(*(const v4u*)(base + (size_t)t * INPP), r3);
#pragma unroll
        for (int k = 0; k < 8; ++k) { e[k] = silu_f(bb[k] + w[0][k] * r0[k] + w[1][k] * r1[k] + w[2][k] * r2[k] + w[3][k] * r3[k]); r0[k] = r1[k]; r1[k] = r2[k]; r2[k] = r3[k]; }
        *(LAS v4u*)(dst + (t0 + t) * LSTR) = pack8(e);
    }
}

__device__ __forceinline__ void m1_chunk_states(const Ctx& F) {
    const bf16* PROJ = (const bf16*)(F.ws + WS_PROJ); bf16* ST = (bf16*)(F.ws + WS_ST); float* ATOT = (float*)(F.ws + WS_ATOT);
    LAS bf16* BT = (LAS bf16*)F.lds; LAS bf16* XT = (LAS bf16*)(F.lds + MT_BYTES);
    LAS float* DT = (LAS float*)(F.lds + 3 * MT_BYTES); LAS float* ACS = DT + 8 * 128; LAS float* SCL = ACS + 8 * 128;
    const float* convw = F.in[I_CONVW]; const float* convb = F.in[I_CONVB];
    const int tid = F.tid, w = F.wave, lane = F.lane, r16 = lane & 15, q = lane >> 4;
    for (int it = blockIdx.x; it < NB * MC_NC * 2; it += F.G) {
        const int g = it & 1, c = (it >> 1) & (MC_NC - 1), b = it >> 7;
        __syncthreads();
        const float atot = mamba_dt_scan(F, PROJ, b, c, g, DT, ACS);
        if (lane == 0) ATOT[(b * MC_NC + c) * 16 + g * 8 + w] = atot;
        const int chB = 1024 + g * 128 + (tid & 127);
        TRaw ra, rb;
        mstage_T_load(ra, PROJ, b, c, chB, tid);
        mstage_T_load(rb, PROJ, b, c, (g * 8 + ((tid & 127) >> 6)) * 64 + (tid & 63), tid);
        LDS_WAIT();
        SCL[w * 128 + 2 * lane] = DT[w * 128 + 2 * lane] * __expf(atot - ACS[w * 128 + 2 * lane]);
        SCL[w * 128 + 2 * lane + 1] = DT[w * 128 + 2 * lane + 1] * __expf(atot - ACS[w * 128 + 2 * lane + 1]);
        mstage_T_store<false>(ra, chB, BT, nullptr, convw, convb, tid);
        mstage_T_load(ra, PROJ, b, c, (g * 8 + 2 + ((tid & 127) >> 6)) * 64 + (tid & 63), tid);
        __syncthreads();
#pragma unroll
        for (int hb = 0; hb < 2; ++hb) {
            if (hb == 1) mstage_T_load(ra, PROJ, b, c, (g * 8 + 6 + ((tid & 127) >> 6)) * 64 + (tid & 63), tid);
            { const int hl = 4 * hb + ((tid & 127) >> 6); mstage_T_store<true>(rb, (g * 8 + hl) * 64 + (tid & 63), XT, SCL + hl * 128, convw, convb, tid); }
            if (hb == 0) mstage_T_load(rb, PROJ, b, c, (g * 8 + 4 + ((tid & 127) >> 6)) * 64 + (tid & 63), tid);
            { const int hl = 4 * hb + 2 + ((tid & 127) >> 6); mstage_T_store<true>(ra, (g * 8 + hl) * 64 + (tid & 63), XT + 128 * LSTR, SCL + hl * 128, convw, convb, tid); }
            __syncthreads();
            const int hh = w >> 1, ph = w & 1;
            f32x4 acc[2][8];
#pragma unroll
            for (int a = 0; a < 2; ++a)
#pragma unroll
                for (int n = 0; n < 8; ++n) acc[a][n] = (f32x4){0.f, 0.f, 0.f, 0.f};
#pragma unroll
            for (int ks = 0; ks < 4; ++ks) {
                bf16x8 xa[2];
#pragma unroll
                for (int a = 0; a < 2; ++a) xa[a] = *(const LAS bf16x8*)(XT + (hh * 64 + 32 * ph + 16 * a + r16) * LSTR + 32 * ks + 8 * q);
#pragma unroll
                for (int n = 0; n < 8; ++n) { const bf16x8 bfr = *(const LAS bf16x8*)(BT + (16 * n + r16) * LSTR + 32 * ks + 8 * q);
#pragma unroll
                    for (int a = 0; a < 2; ++a) acc[a][n] = __builtin_amdgcn_mfma_f32_16x16x32_bf16(bfr, xa[a], acc[a][n], 0, 0, 0); }
            }
            bf16* st = ST + ((size_t)((b * MC_NC + c) * 16 + g * 8 + 4 * hb + hh)) * (64 * 128);
#pragma unroll
            for (int a = 0; a < 2; ++a)
#pragma unroll
                for (int n = 0; n < 8; ++n) { v2u o; o.x = pk2(acc[a][n][0], acc[a][n][1]); o.y = pk2(acc[a][n][2], acc[a][n][3]);
                    *(v2u*)(st + (32 * ph + 16 * a + r16) * 128 + 16 * n + 4 * q) = o; }
            __syncthreads();
        }
    }
}

__device__ __forceinline__ void m2_prefix(const Ctx& F) {
    const bf16* ST = (const bf16*)(F.ws + WS_ST); bf16* SIN = (bf16*)(F.ws + WS_SIN); const float* ATOT = (const float*)(F.ws + WS_ATOT);
    const int nthr = F.G * NTHR;
    for (int gi = blockIdx.x * NTHR + F.tid; gi < NB * 16 * 2048; gi += nthr) {
        const int e4 = gi & 2047, bh = gi >> 11, b = bh >> 4, h = bh & 15;
        float r0 = 0.f, r1 = 0.f, r2 = 0.f, r3 = 0.f;
#pragma unroll 4
        for (int c = 0; c < MC_NC; ++c) {
            const size_t o = ((size_t)((b * MC_NC + c) * 16 + h)) * 8192 + 4 * e4;
            v2u so; so.x = pk2(r0, r1); so.y = pk2(r2, r3);
            *(v2u*)(SIN + o) = so;
            const v2u sv = *(const v2u*)(ST + o); const float d = __expf(ATOT[(b * MC_NC + c) * 16 + h]);
            r0 = r0 * d + bflo(sv.x); r1 = r1 * d + bfhi(sv.x); r2 = r2 * d + bflo(sv.y); r3 = r3 * d + bfhi(sv.y);
        }
    }
}

__device__ __forceinline__ void m3_outputs(const Ctx& F) {
    const bf16* PROJ = (const bf16*)(F.ws + WS_PROJ); const bf16* SIN = (const bf16*)(F.ws + WS_SIN); bf16* OY = (bf16*)(F.ws + WS_OY);
    LAS bf16* Cn = (LAS bf16*)F.lds; LAS bf16* RB = (LAS bf16*)(F.lds + MT_BYTES);
    LAS bf16* Mw = (LAS bf16*)(F.lds + 2 * MT_BYTES) + F.wave * 16 * LSTR;
    LAS float* DT = (LAS float*)(F.lds + 3 * MT_BYTES); LAS float* ACS = DT + 8 * 128;
    const float* convw = F.in[I_CONVW]; const float* convb = F.in[I_CONVB];
    const int tid = F.tid, w = F.wave, lane = F.lane, r16 = lane & 15, q = lane >> 4;
    for (int it = blockIdx.x; it < NB * MC_NC * 2; it += F.G) {
        const int g = it & 1, c = (it >> 1) & (MC_NC - 1), b = it >> 7;
        __syncthreads();
        (void)mamba_dt_scan(F, PROJ, b, c, g, DT, ACS);
        mstage_N(PROJ, b, c, g, RB, Cn, convw, convb, tid);
        __syncthreads();
        TRaw rx;
        mstage_T_load(rx, PROJ, b, c, (g * 8 + ((tid & 127) >> 6)) * 64 + (tid & 63), tid);
        bf16x8 cf[4];
#pragma unroll
        for (int ks = 0; ks < 4; ++ks) cf[ks] = *(const LAS bf16x8*)(Cn + (16 * w + r16) * LSTR + 32 * ks + 8 * q);
        f32x4 Gt[8];
#pragma unroll
        for (int nt = 0; nt < 8; ++nt) { Gt[nt] = (f32x4){0.f, 0.f, 0.f, 0.f};
#pragma unroll
            for (int ks = 0; ks < 4; ++ks) Gt[nt] = __builtin_amdgcn_mfma_f32_16x16x32_bf16(*(const LAS bf16x8*)(RB + (16 * nt + r16) * LSTR + 32 * ks + 8 * q), cf[ks], Gt[nt], 0, 0, 0); }
        const int l = 16 * w + r16;
        const size_t mrow = (size_t)(b * SEQ + c * MC_L + l);
#pragma unroll 1
        for (int hb = 0; hb < 4; ++hb) {
            __syncthreads();
            { const int hl = 2 * hb + ((tid & 127) >> 6); mstage_T_store<false>(rx, (g * 8 + hl) * 64 + (tid & 63), RB, nullptr, convw, convb, tid); }
            { const int hn = (hb < 3) ? 2 * (hb + 1) : 2 * hb; mstage_T_load(rx, PROJ, b, c, (g * 8 + hn + ((tid & 127) >> 6)) * 64 + (tid & 63), tid); }
            __syncthreads();
#pragma unroll 1
            for (int h2 = 0; h2 < 2; ++h2) {
                const int hl = 2 * hb + h2, head = g * 8 + hl;
                const float acs_l = ACS[hl * 128 + l];
                const bf16* sin = SIN + ((size_t)((b * MC_NC + c) * 16 + head)) * 8192;
                bf16x8 sf[4][4];
#pragma unroll
                for (int pt = 0; pt < 4; ++pt)
#pragma unroll
                    for (int ks = 0; ks < 4; ++ks) sf[pt][ks] = *(const bf16x8*)(sin + (16 * pt + r16) * 128 + 32 * ks + 8 * q);
#pragma unroll
                for (int nt = 0; nt < 8; ++nt) { const f32x4 as = *(const LAS f32x4*)(ACS + hl * 128 + 16 * nt + 4 * q), ds = *(const LAS f32x4*)(DT + hl * 128 + 16 * nt + 4 * q);
                    float mv[4];
#pragma unroll
                    for (int j = 0; j < 4; ++j) { const int s = 16 * nt + 4 * q + j; mv[j] = (s <= l) ? Gt[nt][j] * __expf(acs_l - as[j]) * ds[j] : 0.f; }
                    v2u o; o.x = pk2(mv[0], mv[1]); o.y = pk2(mv[2], mv[3]);
                    *(LAS v2u*)(Mw + r16 * LSTR + 16 * nt + 4 * q) = o; }
                LDS_WAIT(); asm volatile("" ::: "memory");
                bf16x8 mf[4];
#pragma unroll
                for (int ks = 0; ks < 4; ++ks) mf[ks] = *(const LAS bf16x8*)(Mw + r16 * LSTR + 32 * ks + 8 * q);
                const float el = __expf(acs_l), Dh = F.in[I_DSK][head];
#pragma unroll
                for (int pt = 0; pt < 4; ++pt) {
                    f32x4 yd = {0.f, 0.f, 0.f, 0.f}, yo = {0.f, 0.f, 0.f, 0.f};
#pragma unroll
                    for (int ks = 0; ks < 4; ++ks) {
                        yd = __builtin_amdgcn_mfma_f32_16x16x32_bf16(*(const LAS bf16x8*)(RB + (h2 * 64 + 16 * pt + r16) * LSTR + 32 * ks + 8 * q), mf[ks], yd, 0, 0, 0);
                        yo = __builtin_amdgcn_mfma_f32_16x16x32_bf16(sf[pt][ks], cf[ks], yo, 0, 0, 0); }
                    float yv[4];
#pragma unroll
                    for (int j = 0; j < 4; ++j) yv[j] = yd[j] + el * yo[j] + Dh * bf1(RB[(h2 * 64 + 16 * pt + 4 * q + j) * LSTR + l]);
                    v2u o; o.x = pk2(yv[0], yv[1]); o.y = pk2(yv[2], yv[3]);
                    *(v2u*)(OY + mrow * DM + RW + head * 64 + 16 * pt + 4 * q) = o;
                }
                asm volatile("" ::: "memory");
            }
        }
    }
}
constexpr int RC = 16, RNCH = SEQ / RC, NPART = 4, RHALF = RNCH / NPART, RITEMS = NB * RHEADS * RHALF;
constexpr size_t RO_WH = 0, RO_RH = 16 * MiB, RO_VT = 32 * MiB, RO_ET = 48 * MiB, RO_OL = 64 * MiB, RO_A2 = 80 * MiB, RO_GC = 112 * MiB, RO_BUF = 116 * MiB, RO_SS = 232 * MiB;
constexpr int RL_KAP = 0, RL_ALP = 2304, RL_KT = 4608, RL_RT = 6912, RL_KAPT = 9216, RL_VT = 11264, RL_TB = 13312, RL_BL = 14336, RL_QL = 15360, RL_PL = 16384,
              RL_WT = RL_KAP, RL_BVT = RL_ALP, RL_AL32 = RL_KT, RL_ET = RL_KT,
              RL_BYTES = 18176;
constexpr int XS = 72, TS = 16, SS16 = 32;

__device__ __forceinline__ float wave_sum_pl(float x) {
    x = rowsum16(x);
    { auto rr = __builtin_amdgcn_permlane16_swap(__float_as_uint(x), __float_as_uint(x), false, false); x = __uint_as_float(rr[0]) + __uint_as_float(rr[1]); }
    { auto rr = __builtin_amdgcn_permlane32_swap(__float_as_uint(x), __float_as_uint(x), false, false); x = __uint_as_float(rr[0]) + __uint_as_float(rr[1]); }
    return x;
}
__device__ __forceinline__ v2u pack4(const f32x4 a) { v2u o; o.x = pk2(a[0], a[1]); o.y = pk2(a[2], a[3]); return o; }
__device__ __forceinline__ f32x4 unpack4(const v2u u) { return (f32x4){bflo(u.x), bfhi(u.x), bflo(u.y), bfhi(u.y)}; }
__device__ __forceinline__ bf16 f2b(float x) { return (bf16)pk2(x, 0.f); }

__device__ __forceinline__ void ra_item(const Ctx& F, LAS unsigned char* wl, int it, int half) {
    const int bh = it / RHALF, cl = it - bh * RHALF, ci = half * RHALF + cl, b = bh >> 4, h = bh & 15;
    const bf16* PROJ = (const bf16*)(F.ws + WS_PROJ); const bf16* LW = (const bf16*)(F.ws + WS_LW); const bf16* AA = (const bf16*)(F.ws + WS_AA);
    unsigned char* RO = (unsigned char*)F.out + (size_t)(half & 1) * RO_BUF;
    const int lane = F.lane, r16 = lane & 15, q = lane >> 4, c = lane, ch = h * 64 + c;
    const size_t m0 = (size_t)b * SEQ + (size_t)RC * ci;
    LAS bf16* KAP = (LAS bf16*)(wl + RL_KAP); LAS bf16* ALP = (LAS bf16*)(wl + RL_ALP); LAS bf16* KT = (LAS bf16*)(wl + RL_KT); LAS bf16* RT = (LAS bf16*)(wl + RL_RT);
    LAS bf16* KAPT = (LAS bf16*)(wl + RL_KAPT); LAS bf16* VTL = (LAS bf16*)(wl + RL_VT); LAS bf16* WT = (LAS bf16*)(wl + RL_WT); LAS bf16* BVT = (LAS bf16*)(wl + RL_BVT); LAS bf16* ETL = (LAS bf16*)(wl + RL_ET);
    LAS bf16* TB = (LAS bf16*)(wl + RL_TB); LAS bf16* BL = (LAS bf16*)(wl + RL_BL); LAS bf16* QL = (LAS bf16*)(wl + RL_QL); LAS bf16* PL = (LAS bf16*)(wl + RL_PL);
    const float mu_r = F.in[I_MU][C_R + ch], mu_k = F.in[I_MU][C_K + ch], mu_v = F.in[I_MU][C_V + ch], kkw = F.in[I_KK][ch], kaw = F.in[I_KA][ch];
    const bf16* prow = PROJ + m0 * INPP + ch;
    float rp = 0.f, kp = 0.f, vp = 0.f;
    if (ci > 0) { rp = bf1(prow[-INPP + C_R]); kp = bf1(prow[-INPP + C_K]); vp = bf1(prow[-INPP + C_V]); }
    float ec = 1.f, kkna[RC], kpv[RC], env[RC], vvv[RC];
    float cum = 0.f;
#pragma unroll
    for (int t = 0; t < RC; ++t) {
        const bf16* row = prow + (size_t)t * INPP;
        const float rc = bf1(row[C_R]), kc = bf1(row[C_K]), vc = bf1(row[C_V]);
        const float a = bf1(AA[(m0 + t) * RW + ch]), lw = bf1(LW[(m0 + t) * RW + ch]);
        const float rr = rc + (rp - rc) * mu_r, kx = kc + (kp - kc) * mu_k, vv = vc + (vp - vc) * mu_v;
        rp = rc; kp = kc; vp = vc;
        const float kkraw = kx * kkw; const float ss = wave_sum_pl(kkraw * kkraw);
        const float kkn = kkraw * rcp_f(fmaxf(sqrtf(ss), 1e-12f));
        const float kpp = kx * (1.f + (a - 1.f) * kaw);
        const float ep = ec; cum += lw; ec = __expf(cum); const float en = rcp_f(ec);
        const unsigned p0 = pk2(kkn * ep, kkn * a * en), p1 = pk2(kpp * en, rr * ec), p2 = pk2(vv, 0.f);
        KAP[t * XS + c] = (bf16)p0; ALP[t * XS + c] = (bf16)(p0 >> 16); KT[t * XS + c] = (bf16)p1; RT[t * XS + c] = (bf16)(p1 >> 16);
        KAPT[c * TS + t] = (bf16)p0; VTL[c * TS + t] = (bf16)p2;
        kkna[t] = kkn * a; kpv[t] = kpp; env[t] = en; vvv[t] = vv;
    }
    {
        float e8[8]; v4u* vt = (v4u*)((bf16*)(RO + RO_VT) + (size_t)it * 1024 + c * 16);
#pragma unroll
        for (int i = 0; i < 8; ++i) e8[i] = vvv[i];
        vt[0] = pack8(e8);
#pragma unroll
        for (int i = 0; i < 8; ++i) e8[i] = vvv[8 + i];
        vt[1] = pack8(e8);
        v4u* a2 = (v4u*)((bf16*)(RO + RO_A2) + (size_t)it * 2048 + c * 32);
        float dd[RC];
#pragma unroll
        for (int t = 0; t < RC; ++t) dd[t] = ec * env[t];
#pragma unroll
        for (int i = 0; i < 8; ++i) e8[i] = -kkna[i] * dd[i];
        a2[0] = pack8(e8);
#pragma unroll
        for (int i = 0; i < 8; ++i) e8[i] = -kkna[8 + i] * dd[8 + i];
        a2[1] = pack8(e8);
#pragma unroll
        for (int i = 0; i < 8; ++i) e8[i] = kpv[i] * dd[i];
        a2[2] = pack8(e8);
#pragma unroll
        for (int i = 0; i < 8; ++i) e8[i] = kpv[8 + i] * dd[8 + i];
        a2[3] = pack8(e8);
        ((float*)(RO + RO_GC))[(size_t)it * 64 + c] = ec;
    }
    LDS_WAIT(); asm volatile("" ::: "memory");
    const v2u zero2 = {0u, 0u};
    {
        f32x4 alt = {0.f, 0.f, 0.f, 0.f}, blt = alt, qlt = alt, plt = alt;
#pragma unroll
        for (int ks = 0; ks < 2; ++ks) {
            const bf16x8 fa = *(const LAS bf16x8*)(ALP + r16 * XS + 32 * ks + 8 * q), fk = *(const LAS bf16x8*)(KT + r16 * XS + 32 * ks + 8 * q);
            const bf16x8 fkp = *(const LAS bf16x8*)(KAP + r16 * XS + 32 * ks + 8 * q), fr = *(const LAS bf16x8*)(RT + r16 * XS + 32 * ks + 8 * q);
            alt = __builtin_amdgcn_mfma_f32_16x16x32_bf16(fa, fkp, alt, 0, 0, 0); blt = __builtin_amdgcn_mfma_f32_16x16x32_bf16(fk, fkp, blt, 0, 0, 0);
            qlt = __builtin_amdgcn_mfma_f32_16x16x32_bf16(fa, fr, qlt, 0, 0, 0);  plt = __builtin_amdgcn_mfma_f32_16x16x32_bf16(fk, fr, plt, 0, 0, 0);
        }
#pragma unroll
        for (int j = 0; j < 4; ++j) { const int s = 4 * q + j; const bool lt = s < r16, le = s <= r16;
            alt[j] = lt ? alt[j] : 0.f; blt[j] = lt ? blt[j] : 0.f; qlt[j] = le ? qlt[j] : 0.f; plt[j] = le ? plt[j] : 0.f; }
        *(LAS v2u*)(BL + r16 * SS16 + 4 * q) = pack4(blt); *(LAS v2u*)(QL + r16 * SS16 + 4 * q) = pack4(qlt); *(LAS v2u*)(PL + r16 * SS16 + 4 * q) = pack4(plt);
        *(LAS v2u*)(BL + r16 * SS16 + 16 + 4 * q) = zero2; *(LAS v2u*)(QL + r16 * SS16 + 16 + 4 * q) = zero2; *(LAS v2u*)(PL + r16 * SS16 + 16 + 4 * q) = zero2;
        float x[RC];
#pragma unroll
        for (int t = 0; t < RC; ++t) {
            float acc = (t == r16) ? 1.f : 0.f;
#pragma unroll
            for (int s2 = 0; s2 < t; ++s2) { const float a_ts = __uint_as_float(__builtin_amdgcn_readlane(__float_as_uint(alt[s2 & 3]), 16 * (s2 >> 2) + t)); acc -= a_ts * x[s2]; }
            x[t] = acc;
        }
        if (q == 0) {
#pragma unroll
            for (int t = 0; t < RC; ++t) { TB[t * SS16 + r16] = f2b(x[t]); TB[t * SS16 + 16 + r16] = 0; }
        }
    }
    LDS_WAIT(); asm volatile("" ::: "memory");
    const bf16x8 zf = {0, 0, 0, 0, 0, 0, 0, 0};
    const bf16x8 tbf = *(const LAS bf16x8*)(TB + r16 * SS16 + 8 * q), blf = *(const LAS bf16x8*)(BL + r16 * SS16 + 8 * q);
    const bf16x8 qlf = *(const LAS bf16x8*)(QL + r16 * SS16 + 8 * q), plf = *(const LAS bf16x8*)(PL + r16 * SS16 + 8 * q);
    const f32x4 z4 = {0.f, 0.f, 0.f, 0.f};
    bf16* gWH = (bf16*)(RO + RO_WH) + (size_t)it * 1024; bf16* gRH = (bf16*)(RO + RO_RH) + (size_t)it * 1024;
    bf16* gET = (bf16*)(RO + RO_ET) + (size_t)it * 1024; bf16* gOL = (bf16*)(RO + RO_OL) + (size_t)it * 1024;
#pragma unroll
    for (int kt = 0; kt < 4; ++kt) {
        const bf16x8 kf = (q < 2) ? *(const LAS bf16x8*)(KAPT + (16 * kt + r16) * TS + 8 * q) : zf;
        const f32x4 wa = __builtin_amdgcn_mfma_f32_16x16x32_bf16(kf, tbf, z4, 0, 0, 0);
        *(v2u*)(gWH + r16 * 64 + 16 * kt + 4 * q) = pack4(wa);
        const f32x4 wb = __builtin_amdgcn_mfma_f32_16x16x32_bf16(tbf, kf, z4, 0, 0, 0);
        *(LAS v2u*)(WT + (16 * kt + r16) * TS + 4 * q) = pack4(wb);
        const bf16x8 vf = (q < 2) ? *(const LAS bf16x8*)(VTL + (16 * kt + r16) * TS + 8 * q) : zf;
        const f32x4 bv = __builtin_amdgcn_mfma_f32_16x16x32_bf16(blf, vf, z4, 0, 0, 0);
        *(LAS v2u*)(BVT + (16 * kt + r16) * TS + 4 * q) = pack4(bv);
    }
    LDS_WAIT(); asm volatile("" ::: "memory");
#pragma unroll
    for (int vt = 0; vt < 4; ++vt) {
        const bf16x8 bf_ = (q < 2) ? *(const LAS bf16x8*)(BVT + (16 * vt + r16) * TS + 8 * q) : zf;
        const f32x4 e4 = __builtin_amdgcn_mfma_f32_16x16x32_bf16(tbf, bf_, z4, 0, 0, 0);
        const v2u ep = pack4(e4);
        *(LAS v2u*)(ETL + (16 * vt + r16) * TS + 4 * q) = ep; *(v2u*)(gET + (16 * vt + r16) * 16 + 4 * q) = ep;
    }
    LDS_WAIT(); asm volatile("" ::: "memory");
#pragma unroll
    for (int kt = 0; kt < 4; ++kt) {
        const bf16x8 wf = (q < 2) ? *(const LAS bf16x8*)(WT + (16 * kt + r16) * TS + 8 * q) : zf;
        const f32x4 qw = __builtin_amdgcn_mfma_f32_16x16x32_bf16(wf, qlf, z4, 0, 0, 0);
        const f32x4 rt4 = unpack4(*(const LAS v2u*)(RT + r16 * XS + 16 * kt + 4 * q));
        *(v2u*)(gRH + r16 * 64 + 16 * kt + 4 * q) = pack4(rt4 - qw);
        const bf16x8 vf = (q < 2) ? *(const LAS bf16x8*)(VTL + (16 * kt + r16) * TS + 8 * q) : zf;
        const bf16x8 ef = (q < 2) ? *(const LAS bf16x8*)(ETL + (16 * kt + r16) * TS + 8 * q) : zf;
        const f32x4 pv = __builtin_amdgcn_mfma_f32_16x16x32_bf16(vf, plf, z4, 0, 0, 0);
        const f32x4 qe = __builtin_amdgcn_mfma_f32_16x16x32_bf16(ef, qlf, z4, 0, 0, 0);
        *(v2u*)(gOL + r16 * 64 + 16 * kt + 4 * q) = pack4(pv - qe);
    }
    LDS_WAIT(); asm volatile("" ::: "memory");
}
__device__ __forceinline__ void ra_part(const Ctx& F, int part) {
    LAS unsigned* ctr = (LAS unsigned*)(F.lds + LDS_BYTES - 48) + part;
    LAS unsigned char* wl = F.lds + F.wave * RL_BYTES;
    for (;;) {
        unsigned idx = 0;
        if (F.lane == 0) idx = __hip_atomic_fetch_add(ctr, 1u, __ATOMIC_RELAXED, __HIP_MEMORY_SCOPE_WORKGROUP);
        idx = (unsigned)__builtin_amdgcn_readfirstlane((int)idx);
        const int it = (int)blockIdx.x + F.G * (int)idx;
        if (it >= RITEMS) break;
        ra_item(F, wl, it, part);
    }
}

__device__ __forceinline__ void rs_half(const Ctx& F, int half) {
    if (F.wave != 0) return;
    const unsigned char* RO = (const unsigned char*)F.out + (size_t)(half & 1) * RO_BUF; bf16* OY = (bf16*)(F.ws + WS_OY);
    float* SSg = (float*)((unsigned char*)F.out + RO_SS);
    LAS bf16* ST = (LAS bf16*)F.lds;
    LAS bf16* ZT = (LAS bf16*)(F.lds + 16 * XS * 2);
    constexpr int ZS = 24;
    const int lane = F.lane, r16 = lane & 15, q = lane >> 4;
    for (int blk = blockIdx.x; blk < NB * RHEADS * 4; blk += F.G) {
        const int xcd = blk & 7, jj = blk >> 3, qt = jj & 3, bh = (jj >> 2) * 8 + xcd, b = bh >> 4, h = bh & 15;
        f32x4 S[4];
        if (half == 0) {
#pragma unroll
            for (int kt = 0; kt < 4; ++kt) S[kt] = (f32x4){0.f, 0.f, 0.f, 0.f};
        } else {
#pragma unroll
            for (int kt = 0; kt < 4; ++kt) S[kt] = *(const f32x4*)(SSg + (size_t)blk * 1024 + (kt * 64 + lane) * 4);
        }
#pragma unroll
        for (int kt = 0; kt < 4; ++kt) *(LAS v2u*)(ST + r16 * XS + 16 * kt + 4 * q) = pack4(S[kt]);
        LDS_WAIT(); asm volatile("" ::: "memory");
        const size_t it0 = (size_t)bh * RHALF;
        const size_t mbase = (size_t)b * SEQ + (size_t)half * RHALF * RC;
#define RS_LOAD(IT, WF, RF, A2F, VF, ET4, OL4, GC4) do { const size_t it_ = (IT); \
        const bf16* wh_ = (const bf16*)(RO + RO_WH) + it_ * 1024 + r16 * 64 + 8 * q; const bf16* rh_ = (const bf16*)(RO + RO_RH) + it_ * 1024 + r16 * 64 + 8 * q; \
        WF[0] = *(const bf16x8*)wh_; WF[1] = *(const bf16x8*)(wh_ + 32); RF[0] = *(const bf16x8*)rh_; RF[1] = *(const bf16x8*)(rh_ + 32); \
        _Pragma("unroll") for (int kt_ = 0; kt_ < 4; ++kt_) { A2F[kt_] = *(const bf16x8*)((const bf16*)(RO + RO_A2) + it_ * 2048 + (16 * kt_ + r16) * 32 + 8 * q); \
            GC4[kt_] = *(const f32x4*)((const float*)(RO + RO_GC) + it_ * 64 + 16 * kt_ + 4 * q); } \
        VF = *(const bf16x8*)((const bf16*)(RO + RO_VT) + it_ * 1024 + (16 * qt + r16) * 16 + 8 * (q & 1)); \
        ET4 = *(const v2u*)((const bf16*)(RO + RO_ET) + it_ * 1024 + (16 * qt + r16) * 16 + 4 * q); \
        OL4 = *(const v2u*)((const bf16*)(RO + RO_OL) + it_ * 1024 + r16 * 64 + 16 * qt + 4 * q); } while (0)
        bf16x8 wfq[2][2], rfq[2][2], a2q[2][4], vfq[2]; v2u etq[2], olq[2]; f32x4 gcq[2][4];
#pragma unroll
        for (int u = 0; u < 2; ++u) RS_LOAD(it0 + u, wfq[u], rfq[u], a2q[u], vfq[u], etq[u], olq[u], gcq[u]);
#define RS_STEP(U, CL) do { const int cl_ = (CL); \
            const bf16x8 sb0 = *(const LAS bf16x8*)(ST + r16 * XS + 8 * q), sb1 = *(const LAS bf16x8*)(ST + r16 * XS + 32 + 8 * q); \
            f32x4 x1 = __builtin_amdgcn_mfma_f32_16x16x32_bf16(wfq[U][0], sb0, (f32x4){0.f, 0.f, 0.f, 0.f}, 0, 0, 0); \
            x1 = __builtin_amdgcn_mfma_f32_16x16x32_bf16(wfq[U][1], sb1, x1, 0, 0, 0); \
            f32x4 ot = __builtin_amdgcn_mfma_f32_16x16x32_bf16(sb0, rfq[U][0], unpack4(olq[U]), 0, 0, 0); \
            ot = __builtin_amdgcn_mfma_f32_16x16x32_bf16(sb1, rfq[U][1], ot, 0, 0, 0); \
            *(LAS v2u*)(ZT + r16 * ZS + 4 * q) = pack4(x1 + unpack4(etq[U])); \
            *(v2u*)(OY + (mbase + (size_t)cl_ * RC + r16) * DM + h * 64 + 16 * qt + 4 * q) = pack4(ot); \
            LDS_WAIT(); asm volatile("" ::: "memory"); \
            const bf16x8 zr = *(const LAS bf16x8*)(ZT + r16 * ZS + 8 * (q & 1)); \
            const bf16x8 bz = (q < 2) ? zr : vfq[U]; \
            _Pragma("unroll") for (int kt = 0; kt < 4; ++kt) { S[kt] = __builtin_amdgcn_mfma_f32_16x16x32_bf16(a2q[U][kt], bz, S[kt] * gcq[U][kt], 0, 0, 0); \
                *(LAS v2u*)(ST + r16 * XS + 16 * kt + 4 * q) = pack4(S[kt]); } \
            RS_LOAD(it0 + ((cl_ + 2 < RHALF) ? cl_ + 2 : RHALF - 1), wfq[U], rfq[U], a2q[U], vfq[U], etq[U], olq[U], gcq[U]);     \
            LDS_WAIT(); asm volatile("" ::: "memory"); } while (0)
#pragma unroll 1
        for (int cl = 0; cl < RHALF; cl += 2) { RS_STEP(0, cl); RS_STEP(1, cl + 1); }
#undef RS_STEP
#undef RS_LOAD
        if (half + 1 < NPART) {
#pragma unroll
            for (int kt = 0; kt < 4; ++kt) *(f32x4*)(SSg + (size_t)blk * 1024 + (kt * 64 + lane) * 4) = S[kt];
        }
    }
}
__device__ __forceinline__ float rowmax16(float x) { x = fmaxf(x, dpp_f<0xB1>(x)); x = fmaxf(x, dpp_f<0x4E>(x)); x = fmaxf(x, dpp_f<0x124>(x)); x = fmaxf(x, dpp_f<0x128>(x)); return x; }
__device__ __forceinline__ int cand_code(int s) {
    if (s < 16) return s << 4;
    if (s < 24) return 1 | ((s - 16) << 4);
    if (s < 29) return 2 | ((s - 24) << 4);
    if (s < 33) return 3 | ((s - 29) << 4);
    if (s < 36) return 4 | ((s - 33) << 4);
    if (s < 42) { const int k = s - 36; return (5 + (k >> 1)) | ((k & 1) << 4); }
    if (s < 50) return 8 + (s - 42);
    return -1;
}
__device__ __forceinline__ int f2ord(float f) { const int b = __float_as_int(f); return b ^ ((b >> 31) & 0x7fffffff); }
__device__ __forceinline__ float ord2f(int k) { return __int_as_float(k ^ ((k >> 31) & 0x7fffffff)); }
template <int CTRL> __device__ __forceinline__ int dpp_i(int x) { return __builtin_amdgcn_mov_dpp(x, CTRL, 0xf, 0xf, true); }
__device__ __forceinline__ int imax(int a, int b) { return a > b ? a : b; }
__device__ __forceinline__ int imin(int a, int b) { return a < b ? a : b; }
__device__ __forceinline__ int rowmax16_i(int x) { x = imax(x, dpp_i<0xB1>(x)); x = imax(x, dpp_i<0x4E>(x)); x = imax(x, dpp_i<0x124>(x)); x = imax(x, dpp_i<0x128>(x)); return x; }
#define CSWAP_(a, b) do { const int hi_ = imax(a, b), lo_ = imin(a, b); a = hi_; b = lo_; } while (0)
template <int NV> __device__ __forceinline__ void sort_desc(int (&v)[NV]);
template <> __device__ __forceinline__ void sort_desc<8>(int (&v)[8]) {
    CSWAP_(v[0], v[1]); CSWAP_(v[2], v[3]); CSWAP_(v[4], v[5]); CSWAP_(v[6], v[7]);
    CSWAP_(v[0], v[2]); CSWAP_(v[1], v[3]); CSWAP_(v[4], v[6]); CSWAP_(v[5], v[7]);
    CSWAP_(v[1], v[2]); CSWAP_(v[5], v[6]);
    CSWAP_(v[0], v[4]); CSWAP_(v[1], v[5]); CSWAP_(v[2], v[6]); CSWAP_(v[3], v[7]);
    CSWAP_(v[2], v[4]); CSWAP_(v[3], v[5]);
    CSWAP_(v[1], v[2]); CSWAP_(v[3], v[4]); CSWAP_(v[5], v[6]);
}
template <> __device__ __forceinline__ void sort_desc<4>(int (&v)[4]) {
    CSWAP_(v[0], v[1]); CSWAP_(v[2], v[3]); CSWAP_(v[0], v[2]); CSWAP_(v[1], v[3]); CSWAP_(v[1], v[2]);
}
template <int NV>
__device__ __forceinline__ void select16x4(int (&v)[4][NV], int r16, float (&kept_f)[4]) {
    const int IMIN = (int)0x80000000;
    int kept[4];
#pragma unroll
    for (int j = 0; j < 4; ++j) { kept[j] = IMIN; sort_desc<NV>(v[j]); }
#pragma unroll 1
    for (int rd = 0; rd < 16; ++rd) {
#pragma unroll
        for (int j = 0; j < 4; ++j) {
            const int m = rowmax16_i(v[j][0]);
            kept[j] = (r16 == rd) ? m : kept[j];
            const bool own = (v[j][0] == m);
#pragma unroll
            for (int i = 0; i < NV - 1; ++i) v[j][i] = own ? v[j][i + 1] : v[j][i];
            v[j][NV - 1] = own ? IMIN : v[j][NV - 1];
        }
    }
#pragma unroll
    for (int j = 0; j < 4; ++j) kept_f[j] = ord2f(kept[j]);
}
__device__ __forceinline__ float dot2bf(unsigned a, unsigned b, float acc) { return __builtin_amdgcn_fdot2_f32_bf16(__builtin_bit_cast(bf16x2_t, a), __builtin_bit_cast(bf16x2_t, b), acc, false); }

constexpr int PT = 16;
constexpr size_t RANGE_BYTES = (size_t)NEXP * 128;

__device__ __forceinline__ void p9_route(const Ctx& F) {
    constexpr int KSTR = 136;
    const bf16* Q = (const bf16*)(F.ws + WS_Q); const bf16* KEYS = (const bf16*)(F.ws + WS_KEYS);
    int* rtE = (int*)(F.ws + WS_RTE); float* rtG = (float*)(F.ws + WS_RTG);
    LAS bf16* KL = (LAS bf16*)F.lds;
    const int lane = F.lane, w = F.wave, r16 = lane & 15, q = lane >> 4, gbase = lane & 48;
    const int h = blockIdx.x & 7, nbh = (F.G - h + 7) >> 3;
    __syncthreads();
    for (int i = F.tid; i < 2 * 128 * 16; i += NTHR) { const int row = i >> 4, ch = i & 15;
        *(LAS v4u*)(KL + row * KSTR + 8 * ch) = *(const v4u*)(KEYS + (size_t)(2 * h * 128 + row) * 128 + 8 * ch); }
    __syncthreads();
    int ci[4], cj[4]; bool cvalid[4];
#pragma unroll
    for (int u = 0; u < 4; ++u) { const int cd = cand_code(r16 + 16 * u); cvalid[u] = cd >= 0; ci[u] = cd & 15; cj[u] = (cd >> 4) & 15; }
    const float NINF = -__builtin_inff();
    const int tstride = nbh * NWAVES;
    int tile = (blockIdx.x >> 3) * NWAVES + w;
    bf16x8 afn[2][4];
    if (tile < M / PT) {
#pragma unroll
        for (int p = 0; p < 2; ++p)
#pragma unroll
            for (int s = 0; s < 4; ++s) afn[p][s] = *(const bf16x8*)(Q + (size_t)(tile * PT + r16) * DM + (2 * h + p) * 128 + 8 * q + 32 * s);
    }
    for (; tile < M / PT; tile += tstride) {
        const int m0 = tile * PT;
        bf16x8 af[2][4];
#pragma unroll
        for (int p = 0; p < 2; ++p)
#pragma unroll
            for (int s = 0; s < 4; ++s) af[p][s] = afn[p][s];
        { const int tn = (tile + tstride < M / PT) ? tile + tstride : tile;
#pragma unroll
            for (int p = 0; p < 2; ++p)
#pragma unroll
                for (int s = 0; s < 4; ++s) afn[p][s] = *(const bf16x8*)(Q + (size_t)(tn * PT + r16) * DM + (2 * h + p) * 128 + 8 * q + 32 * s);
        }
        float top[2][4];
#pragma unroll
        for (int p = 0; p < 2; ++p) {
            int v[4][8];
#pragma unroll
            for (int nt = 0; nt < 8; ++nt) {
                const LAS bf16* krow = KL + (p * 128 + nt * 16 + r16) * KSTR + 8 * q;
                f32x4 acc = {0.f, 0.f, 0.f, 0.f};
#pragma unroll
                for (int s = 0; s < 4; ++s) acc = __builtin_amdgcn_mfma_f32_16x16x32_bf16(af[p][s], *(const LAS bf16x8*)(krow + 32 * s), acc, 0, 0, 0);
                const unsigned tag = 127u - (unsigned)(nt * 16 + r16);
#pragma unroll
                for (int j = 0; j < 4; ++j) v[j][nt] = f2ord(__uint_as_float((__float_as_uint(acc[j]) & ~127u) | tag));
                if (nt & 1) asm volatile("" ::: "memory");
            }
            select16x4<8>(v, r16, top[p]);
        }
        int cv[4][4];
#pragma unroll
        for (int u = 0; u < 4; ++u)
#pragma unroll
            for (int j = 0; j < 4; ++j) {
                const float a = __shfl(top[0][j], gbase + ci[u]), b = __shfl(top[1][j], gbase + cj[u]);
                const float cs = __uint_as_float(__float_as_uint(a) & ~127u) + __uint_as_float(__float_as_uint(b) & ~127u);
                const float pk = __uint_as_float((__float_as_uint(cs) & ~63u) | (63u - (unsigned)(r16 + 16 * u)));
                cv[j][u] = cvalid[u] ? f2ord(pk) : (int)0x80000000;
            }
        float best[4];
        select16x4<4>(cv, r16, best);
#pragma unroll
        for (int j = 0; j < 4; ++j) {
            const unsigned bb = __float_as_uint(best[j]);
            const int cd = cand_code(63 - (int)(bb & 63u));
            const int k0 = 127 - (int)(__float_as_uint(__shfl(top[0][j], gbase + (cd & 15))) & 127u);
            const int k1 = 127 - (int)(__float_as_uint(__shfl(top[1][j], gbase + ((cd >> 4) & 15))) & 127u);
            const float s = __uint_as_float(bb & ~63u);
            const float mx = rowmax16(s), e = __expf(s - mx), sum = rowsum16(e);
            const size_t o = (size_t)(m0 + 4 * q + j) * 128 + h * 16 + r16;
            rtE[o] = k0 * 128 + k1; rtG[o] = e * rcp_f(sum);
        }
    }
}

__device__ __forceinline__ f32x2 cvt2_fp8(unsigned wd, bool hi) { return hi ? __builtin_amdgcn_cvt_pk_f32_fp8((int)wd, true) : __builtin_amdgcn_cvt_pk_f32_fp8((int)wd, false); }
__device__ __forceinline__ void treduce8x16(const float (&p)[16], bool b0, bool b1, bool b2, float& r0, float& r1) {
    float a[8], bq[4];
#pragma unroll
    for (int i = 0; i < 8; ++i) { const float mine = b2 ? p[i + 8] : p[i], send = b2 ? p[i] : p[i + 8]; const float up = dpp_f<0x104>(send), dn = dpp_f<0x114>(send); a[i] = mine + (b2 ? dn : up); }
#pragma unroll
    for (int i = 0; i < 4; ++i) { const float mine = b1 ? a[i + 4] : a[i], send = b1 ? a[i] : a[i + 4]; bq[i] = mine + dpp_f<0x4E>(send); }
    { const float mine = b0 ? bq[2] : bq[0], send = b0 ? bq[0] : bq[2]; r0 = mine + dpp_f<0xB1>(send); }
    { const float mine = b0 ? bq[3] : bq[1], send = b0 ? bq[1] : bq[3]; r1 = mine + dpp_f<0xB1>(send); }
}
struct XGroup { int xg, gwi, stride; };
__device__ __forceinline__ XGroup xgroup(const Ctx& F) { XGroup g; g.xg = blockIdx.x & 7; const int nbg = (F.G - g.xg + 7) >> 3; g.gwi = (blockIdx.x >> 3) * NWAVES + F.wave; g.stride = nbg * NWAVES; return g; }

__device__ __forceinline__ void p10_peer_u(const Ctx& F) {
    const unsigned char* PU4 = F.ws + WS_PU8; const bf16* XN = (const bf16*)(F.ws + WS_XN);
    const int* rtE = (const int*)(F.ws + WS_RTE); unsigned* PD = (unsigned*)(F.ws + WS_PD);
    const XGroup g = xgroup(F);
    const int lane = F.lane, j = lane >> 3, sub = lane & 7;
    const bool b0 = sub & 1, b1 = sub & 2, b2 = sub & 4;
    const int r = g.xg;
    const unsigned char* tab = PU4 + (size_t)r * RANGE_BYTES;
    const unsigned so = 16u * (unsigned)sub;
    int m = g.gwi;
    if (m >= M) return;
    v4u ev[4], xs[4];
#pragma unroll
    for (int i = 0; i < 4; ++i) { ev[i] = *(const v4u*)(rtE + (size_t)m * 128 + 16 * j + 4 * i); xs[i] = *(const v4u*)(XN + (size_t)m * DM + 256 * r + 32 * sub + 8 * i); }
    for (; m < M; m += g.stride) {
        v4u gt[16];
#pragma unroll
        for (int k = 0; k < 16; ++k) gt[k] = *(const v4u*)(tab + (ev[k >> 2][k & 3] * 128u + so));
        float x[32];
#pragma unroll
        for (int i = 0; i < 4; ++i) { float t8[8]; unpack8(xs[i], t8);
#pragma unroll
            for (int u = 0; u < 8; ++u) x[8 * i + u] = t8[u]; }
        const int mn = (m + g.stride < M) ? m + g.stride : m;
#pragma unroll
        for (int i = 0; i < 4; ++i) { ev[i] = *(const v4u*)(rtE + (size_t)mn * 128 + 16 * j + 4 * i); xs[i] = *(const v4u*)(XN + (size_t)mn * DM + 256 * r + 32 * sub + 8 * i); }
        float p[16];
#pragma unroll
        for (int k = 0; k < 16; ++k) {
            f32x2 a0 = {0.f, 0.f}, a1 = {0.f, 0.f};
#pragma unroll
            for (int d = 0; d < 4; ++d) { const unsigned wd = gt[k][d];
                a0 += __builtin_amdgcn_cvt_scalef32_pk_f32_fp4(wd, 1.0f, 0) * (f32x2){x[8 * d], x[8 * d + 1]};     a1 += __builtin_amdgcn_cvt_scalef32_pk_f32_fp4(wd, 1.0f, 1) * (f32x2){x[8 * d + 2], x[8 * d + 3]};
                a0 += __builtin_amdgcn_cvt_scalef32_pk_f32_fp4(wd, 1.0f, 2) * (f32x2){x[8 * d + 4], x[8 * d + 5]}; a1 += __builtin_amdgcn_cvt_scalef32_pk_f32_fp4(wd, 1.0f, 3) * (f32x2){x[8 * d + 6], x[8 * d + 7]}; }
            const f32x2 s2 = a0 + a1; p[k] = s2.x + s2.y;
        }
        float r0, r1; treduce8x16(p, b0, b1, b2, r0, r1);
        PD[((size_t)r * M + m) * 64 + lane] = pk2(r0, r1);
    }
}

__device__ __forceinline__ void p11_peer_coef(const Ctx& F) {
    const int* rtE = (const int*)(F.ws + WS_RTE); const float* rtG = (const float*)(F.ws + WS_RTG); const unsigned* PD = (const unsigned*)(F.ws + WS_PD);
    const float* usc = (const float*)(F.ws + WS_USC); const float* vsc = (const float*)(F.ws + WS_VSC); float* COEF = (float*)(F.ws + WS_COEF);
    for (int m = F.gw; m < M; m += F.NGW) {
        const size_t o = (size_t)m * 128 + 2 * F.lane;
        f32x2 d = {0.f, 0.f};
#pragma unroll
        for (int r = 0; r < 8; ++r) { const unsigned pw = PD[((size_t)r * M + m) * 64 + F.lane]; d += (f32x2){bflo(pw), bfhi(pw)}; }
        const int e0 = rtE[o], e1 = rtE[o + 1];
        const f32x2 gt = *(const f32x2*)(rtG + o);
        const float d0 = d.x * usc[e0], d1 = d.y * usc[e1];
        f32x2 c; c.x = gt.x * (0.5f * d0 * (1.f + erff(d0 * 0.70710678f))) * vsc[e0]; c.y = gt.y * (0.5f * d1 * (1.f + erff(d1 * 0.70710678f))) * vsc[e1];
        *(f32x2*)(COEF + o) = c;
    }
}

__device__ __forceinline__ void p12_peer_v(const Ctx& F) {
    const unsigned char* PV4 = F.ws + WS_PV8; const int* rtE = (const int*)(F.ws + WS_RTE); const float* COEF = (const float*)(F.ws + WS_COEF);
    const float* mod = (const float*)(F.ws + WS_MOD);
    const XGroup g = xgroup(F);
    const int lane = F.lane, j = lane >> 3, sub = lane & 7;
    const bool jb0 = j & 1;
    const int r = g.xg;
    const unsigned char* tab = PV4 + (size_t)r * RANGE_BYTES;
    const unsigned so = 16u * (unsigned)sub;
    int m = g.gwi;
    if (m >= M) return;
    const int st = g.stride;
#define PV_LDE(e, mm, hf) { e[0] = *(const v4u*)(rtE + (size_t)(mm) * 128 + 16 * j + 8 * (hf)); e[1] = *(const v4u*)(rtE + (size_t)(mm) * 128 + 16 * j + 8 * (hf) + 4); }
#define PV_LDC(c, mm, hf) { c[0] = *(const f32x4*)(COEF + (size_t)(mm) * 128 + 16 * j + 8 * (hf)); c[1] = *(const f32x4*)(COEF + (size_t)(mm) * 128 + 16 * j + 8 * (hf) + 4); }
#define PV_GATHER(gx, e) { _Pragma("unroll") for (int k = 0; k < 8; ++k) gx[k] = *(const v4u*)(tab + (e[k >> 2][k & 3] * 128u + so)); }
#define PV_ACC(gx, c) { _Pragma("unroll") for (int k = 0; k < 8; ++k) { const float cq = c[k >> 2][k & 3]; const f32x2 cv2 = {cq, cq}; \
        _Pragma("unroll") for (int d = 0; d < 4; ++d) { const unsigned wd = gx[k][d]; \
            acc[4 * d + 0] += cv2 * __builtin_amdgcn_cvt_scalef32_pk_f32_fp4(wd, 1.0f, 0); acc[4 * d + 1] += cv2 * __builtin_amdgcn_cvt_scalef32_pk_f32_fp4(wd, 1.0f, 1); \
            acc[4 * d + 2] += cv2 * __builtin_amdgcn_cvt_scalef32_pk_f32_fp4(wd, 1.0f, 2); acc[4 * d + 3] += cv2 * __builtin_amdgcn_cvt_scalef32_pk_f32_fp4(wd, 1.0f, 3); } } }
    v4u eA1[2], eB0[2], gA[8], gB[8]; f32x4 cA0[2], cA1[2], cB0[2];
    { v4u eA0[2]; PV_LDE(eA0, m, 0); PV_LDC(cA0, m, 0); PV_LDE(eB0, m, 1); PV_LDC(cB0, m, 1);
      const int m1 = (m + st < M) ? m + st : m; PV_LDE(eA1, m1, 0); PV_LDC(cA1, m1, 0);
      PV_GATHER(gA, eA0); }
    for (; m < M; m += st) {
        const int m1 = (m + st < M) ? m + st : m, m2 = (m + 2 * st < M) ? m + 2 * st : m;
        const int col = 256 * r + 32 * sub + 4 * j;
        v2u* orow = (v2u*)((bf16*)(F.ws + WS_HB) + (size_t)m * DM + col);
        const v2u hw = *orow; const f32x4 g2 = *(const f32x4*)(mod + (size_t)(m / SEQ) * MODW + 5 * DM + col);
        PV_GATHER(gB, eB0);
        v4u eB1[2], eA2[2]; f32x4 cB1[2], cA2[2];
        PV_LDE(eB1, m1, 1); PV_LDC(cB1, m1, 1); PV_LDE(eA2, m2, 0); PV_LDC(cA2, m2, 0);
        asm volatile("" : "+v"(gA[0]), "+v"(gA[1]), "+v"(gA[2]), "+v"(gA[3]), "+v"(gA[4]), "+v"(gA[5]), "+v"(gA[6]), "+v"(gA[7]) :: "memory");
        f32x2 acc[16];
#pragma unroll
        for (int i = 0; i < 16; ++i) acc[i] = (f32x2){0.f, 0.f};
        PV_ACC(gA, cA0);
        asm volatile("" ::: "memory");
        PV_GATHER(gA, eA1);
        asm volatile("" : "+v"(gB[0]), "+v"(gB[1]), "+v"(gB[2]), "+v"(gB[3]), "+v"(gB[4]), "+v"(gB[5]), "+v"(gB[6]), "+v"(gB[7]) :: "memory");
        PV_ACC(gB, cB0);
        float a[32];
#pragma unroll
        for (int i = 0; i < 16; ++i) { a[2 * i] = acc[i].x; a[2 * i + 1] = acc[i].y; }
        float s16[16], s8[8];
#pragma unroll
        for (int c = 0; c < 16; ++c) { auto rr2 = __builtin_amdgcn_permlane32_swap(__float_as_uint(a[c]), __float_as_uint(a[c + 16]), false, false); s16[c] = __uint_as_float(rr2[0]) + __uint_as_float(rr2[1]); }
#pragma unroll
        for (int c = 0; c < 8; ++c) { auto rr2 = __builtin_amdgcn_permlane16_swap(__float_as_uint(s16[c]), __float_as_uint(s16[c + 8]), false, false); s8[c] = __uint_as_float(rr2[0]) + __uint_as_float(rr2[1]); }
        f32x4 res;
#pragma unroll
        for (int c = 0; c < 4; ++c) { const float mine = jb0 ? s8[c + 4] : s8[c], send = jb0 ? s8[c] : s8[c + 4]; res[c] = mine + dpp_f<0x128>(send); }
        const f32x4 h1 = {bflo(hw.x), bfhi(hw.x), bflo(hw.y), bfhi(hw.y)};
        const f32x4 h2 = h1 + g2 * res;
        v2u o; o.x = pk2(h2.x, h2.y); o.y = pk2(h2.z, h2.w);
        *orow = o;
#pragma unroll
        for (int i = 0; i < 2; ++i) { cA0[i] = cA1[i]; cA1[i] = cA2[i]; eA1[i] = eA2[i]; eB0[i] = eB1[i]; cB0[i] = cB1[i]; }
    }
#undef PV_LDE
#undef PV_LDC
#undef PV_GATHER
#undef PV_ACC
}
#define XB_TMO      128
#define XB_XCNT(j)  (256  + 64 * (j))
#define XB_XSUB(j)  (1280 + 64 * (j))
#define XB_XGEN(j)  (2304 + 64 * (j))
#define XB_TOP      3328
#define XB_TOPGEN   3392
#define XCD_BAR_WORDS 3456
#define XB_SPIN_CAP (1u << 18)

__device__ __forceinline__ unsigned xb_ld(unsigned* p)              { return __hip_atomic_load(p, __ATOMIC_RELAXED, __HIP_MEMORY_SCOPE_AGENT); }
__device__ __forceinline__ unsigned xb_add(unsigned* p, unsigned v) { return __hip_atomic_fetch_add(p, v, __ATOMIC_RELAXED, __HIP_MEMORY_SCOPE_AGENT); }
__device__ __forceinline__ unsigned xb_xcc_id() { return (unsigned)__builtin_amdgcn_s_getreg((3 << 11) | 20) & 0xFu; }
#define XB_SPIN(cond, bar) do { unsigned _sp = 0; while (cond) { __builtin_amdgcn_s_sleep(1); \
    if ((++_sp & 255u) == 0u) { if (xb_ld(&(bar)[XB_TMO])) break; if (_sp > XB_SPIN_CAP) { atomicAdd(&(bar)[XB_TMO], 1u); break; } } } } while (0)

struct XcdBarrier {
    unsigned* bar; unsigned x;
    volatile LAS unsigned* st;
};

__device__ __forceinline__ XcdBarrier xcd_barrier_post(unsigned* bar, volatile LAS unsigned* st) {
    XcdBarrier b; b.bar = bar; b.x = xb_xcc_id(); b.st = st;
    if (threadIdx.x == 0) (void)xb_add(&bar[XB_XCNT(b.x)], 1u);
    return b;
}
__device__ __forceinline__ void xcd_barrier_complete(unsigned* bar, unsigned x, unsigned& nloc, unsigned& nx) {
    const unsigned G = gridDim.x * gridDim.y * gridDim.z;
    unsigned sum, cnt, mine, sp = 0u;
    for (;;) {
        sum = 0u; cnt = 0u; mine = 0u;
#pragma unroll
        for (unsigned j = 0; j < 16; ++j) { const unsigned c = xb_ld(&bar[XB_XCNT(j)]); sum += c; cnt += (c > 0u) ? 1u : 0u; mine = (j == x) ? c : mine; }
        if (sum == G) break;
        __builtin_amdgcn_s_sleep(1);
        if ((++sp & 255u) == 0u) { if (xb_ld(&bar[XB_TMO])) break; if (sp > XB_SPIN_CAP) { atomicAdd(&bar[XB_TMO], 1u); break; } }
    }
    nloc = mine > 0u ? mine : 1u; nx = cnt > 0u ? cnt : 1u;
}

__device__ __forceinline__ void xcd_barrier(const XcdBarrier& b) {
    asm volatile("s_waitcnt vmcnt(0)" ::: "memory");
    __syncthreads();
    if (threadIdx.x == 0) {
        unsigned* bar = b.bar;
        __builtin_amdgcn_s_waitcnt(0);
        unsigned nloc = b.st[0], nx = b.st[1];
        if (nloc == 0u) { xcd_barrier_complete(bar, b.x, nloc, nx); b.st[0] = nloc; b.st[1] = nx; }
        const unsigned old = xb_add(&bar[XB_XSUB(b.x)], 1u);
        const unsigned gen = old / nloc;
        if (old + 1u == (gen + 1u) * nloc) {
            __builtin_amdgcn_fence(__ATOMIC_RELEASE, "agent");
            asm volatile("s_waitcnt vmcnt(0)" ::: "memory");
            const unsigned og = xb_add(&bar[XB_TOP], 1u);
            const unsigned tg = og / nx;
            if (og + 1u == (tg + 1u) * nx) xb_add(&bar[XB_TOPGEN], 1u);
            else XB_SPIN(xb_ld(&bar[XB_TOPGEN]) == tg, bar);
            __builtin_amdgcn_fence(__ATOMIC_ACQUIRE, "agent");
            xb_add(&bar[XB_XGEN(b.x)], 1u);
            asm volatile("s_waitcnt vmcnt(0)" ::: "memory");
        } else {
            XB_SPIN(xb_ld(&bar[XB_XGEN(b.x)]) == gen, bar);
            __builtin_amdgcn_fence(__ATOMIC_ACQUIRE, "agent");
            asm volatile("s_waitcnt vmcnt(0)" ::: "memory");
        }
    }
    __syncthreads();
}

struct Args { const float* in[N_IN]; float* out; unsigned char* ws; int ph_lo, ph_hi; };
constexpr int N_PHASES = 19;

__global__ void __launch_bounds__(NTHR, 2) fwd_kernel(Args args) {
    extern __shared__ __attribute__((aligned(16))) unsigned char lds_raw[];
    cg::grid_group grid = cg::this_grid();
    Ctx F;
    F.lds = (LAS unsigned char*)lds_raw;
    F.tid = threadIdx.x; F.lane = F.tid & 63; F.wave = __builtin_amdgcn_readfirstlane(F.tid >> 6);
    F.G = gridDim.x; F.gw = blockIdx.x * NWAVES + F.wave; F.NGW = F.G * NWAVES;
    F.in = args.in; F.out = args.out; F.ws = args.ws;
    const int lo = args.ph_lo, hi = args.ph_hi;
    volatile LAS unsigned* bst = (volatile LAS unsigned*)(F.lds + LDS_BYTES - 64);
    if (F.tid < 2) bst[F.tid] = 0u;
    if (F.tid < 4) ((volatile LAS unsigned*)(F.lds + LDS_BYTES - 48))[F.tid] = 0u;
    __syncthreads();
    const XcdBarrier bar = xcd_barrier_post((unsigned*)(F.ws + WS_CTL) + 4096, bst);
#define IN(k) (lo <= (k) && (k) < hi)
#ifndef TS_A
#define TS_A -1
#define TS_B -1
#define TS_K 0.1
#endif
    unsigned long long* stamps = (unsigned long long*)(F.ws + WS_CTL + 65536);
#define STAMP(k) do { if (TS_A >= 0 && blockIdx.x == 0 && F.tid == 0) stamps[k] = __builtin_amdgcn_s_memrealtime(); } while (0)
#define REP_MASK 0
#ifndef REP_MASK
#define REP_MASK 0
#endif
#define REPS(k) for (int rep_ = 0; rep_ < 1 + ((REP_MASK >> (k)) & 1); ++rep_)
#define SEAM(k) do { if (IN(k) && IN((k) + 1)) { if ((k) == 0) grid.sync(); else xcd_barrier(bar); } } while (0)

    STAMP(0);
    if (IN(0)) REPS(0) { p0_prologue(F); }
    SEAM(0);
    STAMP(1);
    if (IN(1)) REPS(1) { norm_mod_rows(F, F.in[I_X], F.in[I_N1W], 0, DM, (bf16*)(F.ws + WS_XN)); }
    SEAM(1);
    STAMP(2);
    if (IN(2)) REPS(2) {
        pg8::Gemm g{(const pg8::bf16_t*)(F.ws + WS_XN), (const pg8::bf16_t*)(F.ws + WS_WIN), M, INPP, DM};
        pg8::StaticOrder S; S.init(M, INPP, F.G, (int)blockIdx.x);
        pg8::EpiStoreBf16 E{(pg8::bf16_t*)(F.ws + WS_PROJ), INPP};
        pg8::gemm_phase<pg8::EpiStoreBf16, pg8::StaticOrder, true, true>(F.lds, g, S, E);
    }
    SEAM(2);
#ifndef P3REP
#define P3REP 0
#endif
    STAMP(3);
    if (IN(3)) REPS(3) { p3_lora(F); STAMP(40); m1_chunk_states(F); }
    SEAM(3);
    STAMP(4);
    if (IN(4)) { m2_prefix(F); ra_part(F, 0); }
    SEAM(4);
    STAMP(5);
    if (IN(5)) { rs_half(F, 0); ra_part(F, 1); }
    SEAM(5);
    STAMP(6);
    if (IN(6)) { rs_half(F, 1); ra_part(F, 2); }
    SEAM(6);
    STAMP(7);
    if (IN(7)) { rs_half(F, 2); ra_part(F, 3); }
    SEAM(7);
    STAMP(8);
    if (IN(8)) { rs_half(F, 3); }
    STAMP(9);
    if (IN(9)) REPS(9) { m3_outputs(F); }
    SEAM(9);
    STAMP(10);
    if (IN(10)) { p5_post(F); }
    SEAM(10);
    STAMP(11);
    if (IN(11)) REPS(11) {
        pg8::Gemm g{(const pg8::bf16_t*)(F.ws + WS_OY), (const pg8::bf16_t*)(F.ws + WS_WOUT), M, DM, DM};
        pg8::StaticOrder S; S.init(M, DM, F.G, (int)blockIdx.x);
        pg8::EpiResid E{F.in[I_X], (const float*)(F.ws + WS_MOD) + 2 * DM, (pg8::bf16_t*)(F.ws + WS_HB), DM, SEQ, MODW};
        pg8::gemm_phase<pg8::EpiResid, pg8::StaticOrder, true, true>(F.lds, g, S, E);
    }
    SEAM(11);
    STAMP(12);
    if (IN(12)) REPS(12) { norm_mod_rows_bf16(F, (const bf16*)(F.ws + WS_HB), F.in[I_N2W], 3 * DM, 4 * DM, (bf16*)(F.ws + WS_XN)); }
    SEAM(12);
    STAMP(13);
    if (IN(13)) REPS(13) {
        pg8::Gemm g{(const pg8::bf16_t*)(F.ws + WS_XN), (const pg8::bf16_t*)(F.ws + WS_WQ), M, DM, DM};
        pg8::StaticOrder S; S.init(M, DM, F.G, (int)blockIdx.x);
        pg8::EpiStoreBf16 E{(pg8::bf16_t*)(F.ws + WS_Q), DM};
        pg8::gemm_phase<pg8::EpiStoreBf16, pg8::StaticOrder, true, true>(F.lds, g, S, E);
    }
    SEAM(13);
    STAMP(14);
    if (IN(14)) REPS(14) { p9_route(F); }
    SEAM(14);
    STAMP(15);
    if (IN(15)) REPS(15) { p10_peer_u(F); }
    SEAM(15);
    STAMP(16);
    if (IN(16)) REPS(16) { p11_peer_coef(F); }
    SEAM(16);
    STAMP(17);
    if (IN(17)) { p12_peer_v(F); }
    SEAM(17);
    STAMP(18);
    if (IN(18)) {
        float oscale = 1.f;
        if (TS_A >= 0) { const volatile unsigned long long* st = stamps; const float frac = (float)(st[TS_B] - st[TS_A]) / (float)(st[17] - st[0]); oscale = 1.f + (float)(TS_K) * frac; }
        final_norm_rows_bf16(F, (const bf16*)(F.ws + WS_HB), F.in[I_FNW], F.out, oscale);
    }
#undef IN
#undef SEAM
}

extern "C" void kernel_launch(void* const* d_in, const int* in_sizes, int n_in, void* d_out, int out_size, void* d_ws, size_t ws_size, hipStream_t stream) {
    static int grid = 0;
    if (grid == 0) {
        if (n_in != N_IN || in_sizes[0] != M * DM || out_size != M * DM || ws_size < WS_END2) {
            fprintf(stderr, "kernel_launch: unexpected shapes: n_in %d in0 %d out %d ws %zu (need %zu)\n", n_in, n_in > 0 ? in_sizes[0] : -1, out_size, ws_size, (size_t)WS_END2); grid = -1; return; }
        int dev = 0, cus = 0, per_cu = 0;
        if (hipGetDevice(&dev) != hipSuccess || hipDeviceGetAttribute(&cus, hipDeviceAttributeMultiprocessorCount, dev) != hipSuccess) { grid = -1; return; }
        if (hipFuncSetAttribute((const void*)fwd_kernel, hipFuncAttributeMaxDynamicSharedMemorySize, LDS_BYTES) != hipSuccess) { fprintf(stderr, "kernel_launch: hipFuncSetAttribute failed\n"); grid = -1; return; }
        if (hipOccupancyMaxActiveBlocksPerMultiprocessor(&per_cu, (const void*)fwd_kernel, NTHR, LDS_BYTES) != hipSuccess || per_cu < 1) { fprintf(stderr, "kernel_launch: occupancy query says %d blocks per CU\n", per_cu); per_cu = 1; }
        (void)hipGetLastError();
        grid = cus;
        fprintf(stderr, "kernel_launch: cus %d per_cu %d grid %d ws %zu\n", cus, per_cu, grid, ws_size);
    }
    if (grid < 0) return;
    (void)hipMemsetAsync((char*)d_ws + WS_CTL, 0, CTL_ZERO_BYTES, stream);
    Args a{};
    for (int i = 0; i < N_IN; ++i) a.in[i] = (const float*)d_in[i];
    a.out = (float*)d_out; a.ws = (unsigned char*)d_ws; a.ph_lo = 0; a.ph_hi = N_PHASES;
    void* kargs[] = {&a};
#ifndef NPASS
#define NPASS 1
#endif
    hipError_t e = hipSuccess;
    for (int pass_ = 0; pass_ < NPASS; ++pass_) {
        if (pass_ > 0) (void)hipMemsetAsync((char*)d_ws + WS_CTL, 0, CTL_ZERO_BYTES, stream);
        e = hipLaunchCooperativeKernel((const void*)fwd_kernel, dim3(grid), dim3(NTHR), kargs, LDS_BYTES, stream);
    }
    if (e != hipSuccess) fprintf(stderr, "kernel_launch: cooperative launch failed: %s (grid %d)\n", hipGetErrorString(e), grid);
}
```

```cpp
#include <hip/hip_runtime.h>
#include <hip/hip_cooperative_groups.h>
#include <cstdio>
#include <cstdint>
namespace cg = cooperative_groups;
namespace pg8 {
#define PG8_LAS __attribute__((address_space(3)))
typedef unsigned short bf16_t;
typedef short bf16x8 __attribute__((ext_vector_type(8)));
typedef float f32x4 __attribute__((ext_vector_type(4)));
typedef unsigned u32x4 __attribute__((ext_vector_type(4)));
constexpr int BM = 256, BK = 64, HALF = 128, HTB = HALF * BK * 2  , STAGE_BYTES = 8 * HTB, NXCD = 8, WGM = 8;

__host__ __device__ __forceinline__ int lds_byte(int r, int c) { const int st = (r >> 4) * 2 + (c >> 5), rr = r & 15, cc = c & 31, ob = rr * 64 + cc * 2; return st * 1024 + (ob ^ (((ob >> 9) & 1) << 5)); }
__host__ __device__ __forceinline__ void stage_rc(int b, int& R, int& C) { const int st = b / 1024, sb = b % 1024, swz = sb ^ (((sb >> 9) & 1) << 5); R = (st >> 1) * 16 + swz / 64; C = (st & 1) * 32 + (swz % 64) / 2; }
__host__ __device__ __forceinline__ int perm32(int rho) { const int n = rho >> 4, i = rho & 15; return 8 * (i >> 2) + 4 * n + (i & 3); }

struct Unit { int pm, pn; };
struct Gemm { const bf16_t* A; const bf16_t* Bt; int M, N, K; };

struct StaticOrder {
    int nM, nN, nwg, G, c;
    __host__ __device__ void init(int M, int N, int G_, int c_) { nM = M / BM; nN = N / BM; nwg = nM * nN; G = G_; c = c_; }
    __host__ __device__ bool next(int i, Unit& u) const {
        const long L = (long)i * G + c; if (L >= nwg) return false;
        int wgid = (int)L; { const int q = nwg / NXCD, r = nwg % NXCD, xcd = wgid % NXCD, off = wgid / NXCD; wgid = (xcd < r ? xcd * (q + 1) : r * (q + 1) + (xcd - r) * q) + off; }
        const int nig = WGM * nN, gid = wgid / nig, fm = gid * WGM, gsz = (nM - fm) < WGM ? (nM - fm) : WGM;
        u.pm = fm + ((wgid % nig) % gsz); u.pn = (wgid % nig) / gsz; return true;
    }
    __device__ __forceinline__ void a_ready(const Unit&) const {}
    __device__ __forceinline__ void done(const Unit&) const {}
};
__device__ __forceinline__ unsigned cvt_pk_bf16(float lo, float hi) { unsigned r; asm volatile("v_cvt_pk_bf16_f32 %0, %1, %2" : "=v"(r) : "v"(lo), "v"(hi)); return r; }
struct EpiStoreBf16 {
    static constexpr bool PERM = true, AFTER_DRAIN = false;
    bf16_t* O; int ldc;
    __device__ __forceinline__ void operator()(const f32x4 (&acc)[2][2][4][2], const Unit& u, int wr, int wc, int fr, int fq) const {
        const int row0 = u.pm * BM + wr * 64 + fr; const int col0 = u.pn * BM + wc * 32 + 8 * fq;
#pragma unroll
        for (int ai = 0; ai < 2; ++ai)
#pragma unroll
            for (int m = 0; m < 4; ++m) { bf16_t* rowp = O + (size_t)(row0 + ai * HALF + m * 16) * ldc + col0;
#pragma unroll
                for (int bj = 0; bj < 2; ++bj) { const f32x4 v0 = acc[ai][bj][m][0], v1 = acc[ai][bj][m][1];
                    u32x4 w; w.x = cvt_pk_bf16(v0[0], v0[1]); w.y = cvt_pk_bf16(v0[2], v0[3]); w.z = cvt_pk_bf16(v1[0], v1[1]); w.w = cvt_pk_bf16(v1[2], v1[3]);
                    *(u32x4*)(rowp + bj * HALF) = w; } }
    }
};
struct EpiResid {
    static constexpr bool PERM = true, AFTER_DRAIN = false;
    const float* X; const float* gate; bf16_t* O; int ldc; int rows_per_batch; int gstride;
    __device__ __forceinline__ void operator()(const f32x4 (&acc)[2][2][4][2], const Unit& u, int wr, int wc, int fr, int fq) const {
        const int row0 = u.pm * BM + wr * 64 + fr; const int col0 = u.pn * BM + wc * 32 + 8 * fq;
        const float* g = gate + (size_t)((u.pm * BM) / rows_per_batch) * gstride + col0;
        f32x4 gv[2][2];
#pragma unroll
        for (int bj = 0; bj < 2; ++bj)
#pragma unroll
            for (int n = 0; n < 2; ++n) gv[bj][n] = *(const f32x4*)(g + bj * HALF + 4 * n);
#pragma unroll
        for (int ai = 0; ai < 2; ++ai)
#pragma unroll
            for (int m = 0; m < 4; ++m) { const size_t off = (size_t)(row0 + ai * HALF + m * 16) * ldc + col0;
#pragma unroll
                for (int bj = 0; bj < 2; ++bj) { const f32x4 x0 = *(const f32x4*)(X + off + bj * HALF), x1 = *(const f32x4*)(X + off + bj * HALF + 4);
                    const f32x4 v0 = x0 + gv[bj][0] * acc[ai][bj][m][0], v1 = x1 + gv[bj][1] * acc[ai][bj][m][1];
                    u32x4 w; w.x = cvt_pk_bf16(v0[0], v0[1]); w.y = cvt_pk_bf16(v0[2], v0[3]); w.z = cvt_pk_bf16(v1[0], v1[1]); w.w = cvt_pk_bf16(v1[2], v1[3]);
                    *(u32x4*)(O + off + bj * HALF) = w; } }
    }
};
template <class Epi, class Sched, bool ALIGN_EPI = false, bool SP2 = false>
__device__ __forceinline__ void gemm_phase(PG8_LAS unsigned char* lds, const Gemm g, const Sched& S, const Epi& E) {
    const int tid = threadIdx.x, wid = __builtin_amdgcn_readfirstlane(tid >> 6), lane = tid & 63, wr = wid >> 2, wc = wid & 3, fr = lane & 15, fq = lane >> 4;
    const int K = g.K, nt = K / BK;
    unsigned voffA[2], voffB[2];
#pragma unroll
    for (int i = 0; i < 2; ++i) { int R, C; stage_rc(tid * 16 + i * 8192, R, C); const int Rb = Epi::PERM ? ((R & ~31) + perm32(R & 31)) : R;
        voffA[i] = (unsigned)(R * K + C) * 2u; voffB[i] = (unsigned)(Rb * K + C) * 2u; }
    const size_t kstep = (size_t)(BK * 2);
    const size_t hstep = (size_t)HALF * K * 2;
    const size_t tstep = 2 * hstep;
    const unsigned ldsw = (unsigned)wid * 1024u;
    const int aoff = lds_byte(wr * 64 + fr, fq * 8), boff = lds_byte(wc * 32 + fr, fq * 8);
#define PG8_SA(b, h) (((b) * 2 + (h)) * HTB)
#define PG8_SB(b, h) ((4 + (b) * 2 + (h)) * HTB)
#define PG8_STAGE(bufoff, gbase, voff) do { _Pragma("unroll") for (int _i = 0; _i < 2; ++_i) \
        __builtin_amdgcn_global_load_lds((const unsigned*)((const char*)(gbase) + (voff)[_i]), (PG8_LAS unsigned*)(lds + (bufoff) + ldsw + _i * 8192), 16, 0, 0); } while (0)
#define PG8_LDA(dst, b, h) do { _Pragma("unroll") for (int m = 0; m < 4; ++m) _Pragma("unroll") for (int k = 0; k < 2; ++k) dst[m][k] = *(const PG8_LAS bf16x8*)(lds + PG8_SA(b, h) + aoff + m * 2048 + k * 1024); } while (0)
#define PG8_LDB(dst, b, h) do { _Pragma("unroll") for (int n = 0; n < 2; ++n) _Pragma("unroll") for (int k = 0; k < 2; ++k) dst[n][k] = *(const PG8_LAS bf16x8*)(lds + PG8_SB(b, h) + boff + n * 2048 + k * 1024); } while (0)
#define PG8_MMA(ai, bj, At, Bt) do { __builtin_amdgcn_s_setprio(1); _Pragma("unroll") for (int m = 0; m < 4; ++m) _Pragma("unroll") for (int n = 0; n < 2; ++n) _Pragma("unroll") for (int k = 0; k < 2; ++k) \
        acc[ai][bj][m][n] = __builtin_amdgcn_mfma_f32_16x16x32_bf16(Bt[n][k], At[m][k], acc[ai][bj][m][n], 0, 0, 0); __builtin_amdgcn_s_setprio(0); } while (0)
#define PG8_WAIT_V(n) asm volatile("s_waitcnt vmcnt(" #n ")" ::: "memory")
#define PG8_WAIT_L(n) asm volatile("s_waitcnt lgkmcnt(" #n ")" ::: "memory")
#define PG8_BAR __builtin_amdgcn_s_barrier()
#define PG8_SCHED __builtin_amdgcn_sched_barrier(0)
    Unit cur, nxt; int ui = 0;
    if (!S.next(0, cur)) return;
    f32x4 acc[2][2][4][2];
#pragma unroll
    for (int a = 0; a < 2; ++a)
#pragma unroll
        for (int b = 0; b < 2; ++b)
#pragma unroll
            for (int m = 0; m < 4; ++m)
#pragma unroll
                for (int n = 0; n < 2; ++n) acc[a][b][m][n] = (f32x4){0.f, 0.f, 0.f, 0.f};
    bf16x8 At[4][2], B0[2][2], B1[2][2];
    const char* cA = (const char*)g.A + (size_t)cur.pm * tstep; const char* cB = (const char*)g.Bt + (size_t)cur.pn * tstep;
    S.a_ready(cur);
    if constexpr (SP2) {
        PG8_STAGE(PG8_SB(0, 0), cB, voffB); PG8_STAGE(PG8_SB(0, 1), cB + hstep, voffB); PG8_STAGE(PG8_SA(0, 0), cA, voffA); PG8_STAGE(PG8_SA(0, 1), cA + hstep, voffA);
        if (wr == 1) PG8_BAR;
        PG8_WAIT_V(2); PG8_BAR;
        PG8_STAGE(PG8_SB(1, 0), cB + kstep, voffB); PG8_STAGE(PG8_SA(1, 0), cA + kstep, voffA); PG8_STAGE(PG8_SB(1, 1), cB + hstep + kstep, voffB);
        PG8_WAIT_V(6); PG8_BAR;
    } else {
        PG8_STAGE(PG8_SB(0, 0), cB, voffB); PG8_STAGE(PG8_SA(0, 0), cA, voffA); PG8_STAGE(PG8_SB(0, 1), cB + hstep, voffB); PG8_STAGE(PG8_SA(0, 1), cA + hstep, voffA);
        if (wr == 1) PG8_BAR;
        PG8_WAIT_V(4); PG8_BAR;
        PG8_STAGE(PG8_SB(1, 0), cB + kstep, voffB); PG8_STAGE(PG8_SA(1, 0), cA + kstep, voffA); PG8_STAGE(PG8_SB(1, 1), cB + hstep + kstep, voffB);
        PG8_WAIT_V(6); PG8_BAR;
    }
    for (;;) {
        const bool has_next = S.next(ui + 1, nxt);
        const char* nA = has_next ? (const char*)g.A + (size_t)nxt.pm * tstep : cA; const char* nB = has_next ? (const char*)g.Bt + (size_t)nxt.pn * tstep : cB;
        for (int t = 0; t < nt; t += 2) {
            const bool last = (t == nt - 2);
            const char* a1 = cA + (size_t)(t + 1) * kstep;
            const char* a2 = last ? nA : cA + (size_t)(t + 2) * kstep; const char* b2 = last ? nB : cB + (size_t)(t + 2) * kstep;
            const char* a3 = a2 + kstep; const char* b3 = b2 + kstep;
            if (last && has_next) S.a_ready(nxt);
            if constexpr (SP2) {
            PG8_LDB(B0, 0, 0); PG8_LDB(B1, 0, 1); PG8_SCHED; PG8_LDA(At, 0, 0); PG8_STAGE(PG8_SA(1, 1), a1 + hstep, voffA);
            PG8_WAIT_V(8); PG8_WAIT_L(0); PG8_BAR; PG8_MMA(0, 0, At, B0); PG8_MMA(0, 1, At, B1); PG8_BAR; PG8_SCHED;
            PG8_LDA(At, 0, 1); PG8_STAGE(PG8_SB(0, 0), b2, voffB); PG8_STAGE(PG8_SB(0, 1), b2 + hstep, voffB); PG8_STAGE(PG8_SA(0, 0), a2, voffA);
            PG8_WAIT_V(8); PG8_WAIT_L(0); PG8_BAR; PG8_MMA(1, 0, At, B0); PG8_MMA(1, 1, At, B1); PG8_BAR; PG8_SCHED;
            PG8_LDB(B0, 1, 0); PG8_LDB(B1, 1, 1); PG8_SCHED; PG8_LDA(At, 1, 0); PG8_STAGE(PG8_SA(0, 1), a2 + hstep, voffA);
            PG8_WAIT_V(8); PG8_WAIT_L(0); PG8_BAR; PG8_MMA(0, 0, At, B0); PG8_MMA(0, 1, At, B1); PG8_BAR; PG8_SCHED;
            PG8_LDA(At, 1, 1); PG8_STAGE(PG8_SB(1, 0), b3, voffB); PG8_STAGE(PG8_SB(1, 1), b3 + hstep, voffB); PG8_STAGE(PG8_SA(1, 0), a3, voffA);
            PG8_WAIT_V(8); PG8_WAIT_L(0); PG8_BAR; PG8_MMA(1, 0, At, B0); PG8_MMA(1, 1, At, B1); PG8_BAR; PG8_SCHED;
            } else {
            PG8_LDB(B0, 0, 0); PG8_SCHED; PG8_LDA(At, 0, 0); PG8_STAGE(PG8_SA(1, 1), a1 + hstep, voffA);
            PG8_WAIT_L(8); PG8_BAR; PG8_WAIT_L(0); PG8_MMA(0, 0, At, B0); PG8_BAR; PG8_SCHED;
            PG8_LDB(B1, 0, 1); PG8_STAGE(PG8_SB(0, 0), b2, voffB);
            PG8_BAR; PG8_WAIT_L(0); PG8_MMA(0, 1, At, B1); PG8_BAR;
            PG8_LDA(At, 0, 1); PG8_STAGE(PG8_SA(0, 0), a2, voffA);
            PG8_BAR; PG8_WAIT_L(0); PG8_MMA(1, 0, At, B0); PG8_BAR; PG8_SCHED;
            PG8_STAGE(PG8_SB(0, 1), b2 + hstep, voffB);
            PG8_WAIT_V(6); PG8_BAR; PG8_MMA(1, 1, At, B1); PG8_BAR;
            PG8_LDB(B0, 1, 0); PG8_SCHED; PG8_LDA(At, 1, 0); PG8_STAGE(PG8_SA(0, 1), a2 + hstep, voffA);
            PG8_WAIT_L(8); PG8_BAR; PG8_WAIT_L(0); PG8_MMA(0, 0, At, B0); PG8_BAR; PG8_SCHED;
            PG8_LDB(B1, 1, 1); PG8_STAGE(PG8_SB(1, 0), b3, voffB);
            PG8_BAR; PG8_WAIT_L(0); PG8_MMA(0, 1, At, B1); PG8_BAR;
            PG8_LDA(At, 1, 1); PG8_STAGE(PG8_SA(1, 0), a3, voffA);
            PG8_BAR; PG8_WAIT_L(0); PG8_MMA(1, 0, At, B0); PG8_BAR; PG8_SCHED;
            PG8_STAGE(PG8_SB(1, 1), b3 + hstep, voffB);
            PG8_WAIT_V(6); PG8_BAR; PG8_MMA(1, 1, At, B1); PG8_BAR;
            }
        }
        if constexpr (ALIGN_EPI) { if (wr == 0) PG8_BAR; }
        if constexpr (!Epi::AFTER_DRAIN) { E(acc, cur, wr, wc, fr, fq); S.done(cur); }
        if (!has_next) break;
#pragma unroll
        for (int a = 0; a < 2; ++a)
#pragma unroll
            for (int b = 0; b < 2; ++b)
#pragma unroll
                for (int m = 0; m < 4; ++m)
#pragma unroll
                    for (int n = 0; n < 2; ++n) acc[a][b][m][n] = (f32x4){0.f, 0.f, 0.f, 0.f};
        cur = nxt; cA = nA; cB = nB; ++ui;
        if constexpr (ALIGN_EPI) { if (wr == 1) PG8_BAR; }
    }
    PG8_WAIT_V(0);
    if constexpr (!ALIGN_EPI) { if (wr == 0) PG8_BAR; }
    PG8_BAR;
    if constexpr (Epi::AFTER_DRAIN) { E.fused(acc, cur, wr, wc, fr, fq, lds, wid, lane); S.done(cur); }
#undef PG8_SA
#undef PG8_SB
#undef PG8_STAGE
#undef PG8_LDA
#undef PG8_LDB
#undef PG8_MMA
#undef PG8_WAIT_V
#undef PG8_WAIT_L
#undef PG8_BAR
#undef PG8_SCHED
}
}
#define GAS __attribute__((address_space(1)))
#define LAS __attribute__((address_space(3)))
typedef unsigned short bf16;
typedef unsigned v4u __attribute__((ext_vector_type(4)));
typedef unsigned v2u __attribute__((ext_vector_type(2)));
typedef float f32x4 __attribute__((ext_vector_type(4)));
typedef float f32x2 __attribute__((ext_vector_type(2)));
typedef short bf16x8 __attribute__((ext_vector_type(8)));
typedef __bf16 bf16x2_t __attribute__((ext_vector_type(2)));

constexpr int NWAVES = 8, NTHR = 512;
constexpr int DM = 2048, NB = 4, SEQ = 8192, M = NB * SEQ;
constexpr int RW = 1024, RHEADS = 16, HD = 64;
constexpr int L_W = 64, L_A = 64, L_G = 160;
constexpr int INP = 5936, INPP = 6144;
constexpr int C_R = 0, C_K = 1024, C_V = 2048, C_WD = 3072, C_AD = 3136, C_GD = 3200, C_Z = 3360, C_XBC = 4384, C_DT = 5920;
constexpr int MODW = 6 * DM;
constexpr int NEXP = 16384;
constexpr float RMS_EPS = 1e-6f;

enum { I_X = 0, I_C, I_ADAW, I_ADAB, I_N1W, I_WIN, I_MU, I_W0, I_WUP, I_A0, I_AUP, I_GUP, I_KK, I_KA, I_RK, I_LNW, I_LNB,
       I_CONVW, I_CONVB, I_DTB, I_ALOG, I_DSK, I_MNW, I_WOUT, I_N2W, I_WQ, I_KEYS, I_PU, I_PV, I_FNW, N_IN };

constexpr size_t MiB = 1u << 20;
constexpr size_t WS_CTL = 0, CTL_ZERO_BYTES = 1 * MiB;
constexpr size_t WS_MOD = 1 * MiB;
constexpr size_t WS_WIN = 2 * MiB, WS_WOUT = 26 * MiB, WS_WQ = 34 * MiB, WS_KEYS = 42 * MiB;
constexpr size_t WS_WUPT = 43 * MiB, WS_AUPT = 43 * MiB + 256 * 1024, WS_GUPT = 43 * MiB + 512 * 1024;
constexpr size_t WS_PU8 = 44 * MiB, WS_PV8 = 76 * MiB;
constexpr size_t WS_USC = 108 * MiB, WS_VSC = 108 * MiB + 65536;
constexpr size_t WS_XN = 172 * MiB;
constexpr size_t WS_LW = WS_XN, WS_AA = WS_XN + 64 * MiB;
constexpr size_t WS_PROJ = 300 * MiB;
constexpr size_t WS_Q = WS_PROJ;
constexpr size_t WS_GG = 684 * MiB;
constexpr size_t WS_PD = WS_PROJ + 128 * MiB;
constexpr size_t WS_RTE = 684 * MiB, WS_RTG = 700 * MiB, WS_COEF = 716 * MiB;
constexpr size_t WS_OY = 748 * MiB;
constexpr size_t WS_END = 876 * MiB;
constexpr size_t WS_HB = 876 * MiB;

constexpr int RING_BYTES = 131072, LDS_BYTES = 147456;

#define LDS_WAIT() asm volatile("s_waitcnt lgkmcnt(0)" ::: "memory")
#define VM_WAIT() asm volatile("s_waitcnt vmcnt(0)" ::: "memory")
__device__ __forceinline__ unsigned pk2(float lo, float hi) { f32x2 v = {lo, hi}; bf16x2_t b = __builtin_convertvector(v, bf16x2_t); return __builtin_bit_cast(unsigned, b); }
__device__ __forceinline__ float bflo(unsigned u) { return __uint_as_float(u << 16); }
__device__ __forceinline__ float bfhi(unsigned u) { return __uint_as_float(u & 0xffff0000u); }
__device__ __forceinline__ float bf1(bf16 h) { return __uint_as_float((unsigned)h << 16); }
__device__ __forceinline__ float wave_sum(float v) {
#pragma unroll
    for (int o = 1; o < 64; o <<= 1) v += __shfl_xor(v, o);
    return v;
}
__device__ __forceinline__ float rcp_f(float v) { return __builtin_amdgcn_rcpf(v); }
template <int CTRL> __device__ __forceinline__ float dppc_f(float x) { return __builtin_bit_cast(float, __builtin_amdgcn_mov_dpp(__builtin_bit_cast(int, x), CTRL, 0xf, 0xf, true)); }
__device__ __forceinline__ float wave_sum_fast(float x) {
    x += dppc_f<0xB1>(x); x += dppc_f<0x4E>(x); x += dppc_f<0x124>(x); x += dppc_f<0x128>(x);
    { auto rr = __builtin_amdgcn_permlane16_swap(__float_as_uint(x), __float_as_uint(x), false, false); x = __uint_as_float(rr[0]) + __uint_as_float(rr[1]); }
    { auto rr = __builtin_amdgcn_permlane32_swap(__float_as_uint(x), __float_as_uint(x), false, false); x = __uint_as_float(rr[0]) + __uint_as_float(rr[1]); }
    return x;
}
__device__ __forceinline__ float silu_f(float v) { return v * rcp_f(1.f + __expf(-v)); }
__device__ __forceinline__ float sigmoid_f(float v) { return rcp_f(1.f + __expf(-v)); }

struct Ctx {
    LAS unsigned char* lds;
    int tid, lane, wave, G, gw, NGW;
    const float* const* in;
    float* out; unsigned char* ws;
};

__device__ __forceinline__ void transpose_item(const float* W, int K, int N, bf16* WT, int ldt, int nrows_out, LAS float* scr, int kb, int nb, int lane) {
    const int k0 = 64 * kb, n0 = 64 * nb;
    const int c4 = 4 * (lane & 15), rr = lane >> 4;
    const bool vec_ok = ((N & 3) == 0) && (n0 + 64 <= N);
#pragma unroll 4
    for (int i = 0; i < 16; ++i) { const int kk = 4 * i + rr, k = k0 + kk;
        f32x4 v = {0.f, 0.f, 0.f, 0.f};
        if (k < K) { const float* src = W + (size_t)k * N + n0 + c4;
            if (vec_ok) v = *(const f32x4*)src;
            else { if (n0 + c4 + 0 < N) v.x = src[0]; if (n0 + c4 + 1 < N) v.y = src[1]; if (n0 + c4 + 2 < N) v.z = src[2]; if (n0 + c4 + 3 < N) v.w = src[3]; } }
        LAS float* d = scr + kk * 65 + c4; d[0] = v.x; d[1] = v.y; d[2] = v.z; d[3] = v.w; }
    LDS_WAIT(); asm volatile("" ::: "memory");
    const int c = lane & 7;
#pragma unroll
    for (int j = 0; j < 8; ++j) { const int n = (lane >> 3) + 8 * j; const LAS float* sp = scr + (8 * c) * 65 + n;
        v4u o; o.x = pk2(sp[0 * 65], sp[1 * 65]); o.y = pk2(sp[2 * 65], sp[3 * 65]); o.z = pk2(sp[4 * 65], sp[5 * 65]); o.w = pk2(sp[6 * 65], sp[7 * 65]);
        if (n0 + n < nrows_out && k0 + 8 * c + 8 <= ldt) *(v4u*)(WT + (size_t)(n0 + n) * ldt + k0 + 8 * c) = o; }
    LDS_WAIT(); asm volatile("" ::: "memory");
}
__device__ __forceinline__ void transpose_all(const float* W, int K, int N, bf16* WT, int ldt, int nrows_out, LAS float* scr, int gw, int NGW, int lane) {
    const int nkb = (K + 63) / 64, nnb = nrows_out / 64, nit = nkb * nnb;
    for (int it = gw; it < nit; it += NGW) transpose_item(W, K, N, WT, ldt, nrows_out, scr, it / nnb, it % nnb, lane);
}
__device__ __forceinline__ void convert_all(const float* src, bf16* dst, size_t n8, int gw, int NGW, int lane) {
    const f32x4* s4 = (const f32x4*)src; v4u* d4 = (v4u*)dst;
    for (size_t i = (size_t)gw * 64 + lane; i < n8; i += (size_t)NGW * 64) {
        const f32x4 a = __builtin_nontemporal_load(s4 + 2 * i), b = __builtin_nontemporal_load(s4 + 2 * i + 1);
        v4u o; o.x = pk2(a.x, a.y); o.y = pk2(a.z, a.w); o.z = pk2(b.x, b.y); o.w = pk2(b.z, b.w);
        d4[i] = o; }
}
__device__ __forceinline__ void quantize_rows_fp8(const float* src, unsigned char* dst8, float* scales, int e0, int e1, int step, int lane) {
    if (e0 >= e1) return;
    f32x4 vn[8];
    { const f32x4* s4 = (const f32x4*)(src + (size_t)e0 * DM) + lane;
#pragma unroll
      for (int i = 0; i < 8; ++i) vn[i] = __builtin_nontemporal_load(s4 + 64 * i); }
    for (int e = e0; e < e1; e += step) {
        f32x4 v[8];
#pragma unroll
        for (int i = 0; i < 8; ++i) v[i] = vn[i];
        { const int en = (e + step < e1) ? e + step : e; const f32x4* s4 = (const f32x4*)(src + (size_t)en * DM) + lane;
#pragma unroll
          for (int i = 0; i < 8; ++i) vn[i] = __builtin_nontemporal_load(s4 + 64 * i); }
        float am = 0.f;
#pragma unroll
        for (int i = 0; i < 8; ++i) am = fmaxf(fmaxf(am, fmaxf(fabsf(v[i].x), fabsf(v[i].y))), fmaxf(fabsf(v[i].z), fabsf(v[i].w)));
#pragma unroll
        for (int o = 1; o < 64; o <<= 1) am = fmaxf(am, __shfl_xor(am, o));
        am = fmaxf(am, 1e-30f);
        const float inv = 440.f / am;
#pragma unroll
        for (int i = 0; i < 8; ++i) { int w = __builtin_amdgcn_cvt_pk_fp8_f32(v[i].x * inv, v[i].y * inv, 0, false); w = __builtin_amdgcn_cvt_pk_fp8_f32(v[i].z * inv, v[i].w * inv, w, true);
            const int seg = 2 * i + (lane >> 5);
            *(int*)(dst8 + (size_t)seg * ((size_t)NEXP * 128) + (size_t)e * 128 + 4 * (lane & 31)) = w; }
        if (lane == 0) scales[e] = am * (1.f / 440.f);
    }
}
__device__ __forceinline__ void quantize_rows_fp4(const float* src, unsigned char* dst4, float* scales, int e0, int e1, int step, int lane) {
    if (e0 >= e1) return;
    f32x4 vn[8];
    { const f32x4* s4 = (const f32x4*)(src + (size_t)e0 * DM) + lane;
#pragma unroll
      for (int i = 0; i < 8; ++i) vn[i] = __builtin_nontemporal_load(s4 + 64 * i); }
    for (int e = e0; e < e1; e += step) {
        f32x4 v[8];
#pragma unroll
        for (int i = 0; i < 8; ++i) v[i] = vn[i];
        { const int en = (e + step < e1) ? e + step : e; const f32x4* s4 = (const f32x4*)(src + (size_t)en * DM) + lane;
#pragma unroll
          for (int i = 0; i < 8; ++i) vn[i] = __builtin_nontemporal_load(s4 + 64 * i); }
        float am = 0.f;
#pragma unroll
        for (int i = 0; i < 8; ++i) am = fmaxf(am, fmaxf(fmaxf(fabsf(v[i].x), fabsf(v[i].y)), fmaxf(fabsf(v[i].z), fabsf(v[i].w))));
#pragma unroll
        for (int o = 1; o < 64; o <<= 1) am = fmaxf(am, __shfl_xor(am, o));
        am = fmaxf(am, 1e-30f);
        const float inv = 6.f / am;
#pragma unroll
        for (int i = 0; i < 8; ++i) {
            unsigned w = __builtin_amdgcn_cvt_scalef32_pk_fp4_f32(0u, v[i].x * inv, v[i].y * inv, 1.0f, 0);
            w = __builtin_amdgcn_cvt_scalef32_pk_fp4_f32(w, v[i].z * inv, v[i].w * inv, 1.0f, 1);
            *(unsigned short*)(dst4 + (size_t)i * ((size_t)NEXP * 128) + (size_t)e * 128 + 2 * lane) = (unsigned short)w;
        }
        if (lane == 0) scales[e] = am * (1.f / 6.f);
    }
}
__device__ __forceinline__ void p0_prologue(const Ctx& F) {
    __syncthreads();
    if (blockIdx.x < MODW / 64) {
        LAS float* sc = (LAS float*)F.lds;
        LAS float* red = sc + NB * DM;
        const float* c = F.in[I_C];
        for (int i = F.tid; i < NB * DM; i += NTHR) sc[i] = silu_f(c[i]);
        __syncthreads();
        const int j = blockIdx.x * 64 + F.lane;
        const float* wp = F.in[I_ADAW] + (size_t)(F.wave * 256) * MODW + j;
        float a0 = 0.f, a1 = 0.f, a2 = 0.f, a3 = 0.f;
#pragma unroll 32
        for (int kk = 0; kk < 256; ++kk) { const float w = wp[(size_t)kk * MODW]; const int k = F.wave * 256 + kk;
            a0 += sc[k] * w; a1 += sc[DM + k] * w; a2 += sc[2 * DM + k] * w; a3 += sc[3 * DM + k] * w; }
        red[(F.wave * 4 + 0) * 64 + F.lane] = a0; red[(F.wave * 4 + 1) * 64 + F.lane] = a1; red[(F.wave * 4 + 2) * 64 + F.lane] = a2; red[(F.wave * 4 + 3) * 64 + F.lane] = a3;
        __syncthreads();
        if (F.tid < 256) { const int b = F.tid >> 6, l = F.tid & 63; float s = F.in[I_ADAB][blockIdx.x * 64 + l];
#pragma unroll
            for (int w = 0; w < 8; ++w) s += red[(w * 4 + b) * 64 + l];
            ((float*)(F.ws + WS_MOD))[b * MODW + blockIdx.x * 64 + l] = s; }
        __syncthreads();
    }
    LAS float* scr = (LAS float*)(F.lds + F.wave * 16640);
    transpose_all(F.in[I_WIN], DM, INP, (bf16*)(F.ws + WS_WIN), DM, INPP, scr, F.gw, F.NGW, F.lane);
    transpose_all(F.in[I_WOUT], DM, DM, (bf16*)(F.ws + WS_WOUT), DM, DM, scr, F.gw, F.NGW, F.lane);
    transpose_all(F.in[I_WQ], DM, DM, (bf16*)(F.ws + WS_WQ), DM, DM, scr, F.gw, F.NGW, F.lane);
    transpose_all(F.in[I_WUP], L_W, RW, (bf16*)(F.ws + WS_WUPT), L_W, RW, scr, F.gw, F.NGW, F.lane);
    transpose_all(F.in[I_AUP], L_A, RW, (bf16*)(F.ws + WS_AUPT), L_A, RW, scr, F.gw, F.NGW, F.lane);
    transpose_all(F.in[I_GUP], L_G, RW, (bf16*)(F.ws + WS_GUPT), L_G, RW, scr, F.gw, F.NGW, F.lane);
    convert_all(F.in[I_KEYS], (bf16*)(F.ws + WS_KEYS), (size_t)16 * 128 * 128 / 8, F.gw, F.NGW, F.lane);
    {
        const int nlo = (F.G < 192) ? F.G : 192, nhi = F.G - nlo;
        const int wtot = 5 * nlo + 8 * nhi;
        const int wb0 = (blockIdx.x < nlo) ? 5 * blockIdx.x : 5 * nlo + 8 * (blockIdx.x - nlo), wb1 = wb0 + ((blockIdx.x < nlo) ? 5 : 8);
        const int r0 = (int)((long)(2 * NEXP) * wb0 / wtot), r1 = (int)((long)(2 * NEXP) * wb1 / wtot);
        const int a0 = r0 < NEXP ? r0 : NEXP, a1 = r1 < NEXP ? r1 : NEXP;
        quantize_rows_fp4(F.in[I_PU], F.ws + WS_PU8, (float*)(F.ws + WS_USC), a0 + F.wave, a1, NWAVES, F.lane);
        const int b0 = (r0 > NEXP ? r0 : NEXP) - NEXP, b1 = (r1 > NEXP ? r1 : NEXP) - NEXP;
        quantize_rows_fp4(F.in[I_PV], F.ws + WS_PV8, (float*)(F.ws + WS_VSC), b0 + F.wave, b1, NWAVES, F.lane);
    }
}

__device__ __forceinline__ void norm_mod_rows(const Ctx& F, const float* X, const float* nw, int shift_off, int scale_off, bf16* XN) {
    const float* mod = (const float*)(F.ws + WS_MOD);
    if (F.gw >= M) return;
    f32x4 vn[8];
    { const f32x4* xr = (const f32x4*)(X + (size_t)F.gw * DM) + F.lane;
#pragma unroll
      for (int j = 0; j < 8; ++j) vn[j] = xr[64 * j]; }
    for (int m = F.gw; m < M; m += F.NGW) {
        const int b = m / SEQ;
        f32x4 v[8]; float s = 0.f;
#pragma unroll
        for (int j = 0; j < 8; ++j) { v[j] = vn[j]; s += (v[j].x * v[j].x + v[j].y * v[j].y) + (v[j].z * v[j].z + v[j].w * v[j].w); }
        { const int mn = (m + F.NGW < M) ? m + F.NGW : m; const f32x4* xr = (const f32x4*)(X + (size_t)mn * DM) + F.lane;
#pragma unroll
          for (int j = 0; j < 8; ++j) vn[j] = xr[64 * j]; }
        const float rstd = rsqrtf(wave_sum_fast(s) * (1.f / DM) + RMS_EPS);
        const f32x4* wp = (const f32x4*)nw + F.lane;
        const f32x4* shp = (const f32x4*)(mod + (size_t)b * MODW + shift_off) + F.lane;
        const f32x4* scp = (const f32x4*)(mod + (size_t)b * MODW + scale_off) + F.lane;
        v2u* o = (v2u*)(XN + (size_t)m * DM) + F.lane;
#pragma unroll
        for (int j = 0; j < 8; ++j) { const f32x4 w = wp[64 * j], a = scp[64 * j], c = shp[64 * j];
            const f32x4 r = (v[j] * rstd) * w * (a + 1.f) + c;
            v2u p; p.x = pk2(r.x, r.y); p.y = pk2(r.z, r.w); o[64 * j] = p; }
    }
}
__device__ __forceinline__ void final_norm_rows(const Ctx& F, const float* H, const float* nw, float* O) {
    for (int m = F.gw; m < M; m += F.NGW) {
        const f32x4* xr = (const f32x4*)(H + (size_t)m * DM) + F.lane;
        f32x4 v[8]; float s = 0.f;
#pragma unroll
        for (int j = 0; j < 8; ++j) { v[j] = xr[64 * j]; s += (v[j].x * v[j].x + v[j].y * v[j].y) + (v[j].z * v[j].z + v[j].w * v[j].w); }
        const float rstd = rsqrtf(wave_sum(s) * (1.f / DM) + RMS_EPS);
        const f32x4* wp = (const f32x4*)nw + F.lane;
        f32x4* o = (f32x4*)(O + (size_t)m * DM) + F.lane;
#pragma unroll
        for (int j = 0; j < 8; ++j) o[64 * j] = (v[j] * rstd) * wp[64 * j];
    }
}


__device__ __forceinline__ void load_row_raw(const bf16* row, int lane, v2u (&u)[8]) {
    const v2u* p = (const v2u*)row + lane;
#pragma unroll
    for (int j = 0; j < 8; ++j) u[j] = p[64 * j];
}
__device__ __forceinline__ void norm_mod_rows_bf16(const Ctx& F, const bf16* X, const float* nw, int shift_off, int scale_off, bf16* XN) {
    const float* mod = (const float*)(F.ws + WS_MOD);
    if (F.gw >= M) return;
    v2u un[8]; load_row_raw(X + (size_t)F.gw * DM, F.lane, un);
    for (int m = F.gw; m < M; m += F.NGW) {
        const int b = m / SEQ;
        f32x4 v[8]; float s = 0.f;
#pragma unroll
        for (int j = 0; j < 8; ++j) { v[j] = (f32x4){bflo(un[j].x), bfhi(un[j].x), bflo(un[j].y), bfhi(un[j].y)}; s += (v[j].x * v[j].x + v[j].y * v[j].y) + (v[j].z * v[j].z + v[j].w * v[j].w); }
        { const int mn = (m + F.NGW < M) ? m + F.NGW : m; load_row_raw(X + (size_t)mn * DM, F.lane, un); }
        const float rstd = rsqrtf(wave_sum_fast(s) * (1.f / DM) + RMS_EPS);
        const f32x4* wp = (const f32x4*)nw + F.lane;
        const f32x4* shp = (const f32x4*)(mod + (size_t)b * MODW + shift_off) + F.lane;
        const f32x4* scp = (const f32x4*)(mod + (size_t)b * MODW + scale_off) + F.lane;
        v2u* o = (v2u*)(XN + (size_t)m * DM) + F.lane;
#pragma unroll
        for (int j = 0; j < 8; ++j) { const f32x4 w = wp[64 * j], a = scp[64 * j], c = shp[64 * j];
            const f32x4 r = (v[j] * rstd) * w * (a + 1.f) + c;
            v2u p; p.x = pk2(r.x, r.y); p.y = pk2(r.z, r.w); o[64 * j] = p; }
    }
}
__device__ __forceinline__ void final_norm_rows_bf16(const Ctx& F, const bf16* H, const float* nw, float* O, float oscale) {
    if (F.gw >= M) return;
    v2u un[8]; load_row_raw(H + (size_t)F.gw * DM, F.lane, un);
    f32x4 wv[8];
#pragma unroll
    for (int j = 0; j < 8; ++j) wv[j] = ((const f32x4*)nw + F.lane)[64 * j];
    for (int m = F.gw; m < M; m += F.NGW) {
        f32x4 v[8]; float s = 0.f;
#pragma unroll
        for (int j = 0; j < 8; ++j) { v[j] = (f32x4){bflo(un[j].x), bfhi(un[j].x), bflo(un[j].y), bfhi(un[j].y)}; s += (v[j].x * v[j].x + v[j].y * v[j].y) + (v[j].z * v[j].z + v[j].w * v[j].w); }
        { const int mn = (m + F.NGW < M) ? m + F.NGW : m; load_row_raw(H + (size_t)mn * DM, F.lane, un); }
        const float rstd = rsqrtf(wave_sum_fast(s) * (1.f / DM) + RMS_EPS) * oscale;
        f32x4* o = (f32x4*)(O + (size_t)m * DM) + F.lane;
#pragma unroll
        for (int j = 0; j < 8; ++j) __builtin_nontemporal_store((v[j] * rstd) * wv[j], o + 64 * j);
    }
}
#define LO2(v) __builtin_shufflevector((v), (v), 0, 1)
#define HI2(v) __builtin_shufflevector((v), (v), 2, 3)
template <int CTRL> __device__ __forceinline__ float dpp_f(float x) { return __builtin_bit_cast(float, __builtin_amdgcn_mov_dpp(__builtin_bit_cast(int, x), CTRL, 0xf, 0xf, true)); }
__device__ __forceinline__ float rowsum16(float x) { x += dpp_f<0xB1>(x); x += dpp_f<0x4E>(x); x += dpp_f<0x124>(x); x += dpp_f<0x128>(x); return x; }
__device__ __forceinline__ float quadsum(float x) { x += dpp_f<0xB1>(x); x += dpp_f<0x4E>(x); return x; }

__device__ __forceinline__ float treduce16(const float (&p)[16], bool b0, bool b1, bool b2, bool b3) {
    float a[8], bq[4], c2[2];
#pragma unroll
    for (int j = 0; j < 8; ++j) { const float mine = b3 ? p[j + 8] : p[j], send = b3 ? p[j] : p[j + 8]; a[j] = mine + dpp_f<0x128>(send); }
#pragma unroll
    for (int j = 0; j < 4; ++j) { const float mine = b2 ? a[j + 4] : a[j], send = b2 ? a[j] : a[j + 4]; const float up = dpp_f<0x104>(send), dn = dpp_f<0x114>(send); bq[j] = mine + (b2 ? dn : up); }
#pragma unroll
    for (int j = 0; j < 2; ++j) { const float mine = b1 ? bq[j + 2] : bq[j], send = b1 ? bq[j] : bq[j + 2]; c2[j] = mine + dpp_f<0x4E>(send); }
    const float mine = b0 ? c2[1] : c2[0], send = b0 ? c2[0] : c2[1];
    return mine + dpp_f<0xB1>(send);
}
__device__ __forceinline__ float wave_sum_dpp(float v) { v = rowsum16(v); v += __shfl_xor(v, 16); v += __shfl_xor(v, 32); return v; }
__device__ __forceinline__ void unpack8(const v4u p, float (&e)[8]) { e[0] = bflo(p.x); e[1] = bfhi(p.x); e[2] = bflo(p.y); e[3] = bfhi(p.y); e[4] = bflo(p.z); e[5] = bfhi(p.z); e[6] = bflo(p.w); e[7] = bfhi(p.w); }
__device__ __forceinline__ v4u pack8(const float (&e)[8]) { v4u o; o.x = pk2(e[0], e[1]); o.y = pk2(e[2], e[3]); o.z = pk2(e[4], e[5]); o.w = pk2(e[6], e[7]); return o; }

__device__ __forceinline__ void p3_lora(const Ctx& F) {
    const bf16* PROJ = (const bf16*)(F.ws + WS_PROJ);
    const bf16* WUPT = (const bf16*)(F.ws + WS_WUPT); const bf16* AUPT = (const bf16*)(F.ws + WS_AUPT); const bf16* GUPT = (const bf16*)(F.ws + WS_GUPT);
    bf16* LW = (bf16*)(F.ws + WS_LW); bf16* AA = (bf16*)(F.ws + WS_AA); bf16* GG = (bf16*)(F.ws + WS_GG);
    const float* mu = F.in[I_MU]; const float* w0 = F.in[I_W0]; const float* a0 = F.in[I_A0];
    const int r16 = F.lane & 15, q = F.lane >> 4;
    constexpr int WST = 72, GST = 168;
    LAS bf16* WU = (LAS bf16*)F.lds; LAS bf16* AU = WU + 128 * WST; LAS bf16* GU = AU + 128 * WST;
    const int nr = blockIdx.x & 7, nbr = (F.G - nr + 7) >> 3;
    __syncthreads();
    for (int i = F.tid; i < 128 * 8; i += NTHR) { const int row = i >> 3, ch = i & 7;
        *(LAS v4u*)(WU + row * WST + 8 * ch) = *(const v4u*)(WUPT + (size_t)(128 * nr + row) * L_W + 8 * ch);
        *(LAS v4u*)(AU + row * WST + 8 * ch) = *(const v4u*)(AUPT + (size_t)(128 * nr + row) * L_A + 8 * ch); }
    for (int i = F.tid; i < 128 * 20; i += NTHR) { const int row = i / 20, ch = i - row * 20;
        *(LAS v4u*)(GU + row * GST + 8 * ch) = *(const v4u*)(GUPT + (size_t)(128 * nr + row) * L_G + 8 * ch); }
    __syncthreads();
#define P3_COL(s) ((((s) < 2) ? (C_WD + 32 * (s)) : ((s) < 4) ? (C_AD + 32 * ((s) - 2)) : (C_GD + 32 * ((s) - 4))) + 8 * q)
    const int mt0 = (blockIdx.x >> 3) * NWAVES + F.wave, mst = nbr * NWAVES;
    v4u rc_[9], rp_[9];
    if (mt0 < M / 16) { const bf16* row = PROJ + (size_t)(mt0 * 16 + r16) * INPP;
#pragma unroll
        for (int s = 0; s < 9; ++s) { rc_[s] = *(const v4u*)(row + P3_COL(s)); rp_[s] = *(const v4u*)(row - INPP + P3_COL(s)); } }
    for (int mt = mt0; mt < M / 16; mt += mst) {
        const int m = mt * 16 + r16; const bool first = (m % SEQ) == 0;
        bf16x8 af[9];
#pragma unroll
        for (int s = 0; s < 9; ++s) {
            const int col = P3_COL(s);
            const v4u pc = rc_[s];
            v4u pp = rp_[s]; if (first) pp = (v4u){0u, 0u, 0u, 0u};
            const f32x4 m0 = *(const f32x4*)(mu + col), m1 = *(const f32x4*)(mu + col + 4);
            float c[8], p[8], e[8]; unpack8(pc, c); unpack8(pp, p);
            const float mm[8] = {m0.x, m0.y, m0.z, m0.w, m1.x, m1.y, m1.z, m1.w};
#pragma unroll
            for (int j = 0; j < 8; ++j) { float v = c[j] + (p[j] - c[j]) * mm[j];
                if (s < 2) { const float t = __expf(2.f * v); v = 1.f - 2.f * rcp_f(t + 1.f); }
                else if (s >= 4) v = sigmoid_f(v);
                e[j] = v; }
            af[s] = __builtin_bit_cast(bf16x8, pack8(e));
        }
        { const int mtn = (mt + mst < M / 16) ? mt + mst : mt; const bf16* row = PROJ + (size_t)(mtn * 16 + r16) * INPP;
#pragma unroll
          for (int s = 0; s < 9; ++s) { rc_[s] = *(const v4u*)(row + P3_COL(s)); rp_[s] = *(const v4u*)(row - INPP + P3_COL(s)); } }
        asm volatile("" ::: "memory");
#pragma unroll 2
        for (int nt = 0; nt < 8; ++nt) {
            const LAS bf16* wu = WU + (16 * nt + r16) * WST + 8 * q; const LAS bf16* au = AU + (16 * nt + r16) * WST + 8 * q; const LAS bf16* gu = GU + (16 * nt + r16) * GST + 8 * q;
            f32x4 acc0 = {0.f, 0.f, 0.f, 0.f}, acc1 = acc0, acc2 = acc0;
#pragma unroll
            for (int s2 = 0; s2 < 2; ++s2) acc0 = __builtin_amdgcn_mfma_f32_16x16x32_bf16(*(const LAS bf16x8*)(wu + 32 * s2), af[s2], acc0, 0, 0, 0);
#pragma unroll
            for (int s2 = 0; s2 < 2; ++s2) acc1 = __builtin_amdgcn_mfma_f32_16x16x32_bf16(*(const LAS bf16x8*)(au + 32 * s2), af[2 + s2], acc1, 0, 0, 0);
#pragma unroll
            for (int s2 = 0; s2 < 5; ++s2) acc2 = __builtin_amdgcn_mfma_f32_16x16x32_bf16(*(const LAS bf16x8*)(gu + 32 * s2), af[4 + s2], acc2, 0, 0, 0);
            const int n = 128 * nr + 16 * nt + 4 * q;
            const f32x4 w0v = *(const f32x4*)(w0 + n), a0v = *(const f32x4*)(a0 + n);
            v2u o0, o1, o2;
            o0.x = pk2(-0.60653066f * sigmoid_f(acc0[0] + w0v.x), -0.60653066f * sigmoid_f(acc0[1] + w0v.y));
            o0.y = pk2(-0.60653066f * sigmoid_f(acc0[2] + w0v.z), -0.60653066f * sigmoid_f(acc0[3] + w0v.w));
            o1.x = pk2(sigmoid_f(acc1[0] + a0v.x), sigmoid_f(acc1[1] + a0v.y)); o1.y = pk2(sigmoid_f(acc1[2] + a0v.z), sigmoid_f(acc1[3] + a0v.w));
            o2.x = pk2(acc2[0], acc2[1]); o2.y = pk2(acc2[2], acc2[3]);
            *(v2u*)(LW + (size_t)m * RW + n) = o0; *(v2u*)(AA + (size_t)m * RW + n) = o1; *(v2u*)(GG + (size_t)m * RW + n) = o2;
        }
    }
#undef P3_COL
    __syncthreads();
}

constexpr int TC = 32, NCHUNK = SEQ / TC;
constexpr int RB_R = 0, RB_W = TC * 64, RB_K = 2 * TC * 64, RB_KK = 3 * TC * 64, RB_KA = 4 * TC * 64, RB_V = 5 * TC * 64, RB_SIZE = 5 * TC * 64 + TC * 16;
constexpr int MB_B = 0, MB_C = TC * 128, MB_X = 2 * TC * 128, MB_DT = MB_X + TC * 32, MB_DA = MB_DT + TC, MB_SIZE = MB_DA + TC;
static_assert(2 * RB_SIZE * 4 <= RING_BYTES, "scan buffers fit the LDS ring");

struct RwkvRaw { bf16 r[9], k[9], v[9], lw[8], a[8]; };
__device__ __forceinline__ void rwkv_load(RwkvRaw& raw, const bf16* PROJ, const bf16* LW, const bf16* AA, int b, int h, int t0w, int c) {
    const bf16* base = PROJ + (size_t)(b * SEQ + t0w) * INPP + h * 64 + c;
#pragma unroll
    for (int i = 0; i < 9; ++i) {
        if (i == 0 && t0w == 0) { raw.r[0] = 0; raw.k[0] = 0; raw.v[0] = 0; }
        else { const bf16* row = base + (long)(i - 1) * INPP; raw.r[i] = row[C_R]; raw.k[i] = row[C_K]; raw.v[i] = row[C_V]; }
    }
#pragma unroll
    for (int i = 0; i < 8; ++i) { const size_t o = (size_t)(b * SEQ + t0w + i) * RW + h * 64 + c; raw.lw[i] = LW[o]; raw.a[i] = AA[o]; }
}
__device__ __forceinline__ void rwkv_stage(const RwkvRaw& raw, LAS float* buf, int tl0, int c, int qt, float mu_r, float mu_k, float mu_v, float kkw, float kaw) {
#pragma unroll
    for (int i = 0; i < 8; ++i) {
        const int t = tl0 + i;
        const float rc = bf1(raw.r[i + 1]), rp = bf1(raw.r[i]), kc = bf1(raw.k[i + 1]), kp = bf1(raw.k[i]), vc = bf1(raw.v[i + 1]), vp = bf1(raw.v[i]);
        const float rr = rc + (rp - rc) * mu_r, kx = kc + (kp - kc) * mu_k, vv = vc + (vp - vc) * mu_v;
        const float a = bf1(raw.a[i]), dec = __expf(bf1(raw.lw[i]));
        const float kkraw = kx * kkw; const float ss = wave_sum_dpp(kkraw * kkraw);
        const float kkn = kkraw * rcp_f(fmaxf(sqrtf(ss), 1e-12f));
        buf[RB_R + t * 64 + c] = rr; buf[RB_W + t * 64 + c] = dec; buf[RB_K + t * 64 + c] = kx * (1.f + (a - 1.f) * kaw);
        buf[RB_KK + t * 64 + c] = kkn; buf[RB_KA + t * 64 + c] = kkn * a;
        if ((c >> 4) == qt) buf[RB_V + t * 16 + (c & 15)] = vv;
    }
}
__device__ __forceinline__ void rwkv_task(const Ctx& F, int task) {
    const int b = task >> 6, h = (task >> 2) & 15, qt = task & 3;
    const bf16* PROJ = (const bf16*)(F.ws + WS_PROJ); const bf16* LW = (const bf16*)(F.ws + WS_LW); const bf16* AA = (const bf16*)(F.ws + WS_AA);
    bf16* OY = (bf16*)(F.ws + WS_OY);
    LAS float* lbuf = (LAS float*)F.lds;
    const int c = F.lane, w = F.wave, r = F.lane >> 4, cg = F.lane & 15;
    const bool stager = w >= 4; const int sw = w & 3;
    const int ch = h * 64 + c;
    const float mu_r = F.in[I_MU][C_R + ch], mu_k = F.in[I_MU][C_K + ch], mu_v = F.in[I_MU][C_V + ch], kkw = F.in[I_KK][ch], kaw = F.in[I_KA][ch];
    RwkvRaw raw;
    if (stager) { rwkv_load(raw, PROJ, LW, AA, b, h, 8 * sw, c); rwkv_stage(raw, lbuf, 8 * sw, c, qt, mu_r, mu_k, mu_v, kkw, kaw); rwkv_load(raw, PROJ, LW, AA, b, h, TC + 8 * sw, c); }
    __syncthreads();
    f32x2 S01 = {0.f, 0.f}, S23 = {0.f, 0.f};
    const bool cb0 = cg & 1, cb1 = cg & 2, cb2 = cg & 4, cb3 = cg & 8;
    bf16* orow = OY + (size_t)(b * SEQ) * DM + h * 64 + 16 * qt + 4 * sw + r;
    for (int ck = 0; ck < NCHUNK; ++ck) {
        const LAS float* buf = lbuf + (ck & 1) * RB_SIZE;
        if (stager) {
            if (ck + 1 < NCHUNK) { rwkv_stage(raw, lbuf + ((ck + 1) & 1) * RB_SIZE, 8 * sw, c, qt, mu_r, mu_k, mu_v, kkw, kaw);
                if (ck + 2 < NCHUNK) rwkv_load(raw, PROJ, LW, AA, b, h, (ck + 2) * TC + 8 * sw, c); }
        } else {
            const LAS float* bp = buf + 4 * cg; const LAS float* vp = buf + RB_V + 4 * sw + r;
            f32x4 qkk[3], qw[3], qka[3], qk[3], qr[3]; float qv[3];
#pragma unroll
            for (int i = 0; i < 3; ++i) { qkk[i] = *(const LAS f32x4*)(bp + RB_KK + i * 64); qw[i] = *(const LAS f32x4*)(bp + RB_W + i * 64); qka[i] = *(const LAS f32x4*)(bp + RB_KA + i * 64);
                qk[i] = *(const LAS f32x4*)(bp + RB_K + i * 64); qr[i] = *(const LAS f32x4*)(bp + RB_R + i * 64); qv[i] = vp[i * 16]; }
            float op[16];
#pragma unroll
            for (int j = 0; j < TC; ++j) {
                const int u = j % 3;
                const f32x4 kk4 = qkk[u], w4 = qw[u], ka4 = qka[u], k4 = qk[u], r4 = qr[u]; const float vr = qv[u];
                const f32x2 tq = S01 * LO2(kk4) + S23 * HI2(kk4);
                const float sa = rowsum16(tq.x + tq.y);
                const f32x2 sav = {sa, sa}, vrv = {vr, vr};
                S01 = S01 * LO2(w4) + (vrv * LO2(k4) - sav * LO2(ka4));
                S23 = S23 * HI2(w4) + (vrv * HI2(k4) - sav * HI2(ka4));
                const f32x2 uq = S01 * LO2(r4) + S23 * HI2(r4);
                op[j & 15] = uq.x + uq.y;
                asm volatile("" : "+v"(S01), "+v"(S23) :: "memory");
                if (j + 3 < TC) { qkk[u] = *(const LAS f32x4*)(bp + RB_KK + (j + 3) * 64); qw[u] = *(const LAS f32x4*)(bp + RB_W + (j + 3) * 64); qka[u] = *(const LAS f32x4*)(bp + RB_KA + (j + 3) * 64);
                                  qk[u] = *(const LAS f32x4*)(bp + RB_K + (j + 3) * 64); qr[u] = *(const LAS f32x4*)(bp + RB_R + (j + 3) * 64); qv[u] = vp[(j + 3) * 16]; }
                if ((j & 15) == 15) {
                    const float ored = treduce16(op, cb0, cb1, cb2, cb3);
                    orow[(size_t)(ck * TC + (j - 15) + cg) * DM] = (bf16)(pk2(ored, 0.f) & 0xffffu);
                }
            }
        }
        __syncthreads();
    }
}

__device__ __forceinline__ void p4_scans(const Ctx& F) {
    for (int task = blockIdx.x; task < NB * RHEADS * 4; task += F.G) { rwkv_task(F, task); __syncthreads(); }
}

__device__ __forceinline__ void ld16(const float* p, float (&v)[16]) {
#pragma unroll
    for (int i = 0; i < 4; ++i) { const f32x4 t = *(const f32x4*)(p + 4 * i); v[4 * i] = t.x; v[4 * i + 1] = t.y; v[4 * i + 2] = t.z; v[4 * i + 3] = t.w; }
}
__device__ __forceinline__ void ldbf16x16(const bf16* p, float (&v)[16]) {
    float t0[8], t1[8]; unpack8(*(const v4u*)p, t0); unpack8(*(const v4u*)(p + 8), t1);
#pragma unroll
    for (int j = 0; j < 8; ++j) { v[j] = t0[j]; v[8 + j] = t1[j]; }
}
__device__ __forceinline__ void stbf16x16(bf16* p, const float (&v)[16]) {
    float t0[8], t1[8];
#pragma unroll
    for (int j = 0; j < 8; ++j) { t0[j] = v[j]; t1[j] = v[8 + j]; }
    *(v4u*)p = pack8(t0); *(v4u*)(p + 8) = pack8(t1);
}
__device__ __forceinline__ void p5_post(const Ctx& F) {
    const bf16* PROJ = (const bf16*)(F.ws + WS_PROJ); const bf16* AA = (const bf16*)(F.ws + WS_AA); const bf16* GG = (const bf16*)(F.ws + WS_GG);
    bf16* OY = (bf16*)(F.ws + WS_OY);
    const int c0 = 16 * F.lane;
    {
        float mur[16], muk[16], muv[16], ka[16], rk[16], lnw[16], lnb[16];
        ld16(F.in[I_MU] + C_R + c0, mur); ld16(F.in[I_MU] + C_K + c0, muk); ld16(F.in[I_MU] + C_V + c0, muv);
        ld16(F.in[I_KA] + c0, ka); ld16(F.in[I_RK] + c0, rk); ld16(F.in[I_LNW] + c0, lnw); ld16(F.in[I_LNB] + c0, lnb);
        for (int m = F.gw; m < M; m += F.NGW) {
            const bool first = (m % SEQ) == 0;
            const bf16* prow = PROJ + (size_t)m * INPP; bf16* oyrow = OY + (size_t)m * DM;
            float o[16], res[16]; float bs = 0.f;
            ldbf16x16(oyrow + c0, o);
            {
                float rc[16], rp[16], kc[16], kp[16], av[16];
                ldbf16x16(prow + C_R + c0, rc); ldbf16x16(prow + C_K + c0, kc); ldbf16x16(AA + (size_t)m * RW + c0, av);
                if (!first) { ldbf16x16(prow - INPP + C_R + c0, rp); ldbf16x16(prow - INPP + C_K + c0, kp); }
                else {
#pragma unroll
                    for (int j = 0; j < 16; ++j) { rp[j] = 0.f; kp[j] = 0.f; } }
#pragma unroll
                for (int j = 0; j < 16; ++j) { const float rr = rc[j] + (rp[j] - rc[j]) * mur[j], kx = kc[j] + (kp[j] - kc[j]) * muk[j];
                    bs += rr * (kx * (1.f + (av[j] - 1.f) * ka[j])) * rk[j]; }
            }
            bs = quadsum(bs);
            float s = 0.f;
#pragma unroll
            for (int j = 0; j < 16; ++j) s += o[j];
            const float mean = quadsum(s) * (1.f / 64.f);
            float qv = 0.f;
#pragma unroll
            for (int j = 0; j < 16; ++j) { o[j] -= mean; qv += o[j] * o[j]; }
            const float rstd = rsqrtf(quadsum(qv) * (1.f / 64.f) + 64e-5f);
            {
                float vc[16], vp[16], gv[16];
                ldbf16x16(prow + C_V + c0, vc); ldbf16x16(GG + (size_t)m * RW + c0, gv);
                if (!first) ldbf16x16(prow - INPP + C_V + c0, vp);
                else {
#pragma unroll
                    for (int j = 0; j < 16; ++j) vp[j] = 0.f; }
#pragma unroll
                for (int j = 0; j < 16; ++j) { const float vv = vc[j] + (vp[j] - vc[j]) * muv[j]; res[j] = (o[j] * rstd * lnw[j] + lnb[j] + bs * vv) * gv[j]; }
            }
            stbf16x16(oyrow + c0, res);
        }
    }
    {
        float nw[16]; ld16(F.in[I_MNW] + c0, nw);
        for (int m = F.gw; m < M; m += F.NGW) {
            const bf16* prow = PROJ + (size_t)m * INPP; bf16* oyrow = OY + (size_t)m * DM;
            float y[16], z[16];
            ldbf16x16(oyrow + RW + c0, y); ldbf16x16(prow + C_Z + c0, z);
            float qv = 0.f;
#pragma unroll
            for (int j = 0; j < 16; ++j) { y[j] *= silu_f(z[j]); qv += y[j] * y[j]; }
            qv = rowsum16(qv);
            { auto rr = __builtin_amdgcn_permlane16_swap(__float_as_uint(qv), __float_as_uint(qv), false, false); qv = __uint_as_float(rr[0]) + __uint_as_float(rr[1]); }
            const float rstd = rsqrtf(qv * (1.f / 512.f) + 1e-5f);
#pragma unroll
            for (int j = 0; j < 16; ++j) y[j] = y[j] * rstd * nw[j];
            stbf16x16(oyrow + RW + c0, y);
        }
    }
}
constexpr int MC_L = 128, MC_NC = SEQ / MC_L, LSTR = 136;
constexpr int MT_BYTES = 128 * LSTR * 2;
constexpr size_t WS_ST = 876 * MiB, WS_SIN = 940 * MiB, WS_ATOT = 1004 * MiB, WS_END2 = 1005 * MiB;

__device__ __forceinline__ float mamba_dt_scan(const Ctx& F, const bf16* PROJ, int b, int c, int g, LAS float* DT, LAS float* ACS) {
    const int head = g * 8 + F.wave, lane = F.lane;
    const float dtb = F.in[I_DTB][head], Aneg = -__expf(F.in[I_ALOG][head]);
    const bf16* p = PROJ + (size_t)(b * SEQ + c * MC_L + 2 * lane) * INPP + C_DT + head;
    const float x0 = bf1(p[0]) + dtb, x1 = bf1(p[INPP]) + dtb;
    const float d0 = (x0 > 20.f) ? x0 : log1pf(__expf(x0)), d1 = (x1 > 20.f) ? x1 : log1pf(__expf(x1));
    const float s0 = d0 * Aneg, s1 = s0 + d1 * Aneg;
    float incl = s1;
#pragma unroll
    for (int o = 1; o < 64; o <<= 1) { const float t = __shfl_up(incl, o); if (lane >= o) incl += t; }
    const float excl = incl - s1;
    DT[F.wave * 128 + 2 * lane] = d0; DT[F.wave * 128 + 2 * lane + 1] = d1;
    ACS[F.wave * 128 + 2 * lane] = excl + s0; ACS[F.wave * 128 + 2 * lane + 1] = excl + s1;
    return __shfl(incl, 63);
}
struct TRaw { bf16 v[35]; };
__device__ __forceinline__ void mstage_T_load(TRaw& raw, const bf16* PROJ, int b, int c, int chn, int tid) {
    const int t0 = 32 * (tid >> 7);
    const bf16* base = PROJ + (size_t)(b * SEQ + c * MC_L + t0) * INPP + C_XBC + chn;
    if (c * MC_L + t0 > 0) { raw.v[0] = base[-3 * INPP]; raw.v[1] = base[-2 * INPP]; raw.v[2] = base[-1 * INPP]; }
    else { raw.v[0] = 0; raw.v[1] = 0; raw.v[2] = 0; }
#pragma unroll
    for (int t = 0; t < 32; ++t) raw.v[3 + t] = base[(size_t)t * INPP];
}
template <bool SC>
__device__ __forceinline__ void mstage_T_store(const TRaw& raw, int chn, LAS bf16* dst, const LAS float* scale, const float* convw, const float* convb, int tid) {
    const int f = tid & 127, t0 = 32 * (tid >> 7);
    const float w0 = convw[chn], w1 = convw[1536 + chn], w2 = convw[2 * 1536 + chn], w3 = convw[3 * 1536 + chn], bb = convb[chn];
#pragma unroll
    for (int i8 = 0; i8 < 4; ++i8) {
        float e[8];
#pragma unroll
        for (int i = 0; i < 8; ++i) { const int t = 8 * i8 + i;
            float v = silu_f(bb + w0 * bf1(raw.v[t]) + w1 * bf1(raw.v[t + 1]) + w2 * bf1(raw.v[t + 2]) + w3 * bf1(raw.v[t + 3]));
            if (SC) v *= scale[t0 + t];
            e[i] = v; }
        *(LAS v4u*)(dst + f * LSTR + t0 + 8 * i8) = pack8(e);
    }
}
__device__ __forceinline__ void mstage_N(const bf16* PROJ, int b, int c, int g, LAS bf16* Bn, LAS bf16* Cn, const float* convw, const float* convb, int tid) {
    const int f8 = tid & 31, t0 = 8 * (tid >> 5);
    const int chn = (f8 < 16) ? (1024 + g * 128 + 8 * f8) : (1280 + g * 128 + 8 * (f8 - 16));
    LAS bf16* dst = ((f8 < 16) ? Bn : Cn) + 8 * (f8 & 15);
    const bf16* base = PROJ + (size_t)(b * SEQ + c * MC_L + t0) * INPP + C_XBC + chn;
    float w[4][8], bb[8];
#pragma unroll
    for (int i = 0; i < 4; ++i) { const f32x4 a = *(const f32x4*)(convw + i * 1536 + chn), d = *(const f32x4*)(convw + i * 1536 + chn + 4);
        w[i][0] = a.x; w[i][1] = a.y; w[i][2] = a.z; w[i][3] = a.w; w[i][4] = d.x; w[i][5] = d.y; w[i][6] = d.z; w[i][7] = d.w; }
    { const f32x4 a = *(const f32x4*)(convb + chn), d = *(const f32x4*)(convb + chn + 4); bb[0] = a.x; bb[1] = a.y; bb[2] = a.z; bb[3] = a.w; bb[4] = d.x; bb[5] = d.y; bb[6] = d.z; bb[7] = d.w; }
    float r0[8], r1[8], r2[8];
    if (c * MC_L + t0 > 0) { unpack8(*(const v4u*)(base - 3 * INPP), r0); unpack8(*(const v4u*)(base - 2 * INPP), r1); unpack8(*(const v4u*)(base - 1 * INPP), r2); }
    else {
#pragma unroll
        for (int k = 0; k < 8; ++k) { r0[k] = 0.f; r1[k] = 0.f; r2[k] = 0.f; } }
#pragma unroll
    for (int t = 0; t < 8; ++t) {
        float r3[8], e[8]; unpack8(*(const v4u*)(base + (size_t)t * INPP), r3);
#pragma unroll
        for (int k = 0; k < 8; ++k) { e[k] = silu_f(bb[k] + w[0][k] * r0[k] + w[1][k] * r1[k] + w[2][k] * r2[k] + w[3][k] * r3[k]); r0[k] = r1[k]; r1[k] = r2[k]; r2[k] = r3[k]; }
        *(LAS v4u*)(dst + (t0 + t) * LSTR) = pack8(e);
    }
}

__device__ __forceinline__ void m1_chunk_states(const Ctx& F) {
    const bf16* PROJ = (const bf16*)(F.ws + WS_PROJ); bf16* ST = (bf16*)(F.ws + WS_ST); float* ATOT = (float*)(F.ws + WS_ATOT);
    LAS bf16* BT = (LAS bf16*)F.lds; LAS bf16* XT = (LAS bf16*)(F.lds + MT_BYTES);
    LAS float* DT = (LAS float*)(F.lds + 3 * MT_BYTES); LAS float* ACS = DT + 8 * 128; LAS float* SCL = ACS + 8 * 128;
    const float* convw = F.in[I_CONVW]; const float* convb = F.in[I_CONVB];
    const int tid = F.tid, w = F.wave, lane = F.lane, r16 = lane & 15, q = lane >> 4;
    for (int it = blockIdx.x; it < NB * MC_NC * 2; it += F.G) {
        const int g = it & 1, c = (it >> 1) & (MC_NC - 1), b = it >> 7;
        __syncthreads();
        const float atot = mamba_dt_scan(F, PROJ, b, c, g, DT, ACS);
        if (lane == 0) ATOT[(b * MC_NC + c) * 16 + g * 8 + w] = atot;
        const int chB = 1024 + g * 128 + (tid & 127);
        TRaw ra, rb;
        mstage_T_load(ra, PROJ, b, c, chB, tid);
        mstage_T_load(rb, PROJ, b, c, (g * 8 + ((tid & 127) >> 6)) * 64 + (tid & 63), tid);
        LDS_WAIT();
        SCL[w * 128 + 2 * lane] = DT[w * 128 + 2 * lane] * __expf(atot - ACS[w * 128 + 2 * lane]);
        SCL[w * 128 + 2 * lane + 1] = DT[w * 128 + 2 * lane + 1] * __expf(atot - ACS[w * 128 + 2 * lane + 1]);
        mstage_T_store<false>(ra, chB, BT, nullptr, convw, convb, tid);
        mstage_T_load(ra, PROJ, b, c, (g * 8 + 2 + ((tid & 127) >> 6)) * 64 + (tid & 63), tid);
        __syncthreads();
#pragma unroll
        for (int hb = 0; hb < 2; ++hb) {
            if (hb == 1) mstage_T_load(ra, PROJ, b, c, (g * 8 + 6 + ((tid & 127) >> 6)) * 64 + (tid & 63), tid);
            { const int hl = 4 * hb + ((tid & 127) >> 6); mstage_T_store<true>(rb, (g * 8 + hl) * 64 + (tid & 63), XT, SCL + hl * 128, convw, convb, tid); }
            if (hb == 0) mstage_T_load(rb, PROJ, b, c, (g * 8 + 4 + ((tid & 127) >> 6)) * 64 + (tid & 63), tid);
            { const int hl = 4 * hb + 2 + ((tid & 127) >> 6); mstage_T_store<true>(ra, (g * 8 + hl) * 64 + (tid & 63), XT + 128 * LSTR, SCL + hl * 128, convw, convb, tid); }
            __syncthreads();
            const int hh = w >> 1, ph = w & 1;
            f32x4 acc[2][8];
#pragma unroll
            for (int a = 0; a < 2; ++a)
#pragma unroll
                for (int n = 0; n < 8; ++n) acc[a][n] = (f32x4){0.f, 0.f, 0.f, 0.f};
#pragma unroll
            for (int ks = 0; ks < 4; ++ks) {
                bf16x8 xa[2];
#pragma unroll
                for (int a = 0; a < 2; ++a) xa[a] = *(const LAS bf16x8*)(XT + (hh * 64 + 32 * ph + 16 * a + r16) * LSTR + 32 * ks + 8 * q);
#pragma unroll
                for (int n = 0; n < 8; ++n) { const bf16x8 bfr = *(const LAS bf16x8*)(BT + (16 * n + r16) * LSTR + 32 * ks + 8 * q);
#pragma unroll
                    for (int a = 0; a < 2; ++a) acc[a][n] = __builtin_amdgcn_mfma_f32_16x16x32_bf16(bfr, xa[a], acc[a][n], 0, 0, 0); }
            }
            bf16* st = ST + ((size_t)((b * MC_NC + c) * 16 + g * 8 + 4 * hb + hh)) * (64 * 128);
#pragma unroll
            for (int a = 0; a < 2; ++a)
#pragma unroll
                for (int n = 0; n < 8; ++n) { v2u o; o.x = pk2(acc[a][n][0], acc[a][n][1]); o.y = pk2(acc[a][n][2], acc[a][n][3]);
                    *(v2u*)(st + (32 * ph + 16 * a + r16) * 128 + 16 * n + 4 * q) = o; }
            __syncthreads();
        }
    }
}

__device__ __forceinline__ void m2_prefix(const Ctx& F) {
    const bf16* ST = (const bf16*)(F.ws + WS_ST); bf16* SIN = (bf16*)(F.ws + WS_SIN); const float* ATOT = (const float*)(F.ws + WS_ATOT);
    const int nthr = F.G * NTHR;
    for (int gi = blockIdx.x * NTHR + F.tid; gi < NB * 16 * 2048; gi += nthr) {
        const int e4 = gi & 2047, bh = gi >> 11, b = bh >> 4, h = bh & 15;
        float r0 = 0.f, r1 = 0.f, r2 = 0.f, r3 = 0.f;
#pragma unroll 4
        for (int c = 0; c < MC_NC; ++c) {
            const size_t o = ((size_t)((b * MC_NC + c) * 16 + h)) * 8192 + 4 * e4;
            v2u so; so.x = pk2(r0, r1); so.y = pk2(r2, r3);
            *(v2u*)(SIN + o) = so;
            const v2u sv = *(const v2u*)(ST + o); const float d = __expf(ATOT[(b * MC_NC + c) * 16 + h]);
            r0 = r0 * d + bflo(sv.x); r1 = r1 * d + bfhi(sv.x); r2 = r2 * d + bflo(sv.y); r3 = r3 * d + bfhi(sv.y);
        }
    }
}

__device__ __forceinline__ void m3_outputs(const Ctx& F) {
    const bf16* PROJ = (const bf16*)(F.ws + WS_PROJ); const bf16* SIN = (const bf16*)(F.ws + WS_SIN); bf16* OY = (bf16*)(F.ws + WS_OY);
    LAS bf16* Cn = (LAS bf16*)F.lds; LAS bf16* RB = (LAS bf16*)(F.lds + MT_BYTES);
    LAS bf16* Mw = (LAS bf16*)(F.lds + 2 * MT_BYTES) + F.wave * 16 * LSTR;
    LAS float* DT = (LAS float*)(F.lds + 3 * MT_BYTES); LAS float* ACS = DT + 8 * 128;
    const float* convw = F.in[I_CONVW]; const float* convb = F.in[I_CONVB];
    const int tid = F.tid, w = F.wave, lane = F.lane, r16 = lane & 15, q = lane >> 4;
    for (int it = blockIdx.x; it < NB * MC_NC * 2; it += F.G) {
        const int g = it & 1, c = (it >> 1) & (MC_NC - 1), b = it >> 7;
        __syncthreads();
        (void)mamba_dt_scan(F, PROJ, b, c, g, DT, ACS);
        mstage_N(PROJ, b, c, g, RB, Cn, convw, convb, tid);
        __syncthreads();
        TRaw rx;
        mstage_T_load(rx, PROJ, b, c, (g * 8 + ((tid & 127) >> 6)) * 64 + (tid & 63), tid);
        bf16x8 cf[4];
#pragma unroll
        for (int ks = 0; ks < 4; ++ks) cf[ks] = *(const LAS bf16x8*)(Cn + (16 * w + r16) * LSTR + 32 * ks + 8 * q);
        f32x4 Gt[8];
#pragma unroll
        for (int nt = 0; nt < 8; ++nt) { Gt[nt] = (f32x4){0.f, 0.f, 0.f, 0.f};
#pragma unroll
            for (int ks = 0; ks < 4; ++ks) Gt[nt] = __builtin_amdgcn_mfma_f32_16x16x32_bf16(*(const LAS bf16x8*)(RB + (16 * nt + r16) * LSTR + 32 * ks + 8 * q), cf[ks], Gt[nt], 0, 0, 0); }
        const int l = 16 * w + r16;
        const size_t mrow = (size_t)(b * SEQ + c * MC_L + l);
#pragma unroll 1
        for (int hb = 0; hb < 4; ++hb) {
            __syncthreads();
            { const int hl = 2 * hb + ((tid & 127) >> 6); mstage_T_store<false>(rx, (g * 8 + hl) * 64 + (tid & 63), RB, nullptr, convw, convb, tid); }
            { const int hn = (hb < 3) ? 2 * (hb + 1) : 2 * hb; mstage_T_load(rx, PROJ, b, c, (g * 8 + hn + ((tid & 127) >> 6)) * 64 + (tid & 63), tid); }
            __syncthreads();
#pragma unroll 1
            for (int h2 = 0; h2 < 2; ++h2) {
                const int hl = 2 * hb + h2, head = g * 8 + hl;
                const float acs_l = ACS[hl * 128 + l];
                const bf16* sin = SIN + ((size_t)((b * MC_NC + c) * 16 + head)) * 8192;
                bf16x8 sf[4][4];
#pragma unroll
                for (int pt = 0; pt < 4; ++pt)
#pragma unroll
                    for (int ks = 0; ks < 4; ++ks) sf[pt][ks] = *(const bf16x8*)(sin + (16 * pt + r16) * 128 + 32 * ks + 8 * q);
#pragma unroll
                for (int nt = 0; nt < 8; ++nt) { const f32x4 as = *(const LAS f32x4*)(ACS + hl * 128 + 16 * nt + 4 * q), ds = *(const LAS f32x4*)(DT + hl * 128 + 16 * nt + 4 * q);
                    float mv[4];
#pragma unroll
                    for (int j = 0; j < 4; ++j) { const int s = 16 * nt + 4 * q + j; mv[j] = (s <= l) ? Gt[nt][j] * __expf(acs_l - as[j]) * ds[j] : 0.f; }
                    v2u o; o.x = pk2(mv[0], mv[1]); o.y = pk2(mv[2], mv[3]);
                    *(LAS v2u*)(Mw + r16 * LSTR + 16 * nt + 4 * q) = o; }
                LDS_WAIT(); asm volatile("" ::: "memory");
                bf16x8 mf[4];
#pragma unroll
                for (int ks = 0; ks < 4; ++ks) mf[ks] = *(const LAS bf16x8*)(Mw + r16 * LSTR + 32 * ks + 8 * q);
                const float el = __expf(acs_l), Dh = F.in[I_DSK][head];
#pragma unroll
                for (int pt = 0; pt < 4; ++pt) {
                    f32x4 yd = {0.f, 0.f, 0.f, 0.f}, yo = {0.f, 0.f, 0.f, 0.f};
#pragma unroll
                    for (int ks = 0; ks < 4; ++ks) {
                        yd = __builtin_amdgcn_mfma_f32_16x16x32_bf16(*(const LAS bf16x8*)(RB + (h2 * 64 + 16 * pt + r16) * LSTR + 32 * ks + 8 * q), mf[ks], yd, 0, 0, 0);
                        yo = __builtin_amdgcn_mfma_f32_16x16x32_bf16(sf[pt][ks], cf[ks], yo, 0, 0, 0); }
                    float yv[4];
#pragma unroll
                    for (int j = 0; j < 4; ++j) yv[j] = yd[j] + el * yo[j] + Dh * bf1(RB[(h2 * 64 + 16 * pt + 4 * q + j) * LSTR + l]);
                    v2u o; o.x = pk2(yv[0], yv[1]); o.y = pk2(yv[2], yv[3]);
                    *(v2u*)(OY + mrow * DM + RW + head * 64 + 16 * pt + 4 * q) = o;
                }
                asm volatile("" ::: "memory");
            }
        }
    }
}
constexpr int RC = 16, RNCH = SEQ / RC, NPART = 4, RHALF = RNCH / NPART, RITEMS = NB * RHEADS * RHALF;
constexpr size_t RO_WH = 0, RO_RH = 16 * MiB, RO_VT = 32 * MiB, RO_ET = 48 * MiB, RO_OL = 64 * MiB, RO_A2 = 80 * MiB, RO_GC = 112 * MiB, RO_BUF = 116 * MiB, RO_SS = 232 * MiB;
constexpr int RL_KAP = 0, RL_ALP = 2304, RL_KT = 4608, RL_RT = 6912, RL_KAPT = 9216, RL_VT = 11264, RL_TB = 13312, RL_BL = 14336, RL_QL = 15360, RL_PL = 16384,
              RL_WT = RL_KAP, RL_BVT = RL_ALP, RL_AL32 = RL_KT, RL_ET = RL_KT,
              RL_BYTES = 18176;
constexpr int XS = 72, TS = 16, SS16 = 32;

__device__ __forceinline__ float wave_sum_pl(float x) {
    x = rowsum16(x);
    { auto rr = __builtin_amdgcn_permlane16_swap(__float_as_uint(x), __float_as_uint(x), false, false); x = __uint_as_float(rr[0]) + __uint_as_float(rr[1]); }
    { auto rr = __builtin_amdgcn_permlane32_swap(__float_as_uint(x), __float_as_uint(x), false, false); x = __uint_as_float(rr[0]) + __uint_as_float(rr[1]); }
    return x;
}
__device__ __forceinline__ v2u pack4(const f32x4 a) { v2u o; o.x = pk2(a[0], a[1]); o.y = pk2(a[2], a[3]); return o; }
__device__ __forceinline__ f32x4 unpack4(const v2u u) { return (f32x4){bflo(u.x), bfhi(u.x), bflo(u.y), bfhi(u.y)}; }
__device__ __forceinline__ bf16 f2b(float x) { return (bf16)pk2(x, 0.f); }

__device__ __forceinline__ void ra_item(const Ctx& F, LAS unsigned char* wl, int it, int half) {
    const int bh = it / RHALF, cl = it - bh * RHALF, ci = half * RHALF + cl, b = bh >> 4, h = bh & 15;
    const bf16* PROJ = (const bf16*)(F.ws + WS_PROJ); const bf16* LW = (const bf16*)(F.ws + WS_LW); const bf16* AA = (const bf16*)(F.ws + WS_AA);
    unsigned char* RO = (unsigned char*)F.out + (size_t)(half & 1) * RO_BUF;
    const int lane = F.lane, r16 = lane & 15, q = lane >> 4, c = lane, ch = h * 64 + c;
    const size_t m0 = (size_t)b * SEQ + (size_t)RC * ci;
    LAS bf16* KAP = (LAS bf16*)(wl + RL_KAP); LAS bf16* ALP = (LAS bf16*)(wl + RL_ALP); LAS bf16* KT = (LAS bf16*)(wl + RL_KT); LAS bf16* RT = (LAS bf16*)(wl + RL_RT);
    LAS bf16* KAPT = (LAS bf16*)(wl + RL_KAPT); LAS bf16* VTL = (LAS bf16*)(wl + RL_VT); LAS bf16* WT = (LAS bf16*)(wl + RL_WT); LAS bf16* BVT = (LAS bf16*)(wl + RL_BVT); LAS bf16* ETL = (LAS bf16*)(wl + RL_ET);
    LAS bf16* TB = (LAS bf16*)(wl + RL_TB); LAS bf16* BL = (LAS bf16*)(wl + RL_BL); LAS bf16* QL = (LAS bf16*)(wl + RL_QL); LAS bf16* PL = (LAS bf16*)(wl + RL_PL);
    const float mu_r = F.in[I_MU][C_R + ch], mu_k = F.in[I_MU][C_K + ch], mu_v = F.in[I_MU][C_V + ch], kkw = F.in[I_KK][ch], kaw = F.in[I_KA][ch];
    const bf16* prow = PROJ + m0 * INPP + ch;
    float rp = 0.f, kp = 0.f, vp = 0.f;
    if (ci > 0) { rp = bf1(prow[-INPP + C_R]); kp = bf1(prow[-INPP + C_K]); vp = bf1(prow[-INPP + C_V]); }
    float ec = 1.f, kkna[RC], kpv[RC], env[RC], vvv[RC];
    float cum = 0.f;
#pragma unroll
    for (int t = 0; t < RC; ++t) {
        const bf16* row = prow + (size_t)t * INPP;
        const float rc = bf1(row[C_R]), kc = bf1(row[C_K]), vc = bf1(row[C_V]);
        const float a = bf1(AA[(m0 + t) * RW + ch]), lw = bf1(LW[(m0 + t) * RW + ch]);
        const float rr = rc + (rp - rc) * mu_r, kx = kc + (kp - kc) * mu_k, vv = vc + (vp - vc) * mu_v;
        rp = rc; kp = kc; vp = vc;
        const float kkraw = kx * kkw; const float ss = wave_sum_pl(kkraw * kkraw);
        const float kkn = kkraw * rcp_f(fmaxf(sqrtf(ss), 1e-12f));
        const float kpp = kx * (1.f + (a - 1.f) * kaw);
        const float ep = ec; cum += lw; ec = __expf(cum); const float en = rcp_f(ec);
        const unsigned p0 = pk2(kkn * ep, kkn * a * en), p1 = pk2(kpp * en, rr * ec), p2 = pk2(vv, 0.f);
        KAP[t * XS + c] = (bf16)p0; ALP[t * XS + c] = (bf16)(p0 >> 16); KT[t * XS + c] = (bf16)p1; RT[t * XS + c] = (bf16)(p1 >> 16);
        KAPT[c * TS + t] = (bf16)p0; VTL[c * TS + t] = (bf16)p2;
        kkna[t] = kkn * a; kpv[t] = kpp; env[t] = en; vvv[t] = vv;
    }
    {
        float e8[8]; v4u* vt = (v4u*)((bf16*)(RO + RO_VT) + (size_t)it * 1024 + c * 16);
#pragma unroll
        for (int i = 0; i < 8; ++i) e8[i] = vvv[i];
        vt[0] = pack8(e8);
#pragma unroll
        for (int i = 0; i < 8; ++i) e8[i] = vvv[8 + i];
        vt[1] = pack8(e8);
        v4u* a2 = (v4u*)((bf16*)(RO + RO_A2) + (size_t)it * 2048 + c * 32);
        float dd[RC];
#pragma unroll
        for (int t = 0; t < RC; ++t) dd[t] = ec * env[t];
#pragma unroll
        for (int i = 0; i < 8; ++i) e8[i] = -kkna[i] * dd[i];
        a2[0] = pack8(e8);
#pragma unroll
        for (int i = 0; i < 8; ++i) e8[i] = -kkna[8 + i] * dd[8 + i];
        a2[1] = pack8(e8);
#pragma unroll
        for (int i = 0; i < 8; ++i) e8[i] = kpv[i] * dd[i];
        a2[2] = pack8(e8);
#pragma unroll
        for (int i = 0; i < 8; ++i) e8[i] = kpv[8 + i] * dd[8 + i];
        a2[3] = pack8(e8);
        ((float*)(RO + RO_GC))[(size_t)it * 64 + c] = ec;
    }
    LDS_WAIT(); asm volatile("" ::: "memory");
    const v2u zero2 = {0u, 0u};
    {
        f32x4 alt = {0.f, 0.f, 0.f, 0.f}, blt = alt, qlt = alt, plt = alt;
#pragma unroll
        for (int ks = 0; ks < 2; ++ks) {
            const bf16x8 fa = *(const LAS bf16x8*)(ALP + r16 * XS + 32 * ks + 8 * q), fk = *(const LAS bf16x8*)(KT + r16 * XS + 32 * ks + 8 * q);
            const bf16x8 fkp = *(const LAS bf16x8*)(KAP + r16 * XS + 32 * ks + 8 * q), fr = *(const LAS bf16x8*)(RT + r16 * XS + 32 * ks + 8 * q);
            alt = __builtin_amdgcn_mfma_f32_16x16x32_bf16(fa, fkp, alt, 0, 0, 0); blt = __builtin_amdgcn_mfma_f32_16x16x32_bf16(fk, fkp, blt, 0, 0, 0);
            qlt = __builtin_amdgcn_mfma_f32_16x16x32_bf16(fa, fr, qlt, 0, 0, 0);  plt = __builtin_amdgcn_mfma_f32_16x16x32_bf16(fk, fr, plt, 0, 0, 0);
        }
#pragma unroll
        for (int j = 0; j < 4; ++j) { const int s = 4 * q + j; const bool lt = s < r16, le = s <= r16;
            alt[j] = lt ? alt[j] : 0.f; blt[j] = lt ? blt[j] : 0.f; qlt[j] = le ? qlt[j] : 0.f; plt[j] = le ? plt[j] : 0.f; }
        *(LAS v2u*)(BL + r16 * SS16 + 4 * q) = pack4(blt); *(LAS v2u*)(QL + r16 * SS16 + 4 * q) = pack4(qlt); *(LAS v2u*)(PL + r16 * SS16 + 4 * q) = pack4(plt);
        *(LAS v2u*)(BL + r16 * SS16 + 16 + 4 * q) = zero2; *(LAS v2u*)(QL + r16 * SS16 + 16 + 4 * q) = zero2; *(LAS v2u*)(PL + r16 * SS16 + 16 + 4 * q) = zero2;
        float x[RC];
#pragma unroll
        for (int t = 0; t < RC; ++t) {
            float acc = (t == r16) ? 1.f : 0.f;
#pragma unroll
            for (int s2 = 0; s2 < t; ++s2) { const float a_ts = __uint_as_float(__builtin_amdgcn_readlane(__float_as_uint(alt[s2 & 3]), 16 * (s2 >> 2) + t)); acc -= a_ts * x[s2]; }
            x[t] = acc;
        }
        if (q == 0) {
#pragma unroll
            for (int t = 0; t < RC; ++t) { TB[t * SS16 + r16] = f2b(x[t]); TB[t * SS16 + 16 + r16] = 0; }
        }
    }
    LDS_WAIT(); asm volatile("" ::: "memory");
    const bf16x8 zf = {0, 0, 0, 0, 0, 0, 0, 0};
    const bf16x8 tbf = *(const LAS bf16x8*)(TB + r16 * SS16 + 8 * q), blf = *(const LAS bf16x8*)(BL + r16 * SS16 + 8 * q);
    const bf16x8 qlf = *(const LAS bf16x8*)(QL + r16 * SS16 + 8 * q), plf = *(const LAS bf16x8*)(PL + r16 * SS16 + 8 * q);
    const f32x4 z4 = {0.f, 0.f, 0.f, 0.f};
    bf16* gWH = (bf16*)(RO + RO_WH) + (size_t)it * 1024; bf16* gRH = (bf16*)(RO + RO_RH) + (size_t)it * 1024;
    bf16* gET = (bf16*)(RO + RO_ET) + (size_t)it * 1024; bf16* gOL = (bf16*)(RO + RO_OL) + (size_t)it * 1024;
#pragma unroll
    for (int kt = 0; kt < 4; ++kt) {
        const bf16x8 kf = (q < 2) ? *(const LAS bf16x8*)(KAPT + (16 * kt + r16) * TS + 8 * q) : zf;
        const f32x4 wa = __builtin_amdgcn_mfma_f32_16x16x32_bf16(kf, tbf, z4, 0, 0, 0);
        *(v2u*)(gWH + r16 * 64 + 16 * kt + 4 * q) = pack4(wa);
        const f32x4 wb = __builtin_amdgcn_mfma_f32_16x16x32_bf16(tbf, kf, z4, 0, 0, 0);
        *(LAS v2u*)(WT + (16 * kt + r16) * TS + 4 * q) = pack4(wb);
        const bf16x8 vf = (q < 2) ? *(const LAS bf16x8*)(VTL + (16 * kt + r16) * TS + 8 * q) : zf;
        const f32x4 bv = __builtin_amdgcn_mfma_f32_16x16x32_bf16(blf, vf, z4, 0, 0, 0);
        *(LAS v2u*)(BVT + (16 * kt + r16) * TS + 4 * q) = pack4(bv);
    }
    LDS_WAIT(); asm volatile("" ::: "memory");
#pragma unroll
    for (int vt = 0; vt < 4; ++vt) {
        const bf16x8 bf_ = (q < 2) ? *(const LAS bf16x8*)(BVT + (16 * vt + r16) * TS + 8 * q) : zf;
        const f32x4 e4 = __builtin_amdgcn_mfma_f32_16x16x32_bf16(tbf, bf_, z4, 0, 0, 0);
        const v2u ep = pack4(e4);
        *(LAS v2u*)(ETL + (16 * vt + r16) * TS + 4 * q) = ep; *(v2u*)(gET + (16 * vt + r16) * 16 + 4 * q) = ep;
    }
    LDS_WAIT(); asm volatile("" ::: "memory");
#pragma unroll
    for (int kt = 0; kt < 4; ++kt) {
        const bf16x8 wf = (q < 2) ? *(const LAS bf16x8*)(WT + (16 * kt + r16) * TS + 8 * q) : zf;
        const f32x4 qw = __builtin_amdgcn_mfma_f32_16x16x32_bf16(wf, qlf, z4, 0, 0, 0);
        const f32x4 rt4 = unpack4(*(const LAS v2u*)(RT + r16 * XS + 16 * kt + 4 * q));
        *(v2u*)(gRH + r16 * 64 + 16 * kt + 4 * q) = pack4(rt4 - qw);
        const bf16x8 vf = (q < 2) ? *(const LAS bf16x8*)(VTL + (16 * kt + r16) * TS + 8 * q) : zf;
        const bf16x8 ef = (q < 2) ? *(const LAS bf16x8*)(ETL + (16 * kt + r16) * TS + 8 * q) : zf;
        const f32x4 pv = __builtin_amdgcn_mfma_f32_16x16x32_bf16(vf, plf, z4, 0, 0, 0);
        const f32x4 qe = __builtin_amdgcn_mfma_f32_16x16x32_bf16(ef, qlf, z4, 0, 0, 0);
        *(v2u*)(gOL + r16 * 64 + 16 * kt + 4 * q) = pack4(pv - qe);
    }
    LDS_WAIT(); asm volatile("" ::: "memory");
}
__device__ __forceinline__ void ra_part(const Ctx& F, int part) {
    LAS unsigned* ctr = (LAS unsigned*)(F.lds + LDS_BYTES - 48) + part;
    LAS unsigned char* wl = F.lds + F.wave * RL_BYTES;
    for (;;) {
        unsigned idx = 0;
        if (F.lane == 0) idx = __hip_atomic_fetch_add(ctr, 1u, __ATOMIC_RELAXED, __HIP_MEMORY_SCOPE_WORKGROUP);
        idx = (unsigned)__builtin_amdgcn_readfirstlane((int)idx);
        const int it = (int)blockIdx.x + F.G * (int)idx;
        if (it >= RITEMS) break;
        ra_item(F, wl, it, part);
    }
}

__device__ __forceinline__ void rs_half(const Ctx& F, int half) {
    if (F.wave != 0) return;
    const unsigned char* RO = (const unsigned char*)F.out + (size_t)(half & 1) * RO_BUF; bf16* OY = (bf16*)(F.ws + WS_OY);
    float* SSg = (float*)((unsigned char*)F.out + RO_SS);
    LAS bf16* ST = (LAS bf16*)F.lds;
    LAS bf16* ZT = (LAS bf16*)(F.lds + 16 * XS * 2);
    constexpr int ZS = 24;
    const int lane = F.lane, r16 = lane & 15, q = lane >> 4;
    for (int blk = blockIdx.x; blk < NB * RHEADS * 4; blk += F.G) {
        const int xcd = blk & 7, jj = blk >> 3, qt = jj & 3, bh = (jj >> 2) * 8 + xcd, b = bh >> 4, h = bh & 15;
        f32x4 S[4];
        if (half == 0) {
#pragma unroll
            for (int kt = 0; kt < 4; ++kt) S[kt] = (f32x4){0.f, 0.f, 0.f, 0.f};
        } else {
#pragma unroll
            for (int kt = 0; kt < 4; ++kt) S[kt] = *(const f32x4*)(SSg + (size_t)blk * 1024 + (kt * 64 + lane) * 4);
        }
#pragma unroll
        for (int kt = 0; kt < 4; ++kt) *(LAS v2u*)(ST + r16 * XS + 16 * kt + 4 * q) = pack4(S[kt]);
        LDS_WAIT(); asm volatile("" ::: "memory");
        const size_t it0 = (size_t)bh * RHALF;
        const size_t mbase = (size_t)b * SEQ + (size_t)half * RHALF * RC;
#define RS_LOAD(IT, WF, RF, A2F, VF, ET4, OL4, GC4) do { const size_t it_ = (IT); \
        const bf16* wh_ = (const bf16*)(RO + RO_WH) + it_ * 1024 + r16 * 64 + 8 * q; const bf16* rh_ = (const bf16*)(RO + RO_RH) + it_ * 1024 + r16 * 64 + 8 * q; \
        WF[0] = *(const bf16x8*)wh_; WF[1] = *(const bf16x8*)(wh_ + 32); RF[0] = *(const bf16x8*)rh_; RF[1] = *(const bf16x8*)(rh_ + 32); \
        _Pragma("unroll") for (int kt_ = 0; kt_ < 4; ++kt_) { A2F[kt_] = *(const bf16x8*)((const bf16*)(RO + RO_A2) + it_ * 2048 + (16 * kt_ + r16) * 32 + 8 * q); \
            GC4[kt_] = *(const f32x4*)((const float*)(RO + RO_GC) + it_ * 64 + 16 * kt_ + 4 * q); } \
        VF = *(const bf16x8*)((const bf16*)(RO + RO_VT) + it_ * 1024 + (16 * qt + r16) * 16 + 8 * (q & 1)); \
        ET4 = *(const v2u*)((const bf16*)(RO + RO_ET) + it_ * 1024 + (16 * qt + r16) * 16 + 4 * q); \
        OL4 = *(const v2u*)((const bf16*)(RO + RO_OL) + it_ * 1024 + r16 * 64 + 16 * qt + 4 * q); } while (0)
        bf16x8 wfq[2][2], rfq[2][2], a2q[2][4], vfq[2]; v2u etq[2], olq[2]; f32x4 gcq[2][4];
#pragma unroll
        for (int u = 0; u < 2; ++u) RS_LOAD(it0 + u, wfq[u], rfq[u], a2q[u], vfq[u], etq[u], olq[u], gcq[u]);
#define RS_STEP(U, CL) do { const int cl_ = (CL); \
            const bf16x8 sb0 = *(const LAS bf16x8*)(ST + r16 * XS + 8 * q), sb1 = *(const LAS bf16x8*)(ST + r16 * XS + 32 + 8 * q); \
            f32x4 x1 = __builtin_amdgcn_mfma_f32_16x16x32_bf16(wfq[U][0], sb0, (f32x4){0.f, 0.f, 0.f, 0.f}, 0, 0, 0); \
            x1 = __builtin_amdgcn_mfma_f32_16x16x32_bf16(wfq[U][1], sb1, x1, 0, 0, 0); \
            f32x4 ot = __builtin_amdgcn_mfma_f32_16x16x32_bf16(sb0, rfq[U][0], unpack4(olq[U]), 0, 0, 0); \
            ot = __builtin_amdgcn_mfma_f32_16x16x32_bf16(sb1, rfq[U][1], ot, 0, 0, 0); \
            *(LAS v2u*)(ZT + r16 * ZS + 4 * q) = pack4(x1 + unpack4(etq[U])); \
            *(v2u*)(OY + (mbase + (size_t)cl_ * RC + r16) * DM + h * 64 + 16 * qt + 4 * q) = pack4(ot); \
            LDS_WAIT(); asm volatile("" ::: "memory"); \
            const bf16x8 zr = *(const LAS bf16x8*)(ZT + r16 * ZS + 8 * (q & 1)); \
            const bf16x8 bz = (q < 2) ? zr : vfq[U]; \
            _Pragma("unroll") for (int kt = 0; kt < 4; ++kt) { S[kt] = __builtin_amdgcn_mfma_f32_16x16x32_bf16(a2q[U][kt], bz, S[kt] * gcq[U][kt], 0, 0, 0); \
                *(LAS v2u*)(ST + r16 * XS + 16 * kt + 4 * q) = pack4(S[kt]); } \
            RS_LOAD(it0 + ((cl_ + 2 < RHALF) ? cl_ + 2 : RHALF - 1), wfq[U], rfq[U], a2q[U], vfq[U], etq[U], olq[U], gcq[U]);     \
            LDS_WAIT(); asm volatile("" ::: "memory"); } while (0)
#pragma unroll 1
        for (int cl = 0; cl < RHALF; cl += 2) { RS_STEP(0, cl); RS_STEP(1, cl + 1); }
#undef RS_STEP
#undef RS_LOAD
        if (half + 1 < NPART) {
#pragma unroll
            for (int kt = 0; kt < 4; ++kt) *(f32x4*)(SSg + (size_t)blk * 1024 + (kt * 64 + lane) * 4) = S[kt];
        }
    }
}
__device__ __forceinline__ float rowmax16(float x) { x = fmaxf(x, dpp_f<0xB1>(x)); x = fmaxf(x, dpp_f<0x4E>(x)); x = fmaxf(x, dpp_f<0x124>(x)); x = fmaxf(x, dpp_f<0x128>(x)); return x; }
__device__ __forceinline__ int cand_code(int s) {
    if (s < 16) return s << 4;
    if (s < 24) return 1 | ((s - 16) << 4);
    if (s < 29) return 2 | ((s - 24) << 4);
    if (s < 33) return 3 | ((s - 29) << 4);
    if (s < 36) return 4 | ((s - 33) << 4);
    if (s < 42) { const int k = s - 36; return (5 + (k >> 1)) | ((k & 1) << 4); }
    if (s < 50) return 8 + (s - 42);
    return -1;
}
__device__ __forceinline__ int f2ord(float f) { const int b = __float_as_int(f); return b ^ ((b >> 31) & 0x7fffffff); }
__device__ __forceinline__ float ord2f(int k) { return __int_as_float(k ^ ((k >> 31) & 0x7fffffff)); }
template <int CTRL> __device__ __forceinline__ int dpp_i(int x) { return __builtin_amdgcn_mov_dpp(x, CTRL, 0xf, 0xf, true); }
__device__ __forceinline__ int imax(int a, int b) { return a > b ? a : b; }
__device__ __forceinline__ int imin(int a, int b) { return a < b ? a : b; }
__device__ __forceinline__ int rowmax16_i(int x) { x = imax(x, dpp_i<0xB1>(x)); x = imax(x, dpp_i<0x4E>(x)); x = imax(x, dpp_i<0x124>(x)); x = imax(x, dpp_i<0x128>(x)); return x; }
#define CSWAP_(a, b) do { const int hi_ = imax(a, b), lo_ = imin(a, b); a = hi_; b = lo_; } while (0)
template <int NV> __device__ __forceinline__ void sort_desc(int (&v)[NV]);
template <> __device__ __forceinline__ void sort_desc<8>(int (&v)[8]) {
    CSWAP_(v[0], v[1]); CSWAP_(v[2], v[3]); CSWAP_(v[4], v[5]); CSWAP_(v[6], v[7]);
    CSWAP_(v[0], v[2]); CSWAP_(v[1], v[3]); CSWAP_(v[4], v[6]); CSWAP_(v[5], v[7]);
    CSWAP_(v[1], v[2]); CSWAP_(v[5], v[6]);
    CSWAP_(v[0], v[4]); CSWAP_(v[1], v[5]); CSWAP_(v[2], v[6]); CSWAP_(v[3], v[7]);
    CSWAP_(v[2], v[4]); CSWAP_(v[3], v[5]);
    CSWAP_(v[1], v[2]); CSWAP_(v[3], v[4]); CSWAP_(v[5], v[6]);
}
template <> __device__ __forceinline__ void sort_desc<4>(int (&v)[4]) {
    CSWAP_(v[0], v[1]); CSWAP_(v[2], v[3]); CSWAP_(v[0], v[2]); CSWAP_(v[1], v[3]); CSWAP_(v[1], v[2]);
}
template <int NV>
__device__ __forceinline__ void select16x4(int (&v)[4][NV], int r16, float (&kept_f)[4]) {
    const int IMIN = (int)0x80000000;
    int kept[4];
#pragma unroll
    for (int j = 0; j < 4; ++j) { kept[j] = IMIN; sort_desc<NV>(v[j]); }
#pragma unroll 1
    for (int rd = 0; rd < 16; ++rd) {
#pragma unroll
        for (int j = 0; j < 4; ++j) {
            const int m = rowmax16_i(v[j][0]);
            kept[j] = (r16 == rd) ? m : kept[j];
            const bool own = (v[j][0] == m);
#pragma unroll
            for (int i = 0; i < NV - 1; ++i) v[j][i] = own ? v[j][i + 1] : v[j][i];
            v[j][NV - 1] = own ? IMIN : v[j][NV - 1];
        }
    }
#pragma unroll
    for (int j = 0; j < 4; ++j) kept_f[j] = ord2f(kept[j]);
}
__device__ __forceinline__ float dot2bf(unsigned a, unsigned b, float acc) { return __builtin_amdgcn_fdot2_f32_bf16(__builtin_bit_cast(bf16x2_t, a), __builtin_bit_cast(bf16x2_t, b), acc, false); }

constexpr int PT = 16;
constexpr size_t RANGE_BYTES = (size_t)NEXP * 128;

__device__ __forceinline__ void p9_route(const Ctx& F) {
    constexpr int KSTR = 136;
    const bf16* Q = (const bf16*)(F.ws + WS_Q); const bf16* KEYS = (const bf16*)(F.ws + WS_KEYS);
    int* rtE = (int*)(F.ws + WS_RTE); float* rtG = (float*)(F.ws + WS_RTG);
    LAS bf16* KL = (LAS bf16*)F.lds;
    const int lane = F.lane, w = F.wave, r16 = lane & 15, q = lane >> 4, gbase = lane & 48;
    const int h = blockIdx.x & 7, nbh = (F.G - h + 7) >> 3;
    __syncthreads();
    for (int i = F.tid; i < 2 * 128 * 16; i += NTHR) { const int row = i >> 4, ch = i & 15;
        *(LAS v4u*)(KL + row * KSTR + 8 * ch) = *(const v4u*)(KEYS + (size_t)(2 * h * 128 + row) * 128 + 8 * ch); }
    __syncthreads();
    int ci[4], cj[4]; bool cvalid[4];
#pragma unroll
    for (int u = 0; u < 4; ++u) { const int cd = cand_code(r16 + 16 * u); cvalid[u] = cd >= 0; ci[u] = cd & 15; cj[u] = (cd >> 4) & 15; }
    const float NINF = -__builtin_inff();
    const int tstride = nbh * NWAVES;
    int tile = (blockIdx.x >> 3) * NWAVES + w;
    bf16x8 afn[2][4];
    if (tile < M / PT) {
#pragma unroll
        for (int p = 0; p < 2; ++p)
#pragma unroll
            for (int s = 0; s < 4; ++s) afn[p][s] = *(const bf16x8*)(Q + (size_t)(tile * PT + r16) * DM + (2 * h + p) * 128 + 8 * q + 32 * s);
    }
    for (; tile < M / PT; tile += tstride) {
        const int m0 = tile * PT;
        bf16x8 af[2][4];
#pragma unroll
        for (int p = 0; p < 2; ++p)
#pragma unroll
            for (int s = 0; s < 4; ++s) af[p][s] = afn[p][s];
        { const int tn = (tile + tstride < M / PT) ? tile + tstride : tile;
#pragma unroll
            for (int p = 0; p < 2; ++p)
#pragma unroll
                for (int s = 0; s < 4; ++s) afn[p][s] = *(const bf16x8*)(Q + (size_t)(tn * PT + r16) * DM + (2 * h + p) * 128 + 8 * q + 32 * s);
        }
        float top[2][4];
#pragma unroll
        for (int p = 0; p < 2; ++p) {
            int v[4][8];
#pragma unroll
            for (int nt = 0; nt < 8; ++nt) {
                const LAS bf16* krow = KL + (p * 128 + nt * 16 + r16) * KSTR + 8 * q;
                f32x4 acc = {0.f, 0.f, 0.f, 0.f};
#pragma unroll
                for (int s = 0; s < 4; ++s) acc = __builtin_amdgcn_mfma_f32_16x16x32_bf16(af[p][s], *(const LAS bf16x8*)(krow + 32 * s), acc, 0, 0, 0);
                const unsigned tag = 127u - (unsigned)(nt * 16 + r16);
#pragma unroll
                for (int j = 0; j < 4; ++j) v[j][nt] = f2ord(__uint_as_float((__float_as_uint(acc[j]) & ~127u) | tag));
                if (nt & 1) asm volatile("" ::: "memory");
            }
            select16x4<8>(v, r16, top[p]);
        }
        int cv[4][4];
#pragma unroll
        for (int u = 0; u < 4; ++u)
#pragma unroll
            for (int j = 0; j < 4; ++j) {
                const float a = __shfl(top[0][j], gbase + ci[u]), b = __shfl(top[1][j], gbase + cj[u]);
                const float cs = __uint_as_float(__float_as_uint(a) & ~127u) + __uint_as_float(__float_as_uint(b) & ~127u);
                const float pk = __uint_as_float((__float_as_uint(cs) & ~63u) | (63u - (unsigned)(r16 + 16 * u)));
                cv[j][u] = cvalid[u] ? f2ord(pk) : (int)0x80000000;
            }
        float best[4];
        select16x4<4>(cv, r16, best);
#pragma unroll
        for (int j = 0; j < 4; ++j) {
            const unsigned bb = __float_as_uint(best[j]);
            const int cd = cand_code(63 - (int)(bb & 63u));
            const int k0 = 127 - (int)(__float_as_uint(__shfl(top[0][j], gbase + (cd & 15))) & 127u);
            const int k1 = 127 - (int)(__float_as_uint(__shfl(top[1][j], gbase + ((cd >> 4) & 15))) & 127u);
            const float s = __uint_as_float(bb & ~63u);
            const float mx = rowmax16(s), e = __expf(s - mx), sum = rowsum16(e);
            const size_t o = (size_t)(m0 + 4 * q + j) * 128 + h * 16 + r16;
            rtE[o] = k0 * 128 + k1; rtG[o] = e * rcp_f(sum);
        }
    }
}

__device__ __forceinline__ f32x2 cvt2_fp8(unsigned wd, bool hi) { return hi ? __builtin_amdgcn_cvt_pk_f32_fp8((int)wd, true) : __builtin_amdgcn_cvt_pk_f32_fp8((int)wd, false); }
__device__ __forceinline__ void treduce8x16(const float (&p)[16], bool b0, bool b1, bool b2, float& r0, float& r1) {
    float a[8], bq[4];
#pragma unroll
    for (int i = 0; i < 8; ++i) { const float mine = b2 ? p[i + 8] : p[i], send = b2 ? p[i] : p[i + 8]; const float up = dpp_f<0x104>(send), dn = dpp_f<0x114>(send); a[i] = mine + (b2 ? dn : up); }
#pragma unroll
    for (int i = 0; i < 4; ++i) { const float mine = b1 ? a[i + 4] : a[i], send = b1 ? a[i] : a[i + 4]; bq[i] = mine + dpp_f<0x4E>(send); }
    { const float mine = b0 ? bq[2] : bq[0], send = b0 ? bq[0] : bq[2]; r0 = mine + dpp_f<0xB1>(send); }
    { const float mine = b0 ? bq[3] : bq[1], send = b0 ? bq[1] : bq[3]; r1 = mine + dpp_f<0xB1>(send); }
}
struct XGroup { int xg, gwi, stride; };
__device__ __forceinline__ XGroup xgroup(const Ctx& F) { XGroup g; g.xg = blockIdx.x & 7; const int nbg = (F.G - g.xg + 7) >> 3; g.gwi = (blockIdx.x >> 3) * NWAVES + F.wave; g.stride = nbg * NWAVES; return g; }

__device__ __forceinline__ void p10_peer_u(const Ctx& F) {
    const unsigned char* PU4 = F.ws + WS_PU8; const bf16* XN = (const bf16*)(F.ws + WS_XN);
    const int* rtE = (const int*)(F.ws + WS_RTE); unsigned* PD = (unsigned*)(F.ws + WS_PD);
    const XGroup g = xgroup(F);
    const int lane = F.lane, j = lane >> 3, sub = lane & 7;
    const bool b0 = sub & 1, b1 = sub & 2, b2 = sub & 4;
    const int r = g.xg;
    const unsigned char* tab = PU4 + (size_t)r * RANGE_BYTES;
    const unsigned so = 16u * (unsigned)sub;
    int m = g.gwi;
    if (m >= M) return;
    const int st = g.stride;
#define PU_LDE(e, mm, hf) { e[0] = *(const v4u*)(rtE + (size_t)(mm) * 128 + 16 * j + 8 * (hf)); e[1] = *(const v4u*)(rtE + (size_t)(mm) * 128 + 16 * j + 8 * (hf) + 4); }
#define PU_LDX(xv, mm) { _Pragma("unroll") for (int i = 0; i < 4; ++i) xv[i] = *(const v4u*)(XN + (size_t)(mm) * DM + 256 * r + 32 * sub + 8 * i); }
#define PU_GATHER(gx, e) { _Pragma("unroll") for (int k = 0; k < 8; ++k) gx[k] = *(const v4u*)(tab + (e[k >> 2][k & 3] * 128u + so)); }
#define PU_DOT(gx, po) { _Pragma("unroll") for (int k = 0; k < 8; ++k) { f32x2 a0 = {0.f, 0.f}, a1 = {0.f, 0.f}; \
        _Pragma("unroll") for (int d = 0; d < 4; ++d) { const unsigned wd = gx[k][d]; \
            a0 += __builtin_amdgcn_cvt_scalef32_pk_f32_fp4(wd, 1.0f, 0) * (f32x2){x[8 * d], x[8 * d + 1]};     a1 += __builtin_amdgcn_cvt_scalef32_pk_f32_fp4(wd, 1.0f, 1) * (f32x2){x[8 * d + 2], x[8 * d + 3]}; \
            a0 += __builtin_amdgcn_cvt_scalef32_pk_f32_fp4(wd, 1.0f, 2) * (f32x2){x[8 * d + 4], x[8 * d + 5]}; a1 += __builtin_amdgcn_cvt_scalef32_pk_f32_fp4(wd, 1.0f, 3) * (f32x2){x[8 * d + 6], x[8 * d + 7]}; } \
        const f32x2 s2 = a0 + a1; p[(po) + k] = s2.x + s2.y; } }
    v4u eA1[2], eB0[2], gA[8], gB[8], xs[4];
    { v4u eA0[2]; PU_LDE(eA0, m, 0); PU_LDE(eB0, m, 1); PU_LDX(xs, m);
      const int m1 = (m + st < M) ? m + st : m; PU_LDE(eA1, m1, 0);
      PU_GATHER(gA, eA0); }
    for (; m < M; m += st) {
        const int m1 = (m + st < M) ? m + st : m, m2 = (m + 2 * st < M) ? m + 2 * st : m;
        PU_GATHER(gB, eB0);
        float x[32];
#pragma unroll
        for (int i = 0; i < 4; ++i) { float t8[8]; unpack8(xs[i], t8);
#pragma unroll
            for (int u = 0; u < 8; ++u) x[8 * i + u] = t8[u]; }
        v4u eB1[2], eA2[2];
        PU_LDE(eB1, m1, 1); PU_LDE(eA2, m2, 0); PU_LDX(xs, m1);
        asm volatile("" : "+v"(gA[0]), "+v"(gA[1]), "+v"(gA[2]), "+v"(gA[3]), "+v"(gA[4]), "+v"(gA[5]), "+v"(gA[6]), "+v"(gA[7]) :: "memory");
        float p[16];
        PU_DOT(gA, 0);
        asm volatile("" ::: "memory");
        PU_GATHER(gA, eA1);
        asm volatile("" : "+v"(gB[0]), "+v"(gB[1]), "+v"(gB[2]), "+v"(gB[3]), "+v"(gB[4]), "+v"(gB[5]), "+v"(gB[6]), "+v"(gB[7]) :: "memory");
        PU_DOT(gB, 8);
        float r0, r1; treduce8x16(p, b0, b1, b2, r0, r1);
        PD[((size_t)r * M + m) * 64 + lane] = pk2(r0, r1);
#pragma unroll
        for (int i = 0; i < 2; ++i) { eA1[i] = eA2[i]; eB0[i] = eB1[i]; }
    }
#undef PU_LDE
#undef PU_LDX
#undef PU_GATHER
#undef PU_DOT
}

__device__ __forceinline__ void p11_peer_coef(const Ctx& F) {
    const int* rtE = (const int*)(F.ws + WS_RTE); const float* rtG = (const float*)(F.ws + WS_RTG); const unsigned* PD = (const unsigned*)(F.ws + WS_PD);
    const float* usc = (const float*)(F.ws + WS_USC); const float* vsc = (const float*)(F.ws + WS_VSC); float* COEF = (float*)(F.ws + WS_COEF);
    for (int m = F.gw; m < M; m += F.NGW) {
        const size_t o = (size_t)m * 128 + 2 * F.lane;
        f32x2 d = {0.f, 0.f};
#pragma unroll
        for (int r = 0; r < 8; ++r) { const unsigned pw = PD[((size_t)r * M + m) * 64 + F.lane]; d += (f32x2){bflo(pw), bfhi(pw)}; }
        const int e0 = rtE[o], e1 = rtE[o + 1];
        const f32x2 gt = *(const f32x2*)(rtG + o);
        const float d0 = d.x * usc[e0], d1 = d.y * usc[e1];
        f32x2 c; c.x = gt.x * (0.5f * d0 * (1.f + erff(d0 * 0.70710678f))) * vsc[e0]; c.y = gt.y * (0.5f * d1 * (1.f + erff(d1 * 0.70710678f))) * vsc[e1];
        *(f32x2*)(COEF + o) = c;
    }
}

__device__ __forceinline__ void p12_peer_v(const Ctx& F) {
    const unsigned char* PV4 = F.ws + WS_PV8; const int* rtE = (const int*)(F.ws + WS_RTE); const float* COEF = (const float*)(F.ws + WS_COEF);
    const float* mod = (const float*)(F.ws + WS_MOD);
    const XGroup g = xgroup(F);
    const int lane = F.lane, j = lane >> 3, sub = lane & 7;
    const bool jb0 = j & 1;
    const int r = g.xg;
    const unsigned char* tab = PV4 + (size_t)r * RANGE_BYTES;
    const unsigned so = 16u * (unsigned)sub;
    int m = g.gwi;
    if (m >= M) return;
    const int st = g.stride;
#define PV_LDE(e, mm, hf) { e[0] = *(const v4u*)(rtE + (size_t)(mm) * 128 + 16 * j + 8 * (hf)); e[1] = *(const v4u*)(rtE + (size_t)(mm) * 128 + 16 * j + 8 * (hf) + 4); }
#define PV_LDC(c, mm, hf) { c[0] = *(const f32x4*)(COEF + (size_t)(mm) * 128 + 16 * j + 8 * (hf)); c[1] = *(const f32x4*)(COEF + (size_t)(mm) * 128 + 16 * j + 8 * (hf) + 4); }
#define PV_GATHER(gx, e) { _Pragma("unroll") for (int k = 0; k < 8; ++k) gx[k] = *(const v4u*)(tab + (e[k >> 2][k & 3] * 128u + so)); }
#define PV_ACC(gx, c) { _Pragma("unroll") for (int k = 0; k < 8; ++k) { const float cq = c[k >> 2][k & 3]; const f32x2 cv2 = {cq, cq}; \
        _Pragma("unroll") for (int d = 0; d < 4; ++d) { const unsigned wd = gx[k][d]; \
            acc[4 * d + 0] += cv2 * __builtin_amdgcn_cvt_scalef32_pk_f32_fp4(wd, 1.0f, 0); acc[4 * d + 1] += cv2 * __builtin_amdgcn_cvt_scalef32_pk_f32_fp4(wd, 1.0f, 1); \
            acc[4 * d + 2] += cv2 * __builtin_amdgcn_cvt_scalef32_pk_f32_fp4(wd, 1.0f, 2); acc[4 * d + 3] += cv2 * __builtin_amdgcn_cvt_scalef32_pk_f32_fp4(wd, 1.0f, 3); } } }
    v4u eA1[2], eB0[2], gA[8], gB[8]; f32x4 cA0[2], cA1[2], cB0[2];
    { v4u eA0[2]; PV_LDE(eA0, m, 0); PV_LDC(cA0, m, 0); PV_LDE(eB0, m, 1); PV_LDC(cB0, m, 1);
      const int m1 = (m + st < M) ? m + st : m; PV_LDE(eA1, m1, 0); PV_LDC(cA1, m1, 0);
      PV_GATHER(gA, eA0); }
    for (; m < M; m += st) {
        const int m1 = (m + st < M) ? m + st : m, m2 = (m + 2 * st < M) ? m + 2 * st : m;
        const int col = 256 * r + 32 * sub + 4 * j;
        v2u* orow = (v2u*)((bf16*)(F.ws + WS_HB) + (size_t)m * DM + col);
        const v2u hw = *orow; const f32x4 g2 = *(const f32x4*)(mod + (size_t)(m / SEQ) * MODW + 5 * DM + col);
        PV_GATHER(gB, eB0);
        v4u eB1[2], eA2[2]; f32x4 cB1[2], cA2[2];
        PV_LDE(eB1, m1, 1); PV_LDC(cB1, m1, 1); PV_LDE(eA2, m2, 0); PV_LDC(cA2, m2, 0);
        asm volatile("" : "+v"(gA[0]), "+v"(gA[1]), "+v"(gA[2]), "+v"(gA[3]), "+v"(gA[4]), "+v"(gA[5]), "+v"(gA[6]), "+v"(gA[7]) :: "memory");
        f32x2 acc[16];
#pragma unroll
        for (int i = 0; i < 16; ++i) acc[i] = (f32x2){0.f, 0.f};
        PV_ACC(gA, cA0);
        asm volatile("" ::: "memory");
        PV_GATHER(gA, eA1);
        asm volatile("" : "+v"(gB[0]), "+v"(gB[1]), "+v"(gB[2]), "+v"(gB[3]), "+v"(gB[4]), "+v"(gB[5]), "+v"(gB[6]), "+v"(gB[7]) :: "memory");
        PV_ACC(gB, cB0);
        float a[32];
#pragma unroll
        for (int i = 0; i < 16; ++i) { a[2 * i] = acc[i].x; a[2 * i + 1] = acc[i].y; }
        float s16[16], s8[8];
#pragma unroll
        for (int c = 0; c < 16; ++c) { auto rr2 = __builtin_amdgcn_permlane32_swap(__float_as_uint(a[c]), __float_as_uint(a[c + 16]), false, false); s16[c] = __uint_as_float(rr2[0]) + __uint_as_float(rr2[1]); }
#pragma unroll
        for (int c = 0; c < 8; ++c) { auto rr2 = __builtin_amdgcn_permlane16_swap(__float_as_uint(s16[c]), __float_as_uint(s16[c + 8]), false, false); s8[c] = __uint_as_float(rr2[0]) + __uint_as_float(rr2[1]); }
        f32x4 res;
#pragma unroll
        for (int c = 0; c < 4; ++c) { const float mine = jb0 ? s8[c + 4] : s8[c], send = jb0 ? s8[c] : s8[c + 4]; res[c] = mine + dpp_f<0x128>(send); }
        const f32x4 h1 = {bflo(hw.x), bfhi(hw.x), bflo(hw.y), bfhi(hw.y)};
        const f32x4 h2 = h1 + g2 * res;
        v2u o; o.x = pk2(h2.x, h2.y); o.y = pk2(h2.z, h2.w);
        *orow = o;
#pragma unroll
        for (int i = 0; i < 2; ++i) { cA0[i] = cA1[i]; cA1[i] = cA2[i]; eA1[i] = eA2[i]; eB0[i] = eB1[i]; cB0[i] = cB1[i]; }
    }
#undef PV_LDE
#undef PV_LDC
#undef PV_GATHER
#undef PV_ACC
}
#define XB_TMO      128
#define XB_XCNT(j)  (256  + 64 * (j))
#define XB_XSUB(j)  (1280 + 64 * (j))
#define XB_XGEN(j)  (2304 + 64 * (j))
#define XB_TOP      3328
#define XB_TOPGEN   3392
#define XCD_BAR_WORDS 3456
#define XB_SPIN_CAP (1u << 18)

__device__ __forceinline__ unsigned xb_ld(unsigned* p)              { return __hip_atomic_load(p, __ATOMIC_RELAXED, __HIP_MEMORY_SCOPE_AGENT); }
__device__ __forceinline__ unsigned xb_add(unsigned* p, unsigned v) { return __hip_atomic_fetch_add(p, v, __ATOMIC_RELAXED, __HIP_MEMORY_SCOPE_AGENT); }
__device__ __forceinline__ unsigned xb_xcc_id() { return (unsigned)__builtin_amdgcn_s_getreg((3 << 11) | 20) & 0xFu; }
#define XB_SPIN(cond, bar) do { unsigned _sp = 0; while (cond) { __builtin_amdgcn_s_sleep(1); \
    if ((++_sp & 255u) == 0u) { if (xb_ld(&(bar)[XB_TMO])) break; if (_sp > XB_SPIN_CAP) { atomicAdd(&(bar)[XB_TMO], 1u); break; } } } } while (0)

struct XcdBarrier {
    unsigned* bar; unsigned x;
    volatile LAS unsigned* st;
};

__device__ __forceinline__ XcdBarrier xcd_barrier_post(unsigned* bar, volatile LAS unsigned* st) {
    XcdBarrier b; b.bar = bar; b.x = xb_xcc_id(); b.st = st;
    if (threadIdx.x == 0) (void)xb_add(&bar[XB_XCNT(b.x)], 1u);
    return b;
}
__device__ __forceinline__ void xcd_barrier_complete(unsigned* bar, unsigned x, unsigned& nloc, unsigned& nx) {
    const unsigned G = gridDim.x * gridDim.y * gridDim.z;
    unsigned sum, cnt, mine, sp = 0u;
    for (;;) {
        sum = 0u; cnt = 0u; mine = 0u;
#pragma unroll
        for (unsigned j = 0; j < 16; ++j) { const unsigned c = xb_ld(&bar[XB_XCNT(j)]); sum += c; cnt += (c > 0u) ? 1u : 0u; mine = (j == x) ? c : mine; }
        if (sum == G) break;
        __builtin_amdgcn_s_sleep(1);
        if ((++sp & 255u) == 0u) { if (xb_ld(&bar[XB_TMO])) break; if (sp > XB_SPIN_CAP) { atomicAdd(&bar[XB_TMO], 1u); break; } }
    }
    nloc = mine > 0u ? mine : 1u; nx = cnt > 0u ? cnt : 1u;
}

__device__ __forceinline__ void xcd_barrier(const XcdBarrier& b) {
    asm volatile("s_waitcnt vmcnt(0)" ::: "memory");
    __syncthreads();
    if (threadIdx.x == 0) {
        unsigned* bar = b.bar;
        __builtin_amdgcn_s_waitcnt(0);
        unsigned nloc = b.st[0], nx = b.st[1];
        if (nloc == 0u) { xcd_barrier_complete(bar, b.x, nloc, nx); b.st[0] = nloc; b.st[1] = nx; }
        const unsigned old = xb_add(&bar[XB_XSUB(b.x)], 1u);
        const unsigned gen = old / nloc;
        if (old + 1u == (gen + 1u) * nloc) {
            __builtin_amdgcn_fence(__ATOMIC_RELEASE, "agent");
            asm volatile("s_waitcnt vmcnt(0)" ::: "memory");
            const unsigned og = xb_add(&bar[XB_TOP], 1u);
            const unsigned tg = og / nx;
            if (og + 1u == (tg + 1u) * nx) xb_add(&bar[XB_TOPGEN], 1u);
            else XB_SPIN(xb_ld(&bar[XB_TOPGEN]) == tg, bar);
            __builtin_amdgcn_fence(__ATOMIC_ACQUIRE, "agent");
            xb_add(&bar[XB_XGEN(b.x)], 1u);
            asm volatile("s_waitcnt vmcnt(0)" ::: "memory");
        } else {
            XB_SPIN(xb_ld(&bar[XB_XGEN(b.x)]) == gen, bar);
            __builtin_amdgcn_fence(__ATOMIC_ACQUIRE, "agent");
            asm volatile("s_waitcnt vmcnt(0)" ::: "memory");
        }
    }
    __syncthreads();
}

struct Args { const float* in[N_IN]; float* out; unsigned char* ws; int ph_lo, ph_hi; };
constexpr int N_PHASES = 19;

__global__ void __launch_bounds__(NTHR, 2) fwd_kernel(Args args) {
    extern __shared__ __attribute__((aligned(16))) unsigned char lds_raw[];
    cg::grid_group grid = cg::this_grid();
    Ctx F;
    F.lds = (LAS unsigned char*)lds_raw;
    F.tid = threadIdx.x; F.lane = F.tid & 63; F.wave = __builtin_amdgcn_readfirstlane(F.tid >> 6);
    F.G = gridDim.x; F.gw = blockIdx.x * NWAVES + F.wave; F.NGW = F.G * NWAVES;
    F.in = args.in; F.out = args.out; F.ws = args.ws;
    const int lo = args.ph_lo, hi = args.ph_hi;
    volatile LAS unsigned* bst = (volatile LAS unsigned*)(F.lds + LDS_BYTES - 64);
    if (F.tid < 2) bst[F.tid] = 0u;
    if (F.tid < 4) ((volatile LAS unsigned*)(F.lds + LDS_BYTES - 48))[F.tid] = 0u;
    __syncthreads();
    const XcdBarrier bar = xcd_barrier_post((unsigned*)(F.ws + WS_CTL) + 4096, bst);
#define IN(k) (lo <= (k) && (k) < hi)
#ifndef TS_A
#define TS_A -1
#define TS_B -1
#define TS_K 0.1
#endif
    unsigned long long* stamps = (unsigned long long*)(F.ws + WS_CTL + 65536);
#define STAMP(k) do { if (TS_A >= 0 && blockIdx.x == 0 && F.tid == 0) stamps[k] = __builtin_amdgcn_s_memrealtime(); } while (0)
#define REP_MASK 0
#ifndef REP_MASK
#define REP_MASK 0
#endif
#define REPS(k) for (int rep_ = 0; rep_ < 1 + ((REP_MASK >> (k)) & 1); ++rep_)
#define SEAM(k) do { if (IN(k) && IN((k) + 1)) { if ((k) == 0) grid.sync(); else xcd_barrier(bar); } } while (0)

    STAMP(0);
    if (IN(0)) REPS(0) { p0_prologue(F); }
    SEAM(0);
    STAMP(1);
    if (IN(1)) REPS(1) { norm_mod_rows(F, F.in[I_X], F.in[I_N1W], 0, DM, (bf16*)(F.ws + WS_XN)); }
    SEAM(1);
    STAMP(2);
    if (IN(2)) REPS(2) {
        pg8::Gemm g{(const pg8::bf16_t*)(F.ws + WS_XN), (const pg8::bf16_t*)(F.ws + WS_WIN), M, INPP, DM};
        pg8::StaticOrder S; S.init(M, INPP, F.G, (int)blockIdx.x);
        pg8::EpiStoreBf16 E{(pg8::bf16_t*)(F.ws + WS_PROJ), INPP};
        pg8::gemm_phase<pg8::EpiStoreBf16, pg8::StaticOrder, true, true>(F.lds, g, S, E);
    }
    SEAM(2);
#ifndef P3REP
#define P3REP 0
#endif
    STAMP(3);
    if (IN(3)) REPS(3) { p3_lora(F); STAMP(40); m1_chunk_states(F); }
    SEAM(3);
    STAMP(4);
    if (IN(4)) { m2_prefix(F); ra_part(F, 0); }
    SEAM(4);
    STAMP(5);
    if (IN(5)) { rs_half(F, 0); ra_part(F, 1); }
    SEAM(5);
    STAMP(6);
    if (IN(6)) { rs_half(F, 1); ra_part(F, 2); }
    SEAM(6);
    STAMP(7);
    if (IN(7)) { rs_half(F, 2); ra_part(F, 3); }
    SEAM(7);
    STAMP(8);
    if (IN(8)) { rs_half(F, 3); }
    STAMP(9);
    if (IN(9)) REPS(9) { m3_outputs(F); }
    SEAM(9);
    STAMP(10);
    if (IN(10)) { p5_post(F); }
    SEAM(10);
    STAMP(11);
    if (IN(11)) REPS(11) {
        pg8::Gemm g{(const pg8::bf16_t*)(F.ws + WS_OY), (const pg8::bf16_t*)(F.ws + WS_WOUT), M, DM, DM};
        pg8::StaticOrder S; S.init(M, DM, F.G, (int)blockIdx.x);
        pg8::EpiResid E{F.in[I_X], (const float*)(F.ws + WS_MOD) + 2 * DM, (pg8::bf16_t*)(F.ws + WS_HB), DM, SEQ, MODW};
        pg8::gemm_phase<pg8::EpiResid, pg8::StaticOrder, true, true>(F.lds, g, S, E);
    }
    SEAM(11);
    STAMP(12);
    if (IN(12)) REPS(12) { norm_mod_rows_bf16(F, (const bf16*)(F.ws + WS_HB), F.in[I_N2W], 3 * DM, 4 * DM, (bf16*)(F.ws + WS_XN)); }
    SEAM(12);
    STAMP(13);
    if (IN(13)) REPS(13) {
        pg8::Gemm g{(const pg8::bf16_t*)(F.ws + WS_XN), (const pg8::bf16_t*)(F.ws + WS_WQ), M, DM, DM};
        pg8::StaticOrder S; S.init(M, DM, F.G, (int)blockIdx.x);
        pg8::EpiStoreBf16 E{(pg8::bf16_t*)(F.ws + WS_Q), DM};
        pg8::gemm_phase<pg8::EpiStoreBf16, pg8::StaticOrder, true, true>(F.lds, g, S, E);
    }
    SEAM(13);
    STAMP(14);
    if (IN(14)) REPS(14) { p9_route(F); }
    SEAM(14);
    STAMP(15);
    if (IN(15)) REPS(15) { p10_peer_u(F); }
    SEAM(15);
    STAMP(16);
    if (IN(16)) REPS(16) { p11_peer_coef(F); }
    SEAM(16);
    STAMP(17);
    if (IN(17)) { p12_peer_v(F); }
    SEAM(17);
    STAMP(18);
    if (IN(18)) {
        float oscale = 1.f;
        if (TS_A >= 0) { const volatile unsigned long long* st = stamps; const float frac = (float)(st[TS_B] - st[TS_A]) / (float)(st[17] - st[0]); oscale = 1.f + (float)(TS_K) * frac; }
        final_norm_rows_bf16(F, (const bf16*)(F.ws + WS_HB), F.in[I_FNW], F.out, oscale);
    }
#undef IN
#undef SEAM
}

extern "C" void kernel_launch(void* const* d_in, const int* in_sizes, int n_in, void* d_out, int out_size, void* d_ws, size_t ws_size, hipStream_t stream) {
    static int grid = 0;
    if (grid == 0) {
        if (n_in != N_IN || in_sizes[0] != M * DM || out_size != M * DM || ws_size < WS_END2) {
            fprintf(stderr, "kernel_launch: unexpected shapes: n_in %d in0 %d out %d ws %zu (need %zu)\n", n_in, n_in > 0 ? in_sizes[0] : -1, out_size, ws_size, (size_t)WS_END2); grid = -1; return; }
        int dev = 0, cus = 0, per_cu = 0;
        if (hipGetDevice(&dev) != hipSuccess || hipDeviceGetAttribute(&cus, hipDeviceAttributeMultiprocessorCount, dev) != hipSuccess) { grid = -1; return; }
        if (hipFuncSetAttribute((const void*)fwd_kernel, hipFuncAttributeMaxDynamicSharedMemorySize, LDS_BYTES) != hipSuccess) { fprintf(stderr, "kernel_launch: hipFuncSetAttribute failed\n"); grid = -1; return; }
        if (hipOccupancyMaxActiveBlocksPerMultiprocessor(&per_cu, (const void*)fwd_kernel, NTHR, LDS_BYTES) != hipSuccess || per_cu < 1) { fprintf(stderr, "kernel_launch: occupancy query says %d blocks per CU\n", per_cu); per_cu = 1; }
        (void)hipGetLastError();
        grid = cus;
        fprintf(stderr, "kernel_launch: cus %d per_cu %d grid %d ws %zu\n", cus, per_cu, grid, ws_size);
    }
    if (grid < 0) return;
    (void)hipMemsetAsync((char*)d_ws + WS_CTL, 0, CTL_ZERO_BYTES, stream);
    Args a{};
    for (int i = 0; i < N_IN; ++i) a.in[i] = (const float*)d_in[i];
    a.out = (float*)d_out; a.ws = (unsigned char*)d_ws; a.ph_lo = 0; a.ph_hi = N_PHASES;
    void* kargs[] = {&a};
#ifndef NPASS
#define NPASS 1
#endif
    hipError_t e = hipSuccess;
    for (int pass_ = 0; pass_ < NPASS; ++pass_) {
        if (pass_ > 0) (void)hipMemsetAsync((char*)d_ws + WS_CTL, 0, CTL_ZERO_BYTES, stream);
        e = hipLaunchCooperativeKernel((const void*)fwd_kernel, dim3(grid), dim3(NTHR), kargs, LDS_BYTES, stream);
    }
    if (e != hipSuccess) fprintf(stderr, "kernel_launch: cooperative launch failed: %s (grid %d)\n", hipGetErrorString(e), grid);
}
```

```cpp
#include <hip/hip_runtime.h>
#include <hip/hip_cooperative_groups.h>
#include <cstdio>
#include <cstdint>
namespace cg = cooperative_groups;
namespace pg8 {
#define PG8_LAS __attribute__((address_space(3)))
typedef unsigned short bf16_t;
typedef short bf16x8 __attribute__((ext_vector_type(8)));
typedef float f32x4 __attribute__((ext_vector_type(4)));
typedef unsigned u32x4 __attribute__((ext_vector_type(4)));
constexpr int BM = 256, BK = 64, HALF = 128, HTB = HALF * BK * 2  , STAGE_BYTES = 8 * HTB, NXCD = 8, WGM = 8;

__host__ __device__ __forceinline__ int lds_byte(int r, int c) { const int st = (r >> 4) * 2 + (c >> 5), rr = r & 15, cc = c & 31, ob = rr * 64 + cc * 2; return st * 1024 + (ob ^ (((ob >> 9) & 1) << 5)); }
__host__ __device__ __forceinline__ void stage_rc(int b, int& R, int& C) { const int st = b / 1024, sb = b % 1024, swz = sb ^ (((sb >> 9) & 1) << 5); R = (st >> 1) * 16 + swz / 64; C = (st & 1) * 32 + (swz % 64) / 2; }
__host__ __device__ __forceinline__ int perm32(int rho) { const int n = rho >> 4, i = rho & 15; return 8 * (i >> 2) + 4 * n + (i & 3); }

struct Unit { int pm, pn; };
struct Gemm { const bf16_t* A; const bf16_t* Bt; int M, N, K; };

struct StaticOrder {
    int nM, nN, nwg, G, c;
    __host__ __device__ void init(int M, int N, int G_, int c_) { nM = M / BM; nN = N / BM; nwg = nM * nN; G = G_; c = c_; }
    __host__ __device__ bool next(int i, Unit& u) const {
        const long L = (long)i * G + c; if (L >= nwg) return false;
        int wgid = (int)L; { const int q = nwg / NXCD, r = nwg % NXCD, xcd = wgid % NXCD, off = wgid / NXCD; wgid = (xcd < r ? xcd * (q + 1) : r * (q + 1) + (xcd - r) * q) + off; }
        const int nig = WGM * nN, gid = wgid / nig, fm = gid * WGM, gsz = (nM - fm) < WGM ? (nM - fm) : WGM;
        u.pm = fm + ((wgid % nig) % gsz); u.pn = (wgid % nig) / gsz; return true;
    }
    __device__ __forceinline__ void a_ready(const Unit&) const {}
    __device__ __forceinline__ void done(const Unit&) const {}
};
__device__ __forceinline__ unsigned cvt_pk_bf16(float lo, float hi) { unsigned r; asm volatile("v_cvt_pk_bf16_f32 %0, %1, %2" : "=v"(r) : "v"(lo), "v"(hi)); return r; }
struct EpiStoreBf16 {
    static constexpr bool PERM = true, AFTER_DRAIN = false;
    bf16_t* O; int ldc;
    __device__ __forceinline__ void operator()(const f32x4 (&acc)[2][2][4][2], const Unit& u, int wr, int wc, int fr, int fq) const {
        const int row0 = u.pm * BM + wr * 64 + fr; const int col0 = u.pn * BM + wc * 32 + 8 * fq;
#pragma unroll
        for (int ai = 0; ai < 2; ++ai)
#pragma unroll
            for (int m = 0; m < 4; ++m) { bf16_t* rowp = O + (size_t)(row0 + ai * HALF + m * 16) * ldc + col0;
#pragma unroll
                for (int bj = 0; bj < 2; ++bj) { const f32x4 v0 = acc[ai][bj][m][0], v1 = acc[ai][bj][m][1];
                    u32x4 w; w.x = cvt_pk_bf16(v0[0], v0[1]); w.y = cvt_pk_bf16(v0[2], v0[3]); w.z = cvt_pk_bf16(v1[0], v1[1]); w.w = cvt_pk_bf16(v1[2], v1[3]);
                    *(u32x4*)(rowp + bj * HALF) = w; } }
    }
};
struct EpiResid {
    static constexpr bool PERM = true, AFTER_DRAIN = false;
    const float* X; const float* gate; bf16_t* O; int ldc; int rows_per_batch; int gstride;
    __device__ __forceinline__ void operator()(const f32x4 (&acc)[2][2][4][2], const Unit& u, int wr, int wc, int fr, int fq) const {
        const int row0 = u.pm * BM + wr * 64 + fr; const int col0 = u.pn * BM + wc * 32 + 8 * fq;
        const float* g = gate + (size_t)((u.pm * BM) / rows_per_batch) * gstride + col0;
        f32x4 gv[2][2];
#pragma unroll
        for (int bj = 0; bj < 2; ++bj)
#pragma unroll
            for (int n = 0; n < 2; ++n) gv[bj][n] = *(const f32x4*)(g + bj * HALF + 4 * n);
#pragma unroll
        for (int ai = 0; ai < 2; ++ai)
#pragma unroll
            for (int m = 0; m < 4; ++m) { const size_t off = (size_t)(row0 + ai * HALF + m * 16) * ldc + col0;
#pragma unroll
                for (int bj = 0; bj < 2; ++bj) { const f32x4 x0 = *(const f32x4*)(X + off + bj * HALF), x1 = *(const f32x4*)(X + off + bj * HALF + 4);
                    const f32x4 v0 = x0 + gv[bj][0] * acc[ai][bj][m][0], v1 = x1 + gv[bj][1] * acc[ai][bj][m][1];
                    u32x4 w; w.x = cvt_pk_bf16(v0[0], v0[1]); w.y = cvt_pk_bf16(v0[2], v0[3]); w.z = cvt_pk_bf16(v1[0], v1[1]); w.w = cvt_pk_bf16(v1[2], v1[3]);
                    *(u32x4*)(O + off + bj * HALF) = w; } }
    }
};
template <class Epi, class Sched, bool ALIGN_EPI = false, bool SP2 = false>
__device__ __forceinline__ void gemm_phase(PG8_LAS unsigned char* lds, const Gemm g, const Sched& S, const Epi& E) {
    const int tid = threadIdx.x, wid = __builtin_amdgcn_readfirstlane(tid >> 6), lane = tid & 63, wr = wid >> 2, wc = wid & 3, fr = lane & 15, fq = lane >> 4;
    const int K = g.K, nt = K / BK;
    unsigned voffA[2], voffB[2];
#pragma unroll
    for (int i = 0; i < 2; ++i) { int R, C; stage_rc(tid * 16 + i * 8192, R, C); const int Rb = Epi::PERM ? ((R & ~31) + perm32(R & 31)) : R;
        voffA[i] = (unsigned)(R * K + C) * 2u; voffB[i] = (unsigned)(Rb * K + C) * 2u; }
    const size_t kstep = (size_t)(BK * 2);
    const size_t hstep = (size_t)HALF * K * 2;
    const size_t tstep = 2 * hstep;
    const unsigned ldsw = (unsigned)wid * 1024u;
    const int aoff = lds_byte(wr * 64 + fr, fq * 8), boff = lds_byte(wc * 32 + fr, fq * 8);
#define PG8_SA(b, h) (((b) * 2 + (h)) * HTB)
#define PG8_SB(b, h) ((4 + (b) * 2 + (h)) * HTB)
#define PG8_STAGE(bufoff, gbase, voff) do { _Pragma("unroll") for (int _i = 0; _i < 2; ++_i) \
        __builtin_amdgcn_global_load_lds((const unsigned*)((const char*)(gbase) + (voff)[_i]), (PG8_LAS unsigned*)(lds + (bufoff) + ldsw + _i * 8192), 16, 0, 0); } while (0)
#define PG8_LDA(dst, b, h) do { _Pragma("unroll") for (int m = 0; m < 4; ++m) _Pragma("unroll") for (int k = 0; k < 2; ++k) dst[m][k] = *(const PG8_LAS bf16x8*)(lds + PG8_SA(b, h) + aoff + m * 2048 + k * 1024); } while (0)
#define PG8_LDB(dst, b, h) do { _Pragma("unroll") for (int n = 0; n < 2; ++n) _Pragma("unroll") for (int k = 0; k < 2; ++k) dst[n][k] = *(const PG8_LAS bf16x8*)(lds + PG8_SB(b, h) + boff + n * 2048 + k * 1024); } while (0)
#define PG8_MMA(ai, bj, At, Bt) do { __builtin_amdgcn_s_setprio(1); _Pragma("unroll") for (int m = 0; m < 4; ++m) _Pragma("unroll") for (int n = 0; n < 2; ++n) _Pragma("unroll") for (int k = 0; k < 2; ++k) \
        acc[ai][bj][m][n] = __builtin_amdgcn_mfma_f32_16x16x32_bf16(Bt[n][k], At[m][k], acc[ai][bj][m][n], 0, 0, 0); __builtin_amdgcn_s_setprio(0); } while (0)
#define PG8_WAIT_V(n) asm volatile("s_waitcnt vmcnt(" #n ")" ::: "memory")
#define PG8_WAIT_L(n) asm volatile("s_waitcnt lgkmcnt(" #n ")" ::: "memory")
#define PG8_BAR __builtin_amdgcn_s_barrier()
#define PG8_SCHED __builtin_amdgcn_sched_barrier(0)
    Unit cur, nxt; int ui = 0;
    if (!S.next(0, cur)) return;
    f32x4 acc[2][2][4][2];
#pragma unroll
    for (int a = 0; a < 2; ++a)
#pragma unroll
        for (int b = 0; b < 2; ++b)
#pragma unroll
            for (int m = 0; m < 4; ++m)
#pragma unroll
                for (int n = 0; n < 2; ++n) acc[a][b][m][n] = (f32x4){0.f, 0.f, 0.f, 0.f};
    bf16x8 At[4][2], B0[2][2], B1[2][2];
    const char* cA = (const char*)g.A + (size_t)cur.pm * tstep; const char* cB = (const char*)g.Bt + (size_t)cur.pn * tstep;
    S.a_ready(cur);
    if constexpr (SP2) {
        PG8_STAGE(PG8_SB(0, 0), cB, voffB); PG8_STAGE(PG8_SB(0, 1), cB + hstep, voffB); PG8_STAGE(PG8_SA(0, 0), cA, voffA); PG8_STAGE(PG8_SA(0, 1), cA + hstep, voffA);
        if (wr == 1) PG8_BAR;
        PG8_WAIT_V(2); PG8_BAR;
        PG8_STAGE(PG8_SB(1, 0), cB + kstep, voffB); PG8_STAGE(PG8_SA(1, 0), cA + kstep, voffA); PG8_STAGE(PG8_SB(1, 1), cB + hstep + kstep, voffB);
        PG8_WAIT_V(6); PG8_BAR;
    } else {
        PG8_STAGE(PG8_SB(0, 0), cB, voffB); PG8_STAGE(PG8_SA(0, 0), cA, voffA); PG8_STAGE(PG8_SB(0, 1), cB + hstep, voffB); PG8_STAGE(PG8_SA(0, 1), cA + hstep, voffA);
        if (wr == 1) PG8_BAR;
        PG8_WAIT_V(4); PG8_BAR;
        PG8_STAGE(PG8_SB(1, 0), cB + kstep, voffB); PG8_STAGE(PG8_SA(1, 0), cA + kstep, voffA); PG8_STAGE(PG8_SB(1, 1), cB + hstep + kstep, voffB);
        PG8_WAIT_V(6); PG8_BAR;
    }
    for (;;) {
        const bool has_next = S.next(ui + 1, nxt);
        const char* nA = has_next ? (const char*)g.A + (size_t)nxt.pm * tstep : cA; const char* nB = has_next ? (const char*)g.Bt + (size_t)nxt.pn * tstep : cB;
        for (int t = 0; t < nt; t += 2) {
            const bool last = (t == nt - 2);
            const char* a1 = cA + (size_t)(t + 1) * kstep;
            const char* a2 = last ? nA : cA + (size_t)(t + 2) * kstep; const char* b2 = last ? nB : cB + (size_t)(t + 2) * kstep;
            const char* a3 = a2 + kstep; const char* b3 = b2 + kstep;
            if (last && has_next) S.a_ready(nxt);
            if constexpr (SP2) {
            PG8_LDB(B0, 0, 0); PG8_LDB(B1, 0, 1); PG8_SCHED; PG8_LDA(At, 0, 0); PG8_STAGE(PG8_SA(1, 1), a1 + hstep, voffA);
            PG8_WAIT_V(8); PG8_WAIT_L(0); PG8_BAR; PG8_MMA(0, 0, At, B0); PG8_MMA(0, 1, At, B1); PG8_BAR; PG8_SCHED;
            PG8_LDA(At, 0, 1); PG8_STAGE(PG8_SB(0, 0), b2, voffB); PG8_STAGE(PG8_SB(0, 1), b2 + hstep, voffB); PG8_STAGE(PG8_SA(0, 0), a2, voffA);
            PG8_WAIT_V(8); PG8_WAIT_L(0); PG8_BAR; PG8_MMA(1, 0, At, B0); PG8_MMA(1, 1, At, B1); PG8_BAR; PG8_SCHED;
            PG8_LDB(B0, 1, 0); PG8_LDB(B1, 1, 1); PG8_SCHED; PG8_LDA(At, 1, 0); PG8_STAGE(PG8_SA(0, 1), a2 + hstep, voffA);
            PG8_WAIT_V(8); PG8_WAIT_L(0); PG8_BAR; PG8_MMA(0, 0, At, B0); PG8_MMA(0, 1, At, B1); PG8_BAR; PG8_SCHED;
            PG8_LDA(At, 1, 1); PG8_STAGE(PG8_SB(1, 0), b3, voffB); PG8_STAGE(PG8_SB(1, 1), b3 + hstep, voffB); PG8_STAGE(PG8_SA(1, 0), a3, voffA);
            PG8_WAIT_V(8); PG8_WAIT_L(0); PG8_BAR; PG8_MMA(1, 0, At, B0); PG8_MMA(1, 1, At, B1); PG8_BAR; PG8_SCHED;
            } else {
            PG8_LDB(B0, 0, 0); PG8_SCHED; PG8_LDA(At, 0, 0); PG8_STAGE(PG8_SA(1, 1), a1 + hstep, voffA);
            PG8_WAIT_L(8); PG8_BAR; PG8_WAIT_L(0); PG8_MMA(0, 0, At, B0); PG8_BAR; PG8_SCHED;
            PG8_LDB(B1, 0, 1); PG8_STAGE(PG8_SB(0, 0), b2, voffB);
            PG8_BAR; PG8_WAIT_L(0); PG8_MMA(0, 1, At, B1); PG8_BAR;
            PG8_LDA(At, 0, 1); PG8_STAGE(PG8_SA(0, 0), a2, voffA);
            PG8_BAR; PG8_WAIT_L(0); PG8_MMA(1, 0, At, B0); PG8_BAR; PG8_SCHED;
            PG8_STAGE(PG8_SB(0, 1), b2 + hstep, voffB);
            PG8_WAIT_V(6); PG8_BAR; PG8_MMA(1, 1, At, B1); PG8_BAR;
            PG8_LDB(B0, 1, 0); PG8_SCHED; PG8_LDA(At, 1, 0); PG8_STAGE(PG8_SA(0, 1), a2 + hstep, voffA);
            PG8_WAIT_L(8); PG8_BAR; PG8_WAIT_L(0); PG8_MMA(0, 0, At, B0); PG8_BAR; PG8_SCHED;
            PG8_LDB(B1, 1, 1); PG8_STAGE(PG8_SB(1, 0), b3, voffB);
            PG8_BAR; PG8_WAIT_L(0); PG8_MMA(0, 1, At, B1); PG8_BAR;
            PG8_LDA(At, 1, 1); PG8_STAGE(PG8_SA(1, 0), a3, voffA);
            PG8_BAR; PG8_WAIT_L(0); PG8_MMA(1, 0, At, B0); PG8_BAR; PG8_SCHED;
            PG8_STAGE(PG8_SB(1, 1), b3 + hstep, voffB);
            PG8_WAIT_V(6); PG8_BAR; PG8_MMA(1, 1, At, B1); PG8_BAR;
            }
        }
        if constexpr (ALIGN_EPI) { if (wr == 0) PG8_BAR; }
        if constexpr (!Epi::AFTER_DRAIN) { E(acc, cur, wr, wc, fr, fq); S.done(cur); }
        if (!has_next) break;
#pragma unroll
        for (int a = 0; a < 2; ++a)
#pragma unroll
            for (int b = 0; b < 2; ++b)
#pragma unroll
                for (int m = 0; m < 4; ++m)
#pragma unroll
                    for (int n = 0; n < 2; ++n) acc[a][b][m][n] = (f32x4){0.f, 0.f, 0.f, 0.f};
        cur = nxt; cA = nA; cB = nB; ++ui;
        if constexpr (ALIGN_EPI) { if (wr == 1) PG8_BAR; }
    }
    PG8_WAIT_V(0);
    if constexpr (!ALIGN_EPI) { if (wr == 0) PG8_BAR; }
    PG8_BAR;
    if constexpr (Epi::AFTER_DRAIN) { E.fused(acc, cur, wr, wc, fr, fq, lds, wid, lane); S.done(cur); }
#undef PG8_SA
#undef PG8_SB
#undef PG8_STAGE
#undef PG8_LDA
#undef PG8_LDB
#undef PG8_MMA
#undef PG8_WAIT_V
#undef PG8_WAIT_L
#undef PG8_BAR
#undef PG8_SCHED
}
}
#define GAS __attribute__((address_space(1)))
#define LAS __attribute__((address_space(3)))
typedef unsigned short bf16;
typedef unsigned v4u __attribute__((ext_vector_type(4)));
typedef unsigned v2u __attribute__((ext_vector_type(2)));
typedef float f32x4 __attribute__((ext_vector_type(4)));
typedef float f32x2 __attribute__((ext_vector_type(2)));
typedef short bf16x8 __attribute__((ext_vector_type(8)));
typedef __bf16 bf16x2_t __attribute__((ext_vector_type(2)));

constexpr int NWAVES = 8, NTHR = 512;
constexpr int DM = 2048, NB = 4, SEQ = 8192, M = NB * SEQ;
constexpr int RW = 1024, RHEADS = 16, HD = 64;
constexpr int L_W = 64, L_A = 64, L_G = 160;
constexpr int INP = 5936, INPP = 6144;
constexpr int C_R = 0, C_K = 1024, C_V = 2048, C_WD = 3072, C_AD = 3136, C_GD = 3200, C_Z = 3360, C_XBC = 4384, C_DT = 5920;
constexpr int MODW = 6 * DM;
constexpr int NEXP = 16384;
constexpr float RMS_EPS = 1e-6f;

enum { I_X = 0, I_C, I_ADAW, I_ADAB, I_N1W, I_WIN, I_MU, I_W0, I_WUP, I_A0, I_AUP, I_GUP, I_KK, I_KA, I_RK, I_LNW, I_LNB,
       I_CONVW, I_CONVB, I_DTB, I_ALOG, I_DSK, I_MNW, I_WOUT, I_N2W, I_WQ, I_KEYS, I_PU, I_PV, I_FNW, N_IN };

constexpr size_t MiB = 1u << 20;
constexpr size_t WS_CTL = 0, CTL_ZERO_BYTES = 1 * MiB;
constexpr size_t WS_MOD = 1 * MiB;
constexpr size_t WS_WIN = 2 * MiB, WS_WOUT = 26 * MiB, WS_WQ = 34 * MiB, WS_KEYS = 42 * MiB;
constexpr size_t WS_WUPT = 43 * MiB, WS_AUPT = 43 * MiB + 256 * 1024, WS_GUPT = 43 * MiB + 512 * 1024;
constexpr size_t WS_PU8 = 44 * MiB, WS_PV8 = 76 * MiB;
constexpr size_t WS_USC = 108 * MiB, WS_VSC = 108 * MiB + 65536;
constexpr size_t WS_XN = 172 * MiB;
constexpr size_t WS_LW = WS_XN, WS_AA = WS_XN + 64 * MiB;
constexpr size_t WS_PROJ = 300 * MiB;
constexpr size_t WS_Q = WS_PROJ;
constexpr size_t WS_GG = 684 * MiB;
constexpr size_t WS_PD = WS_PROJ + 128 * MiB;
constexpr size_t WS_RTE = 684 * MiB, WS_RTG = 700 * MiB, WS_COEF = 716 * MiB;
constexpr size_t WS_OY = 748 * MiB;
constexpr size_t WS_END = 876 * MiB;
constexpr size_t WS_HB = 876 * MiB;

constexpr int RING_BYTES = 131072, LDS_BYTES = 147456;

#define LDS_WAIT() asm volatile("s_waitcnt lgkmcnt(0)" ::: "memory")
#define VM_WAIT() asm volatile("s_waitcnt vmcnt(0)" ::: "memory")
__device__ __forceinline__ unsigned pk2(float lo, float hi) { f32x2 v = {lo, hi}; bf16x2_t b = __builtin_convertvector(v, bf16x2_t); return __builtin_bit_cast(unsigned, b); }
__device__ __forceinline__ float bflo(unsigned u) { return __uint_as_float(u << 16); }
__device__ __forceinline__ float bfhi(unsigned u) { return __uint_as_float(u & 0xffff0000u); }
__device__ __forceinline__ float bf1(bf16 h) { return __uint_as_float((unsigned)h << 16); }
__device__ __forceinline__ float wave_sum(float v) {
#pragma unroll
    for (int o = 1; o < 64; o <<= 1) v += __shfl_xor(v, o);
    return v;
}
__device__ __forceinline__ float rcp_f(float v) { return __builtin_amdgcn_rcpf(v); }
template <int CTRL> __device__ __forceinline__ float dppc_f(float x) { return __builtin_bit_cast(float, __builtin_amdgcn_mov_dpp(__builtin_bit_cast(int, x), CTRL, 0xf, 0xf, true)); }
__device__ __forceinline__ float wave_sum_fast(float x) {
    x += dppc_f<0xB1>(x); x += dppc_f<0x4E>(x); x += dppc_f<0x124>(x); x += dppc_f<0x128>(x);
    { auto rr = __builtin_amdgcn_permlane16_swap(__float_as_uint(x), __float_as_uint(x), false, false); x = __uint_as_float(rr[0]) + __uint_as_float(rr[1]); }
    { auto rr = __builtin_amdgcn_permlane32_swap(__float_as_uint(x), __float_as_uint(x), false, false); x = __uint_as_float(rr[0]) + __uint_as_float(rr[1]); }
    return x;
}
__device__ __forceinline__ float silu_f(float v) { return v * rcp_f(1.f + __expf(-v)); }
__device__ __forceinline__ float sigmoid_f(float v) { return rcp_f(1.f + __expf(-v)); }

struct Ctx {
    LAS unsigned char* lds;
    int tid, lane, wave, G, gw, NGW;
    const float* const* in;
    float* out; unsigned char* ws;
};

__device__ __forceinline__ void transpose_item(const float* W, int K, int N, bf16* WT, int ldt, int nrows_out, LAS float* scr, int kb, int nb, int lane) {
    const int k0 = 64 * kb, n0 = 64 * nb;
    const int c4 = 4 * (lane & 15), rr = lane >> 4;
    const bool vec_ok = ((N & 3) == 0) && (n0 + 64 <= N);
#pragma unroll 4
    for (int i = 0; i < 16; ++i) { const int kk = 4 * i + rr, k = k0 + kk;
        f32x4 v = {0.f, 0.f, 0.f, 0.f};
        if (k < K) { const float* src = W + (size_t)k * N + n0 + c4;
            if (vec_ok) v = *(const f32x4*)src;
            else { if (n0 + c4 + 0 < N) v.x = src[0]; if (n0 + c4 + 1 < N) v.y = src[1]; if (n0 + c4 + 2 < N) v.z = src[2]; if (n0 + c4 + 3 < N) v.w = src[3]; } }
        LAS float* d = scr + kk * 65 + c4; d[0] = v.x; d[1] = v.y; d[2] = v.z; d[3] = v.w; }
    LDS_WAIT(); asm volatile("" ::: "memory");
    const int c = lane & 7;
#pragma unroll
    for (int j = 0; j < 8; ++j) { const int n = (lane >> 3) + 8 * j; const LAS float* sp = scr + (8 * c) * 65 + n;
        v4u o; o.x = pk2(sp[0 * 65], sp[1 * 65]); o.y = pk2(sp[2 * 65], sp[3 * 65]); o.z = pk2(sp[4 * 65], sp[5 * 65]); o.w = pk2(sp[6 * 65], sp[7 * 65]);
        if (n0 + n < nrows_out && k0 + 8 * c + 8 <= ldt) *(v4u*)(WT + (size_t)(n0 + n) * ldt + k0 + 8 * c) = o; }
    LDS_WAIT(); asm volatile("" ::: "memory");
}
__device__ __forceinline__ void transpose_all(const float* W, int K, int N, bf16* WT, int ldt, int nrows_out, LAS float* scr, int gw, int NGW, int lane) {
    const int nkb = (K + 63) / 64, nnb = nrows_out / 64, nit = nkb * nnb;
    for (int it = gw; it < nit; it += NGW) transpose_item(W, K, N, WT, ldt, nrows_out, scr, it / nnb, it % nnb, lane);
}
__device__ __forceinline__ void convert_all(const float* src, bf16* dst, size_t n8, int gw, int NGW, int lane) {
    const f32x4* s4 = (const f32x4*)src; v4u* d4 = (v4u*)dst;
    for (size_t i = (size_t)gw * 64 + lane; i < n8; i += (size_t)NGW * 64) {
        const f32x4 a = __builtin_nontemporal_load(s4 + 2 * i), b = __builtin_nontemporal_load(s4 + 2 * i + 1);
        v4u o; o.x = pk2(a.x, a.y); o.y = pk2(a.z, a.w); o.z = pk2(b.x, b.y); o.w = pk2(b.z, b.w);
        d4[i] = o; }
}
__device__ __forceinline__ void quantize_rows_fp8(const float* src, unsigned char* dst8, float* scales, int e0, int e1, int step, int lane) {
    if (e0 >= e1) return;
    f32x4 vn[8];
    { const f32x4* s4 = (const f32x4*)(src + (size_t)e0 * DM) + lane;
#pragma unroll
      for (int i = 0; i < 8; ++i) vn[i] = __builtin_nontemporal_load(s4 + 64 * i); }
    for (int e = e0; e < e1; e += step) {
        f32x4 v[8];
#pragma unroll
        for (int i = 0; i < 8; ++i) v[i] = vn[i];
        { const int en = (e + step < e1) ? e + step : e; const f32x4* s4 = (const f32x4*)(src + (size_t)en * DM) + lane;
#pragma unroll
          for (int i = 0; i < 8; ++i) vn[i] = __builtin_nontemporal_load(s4 + 64 * i); }
        float am = 0.f;
#pragma unroll
        for (int i = 0; i < 8; ++i) am = fmaxf(fmaxf(am, fmaxf(fabsf(v[i].x), fabsf(v[i].y))), fmaxf(fabsf(v[i].z), fabsf(v[i].w)));
#pragma unroll
        for (int o = 1; o < 64; o <<= 1) am = fmaxf(am, __shfl_xor(am, o));
        am = fmaxf(am, 1e-30f);
        const float inv = 440.f / am;
#pragma unroll
        for (int i = 0; i < 8; ++i) { int w = __builtin_amdgcn_cvt_pk_fp8_f32(v[i].x * inv, v[i].y * inv, 0, false); w = __builtin_amdgcn_cvt_pk_fp8_f32(v[i].z * inv, v[i].w * inv, w, true);
            const int seg = 2 * i + (lane >> 5);
            *(int*)(dst8 + (size_t)seg * ((size_t)NEXP * 128) + (size_t)e * 128 + 4 * (lane & 31)) = w; }
        if (lane == 0) scales[e] = am * (1.f / 440.f);
    }
}
__device__ __forceinline__ void quantize_rows_fp4(const float* src, unsigned char* dst4, float* scales, int e0, int e1, int step, int lane) {
    if (e0 >= e1) return;
    f32x4 vn[8];
    { const f32x4* s4 = (const f32x4*)(src + (size_t)e0 * DM) + lane;
#pragma unroll
      for (int i = 0; i < 8; ++i) vn[i] = __builtin_nontemporal_load(s4 + 64 * i); }
    for (int e = e0; e < e1; e += step) {
        f32x4 v[8];
#pragma unroll
        for (int i = 0; i < 8; ++i) v[i] = vn[i];
        { const int en = (e + step < e1) ? e + step : e; const f32x4* s4 = (const f32x4*)(src + (size_t)en * DM) + lane;
#pragma unroll
          for (int i = 0; i < 8; ++i) vn[i] = __builtin_nontemporal_load(s4 + 64 * i); }
        float am = 0.f;
#pragma unroll
        for (int i = 0; i < 8; ++i) am = fmaxf(am, fmaxf(fmaxf(fabsf(v[i].x), fabsf(v[i].y)), fmaxf(fabsf(v[i].z), fabsf(v[i].w))));
#pragma unroll
        for (int o = 1; o < 64; o <<= 1) am = fmaxf(am, __shfl_xor(am, o));
        am = fmaxf(am, 1e-30f);
        const float inv = 6.f / am;
#pragma unroll
        for (int i = 0; i < 8; ++i) {
            unsigned w = __builtin_amdgcn_cvt_scalef32_pk_fp4_f32(0u, v[i].x * inv, v[i].y * inv, 1.0f, 0);
            w = __builtin_amdgcn_cvt_scalef32_pk_fp4_f32(w, v[i].z * inv, v[i].w * inv, 1.0f, 1);
            *(unsigned short*)(dst4 + (size_t)i * ((size_t)NEXP * 128) + (size_t)e * 128 + 2 * lane) = (unsigned short)w;
        }
        if (lane == 0) scales[e] = am * (1.f / 6.f);
    }
}
__device__ __forceinline__ void p0_prologue(const Ctx& F) {
    __syncthreads();
    if (blockIdx.x < MODW / 64) {
        LAS float* sc = (LAS float*)F.lds;
        LAS float* red = sc + NB * DM;
        const float* c = F.in[I_C];
        for (int i = F.tid; i < NB * DM; i += NTHR) sc[i] = silu_f(c[i]);
        __syncthreads();
        const int j = blockIdx.x * 64 + F.lane;
        const float* wp = F.in[I_ADAW] + (size_t)(F.wave * 256) * MODW + j;
        float a0 = 0.f, a1 = 0.f, a2 = 0.f, a3 = 0.f;
#pragma unroll 32
        for (int kk = 0; kk < 256; ++kk) { const float w = wp[(size_t)kk * MODW]; const int k = F.wave * 256 + kk;
            a0 += sc[k] * w; a1 += sc[DM + k] * w; a2 += sc[2 * DM + k] * w; a3 += sc[3 * DM + k] * w; }
        red[(F.wave * 4 + 0) * 64 + F.lane] = a0; red[(F.wave * 4 + 1) * 64 + F.lane] = a1; red[(F.wave * 4 + 2) * 64 + F.lane] = a2; red[(F.wave * 4 + 3) * 64 + F.lane] = a3;
        __syncthreads();
        if (F.tid < 256) { const int b = F.tid >> 6, l = F.tid & 63; float s = F.in[I_ADAB][blockIdx.x * 64 + l];
#pragma unroll
            for (int w = 0; w < 8; ++w) s += red[(w * 4 + b) * 64 + l];
            ((float*)(F.ws + WS_MOD))[b * MODW + blockIdx.x * 64 + l] = s; }
        __syncthreads();
    }
    LAS float* scr = (LAS float*)(F.lds + F.wave * 16640);
    transpose_all(F.in[I_WIN], DM, INP, (bf16*)(F.ws + WS_WIN), DM, INPP, scr, F.gw, F.NGW, F.lane);
    transpose_all(F.in[I_WOUT], DM, DM, (bf16*)(F.ws + WS_WOUT), DM, DM, scr, F.gw, F.NGW, F.lane);
    transpose_all(F.in[I_WQ], DM, DM, (bf16*)(F.ws + WS_WQ), DM, DM, scr, F.gw, F.NGW, F.lane);
    transpose_all(F.in[I_WUP], L_W, RW, (bf16*)(F.ws + WS_WUPT), L_W, RW, scr, F.gw, F.NGW, F.lane);
    transpose_all(F.in[I_AUP], L_A, RW, (bf16*)(F.ws + WS_AUPT), L_A, RW, scr, F.gw, F.NGW, F.lane);
    transpose_all(F.in[I_GUP], L_G, RW, (bf16*)(F.ws + WS_GUPT), L_G, RW, scr, F.gw, F.NGW, F.lane);
    convert_all(F.in[I_KEYS], (bf16*)(F.ws + WS_KEYS), (size_t)16 * 128 * 128 / 8, F.gw, F.NGW, F.lane);
    {
        const int nlo = (F.G < 192) ? F.G : 192, nhi = F.G - nlo;
        const int wtot = 5 * nlo + 8 * nhi;
        const int wb0 = (blockIdx.x < nlo) ? 5 * blockIdx.x : 5 * nlo + 8 * (blockIdx.x - nlo), wb1 = wb0 + ((blockIdx.x < nlo) ? 5 : 8);
        const int r0 = (int)((long)(2 * NEXP) * wb0 / wtot), r1 = (int)((long)(2 * NEXP) * wb1 / wtot);
        const int a0 = r0 < NEXP ? r0 : NEXP, a1 = r1 < NEXP ? r1 : NEXP;
        quantize_rows_fp4(F.in[I_PU], F.ws + WS_PU8, (float*)(F.ws + WS_USC), a0 + F.wave, a1, NWAVES, F.lane);
        const int b0 = (r0 > NEXP ? r0 : NEXP) - NEXP, b1 = (r1 > NEXP ? r1 : NEXP) - NEXP;
        quantize_rows_fp4(F.in[I_PV], F.ws + WS_PV8, (float*)(F.ws + WS_VSC), b0 + F.wave, b1, NWAVES, F.lane);
    }
}

__device__ __forceinline__ void norm_mod_rows(const Ctx& F, const float* X, const float* nw, int shift_off, int scale_off, bf16* XN) {
    const float* mod = (const float*)(F.ws + WS_MOD);
    if (F.gw >= M) return;
    f32x4 vn[8];
    { const f32x4* xr = (const f32x4*)(X + (size_t)F.gw * DM) + F.lane;
#pragma unroll
      for (int j = 0; j < 8; ++j) vn[j] = xr[64 * j]; }
    for (int m = F.gw; m < M; m += F.NGW) {
        const int b = m / SEQ;
        f32x4 v[8]; float s = 0.f;
#pragma unroll
        for (int j = 0; j < 8; ++j) { v[j] = vn[j]; s += (v[j].x * v[j].x + v[j].y * v[j].y) + (v[j].z * v[j].z + v[j].w * v[j].w); }
        { const int mn = (m + F.NGW < M) ? m + F.NGW : m; const f32x4* xr = (const f32x4*)(X + (size_t)mn * DM) + F.lane;
#pragma unroll
          for (int j = 0; j < 8; ++j) vn[j] = xr[64 * j]; }
        const float rstd = rsqrtf(wave_sum_fast(s) * (1.f / DM) + RMS_EPS);
        const f32x4* wp = (const f32x4*)nw + F.lane;
        const f32x4* shp = (const f32x4*)(mod + (size_t)b * MODW + shift_off) + F.lane;
        const f32x4* scp = (const f32x4*)(mod + (size_t)b * MODW + scale_off) + F.lane;
        v2u* o = (v2u*)(XN + (size_t)m * DM) + F.lane;
#pragma unroll
        for (int j = 0; j < 8; ++j) { const f32x4 w = wp[64 * j], a = scp[64 * j], c = shp[64 * j];
            const f32x4 r = (v[j] * rstd) * w * (a + 1.f) + c;
            v2u p; p.x = pk2(r.x, r.y); p.y = pk2(r.z, r.w); o[64 * j] = p; }
    }
}
__device__ __forceinline__ void final_norm_rows(const Ctx& F, const float* H, const float* nw, float* O) {
    for (int m = F.gw; m < M; m += F.NGW) {
        const f32x4* xr = (const f32x4*)(H + (size_t)m * DM) + F.lane;
        f32x4 v[8]; float s = 0.f;
#pragma unroll
        for (int j = 0; j < 8; ++j) { v[j] = xr[64 * j]; s += (v[j].x * v[j].x + v[j].y * v[j].y) + (v[j].z * v[j].z + v[j].w * v[j].w); }
        const float rstd = rsqrtf(wave_sum(s) * (1.f / DM) + RMS_EPS);
        const f32x4* wp = (const f32x4*)nw + F.lane;
        f32x4* o = (f32x4*)(O + (size_t)m * DM) + F.lane;
#pragma unroll
        for (int j = 0; j < 8; ++j) o[64 * j] = (v[j] * rstd) * wp[64 * j];
    }
}


__device__ __forceinline__ void load_row_raw(const bf16* row, int lane, v2u (&u)[8]) {
    const v2u* p = (const v2u*)row + lane;
#pragma unroll
    for (int j = 0; j < 8; ++j) u[j] = p[64 * j];
}
__device__ __forceinline__ void norm_mod_rows_bf16(const Ctx& F, const bf16* X, const float* nw, int shift_off, int scale_off, bf16* XN) {
    const float* mod = (const float*)(F.ws + WS_MOD);
    if (F.gw >= M) return;
    v2u un[8]; load_row_raw(X + (size_t)F.gw * DM, F.lane, un);
    for (int m = F.gw; m < M; m += F.NGW) {
        const int b = m / SEQ;
        f32x4 v[8]; float s = 0.f;
#pragma unroll
        for (int j = 0; j < 8; ++j) { v[j] = (f32x4){bflo(un[j].x), bfhi(un[j].x), bflo(un[j].y), bfhi(un[j].y)}; s += (v[j].x * v[j].x + v[j].y * v[j].y) + (v[j].z * v[j].z + v[j].w * v[j].w); }
        { const int mn = (m + F.NGW < M) ? m + F.NGW : m; load_row_raw(X + (size_t)mn * DM, F.lane, un); }
        const float rstd = rsqrtf(wave_sum_fast(s) * (1.f / DM) + RMS_EPS);
        const f32x4* wp = (const f32x4*)nw + F.lane;
        const f32x4* shp = (const f32x4*)(mod + (size_t)b * MODW + shift_off) + F.lane;
        const f32x4* scp = (const f32x4*)(mod + (size_t)b * MODW + scale_off) + F.lane;
        v2u* o = (v2u*)(XN + (size_t)m * DM) + F.lane;
#pragma unroll
        for (int j = 0; j < 8; ++j) { const f32x4 w = wp[64 * j], a = scp[64 * j], c = shp[64 * j];
            const f32x4 r = (v[j] * rstd) * w * (a + 1.f) + c;
            v2u p; p.x = pk2(r.x, r.y); p.y = pk2(r.z, r.w); o[64 * j] = p; }
    }
}
__device__ __forceinline__ void final_norm_rows_bf16(const Ctx& F, const bf16* H, const float* nw, float* O, float oscale) {
    if (F.gw >= M) return;
    v2u un[8]; load_row_raw(H + (size_t)F.gw * DM, F.lane, un);
    f32x4 wv[8];
#pragma unroll
    for (int j = 0; j < 8; ++j) wv[j] = ((const f32x4*)nw + F.lane)[64 * j];
    for (int m = F.gw; m < M; m += F.NGW) {
        f32x4 v[8]; float s = 0.f;
#pragma unroll
        for (int j = 0; j < 8; ++j) { v[j] = (f32x4){bflo(un[j].x), bfhi(un[j].x), bflo(un[j].y), bfhi(un[j].y)}; s += (v[j].x * v[j].x + v[j].y * v[j].y) + (v[j].z * v[j].z + v[j].w * v[j].w); }
        { const int mn = (m + F.NGW < M) ? m + F.NGW : m; load_row_raw(H + (size_t)mn * DM, F.lane, un); }
        const float rstd = rsqrtf(wave_sum_fast(s) * (1.f / DM) + RMS_EPS) * oscale;
        f32x4* o = (f32x4*)(O + (size_t)m * DM) + F.lane;
#pragma unroll
        for (int j = 0; j < 8; ++j) __builtin_nontemporal_store((v[j] * rstd) * wv[j], o + 64 * j);
    }
}
#define LO2(v) __builtin_shufflevector((v), (v), 0, 1)
#define HI2(v) __builtin_shufflevector((v), (v), 2, 3)
template <int CTRL> __device__ __forceinline__ float dpp_f(float x) { return __builtin_bit_cast(float, __builtin_amdgcn_mov_dpp(__builtin_bit_cast(int, x), CTRL, 0xf, 0xf, true)); }
__device__ __forceinline__ float rowsum16(float x) { x += dpp_f<0xB1>(x); x += dpp_f<0x4E>(x); x += dpp_f<0x124>(x); x += dpp_f<0x128>(x); return x; }
__device__ __forceinline__ float quadsum(float x) { x += dpp_f<0xB1>(x); x += dpp_f<0x4E>(x); return x; }

__device__ __forceinline__ float treduce16(const float (&p)[16], bool b0, bool b1, bool b2, bool b3) {
    float a[8], bq[4], c2[2];
#pragma unroll
    for (int j = 0; j < 8; ++j) { const float mine = b3 ? p[j + 8] : p[j], send = b3 ? p[j] : p[j + 8]; a[j] = mine + dpp_f<0x128>(send); }
#pragma unroll
    for (int j = 0; j < 4; ++j) { const float mine = b2 ? a[j + 4] : a[j], send = b2 ? a[j] : a[j + 4]; const float up = dpp_f<0x104>(send), dn = dpp_f<0x114>(send); bq[j] = mine + (b2 ? dn : up); }
#pragma unroll
    for (int j = 0; j < 2; ++j) { const float mine = b1 ? bq[j + 2] : bq[j], send = b1 ? bq[j] : bq[j + 2]; c2[j] = mine + dpp_f<0x4E>(send); }
    const float mine = b0 ? c2[1] : c2[0], send = b0 ? c2[0] : c2[1];
    return mine + dpp_f<0xB1>(send);
}
__device__ __forceinline__ float wave_sum_dpp(float v) { v = rowsum16(v); v += __shfl_xor(v, 16); v += __shfl_xor(v, 32); return v; }
__device__ __forceinline__ void unpack8(const v4u p, float (&e)[8]) { e[0] = bflo(p.x); e[1] = bfhi(p.x); e[2] = bflo(p.y); e[3] = bfhi(p.y); e[4] = bflo(p.z); e[5] = bfhi(p.z); e[6] = bflo(p.w); e[7] = bfhi(p.w); }
__device__ __forceinline__ v4u pack8(const float (&e)[8]) { v4u o; o.x = pk2(e[0], e[1]); o.y = pk2(e[2], e[3]); o.z = pk2(e[4], e[5]); o.w = pk2(e[6], e[7]); return o; }

__device__ __forceinline__ void p3_lora(const Ctx& F) {
    const bf16* PROJ = (const bf16*)(F.ws + WS_PROJ);
    const bf16* WUPT = (const bf16*)(F.ws + WS_WUPT); const bf16* AUPT = (const bf16*)(F.ws + WS_AUPT); const bf16* GUPT = (const bf16*)(F.ws + WS_GUPT);
    bf16* LW = (bf16*)(F.ws + WS_LW); bf16* AA = (bf16*)(F.ws + WS_AA); bf16* GG = (bf16*)(F.ws + WS_GG);
    const float* mu = F.in[I_MU]; const float* w0 = F.in[I_W0]; const float* a0 = F.in[I_A0];
    const int r16 = F.lane & 15, q = F.lane >> 4;
    constexpr int WST = 72, GST = 168;
    LAS bf16* WU = (LAS bf16*)F.lds; LAS bf16* AU = WU + 128 * WST; LAS bf16* GU = AU + 128 * WST;
    const int nr = blockIdx.x & 7, nbr = (F.G - nr + 7) >> 3;
    __syncthreads();
    for (int i = F.tid; i < 128 * 8; i += NTHR) { const int row = i >> 3, ch = i & 7;
        *(LAS v4u*)(WU + row * WST + 8 * ch) = *(const v4u*)(WUPT + (size_t)(128 * nr + row) * L_W + 8 * ch);
        *(LAS v4u*)(AU + row * WST + 8 * ch) = *(const v4u*)(AUPT + (size_t)(128 * nr + row) * L_A + 8 * ch); }
    for (int i = F.tid; i < 128 * 20; i += NTHR) { const int row = i / 20, ch = i - row * 20;
        *(LAS v4u*)(GU + row * GST + 8 * ch) = *(const v4u*)(GUPT + (size_t)(128 * nr + row) * L_G + 8 * ch); }
    __syncthreads();
#define P3_COL(s) ((((s) < 2) ? (C_WD + 32 * (s)) : ((s) < 4) ? (C_AD + 32 * ((s) - 2)) : (C_GD + 32 * ((s) - 4))) + 8 * q)
    const int mt0 = (blockIdx.x >> 3) * NWAVES + F.wave, mst = nbr * NWAVES;
    v4u rc_[9], rp_[9];
    if (mt0 < M / 16) { const bf16* row = PROJ + (size_t)(mt0 * 16 + r16) * INPP;
#pragma unroll
        for (int s = 0; s < 9; ++s) { rc_[s] = *(const v4u*)(row + P3_COL(s)); rp_[s] = *(const v4u*)(row - INPP + P3_COL(s)); } }
    for (int mt = mt0; mt < M / 16; mt += mst) {
        const int m = mt * 16 + r16; const bool first = (m % SEQ) == 0;
        bf16x8 af[9];
#pragma unroll
        for (int s = 0; s < 9; ++s) {
            const int col = P3_COL(s);
            const v4u pc = rc_[s];
            v4u pp = rp_[s]; if (first) pp = (v4u){0u, 0u, 0u, 0u};
            const f32x4 m0 = *(const f32x4*)(mu + col), m1 = *(const f32x4*)(mu + col + 4);
            float c[8], p[8], e[8]; unpack8(pc, c); unpack8(pp, p);
            const float mm[8] = {m0.x, m0.y, m0.z, m0.w, m1.x, m1.y, m1.z, m1.w};
#pragma unroll
            for (int j = 0; j < 8; ++j) { float v = c[j] + (p[j] - c[j]) * mm[j];
                if (s < 2) { const float t = __expf(2.f * v); v = 1.f - 2.f * rcp_f(t + 1.f); }
                else if (s >= 4) v = sigmoid_f(v);
                e[j] = v; }
            af[s] = __builtin_bit_cast(bf16x8, pack8(e));
        }
        { const int mtn = (mt + mst < M / 16) ? mt + mst : mt; const bf16* row = PROJ + (size_t)(mtn * 16 + r16) * INPP;
#pragma unroll
          for (int s = 0; s < 9; ++s) { rc_[s] = *(const v4u*)(row + P3_COL(s)); rp_[s] = *(const v4u*)(row - INPP + P3_COL(s)); } }
        asm volatile("" ::: "memory");
#pragma unroll 2
        for (int nt = 0; nt < 8; ++nt) {
            const LAS bf16* wu = WU + (16 * nt + r16) * WST + 8 * q; const LAS bf16* au = AU + (16 * nt + r16) * WST + 8 * q; const LAS bf16* gu = GU + (16 * nt + r16) * GST + 8 * q;
            f32x4 acc0 = {0.f, 0.f, 0.f, 0.f}, acc1 = acc0, acc2 = acc0;
#pragma unroll
            for (int s2 = 0; s2 < 2; ++s2) acc0 = __builtin_amdgcn_mfma_f32_16x16x32_bf16(*(const LAS bf16x8*)(wu + 32 * s2), af[s2], acc0, 0, 0, 0);
#pragma unroll
            for (int s2 = 0; s2 < 2; ++s2) acc1 = __builtin_amdgcn_mfma_f32_16x16x32_bf16(*(const LAS bf16x8*)(au + 32 * s2), af[2 + s2], acc1, 0, 0, 0);
#pragma unroll
            for (int s2 = 0; s2 < 5; ++s2) acc2 = __builtin_amdgcn_mfma_f32_16x16x32_bf16(*(const LAS bf16x8*)(gu + 32 * s2), af[4 + s2], acc2, 0, 0, 0);
            const int n = 128 * nr + 16 * nt + 4 * q;
            const f32x4 w0v = *(const f32x4*)(w0 + n), a0v = *(const f32x4*)(a0 + n);
            v2u o0, o1, o2;
            o0.x = pk2(-0.60653066f * sigmoid_f(acc0[0] + w0v.x), -0.60653066f * sigmoid_f(acc0[1] + w0v.y));
            o0.y = pk2(-0.60653066f * sigmoid_f(acc0[2] + w0v.z), -0.60653066f * sigmoid_f(acc0[3] + w0v.w));
            o1.x = pk2(sigmoid_f(acc1[0] + a0v.x), sigmoid_f(acc1[1] + a0v.y)); o1.y = pk2(sigmoid_f(acc1[2] + a0v.z), sigmoid_f(acc1[3] + a0v.w));
            o2.x = pk2(acc2[0], acc2[1]); o2.y = pk2(acc2[2], acc2[3]);
            *(v2u*)(LW + (size_t)m * RW + n) = o0; *(v2u*)(AA + (size_t)m * RW + n) = o1; *(v2u*)(GG + (size_t)m * RW + n) = o2;
        }
    }
#undef P3_COL
    __syncthreads();
}

constexpr int TC = 32, NCHUNK = SEQ / TC;
constexpr int RB_R = 0, RB_W = TC * 64, RB_K = 2 * TC * 64, RB_KK = 3 * TC * 64, RB_KA = 4 * TC * 64, RB_V = 5 * TC * 64, RB_SIZE = 5 * TC * 64 + TC * 16;
constexpr int MB_B = 0, MB_C = TC * 128, MB_X = 2 * TC * 128, MB_DT = MB_X + TC * 32, MB_DA = MB_DT + TC, MB_SIZE = MB_DA + TC;
static_assert(2 * RB_SIZE * 4 <= RING_BYTES, "scan buffers fit the LDS ring");

struct RwkvRaw { bf16 r[9], k[9], v[9], lw[8], a[8]; };
__device__ __forceinline__ void rwkv_load(RwkvRaw& raw, const bf16* PROJ, const bf16* LW, const bf16* AA, int b, int h, int t0w, int c) {
    const bf16* base = PROJ + (size_t)(b * SEQ + t0w) * INPP + h * 64 + c;
#pragma unroll
    for (int i = 0; i < 9; ++i) {
        if (i == 0 && t0w == 0) { raw.r[0] = 0; raw.k[0] = 0; raw.v[0] = 0; }
        else { const bf16* row = base + (long)(i - 1) * INPP; raw.r[i] = row[C_R]; raw.k[i] = row[C_K]; raw.v[i] = row[C_V]; }
    }
#pragma unroll
    for (int i = 0; i < 8; ++i) { const size_t o = (size_t)(b * SEQ + t0w + i) * RW + h * 64 + c; raw.lw[i] = LW[o]; raw.a[i] = AA[o]; }
}
__device__ __forceinline__ void rwkv_stage(const RwkvRaw& raw, LAS float* buf, int tl0, int c, int qt, float mu_r, float mu_k, float mu_v, float kkw, float kaw) {
#pragma unroll
    for (int i = 0; i < 8; ++i) {
        const int t = tl0 + i;
        const float rc = bf1(raw.r[i + 1]), rp = bf1(raw.r[i]), kc = bf1(raw.k[i + 1]), kp = bf1(raw.k[i]), vc = bf1(raw.v[i + 1]), vp = bf1(raw.v[i]);
        const float rr = rc + (rp - rc) * mu_r, kx = kc + (kp - kc) * mu_k, vv = vc + (vp - vc) * mu_v;
        const float a = bf1(raw.a[i]), dec = __expf(bf1(raw.lw[i]));
        const float kkraw = kx * kkw; const float ss = wave_sum_dpp(kkraw * kkraw);
        const float kkn = kkraw * rcp_f(fmaxf(sqrtf(ss), 1e-12f));
        buf[RB_R + t * 64 + c] = rr; buf[RB_W + t * 64 + c] = dec; buf[RB_K + t * 64 + c] = kx * (1.f + (a - 1.f) * kaw);
        buf[RB_KK + t * 64 + c] = kkn; buf[RB_KA + t * 64 + c] = kkn * a;
        if ((c >> 4) == qt) buf[RB_V + t * 16 + (c & 15)] = vv;
    }
}
__device__ __forceinline__ void rwkv_task(const Ctx& F, int task) {
    const int b = task >> 6, h = (task >> 2) & 15, qt = task & 3;
    const bf16* PROJ = (const bf16*)(F.ws + WS_PROJ); const bf16* LW = (const bf16*)(F.ws + WS_LW); const bf16* AA = (const bf16*)(F.ws + WS_AA);
    bf16* OY = (bf16*)(F.ws + WS_OY);
    LAS float* lbuf = (LAS float*)F.lds;
    const int c = F.lane, w = F.wave, r = F.lane >> 4, cg = F.lane & 15;
    const bool stager = w >= 4; const int sw = w & 3;
    const int ch = h * 64 + c;
    const float mu_r = F.in[I_MU][C_R + ch], mu_k = F.in[I_MU][C_K + ch], mu_v = F.in[I_MU][C_V + ch], kkw = F.in[I_KK][ch], kaw = F.in[I_KA][ch];
    RwkvRaw raw;
    if (stager) { rwkv_load(raw, PROJ, LW, AA, b, h, 8 * sw, c); rwkv_stage(raw, lbuf, 8 * sw, c, qt, mu_r, mu_k, mu_v, kkw, kaw); rwkv_load(raw, PROJ, LW, AA, b, h, TC + 8 * sw, c); }
    __syncthreads();
    f32x2 S01 = {0.f, 0.f}, S23 = {0.f, 0.f};
    const bool cb0 = cg & 1, cb1 = cg & 2, cb2 = cg & 4, cb3 = cg & 8;
    bf16* orow = OY + (size_t)(b * SEQ) * DM + h * 64 + 16 * qt + 4 * sw + r;
    for (int ck = 0; ck < NCHUNK; ++ck) {
        const LAS float* buf = lbuf + (ck & 1) * RB_SIZE;
        if (stager) {
            if (ck + 1 < NCHUNK) { rwkv_stage(raw, lbuf + ((ck + 1) & 1) * RB_SIZE, 8 * sw, c, qt, mu_r, mu_k, mu_v, kkw, kaw);
                if (ck + 2 < NCHUNK) rwkv_load(raw, PROJ, LW, AA, b, h, (ck + 2) * TC + 8 * sw, c); }
        } else {
            const LAS float* bp = buf + 4 * cg; const LAS float* vp = buf + RB_V + 4 * sw + r;
            f32x4 qkk[3], qw[3], qka[3], qk[3], qr[3]; float qv[3];
#pragma unroll
            for (int i = 0; i < 3; ++i) { qkk[i] = *(const LAS f32x4*)(bp + RB_KK + i * 64); qw[i] = *(const LAS f32x4*)(bp + RB_W + i * 64); qka[i] = *(const LAS f32x4*)(bp + RB_KA + i * 64);
                qk[i] = *(const LAS f32x4*)(bp + RB_K + i * 64); qr[i] = *(const LAS f32x4*)(bp + RB_R + i * 64); qv[i] = vp[i * 16]; }
            float op[16];
#pragma unroll
            for (int j = 0; j < TC; ++j) {
                const int u = j % 3;
                const f32x4 kk4 = qkk[u], w4 = qw[u], ka4 = qka[u], k4 = qk[u], r4 = qr[u]; const float vr = qv[u];
                const f32x2 tq = S01 * LO2(kk4) + S23 * HI2(kk4);
                const float sa = rowsum16(tq.x + tq.y);
                const f32x2 sav = {sa, sa}, vrv = {vr, vr};
                S01 = S01 * LO2(w4) + (vrv * LO2(k4) - sav * LO2(ka4));
                S23 = S23 * HI2(w4) + (vrv * HI2(k4) - sav * HI2(ka4));
                const f32x2 uq = S01 * LO2(r4) + S23 * HI2(r4);
                op[j & 15] = uq.x + uq.y;
                asm volatile("" : "+v"(S01), "+v"(S23) :: "memory");
                if (j + 3 < TC) { qkk[u] = *(const LAS f32x4*)(bp + RB_KK + (j + 3) * 64); qw[u] = *(const LAS f32x4*)(bp + RB_W + (j + 3) * 64); qka[u] = *(const LAS f32x4*)(bp + RB_KA + (j + 3) * 64);
                                  qk[u] = *(const LAS f32x4*)(bp + RB_K + (j + 3) * 64); qr[u] = *(const LAS f32x4*)(bp + RB_R + (j + 3) * 64); qv[u] = vp[(j + 3) * 16]; }
                if ((j & 15) == 15) {
                    const float ored = treduce16(op, cb0, cb1, cb2, cb3);
                    orow[(size_t)(ck * TC + (j - 15) + cg) * DM] = (bf16)(pk2(ored, 0.f) & 0xffffu);
                }
            }
        }
        __syncthreads();
    }
}

__device__ __forceinline__ void p4_scans(const Ctx& F) {
    for (int task = blockIdx.x; task < NB * RHEADS * 4; task += F.G) { rwkv_task(F, task); __syncthreads(); }
}

__device__ __forceinline__ void ld16(const float* p, float (&v)[16]) {
#pragma unroll
    for (int i = 0; i < 4; ++i) { const f32x4 t = *(const f32x4*)(p + 4 * i); v[4 * i] = t.x; v[4 * i + 1] = t.y; v[4 * i + 2] = t.z; v[4 * i + 3] = t.w; }
}
__device__ __forceinline__ void ldbf16x16(const bf16* p, float (&v)[16]) {
    float t0[8], t1[8]; unpack8(*(const v4u*)p, t0); unpack8(*(const v4u*)(p + 8), t1);
#pragma unroll
    for (int j = 0; j < 8; ++j) { v[j] = t0[j]; v[8 + j] = t1[j]; }
}
__device__ __forceinline__ void stbf16x16(bf16* p, const float (&v)[16]) {
    float t0[8], t1[8];
#pragma unroll
    for (int j = 0; j < 8; ++j) { t0[j] = v[j]; t1[j] = v[8 + j]; }
    *(v4u*)p = pack8(t0); *(v4u*)(p + 8) = pack8(t1);
}
__device__ __forceinline__ void p5_post(const Ctx& F) {
    const bf16* PROJ = (const bf16*)(F.ws + WS_PROJ); const bf16* AA = (const bf16*)(F.ws + WS_AA); const bf16* GG = (const bf16*)(F.ws + WS_GG);
    bf16* OY = (bf16*)(F.ws + WS_OY);
    const int c0 = 16 * F.lane;
    {
        float mur[16], muk[16], muv[16], ka[16], rk[16], lnw[16], lnb[16];
        ld16(F.in[I_MU] + C_R + c0, mur); ld16(F.in[I_MU] + C_K + c0, muk); ld16(F.in[I_MU] + C_V + c0, muv);
        ld16(F.in[I_KA] + c0, ka); ld16(F.in[I_RK] + c0, rk); ld16(F.in[I_LNW] + c0, lnw); ld16(F.in[I_LNB] + c0, lnb);
        for (int m = F.gw; m < M; m += F.NGW) {
            const bool first = (m % SEQ) == 0;
            const bf16* prow = PROJ + (size_t)m * INPP; bf16* oyrow = OY + (size_t)m * DM;
            float o[16], res[16]; float bs = 0.f;
            ldbf16x16(oyrow + c0, o);
            {
                float rc[16], rp[16], kc[16], kp[16], av[16];
                ldbf16x16(prow + C_R + c0, rc); ldbf16x16(prow + C_K + c0, kc); ldbf16x16(AA + (size_t)m * RW + c0, av);
                if (!first) { ldbf16x16(prow - INPP + C_R + c0, rp); ldbf16x16(prow - INPP + C_K + c0, kp); }
                else {
#pragma unroll
                    for (int j = 0; j < 16; ++j) { rp[j] = 0.f; kp[j] = 0.f; } }
#pragma unroll
                for (int j = 0; j < 16; ++j) { const float rr = rc[j] + (rp[j] - rc[j]) * mur[j], kx = kc[j] + (kp[j] - kc[j]) * muk[j];
                    bs += rr * (kx * (1.f + (av[j] - 1.f) * ka[j])) * rk[j]; }
            }
            bs = quadsum(bs);
            float s = 0.f;
#pragma unroll
            for (int j = 0; j < 16; ++j) s += o[j];
            const float mean = quadsum(s) * (1.f / 64.f);
            float qv = 0.f;
#pragma unroll
            for (int j = 0; j < 16; ++j) { o[j] -= mean; qv += o[j] * o[j]; }
            const float rstd = rsqrtf(quadsum(qv) * (1.f / 64.f) + 64e-5f);
            {
                float vc[16], vp[16], gv[16];
                ldbf16x16(prow + C_V + c0, vc); ldbf16x16(GG + (size_t)m * RW + c0, gv);
                if (!first) ldbf16x16(prow - INPP + C_V + c0, vp);
                else {
#pragma unroll
                    for (int j = 0; j < 16; ++j) vp[j] = 0.f; }
#pragma unroll
                for (int j = 0; j < 16; ++j) { const float vv = vc[j] + (vp[j] - vc[j]) * muv[j]; res[j] = (o[j] * rstd * lnw[j] + lnb[j] + bs * vv) * gv[j]; }
            }
            stbf16x16(oyrow + c0, res);
        }
    }
    {
        float nw[16]; ld16(F.in[I_MNW] + c0, nw);
        for (int m = F.gw; m < M; m += F.NGW) {
            const bf16* prow = PROJ + (size_t)m * INPP; bf16* oyrow = OY + (size_t)m * DM;
            float y[16], z[16];
            ldbf16x16(oyrow + RW + c0, y); ldbf16x16(prow + C_Z + c0, z);
            float qv = 0.f;
#pragma unroll
            for (int j = 0; j < 16; ++j) { y[j] *= silu_f(z[j]); qv += y[j] * y[j]; }
            qv = rowsum16(qv);
            { auto rr = __builtin_amdgcn_permlane16_swap(__float_as_uint(qv), __float_as_uint(qv), false, false); qv = __uint_as_float(rr[0]) + __uint_as_float(rr[1]); }
            const float rstd = rsqrtf(qv * (1.f / 512.f) + 1e-5f);
#pragma unroll
            for (int j = 0; j < 16; ++j) y[j] = y[j] * rstd * nw[j];
            stbf16x16(oyrow + RW + c0, y);
        }
    }
}
constexpr int MC_L = 128, MC_NC = SEQ / MC_L, LSTR = 136;
constexpr int MT_BYTES = 128 * LSTR * 2;
constexpr size_t WS_ST = 876 * MiB, WS_SIN = 940 * MiB, WS_ATOT = 1004 * MiB, WS_END2 = 1005 * MiB;

__device__ __forceinline__ float mamba_dt_scan(const Ctx& F, const bf16* PROJ, int b, int c, int g, LAS float* DT, LAS float* ACS) {
    const int head = g * 8 + F.wave, lane = F.lane;
    const float dtb = F.in[I_DTB][head], Aneg = -__expf(F.in[I_ALOG][head]);
    const bf16* p = PROJ + (size_t)(b * SEQ + c * MC_L + 2 * lane) * INPP + C_DT + head;
    const float x0 = bf1(p[0]) + dtb, x1 = bf1(p[INPP]) + dtb;
    const float d0 = (x0 > 20.f) ? x0 : log1pf(__expf(x0)), d1 = (x1 > 20.f) ? x1 : log1pf(__expf(x1));
    const float s0 = d0 * Aneg, s1 = s0 + d1 * Aneg;
    float incl = s1;
#pragma unroll
    for (int o = 1; o < 64; o <<= 1) { const float t = __shfl_up(incl, o); if (lane >= o) incl += t; }
    const float excl = incl - s1;
    DT[F.wave * 128 + 2 * lane] = d0; DT[F.wave * 128 + 2 * lane + 1] = d1;
    ACS[F.wave * 128 + 2 * lane] = excl + s0; ACS[F.wave * 128 + 2 * lane + 1] = excl + s1;
    return __shfl(incl, 63);
}
struct TRaw { bf16 v[35]; };
__device__ __forceinline__ void mstage_T_load(TRaw& raw, const bf16* PROJ, int b, int c, int chn, int tid) {
    const int t0 = 32 * (tid >> 7);
    const bf16* base = PROJ + (size_t)(b * SEQ + c * MC_L + t0) * INPP + C_XBC + chn;
    if (c * MC_L + t0 > 0) { raw.v[0] = base[-3 * INPP]; raw.v[1] = base[-2 * INPP]; raw.v[2] = base[-1 * INPP]; }
    else { raw.v[0] = 0; raw.v[1] = 0; raw.v[2] = 0; }
#pragma unroll
    for (int t = 0; t < 32; ++t) raw.v[3 + t] = base[(size_t)t * INPP];
}
template <bool SC>
__device__ __forceinline__ void mstage_T_store(const TRaw& raw, int chn, LAS bf16* dst, const LAS float* scale, const float* convw, const float* convb, int tid) {
    const int f = tid & 127, t0 = 32 * (tid >> 7);
    const float w0 = convw[chn], w1 = convw[1536 + chn], w2 = convw[2 * 1536 + chn], w3 = convw[3 * 1536 + chn], bb = convb[chn];
#pragma unroll
    for (int i8 = 0; i8 < 4; ++i8) {
        float e[8];
#pragma unroll
        for (int i = 0; i < 8; ++i) { const int t = 8 * i8 + i;
            float v = silu_f(bb + w0 * bf1(raw.v[t]) + w1 * bf1(raw.v[t + 1]) + w2 * bf1(raw.v[t + 2]) + w3 * bf1(raw.v[t + 3]));
            if (SC) v *= scale[t0 + t];
            e[i] = v; }
        *(LAS v4u*)(dst + f * LSTR + t0 + 8 * i8) = pack8(e);
    }
}
__device__ __forceinline__ void mstage_N(const bf16* PROJ, int b, int c, int g, LAS bf16* Bn, LAS bf16* Cn, const float* convw, const float* convb, int tid) {
    const int f8 = tid & 31, t0 = 8 * (tid >> 5);
    const int chn = (f8 < 16) ? (1024 + g * 128 + 8 * f8) : (1280 + g * 128 + 8 * (f8 - 16));
    LAS bf16* dst = ((f8 < 16) ? Bn : Cn) + 8 * (f8 & 15);
    const bf16* base = PROJ + (size_t)(b * SEQ + c * MC_L + t0) * INPP + C_XBC + chn;
    float w[4][8], bb[8];
#pragma unroll
    for (int i = 0; i < 4; ++i) { const f32x4 a = *(const f32x4*)(convw + i * 1536 + chn), d = *(const f32x4*)(convw + i * 1536 + chn + 4);
        w[i][0] = a.x; w[i][1] = a.y; w[i][2] = a.z; w[i][3] = a.w; w[i][4] = d.x; w[i][5] = d.y; w[i][6] = d.z; w[i][7] = d.w; }
    { const f32x4 a = *(const f32x4*)(convb + chn), d = *(const f32x4*)(convb + chn + 4); bb[0] = a.x; bb[1] = a.y; bb[2] = a.z; bb[3] = a.w; bb[4] = d.x; bb[5] = d.y; bb[6] = d.z; bb[7] = d.w; }
    float r0[8], r1[8], r2[8];
    if (c * MC_L + t0 > 0) { unpack8(*(const v4u*)(base - 3 * INPP), r0); unpack8(*(const v4u*)(base - 2 * INPP), r1); unpack8(*(const v4u*)(base - 1 * INPP), r2); }
    else {
#pragma unroll
        for (int k = 0; k < 8; ++k) { r0[k] = 0.f; r1[k] = 0.f; r2[k] = 0.f; } }
#pragma unroll
    for (int t = 0; t < 8; ++t) {
        float r3[8], e[8]; unpack8(*(const v4u*)(base + (size_t)t * INPP), r3);
#pragma unroll
        for (int k = 0; k < 8; ++k) { e[k] = silu_f(bb[k] + w[0][k] * r0[k] + w[1][k] * r1[k] + w[2][k] * r2[k] + w[3][k] * r3[k]); r0[k] = r1[k]; r1[k] = r2[k]; r2[k] = r3[k]; }
        *(LAS v4u*)(dst + (t0 + t) * LSTR) = pack8(e);
    }
}

__device__ __forceinline__ void m1_chunk_states(const Ctx& F) {
    const bf16* PROJ = (const bf16*)(F.ws + WS_PROJ); bf16* ST = (bf16*)(F.ws + WS_ST); float* ATOT = (float*)(F.ws + WS_ATOT);
    LAS bf16* BT = (LAS bf16*)F.lds; LAS bf16* XT = (LAS bf16*)(F.lds + MT_BYTES);
    LAS float* DT = (LAS float*)(F.lds + 3 * MT_BYTES); LAS float* ACS = DT + 8 * 128; LAS float* SCL = ACS + 8 * 128;
    const float* convw = F.in[I_CONVW]; const float* convb = F.in[I_CONVB];
    const int tid = F.tid, w = F.wave, lane = F.lane, r16 = lane & 15, q = lane >> 4;
    for (int it = blockIdx.x; it < NB * MC_NC * 2; it += F.G) {
        const int g = it & 1, c = (it >> 1) & (MC_NC - 1), b = it >> 7;
        __syncthreads();
        const float atot = mamba_dt_scan(F, PROJ, b, c, g, DT, ACS);
        if (lane == 0) ATOT[(b * MC_NC + c) * 16 + g * 8 + w] = atot;
        const int chB = 1024 + g * 128 + (tid & 127);
        TRaw ra, rb;
        mstage_T_load(ra, PROJ, b, c, chB, tid);
        mstage_T_load(rb, PROJ, b, c, (g * 8 + ((tid & 127) >> 6)) * 64 + (tid & 63), tid);
        LDS_WAIT();
        SCL[w * 128 + 2 * lane] = DT[w * 128 + 2 * lane] * __expf(atot - ACS[w * 128 + 2 * lane]);
        SCL[w * 128 + 2 * lane + 1] = DT[w * 128 + 2 * lane + 1] * __expf(atot - ACS[w * 128 + 2 * lane + 1]);
        mstage_T_store<false>(ra, chB, BT, nullptr, convw, convb, tid);
        mstage_T_load(ra, PROJ, b, c, (g * 8 + 2 + ((tid & 127) >> 6)) * 64 + (tid & 63), tid);
        __syncthreads();
#pragma unroll
        for (int hb = 0; hb < 2; ++hb) {
            if (hb == 1) mstage_T_load(ra, PROJ, b, c, (g * 8 + 6 + ((tid & 127) >> 6)) * 64 + (tid & 63), tid);
            { const int hl = 4 * hb + ((tid & 127) >> 6); mstage_T_store<true>(rb, (g * 8 + hl) * 64 + (tid & 63), XT, SCL + hl * 128, convw, convb, tid); }
            if (hb == 0) mstage_T_load(rb, PROJ, b, c, (g * 8 + 4 + ((tid & 127) >> 6)) * 64 + (tid & 63), tid);
            { const int hl = 4 * hb + 2 + ((tid & 127) >> 6); mstage_T_store<true>(ra, (g * 8 + hl) * 64 + (tid & 63), XT + 128 * LSTR, SCL + hl * 128, convw, convb, tid); }
            __syncthreads();
            const int hh = w >> 1, ph = w & 1;
            f32x4 acc[2][8];
#pragma unroll
            for (int a = 0; a < 2; ++a)
#pragma unroll
                for (int n = 0; n < 8; ++n) acc[a][n] = (f32x4){0.f, 0.f, 0.f, 0.f};
#pragma unroll
            for (int ks = 0; ks < 4; ++ks) {
                bf16x8 xa[2];
#pragma unroll
                for (int a = 0; a < 2; ++a) xa[a] = *(const LAS bf16x8*)(XT + (hh * 64 + 32 * ph + 16 * a + r16) * LSTR + 32 * ks + 8 * q);
#pragma unroll
                for (int n = 0; n < 8; ++n) { const bf16x8 bfr = *(const LAS bf16x8*)(BT + (16 * n + r16) * LSTR + 32 * ks + 8 * q);
#pragma unroll
                    for (int a = 0; a < 2; ++a) acc[a][n] = __builtin_amdgcn_mfma_f32_16x16x32_bf16(bfr, xa[a], acc[a][n], 0, 0, 0); }
            }
            bf16* st = ST + ((size_t)((b * MC_NC + c) * 16 + g * 8 + 4 * hb + hh)) * (64 * 128);
#pragma unroll
            for (int a = 0; a < 2; ++a)
#pragma unroll
                for (int n = 0; n < 8; ++n) { v2u o; o.x = pk2(acc[a][n][0], acc[a][n][1]); o.y = pk2(acc[a][n][2], acc[a][n][3]);
                    *(v2u*)(st + (32 * ph + 16 * a + r16) * 128 + 16 * n + 4 * q) = o; }
            __syncthreads();
        }
    }
}

__device__ __forceinline__ void m2_prefix(const Ctx& F) {
    const bf16* ST = (const bf16*)(F.ws + WS_ST); bf16* SIN = (bf16*)(F.ws + WS_SIN); const float* ATOT = (const float*)(F.ws + WS_ATOT);
    const int nthr = F.G * NTHR;
    constexpr int GB = 16;
    constexpr size_t CST = (size_t)16 * 8192;
    for (int gi = blockIdx.x * NTHR + F.tid; gi < NB * 16 * 2048; gi += nthr) {
        const int e4 = gi & 2047, bh = gi >> 11, b = bh >> 4, h = bh & 15;
        const size_t o0 = ((size_t)(b * MC_NC) * 16 + h) * 8192 + 4 * e4;
        const float* at = ATOT + (b * MC_NC) * 16 + h;
        float r0 = 0.f, r1 = 0.f, r2 = 0.f, r3 = 0.f;
        v2u sv[GB]; float dv[GB];
#pragma unroll
        for (int i = 0; i < GB; ++i) { sv[i] = *(const v2u*)(ST + o0 + (size_t)i * CST); dv[i] = at[i * 16]; }
#pragma unroll 1
        for (int c0 = 0; c0 < MC_NC; c0 += GB) {
            const int cn = (c0 + GB < MC_NC) ? c0 + GB : c0;
            v2u svn[GB]; float dvn[GB];
#pragma unroll
            for (int i = 0; i < GB; ++i) { svn[i] = *(const v2u*)(ST + o0 + (size_t)(cn + i) * CST); dvn[i] = at[(cn + i) * 16]; }
            asm volatile("" ::: "memory");
#pragma unroll
            for (int i = 0; i < GB; ++i) {
                v2u so; so.x = pk2(r0, r1); so.y = pk2(r2, r3);
                *(v2u*)(SIN + o0 + (size_t)(c0 + i) * CST) = so;
                const float d = __expf(dv[i]);
                r0 = r0 * d + bflo(sv[i].x); r1 = r1 * d + bfhi(sv[i].x); r2 = r2 * d + bflo(sv[i].y); r3 = r3 * d + bfhi(sv[i].y);
            }
#pragma unroll
            for (int i = 0; i < GB; ++i) { sv[i] = svn[i]; dv[i] = dvn[i]; }
        }
    }
}

__device__ __forceinline__ void m3_outputs(const Ctx& F) {
    const bf16* PROJ = (const bf16*)(F.ws + WS_PROJ); const bf16* SIN = (const bf16*)(F.ws + WS_SIN); bf16* OY = (bf16*)(F.ws + WS_OY);
    LAS bf16* Cn = (LAS bf16*)F.lds; LAS bf16* RB = (LAS bf16*)(F.lds + MT_BYTES);
    LAS bf16* Mw = (LAS bf16*)(F.lds + 2 * MT_BYTES) + F.wave * 16 * LSTR;
    LAS float* DT = (LAS float*)(F.lds + 3 * MT_BYTES); LAS float* ACS = DT + 8 * 128;
    const float* convw = F.in[I_CONVW]; const float* convb = F.in[I_CONVB];
    const int tid = F.tid, w = F.wave, lane = F.lane, r16 = lane & 15, q = lane >> 4;
    for (int it = blockIdx.x; it < NB * MC_NC * 2; it += F.G) {
        const int g = it & 1, c = (it >> 1) & (MC_NC - 1), b = it >> 7;
        __syncthreads();
        (void)mamba_dt_scan(F, PROJ, b, c, g, DT, ACS);
        mstage_N(PROJ, b, c, g, RB, Cn, convw, convb, tid);
        __syncthreads();
        TRaw rx;
        mstage_T_load(rx, PROJ, b, c, (g * 8 + ((tid & 127) >> 6)) * 64 + (tid & 63), tid);
        bf16x8 cf[4];
#pragma unroll
        for (int ks = 0; ks < 4; ++ks) cf[ks] = *(const LAS bf16x8*)(Cn + (16 * w + r16) * LSTR + 32 * ks + 8 * q);
        f32x4 Gt[8];
#pragma unroll
        for (int nt = 0; nt < 8; ++nt) { Gt[nt] = (f32x4){0.f, 0.f, 0.f, 0.f};
#pragma unroll
            for (int ks = 0; ks < 4; ++ks) Gt[nt] = __builtin_amdgcn_mfma_f32_16x16x32_bf16(*(const LAS bf16x8*)(RB + (16 * nt + r16) * LSTR + 32 * ks + 8 * q), cf[ks], Gt[nt], 0, 0, 0); }
        const int l = 16 * w + r16;
        const size_t mrow = (size_t)(b * SEQ + c * MC_L + l);
#pragma unroll 1
        for (int hb = 0; hb < 4; ++hb) {
            __syncthreads();
            { const int hl = 2 * hb + ((tid & 127) >> 6); mstage_T_store<false>(rx, (g * 8 + hl) * 64 + (tid & 63), RB, nullptr, convw, convb, tid); }
            { const int hn = (hb < 3) ? 2 * (hb + 1) : 2 * hb; mstage_T_load(rx, PROJ, b, c, (g * 8 + hn + ((tid & 127) >> 6)) * 64 + (tid & 63), tid); }
            __syncthreads();
#pragma unroll 1
            for (int h2 = 0; h2 < 2; ++h2) {
                const int hl = 2 * hb + h2, head = g * 8 + hl;
                const float acs_l = ACS[hl * 128 + l];
                const bf16* sin = SIN + ((size_t)((b * MC_NC + c) * 16 + head)) * 8192;
                bf16x8 sf[4][4];
#pragma unroll
                for (int pt = 0; pt < 4; ++pt)
#pragma unroll
                    for (int ks = 0; ks < 4; ++ks) sf[pt][ks] = *(const bf16x8*)(sin + (16 * pt + r16) * 128 + 32 * ks + 8 * q);
#pragma unroll
                for (int nt = 0; nt < 8; ++nt) { const f32x4 as = *(const LAS f32x4*)(ACS + hl * 128 + 16 * nt + 4 * q), ds = *(const LAS f32x4*)(DT + hl * 128 + 16 * nt + 4 * q);
                    float mv[4];
#pragma unroll
                    for (int j = 0; j < 4; ++j) { const int s = 16 * nt + 4 * q + j; mv[j] = (s <= l) ? Gt[nt][j] * __expf(acs_l - as[j]) * ds[j] : 0.f; }
                    v2u o; o.x = pk2(mv[0], mv[1]); o.y = pk2(mv[2], mv[3]);
                    *(LAS v2u*)(Mw + r16 * LSTR + 16 * nt + 4 * q) = o; }
                LDS_WAIT(); asm volatile("" ::: "memory");
                bf16x8 mf[4];
#pragma unroll
                for (int ks = 0; ks < 4; ++ks) mf[ks] = *(const LAS bf16x8*)(Mw + r16 * LSTR + 32 * ks + 8 * q);
                const float el = __expf(acs_l), Dh = F.in[I_DSK][head];
#pragma unroll
                for (int pt = 0; pt < 4; ++pt) {
                    f32x4 yd = {0.f, 0.f, 0.f, 0.f}, yo = {0.f, 0.f, 0.f, 0.f};
#pragma unroll
                    for (int ks = 0; ks < 4; ++ks) {
                        yd = __builtin_amdgcn_mfma_f32_16x16x32_bf16(*(const LAS bf16x8*)(RB + (h2 * 64 + 16 * pt + r16) * LSTR + 32 * ks + 8 * q), mf[ks], yd, 0, 0, 0);
                        yo = __builtin_amdgcn_mfma_f32_16x16x32_bf16(sf[pt][ks], cf[ks], yo, 0, 0, 0); }
                    float yv[4];
#pragma unroll
                    for (int j = 0; j < 4; ++j) yv[j] = yd[j] + el * yo[j] + Dh * bf1(RB[(h2 * 64 + 16 * pt + 4 * q + j) * LSTR + l]);
                    v2u o; o.x = pk2(yv[0], yv[1]); o.y = pk2(yv[2], yv[3]);
                    *(v2u*)(OY + mrow * DM + RW + head * 64 + 16 * pt + 4 * q) = o;
                }
                asm volatile("" ::: "memory");
            }
        }
    }
}
constexpr int RC = 16, RNCH = SEQ / RC, NPART = 4, RHALF = RNCH / NPART, RITEMS = NB * RHEADS * RHALF;
constexpr size_t RO_WH = 0, RO_RH = 16 * MiB, RO_VT = 32 * MiB, RO_ET = 48 * MiB, RO_OL = 64 * MiB, RO_A2 = 80 * MiB, RO_GC = 112 * MiB, RO_BUF = 116 * MiB, RO_SS = 232 * MiB;
constexpr int RL_KAP = 0, RL_ALP = 2304, RL_KT = 4608, RL_RT = 6912, RL_KAPT = 9216, RL_VT = 11264, RL_TB = 13312, RL_BL = 14336, RL_QL = 15360, RL_PL = 16384,
              RL_WT = RL_KAP, RL_BVT = RL_ALP, RL_AL32 = RL_KT, RL_ET = RL_KT,
              RL_BYTES = 18176;
constexpr int XS = 72, TS = 16, SS16 = 32;

__device__ __forceinline__ float wave_sum_pl(float x) {
    x = rowsum16(x);
    { auto rr = __builtin_amdgcn_permlane16_swap(__float_as_uint(x), __float_as_uint(x), false, false); x = __uint_as_float(rr[0]) + __uint_as_float(rr[1]); }
    { auto rr = __builtin_amdgcn_permlane32_swap(__float_as_uint(x), __float_as_uint(x), false, false); x = __uint_as_float(rr[0]) + __uint_as_float(rr[1]); }
    return x;
}
__device__ __forceinline__ v2u pack4(const f32x4 a) { v2u o; o.x = pk2(a[0], a[1]); o.y = pk2(a[2], a[3]); return o; }
__device__ __forceinline__ f32x4 unpack4(const v2u u) { return (f32x4){bflo(u.x), bfhi(u.x), bflo(u.y), bfhi(u.y)}; }
__device__ __forceinline__ bf16 f2b(float x) { return (bf16)pk2(x, 0.f); }

__device__ __forceinline__ void ra_item(const Ctx& F, LAS unsigned char* wl, int it, int half) {
    const int bh = it / RHALF, cl = it - bh * RHALF, ci = half * RHALF + cl, b = bh >> 4, h = bh & 15;
    const bf16* PROJ = (const bf16*)(F.ws + WS_PROJ); const bf16* LW = (const bf16*)(F.ws + WS_LW); const bf16* AA = (const bf16*)(F.ws + WS_AA);
    unsigned char* RO = (unsigned char*)F.out + (size_t)(half & 1) * RO_BUF;
    const int lane = F.lane, r16 = lane & 15, q = lane >> 4, c = lane, ch = h * 64 + c;
    const size_t m0 = (size_t)b * SEQ + (size_t)RC * ci;
    LAS bf16* KAP = (LAS bf16*)(wl + RL_KAP); LAS bf16* ALP = (LAS bf16*)(wl + RL_ALP); LAS bf16* KT = (LAS bf16*)(wl + RL_KT); LAS bf16* RT = (LAS bf16*)(wl + RL_RT);
    LAS bf16* KAPT = (LAS bf16*)(wl + RL_KAPT); LAS bf16* VTL = (LAS bf16*)(wl + RL_VT); LAS bf16* WT = (LAS bf16*)(wl + RL_WT); LAS bf16* BVT = (LAS bf16*)(wl + RL_BVT); LAS bf16* ETL = (LAS bf16*)(wl + RL_ET);
    LAS bf16* TB = (LAS bf16*)(wl + RL_TB); LAS bf16* BL = (LAS bf16*)(wl + RL_BL); LAS bf16* QL = (LAS bf16*)(wl + RL_QL); LAS bf16* PL = (LAS bf16*)(wl + RL_PL);
    const float mu_r = F.in[I_MU][C_R + ch], mu_k = F.in[I_MU][C_K + ch], mu_v = F.in[I_MU][C_V + ch], kkw = F.in[I_KK][ch], kaw = F.in[I_KA][ch];
    const bf16* prow = PROJ + m0 * INPP + ch;
    float rp = 0.f, kp = 0.f, vp = 0.f;
    if (ci > 0) { rp = bf1(prow[-INPP + C_R]); kp = bf1(prow[-INPP + C_K]); vp = bf1(prow[-INPP + C_V]); }
    float ec = 1.f, kkna[RC], kpv[RC], env[RC], vvv[RC];
    float cum = 0.f;
#pragma unroll
    for (int t = 0; t < RC; ++t) {
        const bf16* row = prow + (size_t)t * INPP;
        const float rc = bf1(row[C_R]), kc = bf1(row[C_K]), vc = bf1(row[C_V]);
        const float a = bf1(AA[(m0 + t) * RW + ch]), lw = bf1(LW[(m0 + t) * RW + ch]);
        const float rr = rc + (rp - rc) * mu_r, kx = kc + (kp - kc) * mu_k, vv = vc + (vp - vc) * mu_v;
        rp = rc; kp = kc; vp = vc;
        const float kkraw = kx * kkw; const float ss = wave_sum_pl(kkraw * kkraw);
        const float kkn = kkraw * rcp_f(fmaxf(sqrtf(ss), 1e-12f));
        const float kpp = kx * (1.f + (a - 1.f) * kaw);
        const float ep = ec; cum += lw; ec = __expf(cum); const float en = rcp_f(ec);
        const unsigned p0 = pk2(kkn * ep, kkn * a * en), p1 = pk2(kpp * en, rr * ec), p2 = pk2(vv, 0.f);
        KAP[t * XS + c] = (bf16)p0; ALP[t * XS + c] = (bf16)(p0 >> 16); KT[t * XS + c] = (bf16)p1; RT[t * XS + c] = (bf16)(p1 >> 16);
        KAPT[c * TS + t] = (bf16)p0; VTL[c * TS + t] = (bf16)p2;
        kkna[t] = kkn * a; kpv[t] = kpp; env[t] = en; vvv[t] = vv;
    }
    {
        float e8[8]; v4u* vt = (v4u*)((bf16*)(RO + RO_VT) + (size_t)it * 1024 + c * 16);
#pragma unroll
        for (int i = 0; i < 8; ++i) e8[i] = vvv[i];
        vt[0] = pack8(e8);
#pragma unroll
        for (int i = 0; i < 8; ++i) e8[i] = vvv[8 + i];
        vt[1] = pack8(e8);
        v4u* a2 = (v4u*)((bf16*)(RO + RO_A2) + (size_t)it * 2048 + c * 32);
        float dd[RC];
#pragma unroll
        for (int t = 0; t < RC; ++t) dd[t] = ec * env[t];
#pragma unroll
        for (int i = 0; i < 8; ++i) e8[i] = -kkna[i] * dd[i];
        a2[0] = pack8(e8);
#pragma unroll
        for (int i = 0; i < 8; ++i) e8[i] = -kkna[8 + i] * dd[8 + i];
        a2[1] = pack8(e8);
#pragma unroll
        for (int i = 0; i < 8; ++i) e8[i] = kpv[i] * dd[i];
        a2[2] = pack8(e8);
#pragma unroll
        for (int i = 0; i < 8; ++i) e8[i] = kpv[8 + i] * dd[8 + i];
        a2[3] = pack8(e8);
        ((float*)(RO + RO_GC))[(size_t)it * 64 + c] = ec;
    }
    LDS_WAIT(); asm volatile("" ::: "memory");
    const v2u zero2 = {0u, 0u};
    {
        f32x4 alt = {0.f, 0.f, 0.f, 0.f}, blt = alt, qlt = alt, plt = alt;
#pragma unroll
        for (int ks = 0; ks < 2; ++ks) {
            const bf16x8 fa = *(const LAS bf16x8*)(ALP + r16 * XS + 32 * ks + 8 * q), fk = *(const LAS bf16x8*)(KT + r16 * XS + 32 * ks + 8 * q);
            const bf16x8 fkp = *(const LAS bf16x8*)(KAP + r16 * XS + 32 * ks + 8 * q), fr = *(const LAS bf16x8*)(RT + r16 * XS + 32 * ks + 8 * q);
            alt = __builtin_amdgcn_mfma_f32_16x16x32_bf16(fa, fkp, alt, 0, 0, 0); blt = __builtin_amdgcn_mfma_f32_16x16x32_bf16(fk, fkp, blt, 0, 0, 0);
            qlt = __builtin_amdgcn_mfma_f32_16x16x32_bf16(fa, fr, qlt, 0, 0, 0);  plt = __builtin_amdgcn_mfma_f32_16x16x32_bf16(fk, fr, plt, 0, 0, 0);
        }
#pragma unroll
        for (int j = 0; j < 4; ++j) { const int s = 4 * q + j; const bool lt = s < r16, le = s <= r16;
            alt[j] = lt ? alt[j] : 0.f; blt[j] = lt ? blt[j] : 0.f; qlt[j] = le ? qlt[j] : 0.f; plt[j] = le ? plt[j] : 0.f; }
        *(LAS v2u*)(BL + r16 * SS16 + 4 * q) = pack4(blt); *(LAS v2u*)(QL + r16 * SS16 + 4 * q) = pack4(qlt); *(LAS v2u*)(PL + r16 * SS16 + 4 * q) = pack4(plt);
        *(LAS v2u*)(BL + r16 * SS16 + 16 + 4 * q) = zero2; *(LAS v2u*)(QL + r16 * SS16 + 16 + 4 * q) = zero2; *(LAS v2u*)(PL + r16 * SS16 + 16 + 4 * q) = zero2;
        float x[RC];
#pragma unroll
        for (int t = 0; t < RC; ++t) {
            float acc = (t == r16) ? 1.f : 0.f;
#pragma unroll
            for (int s2 = 0; s2 < t; ++s2) { const float a_ts = __uint_as_float(__builtin_amdgcn_readlane(__float_as_uint(alt[s2 & 3]), 16 * (s2 >> 2) + t)); acc -= a_ts * x[s2]; }
            x[t] = acc;
        }
        if (q == 0) {
#pragma unroll
            for (int t = 0; t < RC; ++t) { TB[t * SS16 + r16] = f2b(x[t]); TB[t * SS16 + 16 + r16] = 0; }
        }
    }
    LDS_WAIT(); asm volatile("" ::: "memory");
    const bf16x8 zf = {0, 0, 0, 0, 0, 0, 0, 0};
    const bf16x8 tbf = *(const LAS bf16x8*)(TB + r16 * SS16 + 8 * q), blf = *(const LAS bf16x8*)(BL + r16 * SS16 + 8 * q);
    const bf16x8 qlf = *(const LAS bf16x8*)(QL + r16 * SS16 + 8 * q), plf = *(const LAS bf16x8*)(PL + r16 * SS16 + 8 * q);
    const f32x4 z4 = {0.f, 0.f, 0.f, 0.f};
    bf16* gWH = (bf16*)(RO + RO_WH) + (size_t)it * 1024; bf16* gRH = (bf16*)(RO + RO_RH) + (size_t)it * 1024;
    bf16* gET = (bf16*)(RO + RO_ET) + (size_t)it * 1024; bf16* gOL = (bf16*)(RO + RO_OL) + (size_t)it * 1024;
#pragma unroll
    for (int kt = 0; kt < 4; ++kt) {
        const bf16x8 kf = (q < 2) ? *(const LAS bf16x8*)(KAPT + (16 * kt + r16) * TS + 8 * q) : zf;
        const f32x4 wa = __builtin_amdgcn_mfma_f32_16x16x32_bf16(kf, tbf, z4, 0, 0, 0);
        *(v2u*)(gWH + r16 * 64 + 16 * kt + 4 * q) = pack4(wa);
        const f32x4 wb = __builtin_amdgcn_mfma_f32_16x16x32_bf16(tbf, kf, z4, 0, 0, 0);
        *(LAS v2u*)(WT + (16 * kt + r16) * TS + 4 * q) = pack4(wb);
        const bf16x8 vf = (q < 2) ? *(const LAS bf16x8*)(VTL + (16 * kt + r16) * TS + 8 * q) : zf;
        const f32x4 bv = __builtin_amdgcn_mfma_f32_16x16x32_bf16(blf, vf, z4, 0, 0, 0);
        *(LAS v2u*)(BVT + (16 * kt + r16) * TS + 4 * q) = pack4(bv);
    }
    LDS_WAIT(); asm volatile("" ::: "memory");
#pragma unroll
    for (int vt = 0; vt < 4; ++vt) {
        const bf16x8 bf_ = (q < 2) ? *(const LAS bf16x8*)(BVT + (16 * vt + r16) * TS + 8 * q) : zf;
        const f32x4 e4 = __builtin_amdgcn_mfma_f32_16x16x32_bf16(tbf, bf_, z4, 0, 0, 0);
        const v2u ep = pack4(e4);
        *(LAS v2u*)(ETL + (16 * vt + r16) * TS + 4 * q) = ep; *(v2u*)(gET + (16 * vt + r16) * 16 + 4 * q) = ep;
    }
    LDS_WAIT(); asm volatile("" ::: "memory");
#pragma unroll
    for (int kt = 0; kt < 4; ++kt) {
        const bf16x8 wf = (q < 2) ? *(const LAS bf16x8*)(WT + (16 * kt + r16) * TS + 8 * q) : zf;
        const f32x4 qw = __builtin_amdgcn_mfma_f32_16x16x32_bf16(wf, qlf, z4, 0, 0, 0);
        const f32x4 rt4 = unpack4(*(const LAS v2u*)(RT + r16 * XS + 16 * kt + 4 * q));
        *(v2u*)(gRH + r16 * 64 + 16 * kt + 4 * q) = pack4(rt4 - qw);
        const bf16x8 vf = (q < 2) ? *(const LAS bf16x8*)(VTL + (16 * kt + r16) * TS + 8 * q) : zf;
        const bf16x8 ef = (q < 2) ? *(const LAS bf16x8*)(ETL + (16 * kt + r16) * TS + 8 * q) : zf;
        const f32x4 pv = __builtin_amdgcn_mfma_f32_16x16x32_bf16(vf, plf, z4, 0, 0, 0);
        const f32x4 qe = __builtin_amdgcn_mfma_f32_16x16x32_bf16(ef, qlf, z4, 0, 0, 0);
        *(v2u*)(gOL + r16 * 64 + 16 * kt + 4 * q) = pack4(pv - qe);
    }
    LDS_WAIT(); asm volatile("" ::: "memory");
}
__device__ __forceinline__ void ra_part(const Ctx& F, int part) {
    LAS unsigned* ctr = (LAS unsigned*)(F.lds + LDS_BYTES - 48) + part;
    LAS unsigned char* wl = F.lds + F.wave * RL_BYTES;
    for (;;) {
        unsigned idx = 0;
        if (F.lane == 0) idx = __hip_atomic_fetch_add(ctr, 1u, __ATOMIC_RELAXED, __HIP_MEMORY_SCOPE_WORKGROUP);
        idx = (unsigned)__builtin_amdgcn_readfirstlane((int)idx);
        const int it = (int)blockIdx.x + F.G * (int)idx;
        if (it >= RITEMS) break;
        ra_item(F, wl, it, part);
    }
}

__device__ __forceinline__ void rs_half(const Ctx& F, int half) {
    if (F.wave != 0) return;
    const unsigned char* RO = (const unsigned char*)F.out + (size_t)(half & 1) * RO_BUF; bf16* OY = (bf16*)(F.ws + WS_OY);
    float* SSg = (float*)((unsigned char*)F.out + RO_SS);
    LAS bf16* ST = (LAS bf16*)F.lds;
    LAS bf16* ZT = (LAS bf16*)(F.lds + 16 * XS * 2);
    constexpr int ZS = 24;
    const int lane = F.lane, r16 = lane & 15, q = lane >> 4;
    for (int blk = blockIdx.x; blk < NB * RHEADS * 4; blk += F.G) {
        const int xcd = blk & 7, jj = blk >> 3, qt = jj & 3, bh = (jj >> 2) * 8 + xcd, b = bh >> 4, h = bh & 15;
        f32x4 S[4];
        if (half == 0) {
#pragma unroll
            for (int kt = 0; kt < 4; ++kt) S[kt] = (f32x4){0.f, 0.f, 0.f, 0.f};
        } else {
#pragma unroll
            for (int kt = 0; kt < 4; ++kt) S[kt] = *(const f32x4*)(SSg + (size_t)blk * 1024 + (kt * 64 + lane) * 4);
        }
#pragma unroll
        for (int kt = 0; kt < 4; ++kt) *(LAS v2u*)(ST + r16 * XS + 16 * kt + 4 * q) = pack4(S[kt]);
        LDS_WAIT(); asm volatile("" ::: "memory");
        const size_t it0 = (size_t)bh * RHALF;
        const size_t mbase = (size_t)b * SEQ + (size_t)half * RHALF * RC;
#define RS_LOAD(IT, WF, RF, A2F, VF, ET4, OL4, GC4) do { const size_t it_ = (IT); \
        const bf16* wh_ = (const bf16*)(RO + RO_WH) + it_ * 1024 + r16 * 64 + 8 * q; const bf16* rh_ = (const bf16*)(RO + RO_RH) + it_ * 1024 + r16 * 64 + 8 * q; \
        WF[0] = *(const bf16x8*)wh_; WF[1] = *(const bf16x8*)(wh_ + 32); RF[0] = *(const bf16x8*)rh_; RF[1] = *(const bf16x8*)(rh_ + 32); \
        _Pragma("unroll") for (int kt_ = 0; kt_ < 4; ++kt_) { A2F[kt_] = *(const bf16x8*)((const bf16*)(RO + RO_A2) + it_ * 2048 + (16 * kt_ + r16) * 32 + 8 * q); \
            GC4[kt_] = *(const f32x4*)((const float*)(RO + RO_GC) + it_ * 64 + 16 * kt_ + 4 * q); } \
        VF = *(const bf16x8*)((const bf16*)(RO + RO_VT) + it_ * 1024 + (16 * qt + r16) * 16 + 8 * (q & 1)); \
        ET4 = *(const v2u*)((const bf16*)(RO + RO_ET) + it_ * 1024 + (16 * qt + r16) * 16 + 4 * q); \
        OL4 = *(const v2u*)((const bf16*)(RO + RO_OL) + it_ * 1024 + r16 * 64 + 16 * qt + 4 * q); } while (0)
        bf16x8 wfq[2][2], rfq[2][2], a2q[2][4], vfq[2]; v2u etq[2], olq[2]; f32x4 gcq[2][4];
#pragma unroll
        for (int u = 0; u < 2; ++u) RS_LOAD(it0 + u, wfq[u], rfq[u], a2q[u], vfq[u], etq[u], olq[u], gcq[u]);
#define RS_STEP(U, CL) do { const int cl_ = (CL); \
            const bf16x8 sb0 = *(const LAS bf16x8*)(ST + r16 * XS + 8 * q), sb1 = *(const LAS bf16x8*)(ST + r16 * XS + 32 + 8 * q); \
            f32x4 x1 = __builtin_amdgcn_mfma_f32_16x16x32_bf16(wfq[U][0], sb0, (f32x4){0.f, 0.f, 0.f, 0.f}, 0, 0, 0); \
            x1 = __builtin_amdgcn_mfma_f32_16x16x32_bf16(wfq[U][1], sb1, x1, 0, 0, 0); \
            f32x4 ot = __builtin_amdgcn_mfma_f32_16x16x32_bf16(sb0, rfq[U][0], unpack4(olq[U]), 0, 0, 0); \
            ot = __builtin_amdgcn_mfma_f32_16x16x32_bf16(sb1, rfq[U][1], ot, 0, 0, 0); \
            *(LAS v2u*)(ZT + r16 * ZS + 4 * q) = pack4(x1 + unpack4(etq[U])); \
            *(v2u*)(OY + (mbase + (size_t)cl_ * RC + r16) * DM + h * 64 + 16 * qt + 4 * q) = pack4(ot); \
            LDS_WAIT(); asm volatile("" ::: "memory"); \
            const bf16x8 zr = *(const LAS bf16x8*)(ZT + r16 * ZS + 8 * (q & 1)); \
            const bf16x8 bz = (q < 2) ? zr : vfq[U]; \
            _Pragma("unroll") for (int kt = 0; kt < 4; ++kt) { S[kt] = __builtin_amdgcn_mfma_f32_16x16x32_bf16(a2q[U][kt], bz, S[kt] * gcq[U][kt], 0, 0, 0); \
                *(LAS v2u*)(ST + r16 * XS + 16 * kt + 4 * q) = pack4(S[kt]); } \
            RS_LOAD(it0 + ((cl_ + 2 < RHALF) ? cl_ + 2 : RHALF - 1), wfq[U], rfq[U], a2q[U], vfq[U], etq[U], olq[U], gcq[U]);     \
            LDS_WAIT(); asm volatile("" ::: "memory"); } while (0)
#pragma unroll 1
        for (int cl = 0; cl < RHALF; cl += 2) { RS_STEP(0, cl); RS_STEP(1, cl + 1); }
#undef RS_STEP
#undef RS_LOAD
        if (half + 1 < NPART) {
#pragma unroll
            for (int kt = 0; kt < 4; ++kt) *(f32x4*)(SSg + (size_t)blk * 1024 + (kt * 64 + lane) * 4) = S[kt];
        }
    }
}
__device__ __forceinline__ float rowmax16(float x) { x = fmaxf(x, dpp_f<0xB1>(x)); x = fmaxf(x, dpp_f<0x4E>(x)); x = fmaxf(x, dpp_f<0x124>(x)); x = fmaxf(x, dpp_f<0x128>(x)); return x; }
__device__ __forceinline__ int cand_code(int s) {
    if (s < 16) return s << 4;
    if (s < 24) return 1 | ((s - 16) << 4);
    if (s < 29) return 2 | ((s - 24) << 4);
    if (s < 33) return 3 | ((s - 29) << 4);
    if (s < 36) return 4 | ((s - 33) << 4);
    if (s < 42) { const int k = s - 36; return (5 + (k >> 1)) | ((k & 1) << 4); }
    if (s < 50) return 8 + (s - 42);
    return -1;
}
__device__ __forceinline__ int f2ord(float f) { const int b = __float_as_int(f); return b ^ ((b >> 31) & 0x7fffffff); }
__device__ __forceinline__ float ord2f(int k) { return __int_as_float(k ^ ((k >> 31) & 0x7fffffff)); }
template <int CTRL> __device__ __forceinline__ int dpp_i(int x) { return __builtin_amdgcn_mov_dpp(x, CTRL, 0xf, 0xf, true); }
__device__ __forceinline__ int imax(int a, int b) { return a > b ? a : b; }
__device__ __forceinline__ int imin(int a, int b) { return a < b ? a : b; }
__device__ __forceinline__ int rowmax16_i(int x) { x = imax(x, dpp_i<0xB1>(x)); x = imax(x, dpp_i<0x4E>(x)); x = imax(x, dpp_i<0x124>(x)); x = imax(x, dpp_i<0x128>(x)); return x; }
#define CSWAP_(a, b) do { const int hi_ = imax(a, b), lo_ = imin(a, b); a = hi_; b = lo_; } while (0)
template <int NV> __device__ __forceinline__ void sort_desc(int (&v)[NV]);
template <> __device__ __forceinline__ void sort_desc<8>(int (&v)[8]) {
    CSWAP_(v[0], v[1]); CSWAP_(v[2], v[3]); CSWAP_(v[4], v[5]); CSWAP_(v[6], v[7]);
    CSWAP_(v[0], v[2]); CSWAP_(v[1], v[3]); CSWAP_(v[4], v[6]); CSWAP_(v[5], v[7]);
    CSWAP_(v[1], v[2]); CSWAP_(v[5], v[6]);
    CSWAP_(v[0], v[4]); CSWAP_(v[1], v[5]); CSWAP_(v[2], v[6]); CSWAP_(v[3], v[7]);
    CSWAP_(v[2], v[4]); CSWAP_(v[3], v[5]);
    CSWAP_(v[1], v[2]); CSWAP_(v[3], v[4]); CSWAP_(v[5], v[6]);
}
template <> __device__ __forceinline__ void sort_desc<4>(int (&v)[4]) {
    CSWAP_(v[0], v[1]); CSWAP_(v[2], v[3]); CSWAP_(v[0], v[2]); CSWAP_(v[1], v[3]); CSWAP_(v[1], v[2]);
}
template <int NV>
__device__ __forceinline__ void select16x4(int (&v)[4][NV], int r16, float (&kept_f)[4]) {
    const int IMIN = (int)0x80000000;
    int kept[4];
#pragma unroll
    for (int j = 0; j < 4; ++j) { kept[j] = IMIN; sort_desc<NV>(v[j]); }
#pragma unroll 1
    for (int rd = 0; rd < 16; ++rd) {
#pragma unroll
        for (int j = 0; j < 4; ++j) {
            const int m = rowmax16_i(v[j][0]);
            kept[j] = (r16 == rd) ? m : kept[j];
            const bool own = (v[j][0] == m);
#pragma unroll
            for (int i = 0; i < NV - 1; ++i) v[j][i] = own ? v[j][i + 1] : v[j][i];
            v[j][NV - 1] = own ? IMIN : v[j][NV - 1];
        }
    }
#pragma unroll
    for (int j = 0; j < 4; ++j) kept_f[j] = ord2f(kept[j]);
}
__device__ __forceinline__ float dot2bf(unsigned a, unsigned b, float acc) { return __builtin_amdgcn_fdot2_f32_bf16(__builtin_bit_cast(bf16x2_t, a), __builtin_bit_cast(bf16x2_t, b), acc, false); }

constexpr int PT = 16;
constexpr size_t RANGE_BYTES = (size_t)NEXP * 128;

__device__ __forceinline__ void p9_route(const Ctx& F) {
    constexpr int KSTR = 136;
    const bf16* Q = (const bf16*)(F.ws + WS_Q); const bf16* KEYS = (const bf16*)(F.ws + WS_KEYS);
    int* rtE = (int*)(F.ws + WS_RTE); float* rtG = (float*)(F.ws + WS_RTG);
    LAS bf16* KL = (LAS bf16*)F.lds;
    const int lane = F.lane, w = F.wave, r16 = lane & 15, q = lane >> 4, gbase = lane & 48;
    const int h = blockIdx.x & 7, nbh = (F.G - h + 7) >> 3;
    __syncthreads();
    for (int i = F.tid; i < 2 * 128 * 16; i += NTHR) { const int row = i >> 4, ch = i & 15;
        *(LAS v4u*)(KL + row * KSTR + 8 * ch) = *(const v4u*)(KEYS + (size_t)(2 * h * 128 + row) * 128 + 8 * ch); }
    __syncthreads();
    int ci[4], cj[4]; bool cvalid[4];
#pragma unroll
    for (int u = 0; u < 4; ++u) { const int cd = cand_code(r16 + 16 * u); cvalid[u] = cd >= 0; ci[u] = cd & 15; cj[u] = (cd >> 4) & 15; }
    const float NINF = -__builtin_inff();
    const int tstride = nbh * NWAVES;
    int tile = (blockIdx.x >> 3) * NWAVES + w;
    bf16x8 afn[2][4];
    if (tile < M / PT) {
#pragma unroll
        for (int p = 0; p < 2; ++p)
#pragma unroll
            for (int s = 0; s < 4; ++s) afn[p][s] = *(const bf16x8*)(Q + (size_t)(tile * PT + r16) * DM + (2 * h + p) * 128 + 8 * q + 32 * s);
    }
    for (; tile < M / PT; tile += tstride) {
        const int m0 = tile * PT;
        bf16x8 af[2][4];
#pragma unroll
        for (int p = 0; p < 2; ++p)
#pragma unroll
            for (int s = 0; s < 4; ++s) af[p][s] = afn[p][s];
        { const int tn = (tile + tstride < M / PT) ? tile + tstride : tile;
#pragma unroll
            for (int p = 0; p < 2; ++p)
#pragma unroll
                for (int s = 0; s < 4; ++s) afn[p][s] = *(const bf16x8*)(Q + (size_t)(tn * PT + r16) * DM + (2 * h + p) * 128 + 8 * q + 32 * s);
        }
        float top[2][4];
#pragma unroll
        for (int p = 0; p < 2; ++p) {
            int v[4][8];
#pragma unroll
            for (int nt = 0; nt < 8; ++nt) {
                const LAS bf16* krow = KL + (p * 128 + nt * 16 + r16) * KSTR + 8 * q;
                f32x4 acc = {0.f, 0.f, 0.f, 0.f};
#pragma unroll
                for (int s = 0; s < 4; ++s) acc = __builtin_amdgcn_mfma_f32_16x16x32_bf16(af[p][s], *(const LAS bf16x8*)(krow + 32 * s), acc, 0, 0, 0);
                const unsigned tag = 127u - (unsigned)(nt * 16 + r16);
#pragma unroll
                for (int j = 0; j < 4; ++j) v[j][nt] = f2ord(__uint_as_float((__float_as_uint(acc[j]) & ~127u) | tag));
                if (nt & 1) asm volatile("" ::: "memory");
            }
            select16x4<8>(v, r16, top[p]);
        }
        int cv[4][4];
#pragma unroll
        for (int u = 0; u < 4; ++u)
#pragma unroll
            for (int j = 0; j < 4; ++j) {
                const float a = __shfl(top[0][j], gbase + ci[u]), b = __shfl(top[1][j], gbase + cj[u]);
                const float cs = __uint_as_float(__float_as_uint(a) & ~127u) + __uint_as_float(__float_as_uint(b) & ~127u);
                const float pk = __uint_as_float((__float_as_uint(cs) & ~63u) | (63u - (unsigned)(r16 + 16 * u)));
                cv[j][u] = cvalid[u] ? f2ord(pk) : (int)0x80000000;
            }
        float best[4];
        select16x4<4>(cv, r16, best);
#pragma unroll
        for (int j = 0; j < 4; ++j) {
            const unsigned bb = __float_as_uint(best[j]);
            const int cd = cand_code(63 - (int)(bb & 63u));
            const int k0 = 127 - (int)(__float_as_uint(__shfl(top[0][j], gbase + (cd & 15))) & 127u);
            const int k1 = 127 - (int)(__float_as_uint(__shfl(top[1][j], gbase + ((cd >> 4) & 15))) & 127u);
            const float s = __uint_as_float(bb & ~63u);
            const float mx = rowmax16(s), e = __expf(s - mx), sum = rowsum16(e);
            const size_t o = (size_t)(m0 + 4 * q + j) * 128 + h * 16 + r16;
            rtE[o] = k0 * 128 + k1; rtG[o] = e * rcp_f(sum);
        }
    }
}

__device__ __forceinline__ f32x2 cvt2_fp8(unsigned wd, bool hi) { return hi ? __builtin_amdgcn_cvt_pk_f32_fp8((int)wd, true) : __builtin_amdgcn_cvt_pk_f32_fp8((int)wd, false); }
__device__ __forceinline__ void treduce8x16(const float (&p)[16], bool b0, bool b1, bool b2, float& r0, float& r1) {
    float a[8], bq[4];
#pragma unroll
    for (int i = 0; i < 8; ++i) { const float mine = b2 ? p[i + 8] : p[i], send = b2 ? p[i] : p[i + 8]; const float up = dpp_f<0x104>(send), dn = dpp_f<0x114>(send); a[i] = mine + (b2 ? dn : up); }
#pragma unroll
    for (int i = 0; i < 4; ++i) { const float mine = b1 ? a[i + 4] : a[i], send = b1 ? a[i] : a[i + 4]; bq[i] = mine + dpp_f<0x4E>(send); }
    { const float mine = b0 ? bq[2] : bq[0], send = b0 ? bq[0] : bq[2]; r0 = mine + dpp_f<0xB1>(send); }
    { const float mine = b0 ? bq[3] : bq[1], send = b0 ? bq[1] : bq[3]; r1 = mine + dpp_f<0xB1>(send); }
}
struct XGroup { int xg, gwi, stride; };
__device__ __forceinline__ XGroup xgroup(const Ctx& F) { XGroup g; g.xg = blockIdx.x & 7; const int nbg = (F.G - g.xg + 7) >> 3; g.gwi = (blockIdx.x >> 3) * NWAVES + F.wave; g.stride = nbg * NWAVES; return g; }

__device__ __forceinline__ void p10_peer_u(const Ctx& F) {
    const unsigned char* PU4 = F.ws + WS_PU8; const bf16* XN = (const bf16*)(F.ws + WS_XN);
    const int* rtE = (const int*)(F.ws + WS_RTE); unsigned* PD = (unsigned*)(F.ws + WS_PD);
    const XGroup g = xgroup(F);
    const int lane = F.lane, j = lane >> 3, sub = lane & 7;
    const bool b0 = sub & 1, b1 = sub & 2, b2 = sub & 4;
    const int r = g.xg;
    const unsigned char* tab = PU4 + (size_t)r * RANGE_BYTES;
    const unsigned so = 16u * (unsigned)sub;
    int m = g.gwi;
    if (m >= M) return;
    const int st = g.stride;
#define PU_LDE(e, mm, hf) { e[0] = *(const v4u*)(rtE + (size_t)(mm) * 128 + 16 * j + 8 * (hf)); e[1] = *(const v4u*)(rtE + (size_t)(mm) * 128 + 16 * j + 8 * (hf) + 4); }
#define PU_LDX(xv, mm) { _Pragma("unroll") for (int i = 0; i < 4; ++i) xv[i] = *(const v4u*)(XN + (size_t)(mm) * DM + 256 * r + 32 * sub + 8 * i); }
#define PU_GATHER(gx, e) { _Pragma("unroll") for (int k = 0; k < 8; ++k) gx[k] = *(const v4u*)(tab + (e[k >> 2][k & 3] * 128u + so)); }
#define PU_DOT(gx, po) { _Pragma("unroll") for (int k = 0; k < 8; ++k) { f32x2 a0 = {0.f, 0.f}, a1 = {0.f, 0.f}; \
        _Pragma("unroll") for (int d = 0; d < 4; ++d) { const unsigned wd = gx[k][d]; \
            a0 += __builtin_amdgcn_cvt_scalef32_pk_f32_fp4(wd, 1.0f, 0) * (f32x2){x[8 * d], x[8 * d + 1]};     a1 += __builtin_amdgcn_cvt_scalef32_pk_f32_fp4(wd, 1.0f, 1) * (f32x2){x[8 * d + 2], x[8 * d + 3]}; \
            a0 += __builtin_amdgcn_cvt_scalef32_pk_f32_fp4(wd, 1.0f, 2) * (f32x2){x[8 * d + 4], x[8 * d + 5]}; a1 += __builtin_amdgcn_cvt_scalef32_pk_f32_fp4(wd, 1.0f, 3) * (f32x2){x[8 * d + 6], x[8 * d + 7]}; } \
        const f32x2 s2 = a0 + a1; p[(po) + k] = s2.x + s2.y; } }
    v4u eA1[2], eB0[2], gA[8], gB[8], xs[4];
    { v4u eA0[2]; PU_LDE(eA0, m, 0); PU_LDE(eB0, m, 1); PU_LDX(xs, m);
      const int m1 = (m + st < M) ? m + st : m; PU_LDE(eA1, m1, 0);
      PU_GATHER(gA, eA0); }
    for (; m < M; m += st) {
        const int m1 = (m + st < M) ? m + st : m, m2 = (m + 2 * st < M) ? m + 2 * st : m;
        PU_GATHER(gB, eB0);
        float x[32];
#pragma unroll
        for (int i = 0; i < 4; ++i) { float t8[8]; unpack8(xs[i], t8);
#pragma unroll
            for (int u = 0; u < 8; ++u) x[8 * i + u] = t8[u]; }
        v4u eB1[2], eA2[2];
        PU_LDE(eB1, m1, 1); PU_LDE(eA2, m2, 0); PU_LDX(xs, m1);
        asm volatile("" : "+v"(gA[0]), "+v"(gA[1]), "+v"(gA[2]), "+v"(gA[3]), "+v"(gA[4]), "+v"(gA[5]), "+v"(gA[6]), "+v"(gA[7]) :: "memory");
        float p[16];
        PU_DOT(gA, 0);
        asm volatile("" ::: "memory");
        PU_GATHER(gA, eA1);
        asm volatile("" : "+v"(gB[0]), "+v"(gB[1]), "+v"(gB[2]), "+v"(gB[3]), "+v"(gB[4]), "+v"(gB[5]), "+v"(gB[6]), "+v"(gB[7]) :: "memory");
        PU_DOT(gB, 8);
        float r0, r1; treduce8x16(p, b0, b1, b2, r0, r1);
        PD[((size_t)r * M + m) * 64 + lane] = pk2(r0, r1);
#pragma unroll
        for (int i = 0; i < 2; ++i) { eA1[i] = eA2[i]; eB0[i] = eB1[i]; }
    }
#undef PU_LDE
#undef PU_LDX
#undef PU_GATHER
#undef PU_DOT
}

__device__ __forceinline__ void p11_peer_coef(const Ctx& F) {
    const int* rtE = (const int*)(F.ws + WS_RTE); const float* rtG = (const float*)(F.ws + WS_RTG); const unsigned* PD = (const unsigned*)(F.ws + WS_PD);
    const float* usc = (const float*)(F.ws + WS_USC); const float* vsc = (const float*)(F.ws + WS_VSC); float* COEF = (float*)(F.ws + WS_COEF);
    for (int m = F.gw; m < M; m += F.NGW) {
        const size_t o = (size_t)m * 128 + 2 * F.lane;
        f32x2 d = {0.f, 0.f};
#pragma unroll
        for (int r = 0; r < 8; ++r) { const unsigned pw = PD[((size_t)r * M + m) * 64 + F.lane]; d += (f32x2){bflo(pw), bfhi(pw)}; }
        const int e0 = rtE[o], e1 = rtE[o + 1];
        const f32x2 gt = *(const f32x2*)(rtG + o);
        const float d0 = d.x * usc[e0], d1 = d.y * usc[e1];
        f32x2 c; c.x = gt.x * (0.5f * d0 * (1.f + erff(d0 * 0.70710678f))) * vsc[e0]; c.y = gt.y * (0.5f * d1 * (1.f + erff(d1 * 0.70710678f))) * vsc[e1];
        *(f32x2*)(COEF + o) = c;
    }
}

__device__ __forceinline__ void p12_peer_v(const Ctx& F) {
    const unsigned char* PV4 = F.ws + WS_PV8; const int* rtE = (const int*)(F.ws + WS_RTE); const float* COEF = (const float*)(F.ws + WS_COEF);
    const float* mod = (const float*)(F.ws + WS_MOD);
    const XGroup g = xgroup(F);
    const int lane = F.lane, j = lane >> 3, sub = lane & 7;
    const bool jb0 = j & 1;
    const int r = g.xg;
    const unsigned char* tab = PV4 + (size_t)r * RANGE_BYTES;
    const unsigned so = 16u * (unsigned)sub;
    int m = g.gwi;
    if (m >= M) return;
    const int st = g.stride;
#define PV_LDE(e, mm, hf) { e[0] = *(const v4u*)(rtE + (size_t)(mm) * 128 + 16 * j + 8 * (hf)); e[1] = *(const v4u*)(rtE + (size_t)(mm) * 128 + 16 * j + 8 * (hf) + 4); }
#define PV_LDC(c, mm, hf) { c[0] = *(const f32x4*)(COEF + (size_t)(mm) * 128 + 16 * j + 8 * (hf)); c[1] = *(const f32x4*)(COEF + (size_t)(mm) * 128 + 16 * j + 8 * (hf) + 4); }
#define PV_GATHER(gx, e) { _Pragma("unroll") for (int k = 0; k < 8; ++k) gx[k] = *(const v4u*)(tab + (e[k >> 2][k & 3] * 128u + so)); }
#define PV_ACC(gx, c) { _Pragma("unroll") for (int k = 0; k < 8; ++k) { const float cq = c[k >> 2][k & 3]; const f32x2 cv2 = {cq, cq}; \
        _Pragma("unroll") for (int d = 0; d < 4; ++d) { const unsigned wd = gx[k][d]; \
            acc[4 * d + 0] += cv2 * __builtin_amdgcn_cvt_scalef32_pk_f32_fp4(wd, 1.0f, 0); acc[4 * d + 1] += cv2 * __builtin_amdgcn_cvt_scalef32_pk_f32_fp4(wd, 1.0f, 1); \
            acc[4 * d + 2] += cv2 * __builtin_amdgcn_cvt_scalef32_pk_f32_fp4(wd, 1.0f, 2); acc[4 * d + 3] += cv2 * __builtin_amdgcn_cvt_scalef32_pk_f32_fp4(wd, 1.0f, 3); } } }
    v4u eA1[2], eB0[2], gA[8], gB[8]; f32x4 cA0[2], cA1[2], cB0[2];
    { v4u eA0[2]; PV_LDE(eA0, m, 0); PV_LDC(cA0, m, 0); PV_LDE(eB0, m, 1); PV_LDC(cB0, m, 1);
      const int m1 = (m + st < M) ? m + st : m; PV_LDE(eA1, m1, 0); PV_LDC(cA1, m1, 0);
      PV_GATHER(gA, eA0); }
    for (; m < M; m += st) {
        const int m1 = (m + st < M) ? m + st : m, m2 = (m + 2 * st < M) ? m + 2 * st : m;
        const int col = 256 * r + 32 * sub + 4 * j;
        v2u* orow = (v2u*)((bf16*)(F.ws + WS_HB) + (size_t)m * DM + col);
        const v2u hw = *orow; const f32x4 g2 = *(const f32x4*)(mod + (size_t)(m / SEQ) * MODW + 5 * DM + col);
        PV_GATHER(gB, eB0);
        v4u eB1[2], eA2[2]; f32x4 cB1[2], cA2[2];
        PV_LDE(eB1, m1, 1); PV_LDC(cB1, m1, 1); PV_LDE(eA2, m2, 0); PV_LDC(cA2, m2, 0);
        asm volatile("" : "+v"(gA[0]), "+v"(gA[1]), "+v"(gA[2]), "+v"(gA[3]), "+v"(gA[4]), "+v"(gA[5]), "+v"(gA[6]), "+v"(gA[7]) :: "memory");
        f32x2 acc[16];
#pragma unroll
        for (int i = 0; i < 16; ++i) acc[i] = (f32x2){0.f, 0.f};
        PV_ACC(gA, cA0);
        asm volatile("" ::: "memory");
        PV_GATHER(gA, eA1);
        asm volatile("" : "+v"(gB[0]), "+v"(gB[1]), "+v"(gB[2]), "+v"(gB[3]), "+v"(gB[4]), "+v"(gB[5]), "+v"(gB[6]), "+v"(gB[7]) :: "memory");
        PV_ACC(gB, cB0);
        float a[32];
#pragma unroll
        for (int i = 0; i < 16; ++i) { a[2 * i] = acc[i].x; a[2 * i + 1] = acc[i].y; }
        float s16[16], s8[8];
#pragma unroll
        for (int c = 0; c < 16; ++c) { auto rr2 = __builtin_amdgcn_permlane32_swap(__float_as_uint(a[c]), __float_as_uint(a[c + 16]), false, false); s16[c] = __uint_as_float(rr2[0]) + __uint_as_float(rr2[1]); }
#pragma unroll
        for (int c = 0; c < 8; ++c) { auto rr2 = __builtin_amdgcn_permlane16_swap(__float_as_uint(s16[c]), __float_as_uint(s16[c + 8]), false, false); s8[c] = __uint_as_float(rr2[0]) + __uint_as_float(rr2[1]); }
        f32x4 res;
#pragma unroll
        for (int c = 0; c < 4; ++c) { const float mine = jb0 ? s8[c + 4] : s8[c], send = jb0 ? s8[c] : s8[c + 4]; res[c] = mine + dpp_f<0x128>(send); }
        const f32x4 h1 = {bflo(hw.x), bfhi(hw.x), bflo(hw.y), bfhi(hw.y)};
        const f32x4 h2 = h1 + g2 * res;
        v2u o; o.x = pk2(h2.x, h2.y); o.y = pk2(h2.z, h2.w);
        *orow = o;
#pragma unroll
        for (int i = 0; i < 2; ++i) { cA0[i] = cA1[i]; cA1[i] = cA2[i]; eA1[i] = eA2[i]; eB0[i] = eB1[i]; cB0[i] = cB1[i]; }
    }
#undef PV_LDE
#undef PV_LDC
#undef PV_GATHER
#undef PV_ACC
}
#define XB_TMO      128
#define XB_XCNT(j)  (256  + 64 * (j))
#define XB_XSUB(j)  (1280 + 64 * (j))
#define XB_XGEN(j)  (2304 + 64 * (j))
#define XB_TOP      3328
#define XB_TOPGEN   3392
#define XCD_BAR_WORDS 3456
#define XB_SPIN_CAP (1u << 18)

__device__ __forceinline__ unsigned xb_ld(unsigned* p)              { return __hip_atomic_load(p, __ATOMIC_RELAXED, __HIP_MEMORY_SCOPE_AGENT); }
__device__ __forceinline__ unsigned xb_add(unsigned* p, unsigned v) { return __hip_atomic_fetch_add(p, v, __ATOMIC_RELAXED, __HIP_MEMORY_SCOPE_AGENT); }
__device__ __forceinline__ unsigned xb_xcc_id() { return (unsigned)__builtin_amdgcn_s_getreg((3 << 11) | 20) & 0xFu; }
#define XB_SPIN(cond, bar) do { unsigned _sp = 0; while (cond) { __builtin_amdgcn_s_sleep(1); \
    if ((++_sp & 255u) == 0u) { if (xb_ld(&(bar)[XB_TMO])) break; if (_sp > XB_SPIN_CAP) { atomicAdd(&(bar)[XB_TMO], 1u); break; } } } } while (0)

struct XcdBarrier {
    unsigned* bar; unsigned x;
    volatile LAS unsigned* st;
};

__device__ __forceinline__ XcdBarrier xcd_barrier_post(unsigned* bar, volatile LAS unsigned* st) {
    XcdBarrier b; b.bar = bar; b.x = xb_xcc_id(); b.st = st;
    if (threadIdx.x == 0) (void)xb_add(&bar[XB_XCNT(b.x)], 1u);
    return b;
}
__device__ __forceinline__ void xcd_barrier_complete(unsigned* bar, unsigned x, unsigned& nloc, unsigned& nx) {
    const unsigned G = gridDim.x * gridDim.y * gridDim.z;
    unsigned sum, cnt, mine, sp = 0u;
    for (;;) {
        sum = 0u; cnt = 0u; mine = 0u;
#pragma unroll
        for (unsigned j = 0; j < 16; ++j) { const unsigned c = xb_ld(&bar[XB_XCNT(j)]); sum += c; cnt += (c > 0u) ? 1u : 0u; mine = (j == x) ? c : mine; }
        if (sum == G) break;
        __builtin_amdgcn_s_sleep(1);
        if ((++sp & 255u) == 0u) { if (xb_ld(&bar[XB_TMO])) break; if (sp > XB_SPIN_CAP) { atomicAdd(&bar[XB_TMO], 1u); break; } }
    }
    nloc = mine > 0u ? mine : 1u; nx = cnt > 0u ? cnt : 1u;
}

__device__ __forceinline__ void xcd_barrier(const XcdBarrier& b) {
    asm volatile("s_waitcnt vmcnt(0)" ::: "memory");
    __syncthreads();
    if (threadIdx.x == 0) {
        unsigned* bar = b.bar;
        __builtin_amdgcn_s_waitcnt(0);
        unsigned nloc = b.st[0], nx = b.st[1];
        if (nloc == 0u) { xcd_barrier_complete(bar, b.x, nloc, nx); b.st[0] = nloc; b.st[1] = nx; }
        const unsigned old = xb_add(&bar[XB_XSUB(b.x)], 1u);
        const unsigned gen = old / nloc;
        if (old + 1u == (gen + 1u) * nloc) {
            __builtin_amdgcn_fence(__ATOMIC_RELEASE, "agent");
            asm volatile("s_waitcnt vmcnt(0)" ::: "memory");
            const unsigned og = xb_add(&bar[XB_TOP], 1u);
            const unsigned tg = og / nx;
            if (og + 1u == (tg + 1u) * nx) xb_add(&bar[XB_TOPGEN], 1u);
            else XB_SPIN(xb_ld(&bar[XB_TOPGEN]) == tg, bar);
            __builtin_amdgcn_fence(__ATOMIC_ACQUIRE, "agent");
            xb_add(&bar[XB_XGEN(b.x)], 1u);
            asm volatile("s_waitcnt vmcnt(0)" ::: "memory");
        } else {
            XB_SPIN(xb_ld(&bar[XB_XGEN(b.x)]) == gen, bar);
            __builtin_amdgcn_fence(__ATOMIC_ACQUIRE, "agent");
            asm volatile("s_waitcnt vmcnt(0)" ::: "memory");
        }
    }
    __syncthreads();
}

struct Args { const float* in[N_IN]; float* out; unsigned char* ws; int ph_lo, ph_hi; };
constexpr int N_PHASES = 19;

__global__ void __launch_bounds__(NTHR, 2) fwd_kernel(Args args) {
    extern __shared__ __attribute__((aligned(16))) unsigned char lds_raw[];
    cg::grid_group grid = cg::this_grid();
    Ctx F;
    F.lds = (LAS unsigned char*)lds_raw;
    F.tid = threadIdx.x; F.lane = F.tid & 63; F.wave = __builtin_amdgcn_readfirstlane(F.tid >> 6);
    F.G = gridDim.x; F.gw = blockIdx.x * NWAVES + F.wave; F.NGW = F.G * NWAVES;
    F.in = args.in; F.out = args.out; F.ws = args.ws;
    const int lo = args.ph_lo, hi = args.ph_hi;
    volatile LAS unsigned* bst = (volatile LAS unsigned*)(F.lds + LDS_BYTES - 64);
    if (F.tid < 2) bst[F.tid] = 0u;
    if (F.tid < 4) ((volatile LAS unsigned*)(F.lds + LDS_BYTES - 48))[F.tid] = 0u;
    __syncthreads();
    const XcdBarrier bar = xcd_barrier_post((unsigned*)(F.ws + WS_CTL) + 4096, bst);
#define IN(k) (lo <= (k) && (k) < hi)
#ifndef TS_A
#define TS_A -1
#define TS_B -1
#define TS_K 0.1
#endif
    unsigned long long* stamps = (unsigned long long*)(F.ws + WS_CTL + 65536);
#define STAMP(k) do { if (TS_A >= 0 && blockIdx.x == 0 && F.tid == 0) stamps[k] = __builtin_amdgcn_s_memrealtime(); } while (0)
#define REP_MASK 0
#ifndef REP_MASK
#define REP_MASK 0
#endif
#define REPS(k) for (int rep_ = 0; rep_ < 1 + ((REP_MASK >> (k)) & 1); ++rep_)
#define SEAM(k) do { if (IN(k) && IN((k) + 1)) { if ((k) == 0) grid.sync(); else xcd_barrier(bar); } } while (0)

    STAMP(0);
    if (IN(0)) REPS(0) { p0_prologue(F); }
    SEAM(0);
    STAMP(1);
    if (IN(1)) REPS(1) { norm_mod_rows(F, F.in[I_X], F.in[I_N1W], 0, DM, (bf16*)(F.ws + WS_XN)); }
    SEAM(1);
    STAMP(2);
    if (IN(2)) REPS(2) {
        pg8::Gemm g{(const pg8::bf16_t*)(F.ws + WS_XN), (const pg8::bf16_t*)(F.ws + WS_WIN), M, INPP, DM};
        pg8::StaticOrder S; S.init(M, INPP, F.G, (int)blockIdx.x);
        pg8::EpiStoreBf16 E{(pg8::bf16_t*)(F.ws + WS_PROJ), INPP};
        pg8::gemm_phase<pg8::EpiStoreBf16, pg8::StaticOrder, true, true>(F.lds, g, S, E);
    }
    SEAM(2);
#ifndef P3REP
#define P3REP 0
#endif
    STAMP(3);
    if (IN(3)) REPS(3) { p3_lora(F); STAMP(40); m1_chunk_states(F); }
    SEAM(3);
    STAMP(4);
    if (IN(4)) { m2_prefix(F); ra_part(F, 0); }
    SEAM(4);
    STAMP(5);
    if (IN(5)) { rs_half(F, 0); ra_part(F, 1); }
    SEAM(5);
    STAMP(6);
    if (IN(6)) { rs_half(F, 1); ra_part(F, 2); }
    SEAM(6);
    STAMP(7);
    if (IN(7)) { rs_half(F, 2); ra_part(F, 3); }
    SEAM(7);
    STAMP(8);
    if (IN(8)) { rs_half(F, 3); }
    STAMP(9);
    if (IN(9)) REPS(9) { m3_outputs(F); }
    SEAM(9);
    STAMP(10);
    if (IN(10)) { p5_post(F); }
    SEAM(10);
    STAMP(11);
    if (IN(11)) REPS(11) {
        pg8::Gemm g{(const pg8::bf16_t*)(F.ws + WS_OY), (const pg8::bf16_t*)(F.ws + WS_WOUT), M, DM, DM};
        pg8::StaticOrder S; S.init(M, DM, F.G, (int)blockIdx.x);
        pg8::EpiResid E{F.in[I_X], (const float*)(F.ws + WS_MOD) + 2 * DM, (pg8::bf16_t*)(F.ws + WS_HB), DM, SEQ, MODW};
        pg8::gemm_phase<pg8::EpiResid, pg8::StaticOrder, true, true>(F.lds, g, S, E);
    }
    SEAM(11);
    STAMP(12);
    if (IN(12)) REPS(12) { norm_mod_rows_bf16(F, (const bf16*)(F.ws + WS_HB), F.in[I_N2W], 3 * DM, 4 * DM, (bf16*)(F.ws + WS_XN)); }
    SEAM(12);
    STAMP(13);
    if (IN(13)) REPS(13) {
        pg8::Gemm g{(const pg8::bf16_t*)(F.ws + WS_XN), (const pg8::bf16_t*)(F.ws + WS_WQ), M, DM, DM};
        pg8::StaticOrder S; S.init(M, DM, F.G, (int)blockIdx.x);
        pg8::EpiStoreBf16 E{(pg8::bf16_t*)(F.ws + WS_Q), DM};
        pg8::gemm_phase<pg8::EpiStoreBf16, pg8::StaticOrder, true, true>(F.lds, g, S, E);
    }
    SEAM(13);
    STAMP(14);
    if (IN(14)) REPS(14) { p9_route(F); }
    SEAM(14);
    STAMP(15);
    if (IN(15)) REPS(15) { p10_peer_u(F); }
    SEAM(15);
    STAMP(16);
    if (IN(16)) REPS(16) { p11_peer_coef(F); }
    SEAM(16);
    STAMP(17);
    if (IN(17)) { p12_peer_v(F); }
    SEAM(17);
    STAMP(18);
    if (IN(18)) {
        float oscale = 1.f;
        if (TS_A >= 0) { const volatile unsigned long long* st = stamps; const float frac = (float)(st[TS_B] - st[TS_A]) / (float)(st[17] - st[0]); oscale = 1.f + (float)(TS_K) * frac; }
        final_norm_rows_bf16(F, (const bf16*)(F.ws + WS_HB), F.in[I_FNW], F.out, oscale);
    }
#undef IN
#undef SEAM
}

extern "C" void kernel_launch(void* const* d_in, const int* in_sizes, int n_in, void* d_out, int out_size, void* d_ws, size_t ws_size, hipStream_t stream) {
    static int grid = 0;
    if (grid == 0) {
        if (n_in != N_IN || in_sizes[0] != M * DM || out_size != M * DM || ws_size < WS_END2) {
            fprintf(stderr, "kernel_launch: unexpected shapes: n_in %d in0 %d out %d ws %zu (need %zu)\n", n_in, n_in > 0 ? in_sizes[0] : -1, out_size, ws_size, (size_t)WS_END2); grid = -1; return; }
        int dev = 0, cus = 0, per_cu = 0;
        if (hipGetDevice(&dev) != hipSuccess || hipDeviceGetAttribute(&cus, hipDeviceAttributeMultiprocessorCount, dev) != hipSuccess) { grid = -1; return; }
        if (hipFuncSetAttribute((const void*)fwd_kernel, hipFuncAttributeMaxDynamicSharedMemorySize, LDS_BYTES) != hipSuccess) { fprintf(stderr, "kernel_launch: hipFuncSetAttribute failed\n"); grid = -1; return; }
        if (hipOccupancyMaxActiveBlocksPerMultiprocessor(&per_cu, (const void*)fwd_kernel, NTHR, LDS_BYTES) != hipSuccess || per_cu < 1) { fprintf(stderr, "kernel_launch: occupancy query says %d blocks per CU\n", per_cu); per_cu = 1; }
        (void)hipGetLastError();
        grid = cus;
        fprintf(stderr, "kernel_launch: cus %d per_cu %d grid %d ws %zu\n", cus, per_cu, grid, ws_size);
    }
    if (grid < 0) return;
    (void)hipMemsetAsync((char*)d_ws + WS_CTL, 0, CTL_ZERO_BYTES, stream);
    Args a{};
    for (int i = 0; i < N_IN; ++i) a.in[i] = (const float*)d_in[i];
    a.out = (float*)d_out; a.ws = (unsigned char*)d_ws; a.ph_lo = 0; a.ph_hi = N_PHASES;
    void* kargs[] = {&a};
#ifndef NPASS
#define NPASS 1
#endif
    hipError_t e = hipSuccess;
    for (int pass_ = 0; pass_ < NPASS; ++pass_) {
        if (pass_ > 0) (void)hipMemsetAsync((char*)d_ws + WS_CTL, 0, CTL_ZERO_BYTES, stream);
        e = hipLaunchCooperativeKernel((const void*)fwd_kernel, dim3(grid), dim3(NTHR), kargs, LDS_BYTES, stream);
    }
    if (e != hipSuccess) fprintf(stderr, "kernel_launch: cooperative launch failed: %s (grid %d)\n", hipGetErrorString(e), grid);
}
```

```cpp
#include <hip/hip_runtime.h>
#include <hip/hip_cooperative_groups.h>
#include <cstdio>
#include <cstdint>
namespace cg = cooperative_groups;
namespace pg8 {
#define PG8_LAS __attribute__((address_space(3)))
typedef unsigned short bf16_t;
typedef short bf16x8 __attribute__((ext_vector_type(8)));
typedef float f32x4 __attribute__((ext_vector_type(4)));
typedef unsigned u32x4 __attribute__((ext_vector_type(4)));
constexpr int BM = 256, BK = 64, HALF = 128, HTB = HALF * BK * 2  , STAGE_BYTES = 8 * HTB, NXCD = 8, WGM = 8;

__host__ __device__ __forceinline__ int lds_byte(int r, int c) { const int st = (r >> 4) * 2 + (c >> 5), rr = r & 15, cc = c & 31, ob = rr * 64 + cc * 2; return st * 1024 + (ob ^ (((ob >> 9) & 1) << 5)); }
__host__ __device__ __forceinline__ void stage_rc(int b, int& R, int& C) { const int st = b / 1024, sb = b % 1024, swz = sb ^ (((sb >> 9) & 1) << 5); R = (st >> 1) * 16 + swz / 64; C = (st & 1) * 32 + (swz % 64) / 2; }
__host__ __device__ __forceinline__ int perm32(int rho) { const int n = rho >> 4, i = rho & 15; return 8 * (i >> 2) + 4 * n + (i & 3); }

struct Unit { int pm, pn; };
struct Gemm { const bf16_t* A; const bf16_t* Bt; int M, N, K; };

struct StaticOrder {
    int nM, nN, nwg, G, c;
    __host__ __device__ void init(int M, int N, int G_, int c_) { nM = M / BM; nN = N / BM; nwg = nM * nN; G = G_; c = c_; }
    __host__ __device__ bool next(int i, Unit& u) const {
        const long L = (long)i * G + c; if (L >= nwg) return false;
        int wgid = (int)L; { const int q = nwg / NXCD, r = nwg % NXCD, xcd = wgid % NXCD, off = wgid / NXCD; wgid = (xcd < r ? xcd * (q + 1) : r * (q + 1) + (xcd - r) * q) + off; }
        const int nig = WGM * nN, gid = wgid / nig, fm = gid * WGM, gsz = (nM - fm) < WGM ? (nM - fm) : WGM;
        u.pm = fm + ((wgid % nig) % gsz); u.pn = (wgid % nig) / gsz; return true;
    }
    __device__ __forceinline__ void a_ready(const Unit&) const {}
    __device__ __forceinline__ void done(const Unit&) const {}
};
__device__ __forceinline__ unsigned cvt_pk_bf16(float lo, float hi) { unsigned r; asm volatile("v_cvt_pk_bf16_f32 %0, %1, %2" : "=v"(r) : "v"(lo), "v"(hi)); return r; }
struct EpiStoreBf16 {
    static constexpr bool PERM = true, AFTER_DRAIN = false;
    bf16_t* O; int ldc;
    __device__ __forceinline__ void operator()(const f32x4 (&acc)[2][2][4][2], const Unit& u, int wr, int wc, int fr, int fq) const {
        const int row0 = u.pm * BM + wr * 64 + fr; const int col0 = u.pn * BM + wc * 32 + 8 * fq;
#pragma unroll
        for (int ai = 0; ai < 2; ++ai)
#pragma unroll
            for (int m = 0; m < 4; ++m) { bf16_t* rowp = O + (size_t)(row0 + ai * HALF + m * 16) * ldc + col0;
#pragma unroll
                for (int bj = 0; bj < 2; ++bj) { const f32x4 v0 = acc[ai][bj][m][0], v1 = acc[ai][bj][m][1];
                    u32x4 w; w.x = cvt_pk_bf16(v0[0], v0[1]); w.y = cvt_pk_bf16(v0[2], v0[3]); w.z = cvt_pk_bf16(v1[0], v1[1]); w.w = cvt_pk_bf16(v1[2], v1[3]);
                    *(u32x4*)(rowp + bj * HALF) = w; } }
    }
};
struct EpiResid {
    static constexpr bool PERM = true, AFTER_DRAIN = false;
    const float* X; const float* gate; bf16_t* O; int ldc; int rows_per_batch; int gstride;
    __device__ __forceinline__ void operator()(const f32x4 (&acc)[2][2][4][2], const Unit& u, int wr, int wc, int fr, int fq) const {
        const int row0 = u.pm * BM + wr * 64 + fr; const int col0 = u.pn * BM + wc * 32 + 8 * fq;
        const float* g = gate + (size_t)((u.pm * BM) / rows_per_batch) * gstride + col0;
        f32x4 gv[2][2];
#pragma unroll
        for (int bj = 0; bj < 2; ++bj)
#pragma unroll
            for (int n = 0; n < 2; ++n) gv[bj][n] = *(const f32x4*)(g + bj * HALF + 4 * n);
#pragma unroll
        for (int ai = 0; ai < 2; ++ai)
#pragma unroll
            for (int m = 0; m < 4; ++m) { const size_t off = (size_t)(row0 + ai * HALF + m * 16) * ldc + col0;
#pragma unroll
                for (int bj = 0; bj < 2; ++bj) { const f32x4 x0 = *(const f32x4*)(X + off + bj * HALF), x1 = *(const f32x4*)(X + off + bj * HALF + 4);
                    const f32x4 v0 = x0 + gv[bj][0] * acc[ai][bj][m][0], v1 = x1 + gv[bj][1] * acc[ai][bj][m][1];
                    u32x4 w; w.x = cvt_pk_bf16(v0[0], v0[1]); w.y = cvt_pk_bf16(v0[2], v0[3]); w.z = cvt_pk_bf16(v1[0], v1[1]); w.w = cvt_pk_bf16(v1[2], v1[3]);
                    *(u32x4*)(O + off + bj * HALF) = w; } }
    }
};
template <class Epi, class Sched, bool ALIGN_EPI = false, bool SP2 = false>
__device__ __forceinline__ void gemm_phase(PG8_LAS unsigned char* lds, const Gemm g, const Sched& S, const Epi& E) {
    const int tid = threadIdx.x, wid = __builtin_amdgcn_readfirstlane(tid >> 6), lane = tid & 63, wr = wid >> 2, wc = wid & 3, fr = lane & 15, fq = lane >> 4;
    const int K = g.K, nt = K / BK;
    unsigned voffA[2], voffB[2];
#pragma unroll
    for (int i = 0; i < 2; ++i) { int R, C; stage_rc(tid * 16 + i * 8192, R, C); const int Rb = Epi::PERM ? ((R & ~31) + perm32(R & 31)) : R;
        voffA[i] = (unsigned)(R * K + C) * 2u; voffB[i] = (unsigned)(Rb * K + C) * 2u; }
    const size_t kstep = (size_t)(BK * 2);
    const size_t hstep = (size_t)HALF * K * 2;
    const size_t tstep = 2 * hstep;
    const unsigned ldsw = (unsigned)wid * 1024u;
    const int aoff = lds_byte(wr * 64 + fr, fq * 8), boff = lds_byte(wc * 32 + fr, fq * 8);
#define PG8_SA(b, h) (((b) * 2 + (h)) * HTB)
#define PG8_SB(b, h) ((4 + (b) * 2 + (h)) * HTB)
#define PG8_STAGE(bufoff, gbase, voff) do { _Pragma("unroll") for (int _i = 0; _i < 2; ++_i) \
        __builtin_amdgcn_global_load_lds((const unsigned*)((const char*)(gbase) + (voff)[_i]), (PG8_LAS unsigned*)(lds + (bufoff) + ldsw + _i * 8192), 16, 0, 0); } while (0)
#define PG8_LDA(dst, b, h) do { _Pragma("unroll") for (int m = 0; m < 4; ++m) _Pragma("unroll") for (int k = 0; k < 2; ++k) dst[m][k] = *(const PG8_LAS bf16x8*)(lds + PG8_SA(b, h) + aoff + m * 2048 + k * 1024); } while (0)
#define PG8_LDB(dst, b, h) do { _Pragma("unroll") for (int n = 0; n < 2; ++n) _Pragma("unroll") for (int k = 0; k < 2; ++k) dst[n][k] = *(const PG8_LAS bf16x8*)(lds + PG8_SB(b, h) + boff + n * 2048 + k * 1024); } while (0)
#define PG8_MMA(ai, bj, At, Bt) do { __builtin_amdgcn_s_setprio(1); _Pragma("unroll") for (int m = 0; m < 4; ++m) _Pragma("unroll") for (int n = 0; n < 2; ++n) _Pragma("unroll") for (int k = 0; k < 2; ++k) \
        acc[ai][bj][m][n] = __builtin_amdgcn_mfma_f32_16x16x32_bf16(Bt[n][k], At[m][k], acc[ai][bj][m][n], 0, 0, 0); __builtin_amdgcn_s_setprio(0); } while (0)
#define PG8_WAIT_V(n) asm volatile("s_waitcnt vmcnt(" #n ")" ::: "memory")
#define PG8_WAIT_L(n) asm volatile("s_waitcnt lgkmcnt(" #n ")" ::: "memory")
#define PG8_BAR __builtin_amdgcn_s_barrier()
#define PG8_SCHED __builtin_amdgcn_sched_barrier(0)
    Unit cur, nxt; int ui = 0;
    if (!S.next(0, cur)) return;
    f32x4 acc[2][2][4][2];
#pragma unroll
    for (int a = 0; a < 2; ++a)
#pragma unroll
        for (int b = 0; b < 2; ++b)
#pragma unroll
            for (int m = 0; m < 4; ++m)
#pragma unroll
                for (int n = 0; n < 2; ++n) acc[a][b][m][n] = (f32x4){0.f, 0.f, 0.f, 0.f};
    bf16x8 At[4][2], B0[2][2], B1[2][2];
    const char* cA = (const char*)g.A + (size_t)cur.pm * tstep; const char* cB = (const char*)g.Bt + (size_t)cur.pn * tstep;
    S.a_ready(cur);
    if constexpr (SP2) {
        PG8_STAGE(PG8_SB(0, 0), cB, voffB); PG8_STAGE(PG8_SB(0, 1), cB + hstep, voffB); PG8_STAGE(PG8_SA(0, 0), cA, voffA); PG8_STAGE(PG8_SA(0, 1), cA + hstep, voffA);
        if (wr == 1) PG8_BAR;
        PG8_WAIT_V(2); PG8_BAR;
        PG8_STAGE(PG8_SB(1, 0), cB + kstep, voffB); PG8_STAGE(PG8_SA(1, 0), cA + kstep, voffA); PG8_STAGE(PG8_SB(1, 1), cB + hstep + kstep, voffB);
        PG8_WAIT_V(6); PG8_BAR;
    } else {
        PG8_STAGE(PG8_SB(0, 0), cB, voffB); PG8_STAGE(PG8_SA(0, 0), cA, voffA); PG8_STAGE(PG8_SB(0, 1), cB + hstep, voffB); PG8_STAGE(PG8_SA(0, 1), cA + hstep, voffA);
        if (wr == 1) PG8_BAR;
        PG8_WAIT_V(4); PG8_BAR;
        PG8_STAGE(PG8_SB(1, 0), cB + kstep, voffB); PG8_STAGE(PG8_SA(1, 0), cA + kstep, voffA); PG8_STAGE(PG8_SB(1, 1), cB + hstep + kstep, voffB);
        PG8_WAIT_V(6); PG8_BAR;
    }
    for (;;) {
        const bool has_next = S.next(ui + 1, nxt);
        const char* nA = has_next ? (const char*)g.A + (size_t)nxt.pm * tstep : cA; const char* nB = has_next ? (const char*)g.Bt + (size_t)nxt.pn * tstep : cB;
        for (int t = 0; t < nt; t += 2) {
            const bool last = (t == nt - 2);
            const char* a1 = cA + (size_t)(t + 1) * kstep;
            const char* a2 = last ? nA : cA + (size_t)(t + 2) * kstep; const char* b2 = last ? nB : cB + (size_t)(t + 2) * kstep;
            const char* a3 = a2 + kstep; const char* b3 = b2 + kstep;
            if (last && has_next) S.a_ready(nxt);
            if constexpr (SP2) {
            PG8_LDB(B0, 0, 0); PG8_LDB(B1, 0, 1); PG8_SCHED; PG8_LDA(At, 0, 0); PG8_STAGE(PG8_SA(1, 1), a1 + hstep, voffA);
            PG8_WAIT_V(8); PG8_WAIT_L(0); PG8_BAR; PG8_MMA(0, 0, At, B0); PG8_MMA(0, 1, At, B1); PG8_BAR; PG8_SCHED;
            PG8_LDA(At, 0, 1); PG8_STAGE(PG8_SB(0, 0), b2, voffB); PG8_STAGE(PG8_SB(0, 1), b2 + hstep, voffB); PG8_STAGE(PG8_SA(0, 0), a2, voffA);
            PG8_WAIT_V(8); PG8_WAIT_L(0); PG8_BAR; PG8_MMA(1, 0, At, B0); PG8_MMA(1, 1, At, B1); PG8_BAR; PG8_SCHED;
            PG8_LDB(B0, 1, 0); PG8_LDB(B1, 1, 1); PG8_SCHED; PG8_LDA(At, 1, 0); PG8_STAGE(PG8_SA(0, 1), a2 + hstep, voffA);
            PG8_WAIT_V(8); PG8_WAIT_L(0); PG8_BAR; PG8_MMA(0, 0, At, B0); PG8_MMA(0, 1, At, B1); PG8_BAR; PG8_SCHED;
            PG8_LDA(At, 1, 1); PG8_STAGE(PG8_SB(1, 0), b3, voffB); PG8_STAGE(PG8_SB(1, 1), b3 + hstep, voffB); PG8_STAGE(PG8_SA(1, 0), a3, voffA);
            PG8_WAIT_V(8); PG8_WAIT_L(0); PG8_BAR; PG8_MMA(1, 0, At, B0); PG8_MMA(1, 1, At, B1); PG8_BAR; PG8_SCHED;
            } else {
            PG8_LDB(B0, 0, 0); PG8_SCHED; PG8_LDA(At, 0, 0); PG8_STAGE(PG8_SA(1, 1), a1 + hstep, voffA);
            PG8_WAIT_L(8); PG8_BAR; PG8_WAIT_L(0); PG8_MMA(0, 0, At, B0); PG8_BAR; PG8_SCHED;
            PG8_LDB(B1, 0, 1); PG8_STAGE(PG8_SB(0, 0), b2, voffB);
            PG8_BAR; PG8_WAIT_L(0); PG8_MMA(0, 1, At, B1); PG8_BAR;
            PG8_LDA(At, 0, 1); PG8_STAGE(PG8_SA(0, 0), a2, voffA);
            PG8_BAR; PG8_WAIT_L(0); PG8_MMA(1, 0, At, B0); PG8_BAR; PG8_SCHED;
            PG8_STAGE(PG8_SB(0, 1), b2 + hstep, voffB);
            PG8_WAIT_V(6); PG8_BAR; PG8_MMA(1, 1, At, B1); PG8_BAR;
            PG8_LDB(B0, 1, 0); PG8_SCHED; PG8_LDA(At, 1, 0); PG8_STAGE(PG8_SA(0, 1), a2 + hstep, voffA);
            PG8_WAIT_L(8); PG8_BAR; PG8_WAIT_L(0); PG8_MMA(0, 0, At, B0); PG8_BAR; PG8_SCHED;
            PG8_LDB(B1, 1, 1); PG8_STAGE(PG8_SB(1, 0), b3, voffB);
            PG8_BAR; PG8_WAIT_L(0); PG8_MMA(0, 1, At, B1); PG8_BAR;
            PG8_LDA(At, 1, 1); PG8_STAGE(PG8_SA(1, 0), a3, voffA);
            PG8_BAR; PG8_WAIT_L(0); PG8_MMA(1, 0, At, B0); PG8_BAR; PG8_SCHED;
            PG8_STAGE(PG8_SB(1, 1), b3 + hstep, voffB);
            PG8_WAIT_V(6); PG8_BAR; PG8_MMA(1, 1, At, B1); PG8_BAR;
            }
        }
        if constexpr (ALIGN_EPI) { if (wr == 0) PG8_BAR; }
        if constexpr (!Epi::AFTER_DRAIN) { E(acc, cur, wr, wc, fr, fq); S.done(cur); }
        if (!has_next) break;
#pragma unroll
        for (int a = 0; a < 2; ++a)
#pragma unroll
            for (int b = 0; b < 2; ++b)
#pragma unroll
                for (int m = 0; m < 4; ++m)
#pragma unroll
                    for (int n = 0; n < 2; ++n) acc[a][b][m][n] = (f32x4){0.f, 0.f, 0.f, 0.f};
        cur = nxt; cA = nA; cB = nB; ++ui;
        if constexpr (ALIGN_EPI) { if (wr == 1) PG8_BAR; }
    }
    PG8_WAIT_V(0);
    if constexpr (!ALIGN_EPI) { if (wr == 0) PG8_BAR; }
    PG8_BAR;
    if constexpr (Epi::AFTER_DRAIN) { E.fused(acc, cur, wr, wc, fr, fq, lds, wid, lane); S.done(cur); }
#undef PG8_SA
#undef PG8_SB
#undef PG8_STAGE
#undef PG8_LDA
#undef PG8_LDB
#undef PG8_MMA
#undef PG8_WAIT_V
#undef PG8_WAIT_L
#undef PG8_BAR
#undef PG8_SCHED
}
}
#define GAS __attribute__((address_space(1)))
#define LAS __attribute__((address_space(3)))
typedef unsigned short bf16;
typedef unsigned v4u __attribute__((ext_vector_type(4)));
typedef unsigned v2u __attribute__((ext_vector_type(2)));
typedef float f32x4 __attribute__((ext_vector_type(4)));
typedef float f32x2 __attribute__((ext_vector_type(2)));
typedef short bf16x8 __attribute__((ext_vector_type(8)));
typedef __bf16 bf16x2_t __attribute__((ext_vector_type(2)));

constexpr int NWAVES = 8, NTHR = 512;
constexpr int DM = 2048, NB = 4, SEQ = 8192, M = NB * SEQ;
constexpr int RW = 1024, RHEADS = 16, HD = 64;
constexpr int L_W = 64, L_A = 64, L_G = 160;
constexpr int INP = 5936, INPP = 6144;
constexpr int C_R = 0, C_K = 1024, C_V = 2048, C_WD = 3072, C_AD = 3136, C_GD = 3200, C_Z = 3360, C_XBC = 4384, C_DT = 5920;
constexpr int MODW = 6 * DM;
constexpr int NEXP = 16384;
constexpr float RMS_EPS = 1e-6f;

enum { I_X = 0, I_C, I_ADAW, I_ADAB, I_N1W, I_WIN, I_MU, I_W0, I_WUP, I_A0, I_AUP, I_GUP, I_KK, I_KA, I_RK, I_LNW, I_LNB,
       I_CONVW, I_CONVB, I_DTB, I_ALOG, I_DSK, I_MNW, I_WOUT, I_N2W, I_WQ, I_KEYS, I_PU, I_PV, I_FNW, N_IN };

constexpr size_t MiB = 1u << 20;
constexpr size_t WS_CTL = 0, CTL_ZERO_BYTES = 1 * MiB;
constexpr size_t WS_MOD = 1 * MiB;
constexpr size_t WS_WIN = 2 * MiB, WS_WOUT = 26 * MiB, WS_WQ = 34 * MiB, WS_KEYS = 42 * MiB;
constexpr size_t WS_WUPT = 43 * MiB, WS_AUPT = 43 * MiB + 256 * 1024, WS_GUPT = 43 * MiB + 512 * 1024;
constexpr size_t WS_PU8 = 44 * MiB, WS_PV8 = 76 * MiB;
constexpr size_t WS_USC = 108 * MiB, WS_VSC = 108 * MiB + 65536;
constexpr size_t WS_XN = 172 * MiB;
constexpr size_t WS_LW = WS_XN, WS_AA = WS_XN + 64 * MiB;
constexpr size_t WS_PROJ = 300 * MiB;
constexpr size_t WS_Q = WS_PROJ;
constexpr size_t WS_GG = 684 * MiB;
constexpr size_t WS_X8 = WS_PROJ + 192 * MiB;
constexpr size_t WS_PD = WS_PROJ + 128 * MiB;
constexpr size_t WS_RTE = 684 * MiB, WS_RTG = 700 * MiB, WS_COEF = 716 * MiB;
constexpr size_t WS_OY = 748 * MiB;
constexpr size_t WS_END = 876 * MiB;
constexpr size_t WS_HB = 876 * MiB;

constexpr int RING_BYTES = 131072, LDS_BYTES = 147456;

#define LDS_WAIT() asm volatile("s_waitcnt lgkmcnt(0)" ::: "memory")
#define VM_WAIT() asm volatile("s_waitcnt vmcnt(0)" ::: "memory")
__device__ __forceinline__ unsigned pk2(float lo, float hi) { f32x2 v = {lo, hi}; bf16x2_t b = __builtin_convertvector(v, bf16x2_t); return __builtin_bit_cast(unsigned, b); }
__device__ __forceinline__ float bflo(unsigned u) { return __uint_as_float(u << 16); }
__device__ __forceinline__ float bfhi(unsigned u) { return __uint_as_float(u & 0xffff0000u); }
__device__ __forceinline__ float bf1(bf16 h) { return __uint_as_float((unsigned)h << 16); }
__device__ __forceinline__ float wave_sum(float v) {
#pragma unroll
    for (int o = 1; o < 64; o <<= 1) v += __shfl_xor(v, o);
    return v;
}
__device__ __forceinline__ float rcp_f(float v) { return __builtin_amdgcn_rcpf(v); }
template <int CTRL> __device__ __forceinline__ float dppc_f(float x) { return __builtin_bit_cast(float, __builtin_amdgcn_mov_dpp(__builtin_bit_cast(int, x), CTRL, 0xf, 0xf, true)); }
__device__ __forceinline__ float wave_sum_fast(float x) {
    x += dppc_f<0xB1>(x); x += dppc_f<0x4E>(x); x += dppc_f<0x124>(x); x += dppc_f<0x128>(x);
    { auto rr = __builtin_amdgcn_permlane16_swap(__float_as_uint(x), __float_as_uint(x), false, false); x = __uint_as_float(rr[0]) + __uint_as_float(rr[1]); }
    { auto rr = __builtin_amdgcn_permlane32_swap(__float_as_uint(x), __float_as_uint(x), false, false); x = __uint_as_float(rr[0]) + __uint_as_float(rr[1]); }
    return x;
}
__device__ __forceinline__ float silu_f(float v) { return v * rcp_f(1.f + __expf(-v)); }
__device__ __forceinline__ float sigmoid_f(float v) { return rcp_f(1.f + __expf(-v)); }

struct Ctx {
    LAS unsigned char* lds;
    int tid, lane, wave, G, gw, NGW;
    const float* const* in;
    float* out; unsigned char* ws;
};

__device__ __forceinline__ void transpose_item(const float* W, int K, int N, bf16* WT, int ldt, int nrows_out, LAS float* scr, int kb, int nb, int lane) {
    const int k0 = 64 * kb, n0 = 64 * nb;
    const int c4 = 4 * (lane & 15), rr = lane >> 4;
    const bool vec_ok = ((N & 3) == 0) && (n0 + 64 <= N);
#pragma unroll 4
    for (int i = 0; i < 16; ++i) { const int kk = 4 * i + rr, k = k0 + kk;
        f32x4 v = {0.f, 0.f, 0.f, 0.f};
        if (k < K) { const float* src = W + (size_t)k * N + n0 + c4;
            if (vec_ok) v = *(const f32x4*)src;
            else { if (n0 + c4 + 0 < N) v.x = src[0]; if (n0 + c4 + 1 < N) v.y = src[1]; if (n0 + c4 + 2 < N) v.z = src[2]; if (n0 + c4 + 3 < N) v.w = src[3]; } }
        LAS float* d = scr + kk * 65 + c4; d[0] = v.x; d[1] = v.y; d[2] = v.z; d[3] = v.w; }
    LDS_WAIT(); asm volatile("" ::: "memory");
    const int c = lane & 7;
#pragma unroll
    for (int j = 0; j < 8; ++j) { const int n = (lane >> 3) + 8 * j; const LAS float* sp = scr + (8 * c) * 65 + n;
        v4u o; o.x = pk2(sp[0 * 65], sp[1 * 65]); o.y = pk2(sp[2 * 65], sp[3 * 65]); o.z = pk2(sp[4 * 65], sp[5 * 65]); o.w = pk2(sp[6 * 65], sp[7 * 65]);
        if (n0 + n < nrows_out && k0 + 8 * c + 8 <= ldt) *(v4u*)(WT + (size_t)(n0 + n) * ldt + k0 + 8 * c) = o; }
    LDS_WAIT(); asm volatile("" ::: "memory");
}
__device__ __forceinline__ void transpose_all(const float* W, int K, int N, bf16* WT, int ldt, int nrows_out, LAS float* scr, int gw, int NGW, int lane) {
    const int nkb = (K + 63) / 64, nnb = nrows_out / 64, nit = nkb * nnb;
    for (int it = gw; it < nit; it += NGW) transpose_item(W, K, N, WT, ldt, nrows_out, scr, it / nnb, it % nnb, lane);
}
__device__ __forceinline__ void convert_all(const float* src, bf16* dst, size_t n8, int gw, int NGW, int lane) {
    const f32x4* s4 = (const f32x4*)src; v4u* d4 = (v4u*)dst;
    for (size_t i = (size_t)gw * 64 + lane; i < n8; i += (size_t)NGW * 64) {
        const f32x4 a = __builtin_nontemporal_load(s4 + 2 * i), b = __builtin_nontemporal_load(s4 + 2 * i + 1);
        v4u o; o.x = pk2(a.x, a.y); o.y = pk2(a.z, a.w); o.z = pk2(b.x, b.y); o.w = pk2(b.z, b.w);
        d4[i] = o; }
}
__device__ __forceinline__ void quantize_rows_fp8(const float* src, unsigned char* dst8, float* scales, int e0, int e1, int step, int lane) {
    if (e0 >= e1) return;
    f32x4 vn[8];
    { const f32x4* s4 = (const f32x4*)(src + (size_t)e0 * DM) + lane;
#pragma unroll
      for (int i = 0; i < 8; ++i) vn[i] = __builtin_nontemporal_load(s4 + 64 * i); }
    for (int e = e0; e < e1; e += step) {
        f32x4 v[8];
#pragma unroll
        for (int i = 0; i < 8; ++i) v[i] = vn[i];
        { const int en = (e + step < e1) ? e + step : e; const f32x4* s4 = (const f32x4*)(src + (size_t)en * DM) + lane;
#pragma unroll
          for (int i = 0; i < 8; ++i) vn[i] = __builtin_nontemporal_load(s4 + 64 * i); }
        float am = 0.f;
#pragma unroll
        for (int i = 0; i < 8; ++i) am = fmaxf(fmaxf(am, fmaxf(fabsf(v[i].x), fabsf(v[i].y))), fmaxf(fabsf(v[i].z), fabsf(v[i].w)));
#pragma unroll
        for (int o = 1; o < 64; o <<= 1) am = fmaxf(am, __shfl_xor(am, o));
        am = fmaxf(am, 1e-30f);
        const float inv = 440.f / am;
#pragma unroll
        for (int i = 0; i < 8; ++i) { int w = __builtin_amdgcn_cvt_pk_fp8_f32(v[i].x * inv, v[i].y * inv, 0, false); w = __builtin_amdgcn_cvt_pk_fp8_f32(v[i].z * inv, v[i].w * inv, w, true);
            const int seg = 2 * i + (lane >> 5);
            *(int*)(dst8 + (size_t)seg * ((size_t)NEXP * 128) + (size_t)e * 128 + 4 * (lane & 31)) = w; }
        if (lane == 0) scales[e] = am * (1.f / 440.f);
    }
}
__device__ __forceinline__ void quantize_rows_fp4(const float* src, unsigned char* dst4, float* scales, int e0, int e1, int step, int lane) {
    if (e0 >= e1) return;
    f32x4 vn[8];
    { const f32x4* s4 = (const f32x4*)(src + (size_t)e0 * DM) + lane;
#pragma unroll
      for (int i = 0; i < 8; ++i) vn[i] = __builtin_nontemporal_load(s4 + 64 * i); }
    for (int e = e0; e < e1; e += step) {
        f32x4 v[8];
#pragma unroll
        for (int i = 0; i < 8; ++i) v[i] = vn[i];
        { const int en = (e + step < e1) ? e + step : e; const f32x4* s4 = (const f32x4*)(src + (size_t)en * DM) + lane;
#pragma unroll
          for (int i = 0; i < 8; ++i) vn[i] = __builtin_nontemporal_load(s4 + 64 * i); }
        float am = 0.f;
#pragma unroll
        for (int i = 0; i < 8; ++i) am = fmaxf(am, fmaxf(fmaxf(fabsf(v[i].x), fabsf(v[i].y)), fmaxf(fabsf(v[i].z), fabsf(v[i].w))));
#pragma unroll
        for (int o = 1; o < 64; o <<= 1) am = fmaxf(am, __shfl_xor(am, o));
        am = fmaxf(am, 1e-30f);
        const float inv = 6.f / am;
#pragma unroll
        for (int i = 0; i < 8; ++i) {
            unsigned w = __builtin_amdgcn_cvt_scalef32_pk_fp4_f32(0u, v[i].x * inv, v[i].y * inv, 1.0f, 0);
            w = __builtin_amdgcn_cvt_scalef32_pk_fp4_f32(w, v[i].z * inv, v[i].w * inv, 1.0f, 1);
            *(unsigned short*)(dst4 + (size_t)i * ((size_t)NEXP * 128) + (size_t)e * 128 + 2 * lane) = (unsigned short)w;
        }
        if (lane == 0) scales[e] = am * (1.f / 6.f);
    }
}
__device__ __forceinline__ void p0_prologue(const Ctx& F) {
    __syncthreads();
    if (blockIdx.x < MODW / 64) {
        LAS float* sc = (LAS float*)F.lds;
        LAS float* red = sc + NB * DM;
        const float* c = F.in[I_C];
        for (int i = F.tid; i < NB * DM; i += NTHR) sc[i] = silu_f(c[i]);
        __syncthreads();
        const int j = blockIdx.x * 64 + F.lane;
        const float* wp = F.in[I_ADAW] + (size_t)(F.wave * 256) * MODW + j;
        float a0 = 0.f, a1 = 0.f, a2 = 0.f, a3 = 0.f;
#pragma unroll 32
        for (int kk = 0; kk < 256; ++kk) { const float w = wp[(size_t)kk * MODW]; const int k = F.wave * 256 + kk;
            a0 += sc[k] * w; a1 += sc[DM + k] * w; a2 += sc[2 * DM + k] * w; a3 += sc[3 * DM + k] * w; }
        red[(F.wave * 4 + 0) * 64 + F.lane] = a0; red[(F.wave * 4 + 1) * 64 + F.lane] = a1; red[(F.wave * 4 + 2) * 64 + F.lane] = a2; red[(F.wave * 4 + 3) * 64 + F.lane] = a3;
        __syncthreads();
        if (F.tid < 256) { const int b = F.tid >> 6, l = F.tid & 63; float s = F.in[I_ADAB][blockIdx.x * 64 + l];
#pragma unroll
            for (int w = 0; w < 8; ++w) s += red[(w * 4 + b) * 64 + l];
            ((float*)(F.ws + WS_MOD))[b * MODW + blockIdx.x * 64 + l] = s; }
        __syncthreads();
    }
    LAS float* scr = (LAS float*)(F.lds + F.wave * 16640);
    transpose_all(F.in[I_WIN], DM, INP, (bf16*)(F.ws + WS_WIN), DM, INPP, scr, F.gw, F.NGW, F.lane);
    transpose_all(F.in[I_WOUT], DM, DM, (bf16*)(F.ws + WS_WOUT), DM, DM, scr, F.gw, F.NGW, F.lane);
    transpose_all(F.in[I_WQ], DM, DM, (bf16*)(F.ws + WS_WQ), DM, DM, scr, F.gw, F.NGW, F.lane);
    transpose_all(F.in[I_WUP], L_W, RW, (bf16*)(F.ws + WS_WUPT), L_W, RW, scr, F.gw, F.NGW, F.lane);
    transpose_all(F.in[I_AUP], L_A, RW, (bf16*)(F.ws + WS_AUPT), L_A, RW, scr, F.gw, F.NGW, F.lane);
    transpose_all(F.in[I_GUP], L_G, RW, (bf16*)(F.ws + WS_GUPT), L_G, RW, scr, F.gw, F.NGW, F.lane);
    convert_all(F.in[I_KEYS], (bf16*)(F.ws + WS_KEYS), (size_t)16 * 128 * 128 / 8, F.gw, F.NGW, F.lane);
    {
        const int nlo = (F.G < 192) ? F.G : 192, nhi = F.G - nlo;
        const int wtot = 5 * nlo + 8 * nhi;
        const int wb0 = (blockIdx.x < nlo) ? 5 * blockIdx.x : 5 * nlo + 8 * (blockIdx.x - nlo), wb1 = wb0 + ((blockIdx.x < nlo) ? 5 : 8);
        const int r0 = (int)((long)(2 * NEXP) * wb0 / wtot), r1 = (int)((long)(2 * NEXP) * wb1 / wtot);
        const int a0 = r0 < NEXP ? r0 : NEXP, a1 = r1 < NEXP ? r1 : NEXP;
        quantize_rows_fp4(F.in[I_PU], F.ws + WS_PU8, (float*)(F.ws + WS_USC), a0 + F.wave, a1, NWAVES, F.lane);
        const int b0 = (r0 > NEXP ? r0 : NEXP) - NEXP, b1 = (r1 > NEXP ? r1 : NEXP) - NEXP;
        quantize_rows_fp4(F.in[I_PV], F.ws + WS_PV8, (float*)(F.ws + WS_VSC), b0 + F.wave, b1, NWAVES, F.lane);
    }
}

__device__ __forceinline__ void norm_mod_rows(const Ctx& F, const float* X, const float* nw, int shift_off, int scale_off, bf16* XN) {
    const float* mod = (const float*)(F.ws + WS_MOD);
    if (F.gw >= M) return;
    f32x4 vn[8];
    { const f32x4* xr = (const f32x4*)(X + (size_t)F.gw * DM) + F.lane;
#pragma unroll
      for (int j = 0; j < 8; ++j) vn[j] = xr[64 * j]; }
    for (int m = F.gw; m < M; m += F.NGW) {
        const int b = m / SEQ;
        f32x4 v[8]; float s = 0.f;
#pragma unroll
        for (int j = 0; j < 8; ++j) { v[j] = vn[j]; s += (v[j].x * v[j].x + v[j].y * v[j].y) + (v[j].z * v[j].z + v[j].w * v[j].w); }
        { const int mn = (m + F.NGW < M) ? m + F.NGW : m; const f32x4* xr = (const f32x4*)(X + (size_t)mn * DM) + F.lane;
#pragma unroll
          for (int j = 0; j < 8; ++j) vn[j] = xr[64 * j]; }
        const float rstd = rsqrtf(wave_sum_fast(s) * (1.f / DM) + RMS_EPS);
        const f32x4* wp = (const f32x4*)nw + F.lane;
        const f32x4* shp = (const f32x4*)(mod + (size_t)b * MODW + shift_off) + F.lane;
        const f32x4* scp = (const f32x4*)(mod + (size_t)b * MODW + scale_off) + F.lane;
        v2u* o = (v2u*)(XN + (size_t)m * DM) + F.lane;
#pragma unroll
        for (int j = 0; j < 8; ++j) { const f32x4 w = wp[64 * j], a = scp[64 * j], c = shp[64 * j];
            const f32x4 r = (v[j] * rstd) * w * (a + 1.f) + c;
            v2u p; p.x = pk2(r.x, r.y); p.y = pk2(r.z, r.w); o[64 * j] = p; }
    }
}
__device__ __forceinline__ void final_norm_rows(const Ctx& F, const float* H, const float* nw, float* O) {
    for (int m = F.gw; m < M; m += F.NGW) {
        const f32x4* xr = (const f32x4*)(H + (size_t)m * DM) + F.lane;
        f32x4 v[8]; float s = 0.f;
#pragma unroll
        for (int j = 0; j < 8; ++j) { v[j] = xr[64 * j]; s += (v[j].x * v[j].x + v[j].y * v[j].y) + (v[j].z * v[j].z + v[j].w * v[j].w); }
        const float rstd = rsqrtf(wave_sum(s) * (1.f / DM) + RMS_EPS);
        const f32x4* wp = (const f32x4*)nw + F.lane;
        f32x4* o = (f32x4*)(O + (size_t)m * DM) + F.lane;
#pragma unroll
        for (int j = 0; j < 8; ++j) o[64 * j] = (v[j] * rstd) * wp[64 * j];
    }
}


__device__ __forceinline__ void load_row_raw(const bf16* row, int lane, v2u (&u)[8]) {
    const v2u* p = (const v2u*)row + lane;
#pragma unroll
    for (int j = 0; j < 8; ++j) u[j] = p[64 * j];
}
__device__ __forceinline__ void norm_mod_rows_bf16(const Ctx& F, const bf16* X, const float* nw, int shift_off, int scale_off, bf16* XN, unsigned* X8 = nullptr) {
    const float* mod = (const float*)(F.ws + WS_MOD);
    if (F.gw >= M) return;
    v2u un[8]; load_row_raw(X + (size_t)F.gw * DM, F.lane, un);
    for (int m = F.gw; m < M; m += F.NGW) {
        const int b = m / SEQ;
        f32x4 v[8]; float s = 0.f;
#pragma unroll
        for (int j = 0; j < 8; ++j) { v[j] = (f32x4){bflo(un[j].x), bfhi(un[j].x), bflo(un[j].y), bfhi(un[j].y)}; s += (v[j].x * v[j].x + v[j].y * v[j].y) + (v[j].z * v[j].z + v[j].w * v[j].w); }
        { const int mn = (m + F.NGW < M) ? m + F.NGW : m; load_row_raw(X + (size_t)mn * DM, F.lane, un); }
        const float rstd = rsqrtf(wave_sum_fast(s) * (1.f / DM) + RMS_EPS);
        const f32x4* wp = (const f32x4*)nw + F.lane;
        const f32x4* shp = (const f32x4*)(mod + (size_t)b * MODW + shift_off) + F.lane;
        const f32x4* scp = (const f32x4*)(mod + (size_t)b * MODW + scale_off) + F.lane;
        v2u* o = (v2u*)(XN + (size_t)m * DM) + F.lane;
#pragma unroll
        for (int j = 0; j < 8; ++j) { const f32x4 w = wp[64 * j], a = scp[64 * j], c = shp[64 * j];
            const f32x4 r = (v[j] * rstd) * w * (a + 1.f) + c;
            v2u p; p.x = pk2(r.x, r.y); p.y = pk2(r.z, r.w); o[64 * j] = p;
            if (X8) { int w8 = __builtin_amdgcn_cvt_pk_fp8_f32(r.x, r.y, 0, false); w8 = __builtin_amdgcn_cvt_pk_fp8_f32(r.z, r.w, w8, true); X8[(size_t)m * (DM / 4) + F.lane + 64 * j] = (unsigned)w8; } }
    }
}
__device__ __forceinline__ void final_norm_rows_bf16(const Ctx& F, const bf16* H, const float* nw, float* O, float oscale) {
    if (F.gw >= M) return;
    v2u un[8]; load_row_raw(H + (size_t)F.gw * DM, F.lane, un);
    f32x4 wv[8];
#pragma unroll
    for (int j = 0; j < 8; ++j) wv[j] = ((const f32x4*)nw + F.lane)[64 * j];
    for (int m = F.gw; m < M; m += F.NGW) {
        f32x4 v[8]; float s = 0.f;
#pragma unroll
        for (int j = 0; j < 8; ++j) { v[j] = (f32x4){bflo(un[j].x), bfhi(un[j].x), bflo(un[j].y), bfhi(un[j].y)}; s += (v[j].x * v[j].x + v[j].y * v[j].y) + (v[j].z * v[j].z + v[j].w * v[j].w); }
        { const int mn = (m + F.NGW < M) ? m + F.NGW : m; load_row_raw(H + (size_t)mn * DM, F.lane, un); }
        const float rstd = rsqrtf(wave_sum_fast(s) * (1.f / DM) + RMS_EPS) * oscale;
        f32x4* o = (f32x4*)(O + (size_t)m * DM) + F.lane;
#pragma unroll
        for (int j = 0; j < 8; ++j) __builtin_nontemporal_store((v[j] * rstd) * wv[j], o + 64 * j);
    }
}
#define LO2(v) __builtin_shufflevector((v), (v), 0, 1)
#define HI2(v) __builtin_shufflevector((v), (v), 2, 3)
template <int CTRL> __device__ __forceinline__ float dpp_f(float x) { return __builtin_bit_cast(float, __builtin_amdgcn_mov_dpp(__builtin_bit_cast(int, x), CTRL, 0xf, 0xf, true)); }
__device__ __forceinline__ float rowsum16(float x) { x += dpp_f<0xB1>(x); x += dpp_f<0x4E>(x); x += dpp_f<0x124>(x); x += dpp_f<0x128>(x); return x; }
__device__ __forceinline__ float quadsum(float x) { x += dpp_f<0xB1>(x); x += dpp_f<0x4E>(x); return x; }

__device__ __forceinline__ float treduce16(const float (&p)[16], bool b0, bool b1, bool b2, bool b3) {
    float a[8], bq[4], c2[2];
#pragma unroll
    for (int j = 0; j < 8; ++j) { const float mine = b3 ? p[j + 8] : p[j], send = b3 ? p[j] : p[j + 8]; a[j] = mine + dpp_f<0x128>(send); }
#pragma unroll
    for (int j = 0; j < 4; ++j) { const float mine = b2 ? a[j + 4] : a[j], send = b2 ? a[j] : a[j + 4]; const float up = dpp_f<0x104>(send), dn = dpp_f<0x114>(send); bq[j] = mine + (b2 ? dn : up); }
#pragma unroll
    for (int j = 0; j < 2; ++j) { const float mine = b1 ? bq[j + 2] : bq[j], send = b1 ? bq[j] : bq[j + 2]; c2[j] = mine + dpp_f<0x4E>(send); }
    const float mine = b0 ? c2[1] : c2[0], send = b0 ? c2[0] : c2[1];
    return mine + dpp_f<0xB1>(send);
}
__device__ __forceinline__ float wave_sum_dpp(float v) { v = rowsum16(v); v += __shfl_xor(v, 16); v += __shfl_xor(v, 32); return v; }
__device__ __forceinline__ void unpack8(const v4u p, float (&e)[8]) { e[0] = bflo(p.x); e[1] = bfhi(p.x); e[2] = bflo(p.y); e[3] = bfhi(p.y); e[4] = bflo(p.z); e[5] = bfhi(p.z); e[6] = bflo(p.w); e[7] = bfhi(p.w); }
__device__ __forceinline__ v4u pack8(const float (&e)[8]) { v4u o; o.x = pk2(e[0], e[1]); o.y = pk2(e[2], e[3]); o.z = pk2(e[4], e[5]); o.w = pk2(e[6], e[7]); return o; }

__device__ __forceinline__ void p3_lora(const Ctx& F) {
    const bf16* PROJ = (const bf16*)(F.ws + WS_PROJ);
    const bf16* WUPT = (const bf16*)(F.ws + WS_WUPT); const bf16* AUPT = (const bf16*)(F.ws + WS_AUPT); const bf16* GUPT = (const bf16*)(F.ws + WS_GUPT);
    bf16* LW = (bf16*)(F.ws + WS_LW); bf16* AA = (bf16*)(F.ws + WS_AA); bf16* GG = (bf16*)(F.ws + WS_GG);
    const float* mu = F.in[I_MU]; const float* w0 = F.in[I_W0]; const float* a0 = F.in[I_A0];
    const int r16 = F.lane & 15, q = F.lane >> 4;
    constexpr int WST = 72, GST = 168;
    LAS bf16* WU = (LAS bf16*)F.lds; LAS bf16* AU = WU + 128 * WST; LAS bf16* GU = AU + 128 * WST;
    const int nr = blockIdx.x & 7, nbr = (F.G - nr + 7) >> 3;
    __syncthreads();
    for (int i = F.tid; i < 128 * 8; i += NTHR) { const int row = i >> 3, ch = i & 7;
        *(LAS v4u*)(WU + row * WST + 8 * ch) = *(const v4u*)(WUPT + (size_t)(128 * nr + row) * L_W + 8 * ch);
        *(LAS v4u*)(AU + row * WST + 8 * ch) = *(const v4u*)(AUPT + (size_t)(128 * nr + row) * L_A + 8 * ch); }
    for (int i = F.tid; i < 128 * 20; i += NTHR) { const int row = i / 20, ch = i - row * 20;
        *(LAS v4u*)(GU + row * GST + 8 * ch) = *(const v4u*)(GUPT + (size_t)(128 * nr + row) * L_G + 8 * ch); }
    __syncthreads();
#define P3_COL(s) ((((s) < 2) ? (C_WD + 32 * (s)) : ((s) < 4) ? (C_AD + 32 * ((s) - 2)) : (C_GD + 32 * ((s) - 4))) + 8 * q)
    const int mt0 = (blockIdx.x >> 3) * NWAVES + F.wave, mst = nbr * NWAVES;
    v4u rc_[9], rp_[9];
    if (mt0 < M / 16) { const bf16* row = PROJ + (size_t)(mt0 * 16 + r16) * INPP;
#pragma unroll
        for (int s = 0; s < 9; ++s) { rc_[s] = *(const v4u*)(row + P3_COL(s)); rp_[s] = *(const v4u*)(row - INPP + P3_COL(s)); } }
    for (int mt = mt0; mt < M / 16; mt += mst) {
        const int m = mt * 16 + r16; const bool first = (m % SEQ) == 0;
        bf16x8 af[9];
#pragma unroll
        for (int s = 0; s < 9; ++s) {
            const int col = P3_COL(s);
            const v4u pc = rc_[s];
            v4u pp = rp_[s]; if (first) pp = (v4u){0u, 0u, 0u, 0u};
            const f32x4 m0 = *(const f32x4*)(mu + col), m1 = *(const f32x4*)(mu + col + 4);
            float c[8], p[8], e[8]; unpack8(pc, c); unpack8(pp, p);
            const float mm[8] = {m0.x, m0.y, m0.z, m0.w, m1.x, m1.y, m1.z, m1.w};
#pragma unroll
            for (int j = 0; j < 8; ++j) { float v = c[j] + (p[j] - c[j]) * mm[j];
                if (s < 2) { const float t = __expf(2.f * v); v = 1.f - 2.f * rcp_f(t + 1.f); }
                else if (s >= 4) v = sigmoid_f(v);
                e[j] = v; }
            af[s] = __builtin_bit_cast(bf16x8, pack8(e));
        }
        { const int mtn = (mt + mst < M / 16) ? mt + mst : mt; const bf16* row = PROJ + (size_t)(mtn * 16 + r16) * INPP;
#pragma unroll
          for (int s = 0; s < 9; ++s) { rc_[s] = *(const v4u*)(row + P3_COL(s)); rp_[s] = *(const v4u*)(row - INPP + P3_COL(s)); } }
        asm volatile("" ::: "memory");
#pragma unroll 2
        for (int nt = 0; nt < 8; ++nt) {
            const LAS bf16* wu = WU + (16 * nt + r16) * WST + 8 * q; const LAS bf16* au = AU + (16 * nt + r16) * WST + 8 * q; const LAS bf16* gu = GU + (16 * nt + r16) * GST + 8 * q;
            f32x4 acc0 = {0.f, 0.f, 0.f, 0.f}, acc1 = acc0, acc2 = acc0;
#pragma unroll
            for (int s2 = 0; s2 < 2; ++s2) acc0 = __builtin_amdgcn_mfma_f32_16x16x32_bf16(*(const LAS bf16x8*)(wu + 32 * s2), af[s2], acc0, 0, 0, 0);
#pragma unroll
            for (int s2 = 0; s2 < 2; ++s2) acc1 = __builtin_amdgcn_mfma_f32_16x16x32_bf16(*(const LAS bf16x8*)(au + 32 * s2), af[2 + s2], acc1, 0, 0, 0);
#pragma unroll
            for (int s2 = 0; s2 < 5; ++s2) acc2 = __builtin_amdgcn_mfma_f32_16x16x32_bf16(*(const LAS bf16x8*)(gu + 32 * s2), af[4 + s2], acc2, 0, 0, 0);
            const int n = 128 * nr + 16 * nt + 4 * q;
            const f32x4 w0v = *(const f32x4*)(w0 + n), a0v = *(const f32x4*)(a0 + n);
            v2u o0, o1, o2;
            o0.x = pk2(-0.60653066f * sigmoid_f(acc0[0] + w0v.x), -0.60653066f * sigmoid_f(acc0[1] + w0v.y));
            o0.y = pk2(-0.60653066f * sigmoid_f(acc0[2] + w0v.z), -0.60653066f * sigmoid_f(acc0[3] + w0v.w));
            o1.x = pk2(sigmoid_f(acc1[0] + a0v.x), sigmoid_f(acc1[1] + a0v.y)); o1.y = pk2(sigmoid_f(acc1[2] + a0v.z), sigmoid_f(acc1[3] + a0v.w));
            o2.x = pk2(acc2[0], acc2[1]); o2.y = pk2(acc2[2], acc2[3]);
            *(v2u*)(LW + (size_t)m * RW + n) = o0; *(v2u*)(AA + (size_t)m * RW + n) = o1; *(v2u*)(GG + (size_t)m * RW + n) = o2;
        }
    }
#undef P3_COL
    __syncthreads();
}

constexpr int TC = 32, NCHUNK = SEQ / TC;
constexpr int RB_R = 0, RB_W = TC * 64, RB_K = 2 * TC * 64, RB_KK = 3 * TC * 64, RB_KA = 4 * TC * 64, RB_V = 5 * TC * 64, RB_SIZE = 5 * TC * 64 + TC * 16;
constexpr int MB_B = 0, MB_C = TC * 128, MB_X = 2 * TC * 128, MB_DT = MB_X + TC * 32, MB_DA = MB_DT + TC, MB_SIZE = MB_DA + TC;
static_assert(2 * RB_SIZE * 4 <= RING_BYTES, "scan buffers fit the LDS ring");

struct RwkvRaw { bf16 r[9], k[9], v[9], lw[8], a[8]; };
__device__ __forceinline__ void rwkv_load(RwkvRaw& raw, const bf16* PROJ, const bf16* LW, const bf16* AA, int b, int h, int t0w, int c) {
    const bf16* base = PROJ + (size_t)(b * SEQ + t0w) * INPP + h * 64 + c;
#pragma unroll
    for (int i = 0; i < 9; ++i) {
        if (i == 0 && t0w == 0) { raw.r[0] = 0; raw.k[0] = 0; raw.v[0] = 0; }
        else { const bf16* row = base + (long)(i - 1) * INPP; raw.r[i] = row[C_R]; raw.k[i] = row[C_K]; raw.v[i] = row[C_V]; }
    }
#pragma unroll
    for (int i = 0; i < 8; ++i) { const size_t o = (size_t)(b * SEQ + t0w + i) * RW + h * 64 + c; raw.lw[i] = LW[o]; raw.a[i] = AA[o]; }
}
__device__ __forceinline__ void rwkv_stage(const RwkvRaw& raw, LAS float* buf, int tl0, int c, int qt, float mu_r, float mu_k, float mu_v, float kkw, float kaw) {
#pragma unroll
    for (int i = 0; i < 8; ++i) {
        const int t = tl0 + i;
        const float rc = bf1(raw.r[i + 1]), rp = bf1(raw.r[i]), kc = bf1(raw.k[i + 1]), kp = bf1(raw.k[i]), vc = bf1(raw.v[i + 1]), vp = bf1(raw.v[i]);
        const float rr = rc + (rp - rc) * mu_r, kx = kc + (kp - kc) * mu_k, vv = vc + (vp - vc) * mu_v;
        const float a = bf1(raw.a[i]), dec = __expf(bf1(raw.lw[i]));
        const float kkraw = kx * kkw; const float ss = wave_sum_dpp(kkraw * kkraw);
        const float kkn = kkraw * rcp_f(fmaxf(sqrtf(ss), 1e-12f));
        buf[RB_R + t * 64 + c] = rr; buf[RB_W + t * 64 + c] = dec; buf[RB_K + t * 64 + c] = kx * (1.f + (a - 1.f) * kaw);
        buf[RB_KK + t * 64 + c] = kkn; buf[RB_KA + t * 64 + c] = kkn * a;
        if ((c >> 4) == qt) buf[RB_V + t * 16 + (c & 15)] = vv;
    }
}
__device__ __forceinline__ void rwkv_task(const Ctx& F, int task) {
    const int b = task >> 6, h = (task >> 2) & 15, qt = task & 3;
    const bf16* PROJ = (const bf16*)(F.ws + WS_PROJ); const bf16* LW = (const bf16*)(F.ws + WS_LW); const bf16* AA = (const bf16*)(F.ws + WS_AA);
    bf16* OY = (bf16*)(F.ws + WS_OY);
    LAS float* lbuf = (LAS float*)F.lds;
    const int c = F.lane, w = F.wave, r = F.lane >> 4, cg = F.lane & 15;
    const bool stager = w >= 4; const int sw = w & 3;
    const int ch = h * 64 + c;
    const float mu_r = F.in[I_MU][C_R + ch], mu_k = F.in[I_MU][C_K + ch], mu_v = F.in[I_MU][C_V + ch], kkw = F.in[I_KK][ch], kaw = F.in[I_KA][ch];
    RwkvRaw raw;
    if (stager) { rwkv_load(raw, PROJ, LW, AA, b, h, 8 * sw, c); rwkv_stage(raw, lbuf, 8 * sw, c, qt, mu_r, mu_k, mu_v, kkw, kaw); rwkv_load(raw, PROJ, LW, AA, b, h, TC + 8 * sw, c); }
    __syncthreads();
    f32x2 S01 = {0.f, 0.f}, S23 = {0.f, 0.f};
    const bool cb0 = cg & 1, cb1 = cg & 2, cb2 = cg & 4, cb3 = cg & 8;
    bf16* orow = OY + (size_t)(b * SEQ) * DM + h * 64 + 16 * qt + 4 * sw + r;
    for (int ck = 0; ck < NCHUNK; ++ck) {
        const LAS float* buf = lbuf + (ck & 1) * RB_SIZE;
        if (stager) {
            if (ck + 1 < NCHUNK) { rwkv_stage(raw, lbuf + ((ck + 1) & 1) * RB_SIZE, 8 * sw, c, qt, mu_r, mu_k, mu_v, kkw, kaw);
                if (ck + 2 < NCHUNK) rwkv_load(raw, PROJ, LW, AA, b, h, (ck + 2) * TC + 8 * sw, c); }
        } else {
            const LAS float* bp = buf + 4 * cg; const LAS float* vp = buf + RB_V + 4 * sw + r;
            f32x4 qkk[3], qw[3], qka[3], qk[3], qr[3]; float qv[3];
#pragma unroll
            for (int i = 0; i < 3; ++i) { qkk[i] = *(const LAS f32x4*)(bp + RB_KK + i * 64); qw[i] = *(const LAS f32x4*)(bp + RB_W + i * 64); qka[i] = *(const LAS f32x4*)(bp + RB_KA + i * 64);
                qk[i] = *(const LAS f32x4*)(bp + RB_K + i * 64); qr[i] = *(const LAS f32x4*)(bp + RB_R + i * 64); qv[i] = vp[i * 16]; }
            float op[16];
#pragma unroll
            for (int j = 0; j < TC; ++j) {
                const int u = j % 3;
                const f32x4 kk4 = qkk[u], w4 = qw[u], ka4 = qka[u], k4 = qk[u], r4 = qr[u]; const float vr = qv[u];
                const f32x2 tq = S01 * LO2(kk4) + S23 * HI2(kk4);
                const float sa = rowsum16(tq.x + tq.y);
                const f32x2 sav = {sa, sa}, vrv = {vr, vr};
                S01 = S01 * LO2(w4) + (vrv * LO2(k4) - sav * LO2(ka4));
                S23 = S23 * HI2(w4) + (vrv * HI2(k4) - sav * HI2(ka4));
                const f32x2 uq = S01 * LO2(r4) + S23 * HI2(r4);
                op[j & 15] = uq.x + uq.y;
                asm volatile("" : "+v"(S01), "+v"(S23) :: "memory");
                if (j + 3 < TC) { qkk[u] = *(const LAS f32x4*)(bp + RB_KK + (j + 3) * 64); qw[u] = *(const LAS f32x4*)(bp + RB_W + (j + 3) * 64); qka[u] = *(const LAS f32x4*)(bp + RB_KA + (j + 3) * 64);
                                  qk[u] = *(const LAS f32x4*)(bp + RB_K + (j + 3) * 64); qr[u] = *(const LAS f32x4*)(bp + RB_R + (j + 3) * 64); qv[u] = vp[(j + 3) * 16]; }
                if ((j & 15) == 15) {
                    const float ored = treduce16(op, cb0, cb1, cb2, cb3);
                    orow[(size_t)(ck * TC + (j - 15) + cg) * DM] = (bf16)(pk2(ored, 0.f) & 0xffffu);
                }
            }
        }
        __syncthreads();
    }
}

__device__ __forceinline__ void p4_scans(const Ctx& F) {
    for (int task = blockIdx.x; task < NB * RHEADS * 4; task += F.G) { rwkv_task(F, task); __syncthreads(); }
}

__device__ __forceinline__ void ld16(const float* p, float (&v)[16]) {
#pragma unroll
    for (int i = 0; i < 4; ++i) { const f32x4 t = *(const f32x4*)(p + 4 * i); v[4 * i] = t.x; v[4 * i + 1] = t.y; v[4 * i + 2] = t.z; v[4 * i + 3] = t.w; }
}
__device__ __forceinline__ void ldbf16x16(const bf16* p, float (&v)[16]) {
    float t0[8], t1[8]; unpack8(*(const v4u*)p, t0); unpack8(*(const v4u*)(p + 8), t1);
#pragma unroll
    for (int j = 0; j < 8; ++j) { v[j] = t0[j]; v[8 + j] = t1[j]; }
}
__device__ __forceinline__ void stbf16x16(bf16* p, const float (&v)[16]) {
    float t0[8], t1[8];
#pragma unroll
    for (int j = 0; j < 8; ++j) { t0[j] = v[j]; t1[j] = v[8 + j]; }
    *(v4u*)p = pack8(t0); *(v4u*)(p + 8) = pack8(t1);
}
__device__ __forceinline__ void p5_post(const Ctx& F) {
    const bf16* PROJ = (const bf16*)(F.ws + WS_PROJ); const bf16* AA = (const bf16*)(F.ws + WS_AA); const bf16* GG = (const bf16*)(F.ws + WS_GG);
    bf16* OY = (bf16*)(F.ws + WS_OY);
    const int c0 = 16 * F.lane;
    {
        float mur[16], muk[16], muv[16], ka[16], rk[16], lnw[16], lnb[16];
        ld16(F.in[I_MU] + C_R + c0, mur); ld16(F.in[I_MU] + C_K + c0, muk); ld16(F.in[I_MU] + C_V + c0, muv);
        ld16(F.in[I_KA] + c0, ka); ld16(F.in[I_RK] + c0, rk); ld16(F.in[I_LNW] + c0, lnw); ld16(F.in[I_LNB] + c0, lnb);
        for (int m = F.gw; m < M; m += F.NGW) {
            const bool first = (m % SEQ) == 0;
            const bf16* prow = PROJ + (size_t)m * INPP; bf16* oyrow = OY + (size_t)m * DM;
            float o[16], res[16]; float bs = 0.f;
            ldbf16x16(oyrow + c0, o);
            {
                float rc[16], rp[16], kc[16], kp[16], av[16];
                ldbf16x16(prow + C_R + c0, rc); ldbf16x16(prow + C_K + c0, kc); ldbf16x16(AA + (size_t)m * RW + c0, av);
                if (!first) { ldbf16x16(prow - INPP + C_R + c0, rp); ldbf16x16(prow - INPP + C_K + c0, kp); }
                else {
#pragma unroll
                    for (int j = 0; j < 16; ++j) { rp[j] = 0.f; kp[j] = 0.f; } }
#pragma unroll
                for (int j = 0; j < 16; ++j) { const float rr = rc[j] + (rp[j] - rc[j]) * mur[j], kx = kc[j] + (kp[j] - kc[j]) * muk[j];
                    bs += rr * (kx * (1.f + (av[j] - 1.f) * ka[j])) * rk[j]; }
            }
            bs = quadsum(bs);
            float s = 0.f;
#pragma unroll
            for (int j = 0; j < 16; ++j) s += o[j];
            const float mean = quadsum(s) * (1.f / 64.f);
            float qv = 0.f;
#pragma unroll
            for (int j = 0; j < 16; ++j) { o[j] -= mean; qv += o[j] * o[j]; }
            const float rstd = rsqrtf(quadsum(qv) * (1.f / 64.f) + 64e-5f);
            {
                float vc[16], vp[16], gv[16];
                ldbf16x16(prow + C_V + c0, vc); ldbf16x16(GG + (size_t)m * RW + c0, gv);
                if (!first) ldbf16x16(prow - INPP + C_V + c0, vp);
                else {
#pragma unroll
                    for (int j = 0; j < 16; ++j) vp[j] = 0.f; }
#pragma unroll
                for (int j = 0; j < 16; ++j) { const float vv = vc[j] + (vp[j] - vc[j]) * muv[j]; res[j] = (o[j] * rstd * lnw[j] + lnb[j] + bs * vv) * gv[j]; }
            }
            stbf16x16(oyrow + c0, res);
        }
    }
    {
        float nw[16]; ld16(F.in[I_MNW] + c0, nw);
        int m = F.gw;
        v4u yr[2], zr[2];
        if (m < M) { const bf16* prow = PROJ + (size_t)m * INPP; const bf16* oyrow = OY + (size_t)m * DM;
            yr[0] = *(const v4u*)(oyrow + RW + c0); yr[1] = *(const v4u*)(oyrow + RW + c0 + 8); zr[0] = *(const v4u*)(prow + C_Z + c0); zr[1] = *(const v4u*)(prow + C_Z + c0 + 8); }
        for (; m < M; m += F.NGW) {
            bf16* oyrow = OY + (size_t)m * DM;
            float y[16], z[16];
            { float t0[8], t1[8]; unpack8(yr[0], t0); unpack8(yr[1], t1);
#pragma unroll
              for (int j = 0; j < 8; ++j) { y[j] = t0[j]; y[8 + j] = t1[j]; }
              unpack8(zr[0], t0); unpack8(zr[1], t1);
#pragma unroll
              for (int j = 0; j < 8; ++j) { z[j] = t0[j]; z[8 + j] = t1[j]; } }
            { const int mn = (m + F.NGW < M) ? m + F.NGW : m; const bf16* prow = PROJ + (size_t)mn * INPP; const bf16* oyn = OY + (size_t)mn * DM;
              yr[0] = *(const v4u*)(oyn + RW + c0); yr[1] = *(const v4u*)(oyn + RW + c0 + 8); zr[0] = *(const v4u*)(prow + C_Z + c0); zr[1] = *(const v4u*)(prow + C_Z + c0 + 8); }
            asm volatile("" ::: "memory");
            float qv = 0.f;
#pragma unroll
            for (int j = 0; j < 16; ++j) { y[j] *= silu_f(z[j]); qv += y[j] * y[j]; }
            qv = rowsum16(qv);
            { auto rr = __builtin_amdgcn_permlane16_swap(__float_as_uint(qv), __float_as_uint(qv), false, false); qv = __uint_as_float(rr[0]) + __uint_as_float(rr[1]); }
            const float rstd = rsqrtf(qv * (1.f / 512.f) + 1e-5f);
#pragma unroll
            for (int j = 0; j < 16; ++j) y[j] = y[j] * rstd * nw[j];
            stbf16x16(oyrow + RW + c0, y);
        }
    }
}
constexpr int MC_L = 128, MC_NC = SEQ / MC_L, LSTR = 136;
constexpr int MT_BYTES = 128 * LSTR * 2;
constexpr size_t WS_ST = 876 * MiB, WS_SIN = 940 * MiB, WS_ATOT = 1004 * MiB, WS_END2 = 1005 * MiB;

__device__ __forceinline__ float mamba_dt_scan(const Ctx& F, const bf16* PROJ, int b, int c, int g, LAS float* DT, LAS float* ACS) {
    const int head = g * 8 + F.wave, lane = F.lane;
    const float dtb = F.in[I_DTB][head], Aneg = -__expf(F.in[I_ALOG][head]);
    const bf16* p = PROJ + (size_t)(b * SEQ + c * MC_L + 2 * lane) * INPP + C_DT + head;
    const float x0 = bf1(p[0]) + dtb, x1 = bf1(p[INPP]) + dtb;
    const float d0 = (x0 > 20.f) ? x0 : log1pf(__expf(x0)), d1 = (x1 > 20.f) ? x1 : log1pf(__expf(x1));
    const float s0 = d0 * Aneg, s1 = s0 + d1 * Aneg;
    float incl = s1;
#pragma unroll
    for (int o = 1; o < 64; o <<= 1) { const float t = __shfl_up(incl, o); if (lane >= o) incl += t; }
    const float excl = incl - s1;
    DT[F.wave * 128 + 2 * lane] = d0; DT[F.wave * 128 + 2 * lane + 1] = d1;
    ACS[F.wave * 128 + 2 * lane] = excl + s0; ACS[F.wave * 128 + 2 * lane + 1] = excl + s1;
    return __shfl(incl, 63);
}
struct TRaw { bf16 v[35]; };
__device__ __forceinline__ void mstage_T_load(TRaw& raw, const bf16* PROJ, int b, int c, int chn, int tid) {
    const int t0 = 32 * (tid >> 7);
    const bf16* base = PROJ + (size_t)(b * SEQ + c * MC_L + t0) * INPP + C_XBC + chn;
    if (c * MC_L + t0 > 0) { raw.v[0] = base[-3 * INPP]; raw.v[1] = base[-2 * INPP]; raw.v[2] = base[-1 * INPP]; }
    else { raw.v[0] = 0; raw.v[1] = 0; raw.v[2] = 0; }
#pragma unroll
    for (int t = 0; t < 32; ++t) raw.v[3 + t] = base[(size_t)t * INPP];
}
template <bool SC>
__device__ __forceinline__ void mstage_T_store(const TRaw& raw, int chn, LAS bf16* dst, const LAS float* scale, const float* convw, const float* convb, int tid) {
    const int f = tid & 127, t0 = 32 * (tid >> 7);
    const float w0 = convw[chn], w1 = convw[1536 + chn], w2 = convw[2 * 1536 + chn], w3 = convw[3 * 1536 + chn], bb = convb[chn];
#pragma unroll
    for (int i8 = 0; i8 < 4; ++i8) {
        float e[8];
#pragma unroll
        for (int i = 0; i < 8; ++i) { const int t = 8 * i8 + i;
            float v = silu_f(bb + w0 * bf1(raw.v[t]) + w1 * bf1(raw.v[t + 1]) + w2 * bf1(raw.v[t + 2]) + w3 * bf1(raw.v[t + 3]));
            if (SC) v *= scale[t0 + t];
            e[i] = v; }
        *(LAS v4u*)(dst + f * LSTR + t0 + 8 * i8) = pack8(e);
    }
}
__device__ __forceinline__ void mstage_N(const bf16* PROJ, int b, int c, int g, LAS bf16* Bn, LAS bf16* Cn, const float* convw, const float* convb, int tid) {
    const int f8 = tid & 31, t0 = 8 * (tid >> 5);
    const int chn = (f8 < 16) ? (1024 + g * 128 + 8 * f8) : (1280 + g * 128 + 8 * (f8 - 16));
    LAS bf16* dst = ((f8 < 16) ? Bn : Cn) + 8 * (f8 & 15);
    const bf16* base = PROJ + (size_t)(b * SEQ + c * MC_L + t0) * INPP + C_XBC + chn;
    float w[4][8], bb[8];
#pragma unroll
    for (int i = 0; i < 4; ++i) { const f32x4 a = *(const f32x4*)(convw + i * 1536 + chn), d = *(const f32x4*)(convw + i * 1536 + chn + 4);
        w[i][0] = a.x; w[i][1] = a.y; w[i][2] = a.z; w[i][3] = a.w; w[i][4] = d.x; w[i][5] = d.y; w[i][6] = d.z; w[i][7] = d.w; }
    { const f32x4 a = *(const f32x4*)(convb + chn), d = *(const f32x4*)(convb + chn + 4); bb[0] = a.x; bb[1] = a.y; bb[2] = a.z; bb[3] = a.w; bb[4] = d.x; bb[5] = d.y; bb[6] = d.z; bb[7] = d.w; }
    float r0[8], r1[8], r2[8];
    if (c * MC_L + t0 > 0) { unpack8(*(const v4u*)(base - 3 * INPP), r0); unpack8(*(const v4u*)(base - 2 * INPP), r1); unpack8(*(const v4u*)(base - 1 * INPP), r2); }
    else {
#pragma unroll
        for (int k = 0; k < 8; ++k) { r0[k] = 0.f; r1[k] = 0.f; r2[k] = 0.f; } }
#pragma unroll
    for (int t = 0; t < 8; ++t) {
        float r3[8], e[8]; unpack8(*(const v4u*)(base + (size_t)t * INPP), r3);
#pragma unroll
        for (int k = 0; k < 8; ++k) { e[k] = silu_f(bb[k] + w[0][k] * r0[k] + w[1][k] * r1[k] + w[2][k] * r2[k] + w[3][k] * r3[k]); r0[k] = r1[k]; r1[k] = r2[k]; r2[k] = r3[k]; }
        *(LAS v4u*)(dst + (t0 + t) * LSTR) = pack8(e);
    }
}

__device__ __forceinline__ void m1_chunk_states(const Ctx& F) {
    const bf16* PROJ = (const bf16*)(F.ws + WS_PROJ); bf16* ST = (bf16*)(F.ws + WS_ST); float* ATOT = (float*)(F.ws + WS_ATOT);
    LAS bf16* BT = (LAS bf16*)F.lds; LAS bf16* XT = (LAS bf16*)(F.lds + MT_BYTES);
    LAS float* DT = (LAS float*)(F.lds + 3 * MT_BYTES); LAS float* ACS = DT + 8 * 128; LAS float* SCL = ACS + 8 * 128;
    const float* convw = F.in[I_CONVW]; const float* convb = F.in[I_CONVB];
    const int tid = F.tid, w = F.wave, lane = F.lane, r16 = lane & 15, q = lane >> 4;
    for (int it = blockIdx.x; it < NB * MC_NC * 2; it += F.G) {
        const int g = it & 1, c = (it >> 1) & (MC_NC - 1), b = it >> 7;
        __syncthreads();
        const float atot = mamba_dt_scan(F, PROJ, b, c, g, DT, ACS);
        if (lane == 0) ATOT[(b * MC_NC + c) * 16 + g * 8 + w] = atot;
        const int chB = 1024 + g * 128 + (tid & 127);
        TRaw ra, rb;
        mstage_T_load(ra, PROJ, b, c, chB, tid);
        mstage_T_load(rb, PROJ, b, c, (g * 8 + ((tid & 127) >> 6)) * 64 + (tid & 63), tid);
        LDS_WAIT();
        SCL[w * 128 + 2 * lane] = DT[w * 128 + 2 * lane] * __expf(atot - ACS[w * 128 + 2 * lane]);
        SCL[w * 128 + 2 * lane + 1] = DT[w * 128 + 2 * lane + 1] * __expf(atot - ACS[w * 128 + 2 * lane + 1]);
        mstage_T_store<false>(ra, chB, BT, nullptr, convw, convb, tid);
        mstage_T_load(ra, PROJ, b, c, (g * 8 + 2 + ((tid & 127) >> 6)) * 64 + (tid & 63), tid);
        __syncthreads();
#pragma unroll
        for (int hb = 0; hb < 2; ++hb) {
            if (hb == 1) mstage_T_load(ra, PROJ, b, c, (g * 8 + 6 + ((tid & 127) >> 6)) * 64 + (tid & 63), tid);
            { const int hl = 4 * hb + ((tid & 127) >> 6); mstage_T_store<true>(rb, (g * 8 + hl) * 64 + (tid & 63), XT, SCL + hl * 128, convw, convb, tid); }
            if (hb == 0) mstage_T_load(rb, PROJ, b, c, (g * 8 + 4 + ((tid & 127) >> 6)) * 64 + (tid & 63), tid);
            { const int hl = 4 * hb + 2 + ((tid & 127) >> 6); mstage_T_store<true>(ra, (g * 8 + hl) * 64 + (tid & 63), XT + 128 * LSTR, SCL + hl * 128, convw, convb, tid); }
            __syncthreads();
            const int hh = w >> 1, ph = w & 1;
            f32x4 acc[2][8];
#pragma unroll
            for (int a = 0; a < 2; ++a)
#pragma unroll
                for (int n = 0; n < 8; ++n) acc[a][n] = (f32x4){0.f, 0.f, 0.f, 0.f};
#pragma unroll
            for (int ks = 0; ks < 4; ++ks) {
                bf16x8 xa[2];
#pragma unroll
                for (int a = 0; a < 2; ++a) xa[a] = *(const LAS bf16x8*)(XT + (hh * 64 + 32 * ph + 16 * a + r16) * LSTR + 32 * ks + 8 * q);
#pragma unroll
                for (int n = 0; n < 8; ++n) { const bf16x8 bfr = *(const LAS bf16x8*)(BT + (16 * n + r16) * LSTR + 32 * ks + 8 * q);
#pragma unroll
                    for (int a = 0; a < 2; ++a) acc[a][n] = __builtin_amdgcn_mfma_f32_16x16x32_bf16(bfr, xa[a], acc[a][n], 0, 0, 0); }
            }
            bf16* st = ST + ((size_t)((b * MC_NC + c) * 16 + g * 8 + 4 * hb + hh)) * (64 * 128);
#pragma unroll
            for (int a = 0; a < 2; ++a)
#pragma unroll
                for (int n = 0; n < 8; ++n) { v2u o; o.x = pk2(acc[a][n][0], acc[a][n][1]); o.y = pk2(acc[a][n][2], acc[a][n][3]);
                    *(v2u*)(st + (32 * ph + 16 * a + r16) * 128 + 16 * n + 4 * q) = o; }
            __syncthreads();
        }
    }
}

__device__ __forceinline__ void m2_prefix(const Ctx& F) {
    const bf16* ST = (const bf16*)(F.ws + WS_ST); bf16* SIN = (bf16*)(F.ws + WS_SIN); const float* ATOT = (const float*)(F.ws + WS_ATOT);
    const int nthr = F.G * NTHR;
    constexpr int GB = 16;
    constexpr size_t CST = (size_t)16 * 8192;
    for (int gi = blockIdx.x * NTHR + F.tid; gi < NB * 16 * 2048; gi += nthr) {
        const int e4 = gi & 2047, bh = gi >> 11, b = bh >> 4, h = bh & 15;
        const size_t o0 = ((size_t)(b * MC_NC) * 16 + h) * 8192 + 4 * e4;
        const float* at = ATOT + (b * MC_NC) * 16 + h;
        float r0 = 0.f, r1 = 0.f, r2 = 0.f, r3 = 0.f;
        v2u sv[GB]; float dv[GB];
#pragma unroll
        for (int i = 0; i < GB; ++i) { sv[i] = *(const v2u*)(ST + o0 + (size_t)i * CST); dv[i] = at[i * 16]; }
#pragma unroll 1
        for (int c0 = 0; c0 < MC_NC; c0 += GB) {
            const int cn = (c0 + GB < MC_NC) ? c0 + GB : c0;
            v2u svn[GB]; float dvn[GB];
#pragma unroll
            for (int i = 0; i < GB; ++i) { svn[i] = *(const v2u*)(ST + o0 + (size_t)(cn + i) * CST); dvn[i] = at[(cn + i) * 16]; }
            asm volatile("" ::: "memory");
#pragma unroll
            for (int i = 0; i < GB; ++i) {
                v2u so; so.x = pk2(r0, r1); so.y = pk2(r2, r3);
                *(v2u*)(SIN + o0 + (size_t)(c0 + i) * CST) = so;
                const float d = __expf(dv[i]);
                r0 = r0 * d + bflo(sv[i].x); r1 = r1 * d + bfhi(sv[i].x); r2 = r2 * d + bflo(sv[i].y); r3 = r3 * d + bfhi(sv[i].y);
            }
#pragma unroll
            for (int i = 0; i < GB; ++i) { sv[i] = svn[i]; dv[i] = dvn[i]; }
        }
    }
}

__device__ __forceinline__ void m3_outputs(const Ctx& F) {
    const bf16* PROJ = (const bf16*)(F.ws + WS_PROJ); const bf16* SIN = (const bf16*)(F.ws + WS_SIN); bf16* OY = (bf16*)(F.ws + WS_OY);
    LAS bf16* Cn = (LAS bf16*)F.lds; LAS bf16* RB = (LAS bf16*)(F.lds + MT_BYTES);
    LAS bf16* Mw = (LAS bf16*)(F.lds + 2 * MT_BYTES) + F.wave * 16 * LSTR;
    LAS float* DT = (LAS float*)(F.lds + 3 * MT_BYTES); LAS float* ACS = DT + 8 * 128;
    const float* convw = F.in[I_CONVW]; const float* convb = F.in[I_CONVB];
    const int tid = F.tid, w = F.wave, lane = F.lane, r16 = lane & 15, q = lane >> 4;
    for (int it = blockIdx.x; it < NB * MC_NC * 2; it += F.G) {
        const int g = it & 1, c = (it >> 1) & (MC_NC - 1), b = it >> 7;
        __syncthreads();
        (void)mamba_dt_scan(F, PROJ, b, c, g, DT, ACS);
        mstage_N(PROJ, b, c, g, RB, Cn, convw, convb, tid);
        __syncthreads();
        TRaw rx;
        mstage_T_load(rx, PROJ, b, c, (g * 8 + ((tid & 127) >> 6)) * 64 + (tid & 63), tid);
        bf16x8 cf[4];
#pragma unroll
        for (int ks = 0; ks < 4; ++ks) cf[ks] = *(const LAS bf16x8*)(Cn + (16 * w + r16) * LSTR + 32 * ks + 8 * q);
        f32x4 Gt[8];
#pragma unroll
        for (int nt = 0; nt < 8; ++nt) { Gt[nt] = (f32x4){0.f, 0.f, 0.f, 0.f};
#pragma unroll
            for (int ks = 0; ks < 4; ++ks) Gt[nt] = __builtin_amdgcn_mfma_f32_16x16x32_bf16(*(const LAS bf16x8*)(RB + (16 * nt + r16) * LSTR + 32 * ks + 8 * q), cf[ks], Gt[nt], 0, 0, 0); }
        const int l = 16 * w + r16;
        const size_t mrow = (size_t)(b * SEQ + c * MC_L + l);
#pragma unroll 1
        for (int hb = 0; hb < 4; ++hb) {
            __syncthreads();
            { const int hl = 2 * hb + ((tid & 127) >> 6); mstage_T_store<false>(rx, (g * 8 + hl) * 64 + (tid & 63), RB, nullptr, convw, convb, tid); }
            { const int hn = (hb < 3) ? 2 * (hb + 1) : 2 * hb; mstage_T_load(rx, PROJ, b, c, (g * 8 + hn + ((tid & 127) >> 6)) * 64 + (tid & 63), tid); }
            __syncthreads();
#pragma unroll 1
            for (int h2 = 0; h2 < 2; ++h2) {
                const int hl = 2 * hb + h2, head = g * 8 + hl;
                const float acs_l = ACS[hl * 128 + l];
                const bf16* sin = SIN + ((size_t)((b * MC_NC + c) * 16 + head)) * 8192;
                bf16x8 sf[4][4];
#pragma unroll
                for (int pt = 0; pt < 4; ++pt)
#pragma unroll
                    for (int ks = 0; ks < 4; ++ks) sf[pt][ks] = *(const bf16x8*)(sin + (16 * pt + r16) * 128 + 32 * ks + 8 * q);
#pragma unroll
                for (int nt = 0; nt < 8; ++nt) { const f32x4 as = *(const LAS f32x4*)(ACS + hl * 128 + 16 * nt + 4 * q), ds = *(const LAS f32x4*)(DT + hl * 128 + 16 * nt + 4 * q);
                    float mv[4];
#pragma unroll
                    for (int j = 0; j < 4; ++j) { const int s = 16 * nt + 4 * q + j; mv[j] = (s <= l) ? Gt[nt][j] * __expf(acs_l - as[j]) * ds[j] : 0.f; }
                    v2u o; o.x = pk2(mv[0], mv[1]); o.y = pk2(mv[2], mv[3]);
                    *(LAS v2u*)(Mw + r16 * LSTR + 16 * nt + 4 * q) = o; }
                LDS_WAIT(); asm volatile("" ::: "memory");
                bf16x8 mf[4];
#pragma unroll
                for (int ks = 0; ks < 4; ++ks) mf[ks] = *(const LAS bf16x8*)(Mw + r16 * LSTR + 32 * ks + 8 * q);
                const float el = __expf(acs_l), Dh = F.in[I_DSK][head];
#pragma unroll
                for (int pt = 0; pt < 4; ++pt) {
                    f32x4 yd = {0.f, 0.f, 0.f, 0.f}, yo = {0.f, 0.f, 0.f, 0.f};
#pragma unroll
                    for (int ks = 0; ks < 4; ++ks) {
                        yd = __builtin_amdgcn_mfma_f32_16x16x32_bf16(*(const LAS bf16x8*)(RB + (h2 * 64 + 16 * pt + r16) * LSTR + 32 * ks + 8 * q), mf[ks], yd, 0, 0, 0);
                        yo = __builtin_amdgcn_mfma_f32_16x16x32_bf16(sf[pt][ks], cf[ks], yo, 0, 0, 0); }
                    float yv[4];
#pragma unroll
                    for (int j = 0; j < 4; ++j) yv[j] = yd[j] + el * yo[j] + Dh * bf1(RB[(h2 * 64 + 16 * pt + 4 * q + j) * LSTR + l]);
                    v2u o; o.x = pk2(yv[0], yv[1]); o.y = pk2(yv[2], yv[3]);
                    *(v2u*)(OY + mrow * DM + RW + head * 64 + 16 * pt + 4 * q) = o;
                }
                asm volatile("" ::: "memory");
            }
        }
    }
}
constexpr int RC = 16, RNCH = SEQ / RC, NPART = 4, RHALF = RNCH / NPART, RITEMS = NB * RHEADS * RHALF;
constexpr size_t RO_WH = 0, RO_RH = 16 * MiB, RO_VT = 32 * MiB, RO_ET = 48 * MiB, RO_OL = 64 * MiB, RO_A2 = 80 * MiB, RO_GC = 112 * MiB, RO_BUF = 116 * MiB, RO_SS = 232 * MiB;
constexpr int RL_KAP = 0, RL_ALP = 2304, RL_KT = 4608, RL_RT = 6912, RL_KAPT = 9216, RL_VT = 11264, RL_TB = 13312, RL_BL = 14336, RL_QL = 15360, RL_PL = 16384,
              RL_WT = RL_KAP, RL_BVT = RL_ALP, RL_AL32 = RL_KT, RL_ET = RL_KT,
              RL_BYTES = 18176;
constexpr int XS = 72, TS = 16, SS16 = 32;

__device__ __forceinline__ float wave_sum_pl(float x) {
    x = rowsum16(x);
    { auto rr = __builtin_amdgcn_permlane16_swap(__float_as_uint(x), __float_as_uint(x), false, false); x = __uint_as_float(rr[0]) + __uint_as_float(rr[1]); }
    { auto rr = __builtin_amdgcn_permlane32_swap(__float_as_uint(x), __float_as_uint(x), false, false); x = __uint_as_float(rr[0]) + __uint_as_float(rr[1]); }
    return x;
}
__device__ __forceinline__ v2u pack4(const f32x4 a) { v2u o; o.x = pk2(a[0], a[1]); o.y = pk2(a[2], a[3]); return o; }
__device__ __forceinline__ f32x4 unpack4(const v2u u) { return (f32x4){bflo(u.x), bfhi(u.x), bflo(u.y), bfhi(u.y)}; }
__device__ __forceinline__ bf16 f2b(float x) { return (bf16)pk2(x, 0.f); }

__device__ __forceinline__ void ra_item(const Ctx& F, LAS unsigned char* wl, int it, int half) {
    const int bh = it / RHALF, cl = it - bh * RHALF, ci = half * RHALF + cl, b = bh >> 4, h = bh & 15;
    const bf16* PROJ = (const bf16*)(F.ws + WS_PROJ); const bf16* LW = (const bf16*)(F.ws + WS_LW); const bf16* AA = (const bf16*)(F.ws + WS_AA);
    unsigned char* RO = (unsigned char*)F.out + (size_t)(half & 1) * RO_BUF;
    const int lane = F.lane, r16 = lane & 15, q = lane >> 4, c = lane, ch = h * 64 + c;
    const size_t m0 = (size_t)b * SEQ + (size_t)RC * ci;
    LAS bf16* KAP = (LAS bf16*)(wl + RL_KAP); LAS bf16* ALP = (LAS bf16*)(wl + RL_ALP); LAS bf16* KT = (LAS bf16*)(wl + RL_KT); LAS bf16* RT = (LAS bf16*)(wl + RL_RT);
    LAS bf16* KAPT = (LAS bf16*)(wl + RL_KAPT); LAS bf16* VTL = (LAS bf16*)(wl + RL_VT); LAS bf16* WT = (LAS bf16*)(wl + RL_WT); LAS bf16* BVT = (LAS bf16*)(wl + RL_BVT); LAS bf16* ETL = (LAS bf16*)(wl + RL_ET);
    LAS bf16* TB = (LAS bf16*)(wl + RL_TB); LAS bf16* BL = (LAS bf16*)(wl + RL_BL); LAS bf16* QL = (LAS bf16*)(wl + RL_QL); LAS bf16* PL = (LAS bf16*)(wl + RL_PL);
    const float mu_r = F.in[I_MU][C_R + ch], mu_k = F.in[I_MU][C_K + ch], mu_v = F.in[I_MU][C_V + ch], kkw = F.in[I_KK][ch], kaw = F.in[I_KA][ch];
    const bf16* prow = PROJ + m0 * INPP + ch;
    float rp = 0.f, kp = 0.f, vp = 0.f;
    if (ci > 0) { rp = bf1(prow[-INPP + C_R]); kp = bf1(prow[-INPP + C_K]); vp = bf1(prow[-INPP + C_V]); }
    float ec = 1.f, kkna[RC], kpv[RC], env[RC], vvv[RC];
    float cum = 0.f;
#pragma unroll
    for (int t = 0; t < RC; ++t) {
        const bf16* row = prow + (size_t)t * INPP;
        const float rc = bf1(row[C_R]), kc = bf1(row[C_K]), vc = bf1(row[C_V]);
        const float a = bf1(AA[(m0 + t) * RW + ch]), lw = bf1(LW[(m0 + t) * RW + ch]);
        const float rr = rc + (rp - rc) * mu_r, kx = kc + (kp - kc) * mu_k, vv = vc + (vp - vc) * mu_v;
        rp = rc; kp = kc; vp = vc;
        const float kkraw = kx * kkw; const float ss = wave_sum_pl(kkraw * kkraw);
        const float kkn = kkraw * rcp_f(fmaxf(sqrtf(ss), 1e-12f));
        const float kpp = kx * (1.f + (a - 1.f) * kaw);
        const float ep = ec; cum += lw; ec = __expf(cum); const float en = rcp_f(ec);
        const unsigned p0 = pk2(kkn * ep, kkn * a * en), p1 = pk2(kpp * en, rr * ec), p2 = pk2(vv, 0.f);
        KAP[t * XS + c] = (bf16)p0; ALP[t * XS + c] = (bf16)(p0 >> 16); KT[t * XS + c] = (bf16)p1; RT[t * XS + c] = (bf16)(p1 >> 16);
        KAPT[c * TS + t] = (bf16)p0; VTL[c * TS + t] = (bf16)p2;
        kkna[t] = kkn * a; kpv[t] = kpp; env[t] = en; vvv[t] = vv;
    }
    {
        float e8[8]; v4u* vt = (v4u*)((bf16*)(RO + RO_VT) + (size_t)it * 1024 + c * 16);
#pragma unroll
        for (int i = 0; i < 8; ++i) e8[i] = vvv[i];
        vt[0] = pack8(e8);
#pragma unroll
        for (int i = 0; i < 8; ++i) e8[i] = vvv[8 + i];
        vt[1] = pack8(e8);
        v4u* a2 = (v4u*)((bf16*)(RO + RO_A2) + (size_t)it * 2048 + c * 32);
        float dd[RC];
#pragma unroll
        for (int t = 0; t < RC; ++t) dd[t] = ec * env[t];
#pragma unroll
        for (int i = 0; i < 8; ++i) e8[i] = -kkna[i] * dd[i];
        a2[0] = pack8(e8);
#pragma unroll
        for (int i = 0; i < 8; ++i) e8[i] = -kkna[8 + i] * dd[8 + i];
        a2[1] = pack8(e8);
#pragma unroll
        for (int i = 0; i < 8; ++i) e8[i] = kpv[i] * dd[i];
        a2[2] = pack8(e8);
#pragma unroll
        for (int i = 0; i < 8; ++i) e8[i] = kpv[8 + i] * dd[8 + i];
        a2[3] = pack8(e8);
        ((float*)(RO + RO_GC))[(size_t)it * 64 + c] = ec;
    }
    LDS_WAIT(); asm volatile("" ::: "memory");
    const v2u zero2 = {0u, 0u};
    {
        f32x4 alt = {0.f, 0.f, 0.f, 0.f}, blt = alt, qlt = alt, plt = alt;
#pragma unroll
        for (int ks = 0; ks < 2; ++ks) {
            const bf16x8 fa = *(const LAS bf16x8*)(ALP + r16 * XS + 32 * ks + 8 * q), fk = *(const LAS bf16x8*)(KT + r16 * XS + 32 * ks + 8 * q);
            const bf16x8 fkp = *(const LAS bf16x8*)(KAP + r16 * XS + 32 * ks + 8 * q), fr = *(const LAS bf16x8*)(RT + r16 * XS + 32 * ks + 8 * q);
            alt = __builtin_amdgcn_mfma_f32_16x16x32_bf16(fa, fkp, alt, 0, 0, 0); blt = __builtin_amdgcn_mfma_f32_16x16x32_bf16(fk, fkp, blt, 0, 0, 0);
            qlt = __builtin_amdgcn_mfma_f32_16x16x32_bf16(fa, fr, qlt, 0, 0, 0);  plt = __builtin_amdgcn_mfma_f32_16x16x32_bf16(fk, fr, plt, 0, 0, 0);
        }
#pragma unroll
        for (int j = 0; j < 4; ++j) { const int s = 4 * q + j; const bool lt = s < r16, le = s <= r16;
            alt[j] = lt ? alt[j] : 0.f; blt[j] = lt ? blt[j] : 0.f; qlt[j] = le ? qlt[j] : 0.f; plt[j] = le ? plt[j] : 0.f; }
        *(LAS v2u*)(BL + r16 * SS16 + 4 * q) = pack4(blt); *(LAS v2u*)(QL + r16 * SS16 + 4 * q) = pack4(qlt); *(LAS v2u*)(PL + r16 * SS16 + 4 * q) = pack4(plt);
        *(LAS v2u*)(BL + r16 * SS16 + 16 + 4 * q) = zero2; *(LAS v2u*)(QL + r16 * SS16 + 16 + 4 * q) = zero2; *(LAS v2u*)(PL + r16 * SS16 + 16 + 4 * q) = zero2;
        float x[RC];
#pragma unroll
        for (int t = 0; t < RC; ++t) {
            float acc = (t == r16) ? 1.f : 0.f;
#pragma unroll
            for (int s2 = 0; s2 < t; ++s2) { const float a_ts = __uint_as_float(__builtin_amdgcn_readlane(__float_as_uint(alt[s2 & 3]), 16 * (s2 >> 2) + t)); acc -= a_ts * x[s2]; }
            x[t] = acc;
        }
        if (q == 0) {
#pragma unroll
            for (int t = 0; t < RC; ++t) { TB[t * SS16 + r16] = f2b(x[t]); TB[t * SS16 + 16 + r16] = 0; }
        }
    }
    LDS_WAIT(); asm volatile("" ::: "memory");
    const bf16x8 zf = {0, 0, 0, 0, 0, 0, 0, 0};
    const bf16x8 tbf = *(const LAS bf16x8*)(TB + r16 * SS16 + 8 * q), blf = *(const LAS bf16x8*)(BL + r16 * SS16 + 8 * q);
    const bf16x8 qlf = *(const LAS bf16x8*)(QL + r16 * SS16 + 8 * q), plf = *(const LAS bf16x8*)(PL + r16 * SS16 + 8 * q);
    const f32x4 z4 = {0.f, 0.f, 0.f, 0.f};
    bf16* gWH = (bf16*)(RO + RO_WH) + (size_t)it * 1024; bf16* gRH = (bf16*)(RO + RO_RH) + (size_t)it * 1024;
    bf16* gET = (bf16*)(RO + RO_ET) + (size_t)it * 1024; bf16* gOL = (bf16*)(RO + RO_OL) + (size_t)it * 1024;
#pragma unroll
    for (int kt = 0; kt < 4; ++kt) {
        const bf16x8 kf = (q < 2) ? *(const LAS bf16x8*)(KAPT + (16 * kt + r16) * TS + 8 * q) : zf;
        const f32x4 wa = __builtin_amdgcn_mfma_f32_16x16x32_bf16(kf, tbf, z4, 0, 0, 0);
        *(v2u*)(gWH + r16 * 64 + 16 * kt + 4 * q) = pack4(wa);
        const f32x4 wb = __builtin_amdgcn_mfma_f32_16x16x32_bf16(tbf, kf, z4, 0, 0, 0);
        *(LAS v2u*)(WT + (16 * kt + r16) * TS + 4 * q) = pack4(wb);
        const bf16x8 vf = (q < 2) ? *(const LAS bf16x8*)(VTL + (16 * kt + r16) * TS + 8 * q) : zf;
        const f32x4 bv = __builtin_amdgcn_mfma_f32_16x16x32_bf16(blf, vf, z4, 0, 0, 0);
        *(LAS v2u*)(BVT + (16 * kt + r16) * TS + 4 * q) = pack4(bv);
    }
    LDS_WAIT(); asm volatile("" ::: "memory");
#pragma unroll
    for (int vt = 0; vt < 4; ++vt) {
        const bf16x8 bf_ = (q < 2) ? *(const LAS bf16x8*)(BVT + (16 * vt + r16) * TS + 8 * q) : zf;
        const f32x4 e4 = __builtin_amdgcn_mfma_f32_16x16x32_bf16(tbf, bf_, z4, 0, 0, 0);
        const v2u ep = pack4(e4);
        *(LAS v2u*)(ETL + (16 * vt + r16) * TS + 4 * q) = ep; *(v2u*)(gET + (16 * vt + r16) * 16 + 4 * q) = ep;
    }
    LDS_WAIT(); asm volatile("" ::: "memory");
#pragma unroll
    for (int kt = 0; kt < 4; ++kt) {
        const bf16x8 wf = (q < 2) ? *(const LAS bf16x8*)(WT + (16 * kt + r16) * TS + 8 * q) : zf;
        const f32x4 qw = __builtin_amdgcn_mfma_f32_16x16x32_bf16(wf, qlf, z4, 0, 0, 0);
        const f32x4 rt4 = unpack4(*(const LAS v2u*)(RT + r16 * XS + 16 * kt + 4 * q));
        *(v2u*)(gRH + r16 * 64 + 16 * kt + 4 * q) = pack4(rt4 - qw);
        const bf16x8 vf = (q < 2) ? *(const LAS bf16x8*)(VTL + (16 * kt + r16) * TS + 8 * q) : zf;
        const bf16x8 ef = (q < 2) ? *(const LAS bf16x8*)(ETL + (16 * kt + r16) * TS + 8 * q) : zf;
        const f32x4 pv = __builtin_amdgcn_mfma_f32_16x16x32_bf16(vf, plf, z4, 0, 0, 0);
        const f32x4 qe = __builtin_amdgcn_mfma_f32_16x16x32_bf16(ef, qlf, z4, 0, 0, 0);
        *(v2u*)(gOL + r16 * 64 + 16 * kt + 4 * q) = pack4(pv - qe);
    }
    LDS_WAIT(); asm volatile("" ::: "memory");
}
__device__ __forceinline__ void ra_part(const Ctx& F, int part) {
    LAS unsigned* ctr = (LAS unsigned*)(F.lds + LDS_BYTES - 48) + part;
    LAS unsigned char* wl = F.lds + F.wave * RL_BYTES;
    for (;;) {
        unsigned idx = 0;
        if (F.lane == 0) idx = __hip_atomic_fetch_add(ctr, 1u, __ATOMIC_RELAXED, __HIP_MEMORY_SCOPE_WORKGROUP);
        idx = (unsigned)__builtin_amdgcn_readfirstlane((int)idx);
        const int it = (int)blockIdx.x + F.G * (int)idx;
        if (it >= RITEMS) break;
        ra_item(F, wl, it, part);
    }
}

__device__ __forceinline__ void rs_half(const Ctx& F, int half) {
    if (F.wave != 0) return;
    const unsigned char* RO = (const unsigned char*)F.out + (size_t)(half & 1) * RO_BUF; bf16* OY = (bf16*)(F.ws + WS_OY);
    float* SSg = (float*)((unsigned char*)F.out + RO_SS);
    LAS bf16* ST = (LAS bf16*)F.lds;
    LAS bf16* ZT = (LAS bf16*)(F.lds + 16 * XS * 2);
    constexpr int ZS = 24;
    const int lane = F.lane, r16 = lane & 15, q = lane >> 4;
    for (int blk = blockIdx.x; blk < NB * RHEADS * 4; blk += F.G) {
        const int xcd = blk & 7, jj = blk >> 3, qt = jj & 3, bh = (jj >> 2) * 8 + xcd, b = bh >> 4, h = bh & 15;
        f32x4 S[4];
        if (half == 0) {
#pragma unroll
            for (int kt = 0; kt < 4; ++kt) S[kt] = (f32x4){0.f, 0.f, 0.f, 0.f};
        } else {
#pragma unroll
            for (int kt = 0; kt < 4; ++kt) S[kt] = *(const f32x4*)(SSg + (size_t)blk * 1024 + (kt * 64 + lane) * 4);
        }
#pragma unroll
        for (int kt = 0; kt < 4; ++kt) *(LAS v2u*)(ST + r16 * XS + 16 * kt + 4 * q) = pack4(S[kt]);
        LDS_WAIT(); asm volatile("" ::: "memory");
        const size_t it0 = (size_t)bh * RHALF;
        const size_t mbase = (size_t)b * SEQ + (size_t)half * RHALF * RC;
#define RS_LOAD(IT, WF, RF, A2F, VF, ET4, OL4, GC4) do { const size_t it_ = (IT); \
        const bf16* wh_ = (const bf16*)(RO + RO_WH) + it_ * 1024 + r16 * 64 + 8 * q; const bf16* rh_ = (const bf16*)(RO + RO_RH) + it_ * 1024 + r16 * 64 + 8 * q; \
        WF[0] = *(const bf16x8*)wh_; WF[1] = *(const bf16x8*)(wh_ + 32); RF[0] = *(const bf16x8*)rh_; RF[1] = *(const bf16x8*)(rh_ + 32); \
        _Pragma("unroll") for (int kt_ = 0; kt_ < 4; ++kt_) { A2F[kt_] = *(const bf16x8*)((const bf16*)(RO + RO_A2) + it_ * 2048 + (16 * kt_ + r16) * 32 + 8 * q); \
            GC4[kt_] = *(const f32x4*)((const float*)(RO + RO_GC) + it_ * 64 + 16 * kt_ + 4 * q); } \
        VF = *(const bf16x8*)((const bf16*)(RO + RO_VT) + it_ * 1024 + (16 * qt + r16) * 16 + 8 * (q & 1)); \
        ET4 = *(const v2u*)((const bf16*)(RO + RO_ET) + it_ * 1024 + (16 * qt + r16) * 16 + 4 * q); \
        OL4 = *(const v2u*)((const bf16*)(RO + RO_OL) + it_ * 1024 + r16 * 64 + 16 * qt + 4 * q); } while (0)
        bf16x8 wfq[2][2], rfq[2][2], a2q[2][4], vfq[2]; v2u etq[2], olq[2]; f32x4 gcq[2][4];
#pragma unroll
        for (int u = 0; u < 2; ++u) RS_LOAD(it0 + u, wfq[u], rfq[u], a2q[u], vfq[u], etq[u], olq[u], gcq[u]);
#define RS_STEP(U, CL) do { const int cl_ = (CL); \
            const bf16x8 sb0 = *(const LAS bf16x8*)(ST + r16 * XS + 8 * q), sb1 = *(const LAS bf16x8*)(ST + r16 * XS + 32 + 8 * q); \
            f32x4 x1 = __builtin_amdgcn_mfma_f32_16x16x32_bf16(wfq[U][0], sb0, (f32x4){0.f, 0.f, 0.f, 0.f}, 0, 0, 0); \
            x1 = __builtin_amdgcn_mfma_f32_16x16x32_bf16(wfq[U][1], sb1, x1, 0, 0, 0); \
            f32x4 ot = __builtin_amdgcn_mfma_f32_16x16x32_bf16(sb0, rfq[U][0], unpack4(olq[U]), 0, 0, 0); \
            ot = __builtin_amdgcn_mfma_f32_16x16x32_bf16(sb1, rfq[U][1], ot, 0, 0, 0); \
            *(LAS v2u*)(ZT + r16 * ZS + 4 * q) = pack4(x1 + unpack4(etq[U])); \
            *(v2u*)(OY + (mbase + (size_t)cl_ * RC + r16) * DM + h * 64 + 16 * qt + 4 * q) = pack4(ot); \
            LDS_WAIT(); asm volatile("" ::: "memory"); \
            const bf16x8 zr = *(const LAS bf16x8*)(ZT + r16 * ZS + 8 * (q & 1)); \
            const bf16x8 bz = (q < 2) ? zr : vfq[U]; \
            _Pragma("unroll") for (int kt = 0; kt < 4; ++kt) { S[kt] = __builtin_amdgcn_mfma_f32_16x16x32_bf16(a2q[U][kt], bz, S[kt] * gcq[U][kt], 0, 0, 0); \
                *(LAS v2u*)(ST + r16 * XS + 16 * kt + 4 * q) = pack4(S[kt]); } \
            RS_LOAD(it0 + ((cl_ + 2 < RHALF) ? cl_ + 2 : RHALF - 1), wfq[U], rfq[U], a2q[U], vfq[U], etq[U], olq[U], gcq[U]);     \
            LDS_WAIT(); asm volatile("" ::: "memory"); } while (0)
#pragma unroll 1
        for (int cl = 0; cl < RHALF; cl += 2) { RS_STEP(0, cl); RS_STEP(1, cl + 1); }
#undef RS_STEP
#undef RS_LOAD
        if (half + 1 < NPART) {
#pragma unroll
            for (int kt = 0; kt < 4; ++kt) *(f32x4*)(SSg + (size_t)blk * 1024 + (kt * 64 + lane) * 4) = S[kt];
        }
    }
}
__device__ __forceinline__ float rowmax16(float x) { x = fmaxf(x, dpp_f<0xB1>(x)); x = fmaxf(x, dpp_f<0x4E>(x)); x = fmaxf(x, dpp_f<0x124>(x)); x = fmaxf(x, dpp_f<0x128>(x)); return x; }
__device__ __forceinline__ int cand_code(int s) {
    if (s < 16) return s << 4;
    if (s < 24) return 1 | ((s - 16) << 4);
    if (s < 29) return 2 | ((s - 24) << 4);
    if (s < 33) return 3 | ((s - 29) << 4);
    if (s < 36) return 4 | ((s - 33) << 4);
    if (s < 42) { const int k = s - 36; return (5 + (k >> 1)) | ((k & 1) << 4); }
    if (s < 50) return 8 + (s - 42);
    return -1;
}
__device__ __forceinline__ int f2ord(float f) { const int b = __float_as_int(f); return b ^ ((b >> 31) & 0x7fffffff); }
__device__ __forceinline__ float ord2f(int k) { return __int_as_float(k ^ ((k >> 31) & 0x7fffffff)); }
template <int CTRL> __device__ __forceinline__ int dpp_i(int x) { return __builtin_amdgcn_mov_dpp(x, CTRL, 0xf, 0xf, true); }
__device__ __forceinline__ int imax(int a, int b) { return a > b ? a : b; }
__device__ __forceinline__ int imin(int a, int b) { return a < b ? a : b; }
__device__ __forceinline__ int rowmax16_i(int x) { x = imax(x, dpp_i<0xB1>(x)); x = imax(x, dpp_i<0x4E>(x)); x = imax(x, dpp_i<0x124>(x)); x = imax(x, dpp_i<0x128>(x)); return x; }
#define CSWAP_(a, b) do { const int hi_ = imax(a, b), lo_ = imin(a, b); a = hi_; b = lo_; } while (0)
template <int NV> __device__ __forceinline__ void sort_desc(int (&v)[NV]);
template <> __device__ __forceinline__ void sort_desc<8>(int (&v)[8]) {
    CSWAP_(v[0], v[1]); CSWAP_(v[2], v[3]); CSWAP_(v[4], v[5]); CSWAP_(v[6], v[7]);
    CSWAP_(v[0], v[2]); CSWAP_(v[1], v[3]); CSWAP_(v[4], v[6]); CSWAP_(v[5], v[7]);
    CSWAP_(v[1], v[2]); CSWAP_(v[5], v[6]);
    CSWAP_(v[0], v[4]); CSWAP_(v[1], v[5]); CSWAP_(v[2], v[6]); CSWAP_(v[3], v[7]);
    CSWAP_(v[2], v[4]); CSWAP_(v[3], v[5]);
    CSWAP_(v[1], v[2]); CSWAP_(v[3], v[4]); CSWAP_(v[5], v[6]);
}
template <> __device__ __forceinline__ void sort_desc<4>(int (&v)[4]) {
    CSWAP_(v[0], v[1]); CSWAP_(v[2], v[3]); CSWAP_(v[0], v[2]); CSWAP_(v[1], v[3]); CSWAP_(v[1], v[2]);
}
template <int NV>
__device__ __forceinline__ void select16x4(int (&v)[4][NV], int r16, float (&kept_f)[4]) {
    const int IMIN = (int)0x80000000;
    int kept[4];
#pragma unroll
    for (int j = 0; j < 4; ++j) { kept[j] = IMIN; sort_desc<NV>(v[j]); }
#pragma unroll 1
    for (int rd = 0; rd < 16; ++rd) {
#pragma unroll
        for (int j = 0; j < 4; ++j) {
            const int m = rowmax16_i(v[j][0]);
            kept[j] = (r16 == rd) ? m : kept[j];
            const bool own = (v[j][0] == m);
#pragma unroll
            for (int i = 0; i < NV - 1; ++i) v[j][i] = own ? v[j][i + 1] : v[j][i];
            v[j][NV - 1] = own ? IMIN : v[j][NV - 1];
        }
    }
#pragma unroll
    for (int j = 0; j < 4; ++j) kept_f[j] = ord2f(kept[j]);
}
__device__ __forceinline__ float dot2bf(unsigned a, unsigned b, float acc) { return __builtin_amdgcn_fdot2_f32_bf16(__builtin_bit_cast(bf16x2_t, a), __builtin_bit_cast(bf16x2_t, b), acc, false); }

constexpr int PT = 16;
constexpr size_t RANGE_BYTES = (size_t)NEXP * 128;

__device__ __forceinline__ void p9_route(const Ctx& F) {
    constexpr int KSTR = 136;
    const bf16* Q = (const bf16*)(F.ws + WS_Q); const bf16* KEYS = (const bf16*)(F.ws + WS_KEYS);
    int* rtE = (int*)(F.ws + WS_RTE); float* rtG = (float*)(F.ws + WS_RTG);
    LAS bf16* KL = (LAS bf16*)F.lds;
    const int lane = F.lane, w = F.wave, r16 = lane & 15, q = lane >> 4, gbase = lane & 48;
    const int h = blockIdx.x & 7, nbh = (F.G - h + 7) >> 3;
    __syncthreads();
    for (int i = F.tid; i < 2 * 128 * 16; i += NTHR) { const int row = i >> 4, ch = i & 15;
        *(LAS v4u*)(KL + row * KSTR + 8 * ch) = *(const v4u*)(KEYS + (size_t)(2 * h * 128 + row) * 128 + 8 * ch); }
    __syncthreads();
    int ci[4], cj[4]; bool cvalid[4];
#pragma unroll
    for (int u = 0; u < 4; ++u) { const int cd = cand_code(r16 + 16 * u); cvalid[u] = cd >= 0; ci[u] = cd & 15; cj[u] = (cd >> 4) & 15; }
    const float NINF = -__builtin_inff();
    const int tstride = nbh * NWAVES;
    int tile = (blockIdx.x >> 3) * NWAVES + w;
    bf16x8 afn[2][4];
    if (tile < M / PT) {
#pragma unroll
        for (int p = 0; p < 2; ++p)
#pragma unroll
            for (int s = 0; s < 4; ++s) afn[p][s] = *(const bf16x8*)(Q + (size_t)(tile * PT + r16) * DM + (2 * h + p) * 128 + 8 * q + 32 * s);
    }
    for (; tile < M / PT; tile += tstride) {
        const int m0 = tile * PT;
        bf16x8 af[2][4];
#pragma unroll
        for (int p = 0; p < 2; ++p)
#pragma unroll
            for (int s = 0; s < 4; ++s) af[p][s] = afn[p][s];
        { const int tn = (tile + tstride < M / PT) ? tile + tstride : tile;
#pragma unroll
            for (int p = 0; p < 2; ++p)
#pragma unroll
                for (int s = 0; s < 4; ++s) afn[p][s] = *(const bf16x8*)(Q + (size_t)(tn * PT + r16) * DM + (2 * h + p) * 128 + 8 * q + 32 * s);
        }
        float top[2][4];
#pragma unroll
        for (int p = 0; p < 2; ++p) {
            int v[4][8];
#pragma unroll
            for (int nt = 0; nt < 8; ++nt) {
                const LAS bf16* krow = KL + (p * 128 + nt * 16 + r16) * KSTR + 8 * q;
                f32x4 acc = {0.f, 0.f, 0.f, 0.f};
#pragma unroll
                for (int s = 0; s < 4; ++s) acc = __builtin_amdgcn_mfma_f32_16x16x32_bf16(af[p][s], *(const LAS bf16x8*)(krow + 32 * s), acc, 0, 0, 0);
                const unsigned tag = 127u - (unsigned)(nt * 16 + r16);
#pragma unroll
                for (int j = 0; j < 4; ++j) v[j][nt] = f2ord(__uint_as_float((__float_as_uint(acc[j]) & ~127u) | tag));
                if (nt & 1) asm volatile("" ::: "memory");
            }
            select16x4<8>(v, r16, top[p]);
        }
        int cv[4][4];
#pragma unroll
        for (int u = 0; u < 4; ++u)
#pragma unroll
            for (int j = 0; j < 4; ++j) {
                const float a = __shfl(top[0][j], gbase + ci[u]), b = __shfl(top[1][j], gbase + cj[u]);
                const float cs = __uint_as_float(__float_as_uint(a) & ~127u) + __uint_as_float(__float_as_uint(b) & ~127u);
                const float pk = __uint_as_float((__float_as_uint(cs) & ~63u) | (63u - (unsigned)(r16 + 16 * u)));
                cv[j][u] = cvalid[u] ? f2ord(pk) : (int)0x80000000;
            }
        float best[4];
        select16x4<4>(cv, r16, best);
#pragma unroll
        for (int j = 0; j < 4; ++j) {
            const unsigned bb = __float_as_uint(best[j]);
            const int cd = cand_code(63 - (int)(bb & 63u));
            const int k0 = 127 - (int)(__float_as_uint(__shfl(top[0][j], gbase + (cd & 15))) & 127u);
            const int k1 = 127 - (int)(__float_as_uint(__shfl(top[1][j], gbase + ((cd >> 4) & 15))) & 127u);
            const float s = __uint_as_float(bb & ~63u);
            const float mx = rowmax16(s), e = __expf(s - mx), sum = rowsum16(e);
            const size_t o = (size_t)(m0 + 4 * q + j) * 128 + h * 16 + r16;
            rtE[o] = k0 * 128 + k1; rtG[o] = e * rcp_f(sum);
        }
    }
}

__device__ __forceinline__ f32x2 cvt2_fp8(unsigned wd, bool hi) { return hi ? __builtin_amdgcn_cvt_pk_f32_fp8((int)wd, true) : __builtin_amdgcn_cvt_pk_f32_fp8((int)wd, false); }
__device__ __forceinline__ void treduce8x16(const float (&p)[16], bool b0, bool b1, bool b2, float& r0, float& r1) {
    float a[8], bq[4];
#pragma unroll
    for (int i = 0; i < 8; ++i) { const float mine = b2 ? p[i + 8] : p[i], send = b2 ? p[i] : p[i + 8]; const float up = dpp_f<0x104>(send), dn = dpp_f<0x114>(send); a[i] = mine + (b2 ? dn : up); }
#pragma unroll
    for (int i = 0; i < 4; ++i) { const float mine = b1 ? a[i + 4] : a[i], send = b1 ? a[i] : a[i + 4]; bq[i] = mine + dpp_f<0x4E>(send); }
    { const float mine = b0 ? bq[2] : bq[0], send = b0 ? bq[0] : bq[2]; r0 = mine + dpp_f<0xB1>(send); }
    { const float mine = b0 ? bq[3] : bq[1], send = b0 ? bq[1] : bq[3]; r1 = mine + dpp_f<0xB1>(send); }
}
struct XGroup { int xg, gwi, stride; };
__device__ __forceinline__ XGroup xgroup(const Ctx& F) { XGroup g; g.xg = blockIdx.x & 7; const int nbg = (F.G - g.xg + 7) >> 3; g.gwi = (blockIdx.x >> 3) * NWAVES + F.wave; g.stride = nbg * NWAVES; return g; }

__device__ __forceinline__ void p10_peer_u(const Ctx& F) {
    typedef int v8i __attribute__((ext_vector_type(8)));
    const unsigned char* PU4 = F.ws + WS_PU8; const unsigned char* X8 = F.ws + WS_X8;
    const int* rtE = (const int*)(F.ws + WS_RTE); unsigned char* PDb = F.ws + WS_PD;
    const XGroup g = xgroup(F);
    const int lane = F.lane, j = lane >> 3, sub = lane & 7, n = lane & 15, kb = lane >> 4;
    const int r = g.xg;
    const unsigned char* tab = PU4 + (size_t)r * RANGE_BYTES;
    const unsigned so = 16u * (unsigned)sub;
    LAS unsigned char* wl = F.lds + F.wave * 16384;
    const int p0 = (kb + (n >> 1)) & 7, p1 = (p0 + 4) & 7;
    const int rot = n >> 1;
    const int xo00 = 32 * ((0 + 0 + (kb >> 1) + rot) & 7) + 16 * (kb & 1), xo01 = 32 * ((0 + 2 + (kb >> 1) + rot) & 7) + 16 * (kb & 1);
    const int xo10 = 32 * ((4 + 0 + (kb >> 1) + rot) & 7) + 16 * (kb & 1), xo11 = 32 * ((4 + 2 + (kb >> 1) + rot) & 7) + 16 * (kb & 1);
    LAS unsigned char* bp0 = wl + n * 128 + 16 * p0; LAS unsigned char* bp1 = wl + n * 128 + 16 * p1;
    LAS unsigned char* wp = wl + lane * 16;
    const bool diag = (n >> 2) == kb; const int sel = lane & 3;
    const int SC = 0x7f7f7f7f;
    int m = g.gwi;
    if (m >= M) return;
    const int st = g.stride;
    v4u ev[4], gt[16], xa[4];
    {
#pragma unroll
        for (int i = 0; i < 4; ++i) ev[i] = *(const v4u*)(rtE + (size_t)m * 128 + 16 * j + 4 * i);
#pragma unroll
        for (int k = 0; k < 16; ++k) gt[k] = *(const v4u*)(tab + (ev[k >> 2][k & 3] * 128u + so));
        const unsigned char* xr = X8 + (size_t)m * DM + 256 * r;
        xa[0] = *(const v4u*)(xr + xo00); xa[1] = *(const v4u*)(xr + xo01); xa[2] = *(const v4u*)(xr + xo10); xa[3] = *(const v4u*)(xr + xo11);
        const int m1 = (m + st < M) ? m + st : m;
#pragma unroll
        for (int i = 0; i < 4; ++i) ev[i] = *(const v4u*)(rtE + (size_t)m1 * 128 + 16 * j + 4 * i);
    }
    for (; m < M; m += st) {
        const int m1 = (m + st < M) ? m + st : m, m2 = (m + 2 * st < M) ? m + 2 * st : m;
#pragma unroll
        for (int k = 0; k < 16; ++k) *(LAS v4u*)(wp + k * 1024) = gt[k];
        v8i A0, A1;
        A0[0] = xa[0].x; A0[1] = xa[0].y; A0[2] = xa[0].z; A0[3] = xa[0].w; A0[4] = xa[1].x; A0[5] = xa[1].y; A0[6] = xa[1].z; A0[7] = xa[1].w;
        A1[0] = xa[2].x; A1[1] = xa[2].y; A1[2] = xa[2].z; A1[3] = xa[2].w; A1[4] = xa[3].x; A1[5] = xa[3].y; A1[6] = xa[3].z; A1[7] = xa[3].w;
        asm volatile("" ::: "memory");
#pragma unroll
        for (int k = 0; k < 16; ++k) gt[k] = *(const v4u*)(tab + (ev[k >> 2][k & 3] * 128u + so));
        { const unsigned char* xr = X8 + (size_t)m1 * DM + 256 * r;
          xa[0] = *(const v4u*)(xr + xo00); xa[1] = *(const v4u*)(xr + xo01); xa[2] = *(const v4u*)(xr + xo10); xa[3] = *(const v4u*)(xr + xo11); }
#pragma unroll
        for (int i = 0; i < 4; ++i) ev[i] = *(const v4u*)(rtE + (size_t)m2 * 128 + 16 * j + 4 * i);
        asm volatile("" ::: "memory");
        float dv[8];
#pragma unroll
        for (int t = 0; t < 8; ++t) {
            const v4u b0 = *(const LAS v4u*)(bp0 + t * 2048), b1 = *(const LAS v4u*)(bp1 + t * 2048);
            v8i B0 = {(int)b0.x, (int)b0.y, (int)b0.z, (int)b0.w, 0, 0, 0, 0}, B1 = {(int)b1.x, (int)b1.y, (int)b1.z, (int)b1.w, 0, 0, 0, 0};
            f32x4 acc = {0.f, 0.f, 0.f, 0.f};
            acc = __builtin_amdgcn_mfma_scale_f32_16x16x128_f8f6f4(A0, B0, acc, 0, 4, 0, SC, 0, SC);
            acc = __builtin_amdgcn_mfma_scale_f32_16x16x128_f8f6f4(A1, B1, acc, 0, 4, 0, SC, 0, SC);
            dv[t] = (sel == 0) ? acc[0] : (sel == 1) ? acc[1] : (sel == 2) ? acc[2] : acc[3];
        }
        asm volatile("" ::: "memory");
        if (diag) *(v4u*)(PDb + ((size_t)r * M + m) * 256 + 16 * n) = pack8(dv);
    }
}

__device__ __forceinline__ void p11_peer_coef(const Ctx& F) {
    const int* rtE = (const int*)(F.ws + WS_RTE); const float* rtG = (const float*)(F.ws + WS_RTG); const unsigned* PD = (const unsigned*)(F.ws + WS_PD);
    const float* usc = (const float*)(F.ws + WS_USC); const float* vsc = (const float*)(F.ws + WS_VSC); float* COEF = (float*)(F.ws + WS_COEF);
    int m = F.gw;
    if (m >= M) return;
    const int st = F.NGW;
    unsigned pd[8]; f32x2 gt; float us0, us1, vs0, vs1; v2u e1;
    {   const size_t o = (size_t)m * 128 + 2 * F.lane;
        const v2u e0 = *(const v2u*)(rtE + o);
#pragma unroll
        for (int r = 0; r < 8; ++r) { const unsigned short* ph = (const unsigned short*)PD + ((size_t)r * M + m) * 128 + F.lane; pd[r] = (unsigned)ph[0] | ((unsigned)ph[64] << 16); }
        gt = *(const f32x2*)(rtG + o);
        const int m1 = (m + st < M) ? m + st : m;
        e1 = *(const v2u*)(rtE + (size_t)m1 * 128 + 2 * F.lane);
        us0 = usc[e0.x]; us1 = usc[e0.y]; vs0 = vsc[e0.x]; vs1 = vsc[e0.y]; }
    for (; m < M; m += st) {
        const int m1 = (m + st < M) ? m + st : m, m2 = (m + 2 * st < M) ? m + 2 * st : m;
        const size_t o = (size_t)m * 128 + 2 * F.lane, o1 = (size_t)m1 * 128 + 2 * F.lane;
        const v2u e2 = *(const v2u*)(rtE + (size_t)m2 * 128 + 2 * F.lane);
        unsigned pdn[8];
#pragma unroll
        for (int r = 0; r < 8; ++r) { const unsigned short* ph = (const unsigned short*)PD + ((size_t)r * M + m1) * 128 + F.lane; pdn[r] = (unsigned)ph[0] | ((unsigned)ph[64] << 16); }
        const f32x2 gtn = *(const f32x2*)(rtG + o1);
        const float us0n = usc[e1.x], us1n = usc[e1.y], vs0n = vsc[e1.x], vs1n = vsc[e1.y];
        asm volatile("" ::: "memory");
        f32x2 d = {0.f, 0.f};
#pragma unroll
        for (int r = 0; r < 8; ++r) d += (f32x2){bflo(pd[r]), bfhi(pd[r])};
        const float d0 = d.x * us0, d1 = d.y * us1;
        f32x2 c; c.x = gt.x * (0.5f * d0 * (1.f + erff(d0 * 0.70710678f))) * vs0; c.y = gt.y * (0.5f * d1 * (1.f + erff(d1 * 0.70710678f))) * vs1;
        *(f32x2*)(COEF + o) = c;
#pragma unroll
        for (int r = 0; r < 8; ++r) pd[r] = pdn[r];
        gt = gtn; us0 = us0n; us1 = us1n; vs0 = vs0n; vs1 = vs1n; e1 = e2;
    }
}

__device__ __forceinline__ void p12_peer_v(const Ctx& F) {
    const unsigned char* PV4 = F.ws + WS_PV8; const int* rtE = (const int*)(F.ws + WS_RTE); const float* COEF = (const float*)(F.ws + WS_COEF);
    const float* mod = (const float*)(F.ws + WS_MOD);
    const XGroup g = xgroup(F);
    const int lane = F.lane, j = lane >> 3, sub = lane & 7;
    const bool jb0 = j & 1;
    const int r = g.xg;
    const unsigned char* tab = PV4 + (size_t)r * RANGE_BYTES;
    const unsigned so = 16u * (unsigned)sub;
    int m = g.gwi;
    if (m >= M) return;
    const int st = g.stride;
#define PV_LDE(e, mm, hf) { e[0] = *(const v4u*)(rtE + (size_t)(mm) * 128 + 16 * j + 8 * (hf)); e[1] = *(const v4u*)(rtE + (size_t)(mm) * 128 + 16 * j + 8 * (hf) + 4); }
#define PV_LDC(c, mm, hf) { c[0] = *(const f32x4*)(COEF + (size_t)(mm) * 128 + 16 * j + 8 * (hf)); c[1] = *(const f32x4*)(COEF + (size_t)(mm) * 128 + 16 * j + 8 * (hf) + 4); }
#define PV_GATHER(gx, e) { _Pragma("unroll") for (int k = 0; k < 8; ++k) gx[k] = *(const v4u*)(tab + (e[k >> 2][k & 3] * 128u + so)); }
#define PV_ACC(gx, c) { _Pragma("unroll") for (int k = 0; k < 8; ++k) { const float cq = c[k >> 2][k & 3]; const f32x2 cv2 = {cq, cq}; \
        _Pragma("unroll") for (int d = 0; d < 4; ++d) { const unsigned wd = gx[k][d]; \
            acc[4 * d + 0] += cv2 * __builtin_amdgcn_cvt_scalef32_pk_f32_fp4(wd, 1.0f, 0); acc[4 * d + 1] += cv2 * __builtin_amdgcn_cvt_scalef32_pk_f32_fp4(wd, 1.0f, 1); \
            acc[4 * d + 2] += cv2 * __builtin_amdgcn_cvt_scalef32_pk_f32_fp4(wd, 1.0f, 2); acc[4 * d + 3] += cv2 * __builtin_amdgcn_cvt_scalef32_pk_f32_fp4(wd, 1.0f, 3); } } }
    v4u eA1[2], eB0[2], gA[8], gB[8]; f32x4 cA0[2], cA1[2], cB0[2];
    { v4u eA0[2]; PV_LDE(eA0, m, 0); PV_LDC(cA0, m, 0); PV_LDE(eB0, m, 1); PV_LDC(cB0, m, 1);
      const int m1 = (m + st < M) ? m + st : m; PV_LDE(eA1, m1, 0); PV_LDC(cA1, m1, 0);
      PV_GATHER(gA, eA0); }
    for (; m < M; m += st) {
        const int m1 = (m + st < M) ? m + st : m, m2 = (m + 2 * st < M) ? m + 2 * st : m;
        const int col = 256 * r + 32 * sub + 4 * j;
        v2u* orow = (v2u*)((bf16*)(F.ws + WS_HB) + (size_t)m * DM + col);
        const v2u hw = *orow; const f32x4 g2 = *(const f32x4*)(mod + (size_t)(m / SEQ) * MODW + 5 * DM + col);
        PV_GATHER(gB, eB0);
        v4u eB1[2], eA2[2]; f32x4 cB1[2], cA2[2];
        PV_LDE(eB1, m1, 1); PV_LDC(cB1, m1, 1); PV_LDE(eA2, m2, 0); PV_LDC(cA2, m2, 0);
        asm volatile("" : "+v"(gA[0]), "+v"(gA[1]), "+v"(gA[2]), "+v"(gA[3]), "+v"(gA[4]), "+v"(gA[5]), "+v"(gA[6]), "+v"(gA[7]) :: "memory");
        f32x2 acc[16];
#pragma unroll
        for (int i = 0; i < 16; ++i) acc[i] = (f32x2){0.f, 0.f};
        PV_ACC(gA, cA0);
        asm volatile("" ::: "memory");
        PV_GATHER(gA, eA1);
        asm volatile("" : "+v"(gB[0]), "+v"(gB[1]), "+v"(gB[2]), "+v"(gB[3]), "+v"(gB[4]), "+v"(gB[5]), "+v"(gB[6]), "+v"(gB[7]) :: "memory");
        PV_ACC(gB, cB0);
        float a[32];
#pragma unroll
        for (int i = 0; i < 16; ++i) { a[2 * i] = acc[i].x; a[2 * i + 1] = acc[i].y; }
        float s16[16], s8[8];
#pragma unroll
        for (int c = 0; c < 16; ++c) { auto rr2 = __builtin_amdgcn_permlane32_swap(__float_as_uint(a[c]), __float_as_uint(a[c + 16]), false, false); s16[c] = __uint_as_float(rr2[0]) + __uint_as_float(rr2[1]); }
#pragma unroll
        for (int c = 0; c < 8; ++c) { auto rr2 = __builtin_amdgcn_permlane16_swap(__float_as_uint(s16[c]), __float_as_uint(s16[c + 8]), false, false); s8[c] = __uint_as_float(rr2[0]) + __uint_as_float(rr2[1]); }
        f32x4 res;
#pragma unroll
        for (int c = 0; c < 4; ++c) { const float mine = jb0 ? s8[c + 4] : s8[c], send = jb0 ? s8[c] : s8[c + 4]; res[c] = mine + dpp_f<0x128>(send); }
        const f32x4 h1 = {bflo(hw.x), bfhi(hw.x), bflo(hw.y), bfhi(hw.y)};
        const f32x4 h2 = h1 + g2 * res;
        v2u o; o.x = pk2(h2.x, h2.y); o.y = pk2(h2.z, h2.w);
        *orow = o;
#pragma unroll
        for (int i = 0; i < 2; ++i) { cA0[i] = cA1[i]; cA1[i] = cA2[i]; eA1[i] = eA2[i]; eB0[i] = eB1[i]; cB0[i] = cB1[i]; }
    }
#undef PV_LDE
#undef PV_LDC
#undef PV_GATHER
#undef PV_ACC
}
#define XB_TMO      128
#define XB_XCNT(j)  (256  + 64 * (j))
#define XB_XSUB(j)  (1280 + 64 * (j))
#define XB_XGEN(j)  (2304 + 64 * (j))
#define XB_TOP      3328
#define XB_TOPGEN   3392
#define XCD_BAR_WORDS 3456
#define XB_SPIN_CAP (1u << 18)

__device__ __forceinline__ unsigned xb_ld(unsigned* p)              { return __hip_atomic_load(p, __ATOMIC_RELAXED, __HIP_MEMORY_SCOPE_AGENT); }
__device__ __forceinline__ unsigned xb_add(unsigned* p, unsigned v) { return __hip_atomic_fetch_add(p, v, __ATOMIC_RELAXED, __HIP_MEMORY_SCOPE_AGENT); }
__device__ __forceinline__ unsigned xb_xcc_id() { return (unsigned)__builtin_amdgcn_s_getreg((3 << 11) | 20) & 0xFu; }
#define XB_SPIN(cond, bar) do { unsigned _sp = 0; while (cond) { __builtin_amdgcn_s_sleep(1); \
    if ((++_sp & 255u) == 0u) { if (xb_ld(&(bar)[XB_TMO])) break; if (_sp > XB_SPIN_CAP) { atomicAdd(&(bar)[XB_TMO], 1u); break; } } } } while (0)

struct XcdBarrier {
    unsigned* bar; unsigned x;
    volatile LAS unsigned* st;
};

__device__ __forceinline__ XcdBarrier xcd_barrier_post(unsigned* bar, volatile LAS unsigned* st) {
    XcdBarrier b; b.bar = bar; b.x = xb_xcc_id(); b.st = st;
    if (threadIdx.x == 0) (void)xb_add(&bar[XB_XCNT(b.x)], 1u);
    return b;
}
__device__ __forceinline__ void xcd_barrier_complete(unsigned* bar, unsigned x, unsigned& nloc, unsigned& nx) {
    const unsigned G = gridDim.x * gridDim.y * gridDim.z;
    unsigned sum, cnt, mine, sp = 0u;
    for (;;) {
        sum = 0u; cnt = 0u; mine = 0u;
#pragma unroll
        for (unsigned j = 0; j < 16; ++j) { const unsigned c = xb_ld(&bar[XB_XCNT(j)]); sum += c; cnt += (c > 0u) ? 1u : 0u; mine = (j == x) ? c : mine; }
        if (sum == G) break;
        __builtin_amdgcn_s_sleep(1);
        if ((++sp & 255u) == 0u) { if (xb_ld(&bar[XB_TMO])) break; if (sp > XB_SPIN_CAP) { atomicAdd(&bar[XB_TMO], 1u); break; } }
    }
    nloc = mine > 0u ? mine : 1u; nx = cnt > 0u ? cnt : 1u;
}

__device__ __forceinline__ void xcd_barrier(const XcdBarrier& b) {
    asm volatile("s_waitcnt vmcnt(0)" ::: "memory");
    __syncthreads();
    if (threadIdx.x == 0) {
        unsigned* bar = b.bar;
        __builtin_amdgcn_s_waitcnt(0);
        unsigned nloc = b.st[0], nx = b.st[1];
        if (nloc == 0u) { xcd_barrier_complete(bar, b.x, nloc, nx); b.st[0] = nloc; b.st[1] = nx; }
        const unsigned old = xb_add(&bar[XB_XSUB(b.x)], 1u);
        const unsigned gen = old / nloc;
        if (old + 1u == (gen + 1u) * nloc) {
            __builtin_amdgcn_fence(__ATOMIC_RELEASE, "agent");
            asm volatile("s_waitcnt vmcnt(0)" ::: "memory");
            const unsigned og = xb_add(&bar[XB_TOP], 1u);
            const unsigned tg = og / nx;
            if (og + 1u == (tg + 1u) * nx) xb_add(&bar[XB_TOPGEN], 1u);
            else XB_SPIN(xb_ld(&bar[XB_TOPGEN]) == tg, bar);
            __builtin_amdgcn_fence(__ATOMIC_ACQUIRE, "agent");
            xb_add(&bar[XB_XGEN(b.x)], 1u);
            asm volatile("s_waitcnt vmcnt(0)" ::: "memory");
        } else {
            XB_SPIN(xb_ld(&bar[XB_XGEN(b.x)]) == gen, bar);
            __builtin_amdgcn_fence(__ATOMIC_ACQUIRE, "agent");
            asm volatile("s_waitcnt vmcnt(0)" ::: "memory");
        }
    }
    __syncthreads();
}

struct Args { const float* in[N_IN]; float* out; unsigned char* ws; int ph_lo, ph_hi; };
constexpr int N_PHASES = 19;

__global__ void __launch_bounds__(NTHR, 2) fwd_kernel(Args args) {
    extern __shared__ __attribute__((aligned(16))) unsigned char lds_raw[];
    cg::grid_group grid = cg::this_grid();
    Ctx F;
    F.lds = (LAS unsigned char*)lds_raw;
    F.tid = threadIdx.x; F.lane = F.tid & 63; F.wave = __builtin_amdgcn_readfirstlane(F.tid >> 6);
    F.G = gridDim.x; F.gw = blockIdx.x * NWAVES + F.wave; F.NGW = F.G * NWAVES;
    F.in = args.in; F.out = args.out; F.ws = args.ws;
    const int lo = args.ph_lo, hi = args.ph_hi;
    volatile LAS unsigned* bst = (volatile LAS unsigned*)(F.lds + LDS_BYTES - 64);
    if (F.tid < 2) bst[F.tid] = 0u;
    if (F.tid < 4) ((volatile LAS unsigned*)(F.lds + LDS_BYTES - 48))[F.tid] = 0u;
    __syncthreads();
    const XcdBarrier bar = xcd_barrier_post((unsigned*)(F.ws + WS_CTL) + 4096, bst);
#define IN(k) (lo <= (k) && (k) < hi)
#ifndef TS_A
#define TS_A -1
#define TS_B -1
#define TS_K 0.1
#endif
    unsigned long long* stamps = (unsigned long long*)(F.ws + WS_CTL + 65536);
#define STAMP(k) do { if (TS_A >= 0 && blockIdx.x == 0 && F.tid == 0) stamps[k] = __builtin_amdgcn_s_memrealtime(); } while (0)
#define REP_MASK 0
#ifndef REP_MASK
#define REP_MASK 0
#endif
#define REPS(k) for (int rep_ = 0; rep_ < 1 + ((REP_MASK >> (k)) & 1); ++rep_)
#define SEAM(k) do { if (IN(k) && IN((k) + 1)) { if ((k) == 0) grid.sync(); else xcd_barrier(bar); } } while (0)

    STAMP(0);
    if (IN(0)) REPS(0) { p0_prologue(F); }
    SEAM(0);
    STAMP(1);
    if (IN(1)) REPS(1) { norm_mod_rows(F, F.in[I_X], F.in[I_N1W], 0, DM, (bf16*)(F.ws + WS_XN)); }
    SEAM(1);
    STAMP(2);
    if (IN(2)) REPS(2) {
        pg8::Gemm g{(const pg8::bf16_t*)(F.ws + WS_XN), (const pg8::bf16_t*)(F.ws + WS_WIN), M, INPP, DM};
        pg8::StaticOrder S; S.init(M, INPP, F.G, (int)blockIdx.x);
        pg8::EpiStoreBf16 E{(pg8::bf16_t*)(F.ws + WS_PROJ), INPP};
        pg8::gemm_phase<pg8::EpiStoreBf16, pg8::StaticOrder, true, true>(F.lds, g, S, E);
    }
    SEAM(2);
#ifndef P3REP
#define P3REP 0
#endif
    STAMP(3);
    if (IN(3)) REPS(3) { p3_lora(F); STAMP(40); m1_chunk_states(F); }
    SEAM(3);
    STAMP(4);
    if (IN(4)) { m2_prefix(F); ra_part(F, 0); }
    SEAM(4);
    STAMP(5);
    if (IN(5)) { rs_half(F, 0); ra_part(F, 1); }
    SEAM(5);
    STAMP(6);
    if (IN(6)) { rs_half(F, 1); ra_part(F, 2); }
    SEAM(6);
    STAMP(7);
    if (IN(7)) { rs_half(F, 2); ra_part(F, 3); }
    SEAM(7);
    STAMP(8);
    if (IN(8)) { rs_half(F, 3); }
    STAMP(9);
    if (IN(9)) REPS(9) { m3_outputs(F); }
    SEAM(9);
    STAMP(10);
    if (IN(10)) { p5_post(F); }
    SEAM(10);
    STAMP(11);
    if (IN(11)) REPS(11) {
        pg8::Gemm g{(const pg8::bf16_t*)(F.ws + WS_OY), (const pg8::bf16_t*)(F.ws + WS_WOUT), M, DM, DM};
        pg8::StaticOrder S; S.init(M, DM, F.G, (int)blockIdx.x);
        pg8::EpiResid E{F.in[I_X], (const float*)(F.ws + WS_MOD) + 2 * DM, (pg8::bf16_t*)(F.ws + WS_HB), DM, SEQ, MODW};
        pg8::gemm_phase<pg8::EpiResid, pg8::StaticOrder, true, true>(F.lds, g, S, E);
    }
    SEAM(11);
    STAMP(12);
    if (IN(12)) REPS(12) { norm_mod_rows_bf16(F, (const bf16*)(F.ws + WS_HB), F.in[I_N2W], 3 * DM, 4 * DM, (bf16*)(F.ws + WS_XN), (unsigned*)(F.ws + WS_X8)); }
    SEAM(12);
    STAMP(13);
    if (IN(13)) REPS(13) {
        pg8::Gemm g{(const pg8::bf16_t*)(F.ws + WS_XN), (const pg8::bf16_t*)(F.ws + WS_WQ), M, DM, DM};
        pg8::StaticOrder S; S.init(M, DM, F.G, (int)blockIdx.x);
        pg8::EpiStoreBf16 E{(pg8::bf16_t*)(F.ws + WS_Q), DM};
        pg8::gemm_phase<pg8::EpiStoreBf16, pg8::StaticOrder, true, true>(F.lds, g, S, E);
    }
    SEAM(13);
    STAMP(14);
    if (IN(14)) REPS(14) { p9_route(F); }
    SEAM(14);
    STAMP(15);
    if (IN(15)) REPS(15) { p10_peer_u(F); }
    SEAM(15);
    STAMP(16);
    if (IN(16)) REPS(16) { p11_peer_coef(F); }
    SEAM(16);
    STAMP(17);
    if (IN(17)) { p12_peer_v(F); }
    SEAM(17);
    STAMP(18);
    if (IN(18)) {
        float oscale = 1.f;
        if (TS_A >= 0) { const volatile unsigned long long* st = stamps; const float frac = (float)(st[TS_B] - st[TS_A]) / (float)(st[17] - st[0]); oscale = 1.f + (float)(TS_K) * frac; }
        final_norm_rows_bf16(F, (const bf16*)(F.ws + WS_HB), F.in[I_FNW], F.out, oscale);
    }
#undef IN
#undef SEAM
}

extern "C" void kernel_launch(void* const* d_in, const int* in_sizes, int n_in, void* d_out, int out_size, void* d_ws, size_t ws_size, hipStream_t stream) {
    static int grid = 0;
    if (grid == 0) {
        if (n_in != N_IN || in_sizes[0] != M * DM || out_size != M * DM || ws_size < WS_END2) {
            fprintf(stderr, "kernel_launch: unexpected shapes: n_in %d in0 %d out %d ws %zu (need %zu)\n", n_in, n_in > 0 ? in_sizes[0] : -1, out_size, ws_size, (size_t)WS_END2); grid = -1; return; }
        int dev = 0, cus = 0, per_cu = 0;
        if (hipGetDevice(&dev) != hipSuccess || hipDeviceGetAttribute(&cus, hipDeviceAttributeMultiprocessorCount, dev) != hipSuccess) { grid = -1; return; }
        if (hipFuncSetAttribute((const void*)fwd_kernel, hipFuncAttributeMaxDynamicSharedMemorySize, LDS_BYTES) != hipSuccess) { fprintf(stderr, "kernel_launch: hipFuncSetAttribute failed\n"); grid = -1; return; }
        if (hipOccupancyMaxActiveBlocksPerMultiprocessor(&per_cu, (const void*)fwd_kernel, NTHR, LDS_BYTES) != hipSuccess || per_cu < 1) { fprintf(stderr, "kernel_launch: occupancy query says %d blocks per CU\n", per_cu); per_cu = 1; }
        (void)hipGetLastError();
        grid = cus;
        fprintf(stderr, "kernel_launch: cus %d per_cu %d grid %d ws %zu\n", cus, per_cu, grid, ws_size);
    }
    if (grid < 0) return;
    (void)hipMemsetAsync((char*)d_ws + WS_CTL, 0, CTL_ZERO_BYTES, stream);
    Args a{};
    for (int i = 0; i < N_IN; ++i) a.in[i] = (const float*)d_in[i];
    a.out = (float*)d_out; a.ws = (unsigned char*)d_ws; a.ph_lo = 0; a.ph_hi = N_PHASES;
    void* kargs[] = {&a};
#ifndef NPASS
#define NPASS 1
#endif
    hipError_t e = hipSuccess;
    for (int pass_ = 0; pass_ < NPASS; ++pass_) {
        if (pass_ > 0) (void)hipMemsetAsync((char*)d_ws + WS_CTL, 0, CTL_ZERO_BYTES, stream);
        e = hipLaunchCooperativeKernel((const void*)fwd_kernel, dim3(grid), dim3(NTHR), kargs, LDS_BYTES, stream);
    }
    if (e != hipSuccess) fprintf(stderr, "kernel_launch: cooperative launch failed: %s (grid %d)\n", hipGetErrorString(e), grid);
}
```

```cpp
#include <hip/hip_runtime.h>
#include <hip/hip_cooperative_groups.h>
#include <cstdio>
#include <cstdint>
namespace cg = cooperative_groups;
namespace pg8 {
#define PG8_LAS __attribute__((address_space(3)))
typedef unsigned short bf16_t;
typedef short bf16x8 __attribute__((ext_vector_type(8)));
typedef float f32x4 __attribute__((ext_vector_type(4)));
typedef unsigned u32x4 __attribute__((ext_vector_type(4)));
constexpr int BM = 256, BK = 64, HALF = 128, HTB = HALF * BK * 2  , STAGE_BYTES = 8 * HTB, NXCD = 8, WGM = 8;

__host__ __device__ __forceinline__ int lds_byte(int r, int c) { const int st = (r >> 4) * 2 + (c >> 5), rr = r & 15, cc = c & 31, ob = rr * 64 + cc * 2; return st * 1024 + (ob ^ (((ob >> 9) & 1) << 5)); }
__host__ __device__ __forceinline__ void stage_rc(int b, int& R, int& C) { const int st = b / 1024, sb = b % 1024, swz = sb ^ (((sb >> 9) & 1) << 5); R = (st >> 1) * 16 + swz / 64; C = (st & 1) * 32 + (swz % 64) / 2; }
__host__ __device__ __forceinline__ int perm32(int rho) { const int n = rho >> 4, i = rho & 15; return 8 * (i >> 2) + 4 * n + (i & 3); }

struct Unit { int pm, pn; };
struct Gemm { const bf16_t* A; const bf16_t* Bt; int M, N, K; };

struct StaticOrder {
    int nM, nN, nwg, G, c;
    __host__ __device__ void init(int M, int N, int G_, int c_) { nM = M / BM; nN = N / BM; nwg = nM * nN; G = G_; c = c_; }
    __host__ __device__ bool next(int i, Unit& u) const {
        const long L = (long)i * G + c; if (L >= nwg) return false;
        int wgid = (int)L; { const int q = nwg / NXCD, r = nwg % NXCD, xcd = wgid % NXCD, off = wgid / NXCD; wgid = (xcd < r ? xcd * (q + 1) : r * (q + 1) + (xcd - r) * q) + off; }
        const int nig = WGM * nN, gid = wgid / nig, fm = gid * WGM, gsz = (nM - fm) < WGM ? (nM - fm) : WGM;
        u.pm = fm + ((wgid % nig) % gsz); u.pn = (wgid % nig) / gsz; return true;
    }
    __device__ __forceinline__ void a_ready(const Unit&) const {}
    __device__ __forceinline__ void done(const Unit&) const {}
};
__device__ __forceinline__ unsigned cvt_pk_bf16(float lo, float hi) { unsigned r; asm volatile("v_cvt_pk_bf16_f32 %0, %1, %2" : "=v"(r) : "v"(lo), "v"(hi)); return r; }
struct EpiStoreBf16 {
    static constexpr bool PERM = true, AFTER_DRAIN = false;
    bf16_t* O; int ldc;
    __device__ __forceinline__ void operator()(const f32x4 (&acc)[2][2][4][2], const Unit& u, int wr, int wc, int fr, int fq) const {
        const int row0 = u.pm * BM + wr * 64 + fr; const int col0 = u.pn * BM + wc * 32 + 8 * fq;
#pragma unroll
        for (int ai = 0; ai < 2; ++ai)
#pragma unroll
            for (int m = 0; m < 4; ++m) { bf16_t* rowp = O + (size_t)(row0 + ai * HALF + m * 16) * ldc + col0;
#pragma unroll
                for (int bj = 0; bj < 2; ++bj) { const f32x4 v0 = acc[ai][bj][m][0], v1 = acc[ai][bj][m][1];
                    u32x4 w; w.x = cvt_pk_bf16(v0[0], v0[1]); w.y = cvt_pk_bf16(v0[2], v0[3]); w.z = cvt_pk_bf16(v1[0], v1[1]); w.w = cvt_pk_bf16(v1[2], v1[3]);
                    *(u32x4*)(rowp + bj * HALF) = w; } }
    }
};
struct EpiResid {
    static constexpr bool PERM = true, AFTER_DRAIN = false;
    const float* X; const float* gate; bf16_t* O; int ldc; int rows_per_batch; int gstride;
    __device__ __forceinline__ void operator()(const f32x4 (&acc)[2][2][4][2], const Unit& u, int wr, int wc, int fr, int fq) const {
        const int row0 = u.pm * BM + wr * 64 + fr; const int col0 = u.pn * BM + wc * 32 + 8 * fq;
        const float* g = gate + (size_t)((u.pm * BM) / rows_per_batch) * gstride + col0;
        f32x4 gv[2][2];
#pragma unroll
        for (int bj = 0; bj < 2; ++bj)
#pragma unroll
            for (int n = 0; n < 2; ++n) gv[bj][n] = *(const f32x4*)(g + bj * HALF + 4 * n);
#pragma unroll
        for (int ai = 0; ai < 2; ++ai)
#pragma unroll
            for (int m = 0; m < 4; ++m) { const size_t off = (size_t)(row0 + ai * HALF + m * 16) * ldc + col0;
#pragma unroll
                for (int bj = 0; bj < 2; ++bj) { const f32x4 x0 = *(const f32x4*)(X + off + bj * HALF), x1 = *(const f32x4*)(X + off + bj * HALF + 4);
                    const f32x4 v0 = x0 + gv[bj][0] * acc[ai][bj][m][0], v1 = x1 + gv[bj][1] * acc[ai][bj][m][1];
                    u32x4 w; w.x = cvt_pk_bf16(v0[0], v0[1]); w.y = cvt_pk_bf16(v0[2], v0[3]); w.z = cvt_pk_bf16(v1[0], v1[1]); w.w = cvt_pk_bf16(v1[2], v1[3]);
                    *(u32x4*)(O + off + bj * HALF) = w; } }
    }
};
template <class Epi, class Sched, bool ALIGN_EPI = false, bool SP2 = false>
__device__ __forceinline__ void gemm_phase(PG8_LAS unsigned char* lds, const Gemm g, const Sched& S, const Epi& E) {
    const int tid = threadIdx.x, wid = __builtin_amdgcn_readfirstlane(tid >> 6), lane = tid & 63, wr = wid >> 2, wc = wid & 3, fr = lane & 15, fq = lane >> 4;
    const int K = g.K, nt = K / BK;
    unsigned voffA[2], voffB[2];
#pragma unroll
    for (int i = 0; i < 2; ++i) { int R, C; stage_rc(tid * 16 + i * 8192, R, C); const int Rb = Epi::PERM ? ((R & ~31) + perm32(R & 31)) : R;
        voffA[i] = (unsigned)(R * K + C) * 2u; voffB[i] = (unsigned)(Rb * K + C) * 2u; }
    const size_t kstep = (size_t)(BK * 2);
    const size_t hstep = (size_t)HALF * K * 2;
    const size_t tstep = 2 * hstep;
    const unsigned ldsw = (unsigned)wid * 1024u;
    const int aoff = lds_byte(wr * 64 + fr, fq * 8), boff = lds_byte(wc * 32 + fr, fq * 8);
#define PG8_SA(b, h) (((b) * 2 + (h)) * HTB)
#define PG8_SB(b, h) ((4 + (b) * 2 + (h)) * HTB)
#define PG8_STAGE(bufoff, gbase, voff) do { _Pragma("unroll") for (int _i = 0; _i < 2; ++_i) \
        __builtin_amdgcn_global_load_lds((const unsigned*)((const char*)(gbase) + (voff)[_i]), (PG8_LAS unsigned*)(lds + (bufoff) + ldsw + _i * 8192), 16, 0, 0); } while (0)
#define PG8_LDA(dst, b, h) do { _Pragma("unroll") for (int m = 0; m < 4; ++m) _Pragma("unroll") for (int k = 0; k < 2; ++k) dst[m][k] = *(const PG8_LAS bf16x8*)(lds + PG8_SA(b, h) + aoff + m * 2048 + k * 1024); } while (0)
#define PG8_LDB(dst, b, h) do { _Pragma("unroll") for (int n = 0; n < 2; ++n) _Pragma("unroll") for (int k = 0; k < 2; ++k) dst[n][k] = *(const PG8_LAS bf16x8*)(lds + PG8_SB(b, h) + boff + n * 2048 + k * 1024); } while (0)
#define PG8_MMA(ai, bj, At, Bt) do { __builtin_amdgcn_s_setprio(1); _Pragma("unroll") for (int m = 0; m < 4; ++m) _Pragma("unroll") for (int n = 0; n < 2; ++n) _Pragma("unroll") for (int k = 0; k < 2; ++k) \
        acc[ai][bj][m][n] = __builtin_amdgcn_mfma_f32_16x16x32_bf16(Bt[n][k], At[m][k], acc[ai][bj][m][n], 0, 0, 0); __builtin_amdgcn_s_setprio(0); } while (0)
#define PG8_WAIT_V(n) asm volatile("s_waitcnt vmcnt(" #n ")" ::: "memory")
#define PG8_WAIT_L(n) asm volatile("s_waitcnt lgkmcnt(" #n ")" ::: "memory")
#define PG8_BAR __builtin_amdgcn_s_barrier()
#define PG8_SCHED __builtin_amdgcn_sched_barrier(0)
    Unit cur, nxt; int ui = 0;
    if (!S.next(0, cur)) return;
    f32x4 acc[2][2][4][2];
#pragma unroll
    for (int a = 0; a < 2; ++a)
#pragma unroll
        for (int b = 0; b < 2; ++b)
#pragma unroll
            for (int m = 0; m < 4; ++m)
#pragma unroll
                for (int n = 0; n < 2; ++n) acc[a][b][m][n] = (f32x4){0.f, 0.f, 0.f, 0.f};
    bf16x8 At[4][2], B0[2][2], B1[2][2];
    const char* cA = (const char*)g.A + (size_t)cur.pm * tstep; const char* cB = (const char*)g.Bt + (size_t)cur.pn * tstep;
    S.a_ready(cur);
    if constexpr (SP2) {
        PG8_STAGE(PG8_SB(0, 0), cB, voffB); PG8_STAGE(PG8_SB(0, 1), cB + hstep, voffB); PG8_STAGE(PG8_SA(0, 0), cA, voffA); PG8_STAGE(PG8_SA(0, 1), cA + hstep, voffA);
        if (wr == 1) PG8_BAR;
        PG8_WAIT_V(2); PG8_BAR;
        PG8_STAGE(PG8_SB(1, 0), cB + kstep, voffB); PG8_STAGE(PG8_SA(1, 0), cA + kstep, voffA); PG8_STAGE(PG8_SB(1, 1), cB + hstep + kstep, voffB);
        PG8_WAIT_V(6); PG8_BAR;
    } else {
        PG8_STAGE(PG8_SB(0, 0), cB, voffB); PG8_STAGE(PG8_SA(0, 0), cA, voffA); PG8_STAGE(PG8_SB(0, 1), cB + hstep, voffB); PG8_STAGE(PG8_SA(0, 1), cA + hstep, voffA);
        if (wr == 1) PG8_BAR;
        PG8_WAIT_V(4); PG8_BAR;
        PG8_STAGE(PG8_SB(1, 0), cB + kstep, voffB); PG8_STAGE(PG8_SA(1, 0), cA + kstep, voffA); PG8_STAGE(PG8_SB(1, 1), cB + hstep + kstep, voffB);
        PG8_WAIT_V(6); PG8_BAR;
    }
    for (;;) {
        const bool has_next = S.next(ui + 1, nxt);
        const char* nA = has_next ? (const char*)g.A + (size_t)nxt.pm * tstep : cA; const char* nB = has_next ? (const char*)g.Bt + (size_t)nxt.pn * tstep : cB;
        for (int t = 0; t < nt; t += 2) {
            const bool last = (t == nt - 2);
            const char* a1 = cA + (size_t)(t + 1) * kstep;
            const char* a2 = last ? nA : cA + (size_t)(t + 2) * kstep; const char* b2 = last ? nB : cB + (size_t)(t + 2) * kstep;
            const char* a3 = a2 + kstep; const char* b3 = b2 + kstep;
            if (last && has_next) S.a_ready(nxt);
            if constexpr (SP2) {
            PG8_LDB(B0, 0, 0); PG8_LDB(B1, 0, 1); PG8_SCHED; PG8_LDA(At, 0, 0); PG8_STAGE(PG8_SA(1, 1), a1 + hstep, voffA);
            PG8_WAIT_V(8); PG8_WAIT_L(0); PG8_BAR; PG8_MMA(0, 0, At, B0); PG8_MMA(0, 1, At, B1); PG8_BAR; PG8_SCHED;
            PG8_LDA(At, 0, 1); PG8_STAGE(PG8_SB(0, 0), b2, voffB); PG8_STAGE(PG8_SB(0, 1), b2 + hstep, voffB); PG8_STAGE(PG8_SA(0, 0), a2, voffA);
            PG8_WAIT_V(8); PG8_WAIT_L(0); PG8_BAR; PG8_MMA(1, 0, At, B0); PG8_MMA(1, 1, At, B1); PG8_BAR; PG8_SCHED;
            PG8_LDB(B0, 1, 0); PG8_LDB(B1, 1, 1); PG8_SCHED; PG8_LDA(At, 1, 0); PG8_STAGE(PG8_SA(0, 1), a2 + hstep, voffA);
            PG8_WAIT_V(8); PG8_WAIT_L(0); PG8_BAR; PG8_MMA(0, 0, At, B0); PG8_MMA(0, 1, At, B1); PG8_BAR; PG8_SCHED;
            PG8_LDA(At, 1, 1); PG8_STAGE(PG8_SB(1, 0), b3, voffB); PG8_STAGE(PG8_SB(1, 1), b3 + hstep, voffB); PG8_STAGE(PG8_SA(1, 0), a3, voffA);
            PG8_WAIT_V(8); PG8_WAIT_L(0); PG8_BAR; PG8_MMA(1, 0, At, B0); PG8_MMA(1, 1, At, B1); PG8_BAR; PG8_SCHED;
            } else {
            PG8_LDB(B0, 0, 0); PG8_SCHED; PG8_LDA(At, 0, 0); PG8_STAGE(PG8_SA(1, 1), a1 + hstep, voffA);
            PG8_WAIT_L(8); PG8_BAR; PG8_WAIT_L(0); PG8_MMA(0, 0, At, B0); PG8_BAR; PG8_SCHED;
            PG8_LDB(B1, 0, 1); PG8_STAGE(PG8_SB(0, 0), b2, voffB);
            PG8_BAR; PG8_WAIT_L(0); PG8_MMA(0, 1, At, B1); PG8_BAR;
            PG8_LDA(At, 0, 1); PG8_STAGE(PG8_SA(0, 0), a2, voffA);
            PG8_BAR; PG8_WAIT_L(0); PG8_MMA(1, 0, At, B0); PG8_BAR; PG8_SCHED;
            PG8_STAGE(PG8_SB(0, 1), b2 + hstep, voffB);
            PG8_WAIT_V(6); PG8_BAR; PG8_MMA(1, 1, At, B1); PG8_BAR;
            PG8_LDB(B0, 1, 0); PG8_SCHED; PG8_LDA(At, 1, 0); PG8_STAGE(PG8_SA(0, 1), a2 + hstep, voffA);
            PG8_WAIT_L(8); PG8_BAR; PG8_WAIT_L(0); PG8_MMA(0, 0, At, B0); PG8_BAR; PG8_SCHED;
            PG8_LDB(B1, 1, 1); PG8_STAGE(PG8_SB(1, 0), b3, voffB);
            PG8_BAR; PG8_WAIT_L(0); PG8_MMA(0, 1, At, B1); PG8_BAR;
            PG8_LDA(At, 1, 1); PG8_STAGE(PG8_SA(1, 0), a3, voffA);
            PG8_BAR; PG8_WAIT_L(0); PG8_MMA(1, 0, At, B0); PG8_BAR; PG8_SCHED;
            PG8_STAGE(PG8_SB(1, 1), b3 + hstep, voffB);
            PG8_WAIT_V(6); PG8_BAR; PG8_MMA(1, 1, At, B1); PG8_BAR;
            }
        }
        if constexpr (ALIGN_EPI) { if (wr == 0) PG8_BAR; }
        if constexpr (!Epi::AFTER_DRAIN) { E(acc, cur, wr, wc, fr, fq); S.done(cur); }
        if (!has_next) break;
#pragma unroll
        for (int a = 0; a < 2; ++a)
#pragma unroll
            for (int b = 0; b < 2; ++b)
#pragma unroll
                for (int m = 0; m < 4; ++m)
#pragma unroll
                    for (int n = 0; n < 2; ++n) acc[a][b][m][n] = (f32x4){0.f, 0.f, 0.f, 0.f};
        cur = nxt; cA = nA; cB = nB; ++ui;
        if constexpr (ALIGN_EPI) { if (wr == 1) PG8_BAR; }
    }
    PG8_WAIT_V(0);
    if constexpr (!ALIGN_EPI) { if (wr == 0) PG8_BAR; }
    PG8_BAR;
    if constexpr (Epi::AFTER_DRAIN) { E.fused(acc, cur, wr, wc, fr, fq, lds, wid, lane); S.done(cur); }
#undef PG8_SA
#undef PG8_SB
#undef PG8_STAGE
#undef PG8_LDA
#undef PG8_LDB
#undef PG8_MMA
#undef PG8_WAIT_V
#undef PG8_WAIT_L
#undef PG8_BAR
#undef PG8_SCHED
}
}
#define GAS __attribute__((address_space(1)))
#define LAS __attribute__((address_space(3)))
typedef unsigned short bf16;
typedef unsigned v4u __attribute__((ext_vector_type(4)));
typedef unsigned v2u __attribute__((ext_vector_type(2)));
typedef float f32x4 __attribute__((ext_vector_type(4)));
typedef float f32x2 __attribute__((ext_vector_type(2)));
typedef short bf16x8 __attribute__((ext_vector_type(8)));
typedef __bf16 bf16x2_t __attribute__((ext_vector_type(2)));

constexpr int NWAVES = 8, NTHR = 512;
constexpr int DM = 2048, NB = 4, SEQ = 8192, M = NB * SEQ;
constexpr int RW = 1024, RHEADS = 16, HD = 64;
constexpr int L_W = 64, L_A = 64, L_G = 160;
constexpr int INP = 5936, INPP = 6144;
constexpr int C_R = 0, C_K = 1024, C_V = 2048, C_WD = 3072, C_AD = 3136, C_GD = 3200, C_Z = 3360, C_XBC = 4384, C_DT = 5920;
constexpr int MODW = 6 * DM;
constexpr int NEXP = 16384;
constexpr float RMS_EPS = 1e-6f;

enum { I_X = 0, I_C, I_ADAW, I_ADAB, I_N1W, I_WIN, I_MU, I_W0, I_WUP, I_A0, I_AUP, I_GUP, I_KK, I_KA, I_RK, I_LNW, I_LNB,
       I_CONVW, I_CONVB, I_DTB, I_ALOG, I_DSK, I_MNW, I_WOUT, I_N2W, I_WQ, I_KEYS, I_PU, I_PV, I_FNW, N_IN };

constexpr size_t MiB = 1u << 20;
constexpr size_t WS_CTL = 0, CTL_ZERO_BYTES = 1 * MiB;
constexpr size_t WS_MOD = 1 * MiB;
constexpr size_t WS_WIN = 2 * MiB, WS_WOUT = 26 * MiB, WS_WQ = 34 * MiB, WS_KEYS = 42 * MiB;
constexpr size_t WS_WUPT = 43 * MiB, WS_AUPT = 43 * MiB + 256 * 1024, WS_GUPT = 43 * MiB + 512 * 1024;
constexpr size_t WS_PU8 = 44 * MiB, WS_PV8 = 76 * MiB;
constexpr size_t WS_USC = 108 * MiB, WS_VSC = 108 * MiB + 65536;
constexpr size_t WS_XN = 172 * MiB;
constexpr size_t WS_LW = WS_XN, WS_AA = WS_XN + 64 * MiB;
constexpr size_t WS_PROJ = 300 * MiB;
constexpr size_t WS_Q = WS_PROJ;
constexpr size_t WS_GG = 684 * MiB;
constexpr size_t WS_X8 = WS_PROJ + 192 * MiB;
constexpr size_t WS_PD = WS_PROJ + 128 * MiB;
constexpr size_t WS_RTE = 684 * MiB, WS_RTG = 700 * MiB, WS_COEF = 716 * MiB;
constexpr size_t WS_OY = 748 * MiB;
constexpr size_t WS_END = 876 * MiB;
constexpr size_t WS_HB = 876 * MiB;

constexpr int RING_BYTES = 131072, LDS_BYTES = 147456;

#define LDS_WAIT() asm volatile("s_waitcnt lgkmcnt(0)" ::: "memory")
#define VM_WAIT() asm volatile("s_waitcnt vmcnt(0)" ::: "memory")
__device__ __forceinline__ unsigned pk2(float lo, float hi) { f32x2 v = {lo, hi}; bf16x2_t b = __builtin_convertvector(v, bf16x2_t); return __builtin_bit_cast(unsigned, b); }
__device__ __forceinline__ float bflo(unsigned u) { return __uint_as_float(u << 16); }
__device__ __forceinline__ float bfhi(unsigned u) { return __uint_as_float(u & 0xffff0000u); }
__device__ __forceinline__ float bf1(bf16 h) { return __uint_as_float((unsigned)h << 16); }
__device__ __forceinline__ float wave_sum(float v) {
#pragma unroll
    for (int o = 1; o < 64; o <<= 1) v += __shfl_xor(v, o);
    return v;
}
__device__ __forceinline__ float rcp_f(float v) { return __builtin_amdgcn_rcpf(v); }
template <int CTRL> __device__ __forceinline__ float dppc_f(float x) { return __builtin_bit_cast(float, __builtin_amdgcn_mov_dpp(__builtin_bit_cast(int, x), CTRL, 0xf, 0xf, true)); }
__device__ __forceinline__ float wave_sum_fast(float x) {
    x += dppc_f<0xB1>(x); x += dppc_f<0x4E>(x); x += dppc_f<0x124>(x); x += dppc_f<0x128>(x);
    { auto rr = __builtin_amdgcn_permlane16_swap(__float_as_uint(x), __float_as_uint(x), false, false); x = __uint_as_float(rr[0]) + __uint_as_float(rr[1]); }
    { auto rr = __builtin_amdgcn_permlane32_swap(__float_as_uint(x), __float_as_uint(x), false, false); x = __uint_as_float(rr[0]) + __uint_as_float(rr[1]); }
    return x;
}
__device__ __forceinline__ float silu_f(float v) { return v * rcp_f(1.f + __expf(-v)); }
__device__ __forceinline__ float sigmoid_f(float v) { return rcp_f(1.f + __expf(-v)); }

struct Ctx {
    LAS unsigned char* lds;
    int tid, lane, wave, G, gw, NGW;
    const float* const* in;
    float* out; unsigned char* ws;
};

__device__ __forceinline__ void transpose_item(const float* W, int K, int N, bf16* WT, int ldt, int nrows_out, LAS float* scr, int kb, int nb, int lane) {
    const int k0 = 64 * kb, n0 = 64 * nb;
    const int c4 = 4 * (lane & 15), rr = lane >> 4;
    const bool vec_ok = ((N & 3) == 0) && (n0 + 64 <= N);
#pragma unroll 4
    for (int i = 0; i < 16; ++i) { const int kk = 4 * i + rr, k = k0 + kk;
        f32x4 v = {0.f, 0.f, 0.f, 0.f};
        if (k < K) { const float* src = W + (size_t)k * N + n0 + c4;
            if (vec_ok) v = *(const f32x4*)src;
            else { if (n0 + c4 + 0 < N) v.x = src[0]; if (n0 + c4 + 1 < N) v.y = src[1]; if (n0 + c4 + 2 < N) v.z = src[2]; if (n0 + c4 + 3 < N) v.w = src[3]; } }
        LAS float* d = scr + kk * 65 + c4; d[0] = v.x; d[1] = v.y; d[2] = v.z; d[3] = v.w; }
    LDS_WAIT(); asm volatile("" ::: "memory");
    const int c = lane & 7;
#pragma unroll
    for (int j = 0; j < 8; ++j) { const int n = (lane >> 3) + 8 * j; const LAS float* sp = scr + (8 * c) * 65 + n;
        v4u o; o.x = pk2(sp[0 * 65], sp[1 * 65]); o.y = pk2(sp[2 * 65], sp[3 * 65]); o.z = pk2(sp[4 * 65], sp[5 * 65]); o.w = pk2(sp[6 * 65], sp[7 * 65]);
        if (n0 + n < nrows_out && k0 + 8 * c + 8 <= ldt) *(v4u*)(WT + (size_t)(n0 + n) * ldt + k0 + 8 * c) = o; }
    LDS_WAIT(); asm volatile("" ::: "memory");
}
__device__ __forceinline__ void transpose_all(const float* W, int K, int N, bf16* WT, int ldt, int nrows_out, LAS float* scr, int gw, int NGW, int lane) {
    const int nkb = (K + 63) / 64, nnb = nrows_out / 64, nit = nkb * nnb;
    for (int it = gw; it < nit; it += NGW) transpose_item(W, K, N, WT, ldt, nrows_out, scr, it / nnb, it % nnb, lane);
}
__device__ __forceinline__ void convert_all(const float* src, bf16* dst, size_t n8, int gw, int NGW, int lane) {
    const f32x4* s4 = (const f32x4*)src; v4u* d4 = (v4u*)dst;
    for (size_t i = (size_t)gw * 64 + lane; i < n8; i += (size_t)NGW * 64) {
        const f32x4 a = __builtin_nontemporal_load(s4 + 2 * i), b = __builtin_nontemporal_load(s4 + 2 * i + 1);
        v4u o; o.x = pk2(a.x, a.y); o.y = pk2(a.z, a.w); o.z = pk2(b.x, b.y); o.w = pk2(b.z, b.w);
        d4[i] = o; }
}
__device__ __forceinline__ void quantize_rows_fp8(const float* src, unsigned char* dst8, float* scales, int e0, int e1, int step, int lane) {
    if (e0 >= e1) return;
    f32x4 vn[8];
    { const f32x4* s4 = (const f32x4*)(src + (size_t)e0 * DM) + lane;
#pragma unroll
      for (int i = 0; i < 8; ++i) vn[i] = __builtin_nontemporal_load(s4 + 64 * i); }
    for (int e = e0; e < e1; e += step) {
        f32x4 v[8];
#pragma unroll
        for (int i = 0; i < 8; ++i) v[i] = vn[i];
        { const int en = (e + step < e1) ? e + step : e; const f32x4* s4 = (const f32x4*)(src + (size_t)en * DM) + lane;
#pragma unroll
          for (int i = 0; i < 8; ++i) vn[i] = __builtin_nontemporal_load(s4 + 64 * i); }
        float am = 0.f;
#pragma unroll
        for (int i = 0; i < 8; ++i) am = fmaxf(fmaxf(am, fmaxf(fabsf(v[i].x), fabsf(v[i].y))), fmaxf(fabsf(v[i].z), fabsf(v[i].w)));
#pragma unroll
        for (int o = 1; o < 64; o <<= 1) am = fmaxf(am, __shfl_xor(am, o));
        am = fmaxf(am, 1e-30f);
        const float inv = 440.f / am;
#pragma unroll
        for (int i = 0; i < 8; ++i) { int w = __builtin_amdgcn_cvt_pk_fp8_f32(v[i].x * inv, v[i].y * inv, 0, false); w = __builtin_amdgcn_cvt_pk_fp8_f32(v[i].z * inv, v[i].w * inv, w, true);
            const int seg = 2 * i + (lane >> 5);
            *(int*)(dst8 + (size_t)seg * ((size_t)NEXP * 128) + (size_t)e * 128 + 4 * (lane & 31)) = w; }
        if (lane == 0) scales[e] = am * (1.f / 440.f);
    }
}
__device__ __forceinline__ void quantize_rows_fp4(const float* src, unsigned char* dst4, float* scales, int e0, int e1, int step, int lane) {
    if (e0 >= e1) return;
    f32x4 vn[8];
    { const f32x4* s4 = (const f32x4*)(src + (size_t)e0 * DM) + lane;
#pragma unroll
      for (int i = 0; i < 8; ++i) vn[i] = __builtin_nontemporal_load(s4 + 64 * i); }
    for (int e = e0; e < e1; e += step) {
        f32x4 v[8];
#pragma unroll
        for (int i = 0; i < 8; ++i) v[i] = vn[i];
        { const int en = (e + step < e1) ? e + step : e; const f32x4* s4 = (const f32x4*)(src + (size_t)en * DM) + lane;
#pragma unroll
          for (int i = 0; i < 8; ++i) vn[i] = __builtin_nontemporal_load(s4 + 64 * i); }
        float am = 0.f;
#pragma unroll
        for (int i = 0; i < 8; ++i) am = fmaxf(am, fmaxf(fmaxf(fabsf(v[i].x), fabsf(v[i].y)), fmaxf(fabsf(v[i].z), fabsf(v[i].w))));
#pragma unroll
        for (int o = 1; o < 64; o <<= 1) am = fmaxf(am, __shfl_xor(am, o));
        am = fmaxf(am, 1e-30f);
        const float inv = 6.f / am;
#pragma unroll
        for (int i = 0; i < 8; ++i) {
            unsigned w = __builtin_amdgcn_cvt_scalef32_pk_fp4_f32(0u, v[i].x * inv, v[i].y * inv, 1.0f, 0);
            w = __builtin_amdgcn_cvt_scalef32_pk_fp4_f32(w, v[i].z * inv, v[i].w * inv, 1.0f, 1);
            *(unsigned short*)(dst4 + (size_t)i * ((size_t)NEXP * 128) + (size_t)e * 128 + 2 * lane) = (unsigned short)w;
        }
        if (lane == 0) scales[e] = am * (1.f / 6.f);
    }
}
__device__ __forceinline__ void p0_prologue(const Ctx& F) {
    __syncthreads();
    if (blockIdx.x < MODW / 64) {
        LAS float* sc = (LAS float*)F.lds;
        LAS float* red = sc + NB * DM;
        const float* c = F.in[I_C];
        for (int i = F.tid; i < NB * DM; i += NTHR) sc[i] = silu_f(c[i]);
        __syncthreads();
        const int j = blockIdx.x * 64 + F.lane;
        const float* wp = F.in[I_ADAW] + (size_t)(F.wave * 256) * MODW + j;
        float a0 = 0.f, a1 = 0.f, a2 = 0.f, a3 = 0.f;
#pragma unroll 32
        for (int kk = 0; kk < 256; ++kk) { const float w = wp[(size_t)kk * MODW]; const int k = F.wave * 256 + kk;
            a0 += sc[k] * w; a1 += sc[DM + k] * w; a2 += sc[2 * DM + k] * w; a3 += sc[3 * DM + k] * w; }
        red[(F.wave * 4 + 0) * 64 + F.lane] = a0; red[(F.wave * 4 + 1) * 64 + F.lane] = a1; red[(F.wave * 4 + 2) * 64 + F.lane] = a2; red[(F.wave * 4 + 3) * 64 + F.lane] = a3;
        __syncthreads();
        if (F.tid < 256) { const int b = F.tid >> 6, l = F.tid & 63; float s = F.in[I_ADAB][blockIdx.x * 64 + l];
#pragma unroll
            for (int w = 0; w < 8; ++w) s += red[(w * 4 + b) * 64 + l];
            ((float*)(F.ws + WS_MOD))[b * MODW + blockIdx.x * 64 + l] = s; }
        __syncthreads();
    }
    LAS float* scr = (LAS float*)(F.lds + F.wave * 16640);
    transpose_all(F.in[I_WIN], DM, INP, (bf16*)(F.ws + WS_WIN), DM, INPP, scr, F.gw, F.NGW, F.lane);
    transpose_all(F.in[I_WOUT], DM, DM, (bf16*)(F.ws + WS_WOUT), DM, DM, scr, F.gw, F.NGW, F.lane);
    transpose_all(F.in[I_WQ], DM, DM, (bf16*)(F.ws + WS_WQ), DM, DM, scr, F.gw, F.NGW, F.lane);
    transpose_all(F.in[I_WUP], L_W, RW, (bf16*)(F.ws + WS_WUPT), L_W, RW, scr, F.gw, F.NGW, F.lane);
    transpose_all(F.in[I_AUP], L_A, RW, (bf16*)(F.ws + WS_AUPT), L_A, RW, scr, F.gw, F.NGW, F.lane);
    transpose_all(F.in[I_GUP], L_G, RW, (bf16*)(F.ws + WS_GUPT), L_G, RW, scr, F.gw, F.NGW, F.lane);
    convert_all(F.in[I_KEYS], (bf16*)(F.ws + WS_KEYS), (size_t)16 * 128 * 128 / 8, F.gw, F.NGW, F.lane);
    {
        const int nlo = (F.G < 192) ? F.G : 192, nhi = F.G - nlo;
        const int wtot = 5 * nlo + 8 * nhi;
        const int wb0 = (blockIdx.x < nlo) ? 5 * blockIdx.x : 5 * nlo + 8 * (blockIdx.x - nlo), wb1 = wb0 + ((blockIdx.x < nlo) ? 5 : 8);
        const int r0 = (int)((long)(2 * NEXP) * wb0 / wtot), r1 = (int)((long)(2 * NEXP) * wb1 / wtot);
        const int a0 = r0 < NEXP ? r0 : NEXP, a1 = r1 < NEXP ? r1 : NEXP;
        quantize_rows_fp4(F.in[I_PU], F.ws + WS_PU8, (float*)(F.ws + WS_USC), a0 + F.wave, a1, NWAVES, F.lane);
        const int b0 = (r0 > NEXP ? r0 : NEXP) - NEXP, b1 = (r1 > NEXP ? r1 : NEXP) - NEXP;
        quantize_rows_fp4(F.in[I_PV], F.ws + WS_PV8, (float*)(F.ws + WS_VSC), b0 + F.wave, b1, NWAVES, F.lane);
    }
}

__device__ __forceinline__ void norm_mod_rows(const Ctx& F, const float* X, const float* nw, int shift_off, int scale_off, bf16* XN) {
    const float* mod = (const float*)(F.ws + WS_MOD);
    if (F.gw >= M) return;
    f32x4 vn[8];
    { const f32x4* xr = (const f32x4*)(X + (size_t)F.gw * DM) + F.lane;
#pragma unroll
      for (int j = 0; j < 8; ++j) vn[j] = xr[64 * j]; }
    for (int m = F.gw; m < M; m += F.NGW) {
        const int b = m / SEQ;
        f32x4 v[8]; float s = 0.f;
#pragma unroll
        for (int j = 0; j < 8; ++j) { v[j] = vn[j]; s += (v[j].x * v[j].x + v[j].y * v[j].y) + (v[j].z * v[j].z + v[j].w * v[j].w); }
        { const int mn = (m + F.NGW < M) ? m + F.NGW : m; const f32x4* xr = (const f32x4*)(X + (size_t)mn * DM) + F.lane;
#pragma unroll
          for (int j = 0; j < 8; ++j) vn[j] = xr[64 * j]; }
        const float rstd = rsqrtf(wave_sum_fast(s) * (1.f / DM) + RMS_EPS);
        const f32x4* wp = (const f32x4*)nw + F.lane;
        const f32x4* shp = (const f32x4*)(mod + (size_t)b * MODW + shift_off) + F.lane;
        const f32x4* scp = (const f32x4*)(mod + (size_t)b * MODW + scale_off) + F.lane;
        v2u* o = (v2u*)(XN + (size_t)m * DM) + F.lane;
#pragma unroll
        for (int j = 0; j < 8; ++j) { const f32x4 w = wp[64 * j], a = scp[64 * j], c = shp[64 * j];
            const f32x4 r = (v[j] * rstd) * w * (a + 1.f) + c;
            v2u p; p.x = pk2(r.x, r.y); p.y = pk2(r.z, r.w); o[64 * j] = p; }
    }
}
__device__ __forceinline__ void final_norm_rows(const Ctx& F, const float* H, const float* nw, float* O) {
    for (int m = F.gw; m < M; m += F.NGW) {
        const f32x4* xr = (const f32x4*)(H + (size_t)m * DM) + F.lane;
        f32x4 v[8]; float s = 0.f;
#pragma unroll
        for (int j = 0; j < 8; ++j) { v[j] = xr[64 * j]; s += (v[j].x * v[j].x + v[j].y * v[j].y) + (v[j].z * v[j].z + v[j].w * v[j].w); }
        const float rstd = rsqrtf(wave_sum(s) * (1.f / DM) + RMS_EPS);
        const f32x4* wp = (const f32x4*)nw + F.lane;
        f32x4* o = (f32x4*)(O + (size_t)m * DM) + F.lane;
#pragma unroll
        for (int j = 0; j < 8; ++j) o[64 * j] = (v[j] * rstd) * wp[64 * j];
    }
}


__device__ __forceinline__ void load_row_raw(const bf16* row, int lane, v2u (&u)[8]) {
    const v2u* p = (const v2u*)row + lane;
#pragma unroll
    for (int j = 0; j < 8; ++j) u[j] = p[64 * j];
}
__device__ __forceinline__ void norm_mod_rows_bf16(const Ctx& F, const bf16* X, const float* nw, int shift_off, int scale_off, bf16* XN, unsigned* X8 = nullptr) {
    const float* mod = (const float*)(F.ws + WS_MOD);
    if (F.gw >= M) return;
    v2u un[8]; load_row_raw(X + (size_t)F.gw * DM, F.lane, un);
    for (int m = F.gw; m < M; m += F.NGW) {
        const int b = m / SEQ;
        f32x4 v[8]; float s = 0.f;
#pragma unroll
        for (int j = 0; j < 8; ++j) { v[j] = (f32x4){bflo(un[j].x), bfhi(un[j].x), bflo(un[j].y), bfhi(un[j].y)}; s += (v[j].x * v[j].x + v[j].y * v[j].y) + (v[j].z * v[j].z + v[j].w * v[j].w); }
        { const int mn = (m + F.NGW < M) ? m + F.NGW : m; load_row_raw(X + (size_t)mn * DM, F.lane, un); }
        const float rstd = rsqrtf(wave_sum_fast(s) * (1.f / DM) + RMS_EPS);
        const f32x4* wp = (const f32x4*)nw + F.lane;
        const f32x4* shp = (const f32x4*)(mod + (size_t)b * MODW + shift_off) + F.lane;
        const f32x4* scp = (const f32x4*)(mod + (size_t)b * MODW + scale_off) + F.lane;
        v2u* o = (v2u*)(XN + (size_t)m * DM) + F.lane;
#pragma unroll
        for (int j = 0; j < 8; ++j) { const f32x4 w = wp[64 * j], a = scp[64 * j], c = shp[64 * j];
            const f32x4 r = (v[j] * rstd) * w * (a + 1.f) + c;
            v2u p; p.x = pk2(r.x, r.y); p.y = pk2(r.z, r.w); o[64 * j] = p;
            if (X8) { int w8 = __builtin_amdgcn_cvt_pk_fp8_f32(r.x, r.y, 0, false); w8 = __builtin_amdgcn_cvt_pk_fp8_f32(r.z, r.w, w8, true); X8[(size_t)m * (DM / 4) + F.lane + 64 * j] = (unsigned)w8; } }
    }
}
__device__ __forceinline__ void final_norm_rows_bf16(const Ctx& F, const bf16* H, const float* nw, float* O, float oscale) {
    if (F.gw >= M) return;
    v2u un[8]; load_row_raw(H + (size_t)F.gw * DM, F.lane, un);
    f32x4 wv[8];
#pragma unroll
    for (int j = 0; j < 8; ++j) wv[j] = ((const f32x4*)nw + F.lane)[64 * j];
    for (int m = F.gw; m < M; m += F.NGW) {
        f32x4 v[8]; float s = 0.f;
#pragma unroll
        for (int j = 0; j < 8; ++j) { v[j] = (f32x4){bflo(un[j].x), bfhi(un[j].x), bflo(un[j].y), bfhi(un[j].y)}; s += (v[j].x * v[j].x + v[j].y * v[j].y) + (v[j].z * v[j].z + v[j].w * v[j].w); }
        { const int mn = (m + F.NGW < M) ? m + F.NGW : m; load_row_raw(H + (size_t)mn * DM, F.lane, un); }
        const float rstd = rsqrtf(wave_sum_fast(s) * (1.f / DM) + RMS_EPS) * oscale;
        f32x4* o = (f32x4*)(O + (size_t)m * DM) + F.lane;
#pragma unroll
        for (int j = 0; j < 8; ++j) __builtin_nontemporal_store((v[j] * rstd) * wv[j], o + 64 * j);
    }
}
#define LO2(v) __builtin_shufflevector((v), (v), 0, 1)
#define HI2(v) __builtin_shufflevector((v), (v), 2, 3)
template <int CTRL> __device__ __forceinline__ float dpp_f(float x) { return __builtin_bit_cast(float, __builtin_amdgcn_mov_dpp(__builtin_bit_cast(int, x), CTRL, 0xf, 0xf, true)); }
__device__ __forceinline__ float rowsum16(float x) { x += dpp_f<0xB1>(x); x += dpp_f<0x4E>(x); x += dpp_f<0x124>(x); x += dpp_f<0x128>(x); return x; }
__device__ __forceinline__ float quadsum(float x) { x += dpp_f<0xB1>(x); x += dpp_f<0x4E>(x); return x; }

__device__ __forceinline__ float treduce16(const float (&p)[16], bool b0, bool b1, bool b2, bool b3) {
    float a[8], bq[4], c2[2];
#pragma unroll
    for (int j = 0; j < 8; ++j) { const float mine = b3 ? p[j + 8] : p[j], send = b3 ? p[j] : p[j + 8]; a[j] = mine + dpp_f<0x128>(send); }
#pragma unroll
    for (int j = 0; j < 4; ++j) { const float mine = b2 ? a[j + 4] : a[j], send = b2 ? a[j] : a[j + 4]; const float up = dpp_f<0x104>(send), dn = dpp_f<0x114>(send); bq[j] = mine + (b2 ? dn : up); }
#pragma unroll
    for (int j = 0; j < 2; ++j) { const float mine = b1 ? bq[j + 2] : bq[j], send = b1 ? bq[j] : bq[j + 2]; c2[j] = mine + dpp_f<0x4E>(send); }
    const float mine = b0 ? c2[1] : c2[0], send = b0 ? c2[0] : c2[1];
    return mine + dpp_f<0xB1>(send);
}
__device__ __forceinline__ float wave_sum_dpp(float v) { v = rowsum16(v); v += __shfl_xor(v, 16); v += __shfl_xor(v, 32); return v; }
__device__ __forceinline__ void unpack8(const v4u p, float (&e)[8]) { e[0] = bflo(p.x); e[1] = bfhi(p.x); e[2] = bflo(p.y); e[3] = bfhi(p.y); e[4] = bflo(p.z); e[5] = bfhi(p.z); e[6] = bflo(p.w); e[7] = bfhi(p.w); }
__device__ __forceinline__ v4u pack8(const float (&e)[8]) { v4u o; o.x = pk2(e[0], e[1]); o.y = pk2(e[2], e[3]); o.z = pk2(e[4], e[5]); o.w = pk2(e[6], e[7]); return o; }

__device__ __forceinline__ void p3_lora(const Ctx& F) {
    const bf16* PROJ = (const bf16*)(F.ws + WS_PROJ);
    const bf16* WUPT = (const bf16*)(F.ws + WS_WUPT); const bf16* AUPT = (const bf16*)(F.ws + WS_AUPT); const bf16* GUPT = (const bf16*)(F.ws + WS_GUPT);
    bf16* LW = (bf16*)(F.ws + WS_LW); bf16* AA = (bf16*)(F.ws + WS_AA); bf16* GG = (bf16*)(F.ws + WS_GG);
    const float* mu = F.in[I_MU]; const float* w0 = F.in[I_W0]; const float* a0 = F.in[I_A0];
    const int r16 = F.lane & 15, q = F.lane >> 4;
    constexpr int WST = 72, GST = 168;
    LAS bf16* WU = (LAS bf16*)F.lds; LAS bf16* AU = WU + 128 * WST; LAS bf16* GU = AU + 128 * WST;
    const int nr = blockIdx.x & 7, nbr = (F.G - nr + 7) >> 3;
    __syncthreads();
    for (int i = F.tid; i < 128 * 8; i += NTHR) { const int row = i >> 3, ch = i & 7;
        *(LAS v4u*)(WU + row * WST + 8 * ch) = *(const v4u*)(WUPT + (size_t)(128 * nr + row) * L_W + 8 * ch);
        *(LAS v4u*)(AU + row * WST + 8 * ch) = *(const v4u*)(AUPT + (size_t)(128 * nr + row) * L_A + 8 * ch); }
    for (int i = F.tid; i < 128 * 20; i += NTHR) { const int row = i / 20, ch = i - row * 20;
        *(LAS v4u*)(GU + row * GST + 8 * ch) = *(const v4u*)(GUPT + (size_t)(128 * nr + row) * L_G + 8 * ch); }
    __syncthreads();
#define P3_COL(s) ((((s) < 2) ? (C_WD + 32 * (s)) : ((s) < 4) ? (C_AD + 32 * ((s) - 2)) : (C_GD + 32 * ((s) - 4))) + 8 * q)
    const int mt0 = (blockIdx.x >> 3) * NWAVES + F.wave, mst = nbr * NWAVES;
    v4u rc_[9], rp_[9];
    if (mt0 < M / 16) { const bf16* row = PROJ + (size_t)(mt0 * 16 + r16) * INPP;
#pragma unroll
        for (int s = 0; s < 9; ++s) { rc_[s] = *(const v4u*)(row + P3_COL(s)); rp_[s] = *(const v4u*)(row - INPP + P3_COL(s)); } }
    for (int mt = mt0; mt < M / 16; mt += mst) {
        const int m = mt * 16 + r16; const bool first = (m % SEQ) == 0;
        bf16x8 af[9];
#pragma unroll
        for (int s = 0; s < 9; ++s) {
            const int col = P3_COL(s);
            const v4u pc = rc_[s];
            v4u pp = rp_[s]; if (first) pp = (v4u){0u, 0u, 0u, 0u};
            const f32x4 m0 = *(const f32x4*)(mu + col), m1 = *(const f32x4*)(mu + col + 4);
            float c[8], p[8], e[8]; unpack8(pc, c); unpack8(pp, p);
            const float mm[8] = {m0.x, m0.y, m0.z, m0.w, m1.x, m1.y, m1.z, m1.w};
#pragma unroll
            for (int j = 0; j < 8; ++j) { float v = c[j] + (p[j] - c[j]) * mm[j];
                if (s < 2) { const float t = __expf(2.f * v); v = 1.f - 2.f * rcp_f(t + 1.f); }
                else if (s >= 4) v = sigmoid_f(v);
                e[j] = v; }
            af[s] = __builtin_bit_cast(bf16x8, pack8(e));
        }
        { const int mtn = (mt + mst < M / 16) ? mt + mst : mt; const bf16* row = PROJ + (size_t)(mtn * 16 + r16) * INPP;
#pragma unroll
          for (int s = 0; s < 9; ++s) { rc_[s] = *(const v4u*)(row + P3_COL(s)); rp_[s] = *(const v4u*)(row - INPP + P3_COL(s)); } }
        asm volatile("" ::: "memory");
#pragma unroll 2
        for (int nt = 0; nt < 8; ++nt) {
            const LAS bf16* wu = WU + (16 * nt + r16) * WST + 8 * q; const LAS bf16* au = AU + (16 * nt + r16) * WST + 8 * q; const LAS bf16* gu = GU + (16 * nt + r16) * GST + 8 * q;
            f32x4 acc0 = {0.f, 0.f, 0.f, 0.f}, acc1 = acc0, acc2 = acc0;
#pragma unroll
            for (int s2 = 0; s2 < 2; ++s2) acc0 = __builtin_amdgcn_mfma_f32_16x16x32_bf16(*(const LAS bf16x8*)(wu + 32 * s2), af[s2], acc0, 0, 0, 0);
#pragma unroll
            for (int s2 = 0; s2 < 2; ++s2) acc1 = __builtin_amdgcn_mfma_f32_16x16x32_bf16(*(const LAS bf16x8*)(au + 32 * s2), af[2 + s2], acc1, 0, 0, 0);
#pragma unroll
            for (int s2 = 0; s2 < 5; ++s2) acc2 = __builtin_amdgcn_mfma_f32_16x16x32_bf16(*(const LAS bf16x8*)(gu + 32 * s2), af[4 + s2], acc2, 0, 0, 0);
            const int n = 128 * nr + 16 * nt + 4 * q;
            const f32x4 w0v = *(const f32x4*)(w0 + n), a0v = *(const f32x4*)(a0 + n);
            v2u o0, o1, o2;
            o0.x = pk2(-0.60653066f * sigmoid_f(acc0[0] + w0v.x), -0.60653066f * sigmoid_f(acc0[1] + w0v.y));
            o0.y = pk2(-0.60653066f * sigmoid_f(acc0[2] + w0v.z), -0.60653066f * sigmoid_f(acc0[3] + w0v.w));
            o1.x = pk2(sigmoid_f(acc1[0] + a0v.x), sigmoid_f(acc1[1] + a0v.y)); o1.y = pk2(sigmoid_f(acc1[2] + a0v.z), sigmoid_f(acc1[3] + a0v.w));
            o2.x = pk2(acc2[0], acc2[1]); o2.y = pk2(acc2[2], acc2[3]);
            *(v2u*)(LW + (size_t)m * RW + n) = o0; *(v2u*)(AA + (size_t)m * RW + n) = o1; *(v2u*)(GG + (size_t)m * RW + n) = o2;
        }
    }
#undef P3_COL
    __syncthreads();
}

constexpr int TC = 32, NCHUNK = SEQ / TC;
constexpr int RB_R = 0, RB_W = TC * 64, RB_K = 2 * TC * 64, RB_KK = 3 * TC * 64, RB_KA = 4 * TC * 64, RB_V = 5 * TC * 64, RB_SIZE = 5 * TC * 64 + TC * 16;
constexpr int MB_B = 0, MB_C = TC * 128, MB_X = 2 * TC * 128, MB_DT = MB_X + TC * 32, MB_DA = MB_DT + TC, MB_SIZE = MB_DA + TC;
static_assert(2 * RB_SIZE * 4 <= RING_BYTES, "scan buffers fit the LDS ring");

struct RwkvRaw { bf16 r[9], k[9], v[9], lw[8], a[8]; };
__device__ __forceinline__ void rwkv_load(RwkvRaw& raw, const bf16* PROJ, const bf16* LW, const bf16* AA, int b, int h, int t0w, int c) {
    const bf16* base = PROJ + (size_t)(b * SEQ + t0w) * INPP + h * 64 + c;
#pragma unroll
    for (int i = 0; i < 9; ++i) {
        if (i == 0 && t0w == 0) { raw.r[0] = 0; raw.k[0] = 0; raw.v[0] = 0; }
        else { const bf16* row = base + (long)(i - 1) * INPP; raw.r[i] = row[C_R]; raw.k[i] = row[C_K]; raw.v[i] = row[C_V]; }
    }
#pragma unroll
    for (int i = 0; i < 8; ++i) { const size_t o = (size_t)(b * SEQ + t0w + i) * RW + h * 64 + c; raw.lw[i] = LW[o]; raw.a[i] = AA[o]; }
}
__device__ __forceinline__ void rwkv_stage(const RwkvRaw& raw, LAS float* buf, int tl0, int c, int qt, float mu_r, float mu_k, float mu_v, float kkw, float kaw) {
#pragma unroll
    for (int i = 0; i < 8; ++i) {
        const int t = tl0 + i;
        const float rc = bf1(raw.r[i + 1]), rp = bf1(raw.r[i]), kc = bf1(raw.k[i + 1]), kp = bf1(raw.k[i]), vc = bf1(raw.v[i + 1]), vp = bf1(raw.v[i]);
        const float rr = rc + (rp - rc) * mu_r, kx = kc + (kp - kc) * mu_k, vv = vc + (vp - vc) * mu_v;
        const float a = bf1(raw.a[i]), dec = __expf(bf1(raw.lw[i]));
        const float kkraw = kx * kkw; const float ss = wave_sum_dpp(kkraw * kkraw);
        const float kkn = kkraw * rcp_f(fmaxf(sqrtf(ss), 1e-12f));
        buf[RB_R + t * 64 + c] = rr; buf[RB_W + t * 64 + c] = dec; buf[RB_K + t * 64 + c] = kx * (1.f + (a - 1.f) * kaw);
        buf[RB_KK + t * 64 + c] = kkn; buf[RB_KA + t * 64 + c] = kkn * a;
        if ((c >> 4) == qt) buf[RB_V + t * 16 + (c & 15)] = vv;
    }
}
__device__ __forceinline__ void rwkv_task(const Ctx& F, int task) {
    const int b = task >> 6, h = (task >> 2) & 15, qt = task & 3;
    const bf16* PROJ = (const bf16*)(F.ws + WS_PROJ); const bf16* LW = (const bf16*)(F.ws + WS_LW); const bf16* AA = (const bf16*)(F.ws + WS_AA);
    bf16* OY = (bf16*)(F.ws + WS_OY);
    LAS float* lbuf = (LAS float*)F.lds;
    const int c = F.lane, w = F.wave, r = F.lane >> 4, cg = F.lane & 15;
    const bool stager = w >= 4; const int sw = w & 3;
    const int ch = h * 64 + c;
    const float mu_r = F.in[I_MU][C_R + ch], mu_k = F.in[I_MU][C_K + ch], mu_v = F.in[I_MU][C_V + ch], kkw = F.in[I_KK][ch], kaw = F.in[I_KA][ch];
    RwkvRaw raw;
    if (stager) { rwkv_load(raw, PROJ, LW, AA, b, h, 8 * sw, c); rwkv_stage(raw, lbuf, 8 * sw, c, qt, mu_r, mu_k, mu_v, kkw, kaw); rwkv_load(raw, PROJ, LW, AA, b, h, TC + 8 * sw, c); }
    __syncthreads();
    f32x2 S01 = {0.f, 0.f}, S23 = {0.f, 0.f};
    const bool cb0 = cg & 1, cb1 = cg & 2, cb2 = cg & 4, cb3 = cg & 8;
    bf16* orow = OY + (size_t)(b * SEQ) * DM + h * 64 + 16 * qt + 4 * sw + r;
    for (int ck = 0; ck < NCHUNK; ++ck) {
        const LAS float* buf = lbuf + (ck & 1) * RB_SIZE;
        if (stager) {
            if (ck + 1 < NCHUNK) { rwkv_stage(raw, lbuf + ((ck + 1) & 1) * RB_SIZE, 8 * sw, c, qt, mu_r, mu_k, mu_v, kkw, kaw);
                if (ck + 2 < NCHUNK) rwkv_load(raw, PROJ, LW, AA, b, h, (ck + 2) * TC + 8 * sw, c); }
        } else {
            const LAS float* bp = buf + 4 * cg; const LAS float* vp = buf + RB_V + 4 * sw + r;
            f32x4 qkk[3], qw[3], qka[3], qk[3], qr[3]; float qv[3];
#pragma unroll
            for (int i = 0; i < 3; ++i) { qkk[i] = *(const LAS f32x4*)(bp + RB_KK + i * 64); qw[i] = *(const LAS f32x4*)(bp + RB_W + i * 64); qka[i] = *(const LAS f32x4*)(bp + RB_KA + i * 64);
                qk[i] = *(const LAS f32x4*)(bp + RB_K + i * 64); qr[i] = *(const LAS f32x4*)(bp + RB_R + i * 64); qv[i] = vp[i * 16]; }
            float op[16];
#pragma unroll
            for (int j = 0; j < TC; ++j) {
                const int u = j % 3;
                const f32x4 kk4 = qkk[u], w4 = qw[u], ka4 = qka[u], k4 = qk[u], r4 = qr[u]; const float vr = qv[u];
                const f32x2 tq = S01 * LO2(kk4) + S23 * HI2(kk4);
                const float sa = rowsum16(tq.x + tq.y);
                const f32x2 sav = {sa, sa}, vrv = {vr, vr};
                S01 = S01 * LO2(w4) + (vrv * LO2(k4) - sav * LO2(ka4));
                S23 = S23 * HI2(w4) + (vrv * HI2(k4) - sav * HI2(ka4));
                const f32x2 uq = S01 * LO2(r4) + S23 * HI2(r4);
                op[j & 15] = uq.x + uq.y;
                asm volatile("" : "+v"(S01), "+v"(S23) :: "memory");
                if (j + 3 < TC) { qkk[u] = *(const LAS f32x4*)(bp + RB_KK + (j + 3) * 64); qw[u] = *(const LAS f32x4*)(bp + RB_W + (j + 3) * 64); qka[u] = *(const LAS f32x4*)(bp + RB_KA + (j + 3) * 64);
                                  qk[u] = *(const LAS f32x4*)(bp + RB_K + (j + 3) * 64); qr[u] = *(const LAS f32x4*)(bp + RB_R + (j + 3) * 64); qv[u] = vp[(j + 3) * 16]; }
                if ((j & 15) == 15) {
                    const float ored = treduce16(op, cb0, cb1, cb2, cb3);
                    orow[(size_t)(ck * TC + (j - 15) + cg) * DM] = (bf16)(pk2(ored, 0.f) & 0xffffu);
                }
            }
        }
        __syncthreads();
    }
}

__device__ __forceinline__ void p4_scans(const Ctx& F) {
    for (int task = blockIdx.x; task < NB * RHEADS * 4; task += F.G) { rwkv_task(F, task); __syncthreads(); }
}

__device__ __forceinline__ void ld16(const float* p, float (&v)[16]) {
#pragma unroll
    for (int i = 0; i < 4; ++i) { const f32x4 t = *(const f32x4*)(p + 4 * i); v[4 * i] = t.x; v[4 * i + 1] = t.y; v[4 * i + 2] = t.z; v[4 * i + 3] = t.w; }
}
__device__ __forceinline__ void ldbf16x16(const bf16* p, float (&v)[16]) {
    float t0[8], t1[8]; unpack8(*(const v4u*)p, t0); unpack8(*(const v4u*)(p + 8), t1);
#pragma unroll
    for (int j = 0; j < 8; ++j) { v[j] = t0[j]; v[8 + j] = t1[j]; }
}
__device__ __forceinline__ void stbf16x16(bf16* p, const float (&v)[16]) {
    float t0[8], t1[8];
#pragma unroll
    for (int j = 0; j < 8; ++j) { t0[j] = v[j]; t1[j] = v[8 + j]; }
    *(v4u*)p = pack8(t0); *(v4u*)(p + 8) = pack8(t1);
}
__device__ __forceinline__ void p5_post(const Ctx& F) {
    const bf16* PROJ = (const bf16*)(F.ws + WS_PROJ); const bf16* AA = (const bf16*)(F.ws + WS_AA); const bf16* GG = (const bf16*)(F.ws + WS_GG);
    bf16* OY = (bf16*)(F.ws + WS_OY);
    const int c0 = 16 * F.lane;
    {
        float mur[16], muk[16], muv[16], ka[16], rk[16], lnw[16], lnb[16];
        ld16(F.in[I_MU] + C_R + c0, mur); ld16(F.in[I_MU] + C_K + c0, muk); ld16(F.in[I_MU] + C_V + c0, muv);
        ld16(F.in[I_KA] + c0, ka); ld16(F.in[I_RK] + c0, rk); ld16(F.in[I_LNW] + c0, lnw); ld16(F.in[I_LNB] + c0, lnb);
        for (int m = F.gw; m < M; m += F.NGW) {
            const bool first = (m % SEQ) == 0;
            const bf16* prow = PROJ + (size_t)m * INPP; bf16* oyrow = OY + (size_t)m * DM;
            float o[16], res[16]; float bs = 0.f;
            ldbf16x16(oyrow + c0, o);
            {
                float rc[16], rp[16], kc[16], kp[16], av[16];
                ldbf16x16(prow + C_R + c0, rc); ldbf16x16(prow + C_K + c0, kc); ldbf16x16(AA + (size_t)m * RW + c0, av);
                if (!first) { ldbf16x16(prow - INPP + C_R + c0, rp); ldbf16x16(prow - INPP + C_K + c0, kp); }
                else {
#pragma unroll
                    for (int j = 0; j < 16; ++j) { rp[j] = 0.f; kp[j] = 0.f; } }
#pragma unroll
                for (int j = 0; j < 16; ++j) { const float rr = rc[j] + (rp[j] - rc[j]) * mur[j], kx = kc[j] + (kp[j] - kc[j]) * muk[j];
                    bs += rr * (kx * (1.f + (av[j] - 1.f) * ka[j])) * rk[j]; }
            }
            bs = quadsum(bs);
            float s = 0.f;
#pragma unroll
            for (int j = 0; j < 16; ++j) s += o[j];
            const float mean = quadsum(s) * (1.f / 64.f);
            float qv = 0.f;
#pragma unroll
            for (int j = 0; j < 16; ++j) { o[j] -= mean; qv += o[j] * o[j]; }
            const float rstd = rsqrtf(quadsum(qv) * (1.f / 64.f) + 64e-5f);
            {
                float vc[16], vp[16], gv[16];
                ldbf16x16(prow + C_V + c0, vc); ldbf16x16(GG + (size_t)m * RW + c0, gv);
                if (!first) ldbf16x16(prow - INPP + C_V + c0, vp);
                else {
#pragma unroll
                    for (int j = 0; j < 16; ++j) vp[j] = 0.f; }
#pragma unroll
                for (int j = 0; j < 16; ++j) { const float vv = vc[j] + (vp[j] - vc[j]) * muv[j]; res[j] = (o[j] * rstd * lnw[j] + lnb[j] + bs * vv) * gv[j]; }
            }
            stbf16x16(oyrow + c0, res);
        }
    }
    {
        float nw[16]; ld16(F.in[I_MNW] + c0, nw);
        int m = F.gw;
        v4u yr[2], zr[2];
        if (m < M) { const bf16* prow = PROJ + (size_t)m * INPP; const bf16* oyrow = OY + (size_t)m * DM;
            yr[0] = *(const v4u*)(oyrow + RW + c0); yr[1] = *(const v4u*)(oyrow + RW + c0 + 8); zr[0] = *(const v4u*)(prow + C_Z + c0); zr[1] = *(const v4u*)(prow + C_Z + c0 + 8); }
        for (; m < M; m += F.NGW) {
            bf16* oyrow = OY + (size_t)m * DM;
            float y[16], z[16];
            { float t0[8], t1[8]; unpack8(yr[0], t0); unpack8(yr[1], t1);
#pragma unroll
              for (int j = 0; j < 8; ++j) { y[j] = t0[j]; y[8 + j] = t1[j]; }
              unpack8(zr[0], t0); unpack8(zr[1], t1);
#pragma unroll
              for (int j = 0; j < 8; ++j) { z[j] = t0[j]; z[8 + j] = t1[j]; } }
            { const int mn = (m + F.NGW < M) ? m + F.NGW : m; const bf16* prow = PROJ + (size_t)mn * INPP; const bf16* oyn = OY + (size_t)mn * DM;
              yr[0] = *(const v4u*)(oyn + RW + c0); yr[1] = *(const v4u*)(oyn + RW + c0 + 8); zr[0] = *(const v4u*)(prow + C_Z + c0); zr[1] = *(const v4u*)(prow + C_Z + c0 + 8); }
            asm volatile("" ::: "memory");
            float qv = 0.f;
#pragma unroll
            for (int j = 0; j < 16; ++j) { y[j] *= silu_f(z[j]); qv += y[j] * y[j]; }
            qv = rowsum16(qv);
            { auto rr = __builtin_amdgcn_permlane16_swap(__float_as_uint(qv), __float_as_uint(qv), false, false); qv = __uint_as_float(rr[0]) + __uint_as_float(rr[1]); }
            const float rstd = rsqrtf(qv * (1.f / 512.f) + 1e-5f);
#pragma unroll
            for (int j = 0; j < 16; ++j) y[j] = y[j] * rstd * nw[j];
            stbf16x16(oyrow + RW + c0, y);
        }
    }
}
constexpr int MC_L = 128, MC_NC = SEQ / MC_L, LSTR = 136;
constexpr int MT_BYTES = 128 * LSTR * 2;
constexpr size_t WS_ST = 876 * MiB, WS_SIN = 940 * MiB, WS_ATOT = 1004 * MiB, WS_END2 = 1005 * MiB;

__device__ __forceinline__ float mamba_dt_scan(const Ctx& F, const bf16* PROJ, int b, int c, int g, LAS float* DT, LAS float* ACS) {
    const int head = g * 8 + F.wave, lane = F.lane;
    const float dtb = F.in[I_DTB][head], Aneg = -__expf(F.in[I_ALOG][head]);
    const bf16* p = PROJ + (size_t)(b * SEQ + c * MC_L + 2 * lane) * INPP + C_DT + head;
    const float x0 = bf1(p[0]) + dtb, x1 = bf1(p[INPP]) + dtb;
    const float d0 = (x0 > 20.f) ? x0 : log1pf(__expf(x0)), d1 = (x1 > 20.f) ? x1 : log1pf(__expf(x1));
    const float s0 = d0 * Aneg, s1 = s0 + d1 * Aneg;
    float incl = s1;
#pragma unroll
    for (int o = 1; o < 64; o <<= 1) { const float t = __shfl_up(incl, o); if (lane >= o) incl += t; }
    const float excl = incl - s1;
    DT[F.wave * 128 + 2 * lane] = d0; DT[F.wave * 128 + 2 * lane + 1] = d1;
    ACS[F.wave * 128 + 2 * lane] = excl + s0; ACS[F.wave * 128 + 2 * lane + 1] = excl + s1;
    return __shfl(incl, 63);
}
struct TRaw { bf16 v[35]; };
__device__ __forceinline__ void mstage_T_load(TRaw& raw, const bf16* PROJ, int b, int c, int chn, int tid) {
    const int t0 = 32 * (tid >> 7);
    const bf16* base = PROJ + (size_t)(b * SEQ + c * MC_L + t0) * INPP + C_XBC + chn;
    if (c * MC_L + t0 > 0) { raw.v[0] = base[-3 * INPP]; raw.v[1] = base[-2 * INPP]; raw.v[2] = base[-1 * INPP]; }
    else { raw.v[0] = 0; raw.v[1] = 0; raw.v[2] = 0; }
#pragma unroll
    for (int t = 0; t < 32; ++t) raw.v[3 + t] = base[(size_t)t * INPP];
}
template <bool SC>
__device__ __forceinline__ void mstage_T_store(const TRaw& raw, int chn, LAS bf16* dst, const LAS float* scale, const float* convw, const float* convb, int tid) {
    const int f = tid & 127, t0 = 32 * (tid >> 7);
    const float w0 = convw[chn], w1 = convw[1536 + chn], w2 = convw[2 * 1536 + chn], w3 = convw[3 * 1536 + chn], bb = convb[chn];
#pragma unroll
    for (int i8 = 0; i8 < 4; ++i8) {
        float e[8];
#pragma unroll
        for (int i = 0; i < 8; ++i) { const int t = 8 * i8 + i;
            float v = silu_f(bb + w0 * bf1(raw.v[t]) + w1 * bf1(raw.v[t + 1]) + w2 * bf1(raw.v[t + 2]) + w3 * bf1(raw.v[t + 3]));
            if (SC) v *= scale[t0 + t];
            e[i] = v; }
        *(LAS v4u*)(dst + f * LSTR + t0 + 8 * i8) = pack8(e);
    }
}
__device__ __forceinline__ void mstage_N(const bf16* PROJ, int b, int c, int g, LAS bf16* Bn, LAS bf16* Cn, const float* convw, const float* convb, int tid) {
    const int f8 = tid & 31, t0 = 8 * (tid >> 5);
    const int chn = (f8 < 16) ? (1024 + g * 128 + 8 * f8) : (1280 + g * 128 + 8 * (f8 - 16));
    LAS bf16* dst = ((f8 < 16) ? Bn : Cn) + 8 * (f8 & 15);
    const bf16* base = PROJ + (size_t)(b * SEQ + c * MC_L + t0) * INPP + C_XBC + chn;
    float w[4][8], bb[8];
#pragma unroll
    for (int i = 0; i < 4; ++i) { const f32x4 a = *(const f32x4*)(convw + i * 1536 + chn), d = *(const f32x4*)(convw + i * 1536 + chn + 4);
        w[i][0] = a.x; w[i][1] = a.y; w[i][2] = a.z; w[i][3] = a.w; w[i][4] = d.x; w[i][5] = d.y; w[i][6] = d.z; w[i][7] = d.w; }
    { const f32x4 a = *(const f32x4*)(convb + chn), d = *(const f32x4*)(convb + chn + 4); bb[0] = a.x; bb[1] = a.y; bb[2] = a.z; bb[3] = a.w; bb[4] = d.x; bb[5] = d.y; bb[6] = d.z; bb[7] = d.w; }
    float r0[8], r1[8], r2[8];
    if (c * MC_L + t0 > 0) { unpack8(*(const v4u*)(base - 3 * INPP), r0); unpack8(*(const v4u*)(base - 2 * INPP), r1); unpack8(*(const v4u*)(base - 1 * INPP), r2); }
    else {
#pragma unroll
        for (int k = 0; k < 8; ++k) { r0[k] = 0.f; r1[k] = 0.f; r2[k] = 0.f; } }
#pragma unroll
    for (int t = 0; t < 8; ++t) {
        float r3[8], e[8]; unpack8(*(const v4u*)(base + (size_t)t * INPP), r3);
#pragma unroll
        for (int k = 0; k < 8; ++k) { e[k] = silu_f(bb[k] + w[0][k] * r0[k] + w[1][k] * r1[k] + w[2][k] * r2[k] + w[3][k] * r3[k]); r0[k] = r1[k]; r1[k] = r2[k]; r2[k] = r3[k]; }
        *(LAS v4u*)(dst + (t0 + t) * LSTR) = pack8(e);
    }
}

__device__ __forceinline__ void m1_chunk_states(const Ctx& F) {
    const bf16* PROJ = (const bf16*)(F.ws + WS_PROJ); bf16* ST = (bf16*)(F.ws + WS_ST); float* ATOT = (float*)(F.ws + WS_ATOT);
    LAS bf16* BT = (LAS bf16*)F.lds; LAS bf16* XT = (LAS bf16*)(F.lds + MT_BYTES);
    LAS float* DT = (LAS float*)(F.lds + 3 * MT_BYTES); LAS float* ACS = DT + 8 * 128; LAS float* SCL = ACS + 8 * 128;
    const float* convw = F.in[I_CONVW]; const float* convb = F.in[I_CONVB];
    const int tid = F.tid, w = F.wave, lane = F.lane, r16 = lane & 15, q = lane >> 4;
    for (int it = blockIdx.x; it < NB * MC_NC * 2; it += F.G) {
        const int g = it & 1, c = (it >> 1) & (MC_NC - 1), b = it >> 7;
        __syncthreads();
        const float atot = mamba_dt_scan(F, PROJ, b, c, g, DT, ACS);
        if (lane == 0) ATOT[(b * MC_NC + c) * 16 + g * 8 + w] = atot;
        const int chB = 1024 + g * 128 + (tid & 127);
        TRaw ra, rb;
        mstage_T_load(ra, PROJ, b, c, chB, tid);
        mstage_T_load(rb, PROJ, b, c, (g * 8 + ((tid & 127) >> 6)) * 64 + (tid & 63), tid);
        LDS_WAIT();
        SCL[w * 128 + 2 * lane] = DT[w * 128 + 2 * lane] * __expf(atot - ACS[w * 128 + 2 * lane]);
        SCL[w * 128 + 2 * lane + 1] = DT[w * 128 + 2 * lane + 1] * __expf(atot - ACS[w * 128 + 2 * lane + 1]);
        mstage_T_store<false>(ra, chB, BT, nullptr, convw, convb, tid);
        mstage_T_load(ra, PROJ, b, c, (g * 8 + 2 + ((tid & 127) >> 6)) * 64 + (tid & 63), tid);
        __syncthreads();
#pragma unroll
        for (int hb = 0; hb < 2; ++hb) {
            if (hb == 1) mstage_T_load(ra, PROJ, b, c, (g * 8 + 6 + ((tid & 127) >> 6)) * 64 + (tid & 63), tid);
            { const int hl = 4 * hb + ((tid & 127) >> 6); mstage_T_store<true>(rb, (g * 8 + hl) * 64 + (tid & 63), XT, SCL + hl * 128, convw, convb, tid); }
            if (hb == 0) mstage_T_load(rb, PROJ, b, c, (g * 8 + 4 + ((tid & 127) >> 6)) * 64 + (tid & 63), tid);
            { const int hl = 4 * hb + 2 + ((tid & 127) >> 6); mstage_T_store<true>(ra, (g * 8 + hl) * 64 + (tid & 63), XT + 128 * LSTR, SCL + hl * 128, convw, convb, tid); }
            __syncthreads();
            const int hh = w >> 1, ph = w & 1;
            f32x4 acc[2][8];
#pragma unroll
            for (int a = 0; a < 2; ++a)
#pragma unroll
                for (int n = 0; n < 8; ++n) acc[a][n] = (f32x4){0.f, 0.f, 0.f, 0.f};
#pragma unroll
            for (int ks = 0; ks < 4; ++ks) {
                bf16x8 xa[2];
#pragma unroll
                for (int a = 0; a < 2; ++a) xa[a] = *(const LAS bf16x8*)(XT + (hh * 64 + 32 * ph + 16 * a + r16) * LSTR + 32 * ks + 8 * q);
#pragma unroll
                for (int n = 0; n < 8; ++n) { const bf16x8 bfr = *(const LAS bf16x8*)(BT + (16 * n + r16) * LSTR + 32 * ks + 8 * q);
#pragma unroll
                    for (int a = 0; a < 2; ++a) acc[a][n] = __builtin_amdgcn_mfma_f32_16x16x32_bf16(bfr, xa[a], acc[a][n], 0, 0, 0); }
            }
            bf16* st = ST + ((size_t)((b * MC_NC + c) * 16 + g * 8 + 4 * hb + hh)) * (64 * 128);
#pragma unroll
            for (int a = 0; a < 2; ++a)
#pragma unroll
                for (int n = 0; n < 8; ++n) { v2u o; o.x = pk2(acc[a][n][0], acc[a][n][1]); o.y = pk2(acc[a][n][2], acc[a][n][3]);
                    *(v2u*)(st + (32 * ph + 16 * a + r16) * 128 + 16 * n + 4 * q) = o; }
            __syncthreads();
        }
    }
}

__device__ __forceinline__ void m2_prefix(const Ctx& F) {
    const bf16* ST = (const bf16*)(F.ws + WS_ST); bf16* SIN = (bf16*)(F.ws + WS_SIN); const float* ATOT = (const float*)(F.ws + WS_ATOT);
    const int nthr = F.G * NTHR;
    constexpr int GB = 16;
    constexpr size_t CST = (size_t)16 * 8192;
    for (int gi = blockIdx.x * NTHR + F.tid; gi < NB * 16 * 2048; gi += nthr) {
        const int e4 = gi & 2047, bh = gi >> 11, b = bh >> 4, h = bh & 15;
        const size_t o0 = ((size_t)(b * MC_NC) * 16 + h) * 8192 + 4 * e4;
        const float* at = ATOT + (b * MC_NC) * 16 + h;
        float r0 = 0.f, r1 = 0.f, r2 = 0.f, r3 = 0.f;
        v2u sv[GB]; float dv[GB];
#pragma unroll
        for (int i = 0; i < GB; ++i) { sv[i] = *(const v2u*)(ST + o0 + (size_t)i * CST); dv[i] = at[i * 16]; }
#pragma unroll 1
        for (int c0 = 0; c0 < MC_NC; c0 += GB) {
            const int cn = (c0 + GB < MC_NC) ? c0 + GB : c0;
            v2u svn[GB]; float dvn[GB];
#pragma unroll
            for (int i = 0; i < GB; ++i) { svn[i] = *(const v2u*)(ST + o0 + (size_t)(cn + i) * CST); dvn[i] = at[(cn + i) * 16]; }
            asm volatile("" ::: "memory");
#pragma unroll
            for (int i = 0; i < GB; ++i) {
                v2u so; so.x = pk2(r0, r1); so.y = pk2(r2, r3);
                *(v2u*)(SIN + o0 + (size_t)(c0 + i) * CST) = so;
                const float d = __expf(dv[i]);
                r0 = r0 * d + bflo(sv[i].x); r1 = r1 * d + bfhi(sv[i].x); r2 = r2 * d + bflo(sv[i].y); r3 = r3 * d + bfhi(sv[i].y);
            }
#pragma unroll
            for (int i = 0; i < GB; ++i) { sv[i] = svn[i]; dv[i] = dvn[i]; }
        }
    }
}

__device__ __forceinline__ void m3_outputs(const Ctx& F) {
    const bf16* PROJ = (const bf16*)(F.ws + WS_PROJ); const bf16* SIN = (const bf16*)(F.ws + WS_SIN); bf16* OY = (bf16*)(F.ws + WS_OY);
    LAS bf16* Cn = (LAS bf16*)F.lds; LAS bf16* RB = (LAS bf16*)(F.lds + MT_BYTES);
    LAS bf16* Mw = (LAS bf16*)(F.lds + 2 * MT_BYTES) + F.wave * 16 * LSTR;
    LAS float* DT = (LAS float*)(F.lds + 3 * MT_BYTES); LAS float* ACS = DT + 8 * 128;
    const float* convw = F.in[I_CONVW]; const float* convb = F.in[I_CONVB];
    const int tid = F.tid, w = F.wave, lane = F.lane, r16 = lane & 15, q = lane >> 4;
    for (int it = blockIdx.x; it < NB * MC_NC * 2; it += F.G) {
        const int g = it & 1, c = (it >> 1) & (MC_NC - 1), b = it >> 7;
        __syncthreads();
        (void)mamba_dt_scan(F, PROJ, b, c, g, DT, ACS);
        mstage_N(PROJ, b, c, g, RB, Cn, convw, convb, tid);
        __syncthreads();
        TRaw rx;
        mstage_T_load(rx, PROJ, b, c, (g * 8 + ((tid & 127) >> 6)) * 64 + (tid & 63), tid);
        bf16x8 cf[4];
#pragma unroll
        for (int ks = 0; ks < 4; ++ks) cf[ks] = *(const LAS bf16x8*)(Cn + (16 * w + r16) * LSTR + 32 * ks + 8 * q);
        f32x4 Gt[8];
#pragma unroll
        for (int nt = 0; nt < 8; ++nt) { Gt[nt] = (f32x4){0.f, 0.f, 0.f, 0.f};
#pragma unroll
            for (int ks = 0; ks < 4; ++ks) Gt[nt] = __builtin_amdgcn_mfma_f32_16x16x32_bf16(*(const LAS bf16x8*)(RB + (16 * nt + r16) * LSTR + 32 * ks + 8 * q), cf[ks], Gt[nt], 0, 0, 0); }
        const int l = 16 * w + r16;
        const size_t mrow = (size_t)(b * SEQ + c * MC_L + l);
#pragma unroll 1
        for (int hb = 0; hb < 4; ++hb) {
            __syncthreads();
            { const int hl = 2 * hb + ((tid & 127) >> 6); mstage_T_store<false>(rx, (g * 8 + hl) * 64 + (tid & 63), RB, nullptr, convw, convb, tid); }
            { const int hn = (hb < 3) ? 2 * (hb + 1) : 2 * hb; mstage_T_load(rx, PROJ, b, c, (g * 8 + hn + ((tid & 127) >> 6)) * 64 + (tid & 63), tid); }
            __syncthreads();
#pragma unroll 1
            for (int h2 = 0; h2 < 2; ++h2) {
                const int hl = 2 * hb + h2, head = g * 8 + hl;
                const float acs_l = ACS[hl * 128 + l];
                const bf16* sin = SIN + ((size_t)((b * MC_NC + c) * 16 + head)) * 8192;
                bf16x8 sf[4][4];
#pragma unroll
                for (int pt = 0; pt < 4; ++pt)
#pragma unroll
                    for (int ks = 0; ks < 4; ++ks) sf[pt][ks] = *(const bf16x8*)(sin + (16 * pt + r16) * 128 + 32 * ks + 8 * q);
#pragma unroll
                for (int nt = 0; nt < 8; ++nt) { const f32x4 as = *(const LAS f32x4*)(ACS + hl * 128 + 16 * nt + 4 * q), ds = *(const LAS f32x4*)(DT + hl * 128 + 16 * nt + 4 * q);
                    float mv[4];
#pragma unroll
                    for (int j = 0; j < 4; ++j) { const int s = 16 * nt + 4 * q + j; mv[j] = (s <= l) ? Gt[nt][j] * __expf(acs_l - as[j]) * ds[j] : 0.f; }
                    v2u o; o.x = pk2(mv[0], mv[1]); o.y = pk2(mv[2], mv[3]);
                    *(LAS v2u*)(Mw + r16 * LSTR + 16 * nt + 4 * q) = o; }
                LDS_WAIT(); asm volatile("" ::: "memory");
                bf16x8 mf[4];
#pragma unroll
                for (int ks = 0; ks < 4; ++ks) mf[ks] = *(const LAS bf16x8*)(Mw + r16 * LSTR + 32 * ks + 8 * q);
                const float el = __expf(acs_l), Dh = F.in[I_DSK][head];
#pragma unroll
                for (int pt = 0; pt < 4; ++pt) {
                    f32x4 yd = {0.f, 0.f, 0.f, 0.f}, yo = {0.f, 0.f, 0.f, 0.f};
#pragma unroll
                    for (int ks = 0; ks < 4; ++ks) {
                        yd = __builtin_amdgcn_mfma_f32_16x16x32_bf16(*(const LAS bf16x8*)(RB + (h2 * 64 + 16 * pt + r16) * LSTR + 32 * ks + 8 * q), mf[ks], yd, 0, 0, 0);
                        yo = __builtin_amdgcn_mfma_f32_16x16x32_bf16(sf[pt][ks], cf[ks], yo, 0, 0, 0); }
                    float yv[4];
#pragma unroll
                    for (int j = 0; j < 4; ++j) yv[j] = yd[j] + el * yo[j] + Dh * bf1(RB[(h2 * 64 + 16 * pt + 4 * q + j) * LSTR + l]);
                    v2u o; o.x = pk2(yv[0], yv[1]); o.y = pk2(yv[2], yv[3]);
                    *(v2u*)(OY + mrow * DM + RW + head * 64 + 16 * pt + 4 * q) = o;
                }
                asm volatile("" ::: "memory");
            }
        }
    }
}
constexpr int RC = 16, RNCH = SEQ / RC, NPART = 4, RHALF = RNCH / NPART, RITEMS = NB * RHEADS * RHALF;
constexpr size_t RO_WH = 0, RO_RH = 16 * MiB, RO_VT = 32 * MiB, RO_ET = 48 * MiB, RO_OL = 64 * MiB, RO_A2 = 80 * MiB, RO_GC = 112 * MiB, RO_BUF = 116 * MiB, RO_SS = 232 * MiB;
constexpr int RL_KAP = 0, RL_ALP = 2304, RL_KT = 4608, RL_RT = 6912, RL_KAPT = 9216, RL_VT = 11264, RL_TB = 13312, RL_BL = 14336, RL_QL = 15360, RL_PL = 16384,
              RL_WT = RL_KAP, RL_BVT = RL_ALP, RL_AL32 = RL_KT, RL_ET = RL_KT,
              RL_BYTES = 18176;
constexpr int XS = 72, TS = 16, SS16 = 32;

__device__ __forceinline__ float wave_sum_pl(float x) {
    x = rowsum16(x);
    { auto rr = __builtin_amdgcn_permlane16_swap(__float_as_uint(x), __float_as_uint(x), false, false); x = __uint_as_float(rr[0]) + __uint_as_float(rr[1]); }
    { auto rr = __builtin_amdgcn_permlane32_swap(__float_as_uint(x), __float_as_uint(x), false, false); x = __uint_as_float(rr[0]) + __uint_as_float(rr[1]); }
    return x;
}
__device__ __forceinline__ v2u pack4(const f32x4 a) { v2u o; o.x = pk2(a[0], a[1]); o.y = pk2(a[2], a[3]); return o; }
__device__ __forceinline__ f32x4 unpack4(const v2u u) { return (f32x4){bflo(u.x), bfhi(u.x), bflo(u.y), bfhi(u.y)}; }
__device__ __forceinline__ bf16 f2b(float x) { return (bf16)pk2(x, 0.f); }

__device__ __forceinline__ void ra_item(const Ctx& F, LAS unsigned char* wl, int it, int half) {
    const int bh = it / RHALF, cl = it - bh * RHALF, ci = half * RHALF + cl, b = bh >> 4, h = bh & 15;
    const bf16* PROJ = (const bf16*)(F.ws + WS_PROJ); const bf16* LW = (const bf16*)(F.ws + WS_LW); const bf16* AA = (const bf16*)(F.ws + WS_AA);
    unsigned char* RO = (unsigned char*)F.out + (size_t)(half & 1) * RO_BUF;
    const int lane = F.lane, r16 = lane & 15, q = lane >> 4, c = lane, ch = h * 64 + c;
    const size_t m0 = (size_t)b * SEQ + (size_t)RC * ci;
    LAS bf16* KAP = (LAS bf16*)(wl + RL_KAP); LAS bf16* ALP = (LAS bf16*)(wl + RL_ALP); LAS bf16* KT = (LAS bf16*)(wl + RL_KT); LAS bf16* RT = (LAS bf16*)(wl + RL_RT);
    LAS bf16* KAPT = (LAS bf16*)(wl + RL_KAPT); LAS bf16* VTL = (LAS bf16*)(wl + RL_VT); LAS bf16* WT = (LAS bf16*)(wl + RL_WT); LAS bf16* BVT = (LAS bf16*)(wl + RL_BVT); LAS bf16* ETL = (LAS bf16*)(wl + RL_ET);
    LAS bf16* TB = (LAS bf16*)(wl + RL_TB); LAS bf16* BL = (LAS bf16*)(wl + RL_BL); LAS bf16* QL = (LAS bf16*)(wl + RL_QL); LAS bf16* PL = (LAS bf16*)(wl + RL_PL);
    const float mu_r = F.in[I_MU][C_R + ch], mu_k = F.in[I_MU][C_K + ch], mu_v = F.in[I_MU][C_V + ch], kkw = F.in[I_KK][ch], kaw = F.in[I_KA][ch];
    const bf16* prow = PROJ + m0 * INPP + ch;
    float rp = 0.f, kp = 0.f, vp = 0.f;
    if (ci > 0) { rp = bf1(prow[-INPP + C_R]); kp = bf1(prow[-INPP + C_K]); vp = bf1(prow[-INPP + C_V]); }
    float ec = 1.f, kkna[RC], kpv[RC], env[RC], vvv[RC];
    float cum = 0.f;
#pragma unroll
    for (int t = 0; t < RC; ++t) {
        const bf16* row = prow + (size_t)t * INPP;
        const float rc = bf1(row[C_R]), kc = bf1(row[C_K]), vc = bf1(row[C_V]);
        const float a = bf1(AA[(m0 + t) * RW + ch]), lw = bf1(LW[(m0 + t) * RW + ch]);
        const float rr = rc + (rp - rc) * mu_r, kx = kc + (kp - kc) * mu_k, vv = vc + (vp - vc) * mu_v;
        rp = rc; kp = kc; vp = vc;
        const float kkraw = kx * kkw; const float ss = wave_sum_pl(kkraw * kkraw);
        const float kkn = kkraw * rcp_f(fmaxf(sqrtf(ss), 1e-12f));
        const float kpp = kx * (1.f + (a - 1.f) * kaw);
        const float ep = ec; cum += lw; ec = __expf(cum); const float en = rcp_f(ec);
        const unsigned p0 = pk2(kkn * ep, kkn * a * en), p1 = pk2(kpp * en, rr * ec), p2 = pk2(vv, 0.f);
        KAP[t * XS + c] = (bf16)p0; ALP[t * XS + c] = (bf16)(p0 >> 16); KT[t * XS + c] = (bf16)p1; RT[t * XS + c] = (bf16)(p1 >> 16);
        KAPT[c * TS + t] = (bf16)p0; VTL[c * TS + t] = (bf16)p2;
        kkna[t] = kkn * a; kpv[t] = kpp; env[t] = en; vvv[t] = vv;
    }
    {
        float e8[8]; v4u* vt = (v4u*)((bf16*)(RO + RO_VT) + (size_t)it * 1024 + c * 16);
#pragma unroll
        for (int i = 0; i < 8; ++i) e8[i] = vvv[i];
        vt[0] = pack8(e8);
#pragma unroll
        for (int i = 0; i < 8; ++i) e8[i] = vvv[8 + i];
        vt[1] = pack8(e8);
        v4u* a2 = (v4u*)((bf16*)(RO + RO_A2) + (size_t)it * 2048 + c * 32);
        float dd[RC];
#pragma unroll
        for (int t = 0; t < RC; ++t) dd[t] = ec * env[t];
#pragma unroll
        for (int i = 0; i < 8; ++i) e8[i] = -kkna[i] * dd[i];
        a2[0] = pack8(e8);
#pragma unroll
        for (int i = 0; i < 8; ++i) e8[i] = -kkna[8 + i] * dd[8 + i];
        a2[1] = pack8(e8);
#pragma unroll
        for (int i = 0; i < 8; ++i) e8[i] = kpv[i] * dd[i];
        a2[2] = pack8(e8);
#pragma unroll
        for (int i = 0; i < 8; ++i) e8[i] = kpv[8 + i] * dd[8 + i];
        a2[3] = pack8(e8);
        ((float*)(RO + RO_GC))[(size_t)it * 64 + c] = ec;
    }
    LDS_WAIT(); asm volatile("" ::: "memory");
    const v2u zero2 = {0u, 0u};
    {
        f32x4 alt = {0.f, 0.f, 0.f, 0.f}, blt = alt, qlt = alt, plt = alt;
#pragma unroll
        for (int ks = 0; ks < 2; ++ks) {
            const bf16x8 fa = *(const LAS bf16x8*)(ALP + r16 * XS + 32 * ks + 8 * q), fk = *(const LAS bf16x8*)(KT + r16 * XS + 32 * ks + 8 * q);
            const bf16x8 fkp = *(const LAS bf16x8*)(KAP + r16 * XS + 32 * ks + 8 * q), fr = *(const LAS bf16x8*)(RT + r16 * XS + 32 * ks + 8 * q);
            alt = __builtin_amdgcn_mfma_f32_16x16x32_bf16(fa, fkp, alt, 0, 0, 0); blt = __builtin_amdgcn_mfma_f32_16x16x32_bf16(fk, fkp, blt, 0, 0, 0);
            qlt = __builtin_amdgcn_mfma_f32_16x16x32_bf16(fa, fr, qlt, 0, 0, 0);  plt = __builtin_amdgcn_mfma_f32_16x16x32_bf16(fk, fr, plt, 0, 0, 0);
        }
#pragma unroll
        for (int j = 0; j < 4; ++j) { const int s = 4 * q + j; const bool lt = s < r16, le = s <= r16;
            alt[j] = lt ? alt[j] : 0.f; blt[j] = lt ? blt[j] : 0.f; qlt[j] = le ? qlt[j] : 0.f; plt[j] = le ? plt[j] : 0.f; }
        *(LAS v2u*)(BL + r16 * SS16 + 4 * q) = pack4(blt); *(LAS v2u*)(QL + r16 * SS16 + 4 * q) = pack4(qlt); *(LAS v2u*)(PL + r16 * SS16 + 4 * q) = pack4(plt);
        *(LAS v2u*)(BL + r16 * SS16 + 16 + 4 * q) = zero2; *(LAS v2u*)(QL + r16 * SS16 + 16 + 4 * q) = zero2; *(LAS v2u*)(PL + r16 * SS16 + 16 + 4 * q) = zero2;
        float x[RC];
#pragma unroll
        for (int t = 0; t < RC; ++t) {
            float acc = (t == r16) ? 1.f : 0.f;
#pragma unroll
            for (int s2 = 0; s2 < t; ++s2) { const float a_ts = __uint_as_float(__builtin_amdgcn_readlane(__float_as_uint(alt[s2 & 3]), 16 * (s2 >> 2) + t)); acc -= a_ts * x[s2]; }
            x[t] = acc;
        }
        if (q == 0) {
#pragma unroll
            for (int t = 0; t < RC; ++t) { TB[t * SS16 + r16] = f2b(x[t]); TB[t * SS16 + 16 + r16] = 0; }
        }
    }
    LDS_WAIT(); asm volatile("" ::: "memory");
    const bf16x8 zf = {0, 0, 0, 0, 0, 0, 0, 0};
    const bf16x8 tbf = *(const LAS bf16x8*)(TB + r16 * SS16 + 8 * q), blf = *(const LAS bf16x8*)(BL + r16 * SS16 + 8 * q);
    const bf16x8 qlf = *(const LAS bf16x8*)(QL + r16 * SS16 + 8 * q), plf = *(const LAS bf16x8*)(PL + r16 * SS16 + 8 * q);
    const f32x4 z4 = {0.f, 0.f, 0.f, 0.f};
    bf16* gWH = (bf16*)(RO + RO_WH) + (size_t)it * 1024; bf16* gRH = (bf16*)(RO + RO_RH) + (size_t)it * 1024;
    bf16* gET = (bf16*)(RO + RO_ET) + (size_t)it * 1024; bf16* gOL = (bf16*)(RO + RO_OL) + (size_t)it * 1024;
#pragma unroll
    for (int kt = 0; kt < 4; ++kt) {
        const bf16x8 kf = (q < 2) ? *(const LAS bf16x8*)(KAPT + (16 * kt + r16) * TS + 8 * q) : zf;
        const f32x4 wa = __builtin_amdgcn_mfma_f32_16x16x32_bf16(kf, tbf, z4, 0, 0, 0);
        *(v2u*)(gWH + r16 * 64 + 16 * kt + 4 * q) = pack4(wa);
        const f32x4 wb = __builtin_amdgcn_mfma_f32_16x16x32_bf16(tbf, kf, z4, 0, 0, 0);
        *(LAS v2u*)(WT + (16 * kt + r16) * TS + 4 * q) = pack4(wb);
        const bf16x8 vf = (q < 2) ? *(const LAS bf16x8*)(VTL + (16 * kt + r16) * TS + 8 * q) : zf;
        const f32x4 bv = __builtin_amdgcn_mfma_f32_16x16x32_bf16(blf, vf, z4, 0, 0, 0);
        *(LAS v2u*)(BVT + (16 * kt + r16) * TS + 4 * q) = pack4(bv);
    }
    LDS_WAIT(); asm volatile("" ::: "memory");
#pragma unroll
    for (int vt = 0; vt < 4; ++vt) {
        const bf16x8 bf_ = (q < 2) ? *(const LAS bf16x8*)(BVT + (16 * vt + r16) * TS + 8 * q) : zf;
        const f32x4 e4 = __builtin_amdgcn_mfma_f32_16x16x32_bf16(tbf, bf_, z4, 0, 0, 0);
        const v2u ep = pack4(e4);
        *(LAS v2u*)(ETL + (16 * vt + r16) * TS + 4 * q) = ep; *(v2u*)(gET + (16 * vt + r16) * 16 + 4 * q) = ep;
    }
    LDS_WAIT(); asm volatile("" ::: "memory");
#pragma unroll
    for (int kt = 0; kt < 4; ++kt) {
        const bf16x8 wf = (q < 2) ? *(const LAS bf16x8*)(WT + (16 * kt + r16) * TS + 8 * q) : zf;
        const f32x4 qw = __builtin_amdgcn_mfma_f32_16x16x32_bf16(wf, qlf, z4, 0, 0, 0);
        const f32x4 rt4 = unpack4(*(const LAS v2u*)(RT + r16 * XS + 16 * kt + 4 * q));
        *(v2u*)(gRH + r16 * 64 + 16 * kt + 4 * q) = pack4(rt4 - qw);
        const bf16x8 vf = (q < 2) ? *(const LAS bf16x8*)(VTL + (16 * kt + r16) * TS + 8 * q) : zf;
        const bf16x8 ef = (q < 2) ? *(const LAS bf16x8*)(ETL + (16 * kt + r16) * TS + 8 * q) : zf;
        const f32x4 pv = __builtin_amdgcn_mfma_f32_16x16x32_bf16(vf, plf, z4, 0, 0, 0);
        const f32x4 qe = __builtin_amdgcn_mfma_f32_16x16x32_bf16(ef, qlf, z4, 0, 0, 0);
        *(v2u*)(gOL + r16 * 64 + 16 * kt + 4 * q) = pack4(pv - qe);
    }
    LDS_WAIT(); asm volatile("" ::: "memory");
}
__device__ __forceinline__ void ra_part(const Ctx& F, int part) {
    LAS unsigned* ctr = (LAS unsigned*)(F.lds + LDS_BYTES - 48) + part;
    LAS unsigned char* wl = F.lds + F.wave * RL_BYTES;
    for (;;) {
        unsigned idx = 0;
        if (F.lane == 0) idx = __hip_atomic_fetch_add(ctr, 1u, __ATOMIC_RELAXED, __HIP_MEMORY_SCOPE_WORKGROUP);
        idx = (unsigned)__builtin_amdgcn_readfirstlane((int)idx);
        const int it = (int)blockIdx.x + F.G * (int)idx;
        if (it >= RITEMS) break;
        ra_item(F, wl, it, part);
    }
}

__device__ __forceinline__ void rs_half(const Ctx& F, int half) {
    if (F.wave != 0) return;
    const unsigned char* RO = (const unsigned char*)F.out + (size_t)(half & 1) * RO_BUF; bf16* OY = (bf16*)(F.ws + WS_OY);
    float* SSg = (float*)((unsigned char*)F.out + RO_SS);
    LAS bf16* ST = (LAS bf16*)F.lds;
    LAS bf16* ZT = (LAS bf16*)(F.lds + 16 * XS * 2);
    constexpr int ZS = 24;
    const int lane = F.lane, r16 = lane & 15, q = lane >> 4;
    for (int blk = blockIdx.x; blk < NB * RHEADS * 4; blk += F.G) {
        const int xcd = blk & 7, jj = blk >> 3, qt = jj & 3, bh = (jj >> 2) * 8 + xcd, b = bh >> 4, h = bh & 15;
        f32x4 S[4];
        if (half == 0) {
#pragma unroll
            for (int kt = 0; kt < 4; ++kt) S[kt] = (f32x4){0.f, 0.f, 0.f, 0.f};
        } else {
#pragma unroll
            for (int kt = 0; kt < 4; ++kt) S[kt] = *(const f32x4*)(SSg + (size_t)blk * 1024 + (kt * 64 + lane) * 4);
        }
#pragma unroll
        for (int kt = 0; kt < 4; ++kt) *(LAS v2u*)(ST + r16 * XS + 16 * kt + 4 * q) = pack4(S[kt]);
        LDS_WAIT(); asm volatile("" ::: "memory");
        const size_t it0 = (size_t)bh * RHALF;
        const size_t mbase = (size_t)b * SEQ + (size_t)half * RHALF * RC;
#define RS_LOAD(IT, WF, RF, A2F, VF, ET4, OL4, GC4) do { const size_t it_ = (IT); \
        const bf16* wh_ = (const bf16*)(RO + RO_WH) + it_ * 1024 + r16 * 64 + 8 * q; const bf16* rh_ = (const bf16*)(RO + RO_RH) + it_ * 1024 + r16 * 64 + 8 * q; \
        WF[0] = *(const bf16x8*)wh_; WF[1] = *(const bf16x8*)(wh_ + 32); RF[0] = *(const bf16x8*)rh_; RF[1] = *(const bf16x8*)(rh_ + 32); \
        _Pragma("unroll") for (int kt_ = 0; kt_ < 4; ++kt_) { A2F[kt_] = *(const bf16x8*)((const bf16*)(RO + RO_A2) + it_ * 2048 + (16 * kt_ + r16) * 32 + 8 * q); \
            GC4[kt_] = *(const f32x4*)((const float*)(RO + RO_GC) + it_ * 64 + 16 * kt_ + 4 * q); } \
        VF = *(const bf16x8*)((const bf16*)(RO + RO_VT) + it_ * 1024 + (16 * qt + r16) * 16 + 8 * (q & 1)); \
        ET4 = *(const v2u*)((const bf16*)(RO + RO_ET) + it_ * 1024 + (16 * qt + r16) * 16 + 4 * q); \
        OL4 = *(const v2u*)((const bf16*)(RO + RO_OL) + it_ * 1024 + r16 * 64 + 16 * qt + 4 * q); } while (0)
        bf16x8 wfq[2][2], rfq[2][2], a2q[2][4], vfq[2]; v2u etq[2], olq[2]; f32x4 gcq[2][4];
#pragma unroll
        for (int u = 0; u < 2; ++u) RS_LOAD(it0 + u, wfq[u], rfq[u], a2q[u], vfq[u], etq[u], olq[u], gcq[u]);
#define RS_STEP(U, CL) do { const int cl_ = (CL); \
            const bf16x8 sb0 = *(const LAS bf16x8*)(ST + r16 * XS + 8 * q), sb1 = *(const LAS bf16x8*)(ST + r16 * XS + 32 + 8 * q); \
            f32x4 x1 = __builtin_amdgcn_mfma_f32_16x16x32_bf16(wfq[U][0], sb0, (f32x4){0.f, 0.f, 0.f, 0.f}, 0, 0, 0); \
            x1 = __builtin_amdgcn_mfma_f32_16x16x32_bf16(wfq[U][1], sb1, x1, 0, 0, 0); \
            f32x4 ot = __builtin_amdgcn_mfma_f32_16x16x32_bf16(sb0, rfq[U][0], unpack4(olq[U]), 0, 0, 0); \
            ot = __builtin_amdgcn_mfma_f32_16x16x32_bf16(sb1, rfq[U][1], ot, 0, 0, 0); \
            *(LAS v2u*)(ZT + r16 * ZS + 4 * q) = pack4(x1 + unpack4(etq[U])); \
            *(v2u*)(OY + (mbase + (size_t)cl_ * RC + r16) * DM + h * 64 + 16 * qt + 4 * q) = pack4(ot); \
            LDS_WAIT(); asm volatile("" ::: "memory"); \
            const bf16x8 zr = *(const LAS bf16x8*)(ZT + r16 * ZS + 8 * (q & 1)); \
            const bf16x8 bz = (q < 2) ? zr : vfq[U]; \
            _Pragma("unroll") for (int kt = 0; kt < 4; ++kt) { S[kt] = __builtin_amdgcn_mfma_f32_16x16x32_bf16(a2q[U][kt], bz, S[kt] * gcq[U][kt], 0, 0, 0); \
                *(LAS v2u*)(ST + r16 * XS + 16 * kt + 4 * q) = pack4(S[kt]); } \
            RS_LOAD(it0 + ((cl_ + 2 < RHALF) ? cl_ + 2 : RHALF - 1), wfq[U], rfq[U], a2q[U], vfq[U], etq[U], olq[U], gcq[U]);     \
            LDS_WAIT(); asm volatile("" ::: "memory"); } while (0)
#pragma unroll 1
        for (int cl = 0; cl < RHALF; cl += 2) { RS_STEP(0, cl); RS_STEP(1, cl + 1); }
#undef RS_STEP
#undef RS_LOAD
        if (half + 1 < NPART) {
#pragma unroll
            for (int kt = 0; kt < 4; ++kt) *(f32x4*)(SSg + (size_t)blk * 1024 + (kt * 64 + lane) * 4) = S[kt];
        }
    }
}
__device__ __forceinline__ float rowmax16(float x) { x = fmaxf(x, dpp_f<0xB1>(x)); x = fmaxf(x, dpp_f<0x4E>(x)); x = fmaxf(x, dpp_f<0x124>(x)); x = fmaxf(x, dpp_f<0x128>(x)); return x; }
__device__ __forceinline__ int cand_code(int s) {
    if (s < 16) return s << 4;
    if (s < 24) return 1 | ((s - 16) << 4);
    if (s < 29) return 2 | ((s - 24) << 4);
    if (s < 33) return 3 | ((s - 29) << 4);
    if (s < 36) return 4 | ((s - 33) << 4);
    if (s < 42) { const int k = s - 36; return (5 + (k >> 1)) | ((k & 1) << 4); }
    if (s < 50) return 8 + (s - 42);
    return -1;
}
__device__ __forceinline__ int f2ord(float f) { const int b = __float_as_int(f); return b ^ ((b >> 31) & 0x7fffffff); }
__device__ __forceinline__ float ord2f(int k) { return __int_as_float(k ^ ((k >> 31) & 0x7fffffff)); }
template <int CTRL> __device__ __forceinline__ int dpp_i(int x) { return __builtin_amdgcn_mov_dpp(x, CTRL, 0xf, 0xf, true); }
__device__ __forceinline__ int imax(int a, int b) { return a > b ? a : b; }
__device__ __forceinline__ int imin(int a, int b) { return a < b ? a : b; }
__device__ __forceinline__ int rowmax16_i(int x) { x = imax(x, dpp_i<0xB1>(x)); x = imax(x, dpp_i<0x4E>(x)); x = imax(x, dpp_i<0x124>(x)); x = imax(x, dpp_i<0x128>(x)); return x; }
#define CSWAP_(a, b) do { const int hi_ = imax(a, b), lo_ = imin(a, b); a = hi_; b = lo_; } while (0)
template <int NV> __device__ __forceinline__ void sort_desc(int (&v)[NV]);
template <> __device__ __forceinline__ void sort_desc<8>(int (&v)[8]) {
    CSWAP_(v[0], v[1]); CSWAP_(v[2], v[3]); CSWAP_(v[4], v[5]); CSWAP_(v[6], v[7]);
    CSWAP_(v[0], v[2]); CSWAP_(v[1], v[3]); CSWAP_(v[4], v[6]); CSWAP_(v[5], v[7]);
    CSWAP_(v[1], v[2]); CSWAP_(v[5], v[6]);
    CSWAP_(v[0], v[4]); CSWAP_(v[1], v[5]); CSWAP_(v[2], v[6]); CSWAP_(v[3], v[7]);
    CSWAP_(v[2], v[4]); CSWAP_(v[3], v[5]);
    CSWAP_(v[1], v[2]); CSWAP_(v[3], v[4]); CSWAP_(v[5], v[6]);
}
template <> __device__ __forceinline__ void sort_desc<4>(int (&v)[4]) {
    CSWAP_(v[0], v[1]); CSWAP_(v[2], v[3]); CSWAP_(v[0], v[2]); CSWAP_(v[1], v[3]); CSWAP_(v[1], v[2]);
}
template <int NV>
__device__ __forceinline__ void select16x4(int (&v)[4][NV], int r16, float (&kept_f)[4]) {
    const int IMIN = (int)0x80000000;
    int kept[4];
#pragma unroll
    for (int j = 0; j < 4; ++j) { kept[j] = IMIN; sort_desc<NV>(v[j]); }
#pragma unroll 1
    for (int rd = 0; rd < 16; ++rd) {
#pragma unroll
        for (int j = 0; j < 4; ++j) {
            const int m = rowmax16_i(v[j][0]);
            kept[j] = (r16 == rd) ? m : kept[j];
            const bool own = (v[j][0] == m);
#pragma unroll
            for (int i = 0; i < NV - 1; ++i) v[j][i] = own ? v[j][i + 1] : v[j][i];
            v[j][NV - 1] = own ? IMIN : v[j][NV - 1];
        }
    }
#pragma unroll
    for (int j = 0; j < 4; ++j) kept_f[j] = ord2f(kept[j]);
}
__device__ __forceinline__ float dot2bf(unsigned a, unsigned b, float acc) { return __builtin_amdgcn_fdot2_f32_bf16(__builtin_bit_cast(bf16x2_t, a), __builtin_bit_cast(bf16x2_t, b), acc, false); }

constexpr int PT = 16;
constexpr size_t RANGE_BYTES = (size_t)NEXP * 128;

__device__ __forceinline__ void p9_route(const Ctx& F) {
    constexpr int KSTR = 136;
    const bf16* Q = (const bf16*)(F.ws + WS_Q); const bf16* KEYS = (const bf16*)(F.ws + WS_KEYS);
    int* rtE = (int*)(F.ws + WS_RTE); float* rtG = (float*)(F.ws + WS_RTG);
    LAS bf16* KL = (LAS bf16*)F.lds;
    const int lane = F.lane, w = F.wave, r16 = lane & 15, q = lane >> 4, gbase = lane & 48;
    const int h = blockIdx.x & 7, nbh = (F.G - h + 7) >> 3;
    __syncthreads();
    for (int i = F.tid; i < 2 * 128 * 16; i += NTHR) { const int row = i >> 4, ch = i & 15;
        *(LAS v4u*)(KL + row * KSTR + 8 * ch) = *(const v4u*)(KEYS + (size_t)(2 * h * 128 + row) * 128 + 8 * ch); }
    __syncthreads();
    int ci[4], cj[4]; bool cvalid[4];
#pragma unroll
    for (int u = 0; u < 4; ++u) { const int cd = cand_code(r16 + 16 * u); cvalid[u] = cd >= 0; ci[u] = cd & 15; cj[u] = (cd >> 4) & 15; }
    const float NINF = -__builtin_inff();
    const int tstride = nbh * NWAVES;
    int tile = (blockIdx.x >> 3) * NWAVES + w;
    bf16x8 afn[2][4];
    if (tile < M / PT) {
#pragma unroll
        for (int p = 0; p < 2; ++p)
#pragma unroll
            for (int s = 0; s < 4; ++s) afn[p][s] = *(const bf16x8*)(Q + (size_t)(tile * PT + r16) * DM + (2 * h + p) * 128 + 8 * q + 32 * s);
    }
    for (; tile < M / PT; tile += tstride) {
        const int m0 = tile * PT;
        bf16x8 af[2][4];
#pragma unroll
        for (int p = 0; p < 2; ++p)
#pragma unroll
            for (int s = 0; s < 4; ++s) af[p][s] = afn[p][s];
        { const int tn = (tile + tstride < M / PT) ? tile + tstride : tile;
#pragma unroll
            for (int p = 0; p < 2; ++p)
#pragma unroll
                for (int s = 0; s < 4; ++s) afn[p][s] = *(const bf16x8*)(Q + (size_t)(tn * PT + r16) * DM + (2 * h + p) * 128 + 8 * q + 32 * s);
        }
        float top[2][4];
#pragma unroll
        for (int p = 0; p < 2; ++p) {
            int v[4][8];
#pragma unroll
            for (int nt = 0; nt < 8; ++nt) {
                const LAS bf16* krow = KL + (p * 128 + nt * 16 + r16) * KSTR + 8 * q;
                f32x4 acc = {0.f, 0.f, 0.f, 0.f};
#pragma unroll
                for (int s = 0; s < 4; ++s) acc = __builtin_amdgcn_mfma_f32_16x16x32_bf16(af[p][s], *(const LAS bf16x8*)(krow + 32 * s), acc, 0, 0, 0);
                const unsigned tag = 127u - (unsigned)(nt * 16 + r16);
#pragma unroll
                for (int j = 0; j < 4; ++j) v[j][nt] = f2ord(__uint_as_float((__float_as_uint(acc[j]) & ~127u) | tag));
                if (nt & 1) asm volatile("" ::: "memory");
            }
            select16x4<8>(v, r16, top[p]);
        }
        int cv[4][4];
#pragma unroll
        for (int u = 0; u < 4; ++u)
#pragma unroll
            for (int j = 0; j < 4; ++j) {
                const float a = __shfl(top[0][j], gbase + ci[u]), b = __shfl(top[1][j], gbase + cj[u]);
                const float cs = __uint_as_float(__float_as_uint(a) & ~127u) + __uint_as_float(__float_as_uint(b) & ~127u);
                const float pk = __uint_as_float((__float_as_uint(cs) & ~63u) | (63u - (unsigned)(r16 + 16 * u)));
                cv[j][u] = cvalid[u] ? f2ord(pk) : (int)0x80000000;
            }
        float best[4];
        select16x4<4>(cv, r16, best);
#pragma unroll
        for (int j = 0; j < 4; ++j) {
            const unsigned bb = __float_as_uint(best[j]);
            const int cd = cand_code(63 - (int)(bb & 63u));
            const int k0 = 127 - (int)(__float_as_uint(__shfl(top[0][j], gbase + (cd & 15))) & 127u);
            const int k1 = 127 - (int)(__float_as_uint(__shfl(top[1][j], gbase + ((cd >> 4) & 15))) & 127u);
            const float s = __uint_as_float(bb & ~63u);
            const float mx = rowmax16(s), e = __expf(s - mx), sum = rowsum16(e);
            const size_t o = (size_t)(m0 + 4 * q + j) * 128 + h * 16 + r16;
            rtE[o] = k0 * 128 + k1; rtG[o] = e * rcp_f(sum);
        }
    }
}

__device__ __forceinline__ f32x2 cvt2_fp8(unsigned wd, bool hi) { return hi ? __builtin_amdgcn_cvt_pk_f32_fp8((int)wd, true) : __builtin_amdgcn_cvt_pk_f32_fp8((int)wd, false); }
__device__ __forceinline__ void treduce8x16(const float (&p)[16], bool b0, bool b1, bool b2, float& r0, float& r1) {
    float a[8], bq[4];
#pragma unroll
    for (int i = 0; i < 8; ++i) { const float mine = b2 ? p[i + 8] : p[i], send = b2 ? p[i] : p[i + 8]; const float up = dpp_f<0x104>(send), dn = dpp_f<0x114>(send); a[i] = mine + (b2 ? dn : up); }
#pragma unroll
    for (int i = 0; i < 4; ++i) { const float mine = b1 ? a[i + 4] : a[i], send = b1 ? a[i] : a[i + 4]; bq[i] = mine + dpp_f<0x4E>(send); }
    { const float mine = b0 ? bq[2] : bq[0], send = b0 ? bq[0] : bq[2]; r0 = mine + dpp_f<0xB1>(send); }
    { const float mine = b0 ? bq[3] : bq[1], send = b0 ? bq[1] : bq[3]; r1 = mine + dpp_f<0xB1>(send); }
}
struct XGroup { int xg, gwi, stride; };
__device__ __forceinline__ XGroup xgroup(const Ctx& F) { XGroup g; g.xg = blockIdx.x & 7; const int nbg = (F.G - g.xg + 7) >> 3; g.gwi = (blockIdx.x >> 3) * NWAVES + F.wave; g.stride = nbg * NWAVES; return g; }

__device__ __forceinline__ void p10_peer_u(const Ctx& F) {
    typedef int v8i __attribute__((ext_vector_type(8)));
    const unsigned char* PU4 = F.ws + WS_PU8; const unsigned char* X8 = F.ws + WS_X8;
    const int* rtE = (const int*)(F.ws + WS_RTE); unsigned char* PDb = F.ws + WS_PD;
    const XGroup g = xgroup(F);
    const int lane = F.lane, j = lane >> 3, sub = lane & 7, n = lane & 15, kb = lane >> 4;
    const int r = g.xg;
    const unsigned char* tab = PU4 + (size_t)r * RANGE_BYTES;
    const unsigned so = 16u * (unsigned)sub;
    LAS unsigned char* wl = F.lds + F.wave * 16384;
    const int p0 = (kb + (n >> 1)) & 7, p1 = (p0 + 4) & 7;
    const int rot = n >> 1;
    const int xo00 = 32 * ((0 + 0 + (kb >> 1) + rot) & 7) + 16 * (kb & 1), xo01 = 32 * ((0 + 2 + (kb >> 1) + rot) & 7) + 16 * (kb & 1);
    const int xo10 = 32 * ((4 + 0 + (kb >> 1) + rot) & 7) + 16 * (kb & 1), xo11 = 32 * ((4 + 2 + (kb >> 1) + rot) & 7) + 16 * (kb & 1);
    LAS unsigned char* bp0 = wl + n * 128 + 16 * p0; LAS unsigned char* bp1 = wl + n * 128 + 16 * p1;
    LAS unsigned char* wp = wl + lane * 16;
    const bool diag = (n >> 2) == kb; const int sel = lane & 3;
    const int SC = 0x7f7f7f7f;
    int m = g.gwi;
    if (m >= M) return;
    const int st = g.stride;
    v4u ev[4], evn[4], gtA[16], gtB[16], xaA[4], xaB[4];
#define PU_IDS(e, mm) { _Pragma("unroll") for (int i = 0; i < 4; ++i) e[i] = *(const v4u*)(rtE + (size_t)(mm) * 128 + 16 * j + 4 * i); }
#define PU_X(xv, mm) { const unsigned char* xr_ = X8 + (size_t)(mm) * DM + 256 * r; xv[0] = *(const v4u*)(xr_ + xo00); xv[1] = *(const v4u*)(xr_ + xo01); xv[2] = *(const v4u*)(xr_ + xo10); xv[3] = *(const v4u*)(xr_ + xo11); }
#define PU_GATHER(gx, e) { _Pragma("unroll") for (int k = 0; k < 16; ++k) gx[k] = *(const v4u*)(tab + (e[k >> 2][k & 3] * 128u + so)); }
#define PU_CLAMP(mm) (((mm) < M) ? (mm) : m)
#define PU_ITEM(GT, XC, XN, MC) { const int mc_ = (MC); \
        _Pragma("unroll") for (int k = 0; k < 16; ++k) *(LAS v4u*)(wp + k * 1024) = GT[k]; \
        asm volatile("" ::: "memory"); \
        PU_X(XN, PU_CLAMP(mc_ + st)); PU_IDS(evn, PU_CLAMP(mc_ + 3 * st)); \
        asm volatile("" ::: "memory"); \
        PU_GATHER(GT, ev); \
        asm volatile("" ::: "memory"); \
        v8i A0, A1; \
        A0[0] = XC[0].x; A0[1] = XC[0].y; A0[2] = XC[0].z; A0[3] = XC[0].w; A0[4] = XC[1].x; A0[5] = XC[1].y; A0[6] = XC[1].z; A0[7] = XC[1].w; \
        A1[0] = XC[2].x; A1[1] = XC[2].y; A1[2] = XC[2].z; A1[3] = XC[2].w; A1[4] = XC[3].x; A1[5] = XC[3].y; A1[6] = XC[3].z; A1[7] = XC[3].w; \
        float dv[8]; \
        _Pragma("unroll") for (int tg = 0; tg < 4; ++tg) { \
            v4u b0[2], b1[2]; \
            _Pragma("unroll") for (int u = 0; u < 2; ++u) { b0[u] = *(const LAS v4u*)(bp0 + (2 * tg + u) * 2048); b1[u] = *(const LAS v4u*)(bp1 + (2 * tg + u) * 2048); } \
            f32x4 acc[2]; \
            _Pragma("unroll") for (int u = 0; u < 2; ++u) { const v8i B0 = {(int)b0[u].x, (int)b0[u].y, (int)b0[u].z, (int)b0[u].w, 0, 0, 0, 0}; \
                acc[u] = __builtin_amdgcn_mfma_scale_f32_16x16x128_f8f6f4(A0, B0, (f32x4){0.f, 0.f, 0.f, 0.f}, 0, 4, 0, SC, 0, SC); } \
            _Pragma("unroll") for (int u = 0; u < 2; ++u) { const v8i B1 = {(int)b1[u].x, (int)b1[u].y, (int)b1[u].z, (int)b1[u].w, 0, 0, 0, 0}; \
                acc[u] = __builtin_amdgcn_mfma_scale_f32_16x16x128_f8f6f4(A1, B1, acc[u], 0, 4, 0, SC, 0, SC); } \
            _Pragma("unroll") for (int u = 0; u < 2; ++u) { const float lo = s1 ? acc[u][1] : acc[u][0], hi = s1 ? acc[u][3] : acc[u][2]; dv[2 * tg + u] = s2 ? hi : lo; } \
        } \
        asm volatile("" : "+v"(dv[0]), "+v"(dv[1]), "+v"(dv[2]), "+v"(dv[3]), "+v"(dv[4]), "+v"(dv[5]), "+v"(dv[6]), "+v"(dv[7]) :: "memory"); \
        if (diag) *(v4u*)(PDb + ((size_t)r * M + mc_) * 256 + 16 * n) = pack8(dv); \
        _Pragma("unroll") for (int i = 0; i < 4; ++i) ev[i] = evn[i]; }
    const bool s1 = sel & 1, s2 = sel & 2;
    {
        PU_IDS(ev, m); PU_X(xaA, m); PU_IDS(evn, PU_CLAMP(m + st));
        PU_GATHER(gtA, ev);
        PU_GATHER(gtB, evn);
        PU_IDS(ev, PU_CLAMP(m + 2 * st));
    }
    for (; m < M; m += 2 * st) {
        PU_ITEM(gtA, xaA, xaB, m);
        if (m + st < M) PU_ITEM(gtB, xaB, xaA, m + st);
    }
#undef PU_IDS
#undef PU_X
#undef PU_GATHER
#undef PU_CLAMP
#undef PU_ITEM
}

__device__ __forceinline__ void p11_peer_coef(const Ctx& F) {
    const int* rtE = (const int*)(F.ws + WS_RTE); const float* rtG = (const float*)(F.ws + WS_RTG); const unsigned* PD = (const unsigned*)(F.ws + WS_PD);
    const float* usc = (const float*)(F.ws + WS_USC); const float* vsc = (const float*)(F.ws + WS_VSC); float* COEF = (float*)(F.ws + WS_COEF);
    int m = F.gw;
    if (m >= M) return;
    const int st = F.NGW;
    unsigned pd[8]; f32x2 gt; float us0, us1, vs0, vs1; v2u e1;
    {   const size_t o = (size_t)m * 128 + 2 * F.lane;
        const v2u e0 = *(const v2u*)(rtE + o);
#pragma unroll
        for (int r = 0; r < 8; ++r) { const unsigned short* ph = (const unsigned short*)PD + ((size_t)r * M + m) * 128 + F.lane; pd[r] = (unsigned)ph[0] | ((unsigned)ph[64] << 16); }
        gt = *(const f32x2*)(rtG + o);
        const int m1 = (m + st < M) ? m + st : m;
        e1 = *(const v2u*)(rtE + (size_t)m1 * 128 + 2 * F.lane);
        us0 = usc[e0.x]; us1 = usc[e0.y]; vs0 = vsc[e0.x]; vs1 = vsc[e0.y]; }
    for (; m < M; m += st) {
        const int m1 = (m + st < M) ? m + st : m, m2 = (m + 2 * st < M) ? m + 2 * st : m;
        const size_t o = (size_t)m * 128 + 2 * F.lane, o1 = (size_t)m1 * 128 + 2 * F.lane;
        const v2u e2 = *(const v2u*)(rtE + (size_t)m2 * 128 + 2 * F.lane);
        unsigned pdn[8];
#pragma unroll
        for (int r = 0; r < 8; ++r) { const unsigned short* ph = (const unsigned short*)PD + ((size_t)r * M + m1) * 128 + F.lane; pdn[r] = (unsigned)ph[0] | ((unsigned)ph[64] << 16); }
        const f32x2 gtn = *(const f32x2*)(rtG + o1);
        const float us0n = usc[e1.x], us1n = usc[e1.y], vs0n = vsc[e1.x], vs1n = vsc[e1.y];
        asm volatile("" ::: "memory");
        f32x2 d = {0.f, 0.f};
#pragma unroll
        for (int r = 0; r < 8; ++r) d += (f32x2){bflo(pd[r]), bfhi(pd[r])};
        const float d0 = d.x * us0, d1 = d.y * us1;
        f32x2 c; c.x = gt.x * (0.5f * d0 * (1.f + erff(d0 * 0.70710678f))) * vs0; c.y = gt.y * (0.5f * d1 * (1.f + erff(d1 * 0.70710678f))) * vs1;
        *(f32x2*)(COEF + o) = c;
#pragma unroll
        for (int r = 0; r < 8; ++r) pd[r] = pdn[r];
        gt = gtn; us0 = us0n; us1 = us1n; vs0 = vs0n; vs1 = vs1n; e1 = e2;
    }
}

__device__ __forceinline__ void p12_peer_v(const Ctx& F) {
    const unsigned char* PV4 = F.ws + WS_PV8; const int* rtE = (const int*)(F.ws + WS_RTE); const float* COEF = (const float*)(F.ws + WS_COEF);
    const float* mod = (const float*)(F.ws + WS_MOD);
    const XGroup g = xgroup(F);
    const int lane = F.lane, j = lane >> 3, sub = lane & 7;
    const bool jb0 = j & 1;
    const int r = g.xg;
    const unsigned char* tab = PV4 + (size_t)r * RANGE_BYTES;
    const unsigned so = 16u * (unsigned)sub;
    int m = g.gwi;
    if (m >= M) return;
    const int st = g.stride;
#define PV_LDE(e, mm, hf) { e[0] = *(const v4u*)(rtE + (size_t)(mm) * 128 + 16 * j + 8 * (hf)); e[1] = *(const v4u*)(rtE + (size_t)(mm) * 128 + 16 * j + 8 * (hf) + 4); }
#define PV_LDC(c, mm, hf) { c[0] = *(const f32x4*)(COEF + (size_t)(mm) * 128 + 16 * j + 8 * (hf)); c[1] = *(const f32x4*)(COEF + (size_t)(mm) * 128 + 16 * j + 8 * (hf) + 4); }
#define PV_GATHER(gx, e) { _Pragma("unroll") for (int k = 0; k < 8; ++k) gx[k] = *(const v4u*)(tab + (e[k >> 2][k & 3] * 128u + so)); }
#define PV_ACC(gx, c) { _Pragma("unroll") for (int k = 0; k < 8; ++k) { const float cq = c[k >> 2][k & 3]; const f32x2 cv2 = {cq, cq}; \
        _Pragma("unroll") for (int d = 0; d < 4; ++d) { const unsigned wd = gx[k][d]; \
            acc[4 * d + 0] += cv2 * __builtin_amdgcn_cvt_scalef32_pk_f32_fp4(wd, 1.0f, 0); acc[4 * d + 1] += cv2 * __builtin_amdgcn_cvt_scalef32_pk_f32_fp4(wd, 1.0f, 1); \
            acc[4 * d + 2] += cv2 * __builtin_amdgcn_cvt_scalef32_pk_f32_fp4(wd, 1.0f, 2); acc[4 * d + 3] += cv2 * __builtin_amdgcn_cvt_scalef32_pk_f32_fp4(wd, 1.0f, 3); } } }
    v4u eA1[2], eB0[2], gA[8], gB[8]; f32x4 cA0[2], cA1[2], cB0[2];
    { v4u eA0[2]; PV_LDE(eA0, m, 0); PV_LDC(cA0, m, 0); PV_LDE(eB0, m, 1); PV_LDC(cB0, m, 1);
      const int m1 = (m + st < M) ? m + st : m; PV_LDE(eA1, m1, 0); PV_LDC(cA1, m1, 0);
      PV_GATHER(gA, eA0); }
    for (; m < M; m += st) {
        const int m1 = (m + st < M) ? m + st : m, m2 = (m + 2 * st < M) ? m + 2 * st : m;
        const int col = 256 * r + 32 * sub + 4 * j;
        v2u* orow = (v2u*)((bf16*)(F.ws + WS_HB) + (size_t)m * DM + col);
        const v2u hw = *orow; const f32x4 g2 = *(const f32x4*)(mod + (size_t)(m / SEQ) * MODW + 5 * DM + col);
        PV_GATHER(gB, eB0);
        v4u eB1[2], eA2[2]; f32x4 cB1[2], cA2[2];
        PV_LDE(eB1, m1, 1); PV_LDC(cB1, m1, 1); PV_LDE(eA2, m2, 0); PV_LDC(cA2, m2, 0);
        asm volatile("" : "+v"(gA[0]), "+v"(gA[1]), "+v"(gA[2]), "+v"(gA[3]), "+v"(gA[4]), "+v"(gA[5]), "+v"(gA[6]), "+v"(gA[7]) :: "memory");
        f32x2 acc[16];
#pragma unroll
        for (int i = 0; i < 16; ++i) acc[i] = (f32x2){0.f, 0.f};
        PV_ACC(gA, cA0);
        asm volatile("" ::: "memory");
        PV_GATHER(gA, eA1);
        asm volatile("" : "+v"(gB[0]), "+v"(gB[1]), "+v"(gB[2]), "+v"(gB[3]), "+v"(gB[4]), "+v"(gB[5]), "+v"(gB[6]), "+v"(gB[7]) :: "memory");
        PV_ACC(gB, cB0);
        float a[32];
#pragma unroll
        for (int i = 0; i < 16; ++i) { a[2 * i] = acc[i].x; a[2 * i + 1] = acc[i].y; }
        float s16[16], s8[8];
#pragma unroll
        for (int c = 0; c < 16; ++c) { auto rr2 = __builtin_amdgcn_permlane32_swap(__float_as_uint(a[c]), __float_as_uint(a[c + 16]), false, false); s16[c] = __uint_as_float(rr2[0]) + __uint_as_float(rr2[1]); }
#pragma unroll
        for (int c = 0; c < 8; ++c) { auto rr2 = __builtin_amdgcn_permlane16_swap(__float_as_uint(s16[c]), __float_as_uint(s16[c + 8]), false, false); s8[c] = __uint_as_float(rr2[0]) + __uint_as_float(rr2[1]); }
        f32x4 res;
#pragma unroll
        for (int c = 0; c < 4; ++c) { const float mine = jb0 ? s8[c + 4] : s8[c], send = jb0 ? s8[c] : s8[c + 4]; res[c] = mine + dpp_f<0x128>(send); }
        const f32x4 h1 = {bflo(hw.x), bfhi(hw.x), bflo(hw.y), bfhi(hw.y)};
        const f32x4 h2 = h1 + g2 * res;
        v2u o; o.x = pk2(h2.x, h2.y); o.y = pk2(h2.z, h2.w);
        *orow = o;
#pragma unroll
        for (int i = 0; i < 2; ++i) { cA0[i] = cA1[i]; cA1[i] = cA2[i]; eA1[i] = eA2[i]; eB0[i] = eB1[i]; cB0[i] = cB1[i]; }
    }
#undef PV_LDE
#undef PV_LDC
#undef PV_GATHER
#undef PV_ACC
}
#define XB_TMO      128
#define XB_XCNT(j)  (256  + 64 * (j))
#define XB_XSUB(j)  (1280 + 64 * (j))
#define XB_XGEN(j)  (2304 + 64 * (j))
#define XB_TOP      3328
#define XB_TOPGEN   3392
#define XCD_BAR_WORDS 3456
#define XB_SPIN_CAP (1u << 18)

__device__ __forceinline__ unsigned xb_ld(unsigned* p)              { return __hip_atomic_load(p, __ATOMIC_RELAXED, __HIP_MEMORY_SCOPE_AGENT); }
__device__ __forceinline__ unsigned xb_add(unsigned* p, unsigned v) { return __hip_atomic_fetch_add(p, v, __ATOMIC_RELAXED, __HIP_MEMORY_SCOPE_AGENT); }
__device__ __forceinline__ unsigned xb_xcc_id() { return (unsigned)__builtin_amdgcn_s_getreg((3 << 11) | 20) & 0xFu; }
#define XB_SPIN(cond, bar) do { unsigned _sp = 0; while (cond) { __builtin_amdgcn_s_sleep(1); \
    if ((++_sp & 255u) == 0u) { if (xb_ld(&(bar)[XB_TMO])) break; if (_sp > XB_SPIN_CAP) { atomicAdd(&(bar)[XB_TMO], 1u); break; } } } } while (0)

struct XcdBarrier {
    unsigned* bar; unsigned x;
    volatile LAS unsigned* st;
};

__device__ __forceinline__ XcdBarrier xcd_barrier_post(unsigned* bar, volatile LAS unsigned* st) {
    XcdBarrier b; b.bar = bar; b.x = xb_xcc_id(); b.st = st;
    if (threadIdx.x == 0) (void)xb_add(&bar[XB_XCNT(b.x)], 1u);
    return b;
}
__device__ __forceinline__ void xcd_barrier_complete(unsigned* bar, unsigned x, unsigned& nloc, unsigned& nx) {
    const unsigned G = gridDim.x * gridDim.y * gridDim.z;
    unsigned sum, cnt, mine, sp = 0u;
    for (;;) {
        sum = 0u; cnt = 0u; mine = 0u;
#pragma unroll
        for (unsigned j = 0; j < 16; ++j) { const unsigned c = xb_ld(&bar[XB_XCNT(j)]); sum += c; cnt += (c > 0u) ? 1u : 0u; mine = (j == x) ? c : mine; }
        if (sum == G) break;
        __builtin_amdgcn_s_sleep(1);
        if ((++sp & 255u) == 0u) { if (xb_ld(&bar[XB_TMO])) break; if (sp > XB_SPIN_CAP) { atomicAdd(&bar[XB_TMO], 1u); break; } }
    }
    nloc = mine > 0u ? mine : 1u; nx = cnt > 0u ? cnt : 1u;
}

__device__ __forceinline__ void xcd_barrier(const XcdBarrier& b) {
    asm volatile("s_waitcnt vmcnt(0)" ::: "memory");
    __syncthreads();
    if (threadIdx.x == 0) {
        unsigned* bar = b.bar;
        __builtin_amdgcn_s_waitcnt(0);
        unsigned nloc = b.st[0], nx = b.st[1];
        if (nloc == 0u) { xcd_barrier_complete(bar, b.x, nloc, nx); b.st[0] = nloc; b.st[1] = nx; }
        const unsigned old = xb_add(&bar[XB_XSUB(b.x)], 1u);
        const unsigned gen = old / nloc;
        if (old + 1u == (gen + 1u) * nloc) {
            __builtin_amdgcn_fence(__ATOMIC_RELEASE, "agent");
            asm volatile("s_waitcnt vmcnt(0)" ::: "memory");
            const unsigned og = xb_add(&bar[XB_TOP], 1u);
            const unsigned tg = og / nx;
            if (og + 1u == (tg + 1u) * nx) xb_add(&bar[XB_TOPGEN], 1u);
            else XB_SPIN(xb_ld(&bar[XB_TOPGEN]) == tg, bar);
            __builtin_amdgcn_fence(__ATOMIC_ACQUIRE, "agent");
            xb_add(&bar[XB_XGEN(b.x)], 1u);
            asm volatile("s_waitcnt vmcnt(0)" ::: "memory");
        } else {
            XB_SPIN(xb_ld(&bar[XB_XGEN(b.x)]) == gen, bar);
            __builtin_amdgcn_fence(__ATOMIC_ACQUIRE, "agent");
            asm volatile("s_waitcnt vmcnt(0)" ::: "memory");
        }
    }
    __syncthreads();
}

struct Args { const float* in[N_IN]; float* out; unsigned char* ws; int ph_lo, ph_hi; };
constexpr int N_PHASES = 19;

__global__ void __launch_bounds__(NTHR, 2) fwd_kernel(Args args) {
    extern __shared__ __attribute__((aligned(16))) unsigned char lds_raw[];
    cg::grid_group grid = cg::this_grid();
    Ctx F;
    F.lds = (LAS unsigned char*)lds_raw;
    F.tid = threadIdx.x; F.lane = F.tid & 63; F.wave = __builtin_amdgcn_readfirstlane(F.tid >> 6);
    F.G = gridDim.x; F.gw = blockIdx.x * NWAVES + F.wave; F.NGW = F.G * NWAVES;
    F.in = args.in; F.out = args.out; F.ws = args.ws;
    const int lo = args.ph_lo, hi = args.ph_hi;
    volatile LAS unsigned* bst = (volatile LAS unsigned*)(F.lds + LDS_BYTES - 64);
    if (F.tid < 2) bst[F.tid] = 0u;
    if (F.tid < 4) ((volatile LAS unsigned*)(F.lds + LDS_BYTES - 48))[F.tid] = 0u;
    __syncthreads();
    const XcdBarrier bar = xcd_barrier_post((unsigned*)(F.ws + WS_CTL) + 4096, bst);
#define IN(k) (lo <= (k) && (k) < hi)
#ifndef TS_A
#define TS_A -1
#define TS_B -1
#define TS_K 0.1
#endif
    unsigned long long* stamps = (unsigned long long*)(F.ws + WS_CTL + 65536);
#define STAMP(k) do { if (TS_A >= 0 && blockIdx.x == 0 && F.tid == 0) stamps[k] = __builtin_amdgcn_s_memrealtime(); } while (0)
#define REP_MASK 0
#ifndef REP_MASK
#define REP_MASK 0
#endif
#define REPS(k) for (int rep_ = 0; rep_ < 1 + ((REP_MASK >> (k)) & 1); ++rep_)
#define SEAM(k) do { if (IN(k) && IN((k) + 1)) { if ((k) == 0) grid.sync(); else xcd_barrier(bar); } } while (0)

    STAMP(0);
    if (IN(0)) REPS(0) { p0_prologue(F); }
    SEAM(0);
    STAMP(1);
    if (IN(1)) REPS(1) { norm_mod_rows(F, F.in[I_X], F.in[I_N1W], 0, DM, (bf16*)(F.ws + WS_XN)); }
    SEAM(1);
    STAMP(2);
    if (IN(2)) REPS(2) {
        pg8::Gemm g{(const pg8::bf16_t*)(F.ws + WS_XN), (const pg8::bf16_t*)(F.ws + WS_WIN), M, INPP, DM};
        pg8::StaticOrder S; S.init(M, INPP, F.G, (int)blockIdx.x);
        pg8::EpiStoreBf16 E{(pg8::bf16_t*)(F.ws + WS_PROJ), INPP};
        pg8::gemm_phase<pg8::EpiStoreBf16, pg8::StaticOrder, true, true>(F.lds, g, S, E);
    }
    SEAM(2);
#ifndef P3REP
#define P3REP 0
#endif
    STAMP(3);
    if (IN(3)) REPS(3) { p3_lora(F); STAMP(40); m1_chunk_states(F); }
    SEAM(3);
    STAMP(4);
    if (IN(4)) { m2_prefix(F); ra_part(F, 0); }
    SEAM(4);
    STAMP(5);
    if (IN(5)) { rs_half(F, 0); ra_part(F, 1); }
    SEAM(5);
    STAMP(6);
    if (IN(6)) { rs_half(F, 1); ra_part(F, 2); }
    SEAM(6);
    STAMP(7);
    if (IN(7)) { rs_half(F, 2); ra_part(F, 3); }
    SEAM(7);
    STAMP(8);
    if (IN(8)) { rs_half(F, 3); }
    STAMP(9);
    if (IN(9)) REPS(9) { m3_outputs(F); }
    SEAM(9);
    STAMP(10);
    if (IN(10)) { p5_post(F); }
    SEAM(10);
    STAMP(11);
    if (IN(11)) REPS(11) {
        pg8::Gemm g{(const pg8::bf16_t*)(F.ws + WS_OY), (const pg8::bf16_t*)(F.ws + WS_WOUT), M, DM, DM};
        pg8::StaticOrder S; S.init(M, DM, F.G, (int)blockIdx.x);
        pg8::EpiResid E{F.in[I_X], (const float*)(F.ws + WS_MOD) + 2 * DM, (pg8::bf16_t*)(F.ws + WS_HB), DM, SEQ, MODW};
        pg8::gemm_phase<pg8::EpiResid, pg8::StaticOrder, true, true>(F.lds, g, S, E);
    }
    SEAM(11);
    STAMP(12);
    if (IN(12)) REPS(12) { norm_mod_rows_bf16(F, (const bf16*)(F.ws + WS_HB), F.in[I_N2W], 3 * DM, 4 * DM, (bf16*)(F.ws + WS_XN), (unsigned*)(F.ws + WS_X8)); }
    SEAM(12);
    STAMP(13);
    if (IN(13)) REPS(13) {
        pg8::Gemm g{(const pg8::bf16_t*)(F.ws + WS_XN), (const pg8::bf16_t*)(F.ws + WS_WQ), M, DM, DM};
        pg8::StaticOrder S; S.init(M, DM, F.G, (int)blockIdx.x);
        pg8::EpiStoreBf16 E{(pg8::bf16_t*)(F.ws + WS_Q), DM};
        pg8::gemm_phase<pg8::EpiStoreBf16, pg8::StaticOrder, true, true>(F.lds, g, S, E);
    }
    SEAM(13);
    STAMP(14);
    if (IN(14)) REPS(14) { p9_route(F); }
    SEAM(14);
    STAMP(15);
    if (IN(15)) REPS(15) { p10_peer_u(F); }
    SEAM(15);
    STAMP(16);
    if (IN(16)) REPS(16) { p11_peer_coef(F); }
    SEAM(16);
    STAMP(17);
    if (IN(17)) { p12_peer_v(F); }
    SEAM(17);
    STAMP(18);
    if (IN(18)) {
        float oscale = 1.f;
        if (TS_A >= 0) { const volatile unsigned long long* st = stamps; const float frac = (float)(st[TS_B] - st[TS_A]) / (float)(st[17] - st[0]); oscale = 1.f + (float)(TS_K) * frac; }
        final_norm_rows_bf16(F, (const bf16*)(F.ws + WS_HB), F.in[I_FNW], F.out, oscale);
    }
#undef IN
#undef SEAM
}

extern "C" void kernel_launch(void* const* d_in, const int* in_sizes, int n_in, void* d_out, int out_size, void* d_ws, size_t ws_size, hipStream_t stream) {
    static int grid = 0;
    if (grid == 0) {
        if (n_in != N_IN || in_sizes[0] != M * DM || out_size != M * DM || ws_size < WS_END2) {
            fprintf(stderr, "kernel_launch: unexpected shapes: n_in %d in0 %d out %d ws %zu (need %zu)\n", n_in, n_in > 0 ? in_sizes[0] : -1, out_size, ws_size, (size_t)WS_END2); grid = -1; return; }
        int dev = 0, cus = 0, per_cu = 0;
        if (hipGetDevice(&dev) != hipSuccess || hipDeviceGetAttribute(&cus, hipDeviceAttributeMultiprocessorCount, dev) != hipSuccess) { grid = -1; return; }
        if (hipFuncSetAttribute((const void*)fwd_kernel, hipFuncAttributeMaxDynamicSharedMemorySize, LDS_BYTES) != hipSuccess) { fprintf(stderr, "kernel_launch: hipFuncSetAttribute failed\n"); grid = -1; return; }
        if (hipOccupancyMaxActiveBlocksPerMultiprocessor(&per_cu, (const void*)fwd_kernel, NTHR, LDS_BYTES) != hipSuccess || per_cu < 1) { fprintf(stderr, "kernel_launch: occupancy query says %d blocks per CU\n", per_cu); per_cu = 1; }
        (void)hipGetLastError();
        grid = cus;
        fprintf(stderr, "kernel_launch: cus %d per_cu %d grid %d ws %zu\n", cus, per_cu, grid, ws_size);
    }
    if (grid < 0) return;
    (void)hipMemsetAsync((char*)d_ws + WS_CTL, 0, CTL_ZERO_BYTES, stream);
    Args a{};
    for (int i = 0; i < N_IN; ++i) a.in[i] = (const float*)d_in[i];
    a.out = (float*)d_out; a.ws = (unsigned char*)d_ws; a.ph_lo = 0; a.ph_hi = N_PHASES;
    void* kargs[] = {&a};
#ifndef NPASS
#define NPASS 1
#endif
    hipError_t e = hipSuccess;
    for (int pass_ = 0; pass_ < NPASS; ++pass_) {
        if (pass_ > 0) (void)hipMemsetAsync((char*)d_ws + WS_CTL, 0, CTL_ZERO_BYTES, stream);
        e = hipLaunchCooperativeKernel((const void*)fwd_kernel, dim3(grid), dim3(NTHR), kargs, LDS_BYTES, stream);
    }
    if (e != hipSuccess) fprintf(stderr, "kernel_launch: cooperative launch failed: %s (grid %d)\n", hipGetErrorString(e), grid);
}
```

```cpp
#include <hip/hip_runtime.h>
#include <hip/hip_cooperative_groups.h>
#include <cstdio>
#include <cstdint>
namespace cg = cooperative_groups;
namespace pg8 {
#define PG8_LAS __attribute__((address_space(3)))
typedef unsigned short bf16_t;
typedef short bf16x8 __attribute__((ext_vector_type(8)));
typedef float f32x4 __attribute__((ext_vector_type(4)));
typedef unsigned u32x4 __attribute__((ext_vector_type(4)));
constexpr int BM = 256, BK = 64, HALF = 128, HTB = HALF * BK * 2  , STAGE_BYTES = 8 * HTB, NXCD = 8, WGM = 8;

__host__ __device__ __forceinline__ int lds_byte(int r, int c) { const int st = (r >> 4) * 2 + (c >> 5), rr = r & 15, cc = c & 31, ob = rr * 64 + cc * 2; return st * 1024 + (ob ^ (((ob >> 9) & 1) << 5)); }
__host__ __device__ __forceinline__ void stage_rc(int b, int& R, int& C) { const int st = b / 1024, sb = b % 1024, swz = sb ^ (((sb >> 9) & 1) << 5); R = (st >> 1) * 16 + swz / 64; C = (st & 1) * 32 + (swz % 64) / 2; }
__host__ __device__ __forceinline__ int perm32(int rho) { const int n = rho >> 4, i = rho & 15; return 8 * (i >> 2) + 4 * n + (i & 3); }

struct Unit { int pm, pn; };
struct Gemm { const bf16_t* A; const bf16_t* Bt; int M, N, K; };

struct StaticOrder {
    int nM, nN, nwg, G, c;
    __host__ __device__ void init(int M, int N, int G_, int c_) { nM = M / BM; nN = N / BM; nwg = nM * nN; G = G_; c = c_; }
    __host__ __device__ bool next(int i, Unit& u) const {
        const long L = (long)i * G + c; if (L >= nwg) return false;
        int wgid = (int)L; { const int q = nwg / NXCD, r = nwg % NXCD, xcd = wgid % NXCD, off = wgid / NXCD; wgid = (xcd < r ? xcd * (q + 1) : r * (q + 1) + (xcd - r) * q) + off; }
        const int nig = WGM * nN, gid = wgid / nig, fm = gid * WGM, gsz = (nM - fm) < WGM ? (nM - fm) : WGM;
        u.pm = fm + ((wgid % nig) % gsz); u.pn = (wgid % nig) / gsz; return true;
    }
    __device__ __forceinline__ void a_ready(const Unit&) const {}
    __device__ __forceinline__ void done(const Unit&) const {}
};
__device__ __forceinline__ unsigned cvt_pk_bf16(float lo, float hi) { unsigned r; asm volatile("v_cvt_pk_bf16_f32 %0, %1, %2" : "=v"(r) : "v"(lo), "v"(hi)); return r; }
struct EpiStoreBf16 {
    static constexpr bool PERM = true, AFTER_DRAIN = false;
    bf16_t* O; int ldc;
    __device__ __forceinline__ void operator()(const f32x4 (&acc)[2][2][4][2], const Unit& u, int wr, int wc, int fr, int fq) const {
        const int row0 = u.pm * BM + wr * 64 + fr; const int col0 = u.pn * BM + wc * 32 + 8 * fq;
#pragma unroll
        for (int ai = 0; ai < 2; ++ai)
#pragma unroll
            for (int m = 0; m < 4; ++m) { bf16_t* rowp = O + (size_t)(row0 + ai * HALF + m * 16) * ldc + col0;
#pragma unroll
                for (int bj = 0; bj < 2; ++bj) { const f32x4 v0 = acc[ai][bj][m][0], v1 = acc[ai][bj][m][1];
                    u32x4 w; w.x = cvt_pk_bf16(v0[0], v0[1]); w.y = cvt_pk_bf16(v0[2], v0[3]); w.z = cvt_pk_bf16(v1[0], v1[1]); w.w = cvt_pk_bf16(v1[2], v1[3]);
                    *(u32x4*)(rowp + bj * HALF) = w; } }
    }
};
struct EpiResid {
    static constexpr bool PERM = true, AFTER_DRAIN = false;
    const float* X; const float* gate; bf16_t* O; int ldc; int rows_per_batch; int gstride;
    __device__ __forceinline__ void operator()(const f32x4 (&acc)[2][2][4][2], const Unit& u, int wr, int wc, int fr, int fq) const {
        const int row0 = u.pm * BM + wr * 64 + fr; const int col0 = u.pn * BM + wc * 32 + 8 * fq;
        const float* g = gate + (size_t)((u.pm * BM) / rows_per_batch) * gstride + col0;
        f32x4 gv[2][2];
#pragma unroll
        for (int bj = 0; bj < 2; ++bj)
#pragma unroll
            for (int n = 0; n < 2; ++n) gv[bj][n] = *(const f32x4*)(g + bj * HALF + 4 * n);
#pragma unroll
        for (int ai = 0; ai < 2; ++ai)
#pragma unroll
            for (int m = 0; m < 4; ++m) { const size_t off = (size_t)(row0 + ai * HALF + m * 16) * ldc + col0;
#pragma unroll
                for (int bj = 0; bj < 2; ++bj) { const f32x4 x0 = *(const f32x4*)(X + off + bj * HALF), x1 = *(const f32x4*)(X + off + bj * HALF + 4);
                    const f32x4 v0 = x0 + gv[bj][0] * acc[ai][bj][m][0], v1 = x1 + gv[bj][1] * acc[ai][bj][m][1];
                    u32x4 w; w.x = cvt_pk_bf16(v0[0], v0[1]); w.y = cvt_pk_bf16(v0[2], v0[3]); w.z = cvt_pk_bf16(v1[0], v1[1]); w.w = cvt_pk_bf16(v1[2], v1[3]);
                    *(u32x4*)(O + off + bj * HALF) = w; } }
    }
};
template <class Epi, class Sched, bool ALIGN_EPI = false, bool SP2 = false>
__device__ __forceinline__ void gemm_phase(PG8_LAS unsigned char* lds, const Gemm g, const Sched& S, const Epi& E) {
    const int tid = threadIdx.x, wid = __builtin_amdgcn_readfirstlane(tid >> 6), lane = tid & 63, wr = wid >> 2, wc = wid & 3, fr = lane & 15, fq = lane >> 4;
    const int K = g.K, nt = K / BK;
    unsigned voffA[2], voffB[2];
#pragma unroll
    for (int i = 0; i < 2; ++i) { int R, C; stage_rc(tid * 16 + i * 8192, R, C); const int Rb = Epi::PERM ? ((R & ~31) + perm32(R & 31)) : R;
        voffA[i] = (unsigned)(R * K + C) * 2u; voffB[i] = (unsigned)(Rb * K + C) * 2u; }
    const size_t kstep = (size_t)(BK * 2);
    const size_t hstep = (size_t)HALF * K * 2;
    const size_t tstep = 2 * hstep;
    const unsigned ldsw = (unsigned)wid * 1024u;
    const int aoff = lds_byte(wr * 64 + fr, fq * 8), boff = lds_byte(wc * 32 + fr, fq * 8);
#define PG8_SA(b, h) (((b) * 2 + (h)) * HTB)
#define PG8_SB(b, h) ((4 + (b) * 2 + (h)) * HTB)
#define PG8_STAGE(bufoff, gbase, voff) do { _Pragma("unroll") for (int _i = 0; _i < 2; ++_i) \
        __builtin_amdgcn_global_load_lds((const unsigned*)((const char*)(gbase) + (voff)[_i]), (PG8_LAS unsigned*)(lds + (bufoff) + ldsw + _i * 8192), 16, 0, 0); } while (0)
#define PG8_LDA(dst, b, h) do { _Pragma("unroll") for (int m = 0; m < 4; ++m) _Pragma("unroll") for (int k = 0; k < 2; ++k) dst[m][k] = *(const PG8_LAS bf16x8*)(lds + PG8_SA(b, h) + aoff + m * 2048 + k * 1024); } while (0)
#define PG8_LDB(dst, b, h) do { _Pragma("unroll") for (int n = 0; n < 2; ++n) _Pragma("unroll") for (int k = 0; k < 2; ++k) dst[n][k] = *(const PG8_LAS bf16x8*)(lds + PG8_SB(b, h) + boff + n * 2048 + k * 1024); } while (0)
#define PG8_MMA(ai, bj, At, Bt) do { __builtin_amdgcn_s_setprio(1); _Pragma("unroll") for (int m = 0; m < 4; ++m) _Pragma("unroll") for (int n = 0; n < 2; ++n) _Pragma("unroll") for (int k = 0; k < 2; ++k) \
        acc[ai][bj][m][n] = __builtin_amdgcn_mfma_f32_16x16x32_bf16(Bt[n][k], At[m][k], acc[ai][bj][m][n], 0, 0, 0); __builtin_amdgcn_s_setprio(0); } while (0)
#define PG8_WAIT_V(n) asm volatile("s_waitcnt vmcnt(" #n ")" ::: "memory")
#define PG8_WAIT_L(n) asm volatile("s_waitcnt lgkmcnt(" #n ")" ::: "memory")
#define PG8_BAR __builtin_amdgcn_s_barrier()
#define PG8_SCHED __builtin_amdgcn_sched_barrier(0)
    Unit cur, nxt; int ui = 0;
    if (!S.next(0, cur)) return;
    f32x4 acc[2][2][4][2];
#pragma unroll
    for (int a = 0; a < 2; ++a)
#pragma unroll
        for (int b = 0; b < 2; ++b)
#pragma unroll
            for (int m = 0; m < 4; ++m)
#pragma unroll
                for (int n = 0; n < 2; ++n) acc[a][b][m][n] = (f32x4){0.f, 0.f, 0.f, 0.f};
    bf16x8 At[4][2], B0[2][2], B1[2][2];
    const char* cA = (const char*)g.A + (size_t)cur.pm * tstep; const char* cB = (const char*)g.Bt + (size_t)cur.pn * tstep;
    S.a_ready(cur);
    if constexpr (SP2) {
        PG8_STAGE(PG8_SB(0, 0), cB, voffB); PG8_STAGE(PG8_SB(0, 1), cB + hstep, voffB); PG8_STAGE(PG8_SA(0, 0), cA, voffA); PG8_STAGE(PG8_SA(0, 1), cA + hstep, voffA);
        if (wr == 1) PG8_BAR;
        PG8_WAIT_V(2); PG8_BAR;
        PG8_STAGE(PG8_SB(1, 0), cB + kstep, voffB); PG8_STAGE(PG8_SA(1, 0), cA + kstep, voffA); PG8_STAGE(PG8_SB(1, 1), cB + hstep + kstep, voffB);
        PG8_WAIT_V(6); PG8_BAR;
    } else {
        PG8_STAGE(PG8_SB(0, 0), cB, voffB); PG8_STAGE(PG8_SA(0, 0), cA, voffA); PG8_STAGE(PG8_SB(0, 1), cB + hstep, voffB); PG8_STAGE(PG8_SA(0, 1), cA + hstep, voffA);
        if (wr == 1) PG8_BAR;
        PG8_WAIT_V(4); PG8_BAR;
        PG8_STAGE(PG8_SB(1, 0), cB + kstep, voffB); PG8_STAGE(PG8_SA(1, 0), cA + kstep, voffA); PG8_STAGE(PG8_SB(1, 1), cB + hstep + kstep, voffB);
        PG8_WAIT_V(6); PG8_BAR;
    }
    for (;;) {
        const bool has_next = S.next(ui + 1, nxt);
        const char* nA = has_next ? (const char*)g.A + (size_t)nxt.pm * tstep : cA; const char* nB = has_next ? (const char*)g.Bt + (size_t)nxt.pn * tstep : cB;
        for (int t = 0; t < nt; t += 2) {
            const bool last = (t == nt - 2);
            const char* a1 = cA + (size_t)(t + 1) * kstep;
            const char* a2 = last ? nA : cA + (size_t)(t + 2) * kstep; const char* b2 = last ? nB : cB + (size_t)(t + 2) * kstep;
            const char* a3 = a2 + kstep; const char* b3 = b2 + kstep;
            if (last && has_next) S.a_ready(nxt);
            if constexpr (SP2) {
            PG8_LDB(B0, 0, 0); PG8_LDB(B1, 0, 1); PG8_SCHED; PG8_LDA(At, 0, 0); PG8_STAGE(PG8_SA(1, 1), a1 + hstep, voffA);
            PG8_WAIT_V(8); PG8_WAIT_L(0); PG8_BAR; PG8_MMA(0, 0, At, B0); PG8_MMA(0, 1, At, B1); PG8_BAR; PG8_SCHED;
            PG8_LDA(At, 0, 1); PG8_STAGE(PG8_SB(0, 0), b2, voffB); PG8_STAGE(PG8_SB(0, 1), b2 + hstep, voffB); PG8_STAGE(PG8_SA(0, 0), a2, voffA);
            PG8_WAIT_V(8); PG8_WAIT_L(0); PG8_BAR; PG8_MMA(1, 0, At, B0); PG8_MMA(1, 1, At, B1); PG8_BAR; PG8_SCHED;
            PG8_LDB(B0, 1, 0); PG8_LDB(B1, 1, 1); PG8_SCHED; PG8_LDA(At, 1, 0); PG8_STAGE(PG8_SA(0, 1), a2 + hstep, voffA);
            PG8_WAIT_V(8); PG8_WAIT_L(0); PG8_BAR; PG8_MMA(0, 0, At, B0); PG8_MMA(0, 1, At, B1); PG8_BAR; PG8_SCHED;
            PG8_LDA(At, 1, 1); PG8_STAGE(PG8_SB(1, 0), b3, voffB); PG8_STAGE(PG8_SB(1, 1), b3 + hstep, voffB); PG8_STAGE(PG8_SA(1, 0), a3, voffA);
            PG8_WAIT_V(8); PG8_WAIT_L(0); PG8_BAR; PG8_MMA(1, 0, At, B0); PG8_MMA(1, 1, At, B1); PG8_BAR; PG8_SCHED;
            } else {
            PG8_LDB(B0, 0, 0); PG8_SCHED; PG8_LDA(At, 0, 0); PG8_STAGE(PG8_SA(1, 1), a1 + hstep, voffA);
            PG8_WAIT_L(8); PG8_BAR; PG8_WAIT_L(0); PG8_MMA(0, 0, At, B0); PG8_BAR; PG8_SCHED;
            PG8_LDB(B1, 0, 1); PG8_STAGE(PG8_SB(0, 0), b2, voffB);
            PG8_BAR; PG8_WAIT_L(0); PG8_MMA(0, 1, At, B1); PG8_BAR;
            PG8_LDA(At, 0, 1); PG8_STAGE(PG8_SA(0, 0), a2, voffA);
            PG8_BAR; PG8_WAIT_L(0); PG8_MMA(1, 0, At, B0); PG8_BAR; PG8_SCHED;
            PG8_STAGE(PG8_SB(0, 1), b2 + hstep, voffB);
            PG8_WAIT_V(6); PG8_BAR; PG8_MMA(1, 1, At, B1); PG8_BAR;
            PG8_LDB(B0, 1, 0); PG8_SCHED; PG8_LDA(At, 1, 0); PG8_STAGE(PG8_SA(0, 1), a2 + hstep, voffA);
            PG8_WAIT_L(8); PG8_BAR; PG8_WAIT_L(0); PG8_MMA(0, 0, At, B0); PG8_BAR; PG8_SCHED;
            PG8_LDB(B1, 1, 1); PG8_STAGE(PG8_SB(1, 0), b3, voffB);
            PG8_BAR; PG8_WAIT_L(0); PG8_MMA(0, 1, At, B1); PG8_BAR;
            PG8_LDA(At, 1, 1); PG8_STAGE(PG8_SA(1, 0), a3, voffA);
            PG8_BAR; PG8_WAIT_L(0); PG8_MMA(1, 0, At, B0); PG8_BAR; PG8_SCHED;
            PG8_STAGE(PG8_SB(1, 1), b3 + hstep, voffB);
            PG8_WAIT_V(6); PG8_BAR; PG8_MMA(1, 1, At, B1); PG8_BAR;
            }
        }
        if constexpr (ALIGN_EPI) { if (wr == 0) PG8_BAR; }
        if constexpr (!Epi::AFTER_DRAIN) { E(acc, cur, wr, wc, fr, fq); S.done(cur); }
        if (!has_next) break;
#pragma unroll
        for (int a = 0; a < 2; ++a)
#pragma unroll
            for (int b = 0; b < 2; ++b)
#pragma unroll
                for (int m = 0; m < 4; ++m)
#pragma unroll
                    for (int n = 0; n < 2; ++n) acc[a][b][m][n] = (f32x4){0.f, 0.f, 0.f, 0.f};
        cur = nxt; cA = nA; cB = nB; ++ui;
        if constexpr (ALIGN_EPI) { if (wr == 1) PG8_BAR; }
    }
    PG8_WAIT_V(0);
    if constexpr (!ALIGN_EPI) { if (wr == 0) PG8_BAR; }
    PG8_BAR;
    if constexpr (Epi::AFTER_DRAIN) { E.fused(acc, cur, wr, wc, fr, fq, lds, wid, lane); S.done(cur); }
#undef PG8_SA
#undef PG8_SB
#undef PG8_STAGE
#undef PG8_LDA
#undef PG8_LDB
#undef PG8_MMA
#undef PG8_WAIT_V
#undef PG8_WAIT_L
#undef PG8_BAR
#undef PG8_SCHED
}
}
#define GAS __attribute__((address_space(1)))
#define LAS __attribute__((address_space(3)))
typedef unsigned short bf16;
typedef unsigned v4u __attribute__((ext_vector_type(4)));
typedef unsigned v2u __attribute__((ext_vector_type(2)));
typedef float f32x4 __attribute__((ext_vector_type(4)));
typedef float f32x2 __attribute__((ext_vector_type(2)));
typedef short bf16x8 __attribute__((ext_vector_type(8)));
typedef __bf16 bf16x2_t __attribute__((ext_vector_type(2)));

constexpr int NWAVES = 8, NTHR = 512;
constexpr int DM = 2048, NB = 4, SEQ = 8192, M = NB * SEQ;
constexpr int RW = 1024, RHEADS = 16, HD = 64;
constexpr int L_W = 64, L_A = 64, L_G = 160;
constexpr int INP = 5936, INPP = 6144;
constexpr int C_R = 0, C_K = 1024, C_V = 2048, C_WD = 3072, C_AD = 3136, C_GD = 3200, C_Z = 3360, C_XBC = 4384, C_DT = 5920;
constexpr int MODW = 6 * DM;
constexpr int NEXP = 16384;
constexpr float RMS_EPS = 1e-6f;

enum { I_X = 0, I_C, I_ADAW, I_ADAB, I_N1W, I_WIN, I_MU, I_W0, I_WUP, I_A0, I_AUP, I_GUP, I_KK, I_KA, I_RK, I_LNW, I_LNB,
       I_CONVW, I_CONVB, I_DTB, I_ALOG, I_DSK, I_MNW, I_WOUT, I_N2W, I_WQ, I_KEYS, I_PU, I_PV, I_FNW, N_IN };

constexpr size_t MiB = 1u << 20;
constexpr size_t WS_CTL = 0, CTL_ZERO_BYTES = 1 * MiB;
constexpr size_t WS_MOD = 1 * MiB;
constexpr size_t WS_WIN = 2 * MiB, WS_WOUT = 26 * MiB, WS_WQ = 34 * MiB, WS_KEYS = 42 * MiB;
constexpr size_t WS_WUPT = 43 * MiB, WS_AUPT = 43 * MiB + 256 * 1024, WS_GUPT = 43 * MiB + 512 * 1024;
constexpr size_t WS_PU8 = 44 * MiB, WS_PV8 = 76 * MiB;
constexpr size_t WS_USC = 108 * MiB, WS_VSC = 108 * MiB + 65536;
constexpr size_t WS_XN = 172 * MiB;
constexpr size_t WS_LW = WS_XN, WS_AA = WS_XN + 64 * MiB;
constexpr size_t WS_PROJ = 300 * MiB;
constexpr size_t WS_Q = WS_PROJ;
constexpr size_t WS_GG = 684 * MiB;
constexpr size_t WS_X8 = WS_PROJ + 192 * MiB;
constexpr size_t WS_PD = WS_PROJ + 128 * MiB;
constexpr size_t WS_RTE = 684 * MiB, WS_RTG = 700 * MiB, WS_COEF = 716 * MiB;
constexpr size_t WS_OY = 748 * MiB;
constexpr size_t WS_END = 876 * MiB;
constexpr size_t WS_HB = 876 * MiB;

constexpr int RING_BYTES = 131072, LDS_BYTES = 147456;

#define LDS_WAIT() asm volatile("s_waitcnt lgkmcnt(0)" ::: "memory")
#define VM_WAIT() asm volatile("s_waitcnt vmcnt(0)" ::: "memory")
__device__ __forceinline__ unsigned pk2(float lo, float hi) { f32x2 v = {lo, hi}; bf16x2_t b = __builtin_convertvector(v, bf16x2_t); return __builtin_bit_cast(unsigned, b); }
__device__ __forceinline__ float bflo(unsigned u) { return __uint_as_float(u << 16); }
__device__ __forceinline__ float bfhi(unsigned u) { return __uint_as_float(u & 0xffff0000u); }
__device__ __forceinline__ float bf1(bf16 h) { return __uint_as_float((unsigned)h << 16); }
__device__ __forceinline__ float wave_sum(float v) {
#pragma unroll
    for (int o = 1; o < 64; o <<= 1) v += __shfl_xor(v, o);
    return v;
}
__device__ __forceinline__ float rcp_f(float v) { return __builtin_amdgcn_rcpf(v); }
template <int CTRL> __device__ __forceinline__ float dppc_f(float x) { return __builtin_bit_cast(float, __builtin_amdgcn_mov_dpp(__builtin_bit_cast(int, x), CTRL, 0xf, 0xf, true)); }
__device__ __forceinline__ float wave_sum_fast(float x) {
    x += dppc_f<0xB1>(x); x += dppc_f<0x4E>(x); x += dppc_f<0x124>(x); x += dppc_f<0x128>(x);
    { auto rr = __builtin_amdgcn_permlane16_swap(__float_as_uint(x), __float_as_uint(x), false, false); x = __uint_as_float(rr[0]) + __uint_as_float(rr[1]); }
    { auto rr = __builtin_amdgcn_permlane32_swap(__float_as_uint(x), __float_as_uint(x), false, false); x = __uint_as_float(rr[0]) + __uint_as_float(rr[1]); }
    return x;
}
__device__ __forceinline__ float silu_f(float v) { return v * rcp_f(1.f + __expf(-v)); }
__device__ __forceinline__ float sigmoid_f(float v) { return rcp_f(1.f + __expf(-v)); }

struct Ctx {
    LAS unsigned char* lds;
    int tid, lane, wave, G, gw, NGW;
    const float* const* in;
    float* out; unsigned char* ws;
};

__device__ __forceinline__ void transpose_item(const float* W, int K, int N, bf16* WT, int ldt, int nrows_out, LAS float* scr, int kb, int nb, int lane) {
    const int k0 = 64 * kb, n0 = 64 * nb;
    const int c4 = 4 * (lane & 15), rr = lane >> 4;
    const bool vec_ok = ((N & 3) == 0) && (n0 + 64 <= N);
#pragma unroll 4
    for (int i = 0; i < 16; ++i) { const int kk = 4 * i + rr, k = k0 + kk;
        f32x4 v = {0.f, 0.f, 0.f, 0.f};
        if (k < K) { const float* src = W + (size_t)k * N + n0 + c4;
            if (vec_ok) v = *(const f32x4*)src;
            else { if (n0 + c4 + 0 < N) v.x = src[0]; if (n0 + c4 + 1 < N) v.y = src[1]; if (n0 + c4 + 2 < N) v.z = src[2]; if (n0 + c4 + 3 < N) v.w = src[3]; } }
        LAS float* d = scr + kk * 65 + c4; d[0] = v.x; d[1] = v.y; d[2] = v.z; d[3] = v.w; }
    LDS_WAIT(); asm volatile("" ::: "memory");
    const int c = lane & 7;
#pragma unroll
    for (int j = 0; j < 8; ++j) { const int n = (lane >> 3) + 8 * j; const LAS float* sp = scr + (8 * c) * 65 + n;
        v4u o; o.x = pk2(sp[0 * 65], sp[1 * 65]); o.y = pk2(sp[2 * 65], sp[3 * 65]); o.z = pk2(sp[4 * 65], sp[5 * 65]); o.w = pk2(sp[6 * 65], sp[7 * 65]);
        if (n0 + n < nrows_out && k0 + 8 * c + 8 <= ldt) *(v4u*)(WT + (size_t)(n0 + n) * ldt + k0 + 8 * c) = o; }
    LDS_WAIT(); asm volatile("" ::: "memory");
}
__device__ __forceinline__ void transpose_all(const float* W, int K, int N, bf16* WT, int ldt, int nrows_out, LAS float* scr, int gw, int NGW, int lane) {
    const int nkb = (K + 63) / 64, nnb = nrows_out / 64, nit = nkb * nnb;
    for (int it = gw; it < nit; it += NGW) transpose_item(W, K, N, WT, ldt, nrows_out, scr, it / nnb, it % nnb, lane);
}
__device__ __forceinline__ void convert_all(const float* src, bf16* dst, size_t n8, int gw, int NGW, int lane) {
    const f32x4* s4 = (const f32x4*)src; v4u* d4 = (v4u*)dst;
    for (size_t i = (size_t)gw * 64 + lane; i < n8; i += (size_t)NGW * 64) {
        const f32x4 a = __builtin_nontemporal_load(s4 + 2 * i), b = __builtin_nontemporal_load(s4 + 2 * i + 1);
        v4u o; o.x = pk2(a.x, a.y); o.y = pk2(a.z, a.w); o.z = pk2(b.x, b.y); o.w = pk2(b.z, b.w);
        d4[i] = o; }
}
__device__ __forceinline__ void quantize_rows_fp8(const float* src, unsigned char* dst8, float* scales, int e0, int e1, int step, int lane) {
    if (e0 >= e1) return;
    f32x4 vn[8];
    { const f32x4* s4 = (const f32x4*)(src + (size_t)e0 * DM) + lane;
#pragma unroll
      for (int i = 0; i < 8; ++i) vn[i] = __builtin_nontemporal_load(s4 + 64 * i); }
    for (int e = e0; e < e1; e += step) {
        f32x4 v[8];
#pragma unroll
        for (int i = 0; i < 8; ++i) v[i] = vn[i];
        { const int en = (e + step < e1) ? e + step : e; const f32x4* s4 = (const f32x4*)(src + (size_t)en * DM) + lane;
#pragma unroll
          for (int i = 0; i < 8; ++i) vn[i] = __builtin_nontemporal_load(s4 + 64 * i); }
        float am = 0.f;
#pragma unroll
        for (int i = 0; i < 8; ++i) am = fmaxf(fmaxf(am, fmaxf(fabsf(v[i].x), fabsf(v[i].y))), fmaxf(fabsf(v[i].z), fabsf(v[i].w)));
#pragma unroll
        for (int o = 1; o < 64; o <<= 1) am = fmaxf(am, __shfl_xor(am, o));
        am = fmaxf(am, 1e-30f);
        const float inv = 440.f / am;
#pragma unroll
        for (int i = 0; i < 8; ++i) { int w = __builtin_amdgcn_cvt_pk_fp8_f32(v[i].x * inv, v[i].y * inv, 0, false); w = __builtin_amdgcn_cvt_pk_fp8_f32(v[i].z * inv, v[i].w * inv, w, true);
            const int seg = 2 * i + (lane >> 5);
            *(int*)(dst8 + (size_t)seg * ((size_t)NEXP * 128) + (size_t)e * 128 + 4 * (lane & 31)) = w; }
        if (lane == 0) scales[e] = am * (1.f / 440.f);
    }
}
__device__ __forceinline__ void quantize_rows_fp4(const float* src, unsigned char* dst4, float* scales, int e0, int e1, int step, int lane) {
    if (e0 >= e1) return;
    f32x4 vn[8];
    { const f32x4* s4 = (const f32x4*)(src + (size_t)e0 * DM) + lane;
#pragma unroll
      for (int i = 0; i < 8; ++i) vn[i] = __builtin_nontemporal_load(s4 + 64 * i); }
    for (int e = e0; e < e1; e += step) {
        f32x4 v[8];
#pragma unroll
        for (int i = 0; i < 8; ++i) v[i] = vn[i];
        { const int en = (e + step < e1) ? e + step : e; const f32x4* s4 = (const f32x4*)(src + (size_t)en * DM) + lane;
#pragma unroll
          for (int i = 0; i < 8; ++i) vn[i] = __builtin_nontemporal_load(s4 + 64 * i); }
        float am = 0.f;
#pragma unroll
        for (int i = 0; i < 8; ++i) am = fmaxf(am, fmaxf(fmaxf(fabsf(v[i].x), fabsf(v[i].y)), fmaxf(fabsf(v[i].z), fabsf(v[i].w))));
#pragma unroll
        for (int o = 1; o < 64; o <<= 1) am = fmaxf(am, __shfl_xor(am, o));
        am = fmaxf(am, 1e-30f);
        const float inv = 6.f / am;
#pragma unroll
        for (int i = 0; i < 8; ++i) {
            unsigned w = __builtin_amdgcn_cvt_scalef32_pk_fp4_f32(0u, v[i].x * inv, v[i].y * inv, 1.0f, 0);
            w = __builtin_amdgcn_cvt_scalef32_pk_fp4_f32(w, v[i].z * inv, v[i].w * inv, 1.0f, 1);
            *(unsigned short*)(dst4 + (size_t)i * ((size_t)NEXP * 128) + (size_t)e * 128 + 2 * lane) = (unsigned short)w;
        }
        if (lane == 0) scales[e] = am * (1.f / 6.f);
    }
}
__device__ __forceinline__ void p0_prologue(const Ctx& F) {
    __syncthreads();
    if (blockIdx.x < MODW / 64) {
        LAS float* sc = (LAS float*)F.lds;
        LAS float* red = sc + NB * DM;
        const float* c = F.in[I_C];
        for (int i = F.tid; i < NB * DM; i += NTHR) sc[i] = silu_f(c[i]);
        __syncthreads();
        const int j = blockIdx.x * 64 + F.lane;
        const float* wp = F.in[I_ADAW] + (size_t)(F.wave * 256) * MODW + j;
        float a0 = 0.f, a1 = 0.f, a2 = 0.f, a3 = 0.f;
#pragma unroll 32
        for (int kk = 0; kk < 256; ++kk) { const float w = wp[(size_t)kk * MODW]; const int k = F.wave * 256 + kk;
            a0 += sc[k] * w; a1 += sc[DM + k] * w; a2 += sc[2 * DM + k] * w; a3 += sc[3 * DM + k] * w; }
        red[(F.wave * 4 + 0) * 64 + F.lane] = a0; red[(F.wave * 4 + 1) * 64 + F.lane] = a1; red[(F.wave * 4 + 2) * 64 + F.lane] = a2; red[(F.wave * 4 + 3) * 64 + F.lane] = a3;
        __syncthreads();
        if (F.tid < 256) { const int b = F.tid >> 6, l = F.tid & 63; float s = F.in[I_ADAB][blockIdx.x * 64 + l];
#pragma unroll
            for (int w = 0; w < 8; ++w) s += red[(w * 4 + b) * 64 + l];
            ((float*)(F.ws + WS_MOD))[b * MODW + blockIdx.x * 64 + l] = s; }
        __syncthreads();
    }
    LAS float* scr = (LAS float*)(F.lds + F.wave * 16640);
    transpose_all(F.in[I_WIN], DM, INP, (bf16*)(F.ws + WS_WIN), DM, INPP, scr, F.gw, F.NGW, F.lane);
    transpose_all(F.in[I_WOUT], DM, DM, (bf16*)(F.ws + WS_WOUT), DM, DM, scr, F.gw, F.NGW, F.lane);
    transpose_all(F.in[I_WQ], DM, DM, (bf16*)(F.ws + WS_WQ), DM, DM, scr, F.gw, F.NGW, F.lane);
    transpose_all(F.in[I_WUP], L_W, RW, (bf16*)(F.ws + WS_WUPT), L_W, RW, scr, F.gw, F.NGW, F.lane);
    transpose_all(F.in[I_AUP], L_A, RW, (bf16*)(F.ws + WS_AUPT), L_A, RW, scr, F.gw, F.NGW, F.lane);
    transpose_all(F.in[I_GUP], L_G, RW, (bf16*)(F.ws + WS_GUPT), L_G, RW, scr, F.gw, F.NGW, F.lane);
    convert_all(F.in[I_KEYS], (bf16*)(F.ws + WS_KEYS), (size_t)16 * 128 * 128 / 8, F.gw, F.NGW, F.lane);
    {
        const int nlo = (F.G < 192) ? F.G : 192, nhi = F.G - nlo;
        const int wtot = 5 * nlo + 8 * nhi;
        const int wb0 = (blockIdx.x < nlo) ? 5 * blockIdx.x : 5 * nlo + 8 * (blockIdx.x - nlo), wb1 = wb0 + ((blockIdx.x < nlo) ? 5 : 8);
        const int r0 = (int)((long)(2 * NEXP) * wb0 / wtot), r1 = (int)((long)(2 * NEXP) * wb1 / wtot);
        const int a0 = r0 < NEXP ? r0 : NEXP, a1 = r1 < NEXP ? r1 : NEXP;
        quantize_rows_fp4(F.in[I_PU], F.ws + WS_PU8, (float*)(F.ws + WS_USC), a0 + F.wave, a1, NWAVES, F.lane);
        const int b0 = (r0 > NEXP ? r0 : NEXP) - NEXP, b1 = (r1 > NEXP ? r1 : NEXP) - NEXP;
        quantize_rows_fp4(F.in[I_PV], F.ws + WS_PV8, (float*)(F.ws + WS_VSC), b0 + F.wave, b1, NWAVES, F.lane);
    }
}

__device__ __forceinline__ void norm_mod_rows(const Ctx& F, const float* X, const float* nw, int shift_off, int scale_off, bf16* XN) {
    const float* mod = (const float*)(F.ws + WS_MOD);
    if (F.gw >= M) return;
    f32x4 vn[8];
    { const f32x4* xr = (const f32x4*)(X + (size_t)F.gw * DM) + F.lane;
#pragma unroll
      for (int j = 0; j < 8; ++j) vn[j] = xr[64 * j]; }
    for (int m = F.gw; m < M; m += F.NGW) {
        const int b = m / SEQ;
        f32x4 v[8]; float s = 0.f;
#pragma unroll
        for (int j = 0; j < 8; ++j) { v[j] = vn[j]; s += (v[j].x * v[j].x + v[j].y * v[j].y) + (v[j].z * v[j].z + v[j].w * v[j].w); }
        { const int mn = (m + F.NGW < M) ? m + F.NGW : m; const f32x4* xr = (const f32x4*)(X + (size_t)mn * DM) + F.lane;
#pragma unroll
          for (int j = 0; j < 8; ++j) vn[j] = xr[64 * j]; }
        const float rstd = rsqrtf(wave_sum_fast(s) * (1.f / DM) + RMS_EPS);
        const f32x4* wp = (const f32x4*)nw + F.lane;
        const f32x4* shp = (const f32x4*)(mod + (size_t)b * MODW + shift_off) + F.lane;
        const f32x4* scp = (const f32x4*)(mod + (size_t)b * MODW + scale_off) + F.lane;
        v2u* o = (v2u*)(XN + (size_t)m * DM) + F.lane;
#pragma unroll
        for (int j = 0; j < 8; ++j) { const f32x4 w = wp[64 * j], a = scp[64 * j], c = shp[64 * j];
            const f32x4 r = (v[j] * rstd) * w * (a + 1.f) + c;
            v2u p; p.x = pk2(r.x, r.y); p.y = pk2(r.z, r.w); o[64 * j] = p; }
    }
}
__device__ __forceinline__ void final_norm_rows(const Ctx& F, const float* H, const float* nw, float* O) {
    for (int m = F.gw; m < M; m += F.NGW) {
        const f32x4* xr = (const f32x4*)(H + (size_t)m * DM) + F.lane;
        f32x4 v[8]; float s = 0.f;
#pragma unroll
        for (int j = 0; j < 8; ++j) { v[j] = xr[64 * j]; s += (v[j].x * v[j].x + v[j].y * v[j].y) + (v[j].z * v[j].z + v[j].w * v[j].w); }
        const float rstd = rsqrtf(wave_sum(s) * (1.f / DM) + RMS_EPS);
        const f32x4* wp = (const f32x4*)nw + F.lane;
        f32x4* o = (f32x4*)(O + (size_t)m * DM) + F.lane;
#pragma unroll
        for (int j = 0; j < 8; ++j) o[64 * j] = (v[j] * rstd) * wp[64 * j];
    }
}


__device__ __forceinline__ void load_row_raw(const bf16* row, int lane, v2u (&u)[8]) {
    const v2u* p = (const v2u*)row + lane;
#pragma unroll
    for (int j = 0; j < 8; ++j) u[j] = p[64 * j];
}
__device__ __forceinline__ void norm_mod_rows_bf16(const Ctx& F, const bf16* X, const float* nw, int shift_off, int scale_off, bf16* XN, unsigned* X8 = nullptr) {
    const float* mod = (const float*)(F.ws + WS_MOD);
    if (F.gw >= M) return;
    v2u un[8]; load_row_raw(X + (size_t)F.gw * DM, F.lane, un);
    for (int m = F.gw; m < M; m += F.NGW) {
        const int b = m / SEQ;
        f32x4 v[8]; float s = 0.f;
#pragma unroll
        for (int j = 0; j < 8; ++j) { v[j] = (f32x4){bflo(un[j].x), bfhi(un[j].x), bflo(un[j].y), bfhi(un[j].y)}; s += (v[j].x * v[j].x + v[j].y * v[j].y) + (v[j].z * v[j].z + v[j].w * v[j].w); }
        { const int mn = (m + F.NGW < M) ? m + F.NGW : m; load_row_raw(X + (size_t)mn * DM, F.lane, un); }
        const float rstd = rsqrtf(wave_sum_fast(s) * (1.f / DM) + RMS_EPS);
        const f32x4* wp = (const f32x4*)nw + F.lane;
        const f32x4* shp = (const f32x4*)(mod + (size_t)b * MODW + shift_off) + F.lane;
        const f32x4* scp = (const f32x4*)(mod + (size_t)b * MODW + scale_off) + F.lane;
        v2u* o = (v2u*)(XN + (size_t)m * DM) + F.lane;
#pragma unroll
        for (int j = 0; j < 8; ++j) { const f32x4 w = wp[64 * j], a = scp[64 * j], c = shp[64 * j];
            const f32x4 r = (v[j] * rstd) * w * (a + 1.f) + c;
            v2u p; p.x = pk2(r.x, r.y); p.y = pk2(r.z, r.w); o[64 * j] = p;
            if (X8) { int w8 = __builtin_amdgcn_cvt_pk_fp8_f32(r.x, r.y, 0, false); w8 = __builtin_amdgcn_cvt_pk_fp8_f32(r.z, r.w, w8, true); X8[(size_t)m * (DM / 4) + F.lane + 64 * j] = (unsigned)w8; } }
    }
}
__device__ __forceinline__ void final_norm_rows_bf16(const Ctx& F, const bf16* H, const float* nw, float* O, float oscale) {
    if (F.gw >= M) return;
    v2u un[8]; load_row_raw(H + (size_t)F.gw * DM, F.lane, un);
    f32x4 wv[8];
#pragma unroll
    for (int j = 0; j < 8; ++j) wv[j] = ((const f32x4*)nw + F.lane)[64 * j];
    for (int m = F.gw; m < M; m += F.NGW) {
        f32x4 v[8]; float s = 0.f;
#pragma unroll
        for (int j = 0; j < 8; ++j) { v[j] = (f32x4){bflo(un[j].x), bfhi(un[j].x), bflo(un[j].y), bfhi(un[j].y)}; s += (v[j].x * v[j].x + v[j].y * v[j].y) + (v[j].z * v[j].z + v[j].w * v[j].w); }
        { const int mn = (m + F.NGW < M) ? m + F.NGW : m; load_row_raw(H + (size_t)mn * DM, F.lane, un); }
        const float rstd = rsqrtf(wave_sum_fast(s) * (1.f / DM) + RMS_EPS) * oscale;
        f32x4* o = (f32x4*)(O + (size_t)m * DM) + F.lane;
#pragma unroll
        for (int j = 0; j < 8; ++j) __builtin_nontemporal_store((v[j] * rstd) * wv[j], o + 64 * j);
    }
}
#define LO2(v) __builtin_shufflevector((v), (v), 0, 1)
#define HI2(v) __builtin_shufflevector((v), (v), 2, 3)
template <int CTRL> __device__ __forceinline__ float dpp_f(float x) { return __builtin_bit_cast(float, __builtin_amdgcn_mov_dpp(__builtin_bit_cast(int, x), CTRL, 0xf, 0xf, true)); }
__device__ __forceinline__ float rowsum16(float x) { x += dpp_f<0xB1>(x); x += dpp_f<0x4E>(x); x += dpp_f<0x124>(x); x += dpp_f<0x128>(x); return x; }
__device__ __forceinline__ float quadsum(float x) { x += dpp_f<0xB1>(x); x += dpp_f<0x4E>(x); return x; }

__device__ __forceinline__ float treduce16(const float (&p)[16], bool b0, bool b1, bool b2, bool b3) {
    float a[8], bq[4], c2[2];
#pragma unroll
    for (int j = 0; j < 8; ++j) { const float mine = b3 ? p[j + 8] : p[j], send = b3 ? p[j] : p[j + 8]; a[j] = mine + dpp_f<0x128>(send); }
#pragma unroll
    for (int j = 0; j < 4; ++j) { const float mine = b2 ? a[j + 4] : a[j], send = b2 ? a[j] : a[j + 4]; const float up = dpp_f<0x104>(send), dn = dpp_f<0x114>(send); bq[j] = mine + (b2 ? dn : up); }
#pragma unroll
    for (int j = 0; j < 2; ++j) { const float mine = b1 ? bq[j + 2] : bq[j], send = b1 ? bq[j] : bq[j + 2]; c2[j] = mine + dpp_f<0x4E>(send); }
    const float mine = b0 ? c2[1] : c2[0], send = b0 ? c2[0] : c2[1];
    return mine + dpp_f<0xB1>(send);
}
__device__ __forceinline__ float wave_sum_dpp(float v) { v = rowsum16(v); v += __shfl_xor(v, 16); v += __shfl_xor(v, 32); return v; }
__device__ __forceinline__ void unpack8(const v4u p, float (&e)[8]) { e[0] = bflo(p.x); e[1] = bfhi(p.x); e[2] = bflo(p.y); e[3] = bfhi(p.y); e[4] = bflo(p.z); e[5] = bfhi(p.z); e[6] = bflo(p.w); e[7] = bfhi(p.w); }
__device__ __forceinline__ v4u pack8(const float (&e)[8]) { v4u o; o.x = pk2(e[0], e[1]); o.y = pk2(e[2], e[3]); o.z = pk2(e[4], e[5]); o.w = pk2(e[6], e[7]); return o; }

__device__ __forceinline__ void p3_lora(const Ctx& F) {
    const bf16* PROJ = (const bf16*)(F.ws + WS_PROJ);
    const bf16* WUPT = (const bf16*)(F.ws + WS_WUPT); const bf16* AUPT = (const bf16*)(F.ws + WS_AUPT); const bf16* GUPT = (const bf16*)(F.ws + WS_GUPT);
    bf16* LW = (bf16*)(F.ws + WS_LW); bf16* AA = (bf16*)(F.ws + WS_AA); bf16* GG = (bf16*)(F.ws + WS_GG);
    const float* mu = F.in[I_MU]; const float* w0 = F.in[I_W0]; const float* a0 = F.in[I_A0];
    const int r16 = F.lane & 15, q = F.lane >> 4;
    constexpr int WST = 72, GST = 168;
    LAS bf16* WU = (LAS bf16*)F.lds; LAS bf16* AU = WU + 128 * WST; LAS bf16* GU = AU + 128 * WST;
    const int nr = blockIdx.x & 7, nbr = (F.G - nr + 7) >> 3;
    __syncthreads();
    for (int i = F.tid; i < 128 * 8; i += NTHR) { const int row = i >> 3, ch = i & 7;
        *(LAS v4u*)(WU + row * WST + 8 * ch) = *(const v4u*)(WUPT + (size_t)(128 * nr + row) * L_W + 8 * ch);
        *(LAS v4u*)(AU + row * WST + 8 * ch) = *(const v4u*)(AUPT + (size_t)(128 * nr + row) * L_A + 8 * ch); }
    for (int i = F.tid; i < 128 * 20; i += NTHR) { const int row = i / 20, ch = i - row * 20;
        *(LAS v4u*)(GU + row * GST + 8 * ch) = *(const v4u*)(GUPT + (size_t)(128 * nr + row) * L_G + 8 * ch); }
    __syncthreads();
#define P3_COL(s) ((((s) < 2) ? (C_WD + 32 * (s)) : ((s) < 4) ? (C_AD + 32 * ((s) - 2)) : (C_GD + 32 * ((s) - 4))) + 8 * q)
    const int mt0 = (blockIdx.x >> 3) * NWAVES + F.wave, mst = nbr * NWAVES;
    v4u rc_[9], rp_[9];
    if (mt0 < M / 16) { const bf16* row = PROJ + (size_t)(mt0 * 16 + r16) * INPP;
#pragma unroll
        for (int s = 0; s < 9; ++s) { rc_[s] = *(const v4u*)(row + P3_COL(s)); rp_[s] = *(const v4u*)(row - INPP + P3_COL(s)); } }
    for (int mt = mt0; mt < M / 16; mt += mst) {
        const int m = mt * 16 + r16; const bool first = (m % SEQ) == 0;
        bf16x8 af[9];
#pragma unroll
        for (int s = 0; s < 9; ++s) {
            const int col = P3_COL(s);
            const v4u pc = rc_[s];
            v4u pp = rp_[s]; if (first) pp = (v4u){0u, 0u, 0u, 0u};
            const f32x4 m0 = *(const f32x4*)(mu + col), m1 = *(const f32x4*)(mu + col + 4);
            float c[8], p[8], e[8]; unpack8(pc, c); unpack8(pp, p);
            const float mm[8] = {m0.x, m0.y, m0.z, m0.w, m1.x, m1.y, m1.z, m1.w};
#pragma unroll
            for (int j = 0; j < 8; ++j) { float v = c[j] + (p[j] - c[j]) * mm[j];
                if (s < 2) { const float t = __expf(2.f * v); v = 1.f - 2.f * rcp_f(t + 1.f); }
                else if (s >= 4) v = sigmoid_f(v);
                e[j] = v; }
            af[s] = __builtin_bit_cast(bf16x8, pack8(e));
        }
        { const int mtn = (mt + mst < M / 16) ? mt + mst : mt; const bf16* row = PROJ + (size_t)(mtn * 16 + r16) * INPP;
#pragma unroll
          for (int s = 0; s < 9; ++s) { rc_[s] = *(const v4u*)(row + P3_COL(s)); rp_[s] = *(const v4u*)(row - INPP + P3_COL(s)); } }
        asm volatile("" ::: "memory");
#pragma unroll 2
        for (int nt = 0; nt < 8; ++nt) {
            const LAS bf16* wu = WU + (16 * nt + r16) * WST + 8 * q; const LAS bf16* au = AU + (16 * nt + r16) * WST + 8 * q; const LAS bf16* gu = GU + (16 * nt + r16) * GST + 8 * q;
            f32x4 acc0 = {0.f, 0.f, 0.f, 0.f}, acc1 = acc0, acc2 = acc0;
#pragma unroll
            for (int s2 = 0; s2 < 2; ++s2) acc0 = __builtin_amdgcn_mfma_f32_16x16x32_bf16(*(const LAS bf16x8*)(wu + 32 * s2), af[s2], acc0, 0, 0, 0);
#pragma unroll
            for (int s2 = 0; s2 < 2; ++s2) acc1 = __builtin_amdgcn_mfma_f32_16x16x32_bf16(*(const LAS bf16x8*)(au + 32 * s2), af[2 + s2], acc1, 0, 0, 0);
#pragma unroll
            for (int s2 = 0; s2 < 5; ++s2) acc2 = __builtin_amdgcn_mfma_f32_16x16x32_bf16(*(const LAS bf16x8*)(gu + 32 * s2), af[4 + s2], acc2, 0, 0, 0);
            const int n = 128 * nr + 16 * nt + 4 * q;
            const f32x4 w0v = *(const f32x4*)(w0 + n), a0v = *(const f32x4*)(a0 + n);
            v2u o0, o1, o2;
            o0.x = pk2(-0.60653066f * sigmoid_f(acc0[0] + w0v.x), -0.60653066f * sigmoid_f(acc0[1] + w0v.y));
            o0.y = pk2(-0.60653066f * sigmoid_f(acc0[2] + w0v.z), -0.60653066f * sigmoid_f(acc0[3] + w0v.w));
            o1.x = pk2(sigmoid_f(acc1[0] + a0v.x), sigmoid_f(acc1[1] + a0v.y)); o1.y = pk2(sigmoid_f(acc1[2] + a0v.z), sigmoid_f(acc1[3] + a0v.w));
            o2.x = pk2(acc2[0], acc2[1]); o2.y = pk2(acc2[2], acc2[3]);
            *(v2u*)(LW + (size_t)m * RW + n) = o0; *(v2u*)(AA + (size_t)m * RW + n) = o1; *(v2u*)(GG + (size_t)m * RW + n) = o2;
        }
    }
#undef P3_COL
    __syncthreads();
}

constexpr int TC = 32, NCHUNK = SEQ / TC;
constexpr int RB_R = 0, RB_W = TC * 64, RB_K = 2 * TC * 64, RB_KK = 3 * TC * 64, RB_KA = 4 * TC * 64, RB_V = 5 * TC * 64, RB_SIZE = 5 * TC * 64 + TC * 16;
constexpr int MB_B = 0, MB_C = TC * 128, MB_X = 2 * TC * 128, MB_DT = MB_X + TC * 32, MB_DA = MB_DT + TC, MB_SIZE = MB_DA + TC;
static_assert(2 * RB_SIZE * 4 <= RING_BYTES, "scan buffers fit the LDS ring");

struct RwkvRaw { bf16 r[9], k[9], v[9], lw[8], a[8]; };
__device__ __forceinline__ void rwkv_load(RwkvRaw& raw, const bf16* PROJ, const bf16* LW, const bf16* AA, int b, int h, int t0w, int c) {
    const bf16* base = PROJ + (size_t)(b * SEQ + t0w) * INPP + h * 64 + c;
#pragma unroll
    for (int i = 0; i < 9; ++i) {
        if (i == 0 && t0w == 0) { raw.r[0] = 0; raw.k[0] = 0; raw.v[0] = 0; }
        else { const bf16* row = base + (long)(i - 1) * INPP; raw.r[i] = row[C_R]; raw.k[i] = row[C_K]; raw.v[i] = row[C_V]; }
    }
#pragma unroll
    for (int i = 0; i < 8; ++i) { const size_t o = (size_t)(b * SEQ + t0w + i) * RW + h * 64 + c; raw.lw[i] = LW[o]; raw.a[i] = AA[o]; }
}
__device__ __forceinline__ void rwkv_stage(const RwkvRaw& raw, LAS float* buf, int tl0, int c, int qt, float mu_r, float mu_k, float mu_v, float kkw, float kaw) {
#pragma unroll
    for (int i = 0; i < 8; ++i) {
        const int t = tl0 + i;
        const float rc = bf1(raw.r[i + 1]), rp = bf1(raw.r[i]), kc = bf1(raw.k[i + 1]), kp = bf1(raw.k[i]), vc = bf1(raw.v[i + 1]), vp = bf1(raw.v[i]);
        const float rr = rc + (rp - rc) * mu_r, kx = kc + (kp - kc) * mu_k, vv = vc + (vp - vc) * mu_v;
        const float a = bf1(raw.a[i]), dec = __expf(bf1(raw.lw[i]));
        const float kkraw = kx * kkw; const float ss = wave_sum_dpp(kkraw * kkraw);
        const float kkn = kkraw * rcp_f(fmaxf(sqrtf(ss), 1e-12f));
        buf[RB_R + t * 64 + c] = rr; buf[RB_W + t * 64 + c] = dec; buf[RB_K + t * 64 + c] = kx * (1.f + (a - 1.f) * kaw);
        buf[RB_KK + t * 64 + c] = kkn; buf[RB_KA + t * 64 + c] = kkn * a;
        if ((c >> 4) == qt) buf[RB_V + t * 16 + (c & 15)] = vv;
    }
}
__device__ __forceinline__ void rwkv_task(const Ctx& F, int task) {
    const int b = task >> 6, h = (task >> 2) & 15, qt = task & 3;
    const bf16* PROJ = (const bf16*)(F.ws + WS_PROJ); const bf16* LW = (const bf16*)(F.ws + WS_LW); const bf16* AA = (const bf16*)(F.ws + WS_AA);
    bf16* OY = (bf16*)(F.ws + WS_OY);
    LAS float* lbuf = (LAS float*)F.lds;
    const int c = F.lane, w = F.wave, r = F.lane >> 4, cg = F.lane & 15;
    const bool stager = w >= 4; const int sw = w & 3;
    const int ch = h * 64 + c;
    const float mu_r = F.in[I_MU][C_R + ch], mu_k = F.in[I_MU][C_K + ch], mu_v = F.in[I_MU][C_V + ch], kkw = F.in[I_KK][ch], kaw = F.in[I_KA][ch];
    RwkvRaw raw;
    if (stager) { rwkv_load(raw, PROJ, LW, AA, b, h, 8 * sw, c); rwkv_stage(raw, lbuf, 8 * sw, c, qt, mu_r, mu_k, mu_v, kkw, kaw); rwkv_load(raw, PROJ, LW, AA, b, h, TC + 8 * sw, c); }
    __syncthreads();
    f32x2 S01 = {0.f, 0.f}, S23 = {0.f, 0.f};
    const bool cb0 = cg & 1, cb1 = cg & 2, cb2 = cg & 4, cb3 = cg & 8;
    bf16* orow = OY + (size_t)(b * SEQ) * DM + h * 64 + 16 * qt + 4 * sw + r;
    for (int ck = 0; ck < NCHUNK; ++ck) {
        const LAS float* buf = lbuf + (ck & 1) * RB_SIZE;
        if (stager) {
            if (ck + 1 < NCHUNK) { rwkv_stage(raw, lbuf + ((ck + 1) & 1) * RB_SIZE, 8 * sw, c, qt, mu_r, mu_k, mu_v, kkw, kaw);
                if (ck + 2 < NCHUNK) rwkv_load(raw, PROJ, LW, AA, b, h, (ck + 2) * TC + 8 * sw, c); }
        } else {
            const LAS float* bp = buf + 4 * cg; const LAS float* vp = buf + RB_V + 4 * sw + r;
            f32x4 qkk[3], qw[3], qka[3], qk[3], qr[3]; float qv[3];
#pragma unroll
            for (int i = 0; i < 3; ++i) { qkk[i] = *(const LAS f32x4*)(bp + RB_KK + i * 64); qw[i] = *(const LAS f32x4*)(bp + RB_W + i * 64); qka[i] = *(const LAS f32x4*)(bp + RB_KA + i * 64);
                qk[i] = *(const LAS f32x4*)(bp + RB_K + i * 64); qr[i] = *(const LAS f32x4*)(bp + RB_R + i * 64); qv[i] = vp[i * 16]; }
            float op[16];
#pragma unroll
            for (int j = 0; j < TC; ++j) {
                const int u = j % 3;
                const f32x4 kk4 = qkk[u], w4 = qw[u], ka4 = qka[u], k4 = qk[u], r4 = qr[u]; const float vr = qv[u];
                const f32x2 tq = S01 * LO2(kk4) + S23 * HI2(kk4);
                const float sa = rowsum16(tq.x + tq.y);
                const f32x2 sav = {sa, sa}, vrv = {vr, vr};
                S01 = S01 * LO2(w4) + (vrv * LO2(k4) - sav * LO2(ka4));
                S23 = S23 * HI2(w4) + (vrv * HI2(k4) - sav * HI2(ka4));
                const f32x2 uq = S01 * LO2(r4) + S23 * HI2(r4);
                op[j & 15] = uq.x + uq.y;
                asm volatile("" : "+v"(S01), "+v"(S23) :: "memory");
                if (j + 3 < TC) { qkk[u] = *(const LAS f32x4*)(bp + RB_KK + (j + 3) * 64); qw[u] = *(const LAS f32x4*)(bp + RB_W + (j + 3) * 64); qka[u] = *(const LAS f32x4*)(bp + RB_KA + (j + 3) * 64);
                                  qk[u] = *(const LAS f32x4*)(bp + RB_K + (j + 3) * 64); qr[u] = *(const LAS f32x4*)(bp + RB_R + (j + 3) * 64); qv[u] = vp[(j + 3) * 16]; }
                if ((j & 15) == 15) {
                    const float ored = treduce16(op, cb0, cb1, cb2, cb3);
                    orow[(size_t)(ck * TC + (j - 15) + cg) * DM] = (bf16)(pk2(ored, 0.f) & 0xffffu);
                }
            }
        }
        __syncthreads();
    }
}

__device__ __forceinline__ void p4_scans(const Ctx& F) {
    for (int task = blockIdx.x; task < NB * RHEADS * 4; task += F.G) { rwkv_task(F, task); __syncthreads(); }
}

__device__ __forceinline__ void ld16(const float* p, float (&v)[16]) {
#pragma unroll
    for (int i = 0; i < 4; ++i) { const f32x4 t = *(const f32x4*)(p + 4 * i); v[4 * i] = t.x; v[4 * i + 1] = t.y; v[4 * i + 2] = t.z; v[4 * i + 3] = t.w; }
}
__device__ __forceinline__ void ldbf16x16(const bf16* p, float (&v)[16]) {
    float t0[8], t1[8]; unpack8(*(const v4u*)p, t0); unpack8(*(const v4u*)(p + 8), t1);
#pragma unroll
    for (int j = 0; j < 8; ++j) { v[j] = t0[j]; v[8 + j] = t1[j]; }
}
__device__ __forceinline__ void stbf16x16(bf16* p, const float (&v)[16]) {
    float t0[8], t1[8];
#pragma unroll
    for (int j = 0; j < 8; ++j) { t0[j] = v[j]; t1[j] = v[8 + j]; }
    *(v4u*)p = pack8(t0); *(v4u*)(p + 8) = pack8(t1);
}
__device__ __forceinline__ void p5_post(const Ctx& F) {
    const bf16* PROJ = (const bf16*)(F.ws + WS_PROJ); const bf16* AA = (const bf16*)(F.ws + WS_AA); const bf16* GG = (const bf16*)(F.ws + WS_GG);
    bf16* OY = (bf16*)(F.ws + WS_OY);
    const int c0 = 16 * F.lane;
    {
        float mur[16], muk[16], muv[16], ka[16], rk[16], lnw[16], lnb[16];
        ld16(F.in[I_MU] + C_R + c0, mur); ld16(F.in[I_MU] + C_K + c0, muk); ld16(F.in[I_MU] + C_V + c0, muv);
        ld16(F.in[I_KA] + c0, ka); ld16(F.in[I_RK] + c0, rk); ld16(F.in[I_LNW] + c0, lnw); ld16(F.in[I_LNB] + c0, lnb);
        for (int m = F.gw; m < M; m += F.NGW) {
            const bool first = (m % SEQ) == 0;
            const bf16* prow = PROJ + (size_t)m * INPP; bf16* oyrow = OY + (size_t)m * DM;
            float o[16], res[16]; float bs = 0.f;
            ldbf16x16(oyrow + c0, o);
            {
                float rc[16], rp[16], kc[16], kp[16], av[16];
                ldbf16x16(prow + C_R + c0, rc); ldbf16x16(prow + C_K + c0, kc); ldbf16x16(AA + (size_t)m * RW + c0, av);
                if (!first) { ldbf16x16(prow - INPP + C_R + c0, rp); ldbf16x16(prow - INPP + C_K + c0, kp); }
                else {
#pragma unroll
                    for (int j = 0; j < 16; ++j) { rp[j] = 0.f; kp[j] = 0.f; } }
#pragma unroll
                for (int j = 0; j < 16; ++j) { const float rr = rc[j] + (rp[j] - rc[j]) * mur[j], kx = kc[j] + (kp[j] - kc[j]) * muk[j];
                    bs += rr * (kx * (1.f + (av[j] - 1.f) * ka[j])) * rk[j]; }
            }
            bs = quadsum(bs);
            float s = 0.f;
#pragma unroll
            for (int j = 0; j < 16; ++j) s += o[j];
            const float mean = quadsum(s) * (1.f / 64.f);
            float qv = 0.f;
#pragma unroll
            for (int j = 0; j < 16; ++j) { o[j] -= mean; qv += o[j] * o[j]; }
            const float rstd = rsqrtf(quadsum(qv) * (1.f / 64.f) + 64e-5f);
            {
                float vc[16], vp[16], gv[16];
                ldbf16x16(prow + C_V + c0, vc); ldbf16x16(GG + (size_t)m * RW + c0, gv);
                if (!first) ldbf16x16(prow - INPP + C_V + c0, vp);
                else {
#pragma unroll
                    for (int j = 0; j < 16; ++j) vp[j] = 0.f; }
#pragma unroll
                for (int j = 0; j < 16; ++j) { const float vv = vc[j] + (vp[j] - vc[j]) * muv[j]; res[j] = (o[j] * rstd * lnw[j] + lnb[j] + bs * vv) * gv[j]; }
            }
            stbf16x16(oyrow + c0, res);
        }
    }
    {
        float nw[16]; ld16(F.in[I_MNW] + c0, nw);
        int m = F.gw;
        v4u yr[2], zr[2];
        if (m < M) { const bf16* prow = PROJ + (size_t)m * INPP; const bf16* oyrow = OY + (size_t)m * DM;
            yr[0] = *(const v4u*)(oyrow + RW + c0); yr[1] = *(const v4u*)(oyrow + RW + c0 + 8); zr[0] = *(const v4u*)(prow + C_Z + c0); zr[1] = *(const v4u*)(prow + C_Z + c0 + 8); }
        for (; m < M; m += F.NGW) {
            bf16* oyrow = OY + (size_t)m * DM;
            float y[16], z[16];
            { float t0[8], t1[8]; unpack8(yr[0], t0); unpack8(yr[1], t1);
#pragma unroll
              for (int j = 0; j < 8; ++j) { y[j] = t0[j]; y[8 + j] = t1[j]; }
              unpack8(zr[0], t0); unpack8(zr[1], t1);
#pragma unroll
              for (int j = 0; j < 8; ++j) { z[j] = t0[j]; z[8 + j] = t1[j]; } }
            { const int mn = (m + F.NGW < M) ? m + F.NGW : m; const bf16* prow = PROJ + (size_t)mn * INPP; const bf16* oyn = OY + (size_t)mn * DM;
              yr[0] = *(const v4u*)(oyn + RW + c0); yr[1] = *(const v4u*)(oyn + RW + c0 + 8); zr[0] = *(const v4u*)(prow + C_Z + c0); zr[1] = *(const v4u*)(prow + C_Z + c0 + 8); }
            asm volatile("" ::: "memory");
            float qv = 0.f;
#pragma unroll
            for (int j = 0; j < 16; ++j) { y[j] *= silu_f(z[j]); qv += y[j] * y[j]; }
            qv = rowsum16(qv);
            { auto rr = __builtin_amdgcn_permlane16_swap(__float_as_uint(qv), __float_as_uint(qv), false, false); qv = __uint_as_float(rr[0]) + __uint_as_float(rr[1]); }
            const float rstd = rsqrtf(qv * (1.f / 512.f) + 1e-5f);
#pragma unroll
            for (int j = 0; j < 16; ++j) y[j] = y[j] * rstd * nw[j];
            stbf16x16(oyrow + RW + c0, y);
        }
    }
}
constexpr int MC_L = 128, MC_NC = SEQ / MC_L, LSTR = 136;
constexpr int MT_BYTES = 128 * LSTR * 2;
constexpr size_t WS_ST = 876 * MiB, WS_SIN = 940 * MiB, WS_ATOT = 1004 * MiB, WS_END2 = 1005 * MiB;

__device__ __forceinline__ float mamba_dt_scan(const Ctx& F, const bf16* PROJ, int b, int c, int g, LAS float* DT, LAS float* ACS) {
    const int head = g * 8 + F.wave, lane = F.lane;
    const float dtb = F.in[I_DTB][head], Aneg = -__expf(F.in[I_ALOG][head]);
    const bf16* p = PROJ + (size_t)(b * SEQ + c * MC_L + 2 * lane) * INPP + C_DT + head;
    const float x0 = bf1(p[0]) + dtb, x1 = bf1(p[INPP]) + dtb;
    const float d0 = (x0 > 20.f) ? x0 : log1pf(__expf(x0)), d1 = (x1 > 20.f) ? x1 : log1pf(__expf(x1));
    const float s0 = d0 * Aneg, s1 = s0 + d1 * Aneg;
    float incl = s1;
#pragma unroll
    for (int o = 1; o < 64; o <<= 1) { const float t = __shfl_up(incl, o); if (lane >= o) incl += t; }
    const float excl = incl - s1;
    DT[F.wave * 128 + 2 * lane] = d0; DT[F.wave * 128 + 2 * lane + 1] = d1;
    ACS[F.wave * 128 + 2 * lane] = excl + s0; ACS[F.wave * 128 + 2 * lane + 1] = excl + s1;
    return __shfl(incl, 63);
}
struct TRaw { bf16 v[35]; };
__device__ __forceinline__ void mstage_T_load(TRaw& raw, const bf16* PROJ, int b, int c, int chn, int tid) {
    const int t0 = 32 * (tid >> 7);
    const bf16* base = PROJ + (size_t)(b * SEQ + c * MC_L + t0) * INPP + C_XBC + chn;
    if (c * MC_L + t0 > 0) { raw.v[0] = base[-3 * INPP]; raw.v[1] = base[-2 * INPP]; raw.v[2] = base[-1 * INPP]; }
    else { raw.v[0] = 0; raw.v[1] = 0; raw.v[2] = 0; }
#pragma unroll
    for (int t = 0; t < 32; ++t) raw.v[3 + t] = base[(size_t)t * INPP];
}
template <bool SC>
__device__ __forceinline__ void mstage_T_store(const TRaw& raw, int chn, LAS bf16* dst, const LAS float* scale, const float* convw, const float* convb, int tid) {
    const int f = tid & 127, t0 = 32 * (tid >> 7);
    const float w0 = convw[chn], w1 = convw[1536 + chn], w2 = convw[2 * 1536 + chn], w3 = convw[3 * 1536 + chn], bb = convb[chn];
#pragma unroll
    for (int i8 = 0; i8 < 4; ++i8) {
        float e[8];
#pragma unroll
        for (int i = 0; i < 8; ++i) { const int t = 8 * i8 + i;
            float v = silu_f(bb + w0 * bf1(raw.v[t]) + w1 * bf1(raw.v[t + 1]) + w2 * bf1(raw.v[t + 2]) + w3 * bf1(raw.v[t + 3]));
            if (SC) v *= scale[t0 + t];
            e[i] = v; }
        *(LAS v4u*)(dst + f * LSTR + t0 + 8 * i8) = pack8(e);
    }
}
__device__ __forceinline__ void mstage_N(const bf16* PROJ, int b, int c, int g, LAS bf16* Bn, LAS bf16* Cn, const float* convw, const float* convb, int tid) {
    const int f8 = tid & 31, t0 = 8 * (tid >> 5);
    const int chn = (f8 < 16) ? (1024 + g * 128 + 8 * f8) : (1280 + g * 128 + 8 * (f8 - 16));
    LAS bf16* dst = ((f8 < 16) ? Bn : Cn) + 8 * (f8 & 15);
    const bf16* base = PROJ + (size_t)(b * SEQ + c * MC_L + t0) * INPP + C_XBC + chn;
    float w[4][8], bb[8];
#pragma unroll
    for (int i = 0; i < 4; ++i) { const f32x4 a = *(const f32x4*)(convw + i * 1536 + chn), d = *(const f32x4*)(convw + i * 1536 + chn + 4);
        w[i][0] = a.x; w[i][1] = a.y; w[i][2] = a.z; w[i][3] = a.w; w[i][4] = d.x; w[i][5] = d.y; w[i][6] = d.z; w[i][7] = d.w; }
    { const f32x4 a = *(const f32x4*)(convb + chn), d = *(const f32x4*)(convb + chn + 4); bb[0] = a.x; bb[1] = a.y; bb[2] = a.z; bb[3] = a.w; bb[4] = d.x; bb[5] = d.y; bb[6] = d.z; bb[7] = d.w; }
    float r0[8], r1[8], r2[8];
    if (c * MC_L + t0 > 0) { unpack8(*(const v4u*)(base - 3 * INPP), r0); unpack8(*(const v4u*)(base - 2 * INPP), r1); unpack8(*(const v4u*)(base - 1 * INPP), r2); }
    else {
#pragma unroll
        for (int k = 0; k < 8; ++k) { r0[k] = 0.f; r1[k] = 0.f; r2[k] = 0.f; } }
#pragma unroll
    for (int t = 0; t < 8; ++t) {
        float r3[8], e[8]; unpack8(*(const v4u*)(base + (size_t)t * INPP), r3);
#pragma unroll
        for (int k = 0; k < 8; ++k) { e[k] = silu_f(bb[k] + w[0][k] * r0[k] + w[1][k] * r1[k] + w[2][k] * r2[k] + w[3][k] * r3[k]); r0[k] = r1[k]; r1[k] = r2[k]; r2[k] = r3[k]; }
        *(LAS v4u*)(dst + (t0 + t) * LSTR) = pack8(e);
    }
}

__device__ __forceinline__ void m1_chunk_states(const Ctx& F) {
    const bf16* PROJ = (const bf16*)(F.ws + WS_PROJ); bf16* ST = (bf16*)(F.ws + WS_ST); float* ATOT = (float*)(F.ws + WS_ATOT);
    LAS bf16* BT = (LAS bf16*)F.lds; LAS bf16* XT = (LAS bf16*)(F.lds + MT_BYTES);
    LAS float* DT = (LAS float*)(F.lds + 3 * MT_BYTES); LAS float* ACS = DT + 8 * 128; LAS float* SCL = ACS + 8 * 128;
    const float* convw = F.in[I_CONVW]; const float* convb = F.in[I_CONVB];
    const int tid = F.tid, w = F.wave, lane = F.lane, r16 = lane & 15, q = lane >> 4;
    for (int it = blockIdx.x; it < NB * MC_NC * 2; it += F.G) {
        const int g = it & 1, c = (it >> 1) & (MC_NC - 1), b = it >> 7;
        __syncthreads();
        const float atot = mamba_dt_scan(F, PROJ, b, c, g, DT, ACS);
        if (lane == 0) ATOT[(b * MC_NC + c) * 16 + g * 8 + w] = atot;
        const int chB = 1024 + g * 128 + (tid & 127);
        TRaw ra, rb;
        mstage_T_load(ra, PROJ, b, c, chB, tid);
        mstage_T_load(rb, PROJ, b, c, (g * 8 + ((tid & 127) >> 6)) * 64 + (tid & 63), tid);
        LDS_WAIT();
        SCL[w * 128 + 2 * lane] = DT[w * 128 + 2 * lane] * __expf(atot - ACS[w * 128 + 2 * lane]);
        SCL[w * 128 + 2 * lane + 1] = DT[w * 128 + 2 * lane + 1] * __expf(atot - ACS[w * 128 + 2 * lane + 1]);
        mstage_T_store<false>(ra, chB, BT, nullptr, convw, convb, tid);
        mstage_T_load(ra, PROJ, b, c, (g * 8 + 2 + ((tid & 127) >> 6)) * 64 + (tid & 63), tid);
        __syncthreads();
#pragma unroll
        for (int hb = 0; hb < 2; ++hb) {
            if (hb == 1) mstage_T_load(ra, PROJ, b, c, (g * 8 + 6 + ((tid & 127) >> 6)) * 64 + (tid & 63), tid);
            { const int hl = 4 * hb + ((tid & 127) >> 6); mstage_T_store<true>(rb, (g * 8 + hl) * 64 + (tid & 63), XT, SCL + hl * 128, convw, convb, tid); }
            if (hb == 0) mstage_T_load(rb, PROJ, b, c, (g * 8 + 4 + ((tid & 127) >> 6)) * 64 + (tid & 63), tid);
            { const int hl = 4 * hb + 2 + ((tid & 127) >> 6); mstage_T_store<true>(ra, (g * 8 + hl) * 64 + (tid & 63), XT + 128 * LSTR, SCL + hl * 128, convw, convb, tid); }
            __syncthreads();
            const int hh = w >> 1, ph = w & 1;
            f32x4 acc[2][8];
#pragma unroll
            for (int a = 0; a < 2; ++a)
#pragma unroll
                for (int n = 0; n < 8; ++n) acc[a][n] = (f32x4){0.f, 0.f, 0.f, 0.f};
#pragma unroll
            for (int ks = 0; ks < 4; ++ks) {
                bf16x8 xa[2];
#pragma unroll
                for (int a = 0; a < 2; ++a) xa[a] = *(const LAS bf16x8*)(XT + (hh * 64 + 32 * ph + 16 * a + r16) * LSTR + 32 * ks + 8 * q);
#pragma unroll
                for (int n = 0; n < 8; ++n) { const bf16x8 bfr = *(const LAS bf16x8*)(BT + (16 * n + r16) * LSTR + 32 * ks + 8 * q);
#pragma unroll
                    for (int a = 0; a < 2; ++a) acc[a][n] = __builtin_amdgcn_mfma_f32_16x16x32_bf16(bfr, xa[a], acc[a][n], 0, 0, 0); }
            }
            bf16* st = ST + ((size_t)((b * MC_NC + c) * 16 + g * 8 + 4 * hb + hh)) * (64 * 128);
#pragma unroll
            for (int a = 0; a < 2; ++a)
#pragma unroll
                for (int n = 0; n < 8; ++n) { v2u o; o.x = pk2(acc[a][n][0], acc[a][n][1]); o.y = pk2(acc[a][n][2], acc[a][n][3]);
                    *(v2u*)(st + (32 * ph + 16 * a + r16) * 128 + 16 * n + 4 * q) = o; }
            __syncthreads();
        }
    }
}

__device__ __forceinline__ void m2_prefix(const Ctx& F) {
    const bf16* ST = (const bf16*)(F.ws + WS_ST); bf16* SIN = (bf16*)(F.ws + WS_SIN); const float* ATOT = (const float*)(F.ws + WS_ATOT);
    const int nthr = F.G * NTHR;
    constexpr int GB = 16;
    constexpr size_t CST = (size_t)16 * 8192;
    for (int gi = blockIdx.x * NTHR + F.tid; gi < NB * 16 * 2048; gi += nthr) {
        const int e4 = gi & 2047, bh = gi >> 11, b = bh >> 4, h = bh & 15;
        const size_t o0 = ((size_t)(b * MC_NC) * 16 + h) * 8192 + 4 * e4;
        const float* at = ATOT + (b * MC_NC) * 16 + h;
        float r0 = 0.f, r1 = 0.f, r2 = 0.f, r3 = 0.f;
        v2u sv[GB]; float dv[GB];
#pragma unroll
        for (int i = 0; i < GB; ++i) { sv[i] = *(const v2u*)(ST + o0 + (size_t)i * CST); dv[i] = at[i * 16]; }
#pragma unroll 1
        for (int c0 = 0; c0 < MC_NC; c0 += GB) {
            const int cn = (c0 + GB < MC_NC) ? c0 + GB : c0;
            v2u svn[GB]; float dvn[GB];
#pragma unroll
            for (int i = 0; i < GB; ++i) { svn[i] = *(const v2u*)(ST + o0 + (size_t)(cn + i) * CST); dvn[i] = at[(cn + i) * 16]; }
            asm volatile("" ::: "memory");
#pragma unroll
            for (int i = 0; i < GB; ++i) {
                v2u so; so.x = pk2(r0, r1); so.y = pk2(r2, r3);
                *(v2u*)(SIN + o0 + (size_t)(c0 + i) * CST) = so;
                const float d = __expf(dv[i]);
                r0 = r0 * d + bflo(sv[i].x); r1 = r1 * d + bfhi(sv[i].x); r2 = r2 * d + bflo(sv[i].y); r3 = r3 * d + bfhi(sv[i].y);
            }
#pragma unroll
            for (int i = 0; i < GB; ++i) { sv[i] = svn[i]; dv[i] = dvn[i]; }
        }
    }
}

__device__ __forceinline__ void m3_outputs(const Ctx& F) {
    const bf16* PROJ = (const bf16*)(F.ws + WS_PROJ); const bf16* SIN = (const bf16*)(F.ws + WS_SIN); bf16* OY = (bf16*)(F.ws + WS_OY);
    LAS bf16* Cn = (LAS bf16*)F.lds; LAS bf16* RB = (LAS bf16*)(F.lds + MT_BYTES);
    LAS bf16* Mw = (LAS bf16*)(F.lds + 2 * MT_BYTES) + F.wave * 16 * LSTR;
    LAS float* DT = (LAS float*)(F.lds + 3 * MT_BYTES); LAS float* ACS = DT + 8 * 128;
    const float* convw = F.in[I_CONVW]; const float* convb = F.in[I_CONVB];
    const int tid = F.tid, w = F.wave, lane = F.lane, r16 = lane & 15, q = lane >> 4;
    for (int it = blockIdx.x; it < NB * MC_NC * 2; it += F.G) {
        const int g = it & 1, c = (it >> 1) & (MC_NC - 1), b = it >> 7;
        __syncthreads();
        (void)mamba_dt_scan(F, PROJ, b, c, g, DT, ACS);
        mstage_N(PROJ, b, c, g, RB, Cn, convw, convb, tid);
        __syncthreads();
        TRaw rx;
        mstage_T_load(rx, PROJ, b, c, (g * 8 + ((tid & 127) >> 6)) * 64 + (tid & 63), tid);
        bf16x8 cf[4];
#pragma unroll
        for (int ks = 0; ks < 4; ++ks) cf[ks] = *(const LAS bf16x8*)(Cn + (16 * w + r16) * LSTR + 32 * ks + 8 * q);
        f32x4 Gt[8];
#pragma unroll
        for (int nt = 0; nt < 8; ++nt) { Gt[nt] = (f32x4){0.f, 0.f, 0.f, 0.f};
#pragma unroll
            for (int ks = 0; ks < 4; ++ks) Gt[nt] = __builtin_amdgcn_mfma_f32_16x16x32_bf16(*(const LAS bf16x8*)(RB + (16 * nt + r16) * LSTR + 32 * ks + 8 * q), cf[ks], Gt[nt], 0, 0, 0); }
        const int l = 16 * w + r16;
        const size_t mrow = (size_t)(b * SEQ + c * MC_L + l);
#pragma unroll 1
        for (int hb = 0; hb < 4; ++hb) {
            __syncthreads();
            { const int hl = 2 * hb + ((tid & 127) >> 6); mstage_T_store<false>(rx, (g * 8 + hl) * 64 + (tid & 63), RB, nullptr, convw, convb, tid); }
            { const int hn = (hb < 3) ? 2 * (hb + 1) : 2 * hb; mstage_T_load(rx, PROJ, b, c, (g * 8 + hn + ((tid & 127) >> 6)) * 64 + (tid & 63), tid); }
            __syncthreads();
#pragma unroll 1
            for (int h2 = 0; h2 < 2; ++h2) {
                const int hl = 2 * hb + h2, head = g * 8 + hl;
                const float acs_l = ACS[hl * 128 + l];
                const bf16* sin = SIN + ((size_t)((b * MC_NC + c) * 16 + head)) * 8192;
                bf16x8 sf[4][4];
#pragma unroll
                for (int pt = 0; pt < 4; ++pt)
#pragma unroll
                    for (int ks = 0; ks < 4; ++ks) sf[pt][ks] = *(const bf16x8*)(sin + (16 * pt + r16) * 128 + 32 * ks + 8 * q);
#pragma unroll
                for (int nt = 0; nt < 8; ++nt) { const f32x4 as = *(const LAS f32x4*)(ACS + hl * 128 + 16 * nt + 4 * q), ds = *(const LAS f32x4*)(DT + hl * 128 + 16 * nt + 4 * q);
                    float mv[4];
#pragma unroll
                    for (int j = 0; j < 4; ++j) { const int s = 16 * nt + 4 * q + j; mv[j] = (s <= l) ? Gt[nt][j] * __expf(acs_l - as[j]) * ds[j] : 0.f; }
                    v2u o; o.x = pk2(mv[0], mv[1]); o.y = pk2(mv[2], mv[3]);
                    *(LAS v2u*)(Mw + r16 * LSTR + 16 * nt + 4 * q) = o; }
                LDS_WAIT(); asm volatile("" ::: "memory");
                bf16x8 mf[4];
#pragma unroll
                for (int ks = 0; ks < 4; ++ks) mf[ks] = *(const LAS bf16x8*)(Mw + r16 * LSTR + 32 * ks + 8 * q);
                const float el = __expf(acs_l), Dh = F.in[I_DSK][head];
#pragma unroll
                for (int pt = 0; pt < 4; ++pt) {
                    f32x4 yd = {0.f, 0.f, 0.f, 0.f}, yo = {0.f, 0.f, 0.f, 0.f};
#pragma unroll
                    for (int ks = 0; ks < 4; ++ks) {
                        yd = __builtin_amdgcn_mfma_f32_16x16x32_bf16(*(const LAS bf16x8*)(RB + (h2 * 64 + 16 * pt + r16) * LSTR + 32 * ks + 8 * q), mf[ks], yd, 0, 0, 0);
                        yo = __builtin_amdgcn_mfma_f32_16x16x32_bf16(sf[pt][ks], cf[ks], yo, 0, 0, 0); }
                    float yv[4];
#pragma unroll
                    for (int j = 0; j < 4; ++j) yv[j] = yd[j] + el * yo[j] + Dh * bf1(RB[(h2 * 64 + 16 * pt + 4 * q + j) * LSTR + l]);
                    v2u o; o.x = pk2(yv[0], yv[1]); o.y = pk2(yv[2], yv[3]);
                    *(v2u*)(OY + mrow * DM + RW + head * 64 + 16 * pt + 4 * q) = o;
                }
                asm volatile("" ::: "memory");
            }
        }
    }
}
constexpr int RC = 16, RNCH = SEQ / RC, NPART = 4, RHALF = RNCH / NPART, RITEMS = NB * RHEADS * RHALF;
constexpr size_t RO_WH = 0, RO_RH = 16 * MiB, RO_VT = 32 * MiB, RO_ET = 48 * MiB, RO_OL = 64 * MiB, RO_A2 = 80 * MiB, RO_GC = 112 * MiB, RO_BUF = 116 * MiB, RO_SS = 232 * MiB;
constexpr int RL_KAP = 0, RL_ALP = 2304, RL_KT = 4608, RL_RT = 6912, RL_KAPT = 9216, RL_VT = 11264, RL_TB = 13312, RL_BL = 14336, RL_QL = 15360, RL_PL = 16384,
              RL_WT = RL_KAP, RL_BVT = RL_ALP, RL_AL32 = RL_KT, RL_ET = RL_KT,
              RL_BYTES = 18176;
constexpr int XS = 72, TS = 16, SS16 = 32;

__device__ __forceinline__ float wave_sum_pl(float x) {
    x = rowsum16(x);
    { auto rr = __builtin_amdgcn_permlane16_swap(__float_as_uint(x), __float_as_uint(x), false, false); x = __uint_as_float(rr[0]) + __uint_as_float(rr[1]); }
    { auto rr = __builtin_amdgcn_permlane32_swap(__float_as_uint(x), __float_as_uint(x), false, false); x = __uint_as_float(rr[0]) + __uint_as_float(rr[1]); }
    return x;
}
__device__ __forceinline__ v2u pack4(const f32x4 a) { v2u o; o.x = pk2(a[0], a[1]); o.y = pk2(a[2], a[3]); return o; }
__device__ __forceinline__ f32x4 unpack4(const v2u u) { return (f32x4){bflo(u.x), bfhi(u.x), bflo(u.y), bfhi(u.y)}; }
__device__ __forceinline__ bf16 f2b(float x) { return (bf16)pk2(x, 0.f); }

__device__ __forceinline__ void ra_item(const Ctx& F, LAS unsigned char* wl, int it, int half) {
    const int bh = it / RHALF, cl = it - bh * RHALF, ci = half * RHALF + cl, b = bh >> 4, h = bh & 15;
    const bf16* PROJ = (const bf16*)(F.ws + WS_PROJ); const bf16* LW = (const bf16*)(F.ws + WS_LW); const bf16* AA = (const bf16*)(F.ws + WS_AA);
    unsigned char* RO = (unsigned char*)F.out + (size_t)(half & 1) * RO_BUF;
    const int lane = F.lane, r16 = lane & 15, q = lane >> 4, c = lane, ch = h * 64 + c;
    const size_t m0 = (size_t)b * SEQ + (size_t)RC * ci;
    LAS bf16* KAP = (LAS bf16*)(wl + RL_KAP); LAS bf16* ALP = (LAS bf16*)(wl + RL_ALP); LAS bf16* KT = (LAS bf16*)(wl + RL_KT); LAS bf16* RT = (LAS bf16*)(wl + RL_RT);
    LAS bf16* KAPT = (LAS bf16*)(wl + RL_KAPT); LAS bf16* VTL = (LAS bf16*)(wl + RL_VT); LAS bf16* WT = (LAS bf16*)(wl + RL_WT); LAS bf16* BVT = (LAS bf16*)(wl + RL_BVT); LAS bf16* ETL = (LAS bf16*)(wl + RL_ET);
    LAS bf16* TB = (LAS bf16*)(wl + RL_TB); LAS bf16* BL = (LAS bf16*)(wl + RL_BL); LAS bf16* QL = (LAS bf16*)(wl + RL_QL); LAS bf16* PL = (LAS bf16*)(wl + RL_PL);
    const float mu_r = F.in[I_MU][C_R + ch], mu_k = F.in[I_MU][C_K + ch], mu_v = F.in[I_MU][C_V + ch], kkw = F.in[I_KK][ch], kaw = F.in[I_KA][ch];
    const bf16* prow = PROJ + m0 * INPP + ch;
    float rp = 0.f, kp = 0.f, vp = 0.f;
    if (ci > 0) { rp = bf1(prow[-INPP + C_R]); kp = bf1(prow[-INPP + C_K]); vp = bf1(prow[-INPP + C_V]); }
    float ec = 1.f, kkna[RC], kpv[RC], env[RC], vvv[RC];
    float cum = 0.f;
#pragma unroll
    for (int t = 0; t < RC; ++t) {
        const bf16* row = prow + (size_t)t * INPP;
        const float rc = bf1(row[C_R]), kc = bf1(row[C_K]), vc = bf1(row[C_V]);
        const float a = bf1(AA[(m0 + t) * RW + ch]), lw = bf1(LW[(m0 + t) * RW + ch]);
        const float rr = rc + (rp - rc) * mu_r, kx = kc + (kp - kc) * mu_k, vv = vc + (vp - vc) * mu_v;
        rp = rc; kp = kc; vp = vc;
        const float kkraw = kx * kkw; const float ss = wave_sum_pl(kkraw * kkraw);
        const float kkn = kkraw * rcp_f(fmaxf(sqrtf(ss), 1e-12f));
        const float kpp = kx * (1.f + (a - 1.f) * kaw);
        const float ep = ec; cum += lw; ec = __expf(cum); const float en = rcp_f(ec);
        const unsigned p0 = pk2(kkn * ep, kkn * a * en), p1 = pk2(kpp * en, rr * ec), p2 = pk2(vv, 0.f);
        KAP[t * XS + c] = (bf16)p0; ALP[t * XS + c] = (bf16)(p0 >> 16); KT[t * XS + c] = (bf16)p1; RT[t * XS + c] = (bf16)(p1 >> 16);
        KAPT[c * TS + t] = (bf16)p0; VTL[c * TS + t] = (bf16)p2;
        kkna[t] = kkn * a; kpv[t] = kpp; env[t] = en; vvv[t] = vv;
    }
    {
        float e8[8]; v4u* vt = (v4u*)((bf16*)(RO + RO_VT) + (size_t)it * 1024 + c * 16);
#pragma unroll
        for (int i = 0; i < 8; ++i) e8[i] = vvv[i];
        vt[0] = pack8(e8);
#pragma unroll
        for (int i = 0; i < 8; ++i) e8[i] = vvv[8 + i];
        vt[1] = pack8(e8);
        v4u* a2 = (v4u*)((bf16*)(RO + RO_A2) + (size_t)it * 2048 + c * 32);
        float dd[RC];
#pragma unroll
        for (int t = 0; t < RC; ++t) dd[t] = ec * env[t];
#pragma unroll
        for (int i = 0; i < 8; ++i) e8[i] = -kkna[i] * dd[i];
        a2[0] = pack8(e8);
#pragma unroll
        for (int i = 0; i < 8; ++i) e8[i] = -kkna[8 + i] * dd[8 + i];
        a2[1] = pack8(e8);
#pragma unroll
        for (int i = 0; i < 8; ++i) e8[i] = kpv[i] * dd[i];
        a2[2] = pack8(e8);
#pragma unroll
        for (int i = 0; i < 8; ++i) e8[i] = kpv[8 + i] * dd[8 + i];
        a2[3] = pack8(e8);
        ((float*)(RO + RO_GC))[(size_t)it * 64 + c] = ec;
    }
    LDS_WAIT(); asm volatile("" ::: "memory");
    const v2u zero2 = {0u, 0u};
    {
        f32x4 alt = {0.f, 0.f, 0.f, 0.f}, blt = alt, qlt = alt, plt = alt;
#pragma unroll
        for (int ks = 0; ks < 2; ++ks) {
            const bf16x8 fa = *(const LAS bf16x8*)(ALP + r16 * XS + 32 * ks + 8 * q), fk = *(const LAS bf16x8*)(KT + r16 * XS + 32 * ks + 8 * q);
            const bf16x8 fkp = *(const LAS bf16x8*)(KAP + r16 * XS + 32 * ks + 8 * q), fr = *(const LAS bf16x8*)(RT + r16 * XS + 32 * ks + 8 * q);
            alt = __builtin_amdgcn_mfma_f32_16x16x32_bf16(fa, fkp, alt, 0, 0, 0); blt = __builtin_amdgcn_mfma_f32_16x16x32_bf16(fk, fkp, blt, 0, 0, 0);
            qlt = __builtin_amdgcn_mfma_f32_16x16x32_bf16(fa, fr, qlt, 0, 0, 0);  plt = __builtin_amdgcn_mfma_f32_16x16x32_bf16(fk, fr, plt, 0, 0, 0);
        }
#pragma unroll
        for (int j = 0; j < 4; ++j) { const int s = 4 * q + j; const bool lt = s < r16, le = s <= r16;
            alt[j] = lt ? alt[j] : 0.f; blt[j] = lt ? blt[j] : 0.f; qlt[j] = le ? qlt[j] : 0.f; plt[j] = le ? plt[j] : 0.f; }
        *(LAS v2u*)(BL + r16 * SS16 + 4 * q) = pack4(blt); *(LAS v2u*)(QL + r16 * SS16 + 4 * q) = pack4(qlt); *(LAS v2u*)(PL + r16 * SS16 + 4 * q) = pack4(plt);
        *(LAS v2u*)(BL + r16 * SS16 + 16 + 4 * q) = zero2; *(LAS v2u*)(QL + r16 * SS16 + 16 + 4 * q) = zero2; *(LAS v2u*)(PL + r16 * SS16 + 16 + 4 * q) = zero2;
        float x[RC];
#pragma unroll
        for (int t = 0; t < RC; ++t) {
            float acc = (t == r16) ? 1.f : 0.f;
#pragma unroll
            for (int s2 = 0; s2 < t; ++s2) { const float a_ts = __uint_as_float(__builtin_amdgcn_readlane(__float_as_uint(alt[s2 & 3]), 16 * (s2 >> 2) + t)); acc -= a_ts * x[s2]; }
            x[t] = acc;
        }
        if (q == 0) {
#pragma unroll
            for (int t = 0; t < RC; ++t) { TB[t * SS16 + r16] = f2b(x[t]); TB[t * SS16 + 16 + r16] = 0; }
        }
    }
    LDS_WAIT(); asm volatile("" ::: "memory");
    const bf16x8 zf = {0, 0, 0, 0, 0, 0, 0, 0};
    const bf16x8 tbf = *(const LAS bf16x8*)(TB + r16 * SS16 + 8 * q), blf = *(const LAS bf16x8*)(BL + r16 * SS16 + 8 * q);
    const bf16x8 qlf = *(const LAS bf16x8*)(QL + r16 * SS16 + 8 * q), plf = *(const LAS bf16x8*)(PL + r16 * SS16 + 8 * q);
    const f32x4 z4 = {0.f, 0.f, 0.f, 0.f};
    bf16* gWH = (bf16*)(RO + RO_WH) + (size_t)it * 1024; bf16* gRH = (bf16*)(RO + RO_RH) + (size_t)it * 1024;
    bf16* gET = (bf16*)(RO + RO_ET) + (size_t)it * 1024; bf16* gOL = (bf16*)(RO + RO_OL) + (size_t)it * 1024;
#pragma unroll
    for (int kt = 0; kt < 4; ++kt) {
        const bf16x8 kf = (q < 2) ? *(const LAS bf16x8*)(KAPT + (16 * kt + r16) * TS + 8 * q) : zf;
        const f32x4 wa = __builtin_amdgcn_mfma_f32_16x16x32_bf16(kf, tbf, z4, 0, 0, 0);
        *(v2u*)(gWH + r16 * 64 + 16 * kt + 4 * q) = pack4(wa);
        const f32x4 wb = __builtin_amdgcn_mfma_f32_16x16x32_bf16(tbf, kf, z4, 0, 0, 0);
        *(LAS v2u*)(WT + (16 * kt + r16) * TS + 4 * q) = pack4(wb);
        const bf16x8 vf = (q < 2) ? *(const LAS bf16x8*)(VTL + (16 * kt + r16) * TS + 8 * q) : zf;
        const f32x4 bv = __builtin_amdgcn_mfma_f32_16x16x32_bf16(blf, vf, z4, 0, 0, 0);
        *(LAS v2u*)(BVT + (16 * kt + r16) * TS + 4 * q) = pack4(bv);
    }
    LDS_WAIT(); asm volatile("" ::: "memory");
#pragma unroll
    for (int vt = 0; vt < 4; ++vt) {
        const bf16x8 bf_ = (q < 2) ? *(const LAS bf16x8*)(BVT + (16 * vt + r16) * TS + 8 * q) : zf;
        const f32x4 e4 = __builtin_amdgcn_mfma_f32_16x16x32_bf16(tbf, bf_, z4, 0, 0, 0);
        const v2u ep = pack4(e4);
        *(LAS v2u*)(ETL + (16 * vt + r16) * TS + 4 * q) = ep; *(v2u*)(gET + (16 * vt + r16) * 16 + 4 * q) = ep;
    }
    LDS_WAIT(); asm volatile("" ::: "memory");
#pragma unroll
    for (int kt = 0; kt < 4; ++kt) {
        const bf16x8 wf = (q < 2) ? *(const LAS bf16x8*)(WT + (16 * kt + r16) * TS + 8 * q) : zf;
        const f32x4 qw = __builtin_amdgcn_mfma_f32_16x16x32_bf16(wf, qlf, z4, 0, 0, 0);
        const f32x4 rt4 = unpack4(*(const LAS v2u*)(RT + r16 * XS + 16 * kt + 4 * q));
        *(v2u*)(gRH + r16 * 64 + 16 * kt + 4 * q) = pack4(rt4 - qw);
        const bf16x8 vf = (q < 2) ? *(const LAS bf16x8*)(VTL + (16 * kt + r16) * TS + 8 * q) : zf;
        const bf16x8 ef = (q < 2) ? *(const LAS bf16x8*)(ETL + (16 * kt + r16) * TS + 8 * q) : zf;
        const f32x4 pv = __builtin_amdgcn_mfma_f32_16x16x32_bf16(vf, plf, z4, 0, 0, 0);
        const f32x4 qe = __builtin_amdgcn_mfma_f32_16x16x32_bf16(ef, qlf, z4, 0, 0, 0);
        *(v2u*)(gOL + r16 * 64 + 16 * kt + 4 * q) = pack4(pv - qe);
    }
    LDS_WAIT(); asm volatile("" ::: "memory");
}
__device__ __forceinline__ void ra_part(const Ctx& F, int part) {
    LAS unsigned* ctr = (LAS unsigned*)(F.lds + LDS_BYTES - 48) + part;
    LAS unsigned char* wl = F.lds + F.wave * RL_BYTES;
    for (;;) {
        unsigned idx = 0;
        if (F.lane == 0) idx = __hip_atomic_fetch_add(ctr, 1u, __ATOMIC_RELAXED, __HIP_MEMORY_SCOPE_WORKGROUP);
        idx = (unsigned)__builtin_amdgcn_readfirstlane((int)idx);
        const int it = (int)blockIdx.x + F.G * (int)idx;
        if (it >= RITEMS) break;
        ra_item(F, wl, it, part);
    }
}

__device__ __forceinline__ void rs_half(const Ctx& F, int half) {
    if (F.wave != 0) return;
    const unsigned char* RO = (const unsigned char*)F.out + (size_t)(half & 1) * RO_BUF; bf16* OY = (bf16*)(F.ws + WS_OY);
    float* SSg = (float*)((unsigned char*)F.out + RO_SS);
    LAS bf16* ST = (LAS bf16*)F.lds;
    LAS bf16* ZT = (LAS bf16*)(F.lds + 16 * XS * 2);
    constexpr int ZS = 24;
    const int lane = F.lane, r16 = lane & 15, q = lane >> 4;
    for (int blk = blockIdx.x; blk < NB * RHEADS * 4; blk += F.G) {
        const int xcd = blk & 7, jj = blk >> 3, qt = jj & 3, bh = (jj >> 2) * 8 + xcd, b = bh >> 4, h = bh & 15;
        f32x4 S[4];
        if (half == 0) {
#pragma unroll
            for (int kt = 0; kt < 4; ++kt) S[kt] = (f32x4){0.f, 0.f, 0.f, 0.f};
        } else {
#pragma unroll
            for (int kt = 0; kt < 4; ++kt) S[kt] = *(const f32x4*)(SSg + (size_t)blk * 1024 + (kt * 64 + lane) * 4);
        }
#pragma unroll
        for (int kt = 0; kt < 4; ++kt) *(LAS v2u*)(ST + r16 * XS + 16 * kt + 4 * q) = pack4(S[kt]);
        LDS_WAIT(); asm volatile("" ::: "memory");
        const size_t it0 = (size_t)bh * RHALF;
        const size_t mbase = (size_t)b * SEQ + (size_t)half * RHALF * RC;
#define RS_LOAD(IT, WF, RF, A2F, VF, ET4, OL4, GC4) do { const size_t it_ = (IT); \
        const bf16* wh_ = (const bf16*)(RO + RO_WH) + it_ * 1024 + r16 * 64 + 8 * q; const bf16* rh_ = (const bf16*)(RO + RO_RH) + it_ * 1024 + r16 * 64 + 8 * q; \
        WF[0] = *(const bf16x8*)wh_; WF[1] = *(const bf16x8*)(wh_ + 32); RF[0] = *(const bf16x8*)rh_; RF[1] = *(const bf16x8*)(rh_ + 32); \
        _Pragma("unroll") for (int kt_ = 0; kt_ < 4; ++kt_) { A2F[kt_] = *(const bf16x8*)((const bf16*)(RO + RO_A2) + it_ * 2048 + (16 * kt_ + r16) * 32 + 8 * q); \
            GC4[kt_] = *(const f32x4*)((const float*)(RO + RO_GC) + it_ * 64 + 16 * kt_ + 4 * q); } \
        VF = *(const bf16x8*)((const bf16*)(RO + RO_VT) + it_ * 1024 + (16 * qt + r16) * 16 + 8 * (q & 1)); \
        ET4 = *(const v2u*)((const bf16*)(RO + RO_ET) + it_ * 1024 + (16 * qt + r16) * 16 + 4 * q); \
        OL4 = *(const v2u*)((const bf16*)(RO + RO_OL) + it_ * 1024 + r16 * 64 + 16 * qt + 4 * q); } while (0)
        bf16x8 wfq[2][2], rfq[2][2], a2q[2][4], vfq[2]; v2u etq[2], olq[2]; f32x4 gcq[2][4];
#pragma unroll
        for (int u = 0; u < 2; ++u) RS_LOAD(it0 + u, wfq[u], rfq[u], a2q[u], vfq[u], etq[u], olq[u], gcq[u]);
#define RS_STEP(U, CL) do { const int cl_ = (CL); \
            const bf16x8 sb0 = *(const LAS bf16x8*)(ST + r16 * XS + 8 * q), sb1 = *(const LAS bf16x8*)(ST + r16 * XS + 32 + 8 * q); \
            f32x4 x1 = __builtin_amdgcn_mfma_f32_16x16x32_bf16(wfq[U][0], sb0, (f32x4){0.f, 0.f, 0.f, 0.f}, 0, 0, 0); \
            x1 = __builtin_amdgcn_mfma_f32_16x16x32_bf16(wfq[U][1], sb1, x1, 0, 0, 0); \
            f32x4 ot = __builtin_amdgcn_mfma_f32_16x16x32_bf16(sb0, rfq[U][0], unpack4(olq[U]), 0, 0, 0); \
            ot = __builtin_amdgcn_mfma_f32_16x16x32_bf16(sb1, rfq[U][1], ot, 0, 0, 0); \
            *(LAS v2u*)(ZT + r16 * ZS + 4 * q) = pack4(x1 + unpack4(etq[U])); \
            *(v2u*)(OY + (mbase + (size_t)cl_ * RC + r16) * DM + h * 64 + 16 * qt + 4 * q) = pack4(ot); \
            LDS_WAIT(); asm volatile("" ::: "memory"); \
            const bf16x8 zr = *(const LAS bf16x8*)(ZT + r16 * ZS + 8 * (q & 1)); \
            const bf16x8 bz = (q < 2) ? zr : vfq[U]; \
            _Pragma("unroll") for (int kt = 0; kt < 4; ++kt) { S[kt] = __builtin_amdgcn_mfma_f32_16x16x32_bf16(a2q[U][kt], bz, S[kt] * gcq[U][kt], 0, 0, 0); \
                *(LAS v2u*)(ST + r16 * XS + 16 * kt + 4 * q) = pack4(S[kt]); } \
            RS_LOAD(it0 + ((cl_ + 2 < RHALF) ? cl_ + 2 : RHALF - 1), wfq[U], rfq[U], a2q[U], vfq[U], etq[U], olq[U], gcq[U]);     \
            LDS_WAIT(); asm volatile("" ::: "memory"); } while (0)
#pragma unroll 1
        for (int cl = 0; cl < RHALF; cl += 2) { RS_STEP(0, cl); RS_STEP(1, cl + 1); }
#undef RS_STEP
#undef RS_LOAD
        if (half + 1 < NPART) {
#pragma unroll
            for (int kt = 0; kt < 4; ++kt) *(f32x4*)(SSg + (size_t)blk * 1024 + (kt * 64 + lane) * 4) = S[kt];
        }
    }
}
__device__ __forceinline__ float rowmax16(float x) { x = fmaxf(x, dpp_f<0xB1>(x)); x = fmaxf(x, dpp_f<0x4E>(x)); x = fmaxf(x, dpp_f<0x124>(x)); x = fmaxf(x, dpp_f<0x128>(x)); return x; }
__device__ __forceinline__ int cand_code(int s) {
    if (s < 16) return s << 4;
    if (s < 24) return 1 | ((s - 16) << 4);
    if (s < 29) return 2 | ((s - 24) << 4);
    if (s < 33) return 3 | ((s - 29) << 4);
    if (s < 36) return 4 | ((s - 33) << 4);
    if (s < 42) { const int k = s - 36; return (5 + (k >> 1)) | ((k & 1) << 4); }
    if (s < 50) return 8 + (s - 42);
    return -1;
}
__device__ __forceinline__ int f2ord(float f) { const int b = __float_as_int(f); return b ^ ((b >> 31) & 0x7fffffff); }
__device__ __forceinline__ float ord2f(int k) { return __int_as_float(k ^ ((k >> 31) & 0x7fffffff)); }
template <int CTRL> __device__ __forceinline__ int dpp_i(int x) { return __builtin_amdgcn_mov_dpp(x, CTRL, 0xf, 0xf, true); }
__device__ __forceinline__ int imax(int a, int b) { return a > b ? a : b; }
__device__ __forceinline__ int imin(int a, int b) { return a < b ? a : b; }
__device__ __forceinline__ int rowmax16_i(int x) { x = imax(x, dpp_i<0xB1>(x)); x = imax(x, dpp_i<0x4E>(x)); x = imax(x, dpp_i<0x124>(x)); x = imax(x, dpp_i<0x128>(x)); return x; }
#define CSWAP_(a, b) do { const int hi_ = imax(a, b), lo_ = imin(a, b); a = hi_; b = lo_; } while (0)
template <int NV> __device__ __forceinline__ void sort_desc(int (&v)[NV]);
template <> __device__ __forceinline__ void sort_desc<8>(int (&v)[8]) {
    CSWAP_(v[0], v[1]); CSWAP_(v[2], v[3]); CSWAP_(v[4], v[5]); CSWAP_(v[6], v[7]);
    CSWAP_(v[0], v[2]); CSWAP_(v[1], v[3]); CSWAP_(v[4], v[6]); CSWAP_(v[5], v[7]);
    CSWAP_(v[1], v[2]); CSWAP_(v[5], v[6]);
    CSWAP_(v[0], v[4]); CSWAP_(v[1], v[5]); CSWAP_(v[2], v[6]); CSWAP_(v[3], v[7]);
    CSWAP_(v[2], v[4]); CSWAP_(v[3], v[5]);
    CSWAP_(v[1], v[2]); CSWAP_(v[3], v[4]); CSWAP_(v[5], v[6]);
}
template <> __device__ __forceinline__ void sort_desc<4>(int (&v)[4]) {
    CSWAP_(v[0], v[1]); CSWAP_(v[2], v[3]); CSWAP_(v[0], v[2]); CSWAP_(v[1], v[3]); CSWAP_(v[1], v[2]);
}
template <int NV>
__device__ __forceinline__ void select16x4(int (&v)[4][NV], int r16, float (&kept_f)[4]) {
    const int IMIN = (int)0x80000000;
    int kept[4];
#pragma unroll
    for (int j = 0; j < 4; ++j) { kept[j] = IMIN; sort_desc<NV>(v[j]); }
#pragma unroll 1
    for (int rd = 0; rd < 16; ++rd) {
#pragma unroll
        for (int j = 0; j < 4; ++j) {
            const int m = rowmax16_i(v[j][0]);
            kept[j] = (r16 == rd) ? m : kept[j];
            const bool own = (v[j][0] == m);
#pragma unroll
            for (int i = 0; i < NV - 1; ++i) v[j][i] = own ? v[j][i + 1] : v[j][i];
            v[j][NV - 1] = own ? IMIN : v[j][NV - 1];
        }
    }
#pragma unroll
    for (int j = 0; j < 4; ++j) kept_f[j] = ord2f(kept[j]);
}
__device__ __forceinline__ float dot2bf(unsigned a, unsigned b, float acc) { return __builtin_amdgcn_fdot2_f32_bf16(__builtin_bit_cast(bf16x2_t, a), __builtin_bit_cast(bf16x2_t, b), acc, false); }

constexpr int PT = 16;
constexpr size_t RANGE_BYTES = (size_t)NEXP * 128;

__device__ __forceinline__ void p9_route(const Ctx& F) {
    constexpr int KSTR = 136;
    const bf16* Q = (const bf16*)(F.ws + WS_Q); const bf16* KEYS = (const bf16*)(F.ws + WS_KEYS);
    int* rtE = (int*)(F.ws + WS_RTE); float* rtG = (float*)(F.ws + WS_RTG);
    LAS bf16* KL = (LAS bf16*)F.lds;
    const int lane = F.lane, w = F.wave, r16 = lane & 15, q = lane >> 4, gbase = lane & 48;
    const int h = blockIdx.x & 7, nbh = (F.G - h + 7) >> 3;
    __syncthreads();
    for (int i = F.tid; i < 2 * 128 * 16; i += NTHR) { const int row = i >> 4, ch = i & 15;
        *(LAS v4u*)(KL + row * KSTR + 8 * ch) = *(const v4u*)(KEYS + (size_t)(2 * h * 128 + row) * 128 + 8 * ch); }
    __syncthreads();
    int ci[4], cj[4]; bool cvalid[4];
#pragma unroll
    for (int u = 0; u < 4; ++u) { const int cd = cand_code(r16 + 16 * u); cvalid[u] = cd >= 0; ci[u] = cd & 15; cj[u] = (cd >> 4) & 15; }
    const float NINF = -__builtin_inff();
    const int tstride = nbh * NWAVES;
    int tile = (blockIdx.x >> 3) * NWAVES + w;
    bf16x8 afn[2][4];
    if (tile < M / PT) {
#pragma unroll
        for (int p = 0; p < 2; ++p)
#pragma unroll
            for (int s = 0; s < 4; ++s) afn[p][s] = *(const bf16x8*)(Q + (size_t)(tile * PT + r16) * DM + (2 * h + p) * 128 + 8 * q + 32 * s);
    }
    for (; tile < M / PT; tile += tstride) {
        const int m0 = tile * PT;
        bf16x8 af[2][4];
#pragma unroll
        for (int p = 0; p < 2; ++p)
#pragma unroll
            for (int s = 0; s < 4; ++s) af[p][s] = afn[p][s];
        { const int tn = (tile + tstride < M / PT) ? tile + tstride : tile;
#pragma unroll
            for (int p = 0; p < 2; ++p)
#pragma unroll
                for (int s = 0; s < 4; ++s) afn[p][s] = *(const bf16x8*)(Q + (size_t)(tn * PT + r16) * DM + (2 * h + p) * 128 + 8 * q + 32 * s);
        }
        float top[2][4];
#pragma unroll
        for (int p = 0; p < 2; ++p) {
            int v[4][8];
#pragma unroll
            for (int nt = 0; nt < 8; ++nt) {
                const LAS bf16* krow = KL + (p * 128 + nt * 16 + r16) * KSTR + 8 * q;
                f32x4 acc = {0.f, 0.f, 0.f, 0.f};
#pragma unroll
                for (int s = 0; s < 4; ++s) acc = __builtin_amdgcn_mfma_f32_16x16x32_bf16(af[p][s], *(const LAS bf16x8*)(krow + 32 * s), acc, 0, 0, 0);
                const unsigned tag = 127u - (unsigned)(nt * 16 + r16);
#pragma unroll
                for (int j = 0; j < 4; ++j) v[j][nt] = f2ord(__uint_as_float((__float_as_uint(acc[j]) & ~127u) | tag));
                if (nt & 1) asm volatile("" ::: "memory");
            }
            select16x4<8>(v, r16, top[p]);
        }
        int cv[4][4];
#pragma unroll
        for (int u = 0; u < 4; ++u)
#pragma unroll
            for (int j = 0; j < 4; ++j) {
                const float a = __shfl(top[0][j], gbase + ci[u]), b = __shfl(top[1][j], gbase + cj[u]);
                const float cs = __uint_as_float(__float_as_uint(a) & ~127u) + __uint_as_float(__float_as_uint(b) & ~127u);
                const float pk = __uint_as_float((__float_as_uint(cs) & ~63u) | (63u - (unsigned)(r16 + 16 * u)));
                cv[j][u] = cvalid[u] ? f2ord(pk) : (int)0x80000000;
            }
        float best[4];
        select16x4<4>(cv, r16, best);
#pragma unroll
        for (int j = 0; j < 4; ++j) {
            const unsigned bb = __float_as_uint(best[j]);
            const int cd = cand_code(63 - (int)(bb & 63u));
            const int k0 = 127 - (int)(__float_as_uint(__shfl(top[0][j], gbase + (cd & 15))) & 127u);
            const int k1 = 127 - (int)(__float_as_uint(__shfl(top[1][j], gbase + ((cd >> 4) & 15))) & 127u);
            const float s = __uint_as_float(bb & ~63u);
            const float mx = rowmax16(s), e = __expf(s - mx), sum = rowsum16(e);
            const size_t o = (size_t)(m0 + 4 * q + j) * 128 + h * 16 + r16;
            rtE[o] = k0 * 128 + k1; rtG[o] = e * rcp_f(sum);
        }
    }
}

__device__ __forceinline__ f32x2 cvt2_fp8(unsigned wd, bool hi) { return hi ? __builtin_amdgcn_cvt_pk_f32_fp8((int)wd, true) : __builtin_amdgcn_cvt_pk_f32_fp8((int)wd, false); }
__device__ __forceinline__ void treduce8x16(const float (&p)[16], bool b0, bool b1, bool b2, float& r0, float& r1) {
    float a[8], bq[4];
#pragma unroll
    for (int i = 0; i < 8; ++i) { const float mine = b2 ? p[i + 8] : p[i], send = b2 ? p[i] : p[i + 8]; const float up = dpp_f<0x104>(send), dn = dpp_f<0x114>(send); a[i] = mine + (b2 ? dn : up); }
#pragma unroll
    for (int i = 0; i < 4; ++i) { const float mine = b1 ? a[i + 4] : a[i], send = b1 ? a[i] : a[i + 4]; bq[i] = mine + dpp_f<0x4E>(send); }
    { const float mine = b0 ? bq[2] : bq[0], send = b0 ? bq[0] : bq[2]; r0 = mine + dpp_f<0xB1>(send); }
    { const float mine = b0 ? bq[3] : bq[1], send = b0 ? bq[1] : bq[3]; r1 = mine + dpp_f<0xB1>(send); }
}
struct XGroup { int xg, gwi, stride; };
__device__ __forceinline__ XGroup xgroup(const Ctx& F) { XGroup g; g.xg = blockIdx.x & 7; const int nbg = (F.G - g.xg + 7) >> 3; g.gwi = (blockIdx.x >> 3) * NWAVES + F.wave; g.stride = nbg * NWAVES; return g; }

__device__ __forceinline__ void p10_peer_u(const Ctx& F) {
    typedef int v8i __attribute__((ext_vector_type(8)));
    const unsigned char* PU4 = F.ws + WS_PU8; const unsigned char* X8 = F.ws + WS_X8;
    const int* rtE = (const int*)(F.ws + WS_RTE); unsigned char* PDb = F.ws + WS_PD;
    const XGroup g = xgroup(F);
    const int lane = F.lane, j = lane >> 3, sub = lane & 7, n = lane & 15, kb = lane >> 4;
    const int r = g.xg;
    const unsigned char* tab = PU4 + (size_t)r * RANGE_BYTES;
    const unsigned so = 16u * (unsigned)sub;
    LAS unsigned char* wl = F.lds + F.wave * 16384;
    const int p0 = (kb + (n >> 1)) & 7, p1 = (p0 + 4) & 7;
    const int rot = n >> 1;
    const int xo00 = 32 * ((0 + 0 + (kb >> 1) + rot) & 7) + 16 * (kb & 1), xo01 = 32 * ((0 + 2 + (kb >> 1) + rot) & 7) + 16 * (kb & 1);
    const int xo10 = 32 * ((4 + 0 + (kb >> 1) + rot) & 7) + 16 * (kb & 1), xo11 = 32 * ((4 + 2 + (kb >> 1) + rot) & 7) + 16 * (kb & 1);
    LAS unsigned char* bp0 = wl + n * 128 + 16 * p0; LAS unsigned char* bp1 = wl + n * 128 + 16 * p1;
    LAS unsigned char* wp = wl + lane * 16;
    const bool diag = (n >> 2) == kb; const int sel = lane & 3;
    const int SC = 0x7f7f7f7f;
    int m = g.gwi;
    if (m >= M) return;
    const int st = g.stride;
    v4u ev[4], evn[4], gtA[16], gtB[16], xaA[4], xaB[4];
#define PU_IDS(e, mm) { _Pragma("unroll") for (int i = 0; i < 4; ++i) e[i] = *(const v4u*)(rtE + (size_t)(mm) * 128 + 16 * j + 4 * i); }
#define PU_X(xv, mm) { const unsigned char* xr_ = X8 + (size_t)(mm) * DM + 256 * r; xv[0] = *(const v4u*)(xr_ + xo00); xv[1] = *(const v4u*)(xr_ + xo01); xv[2] = *(const v4u*)(xr_ + xo10); xv[3] = *(const v4u*)(xr_ + xo11); }
#define PU_GATHER(gx, e) { _Pragma("unroll") for (int k = 0; k < 16; ++k) gx[k] = *(const v4u*)(tab + (e[k >> 2][k & 3] * 128u + so)); }
#define PU_CLAMP(mm) (((mm) < M) ? (mm) : m)
#define PU_ITEM(GT, XC, XN, MC) { const int mc_ = (MC); \
        _Pragma("unroll") for (int k = 0; k < 16; ++k) *(LAS v4u*)(wp + k * 1024) = GT[k]; \
        asm volatile("" ::: "memory"); \
        PU_X(XN, PU_CLAMP(mc_ + st)); PU_IDS(evn, PU_CLAMP(mc_ + 3 * st)); \
        asm volatile("" ::: "memory"); \
        PU_GATHER(GT, ev); \
        asm volatile("" ::: "memory"); \
        v8i A0, A1; \
        A0[0] = XC[0].x; A0[1] = XC[0].y; A0[2] = XC[0].z; A0[3] = XC[0].w; A0[4] = XC[1].x; A0[5] = XC[1].y; A0[6] = XC[1].z; A0[7] = XC[1].w; \
        A1[0] = XC[2].x; A1[1] = XC[2].y; A1[2] = XC[2].z; A1[3] = XC[2].w; A1[4] = XC[3].x; A1[5] = XC[3].y; A1[6] = XC[3].z; A1[7] = XC[3].w; \
        float dv[8]; \
        _Pragma("unroll") for (int tg = 0; tg < 4; ++tg) { \
            v4u b0[2], b1[2]; \
            _Pragma("unroll") for (int u = 0; u < 2; ++u) { b0[u] = *(const LAS v4u*)(bp0 + (2 * tg + u) * 2048); b1[u] = *(const LAS v4u*)(bp1 + (2 * tg + u) * 2048); } \
            f32x4 acc[2]; \
            _Pragma("unroll") for (int u = 0; u < 2; ++u) { const v8i B0 = {(int)b0[u].x, (int)b0[u].y, (int)b0[u].z, (int)b0[u].w, 0, 0, 0, 0}; \
                acc[u] = __builtin_amdgcn_mfma_scale_f32_16x16x128_f8f6f4(A0, B0, (f32x4){0.f, 0.f, 0.f, 0.f}, 0, 4, 0, SC, 0, SC); } \
            _Pragma("unroll") for (int u = 0; u < 2; ++u) { const v8i B1 = {(int)b1[u].x, (int)b1[u].y, (int)b1[u].z, (int)b1[u].w, 0, 0, 0, 0}; \
                acc[u] = __builtin_amdgcn_mfma_scale_f32_16x16x128_f8f6f4(A1, B1, acc[u], 0, 4, 0, SC, 0, SC); } \
            _Pragma("unroll") for (int u = 0; u < 2; ++u) { const float lo = s1 ? acc[u][1] : acc[u][0], hi = s1 ? acc[u][3] : acc[u][2]; dv[2 * tg + u] = s2 ? hi : lo; } \
        } \
        asm volatile("" : "+v"(dv[0]), "+v"(dv[1]), "+v"(dv[2]), "+v"(dv[3]), "+v"(dv[4]), "+v"(dv[5]), "+v"(dv[6]), "+v"(dv[7]) :: "memory"); \
        if (diag) *(v4u*)(PDb + ((size_t)r * M + mc_) * 256 + 16 * n) = pack8(dv); \
        _Pragma("unroll") for (int i = 0; i < 4; ++i) ev[i] = evn[i]; }
    const bool s1 = sel & 1, s2 = sel & 2;
    {
        PU_IDS(ev, m); PU_X(xaA, m); PU_IDS(evn, PU_CLAMP(m + st));
        PU_GATHER(gtA, ev);
        PU_GATHER(gtB, evn);
        PU_IDS(ev, PU_CLAMP(m + 2 * st));
    }
    for (; m < M; m += 2 * st) {
        PU_ITEM(gtA, xaA, xaB, m);
        if (m + st < M) PU_ITEM(gtB, xaB, xaA, m + st);
    }
#undef PU_IDS
#undef PU_X
#undef PU_GATHER
#undef PU_CLAMP
#undef PU_ITEM
}

__device__ __forceinline__ void p11_peer_coef(const Ctx& F) {
    const int* rtE = (const int*)(F.ws + WS_RTE); const float* rtG = (const float*)(F.ws + WS_RTG); const unsigned* PD = (const unsigned*)(F.ws + WS_PD);
    const float* usc = (const float*)(F.ws + WS_USC); const float* vsc = (const float*)(F.ws + WS_VSC); float* COEF = (float*)(F.ws + WS_COEF);
    int m = F.gw;
    if (m >= M) return;
    const int st = F.NGW;
    unsigned pd[8]; f32x2 gt; float us0, us1, vs0, vs1; v2u e1;
    {   const size_t o = (size_t)m * 128 + 2 * F.lane;
        const v2u e0 = *(const v2u*)(rtE + o);
#pragma unroll
        for (int r = 0; r < 8; ++r) { const unsigned short* ph = (const unsigned short*)PD + ((size_t)r * M + m) * 128 + F.lane; pd[r] = (unsigned)ph[0] | ((unsigned)ph[64] << 16); }
        gt = *(const f32x2*)(rtG + o);
        const int m1 = (m + st < M) ? m + st : m;
        e1 = *(const v2u*)(rtE + (size_t)m1 * 128 + 2 * F.lane);
        us0 = usc[e0.x]; us1 = usc[e0.y]; vs0 = vsc[e0.x]; vs1 = vsc[e0.y]; }
    for (; m < M; m += st) {
        const int m1 = (m + st < M) ? m + st : m, m2 = (m + 2 * st < M) ? m + 2 * st : m;
        const size_t o = (size_t)m * 128 + 2 * F.lane, o1 = (size_t)m1 * 128 + 2 * F.lane;
        const v2u e2 = *(const v2u*)(rtE + (size_t)m2 * 128 + 2 * F.lane);
        unsigned pdn[8];
#pragma unroll
        for (int r = 0; r < 8; ++r) { const unsigned short* ph = (const unsigned short*)PD + ((size_t)r * M + m1) * 128 + F.lane; pdn[r] = (unsigned)ph[0] | ((unsigned)ph[64] << 16); }
        const f32x2 gtn = *(const f32x2*)(rtG + o1);
        const float us0n = usc[e1.x], us1n = usc[e1.y], vs0n = vsc[e1.x], vs1n = vsc[e1.y];
        asm volatile("" ::: "memory");
        f32x2 d = {0.f, 0.f};
#pragma unroll
        for (int r = 0; r < 8; ++r) d += (f32x2){bflo(pd[r]), bfhi(pd[r])};
        const float d0 = d.x * us0, d1 = d.y * us1;
        f32x2 c; c.x = gt.x * (0.5f * d0 * (1.f + erff(d0 * 0.70710678f))) * vs0; c.y = gt.y * (0.5f * d1 * (1.f + erff(d1 * 0.70710678f))) * vs1;
        {
            float am = fmaxf(fabsf(c.x), fabsf(c.y));
#pragma unroll
            for (int sh = 1; sh < 64; sh <<= 1) am = fmaxf(am, __shfl_xor(am, sh));
            int E = (int)((__float_as_uint(am) >> 23) & 255u); E = E < 8 ? 8 : E;
            const float S = __uint_as_float((unsigned)(261 - E) << 23), Sinv = __uint_as_float((unsigned)(E - 7) << 23);
            const float hx = c.x * S, hy = c.y * S;
            const int h8 = __builtin_amdgcn_cvt_pk_fp8_f32(hx, hy, 0, false);
            const float lx = (hx - __builtin_amdgcn_cvt_f32_fp8(h8, 0)) * 16.f, ly = (hy - __builtin_amdgcn_cvt_f32_fp8(h8, 1)) * 16.f;
            const int l8 = __builtin_amdgcn_cvt_pk_fp8_f32(lx, ly, 0, false);
            unsigned char* ch = (unsigned char*)COEF + (size_t)m * 128 + 16 * (F.lane & 7) + (F.lane >> 3); unsigned char* cl = ch + 4 * MiB;
            ch[0] = (unsigned char)(h8 & 255); ch[8] = (unsigned char)((h8 >> 8) & 255); cl[0] = (unsigned char)(l8 & 255); cl[8] = (unsigned char)((l8 >> 8) & 255);
            if (F.lane == 0) ((float*)((unsigned char*)COEF + 8 * MiB))[m] = Sinv;
        }
#pragma unroll
        for (int r = 0; r < 8; ++r) pd[r] = pdn[r];
        gt = gtn; us0 = us0n; us1 = us1n; vs0 = vs0n; vs1 = vs1n; e1 = e2;
    }
}

__device__ __forceinline__ void p12_peer_v(const Ctx& F) {
    typedef int v8i __attribute__((ext_vector_type(8)));
    typedef int v2i __attribute__((ext_vector_type(2)));
    const unsigned char* PV4 = F.ws + WS_PV8; const int* rtE = (const int*)(F.ws + WS_RTE);
    const unsigned char* CH = F.ws + WS_COEF; const unsigned char* CL = CH + 4 * MiB; const float* CSC = (const float*)(CH + 8 * MiB);
    const float* mod = (const float*)(F.ws + WS_MOD); unsigned short* HB = (unsigned short*)(F.ws + WS_HB);
    const XGroup g = xgroup(F);
    const int lane = F.lane, j = lane >> 3, sub = lane & 7, n = lane & 15, gq = lane >> 4;
    const int r = g.xg;
    const unsigned char* tab = PV4 + (size_t)r * RANGE_BYTES;
    const unsigned so = 16u * (unsigned)sub;
    LAS unsigned char* wl = F.lds + F.wave * 16384;
    LAS unsigned char* wpE = wl + j * 128 + 16 * (sub ^ (j >> 1)); LAS unsigned char* wpO = wl + j * 128 + 16 * (sub ^ (j >> 1) ^ 4);
    LAS unsigned char* rb = wl + (32 * gq + n) * 128; const int nb = 16 * (n >> 1);
    const unsigned char* cab = ((n & 3) == 1 ? CL : CH) + 16 * gq; const bool arow = (n & 3) < 2;
    const int SC = 0x7f7f7f7f;
    int m = g.gwi;
    if (m >= M) return;
    const int st = g.stride;
    struct Nx { v4u a0, a1; unsigned short h[4]; float g2[4]; float cs; };
    v4u ev[4], evn[4], gtA[16], gtB[16]; Nx xA, xB;
#define PV_IDS(e, mm) { _Pragma("unroll") for (int i = 0; i < 4; ++i) e[i] = *(const v4u*)(rtE + (size_t)(mm) * 128 + 16 * j + 4 * i); }
#define PV_NX(X, mm) { const int mq_ = (mm); X.a0 = *(const v4u*)(cab + (size_t)mq_ * 128); X.a1 = *(const v4u*)(cab + (size_t)mq_ * 128 + 64); X.cs = CSC[mq_]; \
        _Pragma("unroll") for (int u = 0; u < 4; ++u) { X.h[u] = HB[(size_t)mq_ * DM + 256 * r + 64 * u + lane]; X.g2[u] = mod[(size_t)(mq_ / SEQ) * MODW + 5 * DM + 256 * r + 64 * u + lane]; } }
#define PV_GATHER(gx, e) { _Pragma("unroll") for (int k = 0; k < 16; ++k) gx[k] = *(const v4u*)(tab + (e[k >> 2][k & 3] * 128u + so)); }
#define PV_CLAMP(mm) (((mm) < M) ? (mm) : m)
#define PV_ITEM(GT, XC, XN, MC) { const int mc_ = (MC); \
        _Pragma("unroll") for (int k = 0; k < 16; ++k) *(LAS v4u*)(((k & 1) ? wpO : wpE) + k * 1024) = GT[k]; \
        asm volatile("" ::: "memory"); \
        PV_NX(XN, PV_CLAMP(mc_ + st)); PV_IDS(evn, PV_CLAMP(mc_ + 3 * st)); \
        asm volatile("" ::: "memory"); \
        PV_GATHER(GT, ev); \
        asm volatile("" ::: "memory"); \
        v8i A; \
        A[0] = arow ? (int)XC.a0.x : 0; A[1] = arow ? (int)XC.a0.y : 0; A[2] = arow ? (int)XC.a0.z : 0; A[3] = arow ? (int)XC.a0.w : 0; \
        A[4] = arow ? (int)XC.a1.x : 0; A[5] = arow ? (int)XC.a1.y : 0; A[6] = arow ? (int)XC.a1.z : 0; A[7] = arow ? (int)XC.a1.w : 0; \
        float res[4]; \
        _Pragma("unroll") for (int q = 0; q < 16; ++q) { \
            LAS unsigned char* ap_ = rb + (nb ^ (8 * q)); \
            const v2i t0 = __builtin_amdgcn_ds_read_tr4_b64_v2i32((LAS v2i*)ap_), t1 = __builtin_amdgcn_ds_read_tr4_b64_v2i32((LAS v2i*)(ap_ + 2048)); \
            const v8i B = {t0.x, t0.y, t1.x, t1.y, 0, 0, 0, 0}; \
            const f32x4 acc = __builtin_amdgcn_mfma_scale_f32_16x16x128_f8f6f4(A, B, (f32x4){0.f, 0.f, 0.f, 0.f}, 0, 4, 0, SC, 0, SC); \
            const float val = acc[0] + acc[1] * 0.0625f; \
            if ((q & 3) == 0) res[q >> 2] = val; else res[q >> 2] = (gq == (q & 3)) ? val : res[q >> 2]; \
        } \
        asm volatile("" : "+v"(res[0]), "+v"(res[1]), "+v"(res[2]), "+v"(res[3]) :: "memory"); \
        _Pragma("unroll") for (int u = 0; u < 4; ++u) { \
            const float h2 = __uint_as_float((unsigned)XC.h[u] << 16) + XC.g2[u] * (res[u] * XC.cs); \
            HB[(size_t)mc_ * DM + 256 * r + 64 * u + lane] = (unsigned short)(pk2(h2, 0.f) & 0xffffu); } \
        _Pragma("unroll") for (int i = 0; i < 4; ++i) ev[i] = evn[i]; }
    {
        PV_IDS(ev, m); PV_NX(xA, m); PV_IDS(evn, PV_CLAMP(m + st));
        PV_GATHER(gtA, ev);
        PV_GATHER(gtB, evn);
        PV_IDS(ev, PV_CLAMP(m + 2 * st));
    }
    for (; m < M; m += 2 * st) {
        PV_ITEM(gtA, xA, xB, m);
        if (m + st < M) PV_ITEM(gtB, xB, xA, m + st);
    }
#undef PV_IDS
#undef PV_NX
#undef PV_GATHER
#undef PV_CLAMP
#undef PV_ITEM
}
#define XB_TMO      128
#define XB_XCNT(j)  (256  + 64 * (j))
#define XB_XSUB(j)  (1280 + 64 * (j))
#define XB_XGEN(j)  (2304 + 64 * (j))
#define XB_TOP      3328
#define XB_TOPGEN   3392
#define XCD_BAR_WORDS 3456
#define XB_SPIN_CAP (1u << 18)

__device__ __forceinline__ unsigned xb_ld(unsigned* p)              { return __hip_atomic_load(p, __ATOMIC_RELAXED, __HIP_MEMORY_SCOPE_AGENT); }
__device__ __forceinline__ unsigned xb_add(unsigned* p, unsigned v) { return __hip_atomic_fetch_add(p, v, __ATOMIC_RELAXED, __HIP_MEMORY_SCOPE_AGENT); }
__device__ __forceinline__ unsigned xb_xcc_id() { return (unsigned)__builtin_amdgcn_s_getreg((3 << 11) | 20) & 0xFu; }
#define XB_SPIN(cond, bar) do { unsigned _sp = 0; while (cond) { __builtin_amdgcn_s_sleep(1); \
    if ((++_sp & 255u) == 0u) { if (xb_ld(&(bar)[XB_TMO])) break; if (_sp > XB_SPIN_CAP) { atomicAdd(&(bar)[XB_TMO], 1u); break; } } } } while (0)

struct XcdBarrier {
    unsigned* bar; unsigned x;
    volatile LAS unsigned* st;
};

__device__ __forceinline__ XcdBarrier xcd_barrier_post(unsigned* bar, volatile LAS unsigned* st) {
    XcdBarrier b; b.bar = bar; b.x = xb_xcc_id(); b.st = st;
    if (threadIdx.x == 0) (void)xb_add(&bar[XB_XCNT(b.x)], 1u);
    return b;
}
__device__ __forceinline__ void xcd_barrier_complete(unsigned* bar, unsigned x, unsigned& nloc, unsigned& nx) {
    const unsigned G = gridDim.x * gridDim.y * gridDim.z;
    unsigned sum, cnt, mine, sp = 0u;
    for (;;) {
        sum = 0u; cnt = 0u; mine = 0u;
#pragma unroll
        for (unsigned j = 0; j < 16; ++j) { const unsigned c = xb_ld(&bar[XB_XCNT(j)]); sum += c; cnt += (c > 0u) ? 1u : 0u; mine = (j == x) ? c : mine; }
        if (sum == G) break;
        __builtin_amdgcn_s_sleep(1);
        if ((++sp & 255u) == 0u) { if (xb_ld(&bar[XB_TMO])) break; if (sp > XB_SPIN_CAP) { atomicAdd(&bar[XB_TMO], 1u); break; } }
    }
    nloc = mine > 0u ? mine : 1u; nx = cnt > 0u ? cnt : 1u;
}

__device__ __forceinline__ void xcd_barrier(const XcdBarrier& b) {
    asm volatile("s_waitcnt vmcnt(0)" ::: "memory");
    __syncthreads();
    if (threadIdx.x == 0) {
        unsigned* bar = b.bar;
        __builtin_amdgcn_s_waitcnt(0);
        unsigned nloc = b.st[0], nx = b.st[1];
        if (nloc == 0u) { xcd_barrier_complete(bar, b.x, nloc, nx); b.st[0] = nloc; b.st[1] = nx; }
        const unsigned old = xb_add(&bar[XB_XSUB(b.x)], 1u);
        const unsigned gen = old / nloc;
        if (old + 1u == (gen + 1u) * nloc) {
            __builtin_amdgcn_fence(__ATOMIC_RELEASE, "agent");
            asm volatile("s_waitcnt vmcnt(0)" ::: "memory");
            const unsigned og = xb_add(&bar[XB_TOP], 1u);
            const unsigned tg = og / nx;
            if (og + 1u == (tg + 1u) * nx) xb_add(&bar[XB_TOPGEN], 1u);
            else XB_SPIN(xb_ld(&bar[XB_TOPGEN]) == tg, bar);
            __builtin_amdgcn_fence(__ATOMIC_ACQUIRE, "agent");
            xb_add(&bar[XB_XGEN(b.x)], 1u);
            asm volatile("s_waitcnt vmcnt(0)" ::: "memory");
        } else {
            XB_SPIN(xb_ld(&bar[XB_XGEN(b.x)]) == gen, bar);
            __builtin_amdgcn_fence(__ATOMIC_ACQUIRE, "agent");
            asm volatile("s_waitcnt vmcnt(0)" ::: "memory");
        }
    }
    __syncthreads();
}

struct Args { const float* in[N_IN]; float* out; unsigned char* ws; int ph_lo, ph_hi; };
constexpr int N_PHASES = 19;

__global__ void __launch_bounds__(NTHR, 2) fwd_kernel(Args args) {
    extern __shared__ __attribute__((aligned(16))) unsigned char lds_raw[];
    cg::grid_group grid = cg::this_grid();
    Ctx F;
    F.lds = (LAS unsigned char*)lds_raw;
    F.tid = threadIdx.x; F.lane = F.tid & 63; F.wave = __builtin_amdgcn_readfirstlane(F.tid >> 6);
    F.G = gridDim.x; F.gw = blockIdx.x * NWAVES + F.wave; F.NGW = F.G * NWAVES;
    F.in = args.in; F.out = args.out; F.ws = args.ws;
    const int lo = args.ph_lo, hi = args.ph_hi;
    volatile LAS unsigned* bst = (volatile LAS unsigned*)(F.lds + LDS_BYTES - 64);
    if (F.tid < 2) bst[F.tid] = 0u;
    if (F.tid < 4) ((volatile LAS unsigned*)(F.lds + LDS_BYTES - 48))[F.tid] = 0u;
    __syncthreads();
    const XcdBarrier bar = xcd_barrier_post((unsigned*)(F.ws + WS_CTL) + 4096, bst);
#define IN(k) (lo <= (k) && (k) < hi)
#ifndef TS_A
#define TS_A -1
#define TS_B -1
#define TS_K 0.1
#endif
    unsigned long long* stamps = (unsigned long long*)(F.ws + WS_CTL + 65536);
#define STAMP(k) do { if (TS_A >= 0 && blockIdx.x == 0 && F.tid == 0) stamps[k] = __builtin_amdgcn_s_memrealtime(); } while (0)
#define REP_MASK 0
#ifndef REP_MASK
#define REP_MASK 0
#endif
#define REPS(k) for (int rep_ = 0; rep_ < 1 + ((REP_MASK >> (k)) & 1); ++rep_)
#define SEAM(k) do { if (IN(k) && IN((k) + 1)) { if ((k) == 0) grid.sync(); else xcd_barrier(bar); } } while (0)

    STAMP(0);
    if (IN(0)) REPS(0) { p0_prologue(F); }
    SEAM(0);
    STAMP(1);
    if (IN(1)) REPS(1) { norm_mod_rows(F, F.in[I_X], F.in[I_N1W], 0, DM, (bf16*)(F.ws + WS_XN)); }
    SEAM(1);
    STAMP(2);
    if (IN(2)) REPS(2) {
        pg8::Gemm g{(const pg8::bf16_t*)(F.ws + WS_XN), (const pg8::bf16_t*)(F.ws + WS_WIN), M, INPP, DM};
        pg8::StaticOrder S; S.init(M, INPP, F.G, (int)blockIdx.x);
        pg8::EpiStoreBf16 E{(pg8::bf16_t*)(F.ws + WS_PROJ), INPP};
        pg8::gemm_phase<pg8::EpiStoreBf16, pg8::StaticOrder, true, true>(F.lds, g, S, E);
    }
    SEAM(2);
#ifndef P3REP
#define P3REP 0
#endif
    STAMP(3);
    if (IN(3)) REPS(3) { p3_lora(F); STAMP(40); m1_chunk_states(F); }
    SEAM(3);
    STAMP(4);
    if (IN(4)) { m2_prefix(F); ra_part(F, 0); }
    SEAM(4);
    STAMP(5);
    if (IN(5)) { rs_half(F, 0); ra_part(F, 1); }
    SEAM(5);
    STAMP(6);
    if (IN(6)) { rs_half(F, 1); ra_part(F, 2); }
    SEAM(6);
    STAMP(7);
    if (IN(7)) { rs_half(F, 2); ra_part(F, 3); }
    SEAM(7);
    STAMP(8);
    if (IN(8)) { rs_half(F, 3); }
    STAMP(9);
    if (IN(9)) REPS(9) { m3_outputs(F); }
    SEAM(9);
    STAMP(10);
    if (IN(10)) { p5_post(F); }
    SEAM(10);
    STAMP(11);
    if (IN(11)) REPS(11) {
        pg8::Gemm g{(const pg8::bf16_t*)(F.ws + WS_OY), (const pg8::bf16_t*)(F.ws + WS_WOUT), M, DM, DM};
        pg8::StaticOrder S; S.init(M, DM, F.G, (int)blockIdx.x);
        pg8::EpiResid E{F.in[I_X], (const float*)(F.ws + WS_MOD) + 2 * DM, (pg8::bf16_t*)(F.ws + WS_HB), DM, SEQ, MODW};
        pg8::gemm_phase<pg8::EpiResid, pg8::StaticOrder, true, true>(F.lds, g, S, E);
    }
    SEAM(11);
    STAMP(12);
    if (IN(12)) REPS(12) { norm_mod_rows_bf16(F, (const bf16*)(F.ws + WS_HB), F.in[I_N2W], 3 * DM, 4 * DM, (bf16*)(F.ws + WS_XN), (unsigned*)(F.ws + WS_X8)); }
    SEAM(12);
    STAMP(13);
    if (IN(13)) REPS(13) {
        pg8::Gemm g{(const pg8::bf16_t*)(F.ws + WS_XN), (const pg8::bf16_t*)(F.ws + WS_WQ), M, DM, DM};
        pg8::StaticOrder S; S.init(M, DM, F.G, (int)blockIdx.x);
        pg8::EpiStoreBf16 E{(pg8::bf16_t*)(F.ws + WS_Q), DM};
        pg8::gemm_phase<pg8::EpiStoreBf16, pg8::StaticOrder, true, true>(F.lds, g, S, E);
    }
    SEAM(13);
    STAMP(14);
    if (IN(14)) REPS(14) { p9_route(F); }
    SEAM(14);
    STAMP(15);
    if (IN(15)) REPS(15) { p10_peer_u(F); }
    SEAM(15);
    STAMP(16);
    if (IN(16)) REPS(16) { p11_peer_coef(F); }
    SEAM(16);
    STAMP(17);
    if (IN(17)) { p12_peer_v(F); }
    SEAM(17);
    STAMP(18);
    if (IN(18)) {
        float oscale = 1.f;
        if (TS_A >= 0) { const volatile unsigned long long* st = stamps; const float frac = (float)(st[TS_B] - st[TS_A]) / (float)(st[17] - st[0]); oscale = 1.f + (float)(TS_K) * frac; }
        final_norm_rows_bf16(F, (const bf16*)(F.ws + WS_HB), F.in[I_FNW], F.out, oscale);
    }
#undef IN
#undef SEAM
}

extern "C" void kernel_launch(void* const* d_in, const int* in_sizes, int n_in, void* d_out, int out_size, void* d_ws, size_t ws_size, hipStream_t stream) {
    static int grid = 0;
    if (grid == 0) {
        if (n_in != N_IN || in_sizes[0] != M * DM || out_size != M * DM || ws_size < WS_END2) {
            fprintf(stderr, "kernel_launch: unexpected shapes: n_in %d in0 %d out %d ws %zu (need %zu)\n", n_in, n_in > 0 ? in_sizes[0] : -1, out_size, ws_size, (size_t)WS_END2); grid = -1; return; }
        int dev = 0, cus = 0, per_cu = 0;
        if (hipGetDevice(&dev) != hipSuccess || hipDeviceGetAttribute(&cus, hipDeviceAttributeMultiprocessorCount, dev) != hipSuccess) { grid = -1; return; }
        if (hipFuncSetAttribute((const void*)fwd_kernel, hipFuncAttributeMaxDynamicSharedMemorySize, LDS_BYTES) != hipSuccess) { fprintf(stderr, "kernel_launch: hipFuncSetAttribute failed\n"); grid = -1; return; }
        if (hipOccupancyMaxActiveBlocksPerMultiprocessor(&per_cu, (const void*)fwd_kernel, NTHR, LDS_BYTES) != hipSuccess || per_cu < 1) { fprintf(stderr, "kernel_launch: occupancy query says %d blocks per CU\n", per_cu); per_cu = 1; }
        (void)hipGetLastError();
        grid = cus;
        fprintf(stderr, "kernel_launch: cus %d per_cu %d grid %d ws %zu\n", cus, per_cu, grid, ws_size);
    }
    if (grid < 0) return;
    (void)hipMemsetAsync((char*)d_ws + WS_CTL, 0, CTL_ZERO_BYTES, stream);
    Args a{};
    for (int i = 0; i < N_IN; ++i) a.in[i] = (const float*)d_in[i];
    a.out = (float*)d_out; a.ws = (unsigned char*)d_ws; a.ph_lo = 0; a.ph_hi = N_PHASES;
    void* kargs[] = {&a};
#ifndef NPASS
#define NPASS 1
#endif
    hipError_t e = hipSuccess;
    for (int pass_ = 0; pass_ < NPASS; ++pass_) {
        if (pass_ > 0) (void)hipMemsetAsync((char*)d_ws + WS_CTL, 0, CTL_ZERO_BYTES, stream);
        e = hipLaunchCooperativeKernel((const void*)fwd_kernel, dim3(grid), dim3(NTHR), kargs, LDS_BYTES, stream);
    }
    if (e != hipSuccess) fprintf(stderr, "kernel_launch: cooperative launch failed: %s (grid %d)\n", hipGetErrorString(e), grid);
}
```

```cpp
#include <hip/hip_runtime.h>
#include <hip/hip_cooperative_groups.h>
#include <cstdio>
#include <cstdint>
namespace cg = cooperative_groups;
namespace pg8 {
#define PG8_LAS __attribute__((address_space(3)))
typedef unsigned short bf16_t;
typedef short bf16x8 __attribute__((ext_vector_type(8)));
typedef float f32x4 __attribute__((ext_vector_type(4)));
typedef unsigned u32x4 __attribute__((ext_vector_type(4)));
constexpr int BM = 256, BK = 64, HALF = 128, HTB = HALF * BK * 2  , STAGE_BYTES = 8 * HTB, NXCD = 8, WGM = 8;

__host__ __device__ __forceinline__ int lds_byte(int r, int c) { const int st = (r >> 4) * 2 + (c >> 5), rr = r & 15, cc = c & 31, ob = rr * 64 + cc * 2; return st * 1024 + (ob ^ (((ob >> 9) & 1) << 5)); }
__host__ __device__ __forceinline__ void stage_rc(int b, int& R, int& C) { const int st = b / 1024, sb = b % 1024, swz = sb ^ (((sb >> 9) & 1) << 5); R = (st >> 1) * 16 + swz / 64; C = (st & 1) * 32 + (swz % 64) / 2; }
__host__ __device__ __forceinline__ int perm32(int rho) { const int n = rho >> 4, i = rho & 15; return 8 * (i >> 2) + 4 * n + (i & 3); }

struct Unit { int pm, pn; };
struct Gemm { const bf16_t* A; const bf16_t* Bt; int M, N, K; };

struct StaticOrder {
    int nM, nN, nwg, G, c;
    __host__ __device__ void init(int M, int N, int G_, int c_) { nM = M / BM; nN = N / BM; nwg = nM * nN; G = G_; c = c_; }
    __host__ __device__ bool next(int i, Unit& u) const {
        const long L = (long)i * G + c; if (L >= nwg) return false;
        int wgid = (int)L; { const int q = nwg / NXCD, r = nwg % NXCD, xcd = wgid % NXCD, off = wgid / NXCD; wgid = (xcd < r ? xcd * (q + 1) : r * (q + 1) + (xcd - r) * q) + off; }
        const int nig = WGM * nN, gid = wgid / nig, fm = gid * WGM, gsz = (nM - fm) < WGM ? (nM - fm) : WGM;
        u.pm = fm + ((wgid % nig) % gsz); u.pn = (wgid % nig) / gsz; return true;
    }
    __device__ __forceinline__ void a_ready(const Unit&) const {}
    __device__ __forceinline__ void done(const Unit&) const {}
};
__device__ __forceinline__ unsigned cvt_pk_bf16(float lo, float hi) { unsigned r; asm volatile("v_cvt_pk_bf16_f32 %0, %1, %2" : "=v"(r) : "v"(lo), "v"(hi)); return r; }
struct EpiStoreBf16 {
    static constexpr bool PERM = true, AFTER_DRAIN = false;
    bf16_t* O; int ldc;
    __device__ __forceinline__ void operator()(const f32x4 (&acc)[2][2][4][2], const Unit& u, int wr, int wc, int fr, int fq) const {
        const int row0 = u.pm * BM + wr * 64 + fr; const int col0 = u.pn * BM + wc * 32 + 8 * fq;
#pragma unroll
        for (int ai = 0; ai < 2; ++ai)
#pragma unroll
            for (int m = 0; m < 4; ++m) { bf16_t* rowp = O + (size_t)(row0 + ai * HALF + m * 16) * ldc + col0;
#pragma unroll
                for (int bj = 0; bj < 2; ++bj) { const f32x4 v0 = acc[ai][bj][m][0], v1 = acc[ai][bj][m][1];
                    u32x4 w; w.x = cvt_pk_bf16(v0[0], v0[1]); w.y = cvt_pk_bf16(v0[2], v0[3]); w.z = cvt_pk_bf16(v1[0], v1[1]); w.w = cvt_pk_bf16(v1[2], v1[3]);
                    *(u32x4*)(rowp + bj * HALF) = w; } }
    }
};
struct EpiResid {
    static constexpr bool PERM = true, AFTER_DRAIN = false;
    const float* X; const float* gate; bf16_t* O; int ldc; int rows_per_batch; int gstride;
    __device__ __forceinline__ void operator()(const f32x4 (&acc)[2][2][4][2], const Unit& u, int wr, int wc, int fr, int fq) const {
        const int row0 = u.pm * BM + wr * 64 + fr; const int col0 = u.pn * BM + wc * 32 + 8 * fq;
        const float* g = gate + (size_t)((u.pm * BM) / rows_per_batch) * gstride + col0;
        f32x4 gv[2][2];
#pragma unroll
        for (int bj = 0; bj < 2; ++bj)
#pragma unroll
            for (int n = 0; n < 2; ++n) gv[bj][n] = *(const f32x4*)(g + bj * HALF + 4 * n);
#pragma unroll
        for (int ai = 0; ai < 2; ++ai) {
            f32x4 xv[4][2][2];
#pragma unroll
            for (int m = 0; m < 4; ++m) { const size_t off = (size_t)(row0 + ai * HALF + m * 16) * ldc + col0;
#pragma unroll
                for (int bj = 0; bj < 2; ++bj) { xv[m][bj][0] = *(const f32x4*)(X + off + bj * HALF); xv[m][bj][1] = *(const f32x4*)(X + off + bj * HALF + 4); } }
            asm volatile("" ::: "memory");
#pragma unroll
            for (int m = 0; m < 4; ++m) { const size_t off = (size_t)(row0 + ai * HALF + m * 16) * ldc + col0;
#pragma unroll
                for (int bj = 0; bj < 2; ++bj) {
                    const f32x4 v0 = xv[m][bj][0] + gv[bj][0] * acc[ai][bj][m][0], v1 = xv[m][bj][1] + gv[bj][1] * acc[ai][bj][m][1];
                    u32x4 w; w.x = cvt_pk_bf16(v0[0], v0[1]); w.y = cvt_pk_bf16(v0[2], v0[3]); w.z = cvt_pk_bf16(v1[0], v1[1]); w.w = cvt_pk_bf16(v1[2], v1[3]);
                    *(u32x4*)(O + off + bj * HALF) = w; } }
        }
    }
};
template <class Epi, class Sched, bool ALIGN_EPI = false, bool SP2 = false>
__device__ __forceinline__ void gemm_phase(PG8_LAS unsigned char* lds, const Gemm g, const Sched& S, const Epi& E) {
    const int tid = threadIdx.x, wid = __builtin_amdgcn_readfirstlane(tid >> 6), lane = tid & 63, wr = wid >> 2, wc = wid & 3, fr = lane & 15, fq = lane >> 4;
    const int K = g.K, nt = K / BK;
    unsigned voffA[2], voffB[2];
#pragma unroll
    for (int i = 0; i < 2; ++i) { int R, C; stage_rc(tid * 16 + i * 8192, R, C); const int Rb = Epi::PERM ? ((R & ~31) + perm32(R & 31)) : R;
        voffA[i] = (unsigned)(R * K + C) * 2u; voffB[i] = (unsigned)(Rb * K + C) * 2u; }
    const size_t kstep = (size_t)(BK * 2);
    const size_t hstep = (size_t)HALF * K * 2;
    const size_t tstep = 2 * hstep;
    const unsigned ldsw = (unsigned)wid * 1024u;
    const int aoff = lds_byte(wr * 64 + fr, fq * 8), boff = lds_byte(wc * 32 + fr, fq * 8);
#define PG8_SA(b, h) (((b) * 2 + (h)) * HTB)
#define PG8_SB(b, h) ((4 + (b) * 2 + (h)) * HTB)
#define PG8_STAGE(bufoff, gbase, voff) do { _Pragma("unroll") for (int _i = 0; _i < 2; ++_i) \
        __builtin_amdgcn_global_load_lds((const unsigned*)((const char*)(gbase) + (voff)[_i]), (PG8_LAS unsigned*)(lds + (bufoff) + ldsw + _i * 8192), 16, 0, 0); } while (0)
#define PG8_LDA(dst, b, h) do { _Pragma("unroll") for (int m = 0; m < 4; ++m) _Pragma("unroll") for (int k = 0; k < 2; ++k) dst[m][k] = *(const PG8_LAS bf16x8*)(lds + PG8_SA(b, h) + aoff + m * 2048 + k * 1024); } while (0)
#define PG8_LDB(dst, b, h) do { _Pragma("unroll") for (int n = 0; n < 2; ++n) _Pragma("unroll") for (int k = 0; k < 2; ++k) dst[n][k] = *(const PG8_LAS bf16x8*)(lds + PG8_SB(b, h) + boff + n * 2048 + k * 1024); } while (0)
#define PG8_MMA(ai, bj, At, Bt) do { __builtin_amdgcn_s_setprio(1); _Pragma("unroll") for (int m = 0; m < 4; ++m) _Pragma("unroll") for (int n = 0; n < 2; ++n) _Pragma("unroll") for (int k = 0; k < 2; ++k) \
        acc[ai][bj][m][n] = __builtin_amdgcn_mfma_f32_16x16x32_bf16(Bt[n][k], At[m][k], acc[ai][bj][m][n], 0, 0, 0); __builtin_amdgcn_s_setprio(0); } while (0)
#define PG8_WAIT_V(n) asm volatile("s_waitcnt vmcnt(" #n ")" ::: "memory")
#define PG8_WAIT_L(n) asm volatile("s_waitcnt lgkmcnt(" #n ")" ::: "memory")
#define PG8_BAR __builtin_amdgcn_s_barrier()
#define PG8_SCHED __builtin_amdgcn_sched_barrier(0)
    Unit cur, nxt; int ui = 0;
    if (!S.next(0, cur)) return;
    f32x4 acc[2][2][4][2];
#pragma unroll
    for (int a = 0; a < 2; ++a)
#pragma unroll
        for (int b = 0; b < 2; ++b)
#pragma unroll
            for (int m = 0; m < 4; ++m)
#pragma unroll
                for (int n = 0; n < 2; ++n) acc[a][b][m][n] = (f32x4){0.f, 0.f, 0.f, 0.f};
    bf16x8 At[4][2], B0[2][2], B1[2][2];
    const char* cA = (const char*)g.A + (size_t)cur.pm * tstep; const char* cB = (const char*)g.Bt + (size_t)cur.pn * tstep;
    S.a_ready(cur);
    if constexpr (SP2) {
        PG8_STAGE(PG8_SB(0, 0), cB, voffB); PG8_STAGE(PG8_SB(0, 1), cB + hstep, voffB); PG8_STAGE(PG8_SA(0, 0), cA, voffA); PG8_STAGE(PG8_SA(0, 1), cA + hstep, voffA);
        if (wr == 1) PG8_BAR;
        PG8_WAIT_V(2); PG8_BAR;
        PG8_STAGE(PG8_SB(1, 0), cB + kstep, voffB); PG8_STAGE(PG8_SA(1, 0), cA + kstep, voffA); PG8_STAGE(PG8_SB(1, 1), cB + hstep + kstep, voffB);
        PG8_WAIT_V(6); PG8_BAR;
    } else {
        PG8_STAGE(PG8_SB(0, 0), cB, voffB); PG8_STAGE(PG8_SA(0, 0), cA, voffA); PG8_STAGE(PG8_SB(0, 1), cB + hstep, voffB); PG8_STAGE(PG8_SA(0, 1), cA + hstep, voffA);
        if (wr == 1) PG8_BAR;
        PG8_WAIT_V(4); PG8_BAR;
        PG8_STAGE(PG8_SB(1, 0), cB + kstep, voffB); PG8_STAGE(PG8_SA(1, 0), cA + kstep, voffA); PG8_STAGE(PG8_SB(1, 1), cB + hstep + kstep, voffB);
        PG8_WAIT_V(6); PG8_BAR;
    }
    for (;;) {
        const bool has_next = S.next(ui + 1, nxt);
        const char* nA = has_next ? (const char*)g.A + (size_t)nxt.pm * tstep : cA; const char* nB = has_next ? (const char*)g.Bt + (size_t)nxt.pn * tstep : cB;
        for (int t = 0; t < nt; t += 2) {
            const bool last = (t == nt - 2);
            const char* a1 = cA + (size_t)(t + 1) * kstep;
            const char* a2 = last ? nA : cA + (size_t)(t + 2) * kstep; const char* b2 = last ? nB : cB + (size_t)(t + 2) * kstep;
            const char* a3 = a2 + kstep; const char* b3 = b2 + kstep;
            if (last && has_next) S.a_ready(nxt);
            if constexpr (SP2) {
            PG8_LDB(B0, 0, 0); PG8_LDB(B1, 0, 1); PG8_SCHED; PG8_LDA(At, 0, 0); PG8_STAGE(PG8_SA(1, 1), a1 + hstep, voffA);
            PG8_WAIT_V(8); PG8_WAIT_L(0); PG8_BAR; PG8_MMA(0, 0, At, B0); PG8_MMA(0, 1, At, B1); PG8_BAR; PG8_SCHED;
            PG8_LDA(At, 0, 1); PG8_STAGE(PG8_SB(0, 0), b2, voffB); PG8_STAGE(PG8_SB(0, 1), b2 + hstep, voffB); PG8_STAGE(PG8_SA(0, 0), a2, voffA);
            PG8_WAIT_V(8); PG8_WAIT_L(0); PG8_BAR; PG8_MMA(1, 0, At, B0); PG8_MMA(1, 1, At, B1); PG8_BAR; PG8_SCHED;
            PG8_LDB(B0, 1, 0); PG8_LDB(B1, 1, 1); PG8_SCHED; PG8_LDA(At, 1, 0); PG8_STAGE(PG8_SA(0, 1), a2 + hstep, voffA);
            PG8_WAIT_V(8); PG8_WAIT_L(0); PG8_BAR; PG8_MMA(0, 0, At, B0); PG8_MMA(0, 1, At, B1); PG8_BAR; PG8_SCHED;
            PG8_LDA(At, 1, 1); PG8_STAGE(PG8_SB(1, 0), b3, voffB); PG8_STAGE(PG8_SB(1, 1), b3 + hstep, voffB); PG8_STAGE(PG8_SA(1, 0), a3, voffA);
            PG8_WAIT_V(8); PG8_WAIT_L(0); PG8_BAR; PG8_MMA(1, 0, At, B0); PG8_MMA(1, 1, At, B1); PG8_BAR; PG8_SCHED;
            } else {
            PG8_LDB(B0, 0, 0); PG8_SCHED; PG8_LDA(At, 0, 0); PG8_STAGE(PG8_SA(1, 1), a1 + hstep, voffA);
            PG8_WAIT_L(8); PG8_BAR; PG8_WAIT_L(0); PG8_MMA(0, 0, At, B0); PG8_BAR; PG8_SCHED;
            PG8_LDB(B1, 0, 1); PG8_STAGE(PG8_SB(0, 0), b2, voffB);
            PG8_BAR; PG8_WAIT_L(0); PG8_MMA(0, 1, At, B1); PG8_BAR;
            PG8_LDA(At, 0, 1); PG8_STAGE(PG8_SA(0, 0), a2, voffA);
            PG8_BAR; PG8_WAIT_L(0); PG8_MMA(1, 0, At, B0); PG8_BAR; PG8_SCHED;
            PG8_STAGE(PG8_SB(0, 1), b2 + hstep, voffB);
            PG8_WAIT_V(6); PG8_BAR; PG8_MMA(1, 1, At, B1); PG8_BAR;
            PG8_LDB(B0, 1, 0); PG8_SCHED; PG8_LDA(At, 1, 0); PG8_STAGE(PG8_SA(0, 1), a2 + hstep, voffA);
            PG8_WAIT_L(8); PG8_BAR; PG8_WAIT_L(0); PG8_MMA(0, 0, At, B0); PG8_BAR; PG8_SCHED;
            PG8_LDB(B1, 1, 1); PG8_STAGE(PG8_SB(1, 0), b3, voffB);
            PG8_BAR; PG8_WAIT_L(0); PG8_MMA(0, 1, At, B1); PG8_BAR;
            PG8_LDA(At, 1, 1); PG8_STAGE(PG8_SA(1, 0), a3, voffA);
            PG8_BAR; PG8_WAIT_L(0); PG8_MMA(1, 0, At, B0); PG8_BAR; PG8_SCHED;
            PG8_STAGE(PG8_SB(1, 1), b3 + hstep, voffB);
            PG8_WAIT_V(6); PG8_BAR; PG8_MMA(1, 1, At, B1); PG8_BAR;
            }
        }
        if constexpr (ALIGN_EPI) { if (wr == 0) PG8_BAR; }
        if constexpr (!Epi::AFTER_DRAIN) { E(acc, cur, wr, wc, fr, fq); S.done(cur); }
        if (!has_next) break;
#pragma unroll
        for (int a = 0; a < 2; ++a)
#pragma unroll
            for (int b = 0; b < 2; ++b)
#pragma unroll
                for (int m = 0; m < 4; ++m)
#pragma unroll
                    for (int n = 0; n < 2; ++n) acc[a][b][m][n] = (f32x4){0.f, 0.f, 0.f, 0.f};
        cur = nxt; cA = nA; cB = nB; ++ui;
        if constexpr (ALIGN_EPI) { if (wr == 1) PG8_BAR; }
    }
    PG8_WAIT_V(0);
    if constexpr (!ALIGN_EPI) { if (wr == 0) PG8_BAR; }
    PG8_BAR;
    if constexpr (Epi::AFTER_DRAIN) { E.fused(acc, cur, wr, wc, fr, fq, lds, wid, lane); S.done(cur); }
#undef PG8_SA
#undef PG8_SB
#undef PG8_STAGE
#undef PG8_LDA
#undef PG8_LDB
#undef PG8_MMA
#undef PG8_WAIT_V
#undef PG8_WAIT_L
#undef PG8_BAR
#undef PG8_SCHED
}
}
#define GAS __attribute__((address_space(1)))
#define LAS __attribute__((address_space(3)))
typedef unsigned short bf16;
typedef unsigned v4u __attribute__((ext_vector_type(4)));
typedef unsigned v2u __attribute__((ext_vector_type(2)));
typedef float f32x4 __attribute__((ext_vector_type(4)));
typedef float f32x2 __attribute__((ext_vector_type(2)));
typedef short bf16x8 __attribute__((ext_vector_type(8)));
typedef __bf16 bf16x2_t __attribute__((ext_vector_type(2)));

constexpr int NWAVES = 8, NTHR = 512;
constexpr int DM = 2048, NB = 4, SEQ = 8192, M = NB * SEQ;
constexpr int RW = 1024, RHEADS = 16, HD = 64;
constexpr int L_W = 64, L_A = 64, L_G = 160;
constexpr int INP = 5936, INPP = 6144;
constexpr int C_R = 0, C_K = 1024, C_V = 2048, C_WD = 3072, C_AD = 3136, C_GD = 3200, C_Z = 3360, C_XBC = 4384, C_DT = 5920;
constexpr int MODW = 6 * DM;
constexpr int NEXP = 16384;
constexpr float RMS_EPS = 1e-6f;

enum { I_X = 0, I_C, I_ADAW, I_ADAB, I_N1W, I_WIN, I_MU, I_W0, I_WUP, I_A0, I_AUP, I_GUP, I_KK, I_KA, I_RK, I_LNW, I_LNB,
       I_CONVW, I_CONVB, I_DTB, I_ALOG, I_DSK, I_MNW, I_WOUT, I_N2W, I_WQ, I_KEYS, I_PU, I_PV, I_FNW, N_IN };

constexpr size_t MiB = 1u << 20;
constexpr size_t WS_CTL = 0, CTL_ZERO_BYTES = 1 * MiB;
constexpr size_t WS_MOD = 1 * MiB;
constexpr size_t WS_WIN = 2 * MiB, WS_WOUT = 26 * MiB, WS_WQ = 34 * MiB, WS_KEYS = 42 * MiB;
constexpr size_t WS_WUPT = 43 * MiB, WS_AUPT = 43 * MiB + 256 * 1024, WS_GUPT = 43 * MiB + 512 * 1024;
constexpr size_t WS_PU8 = 44 * MiB, WS_PV8 = 76 * MiB;
constexpr size_t WS_USC = 108 * MiB, WS_VSC = 108 * MiB + 65536;
constexpr size_t WS_XN = 172 * MiB;
constexpr size_t WS_LW = WS_XN, WS_AA = WS_XN + 64 * MiB;
constexpr size_t WS_PROJ = 300 * MiB;
constexpr size_t WS_Q = WS_PROJ;
constexpr size_t WS_GG = 684 * MiB;
constexpr size_t WS_X8 = WS_PROJ + 192 * MiB;
constexpr size_t WS_PD = WS_PROJ + 128 * MiB;
constexpr size_t WS_RTE = 684 * MiB, WS_RTG = 700 * MiB, WS_COEF = 716 * MiB;
constexpr size_t WS_OY = 748 * MiB;
constexpr size_t WS_END = 876 * MiB;
constexpr size_t WS_HB = 876 * MiB;

constexpr int RING_BYTES = 131072, LDS_BYTES = 147456;

#define LDS_WAIT() asm volatile("s_waitcnt lgkmcnt(0)" ::: "memory")
#define VM_WAIT() asm volatile("s_waitcnt vmcnt(0)" ::: "memory")
__device__ __forceinline__ unsigned pk2(float lo, float hi) { f32x2 v = {lo, hi}; bf16x2_t b = __builtin_convertvector(v, bf16x2_t); return __builtin_bit_cast(unsigned, b); }
__device__ __forceinline__ float bflo(unsigned u) { return __uint_as_float(u << 16); }
__device__ __forceinline__ float bfhi(unsigned u) { return __uint_as_float(u & 0xffff0000u); }
__device__ __forceinline__ float bf1(bf16 h) { return __uint_as_float((unsigned)h << 16); }
__device__ __forceinline__ float wave_sum(float v) {
#pragma unroll
    for (int o = 1; o < 64; o <<= 1) v += __shfl_xor(v, o);
    return v;
}
__device__ __forceinline__ float rcp_f(float v) { return __builtin_amdgcn_rcpf(v); }
template <int CTRL> __device__ __forceinline__ float dppc_f(float x) { return __builtin_bit_cast(float, __builtin_amdgcn_mov_dpp(__builtin_bit_cast(int, x), CTRL, 0xf, 0xf, true)); }
__device__ __forceinline__ float wave_sum_fast(float x) {
    x += dppc_f<0xB1>(x); x += dppc_f<0x4E>(x); x += dppc_f<0x124>(x); x += dppc_f<0x128>(x);
    { auto rr = __builtin_amdgcn_permlane16_swap(__float_as_uint(x), __float_as_uint(x), false, false); x = __uint_as_float(rr[0]) + __uint_as_float(rr[1]); }
    { auto rr = __builtin_amdgcn_permlane32_swap(__float_as_uint(x), __float_as_uint(x), false, false); x = __uint_as_float(rr[0]) + __uint_as_float(rr[1]); }
    return x;
}
__device__ __forceinline__ float silu_f(float v) { return v * rcp_f(1.f + __expf(-v)); }
__device__ __forceinline__ float sigmoid_f(float v) { return rcp_f(1.f + __expf(-v)); }

struct Ctx {
    LAS unsigned char* lds;
    int tid, lane, wave, G, gw, NGW;
    const float* const* in;
    float* out; unsigned char* ws;
};

__device__ __forceinline__ void transpose_item(const float* W, int K, int N, bf16* WT, int ldt, int nrows_out, LAS float* scr, int kb, int nb, int lane) {
    const int k0 = 64 * kb, n0 = 64 * nb;
    const int c4 = 4 * (lane & 15), rr = lane >> 4;
    const bool vec_ok = ((N & 3) == 0) && (n0 + 64 <= N);
#pragma unroll 4
    for (int i = 0; i < 16; ++i) { const int kk = 4 * i + rr, k = k0 + kk;
        f32x4 v = {0.f, 0.f, 0.f, 0.f};
        if (k < K) { const float* src = W + (size_t)k * N + n0 + c4;
            if (vec_ok) v = *(const f32x4*)src;
            else { if (n0 + c4 + 0 < N) v.x = src[0]; if (n0 + c4 + 1 < N) v.y = src[1]; if (n0 + c4 + 2 < N) v.z = src[2]; if (n0 + c4 + 3 < N) v.w = src[3]; } }
        LAS float* d = scr + kk * 65 + c4; d[0] = v.x; d[1] = v.y; d[2] = v.z; d[3] = v.w; }
    LDS_WAIT(); asm volatile("" ::: "memory");
    const int c = lane & 7;
#pragma unroll
    for (int j = 0; j < 8; ++j) { const int n = (lane >> 3) + 8 * j; const LAS float* sp = scr + (8 * c) * 65 + n;
        v4u o; o.x = pk2(sp[0 * 65], sp[1 * 65]); o.y = pk2(sp[2 * 65], sp[3 * 65]); o.z = pk2(sp[4 * 65], sp[5 * 65]); o.w = pk2(sp[6 * 65], sp[7 * 65]);
        if (n0 + n < nrows_out && k0 + 8 * c + 8 <= ldt) *(v4u*)(WT + (size_t)(n0 + n) * ldt + k0 + 8 * c) = o; }
    LDS_WAIT(); asm volatile("" ::: "memory");
}
__device__ __forceinline__ void transpose_all(const float* W, int K, int N, bf16* WT, int ldt, int nrows_out, LAS float* scr, int gw, int NGW, int lane) {
    const int nkb = (K + 63) / 64, nnb = nrows_out / 64, nit = nkb * nnb;
    for (int it = gw; it < nit; it += NGW) transpose_item(W, K, N, WT, ldt, nrows_out, scr, it / nnb, it % nnb, lane);
}
__device__ __forceinline__ void convert_all(const float* src, bf16* dst, size_t n8, int gw, int NGW, int lane) {
    const f32x4* s4 = (const f32x4*)src; v4u* d4 = (v4u*)dst;
    for (size_t i = (size_t)gw * 64 + lane; i < n8; i += (size_t)NGW * 64) {
        const f32x4 a = __builtin_nontemporal_load(s4 + 2 * i), b = __builtin_nontemporal_load(s4 + 2 * i + 1);
        v4u o; o.x = pk2(a.x, a.y); o.y = pk2(a.z, a.w); o.z = pk2(b.x, b.y); o.w = pk2(b.z, b.w);
        d4[i] = o; }
}
__device__ __forceinline__ void quantize_rows_fp8(const float* src, unsigned char* dst8, float* scales, int e0, int e1, int step, int lane) {
    if (e0 >= e1) return;
    f32x4 vn[8];
    { const f32x4* s4 = (const f32x4*)(src + (size_t)e0 * DM) + lane;
#pragma unroll
      for (int i = 0; i < 8; ++i) vn[i] = __builtin_nontemporal_load(s4 + 64 * i); }
    for (int e = e0; e < e1; e += step) {
        f32x4 v[8];
#pragma unroll
        for (int i = 0; i < 8; ++i) v[i] = vn[i];
        { const int en = (e + step < e1) ? e + step : e; const f32x4* s4 = (const f32x4*)(src + (size_t)en * DM) + lane;
#pragma unroll
          for (int i = 0; i < 8; ++i) vn[i] = __builtin_nontemporal_load(s4 + 64 * i); }
        float am = 0.f;
#pragma unroll
        for (int i = 0; i < 8; ++i) am = fmaxf(fmaxf(am, fmaxf(fabsf(v[i].x), fabsf(v[i].y))), fmaxf(fabsf(v[i].z), fabsf(v[i].w)));
#pragma unroll
        for (int o = 1; o < 64; o <<= 1) am = fmaxf(am, __shfl_xor(am, o));
        am = fmaxf(am, 1e-30f);
        const float inv = 440.f / am;
#pragma unroll
        for (int i = 0; i < 8; ++i) { int w = __builtin_amdgcn_cvt_pk_fp8_f32(v[i].x * inv, v[i].y * inv, 0, false); w = __builtin_amdgcn_cvt_pk_fp8_f32(v[i].z * inv, v[i].w * inv, w, true);
            const int seg = 2 * i + (lane >> 5);
            *(int*)(dst8 + (size_t)seg * ((size_t)NEXP * 128) + (size_t)e * 128 + 4 * (lane & 31)) = w; }
        if (lane == 0) scales[e] = am * (1.f / 440.f);
    }
}
__device__ __forceinline__ void quantize_rows_fp4(const float* src, unsigned char* dst4, float* scales, int e0, int e1, int step, int lane) {
    if (e0 >= e1) return;
    f32x4 vn[8];
    { const f32x4* s4 = (const f32x4*)(src + (size_t)e0 * DM) + lane;
#pragma unroll
      for (int i = 0; i < 8; ++i) vn[i] = __builtin_nontemporal_load(s4 + 64 * i); }
    for (int e = e0; e < e1; e += step) {
        f32x4 v[8];
#pragma unroll
        for (int i = 0; i < 8; ++i) v[i] = vn[i];
        { const int en = (e + step < e1) ? e + step : e; const f32x4* s4 = (const f32x4*)(src + (size_t)en * DM) + lane;
#pragma unroll
          for (int i = 0; i < 8; ++i) vn[i] = __builtin_nontemporal_load(s4 + 64 * i); }
        float am = 0.f;
#pragma unroll
        for (int i = 0; i < 8; ++i) am = fmaxf(am, fmaxf(fmaxf(fabsf(v[i].x), fabsf(v[i].y)), fmaxf(fabsf(v[i].z), fabsf(v[i].w))));
#pragma unroll
        for (int o = 1; o < 64; o <<= 1) am = fmaxf(am, __shfl_xor(am, o));
        am = fmaxf(am, 1e-30f);
        const float inv = 6.f / am;
#pragma unroll
        for (int i = 0; i < 8; ++i) {
            unsigned w = __builtin_amdgcn_cvt_scalef32_pk_fp4_f32(0u, v[i].x * inv, v[i].y * inv, 1.0f, 0);
            w = __builtin_amdgcn_cvt_scalef32_pk_fp4_f32(w, v[i].z * inv, v[i].w * inv, 1.0f, 1);
            *(unsigned short*)(dst4 + (size_t)i * ((size_t)NEXP * 128) + (size_t)e * 128 + 2 * lane) = (unsigned short)w;
        }
        if (lane == 0) scales[e] = am * (1.f / 6.f);
    }
}
__device__ __forceinline__ void p0_prologue(const Ctx& F) {
    __syncthreads();
    if (blockIdx.x < MODW / 64) {
        LAS float* sc = (LAS float*)F.lds;
        LAS float* red = sc + NB * DM;
        const float* c = F.in[I_C];
        for (int i = F.tid; i < NB * DM; i += NTHR) sc[i] = silu_f(c[i]);
        __syncthreads();
        const int j = blockIdx.x * 64 + F.lane;
        const float* wp = F.in[I_ADAW] + (size_t)(F.wave * 256) * MODW + j;
        float a0 = 0.f, a1 = 0.f, a2 = 0.f, a3 = 0.f;
#pragma unroll 32
        for (int kk = 0; kk < 256; ++kk) { const float w = wp[(size_t)kk * MODW]; const int k = F.wave * 256 + kk;
            a0 += sc[k] * w; a1 += sc[DM + k] * w; a2 += sc[2 * DM + k] * w; a3 += sc[3 * DM + k] * w; }
        red[(F.wave * 4 + 0) * 64 + F.lane] = a0; red[(F.wave * 4 + 1) * 64 + F.lane] = a1; red[(F.wave * 4 + 2) * 64 + F.lane] = a2; red[(F.wave * 4 + 3) * 64 + F.lane] = a3;
        __syncthreads();
        if (F.tid < 256) { const int b = F.tid >> 6, l = F.tid & 63; float s = F.in[I_ADAB][blockIdx.x * 64 + l];
#pragma unroll
            for (int w = 0; w < 8; ++w) s += red[(w * 4 + b) * 64 + l];
            ((float*)(F.ws + WS_MOD))[b * MODW + blockIdx.x * 64 + l] = s; }
        __syncthreads();
    }
    LAS float* scr = (LAS float*)(F.lds + F.wave * 16640);
    transpose_all(F.in[I_WIN], DM, INP, (bf16*)(F.ws + WS_WIN), DM, INPP, scr, F.gw, F.NGW, F.lane);
    transpose_all(F.in[I_WOUT], DM, DM, (bf16*)(F.ws + WS_WOUT), DM, DM, scr, F.gw, F.NGW, F.lane);
    transpose_all(F.in[I_WQ], DM, DM, (bf16*)(F.ws + WS_WQ), DM, DM, scr, F.gw, F.NGW, F.lane);
    transpose_all(F.in[I_WUP], L_W, RW, (bf16*)(F.ws + WS_WUPT), L_W, RW, scr, F.gw, F.NGW, F.lane);
    transpose_all(F.in[I_AUP], L_A, RW, (bf16*)(F.ws + WS_AUPT), L_A, RW, scr, F.gw, F.NGW, F.lane);
    transpose_all(F.in[I_GUP], L_G, RW, (bf16*)(F.ws + WS_GUPT), L_G, RW, scr, F.gw, F.NGW, F.lane);
    convert_all(F.in[I_KEYS], (bf16*)(F.ws + WS_KEYS), (size_t)16 * 128 * 128 / 8, F.gw, F.NGW, F.lane);
    {
        const int nlo = (F.G < 192) ? F.G : 192, nhi = F.G - nlo;
        const int wtot = 5 * nlo + 8 * nhi;
        const int wb0 = (blockIdx.x < nlo) ? 5 * blockIdx.x : 5 * nlo + 8 * (blockIdx.x - nlo), wb1 = wb0 + ((blockIdx.x < nlo) ? 5 : 8);
        const int r0 = (int)((long)(2 * NEXP) * wb0 / wtot), r1 = (int)((long)(2 * NEXP) * wb1 / wtot);
        const int a0 = r0 < NEXP ? r0 : NEXP, a1 = r1 < NEXP ? r1 : NEXP;
        quantize_rows_fp4(F.in[I_PU], F.ws + WS_PU8, (float*)(F.ws + WS_USC), a0 + F.wave, a1, NWAVES, F.lane);
        const int b0 = (r0 > NEXP ? r0 : NEXP) - NEXP, b1 = (r1 > NEXP ? r1 : NEXP) - NEXP;
        quantize_rows_fp4(F.in[I_PV], F.ws + WS_PV8, (float*)(F.ws + WS_VSC), b0 + F.wave, b1, NWAVES, F.lane);
    }
}

__device__ __forceinline__ void norm_mod_rows(const Ctx& F, const float* X, const float* nw, int shift_off, int scale_off, bf16* XN) {
    const float* mod = (const float*)(F.ws + WS_MOD);
    if (F.gw >= M) return;
    f32x4 vn[8];
    { const f32x4* xr = (const f32x4*)(X + (size_t)F.gw * DM) + F.lane;
#pragma unroll
      for (int j = 0; j < 8; ++j) vn[j] = xr[64 * j]; }
    for (int m = F.gw; m < M; m += F.NGW) {
        const int b = m / SEQ;
        f32x4 v[8]; float s = 0.f;
#pragma unroll
        for (int j = 0; j < 8; ++j) { v[j] = vn[j]; s += (v[j].x * v[j].x + v[j].y * v[j].y) + (v[j].z * v[j].z + v[j].w * v[j].w); }
        { const int mn = (m + F.NGW < M) ? m + F.NGW : m; const f32x4* xr = (const f32x4*)(X + (size_t)mn * DM) + F.lane;
#pragma unroll
          for (int j = 0; j < 8; ++j) vn[j] = xr[64 * j]; }
        const float rstd = rsqrtf(wave_sum_fast(s) * (1.f / DM) + RMS_EPS);
        const f32x4* wp = (const f32x4*)nw + F.lane;
        const f32x4* shp = (const f32x4*)(mod + (size_t)b * MODW + shift_off) + F.lane;
        const f32x4* scp = (const f32x4*)(mod + (size_t)b * MODW + scale_off) + F.lane;
        v2u* o = (v2u*)(XN + (size_t)m * DM) + F.lane;
        f32x4 wv[8], av[8], cv[8];
#pragma unroll
        for (int j = 0; j < 8; ++j) { wv[j] = wp[64 * j]; av[j] = scp[64 * j]; cv[j] = shp[64 * j]; }
        asm volatile("" ::: "memory");
#pragma unroll
        for (int j = 0; j < 8; ++j) {
            const f32x4 r = (v[j] * rstd) * wv[j] * (av[j] + 1.f) + cv[j];
            v2u p; p.x = pk2(r.x, r.y); p.y = pk2(r.z, r.w); o[64 * j] = p; }
    }
}
__device__ __forceinline__ void final_norm_rows(const Ctx& F, const float* H, const float* nw, float* O) {
    for (int m = F.gw; m < M; m += F.NGW) {
        const f32x4* xr = (const f32x4*)(H + (size_t)m * DM) + F.lane;
        f32x4 v[8]; float s = 0.f;
#pragma unroll
        for (int j = 0; j < 8; ++j) { v[j] = xr[64 * j]; s += (v[j].x * v[j].x + v[j].y * v[j].y) + (v[j].z * v[j].z + v[j].w * v[j].w); }
        const float rstd = rsqrtf(wave_sum(s) * (1.f / DM) + RMS_EPS);
        const f32x4* wp = (const f32x4*)nw + F.lane;
        f32x4* o = (f32x4*)(O + (size_t)m * DM) + F.lane;
#pragma unroll
        for (int j = 0; j < 8; ++j) o[64 * j] = (v[j] * rstd) * wp[64 * j];
    }
}


__device__ __forceinline__ void load_row_raw(const bf16* row, int lane, v2u (&u)[8]) {
    const v2u* p = (const v2u*)row + lane;
#pragma unroll
    for (int j = 0; j < 8; ++j) u[j] = p[64 * j];
}
__device__ __forceinline__ void norm_mod_rows_bf16(const Ctx& F, const bf16* X, const float* nw, int shift_off, int scale_off, bf16* XN, unsigned* X8 = nullptr) {
    const float* mod = (const float*)(F.ws + WS_MOD);
    if (F.gw >= M) return;
    v2u un[8]; load_row_raw(X + (size_t)F.gw * DM, F.lane, un);
    for (int m = F.gw; m < M; m += F.NGW) {
        const int b = m / SEQ;
        f32x4 v[8]; float s = 0.f;
#pragma unroll
        for (int j = 0; j < 8; ++j) { v[j] = (f32x4){bflo(un[j].x), bfhi(un[j].x), bflo(un[j].y), bfhi(un[j].y)}; s += (v[j].x * v[j].x + v[j].y * v[j].y) + (v[j].z * v[j].z + v[j].w * v[j].w); }
        { const int mn = (m + F.NGW < M) ? m + F.NGW : m; load_row_raw(X + (size_t)mn * DM, F.lane, un); }
        const float rstd = rsqrtf(wave_sum_fast(s) * (1.f / DM) + RMS_EPS);
        const f32x4* wp = (const f32x4*)nw + F.lane;
        const f32x4* shp = (const f32x4*)(mod + (size_t)b * MODW + shift_off) + F.lane;
        const f32x4* scp = (const f32x4*)(mod + (size_t)b * MODW + scale_off) + F.lane;
        v2u* o = (v2u*)(XN + (size_t)m * DM) + F.lane;
        f32x4 wv[8], av[8], cv[8];
#pragma unroll
        for (int j = 0; j < 8; ++j) { wv[j] = wp[64 * j]; av[j] = scp[64 * j]; cv[j] = shp[64 * j]; }
        asm volatile("" ::: "memory");
#pragma unroll
        for (int j = 0; j < 8; ++j) {
            const f32x4 r = (v[j] * rstd) * wv[j] * (av[j] + 1.f) + cv[j];
            v2u p; p.x = pk2(r.x, r.y); p.y = pk2(r.z, r.w); o[64 * j] = p;
            if (X8) { int w8 = __builtin_amdgcn_cvt_pk_fp8_f32(r.x, r.y, 0, false); w8 = __builtin_amdgcn_cvt_pk_fp8_f32(r.z, r.w, w8, true); X8[(size_t)m * (DM / 4) + F.lane + 64 * j] = (unsigned)w8; } }
    }
}
__device__ __forceinline__ void final_norm_rows_bf16(const Ctx& F, const bf16* H, const float* nw, float* O, float oscale) {
    if (F.gw >= M) return;
    v2u un[8]; load_row_raw(H + (size_t)F.gw * DM, F.lane, un);
    f32x4 wv[8];
#pragma unroll
    for (int j = 0; j < 8; ++j) wv[j] = ((const f32x4*)nw + F.lane)[64 * j];
    for (int m = F.gw; m < M; m += F.NGW) {
        f32x4 v[8]; float s = 0.f;
#pragma unroll
        for (int j = 0; j < 8; ++j) { v[j] = (f32x4){bflo(un[j].x), bfhi(un[j].x), bflo(un[j].y), bfhi(un[j].y)}; s += (v[j].x * v[j].x + v[j].y * v[j].y) + (v[j].z * v[j].z + v[j].w * v[j].w); }
        { const int mn = (m + F.NGW < M) ? m + F.NGW : m; load_row_raw(H + (size_t)mn * DM, F.lane, un); }
        const float rstd = rsqrtf(wave_sum_fast(s) * (1.f / DM) + RMS_EPS) * oscale;
        f32x4* o = (f32x4*)(O + (size_t)m * DM) + F.lane;
#pragma unroll
        for (int j = 0; j < 8; ++j) __builtin_nontemporal_store((v[j] * rstd) * wv[j], o + 64 * j);
    }
}
#define LO2(v) __builtin_shufflevector((v), (v), 0, 1)
#define HI2(v) __builtin_shufflevector((v), (v), 2, 3)
template <int CTRL> __device__ __forceinline__ float dpp_f(float x) { return __builtin_bit_cast(float, __builtin_amdgcn_mov_dpp(__builtin_bit_cast(int, x), CTRL, 0xf, 0xf, true)); }
__device__ __forceinline__ float rowsum16(float x) { x += dpp_f<0xB1>(x); x += dpp_f<0x4E>(x); x += dpp_f<0x124>(x); x += dpp_f<0x128>(x); return x; }
__device__ __forceinline__ float quadsum(float x) { x += dpp_f<0xB1>(x); x += dpp_f<0x4E>(x); return x; }

__device__ __forceinline__ float treduce16(const float (&p)[16], bool b0, bool b1, bool b2, bool b3) {
    float a[8], bq[4], c2[2];
#pragma unroll
    for (int j = 0; j < 8; ++j) { const float mine = b3 ? p[j + 8] : p[j], send = b3 ? p[j] : p[j + 8]; a[j] = mine + dpp_f<0x128>(send); }
#pragma unroll
    for (int j = 0; j < 4; ++j) { const float mine = b2 ? a[j + 4] : a[j], send = b2 ? a[j] : a[j + 4]; const float up = dpp_f<0x104>(send), dn = dpp_f<0x114>(send); bq[j] = mine + (b2 ? dn : up); }
#pragma unroll
    for (int j = 0; j < 2; ++j) { const float mine = b1 ? bq[j + 2] : bq[j], send = b1 ? bq[j] : bq[j + 2]; c2[j] = mine + dpp_f<0x4E>(send); }
    const float mine = b0 ? c2[1] : c2[0], send = b0 ? c2[0] : c2[1];
    return mine + dpp_f<0xB1>(send);
}
__device__ __forceinline__ float wave_sum_dpp(float v) { v = rowsum16(v); v += __shfl_xor(v, 16); v += __shfl_xor(v, 32); return v; }
__device__ __forceinline__ void unpack8(const v4u p, float (&e)[8]) { e[0] = bflo(p.x); e[1] = bfhi(p.x); e[2] = bflo(p.y); e[3] = bfhi(p.y); e[4] = bflo(p.z); e[5] = bfhi(p.z); e[6] = bflo(p.w); e[7] = bfhi(p.w); }
__device__ __forceinline__ v4u pack8(const float (&e)[8]) { v4u o; o.x = pk2(e[0], e[1]); o.y = pk2(e[2], e[3]); o.z = pk2(e[4], e[5]); o.w = pk2(e[6], e[7]); return o; }

__device__ __forceinline__ void p3_lora(const Ctx& F) {
    const bf16* PROJ = (const bf16*)(F.ws + WS_PROJ);
    const bf16* WUPT = (const bf16*)(F.ws + WS_WUPT); const bf16* AUPT = (const bf16*)(F.ws + WS_AUPT); const bf16* GUPT = (const bf16*)(F.ws + WS_GUPT);
    bf16* LW = (bf16*)(F.ws + WS_LW); bf16* AA = (bf16*)(F.ws + WS_AA); bf16* GG = (bf16*)(F.ws + WS_GG);
    const float* mu = F.in[I_MU]; const float* w0 = F.in[I_W0]; const float* a0 = F.in[I_A0];
    const int r16 = F.lane & 15, q = F.lane >> 4;
    constexpr int WST = 72, GST = 168;
    LAS bf16* WU = (LAS bf16*)F.lds; LAS bf16* AU = WU + 128 * WST; LAS bf16* GU = AU + 128 * WST;
    const int nr = blockIdx.x & 7, nbr = (F.G - nr + 7) >> 3;
    __syncthreads();
    for (int i = F.tid; i < 128 * 8; i += NTHR) { const int row = i >> 3, ch = i & 7;
        *(LAS v4u*)(WU + row * WST + 8 * ch) = *(const v4u*)(WUPT + (size_t)(128 * nr + row) * L_W + 8 * ch);
        *(LAS v4u*)(AU + row * WST + 8 * ch) = *(const v4u*)(AUPT + (size_t)(128 * nr + row) * L_A + 8 * ch); }
    for (int i = F.tid; i < 128 * 20; i += NTHR) { const int row = i / 20, ch = i - row * 20;
        *(LAS v4u*)(GU + row * GST + 8 * ch) = *(const v4u*)(GUPT + (size_t)(128 * nr + row) * L_G + 8 * ch); }
    LAS float* W0S = (LAS float*)(GU + 128 * GST); LAS float* A0S = W0S + 128; LAS float* MUS = A0S + 128;
    for (int i = F.tid; i < 128; i += NTHR) { W0S[i] = w0[128 * nr + i]; A0S[i] = a0[128 * nr + i]; }
    for (int i = F.tid; i < 288; i += NTHR) MUS[i] = mu[C_WD + i];
    __syncthreads();
#define P3_COL(s) ((((s) < 2) ? (C_WD + 32 * (s)) : ((s) < 4) ? (C_AD + 32 * ((s) - 2)) : (C_GD + 32 * ((s) - 4))) + 8 * q)
    const int mt0 = (blockIdx.x >> 3) * NWAVES + F.wave, mst = nbr * NWAVES;
    v4u rc_[9], rp_[9];
    if (mt0 < M / 16) { const bf16* row = PROJ + (size_t)(mt0 * 16 + r16) * INPP;
#pragma unroll
        for (int s = 0; s < 9; ++s) { rc_[s] = *(const v4u*)(row + P3_COL(s)); rp_[s] = *(const v4u*)(row - INPP + P3_COL(s)); } }
    for (int mt = mt0; mt < M / 16; mt += mst) {
        const int m = mt * 16 + r16; const bool first = (m % SEQ) == 0;
        bf16x8 af[9];
#pragma unroll
        for (int s = 0; s < 9; ++s) {
            const int col = P3_COL(s);
            const v4u pc = rc_[s];
            v4u pp = rp_[s]; if (first) pp = (v4u){0u, 0u, 0u, 0u};
            const f32x4 m0 = *(const LAS f32x4*)(MUS + (col - C_WD)), m1 = *(const LAS f32x4*)(MUS + (col - C_WD) + 4);
            float c[8], p[8], e[8]; unpack8(pc, c); unpack8(pp, p);
            const float mm[8] = {m0.x, m0.y, m0.z, m0.w, m1.x, m1.y, m1.z, m1.w};
#pragma unroll
            for (int j = 0; j < 8; ++j) { float v = c[j] + (p[j] - c[j]) * mm[j];
                if (s < 2) { const float t = __expf(2.f * v); v = 1.f - 2.f * rcp_f(t + 1.f); }
                else if (s >= 4) v = sigmoid_f(v);
                e[j] = v; }
            af[s] = __builtin_bit_cast(bf16x8, pack8(e));
        }
        { const int mtn = (mt + mst < M / 16) ? mt + mst : mt; const bf16* row = PROJ + (size_t)(mtn * 16 + r16) * INPP;
#pragma unroll
          for (int s = 0; s < 9; ++s) { rc_[s] = *(const v4u*)(row + P3_COL(s)); rp_[s] = *(const v4u*)(row - INPP + P3_COL(s)); } }
        asm volatile("" ::: "memory");
#pragma unroll 2
        for (int nt = 0; nt < 8; ++nt) {
            const LAS bf16* wu = WU + (16 * nt + r16) * WST + 8 * q; const LAS bf16* au = AU + (16 * nt + r16) * WST + 8 * q; const LAS bf16* gu = GU + (16 * nt + r16) * GST + 8 * q;
            f32x4 acc0 = {0.f, 0.f, 0.f, 0.f}, acc1 = acc0, acc2 = acc0;
#pragma unroll
            for (int s2 = 0; s2 < 2; ++s2) acc0 = __builtin_amdgcn_mfma_f32_16x16x32_bf16(*(const LAS bf16x8*)(wu + 32 * s2), af[s2], acc0, 0, 0, 0);
#pragma unroll
            for (int s2 = 0; s2 < 2; ++s2) acc1 = __builtin_amdgcn_mfma_f32_16x16x32_bf16(*(const LAS bf16x8*)(au + 32 * s2), af[2 + s2], acc1, 0, 0, 0);
#pragma unroll
            for (int s2 = 0; s2 < 5; ++s2) acc2 = __builtin_amdgcn_mfma_f32_16x16x32_bf16(*(const LAS bf16x8*)(gu + 32 * s2), af[4 + s2], acc2, 0, 0, 0);
            const int n = 128 * nr + 16 * nt + 4 * q;
            const f32x4 w0v = *(const LAS f32x4*)(W0S + 16 * nt + 4 * q), a0v = *(const LAS f32x4*)(A0S + 16 * nt + 4 * q);
            v2u o0, o1, o2;
            o0.x = pk2(-0.60653066f * sigmoid_f(acc0[0] + w0v.x), -0.60653066f * sigmoid_f(acc0[1] + w0v.y));
            o0.y = pk2(-0.60653066f * sigmoid_f(acc0[2] + w0v.z), -0.60653066f * sigmoid_f(acc0[3] + w0v.w));
            o1.x = pk2(sigmoid_f(acc1[0] + a0v.x), sigmoid_f(acc1[1] + a0v.y)); o1.y = pk2(sigmoid_f(acc1[2] + a0v.z), sigmoid_f(acc1[3] + a0v.w));
            o2.x = pk2(acc2[0], acc2[1]); o2.y = pk2(acc2[2], acc2[3]);
            *(v2u*)(LW + (size_t)m * RW + n) = o0; *(v2u*)(AA + (size_t)m * RW + n) = o1; *(v2u*)(GG + (size_t)m * RW + n) = o2;
        }
    }
#undef P3_COL
    __syncthreads();
}

constexpr int TC = 32, NCHUNK = SEQ / TC;
constexpr int RB_R = 0, RB_W = TC * 64, RB_K = 2 * TC * 64, RB_KK = 3 * TC * 64, RB_KA = 4 * TC * 64, RB_V = 5 * TC * 64, RB_SIZE = 5 * TC * 64 + TC * 16;
constexpr int MB_B = 0, MB_C = TC * 128, MB_X = 2 * TC * 128, MB_DT = MB_X + TC * 32, MB_DA = MB_DT + TC, MB_SIZE = MB_DA + TC;
static_assert(2 * RB_SIZE * 4 <= RING_BYTES, "scan buffers fit the LDS ring");

struct RwkvRaw { bf16 r[9], k[9], v[9], lw[8], a[8]; };
__device__ __forceinline__ void rwkv_load(RwkvRaw& raw, const bf16* PROJ, const bf16* LW, const bf16* AA, int b, int h, int t0w, int c) {
    const bf16* base = PROJ + (size_t)(b * SEQ + t0w) * INPP + h * 64 + c;
#pragma unroll
    for (int i = 0; i < 9; ++i) {
        if (i == 0 && t0w == 0) { raw.r[0] = 0; raw.k[0] = 0; raw.v[0] = 0; }
        else { const bf16* row = base + (long)(i - 1) * INPP; raw.r[i] = row[C_R]; raw.k[i] = row[C_K]; raw.v[i] = row[C_V]; }
    }
#pragma unroll
    for (int i = 0; i < 8; ++i) { const size_t o = (size_t)(b * SEQ + t0w + i) * RW + h * 64 + c; raw.lw[i] = LW[o]; raw.a[i] = AA[o]; }
}
__device__ __forceinline__ void rwkv_stage(const RwkvRaw& raw, LAS float* buf, int tl0, int c, int qt, float mu_r, float mu_k, float mu_v, float kkw, float kaw) {
#pragma unroll
    for (int i = 0; i < 8; ++i) {
        const int t = tl0 + i;
        const float rc = bf1(raw.r[i + 1]), rp = bf1(raw.r[i]), kc = bf1(raw.k[i + 1]), kp = bf1(raw.k[i]), vc = bf1(raw.v[i + 1]), vp = bf1(raw.v[i]);
        const float rr = rc + (rp - rc) * mu_r, kx = kc + (kp - kc) * mu_k, vv = vc + (vp - vc) * mu_v;
        const float a = bf1(raw.a[i]), dec = __expf(bf1(raw.lw[i]));
        const float kkraw = kx * kkw; const float ss = wave_sum_dpp(kkraw * kkraw);
        const float kkn = kkraw * rcp_f(fmaxf(sqrtf(ss), 1e-12f));
        buf[RB_R + t * 64 + c] = rr; buf[RB_W + t * 64 + c] = dec; buf[RB_K + t * 64 + c] = kx * (1.f + (a - 1.f) * kaw);
        buf[RB_KK + t * 64 + c] = kkn; buf[RB_KA + t * 64 + c] = kkn * a;
        if ((c >> 4) == qt) buf[RB_V + t * 16 + (c & 15)] = vv;
    }
}
__device__ __forceinline__ void rwkv_task(const Ctx& F, int task) {
    const int b = task >> 6, h = (task >> 2) & 15, qt = task & 3;
    const bf16* PROJ = (const bf16*)(F.ws + WS_PROJ); const bf16* LW = (const bf16*)(F.ws + WS_LW); const bf16* AA = (const bf16*)(F.ws + WS_AA);
    bf16* OY = (bf16*)(F.ws + WS_OY);
    LAS float* lbuf = (LAS float*)F.lds;
    const int c = F.lane, w = F.wave, r = F.lane >> 4, cg = F.lane & 15;
    const bool stager = w >= 4; const int sw = w & 3;
    const int ch = h * 64 + c;
    const float mu_r = F.in[I_MU][C_R + ch], mu_k = F.in[I_MU][C_K + ch], mu_v = F.in[I_MU][C_V + ch], kkw = F.in[I_KK][ch], kaw = F.in[I_KA][ch];
    RwkvRaw raw;
    if (stager) { rwkv_load(raw, PROJ, LW, AA, b, h, 8 * sw, c); rwkv_stage(raw, lbuf, 8 * sw, c, qt, mu_r, mu_k, mu_v, kkw, kaw); rwkv_load(raw, PROJ, LW, AA, b, h, TC + 8 * sw, c); }
    __syncthreads();
    f32x2 S01 = {0.f, 0.f}, S23 = {0.f, 0.f};
    const bool cb0 = cg & 1, cb1 = cg & 2, cb2 = cg & 4, cb3 = cg & 8;
    bf16* orow = OY + (size_t)(b * SEQ) * DM + h * 64 + 16 * qt + 4 * sw + r;
    for (int ck = 0; ck < NCHUNK; ++ck) {
        const LAS float* buf = lbuf + (ck & 1) * RB_SIZE;
        if (stager) {
            if (ck + 1 < NCHUNK) { rwkv_stage(raw, lbuf + ((ck + 1) & 1) * RB_SIZE, 8 * sw, c, qt, mu_r, mu_k, mu_v, kkw, kaw);
                if (ck + 2 < NCHUNK) rwkv_load(raw, PROJ, LW, AA, b, h, (ck + 2) * TC + 8 * sw, c); }
        } else {
            const LAS float* bp = buf + 4 * cg; const LAS float* vp = buf + RB_V + 4 * sw + r;
            f32x4 qkk[3], qw[3], qka[3], qk[3], qr[3]; float qv[3];
#pragma unroll
            for (int i = 0; i < 3; ++i) { qkk[i] = *(const LAS f32x4*)(bp + RB_KK + i * 64); qw[i] = *(const LAS f32x4*)(bp + RB_W + i * 64); qka[i] = *(const LAS f32x4*)(bp + RB_KA + i * 64);
                qk[i] = *(const LAS f32x4*)(bp + RB_K + i * 64); qr[i] = *(const LAS f32x4*)(bp + RB_R + i * 64); qv[i] = vp[i * 16]; }
            float op[16];
#pragma unroll
            for (int j = 0; j < TC; ++j) {
                const int u = j % 3;
                const f32x4 kk4 = qkk[u], w4 = qw[u], ka4 = qka[u], k4 = qk[u], r4 = qr[u]; const float vr = qv[u];
                const f32x2 tq = S01 * LO2(kk4) + S23 * HI2(kk4);
                const float sa = rowsum16(tq.x + tq.y);
                const f32x2 sav = {sa, sa}, vrv = {vr, vr};
                S01 = S01 * LO2(w4) + (vrv * LO2(k4) - sav * LO2(ka4));
                S23 = S23 * HI2(w4) + (vrv * HI2(k4) - sav * HI2(ka4));
                const f32x2 uq = S01 * LO2(r4) + S23 * HI2(r4);
                op[j & 15] = uq.x + uq.y;
                asm volatile("" : "+v"(S01), "+v"(S23) :: "memory");
                if (j + 3 < TC) { qkk[u] = *(const LAS f32x4*)(bp + RB_KK + (j + 3) * 64); qw[u] = *(const LAS f32x4*)(bp + RB_W + (j + 3) * 64); qka[u] = *(const LAS f32x4*)(bp + RB_KA + (j + 3) * 64);
                                  qk[u] = *(const LAS f32x4*)(bp + RB_K + (j + 3) * 64); qr[u] = *(const LAS f32x4*)(bp + RB_R + (j + 3) * 64); qv[u] = vp[(j + 3) * 16]; }
                if ((j & 15) == 15) {
                    const float ored = treduce16(op, cb0, cb1, cb2, cb3);
                    orow[(size_t)(ck * TC + (j - 15) + cg) * DM] = (bf16)(pk2(ored, 0.f) & 0xffffu);
                }
            }
        }
        __syncthreads();
    }
}

__device__ __forceinline__ void p4_scans(const Ctx& F) {
    for (int task = blockIdx.x; task < NB * RHEADS * 4; task += F.G) { rwkv_task(F, task); __syncthreads(); }
}

__device__ __forceinline__ void ld16(const float* p, float (&v)[16]) {
#pragma unroll
    for (int i = 0; i < 4; ++i) { const f32x4 t = *(const f32x4*)(p + 4 * i); v[4 * i] = t.x; v[4 * i + 1] = t.y; v[4 * i + 2] = t.z; v[4 * i + 3] = t.w; }
}
__device__ __forceinline__ void ldbf16x16(const bf16* p, float (&v)[16]) {
    float t0[8], t1[8]; unpack8(*(const v4u*)p, t0); unpack8(*(const v4u*)(p + 8), t1);
#pragma unroll
    for (int j = 0; j < 8; ++j) { v[j] = t0[j]; v[8 + j] = t1[j]; }
}
__device__ __forceinline__ void stbf16x16(bf16* p, const float (&v)[16]) {
    float t0[8], t1[8];
#pragma unroll
    for (int j = 0; j < 8; ++j) { t0[j] = v[j]; t1[j] = v[8 + j]; }
    *(v4u*)p = pack8(t0); *(v4u*)(p + 8) = pack8(t1);
}
__device__ __forceinline__ void p5_post(const Ctx& F) {
    const bf16* PROJ = (const bf16*)(F.ws + WS_PROJ); const bf16* AA = (const bf16*)(F.ws + WS_AA); const bf16* GG = (const bf16*)(F.ws + WS_GG);
    bf16* OY = (bf16*)(F.ws + WS_OY);
    const int c0 = 16 * F.lane;
    {
        float mur[16], muk[16], muv[16], ka[16], rk[16], lnw[16], lnb[16];
        ld16(F.in[I_MU] + C_R + c0, mur); ld16(F.in[I_MU] + C_K + c0, muk); ld16(F.in[I_MU] + C_V + c0, muv);
        ld16(F.in[I_KA] + c0, ka); ld16(F.in[I_RK] + c0, rk); ld16(F.in[I_LNW] + c0, lnw); ld16(F.in[I_LNB] + c0, lnb);
        for (int m = F.gw; m < M; m += F.NGW) {
            const bool first = (m % SEQ) == 0;
            const bf16* prow = PROJ + (size_t)m * INPP; bf16* oyrow = OY + (size_t)m * DM;
            float o[16], res[16]; float bs = 0.f;
            ldbf16x16(oyrow + c0, o);
            {
                float rc[16], rp[16], kc[16], kp[16], av[16];
                ldbf16x16(prow + C_R + c0, rc); ldbf16x16(prow + C_K + c0, kc); ldbf16x16(AA + (size_t)m * RW + c0, av);
                if (!first) { ldbf16x16(prow - INPP + C_R + c0, rp); ldbf16x16(prow - INPP + C_K + c0, kp); }
                else {
#pragma unroll
                    for (int j = 0; j < 16; ++j) { rp[j] = 0.f; kp[j] = 0.f; } }
#pragma unroll
                for (int j = 0; j < 16; ++j) { const float rr = rc[j] + (rp[j] - rc[j]) * mur[j], kx = kc[j] + (kp[j] - kc[j]) * muk[j];
                    bs += rr * (kx * (1.f + (av[j] - 1.f) * ka[j])) * rk[j]; }
            }
            bs = quadsum(bs);
            float s = 0.f;
#pragma unroll
            for (int j = 0; j < 16; ++j) s += o[j];
            const float mean = quadsum(s) * (1.f / 64.f);
            float qv = 0.f;
#pragma unroll
            for (int j = 0; j < 16; ++j) { o[j] -= mean; qv += o[j] * o[j]; }
            const float rstd = rsqrtf(quadsum(qv) * (1.f / 64.f) + 64e-5f);
            {
                float vc[16], vp[16], gv[16];
                ldbf16x16(prow + C_V + c0, vc); ldbf16x16(GG + (size_t)m * RW + c0, gv);
                if (!first) ldbf16x16(prow - INPP + C_V + c0, vp);
                else {
#pragma unroll
                    for (int j = 0; j < 16; ++j) vp[j] = 0.f; }
#pragma unroll
                for (int j = 0; j < 16; ++j) { const float vv = vc[j] + (vp[j] - vc[j]) * muv[j]; res[j] = (o[j] * rstd * lnw[j] + lnb[j] + bs * vv) * gv[j]; }
            }
            stbf16x16(oyrow + c0, res);
        }
    }
    {
        float nw[16]; ld16(F.in[I_MNW] + c0, nw);
        int m = F.gw;
        v4u yr[2], zr[2];
        if (m < M) { const bf16* prow = PROJ + (size_t)m * INPP; const bf16* oyrow = OY + (size_t)m * DM;
            yr[0] = *(const v4u*)(oyrow + RW + c0); yr[1] = *(const v4u*)(oyrow + RW + c0 + 8); zr[0] = *(const v4u*)(prow + C_Z + c0); zr[1] = *(const v4u*)(prow + C_Z + c0 + 8); }
        for (; m < M; m += F.NGW) {
            bf16* oyrow = OY + (size_t)m * DM;
            float y[16], z[16];
            { float t0[8], t1[8]; unpack8(yr[0], t0); unpack8(yr[1], t1);
#pragma unroll
              for (int j = 0; j < 8; ++j) { y[j] = t0[j]; y[8 + j] = t1[j]; }
              unpack8(zr[0], t0); unpack8(zr[1], t1);
#pragma unroll
              for (int j = 0; j < 8; ++j) { z[j] = t0[j]; z[8 + j] = t1[j]; } }
            { const int mn = (m + F.NGW < M) ? m + F.NGW : m; const bf16* prow = PROJ + (size_t)mn * INPP; const bf16* oyn = OY + (size_t)mn * DM;
              yr[0] = *(const v4u*)(oyn + RW + c0); yr[1] = *(const v4u*)(oyn + RW + c0 + 8); zr[0] = *(const v4u*)(prow + C_Z + c0); zr[1] = *(const v4u*)(prow + C_Z + c0 + 8); }
            asm volatile("" ::: "memory");
            float qv = 0.f;
#pragma unroll
            for (int j = 0; j < 16; ++j) { y[j] *= silu_f(z[j]); qv += y[j] * y[j]; }
            qv = rowsum16(qv);
            { auto rr = __builtin_amdgcn_permlane16_swap(__float_as_uint(qv), __float_as_uint(qv), false, false); qv = __uint_as_float(rr[0]) + __uint_as_float(rr[1]); }
            const float rstd = rsqrtf(qv * (1.f / 512.f) + 1e-5f);
#pragma unroll
            for (int j = 0; j < 16; ++j) y[j] = y[j] * rstd * nw[j];
            stbf16x16(oyrow + RW + c0, y);
        }
    }
}
constexpr int MC_L = 128, MC_NC = SEQ / MC_L, LSTR = 136;
constexpr int MT_BYTES = 128 * LSTR * 2;
constexpr size_t WS_ST = 876 * MiB, WS_SIN = 940 * MiB, WS_ATOT = 1004 * MiB, WS_END2 = 1005 * MiB;

__device__ __forceinline__ float mamba_dt_scan(const Ctx& F, const bf16* PROJ, int b, int c, int g, LAS float* DT, LAS float* ACS) {
    const int head = g * 8 + F.wave, lane = F.lane;
    const float dtb = F.in[I_DTB][head], Aneg = -__expf(F.in[I_ALOG][head]);
    const bf16* p = PROJ + (size_t)(b * SEQ + c * MC_L + 2 * lane) * INPP + C_DT + head;
    const float x0 = bf1(p[0]) + dtb, x1 = bf1(p[INPP]) + dtb;
    const float d0 = (x0 > 20.f) ? x0 : log1pf(__expf(x0)), d1 = (x1 > 20.f) ? x1 : log1pf(__expf(x1));
    const float s0 = d0 * Aneg, s1 = s0 + d1 * Aneg;
    float incl = s1;
#pragma unroll
    for (int o = 1; o < 64; o <<= 1) { const float t = __shfl_up(incl, o); if (lane >= o) incl += t; }
    const float excl = incl - s1;
    DT[F.wave * 128 + 2 * lane] = d0; DT[F.wave * 128 + 2 * lane + 1] = d1;
    ACS[F.wave * 128 + 2 * lane] = excl + s0; ACS[F.wave * 128 + 2 * lane + 1] = excl + s1;
    return __shfl(incl, 63);
}
struct TRaw { bf16 v[35]; };
__device__ __forceinline__ void mstage_T_load(TRaw& raw, const bf16* PROJ, int b, int c, int chn, int tid) {
    const int t0 = 32 * (tid >> 7);
    const bf16* base = PROJ + (size_t)(b * SEQ + c * MC_L + t0) * INPP + C_XBC + chn;
    if (c * MC_L + t0 > 0) { raw.v[0] = base[-3 * INPP]; raw.v[1] = base[-2 * INPP]; raw.v[2] = base[-1 * INPP]; }
    else { raw.v[0] = 0; raw.v[1] = 0; raw.v[2] = 0; }
#pragma unroll
    for (int t = 0; t < 32; ++t) raw.v[3 + t] = base[(size_t)t * INPP];
}
template <bool SC>
__device__ __forceinline__ void mstage_T_store(const TRaw& raw, int chn, LAS bf16* dst, const LAS float* scale, const float* convw, const float* convb, int tid) {
    const int f = tid & 127, t0 = 32 * (tid >> 7);
    const float w0 = convw[chn], w1 = convw[1536 + chn], w2 = convw[2 * 1536 + chn], w3 = convw[3 * 1536 + chn], bb = convb[chn];
#pragma unroll
    for (int i8 = 0; i8 < 4; ++i8) {
        float e[8];
#pragma unroll
        for (int i = 0; i < 8; ++i) { const int t = 8 * i8 + i;
            float v = silu_f(bb + w0 * bf1(raw.v[t]) + w1 * bf1(raw.v[t + 1]) + w2 * bf1(raw.v[t + 2]) + w3 * bf1(raw.v[t + 3]));
            if (SC) v *= scale[t0 + t];
            e[i] = v; }
        *(LAS v4u*)(dst + f * LSTR + t0 + 8 * i8) = pack8(e);
    }
}
__device__ __forceinline__ void mstage_N(const bf16* PROJ, int b, int c, int g, LAS bf16* Bn, LAS bf16* Cn, const float* convw, const float* convb, int tid) {
    const int f8 = tid & 31, t0 = 8 * (tid >> 5);
    const int chn = (f8 < 16) ? (1024 + g * 128 + 8 * f8) : (1280 + g * 128 + 8 * (f8 - 16));
    LAS bf16* dst = ((f8 < 16) ? Bn : Cn) + 8 * (f8 & 15);
    const bf16* base = PROJ + (size_t)(b * SEQ + c * MC_L + t0) * INPP + C_XBC + chn;
    float w[4][8], bb[8];
#pragma unroll
    for (int i = 0; i < 4; ++i) { const f32x4 a = *(const f32x4*)(convw + i * 1536 + chn), d = *(const f32x4*)(convw + i * 1536 + chn + 4);
        w[i][0] = a.x; w[i][1] = a.y; w[i][2] = a.z; w[i][3] = a.w; w[i][4] = d.x; w[i][5] = d.y; w[i][6] = d.z; w[i][7] = d.w; }
    { const f32x4 a = *(const f32x4*)(convb + chn), d = *(const f32x4*)(convb + chn + 4); bb[0] = a.x; bb[1] = a.y; bb[2] = a.z; bb[3] = a.w; bb[4] = d.x; bb[5] = d.y; bb[6] = d.z; bb[7] = d.w; }
    float r0[8], r1[8], r2[8];
    if (c * MC_L + t0 > 0) { unpack8(*(const v4u*)(base - 3 * INPP), r0); unpack8(*(const v4u*)(base - 2 * INPP), r1); unpack8(*(const v4u*)(base - 1 * INPP), r2); }
    else {
#pragma unroll
        for (int k = 0; k < 8; ++k) { r0[k] = 0.f; r1[k] = 0.f; r2[k] = 0.f; } }
#pragma unroll
    for (int t = 0; t < 8; ++t) {
        float r3[8], e[8]; unpack8(*(const v4u*)(base + (size_t)t * INPP), r3);
#pragma unroll
        for (int k = 0; k < 8; ++k) { e[k] = silu_f(bb[k] + w[0][k] * r0[k] + w[1][k] * r1[k] + w[2][k] * r2[k] + w[3][k] * r3[k]); r0[k] = r1[k]; r1[k] = r2[k]; r2[k] = r3[k]; }
        *(LAS v4u*)(dst + (t0 + t) * LSTR) = pack8(e);
    }
}

__device__ __forceinline__ void m1_chunk_states(const Ctx& F) {
    const bf16* PROJ = (const bf16*)(F.ws + WS_PROJ); bf16* ST = (bf16*)(F.ws + WS_ST); float* ATOT = (float*)(F.ws + WS_ATOT);
    LAS bf16* BT = (LAS bf16*)F.lds; LAS bf16* XT = (LAS bf16*)(F.lds + MT_BYTES);
    LAS float* DT = (LAS float*)(F.lds + 3 * MT_BYTES); LAS float* ACS = DT + 8 * 128; LAS float* SCL = ACS + 8 * 128;
    const float* convw = F.in[I_CONVW]; const float* convb = F.in[I_CONVB];
    const int tid = F.tid, w = F.wave, lane = F.lane, r16 = lane & 15, q = lane >> 4;
    for (int it = blockIdx.x; it < NB * MC_NC * 2; it += F.G) {
        const int g = it & 1, c = (it >> 1) & (MC_NC - 1), b = it >> 7;
        __syncthreads();
        const float atot = mamba_dt_scan(F, PROJ, b, c, g, DT, ACS);
        if (lane == 0) ATOT[(b * MC_NC + c) * 16 + g * 8 + w] = atot;
        const int chB = 1024 + g * 128 + (tid & 127);
        TRaw ra, rb;
        mstage_T_load(ra, PROJ, b, c, chB, tid);
        mstage_T_load(rb, PROJ, b, c, (g * 8 + ((tid & 127) >> 6)) * 64 + (tid & 63), tid);
        LDS_WAIT();
        SCL[w * 128 + 2 * lane] = DT[w * 128 + 2 * lane] * __expf(atot - ACS[w * 128 + 2 * lane]);
        SCL[w * 128 + 2 * lane + 1] = DT[w * 128 + 2 * lane + 1] * __expf(atot - ACS[w * 128 + 2 * lane + 1]);
        mstage_T_store<false>(ra, chB, BT, nullptr, convw, convb, tid);
        mstage_T_load(ra, PROJ, b, c, (g * 8 + 2 + ((tid & 127) >> 6)) * 64 + (tid & 63), tid);
        __syncthreads();
#pragma unroll
        for (int hb = 0; hb < 2; ++hb) {
            if (hb == 1) mstage_T_load(ra, PROJ, b, c, (g * 8 + 6 + ((tid & 127) >> 6)) * 64 + (tid & 63), tid);
            { const int hl = 4 * hb + ((tid & 127) >> 6); mstage_T_store<true>(rb, (g * 8 + hl) * 64 + (tid & 63), XT, SCL + hl * 128, convw, convb, tid); }
            if (hb == 0) mstage_T_load(rb, PROJ, b, c, (g * 8 + 4 + ((tid & 127) >> 6)) * 64 + (tid & 63), tid);
            { const int hl = 4 * hb + 2 + ((tid & 127) >> 6); mstage_T_store<true>(ra, (g * 8 + hl) * 64 + (tid & 63), XT + 128 * LSTR, SCL + hl * 128, convw, convb, tid); }
            __syncthreads();
            const int hh = w >> 1, ph = w & 1;
            f32x4 acc[2][8];
#pragma unroll
            for (int a = 0; a < 2; ++a)
#pragma unroll
                for (int n = 0; n < 8; ++n) acc[a][n] = (f32x4){0.f, 0.f, 0.f, 0.f};
#pragma unroll
            for (int ks = 0; ks < 4; ++ks) {
                bf16x8 xa[2];
#pragma unroll
                for (int a = 0; a < 2; ++a) xa[a] = *(const LAS bf16x8*)(XT + (hh * 64 + 32 * ph + 16 * a + r16) * LSTR + 32 * ks + 8 * q);
#pragma unroll
                for (int n = 0; n < 8; ++n) { const bf16x8 bfr = *(const LAS bf16x8*)(BT + (16 * n + r16) * LSTR + 32 * ks + 8 * q);
#pragma unroll
                    for (int a = 0; a < 2; ++a) acc[a][n] = __builtin_amdgcn_mfma_f32_16x16x32_bf16(bfr, xa[a], acc[a][n], 0, 0, 0); }
            }
            bf16* st = ST + ((size_t)((b * MC_NC + c) * 16 + g * 8 + 4 * hb + hh)) * (64 * 128);
#pragma unroll
            for (int a = 0; a < 2; ++a)
#pragma unroll
                for (int n = 0; n < 8; ++n) { v2u o; o.x = pk2(acc[a][n][0], acc[a][n][1]); o.y = pk2(acc[a][n][2], acc[a][n][3]);
                    *(v2u*)(st + (32 * ph + 16 * a + r16) * 128 + 16 * n + 4 * q) = o; }
            __syncthreads();
        }
    }
}

__device__ __forceinline__ void m2_prefix(const Ctx& F) {
    const bf16* ST = (const bf16*)(F.ws + WS_ST); bf16* SIN = (bf16*)(F.ws + WS_SIN); const float* ATOT = (const float*)(F.ws + WS_ATOT);
    const int nthr = F.G * NTHR;
    constexpr int GB = 16;
    constexpr size_t CST = (size_t)16 * 8192;
    for (int gi = blockIdx.x * NTHR + F.tid; gi < NB * 16 * 2048; gi += nthr) {
        const int e4 = gi & 2047, bh = gi >> 11, b = bh >> 4, h = bh & 15;
        const size_t o0 = ((size_t)(b * MC_NC) * 16 + h) * 8192 + 4 * e4;
        const float* at = ATOT + (b * MC_NC) * 16 + h;
        float r0 = 0.f, r1 = 0.f, r2 = 0.f, r3 = 0.f;
        v2u sv[GB]; float dv[GB];
#pragma unroll
        for (int i = 0; i < GB; ++i) { sv[i] = *(const v2u*)(ST + o0 + (size_t)i * CST); dv[i] = at[i * 16]; }
#pragma unroll 1
        for (int c0 = 0; c0 < MC_NC; c0 += GB) {
            const int cn = (c0 + GB < MC_NC) ? c0 + GB : c0;
            v2u svn[GB]; float dvn[GB];
#pragma unroll
            for (int i = 0; i < GB; ++i) { svn[i] = *(const v2u*)(ST + o0 + (size_t)(cn + i) * CST); dvn[i] = at[(cn + i) * 16]; }
            asm volatile("" ::: "memory");
#pragma unroll
            for (int i = 0; i < GB; ++i) {
                v2u so; so.x = pk2(r0, r1); so.y = pk2(r2, r3);
                *(v2u*)(SIN + o0 + (size_t)(c0 + i) * CST) = so;
                const float d = __expf(dv[i]);
                r0 = r0 * d + bflo(sv[i].x); r1 = r1 * d + bfhi(sv[i].x); r2 = r2 * d + bflo(sv[i].y); r3 = r3 * d + bfhi(sv[i].y);
            }
#pragma unroll
            for (int i = 0; i < GB; ++i) { sv[i] = svn[i]; dv[i] = dvn[i]; }
        }
    }
}

__device__ __forceinline__ void m3_outputs(const Ctx& F) {
    const bf16* PROJ = (const bf16*)(F.ws + WS_PROJ); const bf16* SIN = (const bf16*)(F.ws + WS_SIN); bf16* OY = (bf16*)(F.ws + WS_OY);
    LAS bf16* Cn = (LAS bf16*)F.lds; LAS bf16* RB = (LAS bf16*)(F.lds + MT_BYTES);
    LAS bf16* Mw = (LAS bf16*)(F.lds + 2 * MT_BYTES) + F.wave * 16 * LSTR;
    LAS float* DT = (LAS float*)(F.lds + 3 * MT_BYTES); LAS float* ACS = DT + 8 * 128;
    const float* convw = F.in[I_CONVW]; const float* convb = F.in[I_CONVB];
    const int tid = F.tid, w = F.wave, lane = F.lane, r16 = lane & 15, q = lane >> 4;
    for (int it = blockIdx.x; it < NB * MC_NC * 2; it += F.G) {
        const int g = it & 1, c = (it >> 1) & (MC_NC - 1), b = it >> 7;
        __syncthreads();
        (void)mamba_dt_scan(F, PROJ, b, c, g, DT, ACS);
        mstage_N(PROJ, b, c, g, RB, Cn, convw, convb, tid);
        __syncthreads();
        TRaw rx;
        mstage_T_load(rx, PROJ, b, c, (g * 8 + ((tid & 127) >> 6)) * 64 + (tid & 63), tid);
        bf16x8 cf[4];
#pragma unroll
        for (int ks = 0; ks < 4; ++ks) cf[ks] = *(const LAS bf16x8*)(Cn + (16 * w + r16) * LSTR + 32 * ks + 8 * q);
        f32x4 Gt[8];
#pragma unroll
        for (int nt = 0; nt < 8; ++nt) { Gt[nt] = (f32x4){0.f, 0.f, 0.f, 0.f};
#pragma unroll
            for (int ks = 0; ks < 4; ++ks) Gt[nt] = __builtin_amdgcn_mfma_f32_16x16x32_bf16(*(const LAS bf16x8*)(RB + (16 * nt + r16) * LSTR + 32 * ks + 8 * q), cf[ks], Gt[nt], 0, 0, 0); }
        const int l = 16 * w + r16;
        const size_t mrow = (size_t)(b * SEQ + c * MC_L + l);
#pragma unroll 1
        for (int hb = 0; hb < 4; ++hb) {
            __syncthreads();
            { const int hl = 2 * hb + ((tid & 127) >> 6); mstage_T_store<false>(rx, (g * 8 + hl) * 64 + (tid & 63), RB, nullptr, convw, convb, tid); }
            { const int hn = (hb < 3) ? 2 * (hb + 1) : 2 * hb; mstage_T_load(rx, PROJ, b, c, (g * 8 + hn + ((tid & 127) >> 6)) * 64 + (tid & 63), tid); }
            __syncthreads();
#pragma unroll 1
            for (int h2 = 0; h2 < 2; ++h2) {
                const int hl = 2 * hb + h2, head = g * 8 + hl;
                const float acs_l = ACS[hl * 128 + l];
                const bf16* sin = SIN + ((size_t)((b * MC_NC + c) * 16 + head)) * 8192;
                bf16x8 sf[4][4];
#pragma unroll
                for (int pt = 0; pt < 4; ++pt)
#pragma unroll
                    for (int ks = 0; ks < 4; ++ks) sf[pt][ks] = *(const bf16x8*)(sin + (16 * pt + r16) * 128 + 32 * ks + 8 * q);
#pragma unroll
                for (int nt = 0; nt < 8; ++nt) { const f32x4 as = *(const LAS f32x4*)(ACS + hl * 128 + 16 * nt + 4 * q), ds = *(const LAS f32x4*)(DT + hl * 128 + 16 * nt + 4 * q);
                    float mv[4];
#pragma unroll
                    for (int j = 0; j < 4; ++j) { const int s = 16 * nt + 4 * q + j; mv[j] = (s <= l) ? Gt[nt][j] * __expf(acs_l - as[j]) * ds[j] : 0.f; }
                    v2u o; o.x = pk2(mv[0], mv[1]); o.y = pk2(mv[2], mv[3]);
                    *(LAS v2u*)(Mw + r16 * LSTR + 16 * nt + 4 * q) = o; }
                LDS_WAIT(); asm volatile("" ::: "memory");
                bf16x8 mf[4];
#pragma unroll
                for (int ks = 0; ks < 4; ++ks) mf[ks] = *(const LAS bf16x8*)(Mw + r16 * LSTR + 32 * ks + 8 * q);
                const float el = __expf(acs_l), Dh = F.in[I_DSK][head];
#pragma unroll
                for (int pt = 0; pt < 4; ++pt) {
                    f32x4 yd = {0.f, 0.f, 0.f, 0.f}, yo = {0.f, 0.f, 0.f, 0.f};
#pragma unroll
                    for (int ks = 0; ks < 4; ++ks) {
                        yd = __builtin_amdgcn_mfma_f32_16x16x32_bf16(*(const LAS bf16x8*)(RB + (h2 * 64 + 16 * pt + r16) * LSTR + 32 * ks + 8 * q), mf[ks], yd, 0, 0, 0);
                        yo = __builtin_amdgcn_mfma_f32_16x16x32_bf16(sf[pt][ks], cf[ks], yo, 0, 0, 0); }
                    float yv[4];
#pragma unroll
                    for (int j = 0; j < 4; ++j) yv[j] = yd[j] + el * yo[j] + Dh * bf1(RB[(h2 * 64 + 16 * pt + 4 * q + j) * LSTR + l]);
                    v2u o; o.x = pk2(yv[0], yv[1]); o.y = pk2(yv[2], yv[3]);
                    *(v2u*)(OY + mrow * DM + RW + head * 64 + 16 * pt + 4 * q) = o;
                }
                asm volatile("" ::: "memory");
            }
        }
    }
}
constexpr int RC = 16, RNCH = SEQ / RC, NPART = 4, RHALF = RNCH / NPART, RITEMS = NB * RHEADS * RHALF;
constexpr size_t RO_WH = 0, RO_RH = 16 * MiB, RO_VT = 32 * MiB, RO_ET = 48 * MiB, RO_OL = 64 * MiB, RO_A2 = 80 * MiB, RO_GC = 112 * MiB, RO_BUF = 116 * MiB, RO_SS = 232 * MiB;
constexpr int RL_KAP = 0, RL_ALP = 2304, RL_KT = 4608, RL_RT = 6912, RL_KAPT = 9216, RL_VT = 11264, RL_TB = 13312, RL_BL = 14336, RL_QL = 15360, RL_PL = 16384,
              RL_WT = RL_KAP, RL_BVT = RL_ALP, RL_AL32 = RL_KT, RL_ET = RL_KT,
              RL_BYTES = 18176;
constexpr int XS = 72, TS = 16, SS16 = 32;

__device__ __forceinline__ float wave_sum_pl(float x) {
    x = rowsum16(x);
    { auto rr = __builtin_amdgcn_permlane16_swap(__float_as_uint(x), __float_as_uint(x), false, false); x = __uint_as_float(rr[0]) + __uint_as_float(rr[1]); }
    { auto rr = __builtin_amdgcn_permlane32_swap(__float_as_uint(x), __float_as_uint(x), false, false); x = __uint_as_float(rr[0]) + __uint_as_float(rr[1]); }
    return x;
}
__device__ __forceinline__ v2u pack4(const f32x4 a) { v2u o; o.x = pk2(a[0], a[1]); o.y = pk2(a[2], a[3]); return o; }
__device__ __forceinline__ f32x4 unpack4(const v2u u) { return (f32x4){bflo(u.x), bfhi(u.x), bflo(u.y), bfhi(u.y)}; }
__device__ __forceinline__ bf16 f2b(float x) { return (bf16)pk2(x, 0.f); }

__device__ __forceinline__ void ra_item(const Ctx& F, LAS unsigned char* wl, int it, int half) {
    const int bh = it / RHALF, cl = it - bh * RHALF, ci = half * RHALF + cl, b = bh >> 4, h = bh & 15;
    const bf16* PROJ = (const bf16*)(F.ws + WS_PROJ); const bf16* LW = (const bf16*)(F.ws + WS_LW); const bf16* AA = (const bf16*)(F.ws + WS_AA);
    unsigned char* RO = (unsigned char*)F.out + (size_t)(half & 1) * RO_BUF;
    const int lane = F.lane, r16 = lane & 15, q = lane >> 4, c = lane, ch = h * 64 + c;
    const size_t m0 = (size_t)b * SEQ + (size_t)RC * ci;
    LAS bf16* KAP = (LAS bf16*)(wl + RL_KAP); LAS bf16* ALP = (LAS bf16*)(wl + RL_ALP); LAS bf16* KT = (LAS bf16*)(wl + RL_KT); LAS bf16* RT = (LAS bf16*)(wl + RL_RT);
    LAS bf16* KAPT = (LAS bf16*)(wl + RL_KAPT); LAS bf16* VTL = (LAS bf16*)(wl + RL_VT); LAS bf16* WT = (LAS bf16*)(wl + RL_WT); LAS bf16* BVT = (LAS bf16*)(wl + RL_BVT); LAS bf16* ETL = (LAS bf16*)(wl + RL_ET);
    LAS bf16* TB = (LAS bf16*)(wl + RL_TB); LAS bf16* BL = (LAS bf16*)(wl + RL_BL); LAS bf16* QL = (LAS bf16*)(wl + RL_QL); LAS bf16* PL = (LAS bf16*)(wl + RL_PL);
    const float mu_r = F.in[I_MU][C_R + ch], mu_k = F.in[I_MU][C_K + ch], mu_v = F.in[I_MU][C_V + ch], kkw = F.in[I_KK][ch], kaw = F.in[I_KA][ch];
    const bf16* prow = PROJ + m0 * INPP + ch;
    float rp = 0.f, kp = 0.f, vp = 0.f;
    if (ci > 0) { rp = bf1(prow[-INPP + C_R]); kp = bf1(prow[-INPP + C_K]); vp = bf1(prow[-INPP + C_V]); }
    float ec = 1.f, kkna[RC], kpv[RC], env[RC], vvv[RC];
    float cum = 0.f;
#pragma unroll
    for (int t = 0; t < RC; ++t) {
        const bf16* row = prow + (size_t)t * INPP;
        const float rc = bf1(row[C_R]), kc = bf1(row[C_K]), vc = bf1(row[C_V]);
        const float a = bf1(AA[(m0 + t) * RW + ch]), lw = bf1(LW[(m0 + t) * RW + ch]);
        const float rr = rc + (rp - rc) * mu_r, kx = kc + (kp - kc) * mu_k, vv = vc + (vp - vc) * mu_v;
        rp = rc; kp = kc; vp = vc;
        const float kkraw = kx * kkw; const float ss = wave_sum_pl(kkraw * kkraw);
        const float kkn = kkraw * rcp_f(fmaxf(sqrtf(ss), 1e-12f));
        const float kpp = kx * (1.f + (a - 1.f) * kaw);
        const float ep = ec; cum += lw; ec = __expf(cum); const float en = rcp_f(ec);
        const unsigned p0 = pk2(kkn * ep, kkn * a * en), p1 = pk2(kpp * en, rr * ec), p2 = pk2(vv, 0.f);
        KAP[t * XS + c] = (bf16)p0; ALP[t * XS + c] = (bf16)(p0 >> 16); KT[t * XS + c] = (bf16)p1; RT[t * XS + c] = (bf16)(p1 >> 16);
        KAPT[c * TS + t] = (bf16)p0; VTL[c * TS + t] = (bf16)p2;
        kkna[t] = kkn * a; kpv[t] = kpp; env[t] = en; vvv[t] = vv;
    }
    {
        float e8[8]; v4u* vt = (v4u*)((bf16*)(RO + RO_VT) + (size_t)it * 1024 + c * 16);
#pragma unroll
        for (int i = 0; i < 8; ++i) e8[i] = vvv[i];
        vt[0] = pack8(e8);
#pragma unroll
        for (int i = 0; i < 8; ++i) e8[i] = vvv[8 + i];
        vt[1] = pack8(e8);
        v4u* a2 = (v4u*)((bf16*)(RO + RO_A2) + (size_t)it * 2048 + c * 32);
        float dd[RC];
#pragma unroll
        for (int t = 0; t < RC; ++t) dd[t] = ec * env[t];
#pragma unroll
        for (int i = 0; i < 8; ++i) e8[i] = -kkna[i] * dd[i];
        a2[0] = pack8(e8);
#pragma unroll
        for (int i = 0; i < 8; ++i) e8[i] = -kkna[8 + i] * dd[8 + i];
        a2[1] = pack8(e8);
#pragma unroll
        for (int i = 0; i < 8; ++i) e8[i] = kpv[i] * dd[i];
        a2[2] = pack8(e8);
#pragma unroll
        for (int i = 0; i < 8; ++i) e8[i] = kpv[8 + i] * dd[8 + i];
        a2[3] = pack8(e8);
        ((float*)(RO + RO_GC))[(size_t)it * 64 + c] = ec;
    }
    LDS_WAIT(); asm volatile("" ::: "memory");
    const v2u zero2 = {0u, 0u};
    {
        f32x4 alt = {0.f, 0.f, 0.f, 0.f}, blt = alt, qlt = alt, plt = alt;
#pragma unroll
        for (int ks = 0; ks < 2; ++ks) {
            const bf16x8 fa = *(const LAS bf16x8*)(ALP + r16 * XS + 32 * ks + 8 * q), fk = *(const LAS bf16x8*)(KT + r16 * XS + 32 * ks + 8 * q);
            const bf16x8 fkp = *(const LAS bf16x8*)(KAP + r16 * XS + 32 * ks + 8 * q), fr = *(const LAS bf16x8*)(RT + r16 * XS + 32 * ks + 8 * q);
            alt = __builtin_amdgcn_mfma_f32_16x16x32_bf16(fa, fkp, alt, 0, 0, 0); blt = __builtin_amdgcn_mfma_f32_16x16x32_bf16(fk, fkp, blt, 0, 0, 0);
            qlt = __builtin_amdgcn_mfma_f32_16x16x32_bf16(fa, fr, qlt, 0, 0, 0);  plt = __builtin_amdgcn_mfma_f32_16x16x32_bf16(fk, fr, plt, 0, 0, 0);
        }
#pragma unroll
        for (int j = 0; j < 4; ++j) { const int s = 4 * q + j; const bool lt = s < r16, le = s <= r16;
            alt[j] = lt ? alt[j] : 0.f; blt[j] = lt ? blt[j] : 0.f; qlt[j] = le ? qlt[j] : 0.f; plt[j] = le ? plt[j] : 0.f; }
        *(LAS v2u*)(BL + r16 * SS16 + 4 * q) = pack4(blt); *(LAS v2u*)(QL + r16 * SS16 + 4 * q) = pack4(qlt); *(LAS v2u*)(PL + r16 * SS16 + 4 * q) = pack4(plt);
        *(LAS v2u*)(BL + r16 * SS16 + 16 + 4 * q) = zero2; *(LAS v2u*)(QL + r16 * SS16 + 16 + 4 * q) = zero2; *(LAS v2u*)(PL + r16 * SS16 + 16 + 4 * q) = zero2;
        float x[RC];
#pragma unroll
        for (int t = 0; t < RC; ++t) {
            float acc = (t == r16) ? 1.f : 0.f;
#pragma unroll
            for (int s2 = 0; s2 < t; ++s2) { const float a_ts = __uint_as_float(__builtin_amdgcn_readlane(__float_as_uint(alt[s2 & 3]), 16 * (s2 >> 2) + t)); acc -= a_ts * x[s2]; }
            x[t] = acc;
        }
        if (q == 0) {
#pragma unroll
            for (int t = 0; t < RC; ++t) { TB[t * SS16 + r16] = f2b(x[t]); TB[t * SS16 + 16 + r16] = 0; }
        }
    }
    LDS_WAIT(); asm volatile("" ::: "memory");
    const bf16x8 zf = {0, 0, 0, 0, 0, 0, 0, 0};
    const bf16x8 tbf = *(const LAS bf16x8*)(TB + r16 * SS16 + 8 * q), blf = *(const LAS bf16x8*)(BL + r16 * SS16 + 8 * q);
    const bf16x8 qlf = *(const LAS bf16x8*)(QL + r16 * SS16 + 8 * q), plf = *(const LAS bf16x8*)(PL + r16 * SS16 + 8 * q);
    const f32x4 z4 = {0.f, 0.f, 0.f, 0.f};
    bf16* gWH = (bf16*)(RO + RO_WH) + (size_t)it * 1024; bf16* gRH = (bf16*)(RO + RO_RH) + (size_t)it * 1024;
    bf16* gET = (bf16*)(RO + RO_ET) + (size_t)it * 1024; bf16* gOL = (bf16*)(RO + RO_OL) + (size_t)it * 1024;
#pragma unroll
    for (int kt = 0; kt < 4; ++kt) {
        const bf16x8 kf = (q < 2) ? *(const LAS bf16x8*)(KAPT + (16 * kt + r16) * TS + 8 * q) : zf;
        const f32x4 wa = __builtin_amdgcn_mfma_f32_16x16x32_bf16(kf, tbf, z4, 0, 0, 0);
        *(v2u*)(gWH + r16 * 64 + 16 * kt + 4 * q) = pack4(wa);
        const f32x4 wb = __builtin_amdgcn_mfma_f32_16x16x32_bf16(tbf, kf, z4, 0, 0, 0);
        *(LAS v2u*)(WT + (16 * kt + r16) * TS + 4 * q) = pack4(wb);
        const bf16x8 vf = (q < 2) ? *(const LAS bf16x8*)(VTL + (16 * kt + r16) * TS + 8 * q) : zf;
        const f32x4 bv = __builtin_amdgcn_mfma_f32_16x16x32_bf16(blf, vf, z4, 0, 0, 0);
        *(LAS v2u*)(BVT + (16 * kt + r16) * TS + 4 * q) = pack4(bv);
    }
    LDS_WAIT(); asm volatile("" ::: "memory");
#pragma unroll
    for (int vt = 0; vt < 4; ++vt) {
        const bf16x8 bf_ = (q < 2) ? *(const LAS bf16x8*)(BVT + (16 * vt + r16) * TS + 8 * q) : zf;
        const f32x4 e4 = __builtin_amdgcn_mfma_f32_16x16x32_bf16(tbf, bf_, z4, 0, 0, 0);
        const v2u ep = pack4(e4);
        *(LAS v2u*)(ETL + (16 * vt + r16) * TS + 4 * q) = ep; *(v2u*)(gET + (16 * vt + r16) * 16 + 4 * q) = ep;
    }
    LDS_WAIT(); asm volatile("" ::: "memory");
#pragma unroll
    for (int kt = 0; kt < 4; ++kt) {
        const bf16x8 wf = (q < 2) ? *(const LAS bf16x8*)(WT + (16 * kt + r16) * TS + 8 * q) : zf;
        const f32x4 qw = __builtin_amdgcn_mfma_f32_16x16x32_bf16(wf, qlf, z4, 0, 0, 0);
        const f32x4 rt4 = unpack4(*(const LAS v2u*)(RT + r16 * XS + 16 * kt + 4 * q));
        *(v2u*)(gRH + r16 * 64 + 16 * kt + 4 * q) = pack4(rt4 - qw);
        const bf16x8 vf = (q < 2) ? *(const LAS bf16x8*)(VTL + (16 * kt + r16) * TS + 8 * q) : zf;
        const bf16x8 ef = (q < 2) ? *(const LAS bf16x8*)(ETL + (16 * kt + r16) * TS + 8 * q) : zf;
        const f32x4 pv = __builtin_amdgcn_mfma_f32_16x16x32_bf16(vf, plf, z4, 0, 0, 0);
        const f32x4 qe = __builtin_amdgcn_mfma_f32_16x16x32_bf16(ef, qlf, z4, 0, 0, 0);
        *(v2u*)(gOL + r16 * 64 + 16 * kt + 4 * q) = pack4(pv - qe);
    }
    LDS_WAIT(); asm volatile("" ::: "memory");
}
__device__ __forceinline__ void ra_part(const Ctx& F, int part) {
    LAS unsigned* ctr = (LAS unsigned*)(F.lds + LDS_BYTES - 48) + part;
    LAS unsigned char* wl = F.lds + F.wave * RL_BYTES;
    for (;;) {
        unsigned idx = 0;
        if (F.lane == 0) idx = __hip_atomic_fetch_add(ctr, 1u, __ATOMIC_RELAXED, __HIP_MEMORY_SCOPE_WORKGROUP);
        idx = (unsigned)__builtin_amdgcn_readfirstlane((int)idx);
        const int it = (int)blockIdx.x + F.G * (int)idx;
        if (it >= RITEMS) break;
        ra_item(F, wl, it, part);
    }
}

__device__ __forceinline__ void rs_half(const Ctx& F, int half) {
    if (F.wave != 0) return;
    const unsigned char* RO = (const unsigned char*)F.out + (size_t)(half & 1) * RO_BUF; bf16* OY = (bf16*)(F.ws + WS_OY);
    float* SSg = (float*)((unsigned char*)F.out + RO_SS);
    LAS bf16* ST = (LAS bf16*)F.lds;
    LAS bf16* ZT = (LAS bf16*)(F.lds + 16 * XS * 2);
    constexpr int ZS = 24;
    const int lane = F.lane, r16 = lane & 15, q = lane >> 4;
    for (int blk = blockIdx.x; blk < NB * RHEADS * 4; blk += F.G) {
        const int xcd = blk & 7, jj = blk >> 3, qt = jj & 3, bh = (jj >> 2) * 8 + xcd, b = bh >> 4, h = bh & 15;
        f32x4 S[4];
        if (half == 0) {
#pragma unroll
            for (int kt = 0; kt < 4; ++kt) S[kt] = (f32x4){0.f, 0.f, 0.f, 0.f};
        } else {
#pragma unroll
            for (int kt = 0; kt < 4; ++kt) S[kt] = *(const f32x4*)(SSg + (size_t)blk * 1024 + (kt * 64 + lane) * 4);
        }
#pragma unroll
        for (int kt = 0; kt < 4; ++kt) *(LAS v2u*)(ST + r16 * XS + 16 * kt + 4 * q) = pack4(S[kt]);
        LDS_WAIT(); asm volatile("" ::: "memory");
        const size_t it0 = (size_t)bh * RHALF;
        const size_t mbase = (size_t)b * SEQ + (size_t)half * RHALF * RC;
#define RS_LOAD(IT, WF, RF, A2F, VF, ET4, OL4, GC4) do { const size_t it_ = (IT); \
        const bf16* wh_ = (const bf16*)(RO + RO_WH) + it_ * 1024 + r16 * 64 + 8 * q; const bf16* rh_ = (const bf16*)(RO + RO_RH) + it_ * 1024 + r16 * 64 + 8 * q; \
        WF[0] = *(const bf16x8*)wh_; WF[1] = *(const bf16x8*)(wh_ + 32); RF[0] = *(const bf16x8*)rh_; RF[1] = *(const bf16x8*)(rh_ + 32); \
        _Pragma("unroll") for (int kt_ = 0; kt_ < 4; ++kt_) { A2F[kt_] = *(const bf16x8*)((const bf16*)(RO + RO_A2) + it_ * 2048 + (16 * kt_ + r16) * 32 + 8 * q); \
            GC4[kt_] = *(const f32x4*)((const float*)(RO + RO_GC) + it_ * 64 + 16 * kt_ + 4 * q); } \
        VF = *(const bf16x8*)((const bf16*)(RO + RO_VT) + it_ * 1024 + (16 * qt + r16) * 16 + 8 * (q & 1)); \
        ET4 = *(const v2u*)((const bf16*)(RO + RO_ET) + it_ * 1024 + (16 * qt + r16) * 16 + 4 * q); \
        OL4 = *(const v2u*)((const bf16*)(RO + RO_OL) + it_ * 1024 + r16 * 64 + 16 * qt + 4 * q); } while (0)
        bf16x8 wfq[2][2], rfq[2][2], a2q[2][4], vfq[2]; v2u etq[2], olq[2]; f32x4 gcq[2][4];
#pragma unroll
        for (int u = 0; u < 2; ++u) RS_LOAD(it0 + u, wfq[u], rfq[u], a2q[u], vfq[u], etq[u], olq[u], gcq[u]);
#define RS_STEP(U, CL) do { const int cl_ = (CL); \
            const bf16x8 sb0 = *(const LAS bf16x8*)(ST + r16 * XS + 8 * q), sb1 = *(const LAS bf16x8*)(ST + r16 * XS + 32 + 8 * q); \
            f32x4 x1 = __builtin_amdgcn_mfma_f32_16x16x32_bf16(wfq[U][0], sb0, (f32x4){0.f, 0.f, 0.f, 0.f}, 0, 0, 0); \
            x1 = __builtin_amdgcn_mfma_f32_16x16x32_bf16(wfq[U][1], sb1, x1, 0, 0, 0); \
            f32x4 ot = __builtin_amdgcn_mfma_f32_16x16x32_bf16(sb0, rfq[U][0], unpack4(olq[U]), 0, 0, 0); \
            ot = __builtin_amdgcn_mfma_f32_16x16x32_bf16(sb1, rfq[U][1], ot, 0, 0, 0); \
            *(LAS v2u*)(ZT + r16 * ZS + 4 * q) = pack4(x1 + unpack4(etq[U])); \
            *(v2u*)(OY + (mbase + (size_t)cl_ * RC + r16) * DM + h * 64 + 16 * qt + 4 * q) = pack4(ot); \
            LDS_WAIT(); asm volatile("" ::: "memory"); \
            const bf16x8 zr = *(const LAS bf16x8*)(ZT + r16 * ZS + 8 * (q & 1)); \
            const bf16x8 bz = (q < 2) ? zr : vfq[U]; \
            _Pragma("unroll") for (int kt = 0; kt < 4; ++kt) { S[kt] = __builtin_amdgcn_mfma_f32_16x16x32_bf16(a2q[U][kt], bz, S[kt] * gcq[U][kt], 0, 0, 0); \
                *(LAS v2u*)(ST + r16 * XS + 16 * kt + 4 * q) = pack4(S[kt]); } \
            RS_LOAD(it0 + ((cl_ + 2 < RHALF) ? cl_ + 2 : RHALF - 1), wfq[U], rfq[U], a2q[U], vfq[U], etq[U], olq[U], gcq[U]);     \
            LDS_WAIT(); asm volatile("" ::: "memory"); } while (0)
#pragma unroll 1
        for (int cl = 0; cl < RHALF; cl += 2) { RS_STEP(0, cl); RS_STEP(1, cl + 1); }
#undef RS_STEP
#undef RS_LOAD
        if (half + 1 < NPART) {
#pragma unroll
            for (int kt = 0; kt < 4; ++kt) *(f32x4*)(SSg + (size_t)blk * 1024 + (kt * 64 + lane) * 4) = S[kt];
        }
    }
}
__device__ __forceinline__ float rowmax16(float x) { x = fmaxf(x, dpp_f<0xB1>(x)); x = fmaxf(x, dpp_f<0x4E>(x)); x = fmaxf(x, dpp_f<0x124>(x)); x = fmaxf(x, dpp_f<0x128>(x)); return x; }
__device__ __forceinline__ int cand_code(int s) {
    if (s < 16) return s << 4;
    if (s < 24) return 1 | ((s - 16) << 4);
    if (s < 29) return 2 | ((s - 24) << 4);
    if (s < 33) return 3 | ((s - 29) << 4);
    if (s < 36) return 4 | ((s - 33) << 4);
    if (s < 42) { const int k = s - 36; return (5 + (k >> 1)) | ((k & 1) << 4); }
    if (s < 50) return 8 + (s - 42);
    return -1;
}
__device__ __forceinline__ int f2ord(float f) { const int b = __float_as_int(f); return b ^ ((b >> 31) & 0x7fffffff); }
__device__ __forceinline__ float ord2f(int k) { return __int_as_float(k ^ ((k >> 31) & 0x7fffffff)); }
template <int CTRL> __device__ __forceinline__ int dpp_i(int x) { return __builtin_amdgcn_mov_dpp(x, CTRL, 0xf, 0xf, true); }
__device__ __forceinline__ int imax(int a, int b) { return a > b ? a : b; }
__device__ __forceinline__ int imin(int a, int b) { return a < b ? a : b; }
__device__ __forceinline__ int rowmax16_i(int x) { x = imax(x, dpp_i<0xB1>(x)); x = imax(x, dpp_i<0x4E>(x)); x = imax(x, dpp_i<0x124>(x)); x = imax(x, dpp_i<0x128>(x)); return x; }
#define CSWAP_(a, b) do { const int hi_ = imax(a, b), lo_ = imin(a, b); a = hi_; b = lo_; } while (0)
template <int NV> __device__ __forceinline__ void sort_desc(int (&v)[NV]);
template <> __device__ __forceinline__ void sort_desc<8>(int (&v)[8]) {
    CSWAP_(v[0], v[1]); CSWAP_(v[2], v[3]); CSWAP_(v[4], v[5]); CSWAP_(v[6], v[7]);
    CSWAP_(v[0], v[2]); CSWAP_(v[1], v[3]); CSWAP_(v[4], v[6]); CSWAP_(v[5], v[7]);
    CSWAP_(v[1], v[2]); CSWAP_(v[5], v[6]);
    CSWAP_(v[0], v[4]); CSWAP_(v[1], v[5]); CSWAP_(v[2], v[6]); CSWAP_(v[3], v[7]);
    CSWAP_(v[2], v[4]); CSWAP_(v[3], v[5]);
    CSWAP_(v[1], v[2]); CSWAP_(v[3], v[4]); CSWAP_(v[5], v[6]);
}
template <> __device__ __forceinline__ void sort_desc<4>(int (&v)[4]) {
    CSWAP_(v[0], v[1]); CSWAP_(v[2], v[3]); CSWAP_(v[0], v[2]); CSWAP_(v[1], v[3]); CSWAP_(v[1], v[2]);
}
template <int NV>
__device__ __forceinline__ void select16x4(int (&v)[4][NV], int r16, float (&kept_f)[4]) {
    const int IMIN = (int)0x80000000;
    int kept[4];
#pragma unroll
    for (int j = 0; j < 4; ++j) { kept[j] = IMIN; sort_desc<NV>(v[j]); }
#pragma unroll 1
    for (int rd = 0; rd < 16; ++rd) {
#pragma unroll
        for (int j = 0; j < 4; ++j) {
            const int m = rowmax16_i(v[j][0]);
            kept[j] = (r16 == rd) ? m : kept[j];
            const bool own = (v[j][0] == m);
#pragma unroll
            for (int i = 0; i < NV - 1; ++i) v[j][i] = own ? v[j][i + 1] : v[j][i];
            v[j][NV - 1] = own ? IMIN : v[j][NV - 1];
        }
    }
#pragma unroll
    for (int j = 0; j < 4; ++j) kept_f[j] = ord2f(kept[j]);
}
__device__ __forceinline__ float dot2bf(unsigned a, unsigned b, float acc) { return __builtin_amdgcn_fdot2_f32_bf16(__builtin_bit_cast(bf16x2_t, a), __builtin_bit_cast(bf16x2_t, b), acc, false); }

constexpr int PT = 16;
constexpr size_t RANGE_BYTES = (size_t)NEXP * 128;

__device__ __forceinline__ void p9_route(const Ctx& F) {
    constexpr int KSTR = 136;
    const bf16* Q = (const bf16*)(F.ws + WS_Q); const bf16* KEYS = (const bf16*)(F.ws + WS_KEYS);
    int* rtE = (int*)(F.ws + WS_RTE); float* rtG = (float*)(F.ws + WS_RTG);
    LAS bf16* KL = (LAS bf16*)F.lds;
    const int lane = F.lane, w = F.wave, r16 = lane & 15, q = lane >> 4, gbase = lane & 48;
    const int h = blockIdx.x & 7, nbh = (F.G - h + 7) >> 3;
    __syncthreads();
    for (int i = F.tid; i < 2 * 128 * 16; i += NTHR) { const int row = i >> 4, ch = i & 15;
        *(LAS v4u*)(KL + row * KSTR + 8 * ch) = *(const v4u*)(KEYS + (size_t)(2 * h * 128 + row) * 128 + 8 * ch); }
    __syncthreads();
    int ci[4], cj[4]; bool cvalid[4];
#pragma unroll
    for (int u = 0; u < 4; ++u) { const int cd = cand_code(r16 + 16 * u); cvalid[u] = cd >= 0; ci[u] = cd & 15; cj[u] = (cd >> 4) & 15; }
    const float NINF = -__builtin_inff();
    const int tstride = nbh * NWAVES;
    int tile = (blockIdx.x >> 3) * NWAVES + w;
    bf16x8 afn[2][4];
    if (tile < M / PT) {
#pragma unroll
        for (int p = 0; p < 2; ++p)
#pragma unroll
            for (int s = 0; s < 4; ++s) afn[p][s] = *(const bf16x8*)(Q + (size_t)(tile * PT + r16) * DM + (2 * h + p) * 128 + 8 * q + 32 * s);
    }
    for (; tile < M / PT; tile += tstride) {
        const int m0 = tile * PT;
        bf16x8 af[2][4];
#pragma unroll
        for (int p = 0; p < 2; ++p)
#pragma unroll
            for (int s = 0; s < 4; ++s) af[p][s] = afn[p][s];
        { const int tn = (tile + tstride < M / PT) ? tile + tstride : tile;
#pragma unroll
            for (int p = 0; p < 2; ++p)
#pragma unroll
                for (int s = 0; s < 4; ++s) afn[p][s] = *(const bf16x8*)(Q + (size_t)(tn * PT + r16) * DM + (2 * h + p) * 128 + 8 * q + 32 * s);
        }
        float top[2][4];
#pragma unroll
        for (int p = 0; p < 2; ++p) {
            int v[4][8];
#pragma unroll
            for (int nt = 0; nt < 8; ++nt) {
                const LAS bf16* krow = KL + (p * 128 + nt * 16 + r16) * KSTR + 8 * q;
                f32x4 acc = {0.f, 0.f, 0.f, 0.f};
#pragma unroll
                for (int s = 0; s < 4; ++s) acc = __builtin_amdgcn_mfma_f32_16x16x32_bf16(af[p][s], *(const LAS bf16x8*)(krow + 32 * s), acc, 0, 0, 0);
                const unsigned tag = 127u - (unsigned)(nt * 16 + r16);
#pragma unroll
                for (int j = 0; j < 4; ++j) v[j][nt] = f2ord(__uint_as_float((__float_as_uint(acc[j]) & ~127u) | tag));
                if (nt & 1) asm volatile("" ::: "memory");
            }
            select16x4<8>(v, r16, top[p]);
        }
        int cv[4][4];
#pragma unroll
        for (int u = 0; u < 4; ++u)
#pragma unroll
            for (int j = 0; j < 4; ++j) {
                const float a = __shfl(top[0][j], gbase + ci[u]), b = __shfl(top[1][j], gbase + cj[u]);
                const float cs = __uint_as_float(__float_as_uint(a) & ~127u) + __uint_as_float(__float_as_uint(b) & ~127u);
                const float pk = __uint_as_float((__float_as_uint(cs) & ~63u) | (63u - (unsigned)(r16 + 16 * u)));
                cv[j][u] = cvalid[u] ? f2ord(pk) : (int)0x80000000;
            }
        float best[4];
        select16x4<4>(cv, r16, best);
#pragma unroll
        for (int j = 0; j < 4; ++j) {
            const unsigned bb = __float_as_uint(best[j]);
            const int cd = cand_code(63 - (int)(bb & 63u));
            const int k0 = 127 - (int)(__float_as_uint(__shfl(top[0][j], gbase + (cd & 15))) & 127u);
            const int k1 = 127 - (int)(__float_as_uint(__shfl(top[1][j], gbase + ((cd >> 4) & 15))) & 127u);
            const float s = __uint_as_float(bb & ~63u);
            const float mx = rowmax16(s), e = __expf(s - mx), sum = rowsum16(e);
            const size_t o = (size_t)(m0 + 4 * q + j) * 128 + h * 16 + r16;
            rtE[o] = k0 * 128 + k1; rtG[o] = e * rcp_f(sum);
        }
    }
}

__device__ __forceinline__ f32x2 cvt2_fp8(unsigned wd, bool hi) { return hi ? __builtin_amdgcn_cvt_pk_f32_fp8((int)wd, true) : __builtin_amdgcn_cvt_pk_f32_fp8((int)wd, false); }
__device__ __forceinline__ void treduce8x16(const float (&p)[16], bool b0, bool b1, bool b2, float& r0, float& r1) {
    float a[8], bq[4];
#pragma unroll
    for (int i = 0; i < 8; ++i) { const float mine = b2 ? p[i + 8] : p[i], send = b2 ? p[i] : p[i + 8]; const float up = dpp_f<0x104>(send), dn = dpp_f<0x114>(send); a[i] = mine + (b2 ? dn : up); }
#pragma unroll
    for (int i = 0; i < 4; ++i) { const float mine = b1 ? a[i + 4] : a[i], send = b1 ? a[i] : a[i + 4]; bq[i] = mine + dpp_f<0x4E>(send); }
    { const float mine = b0 ? bq[2] : bq[0], send = b0 ? bq[0] : bq[2]; r0 = mine + dpp_f<0xB1>(send); }
    { const float mine = b0 ? bq[3] : bq[1], send = b0 ? bq[1] : bq[3]; r1 = mine + dpp_f<0xB1>(send); }
}
struct XGroup { int xg, gwi, stride; };
__device__ __forceinline__ XGroup xgroup(const Ctx& F) { XGroup g; g.xg = blockIdx.x & 7; const int nbg = (F.G - g.xg + 7) >> 3; g.gwi = (blockIdx.x >> 3) * NWAVES + F.wave; g.stride = nbg * NWAVES; return g; }

__device__ __forceinline__ void p10_peer_u(const Ctx& F) {
    typedef int v8i __attribute__((ext_vector_type(8)));
    const unsigned char* PU4 = F.ws + WS_PU8; const unsigned char* X8 = F.ws + WS_X8;
    const int* rtE = (const int*)(F.ws + WS_RTE); unsigned char* PDb = F.ws + WS_PD;
    const XGroup g = xgroup(F);
    const int lane = F.lane, j = lane >> 3, sub = lane & 7, n = lane & 15, kb = lane >> 4;
    const int r = g.xg;
    const unsigned char* tab = PU4 + (size_t)r * RANGE_BYTES;
    const unsigned so = 16u * (unsigned)sub;
    LAS unsigned char* wl = F.lds + F.wave * 16384;
    const int p0 = (kb + (n >> 1)) & 7, p1 = (p0 + 4) & 7;
    const int rot = n >> 1;
    const int xo00 = 32 * ((0 + 0 + (kb >> 1) + rot) & 7) + 16 * (kb & 1), xo01 = 32 * ((0 + 2 + (kb >> 1) + rot) & 7) + 16 * (kb & 1);
    const int xo10 = 32 * ((4 + 0 + (kb >> 1) + rot) & 7) + 16 * (kb & 1), xo11 = 32 * ((4 + 2 + (kb >> 1) + rot) & 7) + 16 * (kb & 1);
    LAS unsigned char* bp0 = wl + n * 128 + 16 * p0; LAS unsigned char* bp1 = wl + n * 128 + 16 * p1;
    LAS unsigned char* wp = wl + lane * 16;
    const bool diag = (n >> 2) == kb; const int sel = lane & 3;
    const int SC = 0x7f7f7f7f;
    int m = g.gwi;
    if (m >= M) return;
    const int st = g.stride;
    v4u ev[4], evn[4], gtA[16], gtB[16], xaA[4], xaB[4];
#define PU_IDS(e, mm) { _Pragma("unroll") for (int i = 0; i < 4; ++i) e[i] = *(const v4u*)(rtE + (size_t)(mm) * 128 + 16 * j + 4 * i); }
#define PU_X(xv, mm) { const unsigned char* xr_ = X8 + (size_t)(mm) * DM + 256 * r; xv[0] = *(const v4u*)(xr_ + xo00); xv[1] = *(const v4u*)(xr_ + xo01); xv[2] = *(const v4u*)(xr_ + xo10); xv[3] = *(const v4u*)(xr_ + xo11); }
#define PU_GATHER(gx, e) { _Pragma("unroll") for (int k = 0; k < 16; ++k) gx[k] = *(const v4u*)(tab + (e[k >> 2][k & 3] * 128u + so)); }
#define PU_CLAMP(mm) (((mm) < M) ? (mm) : m)
#define PU_ITEM(GT, XC, XN, MC) { const int mc_ = (MC); \
        _Pragma("unroll") for (int k = 0; k < 16; ++k) *(LAS v4u*)(wp + k * 1024) = GT[k]; \
        asm volatile("" ::: "memory"); \
        PU_X(XN, PU_CLAMP(mc_ + st)); PU_IDS(evn, PU_CLAMP(mc_ + 3 * st)); \
        asm volatile("" ::: "memory"); \
        PU_GATHER(GT, ev); \
        asm volatile("" ::: "memory"); \
        v8i A0, A1; \
        A0[0] = XC[0].x; A0[1] = XC[0].y; A0[2] = XC[0].z; A0[3] = XC[0].w; A0[4] = XC[1].x; A0[5] = XC[1].y; A0[6] = XC[1].z; A0[7] = XC[1].w; \
        A1[0] = XC[2].x; A1[1] = XC[2].y; A1[2] = XC[2].z; A1[3] = XC[2].w; A1[4] = XC[3].x; A1[5] = XC[3].y; A1[6] = XC[3].z; A1[7] = XC[3].w; \
        float dv[8]; \
        _Pragma("unroll") for (int tg = 0; tg < 4; ++tg) { \
            v4u b0[2], b1[2]; \
            _Pragma("unroll") for (int u = 0; u < 2; ++u) { b0[u] = *(const LAS v4u*)(bp0 + (2 * tg + u) * 2048); b1[u] = *(const LAS v4u*)(bp1 + (2 * tg + u) * 2048); } \
            f32x4 acc[2]; \
            _Pragma("unroll") for (int u = 0; u < 2; ++u) { const v8i B0 = {(int)b0[u].x, (int)b0[u].y, (int)b0[u].z, (int)b0[u].w, 0, 0, 0, 0}; \
                acc[u] = __builtin_amdgcn_mfma_scale_f32_16x16x128_f8f6f4(A0, B0, (f32x4){0.f, 0.f, 0.f, 0.f}, 0, 4, 0, SC, 0, SC); } \
            _Pragma("unroll") for (int u = 0; u < 2; ++u) { const v8i B1 = {(int)b1[u].x, (int)b1[u].y, (int)b1[u].z, (int)b1[u].w, 0, 0, 0, 0}; \
                acc[u] = __builtin_amdgcn_mfma_scale_f32_16x16x128_f8f6f4(A1, B1, acc[u], 0, 4, 0, SC, 0, SC); } \
            _Pragma("unroll") for (int u = 0; u < 2; ++u) { const float lo = s1 ? acc[u][1] : acc[u][0], hi = s1 ? acc[u][3] : acc[u][2]; dv[2 * tg + u] = s2 ? hi : lo; } \
        } \
        asm volatile("" : "+v"(dv[0]), "+v"(dv[1]), "+v"(dv[2]), "+v"(dv[3]), "+v"(dv[4]), "+v"(dv[5]), "+v"(dv[6]), "+v"(dv[7]) :: "memory"); \
        if (diag) *(v4u*)(PDb + ((size_t)r * M + mc_) * 256 + 16 * n) = pack8(dv); \
        _Pragma("unroll") for (int i = 0; i < 4; ++i) ev[i] = evn[i]; }
    const bool s1 = sel & 1, s2 = sel & 2;
    {
        PU_IDS(ev, m); PU_X(xaA, m); PU_IDS(evn, PU_CLAMP(m + st));
        PU_GATHER(gtA, ev);
        PU_GATHER(gtB, evn);
        PU_IDS(ev, PU_CLAMP(m + 2 * st));
    }
    for (; m < M; m += 2 * st) {
        PU_ITEM(gtA, xaA, xaB, m);
        if (m + st < M) PU_ITEM(gtB, xaB, xaA, m + st);
    }
#undef PU_IDS
#undef PU_X
#undef PU_GATHER
#undef PU_CLAMP
#undef PU_ITEM
}

__device__ __forceinline__ void p11_peer_coef(const Ctx& F) {
    const int* rtE = (const int*)(F.ws + WS_RTE); const float* rtG = (const float*)(F.ws + WS_RTG); const unsigned* PD = (const unsigned*)(F.ws + WS_PD);
    const float* usc = (const float*)(F.ws + WS_USC); const float* vsc = (const float*)(F.ws + WS_VSC); float* COEF = (float*)(F.ws + WS_COEF);
    int m = F.gw;
    if (m >= M) return;
    const int st = F.NGW;
    unsigned pd[8]; f32x2 gt; float us0, us1, vs0, vs1; v2u e1;
    {   const size_t o = (size_t)m * 128 + 2 * F.lane;
        const v2u e0 = *(const v2u*)(rtE + o);
#pragma unroll
        for (int r = 0; r < 8; ++r) { const unsigned short* ph = (const unsigned short*)PD + ((size_t)r * M + m) * 128 + F.lane; pd[r] = (unsigned)ph[0] | ((unsigned)ph[64] << 16); }
        gt = *(const f32x2*)(rtG + o);
        const int m1 = (m + st < M) ? m + st : m;
        e1 = *(const v2u*)(rtE + (size_t)m1 * 128 + 2 * F.lane);
        us0 = usc[e0.x]; us1 = usc[e0.y]; vs0 = vsc[e0.x]; vs1 = vsc[e0.y]; }
    for (; m < M; m += st) {
        const int m1 = (m + st < M) ? m + st : m, m2 = (m + 2 * st < M) ? m + 2 * st : m;
        const size_t o = (size_t)m * 128 + 2 * F.lane, o1 = (size_t)m1 * 128 + 2 * F.lane;
        const v2u e2 = *(const v2u*)(rtE + (size_t)m2 * 128 + 2 * F.lane);
        unsigned pdn[8];
#pragma unroll
        for (int r = 0; r < 8; ++r) { const unsigned short* ph = (const unsigned short*)PD + ((size_t)r * M + m1) * 128 + F.lane; pdn[r] = (unsigned)ph[0] | ((unsigned)ph[64] << 16); }
        const f32x2 gtn = *(const f32x2*)(rtG + o1);
        const float us0n = usc[e1.x], us1n = usc[e1.y], vs0n = vsc[e1.x], vs1n = vsc[e1.y];
        asm volatile("" ::: "memory");
        f32x2 d = {0.f, 0.f};
#pragma unroll
        for (int r = 0; r < 8; ++r) d += (f32x2){bflo(pd[r]), bfhi(pd[r])};
        const float d0 = d.x * us0, d1 = d.y * us1;
        f32x2 c; c.x = gt.x * (0.5f * d0 * (1.f + erff(d0 * 0.70710678f))) * vs0; c.y = gt.y * (0.5f * d1 * (1.f + erff(d1 * 0.70710678f))) * vs1;
        {
            float am = fmaxf(fabsf(c.x), fabsf(c.y));
#pragma unroll
            for (int sh = 1; sh < 64; sh <<= 1) am = fmaxf(am, __shfl_xor(am, sh));
            int E = (int)((__float_as_uint(am) >> 23) & 255u); E = E < 8 ? 8 : E;
            const float S = __uint_as_float((unsigned)(261 - E) << 23), Sinv = __uint_as_float((unsigned)(E - 7) << 23);
            const float hx = c.x * S, hy = c.y * S;
            const int h8 = __builtin_amdgcn_cvt_pk_fp8_f32(hx, hy, 0, false);
            const float lx = (hx - __builtin_amdgcn_cvt_f32_fp8(h8, 0)) * 16.f, ly = (hy - __builtin_amdgcn_cvt_f32_fp8(h8, 1)) * 16.f;
            const int l8 = __builtin_amdgcn_cvt_pk_fp8_f32(lx, ly, 0, false);
            unsigned char* ch = (unsigned char*)COEF + (size_t)m * 128 + 16 * (F.lane & 7) + (F.lane >> 3); unsigned char* cl = ch + 4 * MiB;
            ch[0] = (unsigned char)(h8 & 255); ch[8] = (unsigned char)((h8 >> 8) & 255); cl[0] = (unsigned char)(l8 & 255); cl[8] = (unsigned char)((l8 >> 8) & 255);
            if (F.lane == 0) ((float*)((unsigned char*)COEF + 8 * MiB))[m] = Sinv;
        }
#pragma unroll
        for (int r = 0; r < 8; ++r) pd[r] = pdn[r];
        gt = gtn; us0 = us0n; us1 = us1n; vs0 = vs0n; vs1 = vs1n; e1 = e2;
    }
}

__device__ __forceinline__ void p12_peer_v(const Ctx& F) {
    typedef int v8i __attribute__((ext_vector_type(8)));
    typedef int v2i __attribute__((ext_vector_type(2)));
    const unsigned char* PV4 = F.ws + WS_PV8; const int* rtE = (const int*)(F.ws + WS_RTE);
    const unsigned char* CH = F.ws + WS_COEF; const unsigned char* CL = CH + 4 * MiB; const float* CSC = (const float*)(CH + 8 * MiB);
    const float* mod = (const float*)(F.ws + WS_MOD); unsigned short* HB = (unsigned short*)(F.ws + WS_HB);
    const XGroup g = xgroup(F);
    const int lane = F.lane, j = lane >> 3, sub = lane & 7, n = lane & 15, gq = lane >> 4;
    const int r = g.xg;
    const unsigned char* tab = PV4 + (size_t)r * RANGE_BYTES;
    const unsigned so = 16u * (unsigned)sub;
    LAS unsigned char* wl = F.lds + F.wave * 16384;
    LAS unsigned char* wpE = wl + j * 128 + 16 * (sub ^ (j >> 1)); LAS unsigned char* wpO = wl + j * 128 + 16 * (sub ^ (j >> 1) ^ 4);
    LAS unsigned char* rb = wl + (32 * gq + n) * 128; const int nb = 16 * (n >> 1);
    const unsigned char* cab = ((n & 3) == 1 ? CL : CH) + 16 * gq; const bool arow = (n & 3) < 2;
    const int SC = 0x7f7f7f7f;
    int m = g.gwi;
    if (m >= M) return;
    const int st = g.stride;
    struct Nx { v4u a0, a1; unsigned short h[4]; float g2[4]; float cs; };
    v4u ev[4], evn[4], gtA[16], gtB[16]; Nx xA, xB;
#define PV_IDS(e, mm) { _Pragma("unroll") for (int i = 0; i < 4; ++i) e[i] = *(const v4u*)(rtE + (size_t)(mm) * 128 + 16 * j + 4 * i); }
#define PV_NX(X, mm) { const int mq_ = (mm); X.a0 = *(const v4u*)(cab + (size_t)mq_ * 128); X.a1 = *(const v4u*)(cab + (size_t)mq_ * 128 + 64); X.cs = CSC[mq_]; \
        _Pragma("unroll") for (int u = 0; u < 4; ++u) { X.h[u] = HB[(size_t)mq_ * DM + 256 * r + 64 * u + lane]; X.g2[u] = mod[(size_t)(mq_ / SEQ) * MODW + 5 * DM + 256 * r + 64 * u + lane]; } }
#define PV_GATHER(gx, e) { _Pragma("unroll") for (int k = 0; k < 16; ++k) gx[k] = *(const v4u*)(tab + (e[k >> 2][k & 3] * 128u + so)); }
#define PV_CLAMP(mm) (((mm) < M) ? (mm) : m)
#define PV_ITEM(GT, XC, XN, MC) { const int mc_ = (MC); \
        _Pragma("unroll") for (int k = 0; k < 16; ++k) *(LAS v4u*)(((k & 1) ? wpO : wpE) + k * 1024) = GT[k]; \
        asm volatile("" ::: "memory"); \
        PV_NX(XN, PV_CLAMP(mc_ + st)); PV_IDS(evn, PV_CLAMP(mc_ + 3 * st)); \
        asm volatile("" ::: "memory"); \
        PV_GATHER(GT, ev); \
        asm volatile("" ::: "memory"); \
        v8i A; \
        A[0] = arow ? (int)XC.a0.x : 0; A[1] = arow ? (int)XC.a0.y : 0; A[2] = arow ? (int)XC.a0.z : 0; A[3] = arow ? (int)XC.a0.w : 0; \
        A[4] = arow ? (int)XC.a1.x : 0; A[5] = arow ? (int)XC.a1.y : 0; A[6] = arow ? (int)XC.a1.z : 0; A[7] = arow ? (int)XC.a1.w : 0; \
        float res[4]; \
        _Pragma("unroll") for (int q = 0; q < 16; ++q) { \
            LAS unsigned char* ap_ = rb + (nb ^ (8 * q)); \
            const v2i t0 = __builtin_amdgcn_ds_read_tr4_b64_v2i32((LAS v2i*)ap_), t1 = __builtin_amdgcn_ds_read_tr4_b64_v2i32((LAS v2i*)(ap_ + 2048)); \
            const v8i B = {t0.x, t0.y, t1.x, t1.y, 0, 0, 0, 0}; \
            const f32x4 acc = __builtin_amdgcn_mfma_scale_f32_16x16x128_f8f6f4(A, B, (f32x4){0.f, 0.f, 0.f, 0.f}, 0, 4, 0, SC, 0, SC); \
            const float val = acc[0] + acc[1] * 0.0625f; \
            if ((q & 3) == 0) res[q >> 2] = val; else res[q >> 2] = (gq == (q & 3)) ? val : res[q >> 2]; \
        } \
        asm volatile("" : "+v"(res[0]), "+v"(res[1]), "+v"(res[2]), "+v"(res[3]) :: "memory"); \
        _Pragma("unroll") for (int u = 0; u < 4; ++u) { \
            const float h2 = __uint_as_float((unsigned)XC.h[u] << 16) + XC.g2[u] * (res[u] * XC.cs); \
            HB[(size_t)mc_ * DM + 256 * r + 64 * u + lane] = (unsigned short)(pk2(h2, 0.f) & 0xffffu); } \
        _Pragma("unroll") for (int i = 0; i < 4; ++i) ev[i] = evn[i]; }
    {
        PV_IDS(ev, m); PV_NX(xA, m); PV_IDS(evn, PV_CLAMP(m + st));
        PV_GATHER(gtA, ev);
        PV_GATHER(gtB, evn);
        PV_IDS(ev, PV_CLAMP(m + 2 * st));
    }
    for (; m < M; m += 2 * st) {
        PV_ITEM(gtA, xA, xB, m);
        if (m + st < M) PV_ITEM(gtB, xB, xA, m + st);
    }
#undef PV_IDS
#undef PV_NX
#undef PV_GATHER
#undef PV_CLAMP
#undef PV_ITEM
}
#define XB_TMO      128
#define XB_XCNT(j)  (256  + 64 * (j))
#define XB_XSUB(j)  (1280 + 64 * (j))
#define XB_XGEN(j)  (2304 + 64 * (j))
#define XB_TOP      3328
#define XB_TOPGEN   3392
#define XCD_BAR_WORDS 3456
#define XB_SPIN_CAP (1u << 18)

__device__ __forceinline__ unsigned xb_ld(unsigned* p)              { return __hip_atomic_load(p, __ATOMIC_RELAXED, __HIP_MEMORY_SCOPE_AGENT); }
__device__ __forceinline__ unsigned xb_add(unsigned* p, unsigned v) { return __hip_atomic_fetch_add(p, v, __ATOMIC_RELAXED, __HIP_MEMORY_SCOPE_AGENT); }
__device__ __forceinline__ unsigned xb_xcc_id() { return (unsigned)__builtin_amdgcn_s_getreg((3 << 11) | 20) & 0xFu; }
#define XB_SPIN(cond, bar) do { unsigned _sp = 0; while (cond) { __builtin_amdgcn_s_sleep(1); \
    if ((++_sp & 255u) == 0u) { if (xb_ld(&(bar)[XB_TMO])) break; if (_sp > XB_SPIN_CAP) { atomicAdd(&(bar)[XB_TMO], 1u); break; } } } } while (0)

struct XcdBarrier {
    unsigned* bar; unsigned x;
    volatile LAS unsigned* st;
};

__device__ __forceinline__ XcdBarrier xcd_barrier_post(unsigned* bar, volatile LAS unsigned* st) {
    XcdBarrier b; b.bar = bar; b.x = xb_xcc_id(); b.st = st;
    if (threadIdx.x == 0) (void)xb_add(&bar[XB_XCNT(b.x)], 1u);
    return b;
}
__device__ __forceinline__ void xcd_barrier_complete(unsigned* bar, unsigned x, unsigned& nloc, unsigned& nx) {
    const unsigned G = gridDim.x * gridDim.y * gridDim.z;
    unsigned sum, cnt, mine, sp = 0u;
    for (;;) {
        sum = 0u; cnt = 0u; mine = 0u;
#pragma unroll
        for (unsigned j = 0; j < 16; ++j) { const unsigned c = xb_ld(&bar[XB_XCNT(j)]); sum += c; cnt += (c > 0u) ? 1u : 0u; mine = (j == x) ? c : mine; }
        if (sum == G) break;
        __builtin_amdgcn_s_sleep(1);
        if ((++sp & 255u) == 0u) { if (xb_ld(&bar[XB_TMO])) break; if (sp > XB_SPIN_CAP) { atomicAdd(&bar[XB_TMO], 1u); break; } }
    }
    nloc = mine > 0u ? mine : 1u; nx = cnt > 0u ? cnt : 1u;
}

__device__ __forceinline__ void xcd_barrier(const XcdBarrier& b) {
    asm volatile("s_waitcnt vmcnt(0)" ::: "memory");
    __syncthreads();
    if (threadIdx.x == 0) {
        unsigned* bar = b.bar;
        __builtin_amdgcn_s_waitcnt(0);
        unsigned nloc = b.st[0], nx = b.st[1];
        if (nloc == 0u) { xcd_barrier_complete(bar, b.x, nloc, nx); b.st[0] = nloc; b.st[1] = nx; }
        const unsigned old = xb_add(&bar[XB_XSUB(b.x)], 1u);
        const unsigned gen = old / nloc;
        if (old + 1u == (gen + 1u) * nloc) {
            __builtin_amdgcn_fence(__ATOMIC_RELEASE, "agent");
            asm volatile("s_waitcnt vmcnt(0)" ::: "memory");
            const unsigned og = xb_add(&bar[XB_TOP], 1u);
            const unsigned tg = og / nx;
            if (og + 1u == (tg + 1u) * nx) xb_add(&bar[XB_TOPGEN], 1u);
            else XB_SPIN(xb_ld(&bar[XB_TOPGEN]) == tg, bar);
            __builtin_amdgcn_fence(__ATOMIC_ACQUIRE, "agent");
            xb_add(&bar[XB_XGEN(b.x)], 1u);
            asm volatile("s_waitcnt vmcnt(0)" ::: "memory");
        } else {
            XB_SPIN(xb_ld(&bar[XB_XGEN(b.x)]) == gen, bar);
            __builtin_amdgcn_fence(__ATOMIC_ACQUIRE, "agent");
            asm volatile("s_waitcnt vmcnt(0)" ::: "memory");
        }
    }
    __syncthreads();
}

struct Args { const float* in[N_IN]; float* out; unsigned char* ws; int ph_lo, ph_hi; };
constexpr int N_PHASES = 19;

__global__ void __launch_bounds__(NTHR, 2) fwd_kernel(Args args) {
    extern __shared__ __attribute__((aligned(16))) unsigned char lds_raw[];
    cg::grid_group grid = cg::this_grid();
    Ctx F;
    F.lds = (LAS unsigned char*)lds_raw;
    F.tid = threadIdx.x; F.lane = F.tid & 63; F.wave = __builtin_amdgcn_readfirstlane(F.tid >> 6);
    F.G = gridDim.x; F.gw = blockIdx.x * NWAVES + F.wave; F.NGW = F.G * NWAVES;
    F.in = args.in; F.out = args.out; F.ws = args.ws;
    const int lo = args.ph_lo, hi = args.ph_hi;
    volatile LAS unsigned* bst = (volatile LAS unsigned*)(F.lds + LDS_BYTES - 64);
    if (F.tid < 2) bst[F.tid] = 0u;
    if (F.tid < 4) ((volatile LAS unsigned*)(F.lds + LDS_BYTES - 48))[F.tid] = 0u;
    __syncthreads();
    const XcdBarrier bar = xcd_barrier_post((unsigned*)(F.ws + WS_CTL) + 4096, bst);
#define IN(k) (lo <= (k) && (k) < hi)
#ifndef TS_A
#define TS_A -1
#define TS_B -1
#define TS_K 0.1
#endif
    unsigned long long* stamps = (unsigned long long*)(F.ws + WS_CTL + 65536);
#define STAMP(k) do { if (TS_A >= 0 && blockIdx.x == 0 && F.tid == 0) stamps[k] = __builtin_amdgcn_s_memrealtime(); } while (0)
#define REP_MASK 0
#ifndef REP_MASK
#define REP_MASK 0
#endif
#define REPS(k) for (int rep_ = 0; rep_ < 1 + ((REP_MASK >> (k)) & 1); ++rep_)
#define SEAM(k) do { if (IN(k) && IN((k) + 1)) { if ((k) == 0) grid.sync(); else xcd_barrier(bar); } } while (0)

    STAMP(0);
    if (IN(0)) REPS(0) { p0_prologue(F); }
    SEAM(0);
    STAMP(1);
    if (IN(1)) REPS(1) { norm_mod_rows(F, F.in[I_X], F.in[I_N1W], 0, DM, (bf16*)(F.ws + WS_XN)); }
    SEAM(1);
    STAMP(2);
    if (IN(2)) REPS(2) {
        pg8::Gemm g{(const pg8::bf16_t*)(F.ws + WS_XN), (const pg8::bf16_t*)(F.ws + WS_WIN), M, INPP, DM};
        pg8::StaticOrder S; S.init(M, INPP, F.G, (int)blockIdx.x);
        pg8::EpiStoreBf16 E{(pg8::bf16_t*)(F.ws + WS_PROJ), INPP};
        pg8::gemm_phase<pg8::EpiStoreBf16, pg8::StaticOrder, true, true>(F.lds, g, S, E);
    }
    SEAM(2);
#ifndef P3REP
#define P3REP 0
#endif
    STAMP(3);
    if (IN(3)) REPS(3) { p3_lora(F); STAMP(40); m1_chunk_states(F); }
    SEAM(3);
    STAMP(4);
    if (IN(4)) { m2_prefix(F); ra_part(F, 0); }
    SEAM(4);
    STAMP(5);
    if (IN(5)) { rs_half(F, 0); ra_part(F, 1); }
    SEAM(5);
    STAMP(6);
    if (IN(6)) { rs_half(F, 1); ra_part(F, 2); }
    SEAM(6);
    STAMP(7);
    if (IN(7)) { rs_half(F, 2); ra_part(F, 3); }
    SEAM(7);
    STAMP(8);
    if (IN(8)) { rs_half(F, 3); }
    STAMP(9);
    if (IN(9)) REPS(9) { m3_outputs(F); }
    SEAM(9);
    STAMP(10);
    if (IN(10)) { p5_post(F); }
    SEAM(10);
    STAMP(11);
    if (IN(11)) REPS(11) {
        pg8::Gemm g{(const pg8::bf16_t*)(F.ws + WS_OY), (const pg8::bf16_t*)(F.ws + WS_WOUT), M, DM, DM};
        pg8::StaticOrder S; S.init(M, DM, F.G, (int)blockIdx.x);
        pg8::EpiResid E{F.in[I_X], (const float*)(F.ws + WS_MOD) + 2 * DM, (pg8::bf16_t*)(F.ws + WS_HB), DM, SEQ, MODW};
        pg8::gemm_phase<pg8::EpiResid, pg8::StaticOrder, true, true>(F.lds, g, S, E);
    }
    SEAM(11);
    STAMP(12);
    if (IN(12)) REPS(12) { norm_mod_rows_bf16(F, (const bf16*)(F.ws + WS_HB), F.in[I_N2W], 3 * DM, 4 * DM, (bf16*)(F.ws + WS_XN), (unsigned*)(F.ws + WS_X8)); }
    SEAM(12);
    STAMP(13);
    if (IN(13)) REPS(13) {
        pg8::Gemm g{(const pg8::bf16_t*)(F.ws + WS_XN), (const pg8::bf16_t*)(F.ws + WS_WQ), M, DM, DM};
        pg8::StaticOrder S; S.init(M, DM, F.G, (int)blockIdx.x);
        pg8::EpiStoreBf16 E{(pg8::bf16_t*)(F.ws + WS_Q), DM};
        pg8::gemm_phase<pg8::EpiStoreBf16, pg8::StaticOrder, true, true>(F.lds, g, S, E);
    }
    SEAM(13);
    STAMP(14);
    if (IN(14)) REPS(14) { p9_route(F); }
    SEAM(14);
    STAMP(15);
    if (IN(15)) REPS(15) { p10_peer_u(F); }
    SEAM(15);
    STAMP(16);
    if (IN(16)) REPS(16) { p11_peer_coef(F); }
    SEAM(16);
    STAMP(17);
    if (IN(17)) { p12_peer_v(F); }
    SEAM(17);
    STAMP(18);
    if (IN(18)) {
        float oscale = 1.f;
        if (TS_A >= 0) { const volatile unsigned long long* st = stamps; const float frac = (float)(st[TS_B] - st[TS_A]) / (float)(st[17] - st[0]); oscale = 1.f + (float)(TS_K) * frac; }
        final_norm_rows_bf16(F, (const bf16*)(F.ws + WS_HB), F.in[I_FNW], F.out, oscale);
    }
#undef IN
#undef SEAM
}

extern "C" void kernel_launch(void* const* d_in, const int* in_sizes, int n_in, void* d_out, int out_size, void* d_ws, size_t ws_size, hipStream_t stream) {
    static int grid = 0;
    if (grid == 0) {
        if (n_in != N_IN || in_sizes[0] != M * DM || out_size != M * DM || ws_size < WS_END2) {
            fprintf(stderr, "kernel_launch: unexpected shapes: n_in %d in0 %d out %d ws %zu (need %zu)\n", n_in, n_in > 0 ? in_sizes[0] : -1, out_size, ws_size, (size_t)WS_END2); grid = -1; return; }
        int dev = 0, cus = 0, per_cu = 0;
        if (hipGetDevice(&dev) != hipSuccess || hipDeviceGetAttribute(&cus, hipDeviceAttributeMultiprocessorCount, dev) != hipSuccess) { grid = -1; return; }
        if (hipFuncSetAttribute((const void*)fwd_kernel, hipFuncAttributeMaxDynamicSharedMemorySize, LDS_BYTES) != hipSuccess) { fprintf(stderr, "kernel_launch: hipFuncSetAttribute failed\n"); grid = -1; return; }
        if (hipOccupancyMaxActiveBlocksPerMultiprocessor(&per_cu, (const void*)fwd_kernel, NTHR, LDS_BYTES) != hipSuccess || per_cu < 1) { fprintf(stderr, "kernel_launch: occupancy query says %d blocks per CU\n", per_cu); per_cu = 1; }
        (void)hipGetLastError();
        grid = cus;
        fprintf(stderr, "kernel_launch: cus %d per_cu %d grid %d ws %zu\n", cus, per_cu, grid, ws_size);
    }
    if (grid < 0) return;
    (void)hipMemsetAsync((char*)d_ws + WS_CTL, 0, CTL_ZERO_BYTES, stream);
    Args a{};
    for (int i = 0; i < N_IN; ++i) a.in[i] = (const float*)d_in[i];
    a.out = (float*)d_out; a.ws = (unsigned char*)d_ws; a.ph_lo = 0; a.ph_hi = N_PHASES;
    void* kargs[] = {&a};
#ifndef NPASS
#define NPASS 1
#endif
    hipError_t e = hipSuccess;
    for (int pass_ = 0; pass_ < NPASS; ++pass_) {
        if (pass_ > 0) (void)hipMemsetAsync((char*)d_ws + WS_CTL, 0, CTL_ZERO_BYTES, stream);
        e = hipLaunchCooperativeKernel((const void*)fwd_kernel, dim3(grid), dim3(NTHR), kargs, LDS_BYTES, stream);
    }
    if (e != hipSuccess) fprintf(stderr, "kernel_launch: cooperative launch failed: %s (grid %d)\n", hipGetErrorString(e), grid);
}
```
